# Optimizing an MI355X kernel written in HIP

```python
import math
import jax, jax.numpy as jnp
from jax import lax
import numpy as np

D_MODEL = 1024
BATCH = 4
SEQ = 8192
DEPTH = 2

PLE_DIM = 256
RET_HEADS = 4
RET_DK = 128
RET_DV = 128
RET_CHUNK = 128
POOL_WINDOWS = (2, 4, 8, 16)
POOL_GROUP = 128
POOL_WIDTH = len(POOL_WINDOWS) * POOL_GROUP
AB_IN = RET_HEADS * (2 * RET_DK + 2 * RET_DV) + POOL_WIDTH
AB_MIX = RET_HEADS * RET_DV + POOL_WIDTH
C_HEADS = 16
C_HEAD_DIM = 64
C_Q_RANK = 256
C_KV_RANK = 256
IDX_HEADS = 8
IDX_DIM = 64
IDX_TOPK_MAX = 256
Q_BLOCK = 128
C_IN = C_Q_RANK + C_KV_RANK + IDX_HEADS * IDX_DIM + IDX_DIM + IDX_HEADS
N_GROUPS = 4
EXPERTS_PER_GROUP = 8
N_EXPERTS = N_GROUPS * EXPERTS_PER_GROUP
TOPK_IN_GROUP = 2
EXPERT_FF = 512
MOE_BLOCK = 128
ALPHA = (2.0 * DEPTH) ** 0.25
BETA = (8.0 * DEPTH) ** -0.25
LN_EPS = 1e-5
N_EVEN = (DEPTH + 1) // 2
N_ODD = DEPTH // 2

kernel_name = "hybrid_retention_pool_dsa_hmoe"


def layer_norm(x, g, b):
    xf = x.astype(jnp.float32)
    mu = xf.mean(-1, keepdims=True)
    var = jnp.square(xf - mu).mean(-1, keepdims=True)
    return ((xf - mu) * lax.rsqrt(var + LN_EPS) * g + b).astype(x.dtype)


def rms_norm(x, g):
    xf = x.astype(jnp.float32)
    return (xf * lax.rsqrt(jnp.mean(xf * xf, -1, keepdims=True) + 1e-6) * g).astype(x.dtype)


def retention_chunkwise(q, k, v):
    B, T, H, dk = q.shape
    dv = v.shape[-1]
    C = RET_CHUNK
    N = T // C
    log_g = jnp.log1p(-jnp.exp2(-5.0 - jnp.arange(H, dtype=jnp.float32)))
    i = jnp.arange(C, dtype=jnp.float32)
    diff = i[:, None] - i[None, :]
    inner_decay = jnp.where(diff >= 0, jnp.exp(log_g[:, None, None] * jnp.maximum(diff, 0.0)), 0.0)
    q_decay = jnp.exp(log_g[:, None] * (i + 1.0))
    k_decay = jnp.exp(log_g[:, None] * (C - 1.0 - i))
    chunk_decay = jnp.exp(log_g * C)

    def to_chunks(a):
        return a.astype(jnp.float32).reshape(B, N, C, H, a.shape[-1]).transpose(1, 0, 3, 2, 4)

    def step(R, inp):
        qi, ki, vi = inp
        s = jnp.einsum('bhqd,bhkd->bhqk', qi, ki) * inner_decay
        o = jnp.einsum('bhqk,bhkv->bhqv', s, vi) + jnp.einsum('bhqd,bhdv->bhqv', qi * q_decay[..., None], R)
        R = R * chunk_decay[:, None, None] + jnp.einsum('bhkd,bhkv->bhdv', ki * k_decay[..., None], vi)
        return R, o

    R0 = jnp.zeros((B, H, dk, dv), jnp.float32)
    _, o = lax.scan(step, R0, (to_chunks(q), to_chunks(k), to_chunks(v)))
    return o.transpose(1, 0, 3, 2, 4).reshape(B, T, H, dv)


def causal_multiscale_pool(u, w_group, scale):
    B, T, _ = u.shape
    nG = len(POOL_WINDOWS)
    uf = u.astype(jnp.float32).reshape(B, T, nG, POOL_GROUP)
    c = jnp.concatenate([jnp.zeros((B, 1, nG, POOL_GROUP), jnp.float32), jnp.cumsum(uf, axis=1)], axis=1)
    t = jnp.arange(T)
    means = []
    for gi, w in enumerate(POOL_WINDOWS):
        cg = c[:, :, gi]
        lo = jnp.maximum(t + 1 - w, 0)
        cnt = jnp.minimum(t + 1, w).astype(jnp.float32)
        means.append((cg[:, 1:] - cg[:, lo]) / cnt[None, :, None])
    d = jnp.stack(means, axis=2) - uf
    y = jnp.einsum('btgc,gcd->btgd', d, w_group.astype(jnp.float32)) * scale.reshape(nG, POOL_GROUP)
    return y.reshape(B, T, nG * POOL_GROUP)


def mixer_ab(x, w_in, gn_g, pool_w, pool_scale, w_out):
    B, T, _ = x.shape
    nq = RET_HEADS * RET_DK
    nv = RET_HEADS * RET_DV
    z = x @ w_in
    q, k, v, g, u = jnp.split(z, [nq, 2 * nq, 2 * nq + nv, 2 * nq + 2 * nv], axis=-1)
    q = q.reshape(B, T, RET_HEADS, RET_DK)
    k = k.reshape(B, T, RET_HEADS, RET_DK) * (RET_DK ** -0.5)
    v = v.reshape(B, T, RET_HEADS, RET_DV)
    o = retention_chunkwise(q, k, v)
    mu = o.mean(-1, keepdims=True)
    var = jnp.square(o - mu).mean(-1, keepdims=True)
    o = ((o - mu) * lax.rsqrt(var + LN_EPS)).reshape(B, T, nv) * gn_g
    ret = jax.nn.silu(g.astype(jnp.float32)) * o
    pool = causal_multiscale_pool(u, pool_w, pool_scale)
    mixed = jnp.concatenate([ret, pool], axis=-1).astype(x.dtype)
    return mixed @ w_out


def alibi_slopes(n):
    return jnp.exp2(-8.0 * jnp.arange(1, n + 1, dtype=jnp.float32) / n)


def mixer_c(x, w_in, q_norm, kv_norm, w_uq, w_uk, w_uv, w_out):
    B, T, _ = x.shape
    topk = min(IDX_TOPK_MAX, T // 4)
    z = x @ w_in
    s1 = C_Q_RANK
    s2 = s1 + C_KV_RANK
    s3 = s2 + IDX_HEADS * IDX_DIM
    s4 = s3 + IDX_DIM
    c_q, c_kv, q_idx, k_idx, w_idx = jnp.split(z, [s1, s2, s3, s4], axis=-1)
    c_q = rms_norm(c_q, q_norm)
    c_kv = rms_norm(c_kv, kv_norm)
    q_idx = q_idx.reshape(B, T, IDX_HEADS, IDX_DIM)
    slopes = alibi_slopes(C_HEADS)
    scale = C_HEAD_DIM ** -0.5
    pos = jnp.arange(T)

    def block(bi):
        start = bi * Q_BLOCK
        tq = start + jnp.arange(Q_BLOCK)
        qb = lax.dynamic_slice_in_dim(q_idx, start, Q_BLOCK, axis=1)
        wb = lax.dynamic_slice_in_dim(w_idx, start, Q_BLOCK, axis=1)
        cqb = lax.dynamic_slice_in_dim(c_q, start, Q_BLOCK, axis=1)
        sc = jax.nn.relu(jnp.einsum('bqhd,bsd->bqhs', qb, k_idx))
        I = jnp.einsum('bqh,bqhs->bqs', wb, sc).astype(jnp.float32)
        I = jnp.where((pos[None, :] <= tq[:, None])[None], I, -jnp.inf)
        _, idx = lax.top_k(I, topk)
        valid = idx <= tq[None, :, None]
        c_sel = jax.vmap(lambda c, i: c[i])(c_kv, idx)
        qh = (cqb @ w_uq).reshape(B, Q_BLOCK, C_HEADS, C_HEAD_DIM)
        q_abs = jnp.einsum('bqhd,chd->bqhc', qh, w_uk)
        logits = jnp.einsum('bqhc,bqkc->bqhk', q_abs, c_sel).astype(jnp.float32) * scale
        dist = (tq[None, :, None] - idx).astype(jnp.float32)
        logits = logits - slopes[None, None, :, None] * dist[:, :, None, :]
        logits = jnp.where(valid[:, :, None, :], logits, -jnp.inf)
        prob = jax.nn.softmax(logits, axis=-1).astype(c_sel.dtype)
        o_lat = jnp.einsum('bqhk,bqkc->bqhc', prob, c_sel)
        o = jnp.einsum('bqhc,chd->bqhd', o_lat, w_uv)
        return o.reshape(B, Q_BLOCK, C_HEADS * C_HEAD_DIM)

    o = lax.map(block, jnp.arange(T // Q_BLOCK))
    o = o.transpose(1, 0, 2, 3).reshape(B, T, C_HEADS * C_HEAD_DIM)
    return o @ w_out


def hierarchical_moe(x, w_group, b_group, w_expert, b_expert, w_gu, w_down):
    B, T, D = x.shape
    N = B * T
    xt = x.reshape(N, D)
    ar = jnp.arange(N)
    g_logits = (xt @ w_group).astype(jnp.float32) + b_group
    g_prob = jax.nn.softmax(g_logits, axis=-1)
    _, grp = lax.top_k(g_logits, 1)
    grp = grp[:, 0]
    g_w = g_prob[ar, grp]
    e_logits = ((xt @ w_expert).astype(jnp.float32) + b_expert).reshape(N, N_GROUPS, EXPERTS_PER_GROUP)
    e_logits = e_logits[ar, grp]
    top_v, top_i = lax.top_k(e_logits, TOPK_IN_GROUP)
    gate = g_w[:, None] * jax.nn.softmax(top_v, axis=-1)
    expert = grp[:, None] * EXPERTS_PER_GROUP + top_i
    M = N * TOPK_IN_GROUP
    flat_e = expert.reshape(M)
    flat_tok = jnp.repeat(ar, TOPK_IN_GROUP)
    flat_gate = gate.reshape(M)
    order = jnp.argsort(flat_e)
    e_sorted = flat_e[order]
    counts = jnp.bincount(flat_e, length=N_EXPERTS)
    start = jnp.cumsum(counts) - counts
    padded = ((counts + MOE_BLOCK - 1) // MOE_BLOCK) * MOE_BLOCK
    pend = jnp.cumsum(padded)
    pstart = pend - padded
    dest = pstart[e_sorted] + (jnp.arange(M) - start[e_sorted])
    n_blocks = -(-(M + N_EXPERTS * (MOE_BLOCK - 1)) // MOE_BLOCK)
    R = n_blocks * MOE_BLOCK
    row_tok = jnp.zeros((R,), jnp.int32).at[dest].set(flat_tok[order].astype(jnp.int32))
    row_gate = jnp.zeros((R,), jnp.float32).at[dest].set(flat_gate[order])
    blk_e = jnp.minimum(jnp.searchsorted(pend, jnp.arange(n_blocks) * MOE_BLOCK, side='right'), N_EXPERTS - 1)

    def run(args):
        tok, e = args
        h = xt[tok] @ w_gu[e]
        a, b = jnp.split(h, 2, axis=-1)
        return (jax.nn.silu(a) * b) @ w_down[e]

    ys = lax.map(run, (row_tok.reshape(n_blocks, MOE_BLOCK), blk_e)).reshape(R, D)
    y = jnp.zeros((N, D), jnp.float32).at[row_tok].add(ys.astype(jnp.float32) * row_gate[:, None])
    return y.astype(x.dtype).reshape(B, T, D)


def setup_inputs(seed: int = 0) -> dict:
    key = jax.random.key(seed)
    ks = iter(jax.random.split(key, 40))
    f32 = jnp.float32

    def nrm(shape, s):
        return jax.random.normal(next(ks), shape, f32) * s

    def gain(shape):
        return 1.0 + 0.02 * jax.random.normal(next(ks), shape, f32)

    nq = RET_HEADS * RET_DK
    nv = RET_HEADS * RET_DV
    ab_col_scale = jnp.ones((AB_IN,), f32).at[2 * nq:2 * nq + nv].set(BETA)
    return {
        "x": nrm((BATCH, SEQ, D_MODEL), 1.0),
        "p": nrm((DEPTH, BATCH, SEQ, PLE_DIM), 1.0),
        "ab_w_in": nrm((N_EVEN, D_MODEL, AB_IN), D_MODEL ** -0.5) * ab_col_scale,
        "ret_gn_g": gain((N_EVEN, nv)),
        "pool_w": nrm((N_EVEN, len(POOL_WINDOWS), POOL_GROUP, POOL_GROUP), POOL_GROUP ** -0.5 * BETA),
        "pool_scale": gain((N_EVEN, POOL_WIDTH)),
        "ab_w_out": nrm((N_EVEN, AB_MIX, D_MODEL), AB_MIX ** -0.5 * BETA),
        "c_w_in": nrm((N_ODD, D_MODEL, C_IN), D_MODEL ** -0.5),
        "c_q_norm": gain((N_ODD, C_Q_RANK)),
        "c_kv_norm": gain((N_ODD, C_KV_RANK)),
        "c_w_uq": nrm((N_ODD, C_Q_RANK, C_HEADS * C_HEAD_DIM), C_Q_RANK ** -0.5),
        "c_w_uk": nrm((N_ODD, C_KV_RANK, C_HEADS, C_HEAD_DIM), C_KV_RANK ** -0.5),
        "c_w_uv": nrm((N_ODD, C_KV_RANK, C_HEADS, C_HEAD_DIM), C_KV_RANK ** -0.5 * BETA),
        "c_w_out": nrm((N_ODD, C_HEADS * C_HEAD_DIM, D_MODEL), (C_HEADS * C_HEAD_DIM) ** -0.5 * BETA),
        "ln1_g": gain((DEPTH, D_MODEL)),
        "ln1_b": nrm((DEPTH, D_MODEL), 0.02),
        "ln2_g": gain((DEPTH, D_MODEL)),
        "ln2_b": nrm((DEPTH, D_MODEL), 0.02),
        "moe_w_group": nrm((DEPTH, D_MODEL, N_GROUPS), D_MODEL ** -0.5),
        "moe_b_group": nrm((DEPTH, N_GROUPS), 0.01),
        "moe_w_expert": nrm((DEPTH, D_MODEL, N_EXPERTS), D_MODEL ** -0.5),
        "moe_b_expert": nrm((DEPTH, N_EXPERTS), 0.01),
        "moe_w_gu": nrm((DEPTH, N_EXPERTS, D_MODEL, 2 * EXPERT_FF), D_MODEL ** -0.5),
        "moe_w_down": nrm((DEPTH, N_EXPERTS, EXPERT_FF, D_MODEL), EXPERT_FF ** -0.5 * BETA),
        "ple_w_gate": nrm((DEPTH, D_MODEL, D_MODEL), D_MODEL ** -0.5),
        "ple_w_proj": nrm((DEPTH, PLE_DIM, D_MODEL), PLE_DIM ** -0.5),
    }


def reference(x, p, ab_w_in, ret_gn_g, pool_w, pool_scale, ab_w_out,
              c_w_in, c_q_norm, c_kv_norm, c_w_uq, c_w_uk, c_w_uv, c_w_out,
              ln1_g, ln1_b, ln2_g, ln2_b,
              moe_w_group, moe_b_group, moe_w_expert, moe_b_expert, moe_w_gu, moe_w_down,
              ple_w_gate, ple_w_proj):
    for i in range(DEPTH):
        j = i // 2
        if i % 2 == 0:
            h = mixer_ab(x, ab_w_in[j], ret_gn_g[j], pool_w[j], pool_scale[j], ab_w_out[j])
        else:
            h = mixer_c(x, c_w_in[j], c_q_norm[j], c_kv_norm[j], c_w_uq[j], c_w_uk[j], c_w_uv[j], c_w_out[j])
        x = layer_norm(ALPHA * x + h.astype(x.dtype), ln1_g[i], ln1_b[i])
        m = hierarchical_moe(x, moe_w_group[i], moe_b_group[i], moe_w_expert[i], moe_b_expert[i],
                             moe_w_gu[i], moe_w_down[i])
        x = layer_norm(ALPHA * x + m, ln2_g[i], ln2_b[i])
        x = x + jax.nn.sigmoid(x @ ple_w_gate[i]) * (p[i] @ ple_w_proj[i])
    return x
```

```cpp
#include <hip/hip_runtime.h>
#include <hip/hip_cooperative_groups.h>
#include <cstdio>
#include <cstdint>
namespace cg = cooperative_groups;

#ifndef MK_ONE_LAUNCH
#define MK_ONE_LAUNCH 0
#endif

typedef unsigned short bf16_t;
typedef float f32x4 __attribute__((ext_vector_type(4)));
typedef unsigned u32x4 __attribute__((ext_vector_type(4)));
typedef unsigned u32x2 __attribute__((ext_vector_type(2)));

constexpr int NT = 512;
constexpr int NWAVE = NT / 64;
constexpr int NTOK = 32768, DM = 1024, SEQ = 8192, NBATCH = 4;
constexpr int ZW = 2560;
constexpr int Z1W = 1280;
constexpr int CIN = 1096;
constexpr int TOPK = 256;
constexpr float ALPHA = 1.4142135623730951f;
constexpr float LN_EPS = 1e-5f;
constexpr int LDS_BYTES = 147456;
constexpr int MISC_OFF = 135168;

constexpr size_t MiB = (size_t)1 << 20;
constexpr size_t WS_CTL = 0;
constexpr size_t WS_W_IN0 = 1 * MiB, WS_W_OUT0 = 6 * MiB, WS_W_POOL = 8 * MiB, WS_W_CIN = 9 * MiB, WS_W_QA = 12 * MiB,
                 WS_W_UVBD = 14 * MiB, WS_W_COUT = 16 * MiB, WS_W_G = 18 * MiB, WS_W_P = 22 * MiB, WS_W_GU = 24 * MiB, WS_W_DN = 152 * MiB;
constexpr size_t WS_XB = 224 * MiB, WS_F = 288 * MiB, WS_PB = 416 * MiB, WS_PP = 448 * MiB, WS_CQ = 512 * MiB, WS_CKV = 528 * MiB,
                 WS_SEL = 544 * MiB, WS_TOKG = 560 * MiB, WS_LIST = 561 * MiB;
constexpr size_t WS_M0 = 576 * MiB;
constexpr size_t WS_Z0 = WS_M0, WS_KV = WS_M0 + 160 * MiB, WS_MIX = WS_M0 + 224 * MiB, WS_DP = WS_M0 + 288 * MiB;
constexpr size_t WS_QA = WS_M0, WS_Z1 = WS_M0 + 256 * MiB;
constexpr size_t WS_ACT = WS_M0, WS_YS = WS_M0 + 72 * MiB;
constexpr size_t WS_XB2 = 912 * MiB;
constexpr size_t WS_END = 976 * MiB;
constexpr int LIST_CAP = 32768;

struct Params {
    const float* in[26];
    float* out;
    unsigned char* ws;
};

__device__ __forceinline__ unsigned f2bf(float f) { unsigned u = __float_as_uint(f); return (u + 0x7fffu + ((u >> 16) & 1u)) >> 16; }
__device__ __forceinline__ float bf2f(unsigned h) { return __uint_as_float(h << 16); }
__device__ __forceinline__ unsigned pk2(float lo, float hi) { return f2bf(lo) | (f2bf(hi) << 16); }
__device__ __forceinline__ float bflo(unsigned w) { return __uint_as_float(w << 16); }
__device__ __forceinline__ float bfhi(unsigned w) { return __uint_as_float(w & 0xffff0000u); }
__device__ __forceinline__ float wave_sum(float v) {
#pragma unroll
    for (int o = 1; o < 64; o <<= 1) v += __shfl_xor(v, o);
    return v;
}
__device__ __forceinline__ float wave_max(float v) {
#pragma unroll
    for (int o = 1; o < 64; o <<= 1) v = fmaxf(v, __shfl_xor(v, o));
    return v;
}
__device__ __forceinline__ float silu_f(float a) { return a / (1.0f + __expf(-a)); }
__device__ __forceinline__ float sigmoid_f(float a) { return 1.0f / (1.0f + __expf(-a)); }
#define LDS_FENCE() asm volatile("s_waitcnt lgkmcnt(0)" ::: "memory")

struct UnitInfo {
    const bf16_t* A; int lda;
    const int* rows; int rshift;
    int nvalid;
    const bf16_t* Bt; int ldb;
    int K;
    int orow0;
    int pn;
};
__device__ __forceinline__ const bf16_t* unit_arow(const UnitInfo& u, int r) {
    if (u.rows) { const int idx = (r < u.nvalid) ? (u.rows[r] >> u.rshift) : 0; return u.A + (size_t)idx * u.lda; }
    return u.A + (size_t)r * u.lda;
}

struct DenseSched {
    const bf16_t* A; const bf16_t* Bt; int M, N, K, lda, a_pn_stride;
    __device__ __forceinline__ bool get(int i, UnitInfo& u) const {
        const int nN = N >> 8, nM = M >> 8;
        if (i >= nN * nM) return false;
        const int pm = i / nN, pn = i % nN;
        u.A = A + (size_t)pm * 256 * lda + (size_t)pn * a_pn_stride; u.lda = lda; u.rows = nullptr; u.rshift = 0; u.nvalid = 256;
        u.Bt = Bt + (size_t)pn * 256 * K; u.ldb = K; u.K = K; u.orow0 = pm * 256; u.pn = pn;
        return true;
    }
};
struct MoeSched {
    const int* tb; const int* cnt; const int* list;
    const bf16_t* A; const bf16_t* W; int K; size_t wstride; bool gather;
    __device__ __forceinline__ bool get(int i, UnitInfo& u) const {
        const int j = i >> 2, pn = i & 3;
        if (j >= tb[32]) return false;
        int e = 0;
        while (tb[e + 1] <= j) ++e;
        const int rb = j - tb[e];
        const int nv = min(256, cnt[e] - rb * 256);
        u.rows = list + (size_t)e * LIST_CAP + rb * 256; u.nvalid = nv; u.orow0 = j * 256; u.pn = pn;
        if (gather) { u.A = A; u.lda = K; u.rshift = 1; }
        else { u.A = A + (size_t)j * 256 * K; u.lda = K; u.rshift = 31;   }
        u.Bt = W + (size_t)e * wstride + (size_t)pn * 256 * K; u.ldb = K; u.K = K;
        return true;
    }
};

template <class Sched, class Epi>
__device__ __forceinline__ void gemm_simple(unsigned char* lds, const Sched& S, const Epi& E, bool contiguousA) {
    float* As = (float*)lds;
    float* Bs = As + 128 * 33;
    const int tid = threadIdx.x, ty = tid >> 3, tx = tid & 7;
    const int lr = tid >> 2, kc = (tid & 3) * 8;
    UnitInfo u;
    for (int i = blockIdx.x; S.get(i, u); i += gridDim.x) {
        for (int sm = 0; sm < 2; ++sm) {
            const int ar = sm * 128 + lr;
            const bf16_t* arow = contiguousA ? (u.A + (size_t)ar * u.lda) : unit_arow(u, ar);
            for (int sn = 0; sn < 4; ++sn) {
                float acc[2][8];
#pragma unroll
                for (int a = 0; a < 2; ++a)
#pragma unroll
                    for (int b = 0; b < 8; ++b) acc[a][b] = 0.f;
                const bf16_t* brow = u.Bt + (size_t)(sn * 64 + (tid >> 2)) * u.ldb;
                for (int k0 = 0; k0 < u.K; k0 += 32) {
                    const u32x4 av = *(const u32x4*)(arow + k0 + kc);
                    float* ap = As + lr * 33 + kc;
                    ap[0] = bflo(av.x); ap[1] = bfhi(av.x); ap[2] = bflo(av.y); ap[3] = bfhi(av.y);
                    ap[4] = bflo(av.z); ap[5] = bfhi(av.z); ap[6] = bflo(av.w); ap[7] = bfhi(av.w);
                    if (tid < 256) {
                        const u32x4 bv = *(const u32x4*)(brow + k0 + kc);
                        float* bp = Bs + (tid >> 2) * 33 + kc;
                        bp[0] = bflo(bv.x); bp[1] = bfhi(bv.x); bp[2] = bflo(bv.y); bp[3] = bfhi(bv.y);
                        bp[4] = bflo(bv.z); bp[5] = bfhi(bv.z); bp[6] = bflo(bv.w); bp[7] = bfhi(bv.w);
                    }
                    __syncthreads();
#pragma unroll 8
                    for (int kk = 0; kk < 32; ++kk) {
                        const float a0 = As[(2 * ty) * 33 + kk], a1 = As[(2 * ty + 1) * 33 + kk];
#pragma unroll
                        for (int j = 0; j < 8; ++j) { const float b = Bs[(tx * 8 + j) * 33 + kk]; acc[0][j] += a0 * b; acc[1][j] += a1 * b; }
                    }
                    __syncthreads();
                }
#pragma unroll
                for (int rr = 0; rr < 2; ++rr) {
                    const f32x4 v0 = {acc[rr][0], acc[rr][1], acc[rr][2], acc[rr][3]}, v1 = {acc[rr][4], acc[rr][5], acc[rr][6], acc[rr][7]};
                    E(u, sm * 128 + 2 * ty + rr, sn * 64 + tx * 8, v0, v1);
                }
            }
        }
    }
}

__device__ __forceinline__ u32x4 pack8(f32x4 a, f32x4 b) { u32x4 w; w.x = pk2(a.x, a.y); w.y = pk2(a.z, a.w); w.z = pk2(b.x, b.y); w.w = pk2(b.z, b.w); return w; }
struct EpiStoreBf16 {
    bf16_t* O; int ldc; int coff; const float* colscale;
    __device__ __forceinline__ void operator()(const UnitInfo& u, int r, int c, f32x4 v0, f32x4 v1) const {
        const int col = u.pn * 256 + c;
        if (colscale) { const f32x4 s0 = *(const f32x4*)(colscale + col), s1 = *(const f32x4*)(colscale + col + 4); v0 *= s0; v1 *= s1; }
        *(u32x4*)(O + (size_t)(u.orow0 + r) * ldc + coff + col) = pack8(v0, v1);
    }
};
struct EpiResid {
    const float* X; float* Fo;
    __device__ __forceinline__ void operator()(const UnitInfo& u, int r, int c, f32x4 v0, f32x4 v1) const {
        const size_t off = (size_t)(u.orow0 + r) * DM + u.pn * 256 + c;
        const f32x4 x0 = *(const f32x4*)(X + off), x1 = *(const f32x4*)(X + off + 4);
        *(f32x4*)(Fo + off) = x0 * ALPHA + v0; *(f32x4*)(Fo + off + 4) = x1 * ALPHA + v1;
    }
};
struct EpiGU {
    bf16_t* ACT;
    __device__ __forceinline__ void operator()(const UnitInfo& u, int r, int c, f32x4 v0, f32x4 v1) const {
        u32x2 w; w.x = pk2(silu_f(v0.x) * v0.y, silu_f(v0.z) * v0.w); w.y = pk2(silu_f(v1.x) * v1.y, silu_f(v1.z) * v1.w);
        *(u32x2*)(ACT + (size_t)(u.orow0 + r) * 512 + u.pn * 128 + (c >> 1)) = w;
    }
};
struct EpiDown {
    bf16_t* YS;
    __device__ __forceinline__ void operator()(const UnitInfo& u, int r, int c, f32x4 v0, f32x4 v1) const {
        if (r < u.nvalid) { const int pair = u.rows[r]; *(u32x4*)(YS + (size_t)pair * DM + u.pn * 256 + c) = pack8(v0, v1); }
    }
};
struct EpiPle {
    const float* F; const bf16_t* PP; float* OUT; bf16_t* XB;
    __device__ __forceinline__ void operator()(const UnitInfo& u, int r, int c, f32x4 v0, f32x4 v1) const {
        const size_t off = (size_t)(u.orow0 + r) * DM + u.pn * 256 + c;
        const u32x4 pw = *(const u32x4*)(PP + off);
        const f32x4 p0 = {bflo(pw.x), bfhi(pw.x), bflo(pw.y), bfhi(pw.y)}, p1 = {bflo(pw.z), bfhi(pw.z), bflo(pw.w), bfhi(pw.w)};
        f32x4 f0 = *(const f32x4*)(F + off), f1 = *(const f32x4*)(F + off + 4);
        f0.x += sigmoid_f(v0.x) * p0.x; f0.y += sigmoid_f(v0.y) * p0.y; f0.z += sigmoid_f(v0.z) * p0.z; f0.w += sigmoid_f(v0.w) * p0.w;
        f1.x += sigmoid_f(v1.x) * p1.x; f1.y += sigmoid_f(v1.y) * p1.y; f1.z += sigmoid_f(v1.z) * p1.z; f1.w += sigmoid_f(v1.w) * p1.w;
        *(f32x4*)(OUT + off) = f0; *(f32x4*)(OUT + off + 4) = f1;
        if (XB) *(u32x4*)(XB + off) = pack8(f0, f1);
    }
};

__device__ __forceinline__ void tr_item(const float* W, int K, int N, bf16_t* WT, int mode, float* scr, int kb, int nb, int lane) {
    const int k0 = 64 * kb, n0 = 32 * nb;
#pragma unroll 8
    for (int i = 0; i < 32; ++i) { const int kk = 2 * i + (lane >> 5); scr[kk * 33 + (lane & 31)] = W[(size_t)(k0 + kk) * N + n0 + (lane & 31)]; }
    LDS_FENCE();
    const int c = lane & 7;
#pragma unroll
    for (int j = 0; j < 4; ++j) {
        const int n = (lane >> 3) + 8 * j; const float* s = scr + (8 * c) * 33 + n;
        const int ng = n0 + n;
        float sc = 1.f; int nd = ng;
        if (mode == 1) { if (ng >= 512 && ng < 1024) sc = 0.08838834764831845f; }
        if (mode == 2) { nd = (ng < 512) ? 2 * ng : 2 * (ng - 512) + 1; }
        u32x4 o; o.x = pk2(s[0 * 33] * sc, s[1 * 33] * sc); o.y = pk2(s[2 * 33] * sc, s[3 * 33] * sc); o.z = pk2(s[4 * 33] * sc, s[5 * 33] * sc); o.w = pk2(s[6 * 33] * sc, s[7 * 33] * sc);
        *(u32x4*)(WT + (size_t)nd * K + k0 + 8 * c) = o;
    }
    LDS_FENCE();
}
struct TrDesc { const float* src; bf16_t* dst; int K, N, nbatch, mode; };
__device__ __forceinline__ int tr_items(const TrDesc& d) { return d.nbatch * (d.K / 64) * (d.N / 32); }
__device__ __forceinline__ void tr_run(const TrDesc& d, int it, float* scr, int lane) {
    const int per = (d.K / 64) * (d.N / 32), b = it / per, r = it % per, nblk = d.N / 32;
    tr_item(d.src + (size_t)b * d.K * d.N, d.K, d.N, d.dst + (size_t)b * d.K * d.N, d.mode, scr, r / nblk, r % nblk, lane);
}

__device__ __forceinline__ void phase_prep(const Params& P, unsigned char* lds) {
    unsigned char* ws = P.ws;
    const int tid = threadIdx.x, lane = tid & 63, wave = tid >> 6;
    const int gw = blockIdx.x * NWAVE + wave, NGW = gridDim.x * NWAVE;
    float* scr = (float*)lds + wave * (64 * 33);
    TrDesc d[7];
    d[0] = {P.in[22], (bf16_t*)(ws + WS_W_GU), 1024, 1024, 64, 2};
    d[1] = {P.in[23], (bf16_t*)(ws + WS_W_DN), 512, 1024, 64, 0};
    d[2] = {P.in[2], (bf16_t*)(ws + WS_W_IN0), 1024, 2560, 1, 1};
    d[3] = {P.in[6], (bf16_t*)(ws + WS_W_OUT0), 1024, 1024, 1, 0};
    d[4] = {P.in[13], (bf16_t*)(ws + WS_W_COUT), 1024, 1024, 1, 0};
    d[5] = {P.in[24], (bf16_t*)(ws + WS_W_G), 1024, 1024, 2, 0};
    d[6] = {P.in[25], (bf16_t*)(ws + WS_W_P), 256, 1024, 2, 0};
    int total = 0;
#pragma unroll
    for (int i = 0; i < 7; ++i) total += tr_items(d[i]);
    for (int it = gw; it < total; it += NGW) {
        int r = it;
#pragma unroll
        for (int i = 0; i < 7; ++i) { const int n = tr_items(d[i]); if (r >= 0 && r < n) { tr_run(d[i], r, scr, lane); r = -1; } else if (r >= 0) r -= n; }
    }
    const size_t gt = (size_t)blockIdx.x * NT + tid, GS = (size_t)gridDim.x * NT;
    {
        bf16_t* o = (bf16_t*)(ws + WS_W_POOL); const float* pw = P.in[4];
        for (size_t i = gt; i < 512 * 256; i += GS) { const int n = (int)(i >> 8), k = (int)(i & 255), g = n >> 7, dd = n & 127, kg = k >> 7, c = k & 127;
            o[i] = (bf16_t)((kg == (g & 1)) ? f2bf(pw[((size_t)g * 128 + c) * 128 + dd]) : 0u); }
    }
    {
        bf16_t* o = (bf16_t*)(ws + WS_W_CIN); const float* w = P.in[7];
        for (size_t i = gt; i < (size_t)Z1W * 1024; i += GS) { const int n = (int)(i >> 10), k = (int)(i & 1023);
            o[i] = (bf16_t)((n < CIN) ? f2bf(w[(size_t)k * CIN + n]) : 0u); }
    }
    {
        bf16_t* o = (bf16_t*)(ws + WS_W_QA); const float* uq = P.in[10]; const float* uk = P.in[11];
        for (size_t i = gt; i < (size_t)4096 * 256; i += GS) { const int n = (int)(i >> 8), r = (int)(i & 255), h = n >> 8, c = n & 255;
            const float* a = uq + (size_t)r * 1024 + h * 64; const float* b = uk + (size_t)c * 1024 + h * 64; float s = 0.f;
            for (int dd = 0; dd < 64; ++dd) s += a[dd] * b[dd];
            o[i] = (bf16_t)f2bf(s * 0.125f); }
    }
    {
        bf16_t* o = (bf16_t*)(ws + WS_W_UVBD); const float* uv = P.in[12];
        for (size_t i = gt; i < (size_t)1024 * 1024; i += GS) { const int n = (int)(i >> 10), k = (int)(i & 1023), h = n >> 6, dd = n & 63, hq = k >> 8, c = k & 255;
            o[i] = (bf16_t)(((h & 3) == hq) ? f2bf(uv[(size_t)c * 1024 + h * 64 + dd]) : 0u); }
    }
    {
        const f32x4* x = (const f32x4*)P.in[0]; u32x4* xb = (u32x4*)(ws + WS_XB);
        for (size_t i = gt; i < (size_t)NTOK * DM / 8; i += GS) xb[i] = pack8(x[2 * i], x[2 * i + 1]);
        const f32x4* p = (const f32x4*)P.in[1]; u32x4* pb = (u32x4*)(ws + WS_PB);
        for (size_t i = gt; i < (size_t)2 * NTOK * 256 / 8; i += GS) pb[i] = pack8(p[2 * i], p[2 * i + 1]);
    }
}

__device__ __forceinline__ float ret_logg(int h) { return log1pf(-exp2f(-5.0f - (float)h)); }

__device__ __forceinline__ void phase_ret_kv(const Params& P, unsigned char* lds) {
    const bf16_t* Z0 = (const bf16_t*)(P.ws + WS_Z0); float* KV = (float*)(P.ws + WS_KV);
    float* Ks = (float*)lds; float* Vs = Ks + 128 * 128;
    const int tid = threadIdx.x;
    for (int u = blockIdx.x; u < 1024; u += gridDim.x) {
        const int n = u & 63, h = (u >> 6) & 3, b = u >> 8;
        const float lg = ret_logg(h);
        const size_t row0 = (size_t)b * SEQ + n * 128;
        for (int i = tid; i < 128 * 16; i += NT) {
            const int r = i >> 4, c8 = (i & 15) * 8;
            const u32x4 kv = *(const u32x4*)(Z0 + (row0 + r) * ZW + 512 + h * 128 + c8);
            const u32x4 vv = *(const u32x4*)(Z0 + (row0 + r) * ZW + 1024 + h * 128 + c8);
            const float dec = __expf(lg * (float)(127 - r));
            float* kp = Ks + r * 128 + c8; float* vp = Vs + r * 128 + c8;
            kp[0] = bflo(kv.x) * dec; kp[1] = bfhi(kv.x) * dec; kp[2] = bflo(kv.y) * dec; kp[3] = bfhi(kv.y) * dec;
            kp[4] = bflo(kv.z) * dec; kp[5] = bfhi(kv.z) * dec; kp[6] = bflo(kv.w) * dec; kp[7] = bfhi(kv.w) * dec;
            vp[0] = bflo(vv.x); vp[1] = bfhi(vv.x); vp[2] = bflo(vv.y); vp[3] = bfhi(vv.y);
            vp[4] = bflo(vv.z); vp[5] = bfhi(vv.z); vp[6] = bflo(vv.w); vp[7] = bfhi(vv.w);
        }
        __syncthreads();
        const int dd = tid >> 2, v0 = (tid & 3) * 32;
        float acc[32];
#pragma unroll
        for (int j = 0; j < 32; ++j) acc[j] = 0.f;
        for (int i = 0; i < 128; ++i) {
            const float kd = Ks[i * 128 + dd];
#pragma unroll
            for (int j = 0; j < 32; j += 4) { const f32x4 vv = *(const f32x4*)(Vs + i * 128 + v0 + j); acc[j] += kd * vv.x; acc[j + 1] += kd * vv.y; acc[j + 2] += kd * vv.z; acc[j + 3] += kd * vv.w; }
        }
        float* o = KV + (size_t)u * 16384 + dd * 128 + v0;
#pragma unroll
        for (int j = 0; j < 32; j += 4) *(f32x4*)(o + j) = (f32x4){acc[j], acc[j + 1], acc[j + 2], acc[j + 3]};
        __syncthreads();
    }
}
__device__ __forceinline__ void phase_ret_scan_pool(const Params& P) {
    float* KV = (float*)(P.ws + WS_KV);
    const size_t gt = (size_t)blockIdx.x * NT + threadIdx.x, GS = (size_t)gridDim.x * NT;
    for (size_t i = gt; i < (size_t)16 * 4096; i += GS) {
        const int s = (int)(i >> 12), e4 = (int)(i & 4095), h = s & 3;
        const float cd = __expf(ret_logg(h) * 128.0f);
        f32x4* p = (f32x4*)(KV + (size_t)s * 64 * 16384) + e4;
        f32x4 R = {0.f, 0.f, 0.f, 0.f};
        for (int n0 = 0; n0 < 64; n0 += 8) {
            f32x4 kv[8];
#pragma unroll
            for (int j = 0; j < 8; ++j) kv[j] = p[(size_t)(n0 + j) * 4096];
#pragma unroll
            for (int j = 0; j < 8; ++j) { p[(size_t)(n0 + j) * 4096] = R; R = R * cd + kv[j]; }
        }
    }
    const bf16_t* Z0 = (const bf16_t*)(P.ws + WS_Z0); bf16_t* DP = (bf16_t*)(P.ws + WS_DP);
    for (size_t i = gt; i < (size_t)NTOK * 64; i += GS) {
        const int t = (int)(i >> 6), c8 = (int)(i & 63) * 8, g = c8 >> 7, w = 2 << g, tl = t & (SEQ - 1);
        const int cnt = min(tl + 1, w);
        float s[8];
#pragma unroll
        for (int j = 0; j < 8; ++j) s[j] = 0.f;
        float u0[8];
        for (int q = 0; q < cnt; ++q) {
            const u32x4 v = *(const u32x4*)(Z0 + (size_t)(t - q) * ZW + 2048 + c8);
            const float f[8] = {bflo(v.x), bfhi(v.x), bflo(v.y), bfhi(v.y), bflo(v.z), bfhi(v.z), bflo(v.w), bfhi(v.w)};
#pragma unroll
            for (int j = 0; j < 8; ++j) { s[j] += f[j]; if (q == 0) u0[j] = f[j]; }
        }
        const float inv = 1.0f / (float)cnt;
        u32x4 o; o.x = pk2(s[0] * inv - u0[0], s[1] * inv - u0[1]); o.y = pk2(s[2] * inv - u0[2], s[3] * inv - u0[3]);
        o.z = pk2(s[4] * inv - u0[4], s[5] * inv - u0[5]); o.w = pk2(s[6] * inv - u0[6], s[7] * inv - u0[7]);
        *(u32x4*)(DP + (size_t)t * 512 + c8) = o;
    }
}
__device__ __forceinline__ void phase_ret_out(const Params& P, unsigned char* lds) {
    const bf16_t* Z0 = (const bf16_t*)(P.ws + WS_Z0); const float* KV = (const float*)(P.ws + WS_KV); bf16_t* MIX = (bf16_t*)(P.ws + WS_MIX);
    const float* gn = P.in[3];
    bf16_t* Qs = (bf16_t*)lds;
    bf16_t* Ksm = Qs + 128 * 136;
    float* Sc = (float*)(lds + 2 * 128 * 136 * 2);
    const int tid = threadIdx.x;
    for (int u = blockIdx.x; u < 1024; u += gridDim.x) {
        const int n = u & 63, h = (u >> 6) & 3, b = u >> 8;
        const float lg = ret_logg(h);
        const size_t row0 = (size_t)b * SEQ + n * 128;
        for (int i = tid; i < 128 * 16; i += NT) {
            const int r = i >> 4, c8 = (i & 15) * 8;
            *(u32x4*)(Qs + r * 136 + c8) = *(const u32x4*)(Z0 + (row0 + r) * ZW + h * 128 + c8);
            *(u32x4*)(Ksm + r * 136 + c8) = *(const u32x4*)(Z0 + (row0 + r) * ZW + 512 + h * 128 + c8);
        }
        __syncthreads();
        for (int e = tid; e < 128 * 128; e += NT) {
            const int i = e >> 7, j = e & 127;
            float s = 0.f;
            if (j <= i) {
                const bf16_t* q = Qs + i * 136; const bf16_t* k = Ksm + j * 136;
                for (int dd = 0; dd < 128; dd += 2) { const unsigned qa = *(const unsigned*)(q + dd), ka = *(const unsigned*)(k + dd); s += bflo(qa) * bflo(ka) + bfhi(qa) * bfhi(ka); }
                s *= __expf(lg * (float)(i - j));
            }
            Sc[e] = s;
        }
        __syncthreads();
        const int i = tid >> 2, v0 = (tid & 3) * 32;
        float acc[32];
#pragma unroll
        for (int j = 0; j < 32; ++j) acc[j] = 0.f;
        for (int j = 0; j <= i; ++j) {
            const float s = Sc[i * 128 + j];
            const bf16_t* vr = Z0 + (row0 + j) * ZW + 1024 + h * 128 + v0;
#pragma unroll
            for (int q = 0; q < 4; ++q) { const u32x4 vv = *(const u32x4*)(vr + q * 8);
                acc[q * 8 + 0] += s * bflo(vv.x); acc[q * 8 + 1] += s * bfhi(vv.x); acc[q * 8 + 2] += s * bflo(vv.y); acc[q * 8 + 3] += s * bfhi(vv.y);
                acc[q * 8 + 4] += s * bflo(vv.z); acc[q * 8 + 5] += s * bfhi(vv.z); acc[q * 8 + 6] += s * bflo(vv.w); acc[q * 8 + 7] += s * bfhi(vv.w); }
        }
        const float qdec = __expf(lg * (float)(i + 1));
        const float* S = KV + (size_t)u * 16384;
        for (int dd = 0; dd < 128; ++dd) {
            const float qd = bf2f(Qs[i * 136 + dd]) * qdec;
            const float* sr = S + dd * 128 + v0;
#pragma unroll
            for (int q = 0; q < 32; q += 4) { const f32x4 sv = *(const f32x4*)(sr + q); acc[q] += qd * sv.x; acc[q + 1] += qd * sv.y; acc[q + 2] += qd * sv.z; acc[q + 3] += qd * sv.w; }
        }
        float sm = 0.f;
#pragma unroll
        for (int j = 0; j < 32; ++j) sm += acc[j];
        sm += __shfl_xor(sm, 1); sm += __shfl_xor(sm, 2);
        const float mu = sm * (1.0f / 128.0f);
        float sq = 0.f;
#pragma unroll
        for (int j = 0; j < 32; ++j) { const float dlt = acc[j] - mu; sq += dlt * dlt; }
        sq += __shfl_xor(sq, 1); sq += __shfl_xor(sq, 2);
        const float rstd = 1.0f / sqrtf(sq * (1.0f / 128.0f) + LN_EPS);
        const bf16_t* gr = Z0 + (row0 + i) * ZW + 1536 + h * 128 + v0;
        bf16_t* orow = MIX + (row0 + i) * DM + h * 128 + v0;
#pragma unroll
        for (int q = 0; q < 4; ++q) {
            const u32x4 gv = *(const u32x4*)(gr + q * 8);
            const float g8[8] = {bflo(gv.x), bfhi(gv.x), bflo(gv.y), bfhi(gv.y), bflo(gv.z), bfhi(gv.z), bflo(gv.w), bfhi(gv.w)};
            float o8[8];
#pragma unroll
            for (int j = 0; j < 8; ++j) o8[j] = (acc[q * 8 + j] - mu) * rstd * gn[h * 128 + v0 + q * 8 + j] * silu_f(g8[j]);
            u32x4 w; w.x = pk2(o8[0], o8[1]); w.y = pk2(o8[2], o8[3]); w.z = pk2(o8[4], o8[5]); w.w = pk2(o8[6], o8[7]);
            *(u32x4*)(orow + q * 8) = w;
        }
        __syncthreads();
    }
}

__device__ __forceinline__ void phase_ln_route(const Params& P, unsigned char* lds, int layer) {
    float* F = (float*)(P.ws + WS_F); bf16_t* XB = (bf16_t*)(P.ws + WS_XB);
    float* TOKG = (float*)(P.ws + WS_TOKG); int* LIST = (int*)(P.ws + WS_LIST);
    int* CNT = (int*)(P.ws + WS_CTL) + layer * 64;
    const float* lg = P.in[14] + layer * DM; const float* lb = P.in[15] + layer * DM;
    const float* wg = P.in[18] + (size_t)layer * DM * 4; const float* bg = P.in[19] + layer * 4;
    const float* we = P.in[20] + (size_t)layer * DM * 32; const float* be = P.in[21] + layer * 32;
    int* dec = (int*)lds;
    int* rank = dec + 256;
    int* lcnt = rank + 256;
    int* lbase = lcnt + 32;
    const int tid = threadIdx.x, lane = tid & 63, wave = tid >> 6;
    for (int rb = blockIdx.x; rb < NTOK / 128; rb += gridDim.x) {
        if (tid < 32) lcnt[tid] = 0;
        __syncthreads();
        for (int ri = 0; ri < 16; ++ri) {
            const int rl = wave * 16 + ri, t = rb * 128 + rl;
            float* fr = F + (size_t)t * DM;
            f32x4 v[4]; float s = 0.f;
#pragma unroll
            for (int j = 0; j < 4; ++j) { v[j] = *(const f32x4*)(fr + 256 * j + 4 * lane); s += (v[j].x + v[j].y) + (v[j].z + v[j].w); }
            const float mean = wave_sum(s) * (1.0f / DM); float s2 = 0.f;
#pragma unroll
            for (int j = 0; j < 4; ++j) { v[j] = v[j] - mean; s2 += (v[j].x * v[j].x + v[j].y * v[j].y) + (v[j].z * v[j].z + v[j].w * v[j].w); }
            const float rstd = 1.0f / sqrtf(wave_sum(s2) * (1.0f / DM) + LN_EPS);
            float acc[36];
#pragma unroll
            for (int j = 0; j < 36; ++j) acc[j] = 0.f;
#pragma unroll
            for (int j = 0; j < 4; ++j) {
                const int c0 = 256 * j + 4 * lane;
                const f32x4 g4 = *(const f32x4*)(lg + c0), b4 = *(const f32x4*)(lb + c0);
                v[j] = v[j] * rstd * g4 + b4;
                *(f32x4*)(fr + c0) = v[j];
                u32x2 w; w.x = pk2(v[j].x, v[j].y); w.y = pk2(v[j].z, v[j].w);
                *(u32x2*)(XB + (size_t)t * DM + c0) = w;
#pragma unroll
                for (int q = 0; q < 4; ++q) {
                    const float xv = v[j][q]; const int c = c0 + q;
                    const f32x4 w4 = *(const f32x4*)(wg + (size_t)c * 4);
                    acc[0] += xv * w4.x; acc[1] += xv * w4.y; acc[2] += xv * w4.z; acc[3] += xv * w4.w;
#pragma unroll
                    for (int e4 = 0; e4 < 8; ++e4) { const f32x4 w8 = *(const f32x4*)(we + (size_t)c * 32 + e4 * 4);
                        acc[4 + e4 * 4] += xv * w8.x; acc[5 + e4 * 4] += xv * w8.y; acc[6 + e4 * 4] += xv * w8.z; acc[7 + e4 * 4] += xv * w8.w; }
                    asm volatile("" ::: "memory");
                }
            }
#pragma unroll
            for (int j = 0; j < 36; ++j) acc[j] = wave_sum(acc[j]);
            float gl[4];
#pragma unroll
            for (int j = 0; j < 4; ++j) gl[j] = acc[j] + bg[j];
            int grp = 0; float gm = gl[0];
#pragma unroll
            for (int j = 1; j < 4; ++j) if (gl[j] > gm) { gm = gl[j]; grp = j; }
            float gs = 0.f;
#pragma unroll
            for (int j = 0; j < 4; ++j) gs += __expf(gl[j] - gm);
            const float gw = 1.0f / gs;
            float el[8];
#pragma unroll
            for (int j = 0; j < 8; ++j) el[j] = 0.f;
#pragma unroll
            for (int g = 0; g < 4; ++g)
#pragma unroll
                for (int j = 0; j < 8; ++j) el[j] = (g == grp) ? (acc[4 + g * 8 + j] + be[g * 8 + j]) : el[j];
            int i0 = 0; float m0 = el[0];
#pragma unroll
            for (int j = 1; j < 8; ++j) if (el[j] > m0) { m0 = el[j]; i0 = j; }
            int i1 = -1; float m1 = -INFINITY;
#pragma unroll
            for (int j = 0; j < 8; ++j) if (j != i0 && el[j] > m1) { m1 = el[j]; i1 = j; }
            const float ex = __expf(m1 - m0);
            const float p0 = 1.0f / (1.0f + ex), p1 = ex / (1.0f + ex);
            if (lane == 0) {
                dec[rl * 2] = grp * 8 + i0; dec[rl * 2 + 1] = grp * 8 + i1;
                TOKG[(size_t)t * 2] = gw * p0; TOKG[(size_t)t * 2 + 1] = gw * p1;
            }
        }
        __syncthreads();
        if (tid < 256) rank[tid] = atomicAdd(&lcnt[dec[tid]], 1);
        __syncthreads();
        if (tid < 32) lbase[tid] = atomicAdd(&CNT[tid], lcnt[tid]);
        __syncthreads();
        if (tid < 256) { const int e = dec[tid]; LIST[(size_t)e * LIST_CAP + lbase[e] + rank[tid]] = (rb * 128 + (tid >> 1)) * 2 + (tid & 1); }
        __syncthreads();
    }
}
__device__ __forceinline__ void moe_setup(const Params& P, int* tb, int layer) {
    const int* CNT = (const int*)(P.ws + WS_CTL) + layer * 64;
    if (threadIdx.x == 0) { int a = 0; for (int e = 0; e < 32; ++e) { tb[e] = a; a += (CNT[e] + 255) >> 8; } tb[32] = a; }
    __syncthreads();
}
__device__ __forceinline__ void phase_ln2(const Params& P, int layer) {
    float* F = (float*)(P.ws + WS_F); bf16_t* XB = (bf16_t*)(P.ws + WS_XB); const bf16_t* YS = (const bf16_t*)(P.ws + WS_YS); const float* TOKG = (const float*)(P.ws + WS_TOKG);
    const float* lg = P.in[16] + layer * DM; const float* lb = P.in[17] + layer * DM;
    const int lane = threadIdx.x & 63, gw = blockIdx.x * NWAVE + (threadIdx.x >> 6), NGW = gridDim.x * NWAVE;
    for (int t = gw; t < NTOK; t += NGW) {
        float* fr = F + (size_t)t * DM; const float g0 = TOKG[(size_t)t * 2], g1 = TOKG[(size_t)t * 2 + 1];
        const bf16_t* y0 = YS + (size_t)(2 * t) * DM; const bf16_t* y1 = y0 + DM;
        f32x4 v[4]; float s = 0.f;
#pragma unroll
        for (int j = 0; j < 4; ++j) { const int c0 = 256 * j + 4 * lane; v[j] = *(const f32x4*)(fr + c0);
            const u32x2 a = *(const u32x2*)(y0 + c0), b = *(const u32x2*)(y1 + c0);
            v[j].x = v[j].x * ALPHA + g0 * bflo(a.x) + g1 * bflo(b.x); v[j].y = v[j].y * ALPHA + g0 * bfhi(a.x) + g1 * bfhi(b.x);
            v[j].z = v[j].z * ALPHA + g0 * bflo(a.y) + g1 * bflo(b.y); v[j].w = v[j].w * ALPHA + g0 * bfhi(a.y) + g1 * bfhi(b.y);
            s += (v[j].x + v[j].y) + (v[j].z + v[j].w); }
        const float mean = wave_sum(s) * (1.0f / DM); float s2 = 0.f;
#pragma unroll
        for (int j = 0; j < 4; ++j) { v[j] = v[j] - mean; s2 += (v[j].x * v[j].x + v[j].y * v[j].y) + (v[j].z * v[j].z + v[j].w * v[j].w); }
        const float rstd = 1.0f / sqrtf(wave_sum(s2) * (1.0f / DM) + LN_EPS);
#pragma unroll
        for (int j = 0; j < 4; ++j) { const int c0 = 256 * j + 4 * lane;
            const f32x4 g4 = *(const f32x4*)(lg + c0), b4 = *(const f32x4*)(lb + c0);
            v[j] = v[j] * rstd * g4 + b4; *(f32x4*)(fr + c0) = v[j];
            u32x2 w; w.x = pk2(v[j].x, v[j].y); w.y = pk2(v[j].z, v[j].w); *(u32x2*)(XB + (size_t)t * DM + c0) = w; }
    }
}

__device__ __forceinline__ void phase_norms(const Params& P) {
    const bf16_t* Z1 = (const bf16_t*)(P.ws + WS_Z1); bf16_t* CQ = (bf16_t*)(P.ws + WS_CQ); bf16_t* CKV = (bf16_t*)(P.ws + WS_CKV);
    const float* qn = P.in[8]; const float* kn = P.in[9];
    const int lane = threadIdx.x & 63, gw = blockIdx.x * NWAVE + (threadIdx.x >> 6), NGW = gridDim.x * NWAVE;
    for (int t = gw; t < NTOK; t += NGW) {
        const u32x2 a = *(const u32x2*)(Z1 + (size_t)t * Z1W + 4 * lane), b = *(const u32x2*)(Z1 + (size_t)t * Z1W + 256 + 4 * lane);
        const float q[4] = {bflo(a.x), bfhi(a.x), bflo(a.y), bfhi(a.y)}, k[4] = {bflo(b.x), bfhi(b.x), bflo(b.y), bfhi(b.y)};
        const float sq = wave_sum(q[0] * q[0] + q[1] * q[1] + q[2] * q[2] + q[3] * q[3]), sk = wave_sum(k[0] * k[0] + k[1] * k[1] + k[2] * k[2] + k[3] * k[3]);
        const float rq = 1.0f / sqrtf(sq * (1.0f / 256.0f) + 1e-6f), rk = 1.0f / sqrtf(sk * (1.0f / 256.0f) + 1e-6f);
        const f32x4 gq = *(const f32x4*)(qn + 4 * lane), gk = *(const f32x4*)(kn + 4 * lane);
        u32x2 o; o.x = pk2(q[0] * rq * gq.x, q[1] * rq * gq.y); o.y = pk2(q[2] * rq * gq.z, q[3] * rq * gq.w);
        *(u32x2*)(CQ + (size_t)t * 256 + 4 * lane) = o;
        o.x = pk2(k[0] * rk * gk.x, k[1] * rk * gk.y); o.y = pk2(k[2] * rk * gk.z, k[3] * rk * gk.w);
        *(u32x2*)(CKV + (size_t)t * 256 + 4 * lane) = o;
    }
}
__device__ __forceinline__ unsigned fkey(float f) { const unsigned u = __float_as_uint(f); return (u & 0x80000000u) ? ~u : (u | 0x80000000u); }

__device__ __forceinline__ void phase_index(const Params& P, unsigned char* lds) {
    const bf16_t* Z1 = (const bf16_t*)(P.ws + WS_Z1); unsigned short* SEL = (unsigned short*)(P.ws + WS_SEL);
    float* sc = (float*)lds;
    float* qf = sc + 8192;
    float* wf = qf + 512;
    int* hist = (int*)(wf + 8);
    int* misc = hist + 256;
    int* seg = misc + 8;
    const int tid = threadIdx.x;
    for (int t = blockIdx.x; t < NTOK; t += gridDim.x) {
        const int b = t >> 13, tl = t & (SEQ - 1), n = tl + 1;
        unsigned short* so = SEL + (size_t)t * TOPK;
        if (n <= TOPK) { if (tid < n) so[tid] = (unsigned short)tid; continue; }
        qf[tid] = bf2f(Z1[(size_t)t * Z1W + 512 + tid]);
        if (tid < 8) wf[tid] = bf2f(Z1[(size_t)t * Z1W + 1088 + tid]);
        __syncthreads();
        for (int s = tid; s < n; s += NT) {
            const bf16_t* kr = Z1 + ((size_t)b * SEQ + s) * Z1W + 1024;
            float k[64];
#pragma unroll
            for (int q = 0; q < 8; ++q) { const u32x4 v = *(const u32x4*)(kr + q * 8);
                k[q * 8] = bflo(v.x); k[q * 8 + 1] = bfhi(v.x); k[q * 8 + 2] = bflo(v.y); k[q * 8 + 3] = bfhi(v.y);
                k[q * 8 + 4] = bflo(v.z); k[q * 8 + 5] = bfhi(v.z); k[q * 8 + 6] = bflo(v.w); k[q * 8 + 7] = bfhi(v.w); }
            float I = 0.f;
#pragma unroll
            for (int h = 0; h < 8; ++h) { float d = 0.f;
#pragma unroll
                for (int dd = 0; dd < 64; ++dd) d += qf[h * 64 + dd] * k[dd];
                I += wf[h] * fmaxf(d, 0.f); }
            sc[s] = I;
        }
        if (tid == 0) { misc[0] = 0; misc[1] = TOPK; misc[2] = 0; }
        __syncthreads();
        for (int pass = 0; pass < 4; ++pass) {
            const int shift = 24 - 8 * pass;
            if (tid < 256) hist[tid] = 0;
            __syncthreads();
            const unsigned prefix = (unsigned)misc[0]; const int kk = misc[1];
            for (int s = tid; s < n; s += NT) { const unsigned key = fkey(sc[s]);
                if (pass == 0 || (key >> (shift + 8)) == prefix) atomicAdd(&hist[(key >> shift) & 255], 1); }
            __syncthreads();
            if (tid == 0) { int a = 0, bsel = 0; for (int bin = 255; bin >= 0; --bin) { const int c = hist[bin]; if (a + c >= kk) { bsel = bin; break; } a += c; }
                misc[0] = (int)((prefix << 8) | (unsigned)bsel); misc[1] = kk - a; }
            __syncthreads();
        }
        const unsigned T = (unsigned)misc[0]; const int keq = misc[1];
        for (int s = tid; s < n; s += NT) if (fkey(sc[s]) > T) { const int o = atomicAdd(&misc[2], 1); so[o] = (unsigned short)s; }
        const int per = (n + NT - 1) / NT, s0 = tid * per, s1 = min(n, s0 + per);
        int ce = 0;
        for (int s = s0; s < s1; ++s) ce += (fkey(sc[s]) == T) ? 1 : 0;
        seg[tid] = ce;
        __syncthreads();
        if (tid == 0) { int a = 0; for (int i = 0; i < NT; ++i) { const int c = seg[i]; seg[i] = a; a += c; } }
        __syncthreads();
        const int ngt = TOPK - keq;
        int r = seg[tid];
        for (int s = s0; s < s1 && r < keq; ++s) if (fkey(sc[s]) == T) { so[ngt + r] = (unsigned short)s; ++r; }
        __syncthreads();
    }
}
__device__ __forceinline__ void phase_sparse_attn(const Params& P, unsigned char* lds) {
    bf16_t* QA = (bf16_t*)(P.ws + WS_QA); const bf16_t* CKV = (const bf16_t*)(P.ws + WS_CKV); const unsigned short* SEL = (const unsigned short*)(P.ws + WS_SEL);
    float* qa = (float*)lds;
    float* lgt = qa + 4096;
    int* sel = (int*)(lgt + 4096);
    const int tid = threadIdx.x, lane = tid & 63, wave = tid >> 6;
    for (int t = blockIdx.x; t < NTOK; t += gridDim.x) {
        const int b = t >> 13, tl = t & (SEQ - 1), ns = min(tl + 1, TOPK);
        { const u32x4 v = *(const u32x4*)(QA + (size_t)t * 4096 + tid * 8); float* q = qa + tid * 8;
          q[0] = bflo(v.x); q[1] = bfhi(v.x); q[2] = bflo(v.y); q[3] = bfhi(v.y); q[4] = bflo(v.z); q[5] = bfhi(v.z); q[6] = bflo(v.w); q[7] = bfhi(v.w); }
        if (tid < TOPK) sel[tid] = (tid < ns) ? (int)SEL[(size_t)t * TOPK + tid] : 0;
        __syncthreads();
        const int k = tid & 255, hg = tid >> 8;
        {
            float acc[8];
#pragma unroll
            for (int h = 0; h < 8; ++h) acc[h] = 0.f;
            if (k < ns) {
                const bf16_t* cr = CKV + ((size_t)b * SEQ + sel[k]) * 256;
                for (int c8 = 0; c8 < 256; c8 += 8) {
                    const u32x4 v = *(const u32x4*)(cr + c8);
                    const float cv[8] = {bflo(v.x), bfhi(v.x), bflo(v.y), bfhi(v.y), bflo(v.z), bfhi(v.z), bflo(v.w), bfhi(v.w)};
#pragma unroll
                    for (int h = 0; h < 8; ++h) { const float* q = qa + (hg * 8 + h) * 256 + c8;
#pragma unroll
                        for (int j = 0; j < 8; ++j) acc[h] += q[j] * cv[j]; }
                }
            }
#pragma unroll
            for (int h = 0; h < 8; ++h) { const int hh = hg * 8 + h; const float slope = exp2f(-0.5f * (float)(hh + 1));
                lgt[hh * 256 + k] = (k < ns) ? (acc[h] - slope * (float)(tl - sel[k])) : -INFINITY; }
        }
        __syncthreads();
        for (int hh = wave * 2; hh < wave * 2 + 2; ++hh) {
            float* row = lgt + hh * 256;
            float x[4]; float m = -INFINITY;
#pragma unroll
            for (int j = 0; j < 4; ++j) { x[j] = row[lane + 64 * j]; m = fmaxf(m, x[j]); }
            m = wave_max(m); float s = 0.f;
#pragma unroll
            for (int j = 0; j < 4; ++j) { x[j] = __expf(x[j] - m); s += x[j]; }
            s = wave_sum(s); const float inv = 1.0f / s;
#pragma unroll
            for (int j = 0; j < 4; ++j) row[lane + 64 * j] = x[j] * inv;
        }
        __syncthreads();
        {
            const int c = tid & 255;
            float acc[8];
#pragma unroll
            for (int h = 0; h < 8; ++h) acc[h] = 0.f;
            const bf16_t* cb = CKV + (size_t)b * SEQ * 256 + c;
            for (int kk = 0; kk < ns; ++kk) {
                const float cv = bf2f(cb[(size_t)sel[kk] * 256]);
#pragma unroll
                for (int h = 0; h < 8; ++h) acc[h] += lgt[(hg * 8 + h) * 256 + kk] * cv;
            }
#pragma unroll
            for (int h = 0; h < 8; ++h) QA[(size_t)t * 4096 + (hg * 8 + h) * 256 + c] = (bf16_t)f2bf(acc[h]);
        }
        __syncthreads();
    }
}

constexpr int NPH_TOTAL = 23;

#ifdef PH_ONLY
#define IN(k) ((k) == PH_ONLY)
#else
#define IN(k) (lo <= (k) && (k) < hi)
#endif
#define SEAM(k) do { if (IN(k) && IN((k) + 1)) grid.sync(); } while (0)

template <int LAYER, int BASE>
__device__ __forceinline__ void layer_tail(const Params& P, unsigned char* lds, cg::grid_group& grid, int lo, int hi) {
    unsigned char* ws = P.ws;
    int* tb = (int*)(lds + MISC_OFF);
    if (IN(BASE)) phase_ln_route(P, lds, LAYER);
    SEAM(BASE);
    if (IN(BASE + 1)) { moe_setup(P, tb, LAYER);
        MoeSched S{tb, (const int*)(ws + WS_CTL) + LAYER * 64, (const int*)(ws + WS_LIST), (const bf16_t*)(ws + WS_XB),
                   (const bf16_t*)(ws + WS_W_GU) + (size_t)LAYER * 32 * DM * DM, DM, (size_t)DM * DM, true};
        EpiGU E{(bf16_t*)(ws + WS_ACT)}; gemm_simple(lds, S, E, false); }
    SEAM(BASE + 1);
    if (IN(BASE + 2)) { moe_setup(P, tb, LAYER);
        MoeSched S{tb, (const int*)(ws + WS_CTL) + LAYER * 64, (const int*)(ws + WS_LIST), (const bf16_t*)(ws + WS_ACT),
                   (const bf16_t*)(ws + WS_W_DN) + (size_t)LAYER * 32 * DM * 512, 512, (size_t)DM * 512, false};
        EpiDown E{(bf16_t*)(ws + WS_YS)}; gemm_simple(lds, S, E, true); }
    SEAM(BASE + 2);
    if (IN(BASE + 3)) phase_ln2(P, LAYER);
    SEAM(BASE + 3);
    if (IN(BASE + 4)) {
        { DenseSched S{(const bf16_t*)(ws + WS_PB) + (size_t)LAYER * NTOK * 256, (const bf16_t*)(ws + WS_W_P) + (size_t)LAYER * DM * 256, NTOK, DM, 256, 256, 0};
          EpiStoreBf16 E{(bf16_t*)(ws + WS_PP), DM, 0, nullptr}; gemm_simple(lds, S, E, true); }
        __syncthreads();
        { DenseSched S{(const bf16_t*)(ws + WS_XB), (const bf16_t*)(ws + WS_W_G) + (size_t)LAYER * DM * DM, NTOK, DM, DM, DM, 0};
          EpiPle E{(const float*)(ws + WS_F), (const bf16_t*)(ws + WS_PP), LAYER == 1 ? P.out : (float*)(ws + WS_F), LAYER == 1 ? (bf16_t*)nullptr : (bf16_t*)(ws + WS_XB2)}; gemm_simple(lds, S, E, true); }
    }
}

__global__ void __launch_bounds__(NT, 2) mega(Params P, int lo, int hi) {
    extern __shared__ __attribute__((aligned(16))) unsigned char lds[];
    unsigned char* ws = P.ws;
    cg::grid_group grid = cg::this_grid();
    if (IN(0)) phase_prep(P, lds);
    SEAM(0);
    if (IN(1)) { DenseSched S{(const bf16_t*)(ws + WS_XB), (const bf16_t*)(ws + WS_W_IN0), NTOK, ZW, DM, DM, 0};
        EpiStoreBf16 E{(bf16_t*)(ws + WS_Z0), ZW, 0, nullptr}; gemm_simple(lds, S, E, true); }
    SEAM(1);
    if (IN(2)) phase_ret_kv(P, lds);
    SEAM(2);
    if (IN(3)) phase_ret_scan_pool(P);
    SEAM(3);
    if (IN(4)) { phase_ret_out(P, lds);
        DenseSched S{(const bf16_t*)(ws + WS_DP), (const bf16_t*)(ws + WS_W_POOL), NTOK, 512, 256, 512, 256};
        EpiStoreBf16 E{(bf16_t*)(ws + WS_MIX), DM, 512, P.in[5]}; gemm_simple(lds, S, E, true); }
    SEAM(4);
    if (IN(5)) { DenseSched S{(const bf16_t*)(ws + WS_MIX), (const bf16_t*)(ws + WS_W_OUT0), NTOK, DM, DM, DM, 0};
        EpiResid E{P.in[0], (float*)(ws + WS_F)}; gemm_simple(lds, S, E, true); }
    SEAM(5);
    layer_tail<0, 6>(P, lds, grid, lo, hi);
    SEAM(10);
    if (IN(11)) { DenseSched S{(const bf16_t*)(ws + WS_XB2), (const bf16_t*)(ws + WS_W_CIN), NTOK, Z1W, DM, DM, 0};
        EpiStoreBf16 E{(bf16_t*)(ws + WS_Z1), Z1W, 0, nullptr}; gemm_simple(lds, S, E, true); }
    SEAM(11);
    if (IN(12)) phase_norms(P);
    SEAM(12);
    if (IN(13)) { DenseSched S{(const bf16_t*)(ws + WS_CQ), (const bf16_t*)(ws + WS_W_QA), NTOK, 4096, 256, 256, 0};
        EpiStoreBf16 E{(bf16_t*)(ws + WS_QA), 4096, 0, nullptr}; gemm_simple(lds, S, E, true); }
    SEAM(13);
    if (IN(14)) phase_index(P, lds);
    SEAM(14);
    if (IN(15)) phase_sparse_attn(P, lds);
    SEAM(15);
    if (IN(16)) { DenseSched S{(const bf16_t*)(ws + WS_QA), (const bf16_t*)(ws + WS_W_UVBD), NTOK, DM, DM, 4096, 1024};
        EpiStoreBf16 E{(bf16_t*)(ws + WS_XB), DM, 0, nullptr}; gemm_simple(lds, S, E, true); }
    SEAM(16);
    if (IN(17)) { DenseSched S{(const bf16_t*)(ws + WS_XB), (const bf16_t*)(ws + WS_W_COUT), NTOK, DM, DM, DM, 0};
        EpiResid E{(const float*)(ws + WS_F), (float*)(ws + WS_F)}; gemm_simple(lds, S, E, true); }
    SEAM(17);
    layer_tail<1, 18>(P, lds, grid, lo, hi);
}
#undef IN
#undef SEAM

extern "C" void kernel_launch(void* const* d_in, const int* in_sizes, int n_in, void* d_out, int out_size, void* d_ws, size_t ws_size, hipStream_t stream) {
    static int grid = 0;
    if (grid == 0) {
        if (n_in != 26 || ws_size < WS_END || out_size != NTOK * DM) { fprintf(stderr, "kernel_launch: unexpected problem (n_in %d, ws %zu, out %d)\n", n_in, ws_size, out_size); grid = -1; return; }
        int dev = 0, cus = 0, per_cu = 0;
        (void)hipGetDevice(&dev);
        (void)hipDeviceGetAttribute(&cus, hipDeviceAttributeMultiprocessorCount, dev);
        (void)hipFuncSetAttribute((const void*)mega, hipFuncAttributeMaxDynamicSharedMemorySize, LDS_BYTES);
        (void)hipOccupancyMaxActiveBlocksPerMultiprocessor(&per_cu, (const void*)mega, NT, LDS_BYTES);
        if (per_cu < 1) { fprintf(stderr, "kernel_launch: occupancy query reports %d blocks per CU\n", per_cu); per_cu = 1; }
        (void)hipGetLastError();
        grid = cus;
    }
    if (grid < 0) return;
    (void)hipMemsetAsync((char*)d_ws + WS_CTL, 0, 4096, stream);
    Params p{};
    for (int i = 0; i < 26; ++i) p.in[i] = (const float*)d_in[i];
    p.out = (float*)d_out; p.ws = (unsigned char*)d_ws;
#if MK_ONE_LAUNCH
    int lo = 0, hi = NPH_TOTAL;
    void* args[] = {&p, &lo, &hi};
    hipError_t e = hipLaunchCooperativeKernel((const void*)mega, dim3(grid), dim3(NT), args, LDS_BYTES, stream);
    if (e != hipSuccess) fprintf(stderr, "cooperative launch failed: %s (grid %d)\n", hipGetErrorString(e), grid);
#else
    for (int k = 0; k < NPH_TOTAL; ++k) hipLaunchKernelGGL(mega, dim3(grid), dim3(NT), LDS_BYTES, stream, p, k, k + 1);
#endif
}
```

```cpp
#include <hip/hip_runtime.h>
#include <hip/hip_cooperative_groups.h>
#include <cstdio>
#include <cstdint>
namespace cg = cooperative_groups;

#ifndef MK_ONE_LAUNCH
#define MK_ONE_LAUNCH 1
#endif

typedef unsigned short bf16_t;
typedef float f32x4 __attribute__((ext_vector_type(4)));
typedef unsigned u32x4 __attribute__((ext_vector_type(4)));
typedef unsigned u32x2 __attribute__((ext_vector_type(2)));

constexpr int NT = 512;
constexpr int NWAVE = NT / 64;
constexpr int NTOK = 32768, DM = 1024, SEQ = 8192, NBATCH = 4;
constexpr int ZW = 2560;
constexpr int Z1W = 1280;
constexpr int CIN = 1096;
constexpr int TOPK = 256;
constexpr float ALPHA = 1.4142135623730951f;
constexpr float LN_EPS = 1e-5f;
constexpr int LDS_BYTES = 147456;
constexpr int MISC_OFF = 135168;

constexpr size_t MiB = (size_t)1 << 20;
constexpr size_t WS_CTL = 0;
constexpr size_t WS_W_IN0 = 1 * MiB, WS_W_OUT0 = 6 * MiB, WS_W_POOL = 8 * MiB, WS_W_CIN = 9 * MiB, WS_W_QA = 12 * MiB,
                 WS_W_UVBD = 14 * MiB, WS_W_COUT = 16 * MiB, WS_W_G = 18 * MiB, WS_W_P = 22 * MiB, WS_W_GU = 24 * MiB, WS_W_DN = 152 * MiB;
constexpr size_t WS_XB = 224 * MiB, WS_F = 288 * MiB, WS_PB = 416 * MiB, WS_PP = 448 * MiB, WS_CQ = 512 * MiB, WS_CKV = 528 * MiB,
                 WS_SEL = 544 * MiB, WS_TOKG = 560 * MiB, WS_LIST = 561 * MiB;
constexpr size_t WS_M0 = 576 * MiB;
constexpr size_t WS_Z0 = WS_M0, WS_KV = WS_M0 + 160 * MiB, WS_MIX = WS_M0 + 224 * MiB, WS_DP = WS_M0 + 288 * MiB;
constexpr size_t WS_QA = WS_M0, WS_Z1 = WS_M0 + 256 * MiB;
constexpr size_t WS_ACT = WS_M0, WS_YS = WS_M0 + 72 * MiB;
constexpr size_t WS_XB2 = 912 * MiB;
constexpr size_t WS_END = 976 * MiB;
constexpr int LIST_CAP = 32768;

struct Params {
    const float* in[26];
    float* out;
    unsigned char* ws;
};

__device__ __forceinline__ unsigned f2bf(float f) { unsigned u = __float_as_uint(f); return (u + 0x7fffu + ((u >> 16) & 1u)) >> 16; }
__device__ __forceinline__ float bf2f(unsigned h) { return __uint_as_float(h << 16); }
__device__ __forceinline__ unsigned pk2(float lo, float hi) { return f2bf(lo) | (f2bf(hi) << 16); }
__device__ __forceinline__ float bflo(unsigned w) { return __uint_as_float(w << 16); }
__device__ __forceinline__ float bfhi(unsigned w) { return __uint_as_float(w & 0xffff0000u); }
__device__ __forceinline__ float wave_sum(float v) {
#pragma unroll
    for (int o = 1; o < 64; o <<= 1) v += __shfl_xor(v, o);
    return v;
}
__device__ __forceinline__ float wave_max(float v) {
#pragma unroll
    for (int o = 1; o < 64; o <<= 1) v = fmaxf(v, __shfl_xor(v, o));
    return v;
}
__device__ __forceinline__ float silu_f(float a) { return a / (1.0f + __expf(-a)); }
__device__ __forceinline__ float sigmoid_f(float a) { return 1.0f / (1.0f + __expf(-a)); }
#define LDS_FENCE() asm volatile("s_waitcnt lgkmcnt(0)" ::: "memory")

struct UnitInfo {
    const bf16_t* A; int lda;
    const int* rows; int rshift;
    int nvalid;
    const bf16_t* Bt; int ldb;
    int K;
    int orow0;
    int pn;
};
__device__ __forceinline__ const bf16_t* unit_arow(const UnitInfo& u, int r) {
    if (u.rows) { const int idx = (r < u.nvalid) ? (u.rows[r] >> u.rshift) : 0; return u.A + (size_t)idx * u.lda; }
    return u.A + (size_t)r * u.lda;
}

struct DenseSched {
    const bf16_t* A; const bf16_t* Bt; int M, N, K, lda, a_pn_stride;
    __device__ __forceinline__ bool get(int i, UnitInfo& u) const {
        const int nN = N >> 8, nM = M >> 8;
        if (i >= nN * nM) return false;
        const int pm = i / nN, pn = i % nN;
        u.A = A + (size_t)pm * 256 * lda + (size_t)pn * a_pn_stride; u.lda = lda; u.rows = nullptr; u.rshift = 0; u.nvalid = 256;
        u.Bt = Bt + (size_t)pn * 256 * K; u.ldb = K; u.K = K; u.orow0 = pm * 256; u.pn = pn;
        return true;
    }
};
struct MoeSched {
    const int* tb; const int* cnt; const int* list;
    const bf16_t* A; const bf16_t* W; int K; size_t wstride; bool gather;
    __device__ __forceinline__ bool get(int i, UnitInfo& u) const {
        const int j = i >> 2, pn = i & 3;
        if (j >= tb[32]) return false;
        int e = 0;
        while (tb[e + 1] <= j) ++e;
        const int rb = j - tb[e];
        const int nv = min(256, cnt[e] - rb * 256);
        u.rows = list + (size_t)e * LIST_CAP + rb * 256; u.nvalid = nv; u.orow0 = j * 256; u.pn = pn;
        if (gather) { u.A = A; u.lda = K; u.rshift = 1; }
        else { u.A = A + (size_t)j * 256 * K; u.lda = K; u.rshift = 31;   }
        u.Bt = W + (size_t)e * wstride + (size_t)pn * 256 * K; u.ldb = K; u.K = K;
        return true;
    }
};

template <class Sched, class Epi>
__device__ __forceinline__ void gemm_simple(unsigned char* lds, const Sched& S, const Epi& E, bool contiguousA) {
    float* As = (float*)lds;
    float* Bs = As + 128 * 33;
    const int tid = threadIdx.x, ty = tid >> 3, tx = tid & 7;
    const int lr = tid >> 2, kc = (tid & 3) * 8;
    UnitInfo u;
    for (int i = blockIdx.x; S.get(i, u); i += gridDim.x) {
        for (int sm = 0; sm < 2; ++sm) {
            const int ar = sm * 128 + lr;
            const bf16_t* arow = contiguousA ? (u.A + (size_t)ar * u.lda) : unit_arow(u, ar);
            for (int sn = 0; sn < 4; ++sn) {
                float acc[2][8];
#pragma unroll
                for (int a = 0; a < 2; ++a)
#pragma unroll
                    for (int b = 0; b < 8; ++b) acc[a][b] = 0.f;
                const bf16_t* brow = u.Bt + (size_t)(sn * 64 + (tid >> 2)) * u.ldb;
                for (int k0 = 0; k0 < u.K; k0 += 32) {
                    const u32x4 av = *(const u32x4*)(arow + k0 + kc);
                    float* ap = As + lr * 33 + kc;
                    ap[0] = bflo(av.x); ap[1] = bfhi(av.x); ap[2] = bflo(av.y); ap[3] = bfhi(av.y);
                    ap[4] = bflo(av.z); ap[5] = bfhi(av.z); ap[6] = bflo(av.w); ap[7] = bfhi(av.w);
                    if (tid < 256) {
                        const u32x4 bv = *(const u32x4*)(brow + k0 + kc);
                        float* bp = Bs + (tid >> 2) * 33 + kc;
                        bp[0] = bflo(bv.x); bp[1] = bfhi(bv.x); bp[2] = bflo(bv.y); bp[3] = bfhi(bv.y);
                        bp[4] = bflo(bv.z); bp[5] = bfhi(bv.z); bp[6] = bflo(bv.w); bp[7] = bfhi(bv.w);
                    }
                    __syncthreads();
#pragma unroll 8
                    for (int kk = 0; kk < 32; ++kk) {
                        const float a0 = As[(2 * ty) * 33 + kk], a1 = As[(2 * ty + 1) * 33 + kk];
#pragma unroll
                        for (int j = 0; j < 8; ++j) { const float b = Bs[(tx * 8 + j) * 33 + kk]; acc[0][j] += a0 * b; acc[1][j] += a1 * b; }
                    }
                    __syncthreads();
                }
#pragma unroll
                for (int rr = 0; rr < 2; ++rr) {
                    const f32x4 v0 = {acc[rr][0], acc[rr][1], acc[rr][2], acc[rr][3]}, v1 = {acc[rr][4], acc[rr][5], acc[rr][6], acc[rr][7]};
                    E(u, sm * 128 + 2 * ty + rr, sn * 64 + tx * 8, v0, v1);
                }
            }
        }
    }
}

__device__ __forceinline__ u32x4 pack8(f32x4 a, f32x4 b) { u32x4 w; w.x = pk2(a.x, a.y); w.y = pk2(a.z, a.w); w.z = pk2(b.x, b.y); w.w = pk2(b.z, b.w); return w; }
struct EpiStoreBf16 {
    bf16_t* O; int ldc; int coff; const float* colscale;
    __device__ __forceinline__ void operator()(const UnitInfo& u, int r, int c, f32x4 v0, f32x4 v1) const {
        const int col = u.pn * 256 + c;
        if (colscale) { const f32x4 s0 = *(const f32x4*)(colscale + col), s1 = *(const f32x4*)(colscale + col + 4); v0 *= s0; v1 *= s1; }
        *(u32x4*)(O + (size_t)(u.orow0 + r) * ldc + coff + col) = pack8(v0, v1);
    }
};
struct EpiResid {
    const float* X; float* Fo;
    __device__ __forceinline__ void operator()(const UnitInfo& u, int r, int c, f32x4 v0, f32x4 v1) const {
        const size_t off = (size_t)(u.orow0 + r) * DM + u.pn * 256 + c;
        const f32x4 x0 = *(const f32x4*)(X + off), x1 = *(const f32x4*)(X + off + 4);
        *(f32x4*)(Fo + off) = x0 * ALPHA + v0; *(f32x4*)(Fo + off + 4) = x1 * ALPHA + v1;
    }
};
struct EpiGU {
    bf16_t* ACT;
    __device__ __forceinline__ void operator()(const UnitInfo& u, int r, int c, f32x4 v0, f32x4 v1) const {
        u32x2 w; w.x = pk2(silu_f(v0.x) * v0.y, silu_f(v0.z) * v0.w); w.y = pk2(silu_f(v1.x) * v1.y, silu_f(v1.z) * v1.w);
        *(u32x2*)(ACT + (size_t)(u.orow0 + r) * 512 + u.pn * 128 + (c >> 1)) = w;
    }
};
struct EpiDown {
    bf16_t* YS;
    __device__ __forceinline__ void operator()(const UnitInfo& u, int r, int c, f32x4 v0, f32x4 v1) const {
        if (r < u.nvalid) { const int pair = u.rows[r]; *(u32x4*)(YS + (size_t)pair * DM + u.pn * 256 + c) = pack8(v0, v1); }
    }
};
struct EpiPle {
    const float* F; const bf16_t* PP; float* OUT; bf16_t* XB;
    __device__ __forceinline__ void operator()(const UnitInfo& u, int r, int c, f32x4 v0, f32x4 v1) const {
        const size_t off = (size_t)(u.orow0 + r) * DM + u.pn * 256 + c;
        const u32x4 pw = *(const u32x4*)(PP + off);
        const f32x4 p0 = {bflo(pw.x), bfhi(pw.x), bflo(pw.y), bfhi(pw.y)}, p1 = {bflo(pw.z), bfhi(pw.z), bflo(pw.w), bfhi(pw.w)};
        f32x4 f0 = *(const f32x4*)(F + off), f1 = *(const f32x4*)(F + off + 4);
        f0.x += sigmoid_f(v0.x) * p0.x; f0.y += sigmoid_f(v0.y) * p0.y; f0.z += sigmoid_f(v0.z) * p0.z; f0.w += sigmoid_f(v0.w) * p0.w;
        f1.x += sigmoid_f(v1.x) * p1.x; f1.y += sigmoid_f(v1.y) * p1.y; f1.z += sigmoid_f(v1.z) * p1.z; f1.w += sigmoid_f(v1.w) * p1.w;
        *(f32x4*)(OUT + off) = f0; *(f32x4*)(OUT + off + 4) = f1;
        if (XB) *(u32x4*)(XB + off) = pack8(f0, f1);
    }
};

__device__ __forceinline__ void tr_item(const float* W, int K, int N, bf16_t* WT, int mode, float* scr, int kb, int nb, int lane) {
    const int k0 = 64 * kb, n0 = 32 * nb;
#pragma unroll 8
    for (int i = 0; i < 32; ++i) { const int kk = 2 * i + (lane >> 5); scr[kk * 33 + (lane & 31)] = W[(size_t)(k0 + kk) * N + n0 + (lane & 31)]; }
    LDS_FENCE();
    const int c = lane & 7;
#pragma unroll
    for (int j = 0; j < 4; ++j) {
        const int n = (lane >> 3) + 8 * j; const float* s = scr + (8 * c) * 33 + n;
        const int ng = n0 + n;
        float sc = 1.f; int nd = ng;
        if (mode == 1) { if (ng >= 512 && ng < 1024) sc = 0.08838834764831845f; }
        if (mode == 2) { nd = (ng < 512) ? 2 * ng : 2 * (ng - 512) + 1; }
        u32x4 o; o.x = pk2(s[0 * 33] * sc, s[1 * 33] * sc); o.y = pk2(s[2 * 33] * sc, s[3 * 33] * sc); o.z = pk2(s[4 * 33] * sc, s[5 * 33] * sc); o.w = pk2(s[6 * 33] * sc, s[7 * 33] * sc);
        *(u32x4*)(WT + (size_t)nd * K + k0 + 8 * c) = o;
    }
    LDS_FENCE();
}
struct TrDesc { const float* src; bf16_t* dst; int K, N, nbatch, mode; };
__device__ __forceinline__ int tr_items(const TrDesc& d) { return d.nbatch * (d.K / 64) * (d.N / 32); }
__device__ __forceinline__ void tr_run(const TrDesc& d, int it, float* scr, int lane) {
    const int per = (d.K / 64) * (d.N / 32), b = it / per, r = it % per, nblk = d.N / 32;
    tr_item(d.src + (size_t)b * d.K * d.N, d.K, d.N, d.dst + (size_t)b * d.K * d.N, d.mode, scr, r / nblk, r % nblk, lane);
}

__device__ __forceinline__ void phase_prep(const Params& P, unsigned char* lds) {
    unsigned char* ws = P.ws;
    const int tid = threadIdx.x, lane = tid & 63, wave = tid >> 6;
    const int gw = blockIdx.x * NWAVE + wave, NGW = gridDim.x * NWAVE;
    float* scr = (float*)lds + wave * (64 * 33);
    TrDesc d[7];
    d[0] = {P.in[22], (bf16_t*)(ws + WS_W_GU), 1024, 1024, 64, 2};
    d[1] = {P.in[23], (bf16_t*)(ws + WS_W_DN), 512, 1024, 64, 0};
    d[2] = {P.in[2], (bf16_t*)(ws + WS_W_IN0), 1024, 2560, 1, 1};
    d[3] = {P.in[6], (bf16_t*)(ws + WS_W_OUT0), 1024, 1024, 1, 0};
    d[4] = {P.in[13], (bf16_t*)(ws + WS_W_COUT), 1024, 1024, 1, 0};
    d[5] = {P.in[24], (bf16_t*)(ws + WS_W_G), 1024, 1024, 2, 0};
    d[6] = {P.in[25], (bf16_t*)(ws + WS_W_P), 256, 1024, 2, 0};
    int total = 0;
#pragma unroll
    for (int i = 0; i < 7; ++i) total += tr_items(d[i]);
    for (int it = gw; it < total; it += NGW) {
        int r = it;
#pragma unroll
        for (int i = 0; i < 7; ++i) { const int n = tr_items(d[i]); if (r >= 0 && r < n) { tr_run(d[i], r, scr, lane); r = -1; } else if (r >= 0) r -= n; }
    }
    const size_t gt = (size_t)blockIdx.x * NT + tid, GS = (size_t)gridDim.x * NT;
    {
        bf16_t* o = (bf16_t*)(ws + WS_W_POOL); const float* pw = P.in[4];
        for (size_t i = gt; i < 512 * 256; i += GS) { const int n = (int)(i >> 8), k = (int)(i & 255), g = n >> 7, dd = n & 127, kg = k >> 7, c = k & 127;
            o[i] = (bf16_t)((kg == (g & 1)) ? f2bf(pw[((size_t)g * 128 + c) * 128 + dd]) : 0u); }
    }
    {
        bf16_t* o = (bf16_t*)(ws + WS_W_CIN); const float* w = P.in[7];
        for (size_t i = gt; i < (size_t)Z1W * 1024; i += GS) { const int n = (int)(i >> 10), k = (int)(i & 1023);
            o[i] = (bf16_t)((n < CIN) ? f2bf(w[(size_t)k * CIN + n]) : 0u); }
    }
    {
        bf16_t* o = (bf16_t*)(ws + WS_W_QA); const float* uq = P.in[10]; const float* uk = P.in[11];
        for (size_t i = gt; i < (size_t)4096 * 256; i += GS) { const int n = (int)(i >> 8), r = (int)(i & 255), h = n >> 8, c = n & 255;
            const float* a = uq + (size_t)r * 1024 + h * 64; const float* b = uk + (size_t)c * 1024 + h * 64; float s = 0.f;
            for (int dd = 0; dd < 64; ++dd) s += a[dd] * b[dd];
            o[i] = (bf16_t)f2bf(s * 0.125f); }
    }
    {
        bf16_t* o = (bf16_t*)(ws + WS_W_UVBD); const float* uv = P.in[12];
        for (size_t i = gt; i < (size_t)1024 * 1024; i += GS) { const int n = (int)(i >> 10), k = (int)(i & 1023), h = n >> 6, dd = n & 63, hq = k >> 8, c = k & 255;
            o[i] = (bf16_t)(((h & 3) == hq) ? f2bf(uv[(size_t)c * 1024 + h * 64 + dd]) : 0u); }
    }
    {
        const f32x4* x = (const f32x4*)P.in[0]; u32x4* xb = (u32x4*)(ws + WS_XB);
        for (size_t i = gt; i < (size_t)NTOK * DM / 8; i += GS) xb[i] = pack8(x[2 * i], x[2 * i + 1]);
        const f32x4* p = (const f32x4*)P.in[1]; u32x4* pb = (u32x4*)(ws + WS_PB);
        for (size_t i = gt; i < (size_t)2 * NTOK * 256 / 8; i += GS) pb[i] = pack8(p[2 * i], p[2 * i + 1]);
    }
}

__device__ __forceinline__ float ret_logg(int h) { return log1pf(-exp2f(-5.0f - (float)h)); }

__device__ __forceinline__ void phase_ret_kv(const Params& P, unsigned char* lds) {
    const bf16_t* Z0 = (const bf16_t*)(P.ws + WS_Z0); float* KV = (float*)(P.ws + WS_KV);
    float* Ks = (float*)lds; float* Vs = Ks + 128 * 128;
    const int tid = threadIdx.x;
    for (int u = blockIdx.x; u < 1024; u += gridDim.x) {
        const int n = u & 63, h = (u >> 6) & 3, b = u >> 8;
        const float lg = ret_logg(h);
        const size_t row0 = (size_t)b * SEQ + n * 128;
        for (int i = tid; i < 128 * 16; i += NT) {
            const int r = i >> 4, c8 = (i & 15) * 8;
            const u32x4 kv = *(const u32x4*)(Z0 + (row0 + r) * ZW + 512 + h * 128 + c8);
            const u32x4 vv = *(const u32x4*)(Z0 + (row0 + r) * ZW + 1024 + h * 128 + c8);
            const float dec = __expf(lg * (float)(127 - r));
            float* kp = Ks + r * 128 + c8; float* vp = Vs + r * 128 + c8;
            kp[0] = bflo(kv.x) * dec; kp[1] = bfhi(kv.x) * dec; kp[2] = bflo(kv.y) * dec; kp[3] = bfhi(kv.y) * dec;
            kp[4] = bflo(kv.z) * dec; kp[5] = bfhi(kv.z) * dec; kp[6] = bflo(kv.w) * dec; kp[7] = bfhi(kv.w) * dec;
            vp[0] = bflo(vv.x); vp[1] = bfhi(vv.x); vp[2] = bflo(vv.y); vp[3] = bfhi(vv.y);
            vp[4] = bflo(vv.z); vp[5] = bfhi(vv.z); vp[6] = bflo(vv.w); vp[7] = bfhi(vv.w);
        }
        __syncthreads();
        const int dd = tid >> 2, v0 = (tid & 3) * 32;
        float acc[32];
#pragma unroll
        for (int j = 0; j < 32; ++j) acc[j] = 0.f;
        for (int i = 0; i < 128; ++i) {
            const float kd = Ks[i * 128 + dd];
#pragma unroll
            for (int j = 0; j < 32; j += 4) { const f32x4 vv = *(const f32x4*)(Vs + i * 128 + v0 + j); acc[j] += kd * vv.x; acc[j + 1] += kd * vv.y; acc[j + 2] += kd * vv.z; acc[j + 3] += kd * vv.w; }
        }
        float* o = KV + (size_t)u * 16384 + dd * 128 + v0;
#pragma unroll
        for (int j = 0; j < 32; j += 4) *(f32x4*)(o + j) = (f32x4){acc[j], acc[j + 1], acc[j + 2], acc[j + 3]};
        __syncthreads();
    }
}
__device__ __forceinline__ void phase_ret_scan_pool(const Params& P) {
    float* KV = (float*)(P.ws + WS_KV);
    const size_t gt = (size_t)blockIdx.x * NT + threadIdx.x, GS = (size_t)gridDim.x * NT;
    for (size_t i = gt; i < (size_t)16 * 4096; i += GS) {
        const int s = (int)(i >> 12), e4 = (int)(i & 4095), h = s & 3;
        const float cd = __expf(ret_logg(h) * 128.0f);
        f32x4* p = (f32x4*)(KV + (size_t)s * 64 * 16384) + e4;
        f32x4 R = {0.f, 0.f, 0.f, 0.f};
        for (int n0 = 0; n0 < 64; n0 += 8) {
            f32x4 kv[8];
#pragma unroll
            for (int j = 0; j < 8; ++j) kv[j] = p[(size_t)(n0 + j) * 4096];
#pragma unroll
            for (int j = 0; j < 8; ++j) { p[(size_t)(n0 + j) * 4096] = R; R = R * cd + kv[j]; }
        }
    }
    const bf16_t* Z0 = (const bf16_t*)(P.ws + WS_Z0); bf16_t* DP = (bf16_t*)(P.ws + WS_DP);
    for (size_t i = gt; i < (size_t)NTOK * 64; i += GS) {
        const int t = (int)(i >> 6), c8 = (int)(i & 63) * 8, g = c8 >> 7, w = 2 << g, tl = t & (SEQ - 1);
        const int cnt = min(tl + 1, w);
        float s[8];
#pragma unroll
        for (int j = 0; j < 8; ++j) s[j] = 0.f;
        float u0[8];
        for (int q = 0; q < cnt; ++q) {
            const u32x4 v = *(const u32x4*)(Z0 + (size_t)(t - q) * ZW + 2048 + c8);
            const float f[8] = {bflo(v.x), bfhi(v.x), bflo(v.y), bfhi(v.y), bflo(v.z), bfhi(v.z), bflo(v.w), bfhi(v.w)};
#pragma unroll
            for (int j = 0; j < 8; ++j) { s[j] += f[j]; if (q == 0) u0[j] = f[j]; }
        }
        const float inv = 1.0f / (float)cnt;
        u32x4 o; o.x = pk2(s[0] * inv - u0[0], s[1] * inv - u0[1]); o.y = pk2(s[2] * inv - u0[2], s[3] * inv - u0[3]);
        o.z = pk2(s[4] * inv - u0[4], s[5] * inv - u0[5]); o.w = pk2(s[6] * inv - u0[6], s[7] * inv - u0[7]);
        *(u32x4*)(DP + (size_t)t * 512 + c8) = o;
    }
}
__device__ __forceinline__ void phase_ret_out(const Params& P, unsigned char* lds) {
    const bf16_t* Z0 = (const bf16_t*)(P.ws + WS_Z0); const float* KV = (const float*)(P.ws + WS_KV); bf16_t* MIX = (bf16_t*)(P.ws + WS_MIX);
    const float* gn = P.in[3];
    bf16_t* Qs = (bf16_t*)lds;
    bf16_t* Ksm = Qs + 128 * 136;
    float* Sc = (float*)(lds + 2 * 128 * 136 * 2);
    const int tid = threadIdx.x;
    for (int u = blockIdx.x; u < 1024; u += gridDim.x) {
        const int n = u & 63, h = (u >> 6) & 3, b = u >> 8;
        const float lg = ret_logg(h);
        const size_t row0 = (size_t)b * SEQ + n * 128;
        for (int i = tid; i < 128 * 16; i += NT) {
            const int r = i >> 4, c8 = (i & 15) * 8;
            *(u32x4*)(Qs + r * 136 + c8) = *(const u32x4*)(Z0 + (row0 + r) * ZW + h * 128 + c8);
            *(u32x4*)(Ksm + r * 136 + c8) = *(const u32x4*)(Z0 + (row0 + r) * ZW + 512 + h * 128 + c8);
        }
        __syncthreads();
        for (int e = tid; e < 128 * 128; e += NT) {
            const int i = e >> 7, j = e & 127;
            float s = 0.f;
            if (j <= i) {
                const bf16_t* q = Qs + i * 136; const bf16_t* k = Ksm + j * 136;
                for (int dd = 0; dd < 128; dd += 2) { const unsigned qa = *(const unsigned*)(q + dd), ka = *(const unsigned*)(k + dd); s += bflo(qa) * bflo(ka) + bfhi(qa) * bfhi(ka); }
                s *= __expf(lg * (float)(i - j));
            }
            Sc[e] = s;
        }
        __syncthreads();
        const int i = tid >> 2, v0 = (tid & 3) * 32;
        float acc[32];
#pragma unroll
        for (int j = 0; j < 32; ++j) acc[j] = 0.f;
        for (int j = 0; j <= i; ++j) {
            const float s = Sc[i * 128 + j];
            const bf16_t* vr = Z0 + (row0 + j) * ZW + 1024 + h * 128 + v0;
#pragma unroll
            for (int q = 0; q < 4; ++q) { const u32x4 vv = *(const u32x4*)(vr + q * 8);
                acc[q * 8 + 0] += s * bflo(vv.x); acc[q * 8 + 1] += s * bfhi(vv.x); acc[q * 8 + 2] += s * bflo(vv.y); acc[q * 8 + 3] += s * bfhi(vv.y);
                acc[q * 8 + 4] += s * bflo(vv.z); acc[q * 8 + 5] += s * bfhi(vv.z); acc[q * 8 + 6] += s * bflo(vv.w); acc[q * 8 + 7] += s * bfhi(vv.w); }
        }
        const float qdec = __expf(lg * (float)(i + 1));
        const float* S = KV + (size_t)u * 16384;
        for (int dd = 0; dd < 128; ++dd) {
            const float qd = bf2f(Qs[i * 136 + dd]) * qdec;
            const float* sr = S + dd * 128 + v0;
#pragma unroll
            for (int q = 0; q < 32; q += 4) { const f32x4 sv = *(const f32x4*)(sr + q); acc[q] += qd * sv.x; acc[q + 1] += qd * sv.y; acc[q + 2] += qd * sv.z; acc[q + 3] += qd * sv.w; }
        }
        float sm = 0.f;
#pragma unroll
        for (int j = 0; j < 32; ++j) sm += acc[j];
        sm += __shfl_xor(sm, 1); sm += __shfl_xor(sm, 2);
        const float mu = sm * (1.0f / 128.0f);
        float sq = 0.f;
#pragma unroll
        for (int j = 0; j < 32; ++j) { const float dlt = acc[j] - mu; sq += dlt * dlt; }
        sq += __shfl_xor(sq, 1); sq += __shfl_xor(sq, 2);
        const float rstd = 1.0f / sqrtf(sq * (1.0f / 128.0f) + LN_EPS);
        const bf16_t* gr = Z0 + (row0 + i) * ZW + 1536 + h * 128 + v0;
        bf16_t* orow = MIX + (row0 + i) * DM + h * 128 + v0;
#pragma unroll
        for (int q = 0; q < 4; ++q) {
            const u32x4 gv = *(const u32x4*)(gr + q * 8);
            const float g8[8] = {bflo(gv.x), bfhi(gv.x), bflo(gv.y), bfhi(gv.y), bflo(gv.z), bfhi(gv.z), bflo(gv.w), bfhi(gv.w)};
            float o8[8];
#pragma unroll
            for (int j = 0; j < 8; ++j) o8[j] = (acc[q * 8 + j] - mu) * rstd * gn[h * 128 + v0 + q * 8 + j] * silu_f(g8[j]);
            u32x4 w; w.x = pk2(o8[0], o8[1]); w.y = pk2(o8[2], o8[3]); w.z = pk2(o8[4], o8[5]); w.w = pk2(o8[6], o8[7]);
            *(u32x4*)(orow + q * 8) = w;
        }
        __syncthreads();
    }
}

__device__ __forceinline__ void phase_ln_route(const Params& P, unsigned char* lds, int layer) {
    float* F = (float*)(P.ws + WS_F); bf16_t* XB = (bf16_t*)(P.ws + WS_XB);
    float* TOKG = (float*)(P.ws + WS_TOKG); int* LIST = (int*)(P.ws + WS_LIST);
    int* CNT = (int*)(P.ws + WS_CTL) + layer * 64;
    const float* lg = P.in[14] + layer * DM; const float* lb = P.in[15] + layer * DM;
    const float* wg = P.in[18] + (size_t)layer * DM * 4; const float* bg = P.in[19] + layer * 4;
    const float* we = P.in[20] + (size_t)layer * DM * 32; const float* be = P.in[21] + layer * 32;
    int* dec = (int*)lds;
    int* rank = dec + 256;
    int* lcnt = rank + 256;
    int* lbase = lcnt + 32;
    const int tid = threadIdx.x, lane = tid & 63, wave = tid >> 6;
    for (int rb = blockIdx.x; rb < NTOK / 128; rb += gridDim.x) {
        if (tid < 32) lcnt[tid] = 0;
        __syncthreads();
        for (int ri = 0; ri < 16; ++ri) {
            const int rl = wave * 16 + ri, t = rb * 128 + rl;
            float* fr = F + (size_t)t * DM;
            f32x4 v[4]; float s = 0.f;
#pragma unroll
            for (int j = 0; j < 4; ++j) { v[j] = *(const f32x4*)(fr + 256 * j + 4 * lane); s += (v[j].x + v[j].y) + (v[j].z + v[j].w); }
            const float mean = wave_sum(s) * (1.0f / DM); float s2 = 0.f;
#pragma unroll
            for (int j = 0; j < 4; ++j) { v[j] = v[j] - mean; s2 += (v[j].x * v[j].x + v[j].y * v[j].y) + (v[j].z * v[j].z + v[j].w * v[j].w); }
            const float rstd = 1.0f / sqrtf(wave_sum(s2) * (1.0f / DM) + LN_EPS);
            float acc[36];
#pragma unroll
            for (int j = 0; j < 36; ++j) acc[j] = 0.f;
#pragma unroll
            for (int j = 0; j < 4; ++j) {
                const int c0 = 256 * j + 4 * lane;
                const f32x4 g4 = *(const f32x4*)(lg + c0), b4 = *(const f32x4*)(lb + c0);
                v[j] = v[j] * rstd * g4 + b4;
                *(f32x4*)(fr + c0) = v[j];
                u32x2 w; w.x = pk2(v[j].x, v[j].y); w.y = pk2(v[j].z, v[j].w);
                *(u32x2*)(XB + (size_t)t * DM + c0) = w;
#pragma unroll
                for (int q = 0; q < 4; ++q) {
                    const float xv = v[j][q]; const int c = c0 + q;
                    const f32x4 w4 = *(const f32x4*)(wg + (size_t)c * 4);
                    acc[0] += xv * w4.x; acc[1] += xv * w4.y; acc[2] += xv * w4.z; acc[3] += xv * w4.w;
#pragma unroll
                    for (int e4 = 0; e4 < 8; ++e4) { const f32x4 w8 = *(const f32x4*)(we + (size_t)c * 32 + e4 * 4);
                        acc[4 + e4 * 4] += xv * w8.x; acc[5 + e4 * 4] += xv * w8.y; acc[6 + e4 * 4] += xv * w8.z; acc[7 + e4 * 4] += xv * w8.w; }
                    asm volatile("" ::: "memory");
                }
            }
#pragma unroll
            for (int j = 0; j < 36; ++j) acc[j] = wave_sum(acc[j]);
            float gl[4];
#pragma unroll
            for (int j = 0; j < 4; ++j) gl[j] = acc[j] + bg[j];
            int grp = 0; float gm = gl[0];
#pragma unroll
            for (int j = 1; j < 4; ++j) if (gl[j] > gm) { gm = gl[j]; grp = j; }
            float gs = 0.f;
#pragma unroll
            for (int j = 0; j < 4; ++j) gs += __expf(gl[j] - gm);
            const float gw = 1.0f / gs;
            float el[8];
#pragma unroll
            for (int j = 0; j < 8; ++j) el[j] = 0.f;
#pragma unroll
            for (int g = 0; g < 4; ++g)
#pragma unroll
                for (int j = 0; j < 8; ++j) el[j] = (g == grp) ? (acc[4 + g * 8 + j] + be[g * 8 + j]) : el[j];
            int i0 = 0; float m0 = el[0];
#pragma unroll
            for (int j = 1; j < 8; ++j) if (el[j] > m0) { m0 = el[j]; i0 = j; }
            int i1 = -1; float m1 = -INFINITY;
#pragma unroll
            for (int j = 0; j < 8; ++j) if (j != i0 && el[j] > m1) { m1 = el[j]; i1 = j; }
            const float ex = __expf(m1 - m0);
            const float p0 = 1.0f / (1.0f + ex), p1 = ex / (1.0f + ex);
            if (lane == 0) {
                dec[rl * 2] = grp * 8 + i0; dec[rl * 2 + 1] = grp * 8 + i1;
                TOKG[(size_t)t * 2] = gw * p0; TOKG[(size_t)t * 2 + 1] = gw * p1;
            }
        }
        __syncthreads();
        if (tid < 256) rank[tid] = atomicAdd(&lcnt[dec[tid]], 1);
        __syncthreads();
        if (tid < 32) lbase[tid] = atomicAdd(&CNT[tid], lcnt[tid]);
        __syncthreads();
        if (tid < 256) { const int e = dec[tid]; LIST[(size_t)e * LIST_CAP + lbase[e] + rank[tid]] = (rb * 128 + (tid >> 1)) * 2 + (tid & 1); }
        __syncthreads();
    }
}
__device__ __forceinline__ void moe_setup(const Params& P, int* tb, int layer) {
    const int* CNT = (const int*)(P.ws + WS_CTL) + layer * 64;
    if (threadIdx.x == 0) { int a = 0; for (int e = 0; e < 32; ++e) { tb[e] = a; a += (CNT[e] + 255) >> 8; } tb[32] = a; }
    __syncthreads();
}
__device__ __forceinline__ void phase_ln2(const Params& P, int layer) {
    float* F = (float*)(P.ws + WS_F); bf16_t* XB = (bf16_t*)(P.ws + WS_XB); const bf16_t* YS = (const bf16_t*)(P.ws + WS_YS); const float* TOKG = (const float*)(P.ws + WS_TOKG);
    const float* lg = P.in[16] + layer * DM; const float* lb = P.in[17] + layer * DM;
    const int lane = threadIdx.x & 63, gw = blockIdx.x * NWAVE + (threadIdx.x >> 6), NGW = gridDim.x * NWAVE;
    for (int t = gw; t < NTOK; t += NGW) {
        float* fr = F + (size_t)t * DM; const float g0 = TOKG[(size_t)t * 2], g1 = TOKG[(size_t)t * 2 + 1];
        const bf16_t* y0 = YS + (size_t)(2 * t) * DM; const bf16_t* y1 = y0 + DM;
        f32x4 v[4]; float s = 0.f;
#pragma unroll
        for (int j = 0; j < 4; ++j) { const int c0 = 256 * j + 4 * lane; v[j] = *(const f32x4*)(fr + c0);
            const u32x2 a = *(const u32x2*)(y0 + c0), b = *(const u32x2*)(y1 + c0);
            v[j].x = v[j].x * ALPHA + g0 * bflo(a.x) + g1 * bflo(b.x); v[j].y = v[j].y * ALPHA + g0 * bfhi(a.x) + g1 * bfhi(b.x);
            v[j].z = v[j].z * ALPHA + g0 * bflo(a.y) + g1 * bflo(b.y); v[j].w = v[j].w * ALPHA + g0 * bfhi(a.y) + g1 * bfhi(b.y);
            s += (v[j].x + v[j].y) + (v[j].z + v[j].w); }
        const float mean = wave_sum(s) * (1.0f / DM); float s2 = 0.f;
#pragma unroll
        for (int j = 0; j < 4; ++j) { v[j] = v[j] - mean; s2 += (v[j].x * v[j].x + v[j].y * v[j].y) + (v[j].z * v[j].z + v[j].w * v[j].w); }
        const float rstd = 1.0f / sqrtf(wave_sum(s2) * (1.0f / DM) + LN_EPS);
#pragma unroll
        for (int j = 0; j < 4; ++j) { const int c0 = 256 * j + 4 * lane;
            const f32x4 g4 = *(const f32x4*)(lg + c0), b4 = *(const f32x4*)(lb + c0);
            v[j] = v[j] * rstd * g4 + b4; *(f32x4*)(fr + c0) = v[j];
            u32x2 w; w.x = pk2(v[j].x, v[j].y); w.y = pk2(v[j].z, v[j].w); *(u32x2*)(XB + (size_t)t * DM + c0) = w; }
    }
}

__device__ __forceinline__ void phase_norms(const Params& P) {
    const bf16_t* Z1 = (const bf16_t*)(P.ws + WS_Z1); bf16_t* CQ = (bf16_t*)(P.ws + WS_CQ); bf16_t* CKV = (bf16_t*)(P.ws + WS_CKV);
    const float* qn = P.in[8]; const float* kn = P.in[9];
    const int lane = threadIdx.x & 63, gw = blockIdx.x * NWAVE + (threadIdx.x >> 6), NGW = gridDim.x * NWAVE;
    for (int t = gw; t < NTOK; t += NGW) {
        const u32x2 a = *(const u32x2*)(Z1 + (size_t)t * Z1W + 4 * lane), b = *(const u32x2*)(Z1 + (size_t)t * Z1W + 256 + 4 * lane);
        const float q[4] = {bflo(a.x), bfhi(a.x), bflo(a.y), bfhi(a.y)}, k[4] = {bflo(b.x), bfhi(b.x), bflo(b.y), bfhi(b.y)};
        const float sq = wave_sum(q[0] * q[0] + q[1] * q[1] + q[2] * q[2] + q[3] * q[3]), sk = wave_sum(k[0] * k[0] + k[1] * k[1] + k[2] * k[2] + k[3] * k[3]);
        const float rq = 1.0f / sqrtf(sq * (1.0f / 256.0f) + 1e-6f), rk = 1.0f / sqrtf(sk * (1.0f / 256.0f) + 1e-6f);
        const f32x4 gq = *(const f32x4*)(qn + 4 * lane), gk = *(const f32x4*)(kn + 4 * lane);
        u32x2 o; o.x = pk2(q[0] * rq * gq.x, q[1] * rq * gq.y); o.y = pk2(q[2] * rq * gq.z, q[3] * rq * gq.w);
        *(u32x2*)(CQ + (size_t)t * 256 + 4 * lane) = o;
        o.x = pk2(k[0] * rk * gk.x, k[1] * rk * gk.y); o.y = pk2(k[2] * rk * gk.z, k[3] * rk * gk.w);
        *(u32x2*)(CKV + (size_t)t * 256 + 4 * lane) = o;
    }
}
__device__ __forceinline__ unsigned fkey(float f) { const unsigned u = __float_as_uint(f); return (u & 0x80000000u) ? ~u : (u | 0x80000000u); }

__device__ __forceinline__ void phase_index(const Params& P, unsigned char* lds) {
    const bf16_t* Z1 = (const bf16_t*)(P.ws + WS_Z1); unsigned short* SEL = (unsigned short*)(P.ws + WS_SEL);
    float* sc = (float*)lds;
    float* qf = sc + 8192;
    float* wf = qf + 512;
    int* hist = (int*)(wf + 8);
    int* misc = hist + 256;
    int* seg = misc + 8;
    const int tid = threadIdx.x;
    for (int t = blockIdx.x; t < NTOK; t += gridDim.x) {
        const int b = t >> 13, tl = t & (SEQ - 1), n = tl + 1;
        unsigned short* so = SEL + (size_t)t * TOPK;
        if (n <= TOPK) { if (tid < n) so[tid] = (unsigned short)tid; continue; }
        qf[tid] = bf2f(Z1[(size_t)t * Z1W + 512 + tid]);
        if (tid < 8) wf[tid] = bf2f(Z1[(size_t)t * Z1W + 1088 + tid]);
        __syncthreads();
        for (int s = tid; s < n; s += NT) {
            const bf16_t* kr = Z1 + ((size_t)b * SEQ + s) * Z1W + 1024;
            float k[64];
#pragma unroll
            for (int q = 0; q < 8; ++q) { const u32x4 v = *(const u32x4*)(kr + q * 8);
                k[q * 8] = bflo(v.x); k[q * 8 + 1] = bfhi(v.x); k[q * 8 + 2] = bflo(v.y); k[q * 8 + 3] = bfhi(v.y);
                k[q * 8 + 4] = bflo(v.z); k[q * 8 + 5] = bfhi(v.z); k[q * 8 + 6] = bflo(v.w); k[q * 8 + 7] = bfhi(v.w); }
            float I = 0.f;
#pragma unroll
            for (int h = 0; h < 8; ++h) { float d = 0.f;
#pragma unroll
                for (int dd = 0; dd < 64; ++dd) d += qf[h * 64 + dd] * k[dd];
                I += wf[h] * fmaxf(d, 0.f); }
            sc[s] = I;
        }
        if (tid == 0) { misc[0] = 0; misc[1] = TOPK; misc[2] = 0; }
        __syncthreads();
        for (int pass = 0; pass < 4; ++pass) {
            const int shift = 24 - 8 * pass;
            if (tid < 256) hist[tid] = 0;
            __syncthreads();
            const unsigned prefix = (unsigned)misc[0]; const int kk = misc[1];
            for (int s = tid; s < n; s += NT) { const unsigned key = fkey(sc[s]);
                if (pass == 0 || (key >> (shift + 8)) == prefix) atomicAdd(&hist[(key >> shift) & 255], 1); }
            __syncthreads();
            if (tid == 0) { int a = 0, bsel = 0; for (int bin = 255; bin >= 0; --bin) { const int c = hist[bin]; if (a + c >= kk) { bsel = bin; break; } a += c; }
                misc[0] = (int)((prefix << 8) | (unsigned)bsel); misc[1] = kk - a; }
            __syncthreads();
        }
        const unsigned T = (unsigned)misc[0]; const int keq = misc[1];
        for (int s = tid; s < n; s += NT) if (fkey(sc[s]) > T) { const int o = atomicAdd(&misc[2], 1); so[o] = (unsigned short)s; }
        const int per = (n + NT - 1) / NT, s0 = tid * per, s1 = min(n, s0 + per);
        int ce = 0;
        for (int s = s0; s < s1; ++s) ce += (fkey(sc[s]) == T) ? 1 : 0;
        seg[tid] = ce;
        __syncthreads();
        if (tid == 0) { int a = 0; for (int i = 0; i < NT; ++i) { const int c = seg[i]; seg[i] = a; a += c; } }
        __syncthreads();
        const int ngt = TOPK - keq;
        int r = seg[tid];
        for (int s = s0; s < s1 && r < keq; ++s) if (fkey(sc[s]) == T) { so[ngt + r] = (unsigned short)s; ++r; }
        __syncthreads();
    }
}
__device__ __forceinline__ void phase_sparse_attn(const Params& P, unsigned char* lds) {
    bf16_t* QA = (bf16_t*)(P.ws + WS_QA); const bf16_t* CKV = (const bf16_t*)(P.ws + WS_CKV); const unsigned short* SEL = (const unsigned short*)(P.ws + WS_SEL);
    float* qa = (float*)lds;
    float* lgt = qa + 4096;
    int* sel = (int*)(lgt + 4096);
    const int tid = threadIdx.x, lane = tid & 63, wave = tid >> 6;
    for (int t = blockIdx.x; t < NTOK; t += gridDim.x) {
        const int b = t >> 13, tl = t & (SEQ - 1), ns = min(tl + 1, TOPK);
        { const u32x4 v = *(const u32x4*)(QA + (size_t)t * 4096 + tid * 8); float* q = qa + tid * 8;
          q[0] = bflo(v.x); q[1] = bfhi(v.x); q[2] = bflo(v.y); q[3] = bfhi(v.y); q[4] = bflo(v.z); q[5] = bfhi(v.z); q[6] = bflo(v.w); q[7] = bfhi(v.w); }
        if (tid < TOPK) sel[tid] = (tid < ns) ? (int)SEL[(size_t)t * TOPK + tid] : 0;
        __syncthreads();
        const int k = tid & 255, hg = tid >> 8;
        {
            float acc[8];
#pragma unroll
            for (int h = 0; h < 8; ++h) acc[h] = 0.f;
            if (k < ns) {
                const bf16_t* cr = CKV + ((size_t)b * SEQ + sel[k]) * 256;
                for (int c8 = 0; c8 < 256; c8 += 8) {
                    const u32x4 v = *(const u32x4*)(cr + c8);
                    const float cv[8] = {bflo(v.x), bfhi(v.x), bflo(v.y), bfhi(v.y), bflo(v.z), bfhi(v.z), bflo(v.w), bfhi(v.w)};
#pragma unroll
                    for (int h = 0; h < 8; ++h) { const float* q = qa + (hg * 8 + h) * 256 + c8;
#pragma unroll
                        for (int j = 0; j < 8; ++j) acc[h] += q[j] * cv[j]; }
                }
            }
#pragma unroll
            for (int h = 0; h < 8; ++h) { const int hh = hg * 8 + h; const float slope = exp2f(-0.5f * (float)(hh + 1));
                lgt[hh * 256 + k] = (k < ns) ? (acc[h] - slope * (float)(tl - sel[k])) : -INFINITY; }
        }
        __syncthreads();
        for (int hh = wave * 2; hh < wave * 2 + 2; ++hh) {
            float* row = lgt + hh * 256;
            float x[4]; float m = -INFINITY;
#pragma unroll
            for (int j = 0; j < 4; ++j) { x[j] = row[lane + 64 * j]; m = fmaxf(m, x[j]); }
            m = wave_max(m); float s = 0.f;
#pragma unroll
            for (int j = 0; j < 4; ++j) { x[j] = __expf(x[j] - m); s += x[j]; }
            s = wave_sum(s); const float inv = 1.0f / s;
#pragma unroll
            for (int j = 0; j < 4; ++j) row[lane + 64 * j] = x[j] * inv;
        }
        __syncthreads();
        {
            const int c = tid & 255;
            float acc[8];
#pragma unroll
            for (int h = 0; h < 8; ++h) acc[h] = 0.f;
            const bf16_t* cb = CKV + (size_t)b * SEQ * 256 + c;
            for (int kk = 0; kk < ns; ++kk) {
                const float cv = bf2f(cb[(size_t)sel[kk] * 256]);
#pragma unroll
                for (int h = 0; h < 8; ++h) acc[h] += lgt[(hg * 8 + h) * 256 + kk] * cv;
            }
#pragma unroll
            for (int h = 0; h < 8; ++h) QA[(size_t)t * 4096 + (hg * 8 + h) * 256 + c] = (bf16_t)f2bf(acc[h]);
        }
        __syncthreads();
    }
}

constexpr int NPH_TOTAL = 23;

#ifdef PH_ONLY
#define IN(k) ((k) == PH_ONLY)
#else
#define IN(k) (lo <= (k) && (k) < hi)
#endif
#define SEAM(k) do { if (IN(k) && IN((k) + 1)) grid.sync(); } while (0)

template <int LAYER, int BASE>
__device__ __forceinline__ void layer_tail(const Params& P, unsigned char* lds, cg::grid_group& grid, int lo, int hi) {
    unsigned char* ws = P.ws;
    int* tb = (int*)(lds + MISC_OFF);
    if (IN(BASE)) phase_ln_route(P, lds, LAYER);
    SEAM(BASE);
    if (IN(BASE + 1)) { moe_setup(P, tb, LAYER);
        MoeSched S{tb, (const int*)(ws + WS_CTL) + LAYER * 64, (const int*)(ws + WS_LIST), (const bf16_t*)(ws + WS_XB),
                   (const bf16_t*)(ws + WS_W_GU) + (size_t)LAYER * 32 * DM * DM, DM, (size_t)DM * DM, true};
        EpiGU E{(bf16_t*)(ws + WS_ACT)}; gemm_simple(lds, S, E, false); }
    SEAM(BASE + 1);
    if (IN(BASE + 2)) { moe_setup(P, tb, LAYER);
        MoeSched S{tb, (const int*)(ws + WS_CTL) + LAYER * 64, (const int*)(ws + WS_LIST), (const bf16_t*)(ws + WS_ACT),
                   (const bf16_t*)(ws + WS_W_DN) + (size_t)LAYER * 32 * DM * 512, 512, (size_t)DM * 512, false};
        EpiDown E{(bf16_t*)(ws + WS_YS)}; gemm_simple(lds, S, E, true); }
    SEAM(BASE + 2);
    if (IN(BASE + 3)) phase_ln2(P, LAYER);
    SEAM(BASE + 3);
    if (IN(BASE + 4)) {
        { DenseSched S{(const bf16_t*)(ws + WS_PB) + (size_t)LAYER * NTOK * 256, (const bf16_t*)(ws + WS_W_P) + (size_t)LAYER * DM * 256, NTOK, DM, 256, 256, 0};
          EpiStoreBf16 E{(bf16_t*)(ws + WS_PP), DM, 0, nullptr}; gemm_simple(lds, S, E, true); }
        __syncthreads();
        { DenseSched S{(const bf16_t*)(ws + WS_XB), (const bf16_t*)(ws + WS_W_G) + (size_t)LAYER * DM * DM, NTOK, DM, DM, DM, 0};
          EpiPle E{(const float*)(ws + WS_F), (const bf16_t*)(ws + WS_PP), LAYER == 1 ? P.out : (float*)(ws + WS_F), LAYER == 1 ? (bf16_t*)nullptr : (bf16_t*)(ws + WS_XB2)}; gemm_simple(lds, S, E, true); }
    }
}

__global__ void __launch_bounds__(NT, 2) mega(Params P, int lo, int hi) {
    extern __shared__ __attribute__((aligned(16))) unsigned char lds[];
    unsigned char* ws = P.ws;
    cg::grid_group grid = cg::this_grid();
    if (IN(0)) phase_prep(P, lds);
    SEAM(0);
    if (IN(1)) { DenseSched S{(const bf16_t*)(ws + WS_XB), (const bf16_t*)(ws + WS_W_IN0), NTOK, ZW, DM, DM, 0};
        EpiStoreBf16 E{(bf16_t*)(ws + WS_Z0), ZW, 0, nullptr}; gemm_simple(lds, S, E, true); }
    SEAM(1);
    if (IN(2)) phase_ret_kv(P, lds);
    SEAM(2);
    if (IN(3)) phase_ret_scan_pool(P);
    SEAM(3);
    if (IN(4)) { phase_ret_out(P, lds);
        DenseSched S{(const bf16_t*)(ws + WS_DP), (const bf16_t*)(ws + WS_W_POOL), NTOK, 512, 256, 512, 256};
        EpiStoreBf16 E{(bf16_t*)(ws + WS_MIX), DM, 512, P.in[5]}; gemm_simple(lds, S, E, true); }
    SEAM(4);
    if (IN(5)) { DenseSched S{(const bf16_t*)(ws + WS_MIX), (const bf16_t*)(ws + WS_W_OUT0), NTOK, DM, DM, DM, 0};
        EpiResid E{P.in[0], (float*)(ws + WS_F)}; gemm_simple(lds, S, E, true); }
    SEAM(5);
    layer_tail<0, 6>(P, lds, grid, lo, hi);
    SEAM(10);
    if (IN(11)) { DenseSched S{(const bf16_t*)(ws + WS_XB2), (const bf16_t*)(ws + WS_W_CIN), NTOK, Z1W, DM, DM, 0};
        EpiStoreBf16 E{(bf16_t*)(ws + WS_Z1), Z1W, 0, nullptr}; gemm_simple(lds, S, E, true); }
    SEAM(11);
    if (IN(12)) phase_norms(P);
    SEAM(12);
    if (IN(13)) { DenseSched S{(const bf16_t*)(ws + WS_CQ), (const bf16_t*)(ws + WS_W_QA), NTOK, 4096, 256, 256, 0};
        EpiStoreBf16 E{(bf16_t*)(ws + WS_QA), 4096, 0, nullptr}; gemm_simple(lds, S, E, true); }
    SEAM(13);
    if (IN(14)) phase_index(P, lds);
    SEAM(14);
    if (IN(15)) phase_sparse_attn(P, lds);
    SEAM(15);
    if (IN(16)) { DenseSched S{(const bf16_t*)(ws + WS_QA), (const bf16_t*)(ws + WS_W_UVBD), NTOK, DM, DM, 4096, 1024};
        EpiStoreBf16 E{(bf16_t*)(ws + WS_XB), DM, 0, nullptr}; gemm_simple(lds, S, E, true); }
    SEAM(16);
    if (IN(17)) { DenseSched S{(const bf16_t*)(ws + WS_XB), (const bf16_t*)(ws + WS_W_COUT), NTOK, DM, DM, DM, 0};
        EpiResid E{(const float*)(ws + WS_F), (float*)(ws + WS_F)}; gemm_simple(lds, S, E, true); }
    SEAM(17);
    layer_tail<1, 18>(P, lds, grid, lo, hi);
}
#undef IN
#undef SEAM

extern "C" void kernel_launch(void* const* d_in, const int* in_sizes, int n_in, void* d_out, int out_size, void* d_ws, size_t ws_size, hipStream_t stream) {
    static int grid = 0;
    if (grid == 0) {
        if (n_in != 26 || ws_size < WS_END || out_size != NTOK * DM) { fprintf(stderr, "kernel_launch: unexpected problem (n_in %d, ws %zu, out %d)\n", n_in, ws_size, out_size); grid = -1; return; }
        int dev = 0, cus = 0, per_cu = 0;
        (void)hipGetDevice(&dev);
        (void)hipDeviceGetAttribute(&cus, hipDeviceAttributeMultiprocessorCount, dev);
        (void)hipFuncSetAttribute((const void*)mega, hipFuncAttributeMaxDynamicSharedMemorySize, LDS_BYTES);
        (void)hipOccupancyMaxActiveBlocksPerMultiprocessor(&per_cu, (const void*)mega, NT, LDS_BYTES);
        if (per_cu < 1) { fprintf(stderr, "kernel_launch: occupancy query reports %d blocks per CU\n", per_cu); per_cu = 1; }
        (void)hipGetLastError();
        grid = cus;
    }
    if (grid < 0) return;
    (void)hipMemsetAsync((char*)d_ws + WS_CTL, 0, 4096, stream);
    Params p{};
    for (int i = 0; i < 26; ++i) p.in[i] = (const float*)d_in[i];
    p.out = (float*)d_out; p.ws = (unsigned char*)d_ws;
#if MK_ONE_LAUNCH
    int lo = 0, hi = NPH_TOTAL;
    void* args[] = {&p, &lo, &hi};
    hipError_t e = hipLaunchCooperativeKernel((const void*)mega, dim3(grid), dim3(NT), args, LDS_BYTES, stream);
    if (e != hipSuccess) fprintf(stderr, "cooperative launch failed: %s (grid %d)\n", hipGetErrorString(e), grid);
#else
    for (int k = 0; k < NPH_TOTAL; ++k) hipLaunchKernelGGL(mega, dim3(grid), dim3(NT), LDS_BYTES, stream, p, k, k + 1);
#endif
}
```

```cpp
#include <hip/hip_runtime.h>
#include <hip/hip_cooperative_groups.h>
#include <cstdio>
#include <cstdint>
namespace cg = cooperative_groups;

#ifndef MK_ONE_LAUNCH
#define MK_ONE_LAUNCH 1
#endif

typedef unsigned short bf16_t;
typedef float f32x4 __attribute__((ext_vector_type(4)));
typedef unsigned u32x4 __attribute__((ext_vector_type(4)));
typedef unsigned u32x2 __attribute__((ext_vector_type(2)));

constexpr int NT = 512;
constexpr int NWAVE = NT / 64;
constexpr int NTOK = 32768, DM = 1024, SEQ = 8192, NBATCH = 4;
constexpr int ZW = 2560;
constexpr int Z1W = 1280;
constexpr int CIN = 1096;
constexpr int TOPK = 256;
constexpr float ALPHA = 1.4142135623730951f;
constexpr float LN_EPS = 1e-5f;
constexpr int LDS_BYTES = 147456;
constexpr int MISC_OFF = 135168;

constexpr size_t MiB = (size_t)1 << 20;
constexpr size_t WS_CTL = 0;
constexpr size_t WS_W_IN0 = 1 * MiB, WS_W_OUT0 = 6 * MiB, WS_W_POOL = 8 * MiB, WS_W_CIN = 9 * MiB, WS_W_QA = 12 * MiB,
                 WS_W_UVBD = 14 * MiB, WS_W_COUT = 16 * MiB, WS_W_G = 18 * MiB, WS_W_P = 22 * MiB, WS_W_GU = 24 * MiB, WS_W_DN = 152 * MiB;
constexpr size_t WS_XB = 224 * MiB, WS_F = 288 * MiB, WS_PB = 416 * MiB, WS_PP = 448 * MiB, WS_CQ = 512 * MiB, WS_CKV = 528 * MiB,
                 WS_SEL = 544 * MiB, WS_TOKG = 560 * MiB, WS_LIST = 561 * MiB;
constexpr size_t WS_M0 = 576 * MiB;
constexpr size_t WS_Z0 = WS_M0, WS_KV = WS_M0 + 160 * MiB, WS_MIX = WS_M0 + 224 * MiB, WS_DP = WS_M0 + 288 * MiB;
constexpr size_t WS_QA = WS_M0, WS_Z1 = WS_M0 + 256 * MiB;
constexpr size_t WS_ACT = WS_M0, WS_YS = WS_M0 + 72 * MiB;
constexpr size_t WS_XB2 = 912 * MiB;
constexpr size_t WS_END = 976 * MiB;
constexpr int LIST_CAP = 32768;

struct Params {
    const float* in[26];
    float* out;
    unsigned char* ws;
};

__device__ __forceinline__ unsigned f2bf(float f) { unsigned u = __float_as_uint(f); return (u + 0x7fffu + ((u >> 16) & 1u)) >> 16; }
__device__ __forceinline__ float bf2f(unsigned h) { return __uint_as_float(h << 16); }
__device__ __forceinline__ unsigned pk2(float lo, float hi) { return f2bf(lo) | (f2bf(hi) << 16); }
__device__ __forceinline__ float bflo(unsigned w) { return __uint_as_float(w << 16); }
__device__ __forceinline__ float bfhi(unsigned w) { return __uint_as_float(w & 0xffff0000u); }
__device__ __forceinline__ float wave_sum(float v) {
#pragma unroll
    for (int o = 1; o < 64; o <<= 1) v += __shfl_xor(v, o);
    return v;
}
__device__ __forceinline__ float wave_max(float v) {
#pragma unroll
    for (int o = 1; o < 64; o <<= 1) v = fmaxf(v, __shfl_xor(v, o));
    return v;
}
__device__ __forceinline__ float silu_f(float a) { return a / (1.0f + __expf(-a)); }
__device__ __forceinline__ float sigmoid_f(float a) { return 1.0f / (1.0f + __expf(-a)); }
#define LDS_FENCE() asm volatile("s_waitcnt lgkmcnt(0)" ::: "memory")

struct UnitInfo {
    const bf16_t* A; int lda;
    const int* rows; int rshift;
    int nvalid;
    const bf16_t* Bt; int ldb;
    int K;
    int orow0;
    int pn;
};
__device__ __forceinline__ const bf16_t* unit_arow(const UnitInfo& u, int r) {
    if (u.rows) { const int idx = (r < u.nvalid) ? (u.rows[r] >> u.rshift) : 0; return u.A + (size_t)idx * u.lda; }
    return u.A + (size_t)r * u.lda;
}

struct DenseSched {
    const bf16_t* A; const bf16_t* Bt; int M, N, K, lda, a_pn_stride;
    __device__ __forceinline__ bool next(int round, UnitInfo& u) const {
        const int nN = N >> 8, nM = M >> 8, nwg = nN * nM;
        const long L = (long)round * gridDim.x + blockIdx.x; if (L >= nwg) return false;
        int wgid = (int)L; { const int q = nwg / 8, r = nwg % 8, xcd = wgid % 8, off = wgid / 8; wgid = (xcd < r ? xcd * (q + 1) : r * (q + 1) + (xcd - r) * q) + off; }
        const int nig = 8 * nN, gid = wgid / nig, fm = gid * 8, gsz = (nM - fm) < 8 ? (nM - fm) : 8;
        const int pm = fm + ((wgid % nig) % gsz), pn = (wgid % nig) / gsz;
        u.A = A + (size_t)pm * 256 * lda + (size_t)pn * a_pn_stride; u.lda = lda; u.rows = nullptr; u.rshift = 0; u.nvalid = 256;
        u.Bt = Bt + (size_t)pn * 256 * K; u.ldb = K; u.K = K; u.orow0 = pm * 256; u.pn = pn;
        return true;
    }
};
struct MoeSched {
    const int* tb; const int* cnt; const int* list;
    const bf16_t* A; const bf16_t* W; int K; size_t wstride; bool gather;
    __device__ __forceinline__ bool next(int round, UnitInfo& u) const {
        const int i = round * gridDim.x + blockIdx.x;
        const int j = i >> 2, pn = i & 3;
        if (j >= tb[32]) return false;
        int e = 0;
        while (tb[e + 1] <= j) ++e;
        const int rb = j - tb[e];
        const int nv = min(256, cnt[e] - rb * 256);
        u.rows = list + (size_t)e * LIST_CAP + rb * 256; u.nvalid = nv; u.orow0 = j * 256; u.pn = pn;
        if (gather) { u.A = A; u.lda = K; u.rshift = 1; }
        else { u.A = A + (size_t)j * 256 * K; u.lda = K; u.rshift = 31;   }
        u.Bt = W + (size_t)e * wstride + (size_t)pn * 256 * K; u.ldb = K; u.K = K;
        return true;
    }
};

template <class Sched, class Epi>
__device__ __forceinline__ void gemm_simple(unsigned char* lds, const Sched& S, const Epi& E, bool contiguousA) {
    float* As = (float*)lds;
    float* Bs = As + 128 * 33;
    const int tid = threadIdx.x, ty = tid >> 3, tx = tid & 7;
    const int lr = tid >> 2, kc = (tid & 3) * 8;
    UnitInfo u;
    for (int round = 0; S.next(round, u); ++round) {
        for (int sm = 0; sm < 2; ++sm) {
            const int ar = sm * 128 + lr;
            const bf16_t* arow = contiguousA ? (u.A + (size_t)ar * u.lda) : unit_arow(u, ar);
            for (int sn = 0; sn < 4; ++sn) {
                float acc[2][8];
#pragma unroll
                for (int a = 0; a < 2; ++a)
#pragma unroll
                    for (int b = 0; b < 8; ++b) acc[a][b] = 0.f;
                const bf16_t* brow = u.Bt + (size_t)(sn * 64 + (tid >> 2)) * u.ldb;
                for (int k0 = 0; k0 < u.K; k0 += 32) {
                    const u32x4 av = *(const u32x4*)(arow + k0 + kc);
                    float* ap = As + lr * 33 + kc;
                    ap[0] = bflo(av.x); ap[1] = bfhi(av.x); ap[2] = bflo(av.y); ap[3] = bfhi(av.y);
                    ap[4] = bflo(av.z); ap[5] = bfhi(av.z); ap[6] = bflo(av.w); ap[7] = bfhi(av.w);
                    if (tid < 256) {
                        const u32x4 bv = *(const u32x4*)(brow + k0 + kc);
                        float* bp = Bs + (tid >> 2) * 33 + kc;
                        bp[0] = bflo(bv.x); bp[1] = bfhi(bv.x); bp[2] = bflo(bv.y); bp[3] = bfhi(bv.y);
                        bp[4] = bflo(bv.z); bp[5] = bfhi(bv.z); bp[6] = bflo(bv.w); bp[7] = bfhi(bv.w);
                    }
                    __syncthreads();
#pragma unroll 8
                    for (int kk = 0; kk < 32; ++kk) {
                        const float a0 = As[(2 * ty) * 33 + kk], a1 = As[(2 * ty + 1) * 33 + kk];
#pragma unroll
                        for (int j = 0; j < 8; ++j) { const float b = Bs[(tx * 8 + j) * 33 + kk]; acc[0][j] += a0 * b; acc[1][j] += a1 * b; }
                    }
                    __syncthreads();
                }
#pragma unroll
                for (int rr = 0; rr < 2; ++rr) {
                    const f32x4 v0 = {acc[rr][0], acc[rr][1], acc[rr][2], acc[rr][3]}, v1 = {acc[rr][4], acc[rr][5], acc[rr][6], acc[rr][7]};
                    E(u, sm * 128 + 2 * ty + rr, sn * 64 + tx * 8, v0, v1);
                }
            }
        }
    }
}


namespace pg8 {
#define LAS __attribute__((address_space(3)))
typedef short bf16x8 __attribute__((ext_vector_type(8)));
constexpr int BK = 64, HALF = 128, HTB = HALF * BK * 2, STAGE_BYTES = 8 * HTB;
__device__ __forceinline__ int lds_byte(int r, int c) { const int st = (r >> 4) * 2 + (c >> 5), rr = r & 15, cc = c & 31, ob = rr * 64 + cc * 2; return st * 1024 + (ob ^ (((ob >> 9) & 1) << 5)); }
__device__ __forceinline__ void stage_rc(int b, int& R, int& C) { const int st = b / 1024, sb = b % 1024, swz = sb ^ (((sb >> 9) & 1) << 5); R = (st >> 1) * 16 + swz / 64; C = (st & 1) * 32 + (swz % 64) / 2; }
__device__ __forceinline__ int perm32(int rho) { const int n = rho >> 4, i = rho & 15; return 8 * (i >> 2) + 4 * n + (i & 3); }

template <bool GATHER, class Sched, class Epi>
__device__ __forceinline__ void gemm_phase(LAS unsigned char* lds, const LAS unsigned* rowtab, const Sched& S, const Epi& E, const int lda, const int ldb, const int K) {
    const int tid = threadIdx.x, wid = __builtin_amdgcn_readfirstlane(tid >> 6), lane = tid & 63, wr = wid >> 2, wc = wid & 3, fr = lane & 15, fq = lane >> 4;
    const int nt = K / BK;
    unsigned voffA[2], voffB[2]; int RA[2]; unsigned CA2[2];
#pragma unroll
    for (int i = 0; i < 2; ++i) { int R, C; stage_rc(tid * 16 + i * 8192, R, C); const int Rb = (R & ~31) + perm32(R & 31);
        voffA[i] = (unsigned)(R * lda + C) * 2u; voffB[i] = (unsigned)(Rb * ldb + C) * 2u; RA[i] = R; CA2[i] = (unsigned)C * 2u; }
    const size_t kstep = (size_t)(BK * 2);
    const size_t hstepA = (size_t)HALF * lda * 2, hstepB = (size_t)HALF * ldb * 2;
    const unsigned ldsw = (unsigned)wid * 1024u;
    const int aoff = lds_byte(wr * 64 + fr, fq * 8), boff = lds_byte(wc * 32 + fr, fq * 8);
    unsigned offA[2][2];
#define PG8_SA(b, h) (((b) * 2 + (h)) * HTB)
#define PG8_SB(b, h) ((4 + (b) * 2 + (h)) * HTB)
#define PG8_STAGE(bufoff, gbase, voff) do { _Pragma("unroll") for (int _i = 0; _i < 2; ++_i) \
        __builtin_amdgcn_global_load_lds((const unsigned*)((const char*)(gbase) + (voff)[_i]), (LAS unsigned*)(lds + (bufoff) + ldsw + _i * 8192), 16, 0, 0); } while (0)
#define PG8_STAGE_A(bufoff, h, gbase) do { if (GATHER) PG8_STAGE(bufoff, gbase, offA[h]); else PG8_STAGE(bufoff, (gbase) + (h) * hstepA, voffA); } while (0)
#define PG8_LOADOFF(round) do { _Pragma("unroll") for (int _h = 0; _h < 2; ++_h) _Pragma("unroll") for (int _i = 0; _i < 2; ++_i) offA[_h][_i] = rowtab[(round) * 256 + _h * 128 + RA[_i]] + CA2[_i]; } while (0)
#define PG8_LDA(dst, b, h) do { _Pragma("unroll") for (int m = 0; m < 4; ++m) _Pragma("unroll") for (int k = 0; k < 2; ++k) dst[m][k] = *(const LAS bf16x8*)(lds + PG8_SA(b, h) + aoff + m * 2048 + k * 1024); } while (0)
#define PG8_LDB(dst, b, h) do { _Pragma("unroll") for (int n = 0; n < 2; ++n) _Pragma("unroll") for (int k = 0; k < 2; ++k) dst[n][k] = *(const LAS bf16x8*)(lds + PG8_SB(b, h) + boff + n * 2048 + k * 1024); } while (0)
#define PG8_MMA(ai, bj, At, Bt) do { __builtin_amdgcn_s_setprio(1); _Pragma("unroll") for (int m = 0; m < 4; ++m) _Pragma("unroll") for (int n = 0; n < 2; ++n) _Pragma("unroll") for (int k = 0; k < 2; ++k) \
        acc[ai][bj][m][n] = __builtin_amdgcn_mfma_f32_16x16x32_bf16(Bt[n][k], At[m][k], acc[ai][bj][m][n], 0, 0, 0); __builtin_amdgcn_s_setprio(0); } while (0)
#define PG8_WAIT_V(n) asm volatile("s_waitcnt vmcnt(" #n ")" ::: "memory")
#define PG8_WAIT_L(n) asm volatile("s_waitcnt lgkmcnt(" #n ")" ::: "memory")
#define PG8_BAR __builtin_amdgcn_s_barrier()
#define PG8_SCHED __builtin_amdgcn_sched_barrier(0)
    UnitInfo cur, nxt; int ui = 0;
    if (!S.next(0, cur)) return;
    f32x4 acc[2][2][4][2];
#pragma unroll
    for (int a = 0; a < 2; ++a)
#pragma unroll
        for (int b = 0; b < 2; ++b)
#pragma unroll
            for (int m = 0; m < 4; ++m)
#pragma unroll
                for (int n = 0; n < 2; ++n) acc[a][b][m][n] = (f32x4){0.f, 0.f, 0.f, 0.f};
    bf16x8 At[4][2], B0[2][2], B1[2][2];
    const char* cA = (const char*)cur.A; const char* cB = (const char*)cur.Bt;
    if (GATHER) { PG8_LOADOFF(0); }
    PG8_STAGE(PG8_SB(0, 0), cB, voffB); PG8_STAGE(PG8_SB(0, 1), cB + hstepB, voffB); PG8_STAGE_A(PG8_SA(0, 0), 0, cA); PG8_STAGE_A(PG8_SA(0, 1), 1, cA);
    if (wr == 1) PG8_BAR;
    PG8_WAIT_V(2); PG8_BAR;
    PG8_STAGE(PG8_SB(1, 0), cB + kstep, voffB); PG8_STAGE_A(PG8_SA(1, 0), 0, cA + kstep); PG8_STAGE(PG8_SB(1, 1), cB + hstepB + kstep, voffB);
    PG8_WAIT_V(6); PG8_BAR;
    for (;;) {
        const bool has_next = S.next(ui + 1, nxt);
        const char* nA = has_next ? (const char*)nxt.A : cA; const char* nB = has_next ? (const char*)nxt.Bt : cB;
        for (int t = 0; t < nt; t += 2) {
            const bool last = (t == nt - 2);
            const char* a1 = cA + (size_t)(t + 1) * kstep;
            const char* a2 = last ? nA : cA + (size_t)(t + 2) * kstep; const char* b2 = last ? nB : cB + (size_t)(t + 2) * kstep;
            const char* a3 = a2 + kstep; const char* b3 = b2 + kstep;
            PG8_LDB(B0, 0, 0); PG8_LDB(B1, 0, 1); PG8_SCHED; PG8_LDA(At, 0, 0); PG8_STAGE_A(PG8_SA(1, 1), 1, a1);
            if (GATHER) { if (last && has_next) { PG8_LOADOFF(ui + 1); } }
            PG8_WAIT_V(8); PG8_WAIT_L(0); PG8_BAR; PG8_MMA(0, 0, At, B0); PG8_MMA(0, 1, At, B1); PG8_BAR; PG8_SCHED;
            PG8_LDA(At, 0, 1); PG8_STAGE(PG8_SB(0, 0), b2, voffB); PG8_STAGE(PG8_SB(0, 1), b2 + hstepB, voffB); PG8_STAGE_A(PG8_SA(0, 0), 0, a2);
            PG8_WAIT_V(8); PG8_WAIT_L(0); PG8_BAR; PG8_MMA(1, 0, At, B0); PG8_MMA(1, 1, At, B1); PG8_BAR; PG8_SCHED;
            PG8_LDB(B0, 1, 0); PG8_LDB(B1, 1, 1); PG8_SCHED; PG8_LDA(At, 1, 0); PG8_STAGE_A(PG8_SA(0, 1), 1, a2);
            PG8_WAIT_V(8); PG8_WAIT_L(0); PG8_BAR; PG8_MMA(0, 0, At, B0); PG8_MMA(0, 1, At, B1); PG8_BAR; PG8_SCHED;
            PG8_LDA(At, 1, 1); PG8_STAGE(PG8_SB(1, 0), b3, voffB); PG8_STAGE(PG8_SB(1, 1), b3 + hstepB, voffB); PG8_STAGE_A(PG8_SA(1, 0), 0, a3);
            PG8_WAIT_V(8); PG8_WAIT_L(0); PG8_BAR; PG8_MMA(1, 0, At, B0); PG8_MMA(1, 1, At, B1); PG8_BAR; PG8_SCHED;
        }
        if (wr == 0) PG8_BAR;
#pragma unroll
        for (int ai = 0; ai < 2; ++ai)
#pragma unroll
            for (int m = 0; m < 4; ++m)
#pragma unroll
                for (int bj = 0; bj < 2; ++bj) E(cur, ai * HALF + wr * 64 + m * 16 + fr, bj * HALF + wc * 32 + 8 * fq, acc[ai][bj][m][0], acc[ai][bj][m][1]);
        if (!has_next) break;
#pragma unroll
        for (int a = 0; a < 2; ++a)
#pragma unroll
            for (int b = 0; b < 2; ++b)
#pragma unroll
                for (int m = 0; m < 4; ++m)
#pragma unroll
                    for (int n = 0; n < 2; ++n) acc[a][b][m][n] = (f32x4){0.f, 0.f, 0.f, 0.f};
        cur = nxt; cA = nA; cB = nB; ++ui;
        if (wr == 1) PG8_BAR;
    }
    PG8_WAIT_V(0);
    PG8_BAR;
#undef PG8_SA
#undef PG8_SB
#undef PG8_STAGE
#undef PG8_STAGE_A
#undef PG8_LOADOFF
#undef PG8_LDA
#undef PG8_LDB
#undef PG8_MMA
#undef PG8_WAIT_V
#undef PG8_WAIT_L
#undef PG8_BAR
#undef PG8_SCHED
}
}

#ifndef USE_PG8_DENSE
#define USE_PG8_DENSE 1
#endif
#ifndef USE_PG8_MOE
#define USE_PG8_MOE 1
#endif
template <class Sched, class Epi>
__device__ __forceinline__ void gemm_dense(unsigned char* lds, const Sched& S, const Epi& E) {
#if USE_PG8_DENSE
    pg8::gemm_phase<false>((LAS unsigned char*)lds, (const LAS unsigned*)nullptr, S, E, S.lda, S.K, S.K);
    __syncthreads();
#else
    gemm_simple(lds, S, E, true);
#endif
}


template <bool GATHER, class Epi>
__device__ __forceinline__ void gemm_moe(unsigned char* lds, const MoeSched& S, const Epi& E) {
#if USE_PG8_MOE
    LAS unsigned* rowtab = (LAS unsigned*)(lds + MISC_OFF + 256);
    if (GATHER) {
        UnitInfo u;
        for (int round = 0; round < 10 && S.next(round, u); ++round)
            if (threadIdx.x < 256) rowtab[round * 256 + threadIdx.x] = ((int)threadIdx.x < u.nvalid) ? (unsigned)(u.rows[threadIdx.x] >> 1) * (unsigned)(S.K * 2) : 0u;
        __syncthreads();
    }
    pg8::gemm_phase<GATHER>((LAS unsigned char*)lds, (const LAS unsigned*)rowtab, S, E, S.K, S.K, S.K);
    __syncthreads();
#else
    gemm_simple(lds, S, E, !GATHER);
#endif
}

__device__ __forceinline__ u32x4 pack8(f32x4 a, f32x4 b) { u32x4 w; w.x = pk2(a.x, a.y); w.y = pk2(a.z, a.w); w.z = pk2(b.x, b.y); w.w = pk2(b.z, b.w); return w; }
struct EpiStoreBf16 {
    bf16_t* O; int ldc; int coff; const float* colscale;
    __device__ __forceinline__ void operator()(const UnitInfo& u, int r, int c, f32x4 v0, f32x4 v1) const {
        const int col = u.pn * 256 + c;
        if (colscale) { const f32x4 s0 = *(const f32x4*)(colscale + col), s1 = *(const f32x4*)(colscale + col + 4); v0 *= s0; v1 *= s1; }
        *(u32x4*)(O + (size_t)(u.orow0 + r) * ldc + coff + col) = pack8(v0, v1);
    }
};
struct EpiResid {
    const float* X; float* Fo;
    __device__ __forceinline__ void operator()(const UnitInfo& u, int r, int c, f32x4 v0, f32x4 v1) const {
        const size_t off = (size_t)(u.orow0 + r) * DM + u.pn * 256 + c;
        const f32x4 x0 = *(const f32x4*)(X + off), x1 = *(const f32x4*)(X + off + 4);
        *(f32x4*)(Fo + off) = x0 * ALPHA + v0; *(f32x4*)(Fo + off + 4) = x1 * ALPHA + v1;
    }
};
struct EpiGU {
    bf16_t* ACT;
    __device__ __forceinline__ void operator()(const UnitInfo& u, int r, int c, f32x4 v0, f32x4 v1) const {
        u32x2 w; w.x = pk2(silu_f(v0.x) * v0.y, silu_f(v0.z) * v0.w); w.y = pk2(silu_f(v1.x) * v1.y, silu_f(v1.z) * v1.w);
        *(u32x2*)(ACT + (size_t)(u.orow0 + r) * 512 + u.pn * 128 + (c >> 1)) = w;
    }
};
struct EpiDown {
    bf16_t* YS;
    __device__ __forceinline__ void operator()(const UnitInfo& u, int r, int c, f32x4 v0, f32x4 v1) const {
        if (r < u.nvalid) { const int pair = u.rows[r]; *(u32x4*)(YS + (size_t)pair * DM + u.pn * 256 + c) = pack8(v0, v1); }
    }
};
struct EpiPle {
    const float* F; const bf16_t* PP; float* OUT; bf16_t* XB;
    __device__ __forceinline__ void operator()(const UnitInfo& u, int r, int c, f32x4 v0, f32x4 v1) const {
        const size_t off = (size_t)(u.orow0 + r) * DM + u.pn * 256 + c;
        const u32x4 pw = *(const u32x4*)(PP + off);
        const f32x4 p0 = {bflo(pw.x), bfhi(pw.x), bflo(pw.y), bfhi(pw.y)}, p1 = {bflo(pw.z), bfhi(pw.z), bflo(pw.w), bfhi(pw.w)};
        f32x4 f0 = *(const f32x4*)(F + off), f1 = *(const f32x4*)(F + off + 4);
        f0.x += sigmoid_f(v0.x) * p0.x; f0.y += sigmoid_f(v0.y) * p0.y; f0.z += sigmoid_f(v0.z) * p0.z; f0.w += sigmoid_f(v0.w) * p0.w;
        f1.x += sigmoid_f(v1.x) * p1.x; f1.y += sigmoid_f(v1.y) * p1.y; f1.z += sigmoid_f(v1.z) * p1.z; f1.w += sigmoid_f(v1.w) * p1.w;
        *(f32x4*)(OUT + off) = f0; *(f32x4*)(OUT + off + 4) = f1;
        if (XB) *(u32x4*)(XB + off) = pack8(f0, f1);
    }
};

__device__ __forceinline__ void tr_item(const float* W, int K, int N, bf16_t* WT, int mode, float* scr, int kb, int nb, int lane) {
    const int k0 = 64 * kb, n0 = 32 * nb;
#pragma unroll 8
    for (int i = 0; i < 32; ++i) { const int kk = 2 * i + (lane >> 5); scr[kk * 33 + (lane & 31)] = W[(size_t)(k0 + kk) * N + n0 + (lane & 31)]; }
    LDS_FENCE();
    const int c = lane & 7;
#pragma unroll
    for (int j = 0; j < 4; ++j) {
        const int n = (lane >> 3) + 8 * j; const float* s = scr + (8 * c) * 33 + n;
        const int ng = n0 + n;
        float sc = 1.f; int nd = ng;
        if (mode == 1) { if (ng >= 512 && ng < 1024) sc = 0.08838834764831845f; }
        if (mode == 2) { nd = (ng < 512) ? 2 * ng : 2 * (ng - 512) + 1; }
        u32x4 o; o.x = pk2(s[0 * 33] * sc, s[1 * 33] * sc); o.y = pk2(s[2 * 33] * sc, s[3 * 33] * sc); o.z = pk2(s[4 * 33] * sc, s[5 * 33] * sc); o.w = pk2(s[6 * 33] * sc, s[7 * 33] * sc);
        *(u32x4*)(WT + (size_t)nd * K + k0 + 8 * c) = o;
    }
    LDS_FENCE();
}
struct TrDesc { const float* src; bf16_t* dst; int K, N, nbatch, mode; };
__device__ __forceinline__ int tr_items(const TrDesc& d) { return d.nbatch * (d.K / 64) * (d.N / 32); }
__device__ __forceinline__ void tr_run(const TrDesc& d, int it, float* scr, int lane) {
    const int per = (d.K / 64) * (d.N / 32), b = it / per, r = it % per, nblk = d.N / 32;
    tr_item(d.src + (size_t)b * d.K * d.N, d.K, d.N, d.dst + (size_t)b * d.K * d.N, d.mode, scr, r / nblk, r % nblk, lane);
}

__device__ __forceinline__ void phase_prep(const Params& P, unsigned char* lds) {
    unsigned char* ws = P.ws;
    const int tid = threadIdx.x, lane = tid & 63, wave = tid >> 6;
    const int gw = blockIdx.x * NWAVE + wave, NGW = gridDim.x * NWAVE;
    float* scr = (float*)lds + wave * (64 * 33);
    TrDesc d[7];
    d[0] = {P.in[22], (bf16_t*)(ws + WS_W_GU), 1024, 1024, 64, 2};
    d[1] = {P.in[23], (bf16_t*)(ws + WS_W_DN), 512, 1024, 64, 0};
    d[2] = {P.in[2], (bf16_t*)(ws + WS_W_IN0), 1024, 2560, 1, 1};
    d[3] = {P.in[6], (bf16_t*)(ws + WS_W_OUT0), 1024, 1024, 1, 0};
    d[4] = {P.in[13], (bf16_t*)(ws + WS_W_COUT), 1024, 1024, 1, 0};
    d[5] = {P.in[24], (bf16_t*)(ws + WS_W_G), 1024, 1024, 2, 0};
    d[6] = {P.in[25], (bf16_t*)(ws + WS_W_P), 256, 1024, 2, 0};
    int total = 0;
#pragma unroll
    for (int i = 0; i < 7; ++i) total += tr_items(d[i]);
    for (int it = gw; it < total; it += NGW) {
        int r = it;
#pragma unroll
        for (int i = 0; i < 7; ++i) { const int n = tr_items(d[i]); if (r >= 0 && r < n) { tr_run(d[i], r, scr, lane); r = -1; } else if (r >= 0) r -= n; }
    }
    const size_t gt = (size_t)blockIdx.x * NT + tid, GS = (size_t)gridDim.x * NT;
    {
        bf16_t* o = (bf16_t*)(ws + WS_W_POOL); const float* pw = P.in[4];
        for (size_t i = gt; i < 512 * 256; i += GS) { const int n = (int)(i >> 8), k = (int)(i & 255), g = n >> 7, dd = n & 127, kg = k >> 7, c = k & 127;
            o[i] = (bf16_t)((kg == (g & 1)) ? f2bf(pw[((size_t)g * 128 + c) * 128 + dd]) : 0u); }
    }
    {
        bf16_t* o = (bf16_t*)(ws + WS_W_CIN); const float* w = P.in[7];
        for (size_t i = gt; i < (size_t)Z1W * 1024; i += GS) { const int n = (int)(i >> 10), k = (int)(i & 1023);
            o[i] = (bf16_t)((n < CIN) ? f2bf(w[(size_t)k * CIN + n]) : 0u); }
    }
    {
        bf16_t* o = (bf16_t*)(ws + WS_W_QA); const float* uq = P.in[10]; const float* uk = P.in[11];
        for (size_t i = gt; i < (size_t)4096 * 256; i += GS) { const int n = (int)(i >> 8), r = (int)(i & 255), h = n >> 8, c = n & 255;
            const float* a = uq + (size_t)r * 1024 + h * 64; const float* b = uk + (size_t)c * 1024 + h * 64; float s = 0.f;
            for (int dd = 0; dd < 64; ++dd) s += a[dd] * b[dd];
            o[i] = (bf16_t)f2bf(s * 0.125f); }
    }
    {
        bf16_t* o = (bf16_t*)(ws + WS_W_UVBD); const float* uv = P.in[12];
        for (size_t i = gt; i < (size_t)1024 * 1024; i += GS) { const int n = (int)(i >> 10), k = (int)(i & 1023), h = n >> 6, dd = n & 63, hq = k >> 8, c = k & 255;
            o[i] = (bf16_t)(((h & 3) == hq) ? f2bf(uv[(size_t)c * 1024 + h * 64 + dd]) : 0u); }
    }
    {
        const f32x4* x = (const f32x4*)P.in[0]; u32x4* xb = (u32x4*)(ws + WS_XB);
        for (size_t i = gt; i < (size_t)NTOK * DM / 8; i += GS) xb[i] = pack8(x[2 * i], x[2 * i + 1]);
        const f32x4* p = (const f32x4*)P.in[1]; u32x4* pb = (u32x4*)(ws + WS_PB);
        for (size_t i = gt; i < (size_t)2 * NTOK * 256 / 8; i += GS) pb[i] = pack8(p[2 * i], p[2 * i + 1]);
    }
}

__device__ __forceinline__ float ret_logg(int h) { return log1pf(-exp2f(-5.0f - (float)h)); }

__device__ __forceinline__ void phase_ret_kv(const Params& P, unsigned char* lds) {
    const bf16_t* Z0 = (const bf16_t*)(P.ws + WS_Z0); float* KV = (float*)(P.ws + WS_KV);
    float* Ks = (float*)lds; float* Vs = Ks + 128 * 128;
    const int tid = threadIdx.x;
    for (int u = blockIdx.x; u < 1024; u += gridDim.x) {
        const int n = u & 63, h = (u >> 6) & 3, b = u >> 8;
        const float lg = ret_logg(h);
        const size_t row0 = (size_t)b * SEQ + n * 128;
        for (int i = tid; i < 128 * 16; i += NT) {
            const int r = i >> 4, c8 = (i & 15) * 8;
            const u32x4 kv = *(const u32x4*)(Z0 + (row0 + r) * ZW + 512 + h * 128 + c8);
            const u32x4 vv = *(const u32x4*)(Z0 + (row0 + r) * ZW + 1024 + h * 128 + c8);
            const float dec = __expf(lg * (float)(127 - r));
            float* kp = Ks + r * 128 + c8; float* vp = Vs + r * 128 + c8;
            kp[0] = bflo(kv.x) * dec; kp[1] = bfhi(kv.x) * dec; kp[2] = bflo(kv.y) * dec; kp[3] = bfhi(kv.y) * dec;
            kp[4] = bflo(kv.z) * dec; kp[5] = bfhi(kv.z) * dec; kp[6] = bflo(kv.w) * dec; kp[7] = bfhi(kv.w) * dec;
            vp[0] = bflo(vv.x); vp[1] = bfhi(vv.x); vp[2] = bflo(vv.y); vp[3] = bfhi(vv.y);
            vp[4] = bflo(vv.z); vp[5] = bfhi(vv.z); vp[6] = bflo(vv.w); vp[7] = bfhi(vv.w);
        }
        __syncthreads();
        const int dd = tid >> 2, v0 = (tid & 3) * 32;
        float acc[32];
#pragma unroll
        for (int j = 0; j < 32; ++j) acc[j] = 0.f;
        for (int i = 0; i < 128; ++i) {
            const float kd = Ks[i * 128 + dd];
#pragma unroll
            for (int j = 0; j < 32; j += 4) { const f32x4 vv = *(const f32x4*)(Vs + i * 128 + v0 + j); acc[j] += kd * vv.x; acc[j + 1] += kd * vv.y; acc[j + 2] += kd * vv.z; acc[j + 3] += kd * vv.w; }
        }
        float* o = KV + (size_t)u * 16384 + dd * 128 + v0;
#pragma unroll
        for (int j = 0; j < 32; j += 4) *(f32x4*)(o + j) = (f32x4){acc[j], acc[j + 1], acc[j + 2], acc[j + 3]};
        __syncthreads();
    }
}
__device__ __forceinline__ void phase_ret_scan_pool(const Params& P) {
    float* KV = (float*)(P.ws + WS_KV);
    const size_t gt = (size_t)blockIdx.x * NT + threadIdx.x, GS = (size_t)gridDim.x * NT;
    for (size_t i = gt; i < (size_t)16 * 4096; i += GS) {
        const int s = (int)(i >> 12), e4 = (int)(i & 4095), h = s & 3;
        const float cd = __expf(ret_logg(h) * 128.0f);
        f32x4* p = (f32x4*)(KV + (size_t)s * 64 * 16384) + e4;
        f32x4 R = {0.f, 0.f, 0.f, 0.f};
        for (int n0 = 0; n0 < 64; n0 += 8) {
            f32x4 kv[8];
#pragma unroll
            for (int j = 0; j < 8; ++j) kv[j] = p[(size_t)(n0 + j) * 4096];
#pragma unroll
            for (int j = 0; j < 8; ++j) { p[(size_t)(n0 + j) * 4096] = R; R = R * cd + kv[j]; }
        }
    }
    const bf16_t* Z0 = (const bf16_t*)(P.ws + WS_Z0); bf16_t* DP = (bf16_t*)(P.ws + WS_DP);
    for (size_t i = gt; i < (size_t)NTOK * 64; i += GS) {
        const int t = (int)(i >> 6), c8 = (int)(i & 63) * 8, g = c8 >> 7, w = 2 << g, tl = t & (SEQ - 1);
        const int cnt = min(tl + 1, w);
        float s[8];
#pragma unroll
        for (int j = 0; j < 8; ++j) s[j] = 0.f;
        float u0[8];
        for (int q = 0; q < cnt; ++q) {
            const u32x4 v = *(const u32x4*)(Z0 + (size_t)(t - q) * ZW + 2048 + c8);
            const float f[8] = {bflo(v.x), bfhi(v.x), bflo(v.y), bfhi(v.y), bflo(v.z), bfhi(v.z), bflo(v.w), bfhi(v.w)};
#pragma unroll
            for (int j = 0; j < 8; ++j) { s[j] += f[j]; if (q == 0) u0[j] = f[j]; }
        }
        const float inv = 1.0f / (float)cnt;
        u32x4 o; o.x = pk2(s[0] * inv - u0[0], s[1] * inv - u0[1]); o.y = pk2(s[2] * inv - u0[2], s[3] * inv - u0[3]);
        o.z = pk2(s[4] * inv - u0[4], s[5] * inv - u0[5]); o.w = pk2(s[6] * inv - u0[6], s[7] * inv - u0[7]);
        *(u32x4*)(DP + (size_t)t * 512 + c8) = o;
    }
}
__device__ __forceinline__ void phase_ret_out(const Params& P, unsigned char* lds) {
    const bf16_t* Z0 = (const bf16_t*)(P.ws + WS_Z0); const float* KV = (const float*)(P.ws + WS_KV); bf16_t* MIX = (bf16_t*)(P.ws + WS_MIX);
    const float* gn = P.in[3];
    bf16_t* Qs = (bf16_t*)lds;
    bf16_t* Ksm = Qs + 128 * 136;
    float* Sc = (float*)(lds + 2 * 128 * 136 * 2);
    const int tid = threadIdx.x;
    for (int u = blockIdx.x; u < 1024; u += gridDim.x) {
        const int n = u & 63, h = (u >> 6) & 3, b = u >> 8;
        const float lg = ret_logg(h);
        const size_t row0 = (size_t)b * SEQ + n * 128;
        for (int i = tid; i < 128 * 16; i += NT) {
            const int r = i >> 4, c8 = (i & 15) * 8;
            *(u32x4*)(Qs + r * 136 + c8) = *(const u32x4*)(Z0 + (row0 + r) * ZW + h * 128 + c8);
            *(u32x4*)(Ksm + r * 136 + c8) = *(const u32x4*)(Z0 + (row0 + r) * ZW + 512 + h * 128 + c8);
        }
        __syncthreads();
        for (int e = tid; e < 128 * 128; e += NT) {
            const int i = e >> 7, j = e & 127;
            float s = 0.f;
            if (j <= i) {
                const bf16_t* q = Qs + i * 136; const bf16_t* k = Ksm + j * 136;
                for (int dd = 0; dd < 128; dd += 2) { const unsigned qa = *(const unsigned*)(q + dd), ka = *(const unsigned*)(k + dd); s += bflo(qa) * bflo(ka) + bfhi(qa) * bfhi(ka); }
                s *= __expf(lg * (float)(i - j));
            }
            Sc[e] = s;
        }
        __syncthreads();
        const int i = tid >> 2, v0 = (tid & 3) * 32;
        float acc[32];
#pragma unroll
        for (int j = 0; j < 32; ++j) acc[j] = 0.f;
        for (int j = 0; j <= i; ++j) {
            const float s = Sc[i * 128 + j];
            const bf16_t* vr = Z0 + (row0 + j) * ZW + 1024 + h * 128 + v0;
#pragma unroll
            for (int q = 0; q < 4; ++q) { const u32x4 vv = *(const u32x4*)(vr + q * 8);
                acc[q * 8 + 0] += s * bflo(vv.x); acc[q * 8 + 1] += s * bfhi(vv.x); acc[q * 8 + 2] += s * bflo(vv.y); acc[q * 8 + 3] += s * bfhi(vv.y);
                acc[q * 8 + 4] += s * bflo(vv.z); acc[q * 8 + 5] += s * bfhi(vv.z); acc[q * 8 + 6] += s * bflo(vv.w); acc[q * 8 + 7] += s * bfhi(vv.w); }
        }
        const float qdec = __expf(lg * (float)(i + 1));
        const float* S = KV + (size_t)u * 16384;
        for (int dd = 0; dd < 128; ++dd) {
            const float qd = bf2f(Qs[i * 136 + dd]) * qdec;
            const float* sr = S + dd * 128 + v0;
#pragma unroll
            for (int q = 0; q < 32; q += 4) { const f32x4 sv = *(const f32x4*)(sr + q); acc[q] += qd * sv.x; acc[q + 1] += qd * sv.y; acc[q + 2] += qd * sv.z; acc[q + 3] += qd * sv.w; }
        }
        float sm = 0.f;
#pragma unroll
        for (int j = 0; j < 32; ++j) sm += acc[j];
        sm += __shfl_xor(sm, 1); sm += __shfl_xor(sm, 2);
        const float mu = sm * (1.0f / 128.0f);
        float sq = 0.f;
#pragma unroll
        for (int j = 0; j < 32; ++j) { const float dlt = acc[j] - mu; sq += dlt * dlt; }
        sq += __shfl_xor(sq, 1); sq += __shfl_xor(sq, 2);
        const float rstd = 1.0f / sqrtf(sq * (1.0f / 128.0f) + LN_EPS);
        const bf16_t* gr = Z0 + (row0 + i) * ZW + 1536 + h * 128 + v0;
        bf16_t* orow = MIX + (row0 + i) * DM + h * 128 + v0;
#pragma unroll
        for (int q = 0; q < 4; ++q) {
            const u32x4 gv = *(const u32x4*)(gr + q * 8);
            const float g8[8] = {bflo(gv.x), bfhi(gv.x), bflo(gv.y), bfhi(gv.y), bflo(gv.z), bfhi(gv.z), bflo(gv.w), bfhi(gv.w)};
            float o8[8];
#pragma unroll
            for (int j = 0; j < 8; ++j) o8[j] = (acc[q * 8 + j] - mu) * rstd * gn[h * 128 + v0 + q * 8 + j] * silu_f(g8[j]);
            u32x4 w; w.x = pk2(o8[0], o8[1]); w.y = pk2(o8[2], o8[3]); w.z = pk2(o8[4], o8[5]); w.w = pk2(o8[6], o8[7]);
            *(u32x4*)(orow + q * 8) = w;
        }
        __syncthreads();
    }
}

__device__ __forceinline__ void phase_ln_route(const Params& P, unsigned char* lds, int layer) {
    float* F = (float*)(P.ws + WS_F); bf16_t* XB = (bf16_t*)(P.ws + WS_XB);
    float* TOKG = (float*)(P.ws + WS_TOKG); int* LIST = (int*)(P.ws + WS_LIST);
    int* CNT = (int*)(P.ws + WS_CTL) + layer * 64;
    const float* lg = P.in[14] + layer * DM; const float* lb = P.in[15] + layer * DM;
    const float* wg = P.in[18] + (size_t)layer * DM * 4; const float* bg = P.in[19] + layer * 4;
    const float* we = P.in[20] + (size_t)layer * DM * 32; const float* be = P.in[21] + layer * 32;
    int* dec = (int*)lds;
    int* rank = dec + 256;
    int* lcnt = rank + 256;
    int* lbase = lcnt + 32;
    const int tid = threadIdx.x, lane = tid & 63, wave = tid >> 6;
    for (int rb = blockIdx.x; rb < NTOK / 128; rb += gridDim.x) {
        if (tid < 32) lcnt[tid] = 0;
        __syncthreads();
        for (int ri = 0; ri < 16; ++ri) {
            const int rl = wave * 16 + ri, t = rb * 128 + rl;
            float* fr = F + (size_t)t * DM;
            f32x4 v[4]; float s = 0.f;
#pragma unroll
            for (int j = 0; j < 4; ++j) { v[j] = *(const f32x4*)(fr + 256 * j + 4 * lane); s += (v[j].x + v[j].y) + (v[j].z + v[j].w); }
            const float mean = wave_sum(s) * (1.0f / DM); float s2 = 0.f;
#pragma unroll
            for (int j = 0; j < 4; ++j) { v[j] = v[j] - mean; s2 += (v[j].x * v[j].x + v[j].y * v[j].y) + (v[j].z * v[j].z + v[j].w * v[j].w); }
            const float rstd = 1.0f / sqrtf(wave_sum(s2) * (1.0f / DM) + LN_EPS);
            float acc[36];
#pragma unroll
            for (int j = 0; j < 36; ++j) acc[j] = 0.f;
#pragma unroll
            for (int j = 0; j < 4; ++j) {
                const int c0 = 256 * j + 4 * lane;
                const f32x4 g4 = *(const f32x4*)(lg + c0), b4 = *(const f32x4*)(lb + c0);
                v[j] = v[j] * rstd * g4 + b4;
                *(f32x4*)(fr + c0) = v[j];
                u32x2 w; w.x = pk2(v[j].x, v[j].y); w.y = pk2(v[j].z, v[j].w);
                *(u32x2*)(XB + (size_t)t * DM + c0) = w;
#pragma unroll
                for (int q = 0; q < 4; ++q) {
                    const float xv = v[j][q]; const int c = c0 + q;
                    const f32x4 w4 = *(const f32x4*)(wg + (size_t)c * 4);
                    acc[0] += xv * w4.x; acc[1] += xv * w4.y; acc[2] += xv * w4.z; acc[3] += xv * w4.w;
#pragma unroll
                    for (int e4 = 0; e4 < 8; ++e4) { const f32x4 w8 = *(const f32x4*)(we + (size_t)c * 32 + e4 * 4);
                        acc[4 + e4 * 4] += xv * w8.x; acc[5 + e4 * 4] += xv * w8.y; acc[6 + e4 * 4] += xv * w8.z; acc[7 + e4 * 4] += xv * w8.w; }
                    asm volatile("" ::: "memory");
                }
            }
#pragma unroll
            for (int j = 0; j < 36; ++j) acc[j] = wave_sum(acc[j]);
            float gl[4];
#pragma unroll
            for (int j = 0; j < 4; ++j) gl[j] = acc[j] + bg[j];
            int grp = 0; float gm = gl[0];
#pragma unroll
            for (int j = 1; j < 4; ++j) if (gl[j] > gm) { gm = gl[j]; grp = j; }
            float gs = 0.f;
#pragma unroll
            for (int j = 0; j < 4; ++j) gs += __expf(gl[j] - gm);
            const float gw = 1.0f / gs;
            float el[8];
#pragma unroll
            for (int j = 0; j < 8; ++j) el[j] = 0.f;
#pragma unroll
            for (int g = 0; g < 4; ++g)
#pragma unroll
                for (int j = 0; j < 8; ++j) el[j] = (g == grp) ? (acc[4 + g * 8 + j] + be[g * 8 + j]) : el[j];
            int i0 = 0; float m0 = el[0];
#pragma unroll
            for (int j = 1; j < 8; ++j) if (el[j] > m0) { m0 = el[j]; i0 = j; }
            int i1 = -1; float m1 = -INFINITY;
#pragma unroll
            for (int j = 0; j < 8; ++j) if (j != i0 && el[j] > m1) { m1 = el[j]; i1 = j; }
            const float ex = __expf(m1 - m0);
            const float p0 = 1.0f / (1.0f + ex), p1 = ex / (1.0f + ex);
            if (lane == 0) {
                dec[rl * 2] = grp * 8 + i0; dec[rl * 2 + 1] = grp * 8 + i1;
                TOKG[(size_t)t * 2] = gw * p0; TOKG[(size_t)t * 2 + 1] = gw * p1;
            }
        }
        __syncthreads();
        if (tid < 256) rank[tid] = atomicAdd(&lcnt[dec[tid]], 1);
        __syncthreads();
        if (tid < 32) lbase[tid] = atomicAdd(&CNT[tid], lcnt[tid]);
        __syncthreads();
        if (tid < 256) { const int e = dec[tid]; LIST[(size_t)e * LIST_CAP + lbase[e] + rank[tid]] = (rb * 128 + (tid >> 1)) * 2 + (tid & 1); }
        __syncthreads();
    }
}
__device__ __forceinline__ void moe_setup(const Params& P, int* tb, int layer) {
    const int* CNT = (const int*)(P.ws + WS_CTL) + layer * 64;
    if (threadIdx.x == 0) { int a = 0; for (int e = 0; e < 32; ++e) { tb[e] = a; a += (CNT[e] + 255) >> 8; } tb[32] = a; }
    __syncthreads();
}
__device__ __forceinline__ void phase_ln2(const Params& P, int layer) {
    float* F = (float*)(P.ws + WS_F); bf16_t* XB = (bf16_t*)(P.ws + WS_XB); const bf16_t* YS = (const bf16_t*)(P.ws + WS_YS); const float* TOKG = (const float*)(P.ws + WS_TOKG);
    const float* lg = P.in[16] + layer * DM; const float* lb = P.in[17] + layer * DM;
    const int lane = threadIdx.x & 63, gw = blockIdx.x * NWAVE + (threadIdx.x >> 6), NGW = gridDim.x * NWAVE;
    for (int t = gw; t < NTOK; t += NGW) {
        float* fr = F + (size_t)t * DM; const float g0 = TOKG[(size_t)t * 2], g1 = TOKG[(size_t)t * 2 + 1];
        const bf16_t* y0 = YS + (size_t)(2 * t) * DM; const bf16_t* y1 = y0 + DM;
        f32x4 v[4]; float s = 0.f;
#pragma unroll
        for (int j = 0; j < 4; ++j) { const int c0 = 256 * j + 4 * lane; v[j] = *(const f32x4*)(fr + c0);
            const u32x2 a = *(const u32x2*)(y0 + c0), b = *(const u32x2*)(y1 + c0);
            v[j].x = v[j].x * ALPHA + g0 * bflo(a.x) + g1 * bflo(b.x); v[j].y = v[j].y * ALPHA + g0 * bfhi(a.x) + g1 * bfhi(b.x);
            v[j].z = v[j].z * ALPHA + g0 * bflo(a.y) + g1 * bflo(b.y); v[j].w = v[j].w * ALPHA + g0 * bfhi(a.y) + g1 * bfhi(b.y);
            s += (v[j].x + v[j].y) + (v[j].z + v[j].w); }
        const float mean = wave_sum(s) * (1.0f / DM); float s2 = 0.f;
#pragma unroll
        for (int j = 0; j < 4; ++j) { v[j] = v[j] - mean; s2 += (v[j].x * v[j].x + v[j].y * v[j].y) + (v[j].z * v[j].z + v[j].w * v[j].w); }
        const float rstd = 1.0f / sqrtf(wave_sum(s2) * (1.0f / DM) + LN_EPS);
#pragma unroll
        for (int j = 0; j < 4; ++j) { const int c0 = 256 * j + 4 * lane;
            const f32x4 g4 = *(const f32x4*)(lg + c0), b4 = *(const f32x4*)(lb + c0);
            v[j] = v[j] * rstd * g4 + b4; *(f32x4*)(fr + c0) = v[j];
            u32x2 w; w.x = pk2(v[j].x, v[j].y); w.y = pk2(v[j].z, v[j].w); *(u32x2*)(XB + (size_t)t * DM + c0) = w; }
    }
}

__device__ __forceinline__ void phase_norms(const Params& P) {
    const bf16_t* Z1 = (const bf16_t*)(P.ws + WS_Z1); bf16_t* CQ = (bf16_t*)(P.ws + WS_CQ); bf16_t* CKV = (bf16_t*)(P.ws + WS_CKV);
    const float* qn = P.in[8]; const float* kn = P.in[9];
    const int lane = threadIdx.x & 63, gw = blockIdx.x * NWAVE + (threadIdx.x >> 6), NGW = gridDim.x * NWAVE;
    for (int t = gw; t < NTOK; t += NGW) {
        const u32x2 a = *(const u32x2*)(Z1 + (size_t)t * Z1W + 4 * lane), b = *(const u32x2*)(Z1 + (size_t)t * Z1W + 256 + 4 * lane);
        const float q[4] = {bflo(a.x), bfhi(a.x), bflo(a.y), bfhi(a.y)}, k[4] = {bflo(b.x), bfhi(b.x), bflo(b.y), bfhi(b.y)};
        const float sq = wave_sum(q[0] * q[0] + q[1] * q[1] + q[2] * q[2] + q[3] * q[3]), sk = wave_sum(k[0] * k[0] + k[1] * k[1] + k[2] * k[2] + k[3] * k[3]);
        const float rq = 1.0f / sqrtf(sq * (1.0f / 256.0f) + 1e-6f), rk = 1.0f / sqrtf(sk * (1.0f / 256.0f) + 1e-6f);
        const f32x4 gq = *(const f32x4*)(qn + 4 * lane), gk = *(const f32x4*)(kn + 4 * lane);
        u32x2 o; o.x = pk2(q[0] * rq * gq.x, q[1] * rq * gq.y); o.y = pk2(q[2] * rq * gq.z, q[3] * rq * gq.w);
        *(u32x2*)(CQ + (size_t)t * 256 + 4 * lane) = o;
        o.x = pk2(k[0] * rk * gk.x, k[1] * rk * gk.y); o.y = pk2(k[2] * rk * gk.z, k[3] * rk * gk.w);
        *(u32x2*)(CKV + (size_t)t * 256 + 4 * lane) = o;
    }
}
__device__ __forceinline__ unsigned fkey(float f) { const unsigned u = __float_as_uint(f); return (u & 0x80000000u) ? ~u : (u | 0x80000000u); }

__device__ __forceinline__ void phase_index(const Params& P, unsigned char* lds) {
    const bf16_t* Z1 = (const bf16_t*)(P.ws + WS_Z1); unsigned short* SEL = (unsigned short*)(P.ws + WS_SEL);
    float* sc = (float*)lds;
    float* qf = sc + 8192;
    float* wf = qf + 512;
    int* hist = (int*)(wf + 8);
    int* misc = hist + 256;
    int* seg = misc + 8;
    const int tid = threadIdx.x;
    for (int t = blockIdx.x; t < NTOK; t += gridDim.x) {
        const int b = t >> 13, tl = t & (SEQ - 1), n = tl + 1;
        unsigned short* so = SEL + (size_t)t * TOPK;
        if (n <= TOPK) { if (tid < n) so[tid] = (unsigned short)tid; continue; }
        qf[tid] = bf2f(Z1[(size_t)t * Z1W + 512 + tid]);
        if (tid < 8) wf[tid] = bf2f(Z1[(size_t)t * Z1W + 1088 + tid]);
        __syncthreads();
        for (int s = tid; s < n; s += NT) {
            const bf16_t* kr = Z1 + ((size_t)b * SEQ + s) * Z1W + 1024;
            float k[64];
#pragma unroll
            for (int q = 0; q < 8; ++q) { const u32x4 v = *(const u32x4*)(kr + q * 8);
                k[q * 8] = bflo(v.x); k[q * 8 + 1] = bfhi(v.x); k[q * 8 + 2] = bflo(v.y); k[q * 8 + 3] = bfhi(v.y);
                k[q * 8 + 4] = bflo(v.z); k[q * 8 + 5] = bfhi(v.z); k[q * 8 + 6] = bflo(v.w); k[q * 8 + 7] = bfhi(v.w); }
            float I = 0.f;
#pragma unroll
            for (int h = 0; h < 8; ++h) { float d = 0.f;
#pragma unroll
                for (int dd = 0; dd < 64; ++dd) d += qf[h * 64 + dd] * k[dd];
                I += wf[h] * fmaxf(d, 0.f); }
            sc[s] = I;
        }
        if (tid == 0) { misc[0] = 0; misc[1] = TOPK; misc[2] = 0; }
        __syncthreads();
        for (int pass = 0; pass < 4; ++pass) {
            const int shift = 24 - 8 * pass;
            if (tid < 256) hist[tid] = 0;
            __syncthreads();
            const unsigned prefix = (unsigned)misc[0]; const int kk = misc[1];
            for (int s = tid; s < n; s += NT) { const unsigned key = fkey(sc[s]);
                if (pass == 0 || (key >> (shift + 8)) == prefix) atomicAdd(&hist[(key >> shift) & 255], 1); }
            __syncthreads();
            if (tid == 0) { int a = 0, bsel = 0; for (int bin = 255; bin >= 0; --bin) { const int c = hist[bin]; if (a + c >= kk) { bsel = bin; break; } a += c; }
                misc[0] = (int)((prefix << 8) | (unsigned)bsel); misc[1] = kk - a; }
            __syncthreads();
        }
        const unsigned T = (unsigned)misc[0]; const int keq = misc[1];
        for (int s = tid; s < n; s += NT) if (fkey(sc[s]) > T) { const int o = atomicAdd(&misc[2], 1); so[o] = (unsigned short)s; }
        const int per = (n + NT - 1) / NT, s0 = tid * per, s1 = min(n, s0 + per);
        int ce = 0;
        for (int s = s0; s < s1; ++s) ce += (fkey(sc[s]) == T) ? 1 : 0;
        seg[tid] = ce;
        __syncthreads();
        if (tid == 0) { int a = 0; for (int i = 0; i < NT; ++i) { const int c = seg[i]; seg[i] = a; a += c; } }
        __syncthreads();
        const int ngt = TOPK - keq;
        int r = seg[tid];
        for (int s = s0; s < s1 && r < keq; ++s) if (fkey(sc[s]) == T) { so[ngt + r] = (unsigned short)s; ++r; }
        __syncthreads();
    }
}
__device__ __forceinline__ void phase_sparse_attn(const Params& P, unsigned char* lds) {
    bf16_t* QA = (bf16_t*)(P.ws + WS_QA); const bf16_t* CKV = (const bf16_t*)(P.ws + WS_CKV); const unsigned short* SEL = (const unsigned short*)(P.ws + WS_SEL);
    float* qa = (float*)lds;
    float* lgt = qa + 4096;
    int* sel = (int*)(lgt + 4096);
    const int tid = threadIdx.x, lane = tid & 63, wave = tid >> 6;
    for (int t = blockIdx.x; t < NTOK; t += gridDim.x) {
        const int b = t >> 13, tl = t & (SEQ - 1), ns = min(tl + 1, TOPK);
        { const u32x4 v = *(const u32x4*)(QA + (size_t)t * 4096 + tid * 8); float* q = qa + tid * 8;
          q[0] = bflo(v.x); q[1] = bfhi(v.x); q[2] = bflo(v.y); q[3] = bfhi(v.y); q[4] = bflo(v.z); q[5] = bfhi(v.z); q[6] = bflo(v.w); q[7] = bfhi(v.w); }
        if (tid < TOPK) sel[tid] = (tid < ns) ? (int)SEL[(size_t)t * TOPK + tid] : 0;
        __syncthreads();
        const int k = tid & 255, hg = tid >> 8;
        {
            float acc[8];
#pragma unroll
            for (int h = 0; h < 8; ++h) acc[h] = 0.f;
            if (k < ns) {
                const bf16_t* cr = CKV + ((size_t)b * SEQ + sel[k]) * 256;
                for (int c8 = 0; c8 < 256; c8 += 8) {
                    const u32x4 v = *(const u32x4*)(cr + c8);
                    const float cv[8] = {bflo(v.x), bfhi(v.x), bflo(v.y), bfhi(v.y), bflo(v.z), bfhi(v.z), bflo(v.w), bfhi(v.w)};
#pragma unroll
                    for (int h = 0; h < 8; ++h) { const float* q = qa + (hg * 8 + h) * 256 + c8;
#pragma unroll
                        for (int j = 0; j < 8; ++j) acc[h] += q[j] * cv[j]; }
                }
            }
#pragma unroll
            for (int h = 0; h < 8; ++h) { const int hh = hg * 8 + h; const float slope = exp2f(-0.5f * (float)(hh + 1));
                lgt[hh * 256 + k] = (k < ns) ? (acc[h] - slope * (float)(tl - sel[k])) : -INFINITY; }
        }
        __syncthreads();
        for (int hh = wave * 2; hh < wave * 2 + 2; ++hh) {
            float* row = lgt + hh * 256;
            float x[4]; float m = -INFINITY;
#pragma unroll
            for (int j = 0; j < 4; ++j) { x[j] = row[lane + 64 * j]; m = fmaxf(m, x[j]); }
            m = wave_max(m); float s = 0.f;
#pragma unroll
            for (int j = 0; j < 4; ++j) { x[j] = __expf(x[j] - m); s += x[j]; }
            s = wave_sum(s); const float inv = 1.0f / s;
#pragma unroll
            for (int j = 0; j < 4; ++j) row[lane + 64 * j] = x[j] * inv;
        }
        __syncthreads();
        {
            const int c = tid & 255;
            float acc[8];
#pragma unroll
            for (int h = 0; h < 8; ++h) acc[h] = 0.f;
            const bf16_t* cb = CKV + (size_t)b * SEQ * 256 + c;
            for (int kk = 0; kk < ns; ++kk) {
                const float cv = bf2f(cb[(size_t)sel[kk] * 256]);
#pragma unroll
                for (int h = 0; h < 8; ++h) acc[h] += lgt[(hg * 8 + h) * 256 + kk] * cv;
            }
#pragma unroll
            for (int h = 0; h < 8; ++h) QA[(size_t)t * 4096 + (hg * 8 + h) * 256 + c] = (bf16_t)f2bf(acc[h]);
        }
        __syncthreads();
    }
}

constexpr int NPH_TOTAL = 23;

#ifdef PH_ONLY
#define IN(k) ((k) == PH_ONLY)
#else
#define IN(k) (lo <= (k) && (k) < hi)
#endif
#define SEAM(k) do { if (IN(k) && IN((k) + 1)) grid.sync(); } while (0)

template <int LAYER, int BASE>
__device__ __forceinline__ void layer_tail(const Params& P, unsigned char* lds, cg::grid_group& grid, int lo, int hi) {
    unsigned char* ws = P.ws;
    int* tb = (int*)(lds + MISC_OFF);
    if (IN(BASE)) phase_ln_route(P, lds, LAYER);
    SEAM(BASE);
    if (IN(BASE + 1)) { moe_setup(P, tb, LAYER);
        MoeSched S{tb, (const int*)(ws + WS_CTL) + LAYER * 64, (const int*)(ws + WS_LIST), (const bf16_t*)(ws + WS_XB),
                   (const bf16_t*)(ws + WS_W_GU) + (size_t)LAYER * 32 * DM * DM, DM, (size_t)DM * DM, true};
        EpiGU E{(bf16_t*)(ws + WS_ACT)}; gemm_moe<true>(lds, S, E); }
    SEAM(BASE + 1);
    if (IN(BASE + 2)) { moe_setup(P, tb, LAYER);
        MoeSched S{tb, (const int*)(ws + WS_CTL) + LAYER * 64, (const int*)(ws + WS_LIST), (const bf16_t*)(ws + WS_ACT),
                   (const bf16_t*)(ws + WS_W_DN) + (size_t)LAYER * 32 * DM * 512, 512, (size_t)DM * 512, false};
        EpiDown E{(bf16_t*)(ws + WS_YS)}; gemm_moe<false>(lds, S, E); }
    SEAM(BASE + 2);
    if (IN(BASE + 3)) phase_ln2(P, LAYER);
    SEAM(BASE + 3);
    if (IN(BASE + 4)) {
        { DenseSched S{(const bf16_t*)(ws + WS_PB) + (size_t)LAYER * NTOK * 256, (const bf16_t*)(ws + WS_W_P) + (size_t)LAYER * DM * 256, NTOK, DM, 256, 256, 0};
          EpiStoreBf16 E{(bf16_t*)(ws + WS_PP), DM, 0, nullptr}; gemm_dense(lds, S, E); }
        __syncthreads();
        { DenseSched S{(const bf16_t*)(ws + WS_XB), (const bf16_t*)(ws + WS_W_G) + (size_t)LAYER * DM * DM, NTOK, DM, DM, DM, 0};
          EpiPle E{(const float*)(ws + WS_F), (const bf16_t*)(ws + WS_PP), LAYER == 1 ? P.out : (float*)(ws + WS_F), LAYER == 1 ? (bf16_t*)nullptr : (bf16_t*)(ws + WS_XB2)}; gemm_dense(lds, S, E); }
    }
}

__global__ void __launch_bounds__(NT, 2) mega(Params P, int lo, int hi) {
    extern __shared__ __attribute__((aligned(16))) unsigned char lds[];
    unsigned char* ws = P.ws;
    cg::grid_group grid = cg::this_grid();
    if (IN(0)) phase_prep(P, lds);
    SEAM(0);
    if (IN(1)) { DenseSched S{(const bf16_t*)(ws + WS_XB), (const bf16_t*)(ws + WS_W_IN0), NTOK, ZW, DM, DM, 0};
        EpiStoreBf16 E{(bf16_t*)(ws + WS_Z0), ZW, 0, nullptr}; gemm_dense(lds, S, E); }
    SEAM(1);
    if (IN(2)) phase_ret_kv(P, lds);
    SEAM(2);
    if (IN(3)) phase_ret_scan_pool(P);
    SEAM(3);
    if (IN(4)) { phase_ret_out(P, lds);
        DenseSched S{(const bf16_t*)(ws + WS_DP), (const bf16_t*)(ws + WS_W_POOL), NTOK, 512, 256, 512, 256};
        EpiStoreBf16 E{(bf16_t*)(ws + WS_MIX), DM, 512, P.in[5]}; gemm_dense(lds, S, E); }
    SEAM(4);
    if (IN(5)) { DenseSched S{(const bf16_t*)(ws + WS_MIX), (const bf16_t*)(ws + WS_W_OUT0), NTOK, DM, DM, DM, 0};
        EpiResid E{P.in[0], (float*)(ws + WS_F)}; gemm_dense(lds, S, E); }
    SEAM(5);
    layer_tail<0, 6>(P, lds, grid, lo, hi);
    SEAM(10);
    if (IN(11)) { DenseSched S{(const bf16_t*)(ws + WS_XB2), (const bf16_t*)(ws + WS_W_CIN), NTOK, Z1W, DM, DM, 0};
        EpiStoreBf16 E{(bf16_t*)(ws + WS_Z1), Z1W, 0, nullptr}; gemm_dense(lds, S, E); }
    SEAM(11);
    if (IN(12)) phase_norms(P);
    SEAM(12);
    if (IN(13)) { DenseSched S{(const bf16_t*)(ws + WS_CQ), (const bf16_t*)(ws + WS_W_QA), NTOK, 4096, 256, 256, 0};
        EpiStoreBf16 E{(bf16_t*)(ws + WS_QA), 4096, 0, nullptr}; gemm_dense(lds, S, E); }
    SEAM(13);
    if (IN(14)) phase_index(P, lds);
    SEAM(14);
    if (IN(15)) phase_sparse_attn(P, lds);
    SEAM(15);
    if (IN(16)) { DenseSched S{(const bf16_t*)(ws + WS_QA), (const bf16_t*)(ws + WS_W_UVBD), NTOK, DM, DM, 4096, 1024};
        EpiStoreBf16 E{(bf16_t*)(ws + WS_XB), DM, 0, nullptr}; gemm_dense(lds, S, E); }
    SEAM(16);
    if (IN(17)) { DenseSched S{(const bf16_t*)(ws + WS_XB), (const bf16_t*)(ws + WS_W_COUT), NTOK, DM, DM, DM, 0};
        EpiResid E{(const float*)(ws + WS_F), (float*)(ws + WS_F)}; gemm_dense(lds, S, E); }
    SEAM(17);
    layer_tail<1, 18>(P, lds, grid, lo, hi);
}
#undef IN
#undef SEAM

extern "C" void kernel_launch(void* const* d_in, const int* in_sizes, int n_in, void* d_out, int out_size, void* d_ws, size_t ws_size, hipStream_t stream) {
    static int grid = 0;
    if (grid == 0) {
        if (n_in != 26 || ws_size < WS_END || out_size != NTOK * DM) { fprintf(stderr, "kernel_launch: unexpected problem (n_in %d, ws %zu, out %d)\n", n_in, ws_size, out_size); grid = -1; return; }
        int dev = 0, cus = 0, per_cu = 0;
        (void)hipGetDevice(&dev);
        (void)hipDeviceGetAttribute(&cus, hipDeviceAttributeMultiprocessorCount, dev);
        (void)hipFuncSetAttribute((const void*)mega, hipFuncAttributeMaxDynamicSharedMemorySize, LDS_BYTES);
        (void)hipOccupancyMaxActiveBlocksPerMultiprocessor(&per_cu, (const void*)mega, NT, LDS_BYTES);
        if (per_cu < 1) { fprintf(stderr, "kernel_launch: occupancy query reports %d blocks per CU\n", per_cu); per_cu = 1; }
        (void)hipGetLastError();
        grid = cus;
    }
    if (grid < 0) return;
    (void)hipMemsetAsync((char*)d_ws + WS_CTL, 0, 4096, stream);
    Params p{};
    for (int i = 0; i < 26; ++i) p.in[i] = (const float*)d_in[i];
    p.out = (float*)d_out; p.ws = (unsigned char*)d_ws;
#if MK_ONE_LAUNCH
    int lo = 0, hi = NPH_TOTAL;
    void* args[] = {&p, &lo, &hi};
    hipError_t e = hipLaunchCooperativeKernel((const void*)mega, dim3(grid), dim3(NT), args, LDS_BYTES, stream);
    if (e != hipSuccess) fprintf(stderr, "cooperative launch failed: %s (grid %d)\n", hipGetErrorString(e), grid);
#else
    for (int k = 0; k < NPH_TOTAL; ++k) hipLaunchKernelGGL(mega, dim3(grid), dim3(NT), LDS_BYTES, stream, p, k, k + 1);
#endif
}
```

```cpp
#include <hip/hip_runtime.h>
#include <hip/hip_cooperative_groups.h>
#include <cstdio>
#include <cstdint>
namespace cg = cooperative_groups;

#ifndef MK_ONE_LAUNCH
#define MK_ONE_LAUNCH 1
#endif

typedef unsigned short bf16_t;
typedef float f32x4 __attribute__((ext_vector_type(4)));
typedef unsigned u32x4 __attribute__((ext_vector_type(4)));
typedef unsigned u32x2 __attribute__((ext_vector_type(2)));

constexpr int NT = 512;
constexpr int NWAVE = NT / 64;
constexpr int NTOK = 32768, DM = 1024, SEQ = 8192, NBATCH = 4;
constexpr int ZW = 2560;
constexpr int Z1W = 1280;
constexpr int CIN = 1096;
constexpr int TOPK = 256;
constexpr float ALPHA = 1.4142135623730951f;
constexpr float LN_EPS = 1e-5f;
constexpr int LDS_BYTES = 163840;
constexpr int BARW_OFF = LDS_BYTES - 64;
constexpr int MISC_OFF = 135168;

constexpr size_t MiB = (size_t)1 << 20;
constexpr size_t WS_CTL = 0;
constexpr size_t WS_W_IN0 = 1 * MiB, WS_W_OUT0 = 6 * MiB, WS_W_POOL = 8 * MiB, WS_W_CIN = 9 * MiB, WS_W_QA = 12 * MiB,
                 WS_W_UVBD = 14 * MiB, WS_W_COUT = 16 * MiB, WS_W_G = 18 * MiB, WS_W_P = 22 * MiB, WS_W_GU = 24 * MiB, WS_W_DN = 152 * MiB;
constexpr size_t WS_XB = 224 * MiB, WS_F = 288 * MiB, WS_PB = 416 * MiB, WS_PP = 448 * MiB, WS_CQ = 512 * MiB, WS_CKV = 528 * MiB,
                 WS_SEL = 544 * MiB, WS_TOKG = 560 * MiB, WS_LIST = 561 * MiB;
constexpr size_t WS_M0 = 576 * MiB;
constexpr size_t WS_Z0 = WS_M0, WS_KV = WS_M0 + 160 * MiB, WS_MIX = WS_M0 + 224 * MiB, WS_DP = WS_M0 + 288 * MiB;
constexpr size_t WS_QA = WS_M0, WS_SC = WS_M0, WS_Z1 = WS_M0 + 272 * MiB;
constexpr size_t WS_ACT = WS_M0, WS_YS = WS_M0 + 72 * MiB;
constexpr size_t WS_XB2 = 928 * MiB;
constexpr size_t WS_END = 992 * MiB;
constexpr int LIST_CAP = 32768;

struct Params {
    const float* in[26];
    float* out;
    unsigned char* ws;
};

__device__ __forceinline__ unsigned f2bf(float f) { unsigned u = __float_as_uint(f); return (u + 0x7fffu + ((u >> 16) & 1u)) >> 16; }
__device__ __forceinline__ float bf2f(unsigned h) { return __uint_as_float(h << 16); }
__device__ __forceinline__ unsigned pk2(float lo, float hi) { return f2bf(lo) | (f2bf(hi) << 16); }
__device__ __forceinline__ float bflo(unsigned w) { return __uint_as_float(w << 16); }
__device__ __forceinline__ float bfhi(unsigned w) { return __uint_as_float(w & 0xffff0000u); }
__device__ __forceinline__ float wave_sum(float v) {
#pragma unroll
    for (int o = 1; o < 64; o <<= 1) v += __shfl_xor(v, o);
    return v;
}
__device__ __forceinline__ float wave_max(float v) {
#pragma unroll
    for (int o = 1; o < 64; o <<= 1) v = fmaxf(v, __shfl_xor(v, o));
    return v;
}
__device__ __forceinline__ float silu_f(float a) { return a / (1.0f + __expf(-a)); }
__device__ __forceinline__ float sigmoid_f(float a) { return 1.0f / (1.0f + __expf(-a)); }
#define LDS_FENCE() asm volatile("s_waitcnt lgkmcnt(0)" ::: "memory")

struct UnitInfo {
    const bf16_t* A; int lda;
    const int* rows; int rshift;
    int nvalid;
    const bf16_t* Bt; int ldb;
    int K;
    int orow0;
    int pn;
};
__device__ __forceinline__ const bf16_t* unit_arow(const UnitInfo& u, int r) {
    if (u.rows) { const int idx = (r < u.nvalid) ? (u.rows[r] >> u.rshift) : 0; return u.A + (size_t)idx * u.lda; }
    return u.A + (size_t)r * u.lda;
}

struct DenseSched {
    const bf16_t* A; const bf16_t* Bt; int M, N, K, lda, a_pn_stride;
    __device__ __forceinline__ bool next(int round, UnitInfo& u) const {
        const int nN = N >> 8, nM = M >> 8, nwg = nN * nM;
        const long L = (long)round * gridDim.x + blockIdx.x; if (L >= nwg) return false;
        int wgid = (int)L; { const int q = nwg / 8, r = nwg % 8, xcd = wgid % 8, off = wgid / 8; wgid = (xcd < r ? xcd * (q + 1) : r * (q + 1) + (xcd - r) * q) + off; }
        const int nig = 8 * nN, gid = wgid / nig, fm = gid * 8, gsz = (nM - fm) < 8 ? (nM - fm) : 8;
        const int pm = fm + ((wgid % nig) % gsz), pn = (wgid % nig) / gsz;
        u.A = A + (size_t)pm * 256 * lda + (size_t)pn * a_pn_stride; u.lda = lda; u.rows = nullptr; u.rshift = 0; u.nvalid = 256;
        u.Bt = Bt + (size_t)pn * 256 * K; u.ldb = K; u.K = K; u.orow0 = pm * 256; u.pn = pn;
        return true;
    }
};
struct MoeSched {
    const int* tb; const int* cnt; const int* list;
    const bf16_t* A; const bf16_t* W; int K; size_t wstride; bool gather;
    __device__ __forceinline__ bool next(int round, UnitInfo& u) const {
        const int i = round * gridDim.x + blockIdx.x;
        const int j = i >> 2, pn = i & 3;
        if (j >= tb[32]) return false;
        int e = 0;
        while (tb[e + 1] <= j) ++e;
        const int rb = j - tb[e];
        const int nv = min(256, cnt[e] - rb * 256);
        u.rows = list + (size_t)e * LIST_CAP + rb * 256; u.nvalid = nv; u.orow0 = j * 256; u.pn = pn;
        if (gather) { u.A = A; u.lda = K; u.rshift = 1; }
        else { u.A = A + (size_t)j * 256 * K; u.lda = K; u.rshift = 31;   }
        u.Bt = W + (size_t)e * wstride + (size_t)pn * 256 * K; u.ldb = K; u.K = K;
        return true;
    }
};

template <class Sched, class Epi>
__device__ __forceinline__ void gemm_simple(unsigned char* lds, const Sched& S, const Epi& E, bool contiguousA) {
    float* As = (float*)lds;
    float* Bs = As + 128 * 33;
    const int tid = threadIdx.x, ty = tid >> 3, tx = tid & 7;
    const int lr = tid >> 2, kc = (tid & 3) * 8;
    UnitInfo u;
    for (int round = 0; S.next(round, u); ++round) {
        for (int sm = 0; sm < 2; ++sm) {
            const int ar = sm * 128 + lr;
            const bf16_t* arow = contiguousA ? (u.A + (size_t)ar * u.lda) : unit_arow(u, ar);
            for (int sn = 0; sn < 4; ++sn) {
                float acc[2][8];
#pragma unroll
                for (int a = 0; a < 2; ++a)
#pragma unroll
                    for (int b = 0; b < 8; ++b) acc[a][b] = 0.f;
                const bf16_t* brow = u.Bt + (size_t)(sn * 64 + (tid >> 2)) * u.ldb;
                for (int k0 = 0; k0 < u.K; k0 += 32) {
                    const u32x4 av = *(const u32x4*)(arow + k0 + kc);
                    float* ap = As + lr * 33 + kc;
                    ap[0] = bflo(av.x); ap[1] = bfhi(av.x); ap[2] = bflo(av.y); ap[3] = bfhi(av.y);
                    ap[4] = bflo(av.z); ap[5] = bfhi(av.z); ap[6] = bflo(av.w); ap[7] = bfhi(av.w);
                    if (tid < 256) {
                        const u32x4 bv = *(const u32x4*)(brow + k0 + kc);
                        float* bp = Bs + (tid >> 2) * 33 + kc;
                        bp[0] = bflo(bv.x); bp[1] = bfhi(bv.x); bp[2] = bflo(bv.y); bp[3] = bfhi(bv.y);
                        bp[4] = bflo(bv.z); bp[5] = bfhi(bv.z); bp[6] = bflo(bv.w); bp[7] = bfhi(bv.w);
                    }
                    __syncthreads();
#pragma unroll 8
                    for (int kk = 0; kk < 32; ++kk) {
                        const float a0 = As[(2 * ty) * 33 + kk], a1 = As[(2 * ty + 1) * 33 + kk];
#pragma unroll
                        for (int j = 0; j < 8; ++j) { const float b = Bs[(tx * 8 + j) * 33 + kk]; acc[0][j] += a0 * b; acc[1][j] += a1 * b; }
                    }
                    __syncthreads();
                }
#pragma unroll
                for (int rr = 0; rr < 2; ++rr) {
                    const f32x4 v0 = {acc[rr][0], acc[rr][1], acc[rr][2], acc[rr][3]}, v1 = {acc[rr][4], acc[rr][5], acc[rr][6], acc[rr][7]};
                    E(u, sm * 128 + 2 * ty + rr, sn * 64 + tx * 8, v0, v1);
                }
            }
        }
    }
}


namespace pg8 {
#define LAS __attribute__((address_space(3)))
typedef short bf16x8 __attribute__((ext_vector_type(8)));
constexpr int BK = 64, HALF = 128, HTB = HALF * BK * 2, STAGE_BYTES = 8 * HTB;
__device__ __forceinline__ int lds_byte(int r, int c) { const int st = (r >> 4) * 2 + (c >> 5), rr = r & 15, cc = c & 31, ob = rr * 64 + cc * 2; return st * 1024 + (ob ^ (((ob >> 9) & 1) << 5)); }
__device__ __forceinline__ void stage_rc(int b, int& R, int& C) { const int st = b / 1024, sb = b % 1024, swz = sb ^ (((sb >> 9) & 1) << 5); R = (st >> 1) * 16 + swz / 64; C = (st & 1) * 32 + (swz % 64) / 2; }
__device__ __forceinline__ int perm32(int rho) { const int n = rho >> 4, i = rho & 15; return 8 * (i >> 2) + 4 * n + (i & 3); }

template <bool GATHER, class Sched, class Epi>
__device__ __forceinline__ void gemm_phase(LAS unsigned char* lds, const LAS unsigned* rowtab, const Sched& S, const Epi& E, const int lda, const int ldb, const int K) {
    const int tid = threadIdx.x, wid = __builtin_amdgcn_readfirstlane(tid >> 6), lane = tid & 63, wr = wid >> 2, wc = wid & 3, fr = lane & 15, fq = lane >> 4;
    const int nt = K / BK;
    unsigned voffA[2], voffB[2]; int RA[2]; unsigned CA2[2];
#pragma unroll
    for (int i = 0; i < 2; ++i) { int R, C; stage_rc(tid * 16 + i * 8192, R, C); const int Rb = (R & ~31) + perm32(R & 31);
        voffA[i] = (unsigned)(R * lda + C) * 2u; voffB[i] = (unsigned)(Rb * ldb + C) * 2u; RA[i] = R; CA2[i] = (unsigned)C * 2u; }
    const size_t kstep = (size_t)(BK * 2);
    const size_t hstepA = (size_t)HALF * lda * 2, hstepB = (size_t)HALF * ldb * 2;
    const unsigned ldsw = (unsigned)wid * 1024u;
    const int aoff = lds_byte(wr * 64 + fr, fq * 8), boff = lds_byte(wc * 32 + fr, fq * 8);
    unsigned offA[2][2];
#define PG8_SA(b, h) (((b) * 2 + (h)) * HTB)
#define PG8_SB(b, h) ((4 + (b) * 2 + (h)) * HTB)
#define PG8_STAGE(bufoff, gbase, voff) do { _Pragma("unroll") for (int _i = 0; _i < 2; ++_i) \
        __builtin_amdgcn_global_load_lds((const unsigned*)((const char*)(gbase) + (voff)[_i]), (LAS unsigned*)(lds + (bufoff) + ldsw + _i * 8192), 16, 0, 0); } while (0)
#define PG8_STAGE_A(bufoff, h, gbase) do { if (GATHER) PG8_STAGE(bufoff, gbase, offA[h]); else PG8_STAGE(bufoff, (gbase) + (h) * hstepA, voffA); } while (0)
#define PG8_LOADOFF(round) do { _Pragma("unroll") for (int _h = 0; _h < 2; ++_h) _Pragma("unroll") for (int _i = 0; _i < 2; ++_i) offA[_h][_i] = rowtab[(round) * 256 + _h * 128 + RA[_i]] + CA2[_i]; } while (0)
#define PG8_LDA(dst, b, h) do { _Pragma("unroll") for (int m = 0; m < 4; ++m) _Pragma("unroll") for (int k = 0; k < 2; ++k) dst[m][k] = *(const LAS bf16x8*)(lds + PG8_SA(b, h) + aoff + m * 2048 + k * 1024); } while (0)
#define PG8_LDB(dst, b, h) do { _Pragma("unroll") for (int n = 0; n < 2; ++n) _Pragma("unroll") for (int k = 0; k < 2; ++k) dst[n][k] = *(const LAS bf16x8*)(lds + PG8_SB(b, h) + boff + n * 2048 + k * 1024); } while (0)
#define PG8_MMA(ai, bj, At, Bt) do { __builtin_amdgcn_s_setprio(1); _Pragma("unroll") for (int m = 0; m < 4; ++m) _Pragma("unroll") for (int n = 0; n < 2; ++n) _Pragma("unroll") for (int k = 0; k < 2; ++k) \
        acc[ai][bj][m][n] = __builtin_amdgcn_mfma_f32_16x16x32_bf16(Bt[n][k], At[m][k], acc[ai][bj][m][n], 0, 0, 0); __builtin_amdgcn_s_setprio(0); } while (0)
#define PG8_WAIT_V(n) asm volatile("s_waitcnt vmcnt(" #n ")" ::: "memory")
#define PG8_WAIT_L(n) asm volatile("s_waitcnt lgkmcnt(" #n ")" ::: "memory")
#define PG8_BAR __builtin_amdgcn_s_barrier()
#define PG8_SCHED __builtin_amdgcn_sched_barrier(0)
    UnitInfo cur, nxt; int ui = 0;
    if (!S.next(0, cur)) return;
    f32x4 acc[2][2][4][2];
#pragma unroll
    for (int a = 0; a < 2; ++a)
#pragma unroll
        for (int b = 0; b < 2; ++b)
#pragma unroll
            for (int m = 0; m < 4; ++m)
#pragma unroll
                for (int n = 0; n < 2; ++n) acc[a][b][m][n] = (f32x4){0.f, 0.f, 0.f, 0.f};
    bf16x8 At[4][2], B0[2][2], B1[2][2];
    const char* cA = (const char*)cur.A; const char* cB = (const char*)cur.Bt;
    if (GATHER) { PG8_LOADOFF(0); }
    PG8_STAGE(PG8_SB(0, 0), cB, voffB); PG8_STAGE(PG8_SB(0, 1), cB + hstepB, voffB); PG8_STAGE_A(PG8_SA(0, 0), 0, cA); PG8_STAGE_A(PG8_SA(0, 1), 1, cA);
    if (wr == 1) PG8_BAR;
    PG8_WAIT_V(2); PG8_BAR;
    PG8_STAGE(PG8_SB(1, 0), cB + kstep, voffB); PG8_STAGE_A(PG8_SA(1, 0), 0, cA + kstep); PG8_STAGE(PG8_SB(1, 1), cB + hstepB + kstep, voffB);
    PG8_WAIT_V(6); PG8_BAR;
    for (;;) {
        const bool has_next = S.next(ui + 1, nxt);
        const char* nA = has_next ? (const char*)nxt.A : cA; const char* nB = has_next ? (const char*)nxt.Bt : cB;
        for (int t = 0; t < nt; t += 2) {
            const bool last = (t == nt - 2);
            const char* a1 = cA + (size_t)(t + 1) * kstep;
            const char* a2 = last ? nA : cA + (size_t)(t + 2) * kstep; const char* b2 = last ? nB : cB + (size_t)(t + 2) * kstep;
            const char* a3 = a2 + kstep; const char* b3 = b2 + kstep;
            PG8_LDB(B0, 0, 0); PG8_LDB(B1, 0, 1); PG8_SCHED; PG8_LDA(At, 0, 0); PG8_STAGE_A(PG8_SA(1, 1), 1, a1);
            if (GATHER) { if (last && has_next) { PG8_LOADOFF(ui + 1); } }
            PG8_WAIT_V(8); PG8_WAIT_L(0); PG8_BAR; PG8_MMA(0, 0, At, B0); PG8_MMA(0, 1, At, B1); PG8_BAR; PG8_SCHED;
            PG8_LDA(At, 0, 1); PG8_STAGE(PG8_SB(0, 0), b2, voffB); PG8_STAGE(PG8_SB(0, 1), b2 + hstepB, voffB); PG8_STAGE_A(PG8_SA(0, 0), 0, a2);
            PG8_WAIT_V(8); PG8_WAIT_L(0); PG8_BAR; PG8_MMA(1, 0, At, B0); PG8_MMA(1, 1, At, B1); PG8_BAR; PG8_SCHED;
            PG8_LDB(B0, 1, 0); PG8_LDB(B1, 1, 1); PG8_SCHED; PG8_LDA(At, 1, 0); PG8_STAGE_A(PG8_SA(0, 1), 1, a2);
            PG8_WAIT_V(8); PG8_WAIT_L(0); PG8_BAR; PG8_MMA(0, 0, At, B0); PG8_MMA(0, 1, At, B1); PG8_BAR; PG8_SCHED;
            PG8_LDA(At, 1, 1); PG8_STAGE(PG8_SB(1, 0), b3, voffB); PG8_STAGE(PG8_SB(1, 1), b3 + hstepB, voffB); PG8_STAGE_A(PG8_SA(1, 0), 0, a3);
            PG8_WAIT_V(8); PG8_WAIT_L(0); PG8_BAR; PG8_MMA(1, 0, At, B0); PG8_MMA(1, 1, At, B1); PG8_BAR; PG8_SCHED;
        }
        if (wr == 0) PG8_BAR;
#pragma unroll
        for (int ai = 0; ai < 2; ++ai)
#pragma unroll
            for (int m = 0; m < 4; ++m)
#pragma unroll
                for (int bj = 0; bj < 2; ++bj) E(cur, ai * HALF + wr * 64 + m * 16 + fr, bj * HALF + wc * 32 + 8 * fq, acc[ai][bj][m][0], acc[ai][bj][m][1]);
        if (!has_next) break;
#pragma unroll
        for (int a = 0; a < 2; ++a)
#pragma unroll
            for (int b = 0; b < 2; ++b)
#pragma unroll
                for (int m = 0; m < 4; ++m)
#pragma unroll
                    for (int n = 0; n < 2; ++n) acc[a][b][m][n] = (f32x4){0.f, 0.f, 0.f, 0.f};
        cur = nxt; cA = nA; cB = nB; ++ui;
        if (wr == 1) PG8_BAR;
    }
    PG8_WAIT_V(0);
    PG8_BAR;
#undef PG8_SA
#undef PG8_SB
#undef PG8_STAGE
#undef PG8_STAGE_A
#undef PG8_LOADOFF
#undef PG8_LDA
#undef PG8_LDB
#undef PG8_MMA
#undef PG8_WAIT_V
#undef PG8_WAIT_L
#undef PG8_BAR
#undef PG8_SCHED
}
}

#ifndef USE_PG8_DENSE
#define USE_PG8_DENSE 1
#endif
#ifndef USE_PG8_MOE
#define USE_PG8_MOE 1
#endif
template <class Sched, class Epi>
__device__ __forceinline__ void gemm_dense(unsigned char* lds, const Sched& S, const Epi& E) {
#if USE_PG8_DENSE
    pg8::gemm_phase<false>((LAS unsigned char*)lds, (const LAS unsigned*)nullptr, S, E, S.lda, S.K, S.K);
    __syncthreads();
#else
    gemm_simple(lds, S, E, true);
#endif
}


template <bool GATHER, class Epi>
__device__ __forceinline__ void gemm_moe(unsigned char* lds, const MoeSched& S, const Epi& E) {
#if USE_PG8_MOE
    LAS unsigned* rowtab = (LAS unsigned*)(lds + MISC_OFF + 256);
    if (GATHER) {
        UnitInfo u;
        for (int round = 0; round < 10 && S.next(round, u); ++round)
            if (threadIdx.x < 256) rowtab[round * 256 + threadIdx.x] = ((int)threadIdx.x < u.nvalid) ? (unsigned)(u.rows[threadIdx.x] >> 1) * (unsigned)(S.K * 2) : 0u;
        __syncthreads();
    }
    pg8::gemm_phase<GATHER>((LAS unsigned char*)lds, (const LAS unsigned*)rowtab, S, E, S.K, S.K, S.K);
    __syncthreads();
#else
    gemm_simple(lds, S, E, !GATHER);
#endif
}

__device__ __forceinline__ u32x4 pack8(f32x4 a, f32x4 b) { u32x4 w; w.x = pk2(a.x, a.y); w.y = pk2(a.z, a.w); w.z = pk2(b.x, b.y); w.w = pk2(b.z, b.w); return w; }
struct EpiStoreBf16 {
    bf16_t* O; int ldc; int coff; const float* colscale;
    __device__ __forceinline__ void operator()(const UnitInfo& u, int r, int c, f32x4 v0, f32x4 v1) const {
        const int col = u.pn * 256 + c;
        if (colscale) { const f32x4 s0 = *(const f32x4*)(colscale + col), s1 = *(const f32x4*)(colscale + col + 4); v0 *= s0; v1 *= s1; }
        *(u32x4*)(O + (size_t)(u.orow0 + r) * ldc + coff + col) = pack8(v0, v1);
    }
};
struct EpiResid {
    const float* X; float* Fo;
    __device__ __forceinline__ void operator()(const UnitInfo& u, int r, int c, f32x4 v0, f32x4 v1) const {
        const size_t off = (size_t)(u.orow0 + r) * DM + u.pn * 256 + c;
        const f32x4 x0 = *(const f32x4*)(X + off), x1 = *(const f32x4*)(X + off + 4);
        *(f32x4*)(Fo + off) = x0 * ALPHA + v0; *(f32x4*)(Fo + off + 4) = x1 * ALPHA + v1;
    }
};
struct EpiGU {
    bf16_t* ACT;
    __device__ __forceinline__ void operator()(const UnitInfo& u, int r, int c, f32x4 v0, f32x4 v1) const {
        u32x2 w; w.x = pk2(silu_f(v0.x) * v0.y, silu_f(v0.z) * v0.w); w.y = pk2(silu_f(v1.x) * v1.y, silu_f(v1.z) * v1.w);
        *(u32x2*)(ACT + (size_t)(u.orow0 + r) * 512 + u.pn * 128 + (c >> 1)) = w;
    }
};
struct EpiDown {
    bf16_t* YS;
    __device__ __forceinline__ void operator()(const UnitInfo& u, int r, int c, f32x4 v0, f32x4 v1) const {
        if (r < u.nvalid) { const int pair = u.rows[r]; *(u32x4*)(YS + (size_t)pair * DM + u.pn * 256 + c) = pack8(v0, v1); }
    }
};
struct EpiPle {
    const float* F; const bf16_t* PP; float* OUT; bf16_t* XB;
    __device__ __forceinline__ void operator()(const UnitInfo& u, int r, int c, f32x4 v0, f32x4 v1) const {
        const size_t off = (size_t)(u.orow0 + r) * DM + u.pn * 256 + c;
        const u32x4 pw = *(const u32x4*)(PP + off);
        const f32x4 p0 = {bflo(pw.x), bfhi(pw.x), bflo(pw.y), bfhi(pw.y)}, p1 = {bflo(pw.z), bfhi(pw.z), bflo(pw.w), bfhi(pw.w)};
        f32x4 f0 = *(const f32x4*)(F + off), f1 = *(const f32x4*)(F + off + 4);
        f0.x += sigmoid_f(v0.x) * p0.x; f0.y += sigmoid_f(v0.y) * p0.y; f0.z += sigmoid_f(v0.z) * p0.z; f0.w += sigmoid_f(v0.w) * p0.w;
        f1.x += sigmoid_f(v1.x) * p1.x; f1.y += sigmoid_f(v1.y) * p1.y; f1.z += sigmoid_f(v1.z) * p1.z; f1.w += sigmoid_f(v1.w) * p1.w;
        *(f32x4*)(OUT + off) = f0; *(f32x4*)(OUT + off + 4) = f1;
        if (XB) *(u32x4*)(XB + off) = pack8(f0, f1);
    }
};

__device__ __forceinline__ void tr_item(const float* W, int K, int N, bf16_t* WT, int mode, float* scr, int kb, int nb, int lane) {
    const int k0 = 64 * kb, n0 = 32 * nb;
#pragma unroll 8
    for (int i = 0; i < 32; ++i) { const int kk = 2 * i + (lane >> 5); scr[kk * 33 + (lane & 31)] = W[(size_t)(k0 + kk) * N + n0 + (lane & 31)]; }
    LDS_FENCE();
    const int c = lane & 7;
#pragma unroll
    for (int j = 0; j < 4; ++j) {
        const int n = (lane >> 3) + 8 * j; const float* s = scr + (8 * c) * 33 + n;
        const int ng = n0 + n;
        float sc = 1.f; int nd = ng;
        if (mode == 1) { if (ng >= 512 && ng < 1024) sc = 0.08838834764831845f; }
        if (mode == 2) { nd = (ng < 512) ? 2 * ng : 2 * (ng - 512) + 1; }
        u32x4 o; o.x = pk2(s[0 * 33] * sc, s[1 * 33] * sc); o.y = pk2(s[2 * 33] * sc, s[3 * 33] * sc); o.z = pk2(s[4 * 33] * sc, s[5 * 33] * sc); o.w = pk2(s[6 * 33] * sc, s[7 * 33] * sc);
        *(u32x4*)(WT + (size_t)nd * K + k0 + 8 * c) = o;
    }
    LDS_FENCE();
}
struct TrDesc { const float* src; bf16_t* dst; int K, N, nbatch, mode; };
__device__ __forceinline__ int tr_items(const TrDesc& d) { return d.nbatch * (d.K / 64) * (d.N / 32); }
__device__ __forceinline__ void tr_run(const TrDesc& d, int it, float* scr, int lane) {
    const int per = (d.K / 64) * (d.N / 32), b = it / per, r = it % per, nblk = d.N / 32;
    tr_item(d.src + (size_t)b * d.K * d.N, d.K, d.N, d.dst + (size_t)b * d.K * d.N, d.mode, scr, r / nblk, r % nblk, lane);
}

__device__ __forceinline__ void phase_prep(const Params& P, unsigned char* lds) {
    unsigned char* ws = P.ws;
    const int tid = threadIdx.x, lane = tid & 63, wave = tid >> 6;
    const int gw = blockIdx.x * NWAVE + wave, NGW = gridDim.x * NWAVE;
    float* scr = (float*)lds + wave * (64 * 33);
    TrDesc d[7];
    d[0] = {P.in[22], (bf16_t*)(ws + WS_W_GU), 1024, 1024, 64, 2};
    d[1] = {P.in[23], (bf16_t*)(ws + WS_W_DN), 512, 1024, 64, 0};
    d[2] = {P.in[2], (bf16_t*)(ws + WS_W_IN0), 1024, 2560, 1, 1};
    d[3] = {P.in[6], (bf16_t*)(ws + WS_W_OUT0), 1024, 1024, 1, 0};
    d[4] = {P.in[13], (bf16_t*)(ws + WS_W_COUT), 1024, 1024, 1, 0};
    d[5] = {P.in[24], (bf16_t*)(ws + WS_W_G), 1024, 1024, 2, 0};
    d[6] = {P.in[25], (bf16_t*)(ws + WS_W_P), 256, 1024, 2, 0};
    int total = 0;
#pragma unroll
    for (int i = 0; i < 7; ++i) total += tr_items(d[i]);
    for (int it = gw; it < total; it += NGW) {
        int r = it;
#pragma unroll
        for (int i = 0; i < 7; ++i) { const int n = tr_items(d[i]); if (r >= 0 && r < n) { tr_run(d[i], r, scr, lane); r = -1; } else if (r >= 0) r -= n; }
    }
    const size_t gt = (size_t)blockIdx.x * NT + tid, GS = (size_t)gridDim.x * NT;
    {
        bf16_t* o = (bf16_t*)(ws + WS_W_POOL); const float* pw = P.in[4];
        for (size_t i = gt; i < 512 * 256; i += GS) { const int n = (int)(i >> 8), k = (int)(i & 255), g = n >> 7, dd = n & 127, kg = k >> 7, c = k & 127;
            o[i] = (bf16_t)((kg == (g & 1)) ? f2bf(pw[((size_t)g * 128 + c) * 128 + dd]) : 0u); }
    }
    {
        bf16_t* o = (bf16_t*)(ws + WS_W_CIN); const float* w = P.in[7];
        for (size_t i = gt; i < (size_t)Z1W * 1024; i += GS) { const int n = (int)(i >> 10), k = (int)(i & 1023);
            o[i] = (bf16_t)((n < CIN) ? f2bf(w[(size_t)k * CIN + n]) : 0u); }
    }
    {
        bf16_t* o = (bf16_t*)(ws + WS_W_QA); const float* uq = P.in[10]; const float* uk = P.in[11];
        for (size_t i = gt; i < (size_t)4096 * 256; i += GS) { const int n = (int)(i >> 8), r = (int)(i & 255), h = n >> 8, c = n & 255;
            const float* a = uq + (size_t)r * 1024 + h * 64; const float* b = uk + (size_t)c * 1024 + h * 64; float s = 0.f;
            for (int dd = 0; dd < 64; ++dd) s += a[dd] * b[dd];
            o[i] = (bf16_t)f2bf(s * 0.125f); }
    }
    {
        bf16_t* o = (bf16_t*)(ws + WS_W_UVBD); const float* uv = P.in[12];
        for (size_t i = gt; i < (size_t)1024 * 1024; i += GS) { const int n = (int)(i >> 10), k = (int)(i & 1023), h = n >> 6, dd = n & 63, hq = k >> 8, c = k & 255;
            o[i] = (bf16_t)(((h & 3) == hq) ? f2bf(uv[(size_t)c * 1024 + h * 64 + dd]) : 0u); }
    }
    {
        const f32x4* x = (const f32x4*)P.in[0]; u32x4* xb = (u32x4*)(ws + WS_XB);
        for (size_t i = gt; i < (size_t)NTOK * DM / 8; i += GS) xb[i] = pack8(x[2 * i], x[2 * i + 1]);
        const f32x4* p = (const f32x4*)P.in[1]; u32x4* pb = (u32x4*)(ws + WS_PB);
        for (size_t i = gt; i < (size_t)2 * NTOK * 256 / 8; i += GS) pb[i] = pack8(p[2 * i], p[2 * i + 1]);
    }
}

__device__ __forceinline__ float ret_logg(int h) { return log1pf(-exp2f(-5.0f - (float)h)); }

__device__ __forceinline__ void phase_ret_kv(const Params& P, unsigned char* lds) {
    const bf16_t* Z0 = (const bf16_t*)(P.ws + WS_Z0); float* KV = (float*)(P.ws + WS_KV);
    float* Ks = (float*)lds; float* Vs = Ks + 128 * 128;
    const int tid = threadIdx.x;
    for (int u = blockIdx.x; u < 1024; u += gridDim.x) {
        const int n = u & 63, h = (u >> 6) & 3, b = u >> 8;
        const float lg = ret_logg(h);
        const size_t row0 = (size_t)b * SEQ + n * 128;
        for (int i = tid; i < 128 * 16; i += NT) {
            const int r = i >> 4, c8 = (i & 15) * 8;
            const u32x4 kv = *(const u32x4*)(Z0 + (row0 + r) * ZW + 512 + h * 128 + c8);
            const u32x4 vv = *(const u32x4*)(Z0 + (row0 + r) * ZW + 1024 + h * 128 + c8);
            const float dec = __expf(lg * (float)(127 - r));
            float* kp = Ks + r * 128 + c8; float* vp = Vs + r * 128 + c8;
            kp[0] = bflo(kv.x) * dec; kp[1] = bfhi(kv.x) * dec; kp[2] = bflo(kv.y) * dec; kp[3] = bfhi(kv.y) * dec;
            kp[4] = bflo(kv.z) * dec; kp[5] = bfhi(kv.z) * dec; kp[6] = bflo(kv.w) * dec; kp[7] = bfhi(kv.w) * dec;
            vp[0] = bflo(vv.x); vp[1] = bfhi(vv.x); vp[2] = bflo(vv.y); vp[3] = bfhi(vv.y);
            vp[4] = bflo(vv.z); vp[5] = bfhi(vv.z); vp[6] = bflo(vv.w); vp[7] = bfhi(vv.w);
        }
        __syncthreads();
        const int dd = tid >> 2, v0 = (tid & 3) * 32;
        float acc[32];
#pragma unroll
        for (int j = 0; j < 32; ++j) acc[j] = 0.f;
        for (int i = 0; i < 128; ++i) {
            const float kd = Ks[i * 128 + dd];
#pragma unroll
            for (int j = 0; j < 32; j += 4) { const f32x4 vv = *(const f32x4*)(Vs + i * 128 + v0 + j); acc[j] += kd * vv.x; acc[j + 1] += kd * vv.y; acc[j + 2] += kd * vv.z; acc[j + 3] += kd * vv.w; }
        }
        float* o = KV + (size_t)u * 16384 + dd * 128 + v0;
#pragma unroll
        for (int j = 0; j < 32; j += 4) *(f32x4*)(o + j) = (f32x4){acc[j], acc[j + 1], acc[j + 2], acc[j + 3]};
        __syncthreads();
    }
}
__device__ __forceinline__ void phase_ret_scan_pool(const Params& P) {
    float* KV = (float*)(P.ws + WS_KV);
    const size_t gt = (size_t)blockIdx.x * NT + threadIdx.x, GS = (size_t)gridDim.x * NT;
    for (size_t i = gt; i < (size_t)16 * 4096; i += GS) {
        const int s = (int)(i >> 12), e4 = (int)(i & 4095), h = s & 3;
        const float cd = __expf(ret_logg(h) * 128.0f);
        f32x4* p = (f32x4*)(KV + (size_t)s * 64 * 16384) + e4;
        f32x4 R = {0.f, 0.f, 0.f, 0.f};
        for (int n0 = 0; n0 < 64; n0 += 8) {
            f32x4 kv[8];
#pragma unroll
            for (int j = 0; j < 8; ++j) kv[j] = p[(size_t)(n0 + j) * 4096];
#pragma unroll
            for (int j = 0; j < 8; ++j) { p[(size_t)(n0 + j) * 4096] = R; R = R * cd + kv[j]; }
        }
    }
    const bf16_t* Z0 = (const bf16_t*)(P.ws + WS_Z0); bf16_t* DP = (bf16_t*)(P.ws + WS_DP);
    for (size_t i = gt; i < (size_t)NTOK * 64; i += GS) {
        const int t = (int)(i >> 6), c8 = (int)(i & 63) * 8, g = c8 >> 7, w = 2 << g, tl = t & (SEQ - 1);
        const int cnt = min(tl + 1, w);
        float s[8];
#pragma unroll
        for (int j = 0; j < 8; ++j) s[j] = 0.f;
        float u0[8];
        for (int q = 0; q < cnt; ++q) {
            const u32x4 v = *(const u32x4*)(Z0 + (size_t)(t - q) * ZW + 2048 + c8);
            const float f[8] = {bflo(v.x), bfhi(v.x), bflo(v.y), bfhi(v.y), bflo(v.z), bfhi(v.z), bflo(v.w), bfhi(v.w)};
#pragma unroll
            for (int j = 0; j < 8; ++j) { s[j] += f[j]; if (q == 0) u0[j] = f[j]; }
        }
        const float inv = 1.0f / (float)cnt;
        u32x4 o; o.x = pk2(s[0] * inv - u0[0], s[1] * inv - u0[1]); o.y = pk2(s[2] * inv - u0[2], s[3] * inv - u0[3]);
        o.z = pk2(s[4] * inv - u0[4], s[5] * inv - u0[5]); o.w = pk2(s[6] * inv - u0[6], s[7] * inv - u0[7]);
        *(u32x4*)(DP + (size_t)t * 512 + c8) = o;
    }
}
__device__ __forceinline__ void phase_ret_out(const Params& P, unsigned char* lds) {
    const bf16_t* Z0 = (const bf16_t*)(P.ws + WS_Z0); const float* KV = (const float*)(P.ws + WS_KV); bf16_t* MIX = (bf16_t*)(P.ws + WS_MIX);
    const float* gn = P.in[3];
    bf16_t* Qs = (bf16_t*)lds;
    bf16_t* Ksm = Qs + 128 * 136;
    float* Sc = (float*)(lds + 2 * 128 * 136 * 2);
    const int tid = threadIdx.x;
    for (int u = blockIdx.x; u < 1024; u += gridDim.x) {
        const int n = u & 63, h = (u >> 6) & 3, b = u >> 8;
        const float lg = ret_logg(h);
        const size_t row0 = (size_t)b * SEQ + n * 128;
        for (int i = tid; i < 128 * 16; i += NT) {
            const int r = i >> 4, c8 = (i & 15) * 8;
            *(u32x4*)(Qs + r * 136 + c8) = *(const u32x4*)(Z0 + (row0 + r) * ZW + h * 128 + c8);
            *(u32x4*)(Ksm + r * 136 + c8) = *(const u32x4*)(Z0 + (row0 + r) * ZW + 512 + h * 128 + c8);
        }
        __syncthreads();
        for (int e = tid; e < 128 * 128; e += NT) {
            const int i = e >> 7, j = e & 127;
            float s = 0.f;
            if (j <= i) {
                const bf16_t* q = Qs + i * 136; const bf16_t* k = Ksm + j * 136;
                for (int dd = 0; dd < 128; dd += 2) { const unsigned qa = *(const unsigned*)(q + dd), ka = *(const unsigned*)(k + dd); s += bflo(qa) * bflo(ka) + bfhi(qa) * bfhi(ka); }
                s *= __expf(lg * (float)(i - j));
            }
            Sc[e] = s;
        }
        __syncthreads();
        const int i = tid >> 2, v0 = (tid & 3) * 32;
        float acc[32];
#pragma unroll
        for (int j = 0; j < 32; ++j) acc[j] = 0.f;
        for (int j = 0; j <= i; ++j) {
            const float s = Sc[i * 128 + j];
            const bf16_t* vr = Z0 + (row0 + j) * ZW + 1024 + h * 128 + v0;
#pragma unroll
            for (int q = 0; q < 4; ++q) { const u32x4 vv = *(const u32x4*)(vr + q * 8);
                acc[q * 8 + 0] += s * bflo(vv.x); acc[q * 8 + 1] += s * bfhi(vv.x); acc[q * 8 + 2] += s * bflo(vv.y); acc[q * 8 + 3] += s * bfhi(vv.y);
                acc[q * 8 + 4] += s * bflo(vv.z); acc[q * 8 + 5] += s * bfhi(vv.z); acc[q * 8 + 6] += s * bflo(vv.w); acc[q * 8 + 7] += s * bfhi(vv.w); }
        }
        const float qdec = __expf(lg * (float)(i + 1));
        const float* S = KV + (size_t)u * 16384;
        for (int dd = 0; dd < 128; ++dd) {
            const float qd = bf2f(Qs[i * 136 + dd]) * qdec;
            const float* sr = S + dd * 128 + v0;
#pragma unroll
            for (int q = 0; q < 32; q += 4) { const f32x4 sv = *(const f32x4*)(sr + q); acc[q] += qd * sv.x; acc[q + 1] += qd * sv.y; acc[q + 2] += qd * sv.z; acc[q + 3] += qd * sv.w; }
        }
        float sm = 0.f;
#pragma unroll
        for (int j = 0; j < 32; ++j) sm += acc[j];
        sm += __shfl_xor(sm, 1); sm += __shfl_xor(sm, 2);
        const float mu = sm * (1.0f / 128.0f);
        float sq = 0.f;
#pragma unroll
        for (int j = 0; j < 32; ++j) { const float dlt = acc[j] - mu; sq += dlt * dlt; }
        sq += __shfl_xor(sq, 1); sq += __shfl_xor(sq, 2);
        const float rstd = 1.0f / sqrtf(sq * (1.0f / 128.0f) + LN_EPS);
        const bf16_t* gr = Z0 + (row0 + i) * ZW + 1536 + h * 128 + v0;
        bf16_t* orow = MIX + (row0 + i) * DM + h * 128 + v0;
#pragma unroll
        for (int q = 0; q < 4; ++q) {
            const u32x4 gv = *(const u32x4*)(gr + q * 8);
            const float g8[8] = {bflo(gv.x), bfhi(gv.x), bflo(gv.y), bfhi(gv.y), bflo(gv.z), bfhi(gv.z), bflo(gv.w), bfhi(gv.w)};
            float o8[8];
#pragma unroll
            for (int j = 0; j < 8; ++j) o8[j] = (acc[q * 8 + j] - mu) * rstd * gn[h * 128 + v0 + q * 8 + j] * silu_f(g8[j]);
            u32x4 w; w.x = pk2(o8[0], o8[1]); w.y = pk2(o8[2], o8[3]); w.z = pk2(o8[4], o8[5]); w.w = pk2(o8[6], o8[7]);
            *(u32x4*)(orow + q * 8) = w;
        }
        __syncthreads();
    }
}

__device__ __forceinline__ void phase_ln_route(const Params& P, unsigned char* lds, int layer) {
    float* F = (float*)(P.ws + WS_F); bf16_t* XB = (bf16_t*)(P.ws + WS_XB);
    float* TOKG = (float*)(P.ws + WS_TOKG); int* LIST = (int*)(P.ws + WS_LIST);
    int* CNT = (int*)(P.ws + WS_CTL) + layer * 64;
    const float* lg = P.in[14] + layer * DM; const float* lb = P.in[15] + layer * DM;
    const float* wg = P.in[18] + (size_t)layer * DM * 4; const float* bg = P.in[19] + layer * 4;
    const float* we = P.in[20] + (size_t)layer * DM * 32; const float* be = P.in[21] + layer * 32;
    LAS f32x4* WL = (LAS f32x4*)lds;
    int* dec = (int*)(lds + 147456);
    int* rank = dec + 256;
    int* lcnt = rank + 256;
    int* lbase = lcnt + 32;
    for (int idx = threadIdx.x; idx < 16 * 9 * 64; idx += NT) {
        const int sl = idx / 576, rem = idx % 576, jg = rem >> 6, l = rem & 63, c = 256 * (sl >> 2) + 4 * l + (sl & 3);
        WL[idx] = (jg == 0) ? *(const f32x4*)(wg + (size_t)c * 4) : *(const f32x4*)(we + (size_t)c * 32 + (jg - 1) * 4);
    }
    __syncthreads();
    const int tid = threadIdx.x, lane = tid & 63, wave = tid >> 6;
    for (int rb = blockIdx.x; rb < NTOK / 128; rb += gridDim.x) {
        if (tid < 32) lcnt[tid] = 0;
        __syncthreads();
        for (int ri = 0; ri < 16; ++ri) {
            const int rl = wave * 16 + ri, t = rb * 128 + rl;
            float* fr = F + (size_t)t * DM;
            f32x4 v[4]; float s = 0.f;
#pragma unroll
            for (int j = 0; j < 4; ++j) { v[j] = *(const f32x4*)(fr + 256 * j + 4 * lane); s += (v[j].x + v[j].y) + (v[j].z + v[j].w); }
            const float mean = wave_sum(s) * (1.0f / DM); float s2 = 0.f;
#pragma unroll
            for (int j = 0; j < 4; ++j) { v[j] = v[j] - mean; s2 += (v[j].x * v[j].x + v[j].y * v[j].y) + (v[j].z * v[j].z + v[j].w * v[j].w); }
            const float rstd = 1.0f / sqrtf(wave_sum(s2) * (1.0f / DM) + LN_EPS);
            float acc[36];
#pragma unroll
            for (int j = 0; j < 36; ++j) acc[j] = 0.f;
#pragma unroll
            for (int j = 0; j < 4; ++j) {
                const int c0 = 256 * j + 4 * lane;
                const f32x4 g4 = *(const f32x4*)(lg + c0), b4 = *(const f32x4*)(lb + c0);
                v[j] = v[j] * rstd * g4 + b4;
                *(f32x4*)(fr + c0) = v[j];
                u32x2 w; w.x = pk2(v[j].x, v[j].y); w.y = pk2(v[j].z, v[j].w);
                *(u32x2*)(XB + (size_t)t * DM + c0) = w;
#pragma unroll
                for (int q = 0; q < 4; ++q) {
                    const float xv = v[j][q];
#pragma unroll
                    for (int jg = 0; jg < 9; ++jg) { const f32x4 w4 = WL[((j * 4 + q) * 9 + jg) * 64 + lane];
                        acc[jg * 4] += xv * w4.x; acc[jg * 4 + 1] += xv * w4.y; acc[jg * 4 + 2] += xv * w4.z; acc[jg * 4 + 3] += xv * w4.w; }
                }
            }
#pragma unroll
            for (int j = 0; j < 36; ++j) acc[j] = wave_sum(acc[j]);
            float gl[4];
#pragma unroll
            for (int j = 0; j < 4; ++j) gl[j] = acc[j] + bg[j];
            int grp = 0; float gm = gl[0];
#pragma unroll
            for (int j = 1; j < 4; ++j) if (gl[j] > gm) { gm = gl[j]; grp = j; }
            float gs = 0.f;
#pragma unroll
            for (int j = 0; j < 4; ++j) gs += __expf(gl[j] - gm);
            const float gw = 1.0f / gs;
            float el[8];
#pragma unroll
            for (int j = 0; j < 8; ++j) el[j] = 0.f;
#pragma unroll
            for (int g = 0; g < 4; ++g)
#pragma unroll
                for (int j = 0; j < 8; ++j) el[j] = (g == grp) ? (acc[4 + g * 8 + j] + be[g * 8 + j]) : el[j];
            int i0 = 0; float m0 = el[0];
#pragma unroll
            for (int j = 1; j < 8; ++j) if (el[j] > m0) { m0 = el[j]; i0 = j; }
            int i1 = -1; float m1 = -INFINITY;
#pragma unroll
            for (int j = 0; j < 8; ++j) if (j != i0 && el[j] > m1) { m1 = el[j]; i1 = j; }
            const float ex = __expf(m1 - m0);
            const float p0 = 1.0f / (1.0f + ex), p1 = ex / (1.0f + ex);
            if (lane == 0) {
                dec[rl * 2] = grp * 8 + i0; dec[rl * 2 + 1] = grp * 8 + i1;
                TOKG[(size_t)t * 2] = gw * p0; TOKG[(size_t)t * 2 + 1] = gw * p1;
            }
        }
        __syncthreads();
        if (tid < 256) rank[tid] = atomicAdd(&lcnt[dec[tid]], 1);
        __syncthreads();
        if (tid < 32) lbase[tid] = atomicAdd(&CNT[tid], lcnt[tid]);
        __syncthreads();
        if (tid < 256) { const int e = dec[tid]; LIST[(size_t)e * LIST_CAP + lbase[e] + rank[tid]] = (rb * 128 + (tid >> 1)) * 2 + (tid & 1); }
        __syncthreads();
    }
}
__device__ __forceinline__ void moe_setup(const Params& P, int* tb, int layer) {
    const int* CNT = (const int*)(P.ws + WS_CTL) + layer * 64;
    if (threadIdx.x == 0) { int a = 0; for (int e = 0; e < 32; ++e) { tb[e] = a; a += (CNT[e] + 255) >> 8; } tb[32] = a; }
    __syncthreads();
}
__device__ __forceinline__ void phase_ln2(const Params& P, int layer) {
    float* F = (float*)(P.ws + WS_F); bf16_t* XB = (bf16_t*)(P.ws + WS_XB); const bf16_t* YS = (const bf16_t*)(P.ws + WS_YS); const float* TOKG = (const float*)(P.ws + WS_TOKG);
    const float* lg = P.in[16] + layer * DM; const float* lb = P.in[17] + layer * DM;
    const int lane = threadIdx.x & 63, gw = blockIdx.x * NWAVE + (threadIdx.x >> 6), NGW = gridDim.x * NWAVE;
    for (int t = gw; t < NTOK; t += NGW) {
        float* fr = F + (size_t)t * DM; const float g0 = TOKG[(size_t)t * 2], g1 = TOKG[(size_t)t * 2 + 1];
        const bf16_t* y0 = YS + (size_t)(2 * t) * DM; const bf16_t* y1 = y0 + DM;
        f32x4 v[4]; float s = 0.f;
#pragma unroll
        for (int j = 0; j < 4; ++j) { const int c0 = 256 * j + 4 * lane; v[j] = *(const f32x4*)(fr + c0);
            const u32x2 a = *(const u32x2*)(y0 + c0), b = *(const u32x2*)(y1 + c0);
            v[j].x = v[j].x * ALPHA + g0 * bflo(a.x) + g1 * bflo(b.x); v[j].y = v[j].y * ALPHA + g0 * bfhi(a.x) + g1 * bfhi(b.x);
            v[j].z = v[j].z * ALPHA + g0 * bflo(a.y) + g1 * bflo(b.y); v[j].w = v[j].w * ALPHA + g0 * bfhi(a.y) + g1 * bfhi(b.y);
            s += (v[j].x + v[j].y) + (v[j].z + v[j].w); }
        const float mean = wave_sum(s) * (1.0f / DM); float s2 = 0.f;
#pragma unroll
        for (int j = 0; j < 4; ++j) { v[j] = v[j] - mean; s2 += (v[j].x * v[j].x + v[j].y * v[j].y) + (v[j].z * v[j].z + v[j].w * v[j].w); }
        const float rstd = 1.0f / sqrtf(wave_sum(s2) * (1.0f / DM) + LN_EPS);
#pragma unroll
        for (int j = 0; j < 4; ++j) { const int c0 = 256 * j + 4 * lane;
            const f32x4 g4 = *(const f32x4*)(lg + c0), b4 = *(const f32x4*)(lb + c0);
            v[j] = v[j] * rstd * g4 + b4; *(f32x4*)(fr + c0) = v[j];
            u32x2 w; w.x = pk2(v[j].x, v[j].y); w.y = pk2(v[j].z, v[j].w); *(u32x2*)(XB + (size_t)t * DM + c0) = w; }
    }
}

__device__ __forceinline__ void phase_norms(const Params& P) {
    const bf16_t* Z1 = (const bf16_t*)(P.ws + WS_Z1); bf16_t* CQ = (bf16_t*)(P.ws + WS_CQ); bf16_t* CKV = (bf16_t*)(P.ws + WS_CKV);
    const float* qn = P.in[8]; const float* kn = P.in[9];
    const int lane = threadIdx.x & 63, gw = blockIdx.x * NWAVE + (threadIdx.x >> 6), NGW = gridDim.x * NWAVE;
    for (int t = gw; t < NTOK; t += NGW) {
        const u32x2 a = *(const u32x2*)(Z1 + (size_t)t * Z1W + 4 * lane), b = *(const u32x2*)(Z1 + (size_t)t * Z1W + 256 + 4 * lane);
        const float q[4] = {bflo(a.x), bfhi(a.x), bflo(a.y), bfhi(a.y)}, k[4] = {bflo(b.x), bfhi(b.x), bflo(b.y), bfhi(b.y)};
        const float sq = wave_sum(q[0] * q[0] + q[1] * q[1] + q[2] * q[2] + q[3] * q[3]), sk = wave_sum(k[0] * k[0] + k[1] * k[1] + k[2] * k[2] + k[3] * k[3]);
        const float rq = 1.0f / sqrtf(sq * (1.0f / 256.0f) + 1e-6f), rk = 1.0f / sqrtf(sk * (1.0f / 256.0f) + 1e-6f);
        const f32x4 gq = *(const f32x4*)(qn + 4 * lane), gk = *(const f32x4*)(kn + 4 * lane);
        u32x2 o; o.x = pk2(q[0] * rq * gq.x, q[1] * rq * gq.y); o.y = pk2(q[2] * rq * gq.z, q[3] * rq * gq.w);
        *(u32x2*)(CQ + (size_t)t * 256 + 4 * lane) = o;
        o.x = pk2(k[0] * rk * gk.x, k[1] * rk * gk.y); o.y = pk2(k[2] * rk * gk.z, k[3] * rk * gk.w);
        *(u32x2*)(CKV + (size_t)t * 256 + 4 * lane) = o;
    }
}
__device__ __forceinline__ unsigned fkey(float f) { const unsigned u = __float_as_uint(f); return (u & 0x80000000u) ? ~u : (u | 0x80000000u); }

__device__ __forceinline__ void phase_index(const Params& P, unsigned char* lds) {
    const bf16_t* Z1 = (const bf16_t*)(P.ws + WS_Z1); unsigned short* SEL = (unsigned short*)(P.ws + WS_SEL);
    float* sc = (float*)lds;
    float* qf = sc + 8192;
    float* wf = qf + 512;
    int* hist = (int*)(wf + 8);
    int* misc = hist + 256;
    int* seg = misc + 8;
    const int tid = threadIdx.x;
    for (int t = blockIdx.x; t < NTOK; t += gridDim.x) {
        const int b = t >> 13, tl = t & (SEQ - 1), n = tl + 1;
        unsigned short* so = SEL + (size_t)t * TOPK;
        if (n <= TOPK) { if (tid < n) so[tid] = (unsigned short)tid; continue; }
        qf[tid] = bf2f(Z1[(size_t)t * Z1W + 512 + tid]);
        if (tid < 8) wf[tid] = bf2f(Z1[(size_t)t * Z1W + 1088 + tid]);
        __syncthreads();
        for (int s = tid; s < n; s += NT) {
            const bf16_t* kr = Z1 + ((size_t)b * SEQ + s) * Z1W + 1024;
            float k[64];
#pragma unroll
            for (int q = 0; q < 8; ++q) { const u32x4 v = *(const u32x4*)(kr + q * 8);
                k[q * 8] = bflo(v.x); k[q * 8 + 1] = bfhi(v.x); k[q * 8 + 2] = bflo(v.y); k[q * 8 + 3] = bfhi(v.y);
                k[q * 8 + 4] = bflo(v.z); k[q * 8 + 5] = bfhi(v.z); k[q * 8 + 6] = bflo(v.w); k[q * 8 + 7] = bfhi(v.w); }
            float I = 0.f;
#pragma unroll
            for (int h = 0; h < 8; ++h) { float d = 0.f;
#pragma unroll
                for (int dd = 0; dd < 64; ++dd) d += qf[h * 64 + dd] * k[dd];
                I += wf[h] * fmaxf(d, 0.f); }
            sc[s] = I;
        }
        if (tid == 0) { misc[0] = 0; misc[1] = TOPK; misc[2] = 0; }
        __syncthreads();
        for (int pass = 0; pass < 4; ++pass) {
            const int shift = 24 - 8 * pass;
            if (tid < 256) hist[tid] = 0;
            __syncthreads();
            const unsigned prefix = (unsigned)misc[0]; const int kk = misc[1];
            for (int s = tid; s < n; s += NT) { const unsigned key = fkey(sc[s]);
                if (pass == 0 || (key >> (shift + 8)) == prefix) atomicAdd(&hist[(key >> shift) & 255], 1); }
            __syncthreads();
            if (tid == 0) { int a = 0, bsel = 0; for (int bin = 255; bin >= 0; --bin) { const int c = hist[bin]; if (a + c >= kk) { bsel = bin; break; } a += c; }
                misc[0] = (int)((prefix << 8) | (unsigned)bsel); misc[1] = kk - a; }
            __syncthreads();
        }
        const unsigned T = (unsigned)misc[0]; const int keq = misc[1];
        for (int s = tid; s < n; s += NT) if (fkey(sc[s]) > T) { const int o = atomicAdd(&misc[2], 1); so[o] = (unsigned short)s; }
        const int per = (n + NT - 1) / NT, s0 = tid * per, s1 = min(n, s0 + per);
        int ce = 0;
        for (int s = s0; s < s1; ++s) ce += (fkey(sc[s]) == T) ? 1 : 0;
        seg[tid] = ce;
        __syncthreads();
        if (tid == 0) { int a = 0; for (int i = 0; i < NT; ++i) { const int c = seg[i]; seg[i] = a; a += c; } }
        __syncthreads();
        const int ngt = TOPK - keq;
        int r = seg[tid];
        for (int s = s0; s < s1 && r < keq; ++s) if (fkey(sc[s]) == T) { so[ngt + r] = (unsigned short)s; ++r; }
        __syncthreads();
    }
}
__device__ __forceinline__ void phase_sparse_attn(const Params& P, unsigned char* lds) {
    bf16_t* QA = (bf16_t*)(P.ws + WS_QA); const bf16_t* CKV = (const bf16_t*)(P.ws + WS_CKV); const unsigned short* SEL = (const unsigned short*)(P.ws + WS_SEL);
    float* qa = (float*)lds;
    float* lgt = qa + 4096;
    int* sel = (int*)(lgt + 4096);
    const int tid = threadIdx.x, lane = tid & 63, wave = tid >> 6;
    for (int t = blockIdx.x; t < NTOK; t += gridDim.x) {
        const int b = t >> 13, tl = t & (SEQ - 1), ns = min(tl + 1, TOPK);
        { const u32x4 v = *(const u32x4*)(QA + (size_t)t * 4096 + tid * 8); float* q = qa + tid * 8;
          q[0] = bflo(v.x); q[1] = bfhi(v.x); q[2] = bflo(v.y); q[3] = bfhi(v.y); q[4] = bflo(v.z); q[5] = bfhi(v.z); q[6] = bflo(v.w); q[7] = bfhi(v.w); }
        if (tid < TOPK) sel[tid] = (tid < ns) ? (int)SEL[(size_t)t * TOPK + tid] : 0;
        __syncthreads();
        const int k = tid & 255, hg = tid >> 8;
        {
            float acc[8];
#pragma unroll
            for (int h = 0; h < 8; ++h) acc[h] = 0.f;
            if (k < ns) {
                const bf16_t* cr = CKV + ((size_t)b * SEQ + sel[k]) * 256;
                for (int c8 = 0; c8 < 256; c8 += 8) {
                    const u32x4 v = *(const u32x4*)(cr + c8);
                    const float cv[8] = {bflo(v.x), bfhi(v.x), bflo(v.y), bfhi(v.y), bflo(v.z), bfhi(v.z), bflo(v.w), bfhi(v.w)};
#pragma unroll
                    for (int h = 0; h < 8; ++h) { const float* q = qa + (hg * 8 + h) * 256 + c8;
#pragma unroll
                        for (int j = 0; j < 8; ++j) acc[h] += q[j] * cv[j]; }
                }
            }
#pragma unroll
            for (int h = 0; h < 8; ++h) { const int hh = hg * 8 + h; const float slope = exp2f(-0.5f * (float)(hh + 1));
                lgt[hh * 256 + k] = (k < ns) ? (acc[h] - slope * (float)(tl - sel[k])) : -INFINITY; }
        }
        __syncthreads();
        for (int hh = wave * 2; hh < wave * 2 + 2; ++hh) {
            float* row = lgt + hh * 256;
            float x[4]; float m = -INFINITY;
#pragma unroll
            for (int j = 0; j < 4; ++j) { x[j] = row[lane + 64 * j]; m = fmaxf(m, x[j]); }
            m = wave_max(m); float s = 0.f;
#pragma unroll
            for (int j = 0; j < 4; ++j) { x[j] = __expf(x[j] - m); s += x[j]; }
            s = wave_sum(s); const float inv = 1.0f / s;
#pragma unroll
            for (int j = 0; j < 4; ++j) row[lane + 64 * j] = x[j] * inv;
        }
        __syncthreads();
        {
            const int c = tid & 255;
            float acc[8];
#pragma unroll
            for (int h = 0; h < 8; ++h) acc[h] = 0.f;
            const bf16_t* cb = CKV + (size_t)b * SEQ * 256 + c;
            for (int kk = 0; kk < ns; ++kk) {
                const float cv = bf2f(cb[(size_t)sel[kk] * 256]);
#pragma unroll
                for (int h = 0; h < 8; ++h) acc[h] += lgt[(hg * 8 + h) * 256 + kk] * cv;
            }
#pragma unroll
            for (int h = 0; h < 8; ++h) QA[(size_t)t * 4096 + (hg * 8 + h) * 256 + c] = (bf16_t)f2bf(acc[h]);
        }
        __syncthreads();
    }
}

constexpr int NPH_TOTAL = 23;


typedef short v4i16_t __attribute__((ext_vector_type(4)));
__device__ __forceinline__ void phase_sparse_attn_mfma(const Params& P, unsigned char* lds_) {
    using pg8::bf16x8;
    bf16_t* QA = (bf16_t*)(P.ws + WS_QA); const unsigned char* CKV = (const unsigned char*)(P.ws + WS_CKV); const unsigned short* SEL = (const unsigned short*)(P.ws + WS_SEL);
    const int tid = threadIdx.x, lane = tid & 63, wave = __builtin_amdgcn_readfirstlane(tid >> 6);
    const int fr = lane & 15, fq = lane >> 4;
    LAS unsigned char* cbuf = (LAS unsigned char*)lds_ + wave * 16896;
    LAS unsigned short* selw = (LAS unsigned short*)(cbuf + 16384);
    const int G = gridDim.x, NGW = G * NWAVE;
    int vw;
    if ((G & 7) == 0) vw = (((int)blockIdx.x & 7) * (G >> 3) + ((int)blockIdx.x >> 3)) * NWAVE + wave; else vw = (int)blockIdx.x * NWAVE + wave;
    const float LOG2E = 1.4426950408889634f;
    const float slope2 = exp2f(-0.5f * (float)(fr + 1)) * LOG2E;
    unsigned qoffB[4];
#pragma unroll
    for (int e = 0; e < 4; ++e) { const int key7 = (2 * e + (lane >> 5)) & 7; qoffB[e] = (unsigned)(((lane & 31) ^ (key7 << 1)) << 4); }
    const int rowA = fr;
    const unsigned swzA = (unsigned)((rowA & 7) << 1);
    const int rowT = 4 * fq + (fr >> 2);
    const unsigned swzT = (unsigned)((rowT & 7) << 1), pbT = (unsigned)((fr & 3) >> 1), halfT = (unsigned)(fr & 1) * 8u;
    const int per = NGW >> 2, bq = vw / per, wb = vw % per;
    for (int tl0 = wb; tl0 < SEQ; tl0 += per) {
        const int t = bq * SEQ + tl0;
        const int b = t >> 13, tl = t & (SEQ - 1), ns = min(tl + 1, TOPK), nch = (ns + 31) >> 5;
        {
            const u32x2 w = *(const u32x2*)(SEL + (size_t)t * TOPK + 4 * lane);
            unsigned short i0 = (unsigned short)(w.x & 0xffffu), i1 = (unsigned short)(w.x >> 16), i2 = (unsigned short)(w.y & 0xffffu), i3 = (unsigned short)(w.y >> 16);
            const int k0 = 4 * lane;
            if (k0 >= ns) i0 = 0; if (k0 + 1 >= ns) i1 = 0; if (k0 + 2 >= ns) i2 = 0; if (k0 + 3 >= ns) i3 = 0;
            u32x2 o; o.x = (unsigned)i0 | ((unsigned)i1 << 16); o.y = (unsigned)i2 | ((unsigned)i3 << 16);
            *(LAS u32x2*)(selw + 4 * lane) = o;
        }
        bf16x8 qf[8];
#pragma unroll
        for (int cc = 0; cc < 8; ++cc) qf[cc] = *(const bf16x8*)(QA + (size_t)t * 4096 + fr * 256 + 32 * cc + 8 * fq);
        f32x4 O[16];
#pragma unroll
        for (int ct = 0; ct < 16; ++ct) O[ct] = (f32x4){0.f, 0.f, 0.f, 0.f};
        float m = -INFINITY, l = 0.f;
        const unsigned char* cb = CKV + (size_t)b * SEQ * 512;
        for (int j = 0; j < nch; ++j) {
            asm volatile("s_waitcnt lgkmcnt(0)" ::: "memory");
#pragma unroll
            for (int e = 0; e < 16; ++e) {
                const unsigned idx = selw[32 * j + 2 * e + (lane >> 5)];
                __builtin_amdgcn_global_load_lds((const unsigned*)(cb + (size_t)idx * 512 + qoffB[e & 3]), (LAS unsigned*)(cbuf + e * 1024), 16, 0, 0);
            }
            asm volatile("s_waitcnt vmcnt(0)" ::: "memory");
            f32x4 s0 = {0.f, 0.f, 0.f, 0.f}, s1 = {0.f, 0.f, 0.f, 0.f};
#pragma unroll
            for (int cc = 0; cc < 8; ++cc) {
                const unsigned ch = (((unsigned)(4 * cc + fq)) ^ swzA) << 4;
                const bf16x8 a0 = *(const LAS bf16x8*)(cbuf + rowA * 512 + ch);
                const bf16x8 a1 = *(const LAS bf16x8*)(cbuf + (16 + rowA) * 512 + ch);
                s0 = __builtin_amdgcn_mfma_f32_16x16x32_bf16(a0, qf[cc], s0, 0, 0, 0);
                s1 = __builtin_amdgcn_mfma_f32_16x16x32_bf16(a1, qf[cc], s1, 0, 0, 0);
            }
            const u32x2 k0w = *(const LAS u32x2*)(selw + 32 * j + 4 * fq), k1w = *(const LAS u32x2*)(selw + 32 * j + 16 + 4 * fq);
            const int kb0 = 32 * j + 4 * fq, kb1 = kb0 + 16;
            float lg[8];
            {
                const int i00 = (int)(k0w.x & 0xffffu), i01 = (int)(k0w.x >> 16), i02 = (int)(k0w.y & 0xffffu), i03 = (int)(k0w.y >> 16);
                const int i10 = (int)(k1w.x & 0xffffu), i11 = (int)(k1w.x >> 16), i12 = (int)(k1w.y & 0xffffu), i13 = (int)(k1w.y >> 16);
                lg[0] = (kb0 + 0 < ns) ? s0.x * LOG2E - slope2 * (float)(tl - i00) : -INFINITY;
                lg[1] = (kb0 + 1 < ns) ? s0.y * LOG2E - slope2 * (float)(tl - i01) : -INFINITY;
                lg[2] = (kb0 + 2 < ns) ? s0.z * LOG2E - slope2 * (float)(tl - i02) : -INFINITY;
                lg[3] = (kb0 + 3 < ns) ? s0.w * LOG2E - slope2 * (float)(tl - i03) : -INFINITY;
                lg[4] = (kb1 + 0 < ns) ? s1.x * LOG2E - slope2 * (float)(tl - i10) : -INFINITY;
                lg[5] = (kb1 + 1 < ns) ? s1.y * LOG2E - slope2 * (float)(tl - i11) : -INFINITY;
                lg[6] = (kb1 + 2 < ns) ? s1.z * LOG2E - slope2 * (float)(tl - i12) : -INFINITY;
                lg[7] = (kb1 + 3 < ns) ? s1.w * LOG2E - slope2 * (float)(tl - i13) : -INFINITY;
            }
            float cm = fmaxf(fmaxf(fmaxf(lg[0], lg[1]), fmaxf(lg[2], lg[3])), fmaxf(fmaxf(lg[4], lg[5]), fmaxf(lg[6], lg[7])));
            cm = fmaxf(cm, __shfl_xor(cm, 16)); cm = fmaxf(cm, __shfl_xor(cm, 32));
            const float mn = fmaxf(m, cm);
            if (__any(mn > m)) {
                const float sc = exp2f(m - mn);
                l *= sc;
#pragma unroll
                for (int ct = 0; ct < 16; ++ct) O[ct] *= sc;
                m = mn;
            }
            float p[8]; float ps = 0.f;
#pragma unroll
            for (int i = 0; i < 8; ++i) { p[i] = exp2f(lg[i] - m); ps += p[i]; }
            l += ps;
            u32x4 pw; pw.x = pk2(p[0], p[1]); pw.y = pk2(p[2], p[3]); pw.z = pk2(p[4], p[5]); pw.w = pk2(p[6], p[7]);
            const bf16x8 pk = __builtin_bit_cast(bf16x8, pw);
#pragma unroll
            for (int ct = 0; ct < 16; ++ct) {
                const unsigned ch = ((((unsigned)(2 * ct)) ^ swzT) | pbT) << 4;
                const v4i16_t lo = __builtin_amdgcn_ds_read_tr16_b64_v4i16((LAS v4i16_t*)(cbuf + rowT * 512 + ch + halfT));
                const v4i16_t hi = __builtin_amdgcn_ds_read_tr16_b64_v4i16((LAS v4i16_t*)(cbuf + (16 + rowT) * 512 + ch + halfT));
                const bf16x8 a = {lo[0], lo[1], lo[2], lo[3], hi[0], hi[1], hi[2], hi[3]};
                O[ct] = __builtin_amdgcn_mfma_f32_16x16x32_bf16(a, pk, O[ct], 0, 0, 0);
            }
        }
        l += __shfl_xor(l, 16); l += __shfl_xor(l, 32);
        const float inv = 1.0f / l;
        bf16_t* orow = QA + (size_t)t * 4096 + fr * 256 + 4 * fq;
#pragma unroll
        for (int ct = 0; ct < 16; ++ct) { u32x2 w; w.x = pk2(O[ct].x * inv, O[ct].y * inv); w.y = pk2(O[ct].z * inv, O[ct].w * inv); *(u32x2*)(orow + 16 * ct) = w; }
    }
}


constexpr size_t SC_BATCH = (size_t)1024 * 256 * 257 / 2;
__device__ __forceinline__ size_t sc_row_off(int b, int tl) { const size_t m = (size_t)(tl >> 5); return (size_t)b * SC_BATCH + 1024 * (m * (m + 1) / 2) + (size_t)(tl & 31) * 32 * (m + 1); }
typedef float f32x16 __attribute__((ext_vector_type(16)));
__device__ __forceinline__ unsigned okey_pk(float a, float b) {
    const unsigned w = __builtin_bit_cast(unsigned, __builtin_amdgcn_cvt_pkrtz(a, b));
    const unsigned neg = (w >> 15) & 0x00010001u;
    return w ^ ((neg * 0xffffu) | 0x80008000u);
}
__device__ __forceinline__ void phase_index_scores(const Params& P, unsigned char* lds_) {
    using pg8::bf16x8;
    const bf16_t* Z1 = (const bf16_t*)(P.ws + WS_Z1); unsigned short* SC = (unsigned short*)(P.ws + WS_SC);
    LAS unsigned char* lds = (LAS unsigned char*)lds_;
    constexpr int QROW = 144;
    LAS unsigned char* QL = lds;
    LAS float* SG = (LAS float*)(lds + 9 * 64 * QROW);
    const int tid = threadIdx.x, lane = tid & 63, wave = __builtin_amdgcn_readfirstlane(tid >> 6);
    LAS unsigned char* ST = lds + 9 * 64 * QROW + 2048 + wave * 5120;
    const int l31 = lane & 31, hh = lane >> 5;
    for (int pid = blockIdx.x; pid < 256; pid += gridDim.x) {
        const int b = pid >> 6;
        for (int side = 0; side < 2; ++side) {
            const int qb = side ? (127 - (pid & 63)) : (pid & 63);
            const int q0 = qb * 64;
            __syncthreads();
            {
                const int qi = tid >> 3, part = tid & 7;
                const bf16_t* zr = Z1 + ((size_t)b * SEQ + q0 + qi) * Z1W;
                const u32x4 ww = *(const u32x4*)(zr + 1088);
                const float w8[8] = {bflo(ww.x), bfhi(ww.x), bflo(ww.y), bfhi(ww.y), bflo(ww.z), bfhi(ww.z), bflo(ww.w), bfhi(ww.w)};
                float wh = 0.f;
#pragma unroll
                for (int h = 0; h < 8; ++h) wh = (h == part) ? w8[h] : wh;
                const float sc = 0.5f * fabsf(wh);
                SG[qi * 8 + part] = (wh >= 0.f) ? 1.0f : -1.0f;
#pragma unroll
                for (int c = 0; c < 8; ++c) {
                    const u32x4 v = *(const u32x4*)(zr + 512 + part * 64 + c * 8);
                    u32x4 o; o.x = pk2(bflo(v.x) * sc, bfhi(v.x) * sc); o.y = pk2(bflo(v.y) * sc, bfhi(v.y) * sc); o.z = pk2(bflo(v.z) * sc, bfhi(v.z) * sc); o.w = pk2(bflo(v.w) * sc, bfhi(v.w) * sc);
                    *(LAS u32x4*)(QL + (part * 64 + qi) * QROW + c * 16) = o;
                }
                float a8[8];
#pragma unroll
                for (int j = 0; j < 8; ++j) a8[j] = 0.f;
#pragma unroll
                for (int h = 0; h < 8; ++h) {
                    const u32x4 v = *(const u32x4*)(zr + 512 + h * 64 + part * 8); const float s2 = 0.5f * w8[h];
                    a8[0] += s2 * bflo(v.x); a8[1] += s2 * bfhi(v.x); a8[2] += s2 * bflo(v.y); a8[3] += s2 * bfhi(v.y);
                    a8[4] += s2 * bflo(v.z); a8[5] += s2 * bfhi(v.z); a8[6] += s2 * bflo(v.w); a8[7] += s2 * bfhi(v.w);
                }
                u32x4 o; o.x = pk2(a8[0], a8[1]); o.y = pk2(a8[2], a8[3]); o.z = pk2(a8[4], a8[5]); o.w = pk2(a8[6], a8[7]);
                *(LAS u32x4*)(QL + (8 * 64 + qi) * QROW + part * 16) = o;
            }
            __syncthreads();
            const int ktmax = 2 * qb + 1;
            for (int kt = wave; kt <= ktmax; kt += NWAVE) {
                bf16x8 kf[4];
                const bf16_t* kr = Z1 + ((size_t)b * SEQ + kt * 32 + l31) * Z1W + 1024 + hh * 8;
#pragma unroll
                for (int dq = 0; dq < 4; ++dq) kf[dq] = *(const bf16x8*)(kr + dq * 16);
#pragma unroll
                for (int qs = 0; qs < 2; ++qs) {
                    const LAS unsigned char* qrow = QL + (qs * 32 + l31) * QROW + hh * 16;
                    f32x16 acc;
#pragma unroll
                    for (int r = 0; r < 16; ++r) acc[r] = 0.f;
#pragma unroll
                    for (int dq = 0; dq < 4; ++dq) acc = __builtin_amdgcn_mfma_f32_32x32x16_bf16(kf[dq], *(const LAS bf16x8*)(qrow + 8 * 64 * QROW + dq * 32), acc, 0, 0, 0);
#pragma unroll
                    for (int h = 0; h < 8; ++h) {
                        f32x16 u;
#pragma unroll
                        for (int r = 0; r < 16; ++r) u[r] = 0.f;
#pragma unroll
                        for (int dq = 0; dq < 4; ++dq) u = __builtin_amdgcn_mfma_f32_32x32x16_bf16(kf[dq], *(const LAS bf16x8*)(qrow + h * 64 * QROW + dq * 32), u, 0, 0, 0);
                        const float sg = SG[(qs * 32 + l31) * 8 + h];
#pragma unroll
                        for (int r = 0; r < 16; ++r) acc[r] = fmaf(fabsf(u[r]), sg, acc[r]);
                    }
#pragma unroll
                    for (int g = 0; g < 4; ++g) { u32x2 w; w.x = okey_pk(acc[4 * g], acc[4 * g + 1]); w.y = okey_pk(acc[4 * g + 2], acc[4 * g + 3]);
                        *(LAS u32x2*)(ST + (qs * 32 + l31) * 80 + (8 * g + 4 * hh) * 2) = w; }
                }
#pragma unroll
                for (int i = 0; i < 4; ++i) {
                    const int row = 16 * i + (lane >> 2), ch = lane & 3, tl = q0 + row;
                    const u32x4 v = *(const LAS u32x4*)(ST + row * 80 + ch * 16);
                    if (kt <= (tl >> 5)) *(u32x4*)(SC + sc_row_off(b, tl) + (size_t)kt * 32 + ch * 8) = v;
                }
            }
        }
    }
}
__device__ __forceinline__ void phase_index_select(const Params& P, unsigned char* lds_) {
    const unsigned short* SC = (const unsigned short*)(P.ws + WS_SC); unsigned short* SEL = (unsigned short*)(P.ws + WS_SEL);
    const int tid = threadIdx.x, lane = tid & 63, wave = __builtin_amdgcn_readfirstlane(tid >> 6);
    LAS unsigned* hist = (LAS unsigned*)lds_ + wave * 1280;
    LAS unsigned short* outw = (LAS unsigned short*)(hist + 1024);
    const int gw = blockIdx.x * NWAVE + wave, NGW = gridDim.x * NWAVE;
    for (int t = gw; t < NTOK; t += NGW) {
        const int b = t >> 13, tl = t & (SEQ - 1), n = tl + 1;
        unsigned short* so = SEL + (size_t)t * TOPK;
        if (n <= TOPK) { for (int i = lane; i < n; i += 64) so[i] = (unsigned short)i; continue; }
        const u32x4* row = (const u32x4*)(SC + sc_row_off(b, tl));
        u32x4 d[16];
#pragma unroll
        for (int sg = 0; sg < 16; ++sg) { if (sg * 512 < n) d[sg] = row[sg * 64 + lane]; else d[sg] = (u32x4){0u, 0u, 0u, 0u}; }
#pragma unroll
        for (int i = 0; i < 16; ++i) { hist[i * 64 + lane] = 0u; }
        asm volatile("s_waitcnt lgkmcnt(0)" ::: "memory");
#define KEY_OF(sg, j) ((((j) & 1) ? (d[sg][(j) >> 1] >> 16) : (d[sg][(j) >> 1] & 0xffffu)))
#define IDX_OF(sg, j) ((sg) * 512 + lane * 8 + (j))
        LAS unsigned* myh = hist + (lane & 3) * 256;
#pragma unroll
        for (int sg = 0; sg < 16; ++sg) if (sg * 512 < n) {
#pragma unroll
            for (int j = 0; j < 8; ++j) { const unsigned k = KEY_OF(sg, j); if (IDX_OF(sg, j) < n) atomicAdd((unsigned*)(myh + (k >> 8)), 1u); }
        }
        asm volatile("s_waitcnt lgkmcnt(0)" ::: "memory");
        unsigned b1, need1;
        {
            unsigned c[4];
#pragma unroll
            for (int q = 0; q < 4; ++q) c[q] = hist[4 * lane + q] + hist[256 + 4 * lane + q] + hist[512 + 4 * lane + q] + hist[768 + 4 * lane + q];
            const unsigned mine = c[0] + c[1] + c[2] + c[3];
            unsigned suf = mine;
#pragma unroll
            for (int o = 1; o < 64; o <<= 1) { const unsigned v = __shfl_down(suf, o); if (lane + o < 64) suf += v; }
            const unsigned above = suf - mine;
            int fb = -1; unsigned fneed = 0;
            if (above < (unsigned)TOPK && suf >= (unsigned)TOPK) { unsigned a = above;
#pragma unroll
                for (int q = 3; q >= 0; --q) { if (fb < 0 && a + c[q] >= (unsigned)TOPK) { fb = 4 * lane + q; fneed = (unsigned)TOPK - a; } a += c[q]; } }
            const unsigned long long bal = __ballot(fb >= 0);
            const int src = (int)__builtin_ctzll(bal);
            b1 = (unsigned)__shfl(fb, src); need1 = __shfl(fneed, src);
        }
#pragma unroll
        for (int i = 0; i < 16; ++i) { hist[i * 64 + lane] = 0u; }
        asm volatile("s_waitcnt lgkmcnt(0)" ::: "memory");
#pragma unroll
        for (int sg = 0; sg < 16; ++sg) if (sg * 512 < n) {
#pragma unroll
            for (int j = 0; j < 8; ++j) { const unsigned k = KEY_OF(sg, j); if (IDX_OF(sg, j) < n && (k >> 8) == b1) atomicAdd((unsigned*)(myh + (k & 255u)), 1u); }
        }
        asm volatile("s_waitcnt lgkmcnt(0)" ::: "memory");
        unsigned T, need2;
        {
            unsigned c[4];
#pragma unroll
            for (int q = 0; q < 4; ++q) c[q] = hist[4 * lane + q] + hist[256 + 4 * lane + q] + hist[512 + 4 * lane + q] + hist[768 + 4 * lane + q];
            const unsigned mine = c[0] + c[1] + c[2] + c[3];
            unsigned suf = mine;
#pragma unroll
            for (int o = 1; o < 64; o <<= 1) { const unsigned v = __shfl_down(suf, o); if (lane + o < 64) suf += v; }
            const unsigned above = suf - mine;
            int fb = -1; unsigned fneed = 0;
            if (above < need1 && suf >= need1) { unsigned a = above;
#pragma unroll
                for (int q = 3; q >= 0; --q) { if (fb < 0 && a + c[q] >= need1) { fb = 4 * lane + q; fneed = need1 - a; } a += c[q]; } }
            const unsigned long long bal = __ballot(fb >= 0);
            const int src = (int)__builtin_ctzll(bal);
            T = (b1 << 8) | (unsigned)__shfl(fb, src); need2 = __shfl(fneed, src);
        }
        unsigned base = 0; const unsigned ngt = (unsigned)TOPK - need2; unsigned eqbase = 0;
#pragma unroll
        for (int sg = 0; sg < 16; ++sg) if (sg * 512 < n) {
            unsigned ce = 0;
#pragma unroll
            for (int j = 0; j < 8; ++j) {
                const unsigned k = KEY_OF(sg, j); const bool ok = IDX_OF(sg, j) < n;
                const bool gt = ok && k > T;
                const unsigned long long mk = __ballot(gt);
                if (gt) outw[base + (unsigned)__builtin_amdgcn_mbcnt_hi((unsigned)(mk >> 32), __builtin_amdgcn_mbcnt_lo((unsigned)mk, 0u))] = (unsigned short)IDX_OF(sg, j);
                base += (unsigned)__builtin_popcountll(mk);
                ce += (ok && k == T) ? 1u : 0u;
            }
            if (__any(ce > 0u)) {
                unsigned pre = ce;
#pragma unroll
                for (int o = 1; o < 64; o <<= 1) { const unsigned v = __shfl_up(pre, o); if (lane >= o) pre += v; }
                unsigned r = eqbase + pre - ce;
#pragma unroll
                for (int j = 0; j < 8; ++j) { const unsigned k = KEY_OF(sg, j); if (IDX_OF(sg, j) < n && k == T) { if (r < need2) outw[ngt + r] = (unsigned short)IDX_OF(sg, j); ++r; } }
                eqbase += __shfl(pre, 63);
            }
        }
#undef KEY_OF
#undef IDX_OF
        asm volatile("s_waitcnt lgkmcnt(0)" ::: "memory");
        ((unsigned*)so)[lane] = ((LAS unsigned*)outw)[lane];
        ((unsigned*)so)[64 + lane] = ((LAS unsigned*)outw)[64 + lane];
        asm volatile("s_waitcnt lgkmcnt(0)" ::: "memory");
    }
}


#define XB_TMO      128
#define XB_XCNT(j)  (256  + 64 * (j))
#define XB_XSUB(j)  (1280 + 64 * (j))
#define XB_XGEN(j)  (2304 + 64 * (j))
#define XB_TOP      3328
#define XB_TOPGEN   3392
#define XCD_BAR_WORDS 3456
#define XB_SPIN_CAP (1u << 22)
__device__ __forceinline__ unsigned xb_ld(unsigned* p)              { return __hip_atomic_load(p, __ATOMIC_RELAXED, __HIP_MEMORY_SCOPE_AGENT); }
__device__ __forceinline__ unsigned xb_add(unsigned* p, unsigned v) { return __hip_atomic_fetch_add(p, v, __ATOMIC_RELAXED, __HIP_MEMORY_SCOPE_AGENT); }
__device__ __forceinline__ unsigned xb_xcc_id() { return (unsigned)__builtin_amdgcn_s_getreg((3 << 11) | 20) & 0xFu; }
#define XB_SPIN(cond, bar) do { unsigned _sp = 0; while (cond) { __builtin_amdgcn_s_sleep(1); \
    if ((++_sp & 255u) == 0u) { if (xb_ld(&(bar)[XB_TMO])) break; if (_sp > XB_SPIN_CAP) { atomicAdd(&(bar)[XB_TMO], 1u); break; } } } } while (0)
struct XcdBarrier { unsigned* bar; unsigned x; volatile LAS unsigned* st; };
__device__ __forceinline__ XcdBarrier xcd_barrier_post(unsigned* bar, volatile LAS unsigned* st) {
    XcdBarrier b; b.bar = bar; b.x = xb_xcc_id(); b.st = st;
    if (threadIdx.x == 0) (void)xb_add(&bar[XB_XCNT(b.x)], 1u);
    return b;
}
__device__ __forceinline__ void xcd_barrier_complete(unsigned* bar, unsigned x, unsigned& nloc, unsigned& nx) {
    const unsigned G = gridDim.x * gridDim.y * gridDim.z;
    unsigned sum, cnt, mine, sp = 0u;
    for (;;) {
        sum = 0u; cnt = 0u; mine = 0u;
#pragma unroll
        for (unsigned j = 0; j < 16; ++j) { const unsigned c = xb_ld(&bar[XB_XCNT(j)]); sum += c; cnt += (c > 0u) ? 1u : 0u; mine = (j == x) ? c : mine; }
        if (sum == G) break;
        __builtin_amdgcn_s_sleep(1);
        if ((++sp & 255u) == 0u) { if (xb_ld(&bar[XB_TMO])) break; if (sp > XB_SPIN_CAP) { atomicAdd(&bar[XB_TMO], 1u); break; } }
    }
    nloc = mine > 0u ? mine : 1u; nx = cnt > 0u ? cnt : 1u;
}
__device__ __forceinline__ void xcd_barrier(const XcdBarrier& b) {
    asm volatile("s_waitcnt vmcnt(0)" ::: "memory");
    __syncthreads();
    if (threadIdx.x == 0) {
        unsigned* bar = b.bar;
        __builtin_amdgcn_s_waitcnt(0);
        unsigned nloc = b.st[0], nx = b.st[1];
        if (nloc == 0u) { xcd_barrier_complete(bar, b.x, nloc, nx); b.st[0] = nloc; b.st[1] = nx; }
        const unsigned old = xb_add(&bar[XB_XSUB(b.x)], 1u);
        const unsigned gen = old / nloc;
        if (old + 1u == (gen + 1u) * nloc) {
            __builtin_amdgcn_fence(__ATOMIC_RELEASE, "agent");
            asm volatile("s_waitcnt vmcnt(0)" ::: "memory");
            const unsigned og = xb_add(&bar[XB_TOP], 1u);
            const unsigned tg = og / nx;
            if (og + 1u == (tg + 1u) * nx) xb_add(&bar[XB_TOPGEN], 1u);
            else XB_SPIN(xb_ld(&bar[XB_TOPGEN]) == tg, bar);
            __builtin_amdgcn_fence(__ATOMIC_ACQUIRE, "agent");
            xb_add(&bar[XB_XGEN(b.x)], 1u);
            asm volatile("s_waitcnt vmcnt(0)" ::: "memory");
        } else {
            XB_SPIN(xb_ld(&bar[XB_XGEN(b.x)]) == gen, bar);
            __builtin_amdgcn_fence(__ATOMIC_ACQUIRE, "agent");
            asm volatile("s_waitcnt vmcnt(0)" ::: "memory");
        }
    }
    __syncthreads();
}
constexpr size_t CTL_BAR_OFF = 16384;
constexpr size_t CTL_ZERO_BYTES = 65536;

#ifdef PH_ONLY
#define IN(k) ((k) == PH_ONLY)
#else
#define IN(k) (lo <= (k) && (k) < hi)
#endif
#define SEAM(k) do { if (IN(k) && IN((k) + 1)) xcd_barrier(grid); } while (0)

template <int LAYER, int BASE>
__device__ __forceinline__ void layer_tail(const Params& P, unsigned char* lds, const XcdBarrier& grid, int lo, int hi) {
    unsigned char* ws = P.ws;
    int* tb = (int*)(lds + MISC_OFF);
    if (IN(BASE)) phase_ln_route(P, lds, LAYER);
    SEAM(BASE);
    if (IN(BASE + 1)) { moe_setup(P, tb, LAYER);
        MoeSched S{tb, (const int*)(ws + WS_CTL) + LAYER * 64, (const int*)(ws + WS_LIST), (const bf16_t*)(ws + WS_XB),
                   (const bf16_t*)(ws + WS_W_GU) + (size_t)LAYER * 32 * DM * DM, DM, (size_t)DM * DM, true};
        EpiGU E{(bf16_t*)(ws + WS_ACT)}; gemm_moe<true>(lds, S, E); }
    SEAM(BASE + 1);
    if (IN(BASE + 2)) { moe_setup(P, tb, LAYER);
        MoeSched S{tb, (const int*)(ws + WS_CTL) + LAYER * 64, (const int*)(ws + WS_LIST), (const bf16_t*)(ws + WS_ACT),
                   (const bf16_t*)(ws + WS_W_DN) + (size_t)LAYER * 32 * DM * 512, 512, (size_t)DM * 512, false};
        EpiDown E{(bf16_t*)(ws + WS_YS)}; gemm_moe<false>(lds, S, E); }
    SEAM(BASE + 2);
    if (IN(BASE + 3)) phase_ln2(P, LAYER);
    SEAM(BASE + 3);
    if (IN(BASE + 4)) {
        { DenseSched S{(const bf16_t*)(ws + WS_PB) + (size_t)LAYER * NTOK * 256, (const bf16_t*)(ws + WS_W_P) + (size_t)LAYER * DM * 256, NTOK, DM, 256, 256, 0};
          EpiStoreBf16 E{(bf16_t*)(ws + WS_PP), DM, 0, nullptr}; gemm_dense(lds, S, E); }
        __syncthreads();
        { DenseSched S{(const bf16_t*)(ws + WS_XB), (const bf16_t*)(ws + WS_W_G) + (size_t)LAYER * DM * DM, NTOK, DM, DM, DM, 0};
          EpiPle E{(const float*)(ws + WS_F), (const bf16_t*)(ws + WS_PP), LAYER == 1 ? P.out : (float*)(ws + WS_F), LAYER == 1 ? (bf16_t*)nullptr : (bf16_t*)(ws + WS_XB2)}; gemm_dense(lds, S, E); }
    }
}

__global__ void __launch_bounds__(NT, 2) mega(Params P, int lo, int hi) {
    extern __shared__ __attribute__((aligned(16))) unsigned char lds[];
    unsigned char* ws = P.ws;
    if (threadIdx.x < 16) ((LAS unsigned*)((LAS unsigned char*)lds + BARW_OFF))[threadIdx.x] = 0u;
    __syncthreads();
    const XcdBarrier grid = xcd_barrier_post((unsigned*)(ws + WS_CTL + CTL_BAR_OFF), (volatile LAS unsigned*)((LAS unsigned char*)lds + BARW_OFF));
    if (IN(0)) phase_prep(P, lds);
    SEAM(0);
    if (IN(1)) { DenseSched S{(const bf16_t*)(ws + WS_XB), (const bf16_t*)(ws + WS_W_IN0), NTOK, ZW, DM, DM, 0};
        EpiStoreBf16 E{(bf16_t*)(ws + WS_Z0), ZW, 0, nullptr}; gemm_dense(lds, S, E); }
    SEAM(1);
    if (IN(2)) phase_ret_kv(P, lds);
    SEAM(2);
    if (IN(3)) phase_ret_scan_pool(P);
    SEAM(3);
    if (IN(4)) { phase_ret_out(P, lds);
        DenseSched S{(const bf16_t*)(ws + WS_DP), (const bf16_t*)(ws + WS_W_POOL), NTOK, 512, 256, 512, 256};
        EpiStoreBf16 E{(bf16_t*)(ws + WS_MIX), DM, 512, P.in[5]}; gemm_dense(lds, S, E); }
    SEAM(4);
    if (IN(5)) { DenseSched S{(const bf16_t*)(ws + WS_MIX), (const bf16_t*)(ws + WS_W_OUT0), NTOK, DM, DM, DM, 0};
        EpiResid E{P.in[0], (float*)(ws + WS_F)}; gemm_dense(lds, S, E); }
    SEAM(5);
    layer_tail<0, 6>(P, lds, grid, lo, hi);
    SEAM(10);
    if (IN(11)) { DenseSched S{(const bf16_t*)(ws + WS_XB2), (const bf16_t*)(ws + WS_W_CIN), NTOK, Z1W, DM, DM, 0};
        EpiStoreBf16 E{(bf16_t*)(ws + WS_Z1), Z1W, 0, nullptr}; gemm_dense(lds, S, E); }
    SEAM(11);
    if (IN(12)) { phase_norms(P); phase_index_scores(P, lds); }
    SEAM(12);
    if (IN(13)) phase_index_select(P, lds);
    SEAM(13);
    if (IN(14)) { DenseSched S{(const bf16_t*)(ws + WS_CQ), (const bf16_t*)(ws + WS_W_QA), NTOK, 4096, 256, 256, 0};
        EpiStoreBf16 E{(bf16_t*)(ws + WS_QA), 4096, 0, nullptr}; gemm_dense(lds, S, E); }
    SEAM(14);
    if (IN(15)) phase_sparse_attn_mfma(P, lds);
    SEAM(15);
    if (IN(16)) { DenseSched S{(const bf16_t*)(ws + WS_QA), (const bf16_t*)(ws + WS_W_UVBD), NTOK, DM, DM, 4096, 1024};
        EpiStoreBf16 E{(bf16_t*)(ws + WS_XB), DM, 0, nullptr}; gemm_dense(lds, S, E); }
    SEAM(16);
    if (IN(17)) { DenseSched S{(const bf16_t*)(ws + WS_XB), (const bf16_t*)(ws + WS_W_COUT), NTOK, DM, DM, DM, 0};
        EpiResid E{(const float*)(ws + WS_F), (float*)(ws + WS_F)}; gemm_dense(lds, S, E); }
    SEAM(17);
    layer_tail<1, 18>(P, lds, grid, lo, hi);
}
#undef IN
#undef SEAM

extern "C" void kernel_launch(void* const* d_in, const int* in_sizes, int n_in, void* d_out, int out_size, void* d_ws, size_t ws_size, hipStream_t stream) {
    static int grid = 0;
    if (grid == 0) {
        if (n_in != 26 || ws_size < WS_END || out_size != NTOK * DM) { fprintf(stderr, "kernel_launch: unexpected problem (n_in %d, ws %zu, out %d)\n", n_in, ws_size, out_size); grid = -1; return; }
        int dev = 0, cus = 0, per_cu = 0;
        (void)hipGetDevice(&dev);
        (void)hipDeviceGetAttribute(&cus, hipDeviceAttributeMultiprocessorCount, dev);
        (void)hipFuncSetAttribute((const void*)mega, hipFuncAttributeMaxDynamicSharedMemorySize, LDS_BYTES);
        (void)hipOccupancyMaxActiveBlocksPerMultiprocessor(&per_cu, (const void*)mega, NT, LDS_BYTES);
        if (per_cu < 1) { fprintf(stderr, "kernel_launch: occupancy query reports %d blocks per CU\n", per_cu); per_cu = 1; }
        (void)hipGetLastError();
        grid = cus;
    }
    if (grid < 0) return;
    (void)hipMemsetAsync((char*)d_ws + WS_CTL, 0, CTL_ZERO_BYTES, stream);
    Params p{};
    for (int i = 0; i < 26; ++i) p.in[i] = (const float*)d_in[i];
    p.out = (float*)d_out; p.ws = (unsigned char*)d_ws;
#if MK_ONE_LAUNCH
    int lo = 0, hi = NPH_TOTAL;
    void* args[] = {&p, &lo, &hi};
    (void)args;
    hipLaunchKernelGGL(mega, dim3(grid), dim3(NT), LDS_BYTES, stream, p, lo, hi);
    hipError_t e = hipPeekAtLastError();
    if (e != hipSuccess) fprintf(stderr, "launch failed: %s (grid %d)\n", hipGetErrorString(e), grid);
#else
    for (int k = 0; k < NPH_TOTAL; ++k) hipLaunchKernelGGL(mega, dim3(grid), dim3(NT), LDS_BYTES, stream, p, k, k + 1);
#endif
}
```

```cpp
#include <hip/hip_runtime.h>
#include <hip/hip_cooperative_groups.h>
#include <cstdio>
#include <cstdint>
namespace cg = cooperative_groups;

#ifndef MK_ONE_LAUNCH
#define MK_ONE_LAUNCH 1
#endif

typedef unsigned short bf16_t;
typedef float f32x4 __attribute__((ext_vector_type(4)));
typedef unsigned u32x4 __attribute__((ext_vector_type(4)));
typedef unsigned u32x2 __attribute__((ext_vector_type(2)));

constexpr int NT = 512;
constexpr int NWAVE = NT / 64;
constexpr int NTOK = 32768, DM = 1024, SEQ = 8192, NBATCH = 4;
constexpr int ZW = 2560;
constexpr int Z1W = 1280;
constexpr int CIN = 1096;
constexpr int TOPK = 256;
constexpr float ALPHA = 1.4142135623730951f;
constexpr float LN_EPS = 1e-5f;
constexpr int LDS_BYTES = 163840;
constexpr int BARW_OFF = LDS_BYTES - 64;
constexpr int MISC_OFF = 135168;

constexpr size_t MiB = (size_t)1 << 20;
constexpr size_t WS_CTL = 0;
constexpr size_t WS_W_IN0 = 1 * MiB, WS_W_OUT0 = 6 * MiB, WS_W_POOL = 8 * MiB, WS_W_CIN = 9 * MiB, WS_W_QA = 12 * MiB,
                 WS_W_UVBD = 14 * MiB, WS_W_COUT = 16 * MiB, WS_W_G = 18 * MiB, WS_W_P = 22 * MiB, WS_W_GU = 24 * MiB, WS_W_DN = 152 * MiB;
constexpr size_t WS_XB = 224 * MiB, WS_F = 288 * MiB, WS_PB = 416 * MiB, WS_PP = 448 * MiB, WS_CQ = 512 * MiB, WS_CKV = 528 * MiB,
                 WS_SEL = 544 * MiB, WS_TOKG = 560 * MiB, WS_LIST = 561 * MiB;
constexpr size_t WS_M0 = 576 * MiB;
constexpr size_t WS_Z0 = WS_M0, WS_KV = WS_M0 + 160 * MiB, WS_MIX = WS_M0 + 224 * MiB, WS_DP = WS_M0 + 288 * MiB, WS_SB = WS_M0 + 320 * MiB;
constexpr size_t WS_QA = WS_M0, WS_SC = WS_M0, WS_Z1 = WS_M0 + 272 * MiB;
constexpr size_t WS_ACT = WS_M0, WS_YS = WS_M0 + 72 * MiB;
constexpr size_t WS_XB2 = 928 * MiB;
constexpr size_t WS_END = 992 * MiB;
constexpr int LIST_CAP = 32768;

struct Params {
    const float* in[26];
    float* out;
    unsigned char* ws;
};

__device__ __forceinline__ unsigned f2bf(float f) { unsigned u = __float_as_uint(f); return (u + 0x7fffu + ((u >> 16) & 1u)) >> 16; }
__device__ __forceinline__ float bf2f(unsigned h) { return __uint_as_float(h << 16); }
__device__ __forceinline__ unsigned pk2(float lo, float hi) { return f2bf(lo) | (f2bf(hi) << 16); }
__device__ __forceinline__ float bflo(unsigned w) { return __uint_as_float(w << 16); }
__device__ __forceinline__ float bfhi(unsigned w) { return __uint_as_float(w & 0xffff0000u); }
__device__ __forceinline__ float wave_sum(float v) {
#pragma unroll
    for (int o = 1; o < 64; o <<= 1) v += __shfl_xor(v, o);
    return v;
}
__device__ __forceinline__ float wave_max(float v) {
#pragma unroll
    for (int o = 1; o < 64; o <<= 1) v = fmaxf(v, __shfl_xor(v, o));
    return v;
}
__device__ __forceinline__ float silu_f(float a) { return a / (1.0f + __expf(-a)); }
__device__ __forceinline__ float sigmoid_f(float a) { return 1.0f / (1.0f + __expf(-a)); }
#define LDS_FENCE() asm volatile("s_waitcnt lgkmcnt(0)" ::: "memory")

struct UnitInfo {
    const bf16_t* A; int lda;
    const int* rows; int rshift;
    int nvalid;
    const bf16_t* Bt; int ldb;
    int K;
    int orow0;
    int pn;
};
__device__ __forceinline__ const bf16_t* unit_arow(const UnitInfo& u, int r) {
    if (u.rows) { const int idx = (r < u.nvalid) ? (u.rows[r] >> u.rshift) : 0; return u.A + (size_t)idx * u.lda; }
    return u.A + (size_t)r * u.lda;
}

struct DenseSched {
    const bf16_t* A; const bf16_t* Bt; int M, N, K, lda, a_pn_stride;
    __device__ __forceinline__ bool next(int round, UnitInfo& u) const {
        const int nN = N >> 8, nM = M >> 8, nwg = nN * nM;
        const long L = (long)round * gridDim.x + blockIdx.x; if (L >= nwg) return false;
        int wgid = (int)L; { const int q = nwg / 8, r = nwg % 8, xcd = wgid % 8, off = wgid / 8; wgid = (xcd < r ? xcd * (q + 1) : r * (q + 1) + (xcd - r) * q) + off; }
        const int nig = 8 * nN, gid = wgid / nig, fm = gid * 8, gsz = (nM - fm) < 8 ? (nM - fm) : 8;
        const int pm = fm + ((wgid % nig) % gsz), pn = (wgid % nig) / gsz;
        u.A = A + (size_t)pm * 256 * lda + (size_t)pn * a_pn_stride; u.lda = lda; u.rows = nullptr; u.rshift = 0; u.nvalid = 256;
        u.Bt = Bt + (size_t)pn * 256 * K; u.ldb = K; u.K = K; u.orow0 = pm * 256; u.pn = pn;
        return true;
    }
};
struct MoeSched {
    const int* tb; const int* cnt; const int* list;
    const bf16_t* A; const bf16_t* W; int K; size_t wstride; bool gather;
    __device__ __forceinline__ bool next(int round, UnitInfo& u) const {
        const int i = round * gridDim.x + blockIdx.x;
        const int j = i >> 2, pn = i & 3;
        if (j >= tb[32]) return false;
        int e = 0;
        while (tb[e + 1] <= j) ++e;
        const int rb = j - tb[e];
        const int nv = min(256, cnt[e] - rb * 256);
        u.rows = list + (size_t)e * LIST_CAP + rb * 256; u.nvalid = nv; u.orow0 = j * 256; u.pn = pn;
        if (gather) { u.A = A; u.lda = K; u.rshift = 1; }
        else { u.A = A + (size_t)j * 256 * K; u.lda = K; u.rshift = 31;   }
        u.Bt = W + (size_t)e * wstride + (size_t)pn * 256 * K; u.ldb = K; u.K = K;
        return true;
    }
};

template <class Sched, class Epi>
__device__ __forceinline__ void gemm_simple(unsigned char* lds, const Sched& S, const Epi& E, bool contiguousA) {
    float* As = (float*)lds;
    float* Bs = As + 128 * 33;
    const int tid = threadIdx.x, ty = tid >> 3, tx = tid & 7;
    const int lr = tid >> 2, kc = (tid & 3) * 8;
    UnitInfo u;
    for (int round = 0; S.next(round, u); ++round) {
        for (int sm = 0; sm < 2; ++sm) {
            const int ar = sm * 128 + lr;
            const bf16_t* arow = contiguousA ? (u.A + (size_t)ar * u.lda) : unit_arow(u, ar);
            for (int sn = 0; sn < 4; ++sn) {
                float acc[2][8];
#pragma unroll
                for (int a = 0; a < 2; ++a)
#pragma unroll
                    for (int b = 0; b < 8; ++b) acc[a][b] = 0.f;
                const bf16_t* brow = u.Bt + (size_t)(sn * 64 + (tid >> 2)) * u.ldb;
                for (int k0 = 0; k0 < u.K; k0 += 32) {
                    const u32x4 av = *(const u32x4*)(arow + k0 + kc);
                    float* ap = As + lr * 33 + kc;
                    ap[0] = bflo(av.x); ap[1] = bfhi(av.x); ap[2] = bflo(av.y); ap[3] = bfhi(av.y);
                    ap[4] = bflo(av.z); ap[5] = bfhi(av.z); ap[6] = bflo(av.w); ap[7] = bfhi(av.w);
                    if (tid < 256) {
                        const u32x4 bv = *(const u32x4*)(brow + k0 + kc);
                        float* bp = Bs + (tid >> 2) * 33 + kc;
                        bp[0] = bflo(bv.x); bp[1] = bfhi(bv.x); bp[2] = bflo(bv.y); bp[3] = bfhi(bv.y);
                        bp[4] = bflo(bv.z); bp[5] = bfhi(bv.z); bp[6] = bflo(bv.w); bp[7] = bfhi(bv.w);
                    }
                    __syncthreads();
#pragma unroll 8
                    for (int kk = 0; kk < 32; ++kk) {
                        const float a0 = As[(2 * ty) * 33 + kk], a1 = As[(2 * ty + 1) * 33 + kk];
#pragma unroll
                        for (int j = 0; j < 8; ++j) { const float b = Bs[(tx * 8 + j) * 33 + kk]; acc[0][j] += a0 * b; acc[1][j] += a1 * b; }
                    }
                    __syncthreads();
                }
#pragma unroll
                for (int rr = 0; rr < 2; ++rr) {
                    const f32x4 v0 = {acc[rr][0], acc[rr][1], acc[rr][2], acc[rr][3]}, v1 = {acc[rr][4], acc[rr][5], acc[rr][6], acc[rr][7]};
                    E(u, sm * 128 + 2 * ty + rr, sn * 64 + tx * 8, v0, v1);
                }
            }
        }
    }
}


namespace pg8 {
#define LAS __attribute__((address_space(3)))
typedef short bf16x8 __attribute__((ext_vector_type(8)));
constexpr int BK = 64, HALF = 128, HTB = HALF * BK * 2, STAGE_BYTES = 8 * HTB;
__device__ __forceinline__ int lds_byte(int r, int c) { const int st = (r >> 4) * 2 + (c >> 5), rr = r & 15, cc = c & 31, ob = rr * 64 + cc * 2; return st * 1024 + (ob ^ (((ob >> 9) & 1) << 5)); }
__device__ __forceinline__ void stage_rc(int b, int& R, int& C) { const int st = b / 1024, sb = b % 1024, swz = sb ^ (((sb >> 9) & 1) << 5); R = (st >> 1) * 16 + swz / 64; C = (st & 1) * 32 + (swz % 64) / 2; }
__device__ __forceinline__ int perm32(int rho) { const int n = rho >> 4, i = rho & 15; return 8 * (i >> 2) + 4 * n + (i & 3); }

template <bool GATHER, class Sched, class Epi>
__device__ __forceinline__ void gemm_phase(LAS unsigned char* lds, const LAS unsigned* rowtab, const Sched& S, const Epi& E, const int lda, const int ldb, const int K) {
    const int tid = threadIdx.x, wid = __builtin_amdgcn_readfirstlane(tid >> 6), lane = tid & 63, wr = wid >> 2, wc = wid & 3, fr = lane & 15, fq = lane >> 4;
    const int nt = K / BK;
    unsigned voffA[2], voffB[2]; int RA[2]; unsigned CA2[2];
#pragma unroll
    for (int i = 0; i < 2; ++i) { int R, C; stage_rc(tid * 16 + i * 8192, R, C); const int Rb = (R & ~31) + perm32(R & 31);
        voffA[i] = (unsigned)(R * lda + C) * 2u; voffB[i] = (unsigned)(Rb * ldb + C) * 2u; RA[i] = R; CA2[i] = (unsigned)C * 2u; }
    const size_t kstep = (size_t)(BK * 2);
    const size_t hstepA = (size_t)HALF * lda * 2, hstepB = (size_t)HALF * ldb * 2;
    const unsigned ldsw = (unsigned)wid * 1024u;
    const int aoff = lds_byte(wr * 64 + fr, fq * 8), boff = lds_byte(wc * 32 + fr, fq * 8);
    unsigned offA[2][2];
#define PG8_SA(b, h) (((b) * 2 + (h)) * HTB)
#define PG8_SB(b, h) ((4 + (b) * 2 + (h)) * HTB)
#define PG8_STAGE(bufoff, gbase, voff) do { _Pragma("unroll") for (int _i = 0; _i < 2; ++_i) \
        __builtin_amdgcn_global_load_lds((const unsigned*)((const char*)(gbase) + (voff)[_i]), (LAS unsigned*)(lds + (bufoff) + ldsw + _i * 8192), 16, 0, 0); } while (0)
#define PG8_STAGE_A(bufoff, h, gbase) do { if (GATHER) PG8_STAGE(bufoff, gbase, offA[h]); else PG8_STAGE(bufoff, (gbase) + (h) * hstepA, voffA); } while (0)
#define PG8_LOADOFF(round) do { _Pragma("unroll") for (int _h = 0; _h < 2; ++_h) _Pragma("unroll") for (int _i = 0; _i < 2; ++_i) offA[_h][_i] = rowtab[(round) * 256 + _h * 128 + RA[_i]] + CA2[_i]; } while (0)
#define PG8_LDA(dst, b, h) do { _Pragma("unroll") for (int m = 0; m < 4; ++m) _Pragma("unroll") for (int k = 0; k < 2; ++k) dst[m][k] = *(const LAS bf16x8*)(lds + PG8_SA(b, h) + aoff + m * 2048 + k * 1024); } while (0)
#define PG8_LDB(dst, b, h) do { _Pragma("unroll") for (int n = 0; n < 2; ++n) _Pragma("unroll") for (int k = 0; k < 2; ++k) dst[n][k] = *(const LAS bf16x8*)(lds + PG8_SB(b, h) + boff + n * 2048 + k * 1024); } while (0)
#define PG8_MMA(ai, bj, At, Bt) do { __builtin_amdgcn_s_setprio(1); _Pragma("unroll") for (int m = 0; m < 4; ++m) _Pragma("unroll") for (int n = 0; n < 2; ++n) _Pragma("unroll") for (int k = 0; k < 2; ++k) \
        acc[ai][bj][m][n] = __builtin_amdgcn_mfma_f32_16x16x32_bf16(Bt[n][k], At[m][k], acc[ai][bj][m][n], 0, 0, 0); __builtin_amdgcn_s_setprio(0); } while (0)
#define PG8_WAIT_V(n) asm volatile("s_waitcnt vmcnt(" #n ")" ::: "memory")
#define PG8_WAIT_L(n) asm volatile("s_waitcnt lgkmcnt(" #n ")" ::: "memory")
#define PG8_BAR __builtin_amdgcn_s_barrier()
#define PG8_SCHED __builtin_amdgcn_sched_barrier(0)
    UnitInfo cur, nxt; int ui = 0;
    if (!S.next(0, cur)) return;
    f32x4 acc[2][2][4][2];
#pragma unroll
    for (int a = 0; a < 2; ++a)
#pragma unroll
        for (int b = 0; b < 2; ++b)
#pragma unroll
            for (int m = 0; m < 4; ++m)
#pragma unroll
                for (int n = 0; n < 2; ++n) acc[a][b][m][n] = (f32x4){0.f, 0.f, 0.f, 0.f};
    bf16x8 At[4][2], B0[2][2], B1[2][2];
    const char* cA = (const char*)cur.A; const char* cB = (const char*)cur.Bt;
    if (GATHER) { PG8_LOADOFF(0); }
    PG8_STAGE(PG8_SB(0, 0), cB, voffB); PG8_STAGE(PG8_SB(0, 1), cB + hstepB, voffB); PG8_STAGE_A(PG8_SA(0, 0), 0, cA); PG8_STAGE_A(PG8_SA(0, 1), 1, cA);
    if (wr == 1) PG8_BAR;
    PG8_WAIT_V(2); PG8_BAR;
    PG8_STAGE(PG8_SB(1, 0), cB + kstep, voffB); PG8_STAGE_A(PG8_SA(1, 0), 0, cA + kstep); PG8_STAGE(PG8_SB(1, 1), cB + hstepB + kstep, voffB);
    PG8_WAIT_V(6); PG8_BAR;
    for (;;) {
        const bool has_next = S.next(ui + 1, nxt);
        const char* nA = has_next ? (const char*)nxt.A : cA; const char* nB = has_next ? (const char*)nxt.Bt : cB;
        for (int t = 0; t < nt; t += 2) {
            const bool last = (t == nt - 2);
            const char* a1 = cA + (size_t)(t + 1) * kstep;
            const char* a2 = last ? nA : cA + (size_t)(t + 2) * kstep; const char* b2 = last ? nB : cB + (size_t)(t + 2) * kstep;
            const char* a3 = a2 + kstep; const char* b3 = b2 + kstep;
            PG8_LDB(B0, 0, 0); PG8_LDB(B1, 0, 1); PG8_SCHED; PG8_LDA(At, 0, 0); PG8_STAGE_A(PG8_SA(1, 1), 1, a1);
            if (GATHER) { if (last && has_next) { PG8_LOADOFF(ui + 1); } }
            PG8_WAIT_V(8); PG8_WAIT_L(0); PG8_BAR; PG8_MMA(0, 0, At, B0); PG8_MMA(0, 1, At, B1); PG8_BAR; PG8_SCHED;
            PG8_LDA(At, 0, 1); PG8_STAGE(PG8_SB(0, 0), b2, voffB); PG8_STAGE(PG8_SB(0, 1), b2 + hstepB, voffB); PG8_STAGE_A(PG8_SA(0, 0), 0, a2);
            PG8_WAIT_V(8); PG8_WAIT_L(0); PG8_BAR; PG8_MMA(1, 0, At, B0); PG8_MMA(1, 1, At, B1); PG8_BAR; PG8_SCHED;
            PG8_LDB(B0, 1, 0); PG8_LDB(B1, 1, 1); PG8_SCHED; PG8_LDA(At, 1, 0); PG8_STAGE_A(PG8_SA(0, 1), 1, a2);
            PG8_WAIT_V(8); PG8_WAIT_L(0); PG8_BAR; PG8_MMA(0, 0, At, B0); PG8_MMA(0, 1, At, B1); PG8_BAR; PG8_SCHED;
            PG8_LDA(At, 1, 1); PG8_STAGE(PG8_SB(1, 0), b3, voffB); PG8_STAGE(PG8_SB(1, 1), b3 + hstepB, voffB); PG8_STAGE_A(PG8_SA(1, 0), 0, a3);
            PG8_WAIT_V(8); PG8_WAIT_L(0); PG8_BAR; PG8_MMA(1, 0, At, B0); PG8_MMA(1, 1, At, B1); PG8_BAR; PG8_SCHED;
        }
        if (wr == 0) PG8_BAR;
#pragma unroll
        for (int ai = 0; ai < 2; ++ai)
#pragma unroll
            for (int m = 0; m < 4; ++m)
#pragma unroll
                for (int bj = 0; bj < 2; ++bj) E(cur, ai * HALF + wr * 64 + m * 16 + fr, bj * HALF + wc * 32 + 8 * fq, acc[ai][bj][m][0], acc[ai][bj][m][1]);
        if (!has_next) break;
#pragma unroll
        for (int a = 0; a < 2; ++a)
#pragma unroll
            for (int b = 0; b < 2; ++b)
#pragma unroll
                for (int m = 0; m < 4; ++m)
#pragma unroll
                    for (int n = 0; n < 2; ++n) acc[a][b][m][n] = (f32x4){0.f, 0.f, 0.f, 0.f};
        cur = nxt; cA = nA; cB = nB; ++ui;
        if (wr == 1) PG8_BAR;
    }
    PG8_WAIT_V(0);
    PG8_BAR;
#undef PG8_SA
#undef PG8_SB
#undef PG8_STAGE
#undef PG8_STAGE_A
#undef PG8_LOADOFF
#undef PG8_LDA
#undef PG8_LDB
#undef PG8_MMA
#undef PG8_WAIT_V
#undef PG8_WAIT_L
#undef PG8_BAR
#undef PG8_SCHED
}
}

#ifndef USE_PG8_DENSE
#define USE_PG8_DENSE 1
#endif
#ifndef USE_PG8_MOE
#define USE_PG8_MOE 1
#endif
template <class Sched, class Epi>
__device__ __forceinline__ void gemm_dense(unsigned char* lds, const Sched& S, const Epi& E) {
#if USE_PG8_DENSE
    pg8::gemm_phase<false>((LAS unsigned char*)lds, (const LAS unsigned*)nullptr, S, E, S.lda, S.K, S.K);
    __syncthreads();
#else
    gemm_simple(lds, S, E, true);
#endif
}


template <bool GATHER, class Epi>
__device__ __forceinline__ void gemm_moe(unsigned char* lds, const MoeSched& S, const Epi& E) {
#if USE_PG8_MOE
    LAS unsigned* rowtab = (LAS unsigned*)(lds + MISC_OFF + 256);
    if (GATHER) {
        UnitInfo u;
        for (int round = 0; round < 10 && S.next(round, u); ++round)
            if (threadIdx.x < 256) rowtab[round * 256 + threadIdx.x] = ((int)threadIdx.x < u.nvalid) ? (unsigned)(u.rows[threadIdx.x] >> 1) * (unsigned)(S.K * 2) : 0u;
        __syncthreads();
    }
    pg8::gemm_phase<GATHER>((LAS unsigned char*)lds, (const LAS unsigned*)rowtab, S, E, S.K, S.K, S.K);
    __syncthreads();
#else
    gemm_simple(lds, S, E, !GATHER);
#endif
}

__device__ __forceinline__ u32x4 pack8(f32x4 a, f32x4 b) { u32x4 w; w.x = pk2(a.x, a.y); w.y = pk2(a.z, a.w); w.z = pk2(b.x, b.y); w.w = pk2(b.z, b.w); return w; }
struct EpiStoreBf16 {
    bf16_t* O; int ldc; int coff; const float* colscale;
    __device__ __forceinline__ void operator()(const UnitInfo& u, int r, int c, f32x4 v0, f32x4 v1) const {
        const int col = u.pn * 256 + c;
        if (colscale) { const f32x4 s0 = *(const f32x4*)(colscale + col), s1 = *(const f32x4*)(colscale + col + 4); v0 *= s0; v1 *= s1; }
        *(u32x4*)(O + (size_t)(u.orow0 + r) * ldc + coff + col) = pack8(v0, v1);
    }
};

__device__ __forceinline__ float ret_log2g(int h) { return log2f(1.0f - exp2f(-5.0f - (float)h)); }
struct EpiZ0 {
    bf16_t* O;
    __device__ __forceinline__ void operator()(const UnitInfo& u, int r, int c, f32x4 v0, f32x4 v1) const {
        const int col = u.pn * 256 + c, row = u.orow0 + r;
        if (col < 1024) { const float e = ret_log2g((col >> 7) & 3) * (float)(row & 127); const float sc = exp2f(col < 512 ? e : -e); v0 *= sc; v1 *= sc; }
        *(u32x4*)(O + (size_t)row * ZW + col) = pack8(v0, v1);
    }
};
struct EpiResid {
    const float* X; float* Fo;
    __device__ __forceinline__ void operator()(const UnitInfo& u, int r, int c, f32x4 v0, f32x4 v1) const {
        const size_t off = (size_t)(u.orow0 + r) * DM + u.pn * 256 + c;
        const f32x4 x0 = *(const f32x4*)(X + off), x1 = *(const f32x4*)(X + off + 4);
        *(f32x4*)(Fo + off) = x0 * ALPHA + v0; *(f32x4*)(Fo + off + 4) = x1 * ALPHA + v1;
    }
};
struct EpiGU {
    bf16_t* ACT;
    __device__ __forceinline__ void operator()(const UnitInfo& u, int r, int c, f32x4 v0, f32x4 v1) const {
        u32x2 w; w.x = pk2(silu_f(v0.x) * v0.y, silu_f(v0.z) * v0.w); w.y = pk2(silu_f(v1.x) * v1.y, silu_f(v1.z) * v1.w);
        *(u32x2*)(ACT + (size_t)(u.orow0 + r) * 512 + u.pn * 128 + (c >> 1)) = w;
    }
};
struct EpiDown {
    bf16_t* YS;
    __device__ __forceinline__ void operator()(const UnitInfo& u, int r, int c, f32x4 v0, f32x4 v1) const {
        if (r < u.nvalid) { const int pair = u.rows[r]; *(u32x4*)(YS + (size_t)pair * DM + u.pn * 256 + c) = pack8(v0, v1); }
    }
};
struct EpiPle {
    const float* F; const bf16_t* PP; float* OUT; bf16_t* XB;
    __device__ __forceinline__ void operator()(const UnitInfo& u, int r, int c, f32x4 v0, f32x4 v1) const {
        const size_t off = (size_t)(u.orow0 + r) * DM + u.pn * 256 + c;
        const u32x4 pw = *(const u32x4*)(PP + off);
        const f32x4 p0 = {bflo(pw.x), bfhi(pw.x), bflo(pw.y), bfhi(pw.y)}, p1 = {bflo(pw.z), bfhi(pw.z), bflo(pw.w), bfhi(pw.w)};
        f32x4 f0 = *(const f32x4*)(F + off), f1 = *(const f32x4*)(F + off + 4);
        f0.x += sigmoid_f(v0.x) * p0.x; f0.y += sigmoid_f(v0.y) * p0.y; f0.z += sigmoid_f(v0.z) * p0.z; f0.w += sigmoid_f(v0.w) * p0.w;
        f1.x += sigmoid_f(v1.x) * p1.x; f1.y += sigmoid_f(v1.y) * p1.y; f1.z += sigmoid_f(v1.z) * p1.z; f1.w += sigmoid_f(v1.w) * p1.w;
        *(f32x4*)(OUT + off) = f0; *(f32x4*)(OUT + off + 4) = f1;
        if (XB) *(u32x4*)(XB + off) = pack8(f0, f1);
    }
};

__device__ __forceinline__ void tr_item(const float* W, int K, int N, bf16_t* WT, int mode, float* scr, int kb, int nb, int lane) {
    const int k0 = 64 * kb, n0 = 32 * nb;
#pragma unroll 8
    for (int i = 0; i < 32; ++i) { const int kk = 2 * i + (lane >> 5); scr[kk * 33 + (lane & 31)] = W[(size_t)(k0 + kk) * N + n0 + (lane & 31)]; }
    LDS_FENCE();
    const int c = lane & 7;
#pragma unroll
    for (int j = 0; j < 4; ++j) {
        const int n = (lane >> 3) + 8 * j; const float* s = scr + (8 * c) * 33 + n;
        const int ng = n0 + n;
        float sc = 1.f; int nd = ng;
        if (mode == 1) { if (ng >= 512 && ng < 1024) sc = 0.08838834764831845f; }
        if (mode == 2) { nd = (ng < 512) ? 2 * ng : 2 * (ng - 512) + 1; }
        u32x4 o; o.x = pk2(s[0 * 33] * sc, s[1 * 33] * sc); o.y = pk2(s[2 * 33] * sc, s[3 * 33] * sc); o.z = pk2(s[4 * 33] * sc, s[5 * 33] * sc); o.w = pk2(s[6 * 33] * sc, s[7 * 33] * sc);
        *(u32x4*)(WT + (size_t)nd * K + k0 + 8 * c) = o;
    }
    LDS_FENCE();
}
struct TrDesc { const float* src; bf16_t* dst; int K, N, nbatch, mode; };
__device__ __forceinline__ int tr_items(const TrDesc& d) { return d.nbatch * (d.K / 64) * (d.N / 32); }
__device__ __forceinline__ void tr_run(const TrDesc& d, int it, float* scr, int lane) {
    const int per = (d.K / 64) * (d.N / 32), b = it / per, r = it % per, nblk = d.N / 32;
    tr_item(d.src + (size_t)b * d.K * d.N, d.K, d.N, d.dst + (size_t)b * d.K * d.N, d.mode, scr, r / nblk, r % nblk, lane);
}

__device__ __forceinline__ void phase_prep(const Params& P, unsigned char* lds) {
    unsigned char* ws = P.ws;
    const int tid = threadIdx.x, lane = tid & 63, wave = tid >> 6;
    const int gw = blockIdx.x * NWAVE + wave, NGW = gridDim.x * NWAVE;
    float* scr = (float*)lds + wave * (64 * 33);
    TrDesc d[7];
    d[0] = {P.in[22], (bf16_t*)(ws + WS_W_GU), 1024, 1024, 64, 2};
    d[1] = {P.in[23], (bf16_t*)(ws + WS_W_DN), 512, 1024, 64, 0};
    d[2] = {P.in[2], (bf16_t*)(ws + WS_W_IN0), 1024, 2560, 1, 1};
    d[3] = {P.in[6], (bf16_t*)(ws + WS_W_OUT0), 1024, 1024, 1, 0};
    d[4] = {P.in[13], (bf16_t*)(ws + WS_W_COUT), 1024, 1024, 1, 0};
    d[5] = {P.in[24], (bf16_t*)(ws + WS_W_G), 1024, 1024, 2, 0};
    d[6] = {P.in[25], (bf16_t*)(ws + WS_W_P), 256, 1024, 2, 0};
    int total = 0;
#pragma unroll
    for (int i = 0; i < 7; ++i) total += tr_items(d[i]);
    for (int it = gw; it < total; it += NGW) {
        int r = it;
#pragma unroll
        for (int i = 0; i < 7; ++i) { const int n = tr_items(d[i]); if (r >= 0 && r < n) { tr_run(d[i], r, scr, lane); r = -1; } else if (r >= 0) r -= n; }
    }
    const size_t gt = (size_t)blockIdx.x * NT + tid, GS = (size_t)gridDim.x * NT;
    {
        bf16_t* o = (bf16_t*)(ws + WS_W_POOL); const float* pw = P.in[4];
        for (size_t i = gt; i < 512 * 256; i += GS) { const int n = (int)(i >> 8), k = (int)(i & 255), g = n >> 7, dd = n & 127, kg = k >> 7, c = k & 127;
            o[i] = (bf16_t)((kg == (g & 1)) ? f2bf(pw[((size_t)g * 128 + c) * 128 + dd]) : 0u); }
    }
    {
        bf16_t* o = (bf16_t*)(ws + WS_W_CIN); const float* w = P.in[7];
        for (size_t i = gt; i < (size_t)Z1W * 1024; i += GS) { const int n = (int)(i >> 10), k = (int)(i & 1023);
            o[i] = (bf16_t)((n < CIN) ? f2bf(w[(size_t)k * CIN + n]) : 0u); }
    }
    {
        bf16_t* o = (bf16_t*)(ws + WS_W_QA); const float* uq = P.in[10]; const float* uk = P.in[11];
        for (size_t i = gt; i < (size_t)4096 * 256; i += GS) { const int n = (int)(i >> 8), r = (int)(i & 255), h = n >> 8, c = n & 255;
            const float* a = uq + (size_t)r * 1024 + h * 64; const float* b = uk + (size_t)c * 1024 + h * 64; float s = 0.f;
            for (int dd = 0; dd < 64; ++dd) s += a[dd] * b[dd];
            o[i] = (bf16_t)f2bf(s * 0.125f); }
    }
    {
        bf16_t* o = (bf16_t*)(ws + WS_W_UVBD); const float* uv = P.in[12];
        for (size_t i = gt; i < (size_t)1024 * 1024; i += GS) { const int n = (int)(i >> 10), k = (int)(i & 1023), h = n >> 6, dd = n & 63, hq = k >> 8, c = k & 255;
            o[i] = (bf16_t)(((h & 3) == hq) ? f2bf(uv[(size_t)c * 1024 + h * 64 + dd]) : 0u); }
    }
    {
        const f32x4* x = (const f32x4*)P.in[0]; u32x4* xb = (u32x4*)(ws + WS_XB);
        for (size_t i = gt; i < (size_t)NTOK * DM / 8; i += GS) xb[i] = pack8(x[2 * i], x[2 * i + 1]);
        const f32x4* p = (const f32x4*)P.in[1]; u32x4* pb = (u32x4*)(ws + WS_PB);
        for (size_t i = gt; i < (size_t)2 * NTOK * 256 / 8; i += GS) pb[i] = pack8(p[2 * i], p[2 * i + 1]);
    }
}

__device__ __forceinline__ float ret_logg(int h) { return log1pf(-exp2f(-5.0f - (float)h)); }

__device__ __forceinline__ void phase_ret_kv(const Params& P, unsigned char* lds) {
    const bf16_t* Z0 = (const bf16_t*)(P.ws + WS_Z0); float* KV = (float*)(P.ws + WS_KV);
    float* Ks = (float*)lds; float* Vs = Ks + 128 * 128;
    const int tid = threadIdx.x;
    for (int u = blockIdx.x; u < 1024; u += gridDim.x) {
        const int n = u & 63, h = (u >> 6) & 3, b = u >> 8;
        const float lg = ret_logg(h);
        const size_t row0 = (size_t)b * SEQ + n * 128;
        for (int i = tid; i < 128 * 16; i += NT) {
            const int r = i >> 4, c8 = (i & 15) * 8;
            const u32x4 kv = *(const u32x4*)(Z0 + (row0 + r) * ZW + 512 + h * 128 + c8);
            const u32x4 vv = *(const u32x4*)(Z0 + (row0 + r) * ZW + 1024 + h * 128 + c8);
            const float dec = __expf(lg * (float)(127 - r));
            float* kp = Ks + r * 128 + c8; float* vp = Vs + r * 128 + c8;
            kp[0] = bflo(kv.x) * dec; kp[1] = bfhi(kv.x) * dec; kp[2] = bflo(kv.y) * dec; kp[3] = bfhi(kv.y) * dec;
            kp[4] = bflo(kv.z) * dec; kp[5] = bfhi(kv.z) * dec; kp[6] = bflo(kv.w) * dec; kp[7] = bfhi(kv.w) * dec;
            vp[0] = bflo(vv.x); vp[1] = bfhi(vv.x); vp[2] = bflo(vv.y); vp[3] = bfhi(vv.y);
            vp[4] = bflo(vv.z); vp[5] = bfhi(vv.z); vp[6] = bflo(vv.w); vp[7] = bfhi(vv.w);
        }
        __syncthreads();
        const int dd = tid >> 2, v0 = (tid & 3) * 32;
        float acc[32];
#pragma unroll
        for (int j = 0; j < 32; ++j) acc[j] = 0.f;
        for (int i = 0; i < 128; ++i) {
            const float kd = Ks[i * 128 + dd];
#pragma unroll
            for (int j = 0; j < 32; j += 4) { const f32x4 vv = *(const f32x4*)(Vs + i * 128 + v0 + j); acc[j] += kd * vv.x; acc[j + 1] += kd * vv.y; acc[j + 2] += kd * vv.z; acc[j + 3] += kd * vv.w; }
        }
        float* o = KV + (size_t)u * 16384 + dd * 128 + v0;
#pragma unroll
        for (int j = 0; j < 32; j += 4) *(f32x4*)(o + j) = (f32x4){acc[j], acc[j + 1], acc[j + 2], acc[j + 3]};
        __syncthreads();
    }
}
__device__ __forceinline__ void phase_ret_scan_pool(const Params& P) {
    float* KV = (float*)(P.ws + WS_KV);
    const size_t gt = (size_t)blockIdx.x * NT + threadIdx.x, GS = (size_t)gridDim.x * NT;
    for (size_t i = gt; i < (size_t)16 * 4096; i += GS) {
        const int s = (int)(i >> 12), e4 = (int)(i & 4095), h = s & 3;
        const float cd = __expf(ret_logg(h) * 128.0f);
        f32x4* p = (f32x4*)(KV + (size_t)s * 64 * 16384) + e4;
        f32x4 R = {0.f, 0.f, 0.f, 0.f};
        for (int n0 = 0; n0 < 64; n0 += 8) {
            f32x4 kv[8];
#pragma unroll
            for (int j = 0; j < 8; ++j) kv[j] = p[(size_t)(n0 + j) * 4096];
#pragma unroll
            for (int j = 0; j < 8; ++j) { p[(size_t)(n0 + j) * 4096] = R; R = R * cd + kv[j]; }
        }
    }
    const bf16_t* Z0 = (const bf16_t*)(P.ws + WS_Z0); bf16_t* DP = (bf16_t*)(P.ws + WS_DP);
    for (size_t i = gt; i < (size_t)NTOK * 64; i += GS) {
        const int t = (int)(i >> 6), c8 = (int)(i & 63) * 8, g = c8 >> 7, w = 2 << g, tl = t & (SEQ - 1);
        const int cnt = min(tl + 1, w);
        float s[8];
#pragma unroll
        for (int j = 0; j < 8; ++j) s[j] = 0.f;
        float u0[8];
        for (int q = 0; q < cnt; ++q) {
            const u32x4 v = *(const u32x4*)(Z0 + (size_t)(t - q) * ZW + 2048 + c8);
            const float f[8] = {bflo(v.x), bfhi(v.x), bflo(v.y), bfhi(v.y), bflo(v.z), bfhi(v.z), bflo(v.w), bfhi(v.w)};
#pragma unroll
            for (int j = 0; j < 8; ++j) { s[j] += f[j]; if (q == 0) u0[j] = f[j]; }
        }
        const float inv = 1.0f / (float)cnt;
        u32x4 o; o.x = pk2(s[0] * inv - u0[0], s[1] * inv - u0[1]); o.y = pk2(s[2] * inv - u0[2], s[3] * inv - u0[3]);
        o.z = pk2(s[4] * inv - u0[4], s[5] * inv - u0[5]); o.w = pk2(s[6] * inv - u0[6], s[7] * inv - u0[7]);
        *(u32x4*)(DP + (size_t)t * 512 + c8) = o;
    }
}
__device__ __forceinline__ void phase_ret_out(const Params& P, unsigned char* lds) {
    const bf16_t* Z0 = (const bf16_t*)(P.ws + WS_Z0); const float* KV = (const float*)(P.ws + WS_KV); bf16_t* MIX = (bf16_t*)(P.ws + WS_MIX);
    const float* gn = P.in[3];
    bf16_t* Qs = (bf16_t*)lds;
    bf16_t* Ksm = Qs + 128 * 136;
    float* Sc = (float*)(lds + 2 * 128 * 136 * 2);
    const int tid = threadIdx.x;
    for (int u = blockIdx.x; u < 1024; u += gridDim.x) {
        const int n = u & 63, h = (u >> 6) & 3, b = u >> 8;
        const float lg = ret_logg(h);
        const size_t row0 = (size_t)b * SEQ + n * 128;
        for (int i = tid; i < 128 * 16; i += NT) {
            const int r = i >> 4, c8 = (i & 15) * 8;
            *(u32x4*)(Qs + r * 136 + c8) = *(const u32x4*)(Z0 + (row0 + r) * ZW + h * 128 + c8);
            *(u32x4*)(Ksm + r * 136 + c8) = *(const u32x4*)(Z0 + (row0 + r) * ZW + 512 + h * 128 + c8);
        }
        __syncthreads();
        for (int e = tid; e < 128 * 128; e += NT) {
            const int i = e >> 7, j = e & 127;
            float s = 0.f;
            if (j <= i) {
                const bf16_t* q = Qs + i * 136; const bf16_t* k = Ksm + j * 136;
                for (int dd = 0; dd < 128; dd += 2) { const unsigned qa = *(const unsigned*)(q + dd), ka = *(const unsigned*)(k + dd); s += bflo(qa) * bflo(ka) + bfhi(qa) * bfhi(ka); }
                s *= __expf(lg * (float)(i - j));
            }
            Sc[e] = s;
        }
        __syncthreads();
        const int i = tid >> 2, v0 = (tid & 3) * 32;
        float acc[32];
#pragma unroll
        for (int j = 0; j < 32; ++j) acc[j] = 0.f;
        for (int j = 0; j <= i; ++j) {
            const float s = Sc[i * 128 + j];
            const bf16_t* vr = Z0 + (row0 + j) * ZW + 1024 + h * 128 + v0;
#pragma unroll
            for (int q = 0; q < 4; ++q) { const u32x4 vv = *(const u32x4*)(vr + q * 8);
                acc[q * 8 + 0] += s * bflo(vv.x); acc[q * 8 + 1] += s * bfhi(vv.x); acc[q * 8 + 2] += s * bflo(vv.y); acc[q * 8 + 3] += s * bfhi(vv.y);
                acc[q * 8 + 4] += s * bflo(vv.z); acc[q * 8 + 5] += s * bfhi(vv.z); acc[q * 8 + 6] += s * bflo(vv.w); acc[q * 8 + 7] += s * bfhi(vv.w); }
        }
        const float qdec = __expf(lg * (float)(i + 1));
        const float* S = KV + (size_t)u * 16384;
        for (int dd = 0; dd < 128; ++dd) {
            const float qd = bf2f(Qs[i * 136 + dd]) * qdec;
            const float* sr = S + dd * 128 + v0;
#pragma unroll
            for (int q = 0; q < 32; q += 4) { const f32x4 sv = *(const f32x4*)(sr + q); acc[q] += qd * sv.x; acc[q + 1] += qd * sv.y; acc[q + 2] += qd * sv.z; acc[q + 3] += qd * sv.w; }
        }
        float sm = 0.f;
#pragma unroll
        for (int j = 0; j < 32; ++j) sm += acc[j];
        sm += __shfl_xor(sm, 1); sm += __shfl_xor(sm, 2);
        const float mu = sm * (1.0f / 128.0f);
        float sq = 0.f;
#pragma unroll
        for (int j = 0; j < 32; ++j) { const float dlt = acc[j] - mu; sq += dlt * dlt; }
        sq += __shfl_xor(sq, 1); sq += __shfl_xor(sq, 2);
        const float rstd = 1.0f / sqrtf(sq * (1.0f / 128.0f) + LN_EPS);
        const bf16_t* gr = Z0 + (row0 + i) * ZW + 1536 + h * 128 + v0;
        bf16_t* orow = MIX + (row0 + i) * DM + h * 128 + v0;
#pragma unroll
        for (int q = 0; q < 4; ++q) {
            const u32x4 gv = *(const u32x4*)(gr + q * 8);
            const float g8[8] = {bflo(gv.x), bfhi(gv.x), bflo(gv.y), bfhi(gv.y), bflo(gv.z), bfhi(gv.z), bflo(gv.w), bfhi(gv.w)};
            float o8[8];
#pragma unroll
            for (int j = 0; j < 8; ++j) o8[j] = (acc[q * 8 + j] - mu) * rstd * gn[h * 128 + v0 + q * 8 + j] * silu_f(g8[j]);
            u32x4 w; w.x = pk2(o8[0], o8[1]); w.y = pk2(o8[2], o8[3]); w.z = pk2(o8[4], o8[5]); w.w = pk2(o8[6], o8[7]);
            *(u32x4*)(orow + q * 8) = w;
        }
        __syncthreads();
    }
}

__device__ __forceinline__ void phase_ln_route(const Params& P, unsigned char* lds, int layer) {
    float* F = (float*)(P.ws + WS_F); bf16_t* XB = (bf16_t*)(P.ws + WS_XB);
    float* TOKG = (float*)(P.ws + WS_TOKG); int* LIST = (int*)(P.ws + WS_LIST);
    int* CNT = (int*)(P.ws + WS_CTL) + layer * 64;
    const float* lg = P.in[14] + layer * DM; const float* lb = P.in[15] + layer * DM;
    const float* wg = P.in[18] + (size_t)layer * DM * 4; const float* bg = P.in[19] + layer * 4;
    const float* we = P.in[20] + (size_t)layer * DM * 32; const float* be = P.in[21] + layer * 32;
    LAS f32x4* WL = (LAS f32x4*)lds;
    int* dec = (int*)(lds + 147456);
    int* rank = dec + 256;
    int* lcnt = rank + 256;
    int* lbase = lcnt + 32;
    for (int idx = threadIdx.x; idx < 16 * 9 * 64; idx += NT) {
        const int sl = idx / 576, rem = idx % 576, jg = rem >> 6, l = rem & 63, c = 256 * (sl >> 2) + 4 * l + (sl & 3);
        WL[idx] = (jg == 0) ? *(const f32x4*)(wg + (size_t)c * 4) : *(const f32x4*)(we + (size_t)c * 32 + (jg - 1) * 4);
    }
    __syncthreads();
    const int tid = threadIdx.x, lane = tid & 63, wave = tid >> 6;
    for (int rb = blockIdx.x; rb < NTOK / 128; rb += gridDim.x) {
        if (tid < 32) lcnt[tid] = 0;
        __syncthreads();
        for (int ri = 0; ri < 16; ++ri) {
            const int rl = wave * 16 + ri, t = rb * 128 + rl;
            float* fr = F + (size_t)t * DM;
            f32x4 v[4]; float s = 0.f;
#pragma unroll
            for (int j = 0; j < 4; ++j) { v[j] = *(const f32x4*)(fr + 256 * j + 4 * lane); s += (v[j].x + v[j].y) + (v[j].z + v[j].w); }
            const float mean = wave_sum(s) * (1.0f / DM); float s2 = 0.f;
#pragma unroll
            for (int j = 0; j < 4; ++j) { v[j] = v[j] - mean; s2 += (v[j].x * v[j].x + v[j].y * v[j].y) + (v[j].z * v[j].z + v[j].w * v[j].w); }
            const float rstd = 1.0f / sqrtf(wave_sum(s2) * (1.0f / DM) + LN_EPS);
            float acc[36];
#pragma unroll
            for (int j = 0; j < 36; ++j) acc[j] = 0.f;
#pragma unroll
            for (int j = 0; j < 4; ++j) {
                const int c0 = 256 * j + 4 * lane;
                const f32x4 g4 = *(const f32x4*)(lg + c0), b4 = *(const f32x4*)(lb + c0);
                v[j] = v[j] * rstd * g4 + b4;
                *(f32x4*)(fr + c0) = v[j];
                u32x2 w; w.x = pk2(v[j].x, v[j].y); w.y = pk2(v[j].z, v[j].w);
                *(u32x2*)(XB + (size_t)t * DM + c0) = w;
#pragma unroll
                for (int q = 0; q < 4; ++q) {
                    const float xv = v[j][q];
#pragma unroll
                    for (int jg = 0; jg < 9; ++jg) { const f32x4 w4 = WL[((j * 4 + q) * 9 + jg) * 64 + lane];
                        acc[jg * 4] += xv * w4.x; acc[jg * 4 + 1] += xv * w4.y; acc[jg * 4 + 2] += xv * w4.z; acc[jg * 4 + 3] += xv * w4.w; }
                }
            }
#pragma unroll
            for (int j = 0; j < 36; ++j) acc[j] = wave_sum(acc[j]);
            float gl[4];
#pragma unroll
            for (int j = 0; j < 4; ++j) gl[j] = acc[j] + bg[j];
            int grp = 0; float gm = gl[0];
#pragma unroll
            for (int j = 1; j < 4; ++j) if (gl[j] > gm) { gm = gl[j]; grp = j; }
            float gs = 0.f;
#pragma unroll
            for (int j = 0; j < 4; ++j) gs += __expf(gl[j] - gm);
            const float gw = 1.0f / gs;
            float el[8];
#pragma unroll
            for (int j = 0; j < 8; ++j) el[j] = 0.f;
#pragma unroll
            for (int g = 0; g < 4; ++g)
#pragma unroll
                for (int j = 0; j < 8; ++j) el[j] = (g == grp) ? (acc[4 + g * 8 + j] + be[g * 8 + j]) : el[j];
            int i0 = 0; float m0 = el[0];
#pragma unroll
            for (int j = 1; j < 8; ++j) if (el[j] > m0) { m0 = el[j]; i0 = j; }
            int i1 = -1; float m1 = -INFINITY;
#pragma unroll
            for (int j = 0; j < 8; ++j) if (j != i0 && el[j] > m1) { m1 = el[j]; i1 = j; }
            const float ex = __expf(m1 - m0);
            const float p0 = 1.0f / (1.0f + ex), p1 = ex / (1.0f + ex);
            if (lane == 0) {
                dec[rl * 2] = grp * 8 + i0; dec[rl * 2 + 1] = grp * 8 + i1;
                TOKG[(size_t)t * 2] = gw * p0; TOKG[(size_t)t * 2 + 1] = gw * p1;
            }
        }
        __syncthreads();
        if (tid < 256) rank[tid] = atomicAdd(&lcnt[dec[tid]], 1);
        __syncthreads();
        if (tid < 32) lbase[tid] = atomicAdd(&CNT[tid], lcnt[tid]);
        __syncthreads();
        if (tid < 256) { const int e = dec[tid]; LIST[(size_t)e * LIST_CAP + lbase[e] + rank[tid]] = (rb * 128 + (tid >> 1)) * 2 + (tid & 1); }
        __syncthreads();
    }
}
__device__ __forceinline__ void moe_setup(const Params& P, int* tb, int layer) {
    const int* CNT = (const int*)(P.ws + WS_CTL) + layer * 64;
    if (threadIdx.x == 0) { int a = 0; for (int e = 0; e < 32; ++e) { tb[e] = a; a += (CNT[e] + 255) >> 8; } tb[32] = a; }
    __syncthreads();
}
__device__ __forceinline__ void phase_ln2(const Params& P, int layer) {
    float* F = (float*)(P.ws + WS_F); bf16_t* XB = (bf16_t*)(P.ws + WS_XB); const bf16_t* YS = (const bf16_t*)(P.ws + WS_YS); const float* TOKG = (const float*)(P.ws + WS_TOKG);
    const float* lg = P.in[16] + layer * DM; const float* lb = P.in[17] + layer * DM;
    const int lane = threadIdx.x & 63, gw = blockIdx.x * NWAVE + (threadIdx.x >> 6), NGW = gridDim.x * NWAVE;
    for (int t = gw; t < NTOK; t += NGW) {
        float* fr = F + (size_t)t * DM; const float g0 = TOKG[(size_t)t * 2], g1 = TOKG[(size_t)t * 2 + 1];
        const bf16_t* y0 = YS + (size_t)(2 * t) * DM; const bf16_t* y1 = y0 + DM;
        f32x4 v[4]; float s = 0.f;
#pragma unroll
        for (int j = 0; j < 4; ++j) { const int c0 = 256 * j + 4 * lane; v[j] = *(const f32x4*)(fr + c0);
            const u32x2 a = *(const u32x2*)(y0 + c0), b = *(const u32x2*)(y1 + c0);
            v[j].x = v[j].x * ALPHA + g0 * bflo(a.x) + g1 * bflo(b.x); v[j].y = v[j].y * ALPHA + g0 * bfhi(a.x) + g1 * bfhi(b.x);
            v[j].z = v[j].z * ALPHA + g0 * bflo(a.y) + g1 * bflo(b.y); v[j].w = v[j].w * ALPHA + g0 * bfhi(a.y) + g1 * bfhi(b.y);
            s += (v[j].x + v[j].y) + (v[j].z + v[j].w); }
        const float mean = wave_sum(s) * (1.0f / DM); float s2 = 0.f;
#pragma unroll
        for (int j = 0; j < 4; ++j) { v[j] = v[j] - mean; s2 += (v[j].x * v[j].x + v[j].y * v[j].y) + (v[j].z * v[j].z + v[j].w * v[j].w); }
        const float rstd = 1.0f / sqrtf(wave_sum(s2) * (1.0f / DM) + LN_EPS);
#pragma unroll
        for (int j = 0; j < 4; ++j) { const int c0 = 256 * j + 4 * lane;
            const f32x4 g4 = *(const f32x4*)(lg + c0), b4 = *(const f32x4*)(lb + c0);
            v[j] = v[j] * rstd * g4 + b4; *(f32x4*)(fr + c0) = v[j];
            u32x2 w; w.x = pk2(v[j].x, v[j].y); w.y = pk2(v[j].z, v[j].w); *(u32x2*)(XB + (size_t)t * DM + c0) = w; }
    }
}

__device__ __forceinline__ void phase_norms(const Params& P) {
    const bf16_t* Z1 = (const bf16_t*)(P.ws + WS_Z1); bf16_t* CQ = (bf16_t*)(P.ws + WS_CQ); bf16_t* CKV = (bf16_t*)(P.ws + WS_CKV);
    const float* qn = P.in[8]; const float* kn = P.in[9];
    const int lane = threadIdx.x & 63, gw = blockIdx.x * NWAVE + (threadIdx.x >> 6), NGW = gridDim.x * NWAVE;
    for (int t = gw; t < NTOK; t += NGW) {
        const u32x2 a = *(const u32x2*)(Z1 + (size_t)t * Z1W + 4 * lane), b = *(const u32x2*)(Z1 + (size_t)t * Z1W + 256 + 4 * lane);
        const float q[4] = {bflo(a.x), bfhi(a.x), bflo(a.y), bfhi(a.y)}, k[4] = {bflo(b.x), bfhi(b.x), bflo(b.y), bfhi(b.y)};
        const float sq = wave_sum(q[0] * q[0] + q[1] * q[1] + q[2] * q[2] + q[3] * q[3]), sk = wave_sum(k[0] * k[0] + k[1] * k[1] + k[2] * k[2] + k[3] * k[3]);
        const float rq = 1.0f / sqrtf(sq * (1.0f / 256.0f) + 1e-6f), rk = 1.0f / sqrtf(sk * (1.0f / 256.0f) + 1e-6f);
        const f32x4 gq = *(const f32x4*)(qn + 4 * lane), gk = *(const f32x4*)(kn + 4 * lane);
        u32x2 o; o.x = pk2(q[0] * rq * gq.x, q[1] * rq * gq.y); o.y = pk2(q[2] * rq * gq.z, q[3] * rq * gq.w);
        *(u32x2*)(CQ + (size_t)t * 256 + 4 * lane) = o;
        o.x = pk2(k[0] * rk * gk.x, k[1] * rk * gk.y); o.y = pk2(k[2] * rk * gk.z, k[3] * rk * gk.w);
        *(u32x2*)(CKV + (size_t)t * 256 + 4 * lane) = o;
    }
}
__device__ __forceinline__ unsigned fkey(float f) { const unsigned u = __float_as_uint(f); return (u & 0x80000000u) ? ~u : (u | 0x80000000u); }

__device__ __forceinline__ void phase_index(const Params& P, unsigned char* lds) {
    const bf16_t* Z1 = (const bf16_t*)(P.ws + WS_Z1); unsigned short* SEL = (unsigned short*)(P.ws + WS_SEL);
    float* sc = (float*)lds;
    float* qf = sc + 8192;
    float* wf = qf + 512;
    int* hist = (int*)(wf + 8);
    int* misc = hist + 256;
    int* seg = misc + 8;
    const int tid = threadIdx.x;
    for (int t = blockIdx.x; t < NTOK; t += gridDim.x) {
        const int b = t >> 13, tl = t & (SEQ - 1), n = tl + 1;
        unsigned short* so = SEL + (size_t)t * TOPK;
        if (n <= TOPK) { if (tid < n) so[tid] = (unsigned short)tid; continue; }
        qf[tid] = bf2f(Z1[(size_t)t * Z1W + 512 + tid]);
        if (tid < 8) wf[tid] = bf2f(Z1[(size_t)t * Z1W + 1088 + tid]);
        __syncthreads();
        for (int s = tid; s < n; s += NT) {
            const bf16_t* kr = Z1 + ((size_t)b * SEQ + s) * Z1W + 1024;
            float k[64];
#pragma unroll
            for (int q = 0; q < 8; ++q) { const u32x4 v = *(const u32x4*)(kr + q * 8);
                k[q * 8] = bflo(v.x); k[q * 8 + 1] = bfhi(v.x); k[q * 8 + 2] = bflo(v.y); k[q * 8 + 3] = bfhi(v.y);
                k[q * 8 + 4] = bflo(v.z); k[q * 8 + 5] = bfhi(v.z); k[q * 8 + 6] = bflo(v.w); k[q * 8 + 7] = bfhi(v.w); }
            float I = 0.f;
#pragma unroll
            for (int h = 0; h < 8; ++h) { float d = 0.f;
#pragma unroll
                for (int dd = 0; dd < 64; ++dd) d += qf[h * 64 + dd] * k[dd];
                I += wf[h] * fmaxf(d, 0.f); }
            sc[s] = I;
        }
        if (tid == 0) { misc[0] = 0; misc[1] = TOPK; misc[2] = 0; }
        __syncthreads();
        for (int pass = 0; pass < 4; ++pass) {
            const int shift = 24 - 8 * pass;
            if (tid < 256) hist[tid] = 0;
            __syncthreads();
            const unsigned prefix = (unsigned)misc[0]; const int kk = misc[1];
            for (int s = tid; s < n; s += NT) { const unsigned key = fkey(sc[s]);
                if (pass == 0 || (key >> (shift + 8)) == prefix) atomicAdd(&hist[(key >> shift) & 255], 1); }
            __syncthreads();
            if (tid == 0) { int a = 0, bsel = 0; for (int bin = 255; bin >= 0; --bin) { const int c = hist[bin]; if (a + c >= kk) { bsel = bin; break; } a += c; }
                misc[0] = (int)((prefix << 8) | (unsigned)bsel); misc[1] = kk - a; }
            __syncthreads();
        }
        const unsigned T = (unsigned)misc[0]; const int keq = misc[1];
        for (int s = tid; s < n; s += NT) if (fkey(sc[s]) > T) { const int o = atomicAdd(&misc[2], 1); so[o] = (unsigned short)s; }
        const int per = (n + NT - 1) / NT, s0 = tid * per, s1 = min(n, s0 + per);
        int ce = 0;
        for (int s = s0; s < s1; ++s) ce += (fkey(sc[s]) == T) ? 1 : 0;
        seg[tid] = ce;
        __syncthreads();
        if (tid == 0) { int a = 0; for (int i = 0; i < NT; ++i) { const int c = seg[i]; seg[i] = a; a += c; } }
        __syncthreads();
        const int ngt = TOPK - keq;
        int r = seg[tid];
        for (int s = s0; s < s1 && r < keq; ++s) if (fkey(sc[s]) == T) { so[ngt + r] = (unsigned short)s; ++r; }
        __syncthreads();
    }
}
__device__ __forceinline__ void phase_sparse_attn(const Params& P, unsigned char* lds) {
    bf16_t* QA = (bf16_t*)(P.ws + WS_QA); const bf16_t* CKV = (const bf16_t*)(P.ws + WS_CKV); const unsigned short* SEL = (const unsigned short*)(P.ws + WS_SEL);
    float* qa = (float*)lds;
    float* lgt = qa + 4096;
    int* sel = (int*)(lgt + 4096);
    const int tid = threadIdx.x, lane = tid & 63, wave = tid >> 6;
    for (int t = blockIdx.x; t < NTOK; t += gridDim.x) {
        const int b = t >> 13, tl = t & (SEQ - 1), ns = min(tl + 1, TOPK);
        { const u32x4 v = *(const u32x4*)(QA + (size_t)t * 4096 + tid * 8); float* q = qa + tid * 8;
          q[0] = bflo(v.x); q[1] = bfhi(v.x); q[2] = bflo(v.y); q[3] = bfhi(v.y); q[4] = bflo(v.z); q[5] = bfhi(v.z); q[6] = bflo(v.w); q[7] = bfhi(v.w); }
        if (tid < TOPK) sel[tid] = (tid < ns) ? (int)SEL[(size_t)t * TOPK + tid] : 0;
        __syncthreads();
        const int k = tid & 255, hg = tid >> 8;
        {
            float acc[8];
#pragma unroll
            for (int h = 0; h < 8; ++h) acc[h] = 0.f;
            if (k < ns) {
                const bf16_t* cr = CKV + ((size_t)b * SEQ + sel[k]) * 256;
                for (int c8 = 0; c8 < 256; c8 += 8) {
                    const u32x4 v = *(const u32x4*)(cr + c8);
                    const float cv[8] = {bflo(v.x), bfhi(v.x), bflo(v.y), bfhi(v.y), bflo(v.z), bfhi(v.z), bflo(v.w), bfhi(v.w)};
#pragma unroll
                    for (int h = 0; h < 8; ++h) { const float* q = qa + (hg * 8 + h) * 256 + c8;
#pragma unroll
                        for (int j = 0; j < 8; ++j) acc[h] += q[j] * cv[j]; }
                }
            }
#pragma unroll
            for (int h = 0; h < 8; ++h) { const int hh = hg * 8 + h; const float slope = exp2f(-0.5f * (float)(hh + 1));
                lgt[hh * 256 + k] = (k < ns) ? (acc[h] - slope * (float)(tl - sel[k])) : -INFINITY; }
        }
        __syncthreads();
        for (int hh = wave * 2; hh < wave * 2 + 2; ++hh) {
            float* row = lgt + hh * 256;
            float x[4]; float m = -INFINITY;
#pragma unroll
            for (int j = 0; j < 4; ++j) { x[j] = row[lane + 64 * j]; m = fmaxf(m, x[j]); }
            m = wave_max(m); float s = 0.f;
#pragma unroll
            for (int j = 0; j < 4; ++j) { x[j] = __expf(x[j] - m); s += x[j]; }
            s = wave_sum(s); const float inv = 1.0f / s;
#pragma unroll
            for (int j = 0; j < 4; ++j) row[lane + 64 * j] = x[j] * inv;
        }
        __syncthreads();
        {
            const int c = tid & 255;
            float acc[8];
#pragma unroll
            for (int h = 0; h < 8; ++h) acc[h] = 0.f;
            const bf16_t* cb = CKV + (size_t)b * SEQ * 256 + c;
            for (int kk = 0; kk < ns; ++kk) {
                const float cv = bf2f(cb[(size_t)sel[kk] * 256]);
#pragma unroll
                for (int h = 0; h < 8; ++h) acc[h] += lgt[(hg * 8 + h) * 256 + kk] * cv;
            }
#pragma unroll
            for (int h = 0; h < 8; ++h) QA[(size_t)t * 4096 + (hg * 8 + h) * 256 + c] = (bf16_t)f2bf(acc[h]);
        }
        __syncthreads();
    }
}

constexpr int NPH_TOTAL = 23;


typedef short v4i16_t __attribute__((ext_vector_type(4)));
__device__ __forceinline__ void phase_sparse_attn_mfma(const Params& P, unsigned char* lds_) {
    using pg8::bf16x8;
    bf16_t* QA = (bf16_t*)(P.ws + WS_QA); const unsigned char* CKV = (const unsigned char*)(P.ws + WS_CKV); const unsigned short* SEL = (const unsigned short*)(P.ws + WS_SEL);
    const int tid = threadIdx.x, lane = tid & 63, wave = __builtin_amdgcn_readfirstlane(tid >> 6);
    const int fr = lane & 15, fq = lane >> 4;
    LAS unsigned char* cbuf = (LAS unsigned char*)lds_ + wave * 16896;
    LAS unsigned short* selw = (LAS unsigned short*)(cbuf + 16384);
    const int G = gridDim.x, NGW = G * NWAVE;
    int vw;
    if ((G & 7) == 0) vw = (((int)blockIdx.x & 7) * (G >> 3) + ((int)blockIdx.x >> 3)) * NWAVE + wave; else vw = (int)blockIdx.x * NWAVE + wave;
    const float LOG2E = 1.4426950408889634f;
    const float slope2 = exp2f(-0.5f * (float)(fr + 1)) * LOG2E;
    unsigned qoffB[4];
#pragma unroll
    for (int e = 0; e < 4; ++e) { const int key7 = (2 * e + (lane >> 5)) & 7; qoffB[e] = (unsigned)(((lane & 31) ^ (key7 << 1)) << 4); }
    const int rowA = fr;
    const unsigned swzA = (unsigned)((rowA & 7) << 1);
    const int rowT = 4 * fq + (fr >> 2);
    const unsigned swzT = (unsigned)((rowT & 7) << 1), pbT = (unsigned)((fr & 3) >> 1), halfT = (unsigned)(fr & 1) * 8u;
    const int per = NGW >> 2, bq = vw / per, wb = vw % per;
    for (int tl0 = wb; tl0 < SEQ; tl0 += per) {
        const int t = bq * SEQ + tl0;
        const int b = t >> 13, tl = t & (SEQ - 1), ns = min(tl + 1, TOPK), nch = (ns + 31) >> 5;
        {
            const u32x2 w = *(const u32x2*)(SEL + (size_t)t * TOPK + 4 * lane);
            unsigned short i0 = (unsigned short)(w.x & 0xffffu), i1 = (unsigned short)(w.x >> 16), i2 = (unsigned short)(w.y & 0xffffu), i3 = (unsigned short)(w.y >> 16);
            const int k0 = 4 * lane;
            if (k0 >= ns) i0 = 0; if (k0 + 1 >= ns) i1 = 0; if (k0 + 2 >= ns) i2 = 0; if (k0 + 3 >= ns) i3 = 0;
            u32x2 o; o.x = (unsigned)i0 | ((unsigned)i1 << 16); o.y = (unsigned)i2 | ((unsigned)i3 << 16);
            *(LAS u32x2*)(selw + 4 * lane) = o;
        }
        bf16x8 qf[8];
#pragma unroll
        for (int cc = 0; cc < 8; ++cc) qf[cc] = *(const bf16x8*)(QA + (size_t)t * 4096 + fr * 256 + 32 * cc + 8 * fq);
        f32x4 O[16];
#pragma unroll
        for (int ct = 0; ct < 16; ++ct) O[ct] = (f32x4){0.f, 0.f, 0.f, 0.f};
        float m = -INFINITY, l = 0.f;
        const unsigned char* cb = CKV + (size_t)b * SEQ * 512;
        for (int j = 0; j < nch; ++j) {
            asm volatile("s_waitcnt lgkmcnt(0)" ::: "memory");
#pragma unroll
            for (int e = 0; e < 16; ++e) {
                const unsigned idx = selw[32 * j + 2 * e + (lane >> 5)];
                __builtin_amdgcn_global_load_lds((const unsigned*)(cb + (size_t)idx * 512 + qoffB[e & 3]), (LAS unsigned*)(cbuf + e * 1024), 16, 0, 0);
            }
            asm volatile("s_waitcnt vmcnt(0)" ::: "memory");
            f32x4 s0 = {0.f, 0.f, 0.f, 0.f}, s1 = {0.f, 0.f, 0.f, 0.f};
#pragma unroll
            for (int cc = 0; cc < 8; ++cc) {
                const unsigned ch = (((unsigned)(4 * cc + fq)) ^ swzA) << 4;
                const bf16x8 a0 = *(const LAS bf16x8*)(cbuf + rowA * 512 + ch);
                const bf16x8 a1 = *(const LAS bf16x8*)(cbuf + (16 + rowA) * 512 + ch);
                s0 = __builtin_amdgcn_mfma_f32_16x16x32_bf16(a0, qf[cc], s0, 0, 0, 0);
                s1 = __builtin_amdgcn_mfma_f32_16x16x32_bf16(a1, qf[cc], s1, 0, 0, 0);
            }
            const u32x2 k0w = *(const LAS u32x2*)(selw + 32 * j + 4 * fq), k1w = *(const LAS u32x2*)(selw + 32 * j + 16 + 4 * fq);
            const int kb0 = 32 * j + 4 * fq, kb1 = kb0 + 16;
            float lg[8];
            {
                const int i00 = (int)(k0w.x & 0xffffu), i01 = (int)(k0w.x >> 16), i02 = (int)(k0w.y & 0xffffu), i03 = (int)(k0w.y >> 16);
                const int i10 = (int)(k1w.x & 0xffffu), i11 = (int)(k1w.x >> 16), i12 = (int)(k1w.y & 0xffffu), i13 = (int)(k1w.y >> 16);
                lg[0] = (kb0 + 0 < ns) ? s0.x * LOG2E - slope2 * (float)(tl - i00) : -INFINITY;
                lg[1] = (kb0 + 1 < ns) ? s0.y * LOG2E - slope2 * (float)(tl - i01) : -INFINITY;
                lg[2] = (kb0 + 2 < ns) ? s0.z * LOG2E - slope2 * (float)(tl - i02) : -INFINITY;
                lg[3] = (kb0 + 3 < ns) ? s0.w * LOG2E - slope2 * (float)(tl - i03) : -INFINITY;
                lg[4] = (kb1 + 0 < ns) ? s1.x * LOG2E - slope2 * (float)(tl - i10) : -INFINITY;
                lg[5] = (kb1 + 1 < ns) ? s1.y * LOG2E - slope2 * (float)(tl - i11) : -INFINITY;
                lg[6] = (kb1 + 2 < ns) ? s1.z * LOG2E - slope2 * (float)(tl - i12) : -INFINITY;
                lg[7] = (kb1 + 3 < ns) ? s1.w * LOG2E - slope2 * (float)(tl - i13) : -INFINITY;
            }
            float cm = fmaxf(fmaxf(fmaxf(lg[0], lg[1]), fmaxf(lg[2], lg[3])), fmaxf(fmaxf(lg[4], lg[5]), fmaxf(lg[6], lg[7])));
            cm = fmaxf(cm, __shfl_xor(cm, 16)); cm = fmaxf(cm, __shfl_xor(cm, 32));
            const float mn = fmaxf(m, cm);
            if (__any(mn > m)) {
                const float sc = exp2f(m - mn);
                l *= sc;
#pragma unroll
                for (int ct = 0; ct < 16; ++ct) O[ct] *= sc;
                m = mn;
            }
            float p[8]; float ps = 0.f;
#pragma unroll
            for (int i = 0; i < 8; ++i) { p[i] = exp2f(lg[i] - m); ps += p[i]; }
            l += ps;
            u32x4 pw; pw.x = pk2(p[0], p[1]); pw.y = pk2(p[2], p[3]); pw.z = pk2(p[4], p[5]); pw.w = pk2(p[6], p[7]);
            const bf16x8 pk = __builtin_bit_cast(bf16x8, pw);
#pragma unroll
            for (int ct = 0; ct < 16; ++ct) {
                const unsigned ch = ((((unsigned)(2 * ct)) ^ swzT) | pbT) << 4;
                const v4i16_t lo = __builtin_amdgcn_ds_read_tr16_b64_v4i16((LAS v4i16_t*)(cbuf + rowT * 512 + ch + halfT));
                const v4i16_t hi = __builtin_amdgcn_ds_read_tr16_b64_v4i16((LAS v4i16_t*)(cbuf + (16 + rowT) * 512 + ch + halfT));
                const bf16x8 a = {lo[0], lo[1], lo[2], lo[3], hi[0], hi[1], hi[2], hi[3]};
                O[ct] = __builtin_amdgcn_mfma_f32_16x16x32_bf16(a, pk, O[ct], 0, 0, 0);
            }
        }
        l += __shfl_xor(l, 16); l += __shfl_xor(l, 32);
        const float inv = 1.0f / l;
        bf16_t* orow = QA + (size_t)t * 4096 + fr * 256 + 4 * fq;
#pragma unroll
        for (int ct = 0; ct < 16; ++ct) { u32x2 w; w.x = pk2(O[ct].x * inv, O[ct].y * inv); w.y = pk2(O[ct].z * inv, O[ct].w * inv); *(u32x2*)(orow + 16 * ct) = w; }
    }
}


constexpr size_t SC_BATCH = (size_t)1024 * 256 * 257 / 2;
__device__ __forceinline__ size_t sc_row_off(int b, int tl) { const size_t m = (size_t)(tl >> 5); return (size_t)b * SC_BATCH + 1024 * (m * (m + 1) / 2) + (size_t)(tl & 31) * 32 * (m + 1); }
typedef float f32x16 __attribute__((ext_vector_type(16)));
__device__ __forceinline__ unsigned okey_pk(float a, float b) {
    const unsigned w = __builtin_bit_cast(unsigned, __builtin_amdgcn_cvt_pkrtz(a, b));
    const unsigned neg = (w >> 15) & 0x00010001u;
    return w ^ ((neg * 0xffffu) | 0x80008000u);
}
__device__ __forceinline__ void phase_index_scores(const Params& P, unsigned char* lds_) {
    using pg8::bf16x8;
    const bf16_t* Z1 = (const bf16_t*)(P.ws + WS_Z1); unsigned short* SC = (unsigned short*)(P.ws + WS_SC);
    LAS unsigned char* lds = (LAS unsigned char*)lds_;
    constexpr int QROW = 144;
    LAS unsigned char* QL = lds;
    LAS float* SG = (LAS float*)(lds + 9 * 64 * QROW);
    const int tid = threadIdx.x, lane = tid & 63, wave = __builtin_amdgcn_readfirstlane(tid >> 6);
    LAS unsigned char* ST = lds + 9 * 64 * QROW + 2048 + wave * 5120;
    const int l31 = lane & 31, hh = lane >> 5;
    for (int pid = blockIdx.x; pid < 256; pid += gridDim.x) {
        const int b = pid >> 6;
        for (int side = 0; side < 2; ++side) {
            const int qb = side ? (127 - (pid & 63)) : (pid & 63);
            const int q0 = qb * 64;
            __syncthreads();
            {
                const int qi = tid >> 3, part = tid & 7;
                const bf16_t* zr = Z1 + ((size_t)b * SEQ + q0 + qi) * Z1W;
                const u32x4 ww = *(const u32x4*)(zr + 1088);
                const float w8[8] = {bflo(ww.x), bfhi(ww.x), bflo(ww.y), bfhi(ww.y), bflo(ww.z), bfhi(ww.z), bflo(ww.w), bfhi(ww.w)};
                float wh = 0.f;
#pragma unroll
                for (int h = 0; h < 8; ++h) wh = (h == part) ? w8[h] : wh;
                const float sc = 0.5f * fabsf(wh);
                SG[qi * 8 + part] = (wh >= 0.f) ? 1.0f : -1.0f;
#pragma unroll
                for (int c = 0; c < 8; ++c) {
                    const u32x4 v = *(const u32x4*)(zr + 512 + part * 64 + c * 8);
                    u32x4 o; o.x = pk2(bflo(v.x) * sc, bfhi(v.x) * sc); o.y = pk2(bflo(v.y) * sc, bfhi(v.y) * sc); o.z = pk2(bflo(v.z) * sc, bfhi(v.z) * sc); o.w = pk2(bflo(v.w) * sc, bfhi(v.w) * sc);
                    *(LAS u32x4*)(QL + (part * 64 + qi) * QROW + c * 16) = o;
                }
                float a8[8];
#pragma unroll
                for (int j = 0; j < 8; ++j) a8[j] = 0.f;
#pragma unroll
                for (int h = 0; h < 8; ++h) {
                    const u32x4 v = *(const u32x4*)(zr + 512 + h * 64 + part * 8); const float s2 = 0.5f * w8[h];
                    a8[0] += s2 * bflo(v.x); a8[1] += s2 * bfhi(v.x); a8[2] += s2 * bflo(v.y); a8[3] += s2 * bfhi(v.y);
                    a8[4] += s2 * bflo(v.z); a8[5] += s2 * bfhi(v.z); a8[6] += s2 * bflo(v.w); a8[7] += s2 * bfhi(v.w);
                }
                u32x4 o; o.x = pk2(a8[0], a8[1]); o.y = pk2(a8[2], a8[3]); o.z = pk2(a8[4], a8[5]); o.w = pk2(a8[6], a8[7]);
                *(LAS u32x4*)(QL + (8 * 64 + qi) * QROW + part * 16) = o;
            }
            __syncthreads();
            const int ktmax = 2 * qb + 1;
            for (int kt = wave; kt <= ktmax; kt += NWAVE) {
                bf16x8 kf[4];
                const bf16_t* kr = Z1 + ((size_t)b * SEQ + kt * 32 + l31) * Z1W + 1024 + hh * 8;
#pragma unroll
                for (int dq = 0; dq < 4; ++dq) kf[dq] = *(const bf16x8*)(kr + dq * 16);
#pragma unroll
                for (int qs = 0; qs < 2; ++qs) {
                    const LAS unsigned char* qrow = QL + (qs * 32 + l31) * QROW + hh * 16;
                    f32x16 acc;
#pragma unroll
                    for (int r = 0; r < 16; ++r) acc[r] = 0.f;
#pragma unroll
                    for (int dq = 0; dq < 4; ++dq) acc = __builtin_amdgcn_mfma_f32_32x32x16_bf16(kf[dq], *(const LAS bf16x8*)(qrow + 8 * 64 * QROW + dq * 32), acc, 0, 0, 0);
#pragma unroll
                    for (int h = 0; h < 8; ++h) {
                        f32x16 u;
#pragma unroll
                        for (int r = 0; r < 16; ++r) u[r] = 0.f;
#pragma unroll
                        for (int dq = 0; dq < 4; ++dq) u = __builtin_amdgcn_mfma_f32_32x32x16_bf16(kf[dq], *(const LAS bf16x8*)(qrow + h * 64 * QROW + dq * 32), u, 0, 0, 0);
                        const float sg = SG[(qs * 32 + l31) * 8 + h];
#pragma unroll
                        for (int r = 0; r < 16; ++r) acc[r] = fmaf(fabsf(u[r]), sg, acc[r]);
                    }
#pragma unroll
                    for (int g = 0; g < 4; ++g) { u32x2 w; w.x = okey_pk(acc[4 * g], acc[4 * g + 1]); w.y = okey_pk(acc[4 * g + 2], acc[4 * g + 3]);
                        *(LAS u32x2*)(ST + (qs * 32 + l31) * 80 + (8 * g + 4 * hh) * 2) = w; }
                }
#pragma unroll
                for (int i = 0; i < 4; ++i) {
                    const int row = 16 * i + (lane >> 2), ch = lane & 3, tl = q0 + row;
                    const u32x4 v = *(const LAS u32x4*)(ST + row * 80 + ch * 16);
                    if (kt <= (tl >> 5)) *(u32x4*)(SC + sc_row_off(b, tl) + (size_t)kt * 32 + ch * 8) = v;
                }
            }
        }
    }
}
__device__ __forceinline__ void phase_index_select(const Params& P, unsigned char* lds_) {
    const unsigned short* SC = (const unsigned short*)(P.ws + WS_SC); unsigned short* SEL = (unsigned short*)(P.ws + WS_SEL);
    const int tid = threadIdx.x, lane = tid & 63, wave = __builtin_amdgcn_readfirstlane(tid >> 6);
    LAS unsigned* hist = (LAS unsigned*)lds_ + wave * 1280;
    LAS unsigned short* outw = (LAS unsigned short*)(hist + 1024);
    const int gw = blockIdx.x * NWAVE + wave, NGW = gridDim.x * NWAVE;
    for (int t = gw; t < NTOK; t += NGW) {
        const int b = t >> 13, tl = t & (SEQ - 1), n = tl + 1;
        unsigned short* so = SEL + (size_t)t * TOPK;
        if (n <= TOPK) { for (int i = lane; i < n; i += 64) so[i] = (unsigned short)i; continue; }
        const u32x4* row = (const u32x4*)(SC + sc_row_off(b, tl));
        u32x4 d[16];
#pragma unroll
        for (int sg = 0; sg < 16; ++sg) { if (sg * 512 < n) d[sg] = row[sg * 64 + lane]; else d[sg] = (u32x4){0u, 0u, 0u, 0u}; }
#pragma unroll
        for (int i = 0; i < 16; ++i) { hist[i * 64 + lane] = 0u; }
        asm volatile("s_waitcnt lgkmcnt(0)" ::: "memory");
#define KEY_OF(sg, j) ((((j) & 1) ? (d[sg][(j) >> 1] >> 16) : (d[sg][(j) >> 1] & 0xffffu)))
#define IDX_OF(sg, j) ((sg) * 512 + lane * 8 + (j))
        LAS unsigned* myh = hist + (lane & 3) * 256;
#pragma unroll
        for (int sg = 0; sg < 16; ++sg) if (sg * 512 < n) {
#pragma unroll
            for (int j = 0; j < 8; ++j) { const unsigned k = KEY_OF(sg, j); if (IDX_OF(sg, j) < n) atomicAdd((unsigned*)(myh + (k >> 8)), 1u); }
        }
        asm volatile("s_waitcnt lgkmcnt(0)" ::: "memory");
        unsigned b1, need1;
        {
            unsigned c[4];
#pragma unroll
            for (int q = 0; q < 4; ++q) c[q] = hist[4 * lane + q] + hist[256 + 4 * lane + q] + hist[512 + 4 * lane + q] + hist[768 + 4 * lane + q];
            const unsigned mine = c[0] + c[1] + c[2] + c[3];
            unsigned suf = mine;
#pragma unroll
            for (int o = 1; o < 64; o <<= 1) { const unsigned v = __shfl_down(suf, o); if (lane + o < 64) suf += v; }
            const unsigned above = suf - mine;
            int fb = -1; unsigned fneed = 0;
            if (above < (unsigned)TOPK && suf >= (unsigned)TOPK) { unsigned a = above;
#pragma unroll
                for (int q = 3; q >= 0; --q) { if (fb < 0 && a + c[q] >= (unsigned)TOPK) { fb = 4 * lane + q; fneed = (unsigned)TOPK - a; } a += c[q]; } }
            const unsigned long long bal = __ballot(fb >= 0);
            const int src = (int)__builtin_ctzll(bal);
            b1 = (unsigned)__shfl(fb, src); need1 = __shfl(fneed, src);
        }
#pragma unroll
        for (int i = 0; i < 16; ++i) { hist[i * 64 + lane] = 0u; }
        asm volatile("s_waitcnt lgkmcnt(0)" ::: "memory");
#pragma unroll
        for (int sg = 0; sg < 16; ++sg) if (sg * 512 < n) {
#pragma unroll
            for (int j = 0; j < 8; ++j) { const unsigned k = KEY_OF(sg, j); if (IDX_OF(sg, j) < n && (k >> 8) == b1) atomicAdd((unsigned*)(myh + (k & 255u)), 1u); }
        }
        asm volatile("s_waitcnt lgkmcnt(0)" ::: "memory");
        unsigned T, need2;
        {
            unsigned c[4];
#pragma unroll
            for (int q = 0; q < 4; ++q) c[q] = hist[4 * lane + q] + hist[256 + 4 * lane + q] + hist[512 + 4 * lane + q] + hist[768 + 4 * lane + q];
            const unsigned mine = c[0] + c[1] + c[2] + c[3];
            unsigned suf = mine;
#pragma unroll
            for (int o = 1; o < 64; o <<= 1) { const unsigned v = __shfl_down(suf, o); if (lane + o < 64) suf += v; }
            const unsigned above = suf - mine;
            int fb = -1; unsigned fneed = 0;
            if (above < need1 && suf >= need1) { unsigned a = above;
#pragma unroll
                for (int q = 3; q >= 0; --q) { if (fb < 0 && a + c[q] >= need1) { fb = 4 * lane + q; fneed = need1 - a; } a += c[q]; } }
            const unsigned long long bal = __ballot(fb >= 0);
            const int src = (int)__builtin_ctzll(bal);
            T = (b1 << 8) | (unsigned)__shfl(fb, src); need2 = __shfl(fneed, src);
        }
        unsigned base = 0; const unsigned ngt = (unsigned)TOPK - need2; unsigned eqbase = 0;
#pragma unroll
        for (int sg = 0; sg < 16; ++sg) if (sg * 512 < n) {
            unsigned ce = 0;
#pragma unroll
            for (int j = 0; j < 8; ++j) {
                const unsigned k = KEY_OF(sg, j); const bool ok = IDX_OF(sg, j) < n;
                const bool gt = ok && k > T;
                const unsigned long long mk = __ballot(gt);
                if (gt) outw[base + (unsigned)__builtin_amdgcn_mbcnt_hi((unsigned)(mk >> 32), __builtin_amdgcn_mbcnt_lo((unsigned)mk, 0u))] = (unsigned short)IDX_OF(sg, j);
                base += (unsigned)__builtin_popcountll(mk);
                ce += (ok && k == T) ? 1u : 0u;
            }
            if (__any(ce > 0u)) {
                unsigned pre = ce;
#pragma unroll
                for (int o = 1; o < 64; o <<= 1) { const unsigned v = __shfl_up(pre, o); if (lane >= o) pre += v; }
                unsigned r = eqbase + pre - ce;
#pragma unroll
                for (int j = 0; j < 8; ++j) { const unsigned k = KEY_OF(sg, j); if (IDX_OF(sg, j) < n && k == T) { if (r < need2) outw[ngt + r] = (unsigned short)IDX_OF(sg, j); ++r; } }
                eqbase += __shfl(pre, 63);
            }
        }
#undef KEY_OF
#undef IDX_OF
        asm volatile("s_waitcnt lgkmcnt(0)" ::: "memory");
        ((unsigned*)so)[lane] = ((LAS unsigned*)outw)[lane];
        ((unsigned*)so)[64 + lane] = ((LAS unsigned*)outw)[64 + lane];
        asm volatile("s_waitcnt lgkmcnt(0)" ::: "memory");
    }
}


__device__ __forceinline__ void ret_fill_image(LAS unsigned char* img, const unsigned char* src, size_t row_stride_bytes, int wave, int lane) {
#pragma unroll
    for (int e4 = 0; e4 < 4; ++e4) {
        const int e = wave * 4 + e4, row = 4 * e + (lane >> 4), q = (lane & 15) ^ ((row & 7) << 1);
        __builtin_amdgcn_global_load_lds((const unsigned*)(src + (size_t)row * row_stride_bytes + q * 16), (LAS unsigned*)(img + e * 1024), 16, 0, 0);
    }
}
__device__ __forceinline__ pg8::bf16x8 ret_tr_pair(const LAS unsigned char* img, int row0, int chunk2, int lane) {
    const int g = lane >> 4, i = lane & 15, r0 = row0 + 4 * g + (i >> 2), pb = (i & 3) >> 1, half = (i & 1) * 8;
    const int r1 = r0 + 16;
    const v4i16_t lo = __builtin_amdgcn_ds_read_tr16_b64_v4i16((LAS v4i16_t*)(img + r0 * 256 + ((((chunk2) ^ ((r0 & 7) << 1)) | pb) << 4) + half));
    const v4i16_t hi = __builtin_amdgcn_ds_read_tr16_b64_v4i16((LAS v4i16_t*)(img + r1 * 256 + ((((chunk2) ^ ((r1 & 7) << 1)) | pb) << 4) + half));
    return (pg8::bf16x8){lo[0], lo[1], lo[2], lo[3], hi[0], hi[1], hi[2], hi[3]};
}
__device__ __forceinline__ void phase_ret_kv_mfma(const Params& P, unsigned char* lds_) {
    using pg8::bf16x8;
    const unsigned char* Z0 = (const unsigned char*)(P.ws + WS_Z0); float* KV = (float*)(P.ws + WS_KV);
    LAS unsigned char* Kimg = (LAS unsigned char*)lds_; LAS unsigned char* Vimg = Kimg + 32768;
    const int tid = threadIdx.x, lane = tid & 63, wave = __builtin_amdgcn_readfirstlane(tid >> 6), fr = lane & 15, fq = lane >> 4;
    for (int u = blockIdx.x; u < 1024; u += gridDim.x) {
        const int n = u & 63, h = (u >> 6) & 3, b = u >> 8;
        const size_t row0 = (size_t)b * SEQ + n * 128;
        __syncthreads();
        ret_fill_image(Kimg, Z0 + row0 * ZW * 2 + (512 + h * 128) * 2, ZW * 2, wave, lane);
        ret_fill_image(Vimg, Z0 + row0 * ZW * 2 + (1024 + h * 128) * 2, ZW * 2, wave, lane);
        asm volatile("s_waitcnt vmcnt(0)" ::: "memory");
        __syncthreads();
        bf16x8 va[4];
#pragma unroll
        for (int jc = 0; jc < 4; ++jc) va[jc] = ret_tr_pair(Vimg, 32 * jc, 2 * wave, lane);
        const float g127 = exp2f(ret_log2g(h) * 127.0f);
        float* o = KV + (size_t)u * 16384;
#pragma unroll
        for (int dt = 0; dt < 8; ++dt) {
            f32x4 acc = {0.f, 0.f, 0.f, 0.f};
#pragma unroll
            for (int jc = 0; jc < 4; ++jc) acc = __builtin_amdgcn_mfma_f32_16x16x32_bf16(va[jc], ret_tr_pair(Kimg, 32 * jc, 2 * dt, lane), acc, 0, 0, 0);
            *(f32x4*)(o + (size_t)(16 * dt + fr) * 128 + 16 * wave + 4 * fq) = acc * g127;
        }
    }
}
__device__ __forceinline__ void phase_ret_scan_pool2(const Params& P) {
    const float* KV = (const float*)(P.ws + WS_KV); bf16_t* SB = (bf16_t*)(P.ws + WS_SB);
    const size_t gt = (size_t)blockIdx.x * NT + threadIdx.x, GS = (size_t)gridDim.x * NT;
    for (size_t i = gt; i < (size_t)16 * 4096; i += GS) {
        const int s = (int)(i >> 12), e4 = (int)(i & 4095), h = s & 3;
        const float l2 = ret_log2g(h), cd = exp2f(l2 * 128.0f), g1 = exp2f(l2);
        const f32x4* p = (const f32x4*)(KV + (size_t)s * 64 * 16384) + e4;
        u32x2* q = (u32x2*)(SB + (size_t)s * 64 * 16384) + e4;
        f32x4 R = {0.f, 0.f, 0.f, 0.f};
        for (int n0 = 0; n0 < 64; n0 += 8) {
            f32x4 kv[8];
#pragma unroll
            for (int j = 0; j < 8; ++j) kv[j] = p[(size_t)(n0 + j) * 4096];
#pragma unroll
            for (int j = 0; j < 8; ++j) { u32x2 w; w.x = pk2(R.x * g1, R.y * g1); w.y = pk2(R.z * g1, R.w * g1); q[(size_t)(n0 + j) * 4096] = w; R = R * cd + kv[j]; }
        }
    }
    const bf16_t* Z0 = (const bf16_t*)(P.ws + WS_Z0); bf16_t* DP = (bf16_t*)(P.ws + WS_DP);
    for (size_t i = gt; i < (size_t)NTOK * 64; i += GS) {
        const int t = (int)(i >> 6), c8 = (int)(i & 63) * 8, g = c8 >> 7, w = 2 << g, tl = t & (SEQ - 1);
        const int cnt = min(tl + 1, w);
        float sm[8];
#pragma unroll
        for (int j = 0; j < 8; ++j) sm[j] = 0.f;
        float u0[8];
        for (int q = 0; q < cnt; ++q) {
            const u32x4 v = *(const u32x4*)(Z0 + (size_t)(t - q) * ZW + 2048 + c8);
            const float f[8] = {bflo(v.x), bfhi(v.x), bflo(v.y), bfhi(v.y), bflo(v.z), bfhi(v.z), bflo(v.w), bfhi(v.w)};
#pragma unroll
            for (int j = 0; j < 8; ++j) { sm[j] += f[j]; if (q == 0) u0[j] = f[j]; }
        }
        const float inv = 1.0f / (float)cnt;
        u32x4 o; o.x = pk2(sm[0] * inv - u0[0], sm[1] * inv - u0[1]); o.y = pk2(sm[2] * inv - u0[2], sm[3] * inv - u0[3]);
        o.z = pk2(sm[4] * inv - u0[4], sm[5] * inv - u0[5]); o.w = pk2(sm[6] * inv - u0[6], sm[7] * inv - u0[7]);
        *(u32x4*)(DP + (size_t)t * 512 + c8) = o;
    }
}
__device__ __forceinline__ void phase_ret_out_mfma(const Params& P, unsigned char* lds_) {
    using pg8::bf16x8;
    const unsigned char* Z0 = (const unsigned char*)(P.ws + WS_Z0); const unsigned char* SB = (const unsigned char*)(P.ws + WS_SB); bf16_t* MIX = (bf16_t*)(P.ws + WS_MIX);
    const float* gn = P.in[3];
    LAS unsigned char* Kimg = (LAS unsigned char*)lds_; LAS unsigned char* Vimg = Kimg + 32768; LAS unsigned char* Rimg = Kimg + 65536;
    const int tid = threadIdx.x, lane = tid & 63, wave = __builtin_amdgcn_readfirstlane(tid >> 6), fr = lane & 15, fq = lane >> 4;
    for (int u = blockIdx.x; u < 1024; u += gridDim.x) {
        const int n = u & 63, h = (u >> 6) & 3, b = u >> 8;
        const size_t row0 = (size_t)b * SEQ + n * 128;
        __syncthreads();
        ret_fill_image(Kimg, Z0 + row0 * ZW * 2 + (512 + h * 128) * 2, ZW * 2, wave, lane);
        ret_fill_image(Vimg, Z0 + row0 * ZW * 2 + (1024 + h * 128) * 2, ZW * 2, wave, lane);
        ret_fill_image(Rimg, SB + (size_t)u * 32768, 256, wave, lane);
        const bf16_t* qrow = (const bf16_t*)Z0 + (row0 + 16 * wave + fr) * ZW + h * 128;
        bf16x8 qf[4], qr[4];
#pragma unroll
        for (int c = 0; c < 4; ++c) {
            qf[c] = *(const bf16x8*)(qrow + 32 * c + 8 * fq);
            const u32x2 a = *(const u32x2*)(qrow + 32 * c + 4 * fq), bb = *(const u32x2*)(qrow + 32 * c + 16 + 4 * fq);
            u32x4 w; w.x = a.x; w.y = a.y; w.z = bb.x; w.w = bb.y; qr[c] = __builtin_bit_cast(bf16x8, w);
        }
        asm volatile("s_waitcnt vmcnt(0)" ::: "memory");
        __syncthreads();
        f32x4 sT[8];
#pragma unroll
        for (int jt = 0; jt < 8; ++jt) sT[jt] = (f32x4){0.f, 0.f, 0.f, 0.f};
#pragma unroll
        for (int jt = 0; jt < 8; ++jt) if (jt <= wave) {
            const int r = 16 * jt + fr;
#pragma unroll
            for (int c = 0; c < 4; ++c) {
                const bf16x8 a = *(const LAS bf16x8*)(Kimg + r * 256 + ((((4 * c + fq)) ^ ((r & 7) << 1)) << 4));
                sT[jt] = __builtin_amdgcn_mfma_f32_16x16x32_bf16(a, qf[c], sT[jt], 0, 0, 0);
            }
            if (jt == wave) {
                if (4 * fq + 0 > fr) sT[jt].x = 0.f; if (4 * fq + 1 > fr) sT[jt].y = 0.f; if (4 * fq + 2 > fr) sT[jt].z = 0.f; if (4 * fq + 3 > fr) sT[jt].w = 0.f;
            }
        }
        bf16x8 pT[4];
#pragma unroll
        for (int jp = 0; jp < 4; ++jp) { u32x4 w; w.x = pk2(sT[2 * jp].x, sT[2 * jp].y); w.y = pk2(sT[2 * jp].z, sT[2 * jp].w); w.z = pk2(sT[2 * jp + 1].x, sT[2 * jp + 1].y); w.w = pk2(sT[2 * jp + 1].z, sT[2 * jp + 1].w);
            pT[jp] = __builtin_bit_cast(bf16x8, w); }
        f32x4 O[8];
#pragma unroll
        for (int vt = 0; vt < 8; ++vt) {
            f32x4 acc = {0.f, 0.f, 0.f, 0.f};
#pragma unroll
            for (int jp = 0; jp < 4; ++jp) if (2 * jp <= wave) acc = __builtin_amdgcn_mfma_f32_16x16x32_bf16(ret_tr_pair(Vimg, 32 * jp, 2 * vt, lane), pT[jp], acc, 0, 0, 0);
#pragma unroll
            for (int c = 0; c < 4; ++c) acc = __builtin_amdgcn_mfma_f32_16x16x32_bf16(ret_tr_pair(Rimg, 32 * c, 2 * vt, lane), qr[c], acc, 0, 0, 0);
            O[vt] = acc;
        }
        float sm = 0.f;
#pragma unroll
        for (int vt = 0; vt < 8; ++vt) sm += (O[vt].x + O[vt].y) + (O[vt].z + O[vt].w);
        sm += __shfl_xor(sm, 16); sm += __shfl_xor(sm, 32);
        const float mu = sm * (1.0f / 128.0f);
        float sq = 0.f;
#pragma unroll
        for (int vt = 0; vt < 8; ++vt) { const f32x4 dlt = O[vt] - mu; sq += (dlt.x * dlt.x + dlt.y * dlt.y) + (dlt.z * dlt.z + dlt.w * dlt.w); }
        sq += __shfl_xor(sq, 16); sq += __shfl_xor(sq, 32);
        const float rstd = 1.0f / sqrtf(sq * (1.0f / 128.0f) + LN_EPS);
        const bf16_t* grow = (const bf16_t*)Z0 + (row0 + 16 * wave + fr) * ZW + 1536 + h * 128 + 4 * fq;
        bf16_t* orow = MIX + (row0 + 16 * wave + fr) * DM + h * 128 + 4 * fq;
#pragma unroll
        for (int vt = 0; vt < 8; ++vt) {
            const u32x2 gv = *(const u32x2*)(grow + 16 * vt);
            const f32x4 g4 = *(const f32x4*)(gn + h * 128 + 16 * vt + 4 * fq);
            const f32x4 y = (O[vt] - mu) * rstd * g4;
            u32x2 w; w.x = pk2(y.x * silu_f(bflo(gv.x)), y.y * silu_f(bfhi(gv.x))); w.y = pk2(y.z * silu_f(bflo(gv.y)), y.w * silu_f(bfhi(gv.y)));
            *(u32x2*)(orow + 16 * vt) = w;
        }
    }
}

#define XB_TMO      128
#define XB_XCNT(j)  (256  + 64 * (j))
#define XB_XSUB(j)  (1280 + 64 * (j))
#define XB_XGEN(j)  (2304 + 64 * (j))
#define XB_TOP      3328
#define XB_TOPGEN   3392
#define XCD_BAR_WORDS 3456
#define XB_SPIN_CAP (1u << 22)
__device__ __forceinline__ unsigned xb_ld(unsigned* p)              { return __hip_atomic_load(p, __ATOMIC_RELAXED, __HIP_MEMORY_SCOPE_AGENT); }
__device__ __forceinline__ unsigned xb_add(unsigned* p, unsigned v) { return __hip_atomic_fetch_add(p, v, __ATOMIC_RELAXED, __HIP_MEMORY_SCOPE_AGENT); }
__device__ __forceinline__ unsigned xb_xcc_id() { return (unsigned)__builtin_amdgcn_s_getreg((3 << 11) | 20) & 0xFu; }
#define XB_SPIN(cond, bar) do { unsigned _sp = 0; while (cond) { __builtin_amdgcn_s_sleep(1); \
    if ((++_sp & 255u) == 0u) { if (xb_ld(&(bar)[XB_TMO])) break; if (_sp > XB_SPIN_CAP) { atomicAdd(&(bar)[XB_TMO], 1u); break; } } } } while (0)
struct XcdBarrier { unsigned* bar; unsigned x; volatile LAS unsigned* st; };
__device__ __forceinline__ XcdBarrier xcd_barrier_post(unsigned* bar, volatile LAS unsigned* st) {
    XcdBarrier b; b.bar = bar; b.x = xb_xcc_id(); b.st = st;
    if (threadIdx.x == 0) (void)xb_add(&bar[XB_XCNT(b.x)], 1u);
    return b;
}
__device__ __forceinline__ void xcd_barrier_complete(unsigned* bar, unsigned x, unsigned& nloc, unsigned& nx) {
    const unsigned G = gridDim.x * gridDim.y * gridDim.z;
    unsigned sum, cnt, mine, sp = 0u;
    for (;;) {
        sum = 0u; cnt = 0u; mine = 0u;
#pragma unroll
        for (unsigned j = 0; j < 16; ++j) { const unsigned c = xb_ld(&bar[XB_XCNT(j)]); sum += c; cnt += (c > 0u) ? 1u : 0u; mine = (j == x) ? c : mine; }
        if (sum == G) break;
        __builtin_amdgcn_s_sleep(1);
        if ((++sp & 255u) == 0u) { if (xb_ld(&bar[XB_TMO])) break; if (sp > XB_SPIN_CAP) { atomicAdd(&bar[XB_TMO], 1u); break; } }
    }
    nloc = mine > 0u ? mine : 1u; nx = cnt > 0u ? cnt : 1u;
}
__device__ __forceinline__ void xcd_barrier(const XcdBarrier& b) {
    asm volatile("s_waitcnt vmcnt(0)" ::: "memory");
    __syncthreads();
    if (threadIdx.x == 0) {
        unsigned* bar = b.bar;
        __builtin_amdgcn_s_waitcnt(0);
        unsigned nloc = b.st[0], nx = b.st[1];
        if (nloc == 0u) { xcd_barrier_complete(bar, b.x, nloc, nx); b.st[0] = nloc; b.st[1] = nx; }
        const unsigned old = xb_add(&bar[XB_XSUB(b.x)], 1u);
        const unsigned gen = old / nloc;
        if (old + 1u == (gen + 1u) * nloc) {
            __builtin_amdgcn_fence(__ATOMIC_RELEASE, "agent");
            asm volatile("s_waitcnt vmcnt(0)" ::: "memory");
            const unsigned og = xb_add(&bar[XB_TOP], 1u);
            const unsigned tg = og / nx;
            if (og + 1u == (tg + 1u) * nx) xb_add(&bar[XB_TOPGEN], 1u);
            else XB_SPIN(xb_ld(&bar[XB_TOPGEN]) == tg, bar);
            __builtin_amdgcn_fence(__ATOMIC_ACQUIRE, "agent");
            xb_add(&bar[XB_XGEN(b.x)], 1u);
            asm volatile("s_waitcnt vmcnt(0)" ::: "memory");
        } else {
            XB_SPIN(xb_ld(&bar[XB_XGEN(b.x)]) == gen, bar);
            __builtin_amdgcn_fence(__ATOMIC_ACQUIRE, "agent");
            asm volatile("s_waitcnt vmcnt(0)" ::: "memory");
        }
    }
    __syncthreads();
}
constexpr size_t CTL_BAR_OFF = 16384;
constexpr size_t CTL_ZERO_BYTES = 65536;

#ifdef PH_ONLY
#define IN(k) ((k) == PH_ONLY)
#else
#define IN(k) (lo <= (k) && (k) < hi)
#endif
#define SEAM(k) do { if (IN(k) && IN((k) + 1)) xcd_barrier(grid); } while (0)
#ifndef PROBE_DUP
#define PROBE_DUP (-1)
#endif
#define REP(k) for (int _rep = 0; _rep < ((PROBE_DUP == (k)) ? 2 : 1); ++_rep)

template <int LAYER, int BASE>
__device__ __forceinline__ void layer_tail(const Params& P, unsigned char* lds, const XcdBarrier& grid, int lo, int hi) {
    unsigned char* ws = P.ws;
    int* tb = (int*)(lds + MISC_OFF);
    if (IN(BASE)) REP(BASE) phase_ln_route(P, lds, LAYER);
    SEAM(BASE);
    if (IN(BASE + 1)) REP(BASE + 1) { moe_setup(P, tb, LAYER);
        MoeSched S{tb, (const int*)(ws + WS_CTL) + LAYER * 64, (const int*)(ws + WS_LIST), (const bf16_t*)(ws + WS_XB),
                   (const bf16_t*)(ws + WS_W_GU) + (size_t)LAYER * 32 * DM * DM, DM, (size_t)DM * DM, true};
        EpiGU E{(bf16_t*)(ws + WS_ACT)}; gemm_moe<true>(lds, S, E); }
    SEAM(BASE + 1);
    if (IN(BASE + 2)) REP(BASE + 2) { moe_setup(P, tb, LAYER);
        MoeSched S{tb, (const int*)(ws + WS_CTL) + LAYER * 64, (const int*)(ws + WS_LIST), (const bf16_t*)(ws + WS_ACT),
                   (const bf16_t*)(ws + WS_W_DN) + (size_t)LAYER * 32 * DM * 512, 512, (size_t)DM * 512, false};
        EpiDown E{(bf16_t*)(ws + WS_YS)}; gemm_moe<false>(lds, S, E); }
    SEAM(BASE + 2);
    if (IN(BASE + 3)) REP(BASE + 3) phase_ln2(P, LAYER);
    SEAM(BASE + 3);
    if (IN(BASE + 4)) REP(BASE + 4) {
        { DenseSched S{(const bf16_t*)(ws + WS_PB) + (size_t)LAYER * NTOK * 256, (const bf16_t*)(ws + WS_W_P) + (size_t)LAYER * DM * 256, NTOK, DM, 256, 256, 0};
          EpiStoreBf16 E{(bf16_t*)(ws + WS_PP), DM, 0, nullptr}; gemm_dense(lds, S, E); }
        __syncthreads();
        { DenseSched S{(const bf16_t*)(ws + WS_XB), (const bf16_t*)(ws + WS_W_G) + (size_t)LAYER * DM * DM, NTOK, DM, DM, DM, 0};
          EpiPle E{(const float*)(ws + WS_F), (const bf16_t*)(ws + WS_PP), LAYER == 1 ? P.out : (float*)(ws + WS_F), LAYER == 1 ? (bf16_t*)nullptr : (bf16_t*)(ws + WS_XB2)}; gemm_dense(lds, S, E); }
    }
}

__global__ void __launch_bounds__(NT, 2) mega(Params P, int lo, int hi) {
    extern __shared__ __attribute__((aligned(16))) unsigned char lds[];
    unsigned char* ws = P.ws;
    if (threadIdx.x < 16) ((LAS unsigned*)((LAS unsigned char*)lds + BARW_OFF))[threadIdx.x] = 0u;
    __syncthreads();
    const XcdBarrier grid = xcd_barrier_post((unsigned*)(ws + WS_CTL + CTL_BAR_OFF), (volatile LAS unsigned*)((LAS unsigned char*)lds + BARW_OFF));
    if (IN(0)) REP(0) phase_prep(P, lds);
    SEAM(0);
    if (IN(1)) REP(1) { DenseSched S{(const bf16_t*)(ws + WS_XB), (const bf16_t*)(ws + WS_W_IN0), NTOK, ZW, DM, DM, 0};
        EpiZ0 E{(bf16_t*)(ws + WS_Z0)}; gemm_dense(lds, S, E); }
    SEAM(1);
    if (IN(2)) REP(2) phase_ret_kv_mfma(P, lds);
    SEAM(2);
    if (IN(3)) REP(3) phase_ret_scan_pool2(P);
    SEAM(3);
    if (IN(4)) REP(4) { phase_ret_out_mfma(P, lds); __syncthreads();
        DenseSched S{(const bf16_t*)(ws + WS_DP), (const bf16_t*)(ws + WS_W_POOL), NTOK, 512, 256, 512, 256};
        EpiStoreBf16 E{(bf16_t*)(ws + WS_MIX), DM, 512, P.in[5]}; gemm_dense(lds, S, E); }
    SEAM(4);
    if (IN(5)) REP(5) { DenseSched S{(const bf16_t*)(ws + WS_MIX), (const bf16_t*)(ws + WS_W_OUT0), NTOK, DM, DM, DM, 0};
        EpiResid E{P.in[0], (float*)(ws + WS_F)}; gemm_dense(lds, S, E); }
    SEAM(5);
    layer_tail<0, 6>(P, lds, grid, lo, hi);
    SEAM(10);
    if (IN(11)) REP(11) { DenseSched S{(const bf16_t*)(ws + WS_XB2), (const bf16_t*)(ws + WS_W_CIN), NTOK, Z1W, DM, DM, 0};
        EpiStoreBf16 E{(bf16_t*)(ws + WS_Z1), Z1W, 0, nullptr}; gemm_dense(lds, S, E); }
    SEAM(11);
    if (IN(12)) REP(12) { phase_norms(P); phase_index_scores(P, lds); }
    SEAM(12);
    if (IN(13)) REP(13) phase_index_select(P, lds);
    SEAM(13);
    if (IN(14)) REP(14) { DenseSched S{(const bf16_t*)(ws + WS_CQ), (const bf16_t*)(ws + WS_W_QA), NTOK, 4096, 256, 256, 0};
        EpiStoreBf16 E{(bf16_t*)(ws + WS_QA), 4096, 0, nullptr}; gemm_dense(lds, S, E); }
    SEAM(14);
    if (IN(15)) REP(15) phase_sparse_attn_mfma(P, lds);
    SEAM(15);
    if (IN(16)) REP(16) { DenseSched S{(const bf16_t*)(ws + WS_QA), (const bf16_t*)(ws + WS_W_UVBD), NTOK, DM, DM, 4096, 1024};
        EpiStoreBf16 E{(bf16_t*)(ws + WS_XB), DM, 0, nullptr}; gemm_dense(lds, S, E); }
    SEAM(16);
    if (IN(17)) REP(17) { DenseSched S{(const bf16_t*)(ws + WS_XB), (const bf16_t*)(ws + WS_W_COUT), NTOK, DM, DM, DM, 0};
        EpiResid E{(const float*)(ws + WS_F), (float*)(ws + WS_F)}; gemm_dense(lds, S, E); }
    SEAM(17);
    layer_tail<1, 18>(P, lds, grid, lo, hi);
}
#undef IN
#undef SEAM

extern "C" void kernel_launch(void* const* d_in, const int* in_sizes, int n_in, void* d_out, int out_size, void* d_ws, size_t ws_size, hipStream_t stream) {
    static int grid = 0;
    if (grid == 0) {
        if (n_in != 26 || ws_size < WS_END || out_size != NTOK * DM) { fprintf(stderr, "kernel_launch: unexpected problem (n_in %d, ws %zu, out %d)\n", n_in, ws_size, out_size); grid = -1; return; }
        int dev = 0, cus = 0, per_cu = 0;
        (void)hipGetDevice(&dev);
        (void)hipDeviceGetAttribute(&cus, hipDeviceAttributeMultiprocessorCount, dev);
        (void)hipFuncSetAttribute((const void*)mega, hipFuncAttributeMaxDynamicSharedMemorySize, LDS_BYTES);
        (void)hipOccupancyMaxActiveBlocksPerMultiprocessor(&per_cu, (const void*)mega, NT, LDS_BYTES);
        if (per_cu < 1) { fprintf(stderr, "kernel_launch: occupancy query reports %d blocks per CU\n", per_cu); per_cu = 1; }
        (void)hipGetLastError();
        grid = cus;
    }
    if (grid < 0) return;
    (void)hipMemsetAsync((char*)d_ws + WS_CTL, 0, CTL_ZERO_BYTES, stream);
    Params p{};
    for (int i = 0; i < 26; ++i) p.in[i] = (const float*)d_in[i];
    p.out = (float*)d_out; p.ws = (unsigned char*)d_ws;
#if MK_ONE_LAUNCH
    int lo = 0, hi = NPH_TOTAL;
    void* args[] = {&p, &lo, &hi};
    (void)args;
    hipLaunchKernelGGL(mega, dim3(grid), dim3(NT), LDS_BYTES, stream, p, lo, hi);
    hipError_t e = hipPeekAtLastError();
    if (e != hipSuccess) fprintf(stderr, "launch failed: %s (grid %d)\n", hipGetErrorString(e), grid);
#else
    for (int k = 0; k < NPH_TOTAL; ++k) hipLaunchKernelGGL(mega, dim3(grid), dim3(NT), LDS_BYTES, stream, p, k, k + 1);
#endif
}
```

```cpp
#include <hip/hip_runtime.h>
#include <hip/hip_cooperative_groups.h>
#include <cstdio>
#include <cstdint>
namespace cg = cooperative_groups;

#ifndef PROBE_ATT
#define PROBE_ATT 0
#endif
#ifndef MK_ONE_LAUNCH
#define MK_ONE_LAUNCH 1
#endif

typedef unsigned short bf16_t;
typedef float f32x4 __attribute__((ext_vector_type(4)));
typedef unsigned u32x4 __attribute__((ext_vector_type(4)));
typedef unsigned u32x2 __attribute__((ext_vector_type(2)));

constexpr int NT = 512;
constexpr int NWAVE = NT / 64;
constexpr int NTOK = 32768, DM = 1024, SEQ = 8192, NBATCH = 4;
constexpr int ZW = 2560;
constexpr int Z1W = 1280;
constexpr int CIN = 1096;
constexpr int TOPK = 256;
constexpr float ALPHA = 1.4142135623730951f;
constexpr float LN_EPS = 1e-5f;
constexpr int LDS_BYTES = 163840;
constexpr int BARW_OFF = LDS_BYTES - 64;
constexpr int MISC_OFF = 135168;

constexpr size_t MiB = (size_t)1 << 20;
constexpr size_t WS_CTL = 0;
constexpr size_t WS_W_IN0 = 1 * MiB, WS_W_OUT0 = 6 * MiB, WS_W_POOL = 8 * MiB, WS_W_CIN = 9 * MiB, WS_W_QA = 12 * MiB,
                 WS_W_UVBD = 14 * MiB, WS_W_COUT = 16 * MiB, WS_W_G = 18 * MiB, WS_W_P = 22 * MiB, WS_W_GU = 24 * MiB, WS_W_DN = 152 * MiB;
constexpr size_t WS_XB = 224 * MiB, WS_F = 288 * MiB, WS_PB = 416 * MiB, WS_PP = 448 * MiB, WS_CQ = 512 * MiB, WS_CKV = 528 * MiB,
                 WS_SEL = 544 * MiB, WS_TOKG = 560 * MiB, WS_LIST = 561 * MiB, WS_CKV8 = 566 * MiB;
constexpr size_t WS_M0 = 576 * MiB;
constexpr size_t WS_Z0 = WS_M0, WS_KV = WS_M0 + 160 * MiB, WS_MIX = WS_M0 + 224 * MiB, WS_DP = WS_M0 + 288 * MiB, WS_SB = WS_M0 + 320 * MiB;
constexpr size_t WS_QA = WS_M0, WS_SC = WS_M0, WS_Z1 = WS_M0 + 272 * MiB;
constexpr size_t WS_ACT = WS_M0, WS_YS = WS_M0 + 72 * MiB;
constexpr size_t WS_XB2 = 928 * MiB;
constexpr size_t WS_END = 992 * MiB;
constexpr int LIST_CAP = 32768;

struct Params {
    const float* in[26];
    float* out;
    unsigned char* ws;
};

__device__ __forceinline__ unsigned f2bf(float f) { unsigned u = __float_as_uint(f); return (u + 0x7fffu + ((u >> 16) & 1u)) >> 16; }
__device__ __forceinline__ float bf2f(unsigned h) { return __uint_as_float(h << 16); }
typedef float f32x2_t __attribute__((ext_vector_type(2))); typedef __bf16 bf16x2_t __attribute__((ext_vector_type(2)));
__device__ __forceinline__ unsigned pk2(float lo, float hi) { f32x2_t v = {lo, hi}; bf16x2_t b = __builtin_convertvector(v, bf16x2_t); return __builtin_bit_cast(unsigned, b); }
__device__ __forceinline__ float bflo(unsigned w) { return __uint_as_float(w << 16); }
__device__ __forceinline__ float bfhi(unsigned w) { return __uint_as_float(w & 0xffff0000u); }
__device__ __forceinline__ float wave_sum(float v) {
#pragma unroll
    for (int o = 1; o < 64; o <<= 1) v += __shfl_xor(v, o);
    return v;
}
__device__ __forceinline__ float wave_max(float v) {
#pragma unroll
    for (int o = 1; o < 64; o <<= 1) v = fmaxf(v, __shfl_xor(v, o));
    return v;
}
__device__ __forceinline__ float silu_f(float a) { return a / (1.0f + __expf(-a)); }
__device__ __forceinline__ float sigmoid_f(float a) { return 1.0f / (1.0f + __expf(-a)); }
#define LDS_FENCE() asm volatile("s_waitcnt lgkmcnt(0)" ::: "memory")

struct UnitInfo {
    const bf16_t* A; int lda;
    const int* rows; int rshift;
    int nvalid;
    const bf16_t* Bt; int ldb;
    int K;
    int orow0;
    int pn;
};
__device__ __forceinline__ const bf16_t* unit_arow(const UnitInfo& u, int r) {
    if (u.rows) { const int idx = (r < u.nvalid) ? (u.rows[r] >> u.rshift) : 0; return u.A + (size_t)idx * u.lda; }
    return u.A + (size_t)r * u.lda;
}

struct DenseSched {
    const bf16_t* A; const bf16_t* Bt; int M, N, K, lda, a_pn_stride;
    __device__ __forceinline__ bool next(int round, UnitInfo& u) const {
        const int nN = N >> 8, nM = M >> 8, nwg = nN * nM;
        const long L = (long)round * gridDim.x + blockIdx.x; if (L >= nwg) return false;
        int wgid = (int)L; { const int q = nwg / 8, r = nwg % 8, xcd = wgid % 8, off = wgid / 8; wgid = (xcd < r ? xcd * (q + 1) : r * (q + 1) + (xcd - r) * q) + off; }
        const int nig = 8 * nN, gid = wgid / nig, fm = gid * 8, gsz = (nM - fm) < 8 ? (nM - fm) : 8;
        const int pm = fm + ((wgid % nig) % gsz), pn = (wgid % nig) / gsz;
        u.A = A + (size_t)pm * 256 * lda + (size_t)pn * a_pn_stride; u.lda = lda; u.rows = nullptr; u.rshift = 0; u.nvalid = 256;
        u.Bt = Bt + (size_t)pn * 256 * K; u.ldb = K; u.K = K; u.orow0 = pm * 256; u.pn = pn;
        return true;
    }
};
struct MoeSched {
    const int* tb; const int* cnt; const int* list;
    const bf16_t* A; const bf16_t* W; int K; size_t wstride; bool gather;
    __device__ __forceinline__ bool next(int round, UnitInfo& u) const {
        const int i = round * gridDim.x + blockIdx.x;
        const int j = i >> 2, pn = i & 3;
        if (j >= tb[32]) return false;
        int e = 0;
        while (tb[e + 1] <= j) ++e;
        const int rb = j - tb[e];
        const int nv = min(256, cnt[e] - rb * 256);
        u.rows = list + (size_t)e * LIST_CAP + rb * 256; u.nvalid = nv; u.orow0 = j * 256; u.pn = pn;
        if (gather) { u.A = A; u.lda = K; u.rshift = 1; }
        else { u.A = A + (size_t)j * 256 * K; u.lda = K; u.rshift = 31;   }
        u.Bt = W + (size_t)e * wstride + (size_t)pn * 256 * K; u.ldb = K; u.K = K;
        return true;
    }
};

template <class Sched, class Epi>
__device__ __forceinline__ void gemm_simple(unsigned char* lds, const Sched& S, const Epi& E, bool contiguousA) {
    float* As = (float*)lds;
    float* Bs = As + 128 * 33;
    const int tid = threadIdx.x, ty = tid >> 3, tx = tid & 7;
    const int lr = tid >> 2, kc = (tid & 3) * 8;
    UnitInfo u;
    for (int round = 0; S.next(round, u); ++round) {
        for (int sm = 0; sm < 2; ++sm) {
            const int ar = sm * 128 + lr;
            const bf16_t* arow = contiguousA ? (u.A + (size_t)ar * u.lda) : unit_arow(u, ar);
            for (int sn = 0; sn < 4; ++sn) {
                float acc[2][8];
#pragma unroll
                for (int a = 0; a < 2; ++a)
#pragma unroll
                    for (int b = 0; b < 8; ++b) acc[a][b] = 0.f;
                const bf16_t* brow = u.Bt + (size_t)(sn * 64 + (tid >> 2)) * u.ldb;
                for (int k0 = 0; k0 < u.K; k0 += 32) {
                    const u32x4 av = *(const u32x4*)(arow + k0 + kc);
                    float* ap = As + lr * 33 + kc;
                    ap[0] = bflo(av.x); ap[1] = bfhi(av.x); ap[2] = bflo(av.y); ap[3] = bfhi(av.y);
                    ap[4] = bflo(av.z); ap[5] = bfhi(av.z); ap[6] = bflo(av.w); ap[7] = bfhi(av.w);
                    if (tid < 256) {
                        const u32x4 bv = *(const u32x4*)(brow + k0 + kc);
                        float* bp = Bs + (tid >> 2) * 33 + kc;
                        bp[0] = bflo(bv.x); bp[1] = bfhi(bv.x); bp[2] = bflo(bv.y); bp[3] = bfhi(bv.y);
                        bp[4] = bflo(bv.z); bp[5] = bfhi(bv.z); bp[6] = bflo(bv.w); bp[7] = bfhi(bv.w);
                    }
                    __syncthreads();
#pragma unroll 8
                    for (int kk = 0; kk < 32; ++kk) {
                        const float a0 = As[(2 * ty) * 33 + kk], a1 = As[(2 * ty + 1) * 33 + kk];
#pragma unroll
                        for (int j = 0; j < 8; ++j) { const float b = Bs[(tx * 8 + j) * 33 + kk]; acc[0][j] += a0 * b; acc[1][j] += a1 * b; }
                    }
                    __syncthreads();
                }
#pragma unroll
                for (int rr = 0; rr < 2; ++rr) {
                    const f32x4 v0 = {acc[rr][0], acc[rr][1], acc[rr][2], acc[rr][3]}, v1 = {acc[rr][4], acc[rr][5], acc[rr][6], acc[rr][7]};
                    E(u, sm * 128 + 2 * ty + rr, sn * 64 + tx * 8, v0, v1);
                }
            }
        }
    }
}


namespace pg8 {
#define LAS __attribute__((address_space(3)))
typedef short bf16x8 __attribute__((ext_vector_type(8)));
constexpr int BK = 64, HALF = 128, HTB = HALF * BK * 2, STAGE_BYTES = 8 * HTB;
__device__ __forceinline__ int lds_byte(int r, int c) { const int st = (r >> 4) * 2 + (c >> 5), rr = r & 15, cc = c & 31, ob = rr * 64 + cc * 2; return st * 1024 + (ob ^ (((ob >> 9) & 1) << 5)); }
__device__ __forceinline__ void stage_rc(int b, int& R, int& C) { const int st = b / 1024, sb = b % 1024, swz = sb ^ (((sb >> 9) & 1) << 5); R = (st >> 1) * 16 + swz / 64; C = (st & 1) * 32 + (swz % 64) / 2; }
__device__ __forceinline__ int perm32(int rho) { const int n = rho >> 4, i = rho & 15; return 8 * (i >> 2) + 4 * n + (i & 3); }

template <bool GATHER, class Sched, class Epi>
__device__ __forceinline__ void gemm_phase(LAS unsigned char* lds, const LAS unsigned* rowtab, const Sched& S, const Epi& E, const int lda, const int ldb, const int K) {
    const int tid = threadIdx.x, wid = __builtin_amdgcn_readfirstlane(tid >> 6), lane = tid & 63, wr = wid >> 2, wc = wid & 3, fr = lane & 15, fq = lane >> 4;
    const int nt = K / BK;
    unsigned voffA[2], voffB[2]; int RA[2]; unsigned CA2[2];
#pragma unroll
    for (int i = 0; i < 2; ++i) { int R, C; stage_rc(tid * 16 + i * 8192, R, C); const int Rb = (R & ~31) + perm32(R & 31);
        voffA[i] = (unsigned)(R * lda + C) * 2u; voffB[i] = (unsigned)(Rb * ldb + C) * 2u; RA[i] = R; CA2[i] = (unsigned)C * 2u; }
    const size_t kstep = (size_t)(BK * 2);
    const size_t hstepA = (size_t)HALF * lda * 2, hstepB = (size_t)HALF * ldb * 2;
    const unsigned ldsw = (unsigned)wid * 1024u;
    const int aoff = lds_byte(wr * 64 + fr, fq * 8), boff = lds_byte(wc * 32 + fr, fq * 8);
    unsigned offA[2][2];
#define PG8_SA(b, h) (((b) * 2 + (h)) * HTB)
#define PG8_SB(b, h) ((4 + (b) * 2 + (h)) * HTB)
#define PG8_STAGE(bufoff, gbase, voff) do { _Pragma("unroll") for (int _i = 0; _i < 2; ++_i) \
        __builtin_amdgcn_global_load_lds((const unsigned*)((const char*)(gbase) + (voff)[_i]), (LAS unsigned*)(lds + (bufoff) + ldsw + _i * 8192), 16, 0, 0); } while (0)
#define PG8_STAGE_A(bufoff, h, gbase) do { if (GATHER) PG8_STAGE(bufoff, gbase, offA[h]); else PG8_STAGE(bufoff, (gbase) + (h) * hstepA, voffA); } while (0)
#define PG8_LOADOFF(round) do { _Pragma("unroll") for (int _h = 0; _h < 2; ++_h) _Pragma("unroll") for (int _i = 0; _i < 2; ++_i) offA[_h][_i] = rowtab[(round) * 256 + _h * 128 + RA[_i]] + CA2[_i]; } while (0)
#define PG8_LDA(dst, b, h) do { _Pragma("unroll") for (int m = 0; m < 4; ++m) _Pragma("unroll") for (int k = 0; k < 2; ++k) dst[m][k] = *(const LAS bf16x8*)(lds + PG8_SA(b, h) + aoff + m * 2048 + k * 1024); } while (0)
#define PG8_LDB(dst, b, h) do { _Pragma("unroll") for (int n = 0; n < 2; ++n) _Pragma("unroll") for (int k = 0; k < 2; ++k) dst[n][k] = *(const LAS bf16x8*)(lds + PG8_SB(b, h) + boff + n * 2048 + k * 1024); } while (0)
#define PG8_MMA(ai, bj, At, Bt) do { __builtin_amdgcn_s_setprio(1); _Pragma("unroll") for (int m = 0; m < 4; ++m) _Pragma("unroll") for (int n = 0; n < 2; ++n) _Pragma("unroll") for (int k = 0; k < 2; ++k) \
        acc[ai][bj][m][n] = __builtin_amdgcn_mfma_f32_16x16x32_bf16(Bt[n][k], At[m][k], acc[ai][bj][m][n], 0, 0, 0); __builtin_amdgcn_s_setprio(0); } while (0)
#define PG8_WAIT_V(n) asm volatile("s_waitcnt vmcnt(" #n ")" ::: "memory")
#define PG8_WAIT_L(n) asm volatile("s_waitcnt lgkmcnt(" #n ")" ::: "memory")
#define PG8_BAR __builtin_amdgcn_s_barrier()
#define PG8_SCHED __builtin_amdgcn_sched_barrier(0)
    UnitInfo cur, nxt; int ui = 0;
    if (!S.next(0, cur)) return;
    f32x4 acc[2][2][4][2];
#pragma unroll
    for (int a = 0; a < 2; ++a)
#pragma unroll
        for (int b = 0; b < 2; ++b)
#pragma unroll
            for (int m = 0; m < 4; ++m)
#pragma unroll
                for (int n = 0; n < 2; ++n) acc[a][b][m][n] = (f32x4){0.f, 0.f, 0.f, 0.f};
    bf16x8 At[4][2], B0[2][2], B1[2][2];
    const char* cA = (const char*)cur.A; const char* cB = (const char*)cur.Bt;
    if (GATHER) { PG8_LOADOFF(0); }
    PG8_STAGE(PG8_SB(0, 0), cB, voffB); PG8_STAGE(PG8_SB(0, 1), cB + hstepB, voffB); PG8_STAGE_A(PG8_SA(0, 0), 0, cA); PG8_STAGE_A(PG8_SA(0, 1), 1, cA);
    if (wr == 1) PG8_BAR;
    PG8_WAIT_V(2); PG8_BAR;
    PG8_STAGE(PG8_SB(1, 0), cB + kstep, voffB); PG8_STAGE_A(PG8_SA(1, 0), 0, cA + kstep); PG8_STAGE(PG8_SB(1, 1), cB + hstepB + kstep, voffB);
    PG8_WAIT_V(6); PG8_BAR;
    for (;;) {
        const bool has_next = S.next(ui + 1, nxt);
        const char* nA = has_next ? (const char*)nxt.A : cA; const char* nB = has_next ? (const char*)nxt.Bt : cB;
        for (int t = 0; t < nt; t += 2) {
            const bool last = (t == nt - 2);
            const char* a1 = cA + (size_t)(t + 1) * kstep;
            const char* a2 = last ? nA : cA + (size_t)(t + 2) * kstep; const char* b2 = last ? nB : cB + (size_t)(t + 2) * kstep;
            const char* a3 = a2 + kstep; const char* b3 = b2 + kstep;
            PG8_LDB(B0, 0, 0); PG8_LDB(B1, 0, 1); PG8_SCHED; PG8_LDA(At, 0, 0); PG8_STAGE_A(PG8_SA(1, 1), 1, a1);
            if (GATHER) { if (last && has_next) { PG8_LOADOFF(ui + 1); } }
            PG8_WAIT_V(8); PG8_WAIT_L(0); PG8_BAR; PG8_MMA(0, 0, At, B0); PG8_MMA(0, 1, At, B1); PG8_BAR; PG8_SCHED;
            PG8_LDA(At, 0, 1); PG8_STAGE(PG8_SB(0, 0), b2, voffB); PG8_STAGE(PG8_SB(0, 1), b2 + hstepB, voffB); PG8_STAGE_A(PG8_SA(0, 0), 0, a2);
            PG8_WAIT_V(8); PG8_WAIT_L(0); PG8_BAR; PG8_MMA(1, 0, At, B0); PG8_MMA(1, 1, At, B1); PG8_BAR; PG8_SCHED;
            PG8_LDB(B0, 1, 0); PG8_LDB(B1, 1, 1); PG8_SCHED; PG8_LDA(At, 1, 0); PG8_STAGE_A(PG8_SA(0, 1), 1, a2);
            PG8_WAIT_V(8); PG8_WAIT_L(0); PG8_BAR; PG8_MMA(0, 0, At, B0); PG8_MMA(0, 1, At, B1); PG8_BAR; PG8_SCHED;
            PG8_LDA(At, 1, 1); PG8_STAGE(PG8_SB(1, 0), b3, voffB); PG8_STAGE(PG8_SB(1, 1), b3 + hstepB, voffB); PG8_STAGE_A(PG8_SA(1, 0), 0, a3);
            PG8_WAIT_V(8); PG8_WAIT_L(0); PG8_BAR; PG8_MMA(1, 0, At, B0); PG8_MMA(1, 1, At, B1); PG8_BAR; PG8_SCHED;
        }
        if (wr == 0) PG8_BAR;
#pragma unroll
        for (int ai = 0; ai < 2; ++ai)
#pragma unroll
            for (int m = 0; m < 4; ++m)
#pragma unroll
                for (int bj = 0; bj < 2; ++bj) E(cur, ai * HALF + wr * 64 + m * 16 + fr, bj * HALF + wc * 32 + 8 * fq, acc[ai][bj][m][0], acc[ai][bj][m][1]);
        if (!has_next) break;
#pragma unroll
        for (int a = 0; a < 2; ++a)
#pragma unroll
            for (int b = 0; b < 2; ++b)
#pragma unroll
                for (int m = 0; m < 4; ++m)
#pragma unroll
                    for (int n = 0; n < 2; ++n) acc[a][b][m][n] = (f32x4){0.f, 0.f, 0.f, 0.f};
        cur = nxt; cA = nA; cB = nB; ++ui;
        if (wr == 1) PG8_BAR;
    }
    PG8_WAIT_V(0);
    PG8_BAR;
#undef PG8_SA
#undef PG8_SB
#undef PG8_STAGE
#undef PG8_STAGE_A
#undef PG8_LOADOFF
#undef PG8_LDA
#undef PG8_LDB
#undef PG8_MMA
#undef PG8_WAIT_V
#undef PG8_WAIT_L
#undef PG8_BAR
#undef PG8_SCHED
}
}

#ifndef USE_PG8_DENSE
#define USE_PG8_DENSE 1
#endif
#ifndef USE_PG8_MOE
#define USE_PG8_MOE 1
#endif
template <class Sched, class Epi>
__device__ __forceinline__ void gemm_dense(unsigned char* lds, const Sched& S, const Epi& E) {
#if USE_PG8_DENSE
    pg8::gemm_phase<false>((LAS unsigned char*)lds, (const LAS unsigned*)nullptr, S, E, S.lda, S.K, S.K);
    __syncthreads();
#else
    gemm_simple(lds, S, E, true);
#endif
}


template <bool GATHER, class Epi>
__device__ __forceinline__ void gemm_moe(unsigned char* lds, const MoeSched& S, const Epi& E) {
#if USE_PG8_MOE
    LAS unsigned* rowtab = (LAS unsigned*)(lds + MISC_OFF + 256);
    if (GATHER) {
        UnitInfo u;
        for (int round = 0; round < 10 && S.next(round, u); ++round)
            if (threadIdx.x < 256) rowtab[round * 256 + threadIdx.x] = ((int)threadIdx.x < u.nvalid) ? (unsigned)(u.rows[threadIdx.x] >> 1) * (unsigned)(S.K * 2) : 0u;
        __syncthreads();
    }
    pg8::gemm_phase<GATHER>((LAS unsigned char*)lds, (const LAS unsigned*)rowtab, S, E, S.K, S.K, S.K);
    __syncthreads();
#else
    gemm_simple(lds, S, E, !GATHER);
#endif
}

__device__ __forceinline__ u32x4 pack8(f32x4 a, f32x4 b) { u32x4 w; w.x = pk2(a.x, a.y); w.y = pk2(a.z, a.w); w.z = pk2(b.x, b.y); w.w = pk2(b.z, b.w); return w; }
struct EpiStoreBf16 {
    bf16_t* O; int ldc; int coff; const float* colscale;
    __device__ __forceinline__ void operator()(const UnitInfo& u, int r, int c, f32x4 v0, f32x4 v1) const {
        const int col = u.pn * 256 + c;
        if (colscale) { const f32x4 s0 = *(const f32x4*)(colscale + col), s1 = *(const f32x4*)(colscale + col + 4); v0 *= s0; v1 *= s1; }
        *(u32x4*)(O + (size_t)(u.orow0 + r) * ldc + coff + col) = pack8(v0, v1);
    }
};

__device__ __forceinline__ float ret_log2g(int h) { return log2f(1.0f - exp2f(-5.0f - (float)h)); }
struct EpiZ0 {
    bf16_t* O;
    __device__ __forceinline__ void operator()(const UnitInfo& u, int r, int c, f32x4 v0, f32x4 v1) const {
        const int col = u.pn * 256 + c, row = u.orow0 + r;
        if (col < 1024) { const float e = ret_log2g((col >> 7) & 3) * (float)(row & 127); const float sc = exp2f(col < 512 ? e : -e); v0 *= sc; v1 *= sc; }
        *(u32x4*)(O + (size_t)row * ZW + col) = pack8(v0, v1);
    }
};

struct EpiStoreF16 {
    unsigned short* O; int ldc;
    __device__ __forceinline__ void operator()(const UnitInfo& u, int r, int c, f32x4 v0, f32x4 v1) const {
        typedef _Float16 h2 __attribute__((ext_vector_type(2)));
        u32x4 w;
        w.x = __builtin_bit_cast(unsigned, (h2){(_Float16)v0.x, (_Float16)v0.y}); w.y = __builtin_bit_cast(unsigned, (h2){(_Float16)v0.z, (_Float16)v0.w});
        w.z = __builtin_bit_cast(unsigned, (h2){(_Float16)v1.x, (_Float16)v1.y}); w.w = __builtin_bit_cast(unsigned, (h2){(_Float16)v1.z, (_Float16)v1.w});
        *(u32x4*)(O + (size_t)(u.orow0 + r) * ldc + u.pn * 256 + c) = w;
    }
};
struct EpiResid {
    const float* X; float* Fo;
    __device__ __forceinline__ void operator()(const UnitInfo& u, int r, int c, f32x4 v0, f32x4 v1) const {
        const size_t off = (size_t)(u.orow0 + r) * DM + u.pn * 256 + c;
        const f32x4 x0 = *(const f32x4*)(X + off), x1 = *(const f32x4*)(X + off + 4);
        *(f32x4*)(Fo + off) = x0 * ALPHA + v0; *(f32x4*)(Fo + off + 4) = x1 * ALPHA + v1;
    }
};

struct EpiResidB {
    const bf16_t* X; float* Fo;
    __device__ __forceinline__ void operator()(const UnitInfo& u, int r, int c, f32x4 v0, f32x4 v1) const {
        const size_t off = (size_t)(u.orow0 + r) * DM + u.pn * 256 + c;
        const u32x4 xw = *(const u32x4*)(X + off);
        const f32x4 x0 = {bflo(xw.x), bfhi(xw.x), bflo(xw.y), bfhi(xw.y)}, x1 = {bflo(xw.z), bfhi(xw.z), bflo(xw.w), bfhi(xw.w)};
        *(f32x4*)(Fo + off) = x0 * ALPHA + v0; *(f32x4*)(Fo + off + 4) = x1 * ALPHA + v1;
    }
};
struct EpiGU {
    bf16_t* ACT;
    __device__ __forceinline__ void operator()(const UnitInfo& u, int r, int c, f32x4 v0, f32x4 v1) const {
        u32x2 w; w.x = pk2(silu_f(v0.x) * v0.y, silu_f(v0.z) * v0.w); w.y = pk2(silu_f(v1.x) * v1.y, silu_f(v1.z) * v1.w);
        *(u32x2*)(ACT + (size_t)(u.orow0 + r) * 512 + u.pn * 128 + (c >> 1)) = w;
    }
};
struct EpiDown {
    bf16_t* YS;
    __device__ __forceinline__ void operator()(const UnitInfo& u, int r, int c, f32x4 v0, f32x4 v1) const {
        if (r < u.nvalid) { const int pair = u.rows[r]; *(u32x4*)(YS + (size_t)pair * DM + u.pn * 256 + c) = pack8(v0, v1); }
    }
};
struct EpiPle {
    const bf16_t* XI; const bf16_t* PP; float* OUT; bf16_t* XO;
    __device__ __forceinline__ void operator()(const UnitInfo& u, int r, int c, f32x4 v0, f32x4 v1) const {
        const size_t off = (size_t)(u.orow0 + r) * DM + u.pn * 256 + c;
        const u32x4 pw = *(const u32x4*)(PP + off), xw = *(const u32x4*)(XI + off);
        f32x4 f0 = {bflo(xw.x), bfhi(xw.x), bflo(xw.y), bfhi(xw.y)}, f1 = {bflo(xw.z), bfhi(xw.z), bflo(xw.w), bfhi(xw.w)};
        f0.x += sigmoid_f(v0.x) * bflo(pw.x); f0.y += sigmoid_f(v0.y) * bfhi(pw.x); f0.z += sigmoid_f(v0.z) * bflo(pw.y); f0.w += sigmoid_f(v0.w) * bfhi(pw.y);
        f1.x += sigmoid_f(v1.x) * bflo(pw.z); f1.y += sigmoid_f(v1.y) * bfhi(pw.z); f1.z += sigmoid_f(v1.z) * bflo(pw.w); f1.w += sigmoid_f(v1.w) * bfhi(pw.w);
        if (OUT) { *(f32x4*)(OUT + off) = f0; *(f32x4*)(OUT + off + 4) = f1; }
        if (XO) *(u32x4*)(XO + off) = pack8(f0, f1);
    }
};

struct TrDesc { const float* src; bf16_t* dst; int K, N, Nsrc, nbatch, mode, dst_ld; };
__device__ __forceinline__ void tr_item(const TrDesc& d, const float* W, bf16_t* WT, float* scr, int kb, int nb, int lane) {
    const int k0 = 64 * kb, n0 = 32 * nb, Ns = d.Nsrc;
    const bool okc = (n0 + (lane & 31)) < Ns;
    float tmp[32];
#pragma unroll
    for (int i = 0; i < 32; ++i) tmp[i] = okc ? __builtin_nontemporal_load(W + (size_t)(k0 + 2 * i + (lane >> 5)) * Ns + n0 + (lane & 31)) : 0.f;
#pragma unroll
    for (int i = 0; i < 32; ++i) scr[(2 * i + (lane >> 5)) * 33 + (lane & 31)] = tmp[i];
    LDS_FENCE();
    const int c = lane & 7;
#pragma unroll
    for (int j = 0; j < 4; ++j) {
        const int n = (lane >> 3) + 8 * j; const float* sp = scr + (8 * c) * 33 + n;
        const int ng = n0 + n;
        float sc = 1.f; int nd = ng; int coff = 0;
        if (d.mode == 1) { if (ng >= 512 && ng < 1024) sc = 0.08838834764831845f; }
        if (d.mode == 2) { nd = (ng < 512) ? 2 * ng : 2 * (ng - 512) + 1; }
        if (d.mode == 3) { coff = ((ng >> 6) & 3) * 256; }
        u32x4 o; o.x = pk2(sp[0 * 33] * sc, sp[1 * 33] * sc); o.y = pk2(sp[2 * 33] * sc, sp[3 * 33] * sc); o.z = pk2(sp[4 * 33] * sc, sp[5 * 33] * sc); o.w = pk2(sp[6 * 33] * sc, sp[7 * 33] * sc);
        *(u32x4*)(WT + (size_t)nd * d.dst_ld + coff + k0 + 8 * c) = o;
    }
    LDS_FENCE();
}
__device__ __forceinline__ int tr_items(const TrDesc& d) { return d.nbatch * (d.K / 64) * (d.N / 32); }
__device__ __forceinline__ void tr_run(const TrDesc& d, int it, float* scr, int lane) {
    const int per = (d.K / 64) * (d.N / 32), b = it / per, r = it % per, nblk = d.N / 32;
    tr_item(d, d.src + (size_t)b * d.K * d.Nsrc, d.dst + (size_t)b * d.N * d.dst_ld, scr, r / nblk, r % nblk, lane);
}

__device__ __forceinline__ void phase_prep(const Params& P, unsigned char* lds) {
    unsigned char* ws = P.ws;
    const int tid = threadIdx.x, lane = tid & 63, wave = tid >> 6;
    const int gw = blockIdx.x * NWAVE + wave, NGW = gridDim.x * NWAVE;
    float* scr = (float*)lds + wave * (64 * 33);
    constexpr int ND = 9;
    TrDesc d[ND];
    d[0] = {P.in[22], (bf16_t*)(ws + WS_W_GU), 1024, 1024, 1024, 64, 2, 1024};
    d[1] = {P.in[23], (bf16_t*)(ws + WS_W_DN), 512, 1024, 1024, 64, 0, 512};
    d[2] = {P.in[2], (bf16_t*)(ws + WS_W_IN0), 1024, 2560, 2560, 1, 1, 1024};
    d[3] = {P.in[6], (bf16_t*)(ws + WS_W_OUT0), 1024, 1024, 1024, 1, 0, 1024};
    d[4] = {P.in[13], (bf16_t*)(ws + WS_W_COUT), 1024, 1024, 1024, 1, 0, 1024};
    d[5] = {P.in[24], (bf16_t*)(ws + WS_W_G), 1024, 1024, 1024, 2, 0, 1024};
    d[6] = {P.in[25], (bf16_t*)(ws + WS_W_P), 256, 1024, 1024, 2, 0, 256};
    d[7] = {P.in[7], (bf16_t*)(ws + WS_W_CIN), 1024, Z1W, CIN, 1, 0, 1024};
    d[8] = {P.in[12], (bf16_t*)(ws + WS_W_UVBD), 256, 1024, 1024, 1, 3, 1024};
    int total = 0;
#pragma unroll
    for (int i = 0; i < ND; ++i) total += tr_items(d[i]);
    for (int it = gw; it < total; it += NGW) {
        int r = it;
#pragma unroll
        for (int i = 0; i < ND; ++i) { const int n = tr_items(d[i]); if (r >= 0 && r < n) { tr_run(d[i], r, scr, lane); r = -1; } else if (r >= 0) r -= n; }
    }
    const size_t gt = (size_t)blockIdx.x * NT + tid, GS = (size_t)gridDim.x * NT;
    {
        bf16_t* o = (bf16_t*)(ws + WS_W_POOL); const float* pw = P.in[4];
        for (size_t i = gt; i < 512 * 256; i += GS) { const int n = (int)(i >> 8), k = (int)(i & 255), g = n >> 7, dd = n & 127, kg = k >> 7, c = k & 127;
            o[i] = (bf16_t)((kg == (g & 1)) ? f2bf(pw[((size_t)g * 128 + c) * 128 + dd]) : 0u); }
    }
    {
        u32x4* o = (u32x4*)(ws + WS_W_UVBD);
        for (size_t i = gt; i < (size_t)1024 * 1024 / 8; i += GS) { const int n = (int)(i >> 7), k = (int)(i & 127) * 8; if (((n >> 6) & 3) != (k >> 8)) o[i] = (u32x4){0u, 0u, 0u, 0u}; }
    }
    {
        bf16_t* o = (bf16_t*)(ws + WS_W_QA); const float* uq = P.in[10]; const float* uk = P.in[11];
        float* Bq = (float*)lds; float* Ak = Bq + 256 * 65;
        for (int item = blockIdx.x; item < 128; item += gridDim.x) {
            const int h = item >> 3, c0 = (item & 7) * 32;
            __syncthreads();
            for (int i = tid; i < 256 * 16; i += NT) { const int r = i >> 4, d4 = (i & 15) * 4; const f32x4 v = *(const f32x4*)(uq + (size_t)r * 1024 + h * 64 + d4);
                float* q = Bq + r * 65 + d4; q[0] = v.x; q[1] = v.y; q[2] = v.z; q[3] = v.w; }
            for (int i = tid; i < 32 * 16; i += NT) { const int c = i >> 4, d4 = (i & 15) * 4; const f32x4 v = *(const f32x4*)(uk + (size_t)(c0 + c) * 1024 + h * 64 + d4);
                float* q = Ak + c * 65 + d4; q[0] = v.x; q[1] = v.y; q[2] = v.z; q[3] = v.w; }
            __syncthreads();
            const int r = tid & 255, cg = tid >> 8;
            float acc[16];
#pragma unroll
            for (int j = 0; j < 16; ++j) acc[j] = 0.f;
            for (int dd = 0; dd < 64; ++dd) { const float bv = Bq[r * 65 + dd];
#pragma unroll
                for (int j = 0; j < 16; ++j) acc[j] += Ak[(cg * 16 + j) * 65 + dd] * bv; }
#pragma unroll
            for (int j = 0; j < 16; ++j) o[(size_t)(h * 256 + c0 + cg * 16 + j) * 256 + r] = (bf16_t)f2bf(acc[j] * 0.125f);
        }
        __syncthreads();
    }
    {
        const f32x4* x = (const f32x4*)P.in[0]; u32x4* xb = (u32x4*)(ws + WS_XB);
        const size_t nx = (size_t)NTOK * DM / 8, np = (size_t)2 * NTOK * 256 / 8;
        size_t i = gt;
        for (; i + 3 * GS < nx; i += 4 * GS) { f32x4 a[8];
#pragma unroll
            for (int q = 0; q < 4; ++q) { a[2 * q] = __builtin_nontemporal_load(x + 2 * (i + q * GS)); a[2 * q + 1] = __builtin_nontemporal_load(x + 2 * (i + q * GS) + 1); }
#pragma unroll
            for (int q = 0; q < 4; ++q) xb[i + q * GS] = pack8(a[2 * q], a[2 * q + 1]); }
        for (; i < nx; i += GS) xb[i] = pack8(x[2 * i], x[2 * i + 1]);
        const f32x4* p = (const f32x4*)P.in[1]; u32x4* pb = (u32x4*)(ws + WS_PB);
        i = gt;
        for (; i + 3 * GS < np; i += 4 * GS) { f32x4 a[8];
#pragma unroll
            for (int q = 0; q < 4; ++q) { a[2 * q] = __builtin_nontemporal_load(p + 2 * (i + q * GS)); a[2 * q + 1] = __builtin_nontemporal_load(p + 2 * (i + q * GS) + 1); }
#pragma unroll
            for (int q = 0; q < 4; ++q) pb[i + q * GS] = pack8(a[2 * q], a[2 * q + 1]); }
        for (; i < np; i += GS) pb[i] = pack8(p[2 * i], p[2 * i + 1]);
    }
}

__device__ __forceinline__ float ret_logg(int h) { return log1pf(-exp2f(-5.0f - (float)h)); }

__device__ __forceinline__ void phase_ret_kv(const Params& P, unsigned char* lds) {
    const bf16_t* Z0 = (const bf16_t*)(P.ws + WS_Z0); float* KV = (float*)(P.ws + WS_KV);
    float* Ks = (float*)lds; float* Vs = Ks + 128 * 128;
    const int tid = threadIdx.x;
    for (int u = blockIdx.x; u < 1024; u += gridDim.x) {
        const int n = u & 63, h = (u >> 6) & 3, b = u >> 8;
        const float lg = ret_logg(h);
        const size_t row0 = (size_t)b * SEQ + n * 128;
        for (int i = tid; i < 128 * 16; i += NT) {
            const int r = i >> 4, c8 = (i & 15) * 8;
            const u32x4 kv = *(const u32x4*)(Z0 + (row0 + r) * ZW + 512 + h * 128 + c8);
            const u32x4 vv = *(const u32x4*)(Z0 + (row0 + r) * ZW + 1024 + h * 128 + c8);
            const float dec = __expf(lg * (float)(127 - r));
            float* kp = Ks + r * 128 + c8; float* vp = Vs + r * 128 + c8;
            kp[0] = bflo(kv.x) * dec; kp[1] = bfhi(kv.x) * dec; kp[2] = bflo(kv.y) * dec; kp[3] = bfhi(kv.y) * dec;
            kp[4] = bflo(kv.z) * dec; kp[5] = bfhi(kv.z) * dec; kp[6] = bflo(kv.w) * dec; kp[7] = bfhi(kv.w) * dec;
            vp[0] = bflo(vv.x); vp[1] = bfhi(vv.x); vp[2] = bflo(vv.y); vp[3] = bfhi(vv.y);
            vp[4] = bflo(vv.z); vp[5] = bfhi(vv.z); vp[6] = bflo(vv.w); vp[7] = bfhi(vv.w);
        }
        __syncthreads();
        const int dd = tid >> 2, v0 = (tid & 3) * 32;
        float acc[32];
#pragma unroll
        for (int j = 0; j < 32; ++j) acc[j] = 0.f;
        for (int i = 0; i < 128; ++i) {
            const float kd = Ks[i * 128 + dd];
#pragma unroll
            for (int j = 0; j < 32; j += 4) { const f32x4 vv = *(const f32x4*)(Vs + i * 128 + v0 + j); acc[j] += kd * vv.x; acc[j + 1] += kd * vv.y; acc[j + 2] += kd * vv.z; acc[j + 3] += kd * vv.w; }
        }
        float* o = KV + (size_t)u * 16384 + dd * 128 + v0;
#pragma unroll
        for (int j = 0; j < 32; j += 4) *(f32x4*)(o + j) = (f32x4){acc[j], acc[j + 1], acc[j + 2], acc[j + 3]};
        __syncthreads();
    }
}
__device__ __forceinline__ void phase_ret_scan_pool(const Params& P) {
    float* KV = (float*)(P.ws + WS_KV);
    const size_t gt = (size_t)blockIdx.x * NT + threadIdx.x, GS = (size_t)gridDim.x * NT;
    for (size_t i = gt; i < (size_t)16 * 4096; i += GS) {
        const int s = (int)(i >> 12), e4 = (int)(i & 4095), h = s & 3;
        const float cd = __expf(ret_logg(h) * 128.0f);
        f32x4* p = (f32x4*)(KV + (size_t)s * 64 * 16384) + e4;
        f32x4 R = {0.f, 0.f, 0.f, 0.f};
        for (int n0 = 0; n0 < 64; n0 += 8) {
            f32x4 kv[8];
#pragma unroll
            for (int j = 0; j < 8; ++j) kv[j] = p[(size_t)(n0 + j) * 4096];
#pragma unroll
            for (int j = 0; j < 8; ++j) { p[(size_t)(n0 + j) * 4096] = R; R = R * cd + kv[j]; }
        }
    }
    const bf16_t* Z0 = (const bf16_t*)(P.ws + WS_Z0); bf16_t* DP = (bf16_t*)(P.ws + WS_DP);
    for (size_t i = gt; i < (size_t)NTOK * 64; i += GS) {
        const int t = (int)(i >> 6), c8 = (int)(i & 63) * 8, g = c8 >> 7, w = 2 << g, tl = t & (SEQ - 1);
        const int cnt = min(tl + 1, w);
        float s[8];
#pragma unroll
        for (int j = 0; j < 8; ++j) s[j] = 0.f;
        float u0[8];
        for (int q = 0; q < cnt; ++q) {
            const u32x4 v = *(const u32x4*)(Z0 + (size_t)(t - q) * ZW + 2048 + c8);
            const float f[8] = {bflo(v.x), bfhi(v.x), bflo(v.y), bfhi(v.y), bflo(v.z), bfhi(v.z), bflo(v.w), bfhi(v.w)};
#pragma unroll
            for (int j = 0; j < 8; ++j) { s[j] += f[j]; if (q == 0) u0[j] = f[j]; }
        }
        const float inv = 1.0f / (float)cnt;
        u32x4 o; o.x = pk2(s[0] * inv - u0[0], s[1] * inv - u0[1]); o.y = pk2(s[2] * inv - u0[2], s[3] * inv - u0[3]);
        o.z = pk2(s[4] * inv - u0[4], s[5] * inv - u0[5]); o.w = pk2(s[6] * inv - u0[6], s[7] * inv - u0[7]);
        *(u32x4*)(DP + (size_t)t * 512 + c8) = o;
    }
}
__device__ __forceinline__ void phase_ret_out(const Params& P, unsigned char* lds) {
    const bf16_t* Z0 = (const bf16_t*)(P.ws + WS_Z0); const float* KV = (const float*)(P.ws + WS_KV); bf16_t* MIX = (bf16_t*)(P.ws + WS_MIX);
    const float* gn = P.in[3];
    bf16_t* Qs = (bf16_t*)lds;
    bf16_t* Ksm = Qs + 128 * 136;
    float* Sc = (float*)(lds + 2 * 128 * 136 * 2);
    const int tid = threadIdx.x;
    for (int u = blockIdx.x; u < 1024; u += gridDim.x) {
        const int n = u & 63, h = (u >> 6) & 3, b = u >> 8;
        const float lg = ret_logg(h);
        const size_t row0 = (size_t)b * SEQ + n * 128;
        for (int i = tid; i < 128 * 16; i += NT) {
            const int r = i >> 4, c8 = (i & 15) * 8;
            *(u32x4*)(Qs + r * 136 + c8) = *(const u32x4*)(Z0 + (row0 + r) * ZW + h * 128 + c8);
            *(u32x4*)(Ksm + r * 136 + c8) = *(const u32x4*)(Z0 + (row0 + r) * ZW + 512 + h * 128 + c8);
        }
        __syncthreads();
        for (int e = tid; e < 128 * 128; e += NT) {
            const int i = e >> 7, j = e & 127;
            float s = 0.f;
            if (j <= i) {
                const bf16_t* q = Qs + i * 136; const bf16_t* k = Ksm + j * 136;
                for (int dd = 0; dd < 128; dd += 2) { const unsigned qa = *(const unsigned*)(q + dd), ka = *(const unsigned*)(k + dd); s += bflo(qa) * bflo(ka) + bfhi(qa) * bfhi(ka); }
                s *= __expf(lg * (float)(i - j));
            }
            Sc[e] = s;
        }
        __syncthreads();
        const int i = tid >> 2, v0 = (tid & 3) * 32;
        float acc[32];
#pragma unroll
        for (int j = 0; j < 32; ++j) acc[j] = 0.f;
        for (int j = 0; j <= i; ++j) {
            const float s = Sc[i * 128 + j];
            const bf16_t* vr = Z0 + (row0 + j) * ZW + 1024 + h * 128 + v0;
#pragma unroll
            for (int q = 0; q < 4; ++q) { const u32x4 vv = *(const u32x4*)(vr + q * 8);
                acc[q * 8 + 0] += s * bflo(vv.x); acc[q * 8 + 1] += s * bfhi(vv.x); acc[q * 8 + 2] += s * bflo(vv.y); acc[q * 8 + 3] += s * bfhi(vv.y);
                acc[q * 8 + 4] += s * bflo(vv.z); acc[q * 8 + 5] += s * bfhi(vv.z); acc[q * 8 + 6] += s * bflo(vv.w); acc[q * 8 + 7] += s * bfhi(vv.w); }
        }
        const float qdec = __expf(lg * (float)(i + 1));
        const float* S = KV + (size_t)u * 16384;
        for (int dd = 0; dd < 128; ++dd) {
            const float qd = bf2f(Qs[i * 136 + dd]) * qdec;
            const float* sr = S + dd * 128 + v0;
#pragma unroll
            for (int q = 0; q < 32; q += 4) { const f32x4 sv = *(const f32x4*)(sr + q); acc[q] += qd * sv.x; acc[q + 1] += qd * sv.y; acc[q + 2] += qd * sv.z; acc[q + 3] += qd * sv.w; }
        }
        float sm = 0.f;
#pragma unroll
        for (int j = 0; j < 32; ++j) sm += acc[j];
        sm += __shfl_xor(sm, 1); sm += __shfl_xor(sm, 2);
        const float mu = sm * (1.0f / 128.0f);
        float sq = 0.f;
#pragma unroll
        for (int j = 0; j < 32; ++j) { const float dlt = acc[j] - mu; sq += dlt * dlt; }
        sq += __shfl_xor(sq, 1); sq += __shfl_xor(sq, 2);
        const float rstd = 1.0f / sqrtf(sq * (1.0f / 128.0f) + LN_EPS);
        const bf16_t* gr = Z0 + (row0 + i) * ZW + 1536 + h * 128 + v0;
        bf16_t* orow = MIX + (row0 + i) * DM + h * 128 + v0;
#pragma unroll
        for (int q = 0; q < 4; ++q) {
            const u32x4 gv = *(const u32x4*)(gr + q * 8);
            const float g8[8] = {bflo(gv.x), bfhi(gv.x), bflo(gv.y), bfhi(gv.y), bflo(gv.z), bfhi(gv.z), bflo(gv.w), bfhi(gv.w)};
            float o8[8];
#pragma unroll
            for (int j = 0; j < 8; ++j) o8[j] = (acc[q * 8 + j] - mu) * rstd * gn[h * 128 + v0 + q * 8 + j] * silu_f(g8[j]);
            u32x4 w; w.x = pk2(o8[0], o8[1]); w.y = pk2(o8[2], o8[3]); w.z = pk2(o8[4], o8[5]); w.w = pk2(o8[6], o8[7]);
            *(u32x4*)(orow + q * 8) = w;
        }
        __syncthreads();
    }
}

template <bool DRY>
__device__ __forceinline__ void phase_ln_route(const Params& P, unsigned char* lds, int layer) {
    float* F = (float*)(P.ws + WS_F); bf16_t* XB = (bf16_t*)(P.ws + (DRY ? WS_M0 + 128 * MiB : WS_XB)); float* FO = DRY ? (float*)(P.ws + WS_M0) : F;
    float* TOKG = (float*)(P.ws + WS_TOKG); int* LIST = (int*)(P.ws + WS_LIST);
    int* CNT = (int*)(P.ws + WS_CTL) + layer * 64;
    const float* lg = P.in[14] + layer * DM; const float* lb = P.in[15] + layer * DM;
    const float* wg = P.in[18] + (size_t)layer * DM * 4; const float* bg = P.in[19] + layer * 4;
    const float* we = P.in[20] + (size_t)layer * DM * 32; const float* be = P.in[21] + layer * 32;
    LAS f32x4* WL = (LAS f32x4*)lds;
    int* dec = (int*)(lds + 147456);
    int* rank = dec + 256;
    int* lcnt = rank + 256;
    int* lbase = lcnt + 32;
    for (int idx = threadIdx.x; idx < 16 * 9 * 64; idx += NT) {
        const int sl = idx / 576, rem = idx % 576, jg = rem >> 6, l = rem & 63, c = 256 * (sl >> 2) + 4 * l + (sl & 3);
        WL[idx] = (jg == 0) ? *(const f32x4*)(wg + (size_t)c * 4) : *(const f32x4*)(we + (size_t)c * 32 + (jg - 1) * 4);
    }
    __syncthreads();
    const int tid = threadIdx.x, lane = tid & 63, wave = tid >> 6;
    for (int rb = blockIdx.x; rb < NTOK / 128; rb += gridDim.x) {
        if (tid < 32) lcnt[tid] = 0;
        __syncthreads();
        for (int ri = 0; ri < 16; ++ri) {
            const int rl = wave * 16 + ri, t = rb * 128 + rl;
            float* fr = F + (size_t)t * DM;
            f32x4 v[4]; float s = 0.f;
#pragma unroll
            for (int j = 0; j < 4; ++j) { v[j] = *(const f32x4*)(fr + 256 * j + 4 * lane); s += (v[j].x + v[j].y) + (v[j].z + v[j].w); }
            const float mean = wave_sum(s) * (1.0f / DM); float s2 = 0.f;
#pragma unroll
            for (int j = 0; j < 4; ++j) { v[j] = v[j] - mean; s2 += (v[j].x * v[j].x + v[j].y * v[j].y) + (v[j].z * v[j].z + v[j].w * v[j].w); }
            const float rstd = 1.0f / sqrtf(wave_sum(s2) * (1.0f / DM) + LN_EPS);
            float acc[36];
#pragma unroll
            for (int j = 0; j < 36; ++j) acc[j] = 0.f;
#pragma unroll
            for (int j = 0; j < 4; ++j) {
                const int c0 = 256 * j + 4 * lane;
                const f32x4 g4 = *(const f32x4*)(lg + c0), b4 = *(const f32x4*)(lb + c0);
                v[j] = v[j] * rstd * g4 + b4;
                if (DRY) *(f32x4*)(FO + (size_t)t * DM + c0) = v[j];
                u32x2 w; w.x = pk2(v[j].x, v[j].y); w.y = pk2(v[j].z, v[j].w);
                *(u32x2*)(XB + (size_t)t * DM + c0) = w;
#pragma unroll
                for (int q = 0; q < 4; ++q) {
                    const float xv = v[j][q];
#pragma unroll
                    for (int jg = 0; jg < 9; ++jg) { const f32x4 w4 = WL[((j * 4 + q) * 9 + jg) * 64 + lane];
                        acc[jg * 4] += xv * w4.x; acc[jg * 4 + 1] += xv * w4.y; acc[jg * 4 + 2] += xv * w4.z; acc[jg * 4 + 3] += xv * w4.w; }
                }
            }
#pragma unroll
            for (int j = 0; j < 36; ++j) acc[j] = wave_sum(acc[j]);
            float gl[4];
#pragma unroll
            for (int j = 0; j < 4; ++j) gl[j] = acc[j] + bg[j];
            int grp = 0; float gm = gl[0];
#pragma unroll
            for (int j = 1; j < 4; ++j) if (gl[j] > gm) { gm = gl[j]; grp = j; }
            float gs = 0.f;
#pragma unroll
            for (int j = 0; j < 4; ++j) gs += __expf(gl[j] - gm);
            const float gw = 1.0f / gs;
            float el[8];
#pragma unroll
            for (int j = 0; j < 8; ++j) el[j] = 0.f;
#pragma unroll
            for (int g = 0; g < 4; ++g)
#pragma unroll
                for (int j = 0; j < 8; ++j) el[j] = (g == grp) ? (acc[4 + g * 8 + j] + be[g * 8 + j]) : el[j];
            int i0 = 0; float m0 = el[0];
#pragma unroll
            for (int j = 1; j < 8; ++j) if (el[j] > m0) { m0 = el[j]; i0 = j; }
            int i1 = -1; float m1 = -INFINITY;
#pragma unroll
            for (int j = 0; j < 8; ++j) if (j != i0 && el[j] > m1) { m1 = el[j]; i1 = j; }
            const float ex = __expf(m1 - m0);
            const float p0 = 1.0f / (1.0f + ex), p1 = ex / (1.0f + ex);
            if (lane == 0) {
                dec[rl * 2] = grp * 8 + i0; dec[rl * 2 + 1] = grp * 8 + i1;
                if (!DRY) { TOKG[(size_t)t * 2] = gw * p0; TOKG[(size_t)t * 2 + 1] = gw * p1; }
            }
        }
        __syncthreads();
        if (tid < 256) rank[tid] = atomicAdd(&lcnt[dec[tid]], 1);
        __syncthreads();
        if (tid < 32) lbase[tid] = DRY ? 0 : atomicAdd(&CNT[tid], lcnt[tid]);
        __syncthreads();
        if (!DRY && tid < 256) { const int e = dec[tid]; LIST[(size_t)e * LIST_CAP + lbase[e] + rank[tid]] = (rb * 128 + (tid >> 1)) * 2 + (tid & 1); }
        __syncthreads();
    }
}
__device__ __forceinline__ void moe_setup(const Params& P, int* tb, int layer) {
    const int* CNT = (const int*)(P.ws + WS_CTL) + layer * 64;
    if (threadIdx.x == 0) { int a = 0; for (int e = 0; e < 32; ++e) { tb[e] = a; a += (CNT[e] + 255) >> 8; } tb[32] = a; }
    __syncthreads();
}
template <bool DRY>
__device__ __forceinline__ void phase_ln2(const Params& P, int layer) {
    const bf16_t* XI = (const bf16_t*)(P.ws + WS_XB); bf16_t* XO = (bf16_t*)(P.ws + (DRY ? WS_XB2 : WS_XB));
    const bf16_t* YS = (const bf16_t*)(P.ws + WS_YS); const float* TOKG = (const float*)(P.ws + WS_TOKG);
    const float* lg = P.in[16] + layer * DM; const float* lb = P.in[17] + layer * DM;
    const int lane = threadIdx.x & 63, gw = blockIdx.x * NWAVE + (threadIdx.x >> 6), NGW = gridDim.x * NWAVE;
    f32x4 g4[4], b4[4];
#pragma unroll
    for (int j = 0; j < 4; ++j) { g4[j] = *(const f32x4*)(lg + 256 * j + 4 * lane); b4[j] = *(const f32x4*)(lb + 256 * j + 4 * lane); }
    for (int t = gw; t < NTOK; t += NGW) {
        const float g0 = TOKG[(size_t)t * 2], g1 = TOKG[(size_t)t * 2 + 1];
        const bf16_t* xr = XI + (size_t)t * DM; const bf16_t* y0 = YS + (size_t)(2 * t) * DM; const bf16_t* y1 = y0 + DM;
        f32x4 v[4]; float s = 0.f;
#pragma unroll
        for (int j = 0; j < 4; ++j) { const int c0 = 256 * j + 4 * lane;
            const u32x2 x = *(const u32x2*)(xr + c0), a = *(const u32x2*)(y0 + c0), b = *(const u32x2*)(y1 + c0);
            v[j].x = bflo(x.x) * ALPHA + g0 * bflo(a.x) + g1 * bflo(b.x); v[j].y = bfhi(x.x) * ALPHA + g0 * bfhi(a.x) + g1 * bfhi(b.x);
            v[j].z = bflo(x.y) * ALPHA + g0 * bflo(a.y) + g1 * bflo(b.y); v[j].w = bfhi(x.y) * ALPHA + g0 * bfhi(a.y) + g1 * bfhi(b.y);
            s += (v[j].x + v[j].y) + (v[j].z + v[j].w); }
        const float mean = wave_sum(s) * (1.0f / DM); float s2 = 0.f;
#pragma unroll
        for (int j = 0; j < 4; ++j) { v[j] = v[j] - mean; s2 += (v[j].x * v[j].x + v[j].y * v[j].y) + (v[j].z * v[j].z + v[j].w * v[j].w); }
        const float rstd = 1.0f / sqrtf(wave_sum(s2) * (1.0f / DM) + LN_EPS);
#pragma unroll
        for (int j = 0; j < 4; ++j) { const int c0 = 256 * j + 4 * lane;
            v[j] = v[j] * rstd * g4[j] + b4[j];
            u32x2 w; w.x = pk2(v[j].x, v[j].y); w.y = pk2(v[j].z, v[j].w); *(u32x2*)(XO + (size_t)t * DM + c0) = w; }
    }
}

__device__ __forceinline__ unsigned f8enc(float y) {
    const unsigned u = __float_as_uint(y), sg = (u >> 24) & 0x80u;
    unsigned a = u & 0x7fffffffu;
    a = max(a, 0x3c000000u); a = min(a, 0x43f00000u);
    a = a + 0x0007ffffu + ((a >> 20) & 1u);
    const unsigned c = min(a >> 20, (135u << 3) | 7u) - (120u << 3);
    return sg | c;
}
__device__ __forceinline__ unsigned e5m2enc(float y) {
    const unsigned hb = (unsigned)__builtin_bit_cast(unsigned short, (_Float16)y);
    return ((hb + 0x7fu + ((hb >> 8) & 1u)) >> 8) & 0xffu;
}
__device__ __forceinline__ unsigned f8dec2(unsigned e) {
    const unsigned t = (e << 4) + 0x3c003c00u;
    return __umul24(e & 0x00800080u, 240u) + t;
}
__device__ __forceinline__ void phase_norms(const Params& P) {
    const bf16_t* Z1 = (const bf16_t*)(P.ws + WS_Z1); bf16_t* CQ = (bf16_t*)(P.ws + WS_CQ); bf16_t* CKV = (bf16_t*)(P.ws + WS_CKV); unsigned char* CKV8 = (unsigned char*)(P.ws + WS_CKV8);
    const float* qn = P.in[8]; const float* kn = P.in[9];
    const int lane = threadIdx.x & 63, gw = blockIdx.x * NWAVE + (threadIdx.x >> 6), NGW = gridDim.x * NWAVE;
    for (int t = gw; t < NTOK; t += NGW) {
        const u32x2 a = *(const u32x2*)(Z1 + (size_t)t * Z1W + 4 * lane), b = *(const u32x2*)(Z1 + (size_t)t * Z1W + 256 + 4 * lane);
        const float q[4] = {bflo(a.x), bfhi(a.x), bflo(a.y), bfhi(a.y)}, k[4] = {bflo(b.x), bfhi(b.x), bflo(b.y), bfhi(b.y)};
        const float sq = wave_sum(q[0] * q[0] + q[1] * q[1] + q[2] * q[2] + q[3] * q[3]), sk = wave_sum(k[0] * k[0] + k[1] * k[1] + k[2] * k[2] + k[3] * k[3]);
        const float rq = 1.0f / sqrtf(sq * (1.0f / 256.0f) + 1e-6f), rk = 1.0f / sqrtf(sk * (1.0f / 256.0f) + 1e-6f);
        const f32x4 gq = *(const f32x4*)(qn + 4 * lane), gk = *(const f32x4*)(kn + 4 * lane);
        u32x2 o; o.x = pk2(q[0] * rq * gq.x, q[1] * rq * gq.y); o.y = pk2(q[2] * rq * gq.z, q[3] * rq * gq.w);
        *(u32x2*)(CQ + (size_t)t * 256 + 4 * lane) = o;
        o.x = pk2(k[0] * rk * gk.x, k[1] * rk * gk.y); o.y = pk2(k[2] * rk * gk.z, k[3] * rk * gk.w);
        *(u32x2*)(CKV + (size_t)t * 256 + 4 * lane) = o;
        *(unsigned*)(CKV8 + (size_t)t * 256 + 4 * lane) = e5m2enc(k[0] * rk * gk.x) | (e5m2enc(k[1] * rk * gk.y) << 8) | (e5m2enc(k[2] * rk * gk.z) << 16) | (e5m2enc(k[3] * rk * gk.w) << 24);
    }
}
__device__ __forceinline__ unsigned fkey(float f) { const unsigned u = __float_as_uint(f); return (u & 0x80000000u) ? ~u : (u | 0x80000000u); }

__device__ __forceinline__ void phase_index(const Params& P, unsigned char* lds) {
    const bf16_t* Z1 = (const bf16_t*)(P.ws + WS_Z1); unsigned short* SEL = (unsigned short*)(P.ws + WS_SEL);
    float* sc = (float*)lds;
    float* qf = sc + 8192;
    float* wf = qf + 512;
    int* hist = (int*)(wf + 8);
    int* misc = hist + 256;
    int* seg = misc + 8;
    const int tid = threadIdx.x;
    for (int t = blockIdx.x; t < NTOK; t += gridDim.x) {
        const int b = t >> 13, tl = t & (SEQ - 1), n = tl + 1;
        unsigned short* so = SEL + (size_t)t * TOPK;
        if (n <= TOPK) { if (tid < n) so[tid] = (unsigned short)tid; continue; }
        qf[tid] = bf2f(Z1[(size_t)t * Z1W + 512 + tid]);
        if (tid < 8) wf[tid] = bf2f(Z1[(size_t)t * Z1W + 1088 + tid]);
        __syncthreads();
        for (int s = tid; s < n; s += NT) {
            const bf16_t* kr = Z1 + ((size_t)b * SEQ + s) * Z1W + 1024;
            float k[64];
#pragma unroll
            for (int q = 0; q < 8; ++q) { const u32x4 v = *(const u32x4*)(kr + q * 8);
                k[q * 8] = bflo(v.x); k[q * 8 + 1] = bfhi(v.x); k[q * 8 + 2] = bflo(v.y); k[q * 8 + 3] = bfhi(v.y);
                k[q * 8 + 4] = bflo(v.z); k[q * 8 + 5] = bfhi(v.z); k[q * 8 + 6] = bflo(v.w); k[q * 8 + 7] = bfhi(v.w); }
            float I = 0.f;
#pragma unroll
            for (int h = 0; h < 8; ++h) { float d = 0.f;
#pragma unroll
                for (int dd = 0; dd < 64; ++dd) d += qf[h * 64 + dd] * k[dd];
                I += wf[h] * fmaxf(d, 0.f); }
            sc[s] = I;
        }
        if (tid == 0) { misc[0] = 0; misc[1] = TOPK; misc[2] = 0; }
        __syncthreads();
        for (int pass = 0; pass < 4; ++pass) {
            const int shift = 24 - 8 * pass;
            if (tid < 256) hist[tid] = 0;
            __syncthreads();
            const unsigned prefix = (unsigned)misc[0]; const int kk = misc[1];
            for (int s = tid; s < n; s += NT) { const unsigned key = fkey(sc[s]);
                if (pass == 0 || (key >> (shift + 8)) == prefix) atomicAdd(&hist[(key >> shift) & 255], 1); }
            __syncthreads();
            if (tid == 0) { int a = 0, bsel = 0; for (int bin = 255; bin >= 0; --bin) { const int c = hist[bin]; if (a + c >= kk) { bsel = bin; break; } a += c; }
                misc[0] = (int)((prefix << 8) | (unsigned)bsel); misc[1] = kk - a; }
            __syncthreads();
        }
        const unsigned T = (unsigned)misc[0]; const int keq = misc[1];
        for (int s = tid; s < n; s += NT) if (fkey(sc[s]) > T) { const int o = atomicAdd(&misc[2], 1); so[o] = (unsigned short)s; }
        const int per = (n + NT - 1) / NT, s0 = tid * per, s1 = min(n, s0 + per);
        int ce = 0;
        for (int s = s0; s < s1; ++s) ce += (fkey(sc[s]) == T) ? 1 : 0;
        seg[tid] = ce;
        __syncthreads();
        if (tid == 0) { int a = 0; for (int i = 0; i < NT; ++i) { const int c = seg[i]; seg[i] = a; a += c; } }
        __syncthreads();
        const int ngt = TOPK - keq;
        int r = seg[tid];
        for (int s = s0; s < s1 && r < keq; ++s) if (fkey(sc[s]) == T) { so[ngt + r] = (unsigned short)s; ++r; }
        __syncthreads();
    }
}
__device__ __forceinline__ void phase_sparse_attn(const Params& P, unsigned char* lds) {
    bf16_t* QA = (bf16_t*)(P.ws + WS_QA); const bf16_t* CKV = (const bf16_t*)(P.ws + WS_CKV); const unsigned short* SEL = (const unsigned short*)(P.ws + WS_SEL);
    float* qa = (float*)lds;
    float* lgt = qa + 4096;
    int* sel = (int*)(lgt + 4096);
    const int tid = threadIdx.x, lane = tid & 63, wave = tid >> 6;
    for (int t = blockIdx.x; t < NTOK; t += gridDim.x) {
        const int b = t >> 13, tl = t & (SEQ - 1), ns = min(tl + 1, TOPK);
        { const u32x4 v = *(const u32x4*)(QA + (size_t)t * 4096 + tid * 8); float* q = qa + tid * 8;
          q[0] = bflo(v.x); q[1] = bfhi(v.x); q[2] = bflo(v.y); q[3] = bfhi(v.y); q[4] = bflo(v.z); q[5] = bfhi(v.z); q[6] = bflo(v.w); q[7] = bfhi(v.w); }
        if (tid < TOPK) sel[tid] = (tid < ns) ? (int)SEL[(size_t)t * TOPK + tid] : 0;
        __syncthreads();
        const int k = tid & 255, hg = tid >> 8;
        {
            float acc[8];
#pragma unroll
            for (int h = 0; h < 8; ++h) acc[h] = 0.f;
            if (k < ns) {
                const bf16_t* cr = CKV + ((size_t)b * SEQ + sel[k]) * 256;
                for (int c8 = 0; c8 < 256; c8 += 8) {
                    const u32x4 v = *(const u32x4*)(cr + c8);
                    const float cv[8] = {bflo(v.x), bfhi(v.x), bflo(v.y), bfhi(v.y), bflo(v.z), bfhi(v.z), bflo(v.w), bfhi(v.w)};
#pragma unroll
                    for (int h = 0; h < 8; ++h) { const float* q = qa + (hg * 8 + h) * 256 + c8;
#pragma unroll
                        for (int j = 0; j < 8; ++j) acc[h] += q[j] * cv[j]; }
                }
            }
#pragma unroll
            for (int h = 0; h < 8; ++h) { const int hh = hg * 8 + h; const float slope = exp2f(-0.5f * (float)(hh + 1));
                lgt[hh * 256 + k] = (k < ns) ? (acc[h] - slope * (float)(tl - sel[k])) : -INFINITY; }
        }
        __syncthreads();
        for (int hh = wave * 2; hh < wave * 2 + 2; ++hh) {
            float* row = lgt + hh * 256;
            float x[4]; float m = -INFINITY;
#pragma unroll
            for (int j = 0; j < 4; ++j) { x[j] = row[lane + 64 * j]; m = fmaxf(m, x[j]); }
            m = wave_max(m); float s = 0.f;
#pragma unroll
            for (int j = 0; j < 4; ++j) { x[j] = __expf(x[j] - m); s += x[j]; }
            s = wave_sum(s); const float inv = 1.0f / s;
#pragma unroll
            for (int j = 0; j < 4; ++j) row[lane + 64 * j] = x[j] * inv;
        }
        __syncthreads();
        {
            const int c = tid & 255;
            float acc[8];
#pragma unroll
            for (int h = 0; h < 8; ++h) acc[h] = 0.f;
            const bf16_t* cb = CKV + (size_t)b * SEQ * 256 + c;
            for (int kk = 0; kk < ns; ++kk) {
                const float cv = bf2f(cb[(size_t)sel[kk] * 256]);
#pragma unroll
                for (int h = 0; h < 8; ++h) acc[h] += lgt[(hg * 8 + h) * 256 + kk] * cv;
            }
#pragma unroll
            for (int h = 0; h < 8; ++h) QA[(size_t)t * 4096 + (hg * 8 + h) * 256 + c] = (bf16_t)f2bf(acc[h]);
        }
        __syncthreads();
    }
}

constexpr int NPH_TOTAL = 23;


typedef short v4i16_t __attribute__((ext_vector_type(4)));
template <bool DRY>
__device__ __forceinline__ void phase_sparse_attn_mfma(const Params& P, unsigned char* lds_) {
    using pg8::bf16x8;
    bf16_t* QA = (bf16_t*)(P.ws + WS_QA); const unsigned char* CKV = (const unsigned char*)(P.ws + WS_CKV); const unsigned short* SEL = (const unsigned short*)(P.ws + WS_SEL);
    const int tid = threadIdx.x, lane = tid & 63, wave = __builtin_amdgcn_readfirstlane(tid >> 6);
    const int fr = lane & 15, fq = lane >> 4;
    LAS unsigned char* cbuf = (LAS unsigned char*)lds_ + wave * 16896;
    LAS unsigned short* selw = (LAS unsigned short*)(cbuf + 16384);
    const int G = gridDim.x, NGW = G * NWAVE;
    int vw;
    if ((G & 7) == 0) vw = (((int)blockIdx.x & 7) * (G >> 3) + ((int)blockIdx.x >> 3)) * NWAVE + wave; else vw = (int)blockIdx.x * NWAVE + wave;
    const float LOG2E = 1.4426950408889634f;
    const float slope2 = exp2f(-0.5f * (float)(fr + 1)) * LOG2E;
    unsigned qoffB[4];
#pragma unroll
    for (int e = 0; e < 4; ++e) { const int key7 = (2 * e + (lane >> 5)) & 7; qoffB[e] = (unsigned)(((lane & 31) ^ (key7 << 1)) << 4); }
    const int rowA = fr;
    const unsigned swzA = (unsigned)((rowA & 7) << 1);
    const int rowT = 4 * fq + (fr >> 2);
    const unsigned swzT = (unsigned)((rowT & 7) << 1), pbT = (unsigned)((fr & 3) >> 1), halfT = (unsigned)(fr & 1) * 8u;
    const int per = NGW >> 2, bq = vw / per, wb = vw % per;
    for (int tl0 = wb; tl0 < SEQ; tl0 += per) {
        const int t = bq * SEQ + tl0;
        const int b = t >> 13, tl = t & (SEQ - 1), ns = min(tl + 1, TOPK), nch = (ns + 31) >> 5;
        {
            const u32x2 w = *(const u32x2*)(SEL + (size_t)t * TOPK + 4 * lane);
            unsigned short i0 = (unsigned short)(w.x & 0xffffu), i1 = (unsigned short)(w.x >> 16), i2 = (unsigned short)(w.y & 0xffffu), i3 = (unsigned short)(w.y >> 16);
            const int k0 = 4 * lane;
            if (k0 >= ns) i0 = 0; if (k0 + 1 >= ns) i1 = 0; if (k0 + 2 >= ns) i2 = 0; if (k0 + 3 >= ns) i3 = 0;
            u32x2 o; o.x = (unsigned)i0 | ((unsigned)i1 << 16); o.y = (unsigned)i2 | ((unsigned)i3 << 16);
            *(LAS u32x2*)(selw + 4 * lane) = o;
        }
        bf16x8 qf[8];
#pragma unroll
        for (int cc = 0; cc < 8; ++cc) qf[cc] = *(const bf16x8*)(QA + (size_t)t * 4096 + fr * 256 + 32 * cc + 8 * fq);
        f32x4 O[16];
#pragma unroll
        for (int ct = 0; ct < 16; ++ct) O[ct] = (f32x4){0.f, 0.f, 0.f, 0.f};
        float m = -INFINITY, l = 0.f;
        const unsigned char* cb = CKV + (size_t)b * SEQ * 512;
        for (int j = 0; j < nch; ++j) {
            asm volatile("s_waitcnt lgkmcnt(0)" ::: "memory");
#pragma unroll
            for (int e = 0; e < 16; ++e) {
                const unsigned idx = selw[32 * j + 2 * e + (lane >> 5)];
                __builtin_amdgcn_global_load_lds((const unsigned*)(cb + (size_t)idx * 512 + qoffB[e & 3]), (LAS unsigned*)(cbuf + e * 1024), 16, 0, 0);
            }
            asm volatile("s_waitcnt vmcnt(0)" ::: "memory");
            f32x4 s0 = {0.f, 0.f, 0.f, 0.f}, s1 = {0.f, 0.f, 0.f, 0.f};
#pragma unroll
            for (int cc = 0; cc < 8; ++cc) {
                const unsigned ch = (((unsigned)(4 * cc + fq)) ^ swzA) << 4;
                const bf16x8 a0 = *(const LAS bf16x8*)(cbuf + rowA * 512 + ch);
                const bf16x8 a1 = *(const LAS bf16x8*)(cbuf + (16 + rowA) * 512 + ch);
                s0 = __builtin_amdgcn_mfma_f32_16x16x32_bf16(a0, qf[cc], s0, 0, 0, 0);
                s1 = __builtin_amdgcn_mfma_f32_16x16x32_bf16(a1, qf[cc], s1, 0, 0, 0);
            }
            const u32x2 k0w = *(const LAS u32x2*)(selw + 32 * j + 4 * fq), k1w = *(const LAS u32x2*)(selw + 32 * j + 16 + 4 * fq);
            const int kb0 = 32 * j + 4 * fq, kb1 = kb0 + 16;
            float lg[8];
            {
                const int i00 = (int)(k0w.x & 0xffffu), i01 = (int)(k0w.x >> 16), i02 = (int)(k0w.y & 0xffffu), i03 = (int)(k0w.y >> 16);
                const int i10 = (int)(k1w.x & 0xffffu), i11 = (int)(k1w.x >> 16), i12 = (int)(k1w.y & 0xffffu), i13 = (int)(k1w.y >> 16);
                lg[0] = (kb0 + 0 < ns) ? s0.x * LOG2E - slope2 * (float)(tl - i00) : -INFINITY;
                lg[1] = (kb0 + 1 < ns) ? s0.y * LOG2E - slope2 * (float)(tl - i01) : -INFINITY;
                lg[2] = (kb0 + 2 < ns) ? s0.z * LOG2E - slope2 * (float)(tl - i02) : -INFINITY;
                lg[3] = (kb0 + 3 < ns) ? s0.w * LOG2E - slope2 * (float)(tl - i03) : -INFINITY;
                lg[4] = (kb1 + 0 < ns) ? s1.x * LOG2E - slope2 * (float)(tl - i10) : -INFINITY;
                lg[5] = (kb1 + 1 < ns) ? s1.y * LOG2E - slope2 * (float)(tl - i11) : -INFINITY;
                lg[6] = (kb1 + 2 < ns) ? s1.z * LOG2E - slope2 * (float)(tl - i12) : -INFINITY;
                lg[7] = (kb1 + 3 < ns) ? s1.w * LOG2E - slope2 * (float)(tl - i13) : -INFINITY;
            }
            float cm = fmaxf(fmaxf(fmaxf(lg[0], lg[1]), fmaxf(lg[2], lg[3])), fmaxf(fmaxf(lg[4], lg[5]), fmaxf(lg[6], lg[7])));
            cm = fmaxf(cm, __shfl_xor(cm, 16)); cm = fmaxf(cm, __shfl_xor(cm, 32));
            const float mn = fmaxf(m, cm);
            if (__any(mn > m)) {
                const float sc = exp2f(m - mn);
                l *= sc;
#pragma unroll
                for (int ct = 0; ct < 16; ++ct) O[ct] *= sc;
                m = mn;
            }
            float p[8]; float ps = 0.f;
#pragma unroll
            for (int i = 0; i < 8; ++i) { p[i] = exp2f(lg[i] - m); ps += p[i]; }
            l += ps;
            u32x4 pw; pw.x = pk2(p[0], p[1]); pw.y = pk2(p[2], p[3]); pw.z = pk2(p[4], p[5]); pw.w = pk2(p[6], p[7]);
            const bf16x8 pk = __builtin_bit_cast(bf16x8, pw);
#pragma unroll
            for (int ct = 0; ct < 16; ++ct) {
                const unsigned ch = ((((unsigned)(2 * ct)) ^ swzT) | pbT) << 4;
                const v4i16_t lo = __builtin_amdgcn_ds_read_tr16_b64_v4i16((LAS v4i16_t*)(cbuf + rowT * 512 + ch + halfT));
                const v4i16_t hi = __builtin_amdgcn_ds_read_tr16_b64_v4i16((LAS v4i16_t*)(cbuf + (16 + rowT) * 512 + ch + halfT));
                const bf16x8 a = {lo[0], lo[1], lo[2], lo[3], hi[0], hi[1], hi[2], hi[3]};
                O[ct] = __builtin_amdgcn_mfma_f32_16x16x32_bf16(a, pk, O[ct], 0, 0, 0);
            }
        }
        l += __shfl_xor(l, 16); l += __shfl_xor(l, 32);
        const float inv = 1.0f / l;
        bf16_t* orow = (DRY ? (bf16_t*)(P.ws + WS_PP) + (size_t)(t & 8191) * 4096 : QA + (size_t)t * 4096) + fr * 256 + 4 * fq;
#pragma unroll
        for (int ct = 0; ct < 16; ++ct) { u32x2 w; w.x = pk2(O[ct].x * inv, O[ct].y * inv); w.y = pk2(O[ct].z * inv, O[ct].w * inv); *(u32x2*)(orow + 16 * ct) = w; }
    }
}


template <bool DRY>
__device__ __forceinline__ void phase_sparse_attn_f8(const Params& P, unsigned char* lds_) {
    using pg8::bf16x8;
    bf16_t* QA = (bf16_t*)(P.ws + WS_QA); const unsigned char* CKV8 = (const unsigned char*)(P.ws + WS_CKV8); const unsigned short* SEL = (const unsigned short*)(P.ws + WS_SEL);
    const int tid = threadIdx.x, lane = tid & 63, wave = __builtin_amdgcn_readfirstlane(tid >> 6);
    const int fr = lane & 15, fq = lane >> 4;
    LAS unsigned char* cbuf = (LAS unsigned char*)lds_ + wave * 16896;
    LAS unsigned short* selw = (LAS unsigned short*)(cbuf + 16384);
    const int G = gridDim.x, NGW = G * NWAVE;
    int vw;
    if ((G & 7) == 0) vw = (((int)blockIdx.x & 7) * (G >> 3) + ((int)blockIdx.x >> 3)) * NWAVE + wave; else vw = (int)blockIdx.x * NWAVE + wave;
    const float LOG2E = 1.4426950408889634f;
    const float slope2 = exp2f(-0.5f * (float)(fr + 1)) * LOG2E;
    const int rowA = fr;
    const unsigned swzA = (unsigned)((rowA & 7) << 1);
    const int rowT = 4 * fq + (fr >> 2);
    const unsigned swzT = (unsigned)((rowT & 7) << 1), pbT = (unsigned)((fr & 3) >> 1), halfT = (unsigned)(fr & 1) * 8u;
    const unsigned swzA16 = (swzA ^ (unsigned)fq) << 4, baseA = (unsigned)rowA * 512u;
    const unsigned swzT16 = swzT << 4, baseT = (unsigned)rowT * 512u + (pbT << 4) + halfT;
    unsigned wofs[2];
#pragma unroll
    for (int e = 0; e < 2; ++e) { const int key7 = (4 * e + fq) & 7; wofs[e] = (unsigned)(fq * 512 + (((2 * fr) ^ (key7 << 1)) << 4)); }
    const int per = NGW >> 2, bq = vw / per, wb = vw % per;
    for (int tl0 = wb; tl0 < SEQ; tl0 += per) {
        const int t = bq * SEQ + tl0;
        const int b = t >> 13, tl = t & (SEQ - 1), ns = min(tl + 1, TOPK), nch = (ns + 31) >> 5;
        {
            const u32x2 w = *(const u32x2*)(SEL + (size_t)t * TOPK + 4 * lane);
            unsigned short i0 = (unsigned short)(w.x & 0xffffu), i1 = (unsigned short)(w.x >> 16), i2 = (unsigned short)(w.y & 0xffffu), i3 = (unsigned short)(w.y >> 16);
            const int k0 = 4 * lane;
            if (k0 >= ns) i0 = 0; if (k0 + 1 >= ns) i1 = 0; if (k0 + 2 >= ns) i2 = 0; if (k0 + 3 >= ns) i3 = 0;
            u32x2 o; o.x = (unsigned)i0 | ((unsigned)i1 << 16); o.y = (unsigned)i2 | ((unsigned)i3 << 16);
            *(LAS u32x2*)(selw + 4 * lane) = o;
        }
        bf16x8 qf[8];
#pragma unroll
        for (int cc = 0; cc < 8; ++cc) qf[cc] = *(const bf16x8*)(QA + (size_t)t * 4096 + fr * 256 + 32 * cc + 8 * fq);
        f32x4 O[16];
#pragma unroll
        for (int ct = 0; ct < 16; ++ct) O[ct] = (f32x4){0.f, 0.f, 0.f, 0.f};
        float m = -INFINITY, l = 0.f;
        const unsigned char* cb = CKV8 + (size_t)b * SEQ * 256 + 16 * fr;
        u32x4 stg[8];
#pragma unroll
        for (int e = 0; e < 8; ++e) { const unsigned idx = selw[4 * e + fq]; stg[e] = *(const u32x4*)(cb + (size_t)idx * 256); }
        for (int j = 0; j < nch; ++j) {
#pragma unroll
            for (int e = 0; e < 8; ++e) {
                const u32x4 w = stg[e];
                u32x4 lo, hi;
                lo.x = f8dec2(__builtin_amdgcn_perm(0u, w.x, 0x0c010c00u)); lo.y = f8dec2(__builtin_amdgcn_perm(0u, w.x, 0x0c030c02u));
                lo.z = f8dec2(__builtin_amdgcn_perm(0u, w.y, 0x0c010c00u)); lo.w = f8dec2(__builtin_amdgcn_perm(0u, w.y, 0x0c030c02u));
                hi.x = f8dec2(__builtin_amdgcn_perm(0u, w.z, 0x0c010c00u)); hi.y = f8dec2(__builtin_amdgcn_perm(0u, w.z, 0x0c030c02u));
                hi.z = f8dec2(__builtin_amdgcn_perm(0u, w.w, 0x0c010c00u)); hi.w = f8dec2(__builtin_amdgcn_perm(0u, w.w, 0x0c030c02u));
                LAS unsigned char* dst = cbuf + (e >> 1) * 4096 + (e & 1) * 2048 + wofs[e & 1];
                *(LAS u32x4*)dst = lo; *(LAS u32x4*)(dst + 16) = hi;
            }
            if (j + 1 < nch) {
#pragma unroll
                for (int e = 0; e < 8; ++e) { const unsigned idx = selw[32 * (j + 1) + 4 * e + fq]; stg[e] = *(const u32x4*)(cb + (size_t)idx * 256); }
            }
            f32x4 s0 = {0.f, 0.f, 0.f, 0.f}, s1 = {0.f, 0.f, 0.f, 0.f};
#pragma unroll
            for (int cc = 0; cc < 8; ++cc) {
                const LAS unsigned char* pa = cbuf + ((swzA16 ^ (unsigned)(cc << 6)) + baseA);
                const bf16x8 a0 = *(const LAS bf16x8*)(pa);
                const bf16x8 a1 = *(const LAS bf16x8*)(pa + 8192);
                s0 = __builtin_amdgcn_mfma_f32_16x16x32_bf16(a0, qf[cc], s0, 0, 0, 0);
                s1 = __builtin_amdgcn_mfma_f32_16x16x32_bf16(a1, qf[cc], s1, 0, 0, 0);
            }
            const u32x2 k0w = *(const LAS u32x2*)(selw + 32 * j + 4 * fq), k1w = *(const LAS u32x2*)(selw + 32 * j + 16 + 4 * fq);
            const int kb0 = 32 * j + 4 * fq, kb1 = kb0 + 16;
            float lg[8];
            {
                const int i00 = (int)(k0w.x & 0xffffu), i01 = (int)(k0w.x >> 16), i02 = (int)(k0w.y & 0xffffu), i03 = (int)(k0w.y >> 16);
                const int i10 = (int)(k1w.x & 0xffffu), i11 = (int)(k1w.x >> 16), i12 = (int)(k1w.y & 0xffffu), i13 = (int)(k1w.y >> 16);
                lg[0] = (kb0 + 0 < ns) ? s0.x * LOG2E - slope2 * (float)(tl - i00) : -INFINITY;
                lg[1] = (kb0 + 1 < ns) ? s0.y * LOG2E - slope2 * (float)(tl - i01) : -INFINITY;
                lg[2] = (kb0 + 2 < ns) ? s0.z * LOG2E - slope2 * (float)(tl - i02) : -INFINITY;
                lg[3] = (kb0 + 3 < ns) ? s0.w * LOG2E - slope2 * (float)(tl - i03) : -INFINITY;
                lg[4] = (kb1 + 0 < ns) ? s1.x * LOG2E - slope2 * (float)(tl - i10) : -INFINITY;
                lg[5] = (kb1 + 1 < ns) ? s1.y * LOG2E - slope2 * (float)(tl - i11) : -INFINITY;
                lg[6] = (kb1 + 2 < ns) ? s1.z * LOG2E - slope2 * (float)(tl - i12) : -INFINITY;
                lg[7] = (kb1 + 3 < ns) ? s1.w * LOG2E - slope2 * (float)(tl - i13) : -INFINITY;
            }
            float cm = fmaxf(fmaxf(fmaxf(lg[0], lg[1]), fmaxf(lg[2], lg[3])), fmaxf(fmaxf(lg[4], lg[5]), fmaxf(lg[6], lg[7])));
            cm = fmaxf(cm, __shfl_xor(cm, 16)); cm = fmaxf(cm, __shfl_xor(cm, 32));
            const float mn = fmaxf(m, cm);
            if (__any(mn > m)) {
                const float sc = __builtin_amdgcn_exp2f(m - mn);
                l *= sc;
#pragma unroll
                for (int ct = 0; ct < 16; ++ct) O[ct] *= sc;
                m = mn;
            }
            float p[8]; float ps = 0.f;
#pragma unroll
            for (int i = 0; i < 8; ++i) { p[i] = __builtin_amdgcn_exp2f(lg[i] - m); ps += p[i]; }
            l += ps;
            u32x4 pw; pw.x = pk2(p[0], p[1]); pw.y = pk2(p[2], p[3]); pw.z = pk2(p[4], p[5]); pw.w = pk2(p[6], p[7]);
            const bf16x8 pk = __builtin_bit_cast(bf16x8, pw);
#pragma unroll
            for (int ct = 0; ct < 16; ++ct) {
                const LAS unsigned char* pt = cbuf + ((swzT16 ^ (unsigned)(ct << 5)) + baseT);
                const v4i16_t lo = __builtin_amdgcn_ds_read_tr16_b64_v4i16((LAS v4i16_t*)(pt));
                const v4i16_t hi = __builtin_amdgcn_ds_read_tr16_b64_v4i16((LAS v4i16_t*)(pt + 8192));
                const bf16x8 a = {lo[0], lo[1], lo[2], lo[3], hi[0], hi[1], hi[2], hi[3]};
                O[ct] = __builtin_amdgcn_mfma_f32_16x16x32_bf16(a, pk, O[ct], 0, 0, 0);
            }
        }
        l += __shfl_xor(l, 16); l += __shfl_xor(l, 32);
        const float inv = 1.0f / l;
        bf16_t* orow = (DRY ? (bf16_t*)(P.ws + WS_PP) + (size_t)(t & 8191) * 4096 : QA + (size_t)t * 4096) + fr * 256 + 4 * fq;
#pragma unroll
        for (int ct = 0; ct < 16; ++ct) { u32x2 w; w.x = pk2(O[ct].x * inv, O[ct].y * inv); w.y = pk2(O[ct].z * inv, O[ct].w * inv); *(u32x2*)(orow + 16 * ct) = w; }
    }
}


__device__ __forceinline__ void glds16(const void* gsrc, unsigned lds_dst) {
    unsigned keep;
    asm volatile("s_mov_b32 %0, m0\n\ts_mov_b32 m0, %2\n\ts_nop 0\n\tglobal_load_lds_dwordx4 %1, off\n\ts_mov_b32 m0, %0" : "=&s"(keep) : "v"(gsrc), "s"(lds_dst) : "memory");
}
typedef _Float16 f16x8 __attribute__((ext_vector_type(8)));
template <bool DRY>
__device__ __forceinline__ void phase_sparse_attn_e(const Params& P, unsigned char* lds_) {
    unsigned short* QA = (unsigned short*)(P.ws + WS_QA); const unsigned char* CKV8 = (const unsigned char*)(P.ws + WS_CKV8); const unsigned short* SEL = (const unsigned short*)(P.ws + WS_SEL);
    const int tid = threadIdx.x, lane = tid & 63, wave = __builtin_amdgcn_readfirstlane(tid >> 6);
    const int fr = lane & 15, fq = lane >> 4;
    LAS unsigned char* cbuf = (LAS unsigned char*)lds_ + wave * 16896;
    LAS unsigned short* selw = (LAS unsigned short*)(cbuf + 16384);
    const unsigned cbuf0 = (unsigned)(unsigned long)cbuf;
    const int G = gridDim.x, NGW = G * NWAVE;
    int vw;
    if ((G & 7) == 0) vw = (((int)blockIdx.x & 7) * (G >> 3) + ((int)blockIdx.x >> 3)) * NWAVE + wave; else vw = (int)blockIdx.x * NWAVE + wave;
    const float LOG2E = 1.4426950408889634f;
    const float slope2 = exp2f(-0.5f * (float)(fr + 1)) * LOG2E;
    unsigned qoffB[4];
#pragma unroll
    for (int e = 0; e < 4; ++e) { const int r15 = (4 * e + fq) & 15; qoffB[e] = (unsigned)((fr ^ (((r15 & 7) << 1) | (r15 >> 3))) << 4); }
    const unsigned fA = (unsigned)(((fr & 7) << 1) | (fr >> 3));
    const unsigned SA = (fA & 14u) << 4, baseA = (unsigned)fr * 256u + ((((unsigned)fq >> 1) ^ (fA & 1u)) << 4) + ((unsigned)fq & 1u) * 8u;
    const int rT = 4 * fq + (fr >> 2), pT_ = fr & 3;
    const unsigned fT = (unsigned)(((rT & 7) << 1) | (rT >> 3));
    const unsigned ST = (fT & 14u) << 4, baseT = (unsigned)rT * 256u + ((((unsigned)pT_ >> 1) ^ (fT & 1u)) << 4) + ((unsigned)pT_ & 1u) * 8u;
    const int per = NGW >> 2, bq = vw / per, wb = vw % per;
    for (int tl0 = wb; tl0 < SEQ; tl0 += per) {
        const int t = bq * SEQ + tl0;
        const int b = t >> 13, tl = t & (SEQ - 1), ns = min(tl + 1, TOPK), nch = (ns + 31) >> 5;
        {
            const u32x2 w = *(const u32x2*)(SEL + (size_t)t * TOPK + 4 * lane);
            unsigned short i0 = (unsigned short)(w.x & 0xffffu), i1 = (unsigned short)(w.x >> 16), i2 = (unsigned short)(w.y & 0xffffu), i3 = (unsigned short)(w.y >> 16);
            const int k0 = 4 * lane;
            if (k0 >= ns) i0 = 0; if (k0 + 1 >= ns) i1 = 0; if (k0 + 2 >= ns) i2 = 0; if (k0 + 3 >= ns) i3 = 0;
            u32x2 o; o.x = (unsigned)i0 | ((unsigned)i1 << 16); o.y = (unsigned)i2 | ((unsigned)i3 << 16);
            asm volatile("s_waitcnt lgkmcnt(0)" ::: "memory");
            *(LAS u32x2*)(selw + 4 * lane) = o;
        }
        f16x8 qf[8];
#pragma unroll
        for (int cc = 0; cc < 8; ++cc) qf[cc] = *(const f16x8*)(QA + (size_t)t * 4096 + fr * 256 + 32 * cc + 8 * fq);
        f32x4 Oe[8], Oo[8];
#pragma unroll
        for (int ut = 0; ut < 8; ++ut) { Oe[ut] = (f32x4){0.f, 0.f, 0.f, 0.f}; Oo[ut] = (f32x4){0.f, 0.f, 0.f, 0.f}; }
        float m = -INFINITY, l = 0.f;
        const unsigned char* cb = CKV8 + (size_t)b * SEQ * 256;
        asm volatile("s_waitcnt vmcnt(0) lgkmcnt(0)" ::: "memory");
#define ATT_DMA(jj, bufoff) do { unsigned idx_[8]; \
            _Pragma("unroll") for (int e = 0; e < 8; ++e) idx_[e] = (DRY && PROBE_ATT == 1) ? (unsigned)((32 * (jj) + 4 * e + fq + 64 * wave) & 8191) : (unsigned)selw[32 * (jj) + 4 * e + fq]; \
            _Pragma("unroll") for (int e = 0; e < 8; ++e) { \
            if (!(DRY && PROBE_ATT == 3)) glds16(cb + (size_t)idx_[e] * 256 + qoffB[e & 3], (unsigned)__builtin_amdgcn_readfirstlane((int)(cbuf0 + (bufoff) + e * 1024))); } } while (0)
        ATT_DMA(0, 0);
        if (nch > 1) ATT_DMA(1, 8192);
        for (int j = 0; j < nch; ++j) {
            const unsigned bo = (unsigned)(j & 1) * 8192u;
            if (j + 1 < nch) asm volatile("s_waitcnt vmcnt(8)" ::: "memory"); else asm volatile("s_waitcnt vmcnt(0)" ::: "memory");
            const LAS unsigned char* img = cbuf + bo;
            if (DRY && PROBE_ATT == 2) { if (j + 2 < nch) { asm volatile("s_waitcnt lgkmcnt(0)" ::: "memory"); ATT_DMA(j + 2, bo); } continue; }
            u32x2 ra[8], rb[8];
#pragma unroll
            for (int cc = 0; cc < 8; ++cc) { const LAS unsigned char* pa = img + ((SA ^ (unsigned)(cc << 5)) + baseA); ra[cc] = *(const LAS u32x2*)(pa); rb[cc] = *(const LAS u32x2*)(pa + 4096); }
            const u32x2 k0w = *(const LAS u32x2*)(selw + 32 * j + 4 * fq), k1w = *(const LAS u32x2*)(selw + 32 * j + 16 + 4 * fq);
            __builtin_amdgcn_sched_barrier(0);
            f32x4 s0 = {0.f, 0.f, 0.f, 0.f}, s1 = {0.f, 0.f, 0.f, 0.f};
#pragma unroll
            for (int cc = 0; cc < 8; ++cc) {
                u32x4 a0, a1;
                a0.x = __builtin_amdgcn_perm(0u, ra[cc].x, 0x010c000cu); a0.y = __builtin_amdgcn_perm(0u, ra[cc].x, 0x030c020cu); a0.z = __builtin_amdgcn_perm(0u, ra[cc].y, 0x010c000cu); a0.w = __builtin_amdgcn_perm(0u, ra[cc].y, 0x030c020cu);
                a1.x = __builtin_amdgcn_perm(0u, rb[cc].x, 0x010c000cu); a1.y = __builtin_amdgcn_perm(0u, rb[cc].x, 0x030c020cu); a1.z = __builtin_amdgcn_perm(0u, rb[cc].y, 0x010c000cu); a1.w = __builtin_amdgcn_perm(0u, rb[cc].y, 0x030c020cu);
                s0 = __builtin_amdgcn_mfma_f32_16x16x32_f16(__builtin_bit_cast(f16x8, a0), qf[cc], s0, 0, 0, 0);
                s1 = __builtin_amdgcn_mfma_f32_16x16x32_f16(__builtin_bit_cast(f16x8, a1), qf[cc], s1, 0, 0, 0);
            }
            __builtin_amdgcn_sched_barrier(0);
            u32x2 tl_[8], th_[8];
#pragma unroll
            for (int ut = 0; ut < 8; ++ut) { const LAS unsigned char* pt = img + ((ST ^ (unsigned)(ut << 5)) + baseT);
                tl_[ut] = __builtin_bit_cast(u32x2, __builtin_amdgcn_ds_read_tr16_b64_v4i16((LAS v4i16_t*)(pt)));
                th_[ut] = __builtin_bit_cast(u32x2, __builtin_amdgcn_ds_read_tr16_b64_v4i16((LAS v4i16_t*)(pt + 4096))); }
            __builtin_amdgcn_sched_barrier(0);
            const int kb0 = 32 * j + 4 * fq, kb1 = kb0 + 16;
            float lg[8];
            {
                const int i00 = (int)(k0w.x & 0xffffu), i01 = (int)(k0w.x >> 16), i02 = (int)(k0w.y & 0xffffu), i03 = (int)(k0w.y >> 16);
                const int i10 = (int)(k1w.x & 0xffffu), i11 = (int)(k1w.x >> 16), i12 = (int)(k1w.y & 0xffffu), i13 = (int)(k1w.y >> 16);
                lg[0] = (kb0 + 0 < ns) ? s0.x * LOG2E - slope2 * (float)(tl - i00) : -INFINITY;
                lg[1] = (kb0 + 1 < ns) ? s0.y * LOG2E - slope2 * (float)(tl - i01) : -INFINITY;
                lg[2] = (kb0 + 2 < ns) ? s0.z * LOG2E - slope2 * (float)(tl - i02) : -INFINITY;
                lg[3] = (kb0 + 3 < ns) ? s0.w * LOG2E - slope2 * (float)(tl - i03) : -INFINITY;
                lg[4] = (kb1 + 0 < ns) ? s1.x * LOG2E - slope2 * (float)(tl - i10) : -INFINITY;
                lg[5] = (kb1 + 1 < ns) ? s1.y * LOG2E - slope2 * (float)(tl - i11) : -INFINITY;
                lg[6] = (kb1 + 2 < ns) ? s1.z * LOG2E - slope2 * (float)(tl - i12) : -INFINITY;
                lg[7] = (kb1 + 3 < ns) ? s1.w * LOG2E - slope2 * (float)(tl - i13) : -INFINITY;
            }
            const float cm = fmaxf(fmaxf(fmaxf(lg[0], lg[1]), fmaxf(lg[2], lg[3])), fmaxf(fmaxf(lg[4], lg[5]), fmaxf(lg[6], lg[7])));
            if (__any(cm > m + 8.0f)) {
                float cx = fmaxf(cm, __shfl_xor(cm, 16)); cx = fmaxf(cx, __shfl_xor(cx, 32));
                const float mn = fmaxf(m, cx);
                const float sc = __builtin_amdgcn_exp2f(m - mn);
                l *= sc;
#pragma unroll
                for (int ut = 0; ut < 8; ++ut) { Oe[ut] *= sc; Oo[ut] *= sc; }
                m = mn;
            }
            float p[8]; float ps = 0.f;
#pragma unroll
            for (int i = 0; i < 8; ++i) { p[i] = __builtin_amdgcn_exp2f(lg[i] - m); ps += p[i]; }
            l += ps;
            u32x4 pw;
            pw.x = __builtin_bit_cast(unsigned, __builtin_amdgcn_cvt_pkrtz(p[0], p[1])); pw.y = __builtin_bit_cast(unsigned, __builtin_amdgcn_cvt_pkrtz(p[2], p[3]));
            pw.z = __builtin_bit_cast(unsigned, __builtin_amdgcn_cvt_pkrtz(p[4], p[5])); pw.w = __builtin_bit_cast(unsigned, __builtin_amdgcn_cvt_pkrtz(p[6], p[7]));
            const f16x8 pk = __builtin_bit_cast(f16x8, pw);
#pragma unroll
            for (int ut = 0; ut < 8; ++ut) {
                const u32x2 lw = tl_[ut], hw = th_[ut];
                u32x4 ae, ao;
                ae.x = __builtin_amdgcn_perm(0u, lw.x, 0x020c000cu); ae.y = __builtin_amdgcn_perm(0u, lw.y, 0x020c000cu); ae.z = __builtin_amdgcn_perm(0u, hw.x, 0x020c000cu); ae.w = __builtin_amdgcn_perm(0u, hw.y, 0x020c000cu);
                ao.x = __builtin_amdgcn_perm(0u, lw.x, 0x030c010cu); ao.y = __builtin_amdgcn_perm(0u, lw.y, 0x030c010cu); ao.z = __builtin_amdgcn_perm(0u, hw.x, 0x030c010cu); ao.w = __builtin_amdgcn_perm(0u, hw.y, 0x030c010cu);
                Oe[ut] = __builtin_amdgcn_mfma_f32_16x16x32_f16(__builtin_bit_cast(f16x8, ae), pk, Oe[ut], 0, 0, 0);
                Oo[ut] = __builtin_amdgcn_mfma_f32_16x16x32_f16(__builtin_bit_cast(f16x8, ao), pk, Oo[ut], 0, 0, 0);
            }
            if (j + 2 < nch) { asm volatile("s_waitcnt lgkmcnt(0)" ::: "memory"); ATT_DMA(j + 2, bo); }
        }
#undef ATT_DMA
        l += __shfl_xor(l, 16); l += __shfl_xor(l, 32);
        const float inv = 1.0f / l;
        bf16_t* orow = (DRY ? (bf16_t*)(P.ws + WS_PP) + (size_t)(t & 8191) * 4096 : (bf16_t*)QA + (size_t)t * 4096) + fr * 256 + 8 * fq;
#pragma unroll
        for (int ut = 0; ut < 8; ++ut) {
            u32x4 w; w.x = pk2(Oe[ut].x * inv, Oo[ut].x * inv); w.y = pk2(Oe[ut].y * inv, Oo[ut].y * inv); w.z = pk2(Oe[ut].z * inv, Oo[ut].z * inv); w.w = pk2(Oe[ut].w * inv, Oo[ut].w * inv);
            *(u32x4*)(orow + 32 * ut) = w;
        }
    }
}

constexpr size_t SC_BATCH = (size_t)1024 * 256 * 257 / 2;
__device__ __forceinline__ size_t sc_row_off(int b, int tl) { const size_t m = (size_t)(tl >> 5); return (size_t)b * SC_BATCH + 1024 * (m * (m + 1) / 2) + (size_t)(tl & 31) * 32 * (m + 1); }
typedef float f32x16 __attribute__((ext_vector_type(16)));
__device__ __forceinline__ unsigned okey_pk(float a, float b) {
    const unsigned w = __builtin_bit_cast(unsigned, __builtin_amdgcn_cvt_pkrtz(a, b));
    const unsigned neg = (w >> 15) & 0x00010001u;
    return w ^ ((neg * 0xffffu) | 0x80008000u);
}
__device__ __forceinline__ void phase_index_scores(const Params& P, unsigned char* lds_) {
    using pg8::bf16x8;
    const bf16_t* Z1 = (const bf16_t*)(P.ws + WS_Z1); unsigned short* SC = (unsigned short*)(P.ws + WS_SC);
    LAS unsigned char* lds = (LAS unsigned char*)lds_;
    constexpr int QROW = 144;
    LAS unsigned char* QL = lds;
    LAS float* SG = (LAS float*)(lds + 9 * 64 * QROW);
    const int tid = threadIdx.x, lane = tid & 63, wave = __builtin_amdgcn_readfirstlane(tid >> 6);
    LAS unsigned char* ST = lds + 9 * 64 * QROW + 2048 + wave * 5120;
    const int l31 = lane & 31, hh = lane >> 5;
    for (int pid = blockIdx.x; pid < 256; pid += gridDim.x) {
        const int b = pid >> 6;
        for (int side = 0; side < 2; ++side) {
            const int qb = side ? (127 - (pid & 63)) : (pid & 63);
            const int q0 = qb * 64;
            __syncthreads();
            {
                const int qi = tid >> 3, part = tid & 7;
                const bf16_t* zr = Z1 + ((size_t)b * SEQ + q0 + qi) * Z1W;
                const u32x4 ww = *(const u32x4*)(zr + 1088);
                const float w8[8] = {bflo(ww.x), bfhi(ww.x), bflo(ww.y), bfhi(ww.y), bflo(ww.z), bfhi(ww.z), bflo(ww.w), bfhi(ww.w)};
                float wh = 0.f;
#pragma unroll
                for (int h = 0; h < 8; ++h) wh = (h == part) ? w8[h] : wh;
                const float sc = 0.5f * fabsf(wh);
                SG[qi * 8 + part] = (wh >= 0.f) ? 1.0f : -1.0f;
#pragma unroll
                for (int c = 0; c < 8; ++c) {
                    const u32x4 v = *(const u32x4*)(zr + 512 + part * 64 + c * 8);
                    u32x4 o; o.x = pk2(bflo(v.x) * sc, bfhi(v.x) * sc); o.y = pk2(bflo(v.y) * sc, bfhi(v.y) * sc); o.z = pk2(bflo(v.z) * sc, bfhi(v.z) * sc); o.w = pk2(bflo(v.w) * sc, bfhi(v.w) * sc);
                    *(LAS u32x4*)(QL + (part * 64 + qi) * QROW + c * 16) = o;
                }
                float a8[8];
#pragma unroll
                for (int j = 0; j < 8; ++j) a8[j] = 0.f;
#pragma unroll
                for (int h = 0; h < 8; ++h) {
                    const u32x4 v = *(const u32x4*)(zr + 512 + h * 64 + part * 8); const float s2 = 0.5f * w8[h];
                    a8[0] += s2 * bflo(v.x); a8[1] += s2 * bfhi(v.x); a8[2] += s2 * bflo(v.y); a8[3] += s2 * bfhi(v.y);
                    a8[4] += s2 * bflo(v.z); a8[5] += s2 * bfhi(v.z); a8[6] += s2 * bflo(v.w); a8[7] += s2 * bfhi(v.w);
                }
                u32x4 o; o.x = pk2(a8[0], a8[1]); o.y = pk2(a8[2], a8[3]); o.z = pk2(a8[4], a8[5]); o.w = pk2(a8[6], a8[7]);
                *(LAS u32x4*)(QL + (8 * 64 + qi) * QROW + part * 16) = o;
            }
            __syncthreads();
            const int ktmax = 2 * qb + 1;
            for (int kt = wave; kt <= ktmax; kt += NWAVE) {
                bf16x8 kf[4];
                const bf16_t* kr = Z1 + ((size_t)b * SEQ + kt * 32 + l31) * Z1W + 1024 + hh * 8;
#pragma unroll
                for (int dq = 0; dq < 4; ++dq) kf[dq] = *(const bf16x8*)(kr + dq * 16);
#pragma unroll
                for (int qs = 0; qs < 2; ++qs) {
                    const LAS unsigned char* qrow = QL + (qs * 32 + l31) * QROW + hh * 16;
                    f32x16 acc;
#pragma unroll
                    for (int r = 0; r < 16; ++r) acc[r] = 0.f;
#pragma unroll
                    for (int dq = 0; dq < 4; ++dq) acc = __builtin_amdgcn_mfma_f32_32x32x16_bf16(kf[dq], *(const LAS bf16x8*)(qrow + 8 * 64 * QROW + dq * 32), acc, 0, 0, 0);
#pragma unroll
                    for (int h = 0; h < 8; ++h) {
                        f32x16 u;
#pragma unroll
                        for (int r = 0; r < 16; ++r) u[r] = 0.f;
#pragma unroll
                        for (int dq = 0; dq < 4; ++dq) u = __builtin_amdgcn_mfma_f32_32x32x16_bf16(kf[dq], *(const LAS bf16x8*)(qrow + h * 64 * QROW + dq * 32), u, 0, 0, 0);
                        const float sg = SG[(qs * 32 + l31) * 8 + h];
#pragma unroll
                        for (int r = 0; r < 16; ++r) acc[r] = fmaf(fabsf(u[r]), sg, acc[r]);
                    }
#pragma unroll
                    for (int g = 0; g < 4; ++g) { u32x2 w; w.x = okey_pk(acc[4 * g], acc[4 * g + 1]); w.y = okey_pk(acc[4 * g + 2], acc[4 * g + 3]);
                        *(LAS u32x2*)(ST + (qs * 32 + l31) * 80 + (8 * g + 4 * hh) * 2) = w; }
                }
#pragma unroll
                for (int i = 0; i < 4; ++i) {
                    const int row = 16 * i + (lane >> 2), ch = lane & 3, tl = q0 + row;
                    const u32x4 v = *(const LAS u32x4*)(ST + row * 80 + ch * 16);
                    if (kt <= (tl >> 5)) *(u32x4*)(SC + sc_row_off(b, tl) + (size_t)kt * 32 + ch * 8) = v;
                }
            }
        }
    }
}
__device__ __forceinline__ void phase_index_select(const Params& P, unsigned char* lds_) {
    const unsigned short* SC = (const unsigned short*)(P.ws + WS_SC); unsigned short* SEL = (unsigned short*)(P.ws + WS_SEL);
    const int tid = threadIdx.x, lane = tid & 63, wave = __builtin_amdgcn_readfirstlane(tid >> 6);
    LAS unsigned* hist = (LAS unsigned*)lds_ + wave * 1280;
    LAS unsigned short* outw = (LAS unsigned short*)(hist + 1024);
    const int gw = blockIdx.x * NWAVE + wave, NGW = gridDim.x * NWAVE;
    for (int t = gw; t < NTOK; t += NGW) {
        const int b = t >> 13, tl = t & (SEQ - 1), n = tl + 1;
        unsigned short* so = SEL + (size_t)t * TOPK;
        if (n <= TOPK) { for (int i = lane; i < n; i += 64) so[i] = (unsigned short)i; continue; }
        const u32x4* row = (const u32x4*)(SC + sc_row_off(b, tl));
        u32x4 d[16];
#pragma unroll
        for (int sg = 0; sg < 16; ++sg) { if (sg * 512 < n) d[sg] = row[sg * 64 + lane]; else d[sg] = (u32x4){0u, 0u, 0u, 0u}; }
#pragma unroll
        for (int i = 0; i < 16; ++i) { hist[i * 64 + lane] = 0u; }
        asm volatile("s_waitcnt lgkmcnt(0)" ::: "memory");
#define KEY_OF(sg, j) ((((j) & 1) ? (d[sg][(j) >> 1] >> 16) : (d[sg][(j) >> 1] & 0xffffu)))
#define IDX_OF(sg, j) ((sg) * 512 + lane * 8 + (j))
        LAS unsigned* myh = hist + (lane & 3) * 256;
#pragma unroll
        for (int sg = 0; sg < 16; ++sg) if (sg * 512 < n) {
#pragma unroll
            for (int j = 0; j < 8; ++j) { const unsigned k = KEY_OF(sg, j); if (IDX_OF(sg, j) < n) atomicAdd((unsigned*)(myh + (k >> 8)), 1u); }
        }
        asm volatile("s_waitcnt lgkmcnt(0)" ::: "memory");
        unsigned b1, need1;
        {
            unsigned c[4];
#pragma unroll
            for (int q = 0; q < 4; ++q) c[q] = hist[4 * lane + q] + hist[256 + 4 * lane + q] + hist[512 + 4 * lane + q] + hist[768 + 4 * lane + q];
            const unsigned mine = c[0] + c[1] + c[2] + c[3];
            unsigned suf = mine;
#pragma unroll
            for (int o = 1; o < 64; o <<= 1) { const unsigned v = __shfl_down(suf, o); if (lane + o < 64) suf += v; }
            const unsigned above = suf - mine;
            int fb = -1; unsigned fneed = 0;
            if (above < (unsigned)TOPK && suf >= (unsigned)TOPK) { unsigned a = above;
#pragma unroll
                for (int q = 3; q >= 0; --q) { if (fb < 0 && a + c[q] >= (unsigned)TOPK) { fb = 4 * lane + q; fneed = (unsigned)TOPK - a; } a += c[q]; } }
            const unsigned long long bal = __ballot(fb >= 0);
            const int src = (int)__builtin_ctzll(bal);
            b1 = (unsigned)__shfl(fb, src); need1 = __shfl(fneed, src);
        }
#pragma unroll
        for (int i = 0; i < 16; ++i) { hist[i * 64 + lane] = 0u; }
        asm volatile("s_waitcnt lgkmcnt(0)" ::: "memory");
#pragma unroll
        for (int sg = 0; sg < 16; ++sg) if (sg * 512 < n) {
#pragma unroll
            for (int j = 0; j < 8; ++j) { const unsigned k = KEY_OF(sg, j); if (IDX_OF(sg, j) < n && (k >> 8) == b1) atomicAdd((unsigned*)(myh + (k & 255u)), 1u); }
        }
        asm volatile("s_waitcnt lgkmcnt(0)" ::: "memory");
        unsigned T, need2;
        {
            unsigned c[4];
#pragma unroll
            for (int q = 0; q < 4; ++q) c[q] = hist[4 * lane + q] + hist[256 + 4 * lane + q] + hist[512 + 4 * lane + q] + hist[768 + 4 * lane + q];
            const unsigned mine = c[0] + c[1] + c[2] + c[3];
            unsigned suf = mine;
#pragma unroll
            for (int o = 1; o < 64; o <<= 1) { const unsigned v = __shfl_down(suf, o); if (lane + o < 64) suf += v; }
            const unsigned above = suf - mine;
            int fb = -1; unsigned fneed = 0;
            if (above < need1 && suf >= need1) { unsigned a = above;
#pragma unroll
                for (int q = 3; q >= 0; --q) { if (fb < 0 && a + c[q] >= need1) { fb = 4 * lane + q; fneed = need1 - a; } a += c[q]; } }
            const unsigned long long bal = __ballot(fb >= 0);
            const int src = (int)__builtin_ctzll(bal);
            T = (b1 << 8) | (unsigned)__shfl(fb, src); need2 = __shfl(fneed, src);
        }
        unsigned base = 0; const unsigned ngt = (unsigned)TOPK - need2; unsigned eqbase = 0;
#pragma unroll
        for (int sg = 0; sg < 16; ++sg) if (sg * 512 < n) {
            unsigned ce = 0;
#pragma unroll
            for (int j = 0; j < 8; ++j) {
                const unsigned k = KEY_OF(sg, j); const bool ok = IDX_OF(sg, j) < n;
                const bool gt = ok && k > T;
                const unsigned long long mk = __ballot(gt);
                if (gt) outw[base + (unsigned)__builtin_amdgcn_mbcnt_hi((unsigned)(mk >> 32), __builtin_amdgcn_mbcnt_lo((unsigned)mk, 0u))] = (unsigned short)IDX_OF(sg, j);
                base += (unsigned)__builtin_popcountll(mk);
                ce += (ok && k == T) ? 1u : 0u;
            }
            if (__any(ce > 0u)) {
                unsigned pre = ce;
#pragma unroll
                for (int o = 1; o < 64; o <<= 1) { const unsigned v = __shfl_up(pre, o); if (lane >= o) pre += v; }
                unsigned r = eqbase + pre - ce;
#pragma unroll
                for (int j = 0; j < 8; ++j) { const unsigned k = KEY_OF(sg, j); if (IDX_OF(sg, j) < n && k == T) { if (r < need2) outw[ngt + r] = (unsigned short)IDX_OF(sg, j); ++r; } }
                eqbase += __shfl(pre, 63);
            }
        }
#undef KEY_OF
#undef IDX_OF
        asm volatile("s_waitcnt lgkmcnt(0)" ::: "memory");
        ((unsigned*)so)[lane] = ((LAS unsigned*)outw)[lane];
        ((unsigned*)so)[64 + lane] = ((LAS unsigned*)outw)[64 + lane];
        asm volatile("s_waitcnt lgkmcnt(0)" ::: "memory");
    }
}


__device__ __forceinline__ void ret_fill_image(LAS unsigned char* img, const unsigned char* src, size_t row_stride_bytes, int wave, int lane) {
#pragma unroll
    for (int e4 = 0; e4 < 4; ++e4) {
        const int e = wave * 4 + e4, row = 4 * e + (lane >> 4), q = (lane & 15) ^ ((row & 7) << 1);
        __builtin_amdgcn_global_load_lds((const unsigned*)(src + (size_t)row * row_stride_bytes + q * 16), (LAS unsigned*)(img + e * 1024), 16, 0, 0);
    }
}
__device__ __forceinline__ pg8::bf16x8 ret_tr_pair(const LAS unsigned char* img, int row0, int chunk2, int lane) {
    const int g = lane >> 4, i = lane & 15, r0 = row0 + 4 * g + (i >> 2), pb = (i & 3) >> 1, half = (i & 1) * 8;
    const int r1 = r0 + 16;
    const v4i16_t lo = __builtin_amdgcn_ds_read_tr16_b64_v4i16((LAS v4i16_t*)(img + r0 * 256 + ((((chunk2) ^ ((r0 & 7) << 1)) | pb) << 4) + half));
    const v4i16_t hi = __builtin_amdgcn_ds_read_tr16_b64_v4i16((LAS v4i16_t*)(img + r1 * 256 + ((((chunk2) ^ ((r1 & 7) << 1)) | pb) << 4) + half));
    return (pg8::bf16x8){lo[0], lo[1], lo[2], lo[3], hi[0], hi[1], hi[2], hi[3]};
}
__device__ __forceinline__ void phase_ret_kv_mfma(const Params& P, unsigned char* lds_) {
    using pg8::bf16x8;
    const unsigned char* Z0 = (const unsigned char*)(P.ws + WS_Z0); float* KV = (float*)(P.ws + WS_KV);
    LAS unsigned char* Kimg = (LAS unsigned char*)lds_; LAS unsigned char* Vimg = Kimg + 32768;
    const int tid = threadIdx.x, lane = tid & 63, wave = __builtin_amdgcn_readfirstlane(tid >> 6), fr = lane & 15, fq = lane >> 4;
    for (int u = blockIdx.x; u < 1024; u += gridDim.x) {
        const int n = u & 63, h = (u >> 6) & 3, b = u >> 8;
        const size_t row0 = (size_t)b * SEQ + n * 128;
        __syncthreads();
        ret_fill_image(Kimg, Z0 + row0 * ZW * 2 + (512 + h * 128) * 2, ZW * 2, wave, lane);
        ret_fill_image(Vimg, Z0 + row0 * ZW * 2 + (1024 + h * 128) * 2, ZW * 2, wave, lane);
        asm volatile("s_waitcnt vmcnt(0)" ::: "memory");
        __syncthreads();
        bf16x8 va[4];
#pragma unroll
        for (int jc = 0; jc < 4; ++jc) va[jc] = ret_tr_pair(Vimg, 32 * jc, 2 * wave, lane);
        const float g127 = exp2f(ret_log2g(h) * 127.0f);
        float* o = KV + (size_t)u * 16384;
#pragma unroll
        for (int dt = 0; dt < 8; ++dt) {
            f32x4 acc = {0.f, 0.f, 0.f, 0.f};
#pragma unroll
            for (int jc = 0; jc < 4; ++jc) acc = __builtin_amdgcn_mfma_f32_16x16x32_bf16(va[jc], ret_tr_pair(Kimg, 32 * jc, 2 * dt, lane), acc, 0, 0, 0);
            *(f32x4*)(o + (size_t)(16 * dt + fr) * 128 + 16 * wave + 4 * fq) = acc * g127;
        }
    }
}
__device__ __forceinline__ void phase_ret_scan_pool2(const Params& P) {
    const float* KV = (const float*)(P.ws + WS_KV); bf16_t* SB = (bf16_t*)(P.ws + WS_SB);
    const size_t gt = (size_t)blockIdx.x * NT + threadIdx.x, GS = (size_t)gridDim.x * NT;
    for (size_t i = gt; i < (size_t)16 * 4096; i += GS) {
        const int s = (int)(i >> 12), e4 = (int)(i & 4095), h = s & 3;
        const float l2 = ret_log2g(h), cd = exp2f(l2 * 128.0f), g1 = exp2f(l2);
        const f32x4* p = (const f32x4*)(KV + (size_t)s * 64 * 16384) + e4;
        u32x2* q = (u32x2*)(SB + (size_t)s * 64 * 16384) + e4;
        f32x4 R = {0.f, 0.f, 0.f, 0.f};
        for (int n0 = 0; n0 < 64; n0 += 8) {
            f32x4 kv[8];
#pragma unroll
            for (int j = 0; j < 8; ++j) kv[j] = p[(size_t)(n0 + j) * 4096];
#pragma unroll
            for (int j = 0; j < 8; ++j) { u32x2 w; w.x = pk2(R.x * g1, R.y * g1); w.y = pk2(R.z * g1, R.w * g1); q[(size_t)(n0 + j) * 4096] = w; R = R * cd + kv[j]; }
        }
    }
    const bf16_t* Z0 = (const bf16_t*)(P.ws + WS_Z0); bf16_t* DP = (bf16_t*)(P.ws + WS_DP);
    for (size_t i = gt; i < (size_t)NTOK * 64; i += GS) {
        const int t = (int)(i >> 6), c8 = (int)(i & 63) * 8, g = c8 >> 7, w = 2 << g, tl = t & (SEQ - 1);
        const int cnt = min(tl + 1, w);
        float sm[8];
#pragma unroll
        for (int j = 0; j < 8; ++j) sm[j] = 0.f;
        float u0[8];
        for (int q = 0; q < cnt; ++q) {
            const u32x4 v = *(const u32x4*)(Z0 + (size_t)(t - q) * ZW + 2048 + c8);
            const float f[8] = {bflo(v.x), bfhi(v.x), bflo(v.y), bfhi(v.y), bflo(v.z), bfhi(v.z), bflo(v.w), bfhi(v.w)};
#pragma unroll
            for (int j = 0; j < 8; ++j) { sm[j] += f[j]; if (q == 0) u0[j] = f[j]; }
        }
        const float inv = 1.0f / (float)cnt;
        u32x4 o; o.x = pk2(sm[0] * inv - u0[0], sm[1] * inv - u0[1]); o.y = pk2(sm[2] * inv - u0[2], sm[3] * inv - u0[3]);
        o.z = pk2(sm[4] * inv - u0[4], sm[5] * inv - u0[5]); o.w = pk2(sm[6] * inv - u0[6], sm[7] * inv - u0[7]);
        *(u32x4*)(DP + (size_t)t * 512 + c8) = o;
    }
}
__device__ __forceinline__ void phase_ret_out_mfma(const Params& P, unsigned char* lds_) {
    using pg8::bf16x8;
    const unsigned char* Z0 = (const unsigned char*)(P.ws + WS_Z0); const unsigned char* SB = (const unsigned char*)(P.ws + WS_SB); bf16_t* MIX = (bf16_t*)(P.ws + WS_MIX);
    const float* gn = P.in[3];
    LAS unsigned char* Kimg = (LAS unsigned char*)lds_; LAS unsigned char* Vimg = Kimg + 32768; LAS unsigned char* Rimg = Kimg + 65536;
    const int tid = threadIdx.x, lane = tid & 63, wave = __builtin_amdgcn_readfirstlane(tid >> 6), fr = lane & 15, fq = lane >> 4;
    for (int u = blockIdx.x; u < 1024; u += gridDim.x) {
        const int n = u & 63, h = (u >> 6) & 3, b = u >> 8;
        const size_t row0 = (size_t)b * SEQ + n * 128;
        __syncthreads();
        ret_fill_image(Kimg, Z0 + row0 * ZW * 2 + (512 + h * 128) * 2, ZW * 2, wave, lane);
        ret_fill_image(Vimg, Z0 + row0 * ZW * 2 + (1024 + h * 128) * 2, ZW * 2, wave, lane);
        ret_fill_image(Rimg, SB + (size_t)u * 32768, 256, wave, lane);
        const bf16_t* qrow = (const bf16_t*)Z0 + (row0 + 16 * wave + fr) * ZW + h * 128;
        bf16x8 qf[4], qr[4];
#pragma unroll
        for (int c = 0; c < 4; ++c) {
            qf[c] = *(const bf16x8*)(qrow + 32 * c + 8 * fq);
            const u32x2 a = *(const u32x2*)(qrow + 32 * c + 4 * fq), bb = *(const u32x2*)(qrow + 32 * c + 16 + 4 * fq);
            u32x4 w; w.x = a.x; w.y = a.y; w.z = bb.x; w.w = bb.y; qr[c] = __builtin_bit_cast(bf16x8, w);
        }
        asm volatile("s_waitcnt vmcnt(0)" ::: "memory");
        __syncthreads();
        f32x4 sT[8];
#pragma unroll
        for (int jt = 0; jt < 8; ++jt) sT[jt] = (f32x4){0.f, 0.f, 0.f, 0.f};
#pragma unroll
        for (int jt = 0; jt < 8; ++jt) if (jt <= wave) {
            const int r = 16 * jt + fr;
#pragma unroll
            for (int c = 0; c < 4; ++c) {
                const bf16x8 a = *(const LAS bf16x8*)(Kimg + r * 256 + ((((4 * c + fq)) ^ ((r & 7) << 1)) << 4));
                sT[jt] = __builtin_amdgcn_mfma_f32_16x16x32_bf16(a, qf[c], sT[jt], 0, 0, 0);
            }
            if (jt == wave) {
                if (4 * fq + 0 > fr) sT[jt].x = 0.f; if (4 * fq + 1 > fr) sT[jt].y = 0.f; if (4 * fq + 2 > fr) sT[jt].z = 0.f; if (4 * fq + 3 > fr) sT[jt].w = 0.f;
            }
        }
        bf16x8 pT[4];
#pragma unroll
        for (int jp = 0; jp < 4; ++jp) { u32x4 w; w.x = pk2(sT[2 * jp].x, sT[2 * jp].y); w.y = pk2(sT[2 * jp].z, sT[2 * jp].w); w.z = pk2(sT[2 * jp + 1].x, sT[2 * jp + 1].y); w.w = pk2(sT[2 * jp + 1].z, sT[2 * jp + 1].w);
            pT[jp] = __builtin_bit_cast(bf16x8, w); }
        f32x4 O[8];
#pragma unroll
        for (int vt = 0; vt < 8; ++vt) {
            f32x4 acc = {0.f, 0.f, 0.f, 0.f};
#pragma unroll
            for (int jp = 0; jp < 4; ++jp) if (2 * jp <= wave) acc = __builtin_amdgcn_mfma_f32_16x16x32_bf16(ret_tr_pair(Vimg, 32 * jp, 2 * vt, lane), pT[jp], acc, 0, 0, 0);
#pragma unroll
            for (int c = 0; c < 4; ++c) acc = __builtin_amdgcn_mfma_f32_16x16x32_bf16(ret_tr_pair(Rimg, 32 * c, 2 * vt, lane), qr[c], acc, 0, 0, 0);
            O[vt] = acc;
        }
        float sm = 0.f;
#pragma unroll
        for (int vt = 0; vt < 8; ++vt) sm += (O[vt].x + O[vt].y) + (O[vt].z + O[vt].w);
        sm += __shfl_xor(sm, 16); sm += __shfl_xor(sm, 32);
        const float mu = sm * (1.0f / 128.0f);
        float sq = 0.f;
#pragma unroll
        for (int vt = 0; vt < 8; ++vt) { const f32x4 dlt = O[vt] - mu; sq += (dlt.x * dlt.x + dlt.y * dlt.y) + (dlt.z * dlt.z + dlt.w * dlt.w); }
        sq += __shfl_xor(sq, 16); sq += __shfl_xor(sq, 32);
        const float rstd = 1.0f / sqrtf(sq * (1.0f / 128.0f) + LN_EPS);
        const bf16_t* grow = (const bf16_t*)Z0 + (row0 + 16 * wave + fr) * ZW + 1536 + h * 128 + 4 * fq;
        bf16_t* orow = MIX + (row0 + 16 * wave + fr) * DM + h * 128 + 4 * fq;
#pragma unroll
        for (int vt = 0; vt < 8; ++vt) {
            const u32x2 gv = *(const u32x2*)(grow + 16 * vt);
            const f32x4 g4 = *(const f32x4*)(gn + h * 128 + 16 * vt + 4 * fq);
            const f32x4 y = (O[vt] - mu) * rstd * g4;
            u32x2 w; w.x = pk2(y.x * silu_f(bflo(gv.x)), y.y * silu_f(bfhi(gv.x))); w.y = pk2(y.z * silu_f(bflo(gv.y)), y.w * silu_f(bfhi(gv.y)));
            *(u32x2*)(orow + 16 * vt) = w;
        }
    }
}

#define XB_TMO      128
#define XB_XCNT(j)  (256  + 64 * (j))
#define XB_XSUB(j)  (1280 + 64 * (j))
#define XB_XGEN(j)  (2304 + 64 * (j))
#define XB_TOP      3328
#define XB_TOPGEN   3392
#define XCD_BAR_WORDS 3456
#define XB_SPIN_CAP (1u << 22)
__device__ __forceinline__ unsigned xb_ld(unsigned* p)              { return __hip_atomic_load(p, __ATOMIC_RELAXED, __HIP_MEMORY_SCOPE_AGENT); }
__device__ __forceinline__ unsigned xb_add(unsigned* p, unsigned v) { return __hip_atomic_fetch_add(p, v, __ATOMIC_RELAXED, __HIP_MEMORY_SCOPE_AGENT); }
__device__ __forceinline__ unsigned xb_xcc_id() { return (unsigned)__builtin_amdgcn_s_getreg((3 << 11) | 20) & 0xFu; }
#define XB_SPIN(cond, bar) do { unsigned _sp = 0; while (cond) { __builtin_amdgcn_s_sleep(1); \
    if ((++_sp & 255u) == 0u) { if (xb_ld(&(bar)[XB_TMO])) break; if (_sp > XB_SPIN_CAP) { atomicAdd(&(bar)[XB_TMO], 1u); break; } } } } while (0)
struct XcdBarrier { unsigned* bar; unsigned x; volatile LAS unsigned* st; };
__device__ __forceinline__ XcdBarrier xcd_barrier_post(unsigned* bar, volatile LAS unsigned* st) {
    XcdBarrier b; b.bar = bar; b.x = xb_xcc_id(); b.st = st;
    if (threadIdx.x == 0) (void)xb_add(&bar[XB_XCNT(b.x)], 1u);
    return b;
}
__device__ __forceinline__ void xcd_barrier_complete(unsigned* bar, unsigned x, unsigned& nloc, unsigned& nx) {
    const unsigned G = gridDim.x * gridDim.y * gridDim.z;
    unsigned sum, cnt, mine, sp = 0u;
    for (;;) {
        sum = 0u; cnt = 0u; mine = 0u;
#pragma unroll
        for (unsigned j = 0; j < 16; ++j) { const unsigned c = xb_ld(&bar[XB_XCNT(j)]); sum += c; cnt += (c > 0u) ? 1u : 0u; mine = (j == x) ? c : mine; }
        if (sum == G) break;
        __builtin_amdgcn_s_sleep(1);
        if ((++sp & 255u) == 0u) { if (xb_ld(&bar[XB_TMO])) break; if (sp > XB_SPIN_CAP) { atomicAdd(&bar[XB_TMO], 1u); break; } }
    }
    nloc = mine > 0u ? mine : 1u; nx = cnt > 0u ? cnt : 1u;
}
__device__ __forceinline__ void xcd_barrier(const XcdBarrier& b) {
    asm volatile("s_waitcnt vmcnt(0)" ::: "memory");
    __syncthreads();
    if (threadIdx.x == 0) {
        unsigned* bar = b.bar;
        __builtin_amdgcn_s_waitcnt(0);
        unsigned nloc = b.st[0], nx = b.st[1];
        if (nloc == 0u) { xcd_barrier_complete(bar, b.x, nloc, nx); b.st[0] = nloc; b.st[1] = nx; }
        const unsigned old = xb_add(&bar[XB_XSUB(b.x)], 1u);
        const unsigned gen = old / nloc;
        if (old + 1u == (gen + 1u) * nloc) {
            __builtin_amdgcn_fence(__ATOMIC_RELEASE, "agent");
            asm volatile("s_waitcnt vmcnt(0)" ::: "memory");
            const unsigned og = xb_add(&bar[XB_TOP], 1u);
            const unsigned tg = og / nx;
            if (og + 1u == (tg + 1u) * nx) xb_add(&bar[XB_TOPGEN], 1u);
            else XB_SPIN(xb_ld(&bar[XB_TOPGEN]) == tg, bar);
            __builtin_amdgcn_fence(__ATOMIC_ACQUIRE, "agent");
            xb_add(&bar[XB_XGEN(b.x)], 1u);
            asm volatile("s_waitcnt vmcnt(0)" ::: "memory");
        } else {
            XB_SPIN(xb_ld(&bar[XB_XGEN(b.x)]) == gen, bar);
            __builtin_amdgcn_fence(__ATOMIC_ACQUIRE, "agent");
            asm volatile("s_waitcnt vmcnt(0)" ::: "memory");
        }
    }
    __syncthreads();
}
constexpr size_t CTL_BAR_OFF = 16384;
constexpr size_t CTL_ZERO_BYTES = 65536;

#ifdef PH_ONLY
#define IN(k) ((k) == PH_ONLY)
#else
#define IN(k) (lo <= (k) && (k) < hi)
#endif
#define SEAM(k) do { if (IN(k) && IN((k) + 1)) xcd_barrier(grid); } while (0)
#ifndef PROBE_DUP
#define PROBE_DUP (-1)
#endif
#define REP(k) for (int _rep = 0; _rep < ((PROBE_DUP == (k)) ? 2 : 1); ++_rep)

template <int LAYER, int BASE>
__device__ __forceinline__ void layer_tail(const Params& P, unsigned char* lds, const XcdBarrier& grid, int lo, int hi) {
    unsigned char* ws = P.ws;
    int* tb = (int*)(lds + MISC_OFF);
    if (IN(BASE)) { if (PROBE_DUP == BASE) phase_ln_route<true>(P, lds, LAYER); phase_ln_route<false>(P, lds, LAYER); }
    SEAM(BASE);
    if (IN(BASE + 1)) REP(BASE + 1) { moe_setup(P, tb, LAYER);
        MoeSched S{tb, (const int*)(ws + WS_CTL) + LAYER * 64, (const int*)(ws + WS_LIST), (const bf16_t*)(ws + WS_XB),
                   (const bf16_t*)(ws + WS_W_GU) + (size_t)LAYER * 32 * DM * DM, DM, (size_t)DM * DM, true};
        EpiGU E{(bf16_t*)(ws + WS_ACT)}; gemm_moe<true>(lds, S, E); }
    SEAM(BASE + 1);
    if (IN(BASE + 2)) REP(BASE + 2) { moe_setup(P, tb, LAYER);
        MoeSched S{tb, (const int*)(ws + WS_CTL) + LAYER * 64, (const int*)(ws + WS_LIST), (const bf16_t*)(ws + WS_ACT),
                   (const bf16_t*)(ws + WS_W_DN) + (size_t)LAYER * 32 * DM * 512, 512, (size_t)DM * 512, false};
        EpiDown E{(bf16_t*)(ws + WS_YS)}; gemm_moe<false>(lds, S, E); }
    SEAM(BASE + 2);
    if (IN(BASE + 3)) { if (PROBE_DUP == BASE + 3) phase_ln2<true>(P, LAYER); phase_ln2<false>(P, LAYER); }
    SEAM(BASE + 3);
    if (IN(BASE + 4)) REP(BASE + 4) {
        { DenseSched S{(const bf16_t*)(ws + WS_PB) + (size_t)LAYER * NTOK * 256, (const bf16_t*)(ws + WS_W_P) + (size_t)LAYER * DM * 256, NTOK, DM, 256, 256, 0};
          EpiStoreBf16 E{(bf16_t*)(ws + WS_PP), DM, 0, nullptr}; gemm_dense(lds, S, E); }
        __syncthreads();
        { DenseSched S{(const bf16_t*)(ws + WS_XB), (const bf16_t*)(ws + WS_W_G) + (size_t)LAYER * DM * DM, NTOK, DM, DM, DM, 0};
          EpiPle E{(const bf16_t*)(ws + WS_XB), (const bf16_t*)(ws + WS_PP), LAYER == 1 ? P.out : (float*)nullptr, LAYER == 1 ? (bf16_t*)nullptr : (bf16_t*)(ws + WS_XB2)}; gemm_dense(lds, S, E); }
    }
}

__global__ void __launch_bounds__(NT, 2) mega(Params P, int lo, int hi) {
    extern __shared__ __attribute__((aligned(16))) unsigned char lds[];
    unsigned char* ws = P.ws;
    if (threadIdx.x < 16) ((LAS unsigned*)((LAS unsigned char*)lds + BARW_OFF))[threadIdx.x] = 0u;
    __syncthreads();
    const XcdBarrier grid = xcd_barrier_post((unsigned*)(ws + WS_CTL + CTL_BAR_OFF), (volatile LAS unsigned*)((LAS unsigned char*)lds + BARW_OFF));
    if (IN(0)) REP(0) phase_prep(P, lds);
    SEAM(0);
    if (IN(1)) REP(1) { DenseSched S{(const bf16_t*)(ws + WS_XB), (const bf16_t*)(ws + WS_W_IN0), NTOK, ZW, DM, DM, 0};
        EpiZ0 E{(bf16_t*)(ws + WS_Z0)}; gemm_dense(lds, S, E); }
    SEAM(1);
    if (IN(2)) REP(2) phase_ret_kv_mfma(P, lds);
    SEAM(2);
    if (IN(3)) REP(3) phase_ret_scan_pool2(P);
    SEAM(3);
    if (IN(4)) REP(4) { phase_ret_out_mfma(P, lds); __syncthreads();
        DenseSched S{(const bf16_t*)(ws + WS_DP), (const bf16_t*)(ws + WS_W_POOL), NTOK, 512, 256, 512, 256};
        EpiStoreBf16 E{(bf16_t*)(ws + WS_MIX), DM, 512, P.in[5]}; gemm_dense(lds, S, E); }
    SEAM(4);
    if (IN(5)) REP(5) { DenseSched S{(const bf16_t*)(ws + WS_MIX), (const bf16_t*)(ws + WS_W_OUT0), NTOK, DM, DM, DM, 0};
        EpiResid E{P.in[0], (float*)(ws + WS_F)}; gemm_dense(lds, S, E); }
    SEAM(5);
    layer_tail<0, 6>(P, lds, grid, lo, hi);
    SEAM(10);
    if (IN(11)) REP(11) { DenseSched S{(const bf16_t*)(ws + WS_XB2), (const bf16_t*)(ws + WS_W_CIN), NTOK, Z1W, DM, DM, 0};
        EpiStoreBf16 E{(bf16_t*)(ws + WS_Z1), Z1W, 0, nullptr}; gemm_dense(lds, S, E); }
    SEAM(11);
    if (IN(12)) REP(12) { phase_norms(P); phase_index_scores(P, lds); }
    SEAM(12);
    if (IN(13)) REP(13) phase_index_select(P, lds);
    SEAM(13);
    if (IN(14)) REP(14) { DenseSched S{(const bf16_t*)(ws + WS_CQ), (const bf16_t*)(ws + WS_W_QA), NTOK, 4096, 256, 256, 0};
        EpiStoreF16 E{(unsigned short*)(ws + WS_QA), 4096}; gemm_dense(lds, S, E); }
    SEAM(14);
    if (IN(15)) { if (PROBE_DUP == 15) phase_sparse_attn_e<true>(P, lds); phase_sparse_attn_e<false>(P, lds); }
    SEAM(15);
    if (IN(16)) REP(16) { DenseSched S{(const bf16_t*)(ws + WS_QA), (const bf16_t*)(ws + WS_W_UVBD), NTOK, DM, DM, 4096, 1024};
        EpiStoreBf16 E{(bf16_t*)(ws + WS_XB), DM, 0, nullptr}; gemm_dense(lds, S, E); }
    SEAM(16);
    if (IN(17)) REP(17) { DenseSched S{(const bf16_t*)(ws + WS_XB), (const bf16_t*)(ws + WS_W_COUT), NTOK, DM, DM, DM, 0};
        EpiResidB E{(const bf16_t*)(ws + WS_XB2), (float*)(ws + WS_F)}; gemm_dense(lds, S, E); }
    SEAM(17);
    layer_tail<1, 18>(P, lds, grid, lo, hi);
}
#undef IN
#undef SEAM

extern "C" void kernel_launch(void* const* d_in, const int* in_sizes, int n_in, void* d_out, int out_size, void* d_ws, size_t ws_size, hipStream_t stream) {
    static int grid = 0;
    if (grid == 0) {
        if (n_in != 26 || ws_size < WS_END || out_size != NTOK * DM) { fprintf(stderr, "kernel_launch: unexpected problem (n_in %d, ws %zu, out %d)\n", n_in, ws_size, out_size); grid = -1; return; }
        int dev = 0, cus = 0, per_cu = 0;
        (void)hipGetDevice(&dev);
        (void)hipDeviceGetAttribute(&cus, hipDeviceAttributeMultiprocessorCount, dev);
        (void)hipFuncSetAttribute((const void*)mega, hipFuncAttributeMaxDynamicSharedMemorySize, LDS_BYTES);
        (void)hipOccupancyMaxActiveBlocksPerMultiprocessor(&per_cu, (const void*)mega, NT, LDS_BYTES);
        if (per_cu < 1) { fprintf(stderr, "kernel_launch: occupancy query reports %d blocks per CU\n", per_cu); per_cu = 1; }
        (void)hipGetLastError();
        grid = cus;
    }
    if (grid < 0) return;
    (void)hipMemsetAsync((char*)d_ws + WS_CTL, 0, CTL_ZERO_BYTES, stream);
    Params p{};
    for (int i = 0; i < 26; ++i) p.in[i] = (const float*)d_in[i];
    p.out = (float*)d_out; p.ws = (unsigned char*)d_ws;
#if MK_ONE_LAUNCH
    int lo = 0, hi = NPH_TOTAL;
    void* args[] = {&p, &lo, &hi};
    (void)args;
    hipLaunchKernelGGL(mega, dim3(grid), dim3(NT), LDS_BYTES, stream, p, lo, hi);
    hipError_t e = hipPeekAtLastError();
    if (e != hipSuccess) fprintf(stderr, "launch failed: %s (grid %d)\n", hipGetErrorString(e), grid);
#else
    for (int k = 0; k < NPH_TOTAL; ++k) hipLaunchKernelGGL(mega, dim3(grid), dim3(NT), LDS_BYTES, stream, p, k, k + 1);
#endif
}
```

```cpp
#include <hip/hip_runtime.h>
#include <hip/hip_cooperative_groups.h>
#include <cstdio>
#include <cstdint>
namespace cg = cooperative_groups;

#ifndef PROBE_ATT
#define PROBE_ATT 0
#endif
#ifndef MK_ONE_LAUNCH
#define MK_ONE_LAUNCH 1
#endif

typedef unsigned short bf16_t;
typedef float f32x4 __attribute__((ext_vector_type(4)));
typedef unsigned u32x4 __attribute__((ext_vector_type(4)));
typedef unsigned u32x2 __attribute__((ext_vector_type(2)));

constexpr int NT = 512;
constexpr int NWAVE = NT / 64;
constexpr int NTOK = 32768, DM = 1024, SEQ = 8192, NBATCH = 4;
constexpr int ZW = 2560;
constexpr int Z1W = 1280;
constexpr int CIN = 1096;
constexpr int TOPK = 256;
constexpr float ALPHA = 1.4142135623730951f;
constexpr float LN_EPS = 1e-5f;
constexpr int LDS_BYTES = 163840;
constexpr int BARW_OFF = LDS_BYTES - 64;
constexpr int MISC_OFF = 135168;

constexpr size_t MiB = (size_t)1 << 20;
constexpr size_t WS_CTL = 0;
constexpr size_t WS_W_IN0 = 1 * MiB, WS_W_OUT0 = 6 * MiB, WS_W_POOL = 8 * MiB, WS_W_CIN = 9 * MiB, WS_W_QA = 12 * MiB,
                 WS_W_UVBD = 14 * MiB, WS_W_COUT = 16 * MiB, WS_W_G = 18 * MiB, WS_W_P = 22 * MiB, WS_W_GU = 24 * MiB, WS_W_DN = 152 * MiB;
constexpr size_t WS_XB = 224 * MiB, WS_F = 288 * MiB, WS_PB = 416 * MiB, WS_PP = 448 * MiB, WS_CQ = 512 * MiB, WS_CKV = 528 * MiB,
                 WS_SEL = 544 * MiB, WS_TOKG = 560 * MiB, WS_LIST = 561 * MiB, WS_CKV8 = 566 * MiB;
constexpr size_t WS_M0 = 576 * MiB;
constexpr size_t WS_Z0 = WS_M0, WS_KV = WS_M0 + 160 * MiB, WS_MIX = WS_M0 + 224 * MiB, WS_DP = WS_M0 + 288 * MiB, WS_SB = WS_M0 + 320 * MiB;
constexpr size_t WS_QA = WS_M0, WS_SC = WS_M0, WS_Z1 = WS_M0 + 272 * MiB;
constexpr size_t WS_ACT = WS_M0, WS_YS = WS_M0 + 72 * MiB;
constexpr size_t WS_XB2 = 928 * MiB;
constexpr size_t WS_END = 992 * MiB;
constexpr int LIST_CAP = 32768;
constexpr size_t WS_GT = WS_CTL + 262144;
constexpr size_t WS_SGB = WS_CTL + 786432;

struct Params {
    const float* in[26];
    float* out;
    unsigned char* ws;
};

__device__ __forceinline__ unsigned f2bf(float f) { unsigned u = __float_as_uint(f); return (u + 0x7fffu + ((u >> 16) & 1u)) >> 16; }
__device__ __forceinline__ float bf2f(unsigned h) { return __uint_as_float(h << 16); }
typedef float f32x2_t __attribute__((ext_vector_type(2))); typedef __bf16 bf16x2_t __attribute__((ext_vector_type(2)));
__device__ __forceinline__ unsigned pk2(float lo, float hi) { f32x2_t v = {lo, hi}; bf16x2_t b = __builtin_convertvector(v, bf16x2_t); return __builtin_bit_cast(unsigned, b); }
__device__ __forceinline__ float bflo(unsigned w) { return __uint_as_float(w << 16); }
__device__ __forceinline__ float bfhi(unsigned w) { return __uint_as_float(w & 0xffff0000u); }
#define WAVE_SUM_DPP(v) ({ float _v = (v); \
    _v += __builtin_bit_cast(float, __builtin_amdgcn_update_dpp(0, __builtin_bit_cast(int, _v), 0xB1, 0xf, 0xf, true));     \
    _v += __builtin_bit_cast(float, __builtin_amdgcn_update_dpp(0, __builtin_bit_cast(int, _v), 0x4E, 0xf, 0xf, true));     \
    _v += __builtin_bit_cast(float, __builtin_amdgcn_update_dpp(0, __builtin_bit_cast(int, _v), 0x141, 0xf, 0xf, true));    \
    _v += __builtin_bit_cast(float, __builtin_amdgcn_update_dpp(0, __builtin_bit_cast(int, _v), 0x140, 0xf, 0xf, true));    \
    _v += __builtin_bit_cast(float, __builtin_amdgcn_update_dpp(0, __builtin_bit_cast(int, _v), 0x142, 0xa, 0xf, false));   \
    _v += __builtin_bit_cast(float, __builtin_amdgcn_update_dpp(0, __builtin_bit_cast(int, _v), 0x143, 0xc, 0xf, false));   \
    __builtin_bit_cast(float, __builtin_amdgcn_readlane(__builtin_bit_cast(int, _v), 63)); })
__device__ __forceinline__ float wave_sum(float v) { return WAVE_SUM_DPP(v); }
__device__ __forceinline__ float wave_max(float v) {
#pragma unroll
    for (int o = 1; o < 64; o <<= 1) v = fmaxf(v, __shfl_xor(v, o));
    return v;
}
__device__ __forceinline__ float silu_f(float a) { return a / (1.0f + __expf(-a)); }
__device__ __forceinline__ float sigmoid_f(float a) { return 1.0f / (1.0f + __expf(-a)); }
#define LDS_FENCE() asm volatile("s_waitcnt lgkmcnt(0)" ::: "memory")

struct UnitInfo {
    const bf16_t* A; int lda;
    const int* rows; int rshift;
    int nvalid;
    const bf16_t* Bt; int ldb;
    int K;
    int orow0;
    int pn;
};
__device__ __forceinline__ const bf16_t* unit_arow(const UnitInfo& u, int r) {
    if (u.rows) { const int idx = (r < u.nvalid) ? (u.rows[r] >> u.rshift) : 0; return u.A + (size_t)idx * u.lda; }
    return u.A + (size_t)r * u.lda;
}

struct DenseSched {
    const bf16_t* A; const bf16_t* Bt; int M, N, K, lda, a_pn_stride; int reps = 1;
    __device__ __forceinline__ bool next(int round, UnitInfo& u) const {
        const int nN = N >> 8, nM = M >> 8, nwg = nN * nM;
        const long L = (long)round * gridDim.x + blockIdx.x; if (L >= (long)nwg * reps) return false;
        int wgid = (int)(L % nwg); { const int q = nwg / 8, r = nwg % 8, xcd = wgid % 8, off = wgid / 8; wgid = (xcd < r ? xcd * (q + 1) : r * (q + 1) + (xcd - r) * q) + off; }
        const int nig = 8 * nN, gid = wgid / nig, fm = gid * 8, gsz = (nM - fm) < 8 ? (nM - fm) : 8;
        const int pm = fm + ((wgid % nig) % gsz), pn = (wgid % nig) / gsz;
        u.A = A + (size_t)pm * 256 * lda + (size_t)pn * a_pn_stride; u.lda = lda; u.rows = nullptr; u.rshift = 0; u.nvalid = 256;
        u.Bt = Bt + (size_t)pn * 256 * K; u.ldb = K; u.K = K; u.orow0 = pm * 256; u.pn = pn;
        return true;
    }
};
struct MoeSched {
    const int* tb; const int* cnt; const int* list;
    const bf16_t* A; const bf16_t* W; int K; size_t wstride; bool gather;
    __device__ __forceinline__ bool next(int round, UnitInfo& u) const {
        const int i = round * gridDim.x + blockIdx.x;
        const int j = i >> 2, pn = i & 3;
        if (j >= tb[32]) return false;
        int e = 0;
        while (tb[e + 1] <= j) ++e;
        const int rb = j - tb[e];
        const int nv = min(256, cnt[e] - rb * 256);
        u.rows = list + (size_t)e * LIST_CAP + rb * 256; u.nvalid = nv; u.orow0 = j * 256; u.pn = pn;
        if (gather) { u.A = A; u.lda = K; u.rshift = 1; }
        else { u.A = A + (size_t)j * 256 * K; u.lda = K; u.rshift = 31;   }
        u.Bt = W + (size_t)e * wstride + (size_t)pn * 256 * K; u.ldb = K; u.K = K;
        return true;
    }
};

template <class Sched, class Epi>
__device__ __forceinline__ void gemm_simple(unsigned char* lds, const Sched& S, const Epi& E, bool contiguousA) {
    float* As = (float*)lds;
    float* Bs = As + 128 * 33;
    const int tid = threadIdx.x, ty = tid >> 3, tx = tid & 7;
    const int lr = tid >> 2, kc = (tid & 3) * 8;
    UnitInfo u;
    for (int round = 0; S.next(round, u); ++round) {
        for (int sm = 0; sm < 2; ++sm) {
            const int ar = sm * 128 + lr;
            const bf16_t* arow = contiguousA ? (u.A + (size_t)ar * u.lda) : unit_arow(u, ar);
            for (int sn = 0; sn < 4; ++sn) {
                float acc[2][8];
#pragma unroll
                for (int a = 0; a < 2; ++a)
#pragma unroll
                    for (int b = 0; b < 8; ++b) acc[a][b] = 0.f;
                const bf16_t* brow = u.Bt + (size_t)(sn * 64 + (tid >> 2)) * u.ldb;
                for (int k0 = 0; k0 < u.K; k0 += 32) {
                    const u32x4 av = *(const u32x4*)(arow + k0 + kc);
                    float* ap = As + lr * 33 + kc;
                    ap[0] = bflo(av.x); ap[1] = bfhi(av.x); ap[2] = bflo(av.y); ap[3] = bfhi(av.y);
                    ap[4] = bflo(av.z); ap[5] = bfhi(av.z); ap[6] = bflo(av.w); ap[7] = bfhi(av.w);
                    if (tid < 256) {
                        const u32x4 bv = *(const u32x4*)(brow + k0 + kc);
                        float* bp = Bs + (tid >> 2) * 33 + kc;
                        bp[0] = bflo(bv.x); bp[1] = bfhi(bv.x); bp[2] = bflo(bv.y); bp[3] = bfhi(bv.y);
                        bp[4] = bflo(bv.z); bp[5] = bfhi(bv.z); bp[6] = bflo(bv.w); bp[7] = bfhi(bv.w);
                    }
                    __syncthreads();
#pragma unroll 8
                    for (int kk = 0; kk < 32; ++kk) {
                        const float a0 = As[(2 * ty) * 33 + kk], a1 = As[(2 * ty + 1) * 33 + kk];
#pragma unroll
                        for (int j = 0; j < 8; ++j) { const float b = Bs[(tx * 8 + j) * 33 + kk]; acc[0][j] += a0 * b; acc[1][j] += a1 * b; }
                    }
                    __syncthreads();
                }
#pragma unroll
                for (int rr = 0; rr < 2; ++rr) {
                    const f32x4 v0 = {acc[rr][0], acc[rr][1], acc[rr][2], acc[rr][3]}, v1 = {acc[rr][4], acc[rr][5], acc[rr][6], acc[rr][7]};
                    E(u, sm * 128 + 2 * ty + rr, sn * 64 + tx * 8, v0, v1);
                }
            }
        }
    }
}


namespace pg8 {
#define LAS __attribute__((address_space(3)))
typedef short bf16x8 __attribute__((ext_vector_type(8)));
constexpr int BK = 64, HALF = 128, HTB = HALF * BK * 2, STAGE_BYTES = 8 * HTB;
__device__ __forceinline__ int lds_byte(int r, int c) { const int st = (r >> 4) * 2 + (c >> 5), rr = r & 15, cc = c & 31, ob = rr * 64 + cc * 2; return st * 1024 + (ob ^ (((ob >> 9) & 1) << 5)); }
__device__ __forceinline__ void stage_rc(int b, int& R, int& C) { const int st = b / 1024, sb = b % 1024, swz = sb ^ (((sb >> 9) & 1) << 5); R = (st >> 1) * 16 + swz / 64; C = (st & 1) * 32 + (swz % 64) / 2; }
__device__ __forceinline__ int perm32(int rho) { const int n = rho >> 4, i = rho & 15; return 8 * (i >> 2) + 4 * n + (i & 3); }

template <bool GATHER, class Sched, class Epi>
__device__ __forceinline__ void gemm_phase(LAS unsigned char* lds, const LAS unsigned* rowtab, const Sched& S, const Epi& E, const int lda, const int ldb, const int K) {
    const int tid = threadIdx.x, wid = __builtin_amdgcn_readfirstlane(tid >> 6), lane = tid & 63, wr = wid >> 2, wc = wid & 3, fr = lane & 15, fq = lane >> 4;
    const int nt = K / BK;
    unsigned voffA[2], voffB[2]; int RA[2]; unsigned CA2[2];
#pragma unroll
    for (int i = 0; i < 2; ++i) { int R, C; stage_rc(tid * 16 + i * 8192, R, C); const int Rb = (R & ~31) + perm32(R & 31);
        voffA[i] = (unsigned)(R * lda + C) * 2u; voffB[i] = (unsigned)(Rb * ldb + C) * 2u; RA[i] = R; CA2[i] = (unsigned)C * 2u; }
    const size_t kstep = (size_t)(BK * 2);
    const size_t hstepA = (size_t)HALF * lda * 2, hstepB = (size_t)HALF * ldb * 2;
    const unsigned ldsw = (unsigned)wid * 1024u;
    const int aoff = lds_byte(wr * 64 + fr, fq * 8), boff = lds_byte(wc * 32 + fr, fq * 8);
    unsigned offA[2][2];
#define PG8_SA(b, h) (((b) * 2 + (h)) * HTB)
#define PG8_SB(b, h) ((4 + (b) * 2 + (h)) * HTB)
#define PG8_STAGE(bufoff, gbase, voff) do { _Pragma("unroll") for (int _i = 0; _i < 2; ++_i) \
        __builtin_amdgcn_global_load_lds((const unsigned*)((const char*)(gbase) + (voff)[_i]), (LAS unsigned*)(lds + (bufoff) + ldsw + _i * 8192), 16, 0, 0); } while (0)
#define PG8_STAGE_A(bufoff, h, gbase) do { if (GATHER) PG8_STAGE(bufoff, gbase, offA[h]); else PG8_STAGE(bufoff, (gbase) + (h) * hstepA, voffA); } while (0)
#define PG8_LOADOFF(round) do { _Pragma("unroll") for (int _h = 0; _h < 2; ++_h) _Pragma("unroll") for (int _i = 0; _i < 2; ++_i) offA[_h][_i] = rowtab[(round) * 256 + _h * 128 + RA[_i]] + CA2[_i]; } while (0)
#define PG8_LDA(dst, b, h) do { _Pragma("unroll") for (int m = 0; m < 4; ++m) _Pragma("unroll") for (int k = 0; k < 2; ++k) dst[m][k] = *(const LAS bf16x8*)(lds + PG8_SA(b, h) + aoff + m * 2048 + k * 1024); } while (0)
#define PG8_LDB(dst, b, h) do { _Pragma("unroll") for (int n = 0; n < 2; ++n) _Pragma("unroll") for (int k = 0; k < 2; ++k) dst[n][k] = *(const LAS bf16x8*)(lds + PG8_SB(b, h) + boff + n * 2048 + k * 1024); } while (0)
#define PG8_MMA(ai, bj, At, Bt) do { __builtin_amdgcn_s_setprio(1); _Pragma("unroll") for (int m = 0; m < 4; ++m) _Pragma("unroll") for (int n = 0; n < 2; ++n) _Pragma("unroll") for (int k = 0; k < 2; ++k) \
        acc[ai][bj][m][n] = __builtin_amdgcn_mfma_f32_16x16x32_bf16(Bt[n][k], At[m][k], acc[ai][bj][m][n], 0, 0, 0); __builtin_amdgcn_s_setprio(0); } while (0)
#define PG8_WAIT_V(n) asm volatile("s_waitcnt vmcnt(" #n ")" ::: "memory")
#define PG8_WAIT_L(n) asm volatile("s_waitcnt lgkmcnt(" #n ")" ::: "memory")
#define PG8_BAR __builtin_amdgcn_s_barrier()
#define PG8_SCHED __builtin_amdgcn_sched_barrier(0)
    UnitInfo cur, nxt; int ui = 0;
    if (!S.next(0, cur)) return;
    f32x4 acc[2][2][4][2];
#pragma unroll
    for (int a = 0; a < 2; ++a)
#pragma unroll
        for (int b = 0; b < 2; ++b)
#pragma unroll
            for (int m = 0; m < 4; ++m)
#pragma unroll
                for (int n = 0; n < 2; ++n) acc[a][b][m][n] = (f32x4){0.f, 0.f, 0.f, 0.f};
    bf16x8 At[4][2], B0[2][2], B1[2][2];
    const char* cA = (const char*)cur.A; const char* cB = (const char*)cur.Bt;
    if (GATHER) { PG8_LOADOFF(0); }
    PG8_STAGE(PG8_SB(0, 0), cB, voffB); PG8_STAGE(PG8_SB(0, 1), cB + hstepB, voffB); PG8_STAGE_A(PG8_SA(0, 0), 0, cA); PG8_STAGE_A(PG8_SA(0, 1), 1, cA);
    if (wr == 1) PG8_BAR;
    PG8_WAIT_V(2); PG8_BAR;
    PG8_STAGE(PG8_SB(1, 0), cB + kstep, voffB); PG8_STAGE_A(PG8_SA(1, 0), 0, cA + kstep); PG8_STAGE(PG8_SB(1, 1), cB + hstepB + kstep, voffB);
    PG8_WAIT_V(6); PG8_BAR;
    for (;;) {
        const bool has_next = S.next(ui + 1, nxt);
        const char* nA = has_next ? (const char*)nxt.A : cA; const char* nB = has_next ? (const char*)nxt.Bt : cB;
        for (int t = 0; t < nt; t += 2) {
            const bool last = (t == nt - 2);
            const char* a1 = cA + (size_t)(t + 1) * kstep;
            const char* a2 = last ? nA : cA + (size_t)(t + 2) * kstep; const char* b2 = last ? nB : cB + (size_t)(t + 2) * kstep;
            const char* a3 = a2 + kstep; const char* b3 = b2 + kstep;
            PG8_LDB(B0, 0, 0); PG8_LDB(B1, 0, 1); PG8_SCHED; PG8_LDA(At, 0, 0); PG8_STAGE_A(PG8_SA(1, 1), 1, a1);
            if (GATHER) { if (last && has_next) { PG8_LOADOFF(ui + 1); } }
            PG8_WAIT_V(8); PG8_WAIT_L(0); PG8_BAR; PG8_MMA(0, 0, At, B0); PG8_MMA(0, 1, At, B1); PG8_BAR; PG8_SCHED;
            PG8_LDA(At, 0, 1); PG8_STAGE(PG8_SB(0, 0), b2, voffB); PG8_STAGE(PG8_SB(0, 1), b2 + hstepB, voffB); PG8_STAGE_A(PG8_SA(0, 0), 0, a2);
            PG8_WAIT_V(8); PG8_WAIT_L(0); PG8_BAR; PG8_MMA(1, 0, At, B0); PG8_MMA(1, 1, At, B1); PG8_BAR; PG8_SCHED;
            PG8_LDB(B0, 1, 0); PG8_LDB(B1, 1, 1); PG8_SCHED; PG8_LDA(At, 1, 0); PG8_STAGE_A(PG8_SA(0, 1), 1, a2);
            PG8_WAIT_V(8); PG8_WAIT_L(0); PG8_BAR; PG8_MMA(0, 0, At, B0); PG8_MMA(0, 1, At, B1); PG8_BAR; PG8_SCHED;
            PG8_LDA(At, 1, 1); PG8_STAGE(PG8_SB(1, 0), b3, voffB); PG8_STAGE(PG8_SB(1, 1), b3 + hstepB, voffB); PG8_STAGE_A(PG8_SA(1, 0), 0, a3);
            PG8_WAIT_V(8); PG8_WAIT_L(0); PG8_BAR; PG8_MMA(1, 0, At, B0); PG8_MMA(1, 1, At, B1); PG8_BAR; PG8_SCHED;
        }
        if (wr == 0) PG8_BAR;
#pragma unroll
        for (int ai = 0; ai < 2; ++ai)
#pragma unroll
            for (int m = 0; m < 4; ++m)
#pragma unroll
                for (int bj = 0; bj < 2; ++bj) E(cur, ai * HALF + wr * 64 + m * 16 + fr, bj * HALF + wc * 32 + 8 * fq, acc[ai][bj][m][0], acc[ai][bj][m][1]);
        if (!has_next) break;
#pragma unroll
        for (int a = 0; a < 2; ++a)
#pragma unroll
            for (int b = 0; b < 2; ++b)
#pragma unroll
                for (int m = 0; m < 4; ++m)
#pragma unroll
                    for (int n = 0; n < 2; ++n) acc[a][b][m][n] = (f32x4){0.f, 0.f, 0.f, 0.f};
        cur = nxt; cA = nA; cB = nB; ++ui;
        if (wr == 1) PG8_BAR;
    }
    PG8_WAIT_V(0);
    PG8_BAR;
#undef PG8_SA
#undef PG8_SB
#undef PG8_STAGE
#undef PG8_STAGE_A
#undef PG8_LOADOFF
#undef PG8_LDA
#undef PG8_LDB
#undef PG8_MMA
#undef PG8_WAIT_V
#undef PG8_WAIT_L
#undef PG8_BAR
#undef PG8_SCHED
}
}

#ifndef USE_PG8_DENSE
#define USE_PG8_DENSE 1
#endif
#ifndef USE_PG8_MOE
#define USE_PG8_MOE 1
#endif
template <class Sched, class Epi>
__device__ __forceinline__ void gemm_dense(unsigned char* lds, const Sched& S, const Epi& E) {
#if USE_PG8_DENSE
    pg8::gemm_phase<false>((LAS unsigned char*)lds, (const LAS unsigned*)nullptr, S, E, S.lda, S.K, S.K);
    __syncthreads();
#else
    gemm_simple(lds, S, E, true);
#endif
}


template <bool GATHER, class Epi>
__device__ __forceinline__ void gemm_moe(unsigned char* lds, const MoeSched& S, const Epi& E) {
#if USE_PG8_MOE
    LAS unsigned* rowtab = (LAS unsigned*)(lds + MISC_OFF + 256);
    if (GATHER) {
        UnitInfo u;
        for (int round = 0; round < 10 && S.next(round, u); ++round)
            if (threadIdx.x < 256) rowtab[round * 256 + threadIdx.x] = ((int)threadIdx.x < u.nvalid) ? (unsigned)(u.rows[threadIdx.x] >> 1) * (unsigned)(S.K * 2) : 0u;
        __syncthreads();
    }
    pg8::gemm_phase<GATHER>((LAS unsigned char*)lds, (const LAS unsigned*)rowtab, S, E, S.K, S.K, S.K);
    __syncthreads();
#else
    gemm_simple(lds, S, E, !GATHER);
#endif
}

__device__ __forceinline__ u32x4 pack8(f32x4 a, f32x4 b) { u32x4 w; w.x = pk2(a.x, a.y); w.y = pk2(a.z, a.w); w.z = pk2(b.x, b.y); w.w = pk2(b.z, b.w); return w; }
struct EpiStoreBf16 {
    bf16_t* O; int ldc; int coff; const float* colscale;
    __device__ __forceinline__ void operator()(const UnitInfo& u, int r, int c, f32x4 v0, f32x4 v1) const {
        const int col = u.pn * 256 + c;
        if (colscale) { const f32x4 s0 = *(const f32x4*)(colscale + col), s1 = *(const f32x4*)(colscale + col + 4); v0 *= s0; v1 *= s1; }
        *(u32x4*)(O + (size_t)(u.orow0 + r) * ldc + coff + col) = pack8(v0, v1);
    }
};

__device__ __forceinline__ float ret_log2g(int h) { return log2f(1.0f - exp2f(-5.0f - (float)h)); }
struct EpiZ0 {
    bf16_t* O;
    __device__ __forceinline__ void operator()(const UnitInfo& u, int r, int c, f32x4 v0, f32x4 v1) const {
        const int col = u.pn * 256 + c, row = u.orow0 + r;
        if (col < 1024) { const float e = ret_log2g((col >> 7) & 3) * (float)(row & 127); const float sc = exp2f(col < 512 ? e : -e); v0 *= sc; v1 *= sc; }
        *(u32x4*)(O + (size_t)row * ZW + col) = pack8(v0, v1);
    }
};

struct EpiStoreF16 {
    unsigned short* O; int ldc;
    __device__ __forceinline__ void operator()(const UnitInfo& u, int r, int c, f32x4 v0, f32x4 v1) const {
        typedef _Float16 h2 __attribute__((ext_vector_type(2)));
        u32x4 w;
        w.x = __builtin_bit_cast(unsigned, (h2){(_Float16)v0.x, (_Float16)v0.y}); w.y = __builtin_bit_cast(unsigned, (h2){(_Float16)v0.z, (_Float16)v0.w});
        w.z = __builtin_bit_cast(unsigned, (h2){(_Float16)v1.x, (_Float16)v1.y}); w.w = __builtin_bit_cast(unsigned, (h2){(_Float16)v1.z, (_Float16)v1.w});
        *(u32x4*)(O + (size_t)(u.orow0 + r) * ldc + u.pn * 256 + c) = w;
    }
};
struct EpiResid {
    const float* X; float* Fo;
    __device__ __forceinline__ void operator()(const UnitInfo& u, int r, int c, f32x4 v0, f32x4 v1) const {
        const size_t off = (size_t)(u.orow0 + r) * DM + u.pn * 256 + c;
        const f32x4 x0 = *(const f32x4*)(X + off), x1 = *(const f32x4*)(X + off + 4);
        *(f32x4*)(Fo + off) = x0 * ALPHA + v0; *(f32x4*)(Fo + off + 4) = x1 * ALPHA + v1;
    }
};

struct EpiResidB {
    const bf16_t* X; float* Fo;
    __device__ __forceinline__ void operator()(const UnitInfo& u, int r, int c, f32x4 v0, f32x4 v1) const {
        const size_t off = (size_t)(u.orow0 + r) * DM + u.pn * 256 + c;
        const u32x4 xw = *(const u32x4*)(X + off);
        const f32x4 x0 = {bflo(xw.x), bfhi(xw.x), bflo(xw.y), bfhi(xw.y)}, x1 = {bflo(xw.z), bfhi(xw.z), bflo(xw.w), bfhi(xw.w)};
        *(f32x4*)(Fo + off) = x0 * ALPHA + v0; *(f32x4*)(Fo + off + 4) = x1 * ALPHA + v1;
    }
};
struct EpiGU {
    bf16_t* ACT;
    __device__ __forceinline__ void operator()(const UnitInfo& u, int r, int c, f32x4 v0, f32x4 v1) const {
        u32x2 w; w.x = pk2(silu_f(v0.x) * v0.y, silu_f(v0.z) * v0.w); w.y = pk2(silu_f(v1.x) * v1.y, silu_f(v1.z) * v1.w);
        *(u32x2*)(ACT + (size_t)(u.orow0 + r) * 512 + u.pn * 128 + (c >> 1)) = w;
    }
};
struct EpiDown {
    bf16_t* YS;
    __device__ __forceinline__ void operator()(const UnitInfo& u, int r, int c, f32x4 v0, f32x4 v1) const {
        if (r < u.nvalid) { const int pair = u.rows[r]; *(u32x4*)(YS + (size_t)pair * DM + u.pn * 256 + c) = pack8(v0, v1); }
    }
};
struct EpiPle {
    const bf16_t* XI; const bf16_t* PP; float* OUT; bf16_t* XO;
    __device__ __forceinline__ void operator()(const UnitInfo& u, int r, int c, f32x4 v0, f32x4 v1) const {
        const size_t off = (size_t)(u.orow0 + r) * DM + u.pn * 256 + c;
        const u32x4 pw = *(const u32x4*)(PP + off), xw = *(const u32x4*)(XI + off);
        f32x4 f0 = {bflo(xw.x), bfhi(xw.x), bflo(xw.y), bfhi(xw.y)}, f1 = {bflo(xw.z), bfhi(xw.z), bflo(xw.w), bfhi(xw.w)};
        f0.x += sigmoid_f(v0.x) * bflo(pw.x); f0.y += sigmoid_f(v0.y) * bfhi(pw.x); f0.z += sigmoid_f(v0.z) * bflo(pw.y); f0.w += sigmoid_f(v0.w) * bfhi(pw.y);
        f1.x += sigmoid_f(v1.x) * bflo(pw.z); f1.y += sigmoid_f(v1.y) * bfhi(pw.z); f1.z += sigmoid_f(v1.z) * bflo(pw.w); f1.w += sigmoid_f(v1.w) * bfhi(pw.w);
        if (OUT) { *(f32x4*)(OUT + off) = f0; *(f32x4*)(OUT + off + 4) = f1; }
        if (XO) *(u32x4*)(XO + off) = pack8(f0, f1);
    }
};

struct TrDesc { const float* src; bf16_t* dst; int K, N, Nsrc, nbatch, mode, dst_ld; };
__device__ __forceinline__ void tr_item(const TrDesc& d, const float* W, bf16_t* WT, float* scr, int kb, int nb, int lane) {
    const int k0 = 64 * kb, n0 = 32 * nb, Ns = d.Nsrc;
    const bool okc = (n0 + (lane & 31)) < Ns;
    float tmp[32];
#pragma unroll
    for (int i = 0; i < 32; ++i) tmp[i] = okc ? __builtin_nontemporal_load(W + (size_t)(k0 + 2 * i + (lane >> 5)) * Ns + n0 + (lane & 31)) : 0.f;
#pragma unroll
    for (int i = 0; i < 32; ++i) scr[(2 * i + (lane >> 5)) * 33 + (lane & 31)] = tmp[i];
    LDS_FENCE();
    const int c = lane & 7;
#pragma unroll
    for (int j = 0; j < 4; ++j) {
        const int n = (lane >> 3) + 8 * j; const float* sp = scr + (8 * c) * 33 + n;
        const int ng = n0 + n;
        float sc = 1.f; int nd = ng; int coff = 0;
        if (d.mode == 1) { if (ng >= 512 && ng < 1024) sc = 0.08838834764831845f; }
        if (d.mode == 2) { nd = (ng < 512) ? 2 * ng : 2 * (ng - 512) + 1; }
        if (d.mode == 3) { coff = ((ng >> 6) & 3) * 256; }
        u32x4 o; o.x = pk2(sp[0 * 33] * sc, sp[1 * 33] * sc); o.y = pk2(sp[2 * 33] * sc, sp[3 * 33] * sc); o.z = pk2(sp[4 * 33] * sc, sp[5 * 33] * sc); o.w = pk2(sp[6 * 33] * sc, sp[7 * 33] * sc);
        *(u32x4*)(WT + (size_t)nd * d.dst_ld + coff + k0 + 8 * c) = o;
    }
    LDS_FENCE();
}
__device__ __forceinline__ int tr_items(const TrDesc& d) { return d.nbatch * (d.K / 64) * (d.N / 32); }
__device__ __forceinline__ void tr_run(const TrDesc& d, int it, float* scr, int lane) {
    const int per = (d.K / 64) * (d.N / 32), b = it / per, r = it % per, nblk = d.N / 32;
    tr_item(d, d.src + (size_t)b * d.K * d.Nsrc, d.dst + (size_t)b * d.N * d.dst_ld, scr, r / nblk, r % nblk, lane);
}

__device__ __forceinline__ void phase_prep(const Params& P, unsigned char* lds) {
    unsigned char* ws = P.ws;
    const int tid = threadIdx.x, lane = tid & 63, wave = tid >> 6;
    const int gw = blockIdx.x * NWAVE + wave, NGW = gridDim.x * NWAVE;
    float* scr = (float*)lds + wave * (64 * 33);
    constexpr int ND = 9;
    TrDesc d[ND];
    d[0] = {P.in[22], (bf16_t*)(ws + WS_W_GU), 1024, 1024, 1024, 64, 2, 1024};
    d[1] = {P.in[23], (bf16_t*)(ws + WS_W_DN), 512, 1024, 1024, 64, 0, 512};
    d[2] = {P.in[2], (bf16_t*)(ws + WS_W_IN0), 1024, 2560, 2560, 1, 1, 1024};
    d[3] = {P.in[6], (bf16_t*)(ws + WS_W_OUT0), 1024, 1024, 1024, 1, 0, 1024};
    d[4] = {P.in[13], (bf16_t*)(ws + WS_W_COUT), 1024, 1024, 1024, 1, 0, 1024};
    d[5] = {P.in[24], (bf16_t*)(ws + WS_W_G), 1024, 1024, 1024, 2, 0, 1024};
    d[6] = {P.in[25], (bf16_t*)(ws + WS_W_P), 256, 1024, 1024, 2, 0, 256};
    d[7] = {P.in[7], (bf16_t*)(ws + WS_W_CIN), 1024, Z1W, CIN, 1, 0, 1024};
    d[8] = {P.in[12], (bf16_t*)(ws + WS_W_UVBD), 256, 1024, 1024, 1, 3, 1024};
    int total = 0;
#pragma unroll
    for (int i = 0; i < ND; ++i) total += tr_items(d[i]);
    for (int it = gw; it < total; it += NGW) {
        int r = it;
#pragma unroll
        for (int i = 0; i < ND; ++i) { const int n = tr_items(d[i]); if (r >= 0 && r < n) { tr_run(d[i], r, scr, lane); r = -1; } else if (r >= 0) r -= n; }
    }
    const size_t gt = (size_t)blockIdx.x * NT + tid, GS = (size_t)gridDim.x * NT;
    {
        bf16_t* o = (bf16_t*)(ws + WS_W_POOL); const float* pw = P.in[4];
        for (size_t i = gt; i < 512 * 256; i += GS) { const int n = (int)(i >> 8), k = (int)(i & 255), g = n >> 7, dd = n & 127, kg = k >> 7, c = k & 127;
            o[i] = (bf16_t)((kg == (g & 1)) ? f2bf(pw[((size_t)g * 128 + c) * 128 + dd]) : 0u); }
    }
    {
        u32x4* o = (u32x4*)(ws + WS_W_UVBD);
        for (size_t i = gt; i < (size_t)1024 * 1024 / 8; i += GS) { const int n = (int)(i >> 7), k = (int)(i & 127) * 8; if (((n >> 6) & 3) != (k >> 8)) o[i] = (u32x4){0u, 0u, 0u, 0u}; }
    }
    {
        bf16_t* o = (bf16_t*)(ws + WS_W_QA); const float* uq = P.in[10]; const float* uk = P.in[11];
        float* Bq = (float*)lds; float* Ak = Bq + 256 * 65;
        for (int item = blockIdx.x; item < 128; item += gridDim.x) {
            const int h = item >> 3, c0 = (item & 7) * 32;
            __syncthreads();
            for (int i = tid; i < 256 * 16; i += NT) { const int r = i >> 4, d4 = (i & 15) * 4; const f32x4 v = *(const f32x4*)(uq + (size_t)r * 1024 + h * 64 + d4);
                float* q = Bq + r * 65 + d4; q[0] = v.x; q[1] = v.y; q[2] = v.z; q[3] = v.w; }
            for (int i = tid; i < 32 * 16; i += NT) { const int c = i >> 4, d4 = (i & 15) * 4; const f32x4 v = *(const f32x4*)(uk + (size_t)(c0 + c) * 1024 + h * 64 + d4);
                float* q = Ak + c * 65 + d4; q[0] = v.x; q[1] = v.y; q[2] = v.z; q[3] = v.w; }
            __syncthreads();
            const int r = tid & 255, cg = tid >> 8;
            float acc[16];
#pragma unroll
            for (int j = 0; j < 16; ++j) acc[j] = 0.f;
            for (int dd = 0; dd < 64; ++dd) { const float bv = Bq[r * 65 + dd];
#pragma unroll
                for (int j = 0; j < 16; ++j) acc[j] += Ak[(cg * 16 + j) * 65 + dd] * bv; }
#pragma unroll
            for (int j = 0; j < 16; ++j) o[(size_t)(h * 256 + c0 + cg * 16 + j) * 256 + r] = (bf16_t)f2bf(acc[j] * 0.125f);
        }
        __syncthreads();
    }
    {
        bf16_t* GT = (bf16_t*)(ws + WS_GT); float* SGB = (float*)(ws + WS_SGB);
        for (size_t i = gt; i < (size_t)2 * 48 * 1024; i += GS) {
            const int l = (int)(i / (48 * 1024)), j = (int)((i / 1024) % 48), c = (int)(i & 1023);
            float w = 0.f;
            if (j < 4) w = P.in[18][(size_t)l * DM * 4 + (size_t)c * 4 + j]; else if (j < 36) w = P.in[20][(size_t)l * DM * 32 + (size_t)c * 32 + (j - 4)];
            const float g = P.in[14][l * DM + c] * w;
            const unsigned hi = f2bf(g); const unsigned lo = f2bf(g - bf2f(hi));
            GT[((size_t)(l * 2 + 0) * 48 + j) * 1024 + c] = (bf16_t)hi; GT[((size_t)(l * 2 + 1) * 48 + j) * 1024 + c] = (bf16_t)lo;
        }
        for (int it = gw; it < 96; it += NGW) {
            const int l = it / 48, j = it % 48; float sg = 0.f, sb = 0.f;
            for (int c = lane; c < 1024; c += 64) {
                float w = 0.f;
                if (j < 4) w = P.in[18][(size_t)l * DM * 4 + (size_t)c * 4 + j]; else if (j < 36) w = P.in[20][(size_t)l * DM * 32 + (size_t)c * 32 + (j - 4)];
                sg += P.in[14][l * DM + c] * w; sb += P.in[15][l * DM + c] * w;
            }
            sg = wave_sum(sg); sb = wave_sum(sb);
            const float bias = (j < 4) ? P.in[19][l * 4 + j] : ((j < 36) ? P.in[21][l * 32 + (j - 4)] : 0.f);
            if (lane == 0) { SGB[(l * 2 + 0) * 48 + j] = sg; SGB[(l * 2 + 1) * 48 + j] = sb + bias; }
        }
    }
    {
        const f32x4* x = (const f32x4*)P.in[0]; u32x4* xb = (u32x4*)(ws + WS_XB);
        const size_t nx = (size_t)NTOK * DM / 8, np = (size_t)2 * NTOK * 256 / 8;
        size_t i = gt;
        for (; i + 3 * GS < nx; i += 4 * GS) { f32x4 a[8];
#pragma unroll
            for (int q = 0; q < 4; ++q) { a[2 * q] = __builtin_nontemporal_load(x + 2 * (i + q * GS)); a[2 * q + 1] = __builtin_nontemporal_load(x + 2 * (i + q * GS) + 1); }
#pragma unroll
            for (int q = 0; q < 4; ++q) xb[i + q * GS] = pack8(a[2 * q], a[2 * q + 1]); }
        for (; i < nx; i += GS) xb[i] = pack8(x[2 * i], x[2 * i + 1]);
        const f32x4* p = (const f32x4*)P.in[1]; u32x4* pb = (u32x4*)(ws + WS_PB);
        i = gt;
        for (; i + 3 * GS < np; i += 4 * GS) { f32x4 a[8];
#pragma unroll
            for (int q = 0; q < 4; ++q) { a[2 * q] = __builtin_nontemporal_load(p + 2 * (i + q * GS)); a[2 * q + 1] = __builtin_nontemporal_load(p + 2 * (i + q * GS) + 1); }
#pragma unroll
            for (int q = 0; q < 4; ++q) pb[i + q * GS] = pack8(a[2 * q], a[2 * q + 1]); }
        for (; i < np; i += GS) pb[i] = pack8(p[2 * i], p[2 * i + 1]);
    }
}

__device__ __forceinline__ float ret_logg(int h) { return log1pf(-exp2f(-5.0f - (float)h)); }

__device__ __forceinline__ void phase_ret_kv(const Params& P, unsigned char* lds) {
    const bf16_t* Z0 = (const bf16_t*)(P.ws + WS_Z0); float* KV = (float*)(P.ws + WS_KV);
    float* Ks = (float*)lds; float* Vs = Ks + 128 * 128;
    const int tid = threadIdx.x;
    for (int u = blockIdx.x; u < 1024; u += gridDim.x) {
        const int n = u & 63, h = (u >> 6) & 3, b = u >> 8;
        const float lg = ret_logg(h);
        const size_t row0 = (size_t)b * SEQ + n * 128;
        for (int i = tid; i < 128 * 16; i += NT) {
            const int r = i >> 4, c8 = (i & 15) * 8;
            const u32x4 kv = *(const u32x4*)(Z0 + (row0 + r) * ZW + 512 + h * 128 + c8);
            const u32x4 vv = *(const u32x4*)(Z0 + (row0 + r) * ZW + 1024 + h * 128 + c8);
            const float dec = __expf(lg * (float)(127 - r));
            float* kp = Ks + r * 128 + c8; float* vp = Vs + r * 128 + c8;
            kp[0] = bflo(kv.x) * dec; kp[1] = bfhi(kv.x) * dec; kp[2] = bflo(kv.y) * dec; kp[3] = bfhi(kv.y) * dec;
            kp[4] = bflo(kv.z) * dec; kp[5] = bfhi(kv.z) * dec; kp[6] = bflo(kv.w) * dec; kp[7] = bfhi(kv.w) * dec;
            vp[0] = bflo(vv.x); vp[1] = bfhi(vv.x); vp[2] = bflo(vv.y); vp[3] = bfhi(vv.y);
            vp[4] = bflo(vv.z); vp[5] = bfhi(vv.z); vp[6] = bflo(vv.w); vp[7] = bfhi(vv.w);
        }
        __syncthreads();
        const int dd = tid >> 2, v0 = (tid & 3) * 32;
        float acc[32];
#pragma unroll
        for (int j = 0; j < 32; ++j) acc[j] = 0.f;
        for (int i = 0; i < 128; ++i) {
            const float kd = Ks[i * 128 + dd];
#pragma unroll
            for (int j = 0; j < 32; j += 4) { const f32x4 vv = *(const f32x4*)(Vs + i * 128 + v0 + j); acc[j] += kd * vv.x; acc[j + 1] += kd * vv.y; acc[j + 2] += kd * vv.z; acc[j + 3] += kd * vv.w; }
        }
        float* o = KV + (size_t)u * 16384 + dd * 128 + v0;
#pragma unroll
        for (int j = 0; j < 32; j += 4) *(f32x4*)(o + j) = (f32x4){acc[j], acc[j + 1], acc[j + 2], acc[j + 3]};
        __syncthreads();
    }
}
__device__ __forceinline__ void phase_ret_scan_pool(const Params& P) {
    float* KV = (float*)(P.ws + WS_KV);
    const size_t gt = (size_t)blockIdx.x * NT + threadIdx.x, GS = (size_t)gridDim.x * NT;
    for (size_t i = gt; i < (size_t)16 * 4096; i += GS) {
        const int s = (int)(i >> 12), e4 = (int)(i & 4095), h = s & 3;
        const float cd = __expf(ret_logg(h) * 128.0f);
        f32x4* p = (f32x4*)(KV + (size_t)s * 64 * 16384) + e4;
        f32x4 R = {0.f, 0.f, 0.f, 0.f};
        for (int n0 = 0; n0 < 64; n0 += 8) {
            f32x4 kv[8];
#pragma unroll
            for (int j = 0; j < 8; ++j) kv[j] = p[(size_t)(n0 + j) * 4096];
#pragma unroll
            for (int j = 0; j < 8; ++j) { p[(size_t)(n0 + j) * 4096] = R; R = R * cd + kv[j]; }
        }
    }
    const bf16_t* Z0 = (const bf16_t*)(P.ws + WS_Z0); bf16_t* DP = (bf16_t*)(P.ws + WS_DP);
    for (size_t i = gt; i < (size_t)NTOK * 64; i += GS) {
        const int t = (int)(i >> 6), c8 = (int)(i & 63) * 8, g = c8 >> 7, w = 2 << g, tl = t & (SEQ - 1);
        const int cnt = min(tl + 1, w);
        float s[8];
#pragma unroll
        for (int j = 0; j < 8; ++j) s[j] = 0.f;
        float u0[8];
        for (int q = 0; q < cnt; ++q) {
            const u32x4 v = *(const u32x4*)(Z0 + (size_t)(t - q) * ZW + 2048 + c8);
            const float f[8] = {bflo(v.x), bfhi(v.x), bflo(v.y), bfhi(v.y), bflo(v.z), bfhi(v.z), bflo(v.w), bfhi(v.w)};
#pragma unroll
            for (int j = 0; j < 8; ++j) { s[j] += f[j]; if (q == 0) u0[j] = f[j]; }
        }
        const float inv = 1.0f / (float)cnt;
        u32x4 o; o.x = pk2(s[0] * inv - u0[0], s[1] * inv - u0[1]); o.y = pk2(s[2] * inv - u0[2], s[3] * inv - u0[3]);
        o.z = pk2(s[4] * inv - u0[4], s[5] * inv - u0[5]); o.w = pk2(s[6] * inv - u0[6], s[7] * inv - u0[7]);
        *(u32x4*)(DP + (size_t)t * 512 + c8) = o;
    }
}
__device__ __forceinline__ void phase_ret_out(const Params& P, unsigned char* lds) {
    const bf16_t* Z0 = (const bf16_t*)(P.ws + WS_Z0); const float* KV = (const float*)(P.ws + WS_KV); bf16_t* MIX = (bf16_t*)(P.ws + WS_MIX);
    const float* gn = P.in[3];
    bf16_t* Qs = (bf16_t*)lds;
    bf16_t* Ksm = Qs + 128 * 136;
    float* Sc = (float*)(lds + 2 * 128 * 136 * 2);
    const int tid = threadIdx.x;
    for (int u = blockIdx.x; u < 1024; u += gridDim.x) {
        const int n = u & 63, h = (u >> 6) & 3, b = u >> 8;
        const float lg = ret_logg(h);
        const size_t row0 = (size_t)b * SEQ + n * 128;
        for (int i = tid; i < 128 * 16; i += NT) {
            const int r = i >> 4, c8 = (i & 15) * 8;
            *(u32x4*)(Qs + r * 136 + c8) = *(const u32x4*)(Z0 + (row0 + r) * ZW + h * 128 + c8);
            *(u32x4*)(Ksm + r * 136 + c8) = *(const u32x4*)(Z0 + (row0 + r) * ZW + 512 + h * 128 + c8);
        }
        __syncthreads();
        for (int e = tid; e < 128 * 128; e += NT) {
            const int i = e >> 7, j = e & 127;
            float s = 0.f;
            if (j <= i) {
                const bf16_t* q = Qs + i * 136; const bf16_t* k = Ksm + j * 136;
                for (int dd = 0; dd < 128; dd += 2) { const unsigned qa = *(const unsigned*)(q + dd), ka = *(const unsigned*)(k + dd); s += bflo(qa) * bflo(ka) + bfhi(qa) * bfhi(ka); }
                s *= __expf(lg * (float)(i - j));
            }
            Sc[e] = s;
        }
        __syncthreads();
        const int i = tid >> 2, v0 = (tid & 3) * 32;
        float acc[32];
#pragma unroll
        for (int j = 0; j < 32; ++j) acc[j] = 0.f;
        for (int j = 0; j <= i; ++j) {
            const float s = Sc[i * 128 + j];
            const bf16_t* vr = Z0 + (row0 + j) * ZW + 1024 + h * 128 + v0;
#pragma unroll
            for (int q = 0; q < 4; ++q) { const u32x4 vv = *(const u32x4*)(vr + q * 8);
                acc[q * 8 + 0] += s * bflo(vv.x); acc[q * 8 + 1] += s * bfhi(vv.x); acc[q * 8 + 2] += s * bflo(vv.y); acc[q * 8 + 3] += s * bfhi(vv.y);
                acc[q * 8 + 4] += s * bflo(vv.z); acc[q * 8 + 5] += s * bfhi(vv.z); acc[q * 8 + 6] += s * bflo(vv.w); acc[q * 8 + 7] += s * bfhi(vv.w); }
        }
        const float qdec = __expf(lg * (float)(i + 1));
        const float* S = KV + (size_t)u * 16384;
        for (int dd = 0; dd < 128; ++dd) {
            const float qd = bf2f(Qs[i * 136 + dd]) * qdec;
            const float* sr = S + dd * 128 + v0;
#pragma unroll
            for (int q = 0; q < 32; q += 4) { const f32x4 sv = *(const f32x4*)(sr + q); acc[q] += qd * sv.x; acc[q + 1] += qd * sv.y; acc[q + 2] += qd * sv.z; acc[q + 3] += qd * sv.w; }
        }
        float sm = 0.f;
#pragma unroll
        for (int j = 0; j < 32; ++j) sm += acc[j];
        sm += __shfl_xor(sm, 1); sm += __shfl_xor(sm, 2);
        const float mu = sm * (1.0f / 128.0f);
        float sq = 0.f;
#pragma unroll
        for (int j = 0; j < 32; ++j) { const float dlt = acc[j] - mu; sq += dlt * dlt; }
        sq += __shfl_xor(sq, 1); sq += __shfl_xor(sq, 2);
        const float rstd = 1.0f / sqrtf(sq * (1.0f / 128.0f) + LN_EPS);
        const bf16_t* gr = Z0 + (row0 + i) * ZW + 1536 + h * 128 + v0;
        bf16_t* orow = MIX + (row0 + i) * DM + h * 128 + v0;
#pragma unroll
        for (int q = 0; q < 4; ++q) {
            const u32x4 gv = *(const u32x4*)(gr + q * 8);
            const float g8[8] = {bflo(gv.x), bfhi(gv.x), bflo(gv.y), bfhi(gv.y), bflo(gv.z), bfhi(gv.z), bflo(gv.w), bfhi(gv.w)};
            float o8[8];
#pragma unroll
            for (int j = 0; j < 8; ++j) o8[j] = (acc[q * 8 + j] - mu) * rstd * gn[h * 128 + v0 + q * 8 + j] * silu_f(g8[j]);
            u32x4 w; w.x = pk2(o8[0], o8[1]); w.y = pk2(o8[2], o8[3]); w.z = pk2(o8[4], o8[5]); w.w = pk2(o8[6], o8[7]);
            *(u32x4*)(orow + q * 8) = w;
        }
        __syncthreads();
    }
}

template <bool DRY>
__device__ __forceinline__ void phase_ln_route(const Params& P, unsigned char* lds, int layer) {
    using pg8::bf16x8;
    const float* F = (const float*)(P.ws + WS_F); bf16_t* XB = (bf16_t*)(P.ws + (DRY ? WS_M0 + 128 * MiB : WS_XB));
    float* TOKG = (float*)(P.ws + WS_TOKG); int* LIST = (int*)(P.ws + WS_LIST);
    int* CNT = (int*)(P.ws + WS_CTL) + layer * 64;
    const float* lg = P.in[14] + layer * DM; const float* lb = P.in[15] + layer * DM;
    const bf16_t* GTh = (const bf16_t*)(P.ws + WS_GT) + (size_t)(layer * 2) * 48 * 1024; const bf16_t* GTl = GTh + 48 * 1024;
    const float* SG = (const float*)(P.ws + WS_SGB) + (layer * 2) * 48; const float* BB = SG + 48;
    const int tid = threadIdx.x, lane = tid & 63, wave = tid >> 6, r16 = lane & 15, g = lane >> 4;
    int* dec = (int*)lds;
    int* rank = dec + 256;
    int* lcnt = rank + 256;
    int* lbase = lcnt + 32;
    float* stat = (float*)(lds + 4096) + wave * 32;
    float* LG = (float*)(lds + 8192) + wave * (16 * 48);
    f32x4 g4[4], b4[4];
#pragma unroll
    for (int j = 0; j < 4; ++j) { g4[j] = *(const f32x4*)(lg + 256 * j + 4 * lane); b4[j] = *(const f32x4*)(lb + 256 * j + 4 * lane); }
    for (int rb = blockIdx.x; rb < NTOK / 128; rb += gridDim.x) {
        if (tid < 32) lcnt[tid] = 0;
        __syncthreads();
        const int tbase = rb * 128 + wave * 16;
        f32x4 acc[3];
#pragma unroll
        for (int i = 0; i < 3; ++i) acc[i] = (f32x4){0.f, 0.f, 0.f, 0.f};
        float sm = 0.f, sq = 0.f;
        const float* yrow = F + (size_t)(tbase + r16) * DM + 8 * g;
        const bf16_t* ghp = GTh + (size_t)r16 * 1024 + 8 * g; const bf16_t* glp = GTl + (size_t)r16 * 1024 + 8 * g;
#pragma unroll 2
        for (int k = 0; k < 32; ++k) {
            const f32x4 y0 = *(const f32x4*)(yrow + 32 * k), y1 = *(const f32x4*)(yrow + 32 * k + 4);
            bf16x8 gh[3], gl[3];
#pragma unroll
            for (int i = 0; i < 3; ++i) { gh[i] = *(const bf16x8*)(ghp + (size_t)i * 16 * 1024 + 32 * k); gl[i] = *(const bf16x8*)(glp + (size_t)i * 16 * 1024 + 32 * k); }
            sm += (y0.x + y0.y) + (y0.z + y0.w) + (y1.x + y1.y) + (y1.z + y1.w);
            sq += (y0.x * y0.x + y0.y * y0.y) + (y0.z * y0.z + y0.w * y0.w) + (y1.x * y1.x + y1.y * y1.y) + (y1.z * y1.z + y1.w * y1.w);
            u32x4 hw; hw.x = pk2(y0.x, y0.y); hw.y = pk2(y0.z, y0.w); hw.z = pk2(y1.x, y1.y); hw.w = pk2(y1.z, y1.w);
            u32x4 lw; lw.x = pk2(y0.x - bflo(hw.x), y0.y - bfhi(hw.x)); lw.y = pk2(y0.z - bflo(hw.y), y0.w - bfhi(hw.y));
            lw.z = pk2(y1.x - bflo(hw.z), y1.y - bfhi(hw.z)); lw.w = pk2(y1.z - bflo(hw.w), y1.w - bfhi(hw.w));
            const bf16x8 yh = __builtin_bit_cast(bf16x8, hw), yl = __builtin_bit_cast(bf16x8, lw);
#pragma unroll
            for (int i = 0; i < 3; ++i) {
                acc[i] = __builtin_amdgcn_mfma_f32_16x16x32_bf16(yh, gh[i], acc[i], 0, 0, 0);
                acc[i] = __builtin_amdgcn_mfma_f32_16x16x32_bf16(yl, gh[i], acc[i], 0, 0, 0);
                acc[i] = __builtin_amdgcn_mfma_f32_16x16x32_bf16(yh, gl[i], acc[i], 0, 0, 0);
            }
        }
        sm += __shfl_xor(sm, 16); sm += __shfl_xor(sm, 32); sq += __shfl_xor(sq, 16); sq += __shfl_xor(sq, 32);
        const float mean = sm * (1.0f / DM), var = fmaxf(sq * (1.0f / DM) - mean * mean, 0.f), rstd = 1.0f / sqrtf(var + LN_EPS);
        if (g == 0) { stat[r16 * 2] = mean; stat[r16 * 2 + 1] = rstd; }
        LDS_FENCE();
#pragma unroll
        for (int i = 0; i < 3; ++i) { const float sg = SG[16 * i + r16], bb = BB[16 * i + r16];
#pragma unroll
            for (int r = 0; r < 4; ++r) { const float mu = stat[(4 * g + r) * 2], rs = stat[(4 * g + r) * 2 + 1];
                LG[(4 * g + r) * 48 + 16 * i + r16] = rs * (acc[i][r] - mu * sg) + bb; } }
        LDS_FENCE();
        if (lane < 16) {
            const float* lr = LG + lane * 48; const int rl = wave * 16 + lane, t = tbase + lane;
            float gl4[4];
#pragma unroll
            for (int j = 0; j < 4; ++j) gl4[j] = lr[j];
            int grp = 0; float gm = gl4[0];
#pragma unroll
            for (int j = 1; j < 4; ++j) if (gl4[j] > gm) { gm = gl4[j]; grp = j; }
            float gs = 0.f;
#pragma unroll
            for (int j = 0; j < 4; ++j) gs += __expf(gl4[j] - gm);
            const float gwt = 1.0f / gs;
            float el[8];
#pragma unroll
            for (int j = 0; j < 8; ++j) el[j] = lr[4 + grp * 8 + j];
            int i0 = 0; float m0 = el[0];
#pragma unroll
            for (int j = 1; j < 8; ++j) if (el[j] > m0) { m0 = el[j]; i0 = j; }
            int i1 = -1; float m1 = -INFINITY;
#pragma unroll
            for (int j = 0; j < 8; ++j) if (j != i0 && el[j] > m1) { m1 = el[j]; i1 = j; }
            const float ex = __expf(m1 - m0);
            const float p0 = 1.0f / (1.0f + ex), p1 = ex / (1.0f + ex);
            dec[rl * 2] = grp * 8 + i0; dec[rl * 2 + 1] = grp * 8 + i1;
            if (!DRY) { TOKG[(size_t)t * 2] = gwt * p0; TOKG[(size_t)t * 2 + 1] = gwt * p1; }
        }
#pragma unroll 4
        for (int r = 0; r < 16; ++r) {
            const float mu = stat[r * 2], rs = stat[r * 2 + 1];
            const float* fr = F + (size_t)(tbase + r) * DM + 4 * lane; bf16_t* xo = XB + (size_t)(tbase + r) * DM + 4 * lane;
#pragma unroll
            for (int j = 0; j < 4; ++j) { const f32x4 y = *(const f32x4*)(fr + 256 * j); const f32x4 v = (y - mu) * rs * g4[j] + b4[j];
                u32x2 w; w.x = pk2(v.x, v.y); w.y = pk2(v.z, v.w); *(u32x2*)(xo + 256 * j) = w; }
        }
        __syncthreads();
        if (tid < 256) rank[tid] = atomicAdd(&lcnt[dec[tid]], 1);
        __syncthreads();
        if (tid < 32) lbase[tid] = DRY ? 0 : atomicAdd(&CNT[tid], lcnt[tid]);
        __syncthreads();
        if (!DRY && tid < 256) { const int e = dec[tid]; LIST[(size_t)e * LIST_CAP + lbase[e] + rank[tid]] = (rb * 128 + (tid >> 1)) * 2 + (tid & 1); }
        __syncthreads();
    }
}
__device__ __forceinline__ void moe_setup(const Params& P, int* tb, int layer) {
    const int* CNT = (const int*)(P.ws + WS_CTL) + layer * 64;
    if (threadIdx.x == 0) { int a = 0; for (int e = 0; e < 32; ++e) { tb[e] = a; a += (CNT[e] + 255) >> 8; } tb[32] = a; }
    __syncthreads();
}
template <bool DRY>
__device__ __forceinline__ void phase_ln2(const Params& P, int layer) {
    const bf16_t* XI = (const bf16_t*)(P.ws + WS_XB); bf16_t* XO = (bf16_t*)(P.ws + (DRY ? WS_XB2 : WS_XB));
    const bf16_t* YS = (const bf16_t*)(P.ws + WS_YS); const float* TOKG = (const float*)(P.ws + WS_TOKG);
    const float* lg = P.in[16] + layer * DM; const float* lb = P.in[17] + layer * DM;
    const int lane = threadIdx.x & 63, gw = blockIdx.x * NWAVE + (threadIdx.x >> 6), NGW = gridDim.x * NWAVE;
    f32x4 g4[4], b4[4];
#pragma unroll
    for (int j = 0; j < 4; ++j) { g4[j] = *(const f32x4*)(lg + 256 * j + 4 * lane); b4[j] = *(const f32x4*)(lb + 256 * j + 4 * lane); }
    u32x2 nx[4], na[4], nb[4]; float ng0 = 0.f, ng1 = 0.f;
    if (gw < NTOK) { const int t = gw;
#pragma unroll
        for (int j = 0; j < 4; ++j) { const int c0 = 256 * j + 4 * lane; nx[j] = *(const u32x2*)(XI + (size_t)t * DM + c0); na[j] = *(const u32x2*)(YS + (size_t)(2 * t) * DM + c0); nb[j] = *(const u32x2*)(YS + (size_t)(2 * t + 1) * DM + c0); }
        ng0 = TOKG[(size_t)t * 2]; ng1 = TOKG[(size_t)t * 2 + 1]; }
    for (int t = gw; t < NTOK; t += NGW) {
        const float g0 = ng0, g1 = ng1;
        u32x2 xw[4], aw[4], bw[4];
#pragma unroll
        for (int j = 0; j < 4; ++j) { xw[j] = nx[j]; aw[j] = na[j]; bw[j] = nb[j]; }
        if (t + NGW < NTOK) { const int tn = t + NGW;
#pragma unroll
            for (int j = 0; j < 4; ++j) { const int c0 = 256 * j + 4 * lane; nx[j] = *(const u32x2*)(XI + (size_t)tn * DM + c0); na[j] = *(const u32x2*)(YS + (size_t)(2 * tn) * DM + c0); nb[j] = *(const u32x2*)(YS + (size_t)(2 * tn + 1) * DM + c0); }
            ng0 = TOKG[(size_t)tn * 2]; ng1 = TOKG[(size_t)tn * 2 + 1]; }
        f32x4 v[4]; float s = 0.f;
#pragma unroll
        for (int j = 0; j < 4; ++j) {
            const u32x2 x = xw[j], a = aw[j], b = bw[j];
            v[j].x = bflo(x.x) * ALPHA + g0 * bflo(a.x) + g1 * bflo(b.x); v[j].y = bfhi(x.x) * ALPHA + g0 * bfhi(a.x) + g1 * bfhi(b.x);
            v[j].z = bflo(x.y) * ALPHA + g0 * bflo(a.y) + g1 * bflo(b.y); v[j].w = bfhi(x.y) * ALPHA + g0 * bfhi(a.y) + g1 * bfhi(b.y);
            s += (v[j].x + v[j].y) + (v[j].z + v[j].w); }
        const float mean = wave_sum(s) * (1.0f / DM); float s2 = 0.f;
#pragma unroll
        for (int j = 0; j < 4; ++j) { v[j] = v[j] - mean; s2 += (v[j].x * v[j].x + v[j].y * v[j].y) + (v[j].z * v[j].z + v[j].w * v[j].w); }
        const float rstd = 1.0f / sqrtf(wave_sum(s2) * (1.0f / DM) + LN_EPS);
#pragma unroll
        for (int j = 0; j < 4; ++j) { const int c0 = 256 * j + 4 * lane;
            v[j] = v[j] * rstd * g4[j] + b4[j];
            u32x2 w; w.x = pk2(v[j].x, v[j].y); w.y = pk2(v[j].z, v[j].w); *(u32x2*)(XO + (size_t)t * DM + c0) = w; }
    }
}

__device__ __forceinline__ unsigned f8enc(float y) {
    const unsigned u = __float_as_uint(y), sg = (u >> 24) & 0x80u;
    unsigned a = u & 0x7fffffffu;
    a = max(a, 0x3c000000u); a = min(a, 0x43f00000u);
    a = a + 0x0007ffffu + ((a >> 20) & 1u);
    const unsigned c = min(a >> 20, (135u << 3) | 7u) - (120u << 3);
    return sg | c;
}
__device__ __forceinline__ unsigned e5m2enc(float y) {
    const unsigned hb = (unsigned)__builtin_bit_cast(unsigned short, (_Float16)y);
    return ((hb + 0x7fu + ((hb >> 8) & 1u)) >> 8) & 0xffu;
}
__device__ __forceinline__ unsigned f8dec2(unsigned e) {
    const unsigned t = (e << 4) + 0x3c003c00u;
    return __umul24(e & 0x00800080u, 240u) + t;
}
__device__ __forceinline__ void phase_norms(const Params& P) {
    const bf16_t* Z1 = (const bf16_t*)(P.ws + WS_Z1); bf16_t* CQ = (bf16_t*)(P.ws + WS_CQ); bf16_t* CKV = (bf16_t*)(P.ws + WS_CKV); unsigned char* CKV8 = (unsigned char*)(P.ws + WS_CKV8);
    const float* qn = P.in[8]; const float* kn = P.in[9];
    const int lane = threadIdx.x & 63, gw = blockIdx.x * NWAVE + (threadIdx.x >> 6), NGW = gridDim.x * NWAVE;
    for (int t = gw; t < NTOK; t += NGW) {
        const u32x2 a = *(const u32x2*)(Z1 + (size_t)t * Z1W + 4 * lane), b = *(const u32x2*)(Z1 + (size_t)t * Z1W + 256 + 4 * lane);
        const float q[4] = {bflo(a.x), bfhi(a.x), bflo(a.y), bfhi(a.y)}, k[4] = {bflo(b.x), bfhi(b.x), bflo(b.y), bfhi(b.y)};
        const float sq = wave_sum(q[0] * q[0] + q[1] * q[1] + q[2] * q[2] + q[3] * q[3]), sk = wave_sum(k[0] * k[0] + k[1] * k[1] + k[2] * k[2] + k[3] * k[3]);
        const float rq = 1.0f / sqrtf(sq * (1.0f / 256.0f) + 1e-6f), rk = 1.0f / sqrtf(sk * (1.0f / 256.0f) + 1e-6f);
        const f32x4 gq = *(const f32x4*)(qn + 4 * lane), gk = *(const f32x4*)(kn + 4 * lane);
        u32x2 o; o.x = pk2(q[0] * rq * gq.x, q[1] * rq * gq.y); o.y = pk2(q[2] * rq * gq.z, q[3] * rq * gq.w);
        *(u32x2*)(CQ + (size_t)t * 256 + 4 * lane) = o;
        o.x = pk2(k[0] * rk * gk.x, k[1] * rk * gk.y); o.y = pk2(k[2] * rk * gk.z, k[3] * rk * gk.w);
        *(u32x2*)(CKV + (size_t)t * 256 + 4 * lane) = o;
        *(unsigned*)(CKV8 + (size_t)t * 256 + 4 * lane) = e5m2enc(k[0] * rk * gk.x) | (e5m2enc(k[1] * rk * gk.y) << 8) | (e5m2enc(k[2] * rk * gk.z) << 16) | (e5m2enc(k[3] * rk * gk.w) << 24);
    }
}
__device__ __forceinline__ unsigned fkey(float f) { const unsigned u = __float_as_uint(f); return (u & 0x80000000u) ? ~u : (u | 0x80000000u); }

__device__ __forceinline__ void phase_index(const Params& P, unsigned char* lds) {
    const bf16_t* Z1 = (const bf16_t*)(P.ws + WS_Z1); unsigned short* SEL = (unsigned short*)(P.ws + WS_SEL);
    float* sc = (float*)lds;
    float* qf = sc + 8192;
    float* wf = qf + 512;
    int* hist = (int*)(wf + 8);
    int* misc = hist + 256;
    int* seg = misc + 8;
    const int tid = threadIdx.x;
    for (int t = blockIdx.x; t < NTOK; t += gridDim.x) {
        const int b = t >> 13, tl = t & (SEQ - 1), n = tl + 1;
        unsigned short* so = SEL + (size_t)t * TOPK;
        if (n <= TOPK) { if (tid < n) so[tid] = (unsigned short)tid; continue; }
        qf[tid] = bf2f(Z1[(size_t)t * Z1W + 512 + tid]);
        if (tid < 8) wf[tid] = bf2f(Z1[(size_t)t * Z1W + 1088 + tid]);
        __syncthreads();
        for (int s = tid; s < n; s += NT) {
            const bf16_t* kr = Z1 + ((size_t)b * SEQ + s) * Z1W + 1024;
            float k[64];
#pragma unroll
            for (int q = 0; q < 8; ++q) { const u32x4 v = *(const u32x4*)(kr + q * 8);
                k[q * 8] = bflo(v.x); k[q * 8 + 1] = bfhi(v.x); k[q * 8 + 2] = bflo(v.y); k[q * 8 + 3] = bfhi(v.y);
                k[q * 8 + 4] = bflo(v.z); k[q * 8 + 5] = bfhi(v.z); k[q * 8 + 6] = bflo(v.w); k[q * 8 + 7] = bfhi(v.w); }
            float I = 0.f;
#pragma unroll
            for (int h = 0; h < 8; ++h) { float d = 0.f;
#pragma unroll
                for (int dd = 0; dd < 64; ++dd) d += qf[h * 64 + dd] * k[dd];
                I += wf[h] * fmaxf(d, 0.f); }
            sc[s] = I;
        }
        if (tid == 0) { misc[0] = 0; misc[1] = TOPK; misc[2] = 0; }
        __syncthreads();
        for (int pass = 0; pass < 4; ++pass) {
            const int shift = 24 - 8 * pass;
            if (tid < 256) hist[tid] = 0;
            __syncthreads();
            const unsigned prefix = (unsigned)misc[0]; const int kk = misc[1];
            for (int s = tid; s < n; s += NT) { const unsigned key = fkey(sc[s]);
                if (pass == 0 || (key >> (shift + 8)) == prefix) atomicAdd(&hist[(key >> shift) & 255], 1); }
            __syncthreads();
            if (tid == 0) { int a = 0, bsel = 0; for (int bin = 255; bin >= 0; --bin) { const int c = hist[bin]; if (a + c >= kk) { bsel = bin; break; } a += c; }
                misc[0] = (int)((prefix << 8) | (unsigned)bsel); misc[1] = kk - a; }
            __syncthreads();
        }
        const unsigned T = (unsigned)misc[0]; const int keq = misc[1];
        for (int s = tid; s < n; s += NT) if (fkey(sc[s]) > T) { const int o = atomicAdd(&misc[2], 1); so[o] = (unsigned short)s; }
        const int per = (n + NT - 1) / NT, s0 = tid * per, s1 = min(n, s0 + per);
        int ce = 0;
        for (int s = s0; s < s1; ++s) ce += (fkey(sc[s]) == T) ? 1 : 0;
        seg[tid] = ce;
        __syncthreads();
        if (tid == 0) { int a = 0; for (int i = 0; i < NT; ++i) { const int c = seg[i]; seg[i] = a; a += c; } }
        __syncthreads();
        const int ngt = TOPK - keq;
        int r = seg[tid];
        for (int s = s0; s < s1 && r < keq; ++s) if (fkey(sc[s]) == T) { so[ngt + r] = (unsigned short)s; ++r; }
        __syncthreads();
    }
}
__device__ __forceinline__ void phase_sparse_attn(const Params& P, unsigned char* lds) {
    bf16_t* QA = (bf16_t*)(P.ws + WS_QA); const bf16_t* CKV = (const bf16_t*)(P.ws + WS_CKV); const unsigned short* SEL = (const unsigned short*)(P.ws + WS_SEL);
    float* qa = (float*)lds;
    float* lgt = qa + 4096;
    int* sel = (int*)(lgt + 4096);
    const int tid = threadIdx.x, lane = tid & 63, wave = tid >> 6;
    for (int t = blockIdx.x; t < NTOK; t += gridDim.x) {
        const int b = t >> 13, tl = t & (SEQ - 1), ns = min(tl + 1, TOPK);
        { const u32x4 v = *(const u32x4*)(QA + (size_t)t * 4096 + tid * 8); float* q = qa + tid * 8;
          q[0] = bflo(v.x); q[1] = bfhi(v.x); q[2] = bflo(v.y); q[3] = bfhi(v.y); q[4] = bflo(v.z); q[5] = bfhi(v.z); q[6] = bflo(v.w); q[7] = bfhi(v.w); }
        if (tid < TOPK) sel[tid] = (tid < ns) ? (int)SEL[(size_t)t * TOPK + tid] : 0;
        __syncthreads();
        const int k = tid & 255, hg = tid >> 8;
        {
            float acc[8];
#pragma unroll
            for (int h = 0; h < 8; ++h) acc[h] = 0.f;
            if (k < ns) {
                const bf16_t* cr = CKV + ((size_t)b * SEQ + sel[k]) * 256;
                for (int c8 = 0; c8 < 256; c8 += 8) {
                    const u32x4 v = *(const u32x4*)(cr + c8);
                    const float cv[8] = {bflo(v.x), bfhi(v.x), bflo(v.y), bfhi(v.y), bflo(v.z), bfhi(v.z), bflo(v.w), bfhi(v.w)};
#pragma unroll
                    for (int h = 0; h < 8; ++h) { const float* q = qa + (hg * 8 + h) * 256 + c8;
#pragma unroll
                        for (int j = 0; j < 8; ++j) acc[h] += q[j] * cv[j]; }
                }
            }
#pragma unroll
            for (int h = 0; h < 8; ++h) { const int hh = hg * 8 + h; const float slope = exp2f(-0.5f * (float)(hh + 1));
                lgt[hh * 256 + k] = (k < ns) ? (acc[h] - slope * (float)(tl - sel[k])) : -INFINITY; }
        }
        __syncthreads();
        for (int hh = wave * 2; hh < wave * 2 + 2; ++hh) {
            float* row = lgt + hh * 256;
            float x[4]; float m = -INFINITY;
#pragma unroll
            for (int j = 0; j < 4; ++j) { x[j] = row[lane + 64 * j]; m = fmaxf(m, x[j]); }
            m = wave_max(m); float s = 0.f;
#pragma unroll
            for (int j = 0; j < 4; ++j) { x[j] = __expf(x[j] - m); s += x[j]; }
            s = wave_sum(s); const float inv = 1.0f / s;
#pragma unroll
            for (int j = 0; j < 4; ++j) row[lane + 64 * j] = x[j] * inv;
        }
        __syncthreads();
        {
            const int c = tid & 255;
            float acc[8];
#pragma unroll
            for (int h = 0; h < 8; ++h) acc[h] = 0.f;
            const bf16_t* cb = CKV + (size_t)b * SEQ * 256 + c;
            for (int kk = 0; kk < ns; ++kk) {
                const float cv = bf2f(cb[(size_t)sel[kk] * 256]);
#pragma unroll
                for (int h = 0; h < 8; ++h) acc[h] += lgt[(hg * 8 + h) * 256 + kk] * cv;
            }
#pragma unroll
            for (int h = 0; h < 8; ++h) QA[(size_t)t * 4096 + (hg * 8 + h) * 256 + c] = (bf16_t)f2bf(acc[h]);
        }
        __syncthreads();
    }
}

constexpr int NPH_TOTAL = 23;


typedef short v4i16_t __attribute__((ext_vector_type(4)));
template <bool DRY>
__device__ __forceinline__ void phase_sparse_attn_mfma(const Params& P, unsigned char* lds_) {
    using pg8::bf16x8;
    bf16_t* QA = (bf16_t*)(P.ws + WS_QA); const unsigned char* CKV = (const unsigned char*)(P.ws + WS_CKV); const unsigned short* SEL = (const unsigned short*)(P.ws + WS_SEL);
    const int tid = threadIdx.x, lane = tid & 63, wave = __builtin_amdgcn_readfirstlane(tid >> 6);
    const int fr = lane & 15, fq = lane >> 4;
    LAS unsigned char* cbuf = (LAS unsigned char*)lds_ + wave * 16896;
    LAS unsigned short* selw = (LAS unsigned short*)(cbuf + 16384);
    const int G = gridDim.x, NGW = G * NWAVE;
    int vw;
    if ((G & 7) == 0) vw = (((int)blockIdx.x & 7) * (G >> 3) + ((int)blockIdx.x >> 3)) * NWAVE + wave; else vw = (int)blockIdx.x * NWAVE + wave;
    const float LOG2E = 1.4426950408889634f;
    const float slope2 = exp2f(-0.5f * (float)(fr + 1)) * LOG2E;
    unsigned qoffB[4];
#pragma unroll
    for (int e = 0; e < 4; ++e) { const int key7 = (2 * e + (lane >> 5)) & 7; qoffB[e] = (unsigned)(((lane & 31) ^ (key7 << 1)) << 4); }
    const int rowA = fr;
    const unsigned swzA = (unsigned)((rowA & 7) << 1);
    const int rowT = 4 * fq + (fr >> 2);
    const unsigned swzT = (unsigned)((rowT & 7) << 1), pbT = (unsigned)((fr & 3) >> 1), halfT = (unsigned)(fr & 1) * 8u;
    const int per = NGW >> 2, bq = vw / per, wb = vw % per;
    for (int tl0 = wb; tl0 < SEQ; tl0 += per) {
        const int t = bq * SEQ + tl0;
        const int b = t >> 13, tl = t & (SEQ - 1), ns = min(tl + 1, TOPK), nch = (ns + 31) >> 5;
        {
            const u32x2 w = *(const u32x2*)(SEL + (size_t)t * TOPK + 4 * lane);
            unsigned short i0 = (unsigned short)(w.x & 0xffffu), i1 = (unsigned short)(w.x >> 16), i2 = (unsigned short)(w.y & 0xffffu), i3 = (unsigned short)(w.y >> 16);
            const int k0 = 4 * lane;
            if (k0 >= ns) i0 = 0; if (k0 + 1 >= ns) i1 = 0; if (k0 + 2 >= ns) i2 = 0; if (k0 + 3 >= ns) i3 = 0;
            u32x2 o; o.x = (unsigned)i0 | ((unsigned)i1 << 16); o.y = (unsigned)i2 | ((unsigned)i3 << 16);
            *(LAS u32x2*)(selw + 4 * lane) = o;
        }
        bf16x8 qf[8];
#pragma unroll
        for (int cc = 0; cc < 8; ++cc) qf[cc] = *(const bf16x8*)(QA + (size_t)t * 4096 + fr * 256 + 32 * cc + 8 * fq);
        f32x4 O[16];
#pragma unroll
        for (int ct = 0; ct < 16; ++ct) O[ct] = (f32x4){0.f, 0.f, 0.f, 0.f};
        float m = -INFINITY, l = 0.f;
        const unsigned char* cb = CKV + (size_t)b * SEQ * 512;
        for (int j = 0; j < nch; ++j) {
            asm volatile("s_waitcnt lgkmcnt(0)" ::: "memory");
#pragma unroll
            for (int e = 0; e < 16; ++e) {
                const unsigned idx = selw[32 * j + 2 * e + (lane >> 5)];
                __builtin_amdgcn_global_load_lds((const unsigned*)(cb + (size_t)idx * 512 + qoffB[e & 3]), (LAS unsigned*)(cbuf + e * 1024), 16, 0, 0);
            }
            asm volatile("s_waitcnt vmcnt(0)" ::: "memory");
            f32x4 s0 = {0.f, 0.f, 0.f, 0.f}, s1 = {0.f, 0.f, 0.f, 0.f};
#pragma unroll
            for (int cc = 0; cc < 8; ++cc) {
                const unsigned ch = (((unsigned)(4 * cc + fq)) ^ swzA) << 4;
                const bf16x8 a0 = *(const LAS bf16x8*)(cbuf + rowA * 512 + ch);
                const bf16x8 a1 = *(const LAS bf16x8*)(cbuf + (16 + rowA) * 512 + ch);
                s0 = __builtin_amdgcn_mfma_f32_16x16x32_bf16(a0, qf[cc], s0, 0, 0, 0);
                s1 = __builtin_amdgcn_mfma_f32_16x16x32_bf16(a1, qf[cc], s1, 0, 0, 0);
            }
            const u32x2 k0w = *(const LAS u32x2*)(selw + 32 * j + 4 * fq), k1w = *(const LAS u32x2*)(selw + 32 * j + 16 + 4 * fq);
            const int kb0 = 32 * j + 4 * fq, kb1 = kb0 + 16;
            float lg[8];
            {
                const int i00 = (int)(k0w.x & 0xffffu), i01 = (int)(k0w.x >> 16), i02 = (int)(k0w.y & 0xffffu), i03 = (int)(k0w.y >> 16);
                const int i10 = (int)(k1w.x & 0xffffu), i11 = (int)(k1w.x >> 16), i12 = (int)(k1w.y & 0xffffu), i13 = (int)(k1w.y >> 16);
                lg[0] = (kb0 + 0 < ns) ? s0.x * LOG2E - slope2 * (float)(tl - i00) : -INFINITY;
                lg[1] = (kb0 + 1 < ns) ? s0.y * LOG2E - slope2 * (float)(tl - i01) : -INFINITY;
                lg[2] = (kb0 + 2 < ns) ? s0.z * LOG2E - slope2 * (float)(tl - i02) : -INFINITY;
                lg[3] = (kb0 + 3 < ns) ? s0.w * LOG2E - slope2 * (float)(tl - i03) : -INFINITY;
                lg[4] = (kb1 + 0 < ns) ? s1.x * LOG2E - slope2 * (float)(tl - i10) : -INFINITY;
                lg[5] = (kb1 + 1 < ns) ? s1.y * LOG2E - slope2 * (float)(tl - i11) : -INFINITY;
                lg[6] = (kb1 + 2 < ns) ? s1.z * LOG2E - slope2 * (float)(tl - i12) : -INFINITY;
                lg[7] = (kb1 + 3 < ns) ? s1.w * LOG2E - slope2 * (float)(tl - i13) : -INFINITY;
            }
            float cm = fmaxf(fmaxf(fmaxf(lg[0], lg[1]), fmaxf(lg[2], lg[3])), fmaxf(fmaxf(lg[4], lg[5]), fmaxf(lg[6], lg[7])));
            cm = fmaxf(cm, __shfl_xor(cm, 16)); cm = fmaxf(cm, __shfl_xor(cm, 32));
            const float mn = fmaxf(m, cm);
            if (__any(mn > m)) {
                const float sc = exp2f(m - mn);
                l *= sc;
#pragma unroll
                for (int ct = 0; ct < 16; ++ct) O[ct] *= sc;
                m = mn;
            }
            float p[8]; float ps = 0.f;
#pragma unroll
            for (int i = 0; i < 8; ++i) { p[i] = exp2f(lg[i] - m); ps += p[i]; }
            l += ps;
            u32x4 pw; pw.x = pk2(p[0], p[1]); pw.y = pk2(p[2], p[3]); pw.z = pk2(p[4], p[5]); pw.w = pk2(p[6], p[7]);
            const bf16x8 pk = __builtin_bit_cast(bf16x8, pw);
#pragma unroll
            for (int ct = 0; ct < 16; ++ct) {
                const unsigned ch = ((((unsigned)(2 * ct)) ^ swzT) | pbT) << 4;
                const v4i16_t lo = __builtin_amdgcn_ds_read_tr16_b64_v4i16((LAS v4i16_t*)(cbuf + rowT * 512 + ch + halfT));
                const v4i16_t hi = __builtin_amdgcn_ds_read_tr16_b64_v4i16((LAS v4i16_t*)(cbuf + (16 + rowT) * 512 + ch + halfT));
                const bf16x8 a = {lo[0], lo[1], lo[2], lo[3], hi[0], hi[1], hi[2], hi[3]};
                O[ct] = __builtin_amdgcn_mfma_f32_16x16x32_bf16(a, pk, O[ct], 0, 0, 0);
            }
        }
        l += __shfl_xor(l, 16); l += __shfl_xor(l, 32);
        const float inv = 1.0f / l;
        bf16_t* orow = (DRY ? (bf16_t*)(P.ws + WS_PP) + (size_t)(t & 8191) * 4096 : QA + (size_t)t * 4096) + fr * 256 + 4 * fq;
#pragma unroll
        for (int ct = 0; ct < 16; ++ct) { u32x2 w; w.x = pk2(O[ct].x * inv, O[ct].y * inv); w.y = pk2(O[ct].z * inv, O[ct].w * inv); *(u32x2*)(orow + 16 * ct) = w; }
    }
}


template <bool DRY>
__device__ __forceinline__ void phase_sparse_attn_f8(const Params& P, unsigned char* lds_) {
    using pg8::bf16x8;
    bf16_t* QA = (bf16_t*)(P.ws + WS_QA); const unsigned char* CKV8 = (const unsigned char*)(P.ws + WS_CKV8); const unsigned short* SEL = (const unsigned short*)(P.ws + WS_SEL);
    const int tid = threadIdx.x, lane = tid & 63, wave = __builtin_amdgcn_readfirstlane(tid >> 6);
    const int fr = lane & 15, fq = lane >> 4;
    LAS unsigned char* cbuf = (LAS unsigned char*)lds_ + wave * 16896;
    LAS unsigned short* selw = (LAS unsigned short*)(cbuf + 16384);
    const int G = gridDim.x, NGW = G * NWAVE;
    int vw;
    if ((G & 7) == 0) vw = (((int)blockIdx.x & 7) * (G >> 3) + ((int)blockIdx.x >> 3)) * NWAVE + wave; else vw = (int)blockIdx.x * NWAVE + wave;
    const float LOG2E = 1.4426950408889634f;
    const float slope2 = exp2f(-0.5f * (float)(fr + 1)) * LOG2E;
    const int rowA = fr;
    const unsigned swzA = (unsigned)((rowA & 7) << 1);
    const int rowT = 4 * fq + (fr >> 2);
    const unsigned swzT = (unsigned)((rowT & 7) << 1), pbT = (unsigned)((fr & 3) >> 1), halfT = (unsigned)(fr & 1) * 8u;
    const unsigned swzA16 = (swzA ^ (unsigned)fq) << 4, baseA = (unsigned)rowA * 512u;
    const unsigned swzT16 = swzT << 4, baseT = (unsigned)rowT * 512u + (pbT << 4) + halfT;
    unsigned wofs[2];
#pragma unroll
    for (int e = 0; e < 2; ++e) { const int key7 = (4 * e + fq) & 7; wofs[e] = (unsigned)(fq * 512 + (((2 * fr) ^ (key7 << 1)) << 4)); }
    const int per = NGW >> 2, bq = vw / per, wb = vw % per;
    for (int tl0 = wb; tl0 < SEQ; tl0 += per) {
        const int t = bq * SEQ + tl0;
        const int b = t >> 13, tl = t & (SEQ - 1), ns = min(tl + 1, TOPK), nch = (ns + 31) >> 5;
        {
            const u32x2 w = *(const u32x2*)(SEL + (size_t)t * TOPK + 4 * lane);
            unsigned short i0 = (unsigned short)(w.x & 0xffffu), i1 = (unsigned short)(w.x >> 16), i2 = (unsigned short)(w.y & 0xffffu), i3 = (unsigned short)(w.y >> 16);
            const int k0 = 4 * lane;
            if (k0 >= ns) i0 = 0; if (k0 + 1 >= ns) i1 = 0; if (k0 + 2 >= ns) i2 = 0; if (k0 + 3 >= ns) i3 = 0;
            u32x2 o; o.x = (unsigned)i0 | ((unsigned)i1 << 16); o.y = (unsigned)i2 | ((unsigned)i3 << 16);
            *(LAS u32x2*)(selw + 4 * lane) = o;
        }
        bf16x8 qf[8];
#pragma unroll
        for (int cc = 0; cc < 8; ++cc) qf[cc] = *(const bf16x8*)(QA + (size_t)t * 4096 + fr * 256 + 32 * cc + 8 * fq);
        f32x4 O[16];
#pragma unroll
        for (int ct = 0; ct < 16; ++ct) O[ct] = (f32x4){0.f, 0.f, 0.f, 0.f};
        float m = -INFINITY, l = 0.f;
        const unsigned char* cb = CKV8 + (size_t)b * SEQ * 256 + 16 * fr;
        u32x4 stg[8];
#pragma unroll
        for (int e = 0; e < 8; ++e) { const unsigned idx = selw[4 * e + fq]; stg[e] = *(const u32x4*)(cb + (size_t)idx * 256); }
        for (int j = 0; j < nch; ++j) {
#pragma unroll
            for (int e = 0; e < 8; ++e) {
                const u32x4 w = stg[e];
                u32x4 lo, hi;
                lo.x = f8dec2(__builtin_amdgcn_perm(0u, w.x, 0x0c010c00u)); lo.y = f8dec2(__builtin_amdgcn_perm(0u, w.x, 0x0c030c02u));
                lo.z = f8dec2(__builtin_amdgcn_perm(0u, w.y, 0x0c010c00u)); lo.w = f8dec2(__builtin_amdgcn_perm(0u, w.y, 0x0c030c02u));
                hi.x = f8dec2(__builtin_amdgcn_perm(0u, w.z, 0x0c010c00u)); hi.y = f8dec2(__builtin_amdgcn_perm(0u, w.z, 0x0c030c02u));
                hi.z = f8dec2(__builtin_amdgcn_perm(0u, w.w, 0x0c010c00u)); hi.w = f8dec2(__builtin_amdgcn_perm(0u, w.w, 0x0c030c02u));
                LAS unsigned char* dst = cbuf + (e >> 1) * 4096 + (e & 1) * 2048 + wofs[e & 1];
                *(LAS u32x4*)dst = lo; *(LAS u32x4*)(dst + 16) = hi;
            }
            if (j + 1 < nch) {
#pragma unroll
                for (int e = 0; e < 8; ++e) { const unsigned idx = selw[32 * (j + 1) + 4 * e + fq]; stg[e] = *(const u32x4*)(cb + (size_t)idx * 256); }
            }
            f32x4 s0 = {0.f, 0.f, 0.f, 0.f}, s1 = {0.f, 0.f, 0.f, 0.f};
#pragma unroll
            for (int cc = 0; cc < 8; ++cc) {
                const LAS unsigned char* pa = cbuf + ((swzA16 ^ (unsigned)(cc << 6)) + baseA);
                const bf16x8 a0 = *(const LAS bf16x8*)(pa);
                const bf16x8 a1 = *(const LAS bf16x8*)(pa + 8192);
                s0 = __builtin_amdgcn_mfma_f32_16x16x32_bf16(a0, qf[cc], s0, 0, 0, 0);
                s1 = __builtin_amdgcn_mfma_f32_16x16x32_bf16(a1, qf[cc], s1, 0, 0, 0);
            }
            const u32x2 k0w = *(const LAS u32x2*)(selw + 32 * j + 4 * fq), k1w = *(const LAS u32x2*)(selw + 32 * j + 16 + 4 * fq);
            const int kb0 = 32 * j + 4 * fq, kb1 = kb0 + 16;
            float lg[8];
            {
                const int i00 = (int)(k0w.x & 0xffffu), i01 = (int)(k0w.x >> 16), i02 = (int)(k0w.y & 0xffffu), i03 = (int)(k0w.y >> 16);
                const int i10 = (int)(k1w.x & 0xffffu), i11 = (int)(k1w.x >> 16), i12 = (int)(k1w.y & 0xffffu), i13 = (int)(k1w.y >> 16);
                lg[0] = (kb0 + 0 < ns) ? s0.x * LOG2E - slope2 * (float)(tl - i00) : -INFINITY;
                lg[1] = (kb0 + 1 < ns) ? s0.y * LOG2E - slope2 * (float)(tl - i01) : -INFINITY;
                lg[2] = (kb0 + 2 < ns) ? s0.z * LOG2E - slope2 * (float)(tl - i02) : -INFINITY;
                lg[3] = (kb0 + 3 < ns) ? s0.w * LOG2E - slope2 * (float)(tl - i03) : -INFINITY;
                lg[4] = (kb1 + 0 < ns) ? s1.x * LOG2E - slope2 * (float)(tl - i10) : -INFINITY;
                lg[5] = (kb1 + 1 < ns) ? s1.y * LOG2E - slope2 * (float)(tl - i11) : -INFINITY;
                lg[6] = (kb1 + 2 < ns) ? s1.z * LOG2E - slope2 * (float)(tl - i12) : -INFINITY;
                lg[7] = (kb1 + 3 < ns) ? s1.w * LOG2E - slope2 * (float)(tl - i13) : -INFINITY;
            }
            float cm = fmaxf(fmaxf(fmaxf(lg[0], lg[1]), fmaxf(lg[2], lg[3])), fmaxf(fmaxf(lg[4], lg[5]), fmaxf(lg[6], lg[7])));
            cm = fmaxf(cm, __shfl_xor(cm, 16)); cm = fmaxf(cm, __shfl_xor(cm, 32));
            const float mn = fmaxf(m, cm);
            if (__any(mn > m)) {
                const float sc = __builtin_amdgcn_exp2f(m - mn);
                l *= sc;
#pragma unroll
                for (int ct = 0; ct < 16; ++ct) O[ct] *= sc;
                m = mn;
            }
            float p[8]; float ps = 0.f;
#pragma unroll
            for (int i = 0; i < 8; ++i) { p[i] = __builtin_amdgcn_exp2f(lg[i] - m); ps += p[i]; }
            l += ps;
            u32x4 pw; pw.x = pk2(p[0], p[1]); pw.y = pk2(p[2], p[3]); pw.z = pk2(p[4], p[5]); pw.w = pk2(p[6], p[7]);
            const bf16x8 pk = __builtin_bit_cast(bf16x8, pw);
#pragma unroll
            for (int ct = 0; ct < 16; ++ct) {
                const LAS unsigned char* pt = cbuf + ((swzT16 ^ (unsigned)(ct << 5)) + baseT);
                const v4i16_t lo = __builtin_amdgcn_ds_read_tr16_b64_v4i16((LAS v4i16_t*)(pt));
                const v4i16_t hi = __builtin_amdgcn_ds_read_tr16_b64_v4i16((LAS v4i16_t*)(pt + 8192));
                const bf16x8 a = {lo[0], lo[1], lo[2], lo[3], hi[0], hi[1], hi[2], hi[3]};
                O[ct] = __builtin_amdgcn_mfma_f32_16x16x32_bf16(a, pk, O[ct], 0, 0, 0);
            }
        }
        l += __shfl_xor(l, 16); l += __shfl_xor(l, 32);
        const float inv = 1.0f / l;
        bf16_t* orow = (DRY ? (bf16_t*)(P.ws + WS_PP) + (size_t)(t & 8191) * 4096 : QA + (size_t)t * 4096) + fr * 256 + 4 * fq;
#pragma unroll
        for (int ct = 0; ct < 16; ++ct) { u32x2 w; w.x = pk2(O[ct].x * inv, O[ct].y * inv); w.y = pk2(O[ct].z * inv, O[ct].w * inv); *(u32x2*)(orow + 16 * ct) = w; }
    }
}


__device__ __forceinline__ void glds16(const void* gsrc, unsigned lds_dst) {
    unsigned keep;
    asm volatile("s_mov_b32 %0, m0\n\ts_mov_b32 m0, %2\n\ts_nop 0\n\tglobal_load_lds_dwordx4 %1, off\n\ts_mov_b32 m0, %0" : "=&s"(keep) : "v"(gsrc), "s"(lds_dst) : "memory");
}
typedef _Float16 f16x8 __attribute__((ext_vector_type(8)));
template <bool DRY>
__device__ __forceinline__ void phase_sparse_attn_e(const Params& P, unsigned char* lds_) {
    unsigned short* QA = (unsigned short*)(P.ws + WS_QA); const unsigned char* CKV8 = (const unsigned char*)(P.ws + WS_CKV8); const unsigned short* SEL = (const unsigned short*)(P.ws + WS_SEL);
    const int tid = threadIdx.x, lane = tid & 63, wave = __builtin_amdgcn_readfirstlane(tid >> 6);
    const int fr = lane & 15, fq = lane >> 4;
    LAS unsigned char* cbuf = (LAS unsigned char*)lds_ + wave * 16896;
    LAS unsigned short* selw = (LAS unsigned short*)(cbuf + 16384);
    const unsigned cbuf0 = (unsigned)(unsigned long)cbuf;
    const int G = gridDim.x, NGW = G * NWAVE;
    int vw;
    if ((G & 7) == 0) vw = (((int)blockIdx.x & 7) * (G >> 3) + ((int)blockIdx.x >> 3)) * NWAVE + wave; else vw = (int)blockIdx.x * NWAVE + wave;
    const float LOG2E = 1.4426950408889634f;
    const float slope2 = exp2f(-0.5f * (float)(fr + 1)) * LOG2E;
    unsigned qoffB[4];
#pragma unroll
    for (int e = 0; e < 4; ++e) { const int r15 = (4 * e + fq) & 15; qoffB[e] = (unsigned)((fr ^ (((r15 & 7) << 1) | (r15 >> 3))) << 4); }
    const unsigned fA = (unsigned)(((fr & 7) << 1) | (fr >> 3));
    const unsigned SA = (fA & 14u) << 4, baseA = (unsigned)fr * 256u + ((((unsigned)fq >> 1) ^ (fA & 1u)) << 4) + ((unsigned)fq & 1u) * 8u;
    const int rT = 4 * fq + (fr >> 2), pT_ = fr & 3;
    const unsigned fT = (unsigned)(((rT & 7) << 1) | (rT >> 3));
    const unsigned ST = (fT & 14u) << 4, baseT = (unsigned)rT * 256u + ((((unsigned)pT_ >> 1) ^ (fT & 1u)) << 4) + ((unsigned)pT_ & 1u) * 8u;
    const int per = NGW >> 2, bq = vw / per, wb = vw % per;
    for (int tl0 = wb; tl0 < SEQ; tl0 += per) {
        const int t = bq * SEQ + tl0;
        const int b = t >> 13, tl = t & (SEQ - 1), ns = min(tl + 1, TOPK), nch = (ns + 31) >> 5;
        {
            const u32x2 w = *(const u32x2*)(SEL + (size_t)t * TOPK + 4 * lane);
            unsigned short i0 = (unsigned short)(w.x & 0xffffu), i1 = (unsigned short)(w.x >> 16), i2 = (unsigned short)(w.y & 0xffffu), i3 = (unsigned short)(w.y >> 16);
            const int k0 = 4 * lane;
            if (k0 >= ns) i0 = 0; if (k0 + 1 >= ns) i1 = 0; if (k0 + 2 >= ns) i2 = 0; if (k0 + 3 >= ns) i3 = 0;
            u32x2 o; o.x = (unsigned)i0 | ((unsigned)i1 << 16); o.y = (unsigned)i2 | ((unsigned)i3 << 16);
            asm volatile("s_waitcnt lgkmcnt(0)" ::: "memory");
            *(LAS u32x2*)(selw + 4 * lane) = o;
        }
        f16x8 qf[8];
#pragma unroll
        for (int cc = 0; cc < 8; ++cc) qf[cc] = *(const f16x8*)(QA + (size_t)t * 4096 + fr * 256 + 32 * cc + 8 * fq);
        f32x4 Oe[8], Oo[8];
#pragma unroll
        for (int ut = 0; ut < 8; ++ut) { Oe[ut] = (f32x4){0.f, 0.f, 0.f, 0.f}; Oo[ut] = (f32x4){0.f, 0.f, 0.f, 0.f}; }
        float m = -INFINITY, l = 0.f;
        const unsigned char* cb = CKV8 + (size_t)b * SEQ * 256;
        asm volatile("s_waitcnt vmcnt(0) lgkmcnt(0)" ::: "memory");
#define ATT_DMA(jj, bufoff) do { unsigned idx_[8]; \
            _Pragma("unroll") for (int e = 0; e < 8; ++e) idx_[e] = (DRY && PROBE_ATT == 1) ? (unsigned)((32 * (jj) + 4 * e + fq + 64 * wave) & 8191) : (unsigned)selw[32 * (jj) + 4 * e + fq]; \
            _Pragma("unroll") for (int e = 0; e < 8; ++e) { \
            if (!(DRY && PROBE_ATT == 3)) glds16(cb + (size_t)idx_[e] * 256 + qoffB[e & 3], (unsigned)__builtin_amdgcn_readfirstlane((int)(cbuf0 + (bufoff) + e * 1024))); } } while (0)
        ATT_DMA(0, 0);
        if (nch > 1) ATT_DMA(1, 8192);
        for (int j = 0; j < nch; ++j) {
            const unsigned bo = (unsigned)(j & 1) * 8192u;
            if (j + 1 < nch) asm volatile("s_waitcnt vmcnt(8)" ::: "memory"); else asm volatile("s_waitcnt vmcnt(0)" ::: "memory");
            const LAS unsigned char* img = cbuf + bo;
            if (DRY && PROBE_ATT == 2) { if (j + 2 < nch) { asm volatile("s_waitcnt lgkmcnt(0)" ::: "memory"); ATT_DMA(j + 2, bo); } continue; }
            u32x2 ra[8], rb[8];
#pragma unroll
            for (int cc = 0; cc < 8; ++cc) { const LAS unsigned char* pa = img + ((SA ^ (unsigned)(cc << 5)) + baseA); ra[cc] = *(const LAS u32x2*)(pa); rb[cc] = *(const LAS u32x2*)(pa + 4096); }
            const u32x2 k0w = *(const LAS u32x2*)(selw + 32 * j + 4 * fq), k1w = *(const LAS u32x2*)(selw + 32 * j + 16 + 4 * fq);
            __builtin_amdgcn_sched_barrier(0);
            f32x4 s0 = {0.f, 0.f, 0.f, 0.f}, s1 = {0.f, 0.f, 0.f, 0.f};
#pragma unroll
            for (int cc = 0; cc < 8; ++cc) {
                u32x4 a0, a1;
                a0.x = __builtin_amdgcn_perm(0u, ra[cc].x, 0x010c000cu); a0.y = __builtin_amdgcn_perm(0u, ra[cc].x, 0x030c020cu); a0.z = __builtin_amdgcn_perm(0u, ra[cc].y, 0x010c000cu); a0.w = __builtin_amdgcn_perm(0u, ra[cc].y, 0x030c020cu);
                a1.x = __builtin_amdgcn_perm(0u, rb[cc].x, 0x010c000cu); a1.y = __builtin_amdgcn_perm(0u, rb[cc].x, 0x030c020cu); a1.z = __builtin_amdgcn_perm(0u, rb[cc].y, 0x010c000cu); a1.w = __builtin_amdgcn_perm(0u, rb[cc].y, 0x030c020cu);
                s0 = __builtin_amdgcn_mfma_f32_16x16x32_f16(__builtin_bit_cast(f16x8, a0), qf[cc], s0, 0, 0, 0);
                s1 = __builtin_amdgcn_mfma_f32_16x16x32_f16(__builtin_bit_cast(f16x8, a1), qf[cc], s1, 0, 0, 0);
            }
            __builtin_amdgcn_sched_barrier(0);
            u32x2 tl_[8], th_[8];
#pragma unroll
            for (int ut = 0; ut < 8; ++ut) { const LAS unsigned char* pt = img + ((ST ^ (unsigned)(ut << 5)) + baseT);
                tl_[ut] = __builtin_bit_cast(u32x2, __builtin_amdgcn_ds_read_tr16_b64_v4i16((LAS v4i16_t*)(pt)));
                th_[ut] = __builtin_bit_cast(u32x2, __builtin_amdgcn_ds_read_tr16_b64_v4i16((LAS v4i16_t*)(pt + 4096))); }
            __builtin_amdgcn_sched_barrier(0);
            const int kb0 = 32 * j + 4 * fq, kb1 = kb0 + 16;
            float lg[8];
            {
                const int i00 = (int)(k0w.x & 0xffffu), i01 = (int)(k0w.x >> 16), i02 = (int)(k0w.y & 0xffffu), i03 = (int)(k0w.y >> 16);
                const int i10 = (int)(k1w.x & 0xffffu), i11 = (int)(k1w.x >> 16), i12 = (int)(k1w.y & 0xffffu), i13 = (int)(k1w.y >> 16);
                lg[0] = (kb0 + 0 < ns) ? s0.x * LOG2E - slope2 * (float)(tl - i00) : -INFINITY;
                lg[1] = (kb0 + 1 < ns) ? s0.y * LOG2E - slope2 * (float)(tl - i01) : -INFINITY;
                lg[2] = (kb0 + 2 < ns) ? s0.z * LOG2E - slope2 * (float)(tl - i02) : -INFINITY;
                lg[3] = (kb0 + 3 < ns) ? s0.w * LOG2E - slope2 * (float)(tl - i03) : -INFINITY;
                lg[4] = (kb1 + 0 < ns) ? s1.x * LOG2E - slope2 * (float)(tl - i10) : -INFINITY;
                lg[5] = (kb1 + 1 < ns) ? s1.y * LOG2E - slope2 * (float)(tl - i11) : -INFINITY;
                lg[6] = (kb1 + 2 < ns) ? s1.z * LOG2E - slope2 * (float)(tl - i12) : -INFINITY;
                lg[7] = (kb1 + 3 < ns) ? s1.w * LOG2E - slope2 * (float)(tl - i13) : -INFINITY;
            }
            const float cm = fmaxf(fmaxf(fmaxf(lg[0], lg[1]), fmaxf(lg[2], lg[3])), fmaxf(fmaxf(lg[4], lg[5]), fmaxf(lg[6], lg[7])));
            if (__any(cm > m + 8.0f)) {
                float cx = fmaxf(cm, __shfl_xor(cm, 16)); cx = fmaxf(cx, __shfl_xor(cx, 32));
                const float mn = fmaxf(m, cx);
                const float sc = __builtin_amdgcn_exp2f(m - mn);
                l *= sc;
#pragma unroll
                for (int ut = 0; ut < 8; ++ut) { Oe[ut] *= sc; Oo[ut] *= sc; }
                m = mn;
            }
            float p[8]; float ps = 0.f;
#pragma unroll
            for (int i = 0; i < 8; ++i) { p[i] = __builtin_amdgcn_exp2f(lg[i] - m); ps += p[i]; }
            l += ps;
            u32x4 pw;
            pw.x = __builtin_bit_cast(unsigned, __builtin_amdgcn_cvt_pkrtz(p[0], p[1])); pw.y = __builtin_bit_cast(unsigned, __builtin_amdgcn_cvt_pkrtz(p[2], p[3]));
            pw.z = __builtin_bit_cast(unsigned, __builtin_amdgcn_cvt_pkrtz(p[4], p[5])); pw.w = __builtin_bit_cast(unsigned, __builtin_amdgcn_cvt_pkrtz(p[6], p[7]));
            const f16x8 pk = __builtin_bit_cast(f16x8, pw);
#pragma unroll
            for (int ut = 0; ut < 8; ++ut) {
                const u32x2 lw = tl_[ut], hw = th_[ut];
                u32x4 ae, ao;
                ae.x = __builtin_amdgcn_perm(0u, lw.x, 0x020c000cu); ae.y = __builtin_amdgcn_perm(0u, lw.y, 0x020c000cu); ae.z = __builtin_amdgcn_perm(0u, hw.x, 0x020c000cu); ae.w = __builtin_amdgcn_perm(0u, hw.y, 0x020c000cu);
                ao.x = __builtin_amdgcn_perm(0u, lw.x, 0x030c010cu); ao.y = __builtin_amdgcn_perm(0u, lw.y, 0x030c010cu); ao.z = __builtin_amdgcn_perm(0u, hw.x, 0x030c010cu); ao.w = __builtin_amdgcn_perm(0u, hw.y, 0x030c010cu);
                Oe[ut] = __builtin_amdgcn_mfma_f32_16x16x32_f16(__builtin_bit_cast(f16x8, ae), pk, Oe[ut], 0, 0, 0);
                Oo[ut] = __builtin_amdgcn_mfma_f32_16x16x32_f16(__builtin_bit_cast(f16x8, ao), pk, Oo[ut], 0, 0, 0);
            }
            if (j + 2 < nch) { asm volatile("s_waitcnt lgkmcnt(0)" ::: "memory"); ATT_DMA(j + 2, bo); }
        }
#undef ATT_DMA
        l += __shfl_xor(l, 16); l += __shfl_xor(l, 32);
        const float inv = 1.0f / l;
        bf16_t* orow = (DRY ? (bf16_t*)(P.ws + WS_PP) + (size_t)(t & 8191) * 4096 : (bf16_t*)QA + (size_t)t * 4096) + fr * 256 + 8 * fq;
#pragma unroll
        for (int ut = 0; ut < 8; ++ut) {
            u32x4 w; w.x = pk2(Oe[ut].x * inv, Oo[ut].x * inv); w.y = pk2(Oe[ut].y * inv, Oo[ut].y * inv); w.z = pk2(Oe[ut].z * inv, Oo[ut].z * inv); w.w = pk2(Oe[ut].w * inv, Oo[ut].w * inv);
            *(u32x4*)(orow + 32 * ut) = w;
        }
    }
}

constexpr size_t SC_BATCH = (size_t)1024 * 256 * 257 / 2;
__device__ __forceinline__ size_t sc_row_off(int b, int tl) { const size_t m = (size_t)(tl >> 5); return (size_t)b * SC_BATCH + 1024 * (m * (m + 1) / 2) + (size_t)(tl & 31) * 32 * (m + 1); }
typedef float f32x16 __attribute__((ext_vector_type(16)));
__device__ __forceinline__ unsigned okey_pk(float a, float b) {
    const unsigned w = __builtin_bit_cast(unsigned, __builtin_amdgcn_cvt_pkrtz(a, b));
    const unsigned neg = (w >> 15) & 0x00010001u;
    return w ^ ((neg * 0xffffu) | 0x80008000u);
}
__device__ __forceinline__ void phase_index_scores(const Params& P, unsigned char* lds_) {
    using pg8::bf16x8;
    const bf16_t* Z1 = (const bf16_t*)(P.ws + WS_Z1); unsigned short* SC = (unsigned short*)(P.ws + WS_SC);
    LAS unsigned char* lds = (LAS unsigned char*)lds_;
    constexpr int QROW = 144;
    LAS unsigned char* QL = lds;
    LAS float* SG = (LAS float*)(lds + 9 * 64 * QROW);
    const int tid = threadIdx.x, lane = tid & 63, wave = __builtin_amdgcn_readfirstlane(tid >> 6);
    LAS unsigned char* ST = lds + 9 * 64 * QROW + 2048 + wave * 5120;
    const int l31 = lane & 31, hh = lane >> 5;
    for (int pid = blockIdx.x; pid < 256; pid += gridDim.x) {
        const int b = pid >> 6;
        for (int side = 0; side < 2; ++side) {
            const int qb = side ? (127 - (pid & 63)) : (pid & 63);
            const int q0 = qb * 64;
            __syncthreads();
            {
                const int qi = tid >> 3, part = tid & 7;
                const bf16_t* zr = Z1 + ((size_t)b * SEQ + q0 + qi) * Z1W;
                const u32x4 ww = *(const u32x4*)(zr + 1088);
                const float w8[8] = {bflo(ww.x), bfhi(ww.x), bflo(ww.y), bfhi(ww.y), bflo(ww.z), bfhi(ww.z), bflo(ww.w), bfhi(ww.w)};
                float wh = 0.f;
#pragma unroll
                for (int h = 0; h < 8; ++h) wh = (h == part) ? w8[h] : wh;
                const float sc = 0.5f * fabsf(wh);
                SG[qi * 8 + part] = (wh >= 0.f) ? 1.0f : -1.0f;
#pragma unroll
                for (int c = 0; c < 8; ++c) {
                    const u32x4 v = *(const u32x4*)(zr + 512 + part * 64 + c * 8);
                    u32x4 o; o.x = pk2(bflo(v.x) * sc, bfhi(v.x) * sc); o.y = pk2(bflo(v.y) * sc, bfhi(v.y) * sc); o.z = pk2(bflo(v.z) * sc, bfhi(v.z) * sc); o.w = pk2(bflo(v.w) * sc, bfhi(v.w) * sc);
                    *(LAS u32x4*)(QL + (part * 64 + qi) * QROW + c * 16) = o;
                }
                float a8[8];
#pragma unroll
                for (int j = 0; j < 8; ++j) a8[j] = 0.f;
#pragma unroll
                for (int h = 0; h < 8; ++h) {
                    const u32x4 v = *(const u32x4*)(zr + 512 + h * 64 + part * 8); const float s2 = 0.5f * w8[h];
                    a8[0] += s2 * bflo(v.x); a8[1] += s2 * bfhi(v.x); a8[2] += s2 * bflo(v.y); a8[3] += s2 * bfhi(v.y);
                    a8[4] += s2 * bflo(v.z); a8[5] += s2 * bfhi(v.z); a8[6] += s2 * bflo(v.w); a8[7] += s2 * bfhi(v.w);
                }
                u32x4 o; o.x = pk2(a8[0], a8[1]); o.y = pk2(a8[2], a8[3]); o.z = pk2(a8[4], a8[5]); o.w = pk2(a8[6], a8[7]);
                *(LAS u32x4*)(QL + (8 * 64 + qi) * QROW + part * 16) = o;
            }
            __syncthreads();
            const int ktmax = 2 * qb + 1;
            bf16x8 kn[4];
            {   const bf16_t* kr = Z1 + ((size_t)b * SEQ + min(wave, ktmax) * 32 + l31) * Z1W + 1024 + hh * 8;
#pragma unroll
                for (int dq = 0; dq < 4; ++dq) kn[dq] = *(const bf16x8*)(kr + dq * 16); }
            for (int kt = wave; kt <= ktmax; kt += NWAVE) {
                bf16x8 kf[4];
#pragma unroll
                for (int dq = 0; dq < 4; ++dq) kf[dq] = kn[dq];
                {   const bf16_t* kr = Z1 + ((size_t)b * SEQ + min(kt + NWAVE, ktmax) * 32 + l31) * Z1W + 1024 + hh * 8;
#pragma unroll
                    for (int dq = 0; dq < 4; ++dq) kn[dq] = *(const bf16x8*)(kr + dq * 16); }
#pragma unroll
                for (int qs = 0; qs < 2; ++qs) {
                    const LAS unsigned char* qrow = QL + (qs * 32 + l31) * QROW + hh * 16;
                    const LAS float* sgp = SG + (qs * 32 + l31) * 8;
                    bf16x8 fc[4], fn[4];
#pragma unroll
                    for (int dq = 0; dq < 4; ++dq) fc[dq] = *(const LAS bf16x8*)(qrow + 8 * 64 * QROW + dq * 32);
#pragma unroll
                    for (int dq = 0; dq < 4; ++dq) fn[dq] = *(const LAS bf16x8*)(qrow + dq * 32);
                    const f32x4 sg03 = *(const LAS f32x4*)(sgp), sg47 = *(const LAS f32x4*)(sgp + 4);
                    f32x16 acc;
#pragma unroll
                    for (int r = 0; r < 16; ++r) acc[r] = 0.f;
#pragma unroll
                    for (int dq = 0; dq < 4; ++dq) acc = __builtin_amdgcn_mfma_f32_32x32x16_bf16(kf[dq], fc[dq], acc, 0, 0, 0);
                    f32x16 up;
#pragma unroll
                    for (int h = 0; h < 8; ++h) {
#pragma unroll
                        for (int dq = 0; dq < 4; ++dq) fc[dq] = fn[dq];
                        if (h < 7) {
#pragma unroll
                            for (int dq = 0; dq < 4; ++dq) fn[dq] = *(const LAS bf16x8*)(qrow + (h + 1) * 64 * QROW + dq * 32);
                        }
                        f32x16 u;
#pragma unroll
                        for (int r = 0; r < 16; ++r) u[r] = 0.f;
#pragma unroll
                        for (int dq = 0; dq < 4; ++dq) u = __builtin_amdgcn_mfma_f32_32x32x16_bf16(kf[dq], fc[dq], u, 0, 0, 0);
                        __builtin_amdgcn_sched_barrier(0);
                        if (h > 0) {
                            const float sg = (h - 1 < 4) ? sg03[(h - 1) & 3] : sg47[(h - 1) & 3];
#pragma unroll
                            for (int r = 0; r < 16; ++r) acc[r] = fmaf(fabsf(up[r]), sg, acc[r]);
                        }
                        __builtin_amdgcn_sched_barrier(0);
                        up = u;
                    }
                    {
                        const float sg = sg47[3];
#pragma unroll
                        for (int r = 0; r < 16; ++r) acc[r] = fmaf(fabsf(up[r]), sg, acc[r]);
                    }
#pragma unroll
                    for (int g = 0; g < 4; ++g) { u32x2 w; w.x = okey_pk(acc[4 * g], acc[4 * g + 1]); w.y = okey_pk(acc[4 * g + 2], acc[4 * g + 3]);
                        *(LAS u32x2*)(ST + (qs * 32 + l31) * 80 + (8 * g + 4 * hh) * 2) = w; }
                }
#pragma unroll
                for (int i = 0; i < 4; ++i) {
                    const int row = 16 * i + (lane >> 2), ch = lane & 3, tl = q0 + row;
                    const u32x4 v = *(const LAS u32x4*)(ST + row * 80 + ch * 16);
                    if (kt <= (tl >> 5)) *(u32x4*)(SC + sc_row_off(b, tl) + (size_t)kt * 32 + ch * 8) = v;
                }
            }
        }
    }
}
__device__ __forceinline__ void phase_index_select(const Params& P, unsigned char* lds_) {
    const unsigned short* SC = (const unsigned short*)(P.ws + WS_SC); unsigned short* SEL = (unsigned short*)(P.ws + WS_SEL);
    const int tid = threadIdx.x, lane = tid & 63, wave = __builtin_amdgcn_readfirstlane(tid >> 6);
    LAS unsigned* hist = (LAS unsigned*)lds_ + wave * 1280;
    LAS unsigned short* outw = (LAS unsigned short*)(hist + 1024);
    const int gw = blockIdx.x * NWAVE + wave, NGW = gridDim.x * NWAVE;
    for (int t = gw; t < NTOK; t += NGW) {
        const int b = t >> 13, tl = t & (SEQ - 1), n = tl + 1;
        unsigned short* so = SEL + (size_t)t * TOPK;
        if (n <= TOPK) { for (int i = lane; i < n; i += 64) so[i] = (unsigned short)i; continue; }
        const u32x4* row = (const u32x4*)(SC + sc_row_off(b, tl));
        u32x4 d[16];
#pragma unroll
        for (int sg = 0; sg < 16; ++sg) { if (sg * 512 < n) d[sg] = row[sg * 64 + lane]; else d[sg] = (u32x4){0u, 0u, 0u, 0u}; }
#pragma unroll
        for (int i = 0; i < 16; ++i) { hist[i * 64 + lane] = 0u; }
        asm volatile("s_waitcnt lgkmcnt(0)" ::: "memory");
#define KEY_OF(sg, j) ((((j) & 1) ? (d[sg][(j) >> 1] >> 16) : (d[sg][(j) >> 1] & 0xffffu)))
#define IDX_OF(sg, j) ((sg) * 512 + lane * 8 + (j))
        LAS unsigned* myh = hist + (lane & 3) * 256;
#pragma unroll
        for (int sg = 0; sg < 16; ++sg) if (sg * 512 < n) {
#pragma unroll
            for (int j = 0; j < 8; ++j) { const unsigned k = KEY_OF(sg, j); if (IDX_OF(sg, j) < n) atomicAdd((unsigned*)(myh + (k >> 8)), 1u); }
        }
        asm volatile("s_waitcnt lgkmcnt(0)" ::: "memory");
        unsigned b1, need1;
        {
            unsigned c[4];
#pragma unroll
            for (int q = 0; q < 4; ++q) c[q] = hist[4 * lane + q] + hist[256 + 4 * lane + q] + hist[512 + 4 * lane + q] + hist[768 + 4 * lane + q];
            const unsigned mine = c[0] + c[1] + c[2] + c[3];
            unsigned suf = mine;
#pragma unroll
            for (int o = 1; o < 64; o <<= 1) { const unsigned v = __shfl_down(suf, o); if (lane + o < 64) suf += v; }
            const unsigned above = suf - mine;
            int fb = -1; unsigned fneed = 0;
            if (above < (unsigned)TOPK && suf >= (unsigned)TOPK) { unsigned a = above;
#pragma unroll
                for (int q = 3; q >= 0; --q) { if (fb < 0 && a + c[q] >= (unsigned)TOPK) { fb = 4 * lane + q; fneed = (unsigned)TOPK - a; } a += c[q]; } }
            const unsigned long long bal = __ballot(fb >= 0);
            const int src = (int)__builtin_ctzll(bal);
            b1 = (unsigned)__shfl(fb, src); need1 = __shfl(fneed, src);
        }
#pragma unroll
        for (int i = 0; i < 16; ++i) { hist[i * 64 + lane] = 0u; }
        asm volatile("s_waitcnt lgkmcnt(0)" ::: "memory");
#pragma unroll
        for (int sg = 0; sg < 16; ++sg) if (sg * 512 < n) {
#pragma unroll
            for (int j = 0; j < 8; ++j) { const unsigned k = KEY_OF(sg, j); if (IDX_OF(sg, j) < n && (k >> 8) == b1) atomicAdd((unsigned*)(myh + (k & 255u)), 1u); }
        }
        asm volatile("s_waitcnt lgkmcnt(0)" ::: "memory");
        unsigned T, need2;
        {
            unsigned c[4];
#pragma unroll
            for (int q = 0; q < 4; ++q) c[q] = hist[4 * lane + q] + hist[256 + 4 * lane + q] + hist[512 + 4 * lane + q] + hist[768 + 4 * lane + q];
            const unsigned mine = c[0] + c[1] + c[2] + c[3];
            unsigned suf = mine;
#pragma unroll
            for (int o = 1; o < 64; o <<= 1) { const unsigned v = __shfl_down(suf, o); if (lane + o < 64) suf += v; }
            const unsigned above = suf - mine;
            int fb = -1; unsigned fneed = 0;
            if (above < need1 && suf >= need1) { unsigned a = above;
#pragma unroll
                for (int q = 3; q >= 0; --q) { if (fb < 0 && a + c[q] >= need1) { fb = 4 * lane + q; fneed = need1 - a; } a += c[q]; } }
            const unsigned long long bal = __ballot(fb >= 0);
            const int src = (int)__builtin_ctzll(bal);
            T = (b1 << 8) | (unsigned)__shfl(fb, src); need2 = __shfl(fneed, src);
        }
        unsigned base = 0; const unsigned ngt = (unsigned)TOPK - need2; unsigned eqbase = 0;
#pragma unroll
        for (int sg = 0; sg < 16; ++sg) if (sg * 512 < n) {
            unsigned ce = 0;
#pragma unroll
            for (int j = 0; j < 8; ++j) {
                const unsigned k = KEY_OF(sg, j); const bool ok = IDX_OF(sg, j) < n;
                const bool gt = ok && k > T;
                const unsigned long long mk = __ballot(gt);
                if (gt) outw[base + (unsigned)__builtin_amdgcn_mbcnt_hi((unsigned)(mk >> 32), __builtin_amdgcn_mbcnt_lo((unsigned)mk, 0u))] = (unsigned short)IDX_OF(sg, j);
                base += (unsigned)__builtin_popcountll(mk);
                ce += (ok && k == T) ? 1u : 0u;
            }
            if (__any(ce > 0u)) {
                unsigned pre = ce;
#pragma unroll
                for (int o = 1; o < 64; o <<= 1) { const unsigned v = __shfl_up(pre, o); if (lane >= o) pre += v; }
                unsigned r = eqbase + pre - ce;
#pragma unroll
                for (int j = 0; j < 8; ++j) { const unsigned k = KEY_OF(sg, j); if (IDX_OF(sg, j) < n && k == T) { if (r < need2) outw[ngt + r] = (unsigned short)IDX_OF(sg, j); ++r; } }
                eqbase += __shfl(pre, 63);
            }
        }
#undef KEY_OF
#undef IDX_OF
        asm volatile("s_waitcnt lgkmcnt(0)" ::: "memory");
        ((unsigned*)so)[lane] = ((LAS unsigned*)outw)[lane];
        ((unsigned*)so)[64 + lane] = ((LAS unsigned*)outw)[64 + lane];
        asm volatile("s_waitcnt lgkmcnt(0)" ::: "memory");
    }
}


__device__ __forceinline__ void ret_fill_image(LAS unsigned char* img, const unsigned char* src, size_t row_stride_bytes, int wave, int lane) {
#pragma unroll
    for (int e4 = 0; e4 < 4; ++e4) {
        const int e = wave * 4 + e4, row = 4 * e + (lane >> 4), q = (lane & 15) ^ ((row & 7) << 1);
        __builtin_amdgcn_global_load_lds((const unsigned*)(src + (size_t)row * row_stride_bytes + q * 16), (LAS unsigned*)(img + e * 1024), 16, 0, 0);
    }
}
__device__ __forceinline__ pg8::bf16x8 ret_tr_pair(const LAS unsigned char* img, int row0, int chunk2, int lane) {
    const int g = lane >> 4, i = lane & 15, r0 = row0 + 4 * g + (i >> 2), pb = (i & 3) >> 1, half = (i & 1) * 8;
    const int r1 = r0 + 16;
    const v4i16_t lo = __builtin_amdgcn_ds_read_tr16_b64_v4i16((LAS v4i16_t*)(img + r0 * 256 + ((((chunk2) ^ ((r0 & 7) << 1)) | pb) << 4) + half));
    const v4i16_t hi = __builtin_amdgcn_ds_read_tr16_b64_v4i16((LAS v4i16_t*)(img + r1 * 256 + ((((chunk2) ^ ((r1 & 7) << 1)) | pb) << 4) + half));
    return (pg8::bf16x8){lo[0], lo[1], lo[2], lo[3], hi[0], hi[1], hi[2], hi[3]};
}
__device__ __forceinline__ void phase_ret_kv_mfma(const Params& P, unsigned char* lds_) {
    using pg8::bf16x8;
    const unsigned char* Z0 = (const unsigned char*)(P.ws + WS_Z0); float* KV = (float*)(P.ws + WS_KV);
    LAS unsigned char* Kimg = (LAS unsigned char*)lds_; LAS unsigned char* Vimg = Kimg + 32768;
    const int tid = threadIdx.x, lane = tid & 63, wave = __builtin_amdgcn_readfirstlane(tid >> 6), fr = lane & 15, fq = lane >> 4;
    for (int u = blockIdx.x; u < 1024; u += gridDim.x) {
        const int n = u & 63, h = (u >> 6) & 3, b = u >> 8;
        const size_t row0 = (size_t)b * SEQ + n * 128;
        __syncthreads();
        ret_fill_image(Kimg, Z0 + row0 * ZW * 2 + (512 + h * 128) * 2, ZW * 2, wave, lane);
        ret_fill_image(Vimg, Z0 + row0 * ZW * 2 + (1024 + h * 128) * 2, ZW * 2, wave, lane);
        asm volatile("s_waitcnt vmcnt(0)" ::: "memory");
        __syncthreads();
        bf16x8 va[4];
#pragma unroll
        for (int jc = 0; jc < 4; ++jc) va[jc] = ret_tr_pair(Vimg, 32 * jc, 2 * wave, lane);
        const float g127 = exp2f(ret_log2g(h) * 127.0f);
        float* o = KV + (size_t)u * 16384;
#pragma unroll
        for (int dt = 0; dt < 8; ++dt) {
            f32x4 acc = {0.f, 0.f, 0.f, 0.f};
#pragma unroll
            for (int jc = 0; jc < 4; ++jc) acc = __builtin_amdgcn_mfma_f32_16x16x32_bf16(va[jc], ret_tr_pair(Kimg, 32 * jc, 2 * dt, lane), acc, 0, 0, 0);
            *(f32x4*)(o + (size_t)(16 * dt + fr) * 128 + 16 * wave + 4 * fq) = acc * g127;
        }
    }
}
__device__ __forceinline__ void phase_ret_scan_pool2(const Params& P) {
    const float* KV = (const float*)(P.ws + WS_KV); bf16_t* SB = (bf16_t*)(P.ws + WS_SB);
    const size_t gt = (size_t)blockIdx.x * NT + threadIdx.x, GS = (size_t)gridDim.x * NT;
    for (size_t i = gt; i < (size_t)16 * 4096; i += GS) {
        const int s = (int)(i >> 12), e4 = (int)(i & 4095), h = s & 3;
        const float l2 = ret_log2g(h), cd = exp2f(l2 * 128.0f), g1 = exp2f(l2);
        const f32x4* p = (const f32x4*)(KV + (size_t)s * 64 * 16384) + e4;
        u32x2* q = (u32x2*)(SB + (size_t)s * 64 * 16384) + e4;
        f32x4 R = {0.f, 0.f, 0.f, 0.f};
        for (int n0 = 0; n0 < 64; n0 += 8) {
            f32x4 kv[8];
#pragma unroll
            for (int j = 0; j < 8; ++j) kv[j] = p[(size_t)(n0 + j) * 4096];
#pragma unroll
            for (int j = 0; j < 8; ++j) { u32x2 w; w.x = pk2(R.x * g1, R.y * g1); w.y = pk2(R.z * g1, R.w * g1); q[(size_t)(n0 + j) * 4096] = w; R = R * cd + kv[j]; }
        }
    }
    const bf16_t* Z0 = (const bf16_t*)(P.ws + WS_Z0); bf16_t* DP = (bf16_t*)(P.ws + WS_DP);
    for (size_t i = gt; i < (size_t)NTOK * 64; i += GS) {
        const int t = (int)(i >> 6), c8 = (int)(i & 63) * 8, g = c8 >> 7, w = 2 << g, tl = t & (SEQ - 1);
        const int cnt = min(tl + 1, w);
        float sm[8];
#pragma unroll
        for (int j = 0; j < 8; ++j) sm[j] = 0.f;
        float u0[8];
        for (int q = 0; q < cnt; ++q) {
            const u32x4 v = *(const u32x4*)(Z0 + (size_t)(t - q) * ZW + 2048 + c8);
            const float f[8] = {bflo(v.x), bfhi(v.x), bflo(v.y), bfhi(v.y), bflo(v.z), bfhi(v.z), bflo(v.w), bfhi(v.w)};
#pragma unroll
            for (int j = 0; j < 8; ++j) { sm[j] += f[j]; if (q == 0) u0[j] = f[j]; }
        }
        const float inv = 1.0f / (float)cnt;
        u32x4 o; o.x = pk2(sm[0] * inv - u0[0], sm[1] * inv - u0[1]); o.y = pk2(sm[2] * inv - u0[2], sm[3] * inv - u0[3]);
        o.z = pk2(sm[4] * inv - u0[4], sm[5] * inv - u0[5]); o.w = pk2(sm[6] * inv - u0[6], sm[7] * inv - u0[7]);
        *(u32x4*)(DP + (size_t)t * 512 + c8) = o;
    }
}
__device__ __forceinline__ void phase_ret_out_mfma(const Params& P, unsigned char* lds_) {
    using pg8::bf16x8;
    const unsigned char* Z0 = (const unsigned char*)(P.ws + WS_Z0); const unsigned char* SB = (const unsigned char*)(P.ws + WS_SB); bf16_t* MIX = (bf16_t*)(P.ws + WS_MIX);
    const float* gn = P.in[3];
    LAS unsigned char* Kimg = (LAS unsigned char*)lds_; LAS unsigned char* Vimg = Kimg + 32768; LAS unsigned char* Rimg = Kimg + 65536;
    const int tid = threadIdx.x, lane = tid & 63, wave = __builtin_amdgcn_readfirstlane(tid >> 6), fr = lane & 15, fq = lane >> 4;
    for (int u = blockIdx.x; u < 1024; u += gridDim.x) {
        const int n = u & 63, h = (u >> 6) & 3, b = u >> 8;
        const size_t row0 = (size_t)b * SEQ + n * 128;
        __syncthreads();
        ret_fill_image(Kimg, Z0 + row0 * ZW * 2 + (512 + h * 128) * 2, ZW * 2, wave, lane);
        ret_fill_image(Vimg, Z0 + row0 * ZW * 2 + (1024 + h * 128) * 2, ZW * 2, wave, lane);
        ret_fill_image(Rimg, SB + (size_t)u * 32768, 256, wave, lane);
        const bf16_t* qrow = (const bf16_t*)Z0 + (row0 + 16 * wave + fr) * ZW + h * 128;
        bf16x8 qf[4], qr[4];
#pragma unroll
        for (int c = 0; c < 4; ++c) {
            qf[c] = *(const bf16x8*)(qrow + 32 * c + 8 * fq);
            const u32x2 a = *(const u32x2*)(qrow + 32 * c + 4 * fq), bb = *(const u32x2*)(qrow + 32 * c + 16 + 4 * fq);
            u32x4 w; w.x = a.x; w.y = a.y; w.z = bb.x; w.w = bb.y; qr[c] = __builtin_bit_cast(bf16x8, w);
        }
        asm volatile("s_waitcnt vmcnt(0)" ::: "memory");
        __syncthreads();
        f32x4 sT[8];
#pragma unroll
        for (int jt = 0; jt < 8; ++jt) sT[jt] = (f32x4){0.f, 0.f, 0.f, 0.f};
#pragma unroll
        for (int jt = 0; jt < 8; ++jt) if (jt <= wave) {
            const int r = 16 * jt + fr;
#pragma unroll
            for (int c = 0; c < 4; ++c) {
                const bf16x8 a = *(const LAS bf16x8*)(Kimg + r * 256 + ((((4 * c + fq)) ^ ((r & 7) << 1)) << 4));
                sT[jt] = __builtin_amdgcn_mfma_f32_16x16x32_bf16(a, qf[c], sT[jt], 0, 0, 0);
            }
            if (jt == wave) {
                if (4 * fq + 0 > fr) sT[jt].x = 0.f; if (4 * fq + 1 > fr) sT[jt].y = 0.f; if (4 * fq + 2 > fr) sT[jt].z = 0.f; if (4 * fq + 3 > fr) sT[jt].w = 0.f;
            }
        }
        bf16x8 pT[4];
#pragma unroll
        for (int jp = 0; jp < 4; ++jp) { u32x4 w; w.x = pk2(sT[2 * jp].x, sT[2 * jp].y); w.y = pk2(sT[2 * jp].z, sT[2 * jp].w); w.z = pk2(sT[2 * jp + 1].x, sT[2 * jp + 1].y); w.w = pk2(sT[2 * jp + 1].z, sT[2 * jp + 1].w);
            pT[jp] = __builtin_bit_cast(bf16x8, w); }
        f32x4 O[8];
#pragma unroll
        for (int vt = 0; vt < 8; ++vt) {
            f32x4 acc = {0.f, 0.f, 0.f, 0.f};
#pragma unroll
            for (int jp = 0; jp < 4; ++jp) if (2 * jp <= wave) acc = __builtin_amdgcn_mfma_f32_16x16x32_bf16(ret_tr_pair(Vimg, 32 * jp, 2 * vt, lane), pT[jp], acc, 0, 0, 0);
#pragma unroll
            for (int c = 0; c < 4; ++c) acc = __builtin_amdgcn_mfma_f32_16x16x32_bf16(ret_tr_pair(Rimg, 32 * c, 2 * vt, lane), qr[c], acc, 0, 0, 0);
            O[vt] = acc;
        }
        float sm = 0.f;
#pragma unroll
        for (int vt = 0; vt < 8; ++vt) sm += (O[vt].x + O[vt].y) + (O[vt].z + O[vt].w);
        sm += __shfl_xor(sm, 16); sm += __shfl_xor(sm, 32);
        const float mu = sm * (1.0f / 128.0f);
        float sq = 0.f;
#pragma unroll
        for (int vt = 0; vt < 8; ++vt) { const f32x4 dlt = O[vt] - mu; sq += (dlt.x * dlt.x + dlt.y * dlt.y) + (dlt.z * dlt.z + dlt.w * dlt.w); }
        sq += __shfl_xor(sq, 16); sq += __shfl_xor(sq, 32);
        const float rstd = 1.0f / sqrtf(sq * (1.0f / 128.0f) + LN_EPS);
        const bf16_t* grow = (const bf16_t*)Z0 + (row0 + 16 * wave + fr) * ZW + 1536 + h * 128 + 4 * fq;
        bf16_t* orow = MIX + (row0 + 16 * wave + fr) * DM + h * 128 + 4 * fq;
#pragma unroll
        for (int vt = 0; vt < 8; ++vt) {
            const u32x2 gv = *(const u32x2*)(grow + 16 * vt);
            const f32x4 g4 = *(const f32x4*)(gn + h * 128 + 16 * vt + 4 * fq);
            const f32x4 y = (O[vt] - mu) * rstd * g4;
            u32x2 w; w.x = pk2(y.x * silu_f(bflo(gv.x)), y.y * silu_f(bfhi(gv.x))); w.y = pk2(y.z * silu_f(bflo(gv.y)), y.w * silu_f(bfhi(gv.y)));
            *(u32x2*)(orow + 16 * vt) = w;
        }
    }
}

#define XB_TMO      128
#define XB_XCNT(j)  (256  + 64 * (j))
#define XB_XSUB(j)  (1280 + 64 * (j))
#define XB_XGEN(j)  (2304 + 64 * (j))
#define XB_TOP      3328
#define XB_TOPGEN   3392
#define XCD_BAR_WORDS 3456
#define XB_SPIN_CAP (1u << 22)
__device__ __forceinline__ unsigned xb_ld(unsigned* p)              { return __hip_atomic_load(p, __ATOMIC_RELAXED, __HIP_MEMORY_SCOPE_AGENT); }
__device__ __forceinline__ unsigned xb_add(unsigned* p, unsigned v) { return __hip_atomic_fetch_add(p, v, __ATOMIC_RELAXED, __HIP_MEMORY_SCOPE_AGENT); }
__device__ __forceinline__ unsigned xb_xcc_id() { return (unsigned)__builtin_amdgcn_s_getreg((3 << 11) | 20) & 0xFu; }
#define XB_SPIN(cond, bar) do { unsigned _sp = 0; while (cond) { __builtin_amdgcn_s_sleep(1); \
    if ((++_sp & 255u) == 0u) { if (xb_ld(&(bar)[XB_TMO])) break; if (_sp > XB_SPIN_CAP) { atomicAdd(&(bar)[XB_TMO], 1u); break; } } } } while (0)
struct XcdBarrier { unsigned* bar; unsigned x; volatile LAS unsigned* st; };
__device__ __forceinline__ XcdBarrier xcd_barrier_post(unsigned* bar, volatile LAS unsigned* st) {
    XcdBarrier b; b.bar = bar; b.x = xb_xcc_id(); b.st = st;
    if (threadIdx.x == 0) (void)xb_add(&bar[XB_XCNT(b.x)], 1u);
    return b;
}
__device__ __forceinline__ void xcd_barrier_complete(unsigned* bar, unsigned x, unsigned& nloc, unsigned& nx) {
    const unsigned G = gridDim.x * gridDim.y * gridDim.z;
    unsigned sum, cnt, mine, sp = 0u;
    for (;;) {
        sum = 0u; cnt = 0u; mine = 0u;
#pragma unroll
        for (unsigned j = 0; j < 16; ++j) { const unsigned c = xb_ld(&bar[XB_XCNT(j)]); sum += c; cnt += (c > 0u) ? 1u : 0u; mine = (j == x) ? c : mine; }
        if (sum == G) break;
        __builtin_amdgcn_s_sleep(1);
        if ((++sp & 255u) == 0u) { if (xb_ld(&bar[XB_TMO])) break; if (sp > XB_SPIN_CAP) { atomicAdd(&bar[XB_TMO], 1u); break; } }
    }
    nloc = mine > 0u ? mine : 1u; nx = cnt > 0u ? cnt : 1u;
}
__device__ __forceinline__ void xcd_barrier(const XcdBarrier& b) {
    asm volatile("s_waitcnt vmcnt(0)" ::: "memory");
    __syncthreads();
    if (threadIdx.x == 0) {
        unsigned* bar = b.bar;
        __builtin_amdgcn_s_waitcnt(0);
        unsigned nloc = b.st[0], nx = b.st[1];
        if (nloc == 0u) { xcd_barrier_complete(bar, b.x, nloc, nx); b.st[0] = nloc; b.st[1] = nx; }
        const unsigned old = xb_add(&bar[XB_XSUB(b.x)], 1u);
        const unsigned gen = old / nloc;
        if (old + 1u == (gen + 1u) * nloc) {
            __builtin_amdgcn_fence(__ATOMIC_RELEASE, "agent");
            asm volatile("s_waitcnt vmcnt(0)" ::: "memory");
            const unsigned og = xb_add(&bar[XB_TOP], 1u);
            const unsigned tg = og / nx;
            if (og + 1u == (tg + 1u) * nx) xb_add(&bar[XB_TOPGEN], 1u);
            else XB_SPIN(xb_ld(&bar[XB_TOPGEN]) == tg, bar);
            __builtin_amdgcn_fence(__ATOMIC_ACQUIRE, "agent");
            xb_add(&bar[XB_XGEN(b.x)], 1u);
            asm volatile("s_waitcnt vmcnt(0)" ::: "memory");
        } else {
            XB_SPIN(xb_ld(&bar[XB_XGEN(b.x)]) == gen, bar);
            __builtin_amdgcn_fence(__ATOMIC_ACQUIRE, "agent");
            asm volatile("s_waitcnt vmcnt(0)" ::: "memory");
        }
    }
    __syncthreads();
}
constexpr size_t CTL_BAR_OFF = 16384;
constexpr size_t CTL_ZERO_BYTES = 65536;

#ifdef PH_ONLY
#define IN(k) ((k) == PH_ONLY)
#else
#define IN(k) (lo <= (k) && (k) < hi)
#endif
#define SEAM(k) do { if (IN(k) && IN((k) + 1)) xcd_barrier(grid); } while (0)
#ifndef PROBE_DUP
#define PROBE_DUP (-1)
#endif
#define REP(k) for (int _rep = 0; _rep < ((PROBE_DUP == (k)) ? 2 : 1); ++_rep)
#define REPS(k) ((PROBE_DUP == 100 + (k)) ? 2 : 1)

template <int LAYER, int BASE>
__device__ __forceinline__ void layer_tail(const Params& P, unsigned char* lds, const XcdBarrier& grid, int lo, int hi) {
    unsigned char* ws = P.ws;
    int* tb = (int*)(lds + MISC_OFF);
    if (IN(BASE)) { if (PROBE_DUP == BASE) phase_ln_route<true>(P, lds, LAYER); phase_ln_route<false>(P, lds, LAYER); }
    SEAM(BASE);
    if (IN(BASE + 1)) REP(BASE + 1) { moe_setup(P, tb, LAYER);
        MoeSched S{tb, (const int*)(ws + WS_CTL) + LAYER * 64, (const int*)(ws + WS_LIST), (const bf16_t*)(ws + WS_XB),
                   (const bf16_t*)(ws + WS_W_GU) + (size_t)LAYER * 32 * DM * DM, DM, (size_t)DM * DM, true};
        EpiGU E{(bf16_t*)(ws + WS_ACT)}; gemm_moe<true>(lds, S, E); }
    SEAM(BASE + 1);
    if (IN(BASE + 2)) REP(BASE + 2) { moe_setup(P, tb, LAYER);
        MoeSched S{tb, (const int*)(ws + WS_CTL) + LAYER * 64, (const int*)(ws + WS_LIST), (const bf16_t*)(ws + WS_ACT),
                   (const bf16_t*)(ws + WS_W_DN) + (size_t)LAYER * 32 * DM * 512, 512, (size_t)DM * 512, false};
        EpiDown E{(bf16_t*)(ws + WS_YS)}; gemm_moe<false>(lds, S, E); }
    SEAM(BASE + 2);
    if (IN(BASE + 3)) { if (PROBE_DUP == BASE + 3) phase_ln2<true>(P, LAYER); phase_ln2<false>(P, LAYER); }
    SEAM(BASE + 3);
    if (IN(BASE + 4)) REP(BASE + 4) {
        { DenseSched S{(const bf16_t*)(ws + WS_PB) + (size_t)LAYER * NTOK * 256, (const bf16_t*)(ws + WS_W_P) + (size_t)LAYER * DM * 256, NTOK, DM, 256, 256, 0, REPS(BASE + 4)};
          EpiStoreBf16 E{(bf16_t*)(ws + WS_PP), DM, 0, nullptr}; gemm_dense(lds, S, E); }
        __syncthreads();
        { DenseSched S{(const bf16_t*)(ws + WS_XB), (const bf16_t*)(ws + WS_W_G) + (size_t)LAYER * DM * DM, NTOK, DM, DM, DM, 0, REPS(BASE + 4)};
          EpiPle E{(const bf16_t*)(ws + WS_XB), (const bf16_t*)(ws + WS_PP), LAYER == 1 ? P.out : (float*)nullptr, LAYER == 1 ? (bf16_t*)nullptr : (bf16_t*)(ws + WS_XB2)}; gemm_dense(lds, S, E); }
    }
}

__global__ void __launch_bounds__(NT, 2) mega(Params P, int lo, int hi) {
    extern __shared__ __attribute__((aligned(16))) unsigned char lds[];
    unsigned char* ws = P.ws;
    if (threadIdx.x < 16) ((LAS unsigned*)((LAS unsigned char*)lds + BARW_OFF))[threadIdx.x] = 0u;
    __syncthreads();
    const XcdBarrier grid = xcd_barrier_post((unsigned*)(ws + WS_CTL + CTL_BAR_OFF), (volatile LAS unsigned*)((LAS unsigned char*)lds + BARW_OFF));
    if (IN(0)) REP(0) phase_prep(P, lds);
    SEAM(0);
    if (IN(1)) REP(1) { DenseSched S{(const bf16_t*)(ws + WS_XB), (const bf16_t*)(ws + WS_W_IN0), NTOK, ZW, DM, DM, 0, REPS(1)};
        EpiZ0 E{(bf16_t*)(ws + WS_Z0)}; gemm_dense(lds, S, E); }
    SEAM(1);
    if (IN(2)) REP(2) phase_ret_kv_mfma(P, lds);
    SEAM(2);
    if (IN(3)) REP(3) phase_ret_scan_pool2(P);
    SEAM(3);
    if (IN(4)) REP(4) { phase_ret_out_mfma(P, lds); __syncthreads();
        DenseSched S{(const bf16_t*)(ws + WS_DP), (const bf16_t*)(ws + WS_W_POOL), NTOK, 512, 256, 512, 256};
        EpiStoreBf16 E{(bf16_t*)(ws + WS_MIX), DM, 512, P.in[5]}; gemm_dense(lds, S, E); }
    SEAM(4);
    if (IN(5)) REP(5) { DenseSched S{(const bf16_t*)(ws + WS_MIX), (const bf16_t*)(ws + WS_W_OUT0), NTOK, DM, DM, DM, 0, REPS(5)};
        EpiResid E{P.in[0], (float*)(ws + WS_F)}; gemm_dense(lds, S, E); }
    SEAM(5);
    layer_tail<0, 6>(P, lds, grid, lo, hi);
    SEAM(10);
    if (IN(11)) REP(11) { DenseSched S{(const bf16_t*)(ws + WS_XB2), (const bf16_t*)(ws + WS_W_CIN), NTOK, Z1W, DM, DM, 0, REPS(11)};
        EpiStoreBf16 E{(bf16_t*)(ws + WS_Z1), Z1W, 0, nullptr}; gemm_dense(lds, S, E); }
    SEAM(11);
    if (IN(12)) REP(12) { phase_norms(P); phase_index_scores(P, lds); }
    SEAM(12);
    if (IN(13)) REP(13) phase_index_select(P, lds);
    SEAM(13);
    if (IN(14)) REP(14) { DenseSched S{(const bf16_t*)(ws + WS_CQ), (const bf16_t*)(ws + WS_W_QA), NTOK, 4096, 256, 256, 0, REPS(14)};
        EpiStoreF16 E{(unsigned short*)(ws + WS_QA), 4096}; gemm_dense(lds, S, E); }
    SEAM(14);
    if (IN(15)) { if (PROBE_DUP == 15) phase_sparse_attn_e<true>(P, lds); phase_sparse_attn_e<false>(P, lds); }
    SEAM(15);
    if (IN(16)) REP(16) { DenseSched S{(const bf16_t*)(ws + WS_QA), (const bf16_t*)(ws + WS_W_UVBD), NTOK, DM, DM, 4096, 1024, REPS(16)};
        EpiStoreBf16 E{(bf16_t*)(ws + WS_XB), DM, 0, nullptr}; gemm_dense(lds, S, E); }
    SEAM(16);
    if (IN(17)) REP(17) { DenseSched S{(const bf16_t*)(ws + WS_XB), (const bf16_t*)(ws + WS_W_COUT), NTOK, DM, DM, DM, 0, REPS(17)};
        EpiResidB E{(const bf16_t*)(ws + WS_XB2), (float*)(ws + WS_F)}; gemm_dense(lds, S, E); }
    SEAM(17);
    layer_tail<1, 18>(P, lds, grid, lo, hi);
}
#undef IN
#undef SEAM

extern "C" void kernel_launch(void* const* d_in, const int* in_sizes, int n_in, void* d_out, int out_size, void* d_ws, size_t ws_size, hipStream_t stream) {
    static int grid = 0;
    if (grid == 0) {
        if (n_in != 26 || ws_size < WS_END || out_size != NTOK * DM) { fprintf(stderr, "kernel_launch: unexpected problem (n_in %d, ws %zu, out %d)\n", n_in, ws_size, out_size); grid = -1; return; }
        int dev = 0, cus = 0, per_cu = 0;
        (void)hipGetDevice(&dev);
        (void)hipDeviceGetAttribute(&cus, hipDeviceAttributeMultiprocessorCount, dev);
        (void)hipFuncSetAttribute((const void*)mega, hipFuncAttributeMaxDynamicSharedMemorySize, LDS_BYTES);
        (void)hipOccupancyMaxActiveBlocksPerMultiprocessor(&per_cu, (const void*)mega, NT, LDS_BYTES);
        if (per_cu < 1) { fprintf(stderr, "kernel_launch: occupancy query reports %d blocks per CU\n", per_cu); per_cu = 1; }
        (void)hipGetLastError();
        grid = cus;
    }
    if (grid < 0) return;
    (void)hipMemsetAsync((char*)d_ws + WS_CTL, 0, CTL_ZERO_BYTES, stream);
    Params p{};
    for (int i = 0; i < 26; ++i) p.in[i] = (const float*)d_in[i];
    p.out = (float*)d_out; p.ws = (unsigned char*)d_ws;
#if MK_ONE_LAUNCH
    int lo = 0, hi = NPH_TOTAL;
    void* args[] = {&p, &lo, &hi};
    (void)args;
    hipLaunchKernelGGL(mega, dim3(grid), dim3(NT), LDS_BYTES, stream, p, lo, hi);
    hipError_t e = hipPeekAtLastError();
    if (e != hipSuccess) fprintf(stderr, "launch failed: %s (grid %d)\n", hipGetErrorString(e), grid);
#else
    for (int k = 0; k < NPH_TOTAL; ++k) hipLaunchKernelGGL(mega, dim3(grid), dim3(NT), LDS_BYTES, stream, p, k, k + 1);
#endif
}
```

```cpp
#include <hip/hip_runtime.h>
#include <hip/hip_cooperative_groups.h>
#include <cstdio>
#include <cstdint>
namespace cg = cooperative_groups;

#ifndef PROBE_ATT
#define PROBE_ATT 0
#endif
#ifndef PROBE_SEL
#define PROBE_SEL 0
#endif
#ifndef MK_ONE_LAUNCH
#define MK_ONE_LAUNCH 1
#endif

typedef unsigned short bf16_t;
typedef float f32x4 __attribute__((ext_vector_type(4)));
typedef unsigned u32x4 __attribute__((ext_vector_type(4)));
typedef unsigned u32x2 __attribute__((ext_vector_type(2)));

constexpr int NT = 512;
constexpr int NWAVE = NT / 64;
constexpr int NTOK = 32768, DM = 1024, SEQ = 8192, NBATCH = 4;
constexpr int ZW = 2560;
constexpr int Z1W = 1280;
constexpr int CIN = 1096;
constexpr int TOPK = 256;
constexpr float ALPHA = 1.4142135623730951f;
constexpr float LN_EPS = 1e-5f;
constexpr int LDS_BYTES = 163840;
constexpr int BARW_OFF = LDS_BYTES - 64;
constexpr int MISC_OFF = 135168;

constexpr size_t MiB = (size_t)1 << 20;
constexpr size_t WS_CTL = 0;
constexpr size_t WS_W_IN0 = 1 * MiB, WS_W_OUT0 = 6 * MiB, WS_W_POOL = 8 * MiB, WS_W_CIN = 9 * MiB, WS_W_QA = 12 * MiB,
                 WS_W_UVBD = 14 * MiB, WS_W_COUT = 16 * MiB, WS_W_G = 18 * MiB, WS_W_P = 22 * MiB, WS_W_GU = 24 * MiB, WS_W_DN = 152 * MiB;
constexpr size_t WS_XB = 224 * MiB, WS_F = 288 * MiB, WS_PB = 416 * MiB, WS_PP = 448 * MiB, WS_CQ = 512 * MiB, WS_CKV = 528 * MiB,
                 WS_SEL = 544 * MiB, WS_TOKG = 560 * MiB, WS_LIST = 561 * MiB, WS_CKV8 = 566 * MiB;
constexpr size_t WS_M0 = 576 * MiB;
constexpr size_t WS_Z0 = WS_M0, WS_KV = WS_M0 + 160 * MiB, WS_MIX = WS_M0 + 224 * MiB, WS_DP = WS_M0 + 288 * MiB, WS_SB = WS_M0 + 320 * MiB;
constexpr size_t WS_OLAT = WS_M0, WS_QA = WS_M0 + 256 * MiB  , WS_SC = WS_M0, WS_Z1 = WS_M0 + 272 * MiB;
constexpr size_t WS_ACT = WS_M0, WS_YS = WS_M0 + 72 * MiB;
constexpr size_t WS_XB2 = 960 * MiB;
constexpr size_t WS_END = 1024 * MiB;
constexpr int LIST_CAP = 32768;
constexpr size_t WS_GT = WS_CTL + 262144;
constexpr size_t WS_SGB = WS_CTL + 786432;

struct Params {
    const float* in[26];
    float* out;
    unsigned char* ws;
};

__device__ __forceinline__ unsigned f2bf(float f) { unsigned u = __float_as_uint(f); return (u + 0x7fffu + ((u >> 16) & 1u)) >> 16; }
__device__ __forceinline__ float bf2f(unsigned h) { return __uint_as_float(h << 16); }
typedef float f32x2_t __attribute__((ext_vector_type(2))); typedef __bf16 bf16x2_t __attribute__((ext_vector_type(2)));
__device__ __forceinline__ unsigned pk2(float lo, float hi) { f32x2_t v = {lo, hi}; bf16x2_t b = __builtin_convertvector(v, bf16x2_t); return __builtin_bit_cast(unsigned, b); }
__device__ __forceinline__ float bflo(unsigned w) { return __uint_as_float(w << 16); }
__device__ __forceinline__ float bfhi(unsigned w) { return __uint_as_float(w & 0xffff0000u); }
#define WAVE_SUM_DPP(v) ({ float _v = (v); \
    _v += __builtin_bit_cast(float, __builtin_amdgcn_update_dpp(0, __builtin_bit_cast(int, _v), 0xB1, 0xf, 0xf, true));     \
    _v += __builtin_bit_cast(float, __builtin_amdgcn_update_dpp(0, __builtin_bit_cast(int, _v), 0x4E, 0xf, 0xf, true));     \
    _v += __builtin_bit_cast(float, __builtin_amdgcn_update_dpp(0, __builtin_bit_cast(int, _v), 0x141, 0xf, 0xf, true));    \
    _v += __builtin_bit_cast(float, __builtin_amdgcn_update_dpp(0, __builtin_bit_cast(int, _v), 0x140, 0xf, 0xf, true));    \
    _v += __builtin_bit_cast(float, __builtin_amdgcn_update_dpp(0, __builtin_bit_cast(int, _v), 0x142, 0xa, 0xf, false));   \
    _v += __builtin_bit_cast(float, __builtin_amdgcn_update_dpp(0, __builtin_bit_cast(int, _v), 0x143, 0xc, 0xf, false));   \
    __builtin_bit_cast(float, __builtin_amdgcn_readlane(__builtin_bit_cast(int, _v), 63)); })
__device__ __forceinline__ float wave_sum(float v) { return WAVE_SUM_DPP(v); }
#define WAVE_SCAN_DPP(v) ({ unsigned _v = (v); \
    _v += (unsigned)__builtin_amdgcn_update_dpp(0, (int)_v, 0x111, 0xf, 0xf, false); \
    _v += (unsigned)__builtin_amdgcn_update_dpp(0, (int)_v, 0x112, 0xf, 0xf, false); \
    _v += (unsigned)__builtin_amdgcn_update_dpp(0, (int)_v, 0x114, 0xf, 0xf, false); \
    _v += (unsigned)__builtin_amdgcn_update_dpp(0, (int)_v, 0x118, 0xf, 0xf, false); \
    _v += (unsigned)__builtin_amdgcn_update_dpp(0, (int)_v, 0x142, 0xa, 0xf, false); \
    _v += (unsigned)__builtin_amdgcn_update_dpp(0, (int)_v, 0x143, 0xc, 0xf, false); \
    _v; })

__device__ __forceinline__ float wave_max(float v) {
#pragma unroll
    for (int o = 1; o < 64; o <<= 1) v = fmaxf(v, __shfl_xor(v, o));
    return v;
}
__device__ __forceinline__ float silu_f(float a) { return a / (1.0f + __expf(-a)); }
__device__ __forceinline__ float sigmoid_f(float a) { return 1.0f / (1.0f + __expf(-a)); }
#define LDS_FENCE() asm volatile("s_waitcnt lgkmcnt(0)" ::: "memory")

struct UnitInfo {
    const bf16_t* A; int lda;
    const int* rows; int rshift;
    int nvalid;
    const bf16_t* Bt; int ldb;
    int K;
    int orow0;
    int pn;
};
__device__ __forceinline__ const bf16_t* unit_arow(const UnitInfo& u, int r) {
    if (u.rows) { const int idx = (r < u.nvalid) ? (u.rows[r] >> u.rshift) : 0; return u.A + (size_t)idx * u.lda; }
    return u.A + (size_t)r * u.lda;
}

struct DenseSched {
    const bf16_t* A; const bf16_t* Bt; int M, N, K, lda, a_pn_stride; int reps = 1;
    __device__ __forceinline__ bool next(int round, UnitInfo& u) const {
        const int nN = N >> 8, nM = M >> 8, nwg = nN * nM;
        const long L = (long)round * gridDim.x + blockIdx.x; if (L >= (long)nwg * reps) return false;
        int wgid = (int)(L % nwg); { const int q = nwg / 8, r = nwg % 8, xcd = wgid % 8, off = wgid / 8; wgid = (xcd < r ? xcd * (q + 1) : r * (q + 1) + (xcd - r) * q) + off; }
        const int nig = 8 * nN, gid = wgid / nig, fm = gid * 8, gsz = (nM - fm) < 8 ? (nM - fm) : 8;
        const int pm = fm + ((wgid % nig) % gsz), pn = (wgid % nig) / gsz;
        u.A = A + (size_t)pm * 256 * lda + (size_t)pn * a_pn_stride; u.lda = lda; u.rows = nullptr; u.rshift = 0; u.nvalid = 256;
        u.Bt = Bt + (size_t)pn * 256 * K; u.ldb = K; u.K = K; u.orow0 = pm * 256; u.pn = pn;
        return true;
    }
};
struct MoeSched {
    const int* tb; const int* cnt; const int* list;
    const bf16_t* A; const bf16_t* W; int K; size_t wstride; bool gather;
    __device__ __forceinline__ bool next(int round, UnitInfo& u) const {
        const int i = round * gridDim.x + blockIdx.x;
        const int j = i >> 2, pn = i & 3;
        if (j >= tb[32]) return false;
        int e = 0;
        while (tb[e + 1] <= j) ++e;
        const int rb = j - tb[e];
        const int nv = min(256, cnt[e] - rb * 256);
        u.rows = list + (size_t)e * LIST_CAP + rb * 256; u.nvalid = nv; u.orow0 = j * 256; u.pn = pn;
        if (gather) { u.A = A; u.lda = K; u.rshift = 1; }
        else { u.A = A + (size_t)j * 256 * K; u.lda = K; u.rshift = 31;   }
        u.Bt = W + (size_t)e * wstride + (size_t)pn * 256 * K; u.ldb = K; u.K = K;
        return true;
    }
};

template <class Sched, class Epi>
__device__ __forceinline__ void gemm_simple(unsigned char* lds, const Sched& S, const Epi& E, bool contiguousA) {
    float* As = (float*)lds;
    float* Bs = As + 128 * 33;
    const int tid = threadIdx.x, ty = tid >> 3, tx = tid & 7;
    const int lr = tid >> 2, kc = (tid & 3) * 8;
    UnitInfo u;
    for (int round = 0; S.next(round, u); ++round) {
        for (int sm = 0; sm < 2; ++sm) {
            const int ar = sm * 128 + lr;
            const bf16_t* arow = contiguousA ? (u.A + (size_t)ar * u.lda) : unit_arow(u, ar);
            for (int sn = 0; sn < 4; ++sn) {
                float acc[2][8];
#pragma unroll
                for (int a = 0; a < 2; ++a)
#pragma unroll
                    for (int b = 0; b < 8; ++b) acc[a][b] = 0.f;
                const bf16_t* brow = u.Bt + (size_t)(sn * 64 + (tid >> 2)) * u.ldb;
                for (int k0 = 0; k0 < u.K; k0 += 32) {
                    const u32x4 av = *(const u32x4*)(arow + k0 + kc);
                    float* ap = As + lr * 33 + kc;
                    ap[0] = bflo(av.x); ap[1] = bfhi(av.x); ap[2] = bflo(av.y); ap[3] = bfhi(av.y);
                    ap[4] = bflo(av.z); ap[5] = bfhi(av.z); ap[6] = bflo(av.w); ap[7] = bfhi(av.w);
                    if (tid < 256) {
                        const u32x4 bv = *(const u32x4*)(brow + k0 + kc);
                        float* bp = Bs + (tid >> 2) * 33 + kc;
                        bp[0] = bflo(bv.x); bp[1] = bfhi(bv.x); bp[2] = bflo(bv.y); bp[3] = bfhi(bv.y);
                        bp[4] = bflo(bv.z); bp[5] = bfhi(bv.z); bp[6] = bflo(bv.w); bp[7] = bfhi(bv.w);
                    }
                    __syncthreads();
#pragma unroll 8
                    for (int kk = 0; kk < 32; ++kk) {
                        const float a0 = As[(2 * ty) * 33 + kk], a1 = As[(2 * ty + 1) * 33 + kk];
#pragma unroll
                        for (int j = 0; j < 8; ++j) { const float b = Bs[(tx * 8 + j) * 33 + kk]; acc[0][j] += a0 * b; acc[1][j] += a1 * b; }
                    }
                    __syncthreads();
                }
#pragma unroll
                for (int rr = 0; rr < 2; ++rr) {
                    const f32x4 v0 = {acc[rr][0], acc[rr][1], acc[rr][2], acc[rr][3]}, v1 = {acc[rr][4], acc[rr][5], acc[rr][6], acc[rr][7]};
                    E(u, sm * 128 + 2 * ty + rr, sn * 64 + tx * 8, v0, v1);
                }
            }
        }
    }
}


namespace pg8 {
#define LAS __attribute__((address_space(3)))
typedef short bf16x8 __attribute__((ext_vector_type(8)));
constexpr int BK = 64, HALF = 128, HTB = HALF * BK * 2, STAGE_BYTES = 8 * HTB;
__device__ __forceinline__ int lds_byte(int r, int c) { const int st = (r >> 4) * 2 + (c >> 5), rr = r & 15, cc = c & 31, ob = rr * 64 + cc * 2; return st * 1024 + (ob ^ (((ob >> 9) & 1) << 5)); }
__device__ __forceinline__ void stage_rc(int b, int& R, int& C) { const int st = b / 1024, sb = b % 1024, swz = sb ^ (((sb >> 9) & 1) << 5); R = (st >> 1) * 16 + swz / 64; C = (st & 1) * 32 + (swz % 64) / 2; }
__device__ __forceinline__ int perm32(int rho) { const int n = rho >> 4, i = rho & 15; return 8 * (i >> 2) + 4 * n + (i & 3); }

template <bool GATHER, class Sched, class Epi>
__device__ __forceinline__ void gemm_phase(LAS unsigned char* lds, const LAS unsigned* rowtab, const Sched& S, const Epi& E, const int lda, const int ldb, const int K) {
    const int tid = threadIdx.x, wid = __builtin_amdgcn_readfirstlane(tid >> 6), lane = tid & 63, wr = wid >> 2, wc = wid & 3, fr = lane & 15, fq = lane >> 4;
    const int nt = K / BK;
    unsigned voffA[2], voffB[2]; int RA[2]; unsigned CA2[2];
#pragma unroll
    for (int i = 0; i < 2; ++i) { int R, C; stage_rc(tid * 16 + i * 8192, R, C); const int Rb = (R & ~31) + perm32(R & 31);
        voffA[i] = (unsigned)(R * lda + C) * 2u; voffB[i] = (unsigned)(Rb * ldb + C) * 2u; RA[i] = R; CA2[i] = (unsigned)C * 2u; }
    const size_t kstep = (size_t)(BK * 2);
    const size_t hstepA = (size_t)HALF * lda * 2, hstepB = (size_t)HALF * ldb * 2;
    const unsigned ldsw = (unsigned)wid * 1024u;
    const int aoff = lds_byte(wr * 64 + fr, fq * 8), boff = lds_byte(wc * 32 + fr, fq * 8);
    unsigned offA[2][2];
#define PG8_SA(b, h) (((b) * 2 + (h)) * HTB)
#define PG8_SB(b, h) ((4 + (b) * 2 + (h)) * HTB)
#define PG8_STAGE(bufoff, gbase, voff) do { _Pragma("unroll") for (int _i = 0; _i < 2; ++_i) \
        __builtin_amdgcn_global_load_lds((const unsigned*)((const char*)(gbase) + (voff)[_i]), (LAS unsigned*)(lds + (bufoff) + ldsw + _i * 8192), 16, 0, 0); } while (0)
#define PG8_STAGE_A(bufoff, h, gbase) do { if (GATHER) PG8_STAGE(bufoff, gbase, offA[h]); else PG8_STAGE(bufoff, (gbase) + (h) * hstepA, voffA); } while (0)
#define PG8_LOADOFF(round) do { _Pragma("unroll") for (int _h = 0; _h < 2; ++_h) _Pragma("unroll") for (int _i = 0; _i < 2; ++_i) offA[_h][_i] = rowtab[(round) * 256 + _h * 128 + RA[_i]] + CA2[_i]; } while (0)
#define PG8_LDA(dst, b, h) do { _Pragma("unroll") for (int m = 0; m < 4; ++m) _Pragma("unroll") for (int k = 0; k < 2; ++k) dst[m][k] = *(const LAS bf16x8*)(lds + PG8_SA(b, h) + aoff + m * 2048 + k * 1024); } while (0)
#define PG8_LDB(dst, b, h) do { _Pragma("unroll") for (int n = 0; n < 2; ++n) _Pragma("unroll") for (int k = 0; k < 2; ++k) dst[n][k] = *(const LAS bf16x8*)(lds + PG8_SB(b, h) + boff + n * 2048 + k * 1024); } while (0)
#define PG8_MMA(ai, bj, At, Bt) do { __builtin_amdgcn_s_setprio(1); _Pragma("unroll") for (int m = 0; m < 4; ++m) _Pragma("unroll") for (int n = 0; n < 2; ++n) _Pragma("unroll") for (int k = 0; k < 2; ++k) \
        acc[ai][bj][m][n] = __builtin_amdgcn_mfma_f32_16x16x32_bf16(Bt[n][k], At[m][k], acc[ai][bj][m][n], 0, 0, 0); __builtin_amdgcn_s_setprio(0); } while (0)
#define PG8_WAIT_V(n) asm volatile("s_waitcnt vmcnt(" #n ")" ::: "memory")
#define PG8_WAIT_L(n) asm volatile("s_waitcnt lgkmcnt(" #n ")" ::: "memory")
#define PG8_BAR __builtin_amdgcn_s_barrier()
#define PG8_SCHED __builtin_amdgcn_sched_barrier(0)
    UnitInfo cur, nxt; int ui = 0;
    if (!S.next(0, cur)) return;
    f32x4 acc[2][2][4][2];
#pragma unroll
    for (int a = 0; a < 2; ++a)
#pragma unroll
        for (int b = 0; b < 2; ++b)
#pragma unroll
            for (int m = 0; m < 4; ++m)
#pragma unroll
                for (int n = 0; n < 2; ++n) acc[a][b][m][n] = (f32x4){0.f, 0.f, 0.f, 0.f};
    bf16x8 At[4][2], B0[2][2], B1[2][2];
    const char* cA = (const char*)cur.A; const char* cB = (const char*)cur.Bt;
    if (GATHER) { PG8_LOADOFF(0); }
    PG8_STAGE(PG8_SB(0, 0), cB, voffB); PG8_STAGE(PG8_SB(0, 1), cB + hstepB, voffB); PG8_STAGE_A(PG8_SA(0, 0), 0, cA); PG8_STAGE_A(PG8_SA(0, 1), 1, cA);
    if (wr == 1) PG8_BAR;
    PG8_WAIT_V(2); PG8_BAR;
    PG8_STAGE(PG8_SB(1, 0), cB + kstep, voffB); PG8_STAGE_A(PG8_SA(1, 0), 0, cA + kstep); PG8_STAGE(PG8_SB(1, 1), cB + hstepB + kstep, voffB);
    PG8_WAIT_V(6); PG8_BAR;
    for (;;) {
        const bool has_next = S.next(ui + 1, nxt);
        const char* nA = has_next ? (const char*)nxt.A : cA; const char* nB = has_next ? (const char*)nxt.Bt : cB;
        for (int t = 0; t < nt; t += 2) {
            const bool last = (t == nt - 2);
            const char* a1 = cA + (size_t)(t + 1) * kstep;
            const char* a2 = last ? nA : cA + (size_t)(t + 2) * kstep; const char* b2 = last ? nB : cB + (size_t)(t + 2) * kstep;
            const char* a3 = a2 + kstep; const char* b3 = b2 + kstep;
            PG8_LDB(B0, 0, 0); PG8_LDB(B1, 0, 1); PG8_SCHED; PG8_LDA(At, 0, 0); PG8_STAGE_A(PG8_SA(1, 1), 1, a1);
            if (GATHER) { if (last && has_next) { PG8_LOADOFF(ui + 1); } }
            PG8_WAIT_V(8); PG8_WAIT_L(0); PG8_BAR; PG8_MMA(0, 0, At, B0); PG8_MMA(0, 1, At, B1); PG8_BAR; PG8_SCHED;
            PG8_LDA(At, 0, 1); PG8_STAGE(PG8_SB(0, 0), b2, voffB); PG8_STAGE(PG8_SB(0, 1), b2 + hstepB, voffB); PG8_STAGE_A(PG8_SA(0, 0), 0, a2);
            PG8_WAIT_V(8); PG8_WAIT_L(0); PG8_BAR; PG8_MMA(1, 0, At, B0); PG8_MMA(1, 1, At, B1); PG8_BAR; PG8_SCHED;
            PG8_LDB(B0, 1, 0); PG8_LDB(B1, 1, 1); PG8_SCHED; PG8_LDA(At, 1, 0); PG8_STAGE_A(PG8_SA(0, 1), 1, a2);
            PG8_WAIT_V(8); PG8_WAIT_L(0); PG8_BAR; PG8_MMA(0, 0, At, B0); PG8_MMA(0, 1, At, B1); PG8_BAR; PG8_SCHED;
            PG8_LDA(At, 1, 1); PG8_STAGE(PG8_SB(1, 0), b3, voffB); PG8_STAGE(PG8_SB(1, 1), b3 + hstepB, voffB); PG8_STAGE_A(PG8_SA(1, 0), 0, a3);
            PG8_WAIT_V(8); PG8_WAIT_L(0); PG8_BAR; PG8_MMA(1, 0, At, B0); PG8_MMA(1, 1, At, B1); PG8_BAR; PG8_SCHED;
        }
        if (wr == 0) PG8_BAR;
#pragma unroll
        for (int ai = 0; ai < 2; ++ai)
#pragma unroll
            for (int m = 0; m < 4; ++m)
#pragma unroll
                for (int bj = 0; bj < 2; ++bj) E(cur, ai * HALF + wr * 64 + m * 16 + fr, bj * HALF + wc * 32 + 8 * fq, acc[ai][bj][m][0], acc[ai][bj][m][1]);
        if (!has_next) break;
#pragma unroll
        for (int a = 0; a < 2; ++a)
#pragma unroll
            for (int b = 0; b < 2; ++b)
#pragma unroll
                for (int m = 0; m < 4; ++m)
#pragma unroll
                    for (int n = 0; n < 2; ++n) acc[a][b][m][n] = (f32x4){0.f, 0.f, 0.f, 0.f};
        cur = nxt; cA = nA; cB = nB; ++ui;
        if (wr == 1) PG8_BAR;
    }
    PG8_WAIT_V(0);
    PG8_BAR;
#undef PG8_SA
#undef PG8_SB
#undef PG8_STAGE
#undef PG8_STAGE_A
#undef PG8_LOADOFF
#undef PG8_LDA
#undef PG8_LDB
#undef PG8_MMA
#undef PG8_WAIT_V
#undef PG8_WAIT_L
#undef PG8_BAR
#undef PG8_SCHED
}
}

#ifndef USE_PG8_DENSE
#define USE_PG8_DENSE 1
#endif
#ifndef USE_PG8_MOE
#define USE_PG8_MOE 1
#endif
template <class Sched, class Epi>
__device__ __forceinline__ void gemm_dense(unsigned char* lds, const Sched& S, const Epi& E) {
#if USE_PG8_DENSE
    pg8::gemm_phase<false>((LAS unsigned char*)lds, (const LAS unsigned*)nullptr, S, E, S.lda, S.K, S.K);
    __syncthreads();
#else
    gemm_simple(lds, S, E, true);
#endif
}


template <bool GATHER, class Epi>
__device__ __forceinline__ void gemm_moe(unsigned char* lds, const MoeSched& S, const Epi& E) {
#if USE_PG8_MOE
    LAS unsigned* rowtab = (LAS unsigned*)(lds + MISC_OFF + 256);
    if (GATHER) {
        UnitInfo u;
        for (int round = 0; round < 10 && S.next(round, u); ++round)
            if (threadIdx.x < 256) rowtab[round * 256 + threadIdx.x] = ((int)threadIdx.x < u.nvalid) ? (unsigned)(u.rows[threadIdx.x] >> 1) * (unsigned)(S.K * 2) : 0u;
        __syncthreads();
    }
    pg8::gemm_phase<GATHER>((LAS unsigned char*)lds, (const LAS unsigned*)rowtab, S, E, S.K, S.K, S.K);
    __syncthreads();
#else
    gemm_simple(lds, S, E, !GATHER);
#endif
}

__device__ __forceinline__ u32x4 pack8(f32x4 a, f32x4 b) { u32x4 w; w.x = pk2(a.x, a.y); w.y = pk2(a.z, a.w); w.z = pk2(b.x, b.y); w.w = pk2(b.z, b.w); return w; }
struct EpiStoreBf16 {
    bf16_t* O; int ldc; int coff; const float* colscale;
    __device__ __forceinline__ void operator()(const UnitInfo& u, int r, int c, f32x4 v0, f32x4 v1) const {
        const int col = u.pn * 256 + c;
        if (colscale) { const f32x4 s0 = *(const f32x4*)(colscale + col), s1 = *(const f32x4*)(colscale + col + 4); v0 *= s0; v1 *= s1; }
        *(u32x4*)(O + (size_t)(u.orow0 + r) * ldc + coff + col) = pack8(v0, v1);
    }
};

__device__ __forceinline__ float ret_log2g(int h) { return log2f(1.0f - exp2f(-5.0f - (float)h)); }
struct EpiZ0 {
    bf16_t* O;
    __device__ __forceinline__ void operator()(const UnitInfo& u, int r, int c, f32x4 v0, f32x4 v1) const {
        const int col = u.pn * 256 + c, row = u.orow0 + r;
        if (col < 1024) { const float e = ret_log2g((col >> 7) & 3) * (float)(row & 127); const float sc = exp2f(col < 512 ? e : -e); v0 *= sc; v1 *= sc; }
        *(u32x4*)(O + (size_t)row * ZW + col) = pack8(v0, v1);
    }
};

struct EpiStoreF16 {
    unsigned short* O; int ldc;
    __device__ __forceinline__ void operator()(const UnitInfo& u, int r, int c, f32x4 v0, f32x4 v1) const {
        typedef _Float16 h2 __attribute__((ext_vector_type(2)));
        u32x4 w;
        w.x = __builtin_bit_cast(unsigned, (h2){(_Float16)v0.x, (_Float16)v0.y}); w.y = __builtin_bit_cast(unsigned, (h2){(_Float16)v0.z, (_Float16)v0.w});
        w.z = __builtin_bit_cast(unsigned, (h2){(_Float16)v1.x, (_Float16)v1.y}); w.w = __builtin_bit_cast(unsigned, (h2){(_Float16)v1.z, (_Float16)v1.w});
        *(u32x4*)(O + (size_t)(u.orow0 + r) * ldc + u.pn * 256 + c) = w;
    }
};

struct EpiStoreFp8 {
    unsigned char* O; int ldc;
    __device__ __forceinline__ void operator()(const UnitInfo& u, int r, int c, f32x4 v0, f32x4 v1) const {
        int w0 = __builtin_amdgcn_cvt_pk_fp8_f32(v0.x, v0.y, 0, false); w0 = __builtin_amdgcn_cvt_pk_fp8_f32(v0.z, v0.w, w0, true);
        int w1 = __builtin_amdgcn_cvt_pk_fp8_f32(v1.x, v1.y, 0, false); w1 = __builtin_amdgcn_cvt_pk_fp8_f32(v1.z, v1.w, w1, true);
        u32x2 w; w.x = (unsigned)w0; w.y = (unsigned)w1;
        *(u32x2*)(O + (size_t)(u.orow0 + r) * ldc + u.pn * 256 + c) = w;
    }
};
struct EpiResidB {
    const bf16_t* X; bf16_t* Yo;
    __device__ __forceinline__ void operator()(const UnitInfo& u, int r, int c, f32x4 v0, f32x4 v1) const {
        const size_t off = (size_t)(u.orow0 + r) * DM + u.pn * 256 + c;
        const u32x4 xw = *(const u32x4*)(X + off);
        const f32x4 x0 = {bflo(xw.x), bfhi(xw.x), bflo(xw.y), bfhi(xw.y)}, x1 = {bflo(xw.z), bfhi(xw.z), bflo(xw.w), bfhi(xw.w)};
        *(u32x4*)(Yo + off) = pack8(x0 * ALPHA + v0, x1 * ALPHA + v1);
    }
};

struct EpiGU {
    bf16_t* ACT;
    __device__ __forceinline__ void operator()(const UnitInfo& u, int r, int c, f32x4 v0, f32x4 v1) const {
        u32x2 w; w.x = pk2(silu_f(v0.x) * v0.y, silu_f(v0.z) * v0.w); w.y = pk2(silu_f(v1.x) * v1.y, silu_f(v1.z) * v1.w);
        *(u32x2*)(ACT + (size_t)(u.orow0 + r) * 512 + u.pn * 128 + (c >> 1)) = w;
    }
};
struct EpiDown {
    bf16_t* YS;
    __device__ __forceinline__ void operator()(const UnitInfo& u, int r, int c, f32x4 v0, f32x4 v1) const {
        if (r < u.nvalid) { const int pair = u.rows[r]; *(u32x4*)(YS + (size_t)pair * DM + u.pn * 256 + c) = pack8(v0, v1); }
    }
};
struct EpiPle {
    const bf16_t* XI; const bf16_t* PP; float* OUT; bf16_t* XO;
    __device__ __forceinline__ void operator()(const UnitInfo& u, int r, int c, f32x4 v0, f32x4 v1) const {
        const size_t off = (size_t)(u.orow0 + r) * DM + u.pn * 256 + c;
        const u32x4 pw = *(const u32x4*)(PP + off), xw = *(const u32x4*)(XI + off);
        f32x4 f0 = {bflo(xw.x), bfhi(xw.x), bflo(xw.y), bfhi(xw.y)}, f1 = {bflo(xw.z), bfhi(xw.z), bflo(xw.w), bfhi(xw.w)};
        f0.x += sigmoid_f(v0.x) * bflo(pw.x); f0.y += sigmoid_f(v0.y) * bfhi(pw.x); f0.z += sigmoid_f(v0.z) * bflo(pw.y); f0.w += sigmoid_f(v0.w) * bfhi(pw.y);
        f1.x += sigmoid_f(v1.x) * bflo(pw.z); f1.y += sigmoid_f(v1.y) * bfhi(pw.z); f1.z += sigmoid_f(v1.z) * bflo(pw.w); f1.w += sigmoid_f(v1.w) * bfhi(pw.w);
        if (OUT) { *(f32x4*)(OUT + off) = f0; *(f32x4*)(OUT + off + 4) = f1; }
        if (XO) *(u32x4*)(XO + off) = pack8(f0, f1);
    }
};

struct TrDesc { const float* src; bf16_t* dst; int K, N, Nsrc, nbatch, mode, dst_ld; };
struct TrItem { const float* src; bf16_t* dst; int Nsrc, dst_ld, mode, kb, nb; };
__device__ __forceinline__ void tr_load(const TrItem& t, int lane, float (&tmp)[32]) {
    const int k0 = 64 * t.kb, n0 = 32 * t.nb, Ns = t.Nsrc;
    const bool okc = (n0 + (lane & 31)) < Ns;
#pragma unroll
    for (int i = 0; i < 32; ++i) tmp[i] = okc ? __builtin_nontemporal_load(t.src + (size_t)(k0 + 2 * i + (lane >> 5)) * Ns + n0 + (lane & 31)) : 0.f;
}
__device__ __forceinline__ void tr_store(const TrItem& t, float* scr, int lane, const float (&tmp)[32]) {
    const int k0 = 64 * t.kb, n0 = 32 * t.nb;
#pragma unroll
    for (int i = 0; i < 32; ++i) scr[(2 * i + (lane >> 5)) * 33 + (lane & 31)] = tmp[i];
    LDS_FENCE();
    const int c = lane & 7;
#pragma unroll
    for (int j = 0; j < 4; ++j) {
        const int n = (lane >> 3) + 8 * j; const float* sp = scr + (8 * c) * 33 + n;
        const int ng = n0 + n;
        float sc = 1.f; int nd = ng; int coff = 0;
        if (t.mode == 1) { if (ng >= 512 && ng < 1024) sc = 0.08838834764831845f; }
        if (t.mode == 2) { nd = (ng < 512) ? 2 * ng : 2 * (ng - 512) + 1; }
        if (t.mode == 3) { coff = ((ng >> 6) & 3) * 256; }
        u32x4 o; o.x = pk2(sp[0 * 33] * sc, sp[1 * 33] * sc); o.y = pk2(sp[2 * 33] * sc, sp[3 * 33] * sc); o.z = pk2(sp[4 * 33] * sc, sp[5 * 33] * sc); o.w = pk2(sp[6 * 33] * sc, sp[7 * 33] * sc);
        *(u32x4*)(t.dst + (size_t)nd * t.dst_ld + coff + k0 + 8 * c) = o;
    }
    LDS_FENCE();
}
__device__ __forceinline__ int tr_items(const TrDesc& d) { return d.nbatch * (d.K / 64) * (d.N / 32); }
__device__ __forceinline__ void phase_prep(const Params& P, unsigned char* lds) {
    unsigned char* ws = P.ws;
    const int tid = threadIdx.x, lane = tid & 63, wave = tid >> 6;
    const int gw = blockIdx.x * NWAVE + wave, NGW = gridDim.x * NWAVE;
    float* scr = (float*)lds + wave * (64 * 33);
    constexpr int ND = 9;
    TrDesc d[ND];
    d[0] = {P.in[22], (bf16_t*)(ws + WS_W_GU), 1024, 1024, 1024, 64, 2, 1024};
    d[1] = {P.in[23], (bf16_t*)(ws + WS_W_DN), 512, 1024, 1024, 64, 0, 512};
    d[2] = {P.in[2], (bf16_t*)(ws + WS_W_IN0), 1024, 2560, 2560, 1, 1, 1024};
    d[3] = {P.in[6], (bf16_t*)(ws + WS_W_OUT0), 1024, 1024, 1024, 1, 0, 1024};
    d[4] = {P.in[13], (bf16_t*)(ws + WS_W_COUT), 1024, 1024, 1024, 1, 0, 1024};
    d[5] = {P.in[24], (bf16_t*)(ws + WS_W_G), 1024, 1024, 1024, 2, 0, 1024};
    d[6] = {P.in[25], (bf16_t*)(ws + WS_W_P), 256, 1024, 1024, 2, 0, 256};
    d[7] = {P.in[7], (bf16_t*)(ws + WS_W_CIN), 1024, Z1W, CIN, 1, 0, 1024};
    d[8] = {P.in[12], (bf16_t*)(ws + WS_W_UVBD), 256, 1024, 1024, 1, 3, 1024};
    int total = 0;
#pragma unroll
    for (int i = 0; i < ND; ++i) total += tr_items(d[i]);
#define TR_DECODE(it, T) do { int _r = (it); bool _f = false; T = TrItem{nullptr, nullptr, 0, 0, 0, 0, 0}; _Pragma("unroll") for (int _i = 0; _i < ND; ++_i) { const int _n = tr_items(d[_i]); \
            if (!_f && _r < _n) { _f = true; const int _per = (d[_i].K / 64) * (d[_i].N / 32), _b = _r / _per, _q = _r % _per, _nblk = d[_i].N / 32; \
                T.src = d[_i].src + (size_t)_b * d[_i].K * d[_i].Nsrc; T.dst = d[_i].dst + (size_t)_b * d[_i].N * d[_i].dst_ld; T.Nsrc = d[_i].Nsrc; T.dst_ld = d[_i].dst_ld; T.mode = d[_i].mode; T.kb = _q / _nblk; T.nb = _q % _nblk; } \
            if (!_f) _r -= _n; } } while (0)
    {
        float cur[32], nxt[32];
        TrItem tc, tn;
        int it = gw;
        if (it < total) { TR_DECODE(it, tc); tr_load(tc, lane, cur); }
        while (it < total) {
            const int itn = it + NGW;
            if (itn < total) { TR_DECODE(itn, tn); tr_load(tn, lane, nxt); }
            tr_store(tc, scr, lane, cur);
#pragma unroll
            for (int i = 0; i < 32; ++i) cur[i] = nxt[i];
            it = itn; tc = tn;
        }
    }
#undef TR_DECODE
    const size_t gt = (size_t)blockIdx.x * NT + tid, GS = (size_t)gridDim.x * NT;
    {
        bf16_t* o = (bf16_t*)(ws + WS_W_POOL); const float* pw = P.in[4];
        for (size_t i = gt; i < 512 * 256; i += GS) { const int n = (int)(i >> 8), k = (int)(i & 255), g = n >> 7, dd = n & 127, kg = k >> 7, c = k & 127;
            o[i] = (bf16_t)((kg == (g & 1)) ? f2bf(pw[((size_t)g * 128 + c) * 128 + dd]) : 0u); }
    }
    {
        u32x4* o = (u32x4*)(ws + WS_W_UVBD);
        for (size_t i = gt; i < (size_t)1024 * 1024 / 8; i += GS) { const int n = (int)(i >> 7), k = (int)(i & 127) * 8; if (((n >> 6) & 3) != (k >> 8)) o[i] = (u32x4){0u, 0u, 0u, 0u}; }
    }
    {
        bf16_t* o = (bf16_t*)(ws + WS_W_QA); const float* uq = P.in[10]; const float* uk = P.in[11];
        float* Bq = (float*)lds; float* Ak = Bq + 256 * 65;
        for (int item = blockIdx.x; item < 128; item += gridDim.x) {
            const int h = item >> 3, c0 = (item & 7) * 32;
            __syncthreads();
            for (int i = tid; i < 256 * 16; i += NT) { const int r = i >> 4, d4 = (i & 15) * 4; const f32x4 v = *(const f32x4*)(uq + (size_t)r * 1024 + h * 64 + d4);
                float* q = Bq + r * 65 + d4; q[0] = v.x; q[1] = v.y; q[2] = v.z; q[3] = v.w; }
            for (int i = tid; i < 32 * 16; i += NT) { const int c = i >> 4, d4 = (i & 15) * 4; const f32x4 v = *(const f32x4*)(uk + (size_t)(c0 + c) * 1024 + h * 64 + d4);
                float* q = Ak + c * 65 + d4; q[0] = v.x; q[1] = v.y; q[2] = v.z; q[3] = v.w; }
            __syncthreads();
            const int r = tid & 255, cg = tid >> 8;
            float acc[16];
#pragma unroll
            for (int j = 0; j < 16; ++j) acc[j] = 0.f;
            for (int dd = 0; dd < 64; ++dd) { const float bv = Bq[r * 65 + dd];
#pragma unroll
                for (int j = 0; j < 16; ++j) acc[j] += Ak[(cg * 16 + j) * 65 + dd] * bv; }
#pragma unroll
            for (int j = 0; j < 16; ++j) o[(size_t)(h * 256 + c0 + cg * 16 + j) * 256 + r] = (bf16_t)f2bf(acc[j] * 0.125f);
        }
        __syncthreads();
    }
    {
        bf16_t* GT = (bf16_t*)(ws + WS_GT); float* SGB = (float*)(ws + WS_SGB);
        for (size_t i = gt; i < (size_t)2 * 48 * 1024; i += GS) {
            const int l = (int)(i / (48 * 1024)), j = (int)((i / 1024) % 48), c = (int)(i & 1023);
            float w = 0.f;
            if (j < 4) w = P.in[18][(size_t)l * DM * 4 + (size_t)c * 4 + j]; else if (j < 36) w = P.in[20][(size_t)l * DM * 32 + (size_t)c * 32 + (j - 4)];
            const float g = P.in[14][l * DM + c] * w;
            const unsigned hi = f2bf(g); const unsigned lo = f2bf(g - bf2f(hi));
            GT[((size_t)(l * 2 + 0) * 48 + j) * 1024 + c] = (bf16_t)hi; GT[((size_t)(l * 2 + 1) * 48 + j) * 1024 + c] = (bf16_t)lo;
        }
        for (int it = gw; it < 96; it += NGW) {
            const int l = it / 48, j = it % 48; float sg = 0.f, sb = 0.f;
            for (int c = lane; c < 1024; c += 64) {
                float w = 0.f;
                if (j < 4) w = P.in[18][(size_t)l * DM * 4 + (size_t)c * 4 + j]; else if (j < 36) w = P.in[20][(size_t)l * DM * 32 + (size_t)c * 32 + (j - 4)];
                sg += P.in[14][l * DM + c] * w; sb += P.in[15][l * DM + c] * w;
            }
            sg = wave_sum(sg); sb = wave_sum(sb);
            const float bias = (j < 4) ? P.in[19][l * 4 + j] : ((j < 36) ? P.in[21][l * 32 + (j - 4)] : 0.f);
            if (lane == 0) { SGB[(l * 2 + 0) * 48 + j] = sg; SGB[(l * 2 + 1) * 48 + j] = sb + bias; }
        }
    }
    {
        const f32x4* x = (const f32x4*)P.in[0]; u32x4* xb = (u32x4*)(ws + WS_XB);
        const size_t nx = (size_t)NTOK * DM / 8, np = (size_t)2 * NTOK * 256 / 8;
        size_t i = gt;
        for (; i + 3 * GS < nx; i += 4 * GS) { f32x4 a[8];
#pragma unroll
            for (int q = 0; q < 4; ++q) { a[2 * q] = __builtin_nontemporal_load(x + 2 * (i + q * GS)); a[2 * q + 1] = __builtin_nontemporal_load(x + 2 * (i + q * GS) + 1); }
#pragma unroll
            for (int q = 0; q < 4; ++q) xb[i + q * GS] = pack8(a[2 * q], a[2 * q + 1]); }
        for (; i < nx; i += GS) xb[i] = pack8(x[2 * i], x[2 * i + 1]);
        const f32x4* p = (const f32x4*)P.in[1]; u32x4* pb = (u32x4*)(ws + WS_PB);
        i = gt;
        for (; i + 3 * GS < np; i += 4 * GS) { f32x4 a[8];
#pragma unroll
            for (int q = 0; q < 4; ++q) { a[2 * q] = __builtin_nontemporal_load(p + 2 * (i + q * GS)); a[2 * q + 1] = __builtin_nontemporal_load(p + 2 * (i + q * GS) + 1); }
#pragma unroll
            for (int q = 0; q < 4; ++q) pb[i + q * GS] = pack8(a[2 * q], a[2 * q + 1]); }
        for (; i < np; i += GS) pb[i] = pack8(p[2 * i], p[2 * i + 1]);
    }
}

__device__ __forceinline__ float ret_logg(int h) { return log1pf(-exp2f(-5.0f - (float)h)); }

__device__ __forceinline__ void phase_ret_kv(const Params& P, unsigned char* lds) {
    const bf16_t* Z0 = (const bf16_t*)(P.ws + WS_Z0); float* KV = (float*)(P.ws + WS_KV);
    float* Ks = (float*)lds; float* Vs = Ks + 128 * 128;
    const int tid = threadIdx.x;
    for (int u = blockIdx.x; u < 1024; u += gridDim.x) {
        const int n = u & 63, h = (u >> 6) & 3, b = u >> 8;
        const float lg = ret_logg(h);
        const size_t row0 = (size_t)b * SEQ + n * 128;
        for (int i = tid; i < 128 * 16; i += NT) {
            const int r = i >> 4, c8 = (i & 15) * 8;
            const u32x4 kv = *(const u32x4*)(Z0 + (row0 + r) * ZW + 512 + h * 128 + c8);
            const u32x4 vv = *(const u32x4*)(Z0 + (row0 + r) * ZW + 1024 + h * 128 + c8);
            const float dec = __expf(lg * (float)(127 - r));
            float* kp = Ks + r * 128 + c8; float* vp = Vs + r * 128 + c8;
            kp[0] = bflo(kv.x) * dec; kp[1] = bfhi(kv.x) * dec; kp[2] = bflo(kv.y) * dec; kp[3] = bfhi(kv.y) * dec;
            kp[4] = bflo(kv.z) * dec; kp[5] = bfhi(kv.z) * dec; kp[6] = bflo(kv.w) * dec; kp[7] = bfhi(kv.w) * dec;
            vp[0] = bflo(vv.x); vp[1] = bfhi(vv.x); vp[2] = bflo(vv.y); vp[3] = bfhi(vv.y);
            vp[4] = bflo(vv.z); vp[5] = bfhi(vv.z); vp[6] = bflo(vv.w); vp[7] = bfhi(vv.w);
        }
        __syncthreads();
        const int dd = tid >> 2, v0 = (tid & 3) * 32;
        float acc[32];
#pragma unroll
        for (int j = 0; j < 32; ++j) acc[j] = 0.f;
        for (int i = 0; i < 128; ++i) {
            const float kd = Ks[i * 128 + dd];
#pragma unroll
            for (int j = 0; j < 32; j += 4) { const f32x4 vv = *(const f32x4*)(Vs + i * 128 + v0 + j); acc[j] += kd * vv.x; acc[j + 1] += kd * vv.y; acc[j + 2] += kd * vv.z; acc[j + 3] += kd * vv.w; }
        }
        float* o = KV + (size_t)u * 16384 + dd * 128 + v0;
#pragma unroll
        for (int j = 0; j < 32; j += 4) *(f32x4*)(o + j) = (f32x4){acc[j], acc[j + 1], acc[j + 2], acc[j + 3]};
        __syncthreads();
    }
}
__device__ __forceinline__ void phase_ret_scan_pool(const Params& P) {
    float* KV = (float*)(P.ws + WS_KV);
    const size_t gt = (size_t)blockIdx.x * NT + threadIdx.x, GS = (size_t)gridDim.x * NT;
    for (size_t i = gt; i < (size_t)16 * 4096; i += GS) {
        const int s = (int)(i >> 12), e4 = (int)(i & 4095), h = s & 3;
        const float cd = __expf(ret_logg(h) * 128.0f);
        f32x4* p = (f32x4*)(KV + (size_t)s * 64 * 16384) + e4;
        f32x4 R = {0.f, 0.f, 0.f, 0.f};
        for (int n0 = 0; n0 < 64; n0 += 8) {
            f32x4 kv[8];
#pragma unroll
            for (int j = 0; j < 8; ++j) kv[j] = p[(size_t)(n0 + j) * 4096];
#pragma unroll
            for (int j = 0; j < 8; ++j) { p[(size_t)(n0 + j) * 4096] = R; R = R * cd + kv[j]; }
        }
    }
    const bf16_t* Z0 = (const bf16_t*)(P.ws + WS_Z0); bf16_t* DP = (bf16_t*)(P.ws + WS_DP);
    for (size_t i = gt; i < (size_t)NTOK * 64; i += GS) {
        const int t = (int)(i >> 6), c8 = (int)(i & 63) * 8, g = c8 >> 7, w = 2 << g, tl = t & (SEQ - 1);
        const int cnt = min(tl + 1, w);
        float s[8];
#pragma unroll
        for (int j = 0; j < 8; ++j) s[j] = 0.f;
        float u0[8];
        for (int q = 0; q < cnt; ++q) {
            const u32x4 v = *(const u32x4*)(Z0 + (size_t)(t - q) * ZW + 2048 + c8);
            const float f[8] = {bflo(v.x), bfhi(v.x), bflo(v.y), bfhi(v.y), bflo(v.z), bfhi(v.z), bflo(v.w), bfhi(v.w)};
#pragma unroll
            for (int j = 0; j < 8; ++j) { s[j] += f[j]; if (q == 0) u0[j] = f[j]; }
        }
        const float inv = 1.0f / (float)cnt;
        u32x4 o; o.x = pk2(s[0] * inv - u0[0], s[1] * inv - u0[1]); o.y = pk2(s[2] * inv - u0[2], s[3] * inv - u0[3]);
        o.z = pk2(s[4] * inv - u0[4], s[5] * inv - u0[5]); o.w = pk2(s[6] * inv - u0[6], s[7] * inv - u0[7]);
        *(u32x4*)(DP + (size_t)t * 512 + c8) = o;
    }
}
__device__ __forceinline__ void phase_ret_out(const Params& P, unsigned char* lds) {
    const bf16_t* Z0 = (const bf16_t*)(P.ws + WS_Z0); const float* KV = (const float*)(P.ws + WS_KV); bf16_t* MIX = (bf16_t*)(P.ws + WS_MIX);
    const float* gn = P.in[3];
    bf16_t* Qs = (bf16_t*)lds;
    bf16_t* Ksm = Qs + 128 * 136;
    float* Sc = (float*)(lds + 2 * 128 * 136 * 2);
    const int tid = threadIdx.x;
    for (int u = blockIdx.x; u < 1024; u += gridDim.x) {
        const int n = u & 63, h = (u >> 6) & 3, b = u >> 8;
        const float lg = ret_logg(h);
        const size_t row0 = (size_t)b * SEQ + n * 128;
        for (int i = tid; i < 128 * 16; i += NT) {
            const int r = i >> 4, c8 = (i & 15) * 8;
            *(u32x4*)(Qs + r * 136 + c8) = *(const u32x4*)(Z0 + (row0 + r) * ZW + h * 128 + c8);
            *(u32x4*)(Ksm + r * 136 + c8) = *(const u32x4*)(Z0 + (row0 + r) * ZW + 512 + h * 128 + c8);
        }
        __syncthreads();
        for (int e = tid; e < 128 * 128; e += NT) {
            const int i = e >> 7, j = e & 127;
            float s = 0.f;
            if (j <= i) {
                const bf16_t* q = Qs + i * 136; const bf16_t* k = Ksm + j * 136;
                for (int dd = 0; dd < 128; dd += 2) { const unsigned qa = *(const unsigned*)(q + dd), ka = *(const unsigned*)(k + dd); s += bflo(qa) * bflo(ka) + bfhi(qa) * bfhi(ka); }
                s *= __expf(lg * (float)(i - j));
            }
            Sc[e] = s;
        }
        __syncthreads();
        const int i = tid >> 2, v0 = (tid & 3) * 32;
        float acc[32];
#pragma unroll
        for (int j = 0; j < 32; ++j) acc[j] = 0.f;
        for (int j = 0; j <= i; ++j) {
            const float s = Sc[i * 128 + j];
            const bf16_t* vr = Z0 + (row0 + j) * ZW + 1024 + h * 128 + v0;
#pragma unroll
            for (int q = 0; q < 4; ++q) { const u32x4 vv = *(const u32x4*)(vr + q * 8);
                acc[q * 8 + 0] += s * bflo(vv.x); acc[q * 8 + 1] += s * bfhi(vv.x); acc[q * 8 + 2] += s * bflo(vv.y); acc[q * 8 + 3] += s * bfhi(vv.y);
                acc[q * 8 + 4] += s * bflo(vv.z); acc[q * 8 + 5] += s * bfhi(vv.z); acc[q * 8 + 6] += s * bflo(vv.w); acc[q * 8 + 7] += s * bfhi(vv.w); }
        }
        const float qdec = __expf(lg * (float)(i + 1));
        const float* S = KV + (size_t)u * 16384;
        for (int dd = 0; dd < 128; ++dd) {
            const float qd = bf2f(Qs[i * 136 + dd]) * qdec;
            const float* sr = S + dd * 128 + v0;
#pragma unroll
            for (int q = 0; q < 32; q += 4) { const f32x4 sv = *(const f32x4*)(sr + q); acc[q] += qd * sv.x; acc[q + 1] += qd * sv.y; acc[q + 2] += qd * sv.z; acc[q + 3] += qd * sv.w; }
        }
        float sm = 0.f;
#pragma unroll
        for (int j = 0; j < 32; ++j) sm += acc[j];
        sm += __shfl_xor(sm, 1); sm += __shfl_xor(sm, 2);
        const float mu = sm * (1.0f / 128.0f);
        float sq = 0.f;
#pragma unroll
        for (int j = 0; j < 32; ++j) { const float dlt = acc[j] - mu; sq += dlt * dlt; }
        sq += __shfl_xor(sq, 1); sq += __shfl_xor(sq, 2);
        const float rstd = 1.0f / sqrtf(sq * (1.0f / 128.0f) + LN_EPS);
        const bf16_t* gr = Z0 + (row0 + i) * ZW + 1536 + h * 128 + v0;
        bf16_t* orow = MIX + (row0 + i) * DM + h * 128 + v0;
#pragma unroll
        for (int q = 0; q < 4; ++q) {
            const u32x4 gv = *(const u32x4*)(gr + q * 8);
            const float g8[8] = {bflo(gv.x), bfhi(gv.x), bflo(gv.y), bfhi(gv.y), bflo(gv.z), bfhi(gv.z), bflo(gv.w), bfhi(gv.w)};
            float o8[8];
#pragma unroll
            for (int j = 0; j < 8; ++j) o8[j] = (acc[q * 8 + j] - mu) * rstd * gn[h * 128 + v0 + q * 8 + j] * silu_f(g8[j]);
            u32x4 w; w.x = pk2(o8[0], o8[1]); w.y = pk2(o8[2], o8[3]); w.z = pk2(o8[4], o8[5]); w.w = pk2(o8[6], o8[7]);
            *(u32x4*)(orow + q * 8) = w;
        }
        __syncthreads();
    }
}

template <bool DRY>
__device__ __forceinline__ void phase_ln_route(const Params& P, unsigned char* lds, int layer) {
    using pg8::bf16x8;
    const bf16_t* F = (const bf16_t*)(P.ws + WS_F); bf16_t* XB = (bf16_t*)(P.ws + (DRY ? WS_M0 + 128 * MiB : WS_XB));
    float* TOKG = (float*)(P.ws + WS_TOKG); int* LIST = (int*)(P.ws + WS_LIST);
    int* CNT = (int*)(P.ws + WS_CTL) + layer * 64;
    const float* lg = P.in[14] + layer * DM; const float* lb = P.in[15] + layer * DM;
    const bf16_t* GTh = (const bf16_t*)(P.ws + WS_GT) + (size_t)(layer * 2) * 48 * 1024; const bf16_t* GTl = GTh + 48 * 1024;
    const float* SG = (const float*)(P.ws + WS_SGB) + (layer * 2) * 48; const float* BB = SG + 48;
    const int tid = threadIdx.x, lane = tid & 63, wave = tid >> 6, r16 = lane & 15, g = lane >> 4;
    int* dec = (int*)lds;
    int* rank = dec + 256;
    int* lcnt = rank + 256;
    int* lbase = lcnt + 32;
    float* stat = (float*)(lds + 4096) + wave * 32;
    float* LG = (float*)(lds + 8192) + wave * (16 * 48);
    f32x4 g4[4], b4[4];
#pragma unroll
    for (int j = 0; j < 4; ++j) { g4[j] = *(const f32x4*)(lg + 256 * j + 4 * lane); b4[j] = *(const f32x4*)(lb + 256 * j + 4 * lane); }
    for (int rb = blockIdx.x; rb < NTOK / 128; rb += gridDim.x) {
        if (tid < 32) lcnt[tid] = 0;
        __syncthreads();
        const int tbase = rb * 128 + wave * 16;
        f32x4 acc[3];
#pragma unroll
        for (int i = 0; i < 3; ++i) acc[i] = (f32x4){0.f, 0.f, 0.f, 0.f};
        float sm = 0.f, sq = 0.f;
        const bf16_t* yrow = F + (size_t)(tbase + r16) * DM + 8 * g;
        const bf16_t* ghp = GTh + (size_t)r16 * 1024 + 8 * g; const bf16_t* glp = GTl + (size_t)r16 * 1024 + 8 * g;
#pragma unroll 2
        for (int k = 0; k < 32; ++k) {
            const u32x4 yw = *(const u32x4*)(yrow + 32 * k);
            bf16x8 gh[3], gl[3];
#pragma unroll
            for (int i = 0; i < 3; ++i) { gh[i] = *(const bf16x8*)(ghp + (size_t)i * 16 * 1024 + 32 * k); gl[i] = *(const bf16x8*)(glp + (size_t)i * 16 * 1024 + 32 * k); }
            const float y0 = bflo(yw.x), y1 = bfhi(yw.x), y2 = bflo(yw.y), y3 = bfhi(yw.y), y4 = bflo(yw.z), y5 = bfhi(yw.z), y6 = bflo(yw.w), y7 = bfhi(yw.w);
            sm += (y0 + y1) + (y2 + y3) + (y4 + y5) + (y6 + y7);
            sq += (y0 * y0 + y1 * y1) + (y2 * y2 + y3 * y3) + (y4 * y4 + y5 * y5) + (y6 * y6 + y7 * y7);
            const bf16x8 yh = __builtin_bit_cast(bf16x8, yw);
#pragma unroll
            for (int i = 0; i < 3; ++i) {
                acc[i] = __builtin_amdgcn_mfma_f32_16x16x32_bf16(yh, gh[i], acc[i], 0, 0, 0);
                acc[i] = __builtin_amdgcn_mfma_f32_16x16x32_bf16(yh, gl[i], acc[i], 0, 0, 0);
            }
        }
        sm += __shfl_xor(sm, 16); sm += __shfl_xor(sm, 32); sq += __shfl_xor(sq, 16); sq += __shfl_xor(sq, 32);
        const float mean = sm * (1.0f / DM), var = fmaxf(sq * (1.0f / DM) - mean * mean, 0.f), rstd = 1.0f / sqrtf(var + LN_EPS);
        if (g == 0) { stat[r16 * 2] = mean; stat[r16 * 2 + 1] = rstd; }
        LDS_FENCE();
#pragma unroll
        for (int i = 0; i < 3; ++i) { const float sg = SG[16 * i + r16], bb = BB[16 * i + r16];
#pragma unroll
            for (int r = 0; r < 4; ++r) { const float mu = stat[(4 * g + r) * 2], rs = stat[(4 * g + r) * 2 + 1];
                LG[(4 * g + r) * 48 + 16 * i + r16] = rs * (acc[i][r] - mu * sg) + bb; } }
        LDS_FENCE();
        if (lane < 16) {
            const float* lr = LG + lane * 48; const int rl = wave * 16 + lane, t = tbase + lane;
            float gl4[4];
#pragma unroll
            for (int j = 0; j < 4; ++j) gl4[j] = lr[j];
            int grp = 0; float gm = gl4[0];
#pragma unroll
            for (int j = 1; j < 4; ++j) if (gl4[j] > gm) { gm = gl4[j]; grp = j; }
            float gs = 0.f;
#pragma unroll
            for (int j = 0; j < 4; ++j) gs += __expf(gl4[j] - gm);
            const float gwt = 1.0f / gs;
            float el[8];
#pragma unroll
            for (int j = 0; j < 8; ++j) el[j] = lr[4 + grp * 8 + j];
            int i0 = 0; float m0 = el[0];
#pragma unroll
            for (int j = 1; j < 8; ++j) if (el[j] > m0) { m0 = el[j]; i0 = j; }
            int i1 = -1; float m1 = -INFINITY;
#pragma unroll
            for (int j = 0; j < 8; ++j) if (j != i0 && el[j] > m1) { m1 = el[j]; i1 = j; }
            const float ex = __expf(m1 - m0);
            const float p0 = 1.0f / (1.0f + ex), p1 = ex / (1.0f + ex);
            dec[rl * 2] = grp * 8 + i0; dec[rl * 2 + 1] = grp * 8 + i1;
            if (!DRY) { TOKG[(size_t)t * 2] = gwt * p0; TOKG[(size_t)t * 2 + 1] = gwt * p1; }
        }
#pragma unroll 4
        for (int r = 0; r < 16; ++r) {
            const float mu = stat[r * 2], rs = stat[r * 2 + 1];
            const bf16_t* fr = F + (size_t)(tbase + r) * DM + 4 * lane; bf16_t* xo = XB + (size_t)(tbase + r) * DM + 4 * lane;
#pragma unroll
            for (int j = 0; j < 4; ++j) { const u32x2 yw = *(const u32x2*)(fr + 256 * j); const f32x4 y = {bflo(yw.x), bfhi(yw.x), bflo(yw.y), bfhi(yw.y)};
                const f32x4 v = (y - mu) * rs * g4[j] + b4[j];
                u32x2 w; w.x = pk2(v.x, v.y); w.y = pk2(v.z, v.w); *(u32x2*)(xo + 256 * j) = w; }
        }
        __syncthreads();
        if (tid < 256) rank[tid] = atomicAdd(&lcnt[dec[tid]], 1);
        __syncthreads();
        if (tid < 32) lbase[tid] = DRY ? 0 : atomicAdd(&CNT[tid], lcnt[tid]);
        __syncthreads();
        if (!DRY && tid < 256) { const int e = dec[tid]; LIST[(size_t)e * LIST_CAP + lbase[e] + rank[tid]] = (rb * 128 + (tid >> 1)) * 2 + (tid & 1); }
        __syncthreads();
    }
}
__device__ __forceinline__ void moe_setup(const Params& P, int* tb, int layer) {
    const int* CNT = (const int*)(P.ws + WS_CTL) + layer * 64;
    if (threadIdx.x == 0) { int a = 0; for (int e = 0; e < 32; ++e) { tb[e] = a; a += (CNT[e] + 255) >> 8; } tb[32] = a; }
    __syncthreads();
}
template <bool DRY>
__device__ __forceinline__ void phase_ln2(const Params& P, int layer) {
    const bf16_t* XI = (const bf16_t*)(P.ws + WS_XB); bf16_t* XO = (bf16_t*)(P.ws + (DRY ? WS_XB2 : WS_XB));
    const bf16_t* YS = (const bf16_t*)(P.ws + WS_YS); const float* TOKG = (const float*)(P.ws + WS_TOKG);
    const float* lg = P.in[16] + layer * DM; const float* lb = P.in[17] + layer * DM;
    const int lane = threadIdx.x & 63, gw = blockIdx.x * NWAVE + (threadIdx.x >> 6), NGW = gridDim.x * NWAVE;
    f32x4 g4[4], b4[4];
#pragma unroll
    for (int j = 0; j < 4; ++j) { g4[j] = *(const f32x4*)(lg + 256 * j + 4 * lane); b4[j] = *(const f32x4*)(lb + 256 * j + 4 * lane); }
    u32x2 nx[4], na[4], nb[4]; float ng0 = 0.f, ng1 = 0.f;
    if (gw < NTOK) { const int t = gw;
#pragma unroll
        for (int j = 0; j < 4; ++j) { const int c0 = 256 * j + 4 * lane; nx[j] = *(const u32x2*)(XI + (size_t)t * DM + c0); na[j] = *(const u32x2*)(YS + (size_t)(2 * t) * DM + c0); nb[j] = *(const u32x2*)(YS + (size_t)(2 * t + 1) * DM + c0); }
        ng0 = TOKG[(size_t)t * 2]; ng1 = TOKG[(size_t)t * 2 + 1]; }
    for (int t = gw; t < NTOK; t += NGW) {
        const float g0 = ng0, g1 = ng1;
        u32x2 xw[4], aw[4], bw[4];
#pragma unroll
        for (int j = 0; j < 4; ++j) { xw[j] = nx[j]; aw[j] = na[j]; bw[j] = nb[j]; }
        if (t + NGW < NTOK) { const int tn = t + NGW;
#pragma unroll
            for (int j = 0; j < 4; ++j) { const int c0 = 256 * j + 4 * lane; nx[j] = *(const u32x2*)(XI + (size_t)tn * DM + c0); na[j] = *(const u32x2*)(YS + (size_t)(2 * tn) * DM + c0); nb[j] = *(const u32x2*)(YS + (size_t)(2 * tn + 1) * DM + c0); }
            ng0 = TOKG[(size_t)tn * 2]; ng1 = TOKG[(size_t)tn * 2 + 1]; }
        f32x4 v[4]; float s = 0.f;
#pragma unroll
        for (int j = 0; j < 4; ++j) {
            const u32x2 x = xw[j], a = aw[j], b = bw[j];
            v[j].x = bflo(x.x) * ALPHA + g0 * bflo(a.x) + g1 * bflo(b.x); v[j].y = bfhi(x.x) * ALPHA + g0 * bfhi(a.x) + g1 * bfhi(b.x);
            v[j].z = bflo(x.y) * ALPHA + g0 * bflo(a.y) + g1 * bflo(b.y); v[j].w = bfhi(x.y) * ALPHA + g0 * bfhi(a.y) + g1 * bfhi(b.y);
            s += (v[j].x + v[j].y) + (v[j].z + v[j].w); }
        const float mean = wave_sum(s) * (1.0f / DM); float s2 = 0.f;
#pragma unroll
        for (int j = 0; j < 4; ++j) { v[j] = v[j] - mean; s2 += (v[j].x * v[j].x + v[j].y * v[j].y) + (v[j].z * v[j].z + v[j].w * v[j].w); }
        const float rstd = 1.0f / sqrtf(wave_sum(s2) * (1.0f / DM) + LN_EPS);
#pragma unroll
        for (int j = 0; j < 4; ++j) { const int c0 = 256 * j + 4 * lane;
            v[j] = v[j] * rstd * g4[j] + b4[j];
            u32x2 w; w.x = pk2(v[j].x, v[j].y); w.y = pk2(v[j].z, v[j].w); *(u32x2*)(XO + (size_t)t * DM + c0) = w; }
    }
}

__device__ __forceinline__ unsigned f8enc(float y) {
    const unsigned u = __float_as_uint(y), sg = (u >> 24) & 0x80u;
    unsigned a = u & 0x7fffffffu;
    a = max(a, 0x3c000000u); a = min(a, 0x43f00000u);
    a = a + 0x0007ffffu + ((a >> 20) & 1u);
    const unsigned c = min(a >> 20, (135u << 3) | 7u) - (120u << 3);
    return sg | c;
}
__device__ __forceinline__ unsigned e5m2enc(float y) {
    const unsigned hb = (unsigned)__builtin_bit_cast(unsigned short, (_Float16)y);
    return ((hb + 0x7fu + ((hb >> 8) & 1u)) >> 8) & 0xffu;
}
__device__ __forceinline__ unsigned f8dec2(unsigned e) {
    const unsigned t = (e << 4) + 0x3c003c00u;
    return __umul24(e & 0x00800080u, 240u) + t;
}
__device__ __forceinline__ void phase_norms(const Params& P) {
    const bf16_t* Z1 = (const bf16_t*)(P.ws + WS_Z1); bf16_t* CQ = (bf16_t*)(P.ws + WS_CQ); bf16_t* CKV = (bf16_t*)(P.ws + WS_CKV); unsigned char* CKV8 = (unsigned char*)(P.ws + WS_CKV8);
    const float* qn = P.in[8]; const float* kn = P.in[9];
    const int lane = threadIdx.x & 63, gw = blockIdx.x * NWAVE + (threadIdx.x >> 6), NGW = gridDim.x * NWAVE;
    for (int t = gw; t < NTOK; t += NGW) {
        const u32x2 a = *(const u32x2*)(Z1 + (size_t)t * Z1W + 4 * lane), b = *(const u32x2*)(Z1 + (size_t)t * Z1W + 256 + 4 * lane);
        const float q[4] = {bflo(a.x), bfhi(a.x), bflo(a.y), bfhi(a.y)}, k[4] = {bflo(b.x), bfhi(b.x), bflo(b.y), bfhi(b.y)};
        const float sq = wave_sum(q[0] * q[0] + q[1] * q[1] + q[2] * q[2] + q[3] * q[3]), sk = wave_sum(k[0] * k[0] + k[1] * k[1] + k[2] * k[2] + k[3] * k[3]);
        const float rq = 1.0f / sqrtf(sq * (1.0f / 256.0f) + 1e-6f), rk = 1.0f / sqrtf(sk * (1.0f / 256.0f) + 1e-6f);
        const f32x4 gq = *(const f32x4*)(qn + 4 * lane), gk = *(const f32x4*)(kn + 4 * lane);
        u32x2 o; o.x = pk2(q[0] * rq * gq.x, q[1] * rq * gq.y); o.y = pk2(q[2] * rq * gq.z, q[3] * rq * gq.w);
        *(u32x2*)(CQ + (size_t)t * 256 + 4 * lane) = o;
        o.x = pk2(k[0] * rk * gk.x, k[1] * rk * gk.y); o.y = pk2(k[2] * rk * gk.z, k[3] * rk * gk.w);
        *(u32x2*)(CKV + (size_t)t * 256 + 4 * lane) = o;
        *(unsigned*)(CKV8 + (size_t)t * 256 + 4 * lane) = e5m2enc(k[0] * rk * gk.x) | (e5m2enc(k[1] * rk * gk.y) << 8) | (e5m2enc(k[2] * rk * gk.z) << 16) | (e5m2enc(k[3] * rk * gk.w) << 24);
    }
}
__device__ __forceinline__ unsigned fkey(float f) { const unsigned u = __float_as_uint(f); return (u & 0x80000000u) ? ~u : (u | 0x80000000u); }

__device__ __forceinline__ void phase_index(const Params& P, unsigned char* lds) {
    const bf16_t* Z1 = (const bf16_t*)(P.ws + WS_Z1); unsigned short* SEL = (unsigned short*)(P.ws + WS_SEL);
    float* sc = (float*)lds;
    float* qf = sc + 8192;
    float* wf = qf + 512;
    int* hist = (int*)(wf + 8);
    int* misc = hist + 256;
    int* seg = misc + 8;
    const int tid = threadIdx.x;
    for (int t = blockIdx.x; t < NTOK; t += gridDim.x) {
        const int b = t >> 13, tl = t & (SEQ - 1), n = tl + 1;
        unsigned short* so = SEL + (size_t)t * TOPK;
        if (n <= TOPK) { if (tid < n) so[tid] = (unsigned short)tid; continue; }
        qf[tid] = bf2f(Z1[(size_t)t * Z1W + 512 + tid]);
        if (tid < 8) wf[tid] = bf2f(Z1[(size_t)t * Z1W + 1088 + tid]);
        __syncthreads();
        for (int s = tid; s < n; s += NT) {
            const bf16_t* kr = Z1 + ((size_t)b * SEQ + s) * Z1W + 1024;
            float k[64];
#pragma unroll
            for (int q = 0; q < 8; ++q) { const u32x4 v = *(const u32x4*)(kr + q * 8);
                k[q * 8] = bflo(v.x); k[q * 8 + 1] = bfhi(v.x); k[q * 8 + 2] = bflo(v.y); k[q * 8 + 3] = bfhi(v.y);
                k[q * 8 + 4] = bflo(v.z); k[q * 8 + 5] = bfhi(v.z); k[q * 8 + 6] = bflo(v.w); k[q * 8 + 7] = bfhi(v.w); }
            float I = 0.f;
#pragma unroll
            for (int h = 0; h < 8; ++h) { float d = 0.f;
#pragma unroll
                for (int dd = 0; dd < 64; ++dd) d += qf[h * 64 + dd] * k[dd];
                I += wf[h] * fmaxf(d, 0.f); }
            sc[s] = I;
        }
        if (tid == 0) { misc[0] = 0; misc[1] = TOPK; misc[2] = 0; }
        __syncthreads();
        for (int pass = 0; pass < 4; ++pass) {
            const int shift = 24 - 8 * pass;
            if (tid < 256) hist[tid] = 0;
            __syncthreads();
            const unsigned prefix = (unsigned)misc[0]; const int kk = misc[1];
            for (int s = tid; s < n; s += NT) { const unsigned key = fkey(sc[s]);
                if (pass == 0 || (key >> (shift + 8)) == prefix) atomicAdd(&hist[(key >> shift) & 255], 1); }
            __syncthreads();
            if (tid == 0) { int a = 0, bsel = 0; for (int bin = 255; bin >= 0; --bin) { const int c = hist[bin]; if (a + c >= kk) { bsel = bin; break; } a += c; }
                misc[0] = (int)((prefix << 8) | (unsigned)bsel); misc[1] = kk - a; }
            __syncthreads();
        }
        const unsigned T = (unsigned)misc[0]; const int keq = misc[1];
        for (int s = tid; s < n; s += NT) if (fkey(sc[s]) > T) { const int o = atomicAdd(&misc[2], 1); so[o] = (unsigned short)s; }
        const int per = (n + NT - 1) / NT, s0 = tid * per, s1 = min(n, s0 + per);
        int ce = 0;
        for (int s = s0; s < s1; ++s) ce += (fkey(sc[s]) == T) ? 1 : 0;
        seg[tid] = ce;
        __syncthreads();
        if (tid == 0) { int a = 0; for (int i = 0; i < NT; ++i) { const int c = seg[i]; seg[i] = a; a += c; } }
        __syncthreads();
        const int ngt = TOPK - keq;
        int r = seg[tid];
        for (int s = s0; s < s1 && r < keq; ++s) if (fkey(sc[s]) == T) { so[ngt + r] = (unsigned short)s; ++r; }
        __syncthreads();
    }
}
__device__ __forceinline__ void phase_sparse_attn(const Params& P, unsigned char* lds) {
    bf16_t* QA = (bf16_t*)(P.ws + WS_QA); const bf16_t* CKV = (const bf16_t*)(P.ws + WS_CKV); const unsigned short* SEL = (const unsigned short*)(P.ws + WS_SEL);
    float* qa = (float*)lds;
    float* lgt = qa + 4096;
    int* sel = (int*)(lgt + 4096);
    const int tid = threadIdx.x, lane = tid & 63, wave = tid >> 6;
    for (int t = blockIdx.x; t < NTOK; t += gridDim.x) {
        const int b = t >> 13, tl = t & (SEQ - 1), ns = min(tl + 1, TOPK);
        { const u32x4 v = *(const u32x4*)(QA + (size_t)t * 4096 + tid * 8); float* q = qa + tid * 8;
          q[0] = bflo(v.x); q[1] = bfhi(v.x); q[2] = bflo(v.y); q[3] = bfhi(v.y); q[4] = bflo(v.z); q[5] = bfhi(v.z); q[6] = bflo(v.w); q[7] = bfhi(v.w); }
        if (tid < TOPK) sel[tid] = (tid < ns) ? (int)SEL[(size_t)t * TOPK + tid] : 0;
        __syncthreads();
        const int k = tid & 255, hg = tid >> 8;
        {
            float acc[8];
#pragma unroll
            for (int h = 0; h < 8; ++h) acc[h] = 0.f;
            if (k < ns) {
                const bf16_t* cr = CKV + ((size_t)b * SEQ + sel[k]) * 256;
                for (int c8 = 0; c8 < 256; c8 += 8) {
                    const u32x4 v = *(const u32x4*)(cr + c8);
                    const float cv[8] = {bflo(v.x), bfhi(v.x), bflo(v.y), bfhi(v.y), bflo(v.z), bfhi(v.z), bflo(v.w), bfhi(v.w)};
#pragma unroll
                    for (int h = 0; h < 8; ++h) { const float* q = qa + (hg * 8 + h) * 256 + c8;
#pragma unroll
                        for (int j = 0; j < 8; ++j) acc[h] += q[j] * cv[j]; }
                }
            }
#pragma unroll
            for (int h = 0; h < 8; ++h) { const int hh = hg * 8 + h; const float slope = exp2f(-0.5f * (float)(hh + 1));
                lgt[hh * 256 + k] = (k < ns) ? (acc[h] - slope * (float)(tl - sel[k])) : -INFINITY; }
        }
        __syncthreads();
        for (int hh = wave * 2; hh < wave * 2 + 2; ++hh) {
            float* row = lgt + hh * 256;
            float x[4]; float m = -INFINITY;
#pragma unroll
            for (int j = 0; j < 4; ++j) { x[j] = row[lane + 64 * j]; m = fmaxf(m, x[j]); }
            m = wave_max(m); float s = 0.f;
#pragma unroll
            for (int j = 0; j < 4; ++j) { x[j] = __expf(x[j] - m); s += x[j]; }
            s = wave_sum(s); const float inv = 1.0f / s;
#pragma unroll
            for (int j = 0; j < 4; ++j) row[lane + 64 * j] = x[j] * inv;
        }
        __syncthreads();
        {
            const int c = tid & 255;
            float acc[8];
#pragma unroll
            for (int h = 0; h < 8; ++h) acc[h] = 0.f;
            const bf16_t* cb = CKV + (size_t)b * SEQ * 256 + c;
            for (int kk = 0; kk < ns; ++kk) {
                const float cv = bf2f(cb[(size_t)sel[kk] * 256]);
#pragma unroll
                for (int h = 0; h < 8; ++h) acc[h] += lgt[(hg * 8 + h) * 256 + kk] * cv;
            }
#pragma unroll
            for (int h = 0; h < 8; ++h) QA[(size_t)t * 4096 + (hg * 8 + h) * 256 + c] = (bf16_t)f2bf(acc[h]);
        }
        __syncthreads();
    }
}

constexpr int NPH_TOTAL = 23;


typedef short v4i16_t __attribute__((ext_vector_type(4)));
template <bool DRY>
__device__ __forceinline__ void phase_sparse_attn_mfma(const Params& P, unsigned char* lds_) {
    using pg8::bf16x8;
    bf16_t* QA = (bf16_t*)(P.ws + WS_QA); const unsigned char* CKV = (const unsigned char*)(P.ws + WS_CKV); const unsigned short* SEL = (const unsigned short*)(P.ws + WS_SEL);
    const int tid = threadIdx.x, lane = tid & 63, wave = __builtin_amdgcn_readfirstlane(tid >> 6);
    const int fr = lane & 15, fq = lane >> 4;
    LAS unsigned char* cbuf = (LAS unsigned char*)lds_ + wave * 16896;
    LAS unsigned short* selw = (LAS unsigned short*)(cbuf + 16384);
    const int G = gridDim.x, NGW = G * NWAVE;
    int vw;
    if ((G & 7) == 0) vw = (((int)blockIdx.x & 7) * (G >> 3) + ((int)blockIdx.x >> 3)) * NWAVE + wave; else vw = (int)blockIdx.x * NWAVE + wave;
    const float LOG2E = 1.4426950408889634f;
    const float slope2 = exp2f(-0.5f * (float)(fr + 1)) * LOG2E;
    unsigned qoffB[4];
#pragma unroll
    for (int e = 0; e < 4; ++e) { const int key7 = (2 * e + (lane >> 5)) & 7; qoffB[e] = (unsigned)(((lane & 31) ^ (key7 << 1)) << 4); }
    const int rowA = fr;
    const unsigned swzA = (unsigned)((rowA & 7) << 1);
    const int rowT = 4 * fq + (fr >> 2);
    const unsigned swzT = (unsigned)((rowT & 7) << 1), pbT = (unsigned)((fr & 3) >> 1), halfT = (unsigned)(fr & 1) * 8u;
    const int per = NGW >> 2, bq = vw / per, wb = vw % per;
    for (int tl0 = wb; tl0 < SEQ; tl0 += per) {
        const int t = bq * SEQ + tl0;
        const int b = t >> 13, tl = t & (SEQ - 1), ns = min(tl + 1, TOPK), nch = (ns + 31) >> 5;
        {
            const u32x2 w = *(const u32x2*)(SEL + (size_t)t * TOPK + 4 * lane);
            unsigned short i0 = (unsigned short)(w.x & 0xffffu), i1 = (unsigned short)(w.x >> 16), i2 = (unsigned short)(w.y & 0xffffu), i3 = (unsigned short)(w.y >> 16);
            const int k0 = 4 * lane;
            if (k0 >= ns) i0 = 0; if (k0 + 1 >= ns) i1 = 0; if (k0 + 2 >= ns) i2 = 0; if (k0 + 3 >= ns) i3 = 0;
            u32x2 o; o.x = (unsigned)i0 | ((unsigned)i1 << 16); o.y = (unsigned)i2 | ((unsigned)i3 << 16);
            *(LAS u32x2*)(selw + 4 * lane) = o;
        }
        bf16x8 qf[8];
#pragma unroll
        for (int cc = 0; cc < 8; ++cc) qf[cc] = *(const bf16x8*)(QA + (size_t)t * 4096 + fr * 256 + 32 * cc + 8 * fq);
        f32x4 O[16];
#pragma unroll
        for (int ct = 0; ct < 16; ++ct) O[ct] = (f32x4){0.f, 0.f, 0.f, 0.f};
        float m = -INFINITY, l = 0.f;
        const unsigned char* cb = CKV + (size_t)b * SEQ * 512;
        for (int j = 0; j < nch; ++j) {
            asm volatile("s_waitcnt lgkmcnt(0)" ::: "memory");
#pragma unroll
            for (int e = 0; e < 16; ++e) {
                const unsigned idx = selw[32 * j + 2 * e + (lane >> 5)];
                __builtin_amdgcn_global_load_lds((const unsigned*)(cb + (size_t)idx * 512 + qoffB[e & 3]), (LAS unsigned*)(cbuf + e * 1024), 16, 0, 0);
            }
            asm volatile("s_waitcnt vmcnt(0)" ::: "memory");
            f32x4 s0 = {0.f, 0.f, 0.f, 0.f}, s1 = {0.f, 0.f, 0.f, 0.f};
#pragma unroll
            for (int cc = 0; cc < 8; ++cc) {
                const unsigned ch = (((unsigned)(4 * cc + fq)) ^ swzA) << 4;
                const bf16x8 a0 = *(const LAS bf16x8*)(cbuf + rowA * 512 + ch);
                const bf16x8 a1 = *(const LAS bf16x8*)(cbuf + (16 + rowA) * 512 + ch);
                s0 = __builtin_amdgcn_mfma_f32_16x16x32_bf16(a0, qf[cc], s0, 0, 0, 0);
                s1 = __builtin_amdgcn_mfma_f32_16x16x32_bf16(a1, qf[cc], s1, 0, 0, 0);
            }
            const u32x2 k0w = *(const LAS u32x2*)(selw + 32 * j + 4 * fq), k1w = *(const LAS u32x2*)(selw + 32 * j + 16 + 4 * fq);
            const int kb0 = 32 * j + 4 * fq, kb1 = kb0 + 16;
            float lg[8];
            {
                const int i00 = (int)(k0w.x & 0xffffu), i01 = (int)(k0w.x >> 16), i02 = (int)(k0w.y & 0xffffu), i03 = (int)(k0w.y >> 16);
                const int i10 = (int)(k1w.x & 0xffffu), i11 = (int)(k1w.x >> 16), i12 = (int)(k1w.y & 0xffffu), i13 = (int)(k1w.y >> 16);
                lg[0] = (kb0 + 0 < ns) ? s0.x * LOG2E - slope2 * (float)(tl - i00) : -INFINITY;
                lg[1] = (kb0 + 1 < ns) ? s0.y * LOG2E - slope2 * (float)(tl - i01) : -INFINITY;
                lg[2] = (kb0 + 2 < ns) ? s0.z * LOG2E - slope2 * (float)(tl - i02) : -INFINITY;
                lg[3] = (kb0 + 3 < ns) ? s0.w * LOG2E - slope2 * (float)(tl - i03) : -INFINITY;
                lg[4] = (kb1 + 0 < ns) ? s1.x * LOG2E - slope2 * (float)(tl - i10) : -INFINITY;
                lg[5] = (kb1 + 1 < ns) ? s1.y * LOG2E - slope2 * (float)(tl - i11) : -INFINITY;
                lg[6] = (kb1 + 2 < ns) ? s1.z * LOG2E - slope2 * (float)(tl - i12) : -INFINITY;
                lg[7] = (kb1 + 3 < ns) ? s1.w * LOG2E - slope2 * (float)(tl - i13) : -INFINITY;
            }
            float cm = fmaxf(fmaxf(fmaxf(lg[0], lg[1]), fmaxf(lg[2], lg[3])), fmaxf(fmaxf(lg[4], lg[5]), fmaxf(lg[6], lg[7])));
            cm = fmaxf(cm, __shfl_xor(cm, 16)); cm = fmaxf(cm, __shfl_xor(cm, 32));
            const float mn = fmaxf(m, cm);
            if (__any(mn > m)) {
                const float sc = exp2f(m - mn);
                l *= sc;
#pragma unroll
                for (int ct = 0; ct < 16; ++ct) O[ct] *= sc;
                m = mn;
            }
            float p[8]; float ps = 0.f;
#pragma unroll
            for (int i = 0; i < 8; ++i) { p[i] = exp2f(lg[i] - m); ps += p[i]; }
            l += ps;
            u32x4 pw; pw.x = pk2(p[0], p[1]); pw.y = pk2(p[2], p[3]); pw.z = pk2(p[4], p[5]); pw.w = pk2(p[6], p[7]);
            const bf16x8 pk = __builtin_bit_cast(bf16x8, pw);
#pragma unroll
            for (int ct = 0; ct < 16; ++ct) {
                const unsigned ch = ((((unsigned)(2 * ct)) ^ swzT) | pbT) << 4;
                const v4i16_t lo = __builtin_amdgcn_ds_read_tr16_b64_v4i16((LAS v4i16_t*)(cbuf + rowT * 512 + ch + halfT));
                const v4i16_t hi = __builtin_amdgcn_ds_read_tr16_b64_v4i16((LAS v4i16_t*)(cbuf + (16 + rowT) * 512 + ch + halfT));
                const bf16x8 a = {lo[0], lo[1], lo[2], lo[3], hi[0], hi[1], hi[2], hi[3]};
                O[ct] = __builtin_amdgcn_mfma_f32_16x16x32_bf16(a, pk, O[ct], 0, 0, 0);
            }
        }
        l += __shfl_xor(l, 16); l += __shfl_xor(l, 32);
        const float inv = 1.0f / l;
        bf16_t* orow = (DRY ? (bf16_t*)(P.ws + WS_PP) + (size_t)(t & 8191) * 4096 : QA + (size_t)t * 4096) + fr * 256 + 4 * fq;
#pragma unroll
        for (int ct = 0; ct < 16; ++ct) { u32x2 w; w.x = pk2(O[ct].x * inv, O[ct].y * inv); w.y = pk2(O[ct].z * inv, O[ct].w * inv); *(u32x2*)(orow + 16 * ct) = w; }
    }
}


template <bool DRY>
__device__ __forceinline__ void phase_sparse_attn_f8(const Params& P, unsigned char* lds_) {
    using pg8::bf16x8;
    bf16_t* QA = (bf16_t*)(P.ws + WS_QA); const unsigned char* CKV8 = (const unsigned char*)(P.ws + WS_CKV8); const unsigned short* SEL = (const unsigned short*)(P.ws + WS_SEL);
    const int tid = threadIdx.x, lane = tid & 63, wave = __builtin_amdgcn_readfirstlane(tid >> 6);
    const int fr = lane & 15, fq = lane >> 4;
    LAS unsigned char* cbuf = (LAS unsigned char*)lds_ + wave * 16896;
    LAS unsigned short* selw = (LAS unsigned short*)(cbuf + 16384);
    const int G = gridDim.x, NGW = G * NWAVE;
    int vw;
    if ((G & 7) == 0) vw = (((int)blockIdx.x & 7) * (G >> 3) + ((int)blockIdx.x >> 3)) * NWAVE + wave; else vw = (int)blockIdx.x * NWAVE + wave;
    const float LOG2E = 1.4426950408889634f;
    const float slope2 = exp2f(-0.5f * (float)(fr + 1)) * LOG2E;
    const int rowA = fr;
    const unsigned swzA = (unsigned)((rowA & 7) << 1);
    const int rowT = 4 * fq + (fr >> 2);
    const unsigned swzT = (unsigned)((rowT & 7) << 1), pbT = (unsigned)((fr & 3) >> 1), halfT = (unsigned)(fr & 1) * 8u;
    const unsigned swzA16 = (swzA ^ (unsigned)fq) << 4, baseA = (unsigned)rowA * 512u;
    const unsigned swzT16 = swzT << 4, baseT = (unsigned)rowT * 512u + (pbT << 4) + halfT;
    unsigned wofs[2];
#pragma unroll
    for (int e = 0; e < 2; ++e) { const int key7 = (4 * e + fq) & 7; wofs[e] = (unsigned)(fq * 512 + (((2 * fr) ^ (key7 << 1)) << 4)); }
    const int per = NGW >> 2, bq = vw / per, wb = vw % per;
    for (int tl0 = wb; tl0 < SEQ; tl0 += per) {
        const int t = bq * SEQ + tl0;
        const int b = t >> 13, tl = t & (SEQ - 1), ns = min(tl + 1, TOPK), nch = (ns + 31) >> 5;
        {
            const u32x2 w = *(const u32x2*)(SEL + (size_t)t * TOPK + 4 * lane);
            unsigned short i0 = (unsigned short)(w.x & 0xffffu), i1 = (unsigned short)(w.x >> 16), i2 = (unsigned short)(w.y & 0xffffu), i3 = (unsigned short)(w.y >> 16);
            const int k0 = 4 * lane;
            if (k0 >= ns) i0 = 0; if (k0 + 1 >= ns) i1 = 0; if (k0 + 2 >= ns) i2 = 0; if (k0 + 3 >= ns) i3 = 0;
            u32x2 o; o.x = (unsigned)i0 | ((unsigned)i1 << 16); o.y = (unsigned)i2 | ((unsigned)i3 << 16);
            *(LAS u32x2*)(selw + 4 * lane) = o;
        }
        bf16x8 qf[8];
#pragma unroll
        for (int cc = 0; cc < 8; ++cc) qf[cc] = *(const bf16x8*)(QA + (size_t)t * 4096 + fr * 256 + 32 * cc + 8 * fq);
        f32x4 O[16];
#pragma unroll
        for (int ct = 0; ct < 16; ++ct) O[ct] = (f32x4){0.f, 0.f, 0.f, 0.f};
        float m = -INFINITY, l = 0.f;
        const unsigned char* cb = CKV8 + (size_t)b * SEQ * 256 + 16 * fr;
        u32x4 stg[8];
#pragma unroll
        for (int e = 0; e < 8; ++e) { const unsigned idx = selw[4 * e + fq]; stg[e] = *(const u32x4*)(cb + (size_t)idx * 256); }
        for (int j = 0; j < nch; ++j) {
#pragma unroll
            for (int e = 0; e < 8; ++e) {
                const u32x4 w = stg[e];
                u32x4 lo, hi;
                lo.x = f8dec2(__builtin_amdgcn_perm(0u, w.x, 0x0c010c00u)); lo.y = f8dec2(__builtin_amdgcn_perm(0u, w.x, 0x0c030c02u));
                lo.z = f8dec2(__builtin_amdgcn_perm(0u, w.y, 0x0c010c00u)); lo.w = f8dec2(__builtin_amdgcn_perm(0u, w.y, 0x0c030c02u));
                hi.x = f8dec2(__builtin_amdgcn_perm(0u, w.z, 0x0c010c00u)); hi.y = f8dec2(__builtin_amdgcn_perm(0u, w.z, 0x0c030c02u));
                hi.z = f8dec2(__builtin_amdgcn_perm(0u, w.w, 0x0c010c00u)); hi.w = f8dec2(__builtin_amdgcn_perm(0u, w.w, 0x0c030c02u));
                LAS unsigned char* dst = cbuf + (e >> 1) * 4096 + (e & 1) * 2048 + wofs[e & 1];
                *(LAS u32x4*)dst = lo; *(LAS u32x4*)(dst + 16) = hi;
            }
            if (j + 1 < nch) {
#pragma unroll
                for (int e = 0; e < 8; ++e) { const unsigned idx = selw[32 * (j + 1) + 4 * e + fq]; stg[e] = *(const u32x4*)(cb + (size_t)idx * 256); }
            }
            f32x4 s0 = {0.f, 0.f, 0.f, 0.f}, s1 = {0.f, 0.f, 0.f, 0.f};
#pragma unroll
            for (int cc = 0; cc < 8; ++cc) {
                const LAS unsigned char* pa = cbuf + ((swzA16 ^ (unsigned)(cc << 6)) + baseA);
                const bf16x8 a0 = *(const LAS bf16x8*)(pa);
                const bf16x8 a1 = *(const LAS bf16x8*)(pa + 8192);
                s0 = __builtin_amdgcn_mfma_f32_16x16x32_bf16(a0, qf[cc], s0, 0, 0, 0);
                s1 = __builtin_amdgcn_mfma_f32_16x16x32_bf16(a1, qf[cc], s1, 0, 0, 0);
            }
            const u32x2 k0w = *(const LAS u32x2*)(selw + 32 * j + 4 * fq), k1w = *(const LAS u32x2*)(selw + 32 * j + 16 + 4 * fq);
            const int kb0 = 32 * j + 4 * fq, kb1 = kb0 + 16;
            float lg[8];
            {
                const int i00 = (int)(k0w.x & 0xffffu), i01 = (int)(k0w.x >> 16), i02 = (int)(k0w.y & 0xffffu), i03 = (int)(k0w.y >> 16);
                const int i10 = (int)(k1w.x & 0xffffu), i11 = (int)(k1w.x >> 16), i12 = (int)(k1w.y & 0xffffu), i13 = (int)(k1w.y >> 16);
                lg[0] = (kb0 + 0 < ns) ? s0.x * LOG2E - slope2 * (float)(tl - i00) : -INFINITY;
                lg[1] = (kb0 + 1 < ns) ? s0.y * LOG2E - slope2 * (float)(tl - i01) : -INFINITY;
                lg[2] = (kb0 + 2 < ns) ? s0.z * LOG2E - slope2 * (float)(tl - i02) : -INFINITY;
                lg[3] = (kb0 + 3 < ns) ? s0.w * LOG2E - slope2 * (float)(tl - i03) : -INFINITY;
                lg[4] = (kb1 + 0 < ns) ? s1.x * LOG2E - slope2 * (float)(tl - i10) : -INFINITY;
                lg[5] = (kb1 + 1 < ns) ? s1.y * LOG2E - slope2 * (float)(tl - i11) : -INFINITY;
                lg[6] = (kb1 + 2 < ns) ? s1.z * LOG2E - slope2 * (float)(tl - i12) : -INFINITY;
                lg[7] = (kb1 + 3 < ns) ? s1.w * LOG2E - slope2 * (float)(tl - i13) : -INFINITY;
            }
            float cm = fmaxf(fmaxf(fmaxf(lg[0], lg[1]), fmaxf(lg[2], lg[3])), fmaxf(fmaxf(lg[4], lg[5]), fmaxf(lg[6], lg[7])));
            cm = fmaxf(cm, __shfl_xor(cm, 16)); cm = fmaxf(cm, __shfl_xor(cm, 32));
            const float mn = fmaxf(m, cm);
            if (__any(mn > m)) {
                const float sc = __builtin_amdgcn_exp2f(m - mn);
                l *= sc;
#pragma unroll
                for (int ct = 0; ct < 16; ++ct) O[ct] *= sc;
                m = mn;
            }
            float p[8]; float ps = 0.f;
#pragma unroll
            for (int i = 0; i < 8; ++i) { p[i] = __builtin_amdgcn_exp2f(lg[i] - m); ps += p[i]; }
            l += ps;
            u32x4 pw; pw.x = pk2(p[0], p[1]); pw.y = pk2(p[2], p[3]); pw.z = pk2(p[4], p[5]); pw.w = pk2(p[6], p[7]);
            const bf16x8 pk = __builtin_bit_cast(bf16x8, pw);
#pragma unroll
            for (int ct = 0; ct < 16; ++ct) {
                const LAS unsigned char* pt = cbuf + ((swzT16 ^ (unsigned)(ct << 5)) + baseT);
                const v4i16_t lo = __builtin_amdgcn_ds_read_tr16_b64_v4i16((LAS v4i16_t*)(pt));
                const v4i16_t hi = __builtin_amdgcn_ds_read_tr16_b64_v4i16((LAS v4i16_t*)(pt + 8192));
                const bf16x8 a = {lo[0], lo[1], lo[2], lo[3], hi[0], hi[1], hi[2], hi[3]};
                O[ct] = __builtin_amdgcn_mfma_f32_16x16x32_bf16(a, pk, O[ct], 0, 0, 0);
            }
        }
        l += __shfl_xor(l, 16); l += __shfl_xor(l, 32);
        const float inv = 1.0f / l;
        bf16_t* orow = (DRY ? (bf16_t*)(P.ws + WS_PP) + (size_t)(t & 8191) * 4096 : QA + (size_t)t * 4096) + fr * 256 + 4 * fq;
#pragma unroll
        for (int ct = 0; ct < 16; ++ct) { u32x2 w; w.x = pk2(O[ct].x * inv, O[ct].y * inv); w.y = pk2(O[ct].z * inv, O[ct].w * inv); *(u32x2*)(orow + 16 * ct) = w; }
    }
}


__device__ __forceinline__ void glds16(const void* gsrc, unsigned lds_dst) {
    unsigned keep;
    asm volatile("s_mov_b32 %0, m0\n\ts_mov_b32 m0, %2\n\ts_nop 0\n\tglobal_load_lds_dwordx4 %1, off\n\ts_mov_b32 m0, %0" : "=&s"(keep) : "v"(gsrc), "s"(lds_dst) : "memory");
}
typedef _Float16 f16x8 __attribute__((ext_vector_type(8)));
template <bool DRY>
__device__ __forceinline__ void phase_sparse_attn_e(const Params& P, unsigned char* lds_) {
    const unsigned char* QA = (const unsigned char*)(P.ws + WS_QA); bf16_t* OLAT = (bf16_t*)(P.ws + WS_OLAT); const unsigned char* CKV8 = (const unsigned char*)(P.ws + WS_CKV8); const unsigned short* SEL = (const unsigned short*)(P.ws + WS_SEL);
    const int tid = threadIdx.x, lane = tid & 63, wave = __builtin_amdgcn_readfirstlane(tid >> 6);
    const int fr = lane & 15, fq = lane >> 4;
    LAS unsigned char* cbuf = (LAS unsigned char*)lds_ + wave * 16896;
    LAS unsigned short* selw = (LAS unsigned short*)(cbuf + 16384);
    const unsigned cbuf0 = (unsigned)(unsigned long)cbuf;
    const int G = gridDim.x, NGW = G * NWAVE;
    int vw;
    if ((G & 7) == 0) vw = (((int)blockIdx.x & 7) * (G >> 3) + ((int)blockIdx.x >> 3)) * NWAVE + wave; else vw = (int)blockIdx.x * NWAVE + wave;
    const float LOG2E = 1.4426950408889634f;
    const float slope2 = exp2f(-0.5f * (float)(fr + 1)) * LOG2E;
    unsigned qoffB[4];
#pragma unroll
    for (int e = 0; e < 4; ++e) { const int r15 = (4 * e + fq) & 15; qoffB[e] = (unsigned)((fr ^ (((r15 & 7) << 1) | (r15 >> 3))) << 4); }
    const unsigned fA = (unsigned)(((fr & 7) << 1) | (fr >> 3));
    const unsigned SA = (fA & 14u) << 4, baseA = (unsigned)fr * 256u + ((((unsigned)fq >> 1) ^ (fA & 1u)) << 4) + ((unsigned)fq & 1u) * 8u;
    const int rT = 4 * fq + (fr >> 2), pT_ = fr & 3;
    const unsigned fT = (unsigned)(((rT & 7) << 1) | (rT >> 3));
    const unsigned ST = (fT & 14u) << 4, baseT = (unsigned)rT * 256u + ((((unsigned)pT_ >> 1) ^ (fT & 1u)) << 4) + ((unsigned)pT_ & 1u) * 8u;
    const int per = NGW >> 2, bq = vw / per, wb = vw % per;
    for (int tl0 = wb; tl0 < SEQ; tl0 += per) {
        const int t = bq * SEQ + tl0;
        const int b = t >> 13, tl = t & (SEQ - 1), ns = min(tl + 1, TOPK), nch = (ns + 31) >> 5;
        {
            const u32x2 w = *(const u32x2*)(SEL + (size_t)t * TOPK + 4 * lane);
            unsigned short i0 = (unsigned short)(w.x & 0xffffu), i1 = (unsigned short)(w.x >> 16), i2 = (unsigned short)(w.y & 0xffffu), i3 = (unsigned short)(w.y >> 16);
            const int k0 = 4 * lane;
            if (k0 >= ns) i0 = 0; if (k0 + 1 >= ns) i1 = 0; if (k0 + 2 >= ns) i2 = 0; if (k0 + 3 >= ns) i3 = 0;
            u32x2 o; o.x = (unsigned)i0 | ((unsigned)i1 << 16); o.y = (unsigned)i2 | ((unsigned)i3 << 16);
            asm volatile("s_waitcnt lgkmcnt(0)" ::: "memory");
            *(LAS u32x2*)(selw + 4 * lane) = o;
        }
        long qf[8];
#pragma unroll
        for (int cc = 0; cc < 8; ++cc) qf[cc] = *(const long*)(QA + (size_t)t * 4096 + fr * 256 + 32 * cc + 8 * fq);
        f32x4 Oe[8], Oo[8];
#pragma unroll
        for (int ut = 0; ut < 8; ++ut) { Oe[ut] = (f32x4){0.f, 0.f, 0.f, 0.f}; Oo[ut] = (f32x4){0.f, 0.f, 0.f, 0.f}; }
        float m = -INFINITY, l = 0.f;
        const unsigned char* cb = CKV8 + (size_t)b * SEQ * 256;
        asm volatile("s_waitcnt vmcnt(0) lgkmcnt(0)" ::: "memory");
#define ATT_DMA(jj, bufoff) do { unsigned idx_[8]; \
            _Pragma("unroll") for (int e = 0; e < 8; ++e) idx_[e] = (DRY && PROBE_ATT == 1) ? (unsigned)((32 * (jj) + 4 * e + fq + 64 * wave) & 8191) : (unsigned)selw[32 * (jj) + 4 * e + fq]; \
            _Pragma("unroll") for (int e = 0; e < 8; ++e) { \
            if (!(DRY && PROBE_ATT == 3)) glds16(cb + (size_t)idx_[e] * 256 + qoffB[e & 3], (unsigned)__builtin_amdgcn_readfirstlane((int)(cbuf0 + (bufoff) + e * 1024))); } } while (0)
        ATT_DMA(0, 0);
        if (nch > 1) ATT_DMA(1, 8192);
        for (int j = 0; j < nch; ++j) {
            const unsigned bo = (unsigned)(j & 1) * 8192u;
            if (j + 1 < nch) asm volatile("s_waitcnt vmcnt(8)" ::: "memory"); else asm volatile("s_waitcnt vmcnt(0)" ::: "memory");
            const LAS unsigned char* img = cbuf + bo;
            if (DRY && PROBE_ATT == 2) { if (j + 2 < nch) { asm volatile("s_waitcnt lgkmcnt(0)" ::: "memory"); ATT_DMA(j + 2, bo); } continue; }
            u32x2 ra[8], rb[8];
#pragma unroll
            for (int cc = 0; cc < 8; ++cc) { const LAS unsigned char* pa = img + ((SA ^ (unsigned)(cc << 5)) + baseA); ra[cc] = *(const LAS u32x2*)(pa); rb[cc] = *(const LAS u32x2*)(pa + 4096); }
            const u32x2 k0w = *(const LAS u32x2*)(selw + 32 * j + 4 * fq), k1w = *(const LAS u32x2*)(selw + 32 * j + 16 + 4 * fq);
            __builtin_amdgcn_sched_barrier(0);
            f32x4 s0 = {0.f, 0.f, 0.f, 0.f}, s1 = {0.f, 0.f, 0.f, 0.f};
#pragma unroll
            for (int cc = 0; cc < 8; ++cc) {
                s0 = __builtin_amdgcn_mfma_f32_16x16x32_bf8_fp8(__builtin_bit_cast(long, ra[cc]), qf[cc], s0, 0, 0, 0);
                s1 = __builtin_amdgcn_mfma_f32_16x16x32_bf8_fp8(__builtin_bit_cast(long, rb[cc]), qf[cc], s1, 0, 0, 0);
            }
            __builtin_amdgcn_sched_barrier(0);
            u32x2 tl_[8], th_[8];
#pragma unroll
            for (int ut = 0; ut < 8; ++ut) { const LAS unsigned char* pt = img + ((ST ^ (unsigned)(ut << 5)) + baseT);
                tl_[ut] = __builtin_bit_cast(u32x2, __builtin_amdgcn_ds_read_tr16_b64_v4i16((LAS v4i16_t*)(pt)));
                th_[ut] = __builtin_bit_cast(u32x2, __builtin_amdgcn_ds_read_tr16_b64_v4i16((LAS v4i16_t*)(pt + 4096))); }
            __builtin_amdgcn_sched_barrier(0);
            const int kb0 = 32 * j + 4 * fq, kb1 = kb0 + 16;
            float lg[8];
            {
                const int i00 = (int)(k0w.x & 0xffffu), i01 = (int)(k0w.x >> 16), i02 = (int)(k0w.y & 0xffffu), i03 = (int)(k0w.y >> 16);
                const int i10 = (int)(k1w.x & 0xffffu), i11 = (int)(k1w.x >> 16), i12 = (int)(k1w.y & 0xffffu), i13 = (int)(k1w.y >> 16);
                lg[0] = (kb0 + 0 < ns) ? s0.x * LOG2E - slope2 * (float)(tl - i00) : -INFINITY;
                lg[1] = (kb0 + 1 < ns) ? s0.y * LOG2E - slope2 * (float)(tl - i01) : -INFINITY;
                lg[2] = (kb0 + 2 < ns) ? s0.z * LOG2E - slope2 * (float)(tl - i02) : -INFINITY;
                lg[3] = (kb0 + 3 < ns) ? s0.w * LOG2E - slope2 * (float)(tl - i03) : -INFINITY;
                lg[4] = (kb1 + 0 < ns) ? s1.x * LOG2E - slope2 * (float)(tl - i10) : -INFINITY;
                lg[5] = (kb1 + 1 < ns) ? s1.y * LOG2E - slope2 * (float)(tl - i11) : -INFINITY;
                lg[6] = (kb1 + 2 < ns) ? s1.z * LOG2E - slope2 * (float)(tl - i12) : -INFINITY;
                lg[7] = (kb1 + 3 < ns) ? s1.w * LOG2E - slope2 * (float)(tl - i13) : -INFINITY;
            }
            const float cm = fmaxf(fmaxf(fmaxf(lg[0], lg[1]), fmaxf(lg[2], lg[3])), fmaxf(fmaxf(lg[4], lg[5]), fmaxf(lg[6], lg[7])));
            if (__any(cm > m + 8.0f)) {
                float cx = fmaxf(cm, __shfl_xor(cm, 16)); cx = fmaxf(cx, __shfl_xor(cx, 32));
                const float mn = fmaxf(m, cx);
                const float sc = __builtin_amdgcn_exp2f(m - mn);
                l *= sc;
#pragma unroll
                for (int ut = 0; ut < 8; ++ut) { Oe[ut] *= sc; Oo[ut] *= sc; }
                m = mn;
            }
            float p[8]; float ps = 0.f;
#pragma unroll
            for (int i = 0; i < 8; ++i) { p[i] = __builtin_amdgcn_exp2f(lg[i] - m); ps += p[i]; }
            l += ps;
            int pw0 = __builtin_amdgcn_cvt_pk_fp8_f32(p[0], p[1], 0, false); pw0 = __builtin_amdgcn_cvt_pk_fp8_f32(p[2], p[3], pw0, true);
            int pw1 = __builtin_amdgcn_cvt_pk_fp8_f32(p[4], p[5], 0, false); pw1 = __builtin_amdgcn_cvt_pk_fp8_f32(p[6], p[7], pw1, true);
            const long pk = __builtin_bit_cast(long, (u32x2){(unsigned)pw0, (unsigned)pw1});
#pragma unroll
            for (int ut = 0; ut < 8; ++ut) {
                const u32x2 lw = tl_[ut], hw = th_[ut];
                u32x2 ae, ao;
                ae.x = __builtin_amdgcn_perm(lw.y, lw.x, 0x06040200u); ae.y = __builtin_amdgcn_perm(hw.y, hw.x, 0x06040200u);
                ao.x = __builtin_amdgcn_perm(lw.y, lw.x, 0x07050301u); ao.y = __builtin_amdgcn_perm(hw.y, hw.x, 0x07050301u);
                Oe[ut] = __builtin_amdgcn_mfma_f32_16x16x32_bf8_fp8(__builtin_bit_cast(long, ae), pk, Oe[ut], 0, 0, 0);
                Oo[ut] = __builtin_amdgcn_mfma_f32_16x16x32_bf8_fp8(__builtin_bit_cast(long, ao), pk, Oo[ut], 0, 0, 0);
            }
            if (j + 2 < nch) { asm volatile("s_waitcnt lgkmcnt(0)" ::: "memory"); ATT_DMA(j + 2, bo); }
        }
#undef ATT_DMA
        l += __shfl_xor(l, 16); l += __shfl_xor(l, 32);
        const float inv = 1.0f / l;
        bf16_t* orow = (DRY ? (bf16_t*)(P.ws + WS_PP) + (size_t)(t & 8191) * 4096 : OLAT + (size_t)t * 4096) + fr * 256 + 8 * fq;
#pragma unroll
        for (int ut = 0; ut < 8; ++ut) {
            u32x4 w; w.x = pk2(Oe[ut].x * inv, Oo[ut].x * inv); w.y = pk2(Oe[ut].y * inv, Oo[ut].y * inv); w.z = pk2(Oe[ut].z * inv, Oo[ut].z * inv); w.w = pk2(Oe[ut].w * inv, Oo[ut].w * inv);
            *(u32x4*)(orow + 32 * ut) = w;
        }
    }
}

constexpr size_t SC_BATCH = (size_t)1024 * 256 * 257 / 2;
__device__ __forceinline__ size_t sc_row_off(int b, int tl) { const size_t m = (size_t)(tl >> 5); return (size_t)b * SC_BATCH + 1024 * (m * (m + 1) / 2) + (size_t)(tl & 31) * 32 * (m + 1); }
typedef float f32x16 __attribute__((ext_vector_type(16)));
__device__ __forceinline__ unsigned okey_pk(float a, float b) {
    const unsigned w = __builtin_bit_cast(unsigned, __builtin_amdgcn_cvt_pkrtz(a, b));
    const unsigned neg = (w >> 15) & 0x00010001u;
    return w ^ ((neg * 0xffffu) | 0x80008000u);
}
__device__ __forceinline__ void phase_index_scores(const Params& P, unsigned char* lds_) {
    using pg8::bf16x8;
    const bf16_t* Z1 = (const bf16_t*)(P.ws + WS_Z1); unsigned short* SC = (unsigned short*)(P.ws + WS_SC);
    LAS unsigned char* lds = (LAS unsigned char*)lds_;
    constexpr int QROW = 144;
    LAS unsigned char* QL = lds;
    LAS float* SG = (LAS float*)(lds + 9 * 64 * QROW);
    const int tid = threadIdx.x, lane = tid & 63, wave = __builtin_amdgcn_readfirstlane(tid >> 6);
    LAS unsigned char* ST = lds + 9 * 64 * QROW + 2048 + wave * 5120;
    const int l31 = lane & 31, hh = lane >> 5;
    for (int pid = blockIdx.x; pid < 256; pid += gridDim.x) {
        const int b = pid >> 6;
        for (int side = 0; side < 2; ++side) {
            const int qb = side ? (127 - (pid & 63)) : (pid & 63);
            const int q0 = qb * 64;
            __syncthreads();
            {
                const int qi = tid >> 3, part = tid & 7;
                const bf16_t* zr = Z1 + ((size_t)b * SEQ + q0 + qi) * Z1W;
                const u32x4 ww = *(const u32x4*)(zr + 1088);
                const float w8[8] = {bflo(ww.x), bfhi(ww.x), bflo(ww.y), bfhi(ww.y), bflo(ww.z), bfhi(ww.z), bflo(ww.w), bfhi(ww.w)};
                float wh = 0.f;
#pragma unroll
                for (int h = 0; h < 8; ++h) wh = (h == part) ? w8[h] : wh;
                const float sc = 0.5f * fabsf(wh);
                SG[qi * 8 + part] = (wh >= 0.f) ? 1.0f : -1.0f;
#pragma unroll
                for (int c = 0; c < 8; ++c) {
                    const u32x4 v = *(const u32x4*)(zr + 512 + part * 64 + c * 8);
                    u32x4 o; o.x = pk2(bflo(v.x) * sc, bfhi(v.x) * sc); o.y = pk2(bflo(v.y) * sc, bfhi(v.y) * sc); o.z = pk2(bflo(v.z) * sc, bfhi(v.z) * sc); o.w = pk2(bflo(v.w) * sc, bfhi(v.w) * sc);
                    *(LAS u32x4*)(QL + (part * 64 + qi) * QROW + c * 16) = o;
                }
                float a8[8];
#pragma unroll
                for (int j = 0; j < 8; ++j) a8[j] = 0.f;
#pragma unroll
                for (int h = 0; h < 8; ++h) {
                    const u32x4 v = *(const u32x4*)(zr + 512 + h * 64 + part * 8); const float s2 = 0.5f * w8[h];
                    a8[0] += s2 * bflo(v.x); a8[1] += s2 * bfhi(v.x); a8[2] += s2 * bflo(v.y); a8[3] += s2 * bfhi(v.y);
                    a8[4] += s2 * bflo(v.z); a8[5] += s2 * bfhi(v.z); a8[6] += s2 * bflo(v.w); a8[7] += s2 * bfhi(v.w);
                }
                u32x4 o; o.x = pk2(a8[0], a8[1]); o.y = pk2(a8[2], a8[3]); o.z = pk2(a8[4], a8[5]); o.w = pk2(a8[6], a8[7]);
                *(LAS u32x4*)(QL + (8 * 64 + qi) * QROW + part * 16) = o;
            }
            __syncthreads();
            const int ktmax = 2 * qb + 1;
            bf16x8 kn[4];
            {   const bf16_t* kr = Z1 + ((size_t)b * SEQ + min(wave, ktmax) * 32 + l31) * Z1W + 1024 + hh * 8;
#pragma unroll
                for (int dq = 0; dq < 4; ++dq) kn[dq] = *(const bf16x8*)(kr + dq * 16); }
            for (int kt = wave; kt <= ktmax; kt += NWAVE) {
                bf16x8 kf[4];
#pragma unroll
                for (int dq = 0; dq < 4; ++dq) kf[dq] = kn[dq];
                {   const bf16_t* kr = Z1 + ((size_t)b * SEQ + min(kt + NWAVE, ktmax) * 32 + l31) * Z1W + 1024 + hh * 8;
#pragma unroll
                    for (int dq = 0; dq < 4; ++dq) kn[dq] = *(const bf16x8*)(kr + dq * 16); }
#pragma unroll
                for (int qs = 0; qs < 2; ++qs) {
                    const LAS unsigned char* qrow = QL + (qs * 32 + l31) * QROW + hh * 16;
                    const LAS float* sgp = SG + (qs * 32 + l31) * 8;
                    bf16x8 fc[4], fn[4];
#pragma unroll
                    for (int dq = 0; dq < 4; ++dq) fc[dq] = *(const LAS bf16x8*)(qrow + 8 * 64 * QROW + dq * 32);
#pragma unroll
                    for (int dq = 0; dq < 4; ++dq) fn[dq] = *(const LAS bf16x8*)(qrow + dq * 32);
                    const f32x4 sg03 = *(const LAS f32x4*)(sgp), sg47 = *(const LAS f32x4*)(sgp + 4);
                    f32x16 acc;
#pragma unroll
                    for (int r = 0; r < 16; ++r) acc[r] = 0.f;
#pragma unroll
                    for (int dq = 0; dq < 4; ++dq) acc = __builtin_amdgcn_mfma_f32_32x32x16_bf16(kf[dq], fc[dq], acc, 0, 0, 0);
                    f32x16 up;
#pragma unroll
                    for (int h = 0; h < 8; ++h) {
#pragma unroll
                        for (int dq = 0; dq < 4; ++dq) fc[dq] = fn[dq];
                        if (h < 7) {
#pragma unroll
                            for (int dq = 0; dq < 4; ++dq) fn[dq] = *(const LAS bf16x8*)(qrow + (h + 1) * 64 * QROW + dq * 32);
                        }
                        f32x16 u;
#pragma unroll
                        for (int r = 0; r < 16; ++r) u[r] = 0.f;
#pragma unroll
                        for (int dq = 0; dq < 4; ++dq) u = __builtin_amdgcn_mfma_f32_32x32x16_bf16(kf[dq], fc[dq], u, 0, 0, 0);
                        __builtin_amdgcn_sched_barrier(0);
                        if (h > 0) {
                            const float sg = (h - 1 < 4) ? sg03[(h - 1) & 3] : sg47[(h - 1) & 3];
#pragma unroll
                            for (int r = 0; r < 16; ++r) acc[r] = fmaf(fabsf(up[r]), sg, acc[r]);
                        }
                        __builtin_amdgcn_sched_barrier(0);
                        up = u;
                    }
                    {
                        const float sg = sg47[3];
#pragma unroll
                        for (int r = 0; r < 16; ++r) acc[r] = fmaf(fabsf(up[r]), sg, acc[r]);
                    }
#pragma unroll
                    for (int g = 0; g < 4; ++g) { u32x2 w; w.x = okey_pk(acc[4 * g], acc[4 * g + 1]); w.y = okey_pk(acc[4 * g + 2], acc[4 * g + 3]);
                        *(LAS u32x2*)(ST + (qs * 32 + l31) * 80 + (8 * g + 4 * hh) * 2) = w; }
                }
#pragma unroll
                for (int i = 0; i < 4; ++i) {
                    const int row = 16 * i + (lane >> 2), ch = lane & 3, tl = q0 + row;
                    const u32x4 v = *(const LAS u32x4*)(ST + row * 80 + ch * 16);
                    if (kt <= (tl >> 5)) *(u32x4*)(SC + sc_row_off(b, tl) + (size_t)kt * 32 + ch * 8) = v;
                }
            }
        }
    }
}
template <int MODE>
__device__ __forceinline__ void phase_index_select(const Params& P, unsigned char* lds_) {
    const unsigned short* SC = (const unsigned short*)(P.ws + WS_SC); unsigned short* SEL = (unsigned short*)(P.ws + WS_SEL);
    const int tid = threadIdx.x, lane = tid & 63, wave = __builtin_amdgcn_readfirstlane(tid >> 6);
    LAS unsigned char* wbase = (LAS unsigned char*)lds_ + wave * 19456;
    LAS u32x4* rowbuf = (LAS u32x4*)wbase;
    LAS unsigned* hist = (LAS unsigned*)(wbase + 16384);
    LAS unsigned* dummy = hist + 512 + lane;
    LAS unsigned short* outw = (LAS unsigned short*)(wbase + 16384 + 2048 + 256);
    LAS unsigned short* dummy16 = outw + 256 + lane;
    const unsigned rowbuf0 = (unsigned)(unsigned long)wbase;
    const int gw = blockIdx.x * NWAVE + wave, NGW = gridDim.x * NWAVE;
#define SEL_DMA(tt) do { const int _tl = (tt) & (SEQ - 1), _n = _tl + 1; if (_n > TOPK) { const unsigned char* _src = (const unsigned char*)(SC + sc_row_off((tt) >> 13, _tl)) + lane * 16; \
            for (int _sg = 0; _sg * 512 < _n; ++_sg) glds16(_src + _sg * 1024, (unsigned)__builtin_amdgcn_readfirstlane((int)(rowbuf0 + _sg * 1024))); } } while (0)
    if (gw < NTOK) SEL_DMA(gw);
    for (int t = gw; t < NTOK; t += NGW) {
        const int tl = t & (SEQ - 1), n = tl + 1;
        unsigned short* so = SEL + (size_t)t * TOPK;
        if (n <= TOPK) { for (int i = lane; i < n; i += 64) so[i] = (unsigned short)i; if (t + NGW < NTOK) SEL_DMA(t + NGW); continue; }
        asm volatile("s_waitcnt vmcnt(0)" ::: "memory");
        u32x4 d[16];
        const int lastsg = (n - 1) >> 9;
#pragma unroll
        for (int sg = 0; sg < 16; ++sg) {
            if (sg * 512 < n) {
                d[sg] = rowbuf[sg * 64 + lane];
                if (sg == lastsg) {
#pragma unroll
                    for (int q = 0; q < 4; ++q) { const int i0 = sg * 512 + lane * 8 + 2 * q;
                        d[sg][q] &= ((i0 < n) ? 0x0000ffffu : 0u) | ((i0 + 1 < n) ? 0xffff0000u : 0u); }
                }
            } else d[sg] = (u32x4){0u, 0u, 0u, 0u};
        }
        asm volatile("s_waitcnt lgkmcnt(0)" ::: "memory");
        if (t + NGW < NTOK) SEL_DMA(t + NGW);
#pragma unroll
        for (int i = 0; i < 8; ++i) { hist[i * 64 + lane] = 0u; }
        asm volatile("s_waitcnt lgkmcnt(0)" ::: "memory");
        LAS unsigned* myh = hist + (lane & 1) * 256;
        if (MODE == 4) { if (d[0].x == 0x12345u) so[lane] = 1; continue; }
#pragma unroll
        for (int sg = 0; sg < 16; ++sg) if (MODE != 1 && sg * 512 < n) {
#pragma unroll
            for (int q = 0; q < 4; ++q) { const unsigned w = d[sg][q];
                __hip_atomic_fetch_add(myh + ((w >> 8) & 0xffu), 1u, __ATOMIC_RELAXED, __HIP_MEMORY_SCOPE_WORKGROUP);
                __hip_atomic_fetch_add(myh + (w >> 24), 1u, __ATOMIC_RELAXED, __HIP_MEMORY_SCOPE_WORKGROUP); }
        }
        asm volatile("s_waitcnt lgkmcnt(0)" ::: "memory");
        unsigned b1, need1;
        {
            unsigned c[4];
#pragma unroll
            for (int q = 0; q < 4; ++q) c[q] = hist[4 * lane + q] + hist[256 + 4 * lane + q];
            const unsigned mine = c[0] + c[1] + c[2] + c[3];
            unsigned suf = mine;
#pragma unroll
            for (int o = 1; o < 64; o <<= 1) { const unsigned v = __shfl_down(suf, o); if (lane + o < 64) suf += v; }
            const unsigned above = suf - mine;
            int fb = -1; unsigned fneed = 0;
            if (above < (unsigned)TOPK && suf >= (unsigned)TOPK) { unsigned a = above;
#pragma unroll
                for (int q = 3; q >= 0; --q) { if (fb < 0 && a + c[q] >= (unsigned)TOPK) { fb = 4 * lane + q; fneed = (unsigned)TOPK - a; } a += c[q]; } }
            const unsigned long long bal = __ballot(fb >= 0);
            const int src = (int)__builtin_ctzll(bal);
            b1 = (unsigned)__shfl(fb, src); need1 = __shfl(fneed, src);
        }
#pragma unroll
        for (int i = 0; i < 8; ++i) { hist[i * 64 + lane] = 0u; }
        asm volatile("s_waitcnt lgkmcnt(0)" ::: "memory");
#pragma unroll
        for (int sg = 0; sg < 16; ++sg) if (MODE != 2 && sg * 512 < n) {
#pragma unroll
            for (int q = 0; q < 4; ++q) { const unsigned w = d[sg][q];
                LAS unsigned* p0 = (((w >> 8) & 0xffu) == b1) ? (myh + (w & 0xffu)) : dummy;
                LAS unsigned* p1 = ((w >> 24) == b1) ? (myh + ((w >> 16) & 0xffu)) : dummy;
                __hip_atomic_fetch_add(p0, 1u, __ATOMIC_RELAXED, __HIP_MEMORY_SCOPE_WORKGROUP);
                __hip_atomic_fetch_add(p1, 1u, __ATOMIC_RELAXED, __HIP_MEMORY_SCOPE_WORKGROUP); }
        }
        asm volatile("s_waitcnt lgkmcnt(0)" ::: "memory");
        unsigned T, need2;
        {
            unsigned c[4];
#pragma unroll
            for (int q = 0; q < 4; ++q) c[q] = hist[4 * lane + q] + hist[256 + 4 * lane + q];
            const unsigned mine = c[0] + c[1] + c[2] + c[3];
            unsigned suf = mine;
#pragma unroll
            for (int o = 1; o < 64; o <<= 1) { const unsigned v = __shfl_down(suf, o); if (lane + o < 64) suf += v; }
            const unsigned above = suf - mine;
            int fb = -1; unsigned fneed = 0;
            if (above < need1 && suf >= need1) { unsigned a = above;
#pragma unroll
                for (int q = 3; q >= 0; --q) { if (fb < 0 && a + c[q] >= need1) { fb = 4 * lane + q; fneed = need1 - a; } a += c[q]; } }
            const unsigned long long bal = __ballot(fb >= 0);
            const int src = (int)__builtin_ctzll(bal);
            T = (b1 << 8) | (unsigned)__shfl(fb, src); need2 = __shfl(fneed, src);
        }
        unsigned base = 0; const unsigned ngt = (unsigned)TOPK - need2; unsigned eqbase = 0;
#pragma unroll
        for (int sg = 0; sg < 16; ++sg) if (MODE != 3 && sg * 512 < n) {
            unsigned ce = 0;
#pragma unroll
            for (int j = 0; j < 8; ++j) {
                const unsigned k = (j & 1) ? (d[sg][j >> 1] >> 16) : (d[sg][j >> 1] & 0xffffu);
                const bool gt = k > T;
                const unsigned long long mk = __ballot(gt);
                const unsigned pos = base + (unsigned)__builtin_amdgcn_mbcnt_hi((unsigned)(mk >> 32), __builtin_amdgcn_mbcnt_lo((unsigned)mk, 0u));
                LAS unsigned short* po = gt ? (outw + pos) : dummy16;
                *po = (unsigned short)(sg * 512 + lane * 8 + j);
                base += (unsigned)__builtin_popcountll(mk);
                ce += (k == T) ? 1u : 0u;
            }
            if (__any(ce > 0u)) {
                unsigned pre = ce;
#pragma unroll
                for (int o = 1; o < 64; o <<= 1) { const unsigned v = __shfl_up(pre, o); if (lane >= o) pre += v; }
                unsigned r = eqbase + pre - ce;
#pragma unroll
                for (int j = 0; j < 8; ++j) { const unsigned k = (j & 1) ? (d[sg][j >> 1] >> 16) : (d[sg][j >> 1] & 0xffffu);
                    if (k == T) { if (r < need2) outw[ngt + r] = (unsigned short)(sg * 512 + lane * 8 + j); ++r; } }
                eqbase += __shfl(pre, 63);
            }
        }
        asm volatile("s_waitcnt lgkmcnt(0)" ::: "memory");
        ((unsigned*)so)[lane] = ((LAS unsigned*)outw)[lane];
        ((unsigned*)so)[64 + lane] = ((LAS unsigned*)outw)[64 + lane];
        asm volatile("s_waitcnt lgkmcnt(0)" ::: "memory");
    }
#undef SEL_DMA
    asm volatile("s_waitcnt vmcnt(0)" ::: "memory");
}

__device__ __forceinline__ void ret_fill_image(LAS unsigned char* img, const unsigned char* src, size_t row_stride_bytes, int wave, int lane) {
#pragma unroll
    for (int e4 = 0; e4 < 4; ++e4) {
        const int e = wave * 4 + e4, row = 4 * e + (lane >> 4), q = (lane & 15) ^ ((row & 7) << 1);
        __builtin_amdgcn_global_load_lds((const unsigned*)(src + (size_t)row * row_stride_bytes + q * 16), (LAS unsigned*)(img + e * 1024), 16, 0, 0);
    }
}
__device__ __forceinline__ pg8::bf16x8 ret_tr_pair(const LAS unsigned char* img, int row0, int chunk2, int lane) {
    const int g = lane >> 4, i = lane & 15, r0 = row0 + 4 * g + (i >> 2), pb = (i & 3) >> 1, half = (i & 1) * 8;
    const int r1 = r0 + 16;
    const v4i16_t lo = __builtin_amdgcn_ds_read_tr16_b64_v4i16((LAS v4i16_t*)(img + r0 * 256 + ((((chunk2) ^ ((r0 & 7) << 1)) | pb) << 4) + half));
    const v4i16_t hi = __builtin_amdgcn_ds_read_tr16_b64_v4i16((LAS v4i16_t*)(img + r1 * 256 + ((((chunk2) ^ ((r1 & 7) << 1)) | pb) << 4) + half));
    return (pg8::bf16x8){lo[0], lo[1], lo[2], lo[3], hi[0], hi[1], hi[2], hi[3]};
}
__device__ __forceinline__ void phase_ret_kv_mfma(const Params& P, unsigned char* lds_) {
    using pg8::bf16x8;
    const unsigned char* Z0 = (const unsigned char*)(P.ws + WS_Z0); float* KV = (float*)(P.ws + WS_KV);
    LAS unsigned char* Kimg = (LAS unsigned char*)lds_; LAS unsigned char* Vimg = Kimg + 32768;
    const int tid = threadIdx.x, lane = tid & 63, wave = __builtin_amdgcn_readfirstlane(tid >> 6), fr = lane & 15, fq = lane >> 4;
    for (int u = blockIdx.x; u < 1024; u += gridDim.x) {
        const int n = u & 63, h = (u >> 6) & 3, b = u >> 8;
        const size_t row0 = (size_t)b * SEQ + n * 128;
        __syncthreads();
        ret_fill_image(Kimg, Z0 + row0 * ZW * 2 + (512 + h * 128) * 2, ZW * 2, wave, lane);
        ret_fill_image(Vimg, Z0 + row0 * ZW * 2 + (1024 + h * 128) * 2, ZW * 2, wave, lane);
        asm volatile("s_waitcnt vmcnt(0)" ::: "memory");
        __syncthreads();
        bf16x8 va[4];
#pragma unroll
        for (int jc = 0; jc < 4; ++jc) va[jc] = ret_tr_pair(Vimg, 32 * jc, 2 * wave, lane);
        const float g127 = exp2f(ret_log2g(h) * 127.0f);
        float* o = KV + (size_t)u * 16384;
#pragma unroll
        for (int dt = 0; dt < 8; ++dt) {
            f32x4 acc = {0.f, 0.f, 0.f, 0.f};
#pragma unroll
            for (int jc = 0; jc < 4; ++jc) acc = __builtin_amdgcn_mfma_f32_16x16x32_bf16(va[jc], ret_tr_pair(Kimg, 32 * jc, 2 * dt, lane), acc, 0, 0, 0);
            *(f32x4*)(o + (size_t)(16 * dt + fr) * 128 + 16 * wave + 4 * fq) = acc * g127;
        }
    }
}
__device__ __forceinline__ void phase_ret_scan_pool2(const Params& P) {
    const float* KV = (const float*)(P.ws + WS_KV); bf16_t* SB = (bf16_t*)(P.ws + WS_SB);
    const size_t gt = (size_t)blockIdx.x * NT + threadIdx.x, GS = (size_t)gridDim.x * NT;
    for (size_t i = gt; i < (size_t)16 * 8192; i += GS) {
        const int s = (int)(i >> 13), e2 = (int)(i & 8191), h = s & 3;
        const float l2 = ret_log2g(h), cd = exp2f(l2 * 128.0f), g1 = exp2f(l2);
        typedef float f32x2v __attribute__((ext_vector_type(2)));
        const f32x2v* p = (const f32x2v*)(KV + (size_t)s * 64 * 16384) + e2;
        unsigned* q = (unsigned*)(SB + (size_t)s * 64 * 16384) + e2;
        f32x2v R = {0.f, 0.f};
        for (int n0 = 0; n0 < 64; n0 += 16) {
            f32x2v kv[16];
#pragma unroll
            for (int j = 0; j < 16; ++j) kv[j] = __builtin_nontemporal_load(p + (size_t)(n0 + j) * 8192);
#pragma unroll
            for (int j = 0; j < 16; ++j) { q[(size_t)(n0 + j) * 8192] = pk2(R.x * g1, R.y * g1); R = R * cd + kv[j]; }
        }
    }
    const bf16_t* Z0 = (const bf16_t*)(P.ws + WS_Z0); bf16_t* DP = (bf16_t*)(P.ws + WS_DP);
    for (size_t i = gt; i < (size_t)NTOK * 64; i += GS) {
        const int t = (int)(i >> 6), c8 = (int)(i & 63) * 8, g = c8 >> 7, w = 2 << g, tl = t & (SEQ - 1);
        const int cnt = min(tl + 1, w);
        float sm[8];
#pragma unroll
        for (int j = 0; j < 8; ++j) sm[j] = 0.f;
        float u0[8];
        for (int q = 0; q < cnt; ++q) {
            const u32x4 v = *(const u32x4*)(Z0 + (size_t)(t - q) * ZW + 2048 + c8);
            const float f[8] = {bflo(v.x), bfhi(v.x), bflo(v.y), bfhi(v.y), bflo(v.z), bfhi(v.z), bflo(v.w), bfhi(v.w)};
#pragma unroll
            for (int j = 0; j < 8; ++j) { sm[j] += f[j]; if (q == 0) u0[j] = f[j]; }
        }
        const float inv = 1.0f / (float)cnt;
        u32x4 o; o.x = pk2(sm[0] * inv - u0[0], sm[1] * inv - u0[1]); o.y = pk2(sm[2] * inv - u0[2], sm[3] * inv - u0[3]);
        o.z = pk2(sm[4] * inv - u0[4], sm[5] * inv - u0[5]); o.w = pk2(sm[6] * inv - u0[6], sm[7] * inv - u0[7]);
        *(u32x4*)(DP + (size_t)t * 512 + c8) = o;
    }
}
__device__ __forceinline__ void phase_ret_out_mfma(const Params& P, unsigned char* lds_) {
    using pg8::bf16x8;
    const unsigned char* Z0 = (const unsigned char*)(P.ws + WS_Z0); const unsigned char* SB = (const unsigned char*)(P.ws + WS_SB); bf16_t* MIX = (bf16_t*)(P.ws + WS_MIX);
    const float* gn = P.in[3];
    LAS unsigned char* Kimg = (LAS unsigned char*)lds_; LAS unsigned char* Vimg = Kimg + 32768; LAS unsigned char* Rimg = Kimg + 65536;
    const int tid = threadIdx.x, lane = tid & 63, wave = __builtin_amdgcn_readfirstlane(tid >> 6), fr = lane & 15, fq = lane >> 4;
    for (int u = blockIdx.x; u < 1024; u += gridDim.x) {
        const int n = u & 63, h = (u >> 6) & 3, b = u >> 8;
        const size_t row0 = (size_t)b * SEQ + n * 128;
        __syncthreads();
        ret_fill_image(Kimg, Z0 + row0 * ZW * 2 + (512 + h * 128) * 2, ZW * 2, wave, lane);
        ret_fill_image(Vimg, Z0 + row0 * ZW * 2 + (1024 + h * 128) * 2, ZW * 2, wave, lane);
        ret_fill_image(Rimg, SB + (size_t)u * 32768, 256, wave, lane);
        const bf16_t* qrow = (const bf16_t*)Z0 + (row0 + 16 * wave + fr) * ZW + h * 128;
        bf16x8 qf[4], qr[4];
#pragma unroll
        for (int c = 0; c < 4; ++c) {
            qf[c] = *(const bf16x8*)(qrow + 32 * c + 8 * fq);
            const u32x2 a = *(const u32x2*)(qrow + 32 * c + 4 * fq), bb = *(const u32x2*)(qrow + 32 * c + 16 + 4 * fq);
            u32x4 w; w.x = a.x; w.y = a.y; w.z = bb.x; w.w = bb.y; qr[c] = __builtin_bit_cast(bf16x8, w);
        }
        asm volatile("s_waitcnt vmcnt(0)" ::: "memory");
        __syncthreads();
        f32x4 sT[8];
#pragma unroll
        for (int jt = 0; jt < 8; ++jt) sT[jt] = (f32x4){0.f, 0.f, 0.f, 0.f};
#pragma unroll
        for (int jt = 0; jt < 8; ++jt) if (jt <= wave) {
            const int r = 16 * jt + fr;
#pragma unroll
            for (int c = 0; c < 4; ++c) {
                const bf16x8 a = *(const LAS bf16x8*)(Kimg + r * 256 + ((((4 * c + fq)) ^ ((r & 7) << 1)) << 4));
                sT[jt] = __builtin_amdgcn_mfma_f32_16x16x32_bf16(a, qf[c], sT[jt], 0, 0, 0);
            }
            if (jt == wave) {
                if (4 * fq + 0 > fr) sT[jt].x = 0.f; if (4 * fq + 1 > fr) sT[jt].y = 0.f; if (4 * fq + 2 > fr) sT[jt].z = 0.f; if (4 * fq + 3 > fr) sT[jt].w = 0.f;
            }
        }
        bf16x8 pT[4];
#pragma unroll
        for (int jp = 0; jp < 4; ++jp) { u32x4 w; w.x = pk2(sT[2 * jp].x, sT[2 * jp].y); w.y = pk2(sT[2 * jp].z, sT[2 * jp].w); w.z = pk2(sT[2 * jp + 1].x, sT[2 * jp + 1].y); w.w = pk2(sT[2 * jp + 1].z, sT[2 * jp + 1].w);
            pT[jp] = __builtin_bit_cast(bf16x8, w); }
        f32x4 O[8];
#pragma unroll
        for (int vt = 0; vt < 8; ++vt) {
            f32x4 acc = {0.f, 0.f, 0.f, 0.f};
#pragma unroll
            for (int jp = 0; jp < 4; ++jp) if (2 * jp <= wave) acc = __builtin_amdgcn_mfma_f32_16x16x32_bf16(ret_tr_pair(Vimg, 32 * jp, 2 * vt, lane), pT[jp], acc, 0, 0, 0);
#pragma unroll
            for (int c = 0; c < 4; ++c) acc = __builtin_amdgcn_mfma_f32_16x16x32_bf16(ret_tr_pair(Rimg, 32 * c, 2 * vt, lane), qr[c], acc, 0, 0, 0);
            O[vt] = acc;
        }
        float sm = 0.f;
#pragma unroll
        for (int vt = 0; vt < 8; ++vt) sm += (O[vt].x + O[vt].y) + (O[vt].z + O[vt].w);
        sm += __shfl_xor(sm, 16); sm += __shfl_xor(sm, 32);
        const float mu = sm * (1.0f / 128.0f);
        float sq = 0.f;
#pragma unroll
        for (int vt = 0; vt < 8; ++vt) { const f32x4 dlt = O[vt] - mu; sq += (dlt.x * dlt.x + dlt.y * dlt.y) + (dlt.z * dlt.z + dlt.w * dlt.w); }
        sq += __shfl_xor(sq, 16); sq += __shfl_xor(sq, 32);
        const float rstd = 1.0f / sqrtf(sq * (1.0f / 128.0f) + LN_EPS);
        const bf16_t* grow = (const bf16_t*)Z0 + (row0 + 16 * wave + fr) * ZW + 1536 + h * 128 + 4 * fq;
        bf16_t* orow = MIX + (row0 + 16 * wave + fr) * DM + h * 128 + 4 * fq;
#pragma unroll
        for (int vt = 0; vt < 8; ++vt) {
            const u32x2 gv = *(const u32x2*)(grow + 16 * vt);
            const f32x4 g4 = *(const f32x4*)(gn + h * 128 + 16 * vt + 4 * fq);
            const f32x4 y = (O[vt] - mu) * rstd * g4;
            u32x2 w; w.x = pk2(y.x * silu_f(bflo(gv.x)), y.y * silu_f(bfhi(gv.x))); w.y = pk2(y.z * silu_f(bflo(gv.y)), y.w * silu_f(bfhi(gv.y)));
            *(u32x2*)(orow + 16 * vt) = w;
        }
    }
}

#define XB_TMO      128
#define XB_XCNT(j)  (256  + 64 * (j))
#define XB_XSUB(j)  (1280 + 64 * (j))
#define XB_XGEN(j)  (2304 + 64 * (j))
#define XB_TOP      3328
#define XB_TOPGEN   3392
#define XCD_BAR_WORDS 3456
#define XB_SPIN_CAP (1u << 22)
__device__ __forceinline__ unsigned xb_ld(unsigned* p)              { return __hip_atomic_load(p, __ATOMIC_RELAXED, __HIP_MEMORY_SCOPE_AGENT); }
__device__ __forceinline__ unsigned xb_add(unsigned* p, unsigned v) { return __hip_atomic_fetch_add(p, v, __ATOMIC_RELAXED, __HIP_MEMORY_SCOPE_AGENT); }
__device__ __forceinline__ unsigned xb_xcc_id() { return (unsigned)__builtin_amdgcn_s_getreg((3 << 11) | 20) & 0xFu; }
#define XB_SPIN(cond, bar) do { unsigned _sp = 0; while (cond) { __builtin_amdgcn_s_sleep(1); \
    if ((++_sp & 255u) == 0u) { if (xb_ld(&(bar)[XB_TMO])) break; if (_sp > XB_SPIN_CAP) { atomicAdd(&(bar)[XB_TMO], 1u); break; } } } } while (0)
struct XcdBarrier { unsigned* bar; unsigned x; volatile LAS unsigned* st; };
__device__ __forceinline__ XcdBarrier xcd_barrier_post(unsigned* bar, volatile LAS unsigned* st) {
    XcdBarrier b; b.bar = bar; b.x = xb_xcc_id(); b.st = st;
    if (threadIdx.x == 0) (void)xb_add(&bar[XB_XCNT(b.x)], 1u);
    return b;
}
__device__ __forceinline__ void xcd_barrier_complete(unsigned* bar, unsigned x, unsigned& nloc, unsigned& nx) {
    const unsigned G = gridDim.x * gridDim.y * gridDim.z;
    unsigned sum, cnt, mine, sp = 0u;
    for (;;) {
        sum = 0u; cnt = 0u; mine = 0u;
#pragma unroll
        for (unsigned j = 0; j < 16; ++j) { const unsigned c = xb_ld(&bar[XB_XCNT(j)]); sum += c; cnt += (c > 0u) ? 1u : 0u; mine = (j == x) ? c : mine; }
        if (sum == G) break;
        __builtin_amdgcn_s_sleep(1);
        if ((++sp & 255u) == 0u) { if (xb_ld(&bar[XB_TMO])) break; if (sp > XB_SPIN_CAP) { atomicAdd(&bar[XB_TMO], 1u); break; } }
    }
    nloc = mine > 0u ? mine : 1u; nx = cnt > 0u ? cnt : 1u;
}
__device__ __forceinline__ void xcd_barrier(const XcdBarrier& b) {
    asm volatile("s_waitcnt vmcnt(0)" ::: "memory");
    __syncthreads();
    if (threadIdx.x == 0) {
        unsigned* bar = b.bar;
        __builtin_amdgcn_s_waitcnt(0);
        unsigned nloc = b.st[0], nx = b.st[1];
        if (nloc == 0u) { xcd_barrier_complete(bar, b.x, nloc, nx); b.st[0] = nloc; b.st[1] = nx; }
        const unsigned old = xb_add(&bar[XB_XSUB(b.x)], 1u);
        const unsigned gen = old / nloc;
        if (old + 1u == (gen + 1u) * nloc) {
            __builtin_amdgcn_fence(__ATOMIC_RELEASE, "agent");
            asm volatile("s_waitcnt vmcnt(0)" ::: "memory");
            const unsigned og = xb_add(&bar[XB_TOP], 1u);
            const unsigned tg = og / nx;
            if (og + 1u == (tg + 1u) * nx) xb_add(&bar[XB_TOPGEN], 1u);
            else XB_SPIN(xb_ld(&bar[XB_TOPGEN]) == tg, bar);
            __builtin_amdgcn_fence(__ATOMIC_ACQUIRE, "agent");
            xb_add(&bar[XB_XGEN(b.x)], 1u);
            asm volatile("s_waitcnt vmcnt(0)" ::: "memory");
        } else {
            XB_SPIN(xb_ld(&bar[XB_XGEN(b.x)]) == gen, bar);
            __builtin_amdgcn_fence(__ATOMIC_ACQUIRE, "agent");
            asm volatile("s_waitcnt vmcnt(0)" ::: "memory");
        }
    }
    __syncthreads();
}
constexpr size_t CTL_BAR_OFF = 16384;
constexpr size_t CTL_ZERO_BYTES = 65536;

#ifdef PH_ONLY
#define IN(k) ((k) == PH_ONLY)
#else
#define IN(k) (lo <= (k) && (k) < hi)
#endif
#define SEAM(k) do { if (IN(k) && IN((k) + 1)) xcd_barrier(grid); } while (0)
#ifndef PROBE_DUP
#define PROBE_DUP (-1)
#endif
#define REP(k) for (int _rep = 0; _rep < ((PROBE_DUP == (k)) ? 2 : 1); ++_rep)
#define REPS(k) ((PROBE_DUP == 100 + (k)) ? 2 : 1)

template <int LAYER, int BASE>
__device__ __forceinline__ void layer_tail(const Params& P, unsigned char* lds, const XcdBarrier& grid, int lo, int hi) {
    unsigned char* ws = P.ws;
    int* tb = (int*)(lds + MISC_OFF);
    if (IN(BASE)) { if (PROBE_DUP == BASE) phase_ln_route<true>(P, lds, LAYER); phase_ln_route<false>(P, lds, LAYER); }
    SEAM(BASE);
    if (IN(BASE + 1)) REP(BASE + 1) { moe_setup(P, tb, LAYER);
        MoeSched S{tb, (const int*)(ws + WS_CTL) + LAYER * 64, (const int*)(ws + WS_LIST), (const bf16_t*)(ws + WS_XB),
                   (const bf16_t*)(ws + WS_W_GU) + (size_t)LAYER * 32 * DM * DM, DM, (size_t)DM * DM, true};
        EpiGU E{(bf16_t*)(ws + WS_ACT)}; gemm_moe<true>(lds, S, E); }
    SEAM(BASE + 1);
    if (IN(BASE + 2)) REP(BASE + 2) { moe_setup(P, tb, LAYER);
        MoeSched S{tb, (const int*)(ws + WS_CTL) + LAYER * 64, (const int*)(ws + WS_LIST), (const bf16_t*)(ws + WS_ACT),
                   (const bf16_t*)(ws + WS_W_DN) + (size_t)LAYER * 32 * DM * 512, 512, (size_t)DM * 512, false};
        EpiDown E{(bf16_t*)(ws + WS_YS)}; gemm_moe<false>(lds, S, E); }
    SEAM(BASE + 2);
    if (IN(BASE + 3)) { if (PROBE_DUP == BASE + 3) phase_ln2<true>(P, LAYER); phase_ln2<false>(P, LAYER); }
    SEAM(BASE + 3);
    if (IN(BASE + 4)) REP(BASE + 4) {
        { DenseSched S{(const bf16_t*)(ws + WS_PB) + (size_t)LAYER * NTOK * 256, (const bf16_t*)(ws + WS_W_P) + (size_t)LAYER * DM * 256, NTOK, DM, 256, 256, 0, REPS(BASE + 4)};
          EpiStoreBf16 E{(bf16_t*)(ws + WS_PP), DM, 0, nullptr}; gemm_dense(lds, S, E); }
        __syncthreads();
        { DenseSched S{(const bf16_t*)(ws + WS_XB), (const bf16_t*)(ws + WS_W_G) + (size_t)LAYER * DM * DM, NTOK, DM, DM, DM, 0, REPS(BASE + 4)};
          EpiPle E{(const bf16_t*)(ws + WS_XB), (const bf16_t*)(ws + WS_PP), LAYER == 1 ? P.out : (float*)nullptr, LAYER == 1 ? (bf16_t*)nullptr : (bf16_t*)(ws + WS_XB2)}; gemm_dense(lds, S, E); }
    }
}

__global__ void __launch_bounds__(NT, 2) mega(Params P, int lo, int hi) {
    extern __shared__ __attribute__((aligned(16))) unsigned char lds[];
    unsigned char* ws = P.ws;
    if (threadIdx.x < 16) ((LAS unsigned*)((LAS unsigned char*)lds + BARW_OFF))[threadIdx.x] = 0u;
    __syncthreads();
    const XcdBarrier grid = xcd_barrier_post((unsigned*)(ws + WS_CTL + CTL_BAR_OFF), (volatile LAS unsigned*)((LAS unsigned char*)lds + BARW_OFF));
    if (IN(0)) REP(0) phase_prep(P, lds);
    SEAM(0);
    if (IN(1)) REP(1) { DenseSched S{(const bf16_t*)(ws + WS_XB), (const bf16_t*)(ws + WS_W_IN0), NTOK, ZW, DM, DM, 0, REPS(1)};
        EpiZ0 E{(bf16_t*)(ws + WS_Z0)}; gemm_dense(lds, S, E); }
    SEAM(1);
    if (IN(2)) REP(2) phase_ret_kv_mfma(P, lds);
    SEAM(2);
    if (IN(3)) REP(3) phase_ret_scan_pool2(P);
    SEAM(3);
    if (IN(4)) REP(4) { phase_ret_out_mfma(P, lds); __syncthreads();
        DenseSched S{(const bf16_t*)(ws + WS_DP), (const bf16_t*)(ws + WS_W_POOL), NTOK, 512, 256, 512, 256};
        EpiStoreBf16 E{(bf16_t*)(ws + WS_MIX), DM, 512, P.in[5]}; gemm_dense(lds, S, E); }
    SEAM(4);
    if (IN(5)) REP(5) { DenseSched S{(const bf16_t*)(ws + WS_MIX), (const bf16_t*)(ws + WS_W_OUT0), NTOK, DM, DM, DM, 0, REPS(5)};
        EpiResidB E{(const bf16_t*)(ws + WS_XB), (bf16_t*)(ws + WS_F)}; gemm_dense(lds, S, E); }
    SEAM(5);
    layer_tail<0, 6>(P, lds, grid, lo, hi);
    SEAM(10);
    if (IN(11)) REP(11) { DenseSched S{(const bf16_t*)(ws + WS_XB2), (const bf16_t*)(ws + WS_W_CIN), NTOK, Z1W, DM, DM, 0, REPS(11)};
        EpiStoreBf16 E{(bf16_t*)(ws + WS_Z1), Z1W, 0, nullptr}; gemm_dense(lds, S, E); }
    SEAM(11);
    if (IN(12)) REP(12) { phase_norms(P); phase_index_scores(P, lds); }
    SEAM(12);
    if (IN(13)) { if (PROBE_DUP == 13) phase_index_select<PROBE_SEL>(P, lds); phase_index_select<0>(P, lds); }
    SEAM(13);
    if (IN(14)) REP(14) { DenseSched S{(const bf16_t*)(ws + WS_CQ), (const bf16_t*)(ws + WS_W_QA), NTOK, 4096, 256, 256, 0, REPS(14)};
        EpiStoreFp8 E{(unsigned char*)(ws + WS_QA), 4096}; gemm_dense(lds, S, E); }
    SEAM(14);
    if (IN(15)) { if (PROBE_DUP == 15) phase_sparse_attn_e<true>(P, lds); phase_sparse_attn_e<false>(P, lds); }
    SEAM(15);
    if (IN(16)) REP(16) { DenseSched S{(const bf16_t*)(ws + WS_OLAT), (const bf16_t*)(ws + WS_W_UVBD), NTOK, DM, DM, 4096, 1024, REPS(16)};
        EpiStoreBf16 E{(bf16_t*)(ws + WS_XB), DM, 0, nullptr}; gemm_dense(lds, S, E); }
    SEAM(16);
    if (IN(17)) REP(17) { DenseSched S{(const bf16_t*)(ws + WS_XB), (const bf16_t*)(ws + WS_W_COUT), NTOK, DM, DM, DM, 0, REPS(17)};
        EpiResidB E{(const bf16_t*)(ws + WS_XB2), (bf16_t*)(ws + WS_F)}; gemm_dense(lds, S, E); }
    SEAM(17);
    layer_tail<1, 18>(P, lds, grid, lo, hi);
}
#undef IN
#undef SEAM

extern "C" void kernel_launch(void* const* d_in, const int* in_sizes, int n_in, void* d_out, int out_size, void* d_ws, size_t ws_size, hipStream_t stream) {
    static int grid = 0;
    if (grid == 0) {
        if (n_in != 26 || ws_size < WS_END || out_size != NTOK * DM) { fprintf(stderr, "kernel_launch: unexpected problem (n_in %d, ws %zu, out %d)\n", n_in, ws_size, out_size); grid = -1; return; }
        int dev = 0, cus = 0, per_cu = 0;
        (void)hipGetDevice(&dev);
        (void)hipDeviceGetAttribute(&cus, hipDeviceAttributeMultiprocessorCount, dev);
        (void)hipFuncSetAttribute((const void*)mega, hipFuncAttributeMaxDynamicSharedMemorySize, LDS_BYTES);
        (void)hipOccupancyMaxActiveBlocksPerMultiprocessor(&per_cu, (const void*)mega, NT, LDS_BYTES);
        if (per_cu < 1) { fprintf(stderr, "kernel_launch: occupancy query reports %d blocks per CU\n", per_cu); per_cu = 1; }
        (void)hipGetLastError();
        grid = cus;
    }
    if (grid < 0) return;
    (void)hipMemsetAsync((char*)d_ws + WS_CTL, 0, CTL_ZERO_BYTES, stream);
    Params p{};
    for (int i = 0; i < 26; ++i) p.in[i] = (const float*)d_in[i];
    p.out = (float*)d_out; p.ws = (unsigned char*)d_ws;
#if MK_ONE_LAUNCH
    int lo = 0, hi = NPH_TOTAL;
    void* args[] = {&p, &lo, &hi};
    (void)args;
    hipLaunchKernelGGL(mega, dim3(grid), dim3(NT), LDS_BYTES, stream, p, lo, hi);
    hipError_t e = hipPeekAtLastError();
    if (e != hipSuccess) fprintf(stderr, "launch failed: %s (grid %d)\n", hipGetErrorString(e), grid);
#else
    for (int k = 0; k < NPH_TOTAL; ++k) hipLaunchKernelGGL(mega, dim3(grid), dim3(NT), LDS_BYTES, stream, p, k, k + 1);
#endif
}
```

```cpp
#include <hip/hip_runtime.h>
#include <hip/hip_cooperative_groups.h>
#include <cstdio>
#include <cstdint>
namespace cg = cooperative_groups;

#ifndef PROBE_ATT
#define PROBE_ATT 0
#endif
#ifndef PROBE_SEL
#define PROBE_SEL 0
#endif
#ifndef MK_ONE_LAUNCH
#define MK_ONE_LAUNCH 1
#endif

typedef unsigned short bf16_t;
typedef float f32x4 __attribute__((ext_vector_type(4)));
typedef unsigned u32x4 __attribute__((ext_vector_type(4)));
typedef unsigned u32x2 __attribute__((ext_vector_type(2)));

constexpr int NT = 512;
constexpr int NWAVE = NT / 64;
constexpr int NTOK = 32768, DM = 1024, SEQ = 8192, NBATCH = 4;
constexpr int ZW = 2560;
constexpr int Z1W = 1280;
constexpr int CIN = 1096;
constexpr int TOPK = 256;
constexpr float ALPHA = 1.4142135623730951f;
constexpr float LN_EPS = 1e-5f;
constexpr int LDS_BYTES = 163840;
constexpr int BARW_OFF = LDS_BYTES - 64;
constexpr int MISC_OFF = 135168;

constexpr size_t MiB = (size_t)1 << 20;
constexpr size_t WS_CTL = 0;
constexpr size_t WS_W_IN0 = 1 * MiB, WS_W_OUT0 = 6 * MiB, WS_W_POOL = 8 * MiB, WS_W_CIN = 9 * MiB, WS_W_QA = 12 * MiB,
                 WS_W_UVBD = 14 * MiB, WS_W_COUT = 16 * MiB, WS_W_G = 18 * MiB, WS_W_P = 22 * MiB, WS_W_GU = 24 * MiB, WS_W_DN = 152 * MiB;
constexpr size_t WS_XB = 224 * MiB, WS_F = 288 * MiB, WS_PB = 416 * MiB, WS_PP = 448 * MiB, WS_CQ = 512 * MiB, WS_CKV = 528 * MiB,
                 WS_SEL = 544 * MiB, WS_TOKG = 560 * MiB, WS_LIST = 561 * MiB, WS_CKV8 = 566 * MiB;
constexpr size_t WS_M0 = 576 * MiB;
constexpr size_t WS_Z0 = WS_M0, WS_KV = WS_M0 + 160 * MiB, WS_MIX = WS_M0 + 224 * MiB, WS_DP = WS_M0 + 288 * MiB, WS_SB = WS_M0 + 320 * MiB;
constexpr size_t WS_OLAT = WS_M0, WS_QA = WS_M0 + 256 * MiB  , WS_SC = WS_M0, WS_Z1 = WS_M0 + 272 * MiB;
constexpr size_t WS_ACT = WS_M0, WS_YS = WS_M0 + 72 * MiB;
constexpr size_t WS_XB2 = 960 * MiB;
constexpr size_t WS_END = 1024 * MiB;
constexpr int LIST_CAP = 32768;
constexpr size_t WS_GT = WS_CTL + 262144;
constexpr size_t WS_SGB = WS_CTL + 786432;

struct Params {
    const float* in[26];
    float* out;
    unsigned char* ws;
};

__device__ __forceinline__ unsigned f2bf(float f) { unsigned u = __float_as_uint(f); return (u + 0x7fffu + ((u >> 16) & 1u)) >> 16; }
__device__ __forceinline__ float bf2f(unsigned h) { return __uint_as_float(h << 16); }
typedef float f32x2_t __attribute__((ext_vector_type(2))); typedef __bf16 bf16x2_t __attribute__((ext_vector_type(2)));
__device__ __forceinline__ unsigned pk2(float lo, float hi) { f32x2_t v = {lo, hi}; bf16x2_t b = __builtin_convertvector(v, bf16x2_t); return __builtin_bit_cast(unsigned, b); }
__device__ __forceinline__ float bflo(unsigned w) { return __uint_as_float(w << 16); }
__device__ __forceinline__ float bfhi(unsigned w) { return __uint_as_float(w & 0xffff0000u); }
#define WAVE_SUM_DPP(v) ({ float _v = (v); \
    _v += __builtin_bit_cast(float, __builtin_amdgcn_update_dpp(0, __builtin_bit_cast(int, _v), 0xB1, 0xf, 0xf, true));     \
    _v += __builtin_bit_cast(float, __builtin_amdgcn_update_dpp(0, __builtin_bit_cast(int, _v), 0x4E, 0xf, 0xf, true));     \
    _v += __builtin_bit_cast(float, __builtin_amdgcn_update_dpp(0, __builtin_bit_cast(int, _v), 0x141, 0xf, 0xf, true));    \
    _v += __builtin_bit_cast(float, __builtin_amdgcn_update_dpp(0, __builtin_bit_cast(int, _v), 0x140, 0xf, 0xf, true));    \
    _v += __builtin_bit_cast(float, __builtin_amdgcn_update_dpp(0, __builtin_bit_cast(int, _v), 0x142, 0xa, 0xf, false));   \
    _v += __builtin_bit_cast(float, __builtin_amdgcn_update_dpp(0, __builtin_bit_cast(int, _v), 0x143, 0xc, 0xf, false));   \
    __builtin_bit_cast(float, __builtin_amdgcn_readlane(__builtin_bit_cast(int, _v), 63)); })
__device__ __forceinline__ float wave_sum(float v) { return WAVE_SUM_DPP(v); }
#define WAVE_SCAN_DPP(v) ({ unsigned _v = (v); \
    _v += (unsigned)__builtin_amdgcn_update_dpp(0, (int)_v, 0x111, 0xf, 0xf, false); \
    _v += (unsigned)__builtin_amdgcn_update_dpp(0, (int)_v, 0x112, 0xf, 0xf, false); \
    _v += (unsigned)__builtin_amdgcn_update_dpp(0, (int)_v, 0x114, 0xf, 0xf, false); \
    _v += (unsigned)__builtin_amdgcn_update_dpp(0, (int)_v, 0x118, 0xf, 0xf, false); \
    _v += (unsigned)__builtin_amdgcn_update_dpp(0, (int)_v, 0x142, 0xa, 0xf, false); \
    _v += (unsigned)__builtin_amdgcn_update_dpp(0, (int)_v, 0x143, 0xc, 0xf, false); \
    _v; })

__device__ __forceinline__ float wave_max(float v) {
#pragma unroll
    for (int o = 1; o < 64; o <<= 1) v = fmaxf(v, __shfl_xor(v, o));
    return v;
}
__device__ __forceinline__ float silu_f(float a) { return a / (1.0f + __expf(-a)); }
__device__ __forceinline__ float sigmoid_f(float a) { return 1.0f / (1.0f + __expf(-a)); }
#define LDS_FENCE() asm volatile("s_waitcnt lgkmcnt(0)" ::: "memory")

struct UnitInfo {
    const bf16_t* A; int lda;
    const int* rows; int rshift;
    int nvalid;
    const bf16_t* Bt; int ldb;
    int K;
    int orow0;
    int pn;
};
__device__ __forceinline__ const bf16_t* unit_arow(const UnitInfo& u, int r) {
    if (u.rows) { const int idx = (r < u.nvalid) ? (u.rows[r] >> u.rshift) : 0; return u.A + (size_t)idx * u.lda; }
    return u.A + (size_t)r * u.lda;
}

struct DenseSched {
    const bf16_t* A; const bf16_t* Bt; int M, N, K, lda, a_pn_stride; int reps = 1;
    int wrank = -1, wcount = 0;
    __device__ __forceinline__ bool next(int round, UnitInfo& u) const {
        const int nN = N >> 8, nM = M >> 8, nwg = nN * nM;
        if (wcount > 0 && wrank < 0) return false;
        const long L = (wcount > 0) ? ((long)round * wcount + wrank) : ((long)round * gridDim.x + blockIdx.x); if (L >= (long)nwg * reps) return false;
        int wgid = (int)(L % nwg); { const int q = nwg / 8, r = nwg % 8, xcd = wgid % 8, off = wgid / 8; wgid = (xcd < r ? xcd * (q + 1) : r * (q + 1) + (xcd - r) * q) + off; }
        const int nig = 8 * nN, gid = wgid / nig, fm = gid * 8, gsz = (nM - fm) < 8 ? (nM - fm) : 8;
        const int pm = fm + ((wgid % nig) % gsz), pn = (wgid % nig) / gsz;
        u.A = A + (size_t)pm * 256 * lda + (size_t)pn * a_pn_stride; u.lda = lda; u.rows = nullptr; u.rshift = 0; u.nvalid = 256;
        u.Bt = Bt + (size_t)pn * 256 * K; u.ldb = K; u.K = K; u.orow0 = pm * 256; u.pn = pn;
        return true;
    }
};
struct MoeSched {
    const int* tb; const int* cnt; const int* list;
    const bf16_t* A; const bf16_t* W; int K; size_t wstride; bool gather;
    __device__ __forceinline__ bool next(int round, UnitInfo& u) const {
        const int i = round * gridDim.x + blockIdx.x;
        const int j = i >> 2, pn = i & 3;
        if (j >= tb[32]) return false;
        int e = 0;
        while (tb[e + 1] <= j) ++e;
        const int rb = j - tb[e];
        const int nv = min(256, cnt[e] - rb * 256);
        u.rows = list + (size_t)e * LIST_CAP + rb * 256; u.nvalid = nv; u.orow0 = j * 256; u.pn = pn;
        if (gather) { u.A = A; u.lda = K; u.rshift = 1; }
        else { u.A = A + (size_t)j * 256 * K; u.lda = K; u.rshift = 31;   }
        u.Bt = W + (size_t)e * wstride + (size_t)pn * 256 * K; u.ldb = K; u.K = K;
        return true;
    }
};

template <class Sched, class Epi>
__device__ __forceinline__ void gemm_simple(unsigned char* lds, const Sched& S, const Epi& E, bool contiguousA) {
    float* As = (float*)lds;
    float* Bs = As + 128 * 33;
    const int tid = threadIdx.x, ty = tid >> 3, tx = tid & 7;
    const int lr = tid >> 2, kc = (tid & 3) * 8;
    UnitInfo u;
    for (int round = 0; S.next(round, u); ++round) {
        for (int sm = 0; sm < 2; ++sm) {
            const int ar = sm * 128 + lr;
            const bf16_t* arow = contiguousA ? (u.A + (size_t)ar * u.lda) : unit_arow(u, ar);
            for (int sn = 0; sn < 4; ++sn) {
                float acc[2][8];
#pragma unroll
                for (int a = 0; a < 2; ++a)
#pragma unroll
                    for (int b = 0; b < 8; ++b) acc[a][b] = 0.f;
                const bf16_t* brow = u.Bt + (size_t)(sn * 64 + (tid >> 2)) * u.ldb;
                for (int k0 = 0; k0 < u.K; k0 += 32) {
                    const u32x4 av = *(const u32x4*)(arow + k0 + kc);
                    float* ap = As + lr * 33 + kc;
                    ap[0] = bflo(av.x); ap[1] = bfhi(av.x); ap[2] = bflo(av.y); ap[3] = bfhi(av.y);
                    ap[4] = bflo(av.z); ap[5] = bfhi(av.z); ap[6] = bflo(av.w); ap[7] = bfhi(av.w);
                    if (tid < 256) {
                        const u32x4 bv = *(const u32x4*)(brow + k0 + kc);
                        float* bp = Bs + (tid >> 2) * 33 + kc;
                        bp[0] = bflo(bv.x); bp[1] = bfhi(bv.x); bp[2] = bflo(bv.y); bp[3] = bfhi(bv.y);
                        bp[4] = bflo(bv.z); bp[5] = bfhi(bv.z); bp[6] = bflo(bv.w); bp[7] = bfhi(bv.w);
                    }
                    __syncthreads();
#pragma unroll 8
                    for (int kk = 0; kk < 32; ++kk) {
                        const float a0 = As[(2 * ty) * 33 + kk], a1 = As[(2 * ty + 1) * 33 + kk];
#pragma unroll
                        for (int j = 0; j < 8; ++j) { const float b = Bs[(tx * 8 + j) * 33 + kk]; acc[0][j] += a0 * b; acc[1][j] += a1 * b; }
                    }
                    __syncthreads();
                }
#pragma unroll
                for (int rr = 0; rr < 2; ++rr) {
                    const f32x4 v0 = {acc[rr][0], acc[rr][1], acc[rr][2], acc[rr][3]}, v1 = {acc[rr][4], acc[rr][5], acc[rr][6], acc[rr][7]};
                    E(u, sm * 128 + 2 * ty + rr, sn * 64 + tx * 8, v0, v1);
                }
            }
        }
    }
}


namespace pg8 {
#define LAS __attribute__((address_space(3)))
typedef short bf16x8 __attribute__((ext_vector_type(8)));
constexpr int BK = 64, HALF = 128, HTB = HALF * BK * 2, STAGE_BYTES = 8 * HTB;
__device__ __forceinline__ int lds_byte(int r, int c) { const int st = (r >> 4) * 2 + (c >> 5), rr = r & 15, cc = c & 31, ob = rr * 64 + cc * 2; return st * 1024 + (ob ^ (((ob >> 9) & 1) << 5)); }
__device__ __forceinline__ void stage_rc(int b, int& R, int& C) { const int st = b / 1024, sb = b % 1024, swz = sb ^ (((sb >> 9) & 1) << 5); R = (st >> 1) * 16 + swz / 64; C = (st & 1) * 32 + (swz % 64) / 2; }
__device__ __forceinline__ int perm32(int rho) { const int n = rho >> 4, i = rho & 15; return 8 * (i >> 2) + 4 * n + (i & 3); }

template <bool GATHER, class Sched, class Epi>
__device__ __forceinline__ void gemm_phase(LAS unsigned char* lds, const LAS unsigned* rowtab, const Sched& S, const Epi& E, const int lda, const int ldb, const int K) {
    const int tid = threadIdx.x, wid = __builtin_amdgcn_readfirstlane(tid >> 6), lane = tid & 63, wr = wid >> 2, wc = wid & 3, fr = lane & 15, fq = lane >> 4;
    const int nt = K / BK;
    unsigned voffA[2], voffB[2]; int RA[2]; unsigned CA2[2];
#pragma unroll
    for (int i = 0; i < 2; ++i) { int R, C; stage_rc(tid * 16 + i * 8192, R, C); const int Rb = (R & ~31) + perm32(R & 31);
        voffA[i] = (unsigned)(R * lda + C) * 2u; voffB[i] = (unsigned)(Rb * ldb + C) * 2u; RA[i] = R; CA2[i] = (unsigned)C * 2u; }
    const size_t kstep = (size_t)(BK * 2);
    const size_t hstepA = (size_t)HALF * lda * 2, hstepB = (size_t)HALF * ldb * 2;
    const unsigned ldsw = (unsigned)wid * 1024u;
    const int aoff = lds_byte(wr * 64 + fr, fq * 8), boff = lds_byte(wc * 32 + fr, fq * 8);
    unsigned offA[2][2];
#define PG8_SA(b, h) (((b) * 2 + (h)) * HTB)
#define PG8_SB(b, h) ((4 + (b) * 2 + (h)) * HTB)
#define PG8_STAGE(bufoff, gbase, voff) do { _Pragma("unroll") for (int _i = 0; _i < 2; ++_i) \
        __builtin_amdgcn_global_load_lds((const unsigned*)((const char*)(gbase) + (voff)[_i]), (LAS unsigned*)(lds + (bufoff) + ldsw + _i * 8192), 16, 0, 0); } while (0)
#define PG8_STAGE_A(bufoff, h, gbase) do { if (GATHER) PG8_STAGE(bufoff, gbase, offA[h]); else PG8_STAGE(bufoff, (gbase) + (h) * hstepA, voffA); } while (0)
#define PG8_LOADOFF(round) do { _Pragma("unroll") for (int _h = 0; _h < 2; ++_h) _Pragma("unroll") for (int _i = 0; _i < 2; ++_i) offA[_h][_i] = rowtab[(round) * 256 + _h * 128 + RA[_i]] + CA2[_i]; } while (0)
#define PG8_LDA(dst, b, h) do { _Pragma("unroll") for (int m = 0; m < 4; ++m) _Pragma("unroll") for (int k = 0; k < 2; ++k) dst[m][k] = *(const LAS bf16x8*)(lds + PG8_SA(b, h) + aoff + m * 2048 + k * 1024); } while (0)
#define PG8_LDB(dst, b, h) do { _Pragma("unroll") for (int n = 0; n < 2; ++n) _Pragma("unroll") for (int k = 0; k < 2; ++k) dst[n][k] = *(const LAS bf16x8*)(lds + PG8_SB(b, h) + boff + n * 2048 + k * 1024); } while (0)
#define PG8_MMA(ai, bj, At, Bt) do { __builtin_amdgcn_s_setprio(1); _Pragma("unroll") for (int m = 0; m < 4; ++m) _Pragma("unroll") for (int n = 0; n < 2; ++n) _Pragma("unroll") for (int k = 0; k < 2; ++k) \
        acc[ai][bj][m][n] = __builtin_amdgcn_mfma_f32_16x16x32_bf16(Bt[n][k], At[m][k], acc[ai][bj][m][n], 0, 0, 0); __builtin_amdgcn_s_setprio(0); } while (0)
#define PG8_WAIT_V(n) asm volatile("s_waitcnt vmcnt(" #n ")" ::: "memory")
#define PG8_WAIT_L(n) asm volatile("s_waitcnt lgkmcnt(" #n ")" ::: "memory")
#define PG8_BAR __builtin_amdgcn_s_barrier()
#define PG8_SCHED __builtin_amdgcn_sched_barrier(0)
    UnitInfo cur, nxt; int ui = 0;
    if (!S.next(0, cur)) return;
    f32x4 acc[2][2][4][2];
#pragma unroll
    for (int a = 0; a < 2; ++a)
#pragma unroll
        for (int b = 0; b < 2; ++b)
#pragma unroll
            for (int m = 0; m < 4; ++m)
#pragma unroll
                for (int n = 0; n < 2; ++n) acc[a][b][m][n] = (f32x4){0.f, 0.f, 0.f, 0.f};
    bf16x8 At[4][2], B0[2][2], B1[2][2];
    const char* cA = (const char*)cur.A; const char* cB = (const char*)cur.Bt;
    if (GATHER) { PG8_LOADOFF(0); }
    PG8_STAGE(PG8_SB(0, 0), cB, voffB); PG8_STAGE(PG8_SB(0, 1), cB + hstepB, voffB); PG8_STAGE_A(PG8_SA(0, 0), 0, cA); PG8_STAGE_A(PG8_SA(0, 1), 1, cA);
    if (wr == 1) PG8_BAR;
    PG8_WAIT_V(2); PG8_BAR;
    PG8_STAGE(PG8_SB(1, 0), cB + kstep, voffB); PG8_STAGE_A(PG8_SA(1, 0), 0, cA + kstep); PG8_STAGE(PG8_SB(1, 1), cB + hstepB + kstep, voffB);
    PG8_WAIT_V(6); PG8_BAR;
    for (;;) {
        const bool has_next = S.next(ui + 1, nxt);
        const char* nA = has_next ? (const char*)nxt.A : cA; const char* nB = has_next ? (const char*)nxt.Bt : cB;
        for (int t = 0; t < nt; t += 2) {
            const bool last = (t == nt - 2);
            const char* a1 = cA + (size_t)(t + 1) * kstep;
            const char* a2 = last ? nA : cA + (size_t)(t + 2) * kstep; const char* b2 = last ? nB : cB + (size_t)(t + 2) * kstep;
            const char* a3 = a2 + kstep; const char* b3 = b2 + kstep;
            PG8_LDB(B0, 0, 0); PG8_LDB(B1, 0, 1); PG8_SCHED; PG8_LDA(At, 0, 0); PG8_STAGE_A(PG8_SA(1, 1), 1, a1);
            if (GATHER) { if (last && has_next) { PG8_LOADOFF(ui + 1); } }
            PG8_WAIT_V(8); PG8_WAIT_L(0); PG8_BAR; PG8_MMA(0, 0, At, B0); PG8_MMA(0, 1, At, B1); PG8_BAR; PG8_SCHED;
            PG8_LDA(At, 0, 1); PG8_STAGE(PG8_SB(0, 0), b2, voffB); PG8_STAGE(PG8_SB(0, 1), b2 + hstepB, voffB); PG8_STAGE_A(PG8_SA(0, 0), 0, a2);
            PG8_WAIT_V(8); PG8_WAIT_L(0); PG8_BAR; PG8_MMA(1, 0, At, B0); PG8_MMA(1, 1, At, B1); PG8_BAR; PG8_SCHED;
            PG8_LDB(B0, 1, 0); PG8_LDB(B1, 1, 1); PG8_SCHED; PG8_LDA(At, 1, 0); PG8_STAGE_A(PG8_SA(0, 1), 1, a2);
            PG8_WAIT_V(8); PG8_WAIT_L(0); PG8_BAR; PG8_MMA(0, 0, At, B0); PG8_MMA(0, 1, At, B1); PG8_BAR; PG8_SCHED;
            PG8_LDA(At, 1, 1); PG8_STAGE(PG8_SB(1, 0), b3, voffB); PG8_STAGE(PG8_SB(1, 1), b3 + hstepB, voffB); PG8_STAGE_A(PG8_SA(1, 0), 0, a3);
            PG8_WAIT_V(8); PG8_WAIT_L(0); PG8_BAR; PG8_MMA(1, 0, At, B0); PG8_MMA(1, 1, At, B1); PG8_BAR; PG8_SCHED;
        }
        if (wr == 0) PG8_BAR;
#pragma unroll
        for (int ai = 0; ai < 2; ++ai)
#pragma unroll
            for (int m = 0; m < 4; ++m)
#pragma unroll
                for (int bj = 0; bj < 2; ++bj) E(cur, ai * HALF + wr * 64 + m * 16 + fr, bj * HALF + wc * 32 + 8 * fq, acc[ai][bj][m][0], acc[ai][bj][m][1]);
        if (!has_next) break;
#pragma unroll
        for (int a = 0; a < 2; ++a)
#pragma unroll
            for (int b = 0; b < 2; ++b)
#pragma unroll
                for (int m = 0; m < 4; ++m)
#pragma unroll
                    for (int n = 0; n < 2; ++n) acc[a][b][m][n] = (f32x4){0.f, 0.f, 0.f, 0.f};
        cur = nxt; cA = nA; cB = nB; ++ui;
        if (wr == 1) PG8_BAR;
    }
    PG8_WAIT_V(0);
    PG8_BAR;
#undef PG8_SA
#undef PG8_SB
#undef PG8_STAGE
#undef PG8_STAGE_A
#undef PG8_LOADOFF
#undef PG8_LDA
#undef PG8_LDB
#undef PG8_MMA
#undef PG8_WAIT_V
#undef PG8_WAIT_L
#undef PG8_BAR
#undef PG8_SCHED
}
}

#ifndef USE_PG8_DENSE
#define USE_PG8_DENSE 1
#endif
#ifndef USE_PG8_MOE
#define USE_PG8_MOE 1
#endif
template <class Sched, class Epi>
__device__ __forceinline__ void gemm_dense(unsigned char* lds, const Sched& S, const Epi& E) {
#if USE_PG8_DENSE
    pg8::gemm_phase<false>((LAS unsigned char*)lds, (const LAS unsigned*)nullptr, S, E, S.lda, S.K, S.K);
    __syncthreads();
#else
    gemm_simple(lds, S, E, true);
#endif
}


template <bool GATHER, class Epi>
__device__ __forceinline__ void gemm_moe(unsigned char* lds, const MoeSched& S, const Epi& E) {
#if USE_PG8_MOE
    LAS unsigned* rowtab = (LAS unsigned*)(lds + MISC_OFF + 256);
    if (GATHER) {
        UnitInfo u;
        for (int round = 0; round < 10 && S.next(round, u); ++round)
            if (threadIdx.x < 256) rowtab[round * 256 + threadIdx.x] = ((int)threadIdx.x < u.nvalid) ? (unsigned)(u.rows[threadIdx.x] >> 1) * (unsigned)(S.K * 2) : 0u;
        __syncthreads();
    }
    pg8::gemm_phase<GATHER>((LAS unsigned char*)lds, (const LAS unsigned*)rowtab, S, E, S.K, S.K, S.K);
    __syncthreads();
#else
    gemm_simple(lds, S, E, !GATHER);
#endif
}

__device__ __forceinline__ u32x4 pack8(f32x4 a, f32x4 b) { u32x4 w; w.x = pk2(a.x, a.y); w.y = pk2(a.z, a.w); w.z = pk2(b.x, b.y); w.w = pk2(b.z, b.w); return w; }
struct EpiStoreBf16 {
    bf16_t* O; int ldc; int coff; const float* colscale;
    __device__ __forceinline__ void operator()(const UnitInfo& u, int r, int c, f32x4 v0, f32x4 v1) const {
        const int col = u.pn * 256 + c;
        if (colscale) { const f32x4 s0 = *(const f32x4*)(colscale + col), s1 = *(const f32x4*)(colscale + col + 4); v0 *= s0; v1 *= s1; }
        *(u32x4*)(O + (size_t)(u.orow0 + r) * ldc + coff + col) = pack8(v0, v1);
    }
};

__device__ __forceinline__ float ret_log2g(int h) { return log2f(1.0f - exp2f(-5.0f - (float)h)); }
struct EpiZ0 {
    bf16_t* O;
    __device__ __forceinline__ void operator()(const UnitInfo& u, int r, int c, f32x4 v0, f32x4 v1) const {
        const int col = u.pn * 256 + c, row = u.orow0 + r;
        if (col < 1024) { const float e = ret_log2g((col >> 7) & 3) * (float)(row & 127); const float sc = exp2f(col < 512 ? e : -e); v0 *= sc; v1 *= sc; }
        *(u32x4*)(O + (size_t)row * ZW + col) = pack8(v0, v1);
    }
};

struct EpiStoreF16 {
    unsigned short* O; int ldc;
    __device__ __forceinline__ void operator()(const UnitInfo& u, int r, int c, f32x4 v0, f32x4 v1) const {
        typedef _Float16 h2 __attribute__((ext_vector_type(2)));
        u32x4 w;
        w.x = __builtin_bit_cast(unsigned, (h2){(_Float16)v0.x, (_Float16)v0.y}); w.y = __builtin_bit_cast(unsigned, (h2){(_Float16)v0.z, (_Float16)v0.w});
        w.z = __builtin_bit_cast(unsigned, (h2){(_Float16)v1.x, (_Float16)v1.y}); w.w = __builtin_bit_cast(unsigned, (h2){(_Float16)v1.z, (_Float16)v1.w});
        *(u32x4*)(O + (size_t)(u.orow0 + r) * ldc + u.pn * 256 + c) = w;
    }
};

struct EpiStoreFp8 {
    unsigned char* O; int ldc;
    __device__ __forceinline__ void operator()(const UnitInfo& u, int r, int c, f32x4 v0, f32x4 v1) const {
        int w0 = __builtin_amdgcn_cvt_pk_fp8_f32(v0.x, v0.y, 0, false); w0 = __builtin_amdgcn_cvt_pk_fp8_f32(v0.z, v0.w, w0, true);
        int w1 = __builtin_amdgcn_cvt_pk_fp8_f32(v1.x, v1.y, 0, false); w1 = __builtin_amdgcn_cvt_pk_fp8_f32(v1.z, v1.w, w1, true);
        u32x2 w; w.x = (unsigned)w0; w.y = (unsigned)w1;
        *(u32x2*)(O + (size_t)(u.orow0 + r) * ldc + u.pn * 256 + c) = w;
    }
};
struct EpiResidB {
    const bf16_t* X; bf16_t* Yo;
    __device__ __forceinline__ void operator()(const UnitInfo& u, int r, int c, f32x4 v0, f32x4 v1) const {
        const size_t off = (size_t)(u.orow0 + r) * DM + u.pn * 256 + c;
        const u32x4 xw = *(const u32x4*)(X + off);
        const f32x4 x0 = {bflo(xw.x), bfhi(xw.x), bflo(xw.y), bfhi(xw.y)}, x1 = {bflo(xw.z), bfhi(xw.z), bflo(xw.w), bfhi(xw.w)};
        *(u32x4*)(Yo + off) = pack8(x0 * ALPHA + v0, x1 * ALPHA + v1);
    }
};

struct EpiGU {
    bf16_t* ACT;
    __device__ __forceinline__ void operator()(const UnitInfo& u, int r, int c, f32x4 v0, f32x4 v1) const {
        u32x2 w; w.x = pk2(silu_f(v0.x) * v0.y, silu_f(v0.z) * v0.w); w.y = pk2(silu_f(v1.x) * v1.y, silu_f(v1.z) * v1.w);
        *(u32x2*)(ACT + (size_t)(u.orow0 + r) * 512 + u.pn * 128 + (c >> 1)) = w;
    }
};
struct EpiDown {
    bf16_t* YS;
    __device__ __forceinline__ void operator()(const UnitInfo& u, int r, int c, f32x4 v0, f32x4 v1) const {
        if (r < u.nvalid) { const int pair = u.rows[r]; *(u32x4*)(YS + (size_t)pair * DM + u.pn * 256 + c) = pack8(v0, v1); }
    }
};
struct EpiPle {
    const bf16_t* XI; const bf16_t* PP; float* OUT; bf16_t* XO;
    __device__ __forceinline__ void operator()(const UnitInfo& u, int r, int c, f32x4 v0, f32x4 v1) const {
        const size_t off = (size_t)(u.orow0 + r) * DM + u.pn * 256 + c;
        const u32x4 pw = *(const u32x4*)(PP + off), xw = *(const u32x4*)(XI + off);
        f32x4 f0 = {bflo(xw.x), bfhi(xw.x), bflo(xw.y), bfhi(xw.y)}, f1 = {bflo(xw.z), bfhi(xw.z), bflo(xw.w), bfhi(xw.w)};
        f0.x += sigmoid_f(v0.x) * bflo(pw.x); f0.y += sigmoid_f(v0.y) * bfhi(pw.x); f0.z += sigmoid_f(v0.z) * bflo(pw.y); f0.w += sigmoid_f(v0.w) * bfhi(pw.y);
        f1.x += sigmoid_f(v1.x) * bflo(pw.z); f1.y += sigmoid_f(v1.y) * bfhi(pw.z); f1.z += sigmoid_f(v1.z) * bflo(pw.w); f1.w += sigmoid_f(v1.w) * bfhi(pw.w);
        if (OUT) { *(f32x4*)(OUT + off) = f0; *(f32x4*)(OUT + off + 4) = f1; }
        if (XO) *(u32x4*)(XO + off) = pack8(f0, f1);
    }
};

struct TrDesc { const float* src; bf16_t* dst; int K, N, Nsrc, nbatch, mode, dst_ld; };
struct TrItem { const float* src; bf16_t* dst; int Nsrc, dst_ld, mode, kb, nb; };
__device__ __forceinline__ void tr_load(const TrItem& t, int lane, float (&tmp)[32]) {
    const int k0 = 64 * t.kb, n0 = 32 * t.nb, Ns = t.Nsrc;
    const bool okc = (n0 + (lane & 31)) < Ns;
    const float* p = t.src + (size_t)(k0 + (lane >> 5)) * Ns + n0 + (lane & 31);
#pragma unroll
    for (int i = 0; i < 32; ++i) { tmp[i] = okc ? __builtin_nontemporal_load(p) : 0.f; p += 2 * Ns; asm volatile("" : "+v"(p)); }
}
__device__ __forceinline__ void tr_store(const TrItem& t, float* scr, int lane, const float (&tmp)[32]) {
    const int k0 = 64 * t.kb, n0 = 32 * t.nb;
#pragma unroll
    for (int i = 0; i < 32; ++i) scr[(2 * i + (lane >> 5)) * 33 + (lane & 31)] = tmp[i];
    LDS_FENCE();
    const int c = lane & 7;
#pragma unroll
    for (int j = 0; j < 4; ++j) {
        const int n = (lane >> 3) + 8 * j; const float* sp = scr + (8 * c) * 33 + n;
        const int ng = n0 + n;
        float sc = 1.f; int nd = ng; int coff = 0;
        if (t.mode == 1) { if (ng >= 512 && ng < 1024) sc = 0.08838834764831845f; }
        if (t.mode == 2) { nd = (ng < 512) ? 2 * ng : 2 * (ng - 512) + 1; }
        if (t.mode == 3) { coff = ((ng >> 6) & 3) * 256; }
        u32x4 o; o.x = pk2(sp[0 * 33] * sc, sp[1 * 33] * sc); o.y = pk2(sp[2 * 33] * sc, sp[3 * 33] * sc); o.z = pk2(sp[4 * 33] * sc, sp[5 * 33] * sc); o.w = pk2(sp[6 * 33] * sc, sp[7 * 33] * sc);
        *(u32x4*)(t.dst + (size_t)nd * t.dst_ld + coff + k0 + 8 * c) = o;
    }
    LDS_FENCE();
}
__device__ __forceinline__ int tr_items(const TrDesc& d) { return d.nbatch * (d.K / 64) * (d.N / 32); }

constexpr int N_DEFERRED = 32 * 512 + 32 * 256;
__device__ __forceinline__ TrItem deferred_item(const Params& P, int idx) {
    TrItem t;
    if (idx < 32 * 512) { const int b = 32 + (idx >> 9), r = idx & 511;
        t.src = P.in[22] + (size_t)b * 1024 * 1024; t.dst = (bf16_t*)(P.ws + WS_W_GU) + (size_t)b * 1024 * 1024; t.Nsrc = 1024; t.dst_ld = 1024; t.mode = 2; t.kb = r >> 5; t.nb = r & 31; }
    else { const int i2 = idx - 32 * 512, b = 32 + (i2 >> 8), r = i2 & 255;
        t.src = P.in[23] + (size_t)b * 512 * 1024; t.dst = (bf16_t*)(P.ws + WS_W_DN) + (size_t)b * 1024 * 512; t.Nsrc = 1024; t.dst_ld = 512; t.mode = 0; t.kb = r >> 5; t.nb = r & 31; }
    return t;
}
__device__ __forceinline__ void phase_prep(const Params& P, unsigned char* lds) {
    unsigned char* ws = P.ws;
    const int tid = threadIdx.x, lane = tid & 63, wave = tid >> 6;
    const int gw = blockIdx.x * NWAVE + wave, NGW = gridDim.x * NWAVE;
    float* scr = (float*)lds + wave * (64 * 33);
    constexpr int ND = 9;
    TrDesc d[ND];
    d[0] = {P.in[22], (bf16_t*)(ws + WS_W_GU), 1024, 1024, 1024, 32, 2, 1024};
    d[1] = {P.in[23], (bf16_t*)(ws + WS_W_DN), 512, 1024, 1024, 32, 0, 512};
    d[2] = {P.in[2], (bf16_t*)(ws + WS_W_IN0), 1024, 2560, 2560, 1, 1, 1024};
    d[3] = {P.in[6], (bf16_t*)(ws + WS_W_OUT0), 1024, 1024, 1024, 1, 0, 1024};
    d[4] = {P.in[13], (bf16_t*)(ws + WS_W_COUT), 1024, 1024, 1024, 1, 0, 1024};
    d[5] = {P.in[24], (bf16_t*)(ws + WS_W_G), 1024, 1024, 1024, 2, 0, 1024};
    d[6] = {P.in[25], (bf16_t*)(ws + WS_W_P), 256, 1024, 1024, 2, 0, 256};
    d[7] = {P.in[7], (bf16_t*)(ws + WS_W_CIN), 1024, Z1W, CIN, 1, 0, 1024};
    d[8] = {P.in[12], (bf16_t*)(ws + WS_W_UVBD), 256, 1024, 1024, 1, 3, 1024};
    int total = 0;
#pragma unroll
    for (int i = 0; i < ND; ++i) total += tr_items(d[i]);
#define TR_DECODE(it, T) do { int _r = (it); bool _f = false; T = TrItem{nullptr, nullptr, 0, 0, 0, 0, 0}; _Pragma("unroll") for (int _i = 0; _i < ND; ++_i) { const int _n = tr_items(d[_i]); \
            if (!_f && _r < _n) { _f = true; const int _per = (d[_i].K / 64) * (d[_i].N / 32), _b = _r / _per, _q = _r % _per, _nblk = d[_i].N / 32; \
                T.src = d[_i].src + (size_t)_b * d[_i].K * d[_i].Nsrc; T.dst = d[_i].dst + (size_t)_b * d[_i].N * d[_i].dst_ld; T.Nsrc = d[_i].Nsrc; T.dst_ld = d[_i].dst_ld; T.mode = d[_i].mode; T.kb = _q / _nblk; T.nb = _q % _nblk; } \
            if (!_f) _r -= _n; } } while (0)
    {
        float cur[32], nxt[32];
        TrItem tc, tn;
        int it = gw;
        if (it < total) { TR_DECODE(it, tc); tr_load(tc, lane, cur); }
        while (it < total) {
            const int itn = it + NGW;
            if (itn < total) { TR_DECODE(itn, tn); tr_load(tn, lane, nxt); }
            tr_store(tc, scr, lane, cur);
#pragma unroll
            for (int i = 0; i < 32; ++i) cur[i] = nxt[i];
            it = itn; tc = tn;
        }
    }
#undef TR_DECODE
    const size_t gt = (size_t)blockIdx.x * NT + tid, GS = (size_t)gridDim.x * NT;
    {
        bf16_t* o = (bf16_t*)(ws + WS_W_POOL); const float* pw = P.in[4];
        for (size_t i = gt; i < 512 * 256; i += GS) { const int n = (int)(i >> 8), k = (int)(i & 255), g = n >> 7, dd = n & 127, kg = k >> 7, c = k & 127;
            o[i] = (bf16_t)((kg == (g & 1)) ? f2bf(pw[((size_t)g * 128 + c) * 128 + dd]) : 0u); }
    }
    {
        u32x4* o = (u32x4*)(ws + WS_W_UVBD);
        for (size_t i = gt; i < (size_t)1024 * 1024 / 8; i += GS) { const int n = (int)(i >> 7), k = (int)(i & 127) * 8; if (((n >> 6) & 3) != (k >> 8)) o[i] = (u32x4){0u, 0u, 0u, 0u}; }
    }
    {
        bf16_t* o = (bf16_t*)(ws + WS_W_QA); const float* uq = P.in[10]; const float* uk = P.in[11];
        float* Bq = (float*)lds; float* Ak = Bq + 256 * 65;
        for (int item = blockIdx.x; item < 128; item += gridDim.x) {
            const int h = item >> 3, c0 = (item & 7) * 32;
            __syncthreads();
            for (int i = tid; i < 256 * 16; i += NT) { const int r = i >> 4, d4 = (i & 15) * 4; const f32x4 v = *(const f32x4*)(uq + (size_t)r * 1024 + h * 64 + d4);
                float* q = Bq + r * 65 + d4; q[0] = v.x; q[1] = v.y; q[2] = v.z; q[3] = v.w; }
            for (int i = tid; i < 32 * 16; i += NT) { const int c = i >> 4, d4 = (i & 15) * 4; const f32x4 v = *(const f32x4*)(uk + (size_t)(c0 + c) * 1024 + h * 64 + d4);
                float* q = Ak + c * 65 + d4; q[0] = v.x; q[1] = v.y; q[2] = v.z; q[3] = v.w; }
            __syncthreads();
            const int r = tid & 255, cg = tid >> 8;
            float acc[16];
#pragma unroll
            for (int j = 0; j < 16; ++j) acc[j] = 0.f;
            for (int dd = 0; dd < 64; ++dd) { const float bv = Bq[r * 65 + dd];
#pragma unroll
                for (int j = 0; j < 16; ++j) acc[j] += Ak[(cg * 16 + j) * 65 + dd] * bv; }
#pragma unroll
            for (int j = 0; j < 16; ++j) o[(size_t)(h * 256 + c0 + cg * 16 + j) * 256 + r] = (bf16_t)f2bf(acc[j] * 0.125f);
        }
        __syncthreads();
    }
    {
        bf16_t* GT = (bf16_t*)(ws + WS_GT); float* SGB = (float*)(ws + WS_SGB);
        for (size_t i = gt; i < (size_t)2 * 48 * 1024; i += GS) {
            const int l = (int)(i / (48 * 1024)), j = (int)((i / 1024) % 48), c = (int)(i & 1023);
            float w = 0.f;
            if (j < 4) w = P.in[18][(size_t)l * DM * 4 + (size_t)c * 4 + j]; else if (j < 36) w = P.in[20][(size_t)l * DM * 32 + (size_t)c * 32 + (j - 4)];
            const float g = P.in[14][l * DM + c] * w;
            const unsigned hi = f2bf(g); const unsigned lo = f2bf(g - bf2f(hi));
            GT[((size_t)(l * 2 + 0) * 48 + j) * 1024 + c] = (bf16_t)hi; GT[((size_t)(l * 2 + 1) * 48 + j) * 1024 + c] = (bf16_t)lo;
        }
        for (int it = gw; it < 96; it += NGW) {
            const int l = it / 48, j = it % 48; float sg = 0.f, sb = 0.f;
            for (int c = lane; c < 1024; c += 64) {
                float w = 0.f;
                if (j < 4) w = P.in[18][(size_t)l * DM * 4 + (size_t)c * 4 + j]; else if (j < 36) w = P.in[20][(size_t)l * DM * 32 + (size_t)c * 32 + (j - 4)];
                sg += P.in[14][l * DM + c] * w; sb += P.in[15][l * DM + c] * w;
            }
            sg = wave_sum(sg); sb = wave_sum(sb);
            const float bias = (j < 4) ? P.in[19][l * 4 + j] : ((j < 36) ? P.in[21][l * 32 + (j - 4)] : 0.f);
            if (lane == 0) { SGB[(l * 2 + 0) * 48 + j] = sg; SGB[(l * 2 + 1) * 48 + j] = sb + bias; }
        }
    }
    {
        const f32x4* x = (const f32x4*)P.in[0]; u32x4* xb = (u32x4*)(ws + WS_XB);
        const size_t nx = (size_t)NTOK * DM / 8, np = (size_t)2 * NTOK * 256 / 8;
        size_t i = gt;
        for (; i + 3 * GS < nx; i += 4 * GS) { f32x4 a[8];
#pragma unroll
            for (int q = 0; q < 4; ++q) { a[2 * q] = __builtin_nontemporal_load(x + 2 * (i + q * GS)); a[2 * q + 1] = __builtin_nontemporal_load(x + 2 * (i + q * GS) + 1); }
#pragma unroll
            for (int q = 0; q < 4; ++q) xb[i + q * GS] = pack8(a[2 * q], a[2 * q + 1]); }
        for (; i < nx; i += GS) xb[i] = pack8(x[2 * i], x[2 * i + 1]);
        const f32x4* p = (const f32x4*)P.in[1]; u32x4* pb = (u32x4*)(ws + WS_PB);
        i = gt;
        for (; i + 3 * GS < np; i += 4 * GS) { f32x4 a[8];
#pragma unroll
            for (int q = 0; q < 4; ++q) { a[2 * q] = __builtin_nontemporal_load(p + 2 * (i + q * GS)); a[2 * q + 1] = __builtin_nontemporal_load(p + 2 * (i + q * GS) + 1); }
#pragma unroll
            for (int q = 0; q < 4; ++q) pb[i + q * GS] = pack8(a[2 * q], a[2 * q + 1]); }
        for (; i < np; i += GS) pb[i] = pack8(p[2 * i], p[2 * i + 1]);
    }
}

__device__ __forceinline__ float ret_logg(int h) { return log1pf(-exp2f(-5.0f - (float)h)); }

__device__ __forceinline__ void phase_ret_kv(const Params& P, unsigned char* lds) {
    const bf16_t* Z0 = (const bf16_t*)(P.ws + WS_Z0); float* KV = (float*)(P.ws + WS_KV);
    float* Ks = (float*)lds; float* Vs = Ks + 128 * 128;
    const int tid = threadIdx.x;
    for (int u = blockIdx.x; u < 1024; u += gridDim.x) {
        const int n = u & 63, h = (u >> 6) & 3, b = u >> 8;
        const float lg = ret_logg(h);
        const size_t row0 = (size_t)b * SEQ + n * 128;
        for (int i = tid; i < 128 * 16; i += NT) {
            const int r = i >> 4, c8 = (i & 15) * 8;
            const u32x4 kv = *(const u32x4*)(Z0 + (row0 + r) * ZW + 512 + h * 128 + c8);
            const u32x4 vv = *(const u32x4*)(Z0 + (row0 + r) * ZW + 1024 + h * 128 + c8);
            const float dec = __expf(lg * (float)(127 - r));
            float* kp = Ks + r * 128 + c8; float* vp = Vs + r * 128 + c8;
            kp[0] = bflo(kv.x) * dec; kp[1] = bfhi(kv.x) * dec; kp[2] = bflo(kv.y) * dec; kp[3] = bfhi(kv.y) * dec;
            kp[4] = bflo(kv.z) * dec; kp[5] = bfhi(kv.z) * dec; kp[6] = bflo(kv.w) * dec; kp[7] = bfhi(kv.w) * dec;
            vp[0] = bflo(vv.x); vp[1] = bfhi(vv.x); vp[2] = bflo(vv.y); vp[3] = bfhi(vv.y);
            vp[4] = bflo(vv.z); vp[5] = bfhi(vv.z); vp[6] = bflo(vv.w); vp[7] = bfhi(vv.w);
        }
        __syncthreads();
        const int dd = tid >> 2, v0 = (tid & 3) * 32;
        float acc[32];
#pragma unroll
        for (int j = 0; j < 32; ++j) acc[j] = 0.f;
        for (int i = 0; i < 128; ++i) {
            const float kd = Ks[i * 128 + dd];
#pragma unroll
            for (int j = 0; j < 32; j += 4) { const f32x4 vv = *(const f32x4*)(Vs + i * 128 + v0 + j); acc[j] += kd * vv.x; acc[j + 1] += kd * vv.y; acc[j + 2] += kd * vv.z; acc[j + 3] += kd * vv.w; }
        }
        float* o = KV + (size_t)u * 16384 + dd * 128 + v0;
#pragma unroll
        for (int j = 0; j < 32; j += 4) *(f32x4*)(o + j) = (f32x4){acc[j], acc[j + 1], acc[j + 2], acc[j + 3]};
        __syncthreads();
    }
}
__device__ __forceinline__ void phase_ret_scan_pool(const Params& P) {
    float* KV = (float*)(P.ws + WS_KV);
    const size_t gt = (size_t)blockIdx.x * NT + threadIdx.x, GS = (size_t)gridDim.x * NT;
    for (size_t i = gt; i < (size_t)16 * 4096; i += GS) {
        const int s = (int)(i >> 12), e4 = (int)(i & 4095), h = s & 3;
        const float cd = __expf(ret_logg(h) * 128.0f);
        f32x4* p = (f32x4*)(KV + (size_t)s * 64 * 16384) + e4;
        f32x4 R = {0.f, 0.f, 0.f, 0.f};
        for (int n0 = 0; n0 < 64; n0 += 8) {
            f32x4 kv[8];
#pragma unroll
            for (int j = 0; j < 8; ++j) kv[j] = p[(size_t)(n0 + j) * 4096];
#pragma unroll
            for (int j = 0; j < 8; ++j) { p[(size_t)(n0 + j) * 4096] = R; R = R * cd + kv[j]; }
        }
    }
    const bf16_t* Z0 = (const bf16_t*)(P.ws + WS_Z0); bf16_t* DP = (bf16_t*)(P.ws + WS_DP);
    for (size_t i = gt; i < (size_t)NTOK * 64; i += GS) {
        const int t = (int)(i >> 6), c8 = (int)(i & 63) * 8, g = c8 >> 7, w = 2 << g, tl = t & (SEQ - 1);
        const int cnt = min(tl + 1, w);
        float s[8];
#pragma unroll
        for (int j = 0; j < 8; ++j) s[j] = 0.f;
        float u0[8];
        for (int q = 0; q < cnt; ++q) {
            const u32x4 v = *(const u32x4*)(Z0 + (size_t)(t - q) * ZW + 2048 + c8);
            const float f[8] = {bflo(v.x), bfhi(v.x), bflo(v.y), bfhi(v.y), bflo(v.z), bfhi(v.z), bflo(v.w), bfhi(v.w)};
#pragma unroll
            for (int j = 0; j < 8; ++j) { s[j] += f[j]; if (q == 0) u0[j] = f[j]; }
        }
        const float inv = 1.0f / (float)cnt;
        u32x4 o; o.x = pk2(s[0] * inv - u0[0], s[1] * inv - u0[1]); o.y = pk2(s[2] * inv - u0[2], s[3] * inv - u0[3]);
        o.z = pk2(s[4] * inv - u0[4], s[5] * inv - u0[5]); o.w = pk2(s[6] * inv - u0[6], s[7] * inv - u0[7]);
        *(u32x4*)(DP + (size_t)t * 512 + c8) = o;
    }
}
__device__ __forceinline__ void phase_ret_out(const Params& P, unsigned char* lds) {
    const bf16_t* Z0 = (const bf16_t*)(P.ws + WS_Z0); const float* KV = (const float*)(P.ws + WS_KV); bf16_t* MIX = (bf16_t*)(P.ws + WS_MIX);
    const float* gn = P.in[3];
    bf16_t* Qs = (bf16_t*)lds;
    bf16_t* Ksm = Qs + 128 * 136;
    float* Sc = (float*)(lds + 2 * 128 * 136 * 2);
    const int tid = threadIdx.x;
    for (int u = blockIdx.x; u < 1024; u += gridDim.x) {
        const int n = u & 63, h = (u >> 6) & 3, b = u >> 8;
        const float lg = ret_logg(h);
        const size_t row0 = (size_t)b * SEQ + n * 128;
        for (int i = tid; i < 128 * 16; i += NT) {
            const int r = i >> 4, c8 = (i & 15) * 8;
            *(u32x4*)(Qs + r * 136 + c8) = *(const u32x4*)(Z0 + (row0 + r) * ZW + h * 128 + c8);
            *(u32x4*)(Ksm + r * 136 + c8) = *(const u32x4*)(Z0 + (row0 + r) * ZW + 512 + h * 128 + c8);
        }
        __syncthreads();
        for (int e = tid; e < 128 * 128; e += NT) {
            const int i = e >> 7, j = e & 127;
            float s = 0.f;
            if (j <= i) {
                const bf16_t* q = Qs + i * 136; const bf16_t* k = Ksm + j * 136;
                for (int dd = 0; dd < 128; dd += 2) { const unsigned qa = *(const unsigned*)(q + dd), ka = *(const unsigned*)(k + dd); s += bflo(qa) * bflo(ka) + bfhi(qa) * bfhi(ka); }
                s *= __expf(lg * (float)(i - j));
            }
            Sc[e] = s;
        }
        __syncthreads();
        const int i = tid >> 2, v0 = (tid & 3) * 32;
        float acc[32];
#pragma unroll
        for (int j = 0; j < 32; ++j) acc[j] = 0.f;
        for (int j = 0; j <= i; ++j) {
            const float s = Sc[i * 128 + j];
            const bf16_t* vr = Z0 + (row0 + j) * ZW + 1024 + h * 128 + v0;
#pragma unroll
            for (int q = 0; q < 4; ++q) { const u32x4 vv = *(const u32x4*)(vr + q * 8);
                acc[q * 8 + 0] += s * bflo(vv.x); acc[q * 8 + 1] += s * bfhi(vv.x); acc[q * 8 + 2] += s * bflo(vv.y); acc[q * 8 + 3] += s * bfhi(vv.y);
                acc[q * 8 + 4] += s * bflo(vv.z); acc[q * 8 + 5] += s * bfhi(vv.z); acc[q * 8 + 6] += s * bflo(vv.w); acc[q * 8 + 7] += s * bfhi(vv.w); }
        }
        const float qdec = __expf(lg * (float)(i + 1));
        const float* S = KV + (size_t)u * 16384;
        for (int dd = 0; dd < 128; ++dd) {
            const float qd = bf2f(Qs[i * 136 + dd]) * qdec;
            const float* sr = S + dd * 128 + v0;
#pragma unroll
            for (int q = 0; q < 32; q += 4) { const f32x4 sv = *(const f32x4*)(sr + q); acc[q] += qd * sv.x; acc[q + 1] += qd * sv.y; acc[q + 2] += qd * sv.z; acc[q + 3] += qd * sv.w; }
        }
        float sm = 0.f;
#pragma unroll
        for (int j = 0; j < 32; ++j) sm += acc[j];
        sm += __shfl_xor(sm, 1); sm += __shfl_xor(sm, 2);
        const float mu = sm * (1.0f / 128.0f);
        float sq = 0.f;
#pragma unroll
        for (int j = 0; j < 32; ++j) { const float dlt = acc[j] - mu; sq += dlt * dlt; }
        sq += __shfl_xor(sq, 1); sq += __shfl_xor(sq, 2);
        const float rstd = 1.0f / sqrtf(sq * (1.0f / 128.0f) + LN_EPS);
        const bf16_t* gr = Z0 + (row0 + i) * ZW + 1536 + h * 128 + v0;
        bf16_t* orow = MIX + (row0 + i) * DM + h * 128 + v0;
#pragma unroll
        for (int q = 0; q < 4; ++q) {
            const u32x4 gv = *(const u32x4*)(gr + q * 8);
            const float g8[8] = {bflo(gv.x), bfhi(gv.x), bflo(gv.y), bfhi(gv.y), bflo(gv.z), bfhi(gv.z), bflo(gv.w), bfhi(gv.w)};
            float o8[8];
#pragma unroll
            for (int j = 0; j < 8; ++j) o8[j] = (acc[q * 8 + j] - mu) * rstd * gn[h * 128 + v0 + q * 8 + j] * silu_f(g8[j]);
            u32x4 w; w.x = pk2(o8[0], o8[1]); w.y = pk2(o8[2], o8[3]); w.z = pk2(o8[4], o8[5]); w.w = pk2(o8[6], o8[7]);
            *(u32x4*)(orow + q * 8) = w;
        }
        __syncthreads();
    }
}

template <bool DRY>
__device__ __forceinline__ void phase_ln_route(const Params& P, unsigned char* lds, int layer) {
    using pg8::bf16x8;
    const bf16_t* F = (const bf16_t*)(P.ws + WS_F); bf16_t* XB = (bf16_t*)(P.ws + (DRY ? WS_M0 + 128 * MiB : WS_XB));
    float* TOKG = (float*)(P.ws + WS_TOKG); int* LIST = (int*)(P.ws + WS_LIST);
    int* CNT = (int*)(P.ws + WS_CTL) + layer * 64;
    const float* lg = P.in[14] + layer * DM; const float* lb = P.in[15] + layer * DM;
    const bf16_t* GTh = (const bf16_t*)(P.ws + WS_GT) + (size_t)(layer * 2) * 48 * 1024; const bf16_t* GTl = GTh + 48 * 1024;
    const float* SG = (const float*)(P.ws + WS_SGB) + (layer * 2) * 48; const float* BB = SG + 48;
    const int tid = threadIdx.x, lane = tid & 63, wave = tid >> 6, r16 = lane & 15, g = lane >> 4;
    int* dec = (int*)lds;
    int* rank = dec + 256;
    int* lcnt = rank + 256;
    int* lbase = lcnt + 32;
    float* stat = (float*)(lds + 4096) + wave * 32;
    float* LG = (float*)(lds + 8192) + wave * (16 * 48);
    f32x4 g4[4], b4[4];
#pragma unroll
    for (int j = 0; j < 4; ++j) { g4[j] = *(const f32x4*)(lg + 256 * j + 4 * lane); b4[j] = *(const f32x4*)(lb + 256 * j + 4 * lane); }
    for (int rb = blockIdx.x; rb < NTOK / 128; rb += gridDim.x) {
        if (tid < 32) lcnt[tid] = 0;
        __syncthreads();
        const int tbase = rb * 128 + wave * 16;
        f32x4 acc[3];
#pragma unroll
        for (int i = 0; i < 3; ++i) acc[i] = (f32x4){0.f, 0.f, 0.f, 0.f};
        float sm = 0.f, sq = 0.f;
        const bf16_t* yrow = F + (size_t)(tbase + r16) * DM + 8 * g;
        const bf16_t* ghp = GTh + (size_t)r16 * 1024 + 8 * g; const bf16_t* glp = GTl + (size_t)r16 * 1024 + 8 * g;
#pragma unroll 2
        for (int k = 0; k < 32; ++k) {
            const u32x4 yw = *(const u32x4*)(yrow + 32 * k);
            bf16x8 gh[3], gl[3];
#pragma unroll
            for (int i = 0; i < 3; ++i) { gh[i] = *(const bf16x8*)(ghp + (size_t)i * 16 * 1024 + 32 * k); gl[i] = *(const bf16x8*)(glp + (size_t)i * 16 * 1024 + 32 * k); }
            const float y0 = bflo(yw.x), y1 = bfhi(yw.x), y2 = bflo(yw.y), y3 = bfhi(yw.y), y4 = bflo(yw.z), y5 = bfhi(yw.z), y6 = bflo(yw.w), y7 = bfhi(yw.w);
            sm += (y0 + y1) + (y2 + y3) + (y4 + y5) + (y6 + y7);
            sq += (y0 * y0 + y1 * y1) + (y2 * y2 + y3 * y3) + (y4 * y4 + y5 * y5) + (y6 * y6 + y7 * y7);
            const bf16x8 yh = __builtin_bit_cast(bf16x8, yw);
#pragma unroll
            for (int i = 0; i < 3; ++i) {
                acc[i] = __builtin_amdgcn_mfma_f32_16x16x32_bf16(yh, gh[i], acc[i], 0, 0, 0);
                acc[i] = __builtin_amdgcn_mfma_f32_16x16x32_bf16(yh, gl[i], acc[i], 0, 0, 0);
            }
        }
        sm += __shfl_xor(sm, 16); sm += __shfl_xor(sm, 32); sq += __shfl_xor(sq, 16); sq += __shfl_xor(sq, 32);
        const float mean = sm * (1.0f / DM), var = fmaxf(sq * (1.0f / DM) - mean * mean, 0.f), rstd = 1.0f / sqrtf(var + LN_EPS);
        if (g == 0) { stat[r16 * 2] = mean; stat[r16 * 2 + 1] = rstd; }
        LDS_FENCE();
#pragma unroll
        for (int i = 0; i < 3; ++i) { const float sg = SG[16 * i + r16], bb = BB[16 * i + r16];
#pragma unroll
            for (int r = 0; r < 4; ++r) { const float mu = stat[(4 * g + r) * 2], rs = stat[(4 * g + r) * 2 + 1];
                LG[(4 * g + r) * 48 + 16 * i + r16] = rs * (acc[i][r] - mu * sg) + bb; } }
        LDS_FENCE();
        if (lane < 16) {
            const float* lr = LG + lane * 48; const int rl = wave * 16 + lane, t = tbase + lane;
            float gl4[4];
#pragma unroll
            for (int j = 0; j < 4; ++j) gl4[j] = lr[j];
            int grp = 0; float gm = gl4[0];
#pragma unroll
            for (int j = 1; j < 4; ++j) if (gl4[j] > gm) { gm = gl4[j]; grp = j; }
            float gs = 0.f;
#pragma unroll
            for (int j = 0; j < 4; ++j) gs += __expf(gl4[j] - gm);
            const float gwt = 1.0f / gs;
            float el[8];
#pragma unroll
            for (int j = 0; j < 8; ++j) el[j] = lr[4 + grp * 8 + j];
            int i0 = 0; float m0 = el[0];
#pragma unroll
            for (int j = 1; j < 8; ++j) if (el[j] > m0) { m0 = el[j]; i0 = j; }
            int i1 = -1; float m1 = -INFINITY;
#pragma unroll
            for (int j = 0; j < 8; ++j) if (j != i0 && el[j] > m1) { m1 = el[j]; i1 = j; }
            const float ex = __expf(m1 - m0);
            const float p0 = 1.0f / (1.0f + ex), p1 = ex / (1.0f + ex);
            dec[rl * 2] = grp * 8 + i0; dec[rl * 2 + 1] = grp * 8 + i1;
            if (!DRY) { TOKG[(size_t)t * 2] = gwt * p0; TOKG[(size_t)t * 2 + 1] = gwt * p1; }
        }
#pragma unroll 4
        for (int r = 0; r < 16; ++r) {
            const float mu = stat[r * 2], rs = stat[r * 2 + 1];
            const bf16_t* fr = F + (size_t)(tbase + r) * DM + 4 * lane; bf16_t* xo = XB + (size_t)(tbase + r) * DM + 4 * lane;
#pragma unroll
            for (int j = 0; j < 4; ++j) { const u32x2 yw = *(const u32x2*)(fr + 256 * j); const f32x4 y = {bflo(yw.x), bfhi(yw.x), bflo(yw.y), bfhi(yw.y)};
                const f32x4 v = (y - mu) * rs * g4[j] + b4[j];
                u32x2 w; w.x = pk2(v.x, v.y); w.y = pk2(v.z, v.w); *(u32x2*)(xo + 256 * j) = w; }
        }
        __syncthreads();
        if (tid < 256) rank[tid] = atomicAdd(&lcnt[dec[tid]], 1);
        __syncthreads();
        if (tid < 32) lbase[tid] = DRY ? 0 : atomicAdd(&CNT[tid], lcnt[tid]);
        __syncthreads();
        if (!DRY && tid < 256) { const int e = dec[tid]; LIST[(size_t)e * LIST_CAP + lbase[e] + rank[tid]] = (rb * 128 + (tid >> 1)) * 2 + (tid & 1); }
        __syncthreads();
    }
}
__device__ __forceinline__ void moe_setup(const Params& P, int* tb, int layer) {
    const int* CNT = (const int*)(P.ws + WS_CTL) + layer * 64;
    if (threadIdx.x == 0) { int a = 0; for (int e = 0; e < 32; ++e) { tb[e] = a; a += (CNT[e] + 255) >> 8; } tb[32] = a; }
    __syncthreads();
}
template <bool DRY>
__device__ __forceinline__ void phase_ln2(const Params& P, int layer) {
    const bf16_t* XI = (const bf16_t*)(P.ws + WS_XB); bf16_t* XO = (bf16_t*)(P.ws + (DRY ? WS_XB2 : WS_XB));
    const bf16_t* YS = (const bf16_t*)(P.ws + WS_YS); const float* TOKG = (const float*)(P.ws + WS_TOKG);
    const float* lg = P.in[16] + layer * DM; const float* lb = P.in[17] + layer * DM;
    const int lane = threadIdx.x & 63, gw = blockIdx.x * NWAVE + (threadIdx.x >> 6), NGW = gridDim.x * NWAVE;
    f32x4 g4[4], b4[4];
#pragma unroll
    for (int j = 0; j < 4; ++j) { g4[j] = *(const f32x4*)(lg + 256 * j + 4 * lane); b4[j] = *(const f32x4*)(lb + 256 * j + 4 * lane); }
    u32x2 nx[4], na[4], nb[4]; float ng0 = 0.f, ng1 = 0.f;
    if (gw < NTOK) { const int t = gw;
#pragma unroll
        for (int j = 0; j < 4; ++j) { const int c0 = 256 * j + 4 * lane; nx[j] = *(const u32x2*)(XI + (size_t)t * DM + c0); na[j] = *(const u32x2*)(YS + (size_t)(2 * t) * DM + c0); nb[j] = *(const u32x2*)(YS + (size_t)(2 * t + 1) * DM + c0); }
        ng0 = TOKG[(size_t)t * 2]; ng1 = TOKG[(size_t)t * 2 + 1]; }
    for (int t = gw; t < NTOK; t += NGW) {
        const float g0 = ng0, g1 = ng1;
        u32x2 xw[4], aw[4], bw[4];
#pragma unroll
        for (int j = 0; j < 4; ++j) { xw[j] = nx[j]; aw[j] = na[j]; bw[j] = nb[j]; }
        if (t + NGW < NTOK) { const int tn = t + NGW;
#pragma unroll
            for (int j = 0; j < 4; ++j) { const int c0 = 256 * j + 4 * lane; nx[j] = *(const u32x2*)(XI + (size_t)tn * DM + c0); na[j] = *(const u32x2*)(YS + (size_t)(2 * tn) * DM + c0); nb[j] = *(const u32x2*)(YS + (size_t)(2 * tn + 1) * DM + c0); }
            ng0 = TOKG[(size_t)tn * 2]; ng1 = TOKG[(size_t)tn * 2 + 1]; }
        f32x4 v[4]; float s = 0.f;
#pragma unroll
        for (int j = 0; j < 4; ++j) {
            const u32x2 x = xw[j], a = aw[j], b = bw[j];
            v[j].x = bflo(x.x) * ALPHA + g0 * bflo(a.x) + g1 * bflo(b.x); v[j].y = bfhi(x.x) * ALPHA + g0 * bfhi(a.x) + g1 * bfhi(b.x);
            v[j].z = bflo(x.y) * ALPHA + g0 * bflo(a.y) + g1 * bflo(b.y); v[j].w = bfhi(x.y) * ALPHA + g0 * bfhi(a.y) + g1 * bfhi(b.y);
            s += (v[j].x + v[j].y) + (v[j].z + v[j].w); }
        const float mean = wave_sum(s) * (1.0f / DM); float s2 = 0.f;
#pragma unroll
        for (int j = 0; j < 4; ++j) { v[j] = v[j] - mean; s2 += (v[j].x * v[j].x + v[j].y * v[j].y) + (v[j].z * v[j].z + v[j].w * v[j].w); }
        const float rstd = 1.0f / sqrtf(wave_sum(s2) * (1.0f / DM) + LN_EPS);
#pragma unroll
        for (int j = 0; j < 4; ++j) { const int c0 = 256 * j + 4 * lane;
            v[j] = v[j] * rstd * g4[j] + b4[j];
            u32x2 w; w.x = pk2(v[j].x, v[j].y); w.y = pk2(v[j].z, v[j].w); *(u32x2*)(XO + (size_t)t * DM + c0) = w; }
    }
}

__device__ __forceinline__ unsigned f8enc(float y) {
    const unsigned u = __float_as_uint(y), sg = (u >> 24) & 0x80u;
    unsigned a = u & 0x7fffffffu;
    a = max(a, 0x3c000000u); a = min(a, 0x43f00000u);
    a = a + 0x0007ffffu + ((a >> 20) & 1u);
    const unsigned c = min(a >> 20, (135u << 3) | 7u) - (120u << 3);
    return sg | c;
}
__device__ __forceinline__ unsigned e5m2enc(float y) {
    const unsigned hb = (unsigned)__builtin_bit_cast(unsigned short, (_Float16)y);
    return ((hb + 0x7fu + ((hb >> 8) & 1u)) >> 8) & 0xffu;
}
__device__ __forceinline__ unsigned f8dec2(unsigned e) {
    const unsigned t = (e << 4) + 0x3c003c00u;
    return __umul24(e & 0x00800080u, 240u) + t;
}
__device__ __forceinline__ void phase_norms(const Params& P) {
    const bf16_t* Z1 = (const bf16_t*)(P.ws + WS_Z1); bf16_t* CQ = (bf16_t*)(P.ws + WS_CQ); bf16_t* CKV = (bf16_t*)(P.ws + WS_CKV); unsigned char* CKV8 = (unsigned char*)(P.ws + WS_CKV8);
    const float* qn = P.in[8]; const float* kn = P.in[9];
    const int lane = threadIdx.x & 63, gw = blockIdx.x * NWAVE + (threadIdx.x >> 6), NGW = gridDim.x * NWAVE;
    for (int t = gw; t < NTOK; t += NGW) {
        const u32x2 a = *(const u32x2*)(Z1 + (size_t)t * Z1W + 4 * lane), b = *(const u32x2*)(Z1 + (size_t)t * Z1W + 256 + 4 * lane);
        const float q[4] = {bflo(a.x), bfhi(a.x), bflo(a.y), bfhi(a.y)}, k[4] = {bflo(b.x), bfhi(b.x), bflo(b.y), bfhi(b.y)};
        const float sq = wave_sum(q[0] * q[0] + q[1] * q[1] + q[2] * q[2] + q[3] * q[3]), sk = wave_sum(k[0] * k[0] + k[1] * k[1] + k[2] * k[2] + k[3] * k[3]);
        const float rq = 1.0f / sqrtf(sq * (1.0f / 256.0f) + 1e-6f), rk = 1.0f / sqrtf(sk * (1.0f / 256.0f) + 1e-6f);
        const f32x4 gq = *(const f32x4*)(qn + 4 * lane), gk = *(const f32x4*)(kn + 4 * lane);
        u32x2 o; o.x = pk2(q[0] * rq * gq.x, q[1] * rq * gq.y); o.y = pk2(q[2] * rq * gq.z, q[3] * rq * gq.w);
        *(u32x2*)(CQ + (size_t)t * 256 + 4 * lane) = o;
        o.x = pk2(k[0] * rk * gk.x, k[1] * rk * gk.y); o.y = pk2(k[2] * rk * gk.z, k[3] * rk * gk.w);
        *(u32x2*)(CKV + (size_t)t * 256 + 4 * lane) = o;
        *(unsigned*)(CKV8 + (size_t)t * 256 + 4 * lane) = e5m2enc(k[0] * rk * gk.x) | (e5m2enc(k[1] * rk * gk.y) << 8) | (e5m2enc(k[2] * rk * gk.z) << 16) | (e5m2enc(k[3] * rk * gk.w) << 24);
    }
}
__device__ __forceinline__ unsigned fkey(float f) { const unsigned u = __float_as_uint(f); return (u & 0x80000000u) ? ~u : (u | 0x80000000u); }

__device__ __forceinline__ void phase_index(const Params& P, unsigned char* lds) {
    const bf16_t* Z1 = (const bf16_t*)(P.ws + WS_Z1); unsigned short* SEL = (unsigned short*)(P.ws + WS_SEL);
    float* sc = (float*)lds;
    float* qf = sc + 8192;
    float* wf = qf + 512;
    int* hist = (int*)(wf + 8);
    int* misc = hist + 256;
    int* seg = misc + 8;
    const int tid = threadIdx.x;
    for (int t = blockIdx.x; t < NTOK; t += gridDim.x) {
        const int b = t >> 13, tl = t & (SEQ - 1), n = tl + 1;
        unsigned short* so = SEL + (size_t)t * TOPK;
        if (n <= TOPK) { if (tid < n) so[tid] = (unsigned short)tid; continue; }
        qf[tid] = bf2f(Z1[(size_t)t * Z1W + 512 + tid]);
        if (tid < 8) wf[tid] = bf2f(Z1[(size_t)t * Z1W + 1088 + tid]);
        __syncthreads();
        for (int s = tid; s < n; s += NT) {
            const bf16_t* kr = Z1 + ((size_t)b * SEQ + s) * Z1W + 1024;
            float k[64];
#pragma unroll
            for (int q = 0; q < 8; ++q) { const u32x4 v = *(const u32x4*)(kr + q * 8);
                k[q * 8] = bflo(v.x); k[q * 8 + 1] = bfhi(v.x); k[q * 8 + 2] = bflo(v.y); k[q * 8 + 3] = bfhi(v.y);
                k[q * 8 + 4] = bflo(v.z); k[q * 8 + 5] = bfhi(v.z); k[q * 8 + 6] = bflo(v.w); k[q * 8 + 7] = bfhi(v.w); }
            float I = 0.f;
#pragma unroll
            for (int h = 0; h < 8; ++h) { float d = 0.f;
#pragma unroll
                for (int dd = 0; dd < 64; ++dd) d += qf[h * 64 + dd] * k[dd];
                I += wf[h] * fmaxf(d, 0.f); }
            sc[s] = I;
        }
        if (tid == 0) { misc[0] = 0; misc[1] = TOPK; misc[2] = 0; }
        __syncthreads();
        for (int pass = 0; pass < 4; ++pass) {
            const int shift = 24 - 8 * pass;
            if (tid < 256) hist[tid] = 0;
            __syncthreads();
            const unsigned prefix = (unsigned)misc[0]; const int kk = misc[1];
            for (int s = tid; s < n; s += NT) { const unsigned key = fkey(sc[s]);
                if (pass == 0 || (key >> (shift + 8)) == prefix) atomicAdd(&hist[(key >> shift) & 255], 1); }
            __syncthreads();
            if (tid == 0) { int a = 0, bsel = 0; for (int bin = 255; bin >= 0; --bin) { const int c = hist[bin]; if (a + c >= kk) { bsel = bin; break; } a += c; }
                misc[0] = (int)((prefix << 8) | (unsigned)bsel); misc[1] = kk - a; }
            __syncthreads();
        }
        const unsigned T = (unsigned)misc[0]; const int keq = misc[1];
        for (int s = tid; s < n; s += NT) if (fkey(sc[s]) > T) { const int o = atomicAdd(&misc[2], 1); so[o] = (unsigned short)s; }
        const int per = (n + NT - 1) / NT, s0 = tid * per, s1 = min(n, s0 + per);
        int ce = 0;
        for (int s = s0; s < s1; ++s) ce += (fkey(sc[s]) == T) ? 1 : 0;
        seg[tid] = ce;
        __syncthreads();
        if (tid == 0) { int a = 0; for (int i = 0; i < NT; ++i) { const int c = seg[i]; seg[i] = a; a += c; } }
        __syncthreads();
        const int ngt = TOPK - keq;
        int r = seg[tid];
        for (int s = s0; s < s1 && r < keq; ++s) if (fkey(sc[s]) == T) { so[ngt + r] = (unsigned short)s; ++r; }
        __syncthreads();
    }
}
__device__ __forceinline__ void phase_sparse_attn(const Params& P, unsigned char* lds) {
    bf16_t* QA = (bf16_t*)(P.ws + WS_QA); const bf16_t* CKV = (const bf16_t*)(P.ws + WS_CKV); const unsigned short* SEL = (const unsigned short*)(P.ws + WS_SEL);
    float* qa = (float*)lds;
    float* lgt = qa + 4096;
    int* sel = (int*)(lgt + 4096);
    const int tid = threadIdx.x, lane = tid & 63, wave = tid >> 6;
    for (int t = blockIdx.x; t < NTOK; t += gridDim.x) {
        const int b = t >> 13, tl = t & (SEQ - 1), ns = min(tl + 1, TOPK);
        { const u32x4 v = *(const u32x4*)(QA + (size_t)t * 4096 + tid * 8); float* q = qa + tid * 8;
          q[0] = bflo(v.x); q[1] = bfhi(v.x); q[2] = bflo(v.y); q[3] = bfhi(v.y); q[4] = bflo(v.z); q[5] = bfhi(v.z); q[6] = bflo(v.w); q[7] = bfhi(v.w); }
        if (tid < TOPK) sel[tid] = (tid < ns) ? (int)SEL[(size_t)t * TOPK + tid] : 0;
        __syncthreads();
        const int k = tid & 255, hg = tid >> 8;
        {
            float acc[8];
#pragma unroll
            for (int h = 0; h < 8; ++h) acc[h] = 0.f;
            if (k < ns) {
                const bf16_t* cr = CKV + ((size_t)b * SEQ + sel[k]) * 256;
                for (int c8 = 0; c8 < 256; c8 += 8) {
                    const u32x4 v = *(const u32x4*)(cr + c8);
                    const float cv[8] = {bflo(v.x), bfhi(v.x), bflo(v.y), bfhi(v.y), bflo(v.z), bfhi(v.z), bflo(v.w), bfhi(v.w)};
#pragma unroll
                    for (int h = 0; h < 8; ++h) { const float* q = qa + (hg * 8 + h) * 256 + c8;
#pragma unroll
                        for (int j = 0; j < 8; ++j) acc[h] += q[j] * cv[j]; }
                }
            }
#pragma unroll
            for (int h = 0; h < 8; ++h) { const int hh = hg * 8 + h; const float slope = exp2f(-0.5f * (float)(hh + 1));
                lgt[hh * 256 + k] = (k < ns) ? (acc[h] - slope * (float)(tl - sel[k])) : -INFINITY; }
        }
        __syncthreads();
        for (int hh = wave * 2; hh < wave * 2 + 2; ++hh) {
            float* row = lgt + hh * 256;
            float x[4]; float m = -INFINITY;
#pragma unroll
            for (int j = 0; j < 4; ++j) { x[j] = row[lane + 64 * j]; m = fmaxf(m, x[j]); }
            m = wave_max(m); float s = 0.f;
#pragma unroll
            for (int j = 0; j < 4; ++j) { x[j] = __expf(x[j] - m); s += x[j]; }
            s = wave_sum(s); const float inv = 1.0f / s;
#pragma unroll
            for (int j = 0; j < 4; ++j) row[lane + 64 * j] = x[j] * inv;
        }
        __syncthreads();
        {
            const int c = tid & 255;
            float acc[8];
#pragma unroll
            for (int h = 0; h < 8; ++h) acc[h] = 0.f;
            const bf16_t* cb = CKV + (size_t)b * SEQ * 256 + c;
            for (int kk = 0; kk < ns; ++kk) {
                const float cv = bf2f(cb[(size_t)sel[kk] * 256]);
#pragma unroll
                for (int h = 0; h < 8; ++h) acc[h] += lgt[(hg * 8 + h) * 256 + kk] * cv;
            }
#pragma unroll
            for (int h = 0; h < 8; ++h) QA[(size_t)t * 4096 + (hg * 8 + h) * 256 + c] = (bf16_t)f2bf(acc[h]);
        }
        __syncthreads();
    }
}

constexpr int NPH_TOTAL = 23;


typedef short v4i16_t __attribute__((ext_vector_type(4)));
template <bool DRY>
__device__ __forceinline__ void phase_sparse_attn_mfma(const Params& P, unsigned char* lds_) {
    using pg8::bf16x8;
    bf16_t* QA = (bf16_t*)(P.ws + WS_QA); const unsigned char* CKV = (const unsigned char*)(P.ws + WS_CKV); const unsigned short* SEL = (const unsigned short*)(P.ws + WS_SEL);
    const int tid = threadIdx.x, lane = tid & 63, wave = __builtin_amdgcn_readfirstlane(tid >> 6);
    const int fr = lane & 15, fq = lane >> 4;
    LAS unsigned char* cbuf = (LAS unsigned char*)lds_ + wave * 16896;
    LAS unsigned short* selw = (LAS unsigned short*)(cbuf + 16384);
    const int G = gridDim.x, NGW = G * NWAVE;
    int vw;
    if ((G & 7) == 0) vw = (((int)blockIdx.x & 7) * (G >> 3) + ((int)blockIdx.x >> 3)) * NWAVE + wave; else vw = (int)blockIdx.x * NWAVE + wave;
    const float LOG2E = 1.4426950408889634f;
    const float slope2 = exp2f(-0.5f * (float)(fr + 1)) * LOG2E;
    unsigned qoffB[4];
#pragma unroll
    for (int e = 0; e < 4; ++e) { const int key7 = (2 * e + (lane >> 5)) & 7; qoffB[e] = (unsigned)(((lane & 31) ^ (key7 << 1)) << 4); }
    const int rowA = fr;
    const unsigned swzA = (unsigned)((rowA & 7) << 1);
    const int rowT = 4 * fq + (fr >> 2);
    const unsigned swzT = (unsigned)((rowT & 7) << 1), pbT = (unsigned)((fr & 3) >> 1), halfT = (unsigned)(fr & 1) * 8u;
    const int per = NGW >> 2, bq = vw / per, wb = vw % per;
    for (int tl0 = wb; tl0 < SEQ; tl0 += per) {
        const int t = bq * SEQ + tl0;
        const int b = t >> 13, tl = t & (SEQ - 1), ns = min(tl + 1, TOPK), nch = (ns + 31) >> 5;
        {
            const u32x2 w = *(const u32x2*)(SEL + (size_t)t * TOPK + 4 * lane);
            unsigned short i0 = (unsigned short)(w.x & 0xffffu), i1 = (unsigned short)(w.x >> 16), i2 = (unsigned short)(w.y & 0xffffu), i3 = (unsigned short)(w.y >> 16);
            const int k0 = 4 * lane;
            if (k0 >= ns) i0 = 0; if (k0 + 1 >= ns) i1 = 0; if (k0 + 2 >= ns) i2 = 0; if (k0 + 3 >= ns) i3 = 0;
            u32x2 o; o.x = (unsigned)i0 | ((unsigned)i1 << 16); o.y = (unsigned)i2 | ((unsigned)i3 << 16);
            *(LAS u32x2*)(selw + 4 * lane) = o;
        }
        bf16x8 qf[8];
#pragma unroll
        for (int cc = 0; cc < 8; ++cc) qf[cc] = *(const bf16x8*)(QA + (size_t)t * 4096 + fr * 256 + 32 * cc + 8 * fq);
        f32x4 O[16];
#pragma unroll
        for (int ct = 0; ct < 16; ++ct) O[ct] = (f32x4){0.f, 0.f, 0.f, 0.f};
        float m = -INFINITY, l = 0.f;
        const unsigned char* cb = CKV + (size_t)b * SEQ * 512;
        for (int j = 0; j < nch; ++j) {
            asm volatile("s_waitcnt lgkmcnt(0)" ::: "memory");
#pragma unroll
            for (int e = 0; e < 16; ++e) {
                const unsigned idx = selw[32 * j + 2 * e + (lane >> 5)];
                __builtin_amdgcn_global_load_lds((const unsigned*)(cb + (size_t)idx * 512 + qoffB[e & 3]), (LAS unsigned*)(cbuf + e * 1024), 16, 0, 0);
            }
            asm volatile("s_waitcnt vmcnt(0)" ::: "memory");
            f32x4 s0 = {0.f, 0.f, 0.f, 0.f}, s1 = {0.f, 0.f, 0.f, 0.f};
#pragma unroll
            for (int cc = 0; cc < 8; ++cc) {
                const unsigned ch = (((unsigned)(4 * cc + fq)) ^ swzA) << 4;
                const bf16x8 a0 = *(const LAS bf16x8*)(cbuf + rowA * 512 + ch);
                const bf16x8 a1 = *(const LAS bf16x8*)(cbuf + (16 + rowA) * 512 + ch);
                s0 = __builtin_amdgcn_mfma_f32_16x16x32_bf16(a0, qf[cc], s0, 0, 0, 0);
                s1 = __builtin_amdgcn_mfma_f32_16x16x32_bf16(a1, qf[cc], s1, 0, 0, 0);
            }
            const u32x2 k0w = *(const LAS u32x2*)(selw + 32 * j + 4 * fq), k1w = *(const LAS u32x2*)(selw + 32 * j + 16 + 4 * fq);
            const int kb0 = 32 * j + 4 * fq, kb1 = kb0 + 16;
            float lg[8];
            {
                const int i00 = (int)(k0w.x & 0xffffu), i01 = (int)(k0w.x >> 16), i02 = (int)(k0w.y & 0xffffu), i03 = (int)(k0w.y >> 16);
                const int i10 = (int)(k1w.x & 0xffffu), i11 = (int)(k1w.x >> 16), i12 = (int)(k1w.y & 0xffffu), i13 = (int)(k1w.y >> 16);
                lg[0] = (kb0 + 0 < ns) ? s0.x * LOG2E - slope2 * (float)(tl - i00) : -INFINITY;
                lg[1] = (kb0 + 1 < ns) ? s0.y * LOG2E - slope2 * (float)(tl - i01) : -INFINITY;
                lg[2] = (kb0 + 2 < ns) ? s0.z * LOG2E - slope2 * (float)(tl - i02) : -INFINITY;
                lg[3] = (kb0 + 3 < ns) ? s0.w * LOG2E - slope2 * (float)(tl - i03) : -INFINITY;
                lg[4] = (kb1 + 0 < ns) ? s1.x * LOG2E - slope2 * (float)(tl - i10) : -INFINITY;
                lg[5] = (kb1 + 1 < ns) ? s1.y * LOG2E - slope2 * (float)(tl - i11) : -INFINITY;
                lg[6] = (kb1 + 2 < ns) ? s1.z * LOG2E - slope2 * (float)(tl - i12) : -INFINITY;
                lg[7] = (kb1 + 3 < ns) ? s1.w * LOG2E - slope2 * (float)(tl - i13) : -INFINITY;
            }
            float cm = fmaxf(fmaxf(fmaxf(lg[0], lg[1]), fmaxf(lg[2], lg[3])), fmaxf(fmaxf(lg[4], lg[5]), fmaxf(lg[6], lg[7])));
            cm = fmaxf(cm, __shfl_xor(cm, 16)); cm = fmaxf(cm, __shfl_xor(cm, 32));
            const float mn = fmaxf(m, cm);
            if (__any(mn > m)) {
                const float sc = exp2f(m - mn);
                l *= sc;
#pragma unroll
                for (int ct = 0; ct < 16; ++ct) O[ct] *= sc;
                m = mn;
            }
            float p[8]; float ps = 0.f;
#pragma unroll
            for (int i = 0; i < 8; ++i) { p[i] = exp2f(lg[i] - m); ps += p[i]; }
            l += ps;
            u32x4 pw; pw.x = pk2(p[0], p[1]); pw.y = pk2(p[2], p[3]); pw.z = pk2(p[4], p[5]); pw.w = pk2(p[6], p[7]);
            const bf16x8 pk = __builtin_bit_cast(bf16x8, pw);
#pragma unroll
            for (int ct = 0; ct < 16; ++ct) {
                const unsigned ch = ((((unsigned)(2 * ct)) ^ swzT) | pbT) << 4;
                const v4i16_t lo = __builtin_amdgcn_ds_read_tr16_b64_v4i16((LAS v4i16_t*)(cbuf + rowT * 512 + ch + halfT));
                const v4i16_t hi = __builtin_amdgcn_ds_read_tr16_b64_v4i16((LAS v4i16_t*)(cbuf + (16 + rowT) * 512 + ch + halfT));
                const bf16x8 a = {lo[0], lo[1], lo[2], lo[3], hi[0], hi[1], hi[2], hi[3]};
                O[ct] = __builtin_amdgcn_mfma_f32_16x16x32_bf16(a, pk, O[ct], 0, 0, 0);
            }
        }
        l += __shfl_xor(l, 16); l += __shfl_xor(l, 32);
        const float inv = 1.0f / l;
        bf16_t* orow = (DRY ? (bf16_t*)(P.ws + WS_PP) + (size_t)(t & 8191) * 4096 : QA + (size_t)t * 4096) + fr * 256 + 4 * fq;
#pragma unroll
        for (int ct = 0; ct < 16; ++ct) { u32x2 w; w.x = pk2(O[ct].x * inv, O[ct].y * inv); w.y = pk2(O[ct].z * inv, O[ct].w * inv); *(u32x2*)(orow + 16 * ct) = w; }
    }
}


template <bool DRY>
__device__ __forceinline__ void phase_sparse_attn_f8(const Params& P, unsigned char* lds_) {
    using pg8::bf16x8;
    bf16_t* QA = (bf16_t*)(P.ws + WS_QA); const unsigned char* CKV8 = (const unsigned char*)(P.ws + WS_CKV8); const unsigned short* SEL = (const unsigned short*)(P.ws + WS_SEL);
    const int tid = threadIdx.x, lane = tid & 63, wave = __builtin_amdgcn_readfirstlane(tid >> 6);
    const int fr = lane & 15, fq = lane >> 4;
    LAS unsigned char* cbuf = (LAS unsigned char*)lds_ + wave * 16896;
    LAS unsigned short* selw = (LAS unsigned short*)(cbuf + 16384);
    const int G = gridDim.x, NGW = G * NWAVE;
    int vw;
    if ((G & 7) == 0) vw = (((int)blockIdx.x & 7) * (G >> 3) + ((int)blockIdx.x >> 3)) * NWAVE + wave; else vw = (int)blockIdx.x * NWAVE + wave;
    const float LOG2E = 1.4426950408889634f;
    const float slope2 = exp2f(-0.5f * (float)(fr + 1)) * LOG2E;
    const int rowA = fr;
    const unsigned swzA = (unsigned)((rowA & 7) << 1);
    const int rowT = 4 * fq + (fr >> 2);
    const unsigned swzT = (unsigned)((rowT & 7) << 1), pbT = (unsigned)((fr & 3) >> 1), halfT = (unsigned)(fr & 1) * 8u;
    const unsigned swzA16 = (swzA ^ (unsigned)fq) << 4, baseA = (unsigned)rowA * 512u;
    const unsigned swzT16 = swzT << 4, baseT = (unsigned)rowT * 512u + (pbT << 4) + halfT;
    unsigned wofs[2];
#pragma unroll
    for (int e = 0; e < 2; ++e) { const int key7 = (4 * e + fq) & 7; wofs[e] = (unsigned)(fq * 512 + (((2 * fr) ^ (key7 << 1)) << 4)); }
    const int per = NGW >> 2, bq = vw / per, wb = vw % per;
    for (int tl0 = wb; tl0 < SEQ; tl0 += per) {
        const int t = bq * SEQ + tl0;
        const int b = t >> 13, tl = t & (SEQ - 1), ns = min(tl + 1, TOPK), nch = (ns + 31) >> 5;
        {
            const u32x2 w = *(const u32x2*)(SEL + (size_t)t * TOPK + 4 * lane);
            unsigned short i0 = (unsigned short)(w.x & 0xffffu), i1 = (unsigned short)(w.x >> 16), i2 = (unsigned short)(w.y & 0xffffu), i3 = (unsigned short)(w.y >> 16);
            const int k0 = 4 * lane;
            if (k0 >= ns) i0 = 0; if (k0 + 1 >= ns) i1 = 0; if (k0 + 2 >= ns) i2 = 0; if (k0 + 3 >= ns) i3 = 0;
            u32x2 o; o.x = (unsigned)i0 | ((unsigned)i1 << 16); o.y = (unsigned)i2 | ((unsigned)i3 << 16);
            *(LAS u32x2*)(selw + 4 * lane) = o;
        }
        bf16x8 qf[8];
#pragma unroll
        for (int cc = 0; cc < 8; ++cc) qf[cc] = *(const bf16x8*)(QA + (size_t)t * 4096 + fr * 256 + 32 * cc + 8 * fq);
        f32x4 O[16];
#pragma unroll
        for (int ct = 0; ct < 16; ++ct) O[ct] = (f32x4){0.f, 0.f, 0.f, 0.f};
        float m = -INFINITY, l = 0.f;
        const unsigned char* cb = CKV8 + (size_t)b * SEQ * 256 + 16 * fr;
        u32x4 stg[8];
#pragma unroll
        for (int e = 0; e < 8; ++e) { const unsigned idx = selw[4 * e + fq]; stg[e] = *(const u32x4*)(cb + (size_t)idx * 256); }
        for (int j = 0; j < nch; ++j) {
#pragma unroll
            for (int e = 0; e < 8; ++e) {
                const u32x4 w = stg[e];
                u32x4 lo, hi;
                lo.x = f8dec2(__builtin_amdgcn_perm(0u, w.x, 0x0c010c00u)); lo.y = f8dec2(__builtin_amdgcn_perm(0u, w.x, 0x0c030c02u));
                lo.z = f8dec2(__builtin_amdgcn_perm(0u, w.y, 0x0c010c00u)); lo.w = f8dec2(__builtin_amdgcn_perm(0u, w.y, 0x0c030c02u));
                hi.x = f8dec2(__builtin_amdgcn_perm(0u, w.z, 0x0c010c00u)); hi.y = f8dec2(__builtin_amdgcn_perm(0u, w.z, 0x0c030c02u));
                hi.z = f8dec2(__builtin_amdgcn_perm(0u, w.w, 0x0c010c00u)); hi.w = f8dec2(__builtin_amdgcn_perm(0u, w.w, 0x0c030c02u));
                LAS unsigned char* dst = cbuf + (e >> 1) * 4096 + (e & 1) * 2048 + wofs[e & 1];
                *(LAS u32x4*)dst = lo; *(LAS u32x4*)(dst + 16) = hi;
            }
            if (j + 1 < nch) {
#pragma unroll
                for (int e = 0; e < 8; ++e) { const unsigned idx = selw[32 * (j + 1) + 4 * e + fq]; stg[e] = *(const u32x4*)(cb + (size_t)idx * 256); }
            }
            f32x4 s0 = {0.f, 0.f, 0.f, 0.f}, s1 = {0.f, 0.f, 0.f, 0.f};
#pragma unroll
            for (int cc = 0; cc < 8; ++cc) {
                const LAS unsigned char* pa = cbuf + ((swzA16 ^ (unsigned)(cc << 6)) + baseA);
                const bf16x8 a0 = *(const LAS bf16x8*)(pa);
                const bf16x8 a1 = *(const LAS bf16x8*)(pa + 8192);
                s0 = __builtin_amdgcn_mfma_f32_16x16x32_bf16(a0, qf[cc], s0, 0, 0, 0);
                s1 = __builtin_amdgcn_mfma_f32_16x16x32_bf16(a1, qf[cc], s1, 0, 0, 0);
            }
            const u32x2 k0w = *(const LAS u32x2*)(selw + 32 * j + 4 * fq), k1w = *(const LAS u32x2*)(selw + 32 * j + 16 + 4 * fq);
            const int kb0 = 32 * j + 4 * fq, kb1 = kb0 + 16;
            float lg[8];
            {
                const int i00 = (int)(k0w.x & 0xffffu), i01 = (int)(k0w.x >> 16), i02 = (int)(k0w.y & 0xffffu), i03 = (int)(k0w.y >> 16);
                const int i10 = (int)(k1w.x & 0xffffu), i11 = (int)(k1w.x >> 16), i12 = (int)(k1w.y & 0xffffu), i13 = (int)(k1w.y >> 16);
                lg[0] = (kb0 + 0 < ns) ? s0.x * LOG2E - slope2 * (float)(tl - i00) : -INFINITY;
                lg[1] = (kb0 + 1 < ns) ? s0.y * LOG2E - slope2 * (float)(tl - i01) : -INFINITY;
                lg[2] = (kb0 + 2 < ns) ? s0.z * LOG2E - slope2 * (float)(tl - i02) : -INFINITY;
                lg[3] = (kb0 + 3 < ns) ? s0.w * LOG2E - slope2 * (float)(tl - i03) : -INFINITY;
                lg[4] = (kb1 + 0 < ns) ? s1.x * LOG2E - slope2 * (float)(tl - i10) : -INFINITY;
                lg[5] = (kb1 + 1 < ns) ? s1.y * LOG2E - slope2 * (float)(tl - i11) : -INFINITY;
                lg[6] = (kb1 + 2 < ns) ? s1.z * LOG2E - slope2 * (float)(tl - i12) : -INFINITY;
                lg[7] = (kb1 + 3 < ns) ? s1.w * LOG2E - slope2 * (float)(tl - i13) : -INFINITY;
            }
            float cm = fmaxf(fmaxf(fmaxf(lg[0], lg[1]), fmaxf(lg[2], lg[3])), fmaxf(fmaxf(lg[4], lg[5]), fmaxf(lg[6], lg[7])));
            cm = fmaxf(cm, __shfl_xor(cm, 16)); cm = fmaxf(cm, __shfl_xor(cm, 32));
            const float mn = fmaxf(m, cm);
            if (__any(mn > m)) {
                const float sc = __builtin_amdgcn_exp2f(m - mn);
                l *= sc;
#pragma unroll
                for (int ct = 0; ct < 16; ++ct) O[ct] *= sc;
                m = mn;
            }
            float p[8]; float ps = 0.f;
#pragma unroll
            for (int i = 0; i < 8; ++i) { p[i] = __builtin_amdgcn_exp2f(lg[i] - m); ps += p[i]; }
            l += ps;
            u32x4 pw; pw.x = pk2(p[0], p[1]); pw.y = pk2(p[2], p[3]); pw.z = pk2(p[4], p[5]); pw.w = pk2(p[6], p[7]);
            const bf16x8 pk = __builtin_bit_cast(bf16x8, pw);
#pragma unroll
            for (int ct = 0; ct < 16; ++ct) {
                const LAS unsigned char* pt = cbuf + ((swzT16 ^ (unsigned)(ct << 5)) + baseT);
                const v4i16_t lo = __builtin_amdgcn_ds_read_tr16_b64_v4i16((LAS v4i16_t*)(pt));
                const v4i16_t hi = __builtin_amdgcn_ds_read_tr16_b64_v4i16((LAS v4i16_t*)(pt + 8192));
                const bf16x8 a = {lo[0], lo[1], lo[2], lo[3], hi[0], hi[1], hi[2], hi[3]};
                O[ct] = __builtin_amdgcn_mfma_f32_16x16x32_bf16(a, pk, O[ct], 0, 0, 0);
            }
        }
        l += __shfl_xor(l, 16); l += __shfl_xor(l, 32);
        const float inv = 1.0f / l;
        bf16_t* orow = (DRY ? (bf16_t*)(P.ws + WS_PP) + (size_t)(t & 8191) * 4096 : QA + (size_t)t * 4096) + fr * 256 + 4 * fq;
#pragma unroll
        for (int ct = 0; ct < 16; ++ct) { u32x2 w; w.x = pk2(O[ct].x * inv, O[ct].y * inv); w.y = pk2(O[ct].z * inv, O[ct].w * inv); *(u32x2*)(orow + 16 * ct) = w; }
    }
}


__device__ __forceinline__ void glds16(const void* gsrc, unsigned lds_dst) {
    unsigned keep;
    asm volatile("s_mov_b32 %0, m0\n\ts_mov_b32 m0, %2\n\ts_nop 0\n\tglobal_load_lds_dwordx4 %1, off\n\ts_mov_b32 m0, %0" : "=&s"(keep) : "v"(gsrc), "s"(lds_dst) : "memory");
}
typedef _Float16 f16x8 __attribute__((ext_vector_type(8)));
template <bool DRY>
__device__ __forceinline__ void phase_sparse_attn_e(const Params& P, unsigned char* lds_) {
    const unsigned char* QA = (const unsigned char*)(P.ws + WS_QA); bf16_t* OLAT = (bf16_t*)(P.ws + WS_OLAT); const unsigned char* CKV8 = (const unsigned char*)(P.ws + WS_CKV8); const unsigned short* SEL = (const unsigned short*)(P.ws + WS_SEL);
    const int tid = threadIdx.x, lane = tid & 63, wave = __builtin_amdgcn_readfirstlane(tid >> 6);
    const int fr = lane & 15, fq = lane >> 4;
    LAS unsigned char* cbuf = (LAS unsigned char*)lds_ + wave * 16896;
    LAS unsigned short* selw = (LAS unsigned short*)(cbuf + 16384);
    const unsigned cbuf0 = (unsigned)(unsigned long)cbuf;
    const int G = gridDim.x, NGW = G * NWAVE;
    int vw;
    if ((G & 7) == 0) vw = (((int)blockIdx.x & 7) * (G >> 3) + ((int)blockIdx.x >> 3)) * NWAVE + wave; else vw = (int)blockIdx.x * NWAVE + wave;
    const float LOG2E = 1.4426950408889634f;
    const float slope2 = exp2f(-0.5f * (float)(fr + 1)) * LOG2E;
    unsigned qoffB[4];
#pragma unroll
    for (int e = 0; e < 4; ++e) { const int r15 = (4 * e + fq) & 15; qoffB[e] = (unsigned)((fr ^ (((r15 & 7) << 1) | (r15 >> 3))) << 4); }
    const unsigned fA = (unsigned)(((fr & 7) << 1) | (fr >> 3));
    const unsigned SA = (fA & 14u) << 4, baseA = (unsigned)fr * 256u + ((((unsigned)fq >> 1) ^ (fA & 1u)) << 4) + ((unsigned)fq & 1u) * 8u;
    const int rT = 4 * fq + (fr >> 2), pT_ = fr & 3;
    const unsigned fT = (unsigned)(((rT & 7) << 1) | (rT >> 3));
    const unsigned ST = (fT & 14u) << 4, baseT = (unsigned)rT * 256u + ((((unsigned)pT_ >> 1) ^ (fT & 1u)) << 4) + ((unsigned)pT_ & 1u) * 8u;
    const int per = NGW >> 2, bq = vw / per, wb = vw % per;
    int ditem = DRY ? N_DEFERRED : vw;
    for (int tl0 = wb; tl0 < SEQ; tl0 += per) {
        const int t = bq * SEQ + tl0;
        const int b = t >> 13, tl = t & (SEQ - 1), ns = min(tl + 1, TOPK), nch = (ns + 31) >> 5;
        {
            const u32x2 w = *(const u32x2*)(SEL + (size_t)t * TOPK + 4 * lane);
            unsigned short i0 = (unsigned short)(w.x & 0xffffu), i1 = (unsigned short)(w.x >> 16), i2 = (unsigned short)(w.y & 0xffffu), i3 = (unsigned short)(w.y >> 16);
            const int k0 = 4 * lane;
            if (k0 >= ns) i0 = 0; if (k0 + 1 >= ns) i1 = 0; if (k0 + 2 >= ns) i2 = 0; if (k0 + 3 >= ns) i3 = 0;
            u32x2 o; o.x = (unsigned)i0 | ((unsigned)i1 << 16); o.y = (unsigned)i2 | ((unsigned)i3 << 16);
            asm volatile("s_waitcnt lgkmcnt(0)" ::: "memory");
            *(LAS u32x2*)(selw + 4 * lane) = o;
        }
        long qf[8];
#pragma unroll
        for (int cc = 0; cc < 8; ++cc) qf[cc] = *(const long*)(QA + (size_t)t * 4096 + fr * 256 + 32 * cc + 8 * fq);
        f32x4 Oe[8], Oo[8];
#pragma unroll
        for (int ut = 0; ut < 8; ++ut) { Oe[ut] = (f32x4){0.f, 0.f, 0.f, 0.f}; Oo[ut] = (f32x4){0.f, 0.f, 0.f, 0.f}; }
        float m = -INFINITY, l = 0.f;
        const unsigned char* cb = CKV8 + (size_t)b * SEQ * 256;
        asm volatile("s_waitcnt vmcnt(0) lgkmcnt(0)" ::: "memory");
#define ATT_DMA(jj, bufoff) do { unsigned idx_[8]; \
            _Pragma("unroll") for (int e = 0; e < 8; ++e) idx_[e] = (DRY && PROBE_ATT == 1) ? (unsigned)((32 * (jj) + 4 * e + fq + 64 * wave) & 8191) : (unsigned)selw[32 * (jj) + 4 * e + fq]; \
            _Pragma("unroll") for (int e = 0; e < 8; ++e) { \
            if (!(DRY && PROBE_ATT == 3)) glds16(cb + (size_t)idx_[e] * 256 + qoffB[e & 3], (unsigned)__builtin_amdgcn_readfirstlane((int)(cbuf0 + (bufoff) + e * 1024))); } } while (0)
        ATT_DMA(0, 0);
        if (nch > 1) ATT_DMA(1, 8192);
        const bool have_item = ditem < N_DEFERRED;
        TrItem titem = deferred_item(P, have_item ? ditem : 0);
        float tcur[32];
        bool trf = false;
        if (have_item && nch <= 2) { tr_load(titem, lane, tcur); trf = true; }
        for (int j = 0; j < nch; ++j) {
            const unsigned bo = (unsigned)(j & 1) * 8192u;
            if (j + 1 < nch) { if (trf) asm volatile("s_waitcnt vmcnt(40)" ::: "memory"); else asm volatile("s_waitcnt vmcnt(8)" ::: "memory"); }
            else { if (trf) asm volatile("s_waitcnt vmcnt(32)" ::: "memory"); else asm volatile("s_waitcnt vmcnt(0)" ::: "memory"); }
            const LAS unsigned char* img = cbuf + bo;
            if (DRY && PROBE_ATT == 2) { if (j + 2 < nch) { asm volatile("s_waitcnt lgkmcnt(0)" ::: "memory"); ATT_DMA(j + 2, bo); } continue; }
            const u32x2 k0w = *(const LAS u32x2*)(selw + 32 * j + 4 * fq), k1w = *(const LAS u32x2*)(selw + 32 * j + 16 + 4 * fq);
            f32x4 s0 = {0.f, 0.f, 0.f, 0.f}, s1 = {0.f, 0.f, 0.f, 0.f};
#pragma unroll
            for (int hb = 0; hb < 2; ++hb) {
                u32x2 ra[4], rb[4];
#pragma unroll
                for (int c4 = 0; c4 < 4; ++c4) { const int cc = hb * 4 + c4; const LAS unsigned char* pa = img + ((SA ^ (unsigned)(cc << 5)) + baseA); ra[c4] = *(const LAS u32x2*)(pa); rb[c4] = *(const LAS u32x2*)(pa + 4096); }
                __builtin_amdgcn_sched_barrier(0);
#pragma unroll
                for (int c4 = 0; c4 < 4; ++c4) { const int cc = hb * 4 + c4;
                    s0 = __builtin_amdgcn_mfma_f32_16x16x32_bf8_fp8(__builtin_bit_cast(long, ra[c4]), qf[cc], s0, 0, 0, 0);
                    s1 = __builtin_amdgcn_mfma_f32_16x16x32_bf8_fp8(__builtin_bit_cast(long, rb[c4]), qf[cc], s1, 0, 0, 0); }
                __builtin_amdgcn_sched_barrier(0);
            }
            u32x2 tl_[4], th_[4];
#pragma unroll
            for (int ut = 0; ut < 4; ++ut) { const LAS unsigned char* pt = img + ((ST ^ (unsigned)(ut << 5)) + baseT);
                tl_[ut] = __builtin_bit_cast(u32x2, __builtin_amdgcn_ds_read_tr16_b64_v4i16((LAS v4i16_t*)(pt)));
                th_[ut] = __builtin_bit_cast(u32x2, __builtin_amdgcn_ds_read_tr16_b64_v4i16((LAS v4i16_t*)(pt + 4096))); }
            __builtin_amdgcn_sched_barrier(0);
            const int kb0 = 32 * j + 4 * fq, kb1 = kb0 + 16;
            float lg[8];
            {
                const int i00 = (int)(k0w.x & 0xffffu), i01 = (int)(k0w.x >> 16), i02 = (int)(k0w.y & 0xffffu), i03 = (int)(k0w.y >> 16);
                const int i10 = (int)(k1w.x & 0xffffu), i11 = (int)(k1w.x >> 16), i12 = (int)(k1w.y & 0xffffu), i13 = (int)(k1w.y >> 16);
                lg[0] = (kb0 + 0 < ns) ? s0.x * LOG2E - slope2 * (float)(tl - i00) : -INFINITY;
                lg[1] = (kb0 + 1 < ns) ? s0.y * LOG2E - slope2 * (float)(tl - i01) : -INFINITY;
                lg[2] = (kb0 + 2 < ns) ? s0.z * LOG2E - slope2 * (float)(tl - i02) : -INFINITY;
                lg[3] = (kb0 + 3 < ns) ? s0.w * LOG2E - slope2 * (float)(tl - i03) : -INFINITY;
                lg[4] = (kb1 + 0 < ns) ? s1.x * LOG2E - slope2 * (float)(tl - i10) : -INFINITY;
                lg[5] = (kb1 + 1 < ns) ? s1.y * LOG2E - slope2 * (float)(tl - i11) : -INFINITY;
                lg[6] = (kb1 + 2 < ns) ? s1.z * LOG2E - slope2 * (float)(tl - i12) : -INFINITY;
                lg[7] = (kb1 + 3 < ns) ? s1.w * LOG2E - slope2 * (float)(tl - i13) : -INFINITY;
            }
            const float cm = fmaxf(fmaxf(fmaxf(lg[0], lg[1]), fmaxf(lg[2], lg[3])), fmaxf(fmaxf(lg[4], lg[5]), fmaxf(lg[6], lg[7])));
            if (__any(cm > m + 8.0f)) {
                float cx = fmaxf(cm, __shfl_xor(cm, 16)); cx = fmaxf(cx, __shfl_xor(cx, 32));
                const float mn = fmaxf(m, cx);
                const float sc = __builtin_amdgcn_exp2f(m - mn);
                l *= sc;
#pragma unroll
                for (int ut = 0; ut < 8; ++ut) { Oe[ut] *= sc; Oo[ut] *= sc; }
                m = mn;
            }
            float p[8]; float ps = 0.f;
#pragma unroll
            for (int i = 0; i < 8; ++i) { p[i] = __builtin_amdgcn_exp2f(lg[i] - m); ps += p[i]; }
            l += ps;
            int pw0 = __builtin_amdgcn_cvt_pk_fp8_f32(p[0], p[1], 0, false); pw0 = __builtin_amdgcn_cvt_pk_fp8_f32(p[2], p[3], pw0, true);
            int pw1 = __builtin_amdgcn_cvt_pk_fp8_f32(p[4], p[5], 0, false); pw1 = __builtin_amdgcn_cvt_pk_fp8_f32(p[6], p[7], pw1, true);
            const long pk = __builtin_bit_cast(long, (u32x2){(unsigned)pw0, (unsigned)pw1});
#pragma unroll
            for (int hb = 0; hb < 2; ++hb) {
                if (hb == 1) {
#pragma unroll
                    for (int u4 = 0; u4 < 4; ++u4) { const int ut = 4 + u4; const LAS unsigned char* pt = img + ((ST ^ (unsigned)(ut << 5)) + baseT);
                        tl_[u4] = __builtin_bit_cast(u32x2, __builtin_amdgcn_ds_read_tr16_b64_v4i16((LAS v4i16_t*)(pt)));
                        th_[u4] = __builtin_bit_cast(u32x2, __builtin_amdgcn_ds_read_tr16_b64_v4i16((LAS v4i16_t*)(pt + 4096))); }
                    __builtin_amdgcn_sched_barrier(0);
                }
#pragma unroll
                for (int u4 = 0; u4 < 4; ++u4) { const int ut = hb * 4 + u4;
                    const u32x2 lw = tl_[u4], hw = th_[u4];
                    u32x2 ae, ao;
                    ae.x = __builtin_amdgcn_perm(lw.y, lw.x, 0x06040200u); ae.y = __builtin_amdgcn_perm(hw.y, hw.x, 0x06040200u);
                    ao.x = __builtin_amdgcn_perm(lw.y, lw.x, 0x07050301u); ao.y = __builtin_amdgcn_perm(hw.y, hw.x, 0x07050301u);
                    Oe[ut] = __builtin_amdgcn_mfma_f32_16x16x32_bf8_fp8(__builtin_bit_cast(long, ae), pk, Oe[ut], 0, 0, 0);
                    Oo[ut] = __builtin_amdgcn_mfma_f32_16x16x32_bf8_fp8(__builtin_bit_cast(long, ao), pk, Oo[ut], 0, 0, 0);
                }
                __builtin_amdgcn_sched_barrier(0);
            }
            if (j + 2 < nch) { asm volatile("s_waitcnt lgkmcnt(0)" ::: "memory"); ATT_DMA(j + 2, bo);
                if (have_item && j + 3 == nch) { tr_load(titem, lane, tcur); trf = true; } }
        }
#undef ATT_DMA
        l += __shfl_xor(l, 16); l += __shfl_xor(l, 32);
        const float inv = 1.0f / l;
        bf16_t* orow = (DRY ? (bf16_t*)(P.ws + WS_PP) + (size_t)(t & 8191) * 4096 : OLAT + (size_t)t * 4096) + fr * 256 + 8 * fq;
#pragma unroll
        for (int ut = 0; ut < 8; ++ut) {
            u32x4 w; w.x = pk2(Oe[ut].x * inv, Oo[ut].x * inv); w.y = pk2(Oe[ut].y * inv, Oo[ut].y * inv); w.z = pk2(Oe[ut].z * inv, Oo[ut].z * inv); w.w = pk2(Oe[ut].w * inv, Oo[ut].w * inv);
            *(u32x4*)(orow + 32 * ut) = w;
        }
        if (have_item) { asm volatile("s_waitcnt lgkmcnt(0)" ::: "memory"); tr_store(titem, (float*)(lds_ + wave * 16896), lane, tcur); ditem += NGW; }
    }
    for (; ditem < N_DEFERRED; ditem += NGW) { const TrItem t = deferred_item(P, ditem); float tmp[32]; tr_load(t, lane, tmp); tr_store(t, (float*)(lds_ + wave * 16896), lane, tmp); }
}

constexpr size_t SC_BATCH = (size_t)1024 * 256 * 257 / 2;
__device__ __forceinline__ size_t sc_row_off(int b, int tl) { const size_t m = (size_t)(tl >> 5); return (size_t)b * SC_BATCH + 1024 * (m * (m + 1) / 2) + (size_t)(tl & 31) * 32 * (m + 1); }
typedef float f32x16 __attribute__((ext_vector_type(16)));
__device__ __forceinline__ unsigned okey_pk(float a, float b) {
    const unsigned w = __builtin_bit_cast(unsigned, __builtin_amdgcn_cvt_pkrtz(a, b));
    const unsigned neg = (w >> 15) & 0x00010001u;
    return w ^ ((neg * 0xffffu) | 0x80008000u);
}
__device__ __forceinline__ void phase_index_scores(const Params& P, unsigned char* lds_) {
    using pg8::bf16x8;
    const bf16_t* Z1 = (const bf16_t*)(P.ws + WS_Z1); unsigned short* SC = (unsigned short*)(P.ws + WS_SC);
    LAS unsigned char* lds = (LAS unsigned char*)lds_;
    constexpr int QROW = 144;
    LAS unsigned char* QL = lds;
    LAS float* SG = (LAS float*)(lds + 9 * 64 * QROW);
    const int tid = threadIdx.x, lane = tid & 63, wave = __builtin_amdgcn_readfirstlane(tid >> 6);
    LAS unsigned char* ST = lds + 9 * 64 * QROW + 2048 + wave * 5120;
    const int l31 = lane & 31, hh = lane >> 5;
    for (int pid = blockIdx.x; pid < 256; pid += gridDim.x) {
        const int b = pid >> 6;
        for (int side = 0; side < 2; ++side) {
            const int qb = side ? (127 - (pid & 63)) : (pid & 63);
            const int q0 = qb * 64;
            __syncthreads();
            {
                const int qi = tid >> 3, part = tid & 7;
                const bf16_t* zr = Z1 + ((size_t)b * SEQ + q0 + qi) * Z1W;
                const u32x4 ww = *(const u32x4*)(zr + 1088);
                const float w8[8] = {bflo(ww.x), bfhi(ww.x), bflo(ww.y), bfhi(ww.y), bflo(ww.z), bfhi(ww.z), bflo(ww.w), bfhi(ww.w)};
                float wh = 0.f;
#pragma unroll
                for (int h = 0; h < 8; ++h) wh = (h == part) ? w8[h] : wh;
                const float sc = 0.5f * fabsf(wh);
                SG[qi * 8 + part] = (wh >= 0.f) ? 1.0f : -1.0f;
#pragma unroll
                for (int c = 0; c < 8; ++c) {
                    const u32x4 v = *(const u32x4*)(zr + 512 + part * 64 + c * 8);
                    u32x4 o; o.x = pk2(bflo(v.x) * sc, bfhi(v.x) * sc); o.y = pk2(bflo(v.y) * sc, bfhi(v.y) * sc); o.z = pk2(bflo(v.z) * sc, bfhi(v.z) * sc); o.w = pk2(bflo(v.w) * sc, bfhi(v.w) * sc);
                    *(LAS u32x4*)(QL + (part * 64 + qi) * QROW + c * 16) = o;
                }
                float a8[8];
#pragma unroll
                for (int j = 0; j < 8; ++j) a8[j] = 0.f;
#pragma unroll
                for (int h = 0; h < 8; ++h) {
                    const u32x4 v = *(const u32x4*)(zr + 512 + h * 64 + part * 8); const float s2 = 0.5f * w8[h];
                    a8[0] += s2 * bflo(v.x); a8[1] += s2 * bfhi(v.x); a8[2] += s2 * bflo(v.y); a8[3] += s2 * bfhi(v.y);
                    a8[4] += s2 * bflo(v.z); a8[5] += s2 * bfhi(v.z); a8[6] += s2 * bflo(v.w); a8[7] += s2 * bfhi(v.w);
                }
                u32x4 o; o.x = pk2(a8[0], a8[1]); o.y = pk2(a8[2], a8[3]); o.z = pk2(a8[4], a8[5]); o.w = pk2(a8[6], a8[7]);
                *(LAS u32x4*)(QL + (8 * 64 + qi) * QROW + part * 16) = o;
            }
            __syncthreads();
            const int ktmax = 2 * qb + 1;
            bf16x8 kn[4];
            {   const bf16_t* kr = Z1 + ((size_t)b * SEQ + min(wave, ktmax) * 32 + l31) * Z1W + 1024 + hh * 8;
#pragma unroll
                for (int dq = 0; dq < 4; ++dq) kn[dq] = *(const bf16x8*)(kr + dq * 16); }
            for (int kt = wave; kt <= ktmax; kt += NWAVE) {
                bf16x8 kf[4];
#pragma unroll
                for (int dq = 0; dq < 4; ++dq) kf[dq] = kn[dq];
                {   const bf16_t* kr = Z1 + ((size_t)b * SEQ + min(kt + NWAVE, ktmax) * 32 + l31) * Z1W + 1024 + hh * 8;
#pragma unroll
                    for (int dq = 0; dq < 4; ++dq) kn[dq] = *(const bf16x8*)(kr + dq * 16); }
#pragma unroll
                for (int qs = 0; qs < 2; ++qs) {
                    const LAS unsigned char* qrow = QL + (qs * 32 + l31) * QROW + hh * 16;
                    const LAS float* sgp = SG + (qs * 32 + l31) * 8;
                    bf16x8 fc[4], fn[4];
#pragma unroll
                    for (int dq = 0; dq < 4; ++dq) fc[dq] = *(const LAS bf16x8*)(qrow + 8 * 64 * QROW + dq * 32);
#pragma unroll
                    for (int dq = 0; dq < 4; ++dq) fn[dq] = *(const LAS bf16x8*)(qrow + dq * 32);
                    const f32x4 sg03 = *(const LAS f32x4*)(sgp), sg47 = *(const LAS f32x4*)(sgp + 4);
                    f32x16 acc;
#pragma unroll
                    for (int r = 0; r < 16; ++r) acc[r] = 0.f;
#pragma unroll
                    for (int dq = 0; dq < 4; ++dq) acc = __builtin_amdgcn_mfma_f32_32x32x16_bf16(kf[dq], fc[dq], acc, 0, 0, 0);
                    f32x16 up;
#pragma unroll
                    for (int h = 0; h < 8; ++h) {
#pragma unroll
                        for (int dq = 0; dq < 4; ++dq) fc[dq] = fn[dq];
                        if (h < 7) {
#pragma unroll
                            for (int dq = 0; dq < 4; ++dq) fn[dq] = *(const LAS bf16x8*)(qrow + (h + 1) * 64 * QROW + dq * 32);
                        }
                        f32x16 u;
#pragma unroll
                        for (int r = 0; r < 16; ++r) u[r] = 0.f;
#pragma unroll
                        for (int dq = 0; dq < 4; ++dq) u = __builtin_amdgcn_mfma_f32_32x32x16_bf16(kf[dq], fc[dq], u, 0, 0, 0);
                        __builtin_amdgcn_sched_barrier(0);
                        if (h > 0) {
                            const float sg = (h - 1 < 4) ? sg03[(h - 1) & 3] : sg47[(h - 1) & 3];
#pragma unroll
                            for (int r = 0; r < 16; ++r) acc[r] = fmaf(fabsf(up[r]), sg, acc[r]);
                        }
                        __builtin_amdgcn_sched_barrier(0);
                        up = u;
                    }
                    {
                        const float sg = sg47[3];
#pragma unroll
                        for (int r = 0; r < 16; ++r) acc[r] = fmaf(fabsf(up[r]), sg, acc[r]);
                    }
#pragma unroll
                    for (int g = 0; g < 4; ++g) { u32x2 w; w.x = okey_pk(acc[4 * g], acc[4 * g + 1]); w.y = okey_pk(acc[4 * g + 2], acc[4 * g + 3]);
                        *(LAS u32x2*)(ST + (qs * 32 + l31) * 80 + (8 * g + 4 * hh) * 2) = w; }
                }
#pragma unroll
                for (int i = 0; i < 4; ++i) {
                    const int row = 16 * i + (lane >> 2), ch = lane & 3, tl = q0 + row;
                    const u32x4 v = *(const LAS u32x4*)(ST + row * 80 + ch * 16);
                    if (kt <= (tl >> 5)) *(u32x4*)(SC + sc_row_off(b, tl) + (size_t)kt * 32 + ch * 8) = v;
                }
            }
        }
    }
}
template <int MODE>
__device__ __forceinline__ void phase_index_select(const Params& P, unsigned char* lds_) {
    const unsigned short* SC = (const unsigned short*)(P.ws + WS_SC); unsigned short* SEL = (unsigned short*)(P.ws + WS_SEL);
    const int tid = threadIdx.x, lane = tid & 63, wave = __builtin_amdgcn_readfirstlane(tid >> 6);
    LAS unsigned char* wbase = (LAS unsigned char*)lds_ + wave * 19456;
    LAS u32x4* rowbuf = (LAS u32x4*)wbase;
    LAS unsigned* hist = (LAS unsigned*)(wbase + 16384);
    LAS unsigned* dummy = hist + 512 + lane;
    LAS unsigned short* outw = (LAS unsigned short*)(wbase + 16384 + 2048 + 256);
    LAS unsigned short* dummy16 = outw + 256 + lane;
    const unsigned rowbuf0 = (unsigned)(unsigned long)wbase;
    const int gw = blockIdx.x * NWAVE + wave, NGW = gridDim.x * NWAVE;
#define SEL_DMA(tt) do { const int _tl = (tt) & (SEQ - 1), _n = _tl + 1; if (_n > TOPK) { const unsigned char* _src = (const unsigned char*)(SC + sc_row_off((tt) >> 13, _tl)) + lane * 16; \
            for (int _sg = 0; _sg * 512 < _n; ++_sg) glds16(_src + _sg * 1024, (unsigned)__builtin_amdgcn_readfirstlane((int)(rowbuf0 + _sg * 1024))); } } while (0)
    if (gw < NTOK) SEL_DMA(gw);
    for (int t = gw; t < NTOK; t += NGW) {
        const int tl = t & (SEQ - 1), n = tl + 1;
        unsigned short* so = SEL + (size_t)t * TOPK;
        if (n <= TOPK) { for (int i = lane; i < n; i += 64) so[i] = (unsigned short)i; if (t + NGW < NTOK) SEL_DMA(t + NGW); continue; }
        asm volatile("s_waitcnt vmcnt(0)" ::: "memory");
        u32x4 d[16];
        const int lastsg = (n - 1) >> 9;
#pragma unroll
        for (int sg = 0; sg < 16; ++sg) {
            if (sg * 512 < n) {
                d[sg] = rowbuf[sg * 64 + lane];
                if (sg == lastsg) {
#pragma unroll
                    for (int q = 0; q < 4; ++q) { const int i0 = sg * 512 + lane * 8 + 2 * q;
                        d[sg][q] &= ((i0 < n) ? 0x0000ffffu : 0u) | ((i0 + 1 < n) ? 0xffff0000u : 0u); }
                }
            } else d[sg] = (u32x4){0u, 0u, 0u, 0u};
        }
        asm volatile("s_waitcnt lgkmcnt(0)" ::: "memory");
        if (t + NGW < NTOK) SEL_DMA(t + NGW);
#pragma unroll
        for (int i = 0; i < 8; ++i) { hist[i * 64 + lane] = 0u; }
        asm volatile("s_waitcnt lgkmcnt(0)" ::: "memory");
        LAS unsigned* myh = hist + (lane & 1) * 256;
        if (MODE == 4) { if (d[0].x == 0x12345u) so[lane] = 1; continue; }
#pragma unroll
        for (int sg = 0; sg < 16; ++sg) if (MODE != 1 && sg * 512 < n) {
#pragma unroll
            for (int q = 0; q < 4; ++q) { const unsigned w = d[sg][q];
                __hip_atomic_fetch_add(myh + ((w >> 8) & 0xffu), 1u, __ATOMIC_RELAXED, __HIP_MEMORY_SCOPE_WORKGROUP);
                __hip_atomic_fetch_add(myh + (w >> 24), 1u, __ATOMIC_RELAXED, __HIP_MEMORY_SCOPE_WORKGROUP); }
        }
        asm volatile("s_waitcnt lgkmcnt(0)" ::: "memory");
        unsigned b1, need1;
        {
            unsigned c[4];
#pragma unroll
            for (int q = 0; q < 4; ++q) c[q] = hist[4 * lane + q] + hist[256 + 4 * lane + q];
            const unsigned mine = c[0] + c[1] + c[2] + c[3];
            unsigned suf = mine;
#pragma unroll
            for (int o = 1; o < 64; o <<= 1) { const unsigned v = __shfl_down(suf, o); if (lane + o < 64) suf += v; }
            const unsigned above = suf - mine;
            int fb = -1; unsigned fneed = 0;
            if (above < (unsigned)TOPK && suf >= (unsigned)TOPK) { unsigned a = above;
#pragma unroll
                for (int q = 3; q >= 0; --q) { if (fb < 0 && a + c[q] >= (unsigned)TOPK) { fb = 4 * lane + q; fneed = (unsigned)TOPK - a; } a += c[q]; } }
            const unsigned long long bal = __ballot(fb >= 0);
            const int src = (int)__builtin_ctzll(bal);
            b1 = (unsigned)__shfl(fb, src); need1 = __shfl(fneed, src);
        }
#pragma unroll
        for (int i = 0; i < 8; ++i) { hist[i * 64 + lane] = 0u; }
        asm volatile("s_waitcnt lgkmcnt(0)" ::: "memory");
#pragma unroll
        for (int sg = 0; sg < 16; ++sg) if (MODE != 2 && sg * 512 < n) {
#pragma unroll
            for (int q = 0; q < 4; ++q) { const unsigned w = d[sg][q];
                LAS unsigned* p0 = (((w >> 8) & 0xffu) == b1) ? (myh + (w & 0xffu)) : dummy;
                LAS unsigned* p1 = ((w >> 24) == b1) ? (myh + ((w >> 16) & 0xffu)) : dummy;
                __hip_atomic_fetch_add(p0, 1u, __ATOMIC_RELAXED, __HIP_MEMORY_SCOPE_WORKGROUP);
                __hip_atomic_fetch_add(p1, 1u, __ATOMIC_RELAXED, __HIP_MEMORY_SCOPE_WORKGROUP); }
        }
        asm volatile("s_waitcnt lgkmcnt(0)" ::: "memory");
        unsigned T, need2;
        {
            unsigned c[4];
#pragma unroll
            for (int q = 0; q < 4; ++q) c[q] = hist[4 * lane + q] + hist[256 + 4 * lane + q];
            const unsigned mine = c[0] + c[1] + c[2] + c[3];
            unsigned suf = mine;
#pragma unroll
            for (int o = 1; o < 64; o <<= 1) { const unsigned v = __shfl_down(suf, o); if (lane + o < 64) suf += v; }
            const unsigned above = suf - mine;
            int fb = -1; unsigned fneed = 0;
            if (above < need1 && suf >= need1) { unsigned a = above;
#pragma unroll
                for (int q = 3; q >= 0; --q) { if (fb < 0 && a + c[q] >= need1) { fb = 4 * lane + q; fneed = need1 - a; } a += c[q]; } }
            const unsigned long long bal = __ballot(fb >= 0);
            const int src = (int)__builtin_ctzll(bal);
            T = (b1 << 8) | (unsigned)__shfl(fb, src); need2 = __shfl(fneed, src);
        }
        unsigned base = 0; const unsigned ngt = (unsigned)TOPK - need2; unsigned eqbase = 0;
#pragma unroll
        for (int sg = 0; sg < 16; ++sg) if (MODE != 3 && sg * 512 < n) {
            unsigned ce = 0;
#pragma unroll
            for (int j = 0; j < 8; ++j) {
                const unsigned k = (j & 1) ? (d[sg][j >> 1] >> 16) : (d[sg][j >> 1] & 0xffffu);
                const bool gt = k > T;
                const unsigned long long mk = __ballot(gt);
                const unsigned pos = base + (unsigned)__builtin_amdgcn_mbcnt_hi((unsigned)(mk >> 32), __builtin_amdgcn_mbcnt_lo((unsigned)mk, 0u));
                LAS unsigned short* po = gt ? (outw + pos) : dummy16;
                *po = (unsigned short)(sg * 512 + lane * 8 + j);
                base += (unsigned)__builtin_popcountll(mk);
                ce += (k == T) ? 1u : 0u;
            }
            if (__any(ce > 0u)) {
                unsigned pre = ce;
#pragma unroll
                for (int o = 1; o < 64; o <<= 1) { const unsigned v = __shfl_up(pre, o); if (lane >= o) pre += v; }
                unsigned r = eqbase + pre - ce;
#pragma unroll
                for (int j = 0; j < 8; ++j) { const unsigned k = (j & 1) ? (d[sg][j >> 1] >> 16) : (d[sg][j >> 1] & 0xffffu);
                    if (k == T) { if (r < need2) outw[ngt + r] = (unsigned short)(sg * 512 + lane * 8 + j); ++r; } }
                eqbase += __shfl(pre, 63);
            }
        }
        asm volatile("s_waitcnt lgkmcnt(0)" ::: "memory");
        ((unsigned*)so)[lane] = ((LAS unsigned*)outw)[lane];
        ((unsigned*)so)[64 + lane] = ((LAS unsigned*)outw)[64 + lane];
        asm volatile("s_waitcnt lgkmcnt(0)" ::: "memory");
    }
#undef SEL_DMA
    asm volatile("s_waitcnt vmcnt(0)" ::: "memory");
}

__device__ __forceinline__ void ret_fill_image(LAS unsigned char* img, const unsigned char* src, size_t row_stride_bytes, int wave, int lane) {
#pragma unroll
    for (int e4 = 0; e4 < 4; ++e4) {
        const int e = wave * 4 + e4, row = 4 * e + (lane >> 4), q = (lane & 15) ^ ((row & 7) << 1);
        __builtin_amdgcn_global_load_lds((const unsigned*)(src + (size_t)row * row_stride_bytes + q * 16), (LAS unsigned*)(img + e * 1024), 16, 0, 0);
    }
}
__device__ __forceinline__ pg8::bf16x8 ret_tr_pair(const LAS unsigned char* img, int row0, int chunk2, int lane) {
    const int g = lane >> 4, i = lane & 15, r0 = row0 + 4 * g + (i >> 2), pb = (i & 3) >> 1, half = (i & 1) * 8;
    const int r1 = r0 + 16;
    const v4i16_t lo = __builtin_amdgcn_ds_read_tr16_b64_v4i16((LAS v4i16_t*)(img + r0 * 256 + ((((chunk2) ^ ((r0 & 7) << 1)) | pb) << 4) + half));
    const v4i16_t hi = __builtin_amdgcn_ds_read_tr16_b64_v4i16((LAS v4i16_t*)(img + r1 * 256 + ((((chunk2) ^ ((r1 & 7) << 1)) | pb) << 4) + half));
    return (pg8::bf16x8){lo[0], lo[1], lo[2], lo[3], hi[0], hi[1], hi[2], hi[3]};
}
__device__ __forceinline__ void phase_ret_kv_mfma(const Params& P, unsigned char* lds_) {
    using pg8::bf16x8;
    const unsigned char* Z0 = (const unsigned char*)(P.ws + WS_Z0); float* KV = (float*)(P.ws + WS_KV);
    LAS unsigned char* Kimg = (LAS unsigned char*)lds_; LAS unsigned char* Vimg = Kimg + 32768;
    const int tid = threadIdx.x, lane = tid & 63, wave = __builtin_amdgcn_readfirstlane(tid >> 6), fr = lane & 15, fq = lane >> 4;
    for (int u = blockIdx.x; u < 1024; u += gridDim.x) {
        const int n = u & 63, h = (u >> 6) & 3, b = u >> 8;
        const size_t row0 = (size_t)b * SEQ + n * 128;
        __syncthreads();
        ret_fill_image(Kimg, Z0 + row0 * ZW * 2 + (512 + h * 128) * 2, ZW * 2, wave, lane);
        ret_fill_image(Vimg, Z0 + row0 * ZW * 2 + (1024 + h * 128) * 2, ZW * 2, wave, lane);
        asm volatile("s_waitcnt vmcnt(0)" ::: "memory");
        __syncthreads();
        bf16x8 va[4];
#pragma unroll
        for (int jc = 0; jc < 4; ++jc) va[jc] = ret_tr_pair(Vimg, 32 * jc, 2 * wave, lane);
        const float g127 = exp2f(ret_log2g(h) * 127.0f);
        float* o = KV + (size_t)u * 16384;
#pragma unroll
        for (int dt = 0; dt < 8; ++dt) {
            f32x4 acc = {0.f, 0.f, 0.f, 0.f};
#pragma unroll
            for (int jc = 0; jc < 4; ++jc) acc = __builtin_amdgcn_mfma_f32_16x16x32_bf16(va[jc], ret_tr_pair(Kimg, 32 * jc, 2 * dt, lane), acc, 0, 0, 0);
            *(f32x4*)(o + (size_t)(16 * dt + fr) * 128 + 16 * wave + 4 * fq) = acc * g127;
        }
    }
}
__device__ __forceinline__ void phase_ret_scan_pool2(const Params& P) {
    const float* KV = (const float*)(P.ws + WS_KV); bf16_t* SB = (bf16_t*)(P.ws + WS_SB);
    const size_t gt = (size_t)blockIdx.x * NT + threadIdx.x, GS = (size_t)gridDim.x * NT;
    for (size_t i = gt; i < (size_t)16 * 8192; i += GS) {
        const int s = (int)(i >> 13), e2 = (int)(i & 8191), h = s & 3;
        const float l2 = ret_log2g(h), cd = exp2f(l2 * 128.0f), g1 = exp2f(l2);
        typedef float f32x2v __attribute__((ext_vector_type(2)));
        const f32x2v* p = (const f32x2v*)(KV + (size_t)s * 64 * 16384) + e2;
        unsigned* q = (unsigned*)(SB + (size_t)s * 64 * 16384) + e2;
        f32x2v R = {0.f, 0.f};
        for (int n0 = 0; n0 < 64; n0 += 16) {
            f32x2v kv[16];
#pragma unroll
            for (int j = 0; j < 16; ++j) kv[j] = __builtin_nontemporal_load(p + (size_t)(n0 + j) * 8192);
#pragma unroll
            for (int j = 0; j < 16; ++j) { q[(size_t)(n0 + j) * 8192] = pk2(R.x * g1, R.y * g1); R = R * cd + kv[j]; }
        }
    }
    const bf16_t* Z0 = (const bf16_t*)(P.ws + WS_Z0); bf16_t* DP = (bf16_t*)(P.ws + WS_DP);
    for (size_t i = gt; i < (size_t)NTOK * 64; i += GS) {
        const int t = (int)(i >> 6), c8 = (int)(i & 63) * 8, g = c8 >> 7, w = 2 << g, tl = t & (SEQ - 1);
        const int cnt = min(tl + 1, w);
        float sm[8];
#pragma unroll
        for (int j = 0; j < 8; ++j) sm[j] = 0.f;
        float u0[8];
        for (int q = 0; q < cnt; ++q) {
            const u32x4 v = *(const u32x4*)(Z0 + (size_t)(t - q) * ZW + 2048 + c8);
            const float f[8] = {bflo(v.x), bfhi(v.x), bflo(v.y), bfhi(v.y), bflo(v.z), bfhi(v.z), bflo(v.w), bfhi(v.w)};
#pragma unroll
            for (int j = 0; j < 8; ++j) { sm[j] += f[j]; if (q == 0) u0[j] = f[j]; }
        }
        const float inv = 1.0f / (float)cnt;
        u32x4 o; o.x = pk2(sm[0] * inv - u0[0], sm[1] * inv - u0[1]); o.y = pk2(sm[2] * inv - u0[2], sm[3] * inv - u0[3]);
        o.z = pk2(sm[4] * inv - u0[4], sm[5] * inv - u0[5]); o.w = pk2(sm[6] * inv - u0[6], sm[7] * inv - u0[7]);
        *(u32x4*)(DP + (size_t)t * 512 + c8) = o;
    }
}
__device__ __forceinline__ void phase_ret_out_mfma(const Params& P, unsigned char* lds_) {
    using pg8::bf16x8;
    const unsigned char* Z0 = (const unsigned char*)(P.ws + WS_Z0); const unsigned char* SB = (const unsigned char*)(P.ws + WS_SB); bf16_t* MIX = (bf16_t*)(P.ws + WS_MIX);
    const float* gn = P.in[3];
    LAS unsigned char* Kimg = (LAS unsigned char*)lds_; LAS unsigned char* Vimg = Kimg + 32768; LAS unsigned char* Rimg = Kimg + 65536;
    const int tid = threadIdx.x, lane = tid & 63, wave = __builtin_amdgcn_readfirstlane(tid >> 6), fr = lane & 15, fq = lane >> 4;
    for (int u = blockIdx.x; u < 1024; u += gridDim.x) {
        const int n = u & 63, h = (u >> 6) & 3, b = u >> 8;
        const size_t row0 = (size_t)b * SEQ + n * 128;
        __syncthreads();
        ret_fill_image(Kimg, Z0 + row0 * ZW * 2 + (512 + h * 128) * 2, ZW * 2, wave, lane);
        ret_fill_image(Vimg, Z0 + row0 * ZW * 2 + (1024 + h * 128) * 2, ZW * 2, wave, lane);
        ret_fill_image(Rimg, SB + (size_t)u * 32768, 256, wave, lane);
        const bf16_t* qrow = (const bf16_t*)Z0 + (row0 + 16 * wave + fr) * ZW + h * 128;
        bf16x8 qf[4], qr[4];
#pragma unroll
        for (int c = 0; c < 4; ++c) {
            qf[c] = *(const bf16x8*)(qrow + 32 * c + 8 * fq);
            const u32x2 a = *(const u32x2*)(qrow + 32 * c + 4 * fq), bb = *(const u32x2*)(qrow + 32 * c + 16 + 4 * fq);
            u32x4 w; w.x = a.x; w.y = a.y; w.z = bb.x; w.w = bb.y; qr[c] = __builtin_bit_cast(bf16x8, w);
        }
        asm volatile("s_waitcnt vmcnt(0)" ::: "memory");
        __syncthreads();
        f32x4 sT[8];
#pragma unroll
        for (int jt = 0; jt < 8; ++jt) sT[jt] = (f32x4){0.f, 0.f, 0.f, 0.f};
#pragma unroll
        for (int jt = 0; jt < 8; ++jt) if (jt <= wave) {
            const int r = 16 * jt + fr;
#pragma unroll
            for (int c = 0; c < 4; ++c) {
                const bf16x8 a = *(const LAS bf16x8*)(Kimg + r * 256 + ((((4 * c + fq)) ^ ((r & 7) << 1)) << 4));
                sT[jt] = __builtin_amdgcn_mfma_f32_16x16x32_bf16(a, qf[c], sT[jt], 0, 0, 0);
            }
            if (jt == wave) {
                if (4 * fq + 0 > fr) sT[jt].x = 0.f; if (4 * fq + 1 > fr) sT[jt].y = 0.f; if (4 * fq + 2 > fr) sT[jt].z = 0.f; if (4 * fq + 3 > fr) sT[jt].w = 0.f;
            }
        }
        bf16x8 pT[4];
#pragma unroll
        for (int jp = 0; jp < 4; ++jp) { u32x4 w; w.x = pk2(sT[2 * jp].x, sT[2 * jp].y); w.y = pk2(sT[2 * jp].z, sT[2 * jp].w); w.z = pk2(sT[2 * jp + 1].x, sT[2 * jp + 1].y); w.w = pk2(sT[2 * jp + 1].z, sT[2 * jp + 1].w);
            pT[jp] = __builtin_bit_cast(bf16x8, w); }
        f32x4 O[8];
#pragma unroll
        for (int vt = 0; vt < 8; ++vt) {
            f32x4 acc = {0.f, 0.f, 0.f, 0.f};
#pragma unroll
            for (int jp = 0; jp < 4; ++jp) if (2 * jp <= wave) acc = __builtin_amdgcn_mfma_f32_16x16x32_bf16(ret_tr_pair(Vimg, 32 * jp, 2 * vt, lane), pT[jp], acc, 0, 0, 0);
#pragma unroll
            for (int c = 0; c < 4; ++c) acc = __builtin_amdgcn_mfma_f32_16x16x32_bf16(ret_tr_pair(Rimg, 32 * c, 2 * vt, lane), qr[c], acc, 0, 0, 0);
            O[vt] = acc;
        }
        float sm = 0.f;
#pragma unroll
        for (int vt = 0; vt < 8; ++vt) sm += (O[vt].x + O[vt].y) + (O[vt].z + O[vt].w);
        sm += __shfl_xor(sm, 16); sm += __shfl_xor(sm, 32);
        const float mu = sm * (1.0f / 128.0f);
        float sq = 0.f;
#pragma unroll
        for (int vt = 0; vt < 8; ++vt) { const f32x4 dlt = O[vt] - mu; sq += (dlt.x * dlt.x + dlt.y * dlt.y) + (dlt.z * dlt.z + dlt.w * dlt.w); }
        sq += __shfl_xor(sq, 16); sq += __shfl_xor(sq, 32);
        const float rstd = 1.0f / sqrtf(sq * (1.0f / 128.0f) + LN_EPS);
        const bf16_t* grow = (const bf16_t*)Z0 + (row0 + 16 * wave + fr) * ZW + 1536 + h * 128 + 4 * fq;
        bf16_t* orow = MIX + (row0 + 16 * wave + fr) * DM + h * 128 + 4 * fq;
#pragma unroll
        for (int vt = 0; vt < 8; ++vt) {
            const u32x2 gv = *(const u32x2*)(grow + 16 * vt);
            const f32x4 g4 = *(const f32x4*)(gn + h * 128 + 16 * vt + 4 * fq);
            const f32x4 y = (O[vt] - mu) * rstd * g4;
            u32x2 w; w.x = pk2(y.x * silu_f(bflo(gv.x)), y.y * silu_f(bfhi(gv.x))); w.y = pk2(y.z * silu_f(bflo(gv.y)), y.w * silu_f(bfhi(gv.y)));
            *(u32x2*)(orow + 16 * vt) = w;
        }
    }
}

#define XB_TMO      128
#define XB_XCNT(j)  (256  + 64 * (j))
#define XB_XSUB(j)  (1280 + 64 * (j))
#define XB_XGEN(j)  (2304 + 64 * (j))
#define XB_TOP      3328
#define XB_TOPGEN   3392
#define XCD_BAR_WORDS 3456
#define XB_SPIN_CAP (1u << 22)
__device__ __forceinline__ unsigned xb_ld(unsigned* p)              { return __hip_atomic_load(p, __ATOMIC_RELAXED, __HIP_MEMORY_SCOPE_AGENT); }
__device__ __forceinline__ unsigned xb_add(unsigned* p, unsigned v) { return __hip_atomic_fetch_add(p, v, __ATOMIC_RELAXED, __HIP_MEMORY_SCOPE_AGENT); }
__device__ __forceinline__ unsigned xb_xcc_id() { return (unsigned)__builtin_amdgcn_s_getreg((3 << 11) | 20) & 0xFu; }
#define XB_SPIN(cond, bar) do { unsigned _sp = 0; while (cond) { __builtin_amdgcn_s_sleep(1); \
    if ((++_sp & 255u) == 0u) { if (xb_ld(&(bar)[XB_TMO])) break; if (_sp > XB_SPIN_CAP) { atomicAdd(&(bar)[XB_TMO], 1u); break; } } } } while (0)
struct XcdBarrier { unsigned* bar; unsigned x; volatile LAS unsigned* st; };
__device__ __forceinline__ XcdBarrier xcd_barrier_post(unsigned* bar, volatile LAS unsigned* st) {
    XcdBarrier b; b.bar = bar; b.x = xb_xcc_id(); b.st = st;
    if (threadIdx.x == 0) (void)xb_add(&bar[XB_XCNT(b.x)], 1u);
    return b;
}
__device__ __forceinline__ void xcd_barrier_complete(unsigned* bar, unsigned x, unsigned& nloc, unsigned& nx) {
    const unsigned G = gridDim.x * gridDim.y * gridDim.z;
    unsigned sum, cnt, mine, sp = 0u;
    for (;;) {
        sum = 0u; cnt = 0u; mine = 0u;
#pragma unroll
        for (unsigned j = 0; j < 16; ++j) { const unsigned c = xb_ld(&bar[XB_XCNT(j)]); sum += c; cnt += (c > 0u) ? 1u : 0u; mine = (j == x) ? c : mine; }
        if (sum == G) break;
        __builtin_amdgcn_s_sleep(1);
        if ((++sp & 255u) == 0u) { if (xb_ld(&bar[XB_TMO])) break; if (sp > XB_SPIN_CAP) { atomicAdd(&bar[XB_TMO], 1u); break; } }
    }
    nloc = mine > 0u ? mine : 1u; nx = cnt > 0u ? cnt : 1u;
}
__device__ __forceinline__ void xcd_barrier(const XcdBarrier& b) {
    asm volatile("s_waitcnt vmcnt(0)" ::: "memory");
    __syncthreads();
    if (threadIdx.x == 0) {
        unsigned* bar = b.bar;
        __builtin_amdgcn_s_waitcnt(0);
        unsigned nloc = b.st[0], nx = b.st[1];
        if (nloc == 0u) { xcd_barrier_complete(bar, b.x, nloc, nx); b.st[0] = nloc; b.st[1] = nx; }
        const unsigned old = xb_add(&bar[XB_XSUB(b.x)], 1u);
        const unsigned gen = old / nloc;
        if (old + 1u == (gen + 1u) * nloc) {
            __builtin_amdgcn_fence(__ATOMIC_RELEASE, "agent");
            asm volatile("s_waitcnt vmcnt(0)" ::: "memory");
            const unsigned og = xb_add(&bar[XB_TOP], 1u);
            const unsigned tg = og / nx;
            if (og + 1u == (tg + 1u) * nx) xb_add(&bar[XB_TOPGEN], 1u);
            else XB_SPIN(xb_ld(&bar[XB_TOPGEN]) == tg, bar);
            __builtin_amdgcn_fence(__ATOMIC_ACQUIRE, "agent");
            xb_add(&bar[XB_XGEN(b.x)], 1u);
            asm volatile("s_waitcnt vmcnt(0)" ::: "memory");
        } else {
            XB_SPIN(xb_ld(&bar[XB_XGEN(b.x)]) == gen, bar);
            __builtin_amdgcn_fence(__ATOMIC_ACQUIRE, "agent");
            asm volatile("s_waitcnt vmcnt(0)" ::: "memory");
        }
    }
    __syncthreads();
}
constexpr size_t CTL_BAR_OFF = 16384;
constexpr size_t CTL_ZERO_BYTES = 65536;

#ifdef PH_ONLY
#define IN(k) ((k) == PH_ONLY)
#else
#define IN(k) (lo <= (k) && (k) < hi)
#endif
#define SEAM(k) do { if (IN(k) && IN((k) + 1)) xcd_barrier(grid); } while (0)
#ifndef PROBE_DUP
#define PROBE_DUP (-1)
#endif
#define REP(k) for (int _rep = 0; _rep < ((PROBE_DUP == (k)) ? 2 : 1); ++_rep)
#define REPS(k) ((PROBE_DUP == 100 + (k)) ? 2 : 1)

template <int LAYER, int BASE>
__device__ __forceinline__ void layer_tail(const Params& P, unsigned char* lds, const XcdBarrier& grid, int lo, int hi) {
    unsigned char* ws = P.ws;
    int* tb = (int*)(lds + MISC_OFF);
    if (IN(BASE)) { if (PROBE_DUP == BASE) phase_ln_route<true>(P, lds, LAYER); phase_ln_route<false>(P, lds, LAYER); }
    SEAM(BASE);
    if (IN(BASE + 1)) REP(BASE + 1) { moe_setup(P, tb, LAYER);
        MoeSched S{tb, (const int*)(ws + WS_CTL) + LAYER * 64, (const int*)(ws + WS_LIST), (const bf16_t*)(ws + WS_XB),
                   (const bf16_t*)(ws + WS_W_GU) + (size_t)LAYER * 32 * DM * DM, DM, (size_t)DM * DM, true};
        EpiGU E{(bf16_t*)(ws + WS_ACT)}; gemm_moe<true>(lds, S, E);
        { const int U = tb[32] * 4, G = (int)gridDim.x, nheavy = (U % G), nlight = G - nheavy, lr = (int)blockIdx.x - nheavy;
          DenseSched S2{(const bf16_t*)(ws + WS_PB) + (size_t)LAYER * NTOK * 256, (const bf16_t*)(ws + WS_W_P) + (size_t)LAYER * DM * 256, NTOK, DM, 256, 256, 0, 1, lr, nlight};
          EpiStoreBf16 E2{(bf16_t*)(ws + WS_PP), DM, 0, nullptr}; gemm_dense(lds, S2, E2); } }
    SEAM(BASE + 1);
    if (IN(BASE + 2)) REP(BASE + 2) { moe_setup(P, tb, LAYER);
        MoeSched S{tb, (const int*)(ws + WS_CTL) + LAYER * 64, (const int*)(ws + WS_LIST), (const bf16_t*)(ws + WS_ACT),
                   (const bf16_t*)(ws + WS_W_DN) + (size_t)LAYER * 32 * DM * 512, 512, (size_t)DM * 512, false};
        EpiDown E{(bf16_t*)(ws + WS_YS)}; gemm_moe<false>(lds, S, E); }
    SEAM(BASE + 2);
    if (IN(BASE + 3)) { if (PROBE_DUP == BASE + 3) phase_ln2<true>(P, LAYER); phase_ln2<false>(P, LAYER); }
    SEAM(BASE + 3);
    if (IN(BASE + 4)) REP(BASE + 4) {
        { DenseSched S{(const bf16_t*)(ws + WS_XB), (const bf16_t*)(ws + WS_W_G) + (size_t)LAYER * DM * DM, NTOK, DM, DM, DM, 0, REPS(BASE + 4)};
          EpiPle E{(const bf16_t*)(ws + WS_XB), (const bf16_t*)(ws + WS_PP), LAYER == 1 ? P.out : (float*)nullptr, LAYER == 1 ? (bf16_t*)nullptr : (bf16_t*)(ws + WS_XB2)}; gemm_dense(lds, S, E); }
    }
}

__global__ void __launch_bounds__(NT, 2) mega(Params P, int lo, int hi) {
    extern __shared__ __attribute__((aligned(16))) unsigned char lds[];
    unsigned char* ws = P.ws;
    if (threadIdx.x < 16) ((LAS unsigned*)((LAS unsigned char*)lds + BARW_OFF))[threadIdx.x] = 0u;
    __syncthreads();
    const XcdBarrier grid = xcd_barrier_post((unsigned*)(ws + WS_CTL + CTL_BAR_OFF), (volatile LAS unsigned*)((LAS unsigned char*)lds + BARW_OFF));
    if (IN(0)) REP(0) phase_prep(P, lds);
    SEAM(0);
    if (IN(1)) REP(1) { DenseSched S{(const bf16_t*)(ws + WS_XB), (const bf16_t*)(ws + WS_W_IN0), NTOK, ZW, DM, DM, 0, REPS(1)};
        EpiZ0 E{(bf16_t*)(ws + WS_Z0)}; gemm_dense(lds, S, E); }
    SEAM(1);
    if (IN(2)) REP(2) phase_ret_kv_mfma(P, lds);
    SEAM(2);
    if (IN(3)) REP(3) phase_ret_scan_pool2(P);
    SEAM(3);
    if (IN(4)) REP(4) { phase_ret_out_mfma(P, lds); __syncthreads();
        DenseSched S{(const bf16_t*)(ws + WS_DP), (const bf16_t*)(ws + WS_W_POOL), NTOK, 512, 256, 512, 256};
        EpiStoreBf16 E{(bf16_t*)(ws + WS_MIX), DM, 512, P.in[5]}; gemm_dense(lds, S, E); }
    SEAM(4);
    if (IN(5)) REP(5) { DenseSched S{(const bf16_t*)(ws + WS_MIX), (const bf16_t*)(ws + WS_W_OUT0), NTOK, DM, DM, DM, 0, REPS(5)};
        EpiResidB E{(const bf16_t*)(ws + WS_XB), (bf16_t*)(ws + WS_F)}; gemm_dense(lds, S, E); }
    SEAM(5);
    layer_tail<0, 6>(P, lds, grid, lo, hi);
    SEAM(10);
    if (IN(11)) REP(11) { DenseSched S{(const bf16_t*)(ws + WS_XB2), (const bf16_t*)(ws + WS_W_CIN), NTOK, Z1W, DM, DM, 0, REPS(11)};
        EpiStoreBf16 E{(bf16_t*)(ws + WS_Z1), Z1W, 0, nullptr}; gemm_dense(lds, S, E); }
    SEAM(11);
    if (IN(12)) REP(12) { phase_norms(P); phase_index_scores(P, lds); }
    SEAM(12);
    if (IN(13)) { if (PROBE_DUP == 13) phase_index_select<PROBE_SEL>(P, lds); phase_index_select<0>(P, lds); }
    SEAM(13);
    if (IN(14)) REP(14) { DenseSched S{(const bf16_t*)(ws + WS_CQ), (const bf16_t*)(ws + WS_W_QA), NTOK, 4096, 256, 256, 0, REPS(14)};
        EpiStoreFp8 E{(unsigned char*)(ws + WS_QA), 4096}; gemm_dense(lds, S, E); }
    SEAM(14);
    if (IN(15)) { if (PROBE_DUP == 15) phase_sparse_attn_e<true>(P, lds); phase_sparse_attn_e<false>(P, lds); }
    SEAM(15);
    if (IN(16)) REP(16) { DenseSched S{(const bf16_t*)(ws + WS_OLAT), (const bf16_t*)(ws + WS_W_UVBD), NTOK, DM, DM, 4096, 1024, REPS(16)};
        EpiStoreBf16 E{(bf16_t*)(ws + WS_XB), DM, 0, nullptr}; gemm_dense(lds, S, E); }
    SEAM(16);
    if (IN(17)) REP(17) { DenseSched S{(const bf16_t*)(ws + WS_XB), (const bf16_t*)(ws + WS_W_COUT), NTOK, DM, DM, DM, 0, REPS(17)};
        EpiResidB E{(const bf16_t*)(ws + WS_XB2), (bf16_t*)(ws + WS_F)}; gemm_dense(lds, S, E); }
    SEAM(17);
    layer_tail<1, 18>(P, lds, grid, lo, hi);
}
#undef IN
#undef SEAM

extern "C" void kernel_launch(void* const* d_in, const int* in_sizes, int n_in, void* d_out, int out_size, void* d_ws, size_t ws_size, hipStream_t stream) {
    static int grid = 0;
    if (grid == 0) {
        if (n_in != 26 || ws_size < WS_END || out_size != NTOK * DM) { fprintf(stderr, "kernel_launch: unexpected problem (n_in %d, ws %zu, out %d)\n", n_in, ws_size, out_size); grid = -1; return; }
        int dev = 0, cus = 0, per_cu = 0;
        (void)hipGetDevice(&dev);
        (void)hipDeviceGetAttribute(&cus, hipDeviceAttributeMultiprocessorCount, dev);
        (void)hipFuncSetAttribute((const void*)mega, hipFuncAttributeMaxDynamicSharedMemorySize, LDS_BYTES);
        (void)hipOccupancyMaxActiveBlocksPerMultiprocessor(&per_cu, (const void*)mega, NT, LDS_BYTES);
        if (per_cu < 1) { fprintf(stderr, "kernel_launch: occupancy query reports %d blocks per CU\n", per_cu); per_cu = 1; }
        (void)hipGetLastError();
        grid = cus;
    }
    if (grid < 0) return;
    (void)hipMemsetAsync((char*)d_ws + WS_CTL, 0, CTL_ZERO_BYTES, stream);
    Params p{};
    for (int i = 0; i < 26; ++i) p.in[i] = (const float*)d_in[i];
    p.out = (float*)d_out; p.ws = (unsigned char*)d_ws;
#if MK_ONE_LAUNCH
    int lo = 0, hi = NPH_TOTAL;
    void* args[] = {&p, &lo, &hi};
    (void)args;
    hipLaunchKernelGGL(mega, dim3(grid), dim3(NT), LDS_BYTES, stream, p, lo, hi);
    hipError_t e = hipPeekAtLastError();
    if (e != hipSuccess) fprintf(stderr, "launch failed: %s (grid %d)\n", hipGetErrorString(e), grid);
#else
    for (int k = 0; k < NPH_TOTAL; ++k) hipLaunchKernelGGL(mega, dim3(grid), dim3(NT), LDS_BYTES, stream, p, k, k + 1);
#endif
}
```

```cpp
#include <hip/hip_runtime.h>
#include <hip/hip_cooperative_groups.h>
#include <cstdio>
#include <cstdint>
namespace cg = cooperative_groups;

#ifndef PROBE_ATT
#define PROBE_ATT 0
#endif
#ifndef PROBE_SEL
#define PROBE_SEL 0
#endif
#ifndef MK_ONE_LAUNCH
#define MK_ONE_LAUNCH 1
#endif

typedef unsigned short bf16_t;
typedef float f32x4 __attribute__((ext_vector_type(4)));
typedef unsigned u32x4 __attribute__((ext_vector_type(4)));
typedef unsigned u32x2 __attribute__((ext_vector_type(2)));

constexpr int NT = 512;
constexpr int NWAVE = NT / 64;
constexpr int NTOK = 32768, DM = 1024, SEQ = 8192, NBATCH = 4;
constexpr int ZW = 2560;
constexpr int Z1W = 1280;
constexpr int CIN = 1096;
constexpr int TOPK = 256;
constexpr float ALPHA = 1.4142135623730951f;
constexpr float LN_EPS = 1e-5f;
constexpr int LDS_BYTES = 163840;
constexpr int BARW_OFF = LDS_BYTES - 64;
constexpr int MISC_OFF = 135168;

constexpr size_t MiB = (size_t)1 << 20;
constexpr size_t WS_CTL = 0;
constexpr size_t WS_W_IN0 = 1 * MiB, WS_W_OUT0 = 6 * MiB, WS_W_POOL = 8 * MiB, WS_W_CIN = 9 * MiB, WS_W_QA = 12 * MiB,
                 WS_W_UVBD = 14 * MiB, WS_W_COUT = 16 * MiB, WS_W_G = 18 * MiB, WS_W_P = 22 * MiB, WS_W_GU = 24 * MiB, WS_W_DN = 152 * MiB;
constexpr size_t WS_XB = 224 * MiB, WS_F = 288 * MiB, WS_PB = 416 * MiB, WS_PP = 448 * MiB, WS_CQ = 512 * MiB, WS_CKV = 528 * MiB,
                 WS_SEL = 544 * MiB, WS_TOKG = 560 * MiB, WS_LIST = 561 * MiB, WS_CKV8 = 566 * MiB;
constexpr size_t WS_M0 = 576 * MiB;
constexpr size_t WS_Z0 = WS_M0, WS_KV = WS_M0 + 160 * MiB, WS_MIX = WS_M0 + 224 * MiB, WS_DP = WS_M0 + 288 * MiB, WS_SB = WS_M0 + 320 * MiB;
constexpr size_t WS_OLAT = WS_M0, WS_QA = WS_F  , WS_SC = WS_M0, WS_Z1 = WS_M0 + 272 * MiB;
constexpr size_t WS_ACT = WS_M0, WS_YS = WS_M0 + 72 * MiB;
constexpr size_t WS_XB2 = 960 * MiB;
constexpr size_t WS_END = 1024 * MiB;
constexpr int LIST_CAP = 32768;
constexpr size_t WS_GT = WS_CTL + 262144;
constexpr size_t WS_SGB = WS_CTL + 786432;

struct Params {
    const float* in[26];
    float* out;
    unsigned char* ws;
};

__device__ __forceinline__ unsigned f2bf(float f) { unsigned u = __float_as_uint(f); return (u + 0x7fffu + ((u >> 16) & 1u)) >> 16; }
__device__ __forceinline__ float bf2f(unsigned h) { return __uint_as_float(h << 16); }
typedef float f32x2_t __attribute__((ext_vector_type(2))); typedef __bf16 bf16x2_t __attribute__((ext_vector_type(2)));
__device__ __forceinline__ unsigned pk2(float lo, float hi) { f32x2_t v = {lo, hi}; bf16x2_t b = __builtin_convertvector(v, bf16x2_t); return __builtin_bit_cast(unsigned, b); }
__device__ __forceinline__ float bflo(unsigned w) { return __uint_as_float(w << 16); }
__device__ __forceinline__ float bfhi(unsigned w) { return __uint_as_float(w & 0xffff0000u); }
#define WAVE_SUM_DPP(v) ({ float _v = (v); \
    _v += __builtin_bit_cast(float, __builtin_amdgcn_update_dpp(0, __builtin_bit_cast(int, _v), 0xB1, 0xf, 0xf, true));     \
    _v += __builtin_bit_cast(float, __builtin_amdgcn_update_dpp(0, __builtin_bit_cast(int, _v), 0x4E, 0xf, 0xf, true));     \
    _v += __builtin_bit_cast(float, __builtin_amdgcn_update_dpp(0, __builtin_bit_cast(int, _v), 0x141, 0xf, 0xf, true));    \
    _v += __builtin_bit_cast(float, __builtin_amdgcn_update_dpp(0, __builtin_bit_cast(int, _v), 0x140, 0xf, 0xf, true));    \
    _v += __builtin_bit_cast(float, __builtin_amdgcn_update_dpp(0, __builtin_bit_cast(int, _v), 0x142, 0xa, 0xf, false));   \
    _v += __builtin_bit_cast(float, __builtin_amdgcn_update_dpp(0, __builtin_bit_cast(int, _v), 0x143, 0xc, 0xf, false));   \
    __builtin_bit_cast(float, __builtin_amdgcn_readlane(__builtin_bit_cast(int, _v), 63)); })
__device__ __forceinline__ float wave_sum(float v) { return WAVE_SUM_DPP(v); }
#define WAVE_SCAN_DPP(v) ({ unsigned _v = (v); \
    _v += (unsigned)__builtin_amdgcn_update_dpp(0, (int)_v, 0x111, 0xf, 0xf, false); \
    _v += (unsigned)__builtin_amdgcn_update_dpp(0, (int)_v, 0x112, 0xf, 0xf, false); \
    _v += (unsigned)__builtin_amdgcn_update_dpp(0, (int)_v, 0x114, 0xf, 0xf, false); \
    _v += (unsigned)__builtin_amdgcn_update_dpp(0, (int)_v, 0x118, 0xf, 0xf, false); \
    _v += (unsigned)__builtin_amdgcn_update_dpp(0, (int)_v, 0x142, 0xa, 0xf, false); \
    _v += (unsigned)__builtin_amdgcn_update_dpp(0, (int)_v, 0x143, 0xc, 0xf, false); \
    _v; })

__device__ __forceinline__ float wave_max(float v) {
#pragma unroll
    for (int o = 1; o < 64; o <<= 1) v = fmaxf(v, __shfl_xor(v, o));
    return v;
}
__device__ __forceinline__ float silu_f(float a) { return a / (1.0f + __expf(-a)); }
__device__ __forceinline__ float sigmoid_f(float a) { return 1.0f / (1.0f + __expf(-a)); }
#define LDS_FENCE() asm volatile("s_waitcnt lgkmcnt(0)" ::: "memory")

struct UnitInfo {
    const bf16_t* A; int lda;
    const int* rows; int rshift;
    int nvalid;
    const bf16_t* Bt; int ldb;
    int K;
    int orow0;
    int pn;
};
__device__ __forceinline__ const bf16_t* unit_arow(const UnitInfo& u, int r) {
    if (u.rows) { const int idx = (r < u.nvalid) ? (u.rows[r] >> u.rshift) : 0; return u.A + (size_t)idx * u.lda; }
    return u.A + (size_t)r * u.lda;
}

struct DenseSched {
    const bf16_t* A; const bf16_t* Bt; int M, N, K, lda, a_pn_stride; int reps = 1;
    int wrank = -1, wcount = 0;
    __device__ __forceinline__ bool next(int round, UnitInfo& u) const {
        const int nN = N >> 8, nM = M >> 8, nwg = nN * nM;
        if (wcount > 0 && wrank < 0) return false;
        const long L = (wcount > 0) ? ((long)round * wcount + wrank) : ((long)round * gridDim.x + blockIdx.x); if (L >= (long)nwg * reps) return false;
        int wgid = (int)(L % nwg); { const int q = nwg / 8, r = nwg % 8, xcd = wgid % 8, off = wgid / 8; wgid = (xcd < r ? xcd * (q + 1) : r * (q + 1) + (xcd - r) * q) + off; }
        const int nig = 8 * nN, gid = wgid / nig, fm = gid * 8, gsz = (nM - fm) < 8 ? (nM - fm) : 8;
        const int pm = fm + ((wgid % nig) % gsz), pn = (wgid % nig) / gsz;
        u.A = A + (size_t)pm * 256 * lda + (size_t)pn * a_pn_stride; u.lda = lda; u.rows = nullptr; u.rshift = 0; u.nvalid = 256;
        u.Bt = Bt + (size_t)pn * 256 * K; u.ldb = K; u.K = K; u.orow0 = pm * 256; u.pn = pn;
        return true;
    }
};
struct MoeSched {
    const int* tb; const int* cnt; const int* list;
    const bf16_t* A; const bf16_t* W; int K; size_t wstride; bool gather;
    __device__ __forceinline__ bool next(int round, UnitInfo& u) const {
        const int i = round * gridDim.x + blockIdx.x;
        const int j = i >> 2, pn = i & 3;
        if (j >= tb[32]) return false;
        int e = 0;
        while (tb[e + 1] <= j) ++e;
        const int rb = j - tb[e];
        const int nv = min(256, cnt[e] - rb * 256);
        u.rows = list + (size_t)e * LIST_CAP + rb * 256; u.nvalid = nv; u.orow0 = j * 256; u.pn = pn;
        if (gather) { u.A = A; u.lda = K; u.rshift = 1; }
        else { u.A = A + (size_t)j * 256 * K; u.lda = K; u.rshift = 31;   }
        u.Bt = W + (size_t)e * wstride + (size_t)pn * 256 * K; u.ldb = K; u.K = K;
        return true;
    }
};

template <class Sched, class Epi>
__device__ __forceinline__ void gemm_simple(unsigned char* lds, const Sched& S, const Epi& E, bool contiguousA) {
    float* As = (float*)lds;
    float* Bs = As + 128 * 33;
    const int tid = threadIdx.x, ty = tid >> 3, tx = tid & 7;
    const int lr = tid >> 2, kc = (tid & 3) * 8;
    UnitInfo u;
    for (int round = 0; S.next(round, u); ++round) {
        for (int sm = 0; sm < 2; ++sm) {
            const int ar = sm * 128 + lr;
            const bf16_t* arow = contiguousA ? (u.A + (size_t)ar * u.lda) : unit_arow(u, ar);
            for (int sn = 0; sn < 4; ++sn) {
                float acc[2][8];
#pragma unroll
                for (int a = 0; a < 2; ++a)
#pragma unroll
                    for (int b = 0; b < 8; ++b) acc[a][b] = 0.f;
                const bf16_t* brow = u.Bt + (size_t)(sn * 64 + (tid >> 2)) * u.ldb;
                for (int k0 = 0; k0 < u.K; k0 += 32) {
                    const u32x4 av = *(const u32x4*)(arow + k0 + kc);
                    float* ap = As + lr * 33 + kc;
                    ap[0] = bflo(av.x); ap[1] = bfhi(av.x); ap[2] = bflo(av.y); ap[3] = bfhi(av.y);
                    ap[4] = bflo(av.z); ap[5] = bfhi(av.z); ap[6] = bflo(av.w); ap[7] = bfhi(av.w);
                    if (tid < 256) {
                        const u32x4 bv = *(const u32x4*)(brow + k0 + kc);
                        float* bp = Bs + (tid >> 2) * 33 + kc;
                        bp[0] = bflo(bv.x); bp[1] = bfhi(bv.x); bp[2] = bflo(bv.y); bp[3] = bfhi(bv.y);
                        bp[4] = bflo(bv.z); bp[5] = bfhi(bv.z); bp[6] = bflo(bv.w); bp[7] = bfhi(bv.w);
                    }
                    __syncthreads();
#pragma unroll 8
                    for (int kk = 0; kk < 32; ++kk) {
                        const float a0 = As[(2 * ty) * 33 + kk], a1 = As[(2 * ty + 1) * 33 + kk];
#pragma unroll
                        for (int j = 0; j < 8; ++j) { const float b = Bs[(tx * 8 + j) * 33 + kk]; acc[0][j] += a0 * b; acc[1][j] += a1 * b; }
                    }
                    __syncthreads();
                }
#pragma unroll
                for (int rr = 0; rr < 2; ++rr) {
                    const f32x4 v0 = {acc[rr][0], acc[rr][1], acc[rr][2], acc[rr][3]}, v1 = {acc[rr][4], acc[rr][5], acc[rr][6], acc[rr][7]};
                    E(u, sm * 128 + 2 * ty + rr, sn * 64 + tx * 8, v0, v1);
                }
            }
        }
    }
}


namespace pg8 {
#define LAS __attribute__((address_space(3)))
typedef short bf16x8 __attribute__((ext_vector_type(8)));
constexpr int BK = 64, HALF = 128, HTB = HALF * BK * 2, STAGE_BYTES = 8 * HTB;
__device__ __forceinline__ int lds_byte(int r, int c) { const int st = (r >> 4) * 2 + (c >> 5), rr = r & 15, cc = c & 31, ob = rr * 64 + cc * 2; return st * 1024 + (ob ^ (((ob >> 9) & 1) << 5)); }
__device__ __forceinline__ void stage_rc(int b, int& R, int& C) { const int st = b / 1024, sb = b % 1024, swz = sb ^ (((sb >> 9) & 1) << 5); R = (st >> 1) * 16 + swz / 64; C = (st & 1) * 32 + (swz % 64) / 2; }
__device__ __forceinline__ int perm32(int rho) { const int n = rho >> 4, i = rho & 15; return 8 * (i >> 2) + 4 * n + (i & 3); }

template <bool GATHER, class Sched, class Epi>
__device__ __forceinline__ void gemm_phase(LAS unsigned char* lds, const LAS unsigned* rowtab, const Sched& S, const Epi& E, const int lda, const int ldb, const int K) {
    const int tid = threadIdx.x, wid = __builtin_amdgcn_readfirstlane(tid >> 6), lane = tid & 63, wr = wid >> 2, wc = wid & 3, fr = lane & 15, fq = lane >> 4;
    const int nt = K / BK;
    unsigned voffA[2], voffB[2]; int RA[2]; unsigned CA2[2];
#pragma unroll
    for (int i = 0; i < 2; ++i) { int R, C; stage_rc(tid * 16 + i * 8192, R, C); const int Rb = (R & ~31) + perm32(R & 31);
        voffA[i] = (unsigned)(R * lda + C) * 2u; voffB[i] = (unsigned)(Rb * ldb + C) * 2u; RA[i] = R; CA2[i] = (unsigned)C * 2u; }
    const size_t kstep = (size_t)(BK * 2);
    const size_t hstepA = (size_t)HALF * lda * 2, hstepB = (size_t)HALF * ldb * 2;
    const unsigned ldsw = (unsigned)wid * 1024u;
    const int aoff = lds_byte(wr * 64 + fr, fq * 8), boff = lds_byte(wc * 32 + fr, fq * 8);
    unsigned offA[2][2];
#define PG8_SA(b, h) (((b) * 2 + (h)) * HTB)
#define PG8_SB(b, h) ((4 + (b) * 2 + (h)) * HTB)
#define PG8_STAGE(bufoff, gbase, voff) do { _Pragma("unroll") for (int _i = 0; _i < 2; ++_i) \
        __builtin_amdgcn_global_load_lds((const unsigned*)((const char*)(gbase) + (voff)[_i]), (LAS unsigned*)(lds + (bufoff) + ldsw + _i * 8192), 16, 0, 0); } while (0)
#define PG8_STAGE_A(bufoff, h, gbase) do { if (GATHER) PG8_STAGE(bufoff, gbase, offA[h]); else PG8_STAGE(bufoff, (gbase) + (h) * hstepA, voffA); } while (0)
#define PG8_LOADOFF(round) do { _Pragma("unroll") for (int _h = 0; _h < 2; ++_h) _Pragma("unroll") for (int _i = 0; _i < 2; ++_i) offA[_h][_i] = rowtab[(round) * 256 + _h * 128 + RA[_i]] + CA2[_i]; } while (0)
#define PG8_LDA(dst, b, h) do { _Pragma("unroll") for (int m = 0; m < 4; ++m) _Pragma("unroll") for (int k = 0; k < 2; ++k) dst[m][k] = *(const LAS bf16x8*)(lds + PG8_SA(b, h) + aoff + m * 2048 + k * 1024); } while (0)
#define PG8_LDB(dst, b, h) do { _Pragma("unroll") for (int n = 0; n < 2; ++n) _Pragma("unroll") for (int k = 0; k < 2; ++k) dst[n][k] = *(const LAS bf16x8*)(lds + PG8_SB(b, h) + boff + n * 2048 + k * 1024); } while (0)
#define PG8_MMA(ai, bj, At, Bt) do { __builtin_amdgcn_s_setprio(1); _Pragma("unroll") for (int m = 0; m < 4; ++m) _Pragma("unroll") for (int n = 0; n < 2; ++n) _Pragma("unroll") for (int k = 0; k < 2; ++k) \
        acc[ai][bj][m][n] = __builtin_amdgcn_mfma_f32_16x16x32_bf16(Bt[n][k], At[m][k], acc[ai][bj][m][n], 0, 0, 0); __builtin_amdgcn_s_setprio(0); } while (0)
#define PG8_WAIT_V(n) asm volatile("s_waitcnt vmcnt(" #n ")" ::: "memory")
#define PG8_WAIT_L(n) asm volatile("s_waitcnt lgkmcnt(" #n ")" ::: "memory")
#define PG8_BAR __builtin_amdgcn_s_barrier()
#define PG8_SCHED __builtin_amdgcn_sched_barrier(0)
    UnitInfo cur, nxt; int ui = 0;
    if (!S.next(0, cur)) return;
    f32x4 acc[2][2][4][2];
#pragma unroll
    for (int a = 0; a < 2; ++a)
#pragma unroll
        for (int b = 0; b < 2; ++b)
#pragma unroll
            for (int m = 0; m < 4; ++m)
#pragma unroll
                for (int n = 0; n < 2; ++n) acc[a][b][m][n] = (f32x4){0.f, 0.f, 0.f, 0.f};
    bf16x8 At[4][2], B0[2][2], B1[2][2];
    const char* cA = (const char*)cur.A; const char* cB = (const char*)cur.Bt;
    if (GATHER) { PG8_LOADOFF(0); }
    PG8_STAGE(PG8_SB(0, 0), cB, voffB); PG8_STAGE(PG8_SB(0, 1), cB + hstepB, voffB); PG8_STAGE_A(PG8_SA(0, 0), 0, cA); PG8_STAGE_A(PG8_SA(0, 1), 1, cA);
    if (wr == 1) PG8_BAR;
    PG8_WAIT_V(2); PG8_BAR;
    PG8_STAGE(PG8_SB(1, 0), cB + kstep, voffB); PG8_STAGE_A(PG8_SA(1, 0), 0, cA + kstep); PG8_STAGE(PG8_SB(1, 1), cB + hstepB + kstep, voffB);
    PG8_WAIT_V(6); PG8_BAR;
    for (;;) {
        const bool has_next = S.next(ui + 1, nxt);
        const char* nA = has_next ? (const char*)nxt.A : cA; const char* nB = has_next ? (const char*)nxt.Bt : cB;
        for (int t = 0; t < nt; t += 2) {
            const bool last = (t == nt - 2);
            const char* a1 = cA + (size_t)(t + 1) * kstep;
            const char* a2 = last ? nA : cA + (size_t)(t + 2) * kstep; const char* b2 = last ? nB : cB + (size_t)(t + 2) * kstep;
            const char* a3 = a2 + kstep; const char* b3 = b2 + kstep;
            PG8_LDB(B0, 0, 0); PG8_LDB(B1, 0, 1); PG8_SCHED; PG8_LDA(At, 0, 0); PG8_STAGE_A(PG8_SA(1, 1), 1, a1);
            if (GATHER) { if (last && has_next) { PG8_LOADOFF(ui + 1); } }
            PG8_WAIT_V(8); PG8_WAIT_L(0); PG8_BAR; PG8_MMA(0, 0, At, B0); PG8_MMA(0, 1, At, B1); PG8_BAR; PG8_SCHED;
            PG8_LDA(At, 0, 1); PG8_STAGE(PG8_SB(0, 0), b2, voffB); PG8_STAGE(PG8_SB(0, 1), b2 + hstepB, voffB); PG8_STAGE_A(PG8_SA(0, 0), 0, a2);
            PG8_WAIT_V(8); PG8_WAIT_L(0); PG8_BAR; PG8_MMA(1, 0, At, B0); PG8_MMA(1, 1, At, B1); PG8_BAR; PG8_SCHED;
            PG8_LDB(B0, 1, 0); PG8_LDB(B1, 1, 1); PG8_SCHED; PG8_LDA(At, 1, 0); PG8_STAGE_A(PG8_SA(0, 1), 1, a2);
            PG8_WAIT_V(8); PG8_WAIT_L(0); PG8_BAR; PG8_MMA(0, 0, At, B0); PG8_MMA(0, 1, At, B1); PG8_BAR; PG8_SCHED;
            PG8_LDA(At, 1, 1); PG8_STAGE(PG8_SB(1, 0), b3, voffB); PG8_STAGE(PG8_SB(1, 1), b3 + hstepB, voffB); PG8_STAGE_A(PG8_SA(1, 0), 0, a3);
            PG8_WAIT_V(8); PG8_WAIT_L(0); PG8_BAR; PG8_MMA(1, 0, At, B0); PG8_MMA(1, 1, At, B1); PG8_BAR; PG8_SCHED;
        }
        if (wr == 0) PG8_BAR;
#pragma unroll
        for (int ai = 0; ai < 2; ++ai)
#pragma unroll
            for (int m = 0; m < 4; ++m)
#pragma unroll
                for (int bj = 0; bj < 2; ++bj) E(cur, ai * HALF + wr * 64 + m * 16 + fr, bj * HALF + wc * 32 + 8 * fq, acc[ai][bj][m][0], acc[ai][bj][m][1]);
        if (!has_next) break;
#pragma unroll
        for (int a = 0; a < 2; ++a)
#pragma unroll
            for (int b = 0; b < 2; ++b)
#pragma unroll
                for (int m = 0; m < 4; ++m)
#pragma unroll
                    for (int n = 0; n < 2; ++n) acc[a][b][m][n] = (f32x4){0.f, 0.f, 0.f, 0.f};
        cur = nxt; cA = nA; cB = nB; ++ui;
        if (wr == 1) PG8_BAR;
    }
    PG8_WAIT_V(0);
    PG8_BAR;
#undef PG8_SA
#undef PG8_SB
#undef PG8_STAGE
#undef PG8_STAGE_A
#undef PG8_LOADOFF
#undef PG8_LDA
#undef PG8_LDB
#undef PG8_MMA
#undef PG8_WAIT_V
#undef PG8_WAIT_L
#undef PG8_BAR
#undef PG8_SCHED
}
}

#ifndef USE_PG8_DENSE
#define USE_PG8_DENSE 1
#endif
#ifndef USE_PG8_MOE
#define USE_PG8_MOE 1
#endif
template <class Sched, class Epi>
__device__ __forceinline__ void gemm_dense(unsigned char* lds, const Sched& S, const Epi& E) {
#if USE_PG8_DENSE
    pg8::gemm_phase<false>((LAS unsigned char*)lds, (const LAS unsigned*)nullptr, S, E, S.lda, S.K, S.K);
    __syncthreads();
#else
    gemm_simple(lds, S, E, true);
#endif
}


template <bool GATHER, class Epi>
__device__ __forceinline__ void gemm_moe(unsigned char* lds, const MoeSched& S, const Epi& E) {
#if USE_PG8_MOE
    LAS unsigned* rowtab = (LAS unsigned*)(lds + MISC_OFF + 256);
    if (GATHER) {
        UnitInfo u;
        for (int round = 0; round < 10 && S.next(round, u); ++round)
            if (threadIdx.x < 256) rowtab[round * 256 + threadIdx.x] = ((int)threadIdx.x < u.nvalid) ? (unsigned)(u.rows[threadIdx.x] >> 1) * (unsigned)(S.K * 2) : 0u;
        __syncthreads();
    }
    pg8::gemm_phase<GATHER>((LAS unsigned char*)lds, (const LAS unsigned*)rowtab, S, E, S.K, S.K, S.K);
    __syncthreads();
#else
    gemm_simple(lds, S, E, !GATHER);
#endif
}

__device__ __forceinline__ u32x4 pack8(f32x4 a, f32x4 b) { u32x4 w; w.x = pk2(a.x, a.y); w.y = pk2(a.z, a.w); w.z = pk2(b.x, b.y); w.w = pk2(b.z, b.w); return w; }
struct EpiStoreBf16 {
    bf16_t* O; int ldc; int coff; const float* colscale;
    __device__ __forceinline__ void operator()(const UnitInfo& u, int r, int c, f32x4 v0, f32x4 v1) const {
        const int col = u.pn * 256 + c;
        if (colscale) { const f32x4 s0 = *(const f32x4*)(colscale + col), s1 = *(const f32x4*)(colscale + col + 4); v0 *= s0; v1 *= s1; }
        *(u32x4*)(O + (size_t)(u.orow0 + r) * ldc + coff + col) = pack8(v0, v1);
    }
};

__device__ __forceinline__ float ret_log2g(int h) { return log2f(1.0f - exp2f(-5.0f - (float)h)); }
struct EpiZ0 {
    bf16_t* O;
    __device__ __forceinline__ void operator()(const UnitInfo& u, int r, int c, f32x4 v0, f32x4 v1) const {
        const int col = u.pn * 256 + c, row = u.orow0 + r;
        if (col < 1024) { const float e = ret_log2g((col >> 7) & 3) * (float)(row & 127); const float sc = exp2f(col < 512 ? e : -e); v0 *= sc; v1 *= sc; }
        *(u32x4*)(O + (size_t)row * ZW + col) = pack8(v0, v1);
    }
};

struct EpiStoreF16 {
    unsigned short* O; int ldc;
    __device__ __forceinline__ void operator()(const UnitInfo& u, int r, int c, f32x4 v0, f32x4 v1) const {
        typedef _Float16 h2 __attribute__((ext_vector_type(2)));
        u32x4 w;
        w.x = __builtin_bit_cast(unsigned, (h2){(_Float16)v0.x, (_Float16)v0.y}); w.y = __builtin_bit_cast(unsigned, (h2){(_Float16)v0.z, (_Float16)v0.w});
        w.z = __builtin_bit_cast(unsigned, (h2){(_Float16)v1.x, (_Float16)v1.y}); w.w = __builtin_bit_cast(unsigned, (h2){(_Float16)v1.z, (_Float16)v1.w});
        *(u32x4*)(O + (size_t)(u.orow0 + r) * ldc + u.pn * 256 + c) = w;
    }
};

struct EpiStoreFp8 {
    unsigned char* O; int ldc;
    __device__ __forceinline__ void operator()(const UnitInfo& u, int r, int c, f32x4 v0, f32x4 v1) const {
        int w0 = __builtin_amdgcn_cvt_pk_fp8_f32(v0.x, v0.y, 0, false); w0 = __builtin_amdgcn_cvt_pk_fp8_f32(v0.z, v0.w, w0, true);
        int w1 = __builtin_amdgcn_cvt_pk_fp8_f32(v1.x, v1.y, 0, false); w1 = __builtin_amdgcn_cvt_pk_fp8_f32(v1.z, v1.w, w1, true);
        u32x2 w; w.x = (unsigned)w0; w.y = (unsigned)w1;
        *(u32x2*)(O + (size_t)(u.orow0 + r) * ldc + u.pn * 256 + c) = w;
    }
};
struct EpiResidB {
    const bf16_t* X; bf16_t* Yo;
    __device__ __forceinline__ void operator()(const UnitInfo& u, int r, int c, f32x4 v0, f32x4 v1) const {
        const size_t off = (size_t)(u.orow0 + r) * DM + u.pn * 256 + c;
        const u32x4 xw = *(const u32x4*)(X + off);
        const f32x4 x0 = {bflo(xw.x), bfhi(xw.x), bflo(xw.y), bfhi(xw.y)}, x1 = {bflo(xw.z), bfhi(xw.z), bflo(xw.w), bfhi(xw.w)};
        *(u32x4*)(Yo + off) = pack8(x0 * ALPHA + v0, x1 * ALPHA + v1);
    }
};

struct EpiGU {
    bf16_t* ACT;
    __device__ __forceinline__ void operator()(const UnitInfo& u, int r, int c, f32x4 v0, f32x4 v1) const {
        u32x2 w; w.x = pk2(silu_f(v0.x) * v0.y, silu_f(v0.z) * v0.w); w.y = pk2(silu_f(v1.x) * v1.y, silu_f(v1.z) * v1.w);
        *(u32x2*)(ACT + (size_t)(u.orow0 + r) * 512 + u.pn * 128 + (c >> 1)) = w;
    }
};
struct EpiDown {
    bf16_t* YS;
    __device__ __forceinline__ void operator()(const UnitInfo& u, int r, int c, f32x4 v0, f32x4 v1) const {
        if (r < u.nvalid) { const int pair = u.rows[r]; *(u32x4*)(YS + (size_t)pair * DM + u.pn * 256 + c) = pack8(v0, v1); }
    }
};
struct EpiPle {
    const bf16_t* XI; const bf16_t* PP; float* OUT; bf16_t* XO;
    __device__ __forceinline__ void operator()(const UnitInfo& u, int r, int c, f32x4 v0, f32x4 v1) const {
        const size_t off = (size_t)(u.orow0 + r) * DM + u.pn * 256 + c;
        const u32x4 pw = *(const u32x4*)(PP + off), xw = *(const u32x4*)(XI + off);
        f32x4 f0 = {bflo(xw.x), bfhi(xw.x), bflo(xw.y), bfhi(xw.y)}, f1 = {bflo(xw.z), bfhi(xw.z), bflo(xw.w), bfhi(xw.w)};
        f0.x += sigmoid_f(v0.x) * bflo(pw.x); f0.y += sigmoid_f(v0.y) * bfhi(pw.x); f0.z += sigmoid_f(v0.z) * bflo(pw.y); f0.w += sigmoid_f(v0.w) * bfhi(pw.y);
        f1.x += sigmoid_f(v1.x) * bflo(pw.z); f1.y += sigmoid_f(v1.y) * bfhi(pw.z); f1.z += sigmoid_f(v1.z) * bflo(pw.w); f1.w += sigmoid_f(v1.w) * bfhi(pw.w);
        if (OUT) { *(f32x4*)(OUT + off) = f0; *(f32x4*)(OUT + off + 4) = f1; }
        if (XO) *(u32x4*)(XO + off) = pack8(f0, f1);
    }
};

struct TrDesc { const float* src; bf16_t* dst; int K, N, Nsrc, nbatch, mode, dst_ld; };
struct TrItem { const float* src; bf16_t* dst; int Nsrc, dst_ld, mode, kb, nb; };
__device__ __forceinline__ void tr_load(const TrItem& t, int lane, float (&tmp)[32]) {
    const int k0 = 64 * t.kb, n0 = 32 * t.nb, Ns = t.Nsrc;
    const bool okc = (n0 + (lane & 31)) < Ns;
    const float* p = t.src + (size_t)(k0 + (lane >> 5)) * Ns + n0 + (lane & 31);
#pragma unroll
    for (int i = 0; i < 32; ++i) { tmp[i] = okc ? __builtin_nontemporal_load(p) : 0.f; p += 2 * Ns; asm volatile("" : "+v"(p)); }
}
__device__ __forceinline__ void tr_store(const TrItem& t, float* scr, int lane, const float (&tmp)[32]) {
    const int k0 = 64 * t.kb, n0 = 32 * t.nb;
#pragma unroll
    for (int i = 0; i < 32; ++i) scr[(2 * i + (lane >> 5)) * 33 + (lane & 31)] = tmp[i];
    LDS_FENCE();
    const int c = lane & 7;
#pragma unroll
    for (int j = 0; j < 4; ++j) {
        const int n = (lane >> 3) + 8 * j; const float* sp = scr + (8 * c) * 33 + n;
        const int ng = n0 + n;
        float sc = 1.f; int nd = ng; int coff = 0;
        if (t.mode == 1) { if (ng >= 512 && ng < 1024) sc = 0.08838834764831845f; }
        if (t.mode == 2) { nd = (ng < 512) ? 2 * ng : 2 * (ng - 512) + 1; }
        if (t.mode == 3) { coff = ((ng >> 6) & 3) * 256; }
        u32x4 o; o.x = pk2(sp[0 * 33] * sc, sp[1 * 33] * sc); o.y = pk2(sp[2 * 33] * sc, sp[3 * 33] * sc); o.z = pk2(sp[4 * 33] * sc, sp[5 * 33] * sc); o.w = pk2(sp[6 * 33] * sc, sp[7 * 33] * sc);
        *(u32x4*)(t.dst + (size_t)nd * t.dst_ld + coff + k0 + 8 * c) = o;
    }
    LDS_FENCE();
}
__device__ __forceinline__ int tr_items(const TrDesc& d) { return d.nbatch * (d.K / 64) * (d.N / 32); }

constexpr int N_DEFERRED = 32 * 512 + 32 * 256;
__device__ __forceinline__ TrItem deferred_item(const Params& P, int idx) {
    TrItem t;
    if (idx < 32 * 512) { const int b = 32 + (idx >> 9), r = idx & 511;
        t.src = P.in[22] + (size_t)b * 1024 * 1024; t.dst = (bf16_t*)(P.ws + WS_W_GU) + (size_t)b * 1024 * 1024; t.Nsrc = 1024; t.dst_ld = 1024; t.mode = 2; t.kb = r >> 5; t.nb = r & 31; }
    else { const int i2 = idx - 32 * 512, b = 32 + (i2 >> 8), r = i2 & 255;
        t.src = P.in[23] + (size_t)b * 512 * 1024; t.dst = (bf16_t*)(P.ws + WS_W_DN) + (size_t)b * 1024 * 512; t.Nsrc = 1024; t.dst_ld = 512; t.mode = 0; t.kb = r >> 5; t.nb = r & 31; }
    return t;
}
__device__ __forceinline__ void phase_prep(const Params& P, unsigned char* lds) {
    unsigned char* ws = P.ws;
    const int tid = threadIdx.x, lane = tid & 63, wave = tid >> 6;
    const int gw = blockIdx.x * NWAVE + wave, NGW = gridDim.x * NWAVE;
    float* scr = (float*)lds + wave * (64 * 33);
    constexpr int ND = 9;
    TrDesc d[ND];
    d[0] = {P.in[22], (bf16_t*)(ws + WS_W_GU), 1024, 1024, 1024, 32, 2, 1024};
    d[1] = {P.in[23], (bf16_t*)(ws + WS_W_DN), 512, 1024, 1024, 32, 0, 512};
    d[2] = {P.in[2], (bf16_t*)(ws + WS_W_IN0), 1024, 2560, 2560, 1, 1, 1024};
    d[3] = {P.in[6], (bf16_t*)(ws + WS_W_OUT0), 1024, 1024, 1024, 1, 0, 1024};
    d[4] = {P.in[13], (bf16_t*)(ws + WS_W_COUT), 1024, 1024, 1024, 1, 0, 1024};
    d[5] = {P.in[24], (bf16_t*)(ws + WS_W_G), 1024, 1024, 1024, 2, 0, 1024};
    d[6] = {P.in[25], (bf16_t*)(ws + WS_W_P), 256, 1024, 1024, 2, 0, 256};
    d[7] = {P.in[7], (bf16_t*)(ws + WS_W_CIN), 1024, Z1W, CIN, 1, 0, 1024};
    d[8] = {P.in[12], (bf16_t*)(ws + WS_W_UVBD), 256, 1024, 1024, 1, 3, 1024};
    int total = 0;
#pragma unroll
    for (int i = 0; i < ND; ++i) total += tr_items(d[i]);
#define TR_DECODE(it, T) do { int _r = (it); bool _f = false; T = TrItem{nullptr, nullptr, 0, 0, 0, 0, 0}; _Pragma("unroll") for (int _i = 0; _i < ND; ++_i) { const int _n = tr_items(d[_i]); \
            if (!_f && _r < _n) { _f = true; const int _per = (d[_i].K / 64) * (d[_i].N / 32), _b = _r / _per, _q = _r % _per, _nblk = d[_i].N / 32; \
                T.src = d[_i].src + (size_t)_b * d[_i].K * d[_i].Nsrc; T.dst = d[_i].dst + (size_t)_b * d[_i].N * d[_i].dst_ld; T.Nsrc = d[_i].Nsrc; T.dst_ld = d[_i].dst_ld; T.mode = d[_i].mode; T.kb = _q / _nblk; T.nb = _q % _nblk; } \
            if (!_f) _r -= _n; } } while (0)
    {
        float cur[32], nxt[32];
        TrItem tc, tn;
        int it = gw;
        if (it < total) { TR_DECODE(it, tc); tr_load(tc, lane, cur); }
        while (it < total) {
            const int itn = it + NGW;
            if (itn < total) { TR_DECODE(itn, tn); tr_load(tn, lane, nxt); }
            tr_store(tc, scr, lane, cur);
#pragma unroll
            for (int i = 0; i < 32; ++i) cur[i] = nxt[i];
            it = itn; tc = tn;
        }
    }
#undef TR_DECODE
    const size_t gt = (size_t)blockIdx.x * NT + tid, GS = (size_t)gridDim.x * NT;
    {
        bf16_t* o = (bf16_t*)(ws + WS_W_POOL); const float* pw = P.in[4];
        for (size_t i = gt; i < 512 * 256; i += GS) { const int n = (int)(i >> 8), k = (int)(i & 255), g = n >> 7, dd = n & 127, kg = k >> 7, c = k & 127;
            o[i] = (bf16_t)((kg == (g & 1)) ? f2bf(pw[((size_t)g * 128 + c) * 128 + dd]) : 0u); }
    }
    {
        u32x4* o = (u32x4*)(ws + WS_W_UVBD);
        for (size_t i = gt; i < (size_t)1024 * 1024 / 8; i += GS) { const int n = (int)(i >> 7), k = (int)(i & 127) * 8; if (((n >> 6) & 3) != (k >> 8)) o[i] = (u32x4){0u, 0u, 0u, 0u}; }
    }
    {
        bf16_t* o = (bf16_t*)(ws + WS_W_QA); const float* uq = P.in[10]; const float* uk = P.in[11];
        float* Bq = (float*)lds; float* Ak = Bq + 256 * 65;
        for (int item = blockIdx.x; item < 128; item += gridDim.x) {
            const int h = item >> 3, c0 = (item & 7) * 32;
            __syncthreads();
            for (int i = tid; i < 256 * 16; i += NT) { const int r = i >> 4, d4 = (i & 15) * 4; const f32x4 v = *(const f32x4*)(uq + (size_t)r * 1024 + h * 64 + d4);
                float* q = Bq + r * 65 + d4; q[0] = v.x; q[1] = v.y; q[2] = v.z; q[3] = v.w; }
            for (int i = tid; i < 32 * 16; i += NT) { const int c = i >> 4, d4 = (i & 15) * 4; const f32x4 v = *(const f32x4*)(uk + (size_t)(c0 + c) * 1024 + h * 64 + d4);
                float* q = Ak + c * 65 + d4; q[0] = v.x; q[1] = v.y; q[2] = v.z; q[3] = v.w; }
            __syncthreads();
            const int r = tid & 255, cg = tid >> 8;
            float acc[16];
#pragma unroll
            for (int j = 0; j < 16; ++j) acc[j] = 0.f;
            for (int dd = 0; dd < 64; ++dd) { const float bv = Bq[r * 65 + dd];
#pragma unroll
                for (int j = 0; j < 16; ++j) acc[j] += Ak[(cg * 16 + j) * 65 + dd] * bv; }
#pragma unroll
            for (int j = 0; j < 16; ++j) o[(size_t)(h * 256 + c0 + cg * 16 + j) * 256 + r] = (bf16_t)f2bf(acc[j] * 0.125f);
        }
        __syncthreads();
    }
    {
        bf16_t* GT = (bf16_t*)(ws + WS_GT); float* SGB = (float*)(ws + WS_SGB);
        for (size_t i = gt; i < (size_t)2 * 48 * 1024; i += GS) {
            const int l = (int)(i / (48 * 1024)), j = (int)((i / 1024) % 48), c = (int)(i & 1023);
            float w = 0.f;
            if (j < 4) w = P.in[18][(size_t)l * DM * 4 + (size_t)c * 4 + j]; else if (j < 36) w = P.in[20][(size_t)l * DM * 32 + (size_t)c * 32 + (j - 4)];
            const float g = P.in[14][l * DM + c] * w;
            const unsigned hi = f2bf(g); const unsigned lo = f2bf(g - bf2f(hi));
            GT[((size_t)(l * 2 + 0) * 48 + j) * 1024 + c] = (bf16_t)hi; GT[((size_t)(l * 2 + 1) * 48 + j) * 1024 + c] = (bf16_t)lo;
        }
        for (int it = gw; it < 96; it += NGW) {
            const int l = it / 48, j = it % 48; float sg = 0.f, sb = 0.f;
            for (int c = lane; c < 1024; c += 64) {
                float w = 0.f;
                if (j < 4) w = P.in[18][(size_t)l * DM * 4 + (size_t)c * 4 + j]; else if (j < 36) w = P.in[20][(size_t)l * DM * 32 + (size_t)c * 32 + (j - 4)];
                sg += P.in[14][l * DM + c] * w; sb += P.in[15][l * DM + c] * w;
            }
            sg = wave_sum(sg); sb = wave_sum(sb);
            const float bias = (j < 4) ? P.in[19][l * 4 + j] : ((j < 36) ? P.in[21][l * 32 + (j - 4)] : 0.f);
            if (lane == 0) { SGB[(l * 2 + 0) * 48 + j] = sg; SGB[(l * 2 + 1) * 48 + j] = sb + bias; }
        }
    }
    {
        const f32x4* x = (const f32x4*)P.in[0]; u32x4* xb = (u32x4*)(ws + WS_XB);
        const size_t nx = (size_t)NTOK * DM / 8, np = (size_t)2 * NTOK * 256 / 8;
        size_t i = gt;
        for (; i + 3 * GS < nx; i += 4 * GS) { f32x4 a[8];
#pragma unroll
            for (int q = 0; q < 4; ++q) { a[2 * q] = __builtin_nontemporal_load(x + 2 * (i + q * GS)); a[2 * q + 1] = __builtin_nontemporal_load(x + 2 * (i + q * GS) + 1); }
#pragma unroll
            for (int q = 0; q < 4; ++q) xb[i + q * GS] = pack8(a[2 * q], a[2 * q + 1]); }
        for (; i < nx; i += GS) xb[i] = pack8(x[2 * i], x[2 * i + 1]);
        const f32x4* p = (const f32x4*)P.in[1]; u32x4* pb = (u32x4*)(ws + WS_PB);
        i = gt;
        for (; i + 3 * GS < np; i += 4 * GS) { f32x4 a[8];
#pragma unroll
            for (int q = 0; q < 4; ++q) { a[2 * q] = __builtin_nontemporal_load(p + 2 * (i + q * GS)); a[2 * q + 1] = __builtin_nontemporal_load(p + 2 * (i + q * GS) + 1); }
#pragma unroll
            for (int q = 0; q < 4; ++q) pb[i + q * GS] = pack8(a[2 * q], a[2 * q + 1]); }
        for (; i < np; i += GS) pb[i] = pack8(p[2 * i], p[2 * i + 1]);
    }
}

__device__ __forceinline__ float ret_logg(int h) { return log1pf(-exp2f(-5.0f - (float)h)); }

__device__ __forceinline__ void phase_ret_kv(const Params& P, unsigned char* lds) {
    const bf16_t* Z0 = (const bf16_t*)(P.ws + WS_Z0); float* KV = (float*)(P.ws + WS_KV);
    float* Ks = (float*)lds; float* Vs = Ks + 128 * 128;
    const int tid = threadIdx.x;
    for (int u = blockIdx.x; u < 1024; u += gridDim.x) {
        const int n = u & 63, h = (u >> 6) & 3, b = u >> 8;
        const float lg = ret_logg(h);
        const size_t row0 = (size_t)b * SEQ + n * 128;
        for (int i = tid; i < 128 * 16; i += NT) {
            const int r = i >> 4, c8 = (i & 15) * 8;
            const u32x4 kv = *(const u32x4*)(Z0 + (row0 + r) * ZW + 512 + h * 128 + c8);
            const u32x4 vv = *(const u32x4*)(Z0 + (row0 + r) * ZW + 1024 + h * 128 + c8);
            const float dec = __expf(lg * (float)(127 - r));
            float* kp = Ks + r * 128 + c8; float* vp = Vs + r * 128 + c8;
            kp[0] = bflo(kv.x) * dec; kp[1] = bfhi(kv.x) * dec; kp[2] = bflo(kv.y) * dec; kp[3] = bfhi(kv.y) * dec;
            kp[4] = bflo(kv.z) * dec; kp[5] = bfhi(kv.z) * dec; kp[6] = bflo(kv.w) * dec; kp[7] = bfhi(kv.w) * dec;
            vp[0] = bflo(vv.x); vp[1] = bfhi(vv.x); vp[2] = bflo(vv.y); vp[3] = bfhi(vv.y);
            vp[4] = bflo(vv.z); vp[5] = bfhi(vv.z); vp[6] = bflo(vv.w); vp[7] = bfhi(vv.w);
        }
        __syncthreads();
        const int dd = tid >> 2, v0 = (tid & 3) * 32;
        float acc[32];
#pragma unroll
        for (int j = 0; j < 32; ++j) acc[j] = 0.f;
        for (int i = 0; i < 128; ++i) {
            const float kd = Ks[i * 128 + dd];
#pragma unroll
            for (int j = 0; j < 32; j += 4) { const f32x4 vv = *(const f32x4*)(Vs + i * 128 + v0 + j); acc[j] += kd * vv.x; acc[j + 1] += kd * vv.y; acc[j + 2] += kd * vv.z; acc[j + 3] += kd * vv.w; }
        }
        float* o = KV + (size_t)u * 16384 + dd * 128 + v0;
#pragma unroll
        for (int j = 0; j < 32; j += 4) *(f32x4*)(o + j) = (f32x4){acc[j], acc[j + 1], acc[j + 2], acc[j + 3]};
        __syncthreads();
    }
}
__device__ __forceinline__ void phase_ret_scan_pool(const Params& P) {
    float* KV = (float*)(P.ws + WS_KV);
    const size_t gt = (size_t)blockIdx.x * NT + threadIdx.x, GS = (size_t)gridDim.x * NT;
    for (size_t i = gt; i < (size_t)16 * 4096; i += GS) {
        const int s = (int)(i >> 12), e4 = (int)(i & 4095), h = s & 3;
        const float cd = __expf(ret_logg(h) * 128.0f);
        f32x4* p = (f32x4*)(KV + (size_t)s * 64 * 16384) + e4;
        f32x4 R = {0.f, 0.f, 0.f, 0.f};
        for (int n0 = 0; n0 < 64; n0 += 8) {
            f32x4 kv[8];
#pragma unroll
            for (int j = 0; j < 8; ++j) kv[j] = p[(size_t)(n0 + j) * 4096];
#pragma unroll
            for (int j = 0; j < 8; ++j) { p[(size_t)(n0 + j) * 4096] = R; R = R * cd + kv[j]; }
        }
    }
    const bf16_t* Z0 = (const bf16_t*)(P.ws + WS_Z0); bf16_t* DP = (bf16_t*)(P.ws + WS_DP);
    for (size_t i = gt; i < (size_t)NTOK * 64; i += GS) {
        const int t = (int)(i >> 6), c8 = (int)(i & 63) * 8, g = c8 >> 7, w = 2 << g, tl = t & (SEQ - 1);
        const int cnt = min(tl + 1, w);
        float s[8];
#pragma unroll
        for (int j = 0; j < 8; ++j) s[j] = 0.f;
        float u0[8];
        for (int q = 0; q < cnt; ++q) {
            const u32x4 v = *(const u32x4*)(Z0 + (size_t)(t - q) * ZW + 2048 + c8);
            const float f[8] = {bflo(v.x), bfhi(v.x), bflo(v.y), bfhi(v.y), bflo(v.z), bfhi(v.z), bflo(v.w), bfhi(v.w)};
#pragma unroll
            for (int j = 0; j < 8; ++j) { s[j] += f[j]; if (q == 0) u0[j] = f[j]; }
        }
        const float inv = 1.0f / (float)cnt;
        u32x4 o; o.x = pk2(s[0] * inv - u0[0], s[1] * inv - u0[1]); o.y = pk2(s[2] * inv - u0[2], s[3] * inv - u0[3]);
        o.z = pk2(s[4] * inv - u0[4], s[5] * inv - u0[5]); o.w = pk2(s[6] * inv - u0[6], s[7] * inv - u0[7]);
        *(u32x4*)(DP + (size_t)t * 512 + c8) = o;
    }
}
__device__ __forceinline__ void phase_ret_out(const Params& P, unsigned char* lds) {
    const bf16_t* Z0 = (const bf16_t*)(P.ws + WS_Z0); const float* KV = (const float*)(P.ws + WS_KV); bf16_t* MIX = (bf16_t*)(P.ws + WS_MIX);
    const float* gn = P.in[3];
    bf16_t* Qs = (bf16_t*)lds;
    bf16_t* Ksm = Qs + 128 * 136;
    float* Sc = (float*)(lds + 2 * 128 * 136 * 2);
    const int tid = threadIdx.x;
    for (int u = blockIdx.x; u < 1024; u += gridDim.x) {
        const int n = u & 63, h = (u >> 6) & 3, b = u >> 8;
        const float lg = ret_logg(h);
        const size_t row0 = (size_t)b * SEQ + n * 128;
        for (int i = tid; i < 128 * 16; i += NT) {
            const int r = i >> 4, c8 = (i & 15) * 8;
            *(u32x4*)(Qs + r * 136 + c8) = *(const u32x4*)(Z0 + (row0 + r) * ZW + h * 128 + c8);
            *(u32x4*)(Ksm + r * 136 + c8) = *(const u32x4*)(Z0 + (row0 + r) * ZW + 512 + h * 128 + c8);
        }
        __syncthreads();
        for (int e = tid; e < 128 * 128; e += NT) {
            const int i = e >> 7, j = e & 127;
            float s = 0.f;
            if (j <= i) {
                const bf16_t* q = Qs + i * 136; const bf16_t* k = Ksm + j * 136;
                for (int dd = 0; dd < 128; dd += 2) { const unsigned qa = *(const unsigned*)(q + dd), ka = *(const unsigned*)(k + dd); s += bflo(qa) * bflo(ka) + bfhi(qa) * bfhi(ka); }
                s *= __expf(lg * (float)(i - j));
            }
            Sc[e] = s;
        }
        __syncthreads();
        const int i = tid >> 2, v0 = (tid & 3) * 32;
        float acc[32];
#pragma unroll
        for (int j = 0; j < 32; ++j) acc[j] = 0.f;
        for (int j = 0; j <= i; ++j) {
            const float s = Sc[i * 128 + j];
            const bf16_t* vr = Z0 + (row0 + j) * ZW + 1024 + h * 128 + v0;
#pragma unroll
            for (int q = 0; q < 4; ++q) { const u32x4 vv = *(const u32x4*)(vr + q * 8);
                acc[q * 8 + 0] += s * bflo(vv.x); acc[q * 8 + 1] += s * bfhi(vv.x); acc[q * 8 + 2] += s * bflo(vv.y); acc[q * 8 + 3] += s * bfhi(vv.y);
                acc[q * 8 + 4] += s * bflo(vv.z); acc[q * 8 + 5] += s * bfhi(vv.z); acc[q * 8 + 6] += s * bflo(vv.w); acc[q * 8 + 7] += s * bfhi(vv.w); }
        }
        const float qdec = __expf(lg * (float)(i + 1));
        const float* S = KV + (size_t)u * 16384;
        for (int dd = 0; dd < 128; ++dd) {
            const float qd = bf2f(Qs[i * 136 + dd]) * qdec;
            const float* sr = S + dd * 128 + v0;
#pragma unroll
            for (int q = 0; q < 32; q += 4) { const f32x4 sv = *(const f32x4*)(sr + q); acc[q] += qd * sv.x; acc[q + 1] += qd * sv.y; acc[q + 2] += qd * sv.z; acc[q + 3] += qd * sv.w; }
        }
        float sm = 0.f;
#pragma unroll
        for (int j = 0; j < 32; ++j) sm += acc[j];
        sm += __shfl_xor(sm, 1); sm += __shfl_xor(sm, 2);
        const float mu = sm * (1.0f / 128.0f);
        float sq = 0.f;
#pragma unroll
        for (int j = 0; j < 32; ++j) { const float dlt = acc[j] - mu; sq += dlt * dlt; }
        sq += __shfl_xor(sq, 1); sq += __shfl_xor(sq, 2);
        const float rstd = 1.0f / sqrtf(sq * (1.0f / 128.0f) + LN_EPS);
        const bf16_t* gr = Z0 + (row0 + i) * ZW + 1536 + h * 128 + v0;
        bf16_t* orow = MIX + (row0 + i) * DM + h * 128 + v0;
#pragma unroll
        for (int q = 0; q < 4; ++q) {
            const u32x4 gv = *(const u32x4*)(gr + q * 8);
            const float g8[8] = {bflo(gv.x), bfhi(gv.x), bflo(gv.y), bfhi(gv.y), bflo(gv.z), bfhi(gv.z), bflo(gv.w), bfhi(gv.w)};
            float o8[8];
#pragma unroll
            for (int j = 0; j < 8; ++j) o8[j] = (acc[q * 8 + j] - mu) * rstd * gn[h * 128 + v0 + q * 8 + j] * silu_f(g8[j]);
            u32x4 w; w.x = pk2(o8[0], o8[1]); w.y = pk2(o8[2], o8[3]); w.z = pk2(o8[4], o8[5]); w.w = pk2(o8[6], o8[7]);
            *(u32x4*)(orow + q * 8) = w;
        }
        __syncthreads();
    }
}

template <bool DRY>
__device__ __forceinline__ void phase_ln_route(const Params& P, unsigned char* lds, int layer) {
    using pg8::bf16x8;
    const bf16_t* F = (const bf16_t*)(P.ws + WS_F); bf16_t* XB = (bf16_t*)(P.ws + (DRY ? WS_M0 + 128 * MiB : WS_XB));
    float* TOKG = (float*)(P.ws + WS_TOKG); int* LIST = (int*)(P.ws + WS_LIST);
    int* CNT = (int*)(P.ws + WS_CTL) + layer * 64;
    const float* lg = P.in[14] + layer * DM; const float* lb = P.in[15] + layer * DM;
    const bf16_t* GTh = (const bf16_t*)(P.ws + WS_GT) + (size_t)(layer * 2) * 48 * 1024; const bf16_t* GTl = GTh + 48 * 1024;
    const float* SG = (const float*)(P.ws + WS_SGB) + (layer * 2) * 48; const float* BB = SG + 48;
    const int tid = threadIdx.x, lane = tid & 63, wave = tid >> 6, r16 = lane & 15, g = lane >> 4;
    int* dec = (int*)lds;
    int* rank = dec + 256;
    int* lcnt = rank + 256;
    int* lbase = lcnt + 32;
    float* stat = (float*)(lds + 4096) + wave * 32;
    float* LG = (float*)(lds + 8192) + wave * (16 * 48);
    f32x4 g4[4], b4[4];
#pragma unroll
    for (int j = 0; j < 4; ++j) { g4[j] = *(const f32x4*)(lg + 256 * j + 4 * lane); b4[j] = *(const f32x4*)(lb + 256 * j + 4 * lane); }
    for (int rb = blockIdx.x; rb < NTOK / 128; rb += gridDim.x) {
        if (tid < 32) lcnt[tid] = 0;
        __syncthreads();
        const int tbase = rb * 128 + wave * 16;
        f32x4 acc[3];
#pragma unroll
        for (int i = 0; i < 3; ++i) acc[i] = (f32x4){0.f, 0.f, 0.f, 0.f};
        float sm = 0.f, sq = 0.f;
        const bf16_t* yrow = F + (size_t)(tbase + r16) * DM + 8 * g;
        const bf16_t* ghp = GTh + (size_t)r16 * 1024 + 8 * g; const bf16_t* glp = GTl + (size_t)r16 * 1024 + 8 * g;
#pragma unroll 2
        for (int k = 0; k < 32; ++k) {
            const u32x4 yw = *(const u32x4*)(yrow + 32 * k);
            bf16x8 gh[3], gl[3];
#pragma unroll
            for (int i = 0; i < 3; ++i) { gh[i] = *(const bf16x8*)(ghp + (size_t)i * 16 * 1024 + 32 * k); gl[i] = *(const bf16x8*)(glp + (size_t)i * 16 * 1024 + 32 * k); }
            const float y0 = bflo(yw.x), y1 = bfhi(yw.x), y2 = bflo(yw.y), y3 = bfhi(yw.y), y4 = bflo(yw.z), y5 = bfhi(yw.z), y6 = bflo(yw.w), y7 = bfhi(yw.w);
            sm += (y0 + y1) + (y2 + y3) + (y4 + y5) + (y6 + y7);
            sq += (y0 * y0 + y1 * y1) + (y2 * y2 + y3 * y3) + (y4 * y4 + y5 * y5) + (y6 * y6 + y7 * y7);
            const bf16x8 yh = __builtin_bit_cast(bf16x8, yw);
#pragma unroll
            for (int i = 0; i < 3; ++i) {
                acc[i] = __builtin_amdgcn_mfma_f32_16x16x32_bf16(yh, gh[i], acc[i], 0, 0, 0);
                acc[i] = __builtin_amdgcn_mfma_f32_16x16x32_bf16(yh, gl[i], acc[i], 0, 0, 0);
            }
        }
        sm += __shfl_xor(sm, 16); sm += __shfl_xor(sm, 32); sq += __shfl_xor(sq, 16); sq += __shfl_xor(sq, 32);
        const float mean = sm * (1.0f / DM), var = fmaxf(sq * (1.0f / DM) - mean * mean, 0.f), rstd = 1.0f / sqrtf(var + LN_EPS);
        if (g == 0) { stat[r16 * 2] = mean; stat[r16 * 2 + 1] = rstd; }
        LDS_FENCE();
#pragma unroll
        for (int i = 0; i < 3; ++i) { const float sg = SG[16 * i + r16], bb = BB[16 * i + r16];
#pragma unroll
            for (int r = 0; r < 4; ++r) { const float mu = stat[(4 * g + r) * 2], rs = stat[(4 * g + r) * 2 + 1];
                LG[(4 * g + r) * 48 + 16 * i + r16] = rs * (acc[i][r] - mu * sg) + bb; } }
        LDS_FENCE();
        if (lane < 16) {
            const float* lr = LG + lane * 48; const int rl = wave * 16 + lane, t = tbase + lane;
            float gl4[4];
#pragma unroll
            for (int j = 0; j < 4; ++j) gl4[j] = lr[j];
            int grp = 0; float gm = gl4[0];
#pragma unroll
            for (int j = 1; j < 4; ++j) if (gl4[j] > gm) { gm = gl4[j]; grp = j; }
            float gs = 0.f;
#pragma unroll
            for (int j = 0; j < 4; ++j) gs += __expf(gl4[j] - gm);
            const float gwt = 1.0f / gs;
            float el[8];
#pragma unroll
            for (int j = 0; j < 8; ++j) el[j] = lr[4 + grp * 8 + j];
            int i0 = 0; float m0 = el[0];
#pragma unroll
            for (int j = 1; j < 8; ++j) if (el[j] > m0) { m0 = el[j]; i0 = j; }
            int i1 = -1; float m1 = -INFINITY;
#pragma unroll
            for (int j = 0; j < 8; ++j) if (j != i0 && el[j] > m1) { m1 = el[j]; i1 = j; }
            const float ex = __expf(m1 - m0);
            const float p0 = 1.0f / (1.0f + ex), p1 = ex / (1.0f + ex);
            dec[rl * 2] = grp * 8 + i0; dec[rl * 2 + 1] = grp * 8 + i1;
            if (!DRY) { TOKG[(size_t)t * 2] = gwt * p0; TOKG[(size_t)t * 2 + 1] = gwt * p1; }
        }
#pragma unroll 4
        for (int r = 0; r < 16; ++r) {
            const float mu = stat[r * 2], rs = stat[r * 2 + 1];
            const bf16_t* fr = F + (size_t)(tbase + r) * DM + 4 * lane; bf16_t* xo = XB + (size_t)(tbase + r) * DM + 4 * lane;
#pragma unroll
            for (int j = 0; j < 4; ++j) { const u32x2 yw = *(const u32x2*)(fr + 256 * j); const f32x4 y = {bflo(yw.x), bfhi(yw.x), bflo(yw.y), bfhi(yw.y)};
                const f32x4 v = (y - mu) * rs * g4[j] + b4[j];
                u32x2 w; w.x = pk2(v.x, v.y); w.y = pk2(v.z, v.w); *(u32x2*)(xo + 256 * j) = w; }
        }
        __syncthreads();
        if (tid < 256) rank[tid] = atomicAdd(&lcnt[dec[tid]], 1);
        __syncthreads();
        if (tid < 32) lbase[tid] = DRY ? 0 : atomicAdd(&CNT[tid], lcnt[tid]);
        __syncthreads();
        if (!DRY && tid < 256) { const int e = dec[tid]; LIST[(size_t)e * LIST_CAP + lbase[e] + rank[tid]] = (rb * 128 + (tid >> 1)) * 2 + (tid & 1); }
        __syncthreads();
    }
}
__device__ __forceinline__ void moe_setup(const Params& P, int* tb, int layer) {
    const int* CNT = (const int*)(P.ws + WS_CTL) + layer * 64;
    if (threadIdx.x == 0) { int a = 0; for (int e = 0; e < 32; ++e) { tb[e] = a; a += (CNT[e] + 255) >> 8; } tb[32] = a; }
    __syncthreads();
}
template <bool DRY>
__device__ __forceinline__ void phase_ln2(const Params& P, int layer) {
    const bf16_t* XI = (const bf16_t*)(P.ws + WS_XB); bf16_t* XO = (bf16_t*)(P.ws + (DRY ? WS_XB2 : WS_XB));
    const bf16_t* YS = (const bf16_t*)(P.ws + WS_YS); const float* TOKG = (const float*)(P.ws + WS_TOKG);
    const float* lg = P.in[16] + layer * DM; const float* lb = P.in[17] + layer * DM;
    const int lane = threadIdx.x & 63, gw = blockIdx.x * NWAVE + (threadIdx.x >> 6), NGW = gridDim.x * NWAVE;
    f32x4 g4[4], b4[4];
#pragma unroll
    for (int j = 0; j < 4; ++j) { g4[j] = *(const f32x4*)(lg + 256 * j + 4 * lane); b4[j] = *(const f32x4*)(lb + 256 * j + 4 * lane); }
    u32x2 nx[4], na[4], nb[4]; float ng0 = 0.f, ng1 = 0.f;
    if (gw < NTOK) { const int t = gw;
#pragma unroll
        for (int j = 0; j < 4; ++j) { const int c0 = 256 * j + 4 * lane; nx[j] = *(const u32x2*)(XI + (size_t)t * DM + c0); na[j] = *(const u32x2*)(YS + (size_t)(2 * t) * DM + c0); nb[j] = *(const u32x2*)(YS + (size_t)(2 * t + 1) * DM + c0); }
        ng0 = TOKG[(size_t)t * 2]; ng1 = TOKG[(size_t)t * 2 + 1]; }
    for (int t = gw; t < NTOK; t += NGW) {
        const float g0 = ng0, g1 = ng1;
        u32x2 xw[4], aw[4], bw[4];
#pragma unroll
        for (int j = 0; j < 4; ++j) { xw[j] = nx[j]; aw[j] = na[j]; bw[j] = nb[j]; }
        if (t + NGW < NTOK) { const int tn = t + NGW;
#pragma unroll
            for (int j = 0; j < 4; ++j) { const int c0 = 256 * j + 4 * lane; nx[j] = *(const u32x2*)(XI + (size_t)tn * DM + c0); na[j] = *(const u32x2*)(YS + (size_t)(2 * tn) * DM + c0); nb[j] = *(const u32x2*)(YS + (size_t)(2 * tn + 1) * DM + c0); }
            ng0 = TOKG[(size_t)tn * 2]; ng1 = TOKG[(size_t)tn * 2 + 1]; }
        f32x4 v[4]; float s = 0.f;
#pragma unroll
        for (int j = 0; j < 4; ++j) {
            const u32x2 x = xw[j], a = aw[j], b = bw[j];
            v[j].x = bflo(x.x) * ALPHA + g0 * bflo(a.x) + g1 * bflo(b.x); v[j].y = bfhi(x.x) * ALPHA + g0 * bfhi(a.x) + g1 * bfhi(b.x);
            v[j].z = bflo(x.y) * ALPHA + g0 * bflo(a.y) + g1 * bflo(b.y); v[j].w = bfhi(x.y) * ALPHA + g0 * bfhi(a.y) + g1 * bfhi(b.y);
            s += (v[j].x + v[j].y) + (v[j].z + v[j].w); }
        const float mean = wave_sum(s) * (1.0f / DM); float s2 = 0.f;
#pragma unroll
        for (int j = 0; j < 4; ++j) { v[j] = v[j] - mean; s2 += (v[j].x * v[j].x + v[j].y * v[j].y) + (v[j].z * v[j].z + v[j].w * v[j].w); }
        const float rstd = 1.0f / sqrtf(wave_sum(s2) * (1.0f / DM) + LN_EPS);
#pragma unroll
        for (int j = 0; j < 4; ++j) { const int c0 = 256 * j + 4 * lane;
            v[j] = v[j] * rstd * g4[j] + b4[j];
            u32x2 w; w.x = pk2(v[j].x, v[j].y); w.y = pk2(v[j].z, v[j].w); *(u32x2*)(XO + (size_t)t * DM + c0) = w; }
    }
}

__device__ __forceinline__ unsigned f8enc(float y) {
    const unsigned u = __float_as_uint(y), sg = (u >> 24) & 0x80u;
    unsigned a = u & 0x7fffffffu;
    a = max(a, 0x3c000000u); a = min(a, 0x43f00000u);
    a = a + 0x0007ffffu + ((a >> 20) & 1u);
    const unsigned c = min(a >> 20, (135u << 3) | 7u) - (120u << 3);
    return sg | c;
}
__device__ __forceinline__ unsigned e5m2enc(float y) {
    const unsigned hb = (unsigned)__builtin_bit_cast(unsigned short, (_Float16)y);
    return ((hb + 0x7fu + ((hb >> 8) & 1u)) >> 8) & 0xffu;
}
__device__ __forceinline__ unsigned f8dec2(unsigned e) {
    const unsigned t = (e << 4) + 0x3c003c00u;
    return __umul24(e & 0x00800080u, 240u) + t;
}
__device__ __forceinline__ void phase_norms(const Params& P) {
    const bf16_t* Z1 = (const bf16_t*)(P.ws + WS_Z1); bf16_t* CQ = (bf16_t*)(P.ws + WS_CQ); bf16_t* CKV = (bf16_t*)(P.ws + WS_CKV); unsigned char* CKV8 = (unsigned char*)(P.ws + WS_CKV8);
    const float* qn = P.in[8]; const float* kn = P.in[9];
    const int lane = threadIdx.x & 63, gw = blockIdx.x * NWAVE + (threadIdx.x >> 6), NGW = gridDim.x * NWAVE;
    for (int t = gw; t < NTOK; t += NGW) {
        const u32x2 a = *(const u32x2*)(Z1 + (size_t)t * Z1W + 4 * lane), b = *(const u32x2*)(Z1 + (size_t)t * Z1W + 256 + 4 * lane);
        const float q[4] = {bflo(a.x), bfhi(a.x), bflo(a.y), bfhi(a.y)}, k[4] = {bflo(b.x), bfhi(b.x), bflo(b.y), bfhi(b.y)};
        const float sq = wave_sum(q[0] * q[0] + q[1] * q[1] + q[2] * q[2] + q[3] * q[3]), sk = wave_sum(k[0] * k[0] + k[1] * k[1] + k[2] * k[2] + k[3] * k[3]);
        const float rq = 1.0f / sqrtf(sq * (1.0f / 256.0f) + 1e-6f), rk = 1.0f / sqrtf(sk * (1.0f / 256.0f) + 1e-6f);
        const f32x4 gq = *(const f32x4*)(qn + 4 * lane), gk = *(const f32x4*)(kn + 4 * lane);
        u32x2 o; o.x = pk2(q[0] * rq * gq.x, q[1] * rq * gq.y); o.y = pk2(q[2] * rq * gq.z, q[3] * rq * gq.w);
        *(u32x2*)(CQ + (size_t)t * 256 + 4 * lane) = o;
        o.x = pk2(k[0] * rk * gk.x, k[1] * rk * gk.y); o.y = pk2(k[2] * rk * gk.z, k[3] * rk * gk.w);
        *(u32x2*)(CKV + (size_t)t * 256 + 4 * lane) = o;
        *(unsigned*)(CKV8 + (size_t)t * 256 + 4 * lane) = e5m2enc(k[0] * rk * gk.x) | (e5m2enc(k[1] * rk * gk.y) << 8) | (e5m2enc(k[2] * rk * gk.z) << 16) | (e5m2enc(k[3] * rk * gk.w) << 24);
    }
}
__device__ __forceinline__ unsigned fkey(float f) { const unsigned u = __float_as_uint(f); return (u & 0x80000000u) ? ~u : (u | 0x80000000u); }

__device__ __forceinline__ void phase_index(const Params& P, unsigned char* lds) {
    const bf16_t* Z1 = (const bf16_t*)(P.ws + WS_Z1); unsigned short* SEL = (unsigned short*)(P.ws + WS_SEL);
    float* sc = (float*)lds;
    float* qf = sc + 8192;
    float* wf = qf + 512;
    int* hist = (int*)(wf + 8);
    int* misc = hist + 256;
    int* seg = misc + 8;
    const int tid = threadIdx.x;
    for (int t = blockIdx.x; t < NTOK; t += gridDim.x) {
        const int b = t >> 13, tl = t & (SEQ - 1), n = tl + 1;
        unsigned short* so = SEL + (size_t)t * TOPK;
        if (n <= TOPK) { if (tid < n) so[tid] = (unsigned short)tid; continue; }
        qf[tid] = bf2f(Z1[(size_t)t * Z1W + 512 + tid]);
        if (tid < 8) wf[tid] = bf2f(Z1[(size_t)t * Z1W + 1088 + tid]);
        __syncthreads();
        for (int s = tid; s < n; s += NT) {
            const bf16_t* kr = Z1 + ((size_t)b * SEQ + s) * Z1W + 1024;
            float k[64];
#pragma unroll
            for (int q = 0; q < 8; ++q) { const u32x4 v = *(const u32x4*)(kr + q * 8);
                k[q * 8] = bflo(v.x); k[q * 8 + 1] = bfhi(v.x); k[q * 8 + 2] = bflo(v.y); k[q * 8 + 3] = bfhi(v.y);
                k[q * 8 + 4] = bflo(v.z); k[q * 8 + 5] = bfhi(v.z); k[q * 8 + 6] = bflo(v.w); k[q * 8 + 7] = bfhi(v.w); }
            float I = 0.f;
#pragma unroll
            for (int h = 0; h < 8; ++h) { float d = 0.f;
#pragma unroll
                for (int dd = 0; dd < 64; ++dd) d += qf[h * 64 + dd] * k[dd];
                I += wf[h] * fmaxf(d, 0.f); }
            sc[s] = I;
        }
        if (tid == 0) { misc[0] = 0; misc[1] = TOPK; misc[2] = 0; }
        __syncthreads();
        for (int pass = 0; pass < 4; ++pass) {
            const int shift = 24 - 8 * pass;
            if (tid < 256) hist[tid] = 0;
            __syncthreads();
            const unsigned prefix = (unsigned)misc[0]; const int kk = misc[1];
            for (int s = tid; s < n; s += NT) { const unsigned key = fkey(sc[s]);
                if (pass == 0 || (key >> (shift + 8)) == prefix) atomicAdd(&hist[(key >> shift) & 255], 1); }
            __syncthreads();
            if (tid == 0) { int a = 0, bsel = 0; for (int bin = 255; bin >= 0; --bin) { const int c = hist[bin]; if (a + c >= kk) { bsel = bin; break; } a += c; }
                misc[0] = (int)((prefix << 8) | (unsigned)bsel); misc[1] = kk - a; }
            __syncthreads();
        }
        const unsigned T = (unsigned)misc[0]; const int keq = misc[1];
        for (int s = tid; s < n; s += NT) if (fkey(sc[s]) > T) { const int o = atomicAdd(&misc[2], 1); so[o] = (unsigned short)s; }
        const int per = (n + NT - 1) / NT, s0 = tid * per, s1 = min(n, s0 + per);
        int ce = 0;
        for (int s = s0; s < s1; ++s) ce += (fkey(sc[s]) == T) ? 1 : 0;
        seg[tid] = ce;
        __syncthreads();
        if (tid == 0) { int a = 0; for (int i = 0; i < NT; ++i) { const int c = seg[i]; seg[i] = a; a += c; } }
        __syncthreads();
        const int ngt = TOPK - keq;
        int r = seg[tid];
        for (int s = s0; s < s1 && r < keq; ++s) if (fkey(sc[s]) == T) { so[ngt + r] = (unsigned short)s; ++r; }
        __syncthreads();
    }
}
__device__ __forceinline__ void phase_sparse_attn(const Params& P, unsigned char* lds) {
    bf16_t* QA = (bf16_t*)(P.ws + WS_QA); const bf16_t* CKV = (const bf16_t*)(P.ws + WS_CKV); const unsigned short* SEL = (const unsigned short*)(P.ws + WS_SEL);
    float* qa = (float*)lds;
    float* lgt = qa + 4096;
    int* sel = (int*)(lgt + 4096);
    const int tid = threadIdx.x, lane = tid & 63, wave = tid >> 6;
    for (int t = blockIdx.x; t < NTOK; t += gridDim.x) {
        const int b = t >> 13, tl = t & (SEQ - 1), ns = min(tl + 1, TOPK);
        { const u32x4 v = *(const u32x4*)(QA + (size_t)t * 4096 + tid * 8); float* q = qa + tid * 8;
          q[0] = bflo(v.x); q[1] = bfhi(v.x); q[2] = bflo(v.y); q[3] = bfhi(v.y); q[4] = bflo(v.z); q[5] = bfhi(v.z); q[6] = bflo(v.w); q[7] = bfhi(v.w); }
        if (tid < TOPK) sel[tid] = (tid < ns) ? (int)SEL[(size_t)t * TOPK + tid] : 0;
        __syncthreads();
        const int k = tid & 255, hg = tid >> 8;
        {
            float acc[8];
#pragma unroll
            for (int h = 0; h < 8; ++h) acc[h] = 0.f;
            if (k < ns) {
                const bf16_t* cr = CKV + ((size_t)b * SEQ + sel[k]) * 256;
                for (int c8 = 0; c8 < 256; c8 += 8) {
                    const u32x4 v = *(const u32x4*)(cr + c8);
                    const float cv[8] = {bflo(v.x), bfhi(v.x), bflo(v.y), bfhi(v.y), bflo(v.z), bfhi(v.z), bflo(v.w), bfhi(v.w)};
#pragma unroll
                    for (int h = 0; h < 8; ++h) { const float* q = qa + (hg * 8 + h) * 256 + c8;
#pragma unroll
                        for (int j = 0; j < 8; ++j) acc[h] += q[j] * cv[j]; }
                }
            }
#pragma unroll
            for (int h = 0; h < 8; ++h) { const int hh = hg * 8 + h; const float slope = exp2f(-0.5f * (float)(hh + 1));
                lgt[hh * 256 + k] = (k < ns) ? (acc[h] - slope * (float)(tl - sel[k])) : -INFINITY; }
        }
        __syncthreads();
        for (int hh = wave * 2; hh < wave * 2 + 2; ++hh) {
            float* row = lgt + hh * 256;
            float x[4]; float m = -INFINITY;
#pragma unroll
            for (int j = 0; j < 4; ++j) { x[j] = row[lane + 64 * j]; m = fmaxf(m, x[j]); }
            m = wave_max(m); float s = 0.f;
#pragma unroll
            for (int j = 0; j < 4; ++j) { x[j] = __expf(x[j] - m); s += x[j]; }
            s = wave_sum(s); const float inv = 1.0f / s;
#pragma unroll
            for (int j = 0; j < 4; ++j) row[lane + 64 * j] = x[j] * inv;
        }
        __syncthreads();
        {
            const int c = tid & 255;
            float acc[8];
#pragma unroll
            for (int h = 0; h < 8; ++h) acc[h] = 0.f;
            const bf16_t* cb = CKV + (size_t)b * SEQ * 256 + c;
            for (int kk = 0; kk < ns; ++kk) {
                const float cv = bf2f(cb[(size_t)sel[kk] * 256]);
#pragma unroll
                for (int h = 0; h < 8; ++h) acc[h] += lgt[(hg * 8 + h) * 256 + kk] * cv;
            }
#pragma unroll
            for (int h = 0; h < 8; ++h) QA[(size_t)t * 4096 + (hg * 8 + h) * 256 + c] = (bf16_t)f2bf(acc[h]);
        }
        __syncthreads();
    }
}

constexpr int NPH_TOTAL = 23;


typedef short v4i16_t __attribute__((ext_vector_type(4)));
template <bool DRY>
__device__ __forceinline__ void phase_sparse_attn_mfma(const Params& P, unsigned char* lds_) {
    using pg8::bf16x8;
    bf16_t* QA = (bf16_t*)(P.ws + WS_QA); const unsigned char* CKV = (const unsigned char*)(P.ws + WS_CKV); const unsigned short* SEL = (const unsigned short*)(P.ws + WS_SEL);
    const int tid = threadIdx.x, lane = tid & 63, wave = __builtin_amdgcn_readfirstlane(tid >> 6);
    const int fr = lane & 15, fq = lane >> 4;
    LAS unsigned char* cbuf = (LAS unsigned char*)lds_ + wave * 16896;
    LAS unsigned short* selw = (LAS unsigned short*)(cbuf + 16384);
    const int G = gridDim.x, NGW = G * NWAVE;
    int vw;
    if ((G & 7) == 0) vw = (((int)blockIdx.x & 7) * (G >> 3) + ((int)blockIdx.x >> 3)) * NWAVE + wave; else vw = (int)blockIdx.x * NWAVE + wave;
    const float LOG2E = 1.4426950408889634f;
    const float slope2 = exp2f(-0.5f * (float)(fr + 1)) * LOG2E;
    unsigned qoffB[4];
#pragma unroll
    for (int e = 0; e < 4; ++e) { const int key7 = (2 * e + (lane >> 5)) & 7; qoffB[e] = (unsigned)(((lane & 31) ^ (key7 << 1)) << 4); }
    const int rowA = fr;
    const unsigned swzA = (unsigned)((rowA & 7) << 1);
    const int rowT = 4 * fq + (fr >> 2);
    const unsigned swzT = (unsigned)((rowT & 7) << 1), pbT = (unsigned)((fr & 3) >> 1), halfT = (unsigned)(fr & 1) * 8u;
    const int per = NGW >> 2, bq = vw / per, wb = vw % per;
    for (int tl0 = wb; tl0 < SEQ; tl0 += per) {
        const int t = bq * SEQ + tl0;
        const int b = t >> 13, tl = t & (SEQ - 1), ns = min(tl + 1, TOPK), nch = (ns + 31) >> 5;
        {
            const u32x2 w = *(const u32x2*)(SEL + (size_t)t * TOPK + 4 * lane);
            unsigned short i0 = (unsigned short)(w.x & 0xffffu), i1 = (unsigned short)(w.x >> 16), i2 = (unsigned short)(w.y & 0xffffu), i3 = (unsigned short)(w.y >> 16);
            const int k0 = 4 * lane;
            if (k0 >= ns) i0 = 0; if (k0 + 1 >= ns) i1 = 0; if (k0 + 2 >= ns) i2 = 0; if (k0 + 3 >= ns) i3 = 0;
            u32x2 o; o.x = (unsigned)i0 | ((unsigned)i1 << 16); o.y = (unsigned)i2 | ((unsigned)i3 << 16);
            *(LAS u32x2*)(selw + 4 * lane) = o;
        }
        bf16x8 qf[8];
#pragma unroll
        for (int cc = 0; cc < 8; ++cc) qf[cc] = *(const bf16x8*)(QA + (size_t)t * 4096 + fr * 256 + 32 * cc + 8 * fq);
        f32x4 O[16];
#pragma unroll
        for (int ct = 0; ct < 16; ++ct) O[ct] = (f32x4){0.f, 0.f, 0.f, 0.f};
        float m = -INFINITY, l = 0.f;
        const unsigned char* cb = CKV + (size_t)b * SEQ * 512;
        for (int j = 0; j < nch; ++j) {
            asm volatile("s_waitcnt lgkmcnt(0)" ::: "memory");
#pragma unroll
            for (int e = 0; e < 16; ++e) {
                const unsigned idx = selw[32 * j + 2 * e + (lane >> 5)];
                __builtin_amdgcn_global_load_lds((const unsigned*)(cb + (size_t)idx * 512 + qoffB[e & 3]), (LAS unsigned*)(cbuf + e * 1024), 16, 0, 0);
            }
            asm volatile("s_waitcnt vmcnt(0)" ::: "memory");
            f32x4 s0 = {0.f, 0.f, 0.f, 0.f}, s1 = {0.f, 0.f, 0.f, 0.f};
#pragma unroll
            for (int cc = 0; cc < 8; ++cc) {
                const unsigned ch = (((unsigned)(4 * cc + fq)) ^ swzA) << 4;
                const bf16x8 a0 = *(const LAS bf16x8*)(cbuf + rowA * 512 + ch);
                const bf16x8 a1 = *(const LAS bf16x8*)(cbuf + (16 + rowA) * 512 + ch);
                s0 = __builtin_amdgcn_mfma_f32_16x16x32_bf16(a0, qf[cc], s0, 0, 0, 0);
                s1 = __builtin_amdgcn_mfma_f32_16x16x32_bf16(a1, qf[cc], s1, 0, 0, 0);
            }
            const u32x2 k0w = *(const LAS u32x2*)(selw + 32 * j + 4 * fq), k1w = *(const LAS u32x2*)(selw + 32 * j + 16 + 4 * fq);
            const int kb0 = 32 * j + 4 * fq, kb1 = kb0 + 16;
            float lg[8];
            {
                const int i00 = (int)(k0w.x & 0xffffu), i01 = (int)(k0w.x >> 16), i02 = (int)(k0w.y & 0xffffu), i03 = (int)(k0w.y >> 16);
                const int i10 = (int)(k1w.x & 0xffffu), i11 = (int)(k1w.x >> 16), i12 = (int)(k1w.y & 0xffffu), i13 = (int)(k1w.y >> 16);
                lg[0] = (kb0 + 0 < ns) ? s0.x * LOG2E - slope2 * (float)(tl - i00) : -INFINITY;
                lg[1] = (kb0 + 1 < ns) ? s0.y * LOG2E - slope2 * (float)(tl - i01) : -INFINITY;
                lg[2] = (kb0 + 2 < ns) ? s0.z * LOG2E - slope2 * (float)(tl - i02) : -INFINITY;
                lg[3] = (kb0 + 3 < ns) ? s0.w * LOG2E - slope2 * (float)(tl - i03) : -INFINITY;
                lg[4] = (kb1 + 0 < ns) ? s1.x * LOG2E - slope2 * (float)(tl - i10) : -INFINITY;
                lg[5] = (kb1 + 1 < ns) ? s1.y * LOG2E - slope2 * (float)(tl - i11) : -INFINITY;
                lg[6] = (kb1 + 2 < ns) ? s1.z * LOG2E - slope2 * (float)(tl - i12) : -INFINITY;
                lg[7] = (kb1 + 3 < ns) ? s1.w * LOG2E - slope2 * (float)(tl - i13) : -INFINITY;
            }
            float cm = fmaxf(fmaxf(fmaxf(lg[0], lg[1]), fmaxf(lg[2], lg[3])), fmaxf(fmaxf(lg[4], lg[5]), fmaxf(lg[6], lg[7])));
            cm = fmaxf(cm, __shfl_xor(cm, 16)); cm = fmaxf(cm, __shfl_xor(cm, 32));
            const float mn = fmaxf(m, cm);
            if (__any(mn > m)) {
                const float sc = exp2f(m - mn);
                l *= sc;
#pragma unroll
                for (int ct = 0; ct < 16; ++ct) O[ct] *= sc;
                m = mn;
            }
            float p[8]; float ps = 0.f;
#pragma unroll
            for (int i = 0; i < 8; ++i) { p[i] = exp2f(lg[i] - m); ps += p[i]; }
            l += ps;
            u32x4 pw; pw.x = pk2(p[0], p[1]); pw.y = pk2(p[2], p[3]); pw.z = pk2(p[4], p[5]); pw.w = pk2(p[6], p[7]);
            const bf16x8 pk = __builtin_bit_cast(bf16x8, pw);
#pragma unroll
            for (int ct = 0; ct < 16; ++ct) {
                const unsigned ch = ((((unsigned)(2 * ct)) ^ swzT) | pbT) << 4;
                const v4i16_t lo = __builtin_amdgcn_ds_read_tr16_b64_v4i16((LAS v4i16_t*)(cbuf + rowT * 512 + ch + halfT));
                const v4i16_t hi = __builtin_amdgcn_ds_read_tr16_b64_v4i16((LAS v4i16_t*)(cbuf + (16 + rowT) * 512 + ch + halfT));
                const bf16x8 a = {lo[0], lo[1], lo[2], lo[3], hi[0], hi[1], hi[2], hi[3]};
                O[ct] = __builtin_amdgcn_mfma_f32_16x16x32_bf16(a, pk, O[ct], 0, 0, 0);
            }
        }
        l += __shfl_xor(l, 16); l += __shfl_xor(l, 32);
        const float inv = 1.0f / l;
        bf16_t* orow = (DRY ? (bf16_t*)(P.ws + WS_PP) + (size_t)(t & 8191) * 4096 : QA + (size_t)t * 4096) + fr * 256 + 4 * fq;
#pragma unroll
        for (int ct = 0; ct < 16; ++ct) { u32x2 w; w.x = pk2(O[ct].x * inv, O[ct].y * inv); w.y = pk2(O[ct].z * inv, O[ct].w * inv); *(u32x2*)(orow + 16 * ct) = w; }
    }
}


template <bool DRY>
__device__ __forceinline__ void phase_sparse_attn_f8(const Params& P, unsigned char* lds_) {
    using pg8::bf16x8;
    bf16_t* QA = (bf16_t*)(P.ws + WS_QA); const unsigned char* CKV8 = (const unsigned char*)(P.ws + WS_CKV8); const unsigned short* SEL = (const unsigned short*)(P.ws + WS_SEL);
    const int tid = threadIdx.x, lane = tid & 63, wave = __builtin_amdgcn_readfirstlane(tid >> 6);
    const int fr = lane & 15, fq = lane >> 4;
    LAS unsigned char* cbuf = (LAS unsigned char*)lds_ + wave * 16896;
    LAS unsigned short* selw = (LAS unsigned short*)(cbuf + 16384);
    const int G = gridDim.x, NGW = G * NWAVE;
    int vw;
    if ((G & 7) == 0) vw = (((int)blockIdx.x & 7) * (G >> 3) + ((int)blockIdx.x >> 3)) * NWAVE + wave; else vw = (int)blockIdx.x * NWAVE + wave;
    const float LOG2E = 1.4426950408889634f;
    const float slope2 = exp2f(-0.5f * (float)(fr + 1)) * LOG2E;
    const int rowA = fr;
    const unsigned swzA = (unsigned)((rowA & 7) << 1);
    const int rowT = 4 * fq + (fr >> 2);
    const unsigned swzT = (unsigned)((rowT & 7) << 1), pbT = (unsigned)((fr & 3) >> 1), halfT = (unsigned)(fr & 1) * 8u;
    const unsigned swzA16 = (swzA ^ (unsigned)fq) << 4, baseA = (unsigned)rowA * 512u;
    const unsigned swzT16 = swzT << 4, baseT = (unsigned)rowT * 512u + (pbT << 4) + halfT;
    unsigned wofs[2];
#pragma unroll
    for (int e = 0; e < 2; ++e) { const int key7 = (4 * e + fq) & 7; wofs[e] = (unsigned)(fq * 512 + (((2 * fr) ^ (key7 << 1)) << 4)); }
    const int per = NGW >> 2, bq = vw / per, wb = vw % per;
    for (int tl0 = wb; tl0 < SEQ; tl0 += per) {
        const int t = bq * SEQ + tl0;
        const int b = t >> 13, tl = t & (SEQ - 1), ns = min(tl + 1, TOPK), nch = (ns + 31) >> 5;
        {
            const u32x2 w = *(const u32x2*)(SEL + (size_t)t * TOPK + 4 * lane);
            unsigned short i0 = (unsigned short)(w.x & 0xffffu), i1 = (unsigned short)(w.x >> 16), i2 = (unsigned short)(w.y & 0xffffu), i3 = (unsigned short)(w.y >> 16);
            const int k0 = 4 * lane;
            if (k0 >= ns) i0 = 0; if (k0 + 1 >= ns) i1 = 0; if (k0 + 2 >= ns) i2 = 0; if (k0 + 3 >= ns) i3 = 0;
            u32x2 o; o.x = (unsigned)i0 | ((unsigned)i1 << 16); o.y = (unsigned)i2 | ((unsigned)i3 << 16);
            *(LAS u32x2*)(selw + 4 * lane) = o;
        }
        bf16x8 qf[8];
#pragma unroll
        for (int cc = 0; cc < 8; ++cc) qf[cc] = *(const bf16x8*)(QA + (size_t)t * 4096 + fr * 256 + 32 * cc + 8 * fq);
        f32x4 O[16];
#pragma unroll
        for (int ct = 0; ct < 16; ++ct) O[ct] = (f32x4){0.f, 0.f, 0.f, 0.f};
        float m = -INFINITY, l = 0.f;
        const unsigned char* cb = CKV8 + (size_t)b * SEQ * 256 + 16 * fr;
        u32x4 stg[8];
#pragma unroll
        for (int e = 0; e < 8; ++e) { const unsigned idx = selw[4 * e + fq]; stg[e] = *(const u32x4*)(cb + (size_t)idx * 256); }
        for (int j = 0; j < nch; ++j) {
#pragma unroll
            for (int e = 0; e < 8; ++e) {
                const u32x4 w = stg[e];
                u32x4 lo, hi;
                lo.x = f8dec2(__builtin_amdgcn_perm(0u, w.x, 0x0c010c00u)); lo.y = f8dec2(__builtin_amdgcn_perm(0u, w.x, 0x0c030c02u));
                lo.z = f8dec2(__builtin_amdgcn_perm(0u, w.y, 0x0c010c00u)); lo.w = f8dec2(__builtin_amdgcn_perm(0u, w.y, 0x0c030c02u));
                hi.x = f8dec2(__builtin_amdgcn_perm(0u, w.z, 0x0c010c00u)); hi.y = f8dec2(__builtin_amdgcn_perm(0u, w.z, 0x0c030c02u));
                hi.z = f8dec2(__builtin_amdgcn_perm(0u, w.w, 0x0c010c00u)); hi.w = f8dec2(__builtin_amdgcn_perm(0u, w.w, 0x0c030c02u));
                LAS unsigned char* dst = cbuf + (e >> 1) * 4096 + (e & 1) * 2048 + wofs[e & 1];
                *(LAS u32x4*)dst = lo; *(LAS u32x4*)(dst + 16) = hi;
            }
            if (j + 1 < nch) {
#pragma unroll
                for (int e = 0; e < 8; ++e) { const unsigned idx = selw[32 * (j + 1) + 4 * e + fq]; stg[e] = *(const u32x4*)(cb + (size_t)idx * 256); }
            }
            f32x4 s0 = {0.f, 0.f, 0.f, 0.f}, s1 = {0.f, 0.f, 0.f, 0.f};
#pragma unroll
            for (int cc = 0; cc < 8; ++cc) {
                const LAS unsigned char* pa = cbuf + ((swzA16 ^ (unsigned)(cc << 6)) + baseA);
                const bf16x8 a0 = *(const LAS bf16x8*)(pa);
                const bf16x8 a1 = *(const LAS bf16x8*)(pa + 8192);
                s0 = __builtin_amdgcn_mfma_f32_16x16x32_bf16(a0, qf[cc], s0, 0, 0, 0);
                s1 = __builtin_amdgcn_mfma_f32_16x16x32_bf16(a1, qf[cc], s1, 0, 0, 0);
            }
            const u32x2 k0w = *(const LAS u32x2*)(selw + 32 * j + 4 * fq), k1w = *(const LAS u32x2*)(selw + 32 * j + 16 + 4 * fq);
            const int kb0 = 32 * j + 4 * fq, kb1 = kb0 + 16;
            float lg[8];
            {
                const int i00 = (int)(k0w.x & 0xffffu), i01 = (int)(k0w.x >> 16), i02 = (int)(k0w.y & 0xffffu), i03 = (int)(k0w.y >> 16);
                const int i10 = (int)(k1w.x & 0xffffu), i11 = (int)(k1w.x >> 16), i12 = (int)(k1w.y & 0xffffu), i13 = (int)(k1w.y >> 16);
                lg[0] = (kb0 + 0 < ns) ? s0.x * LOG2E - slope2 * (float)(tl - i00) : -INFINITY;
                lg[1] = (kb0 + 1 < ns) ? s0.y * LOG2E - slope2 * (float)(tl - i01) : -INFINITY;
                lg[2] = (kb0 + 2 < ns) ? s0.z * LOG2E - slope2 * (float)(tl - i02) : -INFINITY;
                lg[3] = (kb0 + 3 < ns) ? s0.w * LOG2E - slope2 * (float)(tl - i03) : -INFINITY;
                lg[4] = (kb1 + 0 < ns) ? s1.x * LOG2E - slope2 * (float)(tl - i10) : -INFINITY;
                lg[5] = (kb1 + 1 < ns) ? s1.y * LOG2E - slope2 * (float)(tl - i11) : -INFINITY;
                lg[6] = (kb1 + 2 < ns) ? s1.z * LOG2E - slope2 * (float)(tl - i12) : -INFINITY;
                lg[7] = (kb1 + 3 < ns) ? s1.w * LOG2E - slope2 * (float)(tl - i13) : -INFINITY;
            }
            float cm = fmaxf(fmaxf(fmaxf(lg[0], lg[1]), fmaxf(lg[2], lg[3])), fmaxf(fmaxf(lg[4], lg[5]), fmaxf(lg[6], lg[7])));
            cm = fmaxf(cm, __shfl_xor(cm, 16)); cm = fmaxf(cm, __shfl_xor(cm, 32));
            const float mn = fmaxf(m, cm);
            if (__any(mn > m)) {
                const float sc = __builtin_amdgcn_exp2f(m - mn);
                l *= sc;
#pragma unroll
                for (int ct = 0; ct < 16; ++ct) O[ct] *= sc;
                m = mn;
            }
            float p[8]; float ps = 0.f;
#pragma unroll
            for (int i = 0; i < 8; ++i) { p[i] = __builtin_amdgcn_exp2f(lg[i] - m); ps += p[i]; }
            l += ps;
            u32x4 pw; pw.x = pk2(p[0], p[1]); pw.y = pk2(p[2], p[3]); pw.z = pk2(p[4], p[5]); pw.w = pk2(p[6], p[7]);
            const bf16x8 pk = __builtin_bit_cast(bf16x8, pw);
#pragma unroll
            for (int ct = 0; ct < 16; ++ct) {
                const LAS unsigned char* pt = cbuf + ((swzT16 ^ (unsigned)(ct << 5)) + baseT);
                const v4i16_t lo = __builtin_amdgcn_ds_read_tr16_b64_v4i16((LAS v4i16_t*)(pt));
                const v4i16_t hi = __builtin_amdgcn_ds_read_tr16_b64_v4i16((LAS v4i16_t*)(pt + 8192));
                const bf16x8 a = {lo[0], lo[1], lo[2], lo[3], hi[0], hi[1], hi[2], hi[3]};
                O[ct] = __builtin_amdgcn_mfma_f32_16x16x32_bf16(a, pk, O[ct], 0, 0, 0);
            }
        }
        l += __shfl_xor(l, 16); l += __shfl_xor(l, 32);
        const float inv = 1.0f / l;
        bf16_t* orow = (DRY ? (bf16_t*)(P.ws + WS_PP) + (size_t)(t & 8191) * 4096 : QA + (size_t)t * 4096) + fr * 256 + 4 * fq;
#pragma unroll
        for (int ct = 0; ct < 16; ++ct) { u32x2 w; w.x = pk2(O[ct].x * inv, O[ct].y * inv); w.y = pk2(O[ct].z * inv, O[ct].w * inv); *(u32x2*)(orow + 16 * ct) = w; }
    }
}


__device__ __forceinline__ void glds16(const void* gsrc, unsigned lds_dst) {
    unsigned keep;
    asm volatile("s_mov_b32 %0, m0\n\ts_mov_b32 m0, %2\n\ts_nop 0\n\tglobal_load_lds_dwordx4 %1, off\n\ts_mov_b32 m0, %0" : "=&s"(keep) : "v"(gsrc), "s"(lds_dst) : "memory");
}
typedef _Float16 f16x8 __attribute__((ext_vector_type(8)));
template <bool DRY>
__device__ __forceinline__ void phase_sparse_attn_e(const Params& P, unsigned char* lds_) {
    const unsigned char* QA = (const unsigned char*)(P.ws + WS_QA); bf16_t* OLAT = (bf16_t*)(P.ws + WS_OLAT); const unsigned char* CKV8 = (const unsigned char*)(P.ws + WS_CKV8); const unsigned short* SEL = (const unsigned short*)(P.ws + WS_SEL);
    const int tid = threadIdx.x, lane = tid & 63, wave = __builtin_amdgcn_readfirstlane(tid >> 6);
    const int fr = lane & 15, fq = lane >> 4;
    LAS unsigned char* cbuf = (LAS unsigned char*)lds_ + wave * 16896;
    LAS unsigned short* selw = (LAS unsigned short*)(cbuf + 16384);
    const unsigned cbuf0 = (unsigned)(unsigned long)cbuf;
    const int G = gridDim.x, NGW = G * NWAVE;
    int vw;
    if ((G & 7) == 0) vw = (((int)blockIdx.x & 7) * (G >> 3) + ((int)blockIdx.x >> 3)) * NWAVE + wave; else vw = (int)blockIdx.x * NWAVE + wave;
    const float LOG2E = 1.4426950408889634f;
    const float slope2 = exp2f(-0.5f * (float)(fr + 1)) * LOG2E;
    unsigned qoffB[4];
#pragma unroll
    for (int e = 0; e < 4; ++e) { const int r15 = (4 * e + fq) & 15; qoffB[e] = (unsigned)((fr ^ (((r15 & 7) << 1) | (r15 >> 3))) << 4); }
    const unsigned fA = (unsigned)(((fr & 7) << 1) | (fr >> 3));
    const unsigned SA = (fA & 14u) << 4, baseA = (unsigned)fr * 256u + ((((unsigned)fq >> 1) ^ (fA & 1u)) << 4) + ((unsigned)fq & 1u) * 8u;
    const int rT = 4 * fq + (fr >> 2), pT_ = fr & 3;
    const unsigned fT = (unsigned)(((rT & 7) << 1) | (rT >> 3));
    const unsigned ST = (fT & 14u) << 4, baseT = (unsigned)rT * 256u + ((((unsigned)pT_ >> 1) ^ (fT & 1u)) << 4) + ((unsigned)pT_ & 1u) * 8u;
    const int per = NGW >> 2, bq = vw / per, wb = vw % per;
    int ditem = DRY ? N_DEFERRED : vw;
    for (int tl0 = wb; tl0 < SEQ; tl0 += per) {
        const int t = bq * SEQ + tl0;
        const int b = t >> 13, tl = t & (SEQ - 1), ns = min(tl + 1, TOPK), nch = (ns + 31) >> 5;
        {
            const u32x2 w = *(const u32x2*)(SEL + (size_t)t * TOPK + 4 * lane);
            unsigned short i0 = (unsigned short)(w.x & 0xffffu), i1 = (unsigned short)(w.x >> 16), i2 = (unsigned short)(w.y & 0xffffu), i3 = (unsigned short)(w.y >> 16);
            const int k0 = 4 * lane;
            if (k0 >= ns) i0 = 0; if (k0 + 1 >= ns) i1 = 0; if (k0 + 2 >= ns) i2 = 0; if (k0 + 3 >= ns) i3 = 0;
            u32x2 o; o.x = (unsigned)i0 | ((unsigned)i1 << 16); o.y = (unsigned)i2 | ((unsigned)i3 << 16);
            asm volatile("s_waitcnt lgkmcnt(0)" ::: "memory");
            *(LAS u32x2*)(selw + 4 * lane) = o;
        }
        long qf[8];
#pragma unroll
        for (int cc = 0; cc < 8; ++cc) qf[cc] = *(const long*)(QA + (size_t)t * 4096 + fr * 256 + 32 * cc + 8 * fq);
        f32x4 Oe[8], Oo[8];
#pragma unroll
        for (int ut = 0; ut < 8; ++ut) { Oe[ut] = (f32x4){0.f, 0.f, 0.f, 0.f}; Oo[ut] = (f32x4){0.f, 0.f, 0.f, 0.f}; }
        float m = -INFINITY, l = 0.f;
        const unsigned char* cb = CKV8 + (size_t)b * SEQ * 256;
        asm volatile("s_waitcnt vmcnt(0) lgkmcnt(0)" ::: "memory");
#define ATT_DMA(jj, bufoff) do { unsigned idx_[8]; \
            _Pragma("unroll") for (int e = 0; e < 8; ++e) idx_[e] = (DRY && PROBE_ATT == 1) ? (unsigned)((32 * (jj) + 4 * e + fq + 64 * wave) & 8191) : (unsigned)selw[32 * (jj) + 4 * e + fq]; \
            _Pragma("unroll") for (int e = 0; e < 8; ++e) { \
            if (!(DRY && PROBE_ATT == 3)) glds16(cb + (size_t)idx_[e] * 256 + qoffB[e & 3], (unsigned)__builtin_amdgcn_readfirstlane((int)(cbuf0 + (bufoff) + e * 1024))); } } while (0)
        ATT_DMA(0, 0);
        if (nch > 1) ATT_DMA(1, 8192);
        const bool have_item = ditem < N_DEFERRED;
        TrItem titem = deferred_item(P, have_item ? ditem : 0);
        float tcur[32];
        bool trf = false;
        if (have_item && nch <= 2) { tr_load(titem, lane, tcur); trf = true; }
        for (int j = 0; j < nch; ++j) {
            const unsigned bo = (unsigned)(j & 1) * 8192u;
            if (j + 1 < nch) { if (trf) asm volatile("s_waitcnt vmcnt(40)" ::: "memory"); else asm volatile("s_waitcnt vmcnt(8)" ::: "memory"); }
            else { if (trf) asm volatile("s_waitcnt vmcnt(32)" ::: "memory"); else asm volatile("s_waitcnt vmcnt(0)" ::: "memory"); }
            const LAS unsigned char* img = cbuf + bo;
            if (DRY && PROBE_ATT == 2) { if (j + 2 < nch) { asm volatile("s_waitcnt lgkmcnt(0)" ::: "memory"); ATT_DMA(j + 2, bo); } continue; }
            const u32x2 k0w = *(const LAS u32x2*)(selw + 32 * j + 4 * fq), k1w = *(const LAS u32x2*)(selw + 32 * j + 16 + 4 * fq);
            f32x4 s0 = {0.f, 0.f, 0.f, 0.f}, s1 = {0.f, 0.f, 0.f, 0.f};
#pragma unroll
            for (int hb = 0; hb < 2; ++hb) {
                u32x2 ra[4], rb[4];
#pragma unroll
                for (int c4 = 0; c4 < 4; ++c4) { const int cc = hb * 4 + c4; const LAS unsigned char* pa = img + ((SA ^ (unsigned)(cc << 5)) + baseA); ra[c4] = *(const LAS u32x2*)(pa); rb[c4] = *(const LAS u32x2*)(pa + 4096); }
                __builtin_amdgcn_sched_barrier(0);
#pragma unroll
                for (int c4 = 0; c4 < 4; ++c4) { const int cc = hb * 4 + c4;
                    s0 = __builtin_amdgcn_mfma_f32_16x16x32_bf8_fp8(__builtin_bit_cast(long, ra[c4]), qf[cc], s0, 0, 0, 0);
                    s1 = __builtin_amdgcn_mfma_f32_16x16x32_bf8_fp8(__builtin_bit_cast(long, rb[c4]), qf[cc], s1, 0, 0, 0); }
                __builtin_amdgcn_sched_barrier(0);
            }
            u32x2 tl_[4], th_[4];
#pragma unroll
            for (int ut = 0; ut < 4; ++ut) { const LAS unsigned char* pt = img + ((ST ^ (unsigned)(ut << 5)) + baseT);
                tl_[ut] = __builtin_bit_cast(u32x2, __builtin_amdgcn_ds_read_tr16_b64_v4i16((LAS v4i16_t*)(pt)));
                th_[ut] = __builtin_bit_cast(u32x2, __builtin_amdgcn_ds_read_tr16_b64_v4i16((LAS v4i16_t*)(pt + 4096))); }
            __builtin_amdgcn_sched_barrier(0);
            const int kb0 = 32 * j + 4 * fq, kb1 = kb0 + 16;
            float lg[8];
            {
                const int i00 = (int)(k0w.x & 0xffffu), i01 = (int)(k0w.x >> 16), i02 = (int)(k0w.y & 0xffffu), i03 = (int)(k0w.y >> 16);
                const int i10 = (int)(k1w.x & 0xffffu), i11 = (int)(k1w.x >> 16), i12 = (int)(k1w.y & 0xffffu), i13 = (int)(k1w.y >> 16);
                lg[0] = (kb0 + 0 < ns) ? s0.x * LOG2E - slope2 * (float)(tl - i00) : -INFINITY;
                lg[1] = (kb0 + 1 < ns) ? s0.y * LOG2E - slope2 * (float)(tl - i01) : -INFINITY;
                lg[2] = (kb0 + 2 < ns) ? s0.z * LOG2E - slope2 * (float)(tl - i02) : -INFINITY;
                lg[3] = (kb0 + 3 < ns) ? s0.w * LOG2E - slope2 * (float)(tl - i03) : -INFINITY;
                lg[4] = (kb1 + 0 < ns) ? s1.x * LOG2E - slope2 * (float)(tl - i10) : -INFINITY;
                lg[5] = (kb1 + 1 < ns) ? s1.y * LOG2E - slope2 * (float)(tl - i11) : -INFINITY;
                lg[6] = (kb1 + 2 < ns) ? s1.z * LOG2E - slope2 * (float)(tl - i12) : -INFINITY;
                lg[7] = (kb1 + 3 < ns) ? s1.w * LOG2E - slope2 * (float)(tl - i13) : -INFINITY;
            }
            const float cm = fmaxf(fmaxf(fmaxf(lg[0], lg[1]), fmaxf(lg[2], lg[3])), fmaxf(fmaxf(lg[4], lg[5]), fmaxf(lg[6], lg[7])));
            if (j == 0) { float cx = fmaxf(cm, __shfl_xor(cm, 16)); m = fmaxf(cx, __shfl_xor(cx, 32)); }
            else if (__any(cm > m + 8.0f)) {
                float cx = fmaxf(cm, __shfl_xor(cm, 16)); cx = fmaxf(cx, __shfl_xor(cx, 32));
                const float mn = fmaxf(m, cx);
                const float sc = __builtin_amdgcn_exp2f(m - mn);
                l *= sc;
#pragma unroll
                for (int ut = 0; ut < 8; ++ut) { Oe[ut] *= sc; Oo[ut] *= sc; }
                m = mn;
            }
            float p[8]; float ps = 0.f;
#pragma unroll
            for (int i = 0; i < 8; ++i) { p[i] = __builtin_amdgcn_exp2f(lg[i] - m); ps += p[i]; }
            l += ps;
            int pw0 = __builtin_amdgcn_cvt_pk_fp8_f32(p[0], p[1], 0, false); pw0 = __builtin_amdgcn_cvt_pk_fp8_f32(p[2], p[3], pw0, true);
            int pw1 = __builtin_amdgcn_cvt_pk_fp8_f32(p[4], p[5], 0, false); pw1 = __builtin_amdgcn_cvt_pk_fp8_f32(p[6], p[7], pw1, true);
            const long pk = __builtin_bit_cast(long, (u32x2){(unsigned)pw0, (unsigned)pw1});
#pragma unroll
            for (int hb = 0; hb < 2; ++hb) {
                if (hb == 1) {
#pragma unroll
                    for (int u4 = 0; u4 < 4; ++u4) { const int ut = 4 + u4; const LAS unsigned char* pt = img + ((ST ^ (unsigned)(ut << 5)) + baseT);
                        tl_[u4] = __builtin_bit_cast(u32x2, __builtin_amdgcn_ds_read_tr16_b64_v4i16((LAS v4i16_t*)(pt)));
                        th_[u4] = __builtin_bit_cast(u32x2, __builtin_amdgcn_ds_read_tr16_b64_v4i16((LAS v4i16_t*)(pt + 4096))); }
                    __builtin_amdgcn_sched_barrier(0);
                }
#pragma unroll
                for (int u4 = 0; u4 < 4; ++u4) { const int ut = hb * 4 + u4;
                    const u32x2 lw = tl_[u4], hw = th_[u4];
                    u32x2 ae, ao;
                    ae.x = __builtin_amdgcn_perm(lw.y, lw.x, 0x06040200u); ae.y = __builtin_amdgcn_perm(hw.y, hw.x, 0x06040200u);
                    ao.x = __builtin_amdgcn_perm(lw.y, lw.x, 0x07050301u); ao.y = __builtin_amdgcn_perm(hw.y, hw.x, 0x07050301u);
                    Oe[ut] = __builtin_amdgcn_mfma_f32_16x16x32_bf8_fp8(__builtin_bit_cast(long, ae), pk, Oe[ut], 0, 0, 0);
                    Oo[ut] = __builtin_amdgcn_mfma_f32_16x16x32_bf8_fp8(__builtin_bit_cast(long, ao), pk, Oo[ut], 0, 0, 0);
                }
                __builtin_amdgcn_sched_barrier(0);
            }
            if (j + 2 < nch) { asm volatile("s_waitcnt lgkmcnt(0)" ::: "memory"); ATT_DMA(j + 2, bo);
                if (have_item && j + 3 == nch) { tr_load(titem, lane, tcur); trf = true; } }
        }
#undef ATT_DMA
        l += __shfl_xor(l, 16); l += __shfl_xor(l, 32);
        const float inv = 1.0f / l;
        bf16_t* orow = (DRY ? (bf16_t*)(P.ws + WS_PP) + (size_t)(t & 8191) * 4096 : OLAT + (size_t)t * 4096) + fr * 256 + 8 * fq;
#pragma unroll
        for (int ut = 0; ut < 8; ++ut) {
            u32x4 w; w.x = pk2(Oe[ut].x * inv, Oo[ut].x * inv); w.y = pk2(Oe[ut].y * inv, Oo[ut].y * inv); w.z = pk2(Oe[ut].z * inv, Oo[ut].z * inv); w.w = pk2(Oe[ut].w * inv, Oo[ut].w * inv);
            *(u32x4*)(orow + 32 * ut) = w;
        }
        if (have_item) { asm volatile("s_waitcnt lgkmcnt(0)" ::: "memory"); tr_store(titem, (float*)(lds_ + wave * 16896), lane, tcur); ditem += NGW; }
    }
    for (; ditem < N_DEFERRED; ditem += NGW) { const TrItem t = deferred_item(P, ditem); float tmp[32]; tr_load(t, lane, tmp); tr_store(t, (float*)(lds_ + wave * 16896), lane, tmp); }
}

constexpr size_t SC_BATCH = (size_t)1024 * 256 * 257 / 2;
__device__ __forceinline__ size_t sc_row_off(int b, int tl) { const size_t m = (size_t)(tl >> 5); return (size_t)b * SC_BATCH + 1024 * (m * (m + 1) / 2) + (size_t)(tl & 31) * 32 * (m + 1); }
typedef float f32x16 __attribute__((ext_vector_type(16)));
__device__ __forceinline__ unsigned okey_pk(float a, float b) {
    const unsigned w = __builtin_bit_cast(unsigned, __builtin_amdgcn_cvt_pkrtz(a, b));
    const unsigned neg = (w >> 15) & 0x00010001u;
    return w ^ ((neg * 0xffffu) | 0x80008000u);
}
__device__ __forceinline__ void phase_index_scores(const Params& P, unsigned char* lds_) {
    using pg8::bf16x8;
    const bf16_t* Z1 = (const bf16_t*)(P.ws + WS_Z1); unsigned short* SC = (unsigned short*)(P.ws + WS_SC);
    LAS unsigned char* lds = (LAS unsigned char*)lds_;
    constexpr int QROW = 144;
    LAS unsigned char* QL = lds;
    LAS float* SG = (LAS float*)(lds + 9 * 64 * QROW);
    const int tid = threadIdx.x, lane = tid & 63, wave = __builtin_amdgcn_readfirstlane(tid >> 6);
    LAS unsigned char* ST = lds + 9 * 64 * QROW + 2048 + wave * 5120;
    const int l31 = lane & 31, hh = lane >> 5;
    for (int pid = blockIdx.x; pid < 256; pid += gridDim.x) {
        const int b = pid >> 6;
        for (int side = 0; side < 2; ++side) {
            const int qb = side ? (127 - (pid & 63)) : (pid & 63);
            const int q0 = qb * 64;
            __syncthreads();
            {
                const int qi = tid >> 3, part = tid & 7;
                const bf16_t* zr = Z1 + ((size_t)b * SEQ + q0 + qi) * Z1W;
                const u32x4 ww = *(const u32x4*)(zr + 1088);
                const float w8[8] = {bflo(ww.x), bfhi(ww.x), bflo(ww.y), bfhi(ww.y), bflo(ww.z), bfhi(ww.z), bflo(ww.w), bfhi(ww.w)};
                float wh = 0.f;
#pragma unroll
                for (int h = 0; h < 8; ++h) wh = (h == part) ? w8[h] : wh;
                const float sc = 0.5f * fabsf(wh);
                SG[qi * 8 + part] = (wh >= 0.f) ? 1.0f : -1.0f;
#pragma unroll
                for (int c = 0; c < 8; ++c) {
                    const u32x4 v = *(const u32x4*)(zr + 512 + part * 64 + c * 8);
                    u32x4 o; o.x = pk2(bflo(v.x) * sc, bfhi(v.x) * sc); o.y = pk2(bflo(v.y) * sc, bfhi(v.y) * sc); o.z = pk2(bflo(v.z) * sc, bfhi(v.z) * sc); o.w = pk2(bflo(v.w) * sc, bfhi(v.w) * sc);
                    *(LAS u32x4*)(QL + (part * 64 + qi) * QROW + c * 16) = o;
                }
                float a8[8];
#pragma unroll
                for (int j = 0; j < 8; ++j) a8[j] = 0.f;
#pragma unroll
                for (int h = 0; h < 8; ++h) {
                    const u32x4 v = *(const u32x4*)(zr + 512 + h * 64 + part * 8); const float s2 = 0.5f * w8[h];
                    a8[0] += s2 * bflo(v.x); a8[1] += s2 * bfhi(v.x); a8[2] += s2 * bflo(v.y); a8[3] += s2 * bfhi(v.y);
                    a8[4] += s2 * bflo(v.z); a8[5] += s2 * bfhi(v.z); a8[6] += s2 * bflo(v.w); a8[7] += s2 * bfhi(v.w);
                }
                u32x4 o; o.x = pk2(a8[0], a8[1]); o.y = pk2(a8[2], a8[3]); o.z = pk2(a8[4], a8[5]); o.w = pk2(a8[6], a8[7]);
                *(LAS u32x4*)(QL + (8 * 64 + qi) * QROW + part * 16) = o;
            }
            __syncthreads();
            const int ktmax = 2 * qb + 1;
            bf16x8 kn[4];
            {   const bf16_t* kr = Z1 + ((size_t)b * SEQ + min(wave, ktmax) * 32 + l31) * Z1W + 1024 + hh * 8;
#pragma unroll
                for (int dq = 0; dq < 4; ++dq) kn[dq] = *(const bf16x8*)(kr + dq * 16); }
            for (int kt = wave; kt <= ktmax; kt += NWAVE) {
                bf16x8 kf[4];
#pragma unroll
                for (int dq = 0; dq < 4; ++dq) kf[dq] = kn[dq];
                {   const bf16_t* kr = Z1 + ((size_t)b * SEQ + min(kt + NWAVE, ktmax) * 32 + l31) * Z1W + 1024 + hh * 8;
#pragma unroll
                    for (int dq = 0; dq < 4; ++dq) kn[dq] = *(const bf16x8*)(kr + dq * 16); }
#pragma unroll
                for (int qs = 0; qs < 2; ++qs) {
                    const LAS unsigned char* qrow = QL + (qs * 32 + l31) * QROW + hh * 16;
                    const LAS float* sgp = SG + (qs * 32 + l31) * 8;
                    bf16x8 fc[4], fn[4];
#pragma unroll
                    for (int dq = 0; dq < 4; ++dq) fc[dq] = *(const LAS bf16x8*)(qrow + 8 * 64 * QROW + dq * 32);
#pragma unroll
                    for (int dq = 0; dq < 4; ++dq) fn[dq] = *(const LAS bf16x8*)(qrow + dq * 32);
                    const f32x4 sg03 = *(const LAS f32x4*)(sgp), sg47 = *(const LAS f32x4*)(sgp + 4);
                    f32x16 acc;
#pragma unroll
                    for (int r = 0; r < 16; ++r) acc[r] = 0.f;
#pragma unroll
                    for (int dq = 0; dq < 4; ++dq) acc = __builtin_amdgcn_mfma_f32_32x32x16_bf16(kf[dq], fc[dq], acc, 0, 0, 0);
                    f32x16 up;
#pragma unroll
                    for (int h = 0; h < 8; ++h) {
#pragma unroll
                        for (int dq = 0; dq < 4; ++dq) fc[dq] = fn[dq];
                        if (h < 7) {
#pragma unroll
                            for (int dq = 0; dq < 4; ++dq) fn[dq] = *(const LAS bf16x8*)(qrow + (h + 1) * 64 * QROW + dq * 32);
                        }
                        f32x16 u;
#pragma unroll
                        for (int r = 0; r < 16; ++r) u[r] = 0.f;
#pragma unroll
                        for (int dq = 0; dq < 4; ++dq) u = __builtin_amdgcn_mfma_f32_32x32x16_bf16(kf[dq], fc[dq], u, 0, 0, 0);
                        __builtin_amdgcn_sched_barrier(0);
                        if (h > 0) {
                            const float sg = (h - 1 < 4) ? sg03[(h - 1) & 3] : sg47[(h - 1) & 3];
#pragma unroll
                            for (int r = 0; r < 16; ++r) acc[r] = fmaf(fabsf(up[r]), sg, acc[r]);
                        }
                        __builtin_amdgcn_sched_barrier(0);
                        up = u;
                    }
                    {
                        const float sg = sg47[3];
#pragma unroll
                        for (int r = 0; r < 16; ++r) acc[r] = fmaf(fabsf(up[r]), sg, acc[r]);
                    }
#pragma unroll
                    for (int g = 0; g < 4; ++g) { u32x2 w; w.x = okey_pk(acc[4 * g], acc[4 * g + 1]); w.y = okey_pk(acc[4 * g + 2], acc[4 * g + 3]);
                        *(LAS u32x2*)(ST + (qs * 32 + l31) * 80 + (8 * g + 4 * hh) * 2) = w; }
                }
#pragma unroll
                for (int i = 0; i < 4; ++i) {
                    const int row = 16 * i + (lane >> 2), ch = lane & 3, tl = q0 + row;
                    const u32x4 v = *(const LAS u32x4*)(ST + row * 80 + ch * 16);
                    if (kt <= (tl >> 5)) *(u32x4*)(SC + sc_row_off(b, tl) + (size_t)kt * 32 + ch * 8) = v;
                }
            }
        }
    }
}
template <int MODE>
__device__ __forceinline__ void phase_index_select(const Params& P, unsigned char* lds_) {
    const unsigned short* SC = (const unsigned short*)(P.ws + WS_SC); unsigned short* SEL = (unsigned short*)(P.ws + WS_SEL);
    const int tid = threadIdx.x, lane = tid & 63, wave = __builtin_amdgcn_readfirstlane(tid >> 6);
    LAS unsigned char* wbase = (LAS unsigned char*)lds_ + wave * 19456;
    LAS u32x4* rowbuf = (LAS u32x4*)wbase;
    LAS unsigned* hist = (LAS unsigned*)(wbase + 16384);
    LAS unsigned* dummy = hist + 512 + lane;
    LAS unsigned short* outw = (LAS unsigned short*)(wbase + 16384 + 2048 + 256);
    LAS unsigned short* dummy16 = outw + 256 + lane;
    const unsigned rowbuf0 = (unsigned)(unsigned long)wbase;
    const int gw = blockIdx.x * NWAVE + wave, NGW = gridDim.x * NWAVE;
#define SEL_DMA(tt) do { const int _tl = (tt) & (SEQ - 1), _n = _tl + 1; if (_n > TOPK) { const unsigned char* _src = (const unsigned char*)(SC + sc_row_off((tt) >> 13, _tl)) + lane * 16; \
            for (int _sg = 0; _sg * 512 < _n; ++_sg) glds16(_src + _sg * 1024, (unsigned)__builtin_amdgcn_readfirstlane((int)(rowbuf0 + _sg * 1024))); } } while (0)
#define SEL_Q(i) ((i) * NGW + (((i) & 1) ? (NGW - 1 - gw) : gw))
    if (SEL_Q(0) < NTOK) SEL_DMA(SEL_Q(0));
    for (int qi = 0; qi * NGW < NTOK; ++qi) {
        const int t = SEL_Q(qi), tnext = SEL_Q(qi + 1);
        if (t >= NTOK) { if (tnext < NTOK) SEL_DMA(tnext); continue; }
        const int tl = t & (SEQ - 1), n = tl + 1;
        unsigned short* so = SEL + (size_t)t * TOPK;
        if (n <= TOPK) { for (int i = lane; i < n; i += 64) so[i] = (unsigned short)i; if (tnext < NTOK && (qi + 1) * NGW < NTOK) SEL_DMA(tnext); continue; }
        asm volatile("s_waitcnt vmcnt(0)" ::: "memory");
        u32x4 d[16];
        const int lastsg = (n - 1) >> 9;
#pragma unroll
        for (int sg = 0; sg < 16; ++sg) {
            if (sg * 512 < n) {
                d[sg] = rowbuf[sg * 64 + lane];
                if (sg == lastsg) {
#pragma unroll
                    for (int q = 0; q < 4; ++q) { const int i0 = sg * 512 + lane * 8 + 2 * q;
                        d[sg][q] &= ((i0 < n) ? 0x0000ffffu : 0u) | ((i0 + 1 < n) ? 0xffff0000u : 0u); }
                }
            } else d[sg] = (u32x4){0u, 0u, 0u, 0u};
        }
        asm volatile("s_waitcnt lgkmcnt(0)" ::: "memory");
        if (tnext < NTOK && (qi + 1) * NGW < NTOK) SEL_DMA(tnext);
#pragma unroll
        for (int i = 0; i < 8; ++i) { hist[i * 64 + lane] = 0u; }
        asm volatile("s_waitcnt lgkmcnt(0)" ::: "memory");
        LAS unsigned* myh = hist + (lane & 1) * 256;
        if (MODE == 4) { if (d[0].x == 0x12345u) so[lane] = 1; continue; }
#pragma unroll
        for (int sg = 0; sg < 16; ++sg) if (MODE != 1 && sg * 512 < n) {
#pragma unroll
            for (int q = 0; q < 4; ++q) { const unsigned w = d[sg][q];
                __hip_atomic_fetch_add(myh + ((w >> 8) & 0xffu), 1u, __ATOMIC_RELAXED, __HIP_MEMORY_SCOPE_WORKGROUP);
                __hip_atomic_fetch_add(myh + (w >> 24), 1u, __ATOMIC_RELAXED, __HIP_MEMORY_SCOPE_WORKGROUP); }
        }
        asm volatile("s_waitcnt lgkmcnt(0)" ::: "memory");
        unsigned b1, need1;
        {
            unsigned c[4];
#pragma unroll
            for (int q = 0; q < 4; ++q) c[q] = hist[4 * lane + q] + hist[256 + 4 * lane + q];
            const unsigned mine = c[0] + c[1] + c[2] + c[3];
            unsigned suf = mine;
#pragma unroll
            for (int o = 1; o < 64; o <<= 1) { const unsigned v = __shfl_down(suf, o); if (lane + o < 64) suf += v; }
            const unsigned above = suf - mine;
            int fb = -1; unsigned fneed = 0;
            if (above < (unsigned)TOPK && suf >= (unsigned)TOPK) { unsigned a = above;
#pragma unroll
                for (int q = 3; q >= 0; --q) { if (fb < 0 && a + c[q] >= (unsigned)TOPK) { fb = 4 * lane + q; fneed = (unsigned)TOPK - a; } a += c[q]; } }
            const unsigned long long bal = __ballot(fb >= 0);
            const int src = (int)__builtin_ctzll(bal);
            b1 = (unsigned)__shfl(fb, src); need1 = __shfl(fneed, src);
        }
#pragma unroll
        for (int i = 0; i < 8; ++i) { hist[i * 64 + lane] = 0u; }
        asm volatile("s_waitcnt lgkmcnt(0)" ::: "memory");
#pragma unroll
        for (int sg = 0; sg < 16; ++sg) if (MODE != 2 && sg * 512 < n) {
#pragma unroll
            for (int q = 0; q < 4; ++q) { const unsigned w = d[sg][q];
                LAS unsigned* p0 = (((w >> 8) & 0xffu) == b1) ? (myh + (w & 0xffu)) : dummy;
                LAS unsigned* p1 = ((w >> 24) == b1) ? (myh + ((w >> 16) & 0xffu)) : dummy;
                __hip_atomic_fetch_add(p0, 1u, __ATOMIC_RELAXED, __HIP_MEMORY_SCOPE_WORKGROUP);
                __hip_atomic_fetch_add(p1, 1u, __ATOMIC_RELAXED, __HIP_MEMORY_SCOPE_WORKGROUP); }
        }
        asm volatile("s_waitcnt lgkmcnt(0)" ::: "memory");
        unsigned T, need2;
        {
            unsigned c[4];
#pragma unroll
            for (int q = 0; q < 4; ++q) c[q] = hist[4 * lane + q] + hist[256 + 4 * lane + q];
            const unsigned mine = c[0] + c[1] + c[2] + c[3];
            unsigned suf = mine;
#pragma unroll
            for (int o = 1; o < 64; o <<= 1) { const unsigned v = __shfl_down(suf, o); if (lane + o < 64) suf += v; }
            const unsigned above = suf - mine;
            int fb = -1; unsigned fneed = 0;
            if (above < need1 && suf >= need1) { unsigned a = above;
#pragma unroll
                for (int q = 3; q >= 0; --q) { if (fb < 0 && a + c[q] >= need1) { fb = 4 * lane + q; fneed = need1 - a; } a += c[q]; } }
            const unsigned long long bal = __ballot(fb >= 0);
            const int src = (int)__builtin_ctzll(bal);
            T = (b1 << 8) | (unsigned)__shfl(fb, src); need2 = __shfl(fneed, src);
        }
        unsigned base = 0; const unsigned ngt = (unsigned)TOPK - need2; unsigned eqbase = 0;
#pragma unroll
        for (int sg = 0; sg < 16; ++sg) if (MODE != 3 && sg * 512 < n) {
            unsigned ce = 0;
#pragma unroll
            for (int j = 0; j < 8; ++j) {
                const unsigned k = (j & 1) ? (d[sg][j >> 1] >> 16) : (d[sg][j >> 1] & 0xffffu);
                const bool gt = k > T;
                const unsigned long long mk = __ballot(gt);
                const unsigned pos = base + (unsigned)__builtin_amdgcn_mbcnt_hi((unsigned)(mk >> 32), __builtin_amdgcn_mbcnt_lo((unsigned)mk, 0u));
                LAS unsigned short* po = gt ? (outw + pos) : dummy16;
                *po = (unsigned short)(sg * 512 + lane * 8 + j);
                base += (unsigned)__builtin_popcountll(mk);
                ce += (k == T) ? 1u : 0u;
            }
            if (__any(ce > 0u)) {
                unsigned pre = ce;
#pragma unroll
                for (int o = 1; o < 64; o <<= 1) { const unsigned v = __shfl_up(pre, o); if (lane >= o) pre += v; }
                unsigned r = eqbase + pre - ce;
#pragma unroll
                for (int j = 0; j < 8; ++j) { const unsigned k = (j & 1) ? (d[sg][j >> 1] >> 16) : (d[sg][j >> 1] & 0xffffu);
                    if (k == T) { if (r < need2) outw[ngt + r] = (unsigned short)(sg * 512 + lane * 8 + j); ++r; } }
                eqbase += __shfl(pre, 63);
            }
        }
        asm volatile("s_waitcnt lgkmcnt(0)" ::: "memory");
        ((unsigned*)so)[lane] = ((LAS unsigned*)outw)[lane];
        ((unsigned*)so)[64 + lane] = ((LAS unsigned*)outw)[64 + lane];
        asm volatile("s_waitcnt lgkmcnt(0)" ::: "memory");
    }
#undef SEL_DMA
#undef SEL_Q
    asm volatile("s_waitcnt vmcnt(0)" ::: "memory");
}

__device__ __forceinline__ void ret_fill_image(LAS unsigned char* img, const unsigned char* src, size_t row_stride_bytes, int wave, int lane) {
#pragma unroll
    for (int e4 = 0; e4 < 4; ++e4) {
        const int e = wave * 4 + e4, row = 4 * e + (lane >> 4), q = (lane & 15) ^ ((row & 7) << 1);
        __builtin_amdgcn_global_load_lds((const unsigned*)(src + (size_t)row * row_stride_bytes + q * 16), (LAS unsigned*)(img + e * 1024), 16, 0, 0);
    }
}
__device__ __forceinline__ pg8::bf16x8 ret_tr_pair(const LAS unsigned char* img, int row0, int chunk2, int lane) {
    const int g = lane >> 4, i = lane & 15, r0 = row0 + 4 * g + (i >> 2), pb = (i & 3) >> 1, half = (i & 1) * 8;
    const int r1 = r0 + 16;
    const v4i16_t lo = __builtin_amdgcn_ds_read_tr16_b64_v4i16((LAS v4i16_t*)(img + r0 * 256 + ((((chunk2) ^ ((r0 & 7) << 1)) | pb) << 4) + half));
    const v4i16_t hi = __builtin_amdgcn_ds_read_tr16_b64_v4i16((LAS v4i16_t*)(img + r1 * 256 + ((((chunk2) ^ ((r1 & 7) << 1)) | pb) << 4) + half));
    return (pg8::bf16x8){lo[0], lo[1], lo[2], lo[3], hi[0], hi[1], hi[2], hi[3]};
}
__device__ __forceinline__ void phase_ret_kv_mfma(const Params& P, unsigned char* lds_) {
    using pg8::bf16x8;
    const unsigned char* Z0 = (const unsigned char*)(P.ws + WS_Z0); float* KV = (float*)(P.ws + WS_KV);
    LAS unsigned char* Kimg = (LAS unsigned char*)lds_; LAS unsigned char* Vimg = Kimg + 32768;
    const int tid = threadIdx.x, lane = tid & 63, wave = __builtin_amdgcn_readfirstlane(tid >> 6), fr = lane & 15, fq = lane >> 4;
    for (int u = blockIdx.x; u < 1024; u += gridDim.x) {
        const int n = u & 63, h = (u >> 6) & 3, b = u >> 8;
        const size_t row0 = (size_t)b * SEQ + n * 128;
        __syncthreads();
        ret_fill_image(Kimg, Z0 + row0 * ZW * 2 + (512 + h * 128) * 2, ZW * 2, wave, lane);
        ret_fill_image(Vimg, Z0 + row0 * ZW * 2 + (1024 + h * 128) * 2, ZW * 2, wave, lane);
        asm volatile("s_waitcnt vmcnt(0)" ::: "memory");
        __syncthreads();
        bf16x8 va[4];
#pragma unroll
        for (int jc = 0; jc < 4; ++jc) va[jc] = ret_tr_pair(Vimg, 32 * jc, 2 * wave, lane);
        const float g127 = exp2f(ret_log2g(h) * 127.0f);
        float* o = KV + (size_t)u * 16384;
#pragma unroll
        for (int dt = 0; dt < 8; ++dt) {
            f32x4 acc = {0.f, 0.f, 0.f, 0.f};
#pragma unroll
            for (int jc = 0; jc < 4; ++jc) acc = __builtin_amdgcn_mfma_f32_16x16x32_bf16(va[jc], ret_tr_pair(Kimg, 32 * jc, 2 * dt, lane), acc, 0, 0, 0);
            *(f32x4*)(o + (size_t)(16 * dt + fr) * 128 + 16 * wave + 4 * fq) = acc * g127;
        }
    }
}
__device__ __forceinline__ void phase_ret_scan_pool2(const Params& P) {
    const float* KV = (const float*)(P.ws + WS_KV); bf16_t* SB = (bf16_t*)(P.ws + WS_SB);
    const size_t gt = (size_t)blockIdx.x * NT + threadIdx.x, GS = (size_t)gridDim.x * NT;
    for (size_t i = gt; i < (size_t)16 * 8192; i += GS) {
        const int s = (int)(i >> 13), e2 = (int)(i & 8191), h = s & 3;
        const float l2 = ret_log2g(h), cd = exp2f(l2 * 128.0f), g1 = exp2f(l2);
        typedef float f32x2v __attribute__((ext_vector_type(2)));
        const f32x2v* p = (const f32x2v*)(KV + (size_t)s * 64 * 16384) + e2;
        unsigned* q = (unsigned*)(SB + (size_t)s * 64 * 16384) + e2;
        f32x2v R = {0.f, 0.f};
        for (int n0 = 0; n0 < 64; n0 += 16) {
            f32x2v kv[16];
#pragma unroll
            for (int j = 0; j < 16; ++j) kv[j] = __builtin_nontemporal_load(p + (size_t)(n0 + j) * 8192);
#pragma unroll
            for (int j = 0; j < 16; ++j) { q[(size_t)(n0 + j) * 8192] = pk2(R.x * g1, R.y * g1); R = R * cd + kv[j]; }
        }
    }
    const bf16_t* Z0 = (const bf16_t*)(P.ws + WS_Z0); bf16_t* DP = (bf16_t*)(P.ws + WS_DP);
    for (size_t i = gt; i < (size_t)NTOK * 64; i += GS) {
        const int t = (int)(i >> 6), c8 = (int)(i & 63) * 8, g = c8 >> 7, w = 2 << g, tl = t & (SEQ - 1);
        const int cnt = min(tl + 1, w);
        float sm[8];
#pragma unroll
        for (int j = 0; j < 8; ++j) sm[j] = 0.f;
        float u0[8];
        for (int q = 0; q < cnt; ++q) {
            const u32x4 v = *(const u32x4*)(Z0 + (size_t)(t - q) * ZW + 2048 + c8);
            const float f[8] = {bflo(v.x), bfhi(v.x), bflo(v.y), bfhi(v.y), bflo(v.z), bfhi(v.z), bflo(v.w), bfhi(v.w)};
#pragma unroll
            for (int j = 0; j < 8; ++j) { sm[j] += f[j]; if (q == 0) u0[j] = f[j]; }
        }
        const float inv = 1.0f / (float)cnt;
        u32x4 o; o.x = pk2(sm[0] * inv - u0[0], sm[1] * inv - u0[1]); o.y = pk2(sm[2] * inv - u0[2], sm[3] * inv - u0[3]);
        o.z = pk2(sm[4] * inv - u0[4], sm[5] * inv - u0[5]); o.w = pk2(sm[6] * inv - u0[6], sm[7] * inv - u0[7]);
        *(u32x4*)(DP + (size_t)t * 512 + c8) = o;
    }
}
__device__ __forceinline__ void phase_ret_out_mfma(const Params& P, unsigned char* lds_) {
    using pg8::bf16x8;
    const unsigned char* Z0 = (const unsigned char*)(P.ws + WS_Z0); const unsigned char* SB = (const unsigned char*)(P.ws + WS_SB); bf16_t* MIX = (bf16_t*)(P.ws + WS_MIX);
    const float* gn = P.in[3];
    LAS unsigned char* Kimg = (LAS unsigned char*)lds_; LAS unsigned char* Vimg = Kimg + 32768; LAS unsigned char* Rimg = Kimg + 65536;
    const int tid = threadIdx.x, lane = tid & 63, wave = __builtin_amdgcn_readfirstlane(tid >> 6), fr = lane & 15, fq = lane >> 4;
    for (int u = blockIdx.x; u < 1024; u += gridDim.x) {
        const int n = u & 63, h = (u >> 6) & 3, b = u >> 8;
        const size_t row0 = (size_t)b * SEQ + n * 128;
        __syncthreads();
        ret_fill_image(Kimg, Z0 + row0 * ZW * 2 + (512 + h * 128) * 2, ZW * 2, wave, lane);
        ret_fill_image(Vimg, Z0 + row0 * ZW * 2 + (1024 + h * 128) * 2, ZW * 2, wave, lane);
        ret_fill_image(Rimg, SB + (size_t)u * 32768, 256, wave, lane);
        const bf16_t* qrow = (const bf16_t*)Z0 + (row0 + 16 * wave + fr) * ZW + h * 128;
        bf16x8 qf[4], qr[4];
#pragma unroll
        for (int c = 0; c < 4; ++c) {
            qf[c] = *(const bf16x8*)(qrow + 32 * c + 8 * fq);
            const u32x2 a = *(const u32x2*)(qrow + 32 * c + 4 * fq), bb = *(const u32x2*)(qrow + 32 * c + 16 + 4 * fq);
            u32x4 w; w.x = a.x; w.y = a.y; w.z = bb.x; w.w = bb.y; qr[c] = __builtin_bit_cast(bf16x8, w);
        }
        asm volatile("s_waitcnt vmcnt(0)" ::: "memory");
        __syncthreads();
        f32x4 sT[8];
#pragma unroll
        for (int jt = 0; jt < 8; ++jt) sT[jt] = (f32x4){0.f, 0.f, 0.f, 0.f};
#pragma unroll
        for (int jt = 0; jt < 8; ++jt) if (jt <= wave) {
            const int r = 16 * jt + fr;
#pragma unroll
            for (int c = 0; c < 4; ++c) {
                const bf16x8 a = *(const LAS bf16x8*)(Kimg + r * 256 + ((((4 * c + fq)) ^ ((r & 7) << 1)) << 4));
                sT[jt] = __builtin_amdgcn_mfma_f32_16x16x32_bf16(a, qf[c], sT[jt], 0, 0, 0);
            }
            if (jt == wave) {
                if (4 * fq + 0 > fr) sT[jt].x = 0.f; if (4 * fq + 1 > fr) sT[jt].y = 0.f; if (4 * fq + 2 > fr) sT[jt].z = 0.f; if (4 * fq + 3 > fr) sT[jt].w = 0.f;
            }
        }
        bf16x8 pT[4];
#pragma unroll
        for (int jp = 0; jp < 4; ++jp) { u32x4 w; w.x = pk2(sT[2 * jp].x, sT[2 * jp].y); w.y = pk2(sT[2 * jp].z, sT[2 * jp].w); w.z = pk2(sT[2 * jp + 1].x, sT[2 * jp + 1].y); w.w = pk2(sT[2 * jp + 1].z, sT[2 * jp + 1].w);
            pT[jp] = __builtin_bit_cast(bf16x8, w); }
        f32x4 O[8];
#pragma unroll
        for (int vt = 0; vt < 8; ++vt) {
            f32x4 acc = {0.f, 0.f, 0.f, 0.f};
#pragma unroll
            for (int jp = 0; jp < 4; ++jp) if (2 * jp <= wave) acc = __builtin_amdgcn_mfma_f32_16x16x32_bf16(ret_tr_pair(Vimg, 32 * jp, 2 * vt, lane), pT[jp], acc, 0, 0, 0);
#pragma unroll
            for (int c = 0; c < 4; ++c) acc = __builtin_amdgcn_mfma_f32_16x16x32_bf16(ret_tr_pair(Rimg, 32 * c, 2 * vt, lane), qr[c], acc, 0, 0, 0);
            O[vt] = acc;
        }
        float sm = 0.f;
#pragma unroll
        for (int vt = 0; vt < 8; ++vt) sm += (O[vt].x + O[vt].y) + (O[vt].z + O[vt].w);
        sm += __shfl_xor(sm, 16); sm += __shfl_xor(sm, 32);
        const float mu = sm * (1.0f / 128.0f);
        float sq = 0.f;
#pragma unroll
        for (int vt = 0; vt < 8; ++vt) { const f32x4 dlt = O[vt] - mu; sq += (dlt.x * dlt.x + dlt.y * dlt.y) + (dlt.z * dlt.z + dlt.w * dlt.w); }
        sq += __shfl_xor(sq, 16); sq += __shfl_xor(sq, 32);
        const float rstd = 1.0f / sqrtf(sq * (1.0f / 128.0f) + LN_EPS);
        const bf16_t* grow = (const bf16_t*)Z0 + (row0 + 16 * wave + fr) * ZW + 1536 + h * 128 + 4 * fq;
        bf16_t* orow = MIX + (row0 + 16 * wave + fr) * DM + h * 128 + 4 * fq;
#pragma unroll
        for (int vt = 0; vt < 8; ++vt) {
            const u32x2 gv = *(const u32x2*)(grow + 16 * vt);
            const f32x4 g4 = *(const f32x4*)(gn + h * 128 + 16 * vt + 4 * fq);
            const f32x4 y = (O[vt] - mu) * rstd * g4;
            u32x2 w; w.x = pk2(y.x * silu_f(bflo(gv.x)), y.y * silu_f(bfhi(gv.x))); w.y = pk2(y.z * silu_f(bflo(gv.y)), y.w * silu_f(bfhi(gv.y)));
            *(u32x2*)(orow + 16 * vt) = w;
        }
    }
}

#define XB_TMO      128
#define XB_XCNT(j)  (256  + 64 * (j))
#define XB_XSUB(j)  (1280 + 64 * (j))
#define XB_XGEN(j)  (2304 + 64 * (j))
#define XB_TOP      3328
#define XB_TOPGEN   3392
#define XCD_BAR_WORDS 3456
#define XB_SPIN_CAP (1u << 22)
__device__ __forceinline__ unsigned xb_ld(unsigned* p)              { return __hip_atomic_load(p, __ATOMIC_RELAXED, __HIP_MEMORY_SCOPE_AGENT); }
__device__ __forceinline__ unsigned xb_add(unsigned* p, unsigned v) { return __hip_atomic_fetch_add(p, v, __ATOMIC_RELAXED, __HIP_MEMORY_SCOPE_AGENT); }
__device__ __forceinline__ unsigned xb_xcc_id() { return (unsigned)__builtin_amdgcn_s_getreg((3 << 11) | 20) & 0xFu; }
#define XB_SPIN(cond, bar) do { unsigned _sp = 0; while (cond) { __builtin_amdgcn_s_sleep(1); \
    if ((++_sp & 255u) == 0u) { if (xb_ld(&(bar)[XB_TMO])) break; if (_sp > XB_SPIN_CAP) { atomicAdd(&(bar)[XB_TMO], 1u); break; } } } } while (0)
struct XcdBarrier { unsigned* bar; unsigned x; volatile LAS unsigned* st; };
__device__ __forceinline__ XcdBarrier xcd_barrier_post(unsigned* bar, volatile LAS unsigned* st) {
    XcdBarrier b; b.bar = bar; b.x = xb_xcc_id(); b.st = st;
    if (threadIdx.x == 0) (void)xb_add(&bar[XB_XCNT(b.x)], 1u);
    return b;
}
__device__ __forceinline__ void xcd_barrier_complete(unsigned* bar, unsigned x, unsigned& nloc, unsigned& nx) {
    const unsigned G = gridDim.x * gridDim.y * gridDim.z;
    unsigned sum, cnt, mine, sp = 0u;
    for (;;) {
        sum = 0u; cnt = 0u; mine = 0u;
#pragma unroll
        for (unsigned j = 0; j < 16; ++j) { const unsigned c = xb_ld(&bar[XB_XCNT(j)]); sum += c; cnt += (c > 0u) ? 1u : 0u; mine = (j == x) ? c : mine; }
        if (sum == G) break;
        __builtin_amdgcn_s_sleep(1);
        if ((++sp & 255u) == 0u) { if (xb_ld(&bar[XB_TMO])) break; if (sp > XB_SPIN_CAP) { atomicAdd(&bar[XB_TMO], 1u); break; } }
    }
    nloc = mine > 0u ? mine : 1u; nx = cnt > 0u ? cnt : 1u;
}
__device__ __forceinline__ void xcd_barrier(const XcdBarrier& b) {
    asm volatile("s_waitcnt vmcnt(0)" ::: "memory");
    __syncthreads();
    if (threadIdx.x == 0) {
        unsigned* bar = b.bar;
        __builtin_amdgcn_s_waitcnt(0);
        unsigned nloc = b.st[0], nx = b.st[1];
        if (nloc == 0u) { xcd_barrier_complete(bar, b.x, nloc, nx); b.st[0] = nloc; b.st[1] = nx; }
        const unsigned old = xb_add(&bar[XB_XSUB(b.x)], 1u);
        const unsigned gen = old / nloc;
        if (old + 1u == (gen + 1u) * nloc) {
            __builtin_amdgcn_fence(__ATOMIC_RELEASE, "agent");
            asm volatile("s_waitcnt vmcnt(0)" ::: "memory");
            const unsigned og = xb_add(&bar[XB_TOP], 1u);
            const unsigned tg = og / nx;
            if (og + 1u == (tg + 1u) * nx) xb_add(&bar[XB_TOPGEN], 1u);
            else XB_SPIN(xb_ld(&bar[XB_TOPGEN]) == tg, bar);
            __builtin_amdgcn_fence(__ATOMIC_ACQUIRE, "agent");
            xb_add(&bar[XB_XGEN(b.x)], 1u);
            asm volatile("s_waitcnt vmcnt(0)" ::: "memory");
        } else {
            XB_SPIN(xb_ld(&bar[XB_XGEN(b.x)]) == gen, bar);
            __builtin_amdgcn_fence(__ATOMIC_ACQUIRE, "agent");
            asm volatile("s_waitcnt vmcnt(0)" ::: "memory");
        }
    }
    __syncthreads();
}
constexpr size_t CTL_BAR_OFF = 16384;
constexpr size_t CTL_ZERO_BYTES = 65536;

#ifdef PH_ONLY
#define IN(k) ((k) == PH_ONLY)
#else
#define IN(k) (lo <= (k) && (k) < hi)
#endif
#define SEAM(k) do { if (IN(k) && IN((k) + 1)) xcd_barrier(grid); } while (0)
#ifndef PROBE_DUP
#define PROBE_DUP (-1)
#endif
#define REP(k) for (int _rep = 0; _rep < ((PROBE_DUP == (k)) ? 2 : 1); ++_rep)
#define REPS(k) ((PROBE_DUP == 100 + (k)) ? 2 : 1)

template <int LAYER, int BASE>
__device__ __forceinline__ void layer_tail(const Params& P, unsigned char* lds, const XcdBarrier& grid, int lo, int hi) {
    unsigned char* ws = P.ws;
    int* tb = (int*)(lds + MISC_OFF);
    if (IN(BASE)) { if (PROBE_DUP == BASE) phase_ln_route<true>(P, lds, LAYER); phase_ln_route<false>(P, lds, LAYER); }
    SEAM(BASE);
    if (IN(BASE + 1)) REP(BASE + 1) { moe_setup(P, tb, LAYER);
        MoeSched S{tb, (const int*)(ws + WS_CTL) + LAYER * 64, (const int*)(ws + WS_LIST), (const bf16_t*)(ws + WS_XB),
                   (const bf16_t*)(ws + WS_W_GU) + (size_t)LAYER * 32 * DM * DM, DM, (size_t)DM * DM, true};
        EpiGU E{(bf16_t*)(ws + WS_ACT)}; gemm_moe<true>(lds, S, E);
        { const int U = tb[32] * 4, G = (int)gridDim.x, nheavy = (U % G), nlight = G - nheavy, lr = (int)blockIdx.x - nheavy;
          DenseSched S2{(const bf16_t*)(ws + WS_PB) + (size_t)LAYER * NTOK * 256, (const bf16_t*)(ws + WS_W_P) + (size_t)LAYER * DM * 256, NTOK, DM, 256, 256, 0, 1, lr, nlight};
          EpiStoreBf16 E2{(bf16_t*)(ws + WS_PP), DM, 0, nullptr}; gemm_dense(lds, S2, E2); } }
    SEAM(BASE + 1);
    if (IN(BASE + 2)) REP(BASE + 2) { moe_setup(P, tb, LAYER);
        MoeSched S{tb, (const int*)(ws + WS_CTL) + LAYER * 64, (const int*)(ws + WS_LIST), (const bf16_t*)(ws + WS_ACT),
                   (const bf16_t*)(ws + WS_W_DN) + (size_t)LAYER * 32 * DM * 512, 512, (size_t)DM * 512, false};
        EpiDown E{(bf16_t*)(ws + WS_YS)}; gemm_moe<false>(lds, S, E); }
    SEAM(BASE + 2);
    if (IN(BASE + 3)) { if (PROBE_DUP == BASE + 3) phase_ln2<true>(P, LAYER); phase_ln2<false>(P, LAYER); }
    SEAM(BASE + 3);
    if (IN(BASE + 4)) REP(BASE + 4) {
        { DenseSched S{(const bf16_t*)(ws + WS_XB), (const bf16_t*)(ws + WS_W_G) + (size_t)LAYER * DM * DM, NTOK, DM, DM, DM, 0, REPS(BASE + 4)};
          EpiPle E{(const bf16_t*)(ws + WS_XB), (const bf16_t*)(ws + WS_PP), LAYER == 1 ? P.out : (float*)nullptr, LAYER == 1 ? (bf16_t*)nullptr : (bf16_t*)(ws + WS_XB2)}; gemm_dense(lds, S, E); }
    }
}

__global__ void __launch_bounds__(NT, 2) mega(Params P, int lo, int hi) {
    extern __shared__ __attribute__((aligned(16))) unsigned char lds[];
    unsigned char* ws = P.ws;
    if (threadIdx.x < 16) ((LAS unsigned*)((LAS unsigned char*)lds + BARW_OFF))[threadIdx.x] = 0u;
    __syncthreads();
    const XcdBarrier grid = xcd_barrier_post((unsigned*)(ws + WS_CTL + CTL_BAR_OFF), (volatile LAS unsigned*)((LAS unsigned char*)lds + BARW_OFF));
    if (IN(0)) REP(0) phase_prep(P, lds);
    SEAM(0);
    if (IN(1)) REP(1) { DenseSched S{(const bf16_t*)(ws + WS_XB), (const bf16_t*)(ws + WS_W_IN0), NTOK, ZW, DM, DM, 0, REPS(1)};
        EpiZ0 E{(bf16_t*)(ws + WS_Z0)}; gemm_dense(lds, S, E); }
    SEAM(1);
    if (IN(2)) REP(2) phase_ret_kv_mfma(P, lds);
    SEAM(2);
    if (IN(3)) REP(3) phase_ret_scan_pool2(P);
    SEAM(3);
    if (IN(4)) REP(4) { phase_ret_out_mfma(P, lds); __syncthreads();
        DenseSched S{(const bf16_t*)(ws + WS_DP), (const bf16_t*)(ws + WS_W_POOL), NTOK, 512, 256, 512, 256};
        EpiStoreBf16 E{(bf16_t*)(ws + WS_MIX), DM, 512, P.in[5]}; gemm_dense(lds, S, E); }
    SEAM(4);
    if (IN(5)) REP(5) { DenseSched S{(const bf16_t*)(ws + WS_MIX), (const bf16_t*)(ws + WS_W_OUT0), NTOK, DM, DM, DM, 0, REPS(5)};
        EpiResidB E{(const bf16_t*)(ws + WS_XB), (bf16_t*)(ws + WS_F)}; gemm_dense(lds, S, E); }
    SEAM(5);
    layer_tail<0, 6>(P, lds, grid, lo, hi);
    SEAM(10);
    if (IN(11)) REP(11) { DenseSched S{(const bf16_t*)(ws + WS_XB2), (const bf16_t*)(ws + WS_W_CIN), NTOK, Z1W, DM, DM, 0, REPS(11)};
        EpiStoreBf16 E{(bf16_t*)(ws + WS_Z1), Z1W, 0, nullptr}; gemm_dense(lds, S, E); }
    SEAM(11);
    if (IN(12)) REP(12) { phase_norms(P); phase_index_scores(P, lds); }
    SEAM(12);
    if (IN(13)) { if (PROBE_DUP == 13) phase_index_select<PROBE_SEL>(P, lds); phase_index_select<0>(P, lds); }
    if (IN(13) && IN(14)) __syncthreads();
    if (IN(14)) REP(14) { DenseSched S{(const bf16_t*)(ws + WS_CQ), (const bf16_t*)(ws + WS_W_QA), NTOK, 4096, 256, 256, 0, REPS(14)};
        EpiStoreFp8 E{(unsigned char*)(ws + WS_QA), 4096}; gemm_dense(lds, S, E); }
    SEAM(14);
    if (IN(15)) { if (PROBE_DUP == 15) phase_sparse_attn_e<true>(P, lds); phase_sparse_attn_e<false>(P, lds); }
    SEAM(15);
    if (IN(16)) REP(16) { DenseSched S{(const bf16_t*)(ws + WS_OLAT), (const bf16_t*)(ws + WS_W_UVBD), NTOK, DM, DM, 4096, 1024, REPS(16)};
        EpiStoreBf16 E{(bf16_t*)(ws + WS_XB), DM, 0, nullptr}; gemm_dense(lds, S, E); }
    SEAM(16);
    if (IN(17)) REP(17) { DenseSched S{(const bf16_t*)(ws + WS_XB), (const bf16_t*)(ws + WS_W_COUT), NTOK, DM, DM, DM, 0, REPS(17)};
        EpiResidB E{(const bf16_t*)(ws + WS_XB2), (bf16_t*)(ws + WS_F)}; gemm_dense(lds, S, E); }
    SEAM(17);
    layer_tail<1, 18>(P, lds, grid, lo, hi);
}
#undef IN
#undef SEAM

extern "C" void kernel_launch(void* const* d_in, const int* in_sizes, int n_in, void* d_out, int out_size, void* d_ws, size_t ws_size, hipStream_t stream) {
    static int grid = 0;
    if (grid == 0) {
        if (n_in != 26 || ws_size < WS_END || out_size != NTOK * DM) { fprintf(stderr, "kernel_launch: unexpected problem (n_in %d, ws %zu, out %d)\n", n_in, ws_size, out_size); grid = -1; return; }
        int dev = 0, cus = 0, per_cu = 0;
        (void)hipGetDevice(&dev);
        (void)hipDeviceGetAttribute(&cus, hipDeviceAttributeMultiprocessorCount, dev);
        (void)hipFuncSetAttribute((const void*)mega, hipFuncAttributeMaxDynamicSharedMemorySize, LDS_BYTES);
        (void)hipOccupancyMaxActiveBlocksPerMultiprocessor(&per_cu, (const void*)mega, NT, LDS_BYTES);
        if (per_cu < 1) { fprintf(stderr, "kernel_launch: occupancy query reports %d blocks per CU\n", per_cu); per_cu = 1; }
        (void)hipGetLastError();
        grid = cus;
    }
    if (grid < 0) return;
    (void)hipMemsetAsync((char*)d_ws + WS_CTL, 0, CTL_ZERO_BYTES, stream);
    Params p{};
    for (int i = 0; i < 26; ++i) p.in[i] = (const float*)d_in[i];
    p.out = (float*)d_out; p.ws = (unsigned char*)d_ws;
#if MK_ONE_LAUNCH
    int lo = 0, hi = NPH_TOTAL;
    void* args[] = {&p, &lo, &hi};
    (void)args;
    hipLaunchKernelGGL(mega, dim3(grid), dim3(NT), LDS_BYTES, stream, p, lo, hi);
    hipError_t e = hipPeekAtLastError();
    if (e != hipSuccess) fprintf(stderr, "launch failed: %s (grid %d)\n", hipGetErrorString(e), grid);
#else
    for (int k = 0; k < NPH_TOTAL; ++k) hipLaunchKernelGGL(mega, dim3(grid), dim3(NT), LDS_BYTES, stream, p, k, k + 1);
#endif
}
```

```cpp
#include <hip/hip_runtime.h>
#include <cstdio>
#include <cstdint>

#ifndef PROBE_ATT
#define PROBE_ATT 0
#endif
#ifndef PROBE_SEL
#define PROBE_SEL 0
#endif
#ifndef MK_ONE_LAUNCH
#define MK_ONE_LAUNCH 1
#endif

typedef unsigned short bf16_t;
typedef float f32x4 __attribute__((ext_vector_type(4)));
typedef unsigned u32x4 __attribute__((ext_vector_type(4)));
typedef unsigned u32x2 __attribute__((ext_vector_type(2)));

constexpr int NT = 512;
constexpr int NWAVE = NT / 64;
constexpr int NTOK = 32768, DM = 1024, SEQ = 8192, NBATCH = 4;
constexpr int ZW = 2560;
constexpr int Z1W = 1280;
constexpr int CIN = 1096;
constexpr int TOPK = 256;
constexpr float ALPHA = 1.4142135623730951f;
constexpr float LN_EPS = 1e-5f;
constexpr int LDS_BYTES = 163840;
constexpr int BARW_OFF = LDS_BYTES - 64;
constexpr int MISC_OFF = 135168;

constexpr size_t MiB = (size_t)1 << 20;
constexpr size_t WS_CTL = 0;
constexpr size_t WS_W_IN0 = 1 * MiB, WS_W_OUT0 = 6 * MiB, WS_W_POOL = 8 * MiB, WS_W_CIN = 9 * MiB, WS_W_QA = 12 * MiB,
                 WS_W_UVBD = 14 * MiB, WS_W_COUT = 16 * MiB, WS_W_G = 18 * MiB, WS_W_P = 22 * MiB, WS_W_GU = 24 * MiB, WS_W_DN = 152 * MiB;
constexpr size_t WS_XB = 224 * MiB, WS_F = 288 * MiB, WS_PB = 416 * MiB, WS_PP = 448 * MiB, WS_CQ = 512 * MiB, WS_CKV = 528 * MiB,
                 WS_SEL = 544 * MiB, WS_TOKG = 560 * MiB, WS_LIST = 561 * MiB, WS_CKV8 = 566 * MiB;
constexpr size_t WS_M0 = 576 * MiB;
constexpr size_t WS_Z0 = WS_M0, WS_KV = WS_M0 + 160 * MiB, WS_MIX = WS_M0 + 224 * MiB, WS_DP = WS_M0 + 288 * MiB, WS_SB = WS_M0 + 320 * MiB;
constexpr size_t WS_OLAT = WS_M0, WS_QA = WS_F  , WS_SC = WS_M0, WS_Z1 = WS_M0 + 272 * MiB;
constexpr size_t WS_ACT = WS_M0, WS_YS = WS_M0 + 72 * MiB;
constexpr size_t WS_XB2 = 960 * MiB;
constexpr size_t WS_END = 1024 * MiB;
constexpr int LIST_CAP = 32768;
constexpr size_t WS_GT = WS_CTL + 262144;
constexpr size_t WS_SGB = WS_CTL + 786432;

struct Params {
    const float* in[26];
    float* out;
    unsigned char* ws;
};

__device__ __forceinline__ unsigned f2bf(float f) { unsigned u = __float_as_uint(f); return (u + 0x7fffu + ((u >> 16) & 1u)) >> 16; }
__device__ __forceinline__ float bf2f(unsigned h) { return __uint_as_float(h << 16); }
typedef float f32x2_t __attribute__((ext_vector_type(2))); typedef __bf16 bf16x2_t __attribute__((ext_vector_type(2)));
__device__ __forceinline__ unsigned pk2(float lo, float hi) { f32x2_t v = {lo, hi}; bf16x2_t b = __builtin_convertvector(v, bf16x2_t); return __builtin_bit_cast(unsigned, b); }
__device__ __forceinline__ float bflo(unsigned w) { return __uint_as_float(w << 16); }
__device__ __forceinline__ float bfhi(unsigned w) { return __uint_as_float(w & 0xffff0000u); }
#define WAVE_SUM_DPP(v) ({ float _v = (v); \
    _v += __builtin_bit_cast(float, __builtin_amdgcn_update_dpp(0, __builtin_bit_cast(int, _v), 0xB1, 0xf, 0xf, true));     \
    _v += __builtin_bit_cast(float, __builtin_amdgcn_update_dpp(0, __builtin_bit_cast(int, _v), 0x4E, 0xf, 0xf, true));     \
    _v += __builtin_bit_cast(float, __builtin_amdgcn_update_dpp(0, __builtin_bit_cast(int, _v), 0x141, 0xf, 0xf, true));    \
    _v += __builtin_bit_cast(float, __builtin_amdgcn_update_dpp(0, __builtin_bit_cast(int, _v), 0x140, 0xf, 0xf, true));    \
    _v += __builtin_bit_cast(float, __builtin_amdgcn_update_dpp(0, __builtin_bit_cast(int, _v), 0x142, 0xa, 0xf, false));   \
    _v += __builtin_bit_cast(float, __builtin_amdgcn_update_dpp(0, __builtin_bit_cast(int, _v), 0x143, 0xc, 0xf, false));   \
    __builtin_bit_cast(float, __builtin_amdgcn_readlane(__builtin_bit_cast(int, _v), 63)); })
__device__ __forceinline__ float wave_sum(float v) { return WAVE_SUM_DPP(v); }
#define WAVE_SCAN_DPP(v) ({ unsigned _v = (v); \
    _v += (unsigned)__builtin_amdgcn_update_dpp(0, (int)_v, 0x111, 0xf, 0xf, false); \
    _v += (unsigned)__builtin_amdgcn_update_dpp(0, (int)_v, 0x112, 0xf, 0xf, false); \
    _v += (unsigned)__builtin_amdgcn_update_dpp(0, (int)_v, 0x114, 0xf, 0xf, false); \
    _v += (unsigned)__builtin_amdgcn_update_dpp(0, (int)_v, 0x118, 0xf, 0xf, false); \
    _v += (unsigned)__builtin_amdgcn_update_dpp(0, (int)_v, 0x142, 0xa, 0xf, false); \
    _v += (unsigned)__builtin_amdgcn_update_dpp(0, (int)_v, 0x143, 0xc, 0xf, false); \
    _v; })

__device__ __forceinline__ float silu_f(float a) { return a / (1.0f + __expf(-a)); }
__device__ __forceinline__ float sigmoid_f(float a) { return 1.0f / (1.0f + __expf(-a)); }
#define LDS_FENCE() asm volatile("s_waitcnt lgkmcnt(0)" ::: "memory")

struct UnitInfo {
    const bf16_t* A; int lda;
    const int* rows; int rshift;
    int nvalid;
    const bf16_t* Bt; int ldb;
    int K;
    int orow0;
    int pn;
};

struct DenseSched {
    const bf16_t* A; const bf16_t* Bt; int M, N, K, lda, a_pn_stride; int reps = 1;
    int wrank = -1, wcount = 0;
    __device__ __forceinline__ bool next(int round, UnitInfo& u) const {
        const int nN = N >> 8, nM = M >> 8, nwg = nN * nM;
        if (wcount > 0 && wrank < 0) return false;
        const long L = (wcount > 0) ? ((long)round * wcount + wrank) : ((long)round * gridDim.x + blockIdx.x); if (L >= (long)nwg * reps) return false;
        int wgid = (int)(L % nwg); { const int q = nwg / 8, r = nwg % 8, xcd = wgid % 8, off = wgid / 8; wgid = (xcd < r ? xcd * (q + 1) : r * (q + 1) + (xcd - r) * q) + off; }
        const int nig = 8 * nN, gid = wgid / nig, fm = gid * 8, gsz = (nM - fm) < 8 ? (nM - fm) : 8;
        const int pm = fm + ((wgid % nig) % gsz), pn = (wgid % nig) / gsz;
        u.A = A + (size_t)pm * 256 * lda + (size_t)pn * a_pn_stride; u.lda = lda; u.rows = nullptr; u.rshift = 0; u.nvalid = 256;
        u.Bt = Bt + (size_t)pn * 256 * K; u.ldb = K; u.K = K; u.orow0 = pm * 256; u.pn = pn;
        return true;
    }
};
struct MoeSched {
    const int* tb; const int* cnt; const int* list;
    const bf16_t* A; const bf16_t* W; int K; size_t wstride; bool gather;
    __device__ __forceinline__ bool next(int round, UnitInfo& u) const {
        const int i = round * gridDim.x + blockIdx.x;
        const int j = i >> 2, pn = i & 3;
        if (j >= tb[32]) return false;
        int e = 0;
        while (tb[e + 1] <= j) ++e;
        const int rb = j - tb[e];
        const int nv = min(256, cnt[e] - rb * 256);
        u.rows = list + (size_t)e * LIST_CAP + rb * 256; u.nvalid = nv; u.orow0 = j * 256; u.pn = pn;
        if (gather) { u.A = A; u.lda = K; u.rshift = 1; }
        else { u.A = A + (size_t)j * 256 * K; u.lda = K; u.rshift = 31;   }
        u.Bt = W + (size_t)e * wstride + (size_t)pn * 256 * K; u.ldb = K; u.K = K;
        return true;
    }
};


namespace pg8 {
#define LAS __attribute__((address_space(3)))
typedef short bf16x8 __attribute__((ext_vector_type(8)));
constexpr int BK = 64, HALF = 128, HTB = HALF * BK * 2, STAGE_BYTES = 8 * HTB;
__device__ __forceinline__ int lds_byte(int r, int c) { const int st = (r >> 4) * 2 + (c >> 5), rr = r & 15, cc = c & 31, ob = rr * 64 + cc * 2; return st * 1024 + (ob ^ (((ob >> 9) & 1) << 5)); }
__device__ __forceinline__ void stage_rc(int b, int& R, int& C) { const int st = b / 1024, sb = b % 1024, swz = sb ^ (((sb >> 9) & 1) << 5); R = (st >> 1) * 16 + swz / 64; C = (st & 1) * 32 + (swz % 64) / 2; }
__device__ __forceinline__ int perm32(int rho) { const int n = rho >> 4, i = rho & 15; return 8 * (i >> 2) + 4 * n + (i & 3); }

template <bool GATHER, class Sched, class Epi>
__device__ __forceinline__ void gemm_phase(LAS unsigned char* lds, const LAS unsigned* rowtab, const Sched& S, const Epi& E, const int lda, const int ldb, const int K) {
    const int tid = threadIdx.x, wid = __builtin_amdgcn_readfirstlane(tid >> 6), lane = tid & 63, wr = wid >> 2, wc = wid & 3, fr = lane & 15, fq = lane >> 4;
    const int nt = K / BK;
    unsigned voffA[2], voffB[2]; int RA[2]; unsigned CA2[2];
#pragma unroll
    for (int i = 0; i < 2; ++i) { int R, C; stage_rc(tid * 16 + i * 8192, R, C); const int Rb = (R & ~31) + perm32(R & 31);
        voffA[i] = (unsigned)(R * lda + C) * 2u; voffB[i] = (unsigned)(Rb * ldb + C) * 2u; RA[i] = R; CA2[i] = (unsigned)C * 2u; }
    const size_t kstep = (size_t)(BK * 2);
    const size_t hstepA = (size_t)HALF * lda * 2, hstepB = (size_t)HALF * ldb * 2;
    const unsigned ldsw = (unsigned)wid * 1024u;
    const int aoff = lds_byte(wr * 64 + fr, fq * 8), boff = lds_byte(wc * 32 + fr, fq * 8);
    unsigned offA[2][2];
#define PG8_SA(b, h) (((b) * 2 + (h)) * HTB)
#define PG8_SB(b, h) ((4 + (b) * 2 + (h)) * HTB)
#define PG8_STAGE(bufoff, gbase, voff) do { _Pragma("unroll") for (int _i = 0; _i < 2; ++_i) \
        __builtin_amdgcn_global_load_lds((const unsigned*)((const char*)(gbase) + (voff)[_i]), (LAS unsigned*)(lds + (bufoff) + ldsw + _i * 8192), 16, 0, 0); } while (0)
#define PG8_STAGE_A(bufoff, h, gbase) do { if (GATHER) PG8_STAGE(bufoff, gbase, offA[h]); else PG8_STAGE(bufoff, (gbase) + (h) * hstepA, voffA); } while (0)
#define PG8_LOADOFF(round) do { _Pragma("unroll") for (int _h = 0; _h < 2; ++_h) _Pragma("unroll") for (int _i = 0; _i < 2; ++_i) offA[_h][_i] = rowtab[(round) * 256 + _h * 128 + RA[_i]] + CA2[_i]; } while (0)
#define PG8_LDA(dst, b, h) do { _Pragma("unroll") for (int m = 0; m < 4; ++m) _Pragma("unroll") for (int k = 0; k < 2; ++k) dst[m][k] = *(const LAS bf16x8*)(lds + PG8_SA(b, h) + aoff + m * 2048 + k * 1024); } while (0)
#define PG8_LDB(dst, b, h) do { _Pragma("unroll") for (int n = 0; n < 2; ++n) _Pragma("unroll") for (int k = 0; k < 2; ++k) dst[n][k] = *(const LAS bf16x8*)(lds + PG8_SB(b, h) + boff + n * 2048 + k * 1024); } while (0)
#define PG8_MMA(ai, bj, At, Bt) do { __builtin_amdgcn_s_setprio(1); _Pragma("unroll") for (int m = 0; m < 4; ++m) _Pragma("unroll") for (int n = 0; n < 2; ++n) _Pragma("unroll") for (int k = 0; k < 2; ++k) \
        acc[ai][bj][m][n] = __builtin_amdgcn_mfma_f32_16x16x32_bf16(Bt[n][k], At[m][k], acc[ai][bj][m][n], 0, 0, 0); __builtin_amdgcn_s_setprio(0); } while (0)
#define PG8_WAIT_V(n) asm volatile("s_waitcnt vmcnt(" #n ")" ::: "memory")
#define PG8_WAIT_L(n) asm volatile("s_waitcnt lgkmcnt(" #n ")" ::: "memory")
#define PG8_BAR __builtin_amdgcn_s_barrier()
#define PG8_SCHED __builtin_amdgcn_sched_barrier(0)
    UnitInfo cur, nxt; int ui = 0;
    if (!S.next(0, cur)) return;
    f32x4 acc[2][2][4][2];
#pragma unroll
    for (int a = 0; a < 2; ++a)
#pragma unroll
        for (int b = 0; b < 2; ++b)
#pragma unroll
            for (int m = 0; m < 4; ++m)
#pragma unroll
                for (int n = 0; n < 2; ++n) acc[a][b][m][n] = (f32x4){0.f, 0.f, 0.f, 0.f};
    bf16x8 At[4][2], B0[2][2], B1[2][2];
    const char* cA = (const char*)cur.A; const char* cB = (const char*)cur.Bt;
    if (GATHER) { PG8_LOADOFF(0); }
    PG8_STAGE(PG8_SB(0, 0), cB, voffB); PG8_STAGE(PG8_SB(0, 1), cB + hstepB, voffB); PG8_STAGE_A(PG8_SA(0, 0), 0, cA); PG8_STAGE_A(PG8_SA(0, 1), 1, cA);
    if (wr == 1) PG8_BAR;
    PG8_WAIT_V(2); PG8_BAR;
    PG8_STAGE(PG8_SB(1, 0), cB + kstep, voffB); PG8_STAGE_A(PG8_SA(1, 0), 0, cA + kstep); PG8_STAGE(PG8_SB(1, 1), cB + hstepB + kstep, voffB);
    PG8_WAIT_V(6); PG8_BAR;
    for (;;) {
        const bool has_next = S.next(ui + 1, nxt);
        const char* nA = has_next ? (const char*)nxt.A : cA; const char* nB = has_next ? (const char*)nxt.Bt : cB;
        for (int t = 0; t < nt; t += 2) {
            const bool last = (t == nt - 2);
            const char* a1 = cA + (size_t)(t + 1) * kstep;
            const char* a2 = last ? nA : cA + (size_t)(t + 2) * kstep; const char* b2 = last ? nB : cB + (size_t)(t + 2) * kstep;
            const char* a3 = a2 + kstep; const char* b3 = b2 + kstep;
            PG8_LDB(B0, 0, 0); PG8_LDB(B1, 0, 1); PG8_SCHED; PG8_LDA(At, 0, 0); PG8_STAGE_A(PG8_SA(1, 1), 1, a1);
            if (GATHER) { if (last && has_next) { PG8_LOADOFF(ui + 1); } }
            PG8_WAIT_V(8); PG8_WAIT_L(0); PG8_BAR; PG8_MMA(0, 0, At, B0); PG8_MMA(0, 1, At, B1); PG8_BAR; PG8_SCHED;
            PG8_LDA(At, 0, 1); PG8_STAGE(PG8_SB(0, 0), b2, voffB); PG8_STAGE(PG8_SB(0, 1), b2 + hstepB, voffB); PG8_STAGE_A(PG8_SA(0, 0), 0, a2);
            PG8_WAIT_V(8); PG8_WAIT_L(0); PG8_BAR; PG8_MMA(1, 0, At, B0); PG8_MMA(1, 1, At, B1); PG8_BAR; PG8_SCHED;
            PG8_LDB(B0, 1, 0); PG8_LDB(B1, 1, 1); PG8_SCHED; PG8_LDA(At, 1, 0); PG8_STAGE_A(PG8_SA(0, 1), 1, a2);
            PG8_WAIT_V(8); PG8_WAIT_L(0); PG8_BAR; PG8_MMA(0, 0, At, B0); PG8_MMA(0, 1, At, B1); PG8_BAR; PG8_SCHED;
            PG8_LDA(At, 1, 1); PG8_STAGE(PG8_SB(1, 0), b3, voffB); PG8_STAGE(PG8_SB(1, 1), b3 + hstepB, voffB); PG8_STAGE_A(PG8_SA(1, 0), 0, a3);
            PG8_WAIT_V(8); PG8_WAIT_L(0); PG8_BAR; PG8_MMA(1, 0, At, B0); PG8_MMA(1, 1, At, B1); PG8_BAR; PG8_SCHED;
        }
        if (wr == 0) PG8_BAR;
#pragma unroll
        for (int ai = 0; ai < 2; ++ai)
#pragma unroll
            for (int m = 0; m < 4; ++m)
#pragma unroll
                for (int bj = 0; bj < 2; ++bj) E(cur, ai * HALF + wr * 64 + m * 16 + fr, bj * HALF + wc * 32 + 8 * fq, acc[ai][bj][m][0], acc[ai][bj][m][1]);
        if (!has_next) break;
#pragma unroll
        for (int a = 0; a < 2; ++a)
#pragma unroll
            for (int b = 0; b < 2; ++b)
#pragma unroll
                for (int m = 0; m < 4; ++m)
#pragma unroll
                    for (int n = 0; n < 2; ++n) acc[a][b][m][n] = (f32x4){0.f, 0.f, 0.f, 0.f};
        cur = nxt; cA = nA; cB = nB; ++ui;
        if (wr == 1) PG8_BAR;
    }
    PG8_WAIT_V(0);
    PG8_BAR;
#undef PG8_SA
#undef PG8_SB
#undef PG8_STAGE
#undef PG8_STAGE_A
#undef PG8_LOADOFF
#undef PG8_LDA
#undef PG8_LDB
#undef PG8_MMA
#undef PG8_WAIT_V
#undef PG8_WAIT_L
#undef PG8_BAR
#undef PG8_SCHED
}
}

template <class Sched, class Epi>
__device__ __forceinline__ void gemm_dense(unsigned char* lds, const Sched& S, const Epi& E) {
    pg8::gemm_phase<false>((LAS unsigned char*)lds, (const LAS unsigned*)nullptr, S, E, S.lda, S.K, S.K);
    __syncthreads();
}


template <bool GATHER, class Epi>
__device__ __forceinline__ void gemm_moe(unsigned char* lds, const MoeSched& S, const Epi& E) {
    LAS unsigned* rowtab = (LAS unsigned*)(lds + MISC_OFF + 256);
    if (GATHER) {
        UnitInfo u;
        for (int round = 0; round < 10 && S.next(round, u); ++round)
            if (threadIdx.x < 256) rowtab[round * 256 + threadIdx.x] = ((int)threadIdx.x < u.nvalid) ? (unsigned)(u.rows[threadIdx.x] >> 1) * (unsigned)(S.K * 2) : 0u;
        __syncthreads();
    }
    pg8::gemm_phase<GATHER>((LAS unsigned char*)lds, (const LAS unsigned*)rowtab, S, E, S.K, S.K, S.K);
    __syncthreads();
}

__device__ __forceinline__ u32x4 pack8(f32x4 a, f32x4 b) { u32x4 w; w.x = pk2(a.x, a.y); w.y = pk2(a.z, a.w); w.z = pk2(b.x, b.y); w.w = pk2(b.z, b.w); return w; }
struct EpiStoreBf16 {
    bf16_t* O; int ldc; int coff; const float* colscale;
    __device__ __forceinline__ void operator()(const UnitInfo& u, int r, int c, f32x4 v0, f32x4 v1) const {
        const int col = u.pn * 256 + c;
        if (colscale) { const f32x4 s0 = *(const f32x4*)(colscale + col), s1 = *(const f32x4*)(colscale + col + 4); v0 *= s0; v1 *= s1; }
        *(u32x4*)(O + (size_t)(u.orow0 + r) * ldc + coff + col) = pack8(v0, v1);
    }
};

__device__ __forceinline__ float ret_log2g(int h) { return log2f(1.0f - exp2f(-5.0f - (float)h)); }
struct EpiZ0 {
    bf16_t* O;
    __device__ __forceinline__ void operator()(const UnitInfo& u, int r, int c, f32x4 v0, f32x4 v1) const {
        const int col = u.pn * 256 + c, row = u.orow0 + r;
        if (col < 1024) { const float e = ret_log2g((col >> 7) & 3) * (float)(row & 127); const float sc = exp2f(col < 512 ? e : -e); v0 *= sc; v1 *= sc; }
        *(u32x4*)(O + (size_t)row * ZW + col) = pack8(v0, v1);
    }
};

struct EpiStoreFp8 {
    unsigned char* O; int ldc;
    __device__ __forceinline__ void operator()(const UnitInfo& u, int r, int c, f32x4 v0, f32x4 v1) const {
        int w0 = __builtin_amdgcn_cvt_pk_fp8_f32(v0.x, v0.y, 0, false); w0 = __builtin_amdgcn_cvt_pk_fp8_f32(v0.z, v0.w, w0, true);
        int w1 = __builtin_amdgcn_cvt_pk_fp8_f32(v1.x, v1.y, 0, false); w1 = __builtin_amdgcn_cvt_pk_fp8_f32(v1.z, v1.w, w1, true);
        u32x2 w; w.x = (unsigned)w0; w.y = (unsigned)w1;
        *(u32x2*)(O + (size_t)(u.orow0 + r) * ldc + u.pn * 256 + c) = w;
    }
};
struct EpiResidB {
    const bf16_t* X; bf16_t* Yo;
    __device__ __forceinline__ void operator()(const UnitInfo& u, int r, int c, f32x4 v0, f32x4 v1) const {
        const size_t off = (size_t)(u.orow0 + r) * DM + u.pn * 256 + c;
        const u32x4 xw = *(const u32x4*)(X + off);
        const f32x4 x0 = {bflo(xw.x), bfhi(xw.x), bflo(xw.y), bfhi(xw.y)}, x1 = {bflo(xw.z), bfhi(xw.z), bflo(xw.w), bfhi(xw.w)};
        *(u32x4*)(Yo + off) = pack8(x0 * ALPHA + v0, x1 * ALPHA + v1);
    }
};

struct EpiGU {
    bf16_t* ACT;
    __device__ __forceinline__ void operator()(const UnitInfo& u, int r, int c, f32x4 v0, f32x4 v1) const {
        u32x2 w; w.x = pk2(silu_f(v0.x) * v0.y, silu_f(v0.z) * v0.w); w.y = pk2(silu_f(v1.x) * v1.y, silu_f(v1.z) * v1.w);
        *(u32x2*)(ACT + (size_t)(u.orow0 + r) * 512 + u.pn * 128 + (c >> 1)) = w;
    }
};
struct EpiDown {
    bf16_t* YS;
    __device__ __forceinline__ void operator()(const UnitInfo& u, int r, int c, f32x4 v0, f32x4 v1) const {
        if (r < u.nvalid) { const int pair = u.rows[r]; *(u32x4*)(YS + (size_t)pair * DM + u.pn * 256 + c) = pack8(v0, v1); }
    }
};
struct EpiPle {
    const bf16_t* XI; const bf16_t* PP; float* OUT; bf16_t* XO;
    __device__ __forceinline__ void operator()(const UnitInfo& u, int r, int c, f32x4 v0, f32x4 v1) const {
        const size_t off = (size_t)(u.orow0 + r) * DM + u.pn * 256 + c;
        const u32x4 pw = *(const u32x4*)(PP + off), xw = *(const u32x4*)(XI + off);
        f32x4 f0 = {bflo(xw.x), bfhi(xw.x), bflo(xw.y), bfhi(xw.y)}, f1 = {bflo(xw.z), bfhi(xw.z), bflo(xw.w), bfhi(xw.w)};
        f0.x += sigmoid_f(v0.x) * bflo(pw.x); f0.y += sigmoid_f(v0.y) * bfhi(pw.x); f0.z += sigmoid_f(v0.z) * bflo(pw.y); f0.w += sigmoid_f(v0.w) * bfhi(pw.y);
        f1.x += sigmoid_f(v1.x) * bflo(pw.z); f1.y += sigmoid_f(v1.y) * bfhi(pw.z); f1.z += sigmoid_f(v1.z) * bflo(pw.w); f1.w += sigmoid_f(v1.w) * bfhi(pw.w);
        if (OUT) { *(f32x4*)(OUT + off) = f0; *(f32x4*)(OUT + off + 4) = f1; }
        if (XO) *(u32x4*)(XO + off) = pack8(f0, f1);
    }
};

struct TrDesc { const float* src; bf16_t* dst; int K, N, Nsrc, nbatch, mode, dst_ld; };
struct TrItem { const float* src; bf16_t* dst; int Nsrc, dst_ld, mode, kb, nb; };
__device__ __forceinline__ void tr_load(const TrItem& t, int lane, float (&tmp)[32]) {
    const int k0 = 64 * t.kb, n0 = 32 * t.nb, Ns = t.Nsrc;
    const bool okc = (n0 + (lane & 31)) < Ns;
    const float* p = t.src + (size_t)(k0 + (lane >> 5)) * Ns + n0 + (lane & 31);
#pragma unroll
    for (int i = 0; i < 32; ++i) { tmp[i] = okc ? __builtin_nontemporal_load(p) : 0.f; p += 2 * Ns; asm volatile("" : "+v"(p)); }
}
__device__ __forceinline__ void tr_store(const TrItem& t, float* scr, int lane, const float (&tmp)[32]) {
    const int k0 = 64 * t.kb, n0 = 32 * t.nb;
#pragma unroll
    for (int i = 0; i < 32; ++i) scr[(2 * i + (lane >> 5)) * 33 + (lane & 31)] = tmp[i];
    LDS_FENCE();
    const int c = lane & 7;
#pragma unroll
    for (int j = 0; j < 4; ++j) {
        const int n = (lane >> 3) + 8 * j; const float* sp = scr + (8 * c) * 33 + n;
        const int ng = n0 + n;
        float sc = 1.f; int nd = ng; int coff = 0;
        if (t.mode == 1) { if (ng >= 512 && ng < 1024) sc = 0.08838834764831845f; }
        if (t.mode == 2) { nd = (ng < 512) ? 2 * ng : 2 * (ng - 512) + 1; }
        if (t.mode == 3) { coff = ((ng >> 6) & 3) * 256; }
        u32x4 o; o.x = pk2(sp[0 * 33] * sc, sp[1 * 33] * sc); o.y = pk2(sp[2 * 33] * sc, sp[3 * 33] * sc); o.z = pk2(sp[4 * 33] * sc, sp[5 * 33] * sc); o.w = pk2(sp[6 * 33] * sc, sp[7 * 33] * sc);
        *(u32x4*)(t.dst + (size_t)nd * t.dst_ld + coff + k0 + 8 * c) = o;
    }
    LDS_FENCE();
}
__device__ __forceinline__ int tr_items(const TrDesc& d) { return d.nbatch * (d.K / 64) * (d.N / 32); }

constexpr int N_DEFERRED = 32 * 512 + 32 * 256;
__device__ __forceinline__ TrItem deferred_item(const Params& P, int idx) {
    TrItem t;
    if (idx < 32 * 512) { const int b = 32 + (idx >> 9), r = idx & 511;
        t.src = P.in[22] + (size_t)b * 1024 * 1024; t.dst = (bf16_t*)(P.ws + WS_W_GU) + (size_t)b * 1024 * 1024; t.Nsrc = 1024; t.dst_ld = 1024; t.mode = 2; t.kb = r >> 5; t.nb = r & 31; }
    else { const int i2 = idx - 32 * 512, b = 32 + (i2 >> 8), r = i2 & 255;
        t.src = P.in[23] + (size_t)b * 512 * 1024; t.dst = (bf16_t*)(P.ws + WS_W_DN) + (size_t)b * 1024 * 512; t.Nsrc = 1024; t.dst_ld = 512; t.mode = 0; t.kb = r >> 5; t.nb = r & 31; }
    return t;
}
__device__ __forceinline__ void phase_prep(const Params& P, unsigned char* lds) {
    unsigned char* ws = P.ws;
    const int tid = threadIdx.x, lane = tid & 63, wave = tid >> 6;
    const int gw = blockIdx.x * NWAVE + wave, NGW = gridDim.x * NWAVE;
    float* scr = (float*)lds + wave * (64 * 33);
    constexpr int ND = 9;
    TrDesc d[ND];
    d[0] = {P.in[22], (bf16_t*)(ws + WS_W_GU), 1024, 1024, 1024, 32, 2, 1024};
    d[1] = {P.in[23], (bf16_t*)(ws + WS_W_DN), 512, 1024, 1024, 32, 0, 512};
    d[2] = {P.in[2], (bf16_t*)(ws + WS_W_IN0), 1024, 2560, 2560, 1, 1, 1024};
    d[3] = {P.in[6], (bf16_t*)(ws + WS_W_OUT0), 1024, 1024, 1024, 1, 0, 1024};
    d[4] = {P.in[13], (bf16_t*)(ws + WS_W_COUT), 1024, 1024, 1024, 1, 0, 1024};
    d[5] = {P.in[24], (bf16_t*)(ws + WS_W_G), 1024, 1024, 1024, 2, 0, 1024};
    d[6] = {P.in[25], (bf16_t*)(ws + WS_W_P), 256, 1024, 1024, 2, 0, 256};
    d[7] = {P.in[7], (bf16_t*)(ws + WS_W_CIN), 1024, Z1W, CIN, 1, 0, 1024};
    d[8] = {P.in[12], (bf16_t*)(ws + WS_W_UVBD), 256, 1024, 1024, 1, 3, 1024};
    int total = 0;
#pragma unroll
    for (int i = 0; i < ND; ++i) total += tr_items(d[i]);
#define TR_DECODE(it, T) do { int _r = (it); bool _f = false; T = TrItem{nullptr, nullptr, 0, 0, 0, 0, 0}; _Pragma("unroll") for (int _i = 0; _i < ND; ++_i) { const int _n = tr_items(d[_i]); \
            if (!_f && _r < _n) { _f = true; const int _per = (d[_i].K / 64) * (d[_i].N / 32), _b = _r / _per, _q = _r % _per, _nblk = d[_i].N / 32; \
                T.src = d[_i].src + (size_t)_b * d[_i].K * d[_i].Nsrc; T.dst = d[_i].dst + (size_t)_b * d[_i].N * d[_i].dst_ld; T.Nsrc = d[_i].Nsrc; T.dst_ld = d[_i].dst_ld; T.mode = d[_i].mode; T.kb = _q / _nblk; T.nb = _q % _nblk; } \
            if (!_f) _r -= _n; } } while (0)
    {
        float cur[32], nxt[32];
        TrItem tc, tn;
        int it = gw;
        if (it < total) { TR_DECODE(it, tc); tr_load(tc, lane, cur); }
        while (it < total) {
            const int itn = it + NGW;
            if (itn < total) { TR_DECODE(itn, tn); tr_load(tn, lane, nxt); }
            tr_store(tc, scr, lane, cur);
#pragma unroll
            for (int i = 0; i < 32; ++i) cur[i] = nxt[i];
            it = itn; tc = tn;
        }
    }
#undef TR_DECODE
    const size_t gt = (size_t)blockIdx.x * NT + tid, GS = (size_t)gridDim.x * NT;
    {
        bf16_t* o = (bf16_t*)(ws + WS_W_POOL); const float* pw = P.in[4];
        for (size_t i = gt; i < 512 * 256; i += GS) { const int n = (int)(i >> 8), k = (int)(i & 255), g = n >> 7, dd = n & 127, kg = k >> 7, c = k & 127;
            o[i] = (bf16_t)((kg == (g & 1)) ? f2bf(pw[((size_t)g * 128 + c) * 128 + dd]) : 0u); }
    }
    {
        u32x4* o = (u32x4*)(ws + WS_W_UVBD);
        for (size_t i = gt; i < (size_t)1024 * 1024 / 8; i += GS) { const int n = (int)(i >> 7), k = (int)(i & 127) * 8; if (((n >> 6) & 3) != (k >> 8)) o[i] = (u32x4){0u, 0u, 0u, 0u}; }
    }
    {
        bf16_t* o = (bf16_t*)(ws + WS_W_QA); const float* uq = P.in[10]; const float* uk = P.in[11];
        float* Bq = (float*)lds; float* Ak = Bq + 256 * 65;
        for (int item = blockIdx.x; item < 128; item += gridDim.x) {
            const int h = item >> 3, c0 = (item & 7) * 32;
            __syncthreads();
            for (int i = tid; i < 256 * 16; i += NT) { const int r = i >> 4, d4 = (i & 15) * 4; const f32x4 v = *(const f32x4*)(uq + (size_t)r * 1024 + h * 64 + d4);
                float* q = Bq + r * 65 + d4; q[0] = v.x; q[1] = v.y; q[2] = v.z; q[3] = v.w; }
            for (int i = tid; i < 32 * 16; i += NT) { const int c = i >> 4, d4 = (i & 15) * 4; const f32x4 v = *(const f32x4*)(uk + (size_t)(c0 + c) * 1024 + h * 64 + d4);
                float* q = Ak + c * 65 + d4; q[0] = v.x; q[1] = v.y; q[2] = v.z; q[3] = v.w; }
            __syncthreads();
            const int r = tid & 255, cg = tid >> 8;
            float acc[16];
#pragma unroll
            for (int j = 0; j < 16; ++j) acc[j] = 0.f;
            for (int dd = 0; dd < 64; ++dd) { const float bv = Bq[r * 65 + dd];
#pragma unroll
                for (int j = 0; j < 16; ++j) acc[j] += Ak[(cg * 16 + j) * 65 + dd] * bv; }
#pragma unroll
            for (int j = 0; j < 16; ++j) o[(size_t)(h * 256 + c0 + cg * 16 + j) * 256 + r] = (bf16_t)f2bf(acc[j] * 0.125f);
        }
        __syncthreads();
    }
    {
        bf16_t* GT = (bf16_t*)(ws + WS_GT); float* SGB = (float*)(ws + WS_SGB);
        for (size_t i = gt; i < (size_t)2 * 48 * 1024; i += GS) {
            const int l = (int)(i / (48 * 1024)), j = (int)((i / 1024) % 48), c = (int)(i & 1023);
            float w = 0.f;
            if (j < 4) w = P.in[18][(size_t)l * DM * 4 + (size_t)c * 4 + j]; else if (j < 36) w = P.in[20][(size_t)l * DM * 32 + (size_t)c * 32 + (j - 4)];
            const float g = P.in[14][l * DM + c] * w;
            const unsigned hi = f2bf(g); const unsigned lo = f2bf(g - bf2f(hi));
            GT[((size_t)(l * 2 + 0) * 48 + j) * 1024 + c] = (bf16_t)hi; GT[((size_t)(l * 2 + 1) * 48 + j) * 1024 + c] = (bf16_t)lo;
        }
        for (int it = gw; it < 96; it += NGW) {
            const int l = it / 48, j = it % 48; float sg = 0.f, sb = 0.f;
            for (int c = lane; c < 1024; c += 64) {
                float w = 0.f;
                if (j < 4) w = P.in[18][(size_t)l * DM * 4 + (size_t)c * 4 + j]; else if (j < 36) w = P.in[20][(size_t)l * DM * 32 + (size_t)c * 32 + (j - 4)];
                sg += P.in[14][l * DM + c] * w; sb += P.in[15][l * DM + c] * w;
            }
            sg = wave_sum(sg); sb = wave_sum(sb);
            const float bias = (j < 4) ? P.in[19][l * 4 + j] : ((j < 36) ? P.in[21][l * 32 + (j - 4)] : 0.f);
            if (lane == 0) { SGB[(l * 2 + 0) * 48 + j] = sg; SGB[(l * 2 + 1) * 48 + j] = sb + bias; }
        }
    }
    {
        const f32x4* x = (const f32x4*)P.in[0]; u32x4* xb = (u32x4*)(ws + WS_XB);
        const size_t nx = (size_t)NTOK * DM / 8, np = (size_t)2 * NTOK * 256 / 8;
        size_t i = gt;
        for (; i + 3 * GS < nx; i += 4 * GS) { f32x4 a[8];
#pragma unroll
            for (int q = 0; q < 4; ++q) { a[2 * q] = __builtin_nontemporal_load(x + 2 * (i + q * GS)); a[2 * q + 1] = __builtin_nontemporal_load(x + 2 * (i + q * GS) + 1); }
#pragma unroll
            for (int q = 0; q < 4; ++q) xb[i + q * GS] = pack8(a[2 * q], a[2 * q + 1]); }
        for (; i < nx; i += GS) xb[i] = pack8(x[2 * i], x[2 * i + 1]);
        const f32x4* p = (const f32x4*)P.in[1]; u32x4* pb = (u32x4*)(ws + WS_PB);
        i = gt;
        for (; i + 3 * GS < np; i += 4 * GS) { f32x4 a[8];
#pragma unroll
            for (int q = 0; q < 4; ++q) { a[2 * q] = __builtin_nontemporal_load(p + 2 * (i + q * GS)); a[2 * q + 1] = __builtin_nontemporal_load(p + 2 * (i + q * GS) + 1); }
#pragma unroll
            for (int q = 0; q < 4; ++q) pb[i + q * GS] = pack8(a[2 * q], a[2 * q + 1]); }
        for (; i < np; i += GS) pb[i] = pack8(p[2 * i], p[2 * i + 1]);
    }
}


template <bool DRY>
__device__ __forceinline__ void phase_ln_route(const Params& P, unsigned char* lds, int layer) {
    using pg8::bf16x8;
    const bf16_t* F = (const bf16_t*)(P.ws + WS_F); bf16_t* XB = (bf16_t*)(P.ws + (DRY ? WS_M0 + 128 * MiB : WS_XB));
    float* TOKG = (float*)(P.ws + WS_TOKG); int* LIST = (int*)(P.ws + WS_LIST);
    int* CNT = (int*)(P.ws + WS_CTL) + layer * 64;
    const float* lg = P.in[14] + layer * DM; const float* lb = P.in[15] + layer * DM;
    const bf16_t* GTh = (const bf16_t*)(P.ws + WS_GT) + (size_t)(layer * 2) * 48 * 1024; const bf16_t* GTl = GTh + 48 * 1024;
    const float* SG = (const float*)(P.ws + WS_SGB) + (layer * 2) * 48; const float* BB = SG + 48;
    const int tid = threadIdx.x, lane = tid & 63, wave = tid >> 6, r16 = lane & 15, g = lane >> 4;
    int* dec = (int*)lds;
    int* rank = dec + 256;
    int* lcnt = rank + 256;
    int* lbase = lcnt + 32;
    float* stat = (float*)(lds + 4096) + wave * 32;
    float* LG = (float*)(lds + 8192) + wave * (16 * 48);
    f32x4 g4[4], b4[4];
#pragma unroll
    for (int j = 0; j < 4; ++j) { g4[j] = *(const f32x4*)(lg + 256 * j + 4 * lane); b4[j] = *(const f32x4*)(lb + 256 * j + 4 * lane); }
    for (int rb = blockIdx.x; rb < NTOK / 128; rb += gridDim.x) {
        if (tid < 32) lcnt[tid] = 0;
        __syncthreads();
        const int tbase = rb * 128 + wave * 16;
        f32x4 acc[3];
#pragma unroll
        for (int i = 0; i < 3; ++i) acc[i] = (f32x4){0.f, 0.f, 0.f, 0.f};
        float sm = 0.f, sq = 0.f;
        const bf16_t* yrow = F + (size_t)(tbase + r16) * DM + 8 * g;
        const bf16_t* ghp = GTh + (size_t)r16 * 1024 + 8 * g; const bf16_t* glp = GTl + (size_t)r16 * 1024 + 8 * g;
#pragma unroll 2
        for (int k = 0; k < 32; ++k) {
            const u32x4 yw = *(const u32x4*)(yrow + 32 * k);
            bf16x8 gh[3], gl[3];
#pragma unroll
            for (int i = 0; i < 3; ++i) { gh[i] = *(const bf16x8*)(ghp + (size_t)i * 16 * 1024 + 32 * k); gl[i] = *(const bf16x8*)(glp + (size_t)i * 16 * 1024 + 32 * k); }
            const float y0 = bflo(yw.x), y1 = bfhi(yw.x), y2 = bflo(yw.y), y3 = bfhi(yw.y), y4 = bflo(yw.z), y5 = bfhi(yw.z), y6 = bflo(yw.w), y7 = bfhi(yw.w);
            sm += (y0 + y1) + (y2 + y3) + (y4 + y5) + (y6 + y7);
            sq += (y0 * y0 + y1 * y1) + (y2 * y2 + y3 * y3) + (y4 * y4 + y5 * y5) + (y6 * y6 + y7 * y7);
            const bf16x8 yh = __builtin_bit_cast(bf16x8, yw);
#pragma unroll
            for (int i = 0; i < 3; ++i) {
                acc[i] = __builtin_amdgcn_mfma_f32_16x16x32_bf16(yh, gh[i], acc[i], 0, 0, 0);
                acc[i] = __builtin_amdgcn_mfma_f32_16x16x32_bf16(yh, gl[i], acc[i], 0, 0, 0);
            }
        }
        sm += __shfl_xor(sm, 16); sm += __shfl_xor(sm, 32); sq += __shfl_xor(sq, 16); sq += __shfl_xor(sq, 32);
        const float mean = sm * (1.0f / DM), var = fmaxf(sq * (1.0f / DM) - mean * mean, 0.f), rstd = 1.0f / sqrtf(var + LN_EPS);
        if (g == 0) { stat[r16 * 2] = mean; stat[r16 * 2 + 1] = rstd; }
        LDS_FENCE();
#pragma unroll
        for (int i = 0; i < 3; ++i) { const float sg = SG[16 * i + r16], bb = BB[16 * i + r16];
#pragma unroll
            for (int r = 0; r < 4; ++r) { const float mu = stat[(4 * g + r) * 2], rs = stat[(4 * g + r) * 2 + 1];
                LG[(4 * g + r) * 48 + 16 * i + r16] = rs * (acc[i][r] - mu * sg) + bb; } }
        LDS_FENCE();
        if (lane < 16) {
            const float* lr = LG + lane * 48; const int rl = wave * 16 + lane, t = tbase + lane;
            float gl4[4];
#pragma unroll
            for (int j = 0; j < 4; ++j) gl4[j] = lr[j];
            int grp = 0; float gm = gl4[0];
#pragma unroll
            for (int j = 1; j < 4; ++j) if (gl4[j] > gm) { gm = gl4[j]; grp = j; }
            float gs = 0.f;
#pragma unroll
            for (int j = 0; j < 4; ++j) gs += __expf(gl4[j] - gm);
            const float gwt = 1.0f / gs;
            float el[8];
#pragma unroll
            for (int j = 0; j < 8; ++j) el[j] = lr[4 + grp * 8 + j];
            int i0 = 0; float m0 = el[0];
#pragma unroll
            for (int j = 1; j < 8; ++j) if (el[j] > m0) { m0 = el[j]; i0 = j; }
            int i1 = -1; float m1 = -INFINITY;
#pragma unroll
            for (int j = 0; j < 8; ++j) if (j != i0 && el[j] > m1) { m1 = el[j]; i1 = j; }
            const float ex = __expf(m1 - m0);
            const float p0 = 1.0f / (1.0f + ex), p1 = ex / (1.0f + ex);
            dec[rl * 2] = grp * 8 + i0; dec[rl * 2 + 1] = grp * 8 + i1;
            if (!DRY) { TOKG[(size_t)t * 2] = gwt * p0; TOKG[(size_t)t * 2 + 1] = gwt * p1; }
        }
#pragma unroll 4
        for (int r = 0; r < 16; ++r) {
            const float mu = stat[r * 2], rs = stat[r * 2 + 1];
            const bf16_t* fr = F + (size_t)(tbase + r) * DM + 4 * lane; bf16_t* xo = XB + (size_t)(tbase + r) * DM + 4 * lane;
#pragma unroll
            for (int j = 0; j < 4; ++j) { const u32x2 yw = *(const u32x2*)(fr + 256 * j); const f32x4 y = {bflo(yw.x), bfhi(yw.x), bflo(yw.y), bfhi(yw.y)};
                const f32x4 v = (y - mu) * rs * g4[j] + b4[j];
                u32x2 w; w.x = pk2(v.x, v.y); w.y = pk2(v.z, v.w); *(u32x2*)(xo + 256 * j) = w; }
        }
        __syncthreads();
        if (tid < 256) rank[tid] = atomicAdd(&lcnt[dec[tid]], 1);
        __syncthreads();
        if (tid < 32) lbase[tid] = DRY ? 0 : atomicAdd(&CNT[tid], lcnt[tid]);
        __syncthreads();
        if (!DRY && tid < 256) { const int e = dec[tid]; LIST[(size_t)e * LIST_CAP + lbase[e] + rank[tid]] = (rb * 128 + (tid >> 1)) * 2 + (tid & 1); }
        __syncthreads();
    }
}
__device__ __forceinline__ void moe_setup(const Params& P, int* tb, int layer) {
    const int* CNT = (const int*)(P.ws + WS_CTL) + layer * 64;
    if (threadIdx.x == 0) { int a = 0; for (int e = 0; e < 32; ++e) { tb[e] = a; a += (CNT[e] + 255) >> 8; } tb[32] = a; }
    __syncthreads();
}
template <bool DRY>
__device__ __forceinline__ void phase_ln2(const Params& P, int layer) {
    const bf16_t* XI = (const bf16_t*)(P.ws + WS_XB); bf16_t* XO = (bf16_t*)(P.ws + (DRY ? WS_XB2 : WS_XB));
    const bf16_t* YS = (const bf16_t*)(P.ws + WS_YS); const float* TOKG = (const float*)(P.ws + WS_TOKG);
    const float* lg = P.in[16] + layer * DM; const float* lb = P.in[17] + layer * DM;
    const int lane = threadIdx.x & 63, gw = blockIdx.x * NWAVE + (threadIdx.x >> 6), NGW = gridDim.x * NWAVE;
    f32x4 g4[4], b4[4];
#pragma unroll
    for (int j = 0; j < 4; ++j) { g4[j] = *(const f32x4*)(lg + 256 * j + 4 * lane); b4[j] = *(const f32x4*)(lb + 256 * j + 4 * lane); }
    u32x2 nx[4], na[4], nb[4]; float ng0 = 0.f, ng1 = 0.f;
    if (gw < NTOK) { const int t = gw;
#pragma unroll
        for (int j = 0; j < 4; ++j) { const int c0 = 256 * j + 4 * lane; nx[j] = *(const u32x2*)(XI + (size_t)t * DM + c0); na[j] = *(const u32x2*)(YS + (size_t)(2 * t) * DM + c0); nb[j] = *(const u32x2*)(YS + (size_t)(2 * t + 1) * DM + c0); }
        ng0 = TOKG[(size_t)t * 2]; ng1 = TOKG[(size_t)t * 2 + 1]; }
    for (int t = gw; t < NTOK; t += NGW) {
        const float g0 = ng0, g1 = ng1;
        u32x2 xw[4], aw[4], bw[4];
#pragma unroll
        for (int j = 0; j < 4; ++j) { xw[j] = nx[j]; aw[j] = na[j]; bw[j] = nb[j]; }
        if (t + NGW < NTOK) { const int tn = t + NGW;
#pragma unroll
            for (int j = 0; j < 4; ++j) { const int c0 = 256 * j + 4 * lane; nx[j] = *(const u32x2*)(XI + (size_t)tn * DM + c0); na[j] = *(const u32x2*)(YS + (size_t)(2 * tn) * DM + c0); nb[j] = *(const u32x2*)(YS + (size_t)(2 * tn + 1) * DM + c0); }
            ng0 = TOKG[(size_t)tn * 2]; ng1 = TOKG[(size_t)tn * 2 + 1]; }
        f32x4 v[4]; float s = 0.f;
#pragma unroll
        for (int j = 0; j < 4; ++j) {
            const u32x2 x = xw[j], a = aw[j], b = bw[j];
            v[j].x = bflo(x.x) * ALPHA + g0 * bflo(a.x) + g1 * bflo(b.x); v[j].y = bfhi(x.x) * ALPHA + g0 * bfhi(a.x) + g1 * bfhi(b.x);
            v[j].z = bflo(x.y) * ALPHA + g0 * bflo(a.y) + g1 * bflo(b.y); v[j].w = bfhi(x.y) * ALPHA + g0 * bfhi(a.y) + g1 * bfhi(b.y);
            s += (v[j].x + v[j].y) + (v[j].z + v[j].w); }
        const float mean = wave_sum(s) * (1.0f / DM); float s2 = 0.f;
#pragma unroll
        for (int j = 0; j < 4; ++j) { v[j] = v[j] - mean; s2 += (v[j].x * v[j].x + v[j].y * v[j].y) + (v[j].z * v[j].z + v[j].w * v[j].w); }
        const float rstd = 1.0f / sqrtf(wave_sum(s2) * (1.0f / DM) + LN_EPS);
#pragma unroll
        for (int j = 0; j < 4; ++j) { const int c0 = 256 * j + 4 * lane;
            v[j] = v[j] * rstd * g4[j] + b4[j];
            u32x2 w; w.x = pk2(v[j].x, v[j].y); w.y = pk2(v[j].z, v[j].w); *(u32x2*)(XO + (size_t)t * DM + c0) = w; }
    }
}

__device__ __forceinline__ unsigned e5m2enc(float y) {
    const unsigned hb = (unsigned)__builtin_bit_cast(unsigned short, (_Float16)y);
    return ((hb + 0x7fu + ((hb >> 8) & 1u)) >> 8) & 0xffu;
}
__device__ __forceinline__ void phase_norms(const Params& P) {
    const bf16_t* Z1 = (const bf16_t*)(P.ws + WS_Z1); bf16_t* CQ = (bf16_t*)(P.ws + WS_CQ); bf16_t* CKV = (bf16_t*)(P.ws + WS_CKV); unsigned char* CKV8 = (unsigned char*)(P.ws + WS_CKV8);
    const float* qn = P.in[8]; const float* kn = P.in[9];
    const int lane = threadIdx.x & 63, gw = blockIdx.x * NWAVE + (threadIdx.x >> 6), NGW = gridDim.x * NWAVE;
    for (int t = gw; t < NTOK; t += NGW) {
        const u32x2 a = *(const u32x2*)(Z1 + (size_t)t * Z1W + 4 * lane), b = *(const u32x2*)(Z1 + (size_t)t * Z1W + 256 + 4 * lane);
        const float q[4] = {bflo(a.x), bfhi(a.x), bflo(a.y), bfhi(a.y)}, k[4] = {bflo(b.x), bfhi(b.x), bflo(b.y), bfhi(b.y)};
        const float sq = wave_sum(q[0] * q[0] + q[1] * q[1] + q[2] * q[2] + q[3] * q[3]), sk = wave_sum(k[0] * k[0] + k[1] * k[1] + k[2] * k[2] + k[3] * k[3]);
        const float rq = 1.0f / sqrtf(sq * (1.0f / 256.0f) + 1e-6f), rk = 1.0f / sqrtf(sk * (1.0f / 256.0f) + 1e-6f);
        const f32x4 gq = *(const f32x4*)(qn + 4 * lane), gk = *(const f32x4*)(kn + 4 * lane);
        u32x2 o; o.x = pk2(q[0] * rq * gq.x, q[1] * rq * gq.y); o.y = pk2(q[2] * rq * gq.z, q[3] * rq * gq.w);
        *(u32x2*)(CQ + (size_t)t * 256 + 4 * lane) = o;
        o.x = pk2(k[0] * rk * gk.x, k[1] * rk * gk.y); o.y = pk2(k[2] * rk * gk.z, k[3] * rk * gk.w);
        *(u32x2*)(CKV + (size_t)t * 256 + 4 * lane) = o;
        *(unsigned*)(CKV8 + (size_t)t * 256 + 4 * lane) = e5m2enc(k[0] * rk * gk.x) | (e5m2enc(k[1] * rk * gk.y) << 8) | (e5m2enc(k[2] * rk * gk.z) << 16) | (e5m2enc(k[3] * rk * gk.w) << 24);
    }
}


constexpr int NPH_TOTAL = 23;


typedef short v4i16_t __attribute__((ext_vector_type(4)));


__device__ __forceinline__ void glds16(const void* gsrc, unsigned lds_dst) {
    unsigned keep;
    asm volatile("s_mov_b32 %0, m0\n\ts_mov_b32 m0, %2\n\ts_nop 0\n\tglobal_load_lds_dwordx4 %1, off\n\ts_mov_b32 m0, %0" : "=&s"(keep) : "v"(gsrc), "s"(lds_dst) : "memory");
}
typedef _Float16 f16x8 __attribute__((ext_vector_type(8)));
template <bool DRY>
__device__ __forceinline__ void phase_sparse_attn_e(const Params& P, unsigned char* lds_) {
    const unsigned char* QA = (const unsigned char*)(P.ws + WS_QA); bf16_t* OLAT = (bf16_t*)(P.ws + WS_OLAT); const unsigned char* CKV8 = (const unsigned char*)(P.ws + WS_CKV8); const unsigned short* SEL = (const unsigned short*)(P.ws + WS_SEL);
    const int tid = threadIdx.x, lane = tid & 63, wave = __builtin_amdgcn_readfirstlane(tid >> 6);
    const int fr = lane & 15, fq = lane >> 4;
    LAS unsigned char* cbuf = (LAS unsigned char*)lds_ + wave * 16896;
    LAS unsigned short* selw = (LAS unsigned short*)(cbuf + 16384);
    const unsigned cbuf0 = (unsigned)(unsigned long)cbuf;
    const int G = gridDim.x, NGW = G * NWAVE;
    int vw;
    if ((G & 7) == 0) vw = (((int)blockIdx.x & 7) * (G >> 3) + ((int)blockIdx.x >> 3)) * NWAVE + wave; else vw = (int)blockIdx.x * NWAVE + wave;
    const float LOG2E = 1.4426950408889634f;
    const float slope2 = exp2f(-0.5f * (float)(fr + 1)) * LOG2E;
    unsigned qoffB[4];
#pragma unroll
    for (int e = 0; e < 4; ++e) { const int r15 = (4 * e + fq) & 15; qoffB[e] = (unsigned)((fr ^ (((r15 & 7) << 1) | (r15 >> 3))) << 4); }
    const unsigned fA = (unsigned)(((fr & 7) << 1) | (fr >> 3));
    const unsigned SA = (fA & 14u) << 4, baseA = (unsigned)fr * 256u + ((((unsigned)fq >> 1) ^ (fA & 1u)) << 4) + ((unsigned)fq & 1u) * 8u;
    const int rT = 4 * fq + (fr >> 2), pT_ = fr & 3;
    const unsigned fT = (unsigned)(((rT & 7) << 1) | (rT >> 3));
    const unsigned ST = (fT & 14u) << 4, baseT = (unsigned)rT * 256u + ((((unsigned)pT_ >> 1) ^ (fT & 1u)) << 4) + ((unsigned)pT_ & 1u) * 8u;
    const int per = NGW >> 2, bq = vw / per, wb = vw % per;
    int ditem = DRY ? N_DEFERRED : vw;
    u32x2 selnext = {0u, 0u}; long qfn[8];
    if (wb < SEQ) { const int t0 = bq * SEQ + wb; selnext = *(const u32x2*)(SEL + (size_t)t0 * TOPK + 4 * lane);
#pragma unroll
        for (int cc = 0; cc < 8; ++cc) qfn[cc] = *(const long*)(QA + (size_t)t0 * 4096 + fr * 256 + 32 * cc + 8 * fq); }
    for (int tl0 = wb; tl0 < SEQ; tl0 += per) {
        const int t = bq * SEQ + tl0;
        const int b = t >> 13, tl = t & (SEQ - 1), ns = min(tl + 1, TOPK), nch = (ns + 31) >> 5;
        const bool has_nextq = (tl0 + per < SEQ);
        asm volatile("s_waitcnt vmcnt(0)" ::: "memory");
        {
            const u32x2 w = selnext;
            unsigned short i0 = (unsigned short)(w.x & 0xffffu), i1 = (unsigned short)(w.x >> 16), i2 = (unsigned short)(w.y & 0xffffu), i3 = (unsigned short)(w.y >> 16);
            const int k0 = 4 * lane;
            if (k0 >= ns) i0 = 0; if (k0 + 1 >= ns) i1 = 0; if (k0 + 2 >= ns) i2 = 0; if (k0 + 3 >= ns) i3 = 0;
            u32x2 o; o.x = (unsigned)i0 | ((unsigned)i1 << 16); o.y = (unsigned)i2 | ((unsigned)i3 << 16);
            asm volatile("s_waitcnt lgkmcnt(0)" ::: "memory");
            *(LAS u32x2*)(selw + 4 * lane) = o;
        }
        long qf[8];
#pragma unroll
        for (int cc = 0; cc < 8; ++cc) qf[cc] = qfn[cc];
#define ATT_PREFETCH() do { if (has_nextq) { const int tn_ = t + per; selnext = *(const u32x2*)(SEL + (size_t)tn_ * TOPK + 4 * lane); \
            _Pragma("unroll") for (int cc = 0; cc < 8; ++cc) qfn[cc] = *(const long*)(QA + (size_t)tn_ * 4096 + fr * 256 + 32 * cc + 8 * fq); pf = true; } } while (0)
        f32x4 Oe[8], Oo[8];
#pragma unroll
        for (int ut = 0; ut < 8; ++ut) { Oe[ut] = (f32x4){0.f, 0.f, 0.f, 0.f}; Oo[ut] = (f32x4){0.f, 0.f, 0.f, 0.f}; }
        float m = -INFINITY, l = 0.f;
        const unsigned char* cb = CKV8 + (size_t)b * SEQ * 256;
        asm volatile("s_waitcnt vmcnt(0) lgkmcnt(0)" ::: "memory");
#define ATT_DMA(jj, bufoff) do { unsigned idx_[8]; \
            _Pragma("unroll") for (int e = 0; e < 8; ++e) idx_[e] = (DRY && PROBE_ATT == 1) ? (unsigned)((32 * (jj) + 4 * e + fq + 64 * wave) & 8191) : (unsigned)selw[32 * (jj) + 4 * e + fq]; \
            _Pragma("unroll") for (int e = 0; e < 8; ++e) { \
            if (!(DRY && PROBE_ATT == 3)) glds16(cb + (size_t)idx_[e] * 256 + qoffB[e & 3], (unsigned)__builtin_amdgcn_readfirstlane((int)(cbuf0 + (bufoff) + e * 1024))); } } while (0)
        ATT_DMA(0, 0);
        if (nch > 1) ATT_DMA(1, 8192);
        const bool have_item = ditem < N_DEFERRED;
        TrItem titem = deferred_item(P, have_item ? ditem : 0);
        float tcur[32];
        bool trf = false, pf = false;
        if (nch <= 2) { if (have_item) { tr_load(titem, lane, tcur); trf = true; } ATT_PREFETCH(); }
        for (int j = 0; j < nch; ++j) {
            const unsigned bo = (unsigned)(j & 1) * 8192u;
            if (j + 1 < nch) { if (trf && pf) asm volatile("s_waitcnt vmcnt(49)" ::: "memory"); else if (trf) asm volatile("s_waitcnt vmcnt(40)" ::: "memory");
                               else if (pf) asm volatile("s_waitcnt vmcnt(17)" ::: "memory"); else asm volatile("s_waitcnt vmcnt(8)" ::: "memory"); }
            else { if (trf && pf) asm volatile("s_waitcnt vmcnt(41)" ::: "memory"); else if (trf) asm volatile("s_waitcnt vmcnt(32)" ::: "memory");
                   else if (pf) asm volatile("s_waitcnt vmcnt(9)" ::: "memory"); else asm volatile("s_waitcnt vmcnt(0)" ::: "memory"); }
            const LAS unsigned char* img = cbuf + bo;
            if (DRY && PROBE_ATT == 2) { if (j + 2 < nch) { asm volatile("s_waitcnt lgkmcnt(0)" ::: "memory"); ATT_DMA(j + 2, bo); } continue; }
            const u32x2 k0w = *(const LAS u32x2*)(selw + 32 * j + 4 * fq), k1w = *(const LAS u32x2*)(selw + 32 * j + 16 + 4 * fq);
            f32x4 s0 = {0.f, 0.f, 0.f, 0.f}, s1 = {0.f, 0.f, 0.f, 0.f};
#pragma unroll
            for (int hb = 0; hb < 2; ++hb) {
                u32x2 ra[4], rb[4];
#pragma unroll
                for (int c4 = 0; c4 < 4; ++c4) { const int cc = hb * 4 + c4; const LAS unsigned char* pa = img + ((SA ^ (unsigned)(cc << 5)) + baseA); ra[c4] = *(const LAS u32x2*)(pa); rb[c4] = *(const LAS u32x2*)(pa + 4096); }
                __builtin_amdgcn_sched_barrier(0);
#pragma unroll
                for (int c4 = 0; c4 < 4; ++c4) { const int cc = hb * 4 + c4;
                    s0 = __builtin_amdgcn_mfma_f32_16x16x32_bf8_fp8(__builtin_bit_cast(long, ra[c4]), qf[cc], s0, 0, 0, 0);
                    s1 = __builtin_amdgcn_mfma_f32_16x16x32_bf8_fp8(__builtin_bit_cast(long, rb[c4]), qf[cc], s1, 0, 0, 0); }
                __builtin_amdgcn_sched_barrier(0);
            }
            u32x2 tl_[4], th_[4];
#pragma unroll
            for (int ut = 0; ut < 4; ++ut) { const LAS unsigned char* pt = img + ((ST ^ (unsigned)(ut << 5)) + baseT);
                tl_[ut] = __builtin_bit_cast(u32x2, __builtin_amdgcn_ds_read_tr16_b64_v4i16((LAS v4i16_t*)(pt)));
                th_[ut] = __builtin_bit_cast(u32x2, __builtin_amdgcn_ds_read_tr16_b64_v4i16((LAS v4i16_t*)(pt + 4096))); }
            __builtin_amdgcn_sched_barrier(0);
            const int kb0 = 32 * j + 4 * fq, kb1 = kb0 + 16;
            float lg[8];
            {
                const int i00 = (int)(k0w.x & 0xffffu), i01 = (int)(k0w.x >> 16), i02 = (int)(k0w.y & 0xffffu), i03 = (int)(k0w.y >> 16);
                const int i10 = (int)(k1w.x & 0xffffu), i11 = (int)(k1w.x >> 16), i12 = (int)(k1w.y & 0xffffu), i13 = (int)(k1w.y >> 16);
                lg[0] = (kb0 + 0 < ns) ? s0.x * LOG2E - slope2 * (float)(tl - i00) : -INFINITY;
                lg[1] = (kb0 + 1 < ns) ? s0.y * LOG2E - slope2 * (float)(tl - i01) : -INFINITY;
                lg[2] = (kb0 + 2 < ns) ? s0.z * LOG2E - slope2 * (float)(tl - i02) : -INFINITY;
                lg[3] = (kb0 + 3 < ns) ? s0.w * LOG2E - slope2 * (float)(tl - i03) : -INFINITY;
                lg[4] = (kb1 + 0 < ns) ? s1.x * LOG2E - slope2 * (float)(tl - i10) : -INFINITY;
                lg[5] = (kb1 + 1 < ns) ? s1.y * LOG2E - slope2 * (float)(tl - i11) : -INFINITY;
                lg[6] = (kb1 + 2 < ns) ? s1.z * LOG2E - slope2 * (float)(tl - i12) : -INFINITY;
                lg[7] = (kb1 + 3 < ns) ? s1.w * LOG2E - slope2 * (float)(tl - i13) : -INFINITY;
            }
            const float cm = fmaxf(fmaxf(fmaxf(lg[0], lg[1]), fmaxf(lg[2], lg[3])), fmaxf(fmaxf(lg[4], lg[5]), fmaxf(lg[6], lg[7])));
            if (j == 0) { float cx = fmaxf(cm, __shfl_xor(cm, 16)); m = fmaxf(cx, __shfl_xor(cx, 32)); }
            else if (__any(cm > m + 8.0f)) {
                float cx = fmaxf(cm, __shfl_xor(cm, 16)); cx = fmaxf(cx, __shfl_xor(cx, 32));
                const float mn = fmaxf(m, cx);
                const float sc = __builtin_amdgcn_exp2f(m - mn);
                l *= sc;
#pragma unroll
                for (int ut = 0; ut < 8; ++ut) { Oe[ut] *= sc; Oo[ut] *= sc; }
                m = mn;
            }
            float p[8]; float ps = 0.f;
#pragma unroll
            for (int i = 0; i < 8; ++i) { p[i] = __builtin_amdgcn_exp2f(lg[i] - m); ps += p[i]; }
            l += ps;
            int pw0 = __builtin_amdgcn_cvt_pk_fp8_f32(p[0], p[1], 0, false); pw0 = __builtin_amdgcn_cvt_pk_fp8_f32(p[2], p[3], pw0, true);
            int pw1 = __builtin_amdgcn_cvt_pk_fp8_f32(p[4], p[5], 0, false); pw1 = __builtin_amdgcn_cvt_pk_fp8_f32(p[6], p[7], pw1, true);
            const long pk = __builtin_bit_cast(long, (u32x2){(unsigned)pw0, (unsigned)pw1});
#pragma unroll
            for (int hb = 0; hb < 2; ++hb) {
                if (hb == 1) {
#pragma unroll
                    for (int u4 = 0; u4 < 4; ++u4) { const int ut = 4 + u4; const LAS unsigned char* pt = img + ((ST ^ (unsigned)(ut << 5)) + baseT);
                        tl_[u4] = __builtin_bit_cast(u32x2, __builtin_amdgcn_ds_read_tr16_b64_v4i16((LAS v4i16_t*)(pt)));
                        th_[u4] = __builtin_bit_cast(u32x2, __builtin_amdgcn_ds_read_tr16_b64_v4i16((LAS v4i16_t*)(pt + 4096))); }
                    __builtin_amdgcn_sched_barrier(0);
                }
#pragma unroll
                for (int u4 = 0; u4 < 4; ++u4) { const int ut = hb * 4 + u4;
                    const u32x2 lw = tl_[u4], hw = th_[u4];
                    u32x2 ae, ao;
                    ae.x = __builtin_amdgcn_perm(lw.y, lw.x, 0x06040200u); ae.y = __builtin_amdgcn_perm(hw.y, hw.x, 0x06040200u);
                    ao.x = __builtin_amdgcn_perm(lw.y, lw.x, 0x07050301u); ao.y = __builtin_amdgcn_perm(hw.y, hw.x, 0x07050301u);
                    Oe[ut] = __builtin_amdgcn_mfma_f32_16x16x32_bf8_fp8(__builtin_bit_cast(long, ae), pk, Oe[ut], 0, 0, 0);
                    Oo[ut] = __builtin_amdgcn_mfma_f32_16x16x32_bf8_fp8(__builtin_bit_cast(long, ao), pk, Oo[ut], 0, 0, 0);
                }
                __builtin_amdgcn_sched_barrier(0);
            }
            if (j + 2 < nch) { asm volatile("s_waitcnt lgkmcnt(0)" ::: "memory"); ATT_DMA(j + 2, bo);
                if (j + 3 == nch) { if (have_item) { tr_load(titem, lane, tcur); trf = true; } ATT_PREFETCH(); } }
        }
#undef ATT_DMA
#undef ATT_PREFETCH
        l += __shfl_xor(l, 16); l += __shfl_xor(l, 32);
        const float inv = 1.0f / l;
        bf16_t* orow = (DRY ? (bf16_t*)(P.ws + WS_PP) + (size_t)(t & 8191) * 4096 : OLAT + (size_t)t * 4096) + fr * 256 + 8 * fq;
#pragma unroll
        for (int ut = 0; ut < 8; ++ut) {
            u32x4 w; w.x = pk2(Oe[ut].x * inv, Oo[ut].x * inv); w.y = pk2(Oe[ut].y * inv, Oo[ut].y * inv); w.z = pk2(Oe[ut].z * inv, Oo[ut].z * inv); w.w = pk2(Oe[ut].w * inv, Oo[ut].w * inv);
            *(u32x4*)(orow + 32 * ut) = w;
        }
        if (have_item) { asm volatile("s_waitcnt lgkmcnt(0)" ::: "memory"); tr_store(titem, (float*)(lds_ + wave * 16896), lane, tcur); ditem += NGW; }
    }
    for (; ditem < N_DEFERRED; ditem += NGW) { const TrItem t = deferred_item(P, ditem); float tmp[32]; tr_load(t, lane, tmp); tr_store(t, (float*)(lds_ + wave * 16896), lane, tmp); }
}

constexpr size_t SC_BATCH = (size_t)1024 * 256 * 257 / 2;
__device__ __forceinline__ size_t sc_row_off(int b, int tl) { const size_t m = (size_t)(tl >> 5); return (size_t)b * SC_BATCH + 1024 * (m * (m + 1) / 2) + (size_t)(tl & 31) * 32 * (m + 1); }
typedef float f32x16 __attribute__((ext_vector_type(16)));
__device__ __forceinline__ unsigned okey_pk(float a, float b) {
    const unsigned w = __builtin_bit_cast(unsigned, __builtin_amdgcn_cvt_pkrtz(a, b));
    const unsigned neg = (w >> 15) & 0x00010001u;
    return w ^ ((neg * 0xffffu) | 0x80008000u);
}
__device__ __forceinline__ void phase_index_scores(const Params& P, unsigned char* lds_) {
    using pg8::bf16x8;
    const bf16_t* Z1 = (const bf16_t*)(P.ws + WS_Z1); unsigned short* SC = (unsigned short*)(P.ws + WS_SC);
    LAS unsigned char* lds = (LAS unsigned char*)lds_;
    constexpr int QROW = 144;
    LAS unsigned char* QL = lds;
    LAS float* SG = (LAS float*)(lds + 9 * 64 * QROW);
    const int tid = threadIdx.x, lane = tid & 63, wave = __builtin_amdgcn_readfirstlane(tid >> 6);
    LAS unsigned char* ST = lds + 9 * 64 * QROW + 2048 + wave * 5120;
    const int l31 = lane & 31, hh = lane >> 5;
    for (int pid = blockIdx.x; pid < 256; pid += gridDim.x) {
        const int b = pid >> 6;
        for (int side = 0; side < 2; ++side) {
            const int qb = side ? (127 - (pid & 63)) : (pid & 63);
            const int q0 = qb * 64;
            __syncthreads();
            {
                const int qi = tid >> 3, part = tid & 7;
                const bf16_t* zr = Z1 + ((size_t)b * SEQ + q0 + qi) * Z1W;
                const u32x4 ww = *(const u32x4*)(zr + 1088);
                const float w8[8] = {bflo(ww.x), bfhi(ww.x), bflo(ww.y), bfhi(ww.y), bflo(ww.z), bfhi(ww.z), bflo(ww.w), bfhi(ww.w)};
                float wh = 0.f;
#pragma unroll
                for (int h = 0; h < 8; ++h) wh = (h == part) ? w8[h] : wh;
                const float sc = 0.5f * fabsf(wh);
                SG[qi * 8 + part] = (wh >= 0.f) ? 1.0f : -1.0f;
#pragma unroll
                for (int c = 0; c < 8; ++c) {
                    const u32x4 v = *(const u32x4*)(zr + 512 + part * 64 + c * 8);
                    u32x4 o; o.x = pk2(bflo(v.x) * sc, bfhi(v.x) * sc); o.y = pk2(bflo(v.y) * sc, bfhi(v.y) * sc); o.z = pk2(bflo(v.z) * sc, bfhi(v.z) * sc); o.w = pk2(bflo(v.w) * sc, bfhi(v.w) * sc);
                    *(LAS u32x4*)(QL + (part * 64 + qi) * QROW + c * 16) = o;
                }
                float a8[8];
#pragma unroll
                for (int j = 0; j < 8; ++j) a8[j] = 0.f;
#pragma unroll
                for (int h = 0; h < 8; ++h) {
                    const u32x4 v = *(const u32x4*)(zr + 512 + h * 64 + part * 8); const float s2 = 0.5f * w8[h];
                    a8[0] += s2 * bflo(v.x); a8[1] += s2 * bfhi(v.x); a8[2] += s2 * bflo(v.y); a8[3] += s2 * bfhi(v.y);
                    a8[4] += s2 * bflo(v.z); a8[5] += s2 * bfhi(v.z); a8[6] += s2 * bflo(v.w); a8[7] += s2 * bfhi(v.w);
                }
                u32x4 o; o.x = pk2(a8[0], a8[1]); o.y = pk2(a8[2], a8[3]); o.z = pk2(a8[4], a8[5]); o.w = pk2(a8[6], a8[7]);
                *(LAS u32x4*)(QL + (8 * 64 + qi) * QROW + part * 16) = o;
            }
            __syncthreads();
            const int ktmax = 2 * qb + 1;
            bf16x8 kn[4];
            {   const bf16_t* kr = Z1 + ((size_t)b * SEQ + min(wave, ktmax) * 32 + l31) * Z1W + 1024 + hh * 8;
#pragma unroll
                for (int dq = 0; dq < 4; ++dq) kn[dq] = *(const bf16x8*)(kr + dq * 16); }
            for (int kt = wave; kt <= ktmax; kt += NWAVE) {
                bf16x8 kf[4];
#pragma unroll
                for (int dq = 0; dq < 4; ++dq) kf[dq] = kn[dq];
                {   const bf16_t* kr = Z1 + ((size_t)b * SEQ + min(kt + NWAVE, ktmax) * 32 + l31) * Z1W + 1024 + hh * 8;
#pragma unroll
                    for (int dq = 0; dq < 4; ++dq) kn[dq] = *(const bf16x8*)(kr + dq * 16); }
#pragma unroll
                for (int qs = 0; qs < 2; ++qs) {
                    const LAS unsigned char* qrow = QL + (qs * 32 + l31) * QROW + hh * 16;
                    const LAS float* sgp = SG + (qs * 32 + l31) * 8;
                    bf16x8 fc[4], fn[4];
#pragma unroll
                    for (int dq = 0; dq < 4; ++dq) fc[dq] = *(const LAS bf16x8*)(qrow + 8 * 64 * QROW + dq * 32);
#pragma unroll
                    for (int dq = 0; dq < 4; ++dq) fn[dq] = *(const LAS bf16x8*)(qrow + dq * 32);
                    const f32x4 sg03 = *(const LAS f32x4*)(sgp), sg47 = *(const LAS f32x4*)(sgp + 4);
                    f32x16 acc;
#pragma unroll
                    for (int r = 0; r < 16; ++r) acc[r] = 0.f;
#pragma unroll
                    for (int dq = 0; dq < 4; ++dq) acc = __builtin_amdgcn_mfma_f32_32x32x16_bf16(kf[dq], fc[dq], acc, 0, 0, 0);
                    f32x16 up;
#pragma unroll
                    for (int h = 0; h < 8; ++h) {
#pragma unroll
                        for (int dq = 0; dq < 4; ++dq) fc[dq] = fn[dq];
                        if (h < 7) {
#pragma unroll
                            for (int dq = 0; dq < 4; ++dq) fn[dq] = *(const LAS bf16x8*)(qrow + (h + 1) * 64 * QROW + dq * 32);
                        }
                        f32x16 u;
#pragma unroll
                        for (int r = 0; r < 16; ++r) u[r] = 0.f;
#pragma unroll
                        for (int dq = 0; dq < 4; ++dq) u = __builtin_amdgcn_mfma_f32_32x32x16_bf16(kf[dq], fc[dq], u, 0, 0, 0);
                        __builtin_amdgcn_sched_barrier(0);
                        if (h > 0) {
                            const float sg = (h - 1 < 4) ? sg03[(h - 1) & 3] : sg47[(h - 1) & 3];
#pragma unroll
                            for (int r = 0; r < 16; ++r) acc[r] = fmaf(fabsf(up[r]), sg, acc[r]);
                        }
                        __builtin_amdgcn_sched_barrier(0);
                        up = u;
                    }
                    {
                        const float sg = sg47[3];
#pragma unroll
                        for (int r = 0; r < 16; ++r) acc[r] = fmaf(fabsf(up[r]), sg, acc[r]);
                    }
#pragma unroll
                    for (int g = 0; g < 4; ++g) { u32x2 w; w.x = okey_pk(acc[4 * g], acc[4 * g + 1]); w.y = okey_pk(acc[4 * g + 2], acc[4 * g + 3]);
                        *(LAS u32x2*)(ST + (qs * 32 + l31) * 80 + (8 * g + 4 * hh) * 2) = w; }
                }
#pragma unroll
                for (int i = 0; i < 4; ++i) {
                    const int row = 16 * i + (lane >> 2), ch = lane & 3, tl = q0 + row;
                    const u32x4 v = *(const LAS u32x4*)(ST + row * 80 + ch * 16);
                    if (kt <= (tl >> 5)) *(u32x4*)(SC + sc_row_off(b, tl) + (size_t)kt * 32 + ch * 8) = v;
                }
            }
        }
    }
}
template <int MODE>
__device__ __forceinline__ void phase_index_select(const Params& P, unsigned char* lds_) {
    const unsigned short* SC = (const unsigned short*)(P.ws + WS_SC); unsigned short* SEL = (unsigned short*)(P.ws + WS_SEL);
    const int tid = threadIdx.x, lane = tid & 63, wave = __builtin_amdgcn_readfirstlane(tid >> 6);
    LAS unsigned char* wbase = (LAS unsigned char*)lds_ + wave * 19456;
    LAS u32x4* rowbuf = (LAS u32x4*)wbase;
    LAS unsigned* hist = (LAS unsigned*)(wbase + 16384);
    LAS unsigned* dummy = hist + 512 + lane;
    LAS unsigned short* outw = (LAS unsigned short*)(wbase + 16384 + 2048 + 256);
    LAS unsigned short* dummy16 = outw + 256 + lane;
    const unsigned rowbuf0 = (unsigned)(unsigned long)wbase;
    const int gw = blockIdx.x * NWAVE + wave, NGW = gridDim.x * NWAVE;
#define SEL_DMA(tt) do { const int _tl = (tt) & (SEQ - 1), _n = _tl + 1; if (_n > TOPK) { const unsigned char* _src = (const unsigned char*)(SC + sc_row_off((tt) >> 13, _tl)) + lane * 16; \
            for (int _sg = 0; _sg * 512 < _n; ++_sg) glds16(_src + _sg * 1024, (unsigned)__builtin_amdgcn_readfirstlane((int)(rowbuf0 + _sg * 1024))); } } while (0)
#define SEL_Q(i) ((i) * NGW + (((i) & 1) ? (NGW - 1 - gw) : gw))
    if (SEL_Q(0) < NTOK) SEL_DMA(SEL_Q(0));
    for (int qi = 0; qi * NGW < NTOK; ++qi) {
        const int t = SEL_Q(qi), tnext = SEL_Q(qi + 1);
        if (t >= NTOK) { if (tnext < NTOK) SEL_DMA(tnext); continue; }
        const int tl = t & (SEQ - 1), n = tl + 1;
        unsigned short* so = SEL + (size_t)t * TOPK;
        if (n <= TOPK) { for (int i = lane; i < n; i += 64) so[i] = (unsigned short)i; if (tnext < NTOK && (qi + 1) * NGW < NTOK) SEL_DMA(tnext); continue; }
        asm volatile("s_waitcnt vmcnt(0)" ::: "memory");
        u32x4 d[16];
        const int lastsg = (n - 1) >> 9;
#pragma unroll
        for (int sg = 0; sg < 16; ++sg) {
            if (sg * 512 < n) {
                d[sg] = rowbuf[sg * 64 + lane];
                if (sg == lastsg) {
#pragma unroll
                    for (int q = 0; q < 4; ++q) { const int i0 = sg * 512 + lane * 8 + 2 * q;
                        d[sg][q] &= ((i0 < n) ? 0x0000ffffu : 0u) | ((i0 + 1 < n) ? 0xffff0000u : 0u); }
                }
            } else d[sg] = (u32x4){0u, 0u, 0u, 0u};
        }
        asm volatile("s_waitcnt lgkmcnt(0)" ::: "memory");
        if (tnext < NTOK && (qi + 1) * NGW < NTOK) SEL_DMA(tnext);
#pragma unroll
        for (int i = 0; i < 8; ++i) { hist[i * 64 + lane] = 0u; }
        asm volatile("s_waitcnt lgkmcnt(0)" ::: "memory");
        LAS unsigned* myh = hist + (lane & 1) * 256;
        if (MODE == 4) { if (d[0].x == 0x12345u) so[lane] = 1; continue; }
#pragma unroll
        for (int sg = 0; sg < 16; ++sg) if (MODE != 1 && sg * 512 < n) {
#pragma unroll
            for (int q = 0; q < 4; ++q) { const unsigned w = d[sg][q];
                __hip_atomic_fetch_add(myh + ((w >> 8) & 0xffu), 1u, __ATOMIC_RELAXED, __HIP_MEMORY_SCOPE_WORKGROUP);
                __hip_atomic_fetch_add(myh + (w >> 24), 1u, __ATOMIC_RELAXED, __HIP_MEMORY_SCOPE_WORKGROUP); }
        }
        asm volatile("s_waitcnt lgkmcnt(0)" ::: "memory");
        unsigned b1, need1;
        {
            unsigned c[4];
#pragma unroll
            for (int q = 0; q < 4; ++q) c[q] = hist[4 * lane + q] + hist[256 + 4 * lane + q];
            const unsigned mine = c[0] + c[1] + c[2] + c[3];
            unsigned suf = mine;
#pragma unroll
            for (int o = 1; o < 64; o <<= 1) { const unsigned v = __shfl_down(suf, o); if (lane + o < 64) suf += v; }
            const unsigned above = suf - mine;
            int fb = -1; unsigned fneed = 0;
            if (above < (unsigned)TOPK && suf >= (unsigned)TOPK) { unsigned a = above;
#pragma unroll
                for (int q = 3; q >= 0; --q) { if (fb < 0 && a + c[q] >= (unsigned)TOPK) { fb = 4 * lane + q; fneed = (unsigned)TOPK - a; } a += c[q]; } }
            const unsigned long long bal = __ballot(fb >= 0);
            const int src = (int)__builtin_ctzll(bal);
            b1 = (unsigned)__shfl(fb, src); need1 = __shfl(fneed, src);
        }
#pragma unroll
        for (int i = 0; i < 8; ++i) { hist[i * 64 + lane] = 0u; }
        asm volatile("s_waitcnt lgkmcnt(0)" ::: "memory");
#pragma unroll
        for (int sg = 0; sg < 16; ++sg) if (MODE != 2 && sg * 512 < n) {
#pragma unroll
            for (int q = 0; q < 4; ++q) { const unsigned w = d[sg][q];
                LAS unsigned* p0 = (((w >> 8) & 0xffu) == b1) ? (myh + (w & 0xffu)) : dummy;
                LAS unsigned* p1 = ((w >> 24) == b1) ? (myh + ((w >> 16) & 0xffu)) : dummy;
                __hip_atomic_fetch_add(p0, 1u, __ATOMIC_RELAXED, __HIP_MEMORY_SCOPE_WORKGROUP);
                __hip_atomic_fetch_add(p1, 1u, __ATOMIC_RELAXED, __HIP_MEMORY_SCOPE_WORKGROUP); }
        }
        asm volatile("s_waitcnt lgkmcnt(0)" ::: "memory");
        unsigned T, need2;
        {
            unsigned c[4];
#pragma unroll
            for (int q = 0; q < 4; ++q) c[q] = hist[4 * lane + q] + hist[256 + 4 * lane + q];
            const unsigned mine = c[0] + c[1] + c[2] + c[3];
            unsigned suf = mine;
#pragma unroll
            for (int o = 1; o < 64; o <<= 1) { const unsigned v = __shfl_down(suf, o); if (lane + o < 64) suf += v; }
            const unsigned above = suf - mine;
            int fb = -1; unsigned fneed = 0;
            if (above < need1 && suf >= need1) { unsigned a = above;
#pragma unroll
                for (int q = 3; q >= 0; --q) { if (fb < 0 && a + c[q] >= need1) { fb = 4 * lane + q; fneed = need1 - a; } a += c[q]; } }
            const unsigned long long bal = __ballot(fb >= 0);
            const int src = (int)__builtin_ctzll(bal);
            T = (b1 << 8) | (unsigned)__shfl(fb, src); need2 = __shfl(fneed, src);
        }
        unsigned base = 0; const unsigned ngt = (unsigned)TOPK - need2; unsigned eqbase = 0;
#pragma unroll
        for (int sg = 0; sg < 16; ++sg) if (MODE != 3 && sg * 512 < n) {
            unsigned ce = 0;
#pragma unroll
            for (int j = 0; j < 8; ++j) {
                const unsigned k = (j & 1) ? (d[sg][j >> 1] >> 16) : (d[sg][j >> 1] & 0xffffu);
                const bool gt = k > T;
                const unsigned long long mk = __ballot(gt);
                const unsigned pos = base + (unsigned)__builtin_amdgcn_mbcnt_hi((unsigned)(mk >> 32), __builtin_amdgcn_mbcnt_lo((unsigned)mk, 0u));
                LAS unsigned short* po = gt ? (outw + pos) : dummy16;
                *po = (unsigned short)(sg * 512 + lane * 8 + j);
                base += (unsigned)__builtin_popcountll(mk);
                ce += (k == T) ? 1u : 0u;
            }
            if (__any(ce > 0u)) {
                unsigned pre = ce;
#pragma unroll
                for (int o = 1; o < 64; o <<= 1) { const unsigned v = __shfl_up(pre, o); if (lane >= o) pre += v; }
                unsigned r = eqbase + pre - ce;
#pragma unroll
                for (int j = 0; j < 8; ++j) { const unsigned k = (j & 1) ? (d[sg][j >> 1] >> 16) : (d[sg][j >> 1] & 0xffffu);
                    if (k == T) { if (r < need2) outw[ngt + r] = (unsigned short)(sg * 512 + lane * 8 + j); ++r; } }
                eqbase += __shfl(pre, 63);
            }
        }
        asm volatile("s_waitcnt lgkmcnt(0)" ::: "memory");
        ((unsigned*)so)[lane] = ((LAS unsigned*)outw)[lane];
        ((unsigned*)so)[64 + lane] = ((LAS unsigned*)outw)[64 + lane];
        asm volatile("s_waitcnt lgkmcnt(0)" ::: "memory");
    }
#undef SEL_DMA
#undef SEL_Q
    asm volatile("s_waitcnt vmcnt(0)" ::: "memory");
}

__device__ __forceinline__ void ret_fill_image(LAS unsigned char* img, const unsigned char* src, size_t row_stride_bytes, int wave, int lane) {
#pragma unroll
    for (int e4 = 0; e4 < 4; ++e4) {
        const int e = wave * 4 + e4, row = 4 * e + (lane >> 4), q = (lane & 15) ^ ((row & 7) << 1);
        __builtin_amdgcn_global_load_lds((const unsigned*)(src + (size_t)row * row_stride_bytes + q * 16), (LAS unsigned*)(img + e * 1024), 16, 0, 0);
    }
}
__device__ __forceinline__ pg8::bf16x8 ret_tr_pair(const LAS unsigned char* img, int row0, int chunk2, int lane) {
    const int g = lane >> 4, i = lane & 15, r0 = row0 + 4 * g + (i >> 2), pb = (i & 3) >> 1, half = (i & 1) * 8;
    const int r1 = r0 + 16;
    const v4i16_t lo = __builtin_amdgcn_ds_read_tr16_b64_v4i16((LAS v4i16_t*)(img + r0 * 256 + ((((chunk2) ^ ((r0 & 7) << 1)) | pb) << 4) + half));
    const v4i16_t hi = __builtin_amdgcn_ds_read_tr16_b64_v4i16((LAS v4i16_t*)(img + r1 * 256 + ((((chunk2) ^ ((r1 & 7) << 1)) | pb) << 4) + half));
    return (pg8::bf16x8){lo[0], lo[1], lo[2], lo[3], hi[0], hi[1], hi[2], hi[3]};
}
__device__ __forceinline__ void phase_ret_kv_mfma(const Params& P, unsigned char* lds_) {
    using pg8::bf16x8;
    const unsigned char* Z0 = (const unsigned char*)(P.ws + WS_Z0); float* KV = (float*)(P.ws + WS_KV);
    LAS unsigned char* Kimg = (LAS unsigned char*)lds_; LAS unsigned char* Vimg = Kimg + 32768;
    const int tid = threadIdx.x, lane = tid & 63, wave = __builtin_amdgcn_readfirstlane(tid >> 6), fr = lane & 15, fq = lane >> 4;
    for (int u = blockIdx.x; u < 1024; u += gridDim.x) {
        const int n = u & 63, h = (u >> 6) & 3, b = u >> 8;
        const size_t row0 = (size_t)b * SEQ + n * 128;
        __syncthreads();
        ret_fill_image(Kimg, Z0 + row0 * ZW * 2 + (512 + h * 128) * 2, ZW * 2, wave, lane);
        ret_fill_image(Vimg, Z0 + row0 * ZW * 2 + (1024 + h * 128) * 2, ZW * 2, wave, lane);
        asm volatile("s_waitcnt vmcnt(0)" ::: "memory");
        __syncthreads();
        bf16x8 va[4];
#pragma unroll
        for (int jc = 0; jc < 4; ++jc) va[jc] = ret_tr_pair(Vimg, 32 * jc, 2 * wave, lane);
        const float g127 = exp2f(ret_log2g(h) * 127.0f);
        float* o = KV + (size_t)u * 16384;
#pragma unroll
        for (int dt = 0; dt < 8; ++dt) {
            f32x4 acc = {0.f, 0.f, 0.f, 0.f};
#pragma unroll
            for (int jc = 0; jc < 4; ++jc) acc = __builtin_amdgcn_mfma_f32_16x16x32_bf16(va[jc], ret_tr_pair(Kimg, 32 * jc, 2 * dt, lane), acc, 0, 0, 0);
            *(f32x4*)(o + (size_t)(16 * dt + fr) * 128 + 16 * wave + 4 * fq) = acc * g127;
        }
    }
}
__device__ __forceinline__ void phase_ret_scan_pool2(const Params& P) {
    const float* KV = (const float*)(P.ws + WS_KV); bf16_t* SB = (bf16_t*)(P.ws + WS_SB);
    const size_t gt = (size_t)blockIdx.x * NT + threadIdx.x, GS = (size_t)gridDim.x * NT;
    for (size_t i = gt; i < (size_t)16 * 8192; i += GS) {
        const int s = (int)(i >> 13), e2 = (int)(i & 8191), h = s & 3;
        const float l2 = ret_log2g(h), cd = exp2f(l2 * 128.0f), g1 = exp2f(l2);
        typedef float f32x2v __attribute__((ext_vector_type(2)));
        const f32x2v* p = (const f32x2v*)(KV + (size_t)s * 64 * 16384) + e2;
        unsigned* q = (unsigned*)(SB + (size_t)s * 64 * 16384) + e2;
        f32x2v R = {0.f, 0.f};
        for (int n0 = 0; n0 < 64; n0 += 16) {
            f32x2v kv[16];
#pragma unroll
            for (int j = 0; j < 16; ++j) kv[j] = __builtin_nontemporal_load(p + (size_t)(n0 + j) * 8192);
#pragma unroll
            for (int j = 0; j < 16; ++j) { q[(size_t)(n0 + j) * 8192] = pk2(R.x * g1, R.y * g1); R = R * cd + kv[j]; }
        }
    }
    const bf16_t* Z0 = (const bf16_t*)(P.ws + WS_Z0); bf16_t* DP = (bf16_t*)(P.ws + WS_DP);
    for (size_t i = gt; i < (size_t)NTOK * 64; i += GS) {
        const int t = (int)(i >> 6), c8 = (int)(i & 63) * 8, g = c8 >> 7, w = 2 << g, tl = t & (SEQ - 1);
        const int cnt = min(tl + 1, w);
        float sm[8];
#pragma unroll
        for (int j = 0; j < 8; ++j) sm[j] = 0.f;
        float u0[8];
        for (int q = 0; q < cnt; ++q) {
            const u32x4 v = *(const u32x4*)(Z0 + (size_t)(t - q) * ZW + 2048 + c8);
            const float f[8] = {bflo(v.x), bfhi(v.x), bflo(v.y), bfhi(v.y), bflo(v.z), bfhi(v.z), bflo(v.w), bfhi(v.w)};
#pragma unroll
            for (int j = 0; j < 8; ++j) { sm[j] += f[j]; if (q == 0) u0[j] = f[j]; }
        }
        const float inv = 1.0f / (float)cnt;
        u32x4 o; o.x = pk2(sm[0] * inv - u0[0], sm[1] * inv - u0[1]); o.y = pk2(sm[2] * inv - u0[2], sm[3] * inv - u0[3]);
        o.z = pk2(sm[4] * inv - u0[4], sm[5] * inv - u0[5]); o.w = pk2(sm[6] * inv - u0[6], sm[7] * inv - u0[7]);
        *(u32x4*)(DP + (size_t)t * 512 + c8) = o;
    }
}
__device__ __forceinline__ void phase_ret_out_mfma(const Params& P, unsigned char* lds_) {
    using pg8::bf16x8;
    const unsigned char* Z0 = (const unsigned char*)(P.ws + WS_Z0); const unsigned char* SB = (const unsigned char*)(P.ws + WS_SB); bf16_t* MIX = (bf16_t*)(P.ws + WS_MIX);
    const float* gn = P.in[3];
    LAS unsigned char* Kimg = (LAS unsigned char*)lds_; LAS unsigned char* Vimg = Kimg + 32768; LAS unsigned char* Rimg = Kimg + 65536;
    const int tid = threadIdx.x, lane = tid & 63, wave = __builtin_amdgcn_readfirstlane(tid >> 6), fr = lane & 15, fq = lane >> 4;
    for (int u = blockIdx.x; u < 1024; u += gridDim.x) {
        const int n = u & 63, h = (u >> 6) & 3, b = u >> 8;
        const size_t row0 = (size_t)b * SEQ + n * 128;
        __syncthreads();
        ret_fill_image(Kimg, Z0 + row0 * ZW * 2 + (512 + h * 128) * 2, ZW * 2, wave, lane);
        ret_fill_image(Vimg, Z0 + row0 * ZW * 2 + (1024 + h * 128) * 2, ZW * 2, wave, lane);
        ret_fill_image(Rimg, SB + (size_t)u * 32768, 256, wave, lane);
        const bf16_t* qrow = (const bf16_t*)Z0 + (row0 + 16 * wave + fr) * ZW + h * 128;
        bf16x8 qf[4], qr[4];
#pragma unroll
        for (int c = 0; c < 4; ++c) {
            qf[c] = *(const bf16x8*)(qrow + 32 * c + 8 * fq);
            const u32x2 a = *(const u32x2*)(qrow + 32 * c + 4 * fq), bb = *(const u32x2*)(qrow + 32 * c + 16 + 4 * fq);
            u32x4 w; w.x = a.x; w.y = a.y; w.z = bb.x; w.w = bb.y; qr[c] = __builtin_bit_cast(bf16x8, w);
        }
        asm volatile("s_waitcnt vmcnt(0)" ::: "memory");
        __syncthreads();
        f32x4 sT[8];
#pragma unroll
        for (int jt = 0; jt < 8; ++jt) sT[jt] = (f32x4){0.f, 0.f, 0.f, 0.f};
#pragma unroll
        for (int jt = 0; jt < 8; ++jt) if (jt <= wave) {
            const int r = 16 * jt + fr;
#pragma unroll
            for (int c = 0; c < 4; ++c) {
                const bf16x8 a = *(const LAS bf16x8*)(Kimg + r * 256 + ((((4 * c + fq)) ^ ((r & 7) << 1)) << 4));
                sT[jt] = __builtin_amdgcn_mfma_f32_16x16x32_bf16(a, qf[c], sT[jt], 0, 0, 0);
            }
            if (jt == wave) {
                if (4 * fq + 0 > fr) sT[jt].x = 0.f; if (4 * fq + 1 > fr) sT[jt].y = 0.f; if (4 * fq + 2 > fr) sT[jt].z = 0.f; if (4 * fq + 3 > fr) sT[jt].w = 0.f;
            }
        }
        bf16x8 pT[4];
#pragma unroll
        for (int jp = 0; jp < 4; ++jp) { u32x4 w; w.x = pk2(sT[2 * jp].x, sT[2 * jp].y); w.y = pk2(sT[2 * jp].z, sT[2 * jp].w); w.z = pk2(sT[2 * jp + 1].x, sT[2 * jp + 1].y); w.w = pk2(sT[2 * jp + 1].z, sT[2 * jp + 1].w);
            pT[jp] = __builtin_bit_cast(bf16x8, w); }
        f32x4 O[8];
#pragma unroll
        for (int vt = 0; vt < 8; ++vt) {
            f32x4 acc = {0.f, 0.f, 0.f, 0.f};
#pragma unroll
            for (int jp = 0; jp < 4; ++jp) if (2 * jp <= wave) acc = __builtin_amdgcn_mfma_f32_16x16x32_bf16(ret_tr_pair(Vimg, 32 * jp, 2 * vt, lane), pT[jp], acc, 0, 0, 0);
#pragma unroll
            for (int c = 0; c < 4; ++c) acc = __builtin_amdgcn_mfma_f32_16x16x32_bf16(ret_tr_pair(Rimg, 32 * c, 2 * vt, lane), qr[c], acc, 0, 0, 0);
            O[vt] = acc;
        }
        float sm = 0.f;
#pragma unroll
        for (int vt = 0; vt < 8; ++vt) sm += (O[vt].x + O[vt].y) + (O[vt].z + O[vt].w);
        sm += __shfl_xor(sm, 16); sm += __shfl_xor(sm, 32);
        const float mu = sm * (1.0f / 128.0f);
        float sq = 0.f;
#pragma unroll
        for (int vt = 0; vt < 8; ++vt) { const f32x4 dlt = O[vt] - mu; sq += (dlt.x * dlt.x + dlt.y * dlt.y) + (dlt.z * dlt.z + dlt.w * dlt.w); }
        sq += __shfl_xor(sq, 16); sq += __shfl_xor(sq, 32);
        const float rstd = 1.0f / sqrtf(sq * (1.0f / 128.0f) + LN_EPS);
        const bf16_t* grow = (const bf16_t*)Z0 + (row0 + 16 * wave + fr) * ZW + 1536 + h * 128 + 4 * fq;
        bf16_t* orow = MIX + (row0 + 16 * wave + fr) * DM + h * 128 + 4 * fq;
#pragma unroll
        for (int vt = 0; vt < 8; ++vt) {
            const u32x2 gv = *(const u32x2*)(grow + 16 * vt);
            const f32x4 g4 = *(const f32x4*)(gn + h * 128 + 16 * vt + 4 * fq);
            const f32x4 y = (O[vt] - mu) * rstd * g4;
            u32x2 w; w.x = pk2(y.x * silu_f(bflo(gv.x)), y.y * silu_f(bfhi(gv.x))); w.y = pk2(y.z * silu_f(bflo(gv.y)), y.w * silu_f(bfhi(gv.y)));
            *(u32x2*)(orow + 16 * vt) = w;
        }
    }
}

#define XB_TMO      128
#define XB_XCNT(j)  (256  + 64 * (j))
#define XB_XSUB(j)  (1280 + 64 * (j))
#define XB_XGEN(j)  (2304 + 64 * (j))
#define XB_TOP      3328
#define XB_TOPGEN   3392
#define XCD_BAR_WORDS 3456
#define XB_SPIN_CAP (1u << 22)
__device__ __forceinline__ unsigned xb_ld(unsigned* p)              { return __hip_atomic_load(p, __ATOMIC_RELAXED, __HIP_MEMORY_SCOPE_AGENT); }
__device__ __forceinline__ unsigned xb_add(unsigned* p, unsigned v) { return __hip_atomic_fetch_add(p, v, __ATOMIC_RELAXED, __HIP_MEMORY_SCOPE_AGENT); }
__device__ __forceinline__ unsigned xb_xcc_id() { return (unsigned)__builtin_amdgcn_s_getreg((3 << 11) | 20) & 0xFu; }
#define XB_SPIN(cond, bar) do { unsigned _sp = 0; while (cond) { __builtin_amdgcn_s_sleep(1); \
    if ((++_sp & 255u) == 0u) { if (xb_ld(&(bar)[XB_TMO])) break; if (_sp > XB_SPIN_CAP) { atomicAdd(&(bar)[XB_TMO], 1u); break; } } } } while (0)
struct XcdBarrier { unsigned* bar; unsigned x; volatile LAS unsigned* st; };
__device__ __forceinline__ XcdBarrier xcd_barrier_post(unsigned* bar, volatile LAS unsigned* st) {
    XcdBarrier b; b.bar = bar; b.x = xb_xcc_id(); b.st = st;
    if (threadIdx.x == 0) (void)xb_add(&bar[XB_XCNT(b.x)], 1u);
    return b;
}
__device__ __forceinline__ void xcd_barrier_complete(unsigned* bar, unsigned x, unsigned& nloc, unsigned& nx) {
    const unsigned G = gridDim.x * gridDim.y * gridDim.z;
    unsigned sum, cnt, mine, sp = 0u;
    for (;;) {
        sum = 0u; cnt = 0u; mine = 0u;
#pragma unroll
        for (unsigned j = 0; j < 16; ++j) { const unsigned c = xb_ld(&bar[XB_XCNT(j)]); sum += c; cnt += (c > 0u) ? 1u : 0u; mine = (j == x) ? c : mine; }
        if (sum == G) break;
        __builtin_amdgcn_s_sleep(1);
        if ((++sp & 255u) == 0u) { if (xb_ld(&bar[XB_TMO])) break; if (sp > XB_SPIN_CAP) { atomicAdd(&bar[XB_TMO], 1u); break; } }
    }
    nloc = mine > 0u ? mine : 1u; nx = cnt > 0u ? cnt : 1u;
}
__device__ __forceinline__ void xcd_barrier(const XcdBarrier& b) {
    asm volatile("s_waitcnt vmcnt(0)" ::: "memory");
    __syncthreads();
    if (threadIdx.x == 0) {
        unsigned* bar = b.bar;
        __builtin_amdgcn_s_waitcnt(0);
        unsigned nloc = b.st[0], nx = b.st[1];
        if (nloc == 0u) { xcd_barrier_complete(bar, b.x, nloc, nx); b.st[0] = nloc; b.st[1] = nx; }
        const unsigned old = xb_add(&bar[XB_XSUB(b.x)], 1u);
        const unsigned gen = old / nloc;
        if (old + 1u == (gen + 1u) * nloc) {
            __builtin_amdgcn_fence(__ATOMIC_RELEASE, "agent");
            asm volatile("s_waitcnt vmcnt(0)" ::: "memory");
            const unsigned og = xb_add(&bar[XB_TOP], 1u);
            const unsigned tg = og / nx;
            if (og + 1u == (tg + 1u) * nx) xb_add(&bar[XB_TOPGEN], 1u);
            else XB_SPIN(xb_ld(&bar[XB_TOPGEN]) == tg, bar);
            __builtin_amdgcn_fence(__ATOMIC_ACQUIRE, "agent");
            xb_add(&bar[XB_XGEN(b.x)], 1u);
            asm volatile("s_waitcnt vmcnt(0)" ::: "memory");
        } else {
            XB_SPIN(xb_ld(&bar[XB_XGEN(b.x)]) == gen, bar);
            __builtin_amdgcn_fence(__ATOMIC_ACQUIRE, "agent");
            asm volatile("s_waitcnt vmcnt(0)" ::: "memory");
        }
    }
    __syncthreads();
}
constexpr size_t CTL_BAR_OFF = 16384;
constexpr size_t CTL_ZERO_BYTES = 65536;

#ifdef PH_ONLY
#define IN(k) ((k) == PH_ONLY)
#else
#define IN(k) (lo <= (k) && (k) < hi)
#endif
#define SEAM(k) do { if (IN(k) && IN((k) + 1)) xcd_barrier(grid); } while (0)
#ifndef PROBE_DUP
#define PROBE_DUP (-1)
#endif
#define REP(k) for (int _rep = 0; _rep < ((PROBE_DUP == (k)) ? 2 : 1); ++_rep)
#define REPS(k) ((PROBE_DUP == 100 + (k)) ? 2 : 1)

template <int LAYER, int BASE>
__device__ __forceinline__ void layer_tail(const Params& P, unsigned char* lds, const XcdBarrier& grid, int lo, int hi) {
    unsigned char* ws = P.ws;
    int* tb = (int*)(lds + MISC_OFF);
    if (IN(BASE)) { if (PROBE_DUP == BASE) phase_ln_route<true>(P, lds, LAYER); phase_ln_route<false>(P, lds, LAYER); }
    SEAM(BASE);
    if (IN(BASE + 1)) REP(BASE + 1) { moe_setup(P, tb, LAYER);
        MoeSched S{tb, (const int*)(ws + WS_CTL) + LAYER * 64, (const int*)(ws + WS_LIST), (const bf16_t*)(ws + WS_XB),
                   (const bf16_t*)(ws + WS_W_GU) + (size_t)LAYER * 32 * DM * DM, DM, (size_t)DM * DM, true};
        EpiGU E{(bf16_t*)(ws + WS_ACT)}; gemm_moe<true>(lds, S, E);
        { const int U = tb[32] * 4, G = (int)gridDim.x, nheavy = (U % G), nlight = G - nheavy, lr = (int)blockIdx.x - nheavy;
          DenseSched S2{(const bf16_t*)(ws + WS_PB) + (size_t)LAYER * NTOK * 256, (const bf16_t*)(ws + WS_W_P) + (size_t)LAYER * DM * 256, NTOK, DM, 256, 256, 0, 1, lr, nlight};
          EpiStoreBf16 E2{(bf16_t*)(ws + WS_PP), DM, 0, nullptr}; gemm_dense(lds, S2, E2); } }
    SEAM(BASE + 1);
    if (IN(BASE + 2)) REP(BASE + 2) { moe_setup(P, tb, LAYER);
        MoeSched S{tb, (const int*)(ws + WS_CTL) + LAYER * 64, (const int*)(ws + WS_LIST), (const bf16_t*)(ws + WS_ACT),
                   (const bf16_t*)(ws + WS_W_DN) + (size_t)LAYER * 32 * DM * 512, 512, (size_t)DM * 512, false};
        EpiDown E{(bf16_t*)(ws + WS_YS)}; gemm_moe<false>(lds, S, E); }
    SEAM(BASE + 2);
    if (IN(BASE + 3)) { if (PROBE_DUP == BASE + 3) phase_ln2<true>(P, LAYER); phase_ln2<false>(P, LAYER); }
    SEAM(BASE + 3);
    if (IN(BASE + 4)) REP(BASE + 4) {
        { DenseSched S{(const bf16_t*)(ws + WS_XB), (const bf16_t*)(ws + WS_W_G) + (size_t)LAYER * DM * DM, NTOK, DM, DM, DM, 0, REPS(BASE + 4)};
          EpiPle E{(const bf16_t*)(ws + WS_XB), (const bf16_t*)(ws + WS_PP), LAYER == 1 ? P.out : (float*)nullptr, LAYER == 1 ? (bf16_t*)nullptr : (bf16_t*)(ws + WS_XB2)}; gemm_dense(lds, S, E); }
    }
}

__global__ void __launch_bounds__(NT, 2) mega(Params P, int lo, int hi) {
    extern __shared__ __attribute__((aligned(16))) unsigned char lds[];
    unsigned char* ws = P.ws;
    if (threadIdx.x < 16) ((LAS unsigned*)((LAS unsigned char*)lds + BARW_OFF))[threadIdx.x] = 0u;
    __syncthreads();
    const XcdBarrier grid = xcd_barrier_post((unsigned*)(ws + WS_CTL + CTL_BAR_OFF), (volatile LAS unsigned*)((LAS unsigned char*)lds + BARW_OFF));
    if (IN(0)) REP(0) phase_prep(P, lds);
    SEAM(0);
    if (IN(1)) REP(1) { DenseSched S{(const bf16_t*)(ws + WS_XB), (const bf16_t*)(ws + WS_W_IN0), NTOK, ZW, DM, DM, 0, REPS(1)};
        EpiZ0 E{(bf16_t*)(ws + WS_Z0)}; gemm_dense(lds, S, E); }
    SEAM(1);
    if (IN(2)) REP(2) phase_ret_kv_mfma(P, lds);
    SEAM(2);
    if (IN(3)) REP(3) phase_ret_scan_pool2(P);
    SEAM(3);
    if (IN(4)) REP(4) { phase_ret_out_mfma(P, lds); __syncthreads();
        DenseSched S{(const bf16_t*)(ws + WS_DP), (const bf16_t*)(ws + WS_W_POOL), NTOK, 512, 256, 512, 256};
        EpiStoreBf16 E{(bf16_t*)(ws + WS_MIX), DM, 512, P.in[5]}; gemm_dense(lds, S, E); }
    SEAM(4);
    if (IN(5)) REP(5) { DenseSched S{(const bf16_t*)(ws + WS_MIX), (const bf16_t*)(ws + WS_W_OUT0), NTOK, DM, DM, DM, 0, REPS(5)};
        EpiResidB E{(const bf16_t*)(ws + WS_XB), (bf16_t*)(ws + WS_F)}; gemm_dense(lds, S, E); }
    SEAM(5);
    layer_tail<0, 6>(P, lds, grid, lo, hi);
    SEAM(10);
    if (IN(11)) REP(11) { DenseSched S{(const bf16_t*)(ws + WS_XB2), (const bf16_t*)(ws + WS_W_CIN), NTOK, Z1W, DM, DM, 0, REPS(11)};
        EpiStoreBf16 E{(bf16_t*)(ws + WS_Z1), Z1W, 0, nullptr}; gemm_dense(lds, S, E); }
    SEAM(11);
    if (IN(12)) REP(12) { phase_norms(P); phase_index_scores(P, lds); }
    SEAM(12);
    if (IN(13)) { if (PROBE_DUP == 13) phase_index_select<PROBE_SEL>(P, lds); phase_index_select<0>(P, lds); }
    if (IN(13) && IN(14)) __syncthreads();
    if (IN(14)) REP(14) { DenseSched S{(const bf16_t*)(ws + WS_CQ), (const bf16_t*)(ws + WS_W_QA), NTOK, 4096, 256, 256, 0, REPS(14)};
        EpiStoreFp8 E{(unsigned char*)(ws + WS_QA), 4096}; gemm_dense(lds, S, E); }
    SEAM(14);
    if (IN(15)) { if (PROBE_DUP == 15) phase_sparse_attn_e<true>(P, lds); phase_sparse_attn_e<false>(P, lds); }
    SEAM(15);
    if (IN(16)) REP(16) { DenseSched S{(const bf16_t*)(ws + WS_OLAT), (const bf16_t*)(ws + WS_W_UVBD), NTOK, DM, DM, 4096, 1024, REPS(16)};
        EpiStoreBf16 E{(bf16_t*)(ws + WS_XB), DM, 0, nullptr}; gemm_dense(lds, S, E); }
    SEAM(16);
    if (IN(17)) REP(17) { DenseSched S{(const bf16_t*)(ws + WS_XB), (const bf16_t*)(ws + WS_W_COUT), NTOK, DM, DM, DM, 0, REPS(17)};
        EpiResidB E{(const bf16_t*)(ws + WS_XB2), (bf16_t*)(ws + WS_F)}; gemm_dense(lds, S, E); }
    SEAM(17);
    layer_tail<1, 18>(P, lds, grid, lo, hi);
}
#undef IN
#undef SEAM

extern "C" void kernel_launch(void* const* d_in, const int* in_sizes, int n_in, void* d_out, int out_size, void* d_ws, size_t ws_size, hipStream_t stream) {
    static int grid = 0;
    if (grid == 0) {
        if (n_in != 26 || ws_size < WS_END || out_size != NTOK * DM) { fprintf(stderr, "kernel_launch: unexpected problem (n_in %d, ws %zu, out %d)\n", n_in, ws_size, out_size); grid = -1; return; }
        int dev = 0, cus = 0, per_cu = 0;
        (void)hipGetDevice(&dev);
        (void)hipDeviceGetAttribute(&cus, hipDeviceAttributeMultiprocessorCount, dev);
        (void)hipFuncSetAttribute((const void*)mega, hipFuncAttributeMaxDynamicSharedMemorySize, LDS_BYTES);
        (void)hipOccupancyMaxActiveBlocksPerMultiprocessor(&per_cu, (const void*)mega, NT, LDS_BYTES);
        if (per_cu < 1) { fprintf(stderr, "kernel_launch: occupancy query reports %d blocks per CU\n", per_cu); per_cu = 1; }
        (void)hipGetLastError();
        grid = cus;
    }
    if (grid < 0) return;
    (void)hipMemsetAsync((char*)d_ws + WS_CTL, 0, CTL_ZERO_BYTES, stream);
    Params p{};
    for (int i = 0; i < 26; ++i) p.in[i] = (const float*)d_in[i];
    p.out = (float*)d_out; p.ws = (unsigned char*)d_ws;
#if MK_ONE_LAUNCH
    int lo = 0, hi = NPH_TOTAL;
    void* args[] = {&p, &lo, &hi};
    (void)args;
    hipLaunchKernelGGL(mega, dim3(grid), dim3(NT), LDS_BYTES, stream, p, lo, hi);
    hipError_t e = hipPeekAtLastError();
    if (e != hipSuccess) fprintf(stderr, "launch failed: %s (grid %d)\n", hipGetErrorString(e), grid);
#else
    for (int k = 0; k < NPH_TOTAL; ++k) hipLaunchKernelGGL(mega, dim3(grid), dim3(NT), LDS_BYTES, stream, p, k, k + 1);
#endif
}
```

```cpp
#include <hip/hip_runtime.h>
#include <cstdio>
#include <cstdint>

#ifndef PROBE_ATT
#define PROBE_ATT 0
#endif
#ifndef PROBE_SEL
#define PROBE_SEL 0
#endif
#ifndef MK_ONE_LAUNCH
#define MK_ONE_LAUNCH 1
#endif

typedef unsigned short bf16_t;
typedef float f32x4 __attribute__((ext_vector_type(4)));
typedef unsigned u32x4 __attribute__((ext_vector_type(4)));
typedef unsigned u32x2 __attribute__((ext_vector_type(2)));

constexpr int NT = 512;
constexpr int NWAVE = NT / 64;
constexpr int NTOK = 32768, DM = 1024, SEQ = 8192, NBATCH = 4;
constexpr int ZW = 2560;
constexpr int Z1W = 1280;
constexpr int CIN = 1096;
constexpr int TOPK = 256;
constexpr float ALPHA = 1.4142135623730951f;
constexpr float LN_EPS = 1e-5f;
constexpr int LDS_BYTES = 163840;
constexpr int BARW_OFF = LDS_BYTES - 64;
constexpr int MISC_OFF = 135168;

constexpr size_t MiB = (size_t)1 << 20;
constexpr size_t WS_CTL = 0;
constexpr size_t WS_W_IN0 = 1 * MiB, WS_W_OUT0 = 6 * MiB, WS_W_POOL = 8 * MiB, WS_W_CIN = 9 * MiB, WS_W_QA = 12 * MiB,
                 WS_W_UVBD = 14 * MiB, WS_W_COUT = 16 * MiB, WS_W_G = 18 * MiB, WS_W_P = 22 * MiB, WS_W_GU = 24 * MiB, WS_W_DN = 152 * MiB;
constexpr size_t WS_XB = 224 * MiB, WS_F = 288 * MiB, WS_PB = 416 * MiB, WS_PP = 448 * MiB, WS_CQ = 512 * MiB, WS_CKV = 528 * MiB,
                 WS_SEL = 544 * MiB, WS_TOKG = 560 * MiB, WS_LIST = 561 * MiB, WS_CKV8 = 566 * MiB;
constexpr size_t WS_M0 = 576 * MiB;
constexpr size_t WS_Z0 = WS_M0, WS_KV = WS_M0 + 160 * MiB, WS_MIX = WS_M0 + 224 * MiB, WS_DP = WS_M0 + 288 * MiB, WS_SB = WS_M0 + 320 * MiB;
constexpr size_t WS_OLAT = WS_M0, WS_QA = WS_F  , WS_SC = WS_M0, WS_Z1 = WS_M0 + 272 * MiB;
constexpr size_t WS_ACT = WS_M0, WS_YS = WS_M0 + 72 * MiB;
constexpr size_t WS_XB2 = 960 * MiB;
constexpr size_t WS_END = 1024 * MiB;
constexpr int LIST_CAP = 32768;
constexpr size_t WS_GT = WS_CTL + 262144;
constexpr size_t WS_SGB = WS_CTL + 786432;

struct Params {
    const float* in[26];
    float* out;
    unsigned char* ws;
};

__device__ __forceinline__ unsigned f2bf(float f) { unsigned u = __float_as_uint(f); return (u + 0x7fffu + ((u >> 16) & 1u)) >> 16; }
__device__ __forceinline__ float bf2f(unsigned h) { return __uint_as_float(h << 16); }
typedef float f32x2_t __attribute__((ext_vector_type(2))); typedef __bf16 bf16x2_t __attribute__((ext_vector_type(2)));
__device__ __forceinline__ unsigned pk2(float lo, float hi) { f32x2_t v = {lo, hi}; bf16x2_t b = __builtin_convertvector(v, bf16x2_t); return __builtin_bit_cast(unsigned, b); }
__device__ __forceinline__ float bflo(unsigned w) { return __uint_as_float(w << 16); }
__device__ __forceinline__ float bfhi(unsigned w) { return __uint_as_float(w & 0xffff0000u); }
#define WAVE_SUM_DPP(v) ({ float _v = (v); \
    _v += __builtin_bit_cast(float, __builtin_amdgcn_update_dpp(0, __builtin_bit_cast(int, _v), 0xB1, 0xf, 0xf, true));     \
    _v += __builtin_bit_cast(float, __builtin_amdgcn_update_dpp(0, __builtin_bit_cast(int, _v), 0x4E, 0xf, 0xf, true));     \
    _v += __builtin_bit_cast(float, __builtin_amdgcn_update_dpp(0, __builtin_bit_cast(int, _v), 0x141, 0xf, 0xf, true));    \
    _v += __builtin_bit_cast(float, __builtin_amdgcn_update_dpp(0, __builtin_bit_cast(int, _v), 0x140, 0xf, 0xf, true));    \
    _v += __builtin_bit_cast(float, __builtin_amdgcn_update_dpp(0, __builtin_bit_cast(int, _v), 0x142, 0xa, 0xf, false));   \
    _v += __builtin_bit_cast(float, __builtin_amdgcn_update_dpp(0, __builtin_bit_cast(int, _v), 0x143, 0xc, 0xf, false));   \
    __builtin_bit_cast(float, __builtin_amdgcn_readlane(__builtin_bit_cast(int, _v), 63)); })
__device__ __forceinline__ float wave_sum(float v) { return WAVE_SUM_DPP(v); }
#define WAVE_SCAN_DPP(v) ({ unsigned _v = (v); \
    _v += (unsigned)__builtin_amdgcn_update_dpp(0, (int)_v, 0x111, 0xf, 0xf, false); \
    _v += (unsigned)__builtin_amdgcn_update_dpp(0, (int)_v, 0x112, 0xf, 0xf, false); \
    _v += (unsigned)__builtin_amdgcn_update_dpp(0, (int)_v, 0x114, 0xf, 0xf, false); \
    _v += (unsigned)__builtin_amdgcn_update_dpp(0, (int)_v, 0x118, 0xf, 0xf, false); \
    _v += (unsigned)__builtin_amdgcn_update_dpp(0, (int)_v, 0x142, 0xa, 0xf, false); \
    _v += (unsigned)__builtin_amdgcn_update_dpp(0, (int)_v, 0x143, 0xc, 0xf, false); \
    _v; })

__device__ __forceinline__ float silu_f(float a) { return a / (1.0f + __expf(-a)); }
__device__ __forceinline__ float sigmoid_f(float a) { return 1.0f / (1.0f + __expf(-a)); }
#define LDS_FENCE() asm volatile("s_waitcnt lgkmcnt(0)" ::: "memory")

struct UnitInfo {
    const bf16_t* A; int lda;
    const int* rows; int rshift;
    int nvalid;
    const bf16_t* Bt; int ldb;
    int K;
    int orow0;
    int pn;
};

struct DenseSched {
    const bf16_t* A; const bf16_t* Bt; int M, N, K, lda, a_pn_stride; int reps = 1;
    int wrank = -1, wcount = 0;
    __device__ __forceinline__ bool next(int round, UnitInfo& u) const {
        const int nN = N >> 8, nM = M >> 8, nwg = nN * nM;
        if (wcount > 0 && wrank < 0) return false;
        const long L = (wcount > 0) ? ((long)round * wcount + wrank) : ((long)round * gridDim.x + blockIdx.x); if (L >= (long)nwg * reps) return false;
        int wgid = (int)(L % nwg); { const int q = nwg / 8, r = nwg % 8, xcd = wgid % 8, off = wgid / 8; wgid = (xcd < r ? xcd * (q + 1) : r * (q + 1) + (xcd - r) * q) + off; }
        const int nig = 8 * nN, gid = wgid / nig, fm = gid * 8, gsz = (nM - fm) < 8 ? (nM - fm) : 8;
        const int pm = fm + ((wgid % nig) % gsz), pn = (wgid % nig) / gsz;
        u.A = A + (size_t)pm * 256 * lda + (size_t)pn * a_pn_stride; u.lda = lda; u.rows = nullptr; u.rshift = 0; u.nvalid = 256;
        u.Bt = Bt + (size_t)pn * 256 * K; u.ldb = K; u.K = K; u.orow0 = pm * 256; u.pn = pn;
        return true;
    }
};
struct MoeSched {
    const int* tb; const int* cnt; const int* list;
    const bf16_t* A; const bf16_t* W; int K; size_t wstride; bool gather;
    __device__ __forceinline__ bool next(int round, UnitInfo& u) const {
        const int i = round * gridDim.x + blockIdx.x;
        const int j = i >> 2, pn = i & 3;
        if (j >= tb[32]) return false;
        int e = 0;
        while (tb[e + 1] <= j) ++e;
        const int rb = j - tb[e];
        const int nv = min(256, cnt[e] - rb * 256);
        u.rows = list + (size_t)e * LIST_CAP + rb * 256; u.nvalid = nv; u.orow0 = j * 256; u.pn = pn;
        if (gather) { u.A = A; u.lda = K; u.rshift = 1; }
        else { u.A = A + (size_t)j * 256 * K; u.lda = K; u.rshift = 31;   }
        u.Bt = W + (size_t)e * wstride + (size_t)pn * 256 * K; u.ldb = K; u.K = K;
        return true;
    }
};


namespace pg8 {
#define LAS __attribute__((address_space(3)))
typedef short bf16x8 __attribute__((ext_vector_type(8)));
constexpr int BK = 64, HALF = 128, HTB = HALF * BK * 2, STAGE_BYTES = 8 * HTB;
__device__ __forceinline__ int lds_byte(int r, int c) { const int st = (r >> 4) * 2 + (c >> 5), rr = r & 15, cc = c & 31, ob = rr * 64 + cc * 2; return st * 1024 + (ob ^ (((ob >> 9) & 1) << 5)); }
__device__ __forceinline__ void stage_rc(int b, int& R, int& C) { const int st = b / 1024, sb = b % 1024, swz = sb ^ (((sb >> 9) & 1) << 5); R = (st >> 1) * 16 + swz / 64; C = (st & 1) * 32 + (swz % 64) / 2; }
__device__ __forceinline__ int perm32(int rho) { const int n = rho >> 4, i = rho & 15; return 8 * (i >> 2) + 4 * n + (i & 3); }

template <bool GATHER, class Sched, class Epi, bool BDIAG = false>
__device__ __forceinline__ void gemm_phase(LAS unsigned char* lds, const LAS unsigned* rowtab, const Sched& S, const Epi& E, const int lda, const int ldb, const int K) {
    const int tid = threadIdx.x, wid = __builtin_amdgcn_readfirstlane(tid >> 6), lane = tid & 63, wr = wid >> 2, wc = wid & 3, fr = lane & 15, fq = lane >> 4;
    const int nt = K / BK;
    unsigned voffA[2], voffB[2]; int RA[2]; unsigned CA2[2];
#pragma unroll
    for (int i = 0; i < 2; ++i) { int R, C; stage_rc(tid * 16 + i * 8192, R, C); const int Rb = (R & ~31) + perm32(R & 31);
        voffA[i] = (unsigned)(R * lda + C) * 2u; voffB[i] = (unsigned)(Rb * ldb + C) * 2u; RA[i] = R; CA2[i] = (unsigned)C * 2u; }
    const size_t kstep = (size_t)(BK * 2);
    const size_t hstepA = (size_t)HALF * lda * 2, hstepB = (size_t)HALF * ldb * 2;
    const unsigned ldsw = (unsigned)wid * 1024u;
    const int aoff = lds_byte(wr * 64 + fr, fq * 8), boff = lds_byte(wc * 32 + fr, fq * 8);
    unsigned offA[2][2];
#define PG8_SA(b, h) (((b) * 2 + (h)) * HTB)
#define PG8_SB(b, h) ((4 + (b) * 2 + (h)) * HTB)
#define PG8_STAGE(bufoff, gbase, voff) do { _Pragma("unroll") for (int _i = 0; _i < 2; ++_i) \
        __builtin_amdgcn_global_load_lds((const unsigned*)((const char*)(gbase) + (voff)[_i]), (LAS unsigned*)(lds + (bufoff) + ldsw + _i * 8192), 16, 0, 0); } while (0)
#define PG8_STAGE_A(bufoff, h, gbase) do { if (GATHER) PG8_STAGE(bufoff, gbase, offA[h]); else PG8_STAGE(bufoff, (gbase) + (h) * hstepA, voffA); } while (0)
#define PG8_LOADOFF(round) do { _Pragma("unroll") for (int _h = 0; _h < 2; ++_h) _Pragma("unroll") for (int _i = 0; _i < 2; ++_i) offA[_h][_i] = rowtab[(round) * 256 + _h * 128 + RA[_i]] + CA2[_i]; } while (0)
#define PG8_LDA(dst, b, h) do { _Pragma("unroll") for (int m = 0; m < 4; ++m) _Pragma("unroll") for (int k = 0; k < 2; ++k) dst[m][k] = *(const LAS bf16x8*)(lds + PG8_SA(b, h) + aoff + m * 2048 + k * 1024); } while (0)
#define PG8_LDB(dst, b, h) do { _Pragma("unroll") for (int n = 0; n < 2; ++n) _Pragma("unroll") for (int k = 0; k < 2; ++k) dst[n][k] = *(const LAS bf16x8*)(lds + PG8_SB(b, h) + boff + n * 2048 + k * 1024); } while (0)
#define PG8_MMA(ai, bj, At, Bt) do { if (!BDIAG || (((kt_ >> 2) & 3) == 2 * (bj) + (wc >> 1))) { __builtin_amdgcn_s_setprio(1); _Pragma("unroll") for (int m = 0; m < 4; ++m) _Pragma("unroll") for (int n = 0; n < 2; ++n) _Pragma("unroll") for (int k = 0; k < 2; ++k) \
        acc[ai][bj][m][n] = __builtin_amdgcn_mfma_f32_16x16x32_bf16(Bt[n][k], At[m][k], acc[ai][bj][m][n], 0, 0, 0); __builtin_amdgcn_s_setprio(0); } } while (0)
#define PG8_WAIT_V(n) asm volatile("s_waitcnt vmcnt(" #n ")" ::: "memory")
#define PG8_WAIT_L(n) asm volatile("s_waitcnt lgkmcnt(" #n ")" ::: "memory")
#define PG8_BAR __builtin_amdgcn_s_barrier()
#define PG8_SCHED __builtin_amdgcn_sched_barrier(0)
    UnitInfo cur, nxt; int ui = 0;
    if (!S.next(0, cur)) return;
    f32x4 acc[2][2][4][2];
#pragma unroll
    for (int a = 0; a < 2; ++a)
#pragma unroll
        for (int b = 0; b < 2; ++b)
#pragma unroll
            for (int m = 0; m < 4; ++m)
#pragma unroll
                for (int n = 0; n < 2; ++n) acc[a][b][m][n] = (f32x4){0.f, 0.f, 0.f, 0.f};
    bf16x8 At[4][2], B0[2][2], B1[2][2];
    const char* cA = (const char*)cur.A; const char* cB = (const char*)cur.Bt;
    if (GATHER) { PG8_LOADOFF(0); }
    PG8_STAGE(PG8_SB(0, 0), cB, voffB); PG8_STAGE(PG8_SB(0, 1), cB + hstepB, voffB); PG8_STAGE_A(PG8_SA(0, 0), 0, cA); PG8_STAGE_A(PG8_SA(0, 1), 1, cA);
    if (wr == 1) PG8_BAR;
    PG8_WAIT_V(2); PG8_BAR;
    PG8_STAGE(PG8_SB(1, 0), cB + kstep, voffB); PG8_STAGE_A(PG8_SA(1, 0), 0, cA + kstep); PG8_STAGE(PG8_SB(1, 1), cB + hstepB + kstep, voffB);
    PG8_WAIT_V(6); PG8_BAR;
    for (;;) {
        const bool has_next = S.next(ui + 1, nxt);
        const char* nA = has_next ? (const char*)nxt.A : cA; const char* nB = has_next ? (const char*)nxt.Bt : cB;
        for (int t = 0; t < nt; t += 2) {
            const bool last = (t == nt - 2);
            const char* a1 = cA + (size_t)(t + 1) * kstep;
            const char* a2 = last ? nA : cA + (size_t)(t + 2) * kstep; const char* b2 = last ? nB : cB + (size_t)(t + 2) * kstep;
            const char* a3 = a2 + kstep; const char* b3 = b2 + kstep;
            int kt_ = t;
            PG8_LDB(B0, 0, 0); PG8_LDB(B1, 0, 1); PG8_SCHED; PG8_LDA(At, 0, 0); PG8_STAGE_A(PG8_SA(1, 1), 1, a1);
            if (GATHER) { if (last && has_next) { PG8_LOADOFF(ui + 1); } }
            PG8_WAIT_V(8); PG8_WAIT_L(0); PG8_BAR; PG8_MMA(0, 0, At, B0); PG8_MMA(0, 1, At, B1); PG8_BAR; PG8_SCHED;
            PG8_LDA(At, 0, 1); PG8_STAGE(PG8_SB(0, 0), b2, voffB); PG8_STAGE(PG8_SB(0, 1), b2 + hstepB, voffB); PG8_STAGE_A(PG8_SA(0, 0), 0, a2);
            PG8_WAIT_V(8); PG8_WAIT_L(0); PG8_BAR; PG8_MMA(1, 0, At, B0); PG8_MMA(1, 1, At, B1); PG8_BAR; PG8_SCHED;
            kt_ = t + 1;
            PG8_LDB(B0, 1, 0); PG8_LDB(B1, 1, 1); PG8_SCHED; PG8_LDA(At, 1, 0); PG8_STAGE_A(PG8_SA(0, 1), 1, a2);
            PG8_WAIT_V(8); PG8_WAIT_L(0); PG8_BAR; PG8_MMA(0, 0, At, B0); PG8_MMA(0, 1, At, B1); PG8_BAR; PG8_SCHED;
            PG8_LDA(At, 1, 1); PG8_STAGE(PG8_SB(1, 0), b3, voffB); PG8_STAGE(PG8_SB(1, 1), b3 + hstepB, voffB); PG8_STAGE_A(PG8_SA(1, 0), 0, a3);
            PG8_WAIT_V(8); PG8_WAIT_L(0); PG8_BAR; PG8_MMA(1, 0, At, B0); PG8_MMA(1, 1, At, B1); PG8_BAR; PG8_SCHED;
        }
        if (wr == 0) PG8_BAR;
#pragma unroll
        for (int ai = 0; ai < 2; ++ai)
#pragma unroll
            for (int m = 0; m < 4; ++m)
#pragma unroll
                for (int bj = 0; bj < 2; ++bj) E(cur, ai * HALF + wr * 64 + m * 16 + fr, bj * HALF + wc * 32 + 8 * fq, acc[ai][bj][m][0], acc[ai][bj][m][1]);
        if (!has_next) break;
#pragma unroll
        for (int a = 0; a < 2; ++a)
#pragma unroll
            for (int b = 0; b < 2; ++b)
#pragma unroll
                for (int m = 0; m < 4; ++m)
#pragma unroll
                    for (int n = 0; n < 2; ++n) acc[a][b][m][n] = (f32x4){0.f, 0.f, 0.f, 0.f};
        cur = nxt; cA = nA; cB = nB; ++ui;
        if (wr == 1) PG8_BAR;
    }
    PG8_WAIT_V(0);
    PG8_BAR;
#undef PG8_SA
#undef PG8_SB
#undef PG8_STAGE
#undef PG8_STAGE_A
#undef PG8_LOADOFF
#undef PG8_LDA
#undef PG8_LDB
#undef PG8_MMA
#undef PG8_WAIT_V
#undef PG8_WAIT_L
#undef PG8_BAR
#undef PG8_SCHED
}
}

template <class Sched, class Epi>
__device__ __forceinline__ void gemm_dense(unsigned char* lds, const Sched& S, const Epi& E) {
    pg8::gemm_phase<false>((LAS unsigned char*)lds, (const LAS unsigned*)nullptr, S, E, S.lda, S.K, S.K);
    __syncthreads();
}
template <class Sched, class Epi>
__device__ __forceinline__ void gemm_dense_bdiag(unsigned char* lds, const Sched& S, const Epi& E) {
    pg8::gemm_phase<false, Sched, Epi, true>((LAS unsigned char*)lds, (const LAS unsigned*)nullptr, S, E, S.lda, S.K, S.K);
    __syncthreads();
}


template <bool GATHER, class Epi>
__device__ __forceinline__ void gemm_moe(unsigned char* lds, const MoeSched& S, const Epi& E) {
    LAS unsigned* rowtab = (LAS unsigned*)(lds + MISC_OFF + 256);
    if (GATHER) {
        UnitInfo u;
        for (int round = 0; round < 10 && S.next(round, u); ++round)
            if (threadIdx.x < 256) rowtab[round * 256 + threadIdx.x] = ((int)threadIdx.x < u.nvalid) ? (unsigned)(u.rows[threadIdx.x] >> 1) * (unsigned)(S.K * 2) : 0u;
        __syncthreads();
    }
    pg8::gemm_phase<GATHER>((LAS unsigned char*)lds, (const LAS unsigned*)rowtab, S, E, S.K, S.K, S.K);
    __syncthreads();
}

__device__ __forceinline__ u32x4 pack8(f32x4 a, f32x4 b) { u32x4 w; w.x = pk2(a.x, a.y); w.y = pk2(a.z, a.w); w.z = pk2(b.x, b.y); w.w = pk2(b.z, b.w); return w; }
struct EpiStoreBf16 {
    bf16_t* O; int ldc; int coff; const float* colscale;
    __device__ __forceinline__ void operator()(const UnitInfo& u, int r, int c, f32x4 v0, f32x4 v1) const {
        const int col = u.pn * 256 + c;
        if (colscale) { const f32x4 s0 = *(const f32x4*)(colscale + col), s1 = *(const f32x4*)(colscale + col + 4); v0 *= s0; v1 *= s1; }
        *(u32x4*)(O + (size_t)(u.orow0 + r) * ldc + coff + col) = pack8(v0, v1);
    }
};

__device__ __forceinline__ float ret_log2g(int h) { return log2f(1.0f - exp2f(-5.0f - (float)h)); }
struct EpiZ0 {
    bf16_t* O;
    __device__ __forceinline__ void operator()(const UnitInfo& u, int r, int c, f32x4 v0, f32x4 v1) const {
        const int col = u.pn * 256 + c, row = u.orow0 + r;
        if (col < 1024) { const float e = ret_log2g((col >> 7) & 3) * (float)(row & 127); const float sc = exp2f(col < 512 ? e : -e); v0 *= sc; v1 *= sc; }
        *(u32x4*)(O + (size_t)row * ZW + col) = pack8(v0, v1);
    }
};

struct EpiStoreFp8 {
    unsigned char* O; int ldc;
    __device__ __forceinline__ void operator()(const UnitInfo& u, int r, int c, f32x4 v0, f32x4 v1) const {
        int w0 = __builtin_amdgcn_cvt_pk_fp8_f32(v0.x, v0.y, 0, false); w0 = __builtin_amdgcn_cvt_pk_fp8_f32(v0.z, v0.w, w0, true);
        int w1 = __builtin_amdgcn_cvt_pk_fp8_f32(v1.x, v1.y, 0, false); w1 = __builtin_amdgcn_cvt_pk_fp8_f32(v1.z, v1.w, w1, true);
        u32x2 w; w.x = (unsigned)w0; w.y = (unsigned)w1;
        *(u32x2*)(O + (size_t)(u.orow0 + r) * ldc + u.pn * 256 + c) = w;
    }
};
struct EpiResidB {
    const bf16_t* X; bf16_t* Yo;
    __device__ __forceinline__ void operator()(const UnitInfo& u, int r, int c, f32x4 v0, f32x4 v1) const {
        const size_t off = (size_t)(u.orow0 + r) * DM + u.pn * 256 + c;
        const u32x4 xw = *(const u32x4*)(X + off);
        const f32x4 x0 = {bflo(xw.x), bfhi(xw.x), bflo(xw.y), bfhi(xw.y)}, x1 = {bflo(xw.z), bfhi(xw.z), bflo(xw.w), bfhi(xw.w)};
        *(u32x4*)(Yo + off) = pack8(x0 * ALPHA + v0, x1 * ALPHA + v1);
    }
};

struct EpiGU {
    bf16_t* ACT;
    __device__ __forceinline__ void operator()(const UnitInfo& u, int r, int c, f32x4 v0, f32x4 v1) const {
        u32x2 w; w.x = pk2(silu_f(v0.x) * v0.y, silu_f(v0.z) * v0.w); w.y = pk2(silu_f(v1.x) * v1.y, silu_f(v1.z) * v1.w);
        *(u32x2*)(ACT + (size_t)(u.orow0 + r) * 512 + u.pn * 128 + (c >> 1)) = w;
    }
};
struct EpiDown {
    bf16_t* YS;
    __device__ __forceinline__ void operator()(const UnitInfo& u, int r, int c, f32x4 v0, f32x4 v1) const {
        if (r < u.nvalid) { const int pair = u.rows[r]; *(u32x4*)(YS + (size_t)pair * DM + u.pn * 256 + c) = pack8(v0, v1); }
    }
};
struct EpiPle {
    const bf16_t* XI; const bf16_t* PP; float* OUT; bf16_t* XO;
    __device__ __forceinline__ void operator()(const UnitInfo& u, int r, int c, f32x4 v0, f32x4 v1) const {
        const size_t off = (size_t)(u.orow0 + r) * DM + u.pn * 256 + c;
        const u32x4 pw = *(const u32x4*)(PP + off), xw = *(const u32x4*)(XI + off);
        f32x4 f0 = {bflo(xw.x), bfhi(xw.x), bflo(xw.y), bfhi(xw.y)}, f1 = {bflo(xw.z), bfhi(xw.z), bflo(xw.w), bfhi(xw.w)};
        f0.x += sigmoid_f(v0.x) * bflo(pw.x); f0.y += sigmoid_f(v0.y) * bfhi(pw.x); f0.z += sigmoid_f(v0.z) * bflo(pw.y); f0.w += sigmoid_f(v0.w) * bfhi(pw.y);
        f1.x += sigmoid_f(v1.x) * bflo(pw.z); f1.y += sigmoid_f(v1.y) * bfhi(pw.z); f1.z += sigmoid_f(v1.z) * bflo(pw.w); f1.w += sigmoid_f(v1.w) * bfhi(pw.w);
        if (OUT) { *(f32x4*)(OUT + off) = f0; *(f32x4*)(OUT + off + 4) = f1; }
        if (XO) *(u32x4*)(XO + off) = pack8(f0, f1);
    }
};

struct TrDesc { const float* src; bf16_t* dst; int K, N, Nsrc, nbatch, mode, dst_ld; };
struct TrItem { const float* src; bf16_t* dst; int Nsrc, dst_ld, mode, kb, nb; };
__device__ __forceinline__ void tr_load(const TrItem& t, int lane, float (&tmp)[32]) {
    const int k0 = 64 * t.kb, n0 = 32 * t.nb, Ns = t.Nsrc;
    const bool okc = (n0 + (lane & 31)) < Ns;
    const float* p = t.src + (size_t)(k0 + (lane >> 5)) * Ns + n0 + (lane & 31);
#pragma unroll
    for (int i = 0; i < 32; ++i) { tmp[i] = okc ? __builtin_nontemporal_load(p) : 0.f; p += 2 * Ns; asm volatile("" : "+v"(p)); }
}
__device__ __forceinline__ void tr_store(const TrItem& t, float* scr, int lane, const float (&tmp)[32]) {
    const int k0 = 64 * t.kb, n0 = 32 * t.nb;
#pragma unroll
    for (int i = 0; i < 32; ++i) scr[(2 * i + (lane >> 5)) * 33 + (lane & 31)] = tmp[i];
    LDS_FENCE();
    const int c = lane & 7;
#pragma unroll
    for (int j = 0; j < 4; ++j) {
        const int n = (lane >> 3) + 8 * j; const float* sp = scr + (8 * c) * 33 + n;
        const int ng = n0 + n;
        float sc = 1.f; int nd = ng; int coff = 0;
        if (t.mode == 1) { if (ng >= 512 && ng < 1024) sc = 0.08838834764831845f; }
        if (t.mode == 2) { nd = (ng < 512) ? 2 * ng : 2 * (ng - 512) + 1; }
        if (t.mode == 3) { coff = ((ng >> 6) & 3) * 256; }
        u32x4 o; o.x = pk2(sp[0 * 33] * sc, sp[1 * 33] * sc); o.y = pk2(sp[2 * 33] * sc, sp[3 * 33] * sc); o.z = pk2(sp[4 * 33] * sc, sp[5 * 33] * sc); o.w = pk2(sp[6 * 33] * sc, sp[7 * 33] * sc);
        *(u32x4*)(t.dst + (size_t)nd * t.dst_ld + coff + k0 + 8 * c) = o;
    }
    LDS_FENCE();
}
__device__ __forceinline__ int tr_items(const TrDesc& d) { return d.nbatch * (d.K / 64) * (d.N / 32); }

constexpr int N_DEFERRED = 32 * 512 + 32 * 256;
__device__ __forceinline__ TrItem deferred_item(const Params& P, int idx) {
    TrItem t;
    if (idx < 32 * 512) { const int b = 32 + (idx >> 9), r = idx & 511;
        t.src = P.in[22] + (size_t)b * 1024 * 1024; t.dst = (bf16_t*)(P.ws + WS_W_GU) + (size_t)b * 1024 * 1024; t.Nsrc = 1024; t.dst_ld = 1024; t.mode = 2; t.kb = r >> 5; t.nb = r & 31; }
    else { const int i2 = idx - 32 * 512, b = 32 + (i2 >> 8), r = i2 & 255;
        t.src = P.in[23] + (size_t)b * 512 * 1024; t.dst = (bf16_t*)(P.ws + WS_W_DN) + (size_t)b * 1024 * 512; t.Nsrc = 1024; t.dst_ld = 512; t.mode = 0; t.kb = r >> 5; t.nb = r & 31; }
    return t;
}
__device__ __forceinline__ void phase_prep(const Params& P, unsigned char* lds) {
    unsigned char* ws = P.ws;
    const int tid = threadIdx.x, lane = tid & 63, wave = tid >> 6;
    const int gw = blockIdx.x * NWAVE + wave, NGW = gridDim.x * NWAVE;
    float* scr = (float*)lds + wave * (64 * 33);
    constexpr int ND = 9;
    TrDesc d[ND];
    d[0] = {P.in[22], (bf16_t*)(ws + WS_W_GU), 1024, 1024, 1024, 32, 2, 1024};
    d[1] = {P.in[23], (bf16_t*)(ws + WS_W_DN), 512, 1024, 1024, 32, 0, 512};
    d[2] = {P.in[2], (bf16_t*)(ws + WS_W_IN0), 1024, 2560, 2560, 1, 1, 1024};
    d[3] = {P.in[6], (bf16_t*)(ws + WS_W_OUT0), 1024, 1024, 1024, 1, 0, 1024};
    d[4] = {P.in[13], (bf16_t*)(ws + WS_W_COUT), 1024, 1024, 1024, 1, 0, 1024};
    d[5] = {P.in[24], (bf16_t*)(ws + WS_W_G), 1024, 1024, 1024, 2, 0, 1024};
    d[6] = {P.in[25], (bf16_t*)(ws + WS_W_P), 256, 1024, 1024, 2, 0, 256};
    d[7] = {P.in[7], (bf16_t*)(ws + WS_W_CIN), 1024, Z1W, CIN, 1, 0, 1024};
    d[8] = {P.in[12], (bf16_t*)(ws + WS_W_UVBD), 256, 1024, 1024, 1, 3, 1024};
    int total = 0;
#pragma unroll
    for (int i = 0; i < ND; ++i) total += tr_items(d[i]);
#define TR_DECODE(it, T) do { int _r = (it); bool _f = false; T = TrItem{nullptr, nullptr, 0, 0, 0, 0, 0}; _Pragma("unroll") for (int _i = 0; _i < ND; ++_i) { const int _n = tr_items(d[_i]); \
            if (!_f && _r < _n) { _f = true; const int _per = (d[_i].K / 64) * (d[_i].N / 32), _b = _r / _per, _q = _r % _per, _nblk = d[_i].N / 32; \
                T.src = d[_i].src + (size_t)_b * d[_i].K * d[_i].Nsrc; T.dst = d[_i].dst + (size_t)_b * d[_i].N * d[_i].dst_ld; T.Nsrc = d[_i].Nsrc; T.dst_ld = d[_i].dst_ld; T.mode = d[_i].mode; T.kb = _q / _nblk; T.nb = _q % _nblk; } \
            if (!_f) _r -= _n; } } while (0)
    {
        float cur[32], nxt[32];
        TrItem tc, tn;
        int it = gw;
        if (it < total) { TR_DECODE(it, tc); tr_load(tc, lane, cur); }
        while (it < total) {
            const int itn = it + NGW;
            if (itn < total) { TR_DECODE(itn, tn); tr_load(tn, lane, nxt); }
            tr_store(tc, scr, lane, cur);
#pragma unroll
            for (int i = 0; i < 32; ++i) cur[i] = nxt[i];
            it = itn; tc = tn;
        }
    }
#undef TR_DECODE
    const size_t gt = (size_t)blockIdx.x * NT + tid, GS = (size_t)gridDim.x * NT;
    {
        bf16_t* o = (bf16_t*)(ws + WS_W_POOL); const float* pw = P.in[4];
        for (size_t i = gt; i < 512 * 256; i += GS) { const int n = (int)(i >> 8), k = (int)(i & 255), g = n >> 7, dd = n & 127, kg = k >> 7, c = k & 127;
            o[i] = (bf16_t)((kg == (g & 1)) ? f2bf(pw[((size_t)g * 128 + c) * 128 + dd]) : 0u); }
    }
    {
        u32x4* o = (u32x4*)(ws + WS_W_UVBD);
        for (size_t i = gt; i < (size_t)1024 * 1024 / 8; i += GS) { const int n = (int)(i >> 7), k = (int)(i & 127) * 8; if (((n >> 6) & 3) != (k >> 8)) o[i] = (u32x4){0u, 0u, 0u, 0u}; }
    }
    {
        bf16_t* o = (bf16_t*)(ws + WS_W_QA); const float* uq = P.in[10]; const float* uk = P.in[11];
        float* Bq = (float*)lds; float* Ak = Bq + 256 * 65;
        for (int item = blockIdx.x; item < 128; item += gridDim.x) {
            const int h = item >> 3, c0 = (item & 7) * 32;
            __syncthreads();
            for (int i = tid; i < 256 * 16; i += NT) { const int r = i >> 4, d4 = (i & 15) * 4; const f32x4 v = *(const f32x4*)(uq + (size_t)r * 1024 + h * 64 + d4);
                float* q = Bq + r * 65 + d4; q[0] = v.x; q[1] = v.y; q[2] = v.z; q[3] = v.w; }
            for (int i = tid; i < 32 * 16; i += NT) { const int c = i >> 4, d4 = (i & 15) * 4; const f32x4 v = *(const f32x4*)(uk + (size_t)(c0 + c) * 1024 + h * 64 + d4);
                float* q = Ak + c * 65 + d4; q[0] = v.x; q[1] = v.y; q[2] = v.z; q[3] = v.w; }
            __syncthreads();
            const int r = tid & 255, cg = tid >> 8;
            float acc[16];
#pragma unroll
            for (int j = 0; j < 16; ++j) acc[j] = 0.f;
            for (int dd = 0; dd < 64; ++dd) { const float bv = Bq[r * 65 + dd];
#pragma unroll
                for (int j = 0; j < 16; ++j) acc[j] += Ak[(cg * 16 + j) * 65 + dd] * bv; }
#pragma unroll
            for (int j = 0; j < 16; ++j) o[(size_t)(h * 256 + c0 + cg * 16 + j) * 256 + r] = (bf16_t)f2bf(acc[j] * 0.125f);
        }
        __syncthreads();
    }
    {
        bf16_t* GT = (bf16_t*)(ws + WS_GT); float* SGB = (float*)(ws + WS_SGB);
        for (size_t i = gt; i < (size_t)2 * 48 * 1024; i += GS) {
            const int l = (int)(i / (48 * 1024)), j = (int)((i / 1024) % 48), c = (int)(i & 1023);
            float w = 0.f;
            if (j < 4) w = P.in[18][(size_t)l * DM * 4 + (size_t)c * 4 + j]; else if (j < 36) w = P.in[20][(size_t)l * DM * 32 + (size_t)c * 32 + (j - 4)];
            const float g = P.in[14][l * DM + c] * w;
            const unsigned hi = f2bf(g); const unsigned lo = f2bf(g - bf2f(hi));
            GT[((size_t)(l * 2 + 0) * 48 + j) * 1024 + c] = (bf16_t)hi; GT[((size_t)(l * 2 + 1) * 48 + j) * 1024 + c] = (bf16_t)lo;
        }
        for (int it = gw; it < 96; it += NGW) {
            const int l = it / 48, j = it % 48; float sg = 0.f, sb = 0.f;
            for (int c = lane; c < 1024; c += 64) {
                float w = 0.f;
                if (j < 4) w = P.in[18][(size_t)l * DM * 4 + (size_t)c * 4 + j]; else if (j < 36) w = P.in[20][(size_t)l * DM * 32 + (size_t)c * 32 + (j - 4)];
                sg += P.in[14][l * DM + c] * w; sb += P.in[15][l * DM + c] * w;
            }
            sg = wave_sum(sg); sb = wave_sum(sb);
            const float bias = (j < 4) ? P.in[19][l * 4 + j] : ((j < 36) ? P.in[21][l * 32 + (j - 4)] : 0.f);
            if (lane == 0) { SGB[(l * 2 + 0) * 48 + j] = sg; SGB[(l * 2 + 1) * 48 + j] = sb + bias; }
        }
    }
    {
        const f32x4* x = (const f32x4*)P.in[0]; u32x4* xb = (u32x4*)(ws + WS_XB);
        const size_t nx = (size_t)NTOK * DM / 8, np = (size_t)2 * NTOK * 256 / 8;
        size_t i = gt;
        for (; i + 3 * GS < nx; i += 4 * GS) { f32x4 a[8];
#pragma unroll
            for (int q = 0; q < 4; ++q) { a[2 * q] = __builtin_nontemporal_load(x + 2 * (i + q * GS)); a[2 * q + 1] = __builtin_nontemporal_load(x + 2 * (i + q * GS) + 1); }
#pragma unroll
            for (int q = 0; q < 4; ++q) xb[i + q * GS] = pack8(a[2 * q], a[2 * q + 1]); }
        for (; i < nx; i += GS) xb[i] = pack8(x[2 * i], x[2 * i + 1]);
        const f32x4* p = (const f32x4*)P.in[1]; u32x4* pb = (u32x4*)(ws + WS_PB);
        i = gt;
        for (; i + 3 * GS < np; i += 4 * GS) { f32x4 a[8];
#pragma unroll
            for (int q = 0; q < 4; ++q) { a[2 * q] = __builtin_nontemporal_load(p + 2 * (i + q * GS)); a[2 * q + 1] = __builtin_nontemporal_load(p + 2 * (i + q * GS) + 1); }
#pragma unroll
            for (int q = 0; q < 4; ++q) pb[i + q * GS] = pack8(a[2 * q], a[2 * q + 1]); }
        for (; i < np; i += GS) pb[i] = pack8(p[2 * i], p[2 * i + 1]);
    }
}


template <bool DRY>
__device__ __forceinline__ void phase_ln_route(const Params& P, unsigned char* lds, int layer) {
    using pg8::bf16x8;
    const bf16_t* F = (const bf16_t*)(P.ws + WS_F); bf16_t* XB = (bf16_t*)(P.ws + (DRY ? WS_M0 + 128 * MiB : WS_XB));
    float* TOKG = (float*)(P.ws + WS_TOKG); int* LIST = (int*)(P.ws + WS_LIST);
    int* CNT = (int*)(P.ws + WS_CTL) + layer * 64;
    const float* lg = P.in[14] + layer * DM; const float* lb = P.in[15] + layer * DM;
    const bf16_t* GTh = (const bf16_t*)(P.ws + WS_GT) + (size_t)(layer * 2) * 48 * 1024; const bf16_t* GTl = GTh + 48 * 1024;
    const float* SG = (const float*)(P.ws + WS_SGB) + (layer * 2) * 48; const float* BB = SG + 48;
    const int tid = threadIdx.x, lane = tid & 63, wave = tid >> 6, r16 = lane & 15, g = lane >> 4;
    int* dec = (int*)lds;
    int* rank = dec + 256;
    int* lcnt = rank + 256;
    int* lbase = lcnt + 32;
    float* stat = (float*)(lds + 4096) + wave * 32;
    float* LG = (float*)(lds + 8192) + wave * (16 * 48);
    f32x4 g4[4], b4[4];
#pragma unroll
    for (int j = 0; j < 4; ++j) { g4[j] = *(const f32x4*)(lg + 256 * j + 4 * lane); b4[j] = *(const f32x4*)(lb + 256 * j + 4 * lane); }
    for (int rb = blockIdx.x; rb < NTOK / 128; rb += gridDim.x) {
        if (tid < 32) lcnt[tid] = 0;
        __syncthreads();
        const int tbase = rb * 128 + wave * 16;
        f32x4 acc[3];
#pragma unroll
        for (int i = 0; i < 3; ++i) acc[i] = (f32x4){0.f, 0.f, 0.f, 0.f};
        float sm = 0.f, sq = 0.f;
        const bf16_t* yrow = F + (size_t)(tbase + r16) * DM + 8 * g;
        const bf16_t* ghp = GTh + (size_t)r16 * 1024 + 8 * g; const bf16_t* glp = GTl + (size_t)r16 * 1024 + 8 * g;
#pragma unroll 2
        for (int k = 0; k < 32; ++k) {
            const u32x4 yw = *(const u32x4*)(yrow + 32 * k);
            bf16x8 gh[3], gl[3];
#pragma unroll
            for (int i = 0; i < 3; ++i) { gh[i] = *(const bf16x8*)(ghp + (size_t)i * 16 * 1024 + 32 * k); gl[i] = *(const bf16x8*)(glp + (size_t)i * 16 * 1024 + 32 * k); }
            const float y0 = bflo(yw.x), y1 = bfhi(yw.x), y2 = bflo(yw.y), y3 = bfhi(yw.y), y4 = bflo(yw.z), y5 = bfhi(yw.z), y6 = bflo(yw.w), y7 = bfhi(yw.w);
            sm += (y0 + y1) + (y2 + y3) + (y4 + y5) + (y6 + y7);
            sq += (y0 * y0 + y1 * y1) + (y2 * y2 + y3 * y3) + (y4 * y4 + y5 * y5) + (y6 * y6 + y7 * y7);
            const bf16x8 yh = __builtin_bit_cast(bf16x8, yw);
#pragma unroll
            for (int i = 0; i < 3; ++i) {
                acc[i] = __builtin_amdgcn_mfma_f32_16x16x32_bf16(yh, gh[i], acc[i], 0, 0, 0);
                acc[i] = __builtin_amdgcn_mfma_f32_16x16x32_bf16(yh, gl[i], acc[i], 0, 0, 0);
            }
        }
        sm += __shfl_xor(sm, 16); sm += __shfl_xor(sm, 32); sq += __shfl_xor(sq, 16); sq += __shfl_xor(sq, 32);
        const float mean = sm * (1.0f / DM), var = fmaxf(sq * (1.0f / DM) - mean * mean, 0.f), rstd = 1.0f / sqrtf(var + LN_EPS);
        if (g == 0) { stat[r16 * 2] = mean; stat[r16 * 2 + 1] = rstd; }
        LDS_FENCE();
#pragma unroll
        for (int i = 0; i < 3; ++i) { const float sg = SG[16 * i + r16], bb = BB[16 * i + r16];
#pragma unroll
            for (int r = 0; r < 4; ++r) { const float mu = stat[(4 * g + r) * 2], rs = stat[(4 * g + r) * 2 + 1];
                LG[(4 * g + r) * 48 + 16 * i + r16] = rs * (acc[i][r] - mu * sg) + bb; } }
        LDS_FENCE();
        if (lane < 16) {
            const float* lr = LG + lane * 48; const int rl = wave * 16 + lane, t = tbase + lane;
            float gl4[4];
#pragma unroll
            for (int j = 0; j < 4; ++j) gl4[j] = lr[j];
            int grp = 0; float gm = gl4[0];
#pragma unroll
            for (int j = 1; j < 4; ++j) if (gl4[j] > gm) { gm = gl4[j]; grp = j; }
            float gs = 0.f;
#pragma unroll
            for (int j = 0; j < 4; ++j) gs += __expf(gl4[j] - gm);
            const float gwt = 1.0f / gs;
            float el[8];
#pragma unroll
            for (int j = 0; j < 8; ++j) el[j] = lr[4 + grp * 8 + j];
            int i0 = 0; float m0 = el[0];
#pragma unroll
            for (int j = 1; j < 8; ++j) if (el[j] > m0) { m0 = el[j]; i0 = j; }
            int i1 = -1; float m1 = -INFINITY;
#pragma unroll
            for (int j = 0; j < 8; ++j) if (j != i0 && el[j] > m1) { m1 = el[j]; i1 = j; }
            const float ex = __expf(m1 - m0);
            const float p0 = 1.0f / (1.0f + ex), p1 = ex / (1.0f + ex);
            dec[rl * 2] = grp * 8 + i0; dec[rl * 2 + 1] = grp * 8 + i1;
            if (!DRY) { TOKG[(size_t)t * 2] = gwt * p0; TOKG[(size_t)t * 2 + 1] = gwt * p1; }
        }
#pragma unroll 4
        for (int r = 0; r < 16; ++r) {
            const float mu = stat[r * 2], rs = stat[r * 2 + 1];
            const bf16_t* fr = F + (size_t)(tbase + r) * DM + 4 * lane; bf16_t* xo = XB + (size_t)(tbase + r) * DM + 4 * lane;
#pragma unroll
            for (int j = 0; j < 4; ++j) { const u32x2 yw = *(const u32x2*)(fr + 256 * j); const f32x4 y = {bflo(yw.x), bfhi(yw.x), bflo(yw.y), bfhi(yw.y)};
                const f32x4 v = (y - mu) * rs * g4[j] + b4[j];
                u32x2 w; w.x = pk2(v.x, v.y); w.y = pk2(v.z, v.w); *(u32x2*)(xo + 256 * j) = w; }
        }
        __syncthreads();
        if (tid < 256) rank[tid] = atomicAdd(&lcnt[dec[tid]], 1);
        __syncthreads();
        if (tid < 32) lbase[tid] = DRY ? 0 : atomicAdd(&CNT[tid], lcnt[tid]);
        __syncthreads();
        if (!DRY && tid < 256) { const int e = dec[tid]; LIST[(size_t)e * LIST_CAP + lbase[e] + rank[tid]] = (rb * 128 + (tid >> 1)) * 2 + (tid & 1); }
        __syncthreads();
    }
}
__device__ __forceinline__ void moe_setup(const Params& P, int* tb, int layer) {
    const int* CNT = (const int*)(P.ws + WS_CTL) + layer * 64;
    if (threadIdx.x == 0) { int a = 0; for (int e = 0; e < 32; ++e) { tb[e] = a; a += (CNT[e] + 255) >> 8; } tb[32] = a; }
    __syncthreads();
}
template <bool DRY>
__device__ __forceinline__ void phase_ln2(const Params& P, int layer) {
    const bf16_t* XI = (const bf16_t*)(P.ws + WS_XB); bf16_t* XO = (bf16_t*)(P.ws + (DRY ? WS_XB2 : WS_XB));
    const bf16_t* YS = (const bf16_t*)(P.ws + WS_YS); const float* TOKG = (const float*)(P.ws + WS_TOKG);
    const float* lg = P.in[16] + layer * DM; const float* lb = P.in[17] + layer * DM;
    const int lane = threadIdx.x & 63, gw = blockIdx.x * NWAVE + (threadIdx.x >> 6), NGW = gridDim.x * NWAVE;
    f32x4 g4[4], b4[4];
#pragma unroll
    for (int j = 0; j < 4; ++j) { g4[j] = *(const f32x4*)(lg + 256 * j + 4 * lane); b4[j] = *(const f32x4*)(lb + 256 * j + 4 * lane); }
    u32x2 nx[4], na[4], nb[4]; float ng0 = 0.f, ng1 = 0.f;
    if (gw < NTOK) { const int t = gw;
#pragma unroll
        for (int j = 0; j < 4; ++j) { const int c0 = 256 * j + 4 * lane; nx[j] = *(const u32x2*)(XI + (size_t)t * DM + c0); na[j] = *(const u32x2*)(YS + (size_t)(2 * t) * DM + c0); nb[j] = *(const u32x2*)(YS + (size_t)(2 * t + 1) * DM + c0); }
        ng0 = TOKG[(size_t)t * 2]; ng1 = TOKG[(size_t)t * 2 + 1]; }
    for (int t = gw; t < NTOK; t += NGW) {
        const float g0 = ng0, g1 = ng1;
        u32x2 xw[4], aw[4], bw[4];
#pragma unroll
        for (int j = 0; j < 4; ++j) { xw[j] = nx[j]; aw[j] = na[j]; bw[j] = nb[j]; }
        if (t + NGW < NTOK) { const int tn = t + NGW;
#pragma unroll
            for (int j = 0; j < 4; ++j) { const int c0 = 256 * j + 4 * lane; nx[j] = *(const u32x2*)(XI + (size_t)tn * DM + c0); na[j] = *(const u32x2*)(YS + (size_t)(2 * tn) * DM + c0); nb[j] = *(const u32x2*)(YS + (size_t)(2 * tn + 1) * DM + c0); }
            ng0 = TOKG[(size_t)tn * 2]; ng1 = TOKG[(size_t)tn * 2 + 1]; }
        f32x4 v[4]; float s = 0.f;
#pragma unroll
        for (int j = 0; j < 4; ++j) {
            const u32x2 x = xw[j], a = aw[j], b = bw[j];
            v[j].x = bflo(x.x) * ALPHA + g0 * bflo(a.x) + g1 * bflo(b.x); v[j].y = bfhi(x.x) * ALPHA + g0 * bfhi(a.x) + g1 * bfhi(b.x);
            v[j].z = bflo(x.y) * ALPHA + g0 * bflo(a.y) + g1 * bflo(b.y); v[j].w = bfhi(x.y) * ALPHA + g0 * bfhi(a.y) + g1 * bfhi(b.y);
            s += (v[j].x + v[j].y) + (v[j].z + v[j].w); }
        const float mean = wave_sum(s) * (1.0f / DM); float s2 = 0.f;
#pragma unroll
        for (int j = 0; j < 4; ++j) { v[j] = v[j] - mean; s2 += (v[j].x * v[j].x + v[j].y * v[j].y) + (v[j].z * v[j].z + v[j].w * v[j].w); }
        const float rstd = 1.0f / sqrtf(wave_sum(s2) * (1.0f / DM) + LN_EPS);
#pragma unroll
        for (int j = 0; j < 4; ++j) { const int c0 = 256 * j + 4 * lane;
            v[j] = v[j] * rstd * g4[j] + b4[j];
            u32x2 w; w.x = pk2(v[j].x, v[j].y); w.y = pk2(v[j].z, v[j].w); *(u32x2*)(XO + (size_t)t * DM + c0) = w; }
    }
}

__device__ __forceinline__ unsigned e5m2enc(float y) {
    const unsigned hb = (unsigned)__builtin_bit_cast(unsigned short, (_Float16)y);
    return ((hb + 0x7fu + ((hb >> 8) & 1u)) >> 8) & 0xffu;
}
__device__ __forceinline__ void phase_norms(const Params& P) {
    const bf16_t* Z1 = (const bf16_t*)(P.ws + WS_Z1); bf16_t* CQ = (bf16_t*)(P.ws + WS_CQ); bf16_t* CKV = (bf16_t*)(P.ws + WS_CKV); unsigned char* CKV8 = (unsigned char*)(P.ws + WS_CKV8);
    const float* qn = P.in[8]; const float* kn = P.in[9];
    const int lane = threadIdx.x & 63, gw = blockIdx.x * NWAVE + (threadIdx.x >> 6), NGW = gridDim.x * NWAVE;
    for (int t = gw; t < NTOK; t += NGW) {
        const u32x2 a = *(const u32x2*)(Z1 + (size_t)t * Z1W + 4 * lane), b = *(const u32x2*)(Z1 + (size_t)t * Z1W + 256 + 4 * lane);
        const float q[4] = {bflo(a.x), bfhi(a.x), bflo(a.y), bfhi(a.y)}, k[4] = {bflo(b.x), bfhi(b.x), bflo(b.y), bfhi(b.y)};
        const float sq = wave_sum(q[0] * q[0] + q[1] * q[1] + q[2] * q[2] + q[3] * q[3]), sk = wave_sum(k[0] * k[0] + k[1] * k[1] + k[2] * k[2] + k[3] * k[3]);
        const float rq = 1.0f / sqrtf(sq * (1.0f / 256.0f) + 1e-6f), rk = 1.0f / sqrtf(sk * (1.0f / 256.0f) + 1e-6f);
        const f32x4 gq = *(const f32x4*)(qn + 4 * lane), gk = *(const f32x4*)(kn + 4 * lane);
        u32x2 o; o.x = pk2(q[0] * rq * gq.x, q[1] * rq * gq.y); o.y = pk2(q[2] * rq * gq.z, q[3] * rq * gq.w);
        *(u32x2*)(CQ + (size_t)t * 256 + 4 * lane) = o;
        o.x = pk2(k[0] * rk * gk.x, k[1] * rk * gk.y); o.y = pk2(k[2] * rk * gk.z, k[3] * rk * gk.w);
        *(u32x2*)(CKV + (size_t)t * 256 + 4 * lane) = o;
        *(unsigned*)(CKV8 + (size_t)t * 256 + 4 * lane) = e5m2enc(k[0] * rk * gk.x) | (e5m2enc(k[1] * rk * gk.y) << 8) | (e5m2enc(k[2] * rk * gk.z) << 16) | (e5m2enc(k[3] * rk * gk.w) << 24);
    }
}


constexpr int NPH_TOTAL = 23;


typedef short v4i16_t __attribute__((ext_vector_type(4)));


__device__ __forceinline__ void glds16(const void* gsrc, unsigned lds_dst) {
    unsigned keep;
    asm volatile("s_mov_b32 %0, m0\n\ts_mov_b32 m0, %2\n\ts_nop 0\n\tglobal_load_lds_dwordx4 %1, off\n\ts_mov_b32 m0, %0" : "=&s"(keep) : "v"(gsrc), "s"(lds_dst) : "memory");
}
typedef _Float16 f16x8 __attribute__((ext_vector_type(8)));
template <bool DRY>
__device__ __forceinline__ void phase_sparse_attn_e(const Params& P, unsigned char* lds_) {
    const unsigned char* QA = (const unsigned char*)(P.ws + WS_QA); bf16_t* OLAT = (bf16_t*)(P.ws + WS_OLAT); const unsigned char* CKV8 = (const unsigned char*)(P.ws + WS_CKV8); const unsigned short* SEL = (const unsigned short*)(P.ws + WS_SEL);
    const int tid = threadIdx.x, lane = tid & 63, wave = __builtin_amdgcn_readfirstlane(tid >> 6);
    const int fr = lane & 15, fq = lane >> 4;
    LAS unsigned char* cbuf = (LAS unsigned char*)lds_ + wave * 16896;
    LAS unsigned short* selw = (LAS unsigned short*)(cbuf + 16384);
    const unsigned cbuf0 = (unsigned)(unsigned long)cbuf;
    const int G = gridDim.x, NGW = G * NWAVE;
    int vw;
    if ((G & 7) == 0) vw = (((int)blockIdx.x & 7) * (G >> 3) + ((int)blockIdx.x >> 3)) * NWAVE + wave; else vw = (int)blockIdx.x * NWAVE + wave;
    const float LOG2E = 1.4426950408889634f;
    const float slope2 = exp2f(-0.5f * (float)(fr + 1)) * LOG2E;
    unsigned qoffB[4];
#pragma unroll
    for (int e = 0; e < 4; ++e) { const int r15 = (4 * e + fq) & 15; qoffB[e] = (unsigned)((fr ^ (((r15 & 7) << 1) | (r15 >> 3))) << 4); }
    const unsigned fA = (unsigned)(((fr & 7) << 1) | (fr >> 3));
    const unsigned SA = (fA & 14u) << 4, baseA = (unsigned)fr * 256u + ((((unsigned)fq >> 1) ^ (fA & 1u)) << 4) + ((unsigned)fq & 1u) * 8u;
    const int rT = 4 * fq + (fr >> 2), pT_ = fr & 3;
    const unsigned fT = (unsigned)(((rT & 7) << 1) | (rT >> 3));
    const unsigned ST = (fT & 14u) << 4, baseT = (unsigned)rT * 256u + ((((unsigned)pT_ >> 1) ^ (fT & 1u)) << 4) + ((unsigned)pT_ & 1u) * 8u;
    const int per = NGW >> 2, bq = vw / per, wb = vw % per;
    int ditem = DRY ? N_DEFERRED : vw;
    u32x2 selnext = {0u, 0u}; long qfn[8];
    if (wb < SEQ) { const int t0 = bq * SEQ + wb; selnext = *(const u32x2*)(SEL + (size_t)t0 * TOPK + 4 * lane);
#pragma unroll
        for (int cc = 0; cc < 8; ++cc) qfn[cc] = *(const long*)(QA + (size_t)t0 * 4096 + fr * 256 + 32 * cc + 8 * fq); }
    for (int tl0 = wb; tl0 < SEQ; tl0 += per) {
        const int t = bq * SEQ + tl0;
        const int b = t >> 13, tl = t & (SEQ - 1), ns = min(tl + 1, TOPK), nch = (ns + 31) >> 5;
        const bool has_nextq = (tl0 + per < SEQ);
        asm volatile("s_waitcnt vmcnt(0)" ::: "memory");
        {
            const u32x2 w = selnext;
            unsigned short i0 = (unsigned short)(w.x & 0xffffu), i1 = (unsigned short)(w.x >> 16), i2 = (unsigned short)(w.y & 0xffffu), i3 = (unsigned short)(w.y >> 16);
            const int k0 = 4 * lane;
            if (k0 >= ns) i0 = 0; if (k0 + 1 >= ns) i1 = 0; if (k0 + 2 >= ns) i2 = 0; if (k0 + 3 >= ns) i3 = 0;
            u32x2 o; o.x = (unsigned)i0 | ((unsigned)i1 << 16); o.y = (unsigned)i2 | ((unsigned)i3 << 16);
            asm volatile("s_waitcnt lgkmcnt(0)" ::: "memory");
            *(LAS u32x2*)(selw + 4 * lane) = o;
        }
        long qf[8];
#pragma unroll
        for (int cc = 0; cc < 8; ++cc) qf[cc] = qfn[cc];
#define ATT_PREFETCH() do { if (has_nextq) { const int tn_ = t + per; selnext = *(const u32x2*)(SEL + (size_t)tn_ * TOPK + 4 * lane); \
            _Pragma("unroll") for (int cc = 0; cc < 8; ++cc) qfn[cc] = *(const long*)(QA + (size_t)tn_ * 4096 + fr * 256 + 32 * cc + 8 * fq); pf = true; } } while (0)
        f32x4 Oe[8], Oo[8];
#pragma unroll
        for (int ut = 0; ut < 8; ++ut) { Oe[ut] = (f32x4){0.f, 0.f, 0.f, 0.f}; Oo[ut] = (f32x4){0.f, 0.f, 0.f, 0.f}; }
        float m = -INFINITY, l = 0.f;
        const unsigned char* cb = CKV8 + (size_t)b * SEQ * 256;
        asm volatile("s_waitcnt vmcnt(0) lgkmcnt(0)" ::: "memory");
#define ATT_DMA(jj, bufoff) do { unsigned idx_[8]; \
            _Pragma("unroll") for (int e = 0; e < 8; ++e) idx_[e] = (DRY && PROBE_ATT == 1) ? (unsigned)((32 * (jj) + 4 * e + fq + 64 * wave) & 8191) : (unsigned)selw[32 * (jj) + 4 * e + fq]; \
            _Pragma("unroll") for (int e = 0; e < 8; ++e) { \
            if (!(DRY && PROBE_ATT == 3)) glds16(cb + (size_t)idx_[e] * 256 + qoffB[e & 3], (unsigned)__builtin_amdgcn_readfirstlane((int)(cbuf0 + (bufoff) + e * 1024))); } } while (0)
        ATT_DMA(0, 0);
        if (nch > 1) ATT_DMA(1, 8192);
        const bool have_item = ditem < N_DEFERRED;
        TrItem titem = deferred_item(P, have_item ? ditem : 0);
        float tcur[32];
        bool trf = false, pf = false;
        if (nch <= 2) { if (have_item) { tr_load(titem, lane, tcur); trf = true; } ATT_PREFETCH(); }
        for (int j = 0; j < nch; ++j) {
            const unsigned bo = (unsigned)(j & 1) * 8192u;
            if (j + 1 < nch) { if (trf && pf) asm volatile("s_waitcnt vmcnt(49)" ::: "memory"); else if (trf) asm volatile("s_waitcnt vmcnt(40)" ::: "memory");
                               else if (pf) asm volatile("s_waitcnt vmcnt(17)" ::: "memory"); else asm volatile("s_waitcnt vmcnt(8)" ::: "memory"); }
            else { if (trf && pf) asm volatile("s_waitcnt vmcnt(41)" ::: "memory"); else if (trf) asm volatile("s_waitcnt vmcnt(32)" ::: "memory");
                   else if (pf) asm volatile("s_waitcnt vmcnt(9)" ::: "memory"); else asm volatile("s_waitcnt vmcnt(0)" ::: "memory"); }
            const LAS unsigned char* img = cbuf + bo;
            if (DRY && PROBE_ATT == 2) { if (j + 2 < nch) { asm volatile("s_waitcnt lgkmcnt(0)" ::: "memory"); ATT_DMA(j + 2, bo); } continue; }
            const u32x2 k0w = *(const LAS u32x2*)(selw + 32 * j + 4 * fq), k1w = *(const LAS u32x2*)(selw + 32 * j + 16 + 4 * fq);
            f32x4 s0 = {0.f, 0.f, 0.f, 0.f}, s1 = {0.f, 0.f, 0.f, 0.f};
#pragma unroll
            for (int hb = 0; hb < 2; ++hb) {
                u32x2 ra[4], rb[4];
#pragma unroll
                for (int c4 = 0; c4 < 4; ++c4) { const int cc = hb * 4 + c4; const LAS unsigned char* pa = img + ((SA ^ (unsigned)(cc << 5)) + baseA); ra[c4] = *(const LAS u32x2*)(pa); rb[c4] = *(const LAS u32x2*)(pa + 4096); }
                __builtin_amdgcn_sched_barrier(0);
#pragma unroll
                for (int c4 = 0; c4 < 4; ++c4) { const int cc = hb * 4 + c4;
                    s0 = __builtin_amdgcn_mfma_f32_16x16x32_bf8_fp8(__builtin_bit_cast(long, ra[c4]), qf[cc], s0, 0, 0, 0);
                    s1 = __builtin_amdgcn_mfma_f32_16x16x32_bf8_fp8(__builtin_bit_cast(long, rb[c4]), qf[cc], s1, 0, 0, 0); }
                __builtin_amdgcn_sched_barrier(0);
            }
            u32x2 tl_[4], th_[4];
#pragma unroll
            for (int ut = 0; ut < 4; ++ut) { const LAS unsigned char* pt = img + ((ST ^ (unsigned)(ut << 5)) + baseT);
                tl_[ut] = __builtin_bit_cast(u32x2, __builtin_amdgcn_ds_read_tr16_b64_v4i16((LAS v4i16_t*)(pt)));
                th_[ut] = __builtin_bit_cast(u32x2, __builtin_amdgcn_ds_read_tr16_b64_v4i16((LAS v4i16_t*)(pt + 4096))); }
            __builtin_amdgcn_sched_barrier(0);
            const int kb0 = 32 * j + 4 * fq, kb1 = kb0 + 16;
            float lg[8];
            {
                const int i00 = (int)(k0w.x & 0xffffu), i01 = (int)(k0w.x >> 16), i02 = (int)(k0w.y & 0xffffu), i03 = (int)(k0w.y >> 16);
                const int i10 = (int)(k1w.x & 0xffffu), i11 = (int)(k1w.x >> 16), i12 = (int)(k1w.y & 0xffffu), i13 = (int)(k1w.y >> 16);
                lg[0] = (kb0 + 0 < ns) ? s0.x * LOG2E - slope2 * (float)(tl - i00) : -INFINITY;
                lg[1] = (kb0 + 1 < ns) ? s0.y * LOG2E - slope2 * (float)(tl - i01) : -INFINITY;
                lg[2] = (kb0 + 2 < ns) ? s0.z * LOG2E - slope2 * (float)(tl - i02) : -INFINITY;
                lg[3] = (kb0 + 3 < ns) ? s0.w * LOG2E - slope2 * (float)(tl - i03) : -INFINITY;
                lg[4] = (kb1 + 0 < ns) ? s1.x * LOG2E - slope2 * (float)(tl - i10) : -INFINITY;
                lg[5] = (kb1 + 1 < ns) ? s1.y * LOG2E - slope2 * (float)(tl - i11) : -INFINITY;
                lg[6] = (kb1 + 2 < ns) ? s1.z * LOG2E - slope2 * (float)(tl - i12) : -INFINITY;
                lg[7] = (kb1 + 3 < ns) ? s1.w * LOG2E - slope2 * (float)(tl - i13) : -INFINITY;
            }
            const float cm = fmaxf(fmaxf(fmaxf(lg[0], lg[1]), fmaxf(lg[2], lg[3])), fmaxf(fmaxf(lg[4], lg[5]), fmaxf(lg[6], lg[7])));
            if (j == 0) { float cx = fmaxf(cm, __shfl_xor(cm, 16)); m = fmaxf(cx, __shfl_xor(cx, 32)); }
            else if (__any(cm > m + 8.0f)) {
                float cx = fmaxf(cm, __shfl_xor(cm, 16)); cx = fmaxf(cx, __shfl_xor(cx, 32));
                const float mn = fmaxf(m, cx);
                const float sc = __builtin_amdgcn_exp2f(m - mn);
                l *= sc;
#pragma unroll
                for (int ut = 0; ut < 8; ++ut) { Oe[ut] *= sc; Oo[ut] *= sc; }
                m = mn;
            }
            float p[8]; float ps = 0.f;
#pragma unroll
            for (int i = 0; i < 8; ++i) { p[i] = __builtin_amdgcn_exp2f(lg[i] - m); ps += p[i]; }
            l += ps;
            int pw0 = __builtin_amdgcn_cvt_pk_fp8_f32(p[0], p[1], 0, false); pw0 = __builtin_amdgcn_cvt_pk_fp8_f32(p[2], p[3], pw0, true);
            int pw1 = __builtin_amdgcn_cvt_pk_fp8_f32(p[4], p[5], 0, false); pw1 = __builtin_amdgcn_cvt_pk_fp8_f32(p[6], p[7], pw1, true);
            const long pk = __builtin_bit_cast(long, (u32x2){(unsigned)pw0, (unsigned)pw1});
#pragma unroll
            for (int hb = 0; hb < 2; ++hb) {
                if (hb == 1) {
#pragma unroll
                    for (int u4 = 0; u4 < 4; ++u4) { const int ut = 4 + u4; const LAS unsigned char* pt = img + ((ST ^ (unsigned)(ut << 5)) + baseT);
                        tl_[u4] = __builtin_bit_cast(u32x2, __builtin_amdgcn_ds_read_tr16_b64_v4i16((LAS v4i16_t*)(pt)));
                        th_[u4] = __builtin_bit_cast(u32x2, __builtin_amdgcn_ds_read_tr16_b64_v4i16((LAS v4i16_t*)(pt + 4096))); }
                    __builtin_amdgcn_sched_barrier(0);
                }
#pragma unroll
                for (int u4 = 0; u4 < 4; ++u4) { const int ut = hb * 4 + u4;
                    const u32x2 lw = tl_[u4], hw = th_[u4];
                    u32x2 ae, ao;
                    ae.x = __builtin_amdgcn_perm(lw.y, lw.x, 0x06040200u); ae.y = __builtin_amdgcn_perm(hw.y, hw.x, 0x06040200u);
                    ao.x = __builtin_amdgcn_perm(lw.y, lw.x, 0x07050301u); ao.y = __builtin_amdgcn_perm(hw.y, hw.x, 0x07050301u);
                    Oe[ut] = __builtin_amdgcn_mfma_f32_16x16x32_bf8_fp8(__builtin_bit_cast(long, ae), pk, Oe[ut], 0, 0, 0);
                    Oo[ut] = __builtin_amdgcn_mfma_f32_16x16x32_bf8_fp8(__builtin_bit_cast(long, ao), pk, Oo[ut], 0, 0, 0);
                }
                __builtin_amdgcn_sched_barrier(0);
            }
            if (j + 2 < nch) { asm volatile("s_waitcnt lgkmcnt(0)" ::: "memory"); ATT_DMA(j + 2, bo);
                if (j + 3 == nch) { if (have_item) { tr_load(titem, lane, tcur); trf = true; } ATT_PREFETCH(); } }
        }
#undef ATT_DMA
#undef ATT_PREFETCH
        l += __shfl_xor(l, 16); l += __shfl_xor(l, 32);
        const float inv = 1.0f / l;
        bf16_t* orow = (DRY ? (bf16_t*)(P.ws + WS_PP) + (size_t)(t & 8191) * 4096 : OLAT + (size_t)t * 4096) + fr * 256 + 8 * fq;
#pragma unroll
        for (int ut = 0; ut < 8; ++ut) {
            u32x4 w; w.x = pk2(Oe[ut].x * inv, Oo[ut].x * inv); w.y = pk2(Oe[ut].y * inv, Oo[ut].y * inv); w.z = pk2(Oe[ut].z * inv, Oo[ut].z * inv); w.w = pk2(Oe[ut].w * inv, Oo[ut].w * inv);
            *(u32x4*)(orow + 32 * ut) = w;
        }
        if (have_item) { asm volatile("s_waitcnt lgkmcnt(0)" ::: "memory"); tr_store(titem, (float*)(lds_ + wave * 16896), lane, tcur); ditem += NGW; }
    }
    for (; ditem < N_DEFERRED; ditem += NGW) { const TrItem t = deferred_item(P, ditem); float tmp[32]; tr_load(t, lane, tmp); tr_store(t, (float*)(lds_ + wave * 16896), lane, tmp); }
}

constexpr size_t SC_BATCH = (size_t)1024 * 256 * 257 / 2;
__device__ __forceinline__ size_t sc_row_off(int b, int tl) { const size_t m = (size_t)(tl >> 5); return (size_t)b * SC_BATCH + 1024 * (m * (m + 1) / 2) + (size_t)(tl & 31) * 32 * (m + 1); }
typedef float f32x16 __attribute__((ext_vector_type(16)));
__device__ __forceinline__ unsigned okey_pk(float a, float b) {
    const unsigned w = __builtin_bit_cast(unsigned, __builtin_amdgcn_cvt_pkrtz(a, b));
    const unsigned neg = (w >> 15) & 0x00010001u;
    return w ^ ((neg * 0xffffu) | 0x80008000u);
}
__device__ __forceinline__ void phase_index_scores(const Params& P, unsigned char* lds_) {
    using pg8::bf16x8;
    const bf16_t* Z1 = (const bf16_t*)(P.ws + WS_Z1); unsigned short* SC = (unsigned short*)(P.ws + WS_SC);
    LAS unsigned char* lds = (LAS unsigned char*)lds_;
    constexpr int QROW = 144;
    LAS unsigned char* QL = lds;
    LAS float* SG = (LAS float*)(lds + 9 * 64 * QROW);
    const int tid = threadIdx.x, lane = tid & 63, wave = __builtin_amdgcn_readfirstlane(tid >> 6);
    LAS unsigned char* ST = lds + 9 * 64 * QROW + 2048 + wave * 5120;
    const int l31 = lane & 31, hh = lane >> 5;
    for (int pid = blockIdx.x; pid < 256; pid += gridDim.x) {
        const int b = pid >> 6;
        for (int side = 0; side < 2; ++side) {
            const int qb = side ? (127 - (pid & 63)) : (pid & 63);
            const int q0 = qb * 64;
            __syncthreads();
            {
                const int qi = tid >> 3, part = tid & 7;
                const bf16_t* zr = Z1 + ((size_t)b * SEQ + q0 + qi) * Z1W;
                const u32x4 ww = *(const u32x4*)(zr + 1088);
                const float w8[8] = {bflo(ww.x), bfhi(ww.x), bflo(ww.y), bfhi(ww.y), bflo(ww.z), bfhi(ww.z), bflo(ww.w), bfhi(ww.w)};
                float wh = 0.f;
#pragma unroll
                for (int h = 0; h < 8; ++h) wh = (h == part) ? w8[h] : wh;
                const float sc = 0.5f * fabsf(wh);
                SG[qi * 8 + part] = (wh >= 0.f) ? 1.0f : -1.0f;
#pragma unroll
                for (int c = 0; c < 8; ++c) {
                    const u32x4 v = *(const u32x4*)(zr + 512 + part * 64 + c * 8);
                    u32x4 o; o.x = pk2(bflo(v.x) * sc, bfhi(v.x) * sc); o.y = pk2(bflo(v.y) * sc, bfhi(v.y) * sc); o.z = pk2(bflo(v.z) * sc, bfhi(v.z) * sc); o.w = pk2(bflo(v.w) * sc, bfhi(v.w) * sc);
                    *(LAS u32x4*)(QL + (part * 64 + qi) * QROW + c * 16) = o;
                }
                float a8[8];
#pragma unroll
                for (int j = 0; j < 8; ++j) a8[j] = 0.f;
#pragma unroll
                for (int h = 0; h < 8; ++h) {
                    const u32x4 v = *(const u32x4*)(zr + 512 + h * 64 + part * 8); const float s2 = 0.5f * w8[h];
                    a8[0] += s2 * bflo(v.x); a8[1] += s2 * bfhi(v.x); a8[2] += s2 * bflo(v.y); a8[3] += s2 * bfhi(v.y);
                    a8[4] += s2 * bflo(v.z); a8[5] += s2 * bfhi(v.z); a8[6] += s2 * bflo(v.w); a8[7] += s2 * bfhi(v.w);
                }
                u32x4 o; o.x = pk2(a8[0], a8[1]); o.y = pk2(a8[2], a8[3]); o.z = pk2(a8[4], a8[5]); o.w = pk2(a8[6], a8[7]);
                *(LAS u32x4*)(QL + (8 * 64 + qi) * QROW + part * 16) = o;
            }
            __syncthreads();
            const int ktmax = 2 * qb + 1;
            bf16x8 kn[4];
            {   const bf16_t* kr = Z1 + ((size_t)b * SEQ + min(wave, ktmax) * 32 + l31) * Z1W + 1024 + hh * 8;
#pragma unroll
                for (int dq = 0; dq < 4; ++dq) kn[dq] = *(const bf16x8*)(kr + dq * 16); }
            for (int kt = wave; kt <= ktmax; kt += NWAVE) {
                bf16x8 kf[4];
#pragma unroll
                for (int dq = 0; dq < 4; ++dq) kf[dq] = kn[dq];
                {   const bf16_t* kr = Z1 + ((size_t)b * SEQ + min(kt + NWAVE, ktmax) * 32 + l31) * Z1W + 1024 + hh * 8;
#pragma unroll
                    for (int dq = 0; dq < 4; ++dq) kn[dq] = *(const bf16x8*)(kr + dq * 16); }
#pragma unroll
                for (int qs = 0; qs < 2; ++qs) {
                    const LAS unsigned char* qrow = QL + (qs * 32 + l31) * QROW + hh * 16;
                    const LAS float* sgp = SG + (qs * 32 + l31) * 8;
                    bf16x8 fc[4], fn[4];
#pragma unroll
                    for (int dq = 0; dq < 4; ++dq) fc[dq] = *(const LAS bf16x8*)(qrow + 8 * 64 * QROW + dq * 32);
#pragma unroll
                    for (int dq = 0; dq < 4; ++dq) fn[dq] = *(const LAS bf16x8*)(qrow + dq * 32);
                    const f32x4 sg03 = *(const LAS f32x4*)(sgp), sg47 = *(const LAS f32x4*)(sgp + 4);
                    f32x16 acc;
#pragma unroll
                    for (int r = 0; r < 16; ++r) acc[r] = 0.f;
#pragma unroll
                    for (int dq = 0; dq < 4; ++dq) acc = __builtin_amdgcn_mfma_f32_32x32x16_bf16(kf[dq], fc[dq], acc, 0, 0, 0);
                    f32x16 up;
#pragma unroll
                    for (int h = 0; h < 8; ++h) {
#pragma unroll
                        for (int dq = 0; dq < 4; ++dq) fc[dq] = fn[dq];
                        if (h < 7) {
#pragma unroll
                            for (int dq = 0; dq < 4; ++dq) fn[dq] = *(const LAS bf16x8*)(qrow + (h + 1) * 64 * QROW + dq * 32);
                        }
                        f32x16 u;
#pragma unroll
                        for (int r = 0; r < 16; ++r) u[r] = 0.f;
#pragma unroll
                        for (int dq = 0; dq < 4; ++dq) u = __builtin_amdgcn_mfma_f32_32x32x16_bf16(kf[dq], fc[dq], u, 0, 0, 0);
                        __builtin_amdgcn_sched_barrier(0);
                        if (h > 0) {
                            const float sg = (h - 1 < 4) ? sg03[(h - 1) & 3] : sg47[(h - 1) & 3];
#pragma unroll
                            for (int r = 0; r < 16; ++r) acc[r] = fmaf(fabsf(up[r]), sg, acc[r]);
                        }
                        __builtin_amdgcn_sched_barrier(0);
                        up = u;
                    }
                    {
                        const float sg = sg47[3];
#pragma unroll
                        for (int r = 0; r < 16; ++r) acc[r] = fmaf(fabsf(up[r]), sg, acc[r]);
                    }
#pragma unroll
                    for (int g = 0; g < 4; ++g) { u32x2 w; w.x = okey_pk(acc[4 * g], acc[4 * g + 1]); w.y = okey_pk(acc[4 * g + 2], acc[4 * g + 3]);
                        *(LAS u32x2*)(ST + (qs * 32 + l31) * 80 + (8 * g + 4 * hh) * 2) = w; }
                }
#pragma unroll
                for (int i = 0; i < 4; ++i) {
                    const int row = 16 * i + (lane >> 2), ch = lane & 3, tl = q0 + row;
                    const u32x4 v = *(const LAS u32x4*)(ST + row * 80 + ch * 16);
                    if (kt <= (tl >> 5)) *(u32x4*)(SC + sc_row_off(b, tl) + (size_t)kt * 32 + ch * 8) = v;
                }
            }
        }
    }
}
template <int MODE>
__device__ __forceinline__ void phase_index_select(const Params& P, unsigned char* lds_) {
    const unsigned short* SC = (const unsigned short*)(P.ws + WS_SC); unsigned short* SEL = (unsigned short*)(P.ws + WS_SEL);
    const int tid = threadIdx.x, lane = tid & 63, wave = __builtin_amdgcn_readfirstlane(tid >> 6);
    LAS unsigned char* wbase = (LAS unsigned char*)lds_ + wave * 19456;
    LAS u32x4* rowbuf = (LAS u32x4*)wbase;
    LAS unsigned* hist = (LAS unsigned*)(wbase + 16384);
    LAS unsigned* dummy = hist + 512 + lane;
    LAS unsigned short* outw = (LAS unsigned short*)(wbase + 16384 + 2048 + 256);
    LAS unsigned short* dummy16 = outw + 256 + lane;
    const unsigned rowbuf0 = (unsigned)(unsigned long)wbase;
    const int gw = blockIdx.x * NWAVE + wave, NGW = gridDim.x * NWAVE;
#define SEL_DMA(tt) do { const int _tl = (tt) & (SEQ - 1), _n = _tl + 1; if (_n > TOPK) { const unsigned char* _src = (const unsigned char*)(SC + sc_row_off((tt) >> 13, _tl)) + lane * 16; \
            for (int _sg = 0; _sg * 512 < _n; ++_sg) glds16(_src + _sg * 1024, (unsigned)__builtin_amdgcn_readfirstlane((int)(rowbuf0 + _sg * 1024))); } } while (0)
#define SEL_Q(i) ((i) * NGW + (((i) & 1) ? (NGW - 1 - gw) : gw))
    if (SEL_Q(0) < NTOK) SEL_DMA(SEL_Q(0));
    for (int qi = 0; qi * NGW < NTOK; ++qi) {
        const int t = SEL_Q(qi), tnext = SEL_Q(qi + 1);
        if (t >= NTOK) { if (tnext < NTOK) SEL_DMA(tnext); continue; }
        const int tl = t & (SEQ - 1), n = tl + 1;
        unsigned short* so = SEL + (size_t)t * TOPK;
        if (n <= TOPK) { for (int i = lane; i < n; i += 64) so[i] = (unsigned short)i; if (tnext < NTOK && (qi + 1) * NGW < NTOK) SEL_DMA(tnext); continue; }
        asm volatile("s_waitcnt vmcnt(0)" ::: "memory");
        u32x4 d[16];
        const int lastsg = (n - 1) >> 9;
#pragma unroll
        for (int sg = 0; sg < 16; ++sg) {
            if (sg * 512 < n) {
                d[sg] = rowbuf[sg * 64 + lane];
                if (sg == lastsg) {
#pragma unroll
                    for (int q = 0; q < 4; ++q) { const int i0 = sg * 512 + lane * 8 + 2 * q;
                        d[sg][q] &= ((i0 < n) ? 0x0000ffffu : 0u) | ((i0 + 1 < n) ? 0xffff0000u : 0u); }
                }
            } else d[sg] = (u32x4){0u, 0u, 0u, 0u};
        }
        asm volatile("s_waitcnt lgkmcnt(0)" ::: "memory");
        if (tnext < NTOK && (qi + 1) * NGW < NTOK) SEL_DMA(tnext);
#pragma unroll
        for (int i = 0; i < 8; ++i) { hist[i * 64 + lane] = 0u; }
        asm volatile("s_waitcnt lgkmcnt(0)" ::: "memory");
        LAS unsigned* myh = hist + (lane & 1) * 256;
        if (MODE == 4) { if (d[0].x == 0x12345u) so[lane] = 1; continue; }
#pragma unroll
        for (int sg = 0; sg < 16; ++sg) if (MODE != 1 && sg * 512 < n) {
#pragma unroll
            for (int q = 0; q < 4; ++q) { const unsigned w = d[sg][q];
                __hip_atomic_fetch_add(myh + ((w >> 8) & 0xffu), 1u, __ATOMIC_RELAXED, __HIP_MEMORY_SCOPE_WORKGROUP);
                __hip_atomic_fetch_add(myh + (w >> 24), 1u, __ATOMIC_RELAXED, __HIP_MEMORY_SCOPE_WORKGROUP); }
        }
        asm volatile("s_waitcnt lgkmcnt(0)" ::: "memory");
        unsigned b1, need1;
        {
            unsigned c[4];
#pragma unroll
            for (int q = 0; q < 4; ++q) c[q] = hist[4 * lane + q] + hist[256 + 4 * lane + q];
            const unsigned mine = c[0] + c[1] + c[2] + c[3];
            unsigned suf = mine;
#pragma unroll
            for (int o = 1; o < 64; o <<= 1) { const unsigned v = __shfl_down(suf, o); if (lane + o < 64) suf += v; }
            const unsigned above = suf - mine;
            int fb = -1; unsigned fneed = 0;
            if (above < (unsigned)TOPK && suf >= (unsigned)TOPK) { unsigned a = above;
#pragma unroll
                for (int q = 3; q >= 0; --q) { if (fb < 0 && a + c[q] >= (unsigned)TOPK) { fb = 4 * lane + q; fneed = (unsigned)TOPK - a; } a += c[q]; } }
            const unsigned long long bal = __ballot(fb >= 0);
            const int src = (int)__builtin_ctzll(bal);
            b1 = (unsigned)__shfl(fb, src); need1 = __shfl(fneed, src);
        }
#pragma unroll
        for (int i = 0; i < 8; ++i) { hist[i * 64 + lane] = 0u; }
        asm volatile("s_waitcnt lgkmcnt(0)" ::: "memory");
#pragma unroll
        for (int sg = 0; sg < 16; ++sg) if (MODE != 2 && sg * 512 < n) {
#pragma unroll
            for (int q = 0; q < 4; ++q) { const unsigned w = d[sg][q];
                LAS unsigned* p0 = (((w >> 8) & 0xffu) == b1) ? (myh + (w & 0xffu)) : dummy;
                LAS unsigned* p1 = ((w >> 24) == b1) ? (myh + ((w >> 16) & 0xffu)) : dummy;
                __hip_atomic_fetch_add(p0, 1u, __ATOMIC_RELAXED, __HIP_MEMORY_SCOPE_WORKGROUP);
                __hip_atomic_fetch_add(p1, 1u, __ATOMIC_RELAXED, __HIP_MEMORY_SCOPE_WORKGROUP); }
        }
        asm volatile("s_waitcnt lgkmcnt(0)" ::: "memory");
        unsigned T, need2;
        {
            unsigned c[4];
#pragma unroll
            for (int q = 0; q < 4; ++q) c[q] = hist[4 * lane + q] + hist[256 + 4 * lane + q];
            const unsigned mine = c[0] + c[1] + c[2] + c[3];
            unsigned suf = mine;
#pragma unroll
            for (int o = 1; o < 64; o <<= 1) { const unsigned v = __shfl_down(suf, o); if (lane + o < 64) suf += v; }
            const unsigned above = suf - mine;
            int fb = -1; unsigned fneed = 0;
            if (above < need1 && suf >= need1) { unsigned a = above;
#pragma unroll
                for (int q = 3; q >= 0; --q) { if (fb < 0 && a + c[q] >= need1) { fb = 4 * lane + q; fneed = need1 - a; } a += c[q]; } }
            const unsigned long long bal = __ballot(fb >= 0);
            const int src = (int)__builtin_ctzll(bal);
            T = (b1 << 8) | (unsigned)__shfl(fb, src); need2 = __shfl(fneed, src);
        }
        unsigned base = 0; const unsigned ngt = (unsigned)TOPK - need2; unsigned eqbase = 0;
#pragma unroll
        for (int sg = 0; sg < 16; ++sg) if (MODE != 3 && sg * 512 < n) {
            unsigned ce = 0;
#pragma unroll
            for (int j = 0; j < 8; ++j) {
                const unsigned k = (j & 1) ? (d[sg][j >> 1] >> 16) : (d[sg][j >> 1] & 0xffffu);
                const bool gt = k > T;
                const unsigned long long mk = __ballot(gt);
                const unsigned pos = base + (unsigned)__builtin_amdgcn_mbcnt_hi((unsigned)(mk >> 32), __builtin_amdgcn_mbcnt_lo((unsigned)mk, 0u));
                LAS unsigned short* po = gt ? (outw + pos) : dummy16;
                *po = (unsigned short)(sg * 512 + lane * 8 + j);
                base += (unsigned)__builtin_popcountll(mk);
                ce += (k == T) ? 1u : 0u;
            }
            if (__any(ce > 0u)) {
                unsigned pre = ce;
#pragma unroll
                for (int o = 1; o < 64; o <<= 1) { const unsigned v = __shfl_up(pre, o); if (lane >= o) pre += v; }
                unsigned r = eqbase + pre - ce;
#pragma unroll
                for (int j = 0; j < 8; ++j) { const unsigned k = (j & 1) ? (d[sg][j >> 1] >> 16) : (d[sg][j >> 1] & 0xffffu);
                    if (k == T) { if (r < need2) outw[ngt + r] = (unsigned short)(sg * 512 + lane * 8 + j); ++r; } }
                eqbase += __shfl(pre, 63);
            }
        }
        asm volatile("s_waitcnt lgkmcnt(0)" ::: "memory");
        ((unsigned*)so)[lane] = ((LAS unsigned*)outw)[lane];
        ((unsigned*)so)[64 + lane] = ((LAS unsigned*)outw)[64 + lane];
        asm volatile("s_waitcnt lgkmcnt(0)" ::: "memory");
    }
#undef SEL_DMA
#undef SEL_Q
    asm volatile("s_waitcnt vmcnt(0)" ::: "memory");
}

__device__ __forceinline__ void ret_fill_image(LAS unsigned char* img, const unsigned char* src, size_t row_stride_bytes, int wave, int lane) {
#pragma unroll
    for (int e4 = 0; e4 < 4; ++e4) {
        const int e = wave * 4 + e4, row = 4 * e + (lane >> 4), q = (lane & 15) ^ ((row & 7) << 1);
        __builtin_amdgcn_global_load_lds((const unsigned*)(src + (size_t)row * row_stride_bytes + q * 16), (LAS unsigned*)(img + e * 1024), 16, 0, 0);
    }
}
__device__ __forceinline__ pg8::bf16x8 ret_tr_pair(const LAS unsigned char* img, int row0, int chunk2, int lane) {
    const int g = lane >> 4, i = lane & 15, r0 = row0 + 4 * g + (i >> 2), pb = (i & 3) >> 1, half = (i & 1) * 8;
    const int r1 = r0 + 16;
    const v4i16_t lo = __builtin_amdgcn_ds_read_tr16_b64_v4i16((LAS v4i16_t*)(img + r0 * 256 + ((((chunk2) ^ ((r0 & 7) << 1)) | pb) << 4) + half));
    const v4i16_t hi = __builtin_amdgcn_ds_read_tr16_b64_v4i16((LAS v4i16_t*)(img + r1 * 256 + ((((chunk2) ^ ((r1 & 7) << 1)) | pb) << 4) + half));
    return (pg8::bf16x8){lo[0], lo[1], lo[2], lo[3], hi[0], hi[1], hi[2], hi[3]};
}
__device__ __forceinline__ void phase_ret_kv_mfma(const Params& P, unsigned char* lds_) {
    using pg8::bf16x8;
    const unsigned char* Z0 = (const unsigned char*)(P.ws + WS_Z0); float* KV = (float*)(P.ws + WS_KV);
    LAS unsigned char* Kimg = (LAS unsigned char*)lds_; LAS unsigned char* Vimg = Kimg + 32768;
    const int tid = threadIdx.x, lane = tid & 63, wave = __builtin_amdgcn_readfirstlane(tid >> 6), fr = lane & 15, fq = lane >> 4;
    for (int u = blockIdx.x; u < 1024; u += gridDim.x) {
        const int n = u & 63, h = (u >> 6) & 3, b = u >> 8;
        const size_t row0 = (size_t)b * SEQ + n * 128;
        __syncthreads();
        ret_fill_image(Kimg, Z0 + row0 * ZW * 2 + (512 + h * 128) * 2, ZW * 2, wave, lane);
        ret_fill_image(Vimg, Z0 + row0 * ZW * 2 + (1024 + h * 128) * 2, ZW * 2, wave, lane);
        asm volatile("s_waitcnt vmcnt(0)" ::: "memory");
        __syncthreads();
        bf16x8 va[4];
#pragma unroll
        for (int jc = 0; jc < 4; ++jc) va[jc] = ret_tr_pair(Vimg, 32 * jc, 2 * wave, lane);
        const float g127 = exp2f(ret_log2g(h) * 127.0f);
        float* o = KV + (size_t)u * 16384;
#pragma unroll
        for (int dt = 0; dt < 8; ++dt) {
            f32x4 acc = {0.f, 0.f, 0.f, 0.f};
#pragma unroll
            for (int jc = 0; jc < 4; ++jc) acc = __builtin_amdgcn_mfma_f32_16x16x32_bf16(va[jc], ret_tr_pair(Kimg, 32 * jc, 2 * dt, lane), acc, 0, 0, 0);
            *(f32x4*)(o + (size_t)(16 * dt + fr) * 128 + 16 * wave + 4 * fq) = acc * g127;
        }
    }
}
__device__ __forceinline__ void phase_ret_scan_pool2(const Params& P) {
    const float* KV = (const float*)(P.ws + WS_KV); bf16_t* SB = (bf16_t*)(P.ws + WS_SB);
    const size_t gt = (size_t)blockIdx.x * NT + threadIdx.x, GS = (size_t)gridDim.x * NT;
    for (size_t i = gt; i < (size_t)16 * 8192; i += GS) {
        const int s = (int)(i >> 13), e2 = (int)(i & 8191), h = s & 3;
        const float l2 = ret_log2g(h), cd = exp2f(l2 * 128.0f), g1 = exp2f(l2);
        typedef float f32x2v __attribute__((ext_vector_type(2)));
        const f32x2v* p = (const f32x2v*)(KV + (size_t)s * 64 * 16384) + e2;
        unsigned* q = (unsigned*)(SB + (size_t)s * 64 * 16384) + e2;
        f32x2v R = {0.f, 0.f};
        for (int n0 = 0; n0 < 64; n0 += 16) {
            f32x2v kv[16];
#pragma unroll
            for (int j = 0; j < 16; ++j) kv[j] = __builtin_nontemporal_load(p + (size_t)(n0 + j) * 8192);
#pragma unroll
            for (int j = 0; j < 16; ++j) { q[(size_t)(n0 + j) * 8192] = pk2(R.x * g1, R.y * g1); R = R * cd + kv[j]; }
        }
    }
    const bf16_t* Z0 = (const bf16_t*)(P.ws + WS_Z0); bf16_t* DP = (bf16_t*)(P.ws + WS_DP);
    for (size_t i = gt; i < (size_t)NTOK * 64; i += GS) {
        const int t = (int)(i >> 6), c8 = (int)(i & 63) * 8, g = c8 >> 7, w = 2 << g, tl = t & (SEQ - 1);
        const int cnt = min(tl + 1, w);
        float sm[8];
#pragma unroll
        for (int j = 0; j < 8; ++j) sm[j] = 0.f;
        float u0[8];
        for (int q = 0; q < cnt; ++q) {
            const u32x4 v = *(const u32x4*)(Z0 + (size_t)(t - q) * ZW + 2048 + c8);
            const float f[8] = {bflo(v.x), bfhi(v.x), bflo(v.y), bfhi(v.y), bflo(v.z), bfhi(v.z), bflo(v.w), bfhi(v.w)};
#pragma unroll
            for (int j = 0; j < 8; ++j) { sm[j] += f[j]; if (q == 0) u0[j] = f[j]; }
        }
        const float inv = 1.0f / (float)cnt;
        u32x4 o; o.x = pk2(sm[0] * inv - u0[0], sm[1] * inv - u0[1]); o.y = pk2(sm[2] * inv - u0[2], sm[3] * inv - u0[3]);
        o.z = pk2(sm[4] * inv - u0[4], sm[5] * inv - u0[5]); o.w = pk2(sm[6] * inv - u0[6], sm[7] * inv - u0[7]);
        *(u32x4*)(DP + (size_t)t * 512 + c8) = o;
    }
}
__device__ __forceinline__ void phase_ret_out_mfma(const Params& P, unsigned char* lds_) {
    using pg8::bf16x8;
    const unsigned char* Z0 = (const unsigned char*)(P.ws + WS_Z0); const unsigned char* SB = (const unsigned char*)(P.ws + WS_SB); bf16_t* MIX = (bf16_t*)(P.ws + WS_MIX);
    const float* gn = P.in[3];
    LAS unsigned char* Kimg = (LAS unsigned char*)lds_; LAS unsigned char* Vimg = Kimg + 32768; LAS unsigned char* Rimg = Kimg + 65536;
    const int tid = threadIdx.x, lane = tid & 63, wave = __builtin_amdgcn_readfirstlane(tid >> 6), fr = lane & 15, fq = lane >> 4;
    for (int u = blockIdx.x; u < 1024; u += gridDim.x) {
        const int n = u & 63, h = (u >> 6) & 3, b = u >> 8;
        const size_t row0 = (size_t)b * SEQ + n * 128;
        __syncthreads();
        ret_fill_image(Kimg, Z0 + row0 * ZW * 2 + (512 + h * 128) * 2, ZW * 2, wave, lane);
        ret_fill_image(Vimg, Z0 + row0 * ZW * 2 + (1024 + h * 128) * 2, ZW * 2, wave, lane);
        ret_fill_image(Rimg, SB + (size_t)u * 32768, 256, wave, lane);
        const bf16_t* qrow = (const bf16_t*)Z0 + (row0 + 16 * wave + fr) * ZW + h * 128;
        bf16x8 qf[4], qr[4];
#pragma unroll
        for (int c = 0; c < 4; ++c) {
            qf[c] = *(const bf16x8*)(qrow + 32 * c + 8 * fq);
            const u32x2 a = *(const u32x2*)(qrow + 32 * c + 4 * fq), bb = *(const u32x2*)(qrow + 32 * c + 16 + 4 * fq);
            u32x4 w; w.x = a.x; w.y = a.y; w.z = bb.x; w.w = bb.y; qr[c] = __builtin_bit_cast(bf16x8, w);
        }
        asm volatile("s_waitcnt vmcnt(0)" ::: "memory");
        __syncthreads();
        f32x4 sT[8];
#pragma unroll
        for (int jt = 0; jt < 8; ++jt) sT[jt] = (f32x4){0.f, 0.f, 0.f, 0.f};
#pragma unroll
        for (int jt = 0; jt < 8; ++jt) if (jt <= wave) {
            const int r = 16 * jt + fr;
#pragma unroll
            for (int c = 0; c < 4; ++c) {
                const bf16x8 a = *(const LAS bf16x8*)(Kimg + r * 256 + ((((4 * c + fq)) ^ ((r & 7) << 1)) << 4));
                sT[jt] = __builtin_amdgcn_mfma_f32_16x16x32_bf16(a, qf[c], sT[jt], 0, 0, 0);
            }
            if (jt == wave) {
                if (4 * fq + 0 > fr) sT[jt].x = 0.f; if (4 * fq + 1 > fr) sT[jt].y = 0.f; if (4 * fq + 2 > fr) sT[jt].z = 0.f; if (4 * fq + 3 > fr) sT[jt].w = 0.f;
            }
        }
        bf16x8 pT[4];
#pragma unroll
        for (int jp = 0; jp < 4; ++jp) { u32x4 w; w.x = pk2(sT[2 * jp].x, sT[2 * jp].y); w.y = pk2(sT[2 * jp].z, sT[2 * jp].w); w.z = pk2(sT[2 * jp + 1].x, sT[2 * jp + 1].y); w.w = pk2(sT[2 * jp + 1].z, sT[2 * jp + 1].w);
            pT[jp] = __builtin_bit_cast(bf16x8, w); }
        f32x4 O[8];
#pragma unroll
        for (int vt = 0; vt < 8; ++vt) {
            f32x4 acc = {0.f, 0.f, 0.f, 0.f};
#pragma unroll
            for (int jp = 0; jp < 4; ++jp) if (2 * jp <= wave) acc = __builtin_amdgcn_mfma_f32_16x16x32_bf16(ret_tr_pair(Vimg, 32 * jp, 2 * vt, lane), pT[jp], acc, 0, 0, 0);
#pragma unroll
            for (int c = 0; c < 4; ++c) acc = __builtin_amdgcn_mfma_f32_16x16x32_bf16(ret_tr_pair(Rimg, 32 * c, 2 * vt, lane), qr[c], acc, 0, 0, 0);
            O[vt] = acc;
        }
        float sm = 0.f;
#pragma unroll
        for (int vt = 0; vt < 8; ++vt) sm += (O[vt].x + O[vt].y) + (O[vt].z + O[vt].w);
        sm += __shfl_xor(sm, 16); sm += __shfl_xor(sm, 32);
        const float mu = sm * (1.0f / 128.0f);
        float sq = 0.f;
#pragma unroll
        for (int vt = 0; vt < 8; ++vt) { const f32x4 dlt = O[vt] - mu; sq += (dlt.x * dlt.x + dlt.y * dlt.y) + (dlt.z * dlt.z + dlt.w * dlt.w); }
        sq += __shfl_xor(sq, 16); sq += __shfl_xor(sq, 32);
        const float rstd = 1.0f / sqrtf(sq * (1.0f / 128.0f) + LN_EPS);
        const bf16_t* grow = (const bf16_t*)Z0 + (row0 + 16 * wave + fr) * ZW + 1536 + h * 128 + 4 * fq;
        bf16_t* orow = MIX + (row0 + 16 * wave + fr) * DM + h * 128 + 4 * fq;
#pragma unroll
        for (int vt = 0; vt < 8; ++vt) {
            const u32x2 gv = *(const u32x2*)(grow + 16 * vt);
            const f32x4 g4 = *(const f32x4*)(gn + h * 128 + 16 * vt + 4 * fq);
            const f32x4 y = (O[vt] - mu) * rstd * g4;
            u32x2 w; w.x = pk2(y.x * silu_f(bflo(gv.x)), y.y * silu_f(bfhi(gv.x))); w.y = pk2(y.z * silu_f(bflo(gv.y)), y.w * silu_f(bfhi(gv.y)));
            *(u32x2*)(orow + 16 * vt) = w;
        }
    }
}

#define XB_TMO      128
#define XB_XCNT(j)  (256  + 64 * (j))
#define XB_XSUB(j)  (1280 + 64 * (j))
#define XB_XGEN(j)  (2304 + 64 * (j))
#define XB_TOP      3328
#define XB_TOPGEN   3392
#define XCD_BAR_WORDS 3456
#define XB_SPIN_CAP (1u << 22)
__device__ __forceinline__ unsigned xb_ld(unsigned* p)              { return __hip_atomic_load(p, __ATOMIC_RELAXED, __HIP_MEMORY_SCOPE_AGENT); }
__device__ __forceinline__ unsigned xb_add(unsigned* p, unsigned v) { return __hip_atomic_fetch_add(p, v, __ATOMIC_RELAXED, __HIP_MEMORY_SCOPE_AGENT); }
__device__ __forceinline__ unsigned xb_xcc_id() { return (unsigned)__builtin_amdgcn_s_getreg((3 << 11) | 20) & 0xFu; }
#define XB_SPIN(cond, bar) do { unsigned _sp = 0; while (cond) { __builtin_amdgcn_s_sleep(1); \
    if ((++_sp & 255u) == 0u) { if (xb_ld(&(bar)[XB_TMO])) break; if (_sp > XB_SPIN_CAP) { atomicAdd(&(bar)[XB_TMO], 1u); break; } } } } while (0)
struct XcdBarrier { unsigned* bar; unsigned x; volatile LAS unsigned* st; };
__device__ __forceinline__ XcdBarrier xcd_barrier_post(unsigned* bar, volatile LAS unsigned* st) {
    XcdBarrier b; b.bar = bar; b.x = xb_xcc_id(); b.st = st;
    if (threadIdx.x == 0) (void)xb_add(&bar[XB_XCNT(b.x)], 1u);
    return b;
}
__device__ __forceinline__ void xcd_barrier_complete(unsigned* bar, unsigned x, unsigned& nloc, unsigned& nx) {
    const unsigned G = gridDim.x * gridDim.y * gridDim.z;
    unsigned sum, cnt, mine, sp = 0u;
    for (;;) {
        sum = 0u; cnt = 0u; mine = 0u;
#pragma unroll
        for (unsigned j = 0; j < 16; ++j) { const unsigned c = xb_ld(&bar[XB_XCNT(j)]); sum += c; cnt += (c > 0u) ? 1u : 0u; mine = (j == x) ? c : mine; }
        if (sum == G) break;
        __builtin_amdgcn_s_sleep(1);
        if ((++sp & 255u) == 0u) { if (xb_ld(&bar[XB_TMO])) break; if (sp > XB_SPIN_CAP) { atomicAdd(&bar[XB_TMO], 1u); break; } }
    }
    nloc = mine > 0u ? mine : 1u; nx = cnt > 0u ? cnt : 1u;
}
__device__ __forceinline__ void xcd_barrier(const XcdBarrier& b) {
    asm volatile("s_waitcnt vmcnt(0)" ::: "memory");
    __syncthreads();
    if (threadIdx.x == 0) {
        unsigned* bar = b.bar;
        __builtin_amdgcn_s_waitcnt(0);
        unsigned nloc = b.st[0], nx = b.st[1];
        if (nloc == 0u) { xcd_barrier_complete(bar, b.x, nloc, nx); b.st[0] = nloc; b.st[1] = nx; }
        const unsigned old = xb_add(&bar[XB_XSUB(b.x)], 1u);
        const unsigned gen = old / nloc;
        if (old + 1u == (gen + 1u) * nloc) {
            __builtin_amdgcn_fence(__ATOMIC_RELEASE, "agent");
            asm volatile("s_waitcnt vmcnt(0)" ::: "memory");
            const unsigned og = xb_add(&bar[XB_TOP], 1u);
            const unsigned tg = og / nx;
            if (og + 1u == (tg + 1u) * nx) xb_add(&bar[XB_TOPGEN], 1u);
            else XB_SPIN(xb_ld(&bar[XB_TOPGEN]) == tg, bar);
            __builtin_amdgcn_fence(__ATOMIC_ACQUIRE, "agent");
            xb_add(&bar[XB_XGEN(b.x)], 1u);
            asm volatile("s_waitcnt vmcnt(0)" ::: "memory");
        } else {
            XB_SPIN(xb_ld(&bar[XB_XGEN(b.x)]) == gen, bar);
            __builtin_amdgcn_fence(__ATOMIC_ACQUIRE, "agent");
            asm volatile("s_waitcnt vmcnt(0)" ::: "memory");
        }
    }
    __syncthreads();
}
constexpr size_t CTL_BAR_OFF = 16384;
constexpr size_t CTL_ZERO_BYTES = 65536;

#ifdef PH_ONLY
#define IN(k) ((k) == PH_ONLY)
#else
#define IN(k) (lo <= (k) && (k) < hi)
#endif
#define SEAM(k) do { if (IN(k) && IN((k) + 1)) xcd_barrier(grid); } while (0)
#ifndef PROBE_DUP
#define PROBE_DUP (-1)
#endif
#define REP(k) for (int _rep = 0; _rep < ((PROBE_DUP == (k)) ? 2 : 1); ++_rep)
#define REPS(k) ((PROBE_DUP == 100 + (k)) ? 2 : 1)

template <int LAYER, int BASE>
__device__ __forceinline__ void layer_tail(const Params& P, unsigned char* lds, const XcdBarrier& grid, int lo, int hi) {
    unsigned char* ws = P.ws;
    int* tb = (int*)(lds + MISC_OFF);
    if (IN(BASE)) { if (PROBE_DUP == BASE) phase_ln_route<true>(P, lds, LAYER); phase_ln_route<false>(P, lds, LAYER); }
    SEAM(BASE);
    if (IN(BASE + 1)) REP(BASE + 1) { moe_setup(P, tb, LAYER);
        MoeSched S{tb, (const int*)(ws + WS_CTL) + LAYER * 64, (const int*)(ws + WS_LIST), (const bf16_t*)(ws + WS_XB),
                   (const bf16_t*)(ws + WS_W_GU) + (size_t)LAYER * 32 * DM * DM, DM, (size_t)DM * DM, true};
        EpiGU E{(bf16_t*)(ws + WS_ACT)}; gemm_moe<true>(lds, S, E);
        { const int U = tb[32] * 4, G = (int)gridDim.x, nheavy = (U % G), nlight = G - nheavy, lr = (int)blockIdx.x - nheavy;
          DenseSched S2{(const bf16_t*)(ws + WS_PB) + (size_t)LAYER * NTOK * 256, (const bf16_t*)(ws + WS_W_P) + (size_t)LAYER * DM * 256, NTOK, DM, 256, 256, 0, 1, lr, nlight};
          EpiStoreBf16 E2{(bf16_t*)(ws + WS_PP), DM, 0, nullptr}; gemm_dense(lds, S2, E2); } }
    SEAM(BASE + 1);
    if (IN(BASE + 2)) REP(BASE + 2) { moe_setup(P, tb, LAYER);
        MoeSched S{tb, (const int*)(ws + WS_CTL) + LAYER * 64, (const int*)(ws + WS_LIST), (const bf16_t*)(ws + WS_ACT),
                   (const bf16_t*)(ws + WS_W_DN) + (size_t)LAYER * 32 * DM * 512, 512, (size_t)DM * 512, false};
        EpiDown E{(bf16_t*)(ws + WS_YS)}; gemm_moe<false>(lds, S, E); }
    SEAM(BASE + 2);
    if (IN(BASE + 3)) { if (PROBE_DUP == BASE + 3) phase_ln2<true>(P, LAYER); phase_ln2<false>(P, LAYER); }
    SEAM(BASE + 3);
    if (IN(BASE + 4)) REP(BASE + 4) {
        { DenseSched S{(const bf16_t*)(ws + WS_XB), (const bf16_t*)(ws + WS_W_G) + (size_t)LAYER * DM * DM, NTOK, DM, DM, DM, 0, REPS(BASE + 4)};
          EpiPle E{(const bf16_t*)(ws + WS_XB), (const bf16_t*)(ws + WS_PP), LAYER == 1 ? P.out : (float*)nullptr, LAYER == 1 ? (bf16_t*)nullptr : (bf16_t*)(ws + WS_XB2)}; gemm_dense(lds, S, E); }
    }
}

__global__ void __launch_bounds__(NT, 2) mega(Params P, int lo, int hi) {
    extern __shared__ __attribute__((aligned(16))) unsigned char lds[];
    unsigned char* ws = P.ws;
    if (threadIdx.x < 16) ((LAS unsigned*)((LAS unsigned char*)lds + BARW_OFF))[threadIdx.x] = 0u;
    __syncthreads();
    const XcdBarrier grid = xcd_barrier_post((unsigned*)(ws + WS_CTL + CTL_BAR_OFF), (volatile LAS unsigned*)((LAS unsigned char*)lds + BARW_OFF));
    if (IN(0)) REP(0) phase_prep(P, lds);
    SEAM(0);
    if (IN(1)) REP(1) { DenseSched S{(const bf16_t*)(ws + WS_XB), (const bf16_t*)(ws + WS_W_IN0), NTOK, ZW, DM, DM, 0, REPS(1)};
        EpiZ0 E{(bf16_t*)(ws + WS_Z0)}; gemm_dense(lds, S, E); }
    SEAM(1);
    if (IN(2)) REP(2) phase_ret_kv_mfma(P, lds);
    SEAM(2);
    if (IN(3)) REP(3) phase_ret_scan_pool2(P);
    SEAM(3);
    if (IN(4)) REP(4) { phase_ret_out_mfma(P, lds); __syncthreads();
        DenseSched S{(const bf16_t*)(ws + WS_DP), (const bf16_t*)(ws + WS_W_POOL), NTOK, 512, 256, 512, 256};
        EpiStoreBf16 E{(bf16_t*)(ws + WS_MIX), DM, 512, P.in[5]}; gemm_dense(lds, S, E); }
    SEAM(4);
    if (IN(5)) REP(5) { DenseSched S{(const bf16_t*)(ws + WS_MIX), (const bf16_t*)(ws + WS_W_OUT0), NTOK, DM, DM, DM, 0, REPS(5)};
        EpiResidB E{(const bf16_t*)(ws + WS_XB), (bf16_t*)(ws + WS_F)}; gemm_dense(lds, S, E); }
    SEAM(5);
    layer_tail<0, 6>(P, lds, grid, lo, hi);
    SEAM(10);
    if (IN(11)) REP(11) { DenseSched S{(const bf16_t*)(ws + WS_XB2), (const bf16_t*)(ws + WS_W_CIN), NTOK, Z1W, DM, DM, 0, REPS(11)};
        EpiStoreBf16 E{(bf16_t*)(ws + WS_Z1), Z1W, 0, nullptr}; gemm_dense(lds, S, E); }
    SEAM(11);
    if (IN(12)) REP(12) { phase_norms(P); phase_index_scores(P, lds); }
    SEAM(12);
    if (IN(13)) { if (PROBE_DUP == 13) phase_index_select<PROBE_SEL>(P, lds); phase_index_select<0>(P, lds); }
    if (IN(13) && IN(14)) __syncthreads();
    if (IN(14)) REP(14) { DenseSched S{(const bf16_t*)(ws + WS_CQ), (const bf16_t*)(ws + WS_W_QA), NTOK, 4096, 256, 256, 0, REPS(14)};
        EpiStoreFp8 E{(unsigned char*)(ws + WS_QA), 4096}; gemm_dense(lds, S, E); }
    SEAM(14);
    if (IN(15)) { if (PROBE_DUP == 15) phase_sparse_attn_e<true>(P, lds); phase_sparse_attn_e<false>(P, lds); }
    SEAM(15);
    if (IN(16)) REP(16) { DenseSched S{(const bf16_t*)(ws + WS_OLAT), (const bf16_t*)(ws + WS_W_UVBD), NTOK, DM, DM, 4096, 1024, REPS(16)};
        EpiStoreBf16 E{(bf16_t*)(ws + WS_XB), DM, 0, nullptr}; gemm_dense_bdiag(lds, S, E); }
    SEAM(16);
    if (IN(17)) REP(17) { DenseSched S{(const bf16_t*)(ws + WS_XB), (const bf16_t*)(ws + WS_W_COUT), NTOK, DM, DM, DM, 0, REPS(17)};
        EpiResidB E{(const bf16_t*)(ws + WS_XB2), (bf16_t*)(ws + WS_F)}; gemm_dense(lds, S, E); }
    SEAM(17);
    layer_tail<1, 18>(P, lds, grid, lo, hi);
}
#undef IN
#undef SEAM

extern "C" void kernel_launch(void* const* d_in, const int* in_sizes, int n_in, void* d_out, int out_size, void* d_ws, size_t ws_size, hipStream_t stream) {
    static int grid = 0;
    if (grid == 0) {
        if (n_in != 26 || ws_size < WS_END || out_size != NTOK * DM) { fprintf(stderr, "kernel_launch: unexpected problem (n_in %d, ws %zu, out %d)\n", n_in, ws_size, out_size); grid = -1; return; }
        int dev = 0, cus = 0, per_cu = 0;
        (void)hipGetDevice(&dev);
        (void)hipDeviceGetAttribute(&cus, hipDeviceAttributeMultiprocessorCount, dev);
        (void)hipFuncSetAttribute((const void*)mega, hipFuncAttributeMaxDynamicSharedMemorySize, LDS_BYTES);
        (void)hipOccupancyMaxActiveBlocksPerMultiprocessor(&per_cu, (const void*)mega, NT, LDS_BYTES);
        if (per_cu < 1) { fprintf(stderr, "kernel_launch: occupancy query reports %d blocks per CU\n", per_cu); per_cu = 1; }
        (void)hipGetLastError();
        grid = cus;
    }
    if (grid < 0) return;
    (void)hipMemsetAsync((char*)d_ws + WS_CTL, 0, CTL_ZERO_BYTES, stream);
    Params p{};
    for (int i = 0; i < 26; ++i) p.in[i] = (const float*)d_in[i];
    p.out = (float*)d_out; p.ws = (unsigned char*)d_ws;
#if MK_ONE_LAUNCH
    int lo = 0, hi = NPH_TOTAL;
    void* args[] = {&p, &lo, &hi};
    (void)args;
    hipLaunchKernelGGL(mega, dim3(grid), dim3(NT), LDS_BYTES, stream, p, lo, hi);
    hipError_t e = hipPeekAtLastError();
    if (e != hipSuccess) fprintf(stderr, "launch failed: %s (grid %d)\n", hipGetErrorString(e), grid);
#else
    for (int k = 0; k < NPH_TOTAL; ++k) hipLaunchKernelGGL(mega, dim3(grid), dim3(NT), LDS_BYTES, stream, p, k, k + 1);
#endif
}
```

```cpp
#include <hip/hip_runtime.h>
#include <cstdio>
#include <cstdint>

#ifndef PROBE_ATT
#define PROBE_ATT 0
#endif
#ifndef PROBE_SEL
#define PROBE_SEL 0
#endif
#ifndef MK_ONE_LAUNCH
#define MK_ONE_LAUNCH 1
#endif

typedef unsigned short bf16_t;
typedef float f32x4 __attribute__((ext_vector_type(4)));
typedef unsigned u32x4 __attribute__((ext_vector_type(4)));
typedef unsigned u32x2 __attribute__((ext_vector_type(2)));

constexpr int NT = 512;
constexpr int NWAVE = NT / 64;
constexpr int NTOK = 32768, DM = 1024, SEQ = 8192, NBATCH = 4;
constexpr int ZW = 2560;
constexpr int Z1W = 1280;
constexpr int CIN = 1096;
constexpr int TOPK = 256;
constexpr float ALPHA = 1.4142135623730951f;
constexpr float LN_EPS = 1e-5f;
constexpr int LDS_BYTES = 163840;
constexpr int BARW_OFF = LDS_BYTES - 64;
constexpr int MISC_OFF = 135168;

constexpr size_t MiB = (size_t)1 << 20;
constexpr size_t WS_CTL = 0;
constexpr size_t WS_W_IN0 = 1 * MiB, WS_W_OUT0 = 6 * MiB, WS_W_POOL = 8 * MiB, WS_W_CIN = 9 * MiB, WS_W_QA = 12 * MiB,
                 WS_W_UVBD = 14 * MiB, WS_W_COUT = 16 * MiB, WS_W_G = 18 * MiB, WS_W_P = 22 * MiB, WS_W_GU = 24 * MiB, WS_W_DN = 152 * MiB;
constexpr size_t WS_XB = 224 * MiB, WS_F = 288 * MiB, WS_PB = 416 * MiB, WS_PP = 448 * MiB, WS_CQ = 512 * MiB, WS_CKV = 528 * MiB,
                 WS_SEL = 544 * MiB, WS_TOKG = 560 * MiB, WS_LIST = 561 * MiB, WS_CKV8 = 566 * MiB;
constexpr size_t WS_M0 = 576 * MiB;
constexpr size_t WS_Z0 = WS_M0, WS_KV = WS_M0 + 160 * MiB, WS_MIX = WS_M0 + 224 * MiB, WS_DP = WS_M0 + 288 * MiB, WS_SB = WS_M0 + 320 * MiB;
constexpr size_t WS_OLAT = WS_M0, WS_QA = WS_F  , WS_SC = WS_M0, WS_Z1 = WS_M0 + 272 * MiB;
constexpr size_t WS_ACT = WS_M0, WS_YS = WS_M0 + 72 * MiB;
constexpr size_t WS_XB2 = 960 * MiB;
constexpr size_t WS_END = 1024 * MiB;
constexpr int LIST_CAP = 32768;
constexpr size_t WS_GT = WS_CTL + 262144;
constexpr size_t WS_SGB = WS_CTL + 786432;

struct Params {
    const float* in[26];
    float* out;
    unsigned char* ws;
};

__device__ __forceinline__ unsigned f2bf(float f) { unsigned u = __float_as_uint(f); return (u + 0x7fffu + ((u >> 16) & 1u)) >> 16; }
__device__ __forceinline__ float bf2f(unsigned h) { return __uint_as_float(h << 16); }
typedef float f32x2_t __attribute__((ext_vector_type(2))); typedef __bf16 bf16x2_t __attribute__((ext_vector_type(2)));
__device__ __forceinline__ unsigned pk2(float lo, float hi) { f32x2_t v = {lo, hi}; bf16x2_t b = __builtin_convertvector(v, bf16x2_t); return __builtin_bit_cast(unsigned, b); }
__device__ __forceinline__ float bflo(unsigned w) { return __uint_as_float(w << 16); }
__device__ __forceinline__ float bfhi(unsigned w) { return __uint_as_float(w & 0xffff0000u); }
#define WAVE_SUM_DPP(v) ({ float _v = (v); \
    _v += __builtin_bit_cast(float, __builtin_amdgcn_update_dpp(0, __builtin_bit_cast(int, _v), 0xB1, 0xf, 0xf, true));     \
    _v += __builtin_bit_cast(float, __builtin_amdgcn_update_dpp(0, __builtin_bit_cast(int, _v), 0x4E, 0xf, 0xf, true));     \
    _v += __builtin_bit_cast(float, __builtin_amdgcn_update_dpp(0, __builtin_bit_cast(int, _v), 0x141, 0xf, 0xf, true));    \
    _v += __builtin_bit_cast(float, __builtin_amdgcn_update_dpp(0, __builtin_bit_cast(int, _v), 0x140, 0xf, 0xf, true));    \
    _v += __builtin_bit_cast(float, __builtin_amdgcn_update_dpp(0, __builtin_bit_cast(int, _v), 0x142, 0xa, 0xf, false));   \
    _v += __builtin_bit_cast(float, __builtin_amdgcn_update_dpp(0, __builtin_bit_cast(int, _v), 0x143, 0xc, 0xf, false));   \
    __builtin_bit_cast(float, __builtin_amdgcn_readlane(__builtin_bit_cast(int, _v), 63)); })
__device__ __forceinline__ float wave_sum(float v) { return WAVE_SUM_DPP(v); }
#define WAVE_SCAN_DPP(v) ({ unsigned _v = (v); \
    _v += (unsigned)__builtin_amdgcn_update_dpp(0, (int)_v, 0x111, 0xf, 0xf, false); \
    _v += (unsigned)__builtin_amdgcn_update_dpp(0, (int)_v, 0x112, 0xf, 0xf, false); \
    _v += (unsigned)__builtin_amdgcn_update_dpp(0, (int)_v, 0x114, 0xf, 0xf, false); \
    _v += (unsigned)__builtin_amdgcn_update_dpp(0, (int)_v, 0x118, 0xf, 0xf, false); \
    _v += (unsigned)__builtin_amdgcn_update_dpp(0, (int)_v, 0x142, 0xa, 0xf, false); \
    _v += (unsigned)__builtin_amdgcn_update_dpp(0, (int)_v, 0x143, 0xc, 0xf, false); \
    _v; })

__device__ __forceinline__ float silu_f(float a) { return a / (1.0f + __expf(-a)); }
__device__ __forceinline__ float sigmoid_f(float a) { return 1.0f / (1.0f + __expf(-a)); }
#define LDS_FENCE() asm volatile("s_waitcnt lgkmcnt(0)" ::: "memory")

struct UnitInfo {
    const bf16_t* A; int lda;
    const int* rows; int rshift;
    int nvalid;
    const bf16_t* Bt; int ldb;
    int K;
    int orow0;
    int pn;
};

struct DenseSched {
    const bf16_t* A; const bf16_t* Bt; int M, N, K, lda, a_pn_stride; int reps = 1;
    int wrank = -1, wcount = 0;
    __device__ __forceinline__ bool next(int round, UnitInfo& u) const {
        const int nN = N >> 8, nM = M >> 8, nwg = nN * nM;
        if (wcount > 0 && wrank < 0) return false;
        const long L = (wcount > 0) ? ((long)round * wcount + wrank) : ((long)round * gridDim.x + blockIdx.x); if (L >= (long)nwg * reps) return false;
        int wgid = (int)(L % nwg); { const int q = nwg / 8, r = nwg % 8, xcd = wgid % 8, off = wgid / 8; wgid = (xcd < r ? xcd * (q + 1) : r * (q + 1) + (xcd - r) * q) + off; }
        const int nig = 8 * nN, gid = wgid / nig, fm = gid * 8, gsz = (nM - fm) < 8 ? (nM - fm) : 8;
        const int pm = fm + ((wgid % nig) % gsz), pn = (wgid % nig) / gsz;
        u.A = A + (size_t)pm * 256 * lda + (size_t)pn * a_pn_stride; u.lda = lda; u.rows = nullptr; u.rshift = 0; u.nvalid = 256;
        u.Bt = Bt + (size_t)pn * 256 * K; u.ldb = K; u.K = K; u.orow0 = pm * 256; u.pn = pn;
        return true;
    }
};
struct MoeSched {
    const int* tb; const int* cnt; const int* list;
    const bf16_t* A; const bf16_t* W; int K; size_t wstride; bool gather;
    __device__ __forceinline__ bool next(int round, UnitInfo& u) const {
        const int i = round * gridDim.x + blockIdx.x;
        const int j = i >> 2, pn = i & 3;
        if (j >= tb[32]) return false;
        int e = 0;
        while (tb[e + 1] <= j) ++e;
        const int rb = j - tb[e];
        const int nv = min(256, cnt[e] - rb * 256);
        u.rows = list + (size_t)e * LIST_CAP + rb * 256; u.nvalid = nv; u.orow0 = j * 256; u.pn = pn;
        if (gather) { u.A = A; u.lda = K; u.rshift = 1; }
        else { u.A = A + (size_t)j * 256 * K; u.lda = K; u.rshift = 31;   }
        u.Bt = W + (size_t)e * wstride + (size_t)pn * 256 * K; u.ldb = K; u.K = K;
        return true;
    }
};


namespace pg8 {
#define LAS __attribute__((address_space(3)))
typedef short bf16x8 __attribute__((ext_vector_type(8)));
constexpr int BK = 64, HALF = 128, HTB = HALF * BK * 2, STAGE_BYTES = 8 * HTB;
__device__ __forceinline__ int lds_byte(int r, int c) { const int st = (r >> 4) * 2 + (c >> 5), rr = r & 15, cc = c & 31, ob = rr * 64 + cc * 2; return st * 1024 + (ob ^ (((ob >> 9) & 1) << 5)); }
__device__ __forceinline__ void stage_rc(int b, int& R, int& C) { const int st = b / 1024, sb = b % 1024, swz = sb ^ (((sb >> 9) & 1) << 5); R = (st >> 1) * 16 + swz / 64; C = (st & 1) * 32 + (swz % 64) / 2; }
__device__ __forceinline__ int perm32(int rho) { const int n = rho >> 4, i = rho & 15; return 8 * (i >> 2) + 4 * n + (i & 3); }

template <bool GATHER, class Sched, class Epi, bool BDIAG = false>
__device__ __forceinline__ void gemm_phase(LAS unsigned char* lds, const LAS unsigned* rowtab, const Sched& S, const Epi& E, const int lda, const int ldb, const int K) {
    const int tid = threadIdx.x, wid = __builtin_amdgcn_readfirstlane(tid >> 6), lane = tid & 63, wr = wid >> 2, wc = wid & 3, fr = lane & 15, fq = lane >> 4;
    const int nt = K / BK;
    unsigned voffA[2], voffB[2]; int RA[2]; unsigned CA2[2];
#pragma unroll
    for (int i = 0; i < 2; ++i) { int R, C; stage_rc(tid * 16 + i * 8192, R, C); const int Rb = (R & ~31) + perm32(R & 31);
        voffA[i] = (unsigned)(R * lda + C) * 2u; voffB[i] = (unsigned)(Rb * ldb + C) * 2u; RA[i] = R; CA2[i] = (unsigned)C * 2u; }
    const size_t kstep = (size_t)(BK * 2);
    const size_t hstepA = (size_t)HALF * lda * 2, hstepB = (size_t)HALF * ldb * 2;
    const unsigned ldsw = (unsigned)wid * 1024u;
    const int aoff = lds_byte(wr * 64 + fr, fq * 8), boff = lds_byte(wc * 32 + fr, fq * 8);
    unsigned offA[2][2];
#define PG8_SA(b, h) (((b) * 2 + (h)) * HTB)
#define PG8_SB(b, h) ((4 + (b) * 2 + (h)) * HTB)
#define PG8_STAGE(bufoff, gbase, voff) do { _Pragma("unroll") for (int _i = 0; _i < 2; ++_i) \
        __builtin_amdgcn_global_load_lds((const unsigned*)((const char*)(gbase) + (voff)[_i]), (LAS unsigned*)(lds + (bufoff) + ldsw + _i * 8192), 16, 0, 0); } while (0)
#define PG8_STAGE_A(bufoff, h, gbase) do { if (GATHER) PG8_STAGE(bufoff, gbase, offA[h]); else PG8_STAGE(bufoff, (gbase) + (h) * hstepA, voffA); } while (0)
#define PG8_LOADOFF(round) do { _Pragma("unroll") for (int _h = 0; _h < 2; ++_h) _Pragma("unroll") for (int _i = 0; _i < 2; ++_i) offA[_h][_i] = rowtab[(round) * 256 + _h * 128 + RA[_i]] + CA2[_i]; } while (0)
#define PG8_LDA(dst, b, h) do { _Pragma("unroll") for (int m = 0; m < 4; ++m) _Pragma("unroll") for (int k = 0; k < 2; ++k) dst[m][k] = *(const LAS bf16x8*)(lds + PG8_SA(b, h) + aoff + m * 2048 + k * 1024); } while (0)
#define PG8_LDB(dst, b, h) do { _Pragma("unroll") for (int n = 0; n < 2; ++n) _Pragma("unroll") for (int k = 0; k < 2; ++k) dst[n][k] = *(const LAS bf16x8*)(lds + PG8_SB(b, h) + boff + n * 2048 + k * 1024); } while (0)
#define PG8_MMA(ai, bj, At, Bt) do { if (!BDIAG || (((kt_ >> 2) & 3) == 2 * (bj) + (wc >> 1))) { __builtin_amdgcn_s_setprio(1); _Pragma("unroll") for (int m = 0; m < 4; ++m) _Pragma("unroll") for (int n = 0; n < 2; ++n) _Pragma("unroll") for (int k = 0; k < 2; ++k) \
        acc[ai][bj][m][n] = __builtin_amdgcn_mfma_f32_16x16x32_bf16(Bt[n][k], At[m][k], acc[ai][bj][m][n], 0, 0, 0); __builtin_amdgcn_s_setprio(0); } } while (0)
#define PG8_WAIT_V(n) asm volatile("s_waitcnt vmcnt(" #n ")" ::: "memory")
#define PG8_WAIT_L(n) asm volatile("s_waitcnt lgkmcnt(" #n ")" ::: "memory")
#define PG8_BAR __builtin_amdgcn_s_barrier()
#define PG8_SCHED __builtin_amdgcn_sched_barrier(0)
    UnitInfo cur, nxt; int ui = 0;
    if (!S.next(0, cur)) return;
    f32x4 acc[2][2][4][2];
#pragma unroll
    for (int a = 0; a < 2; ++a)
#pragma unroll
        for (int b = 0; b < 2; ++b)
#pragma unroll
            for (int m = 0; m < 4; ++m)
#pragma unroll
                for (int n = 0; n < 2; ++n) acc[a][b][m][n] = (f32x4){0.f, 0.f, 0.f, 0.f};
    bf16x8 At[4][2], B0[2][2], B1[2][2];
    const char* cA = (const char*)cur.A; const char* cB = (const char*)cur.Bt;
    if (GATHER) { PG8_LOADOFF(0); }
    PG8_STAGE(PG8_SB(0, 0), cB, voffB); PG8_STAGE(PG8_SB(0, 1), cB + hstepB, voffB); PG8_STAGE_A(PG8_SA(0, 0), 0, cA); PG8_STAGE_A(PG8_SA(0, 1), 1, cA);
    if (wr == 1) PG8_BAR;
    PG8_WAIT_V(2); PG8_BAR;
    PG8_STAGE(PG8_SB(1, 0), cB + kstep, voffB); PG8_STAGE_A(PG8_SA(1, 0), 0, cA + kstep); PG8_STAGE(PG8_SB(1, 1), cB + hstepB + kstep, voffB);
    PG8_WAIT_V(6); PG8_BAR;
    for (;;) {
        const bool has_next = S.next(ui + 1, nxt);
        const char* nA = has_next ? (const char*)nxt.A : cA; const char* nB = has_next ? (const char*)nxt.Bt : cB;
        for (int t = 0; t < nt; t += 2) {
            const bool last = (t == nt - 2);
            const char* a1 = cA + (size_t)(t + 1) * kstep;
            const char* a2 = last ? nA : cA + (size_t)(t + 2) * kstep; const char* b2 = last ? nB : cB + (size_t)(t + 2) * kstep;
            const char* a3 = a2 + kstep; const char* b3 = b2 + kstep;
            int kt_ = t;
            PG8_LDB(B0, 0, 0); PG8_LDB(B1, 0, 1); PG8_SCHED; PG8_LDA(At, 0, 0); PG8_STAGE_A(PG8_SA(1, 1), 1, a1);
            if (GATHER) { if (last && has_next) { PG8_LOADOFF(ui + 1); } }
            PG8_WAIT_V(8); PG8_WAIT_L(0); PG8_BAR; PG8_MMA(0, 0, At, B0); PG8_MMA(0, 1, At, B1); PG8_BAR; PG8_SCHED;
            PG8_LDA(At, 0, 1); PG8_STAGE(PG8_SB(0, 0), b2, voffB); PG8_STAGE(PG8_SB(0, 1), b2 + hstepB, voffB); PG8_STAGE_A(PG8_SA(0, 0), 0, a2);
            PG8_WAIT_V(8); PG8_WAIT_L(0); PG8_BAR; PG8_MMA(1, 0, At, B0); PG8_MMA(1, 1, At, B1); PG8_BAR; PG8_SCHED;
            kt_ = t + 1;
            PG8_LDB(B0, 1, 0); PG8_LDB(B1, 1, 1); PG8_SCHED; PG8_LDA(At, 1, 0); PG8_STAGE_A(PG8_SA(0, 1), 1, a2);
            PG8_WAIT_V(8); PG8_WAIT_L(0); PG8_BAR; PG8_MMA(0, 0, At, B0); PG8_MMA(0, 1, At, B1); PG8_BAR; PG8_SCHED;
            PG8_LDA(At, 1, 1); PG8_STAGE(PG8_SB(1, 0), b3, voffB); PG8_STAGE(PG8_SB(1, 1), b3 + hstepB, voffB); PG8_STAGE_A(PG8_SA(1, 0), 0, a3);
            PG8_WAIT_V(8); PG8_WAIT_L(0); PG8_BAR; PG8_MMA(1, 0, At, B0); PG8_MMA(1, 1, At, B1); PG8_BAR; PG8_SCHED;
        }
        if (wr == 0) PG8_BAR;
#pragma unroll
        for (int ai = 0; ai < 2; ++ai)
#pragma unroll
            for (int m = 0; m < 4; ++m)
#pragma unroll
                for (int bj = 0; bj < 2; ++bj) E(cur, ai * HALF + wr * 64 + m * 16 + fr, bj * HALF + wc * 32 + 8 * fq, acc[ai][bj][m][0], acc[ai][bj][m][1]);
        if (!has_next) break;
#pragma unroll
        for (int a = 0; a < 2; ++a)
#pragma unroll
            for (int b = 0; b < 2; ++b)
#pragma unroll
                for (int m = 0; m < 4; ++m)
#pragma unroll
                    for (int n = 0; n < 2; ++n) acc[a][b][m][n] = (f32x4){0.f, 0.f, 0.f, 0.f};
        cur = nxt; cA = nA; cB = nB; ++ui;
        if (wr == 1) PG8_BAR;
    }
    PG8_WAIT_V(0);
    PG8_BAR;
#undef PG8_SA
#undef PG8_SB
#undef PG8_STAGE
#undef PG8_STAGE_A
#undef PG8_LOADOFF
#undef PG8_LDA
#undef PG8_LDB
#undef PG8_MMA
#undef PG8_WAIT_V
#undef PG8_WAIT_L
#undef PG8_BAR
#undef PG8_SCHED
}
}

template <class Sched, class Epi>
__device__ __forceinline__ void gemm_dense(unsigned char* lds, const Sched& S, const Epi& E) {
    pg8::gemm_phase<false>((LAS unsigned char*)lds, (const LAS unsigned*)nullptr, S, E, S.lda, S.K, S.K);
    __syncthreads();
}
template <class Sched, class Epi>
__device__ __forceinline__ void gemm_dense_bdiag(unsigned char* lds, const Sched& S, const Epi& E) {
    pg8::gemm_phase<false, Sched, Epi, true>((LAS unsigned char*)lds, (const LAS unsigned*)nullptr, S, E, S.lda, S.K, S.K);
    __syncthreads();
}


template <bool GATHER, class Epi>
__device__ __forceinline__ void gemm_moe(unsigned char* lds, const MoeSched& S, const Epi& E) {
    LAS unsigned* rowtab = (LAS unsigned*)(lds + MISC_OFF + 256);
    if (GATHER) {
        UnitInfo u;
        for (int round = 0; round < 10 && S.next(round, u); ++round)
            if (threadIdx.x < 256) rowtab[round * 256 + threadIdx.x] = ((int)threadIdx.x < u.nvalid) ? (unsigned)(u.rows[threadIdx.x] >> 1) * (unsigned)(S.K * 2) : 0u;
        __syncthreads();
    }
    pg8::gemm_phase<GATHER>((LAS unsigned char*)lds, (const LAS unsigned*)rowtab, S, E, S.K, S.K, S.K);
    __syncthreads();
}

__device__ __forceinline__ u32x4 pack8(f32x4 a, f32x4 b) { u32x4 w; w.x = pk2(a.x, a.y); w.y = pk2(a.z, a.w); w.z = pk2(b.x, b.y); w.w = pk2(b.z, b.w); return w; }
struct EpiStoreBf16 {
    bf16_t* O; int ldc; int coff; const float* colscale;
    __device__ __forceinline__ void operator()(const UnitInfo& u, int r, int c, f32x4 v0, f32x4 v1) const {
        const int col = u.pn * 256 + c;
        if (colscale) { const f32x4 s0 = *(const f32x4*)(colscale + col), s1 = *(const f32x4*)(colscale + col + 4); v0 *= s0; v1 *= s1; }
        *(u32x4*)(O + (size_t)(u.orow0 + r) * ldc + coff + col) = pack8(v0, v1);
    }
};

__device__ __forceinline__ float ret_log2g(int h) { return log2f(1.0f - exp2f(-5.0f - (float)h)); }
struct EpiZ0 {
    bf16_t* O;
    __device__ __forceinline__ void operator()(const UnitInfo& u, int r, int c, f32x4 v0, f32x4 v1) const {
        const int col = u.pn * 256 + c, row = u.orow0 + r;
        if (col < 1024) { const float e = ret_log2g((col >> 7) & 3) * (float)(row & 127); const float sc = exp2f(col < 512 ? e : -e); v0 *= sc; v1 *= sc; }
        *(u32x4*)(O + (size_t)row * ZW + col) = pack8(v0, v1);
    }
};

struct EpiStoreFp8 {
    unsigned char* O; int ldc;
    __device__ __forceinline__ void operator()(const UnitInfo& u, int r, int c, f32x4 v0, f32x4 v1) const {
        int w0 = __builtin_amdgcn_cvt_pk_fp8_f32(v0.x, v0.y, 0, false); w0 = __builtin_amdgcn_cvt_pk_fp8_f32(v0.z, v0.w, w0, true);
        int w1 = __builtin_amdgcn_cvt_pk_fp8_f32(v1.x, v1.y, 0, false); w1 = __builtin_amdgcn_cvt_pk_fp8_f32(v1.z, v1.w, w1, true);
        u32x2 w; w.x = (unsigned)w0; w.y = (unsigned)w1;
        *(u32x2*)(O + (size_t)(u.orow0 + r) * ldc + u.pn * 256 + c) = w;
    }
};
struct EpiResidB {
    const bf16_t* X; bf16_t* Yo;
    __device__ __forceinline__ void operator()(const UnitInfo& u, int r, int c, f32x4 v0, f32x4 v1) const {
        const size_t off = (size_t)(u.orow0 + r) * DM + u.pn * 256 + c;
        const u32x4 xw = *(const u32x4*)(X + off);
        const f32x4 x0 = {bflo(xw.x), bfhi(xw.x), bflo(xw.y), bfhi(xw.y)}, x1 = {bflo(xw.z), bfhi(xw.z), bflo(xw.w), bfhi(xw.w)};
        *(u32x4*)(Yo + off) = pack8(x0 * ALPHA + v0, x1 * ALPHA + v1);
    }
};

struct EpiGU {
    bf16_t* ACT;
    __device__ __forceinline__ void operator()(const UnitInfo& u, int r, int c, f32x4 v0, f32x4 v1) const {
        u32x2 w; w.x = pk2(silu_f(v0.x) * v0.y, silu_f(v0.z) * v0.w); w.y = pk2(silu_f(v1.x) * v1.y, silu_f(v1.z) * v1.w);
        *(u32x2*)(ACT + (size_t)(u.orow0 + r) * 512 + u.pn * 128 + (c >> 1)) = w;
    }
};
struct EpiDown {
    bf16_t* YS;
    __device__ __forceinline__ void operator()(const UnitInfo& u, int r, int c, f32x4 v0, f32x4 v1) const {
        if (r < u.nvalid) { const int pair = u.rows[r]; *(u32x4*)(YS + (size_t)pair * DM + u.pn * 256 + c) = pack8(v0, v1); }
    }
};
struct EpiPle {
    const bf16_t* XI; const bf16_t* PP; float* OUT; bf16_t* XO;
    __device__ __forceinline__ void operator()(const UnitInfo& u, int r, int c, f32x4 v0, f32x4 v1) const {
        const size_t off = (size_t)(u.orow0 + r) * DM + u.pn * 256 + c;
        const u32x4 pw = *(const u32x4*)(PP + off), xw = *(const u32x4*)(XI + off);
        f32x4 f0 = {bflo(xw.x), bfhi(xw.x), bflo(xw.y), bfhi(xw.y)}, f1 = {bflo(xw.z), bfhi(xw.z), bflo(xw.w), bfhi(xw.w)};
        f0.x += sigmoid_f(v0.x) * bflo(pw.x); f0.y += sigmoid_f(v0.y) * bfhi(pw.x); f0.z += sigmoid_f(v0.z) * bflo(pw.y); f0.w += sigmoid_f(v0.w) * bfhi(pw.y);
        f1.x += sigmoid_f(v1.x) * bflo(pw.z); f1.y += sigmoid_f(v1.y) * bfhi(pw.z); f1.z += sigmoid_f(v1.z) * bflo(pw.w); f1.w += sigmoid_f(v1.w) * bfhi(pw.w);
        if (OUT) { *(f32x4*)(OUT + off) = f0; *(f32x4*)(OUT + off + 4) = f1; }
        if (XO) *(u32x4*)(XO + off) = pack8(f0, f1);
    }
};

struct TrDesc { const float* src; bf16_t* dst; int K, N, Nsrc, nbatch, mode, dst_ld; };
struct TrItem { const float* src; bf16_t* dst; int Nsrc, dst_ld, mode, kb, nb; };
__device__ __forceinline__ void tr_load(const TrItem& t, int lane, float (&tmp)[32]) {
    const int k0 = 64 * t.kb, n0 = 32 * t.nb, Ns = t.Nsrc;
    const bool okc = (n0 + (lane & 31)) < Ns;
    const float* p = t.src + (size_t)(k0 + (lane >> 5)) * Ns + n0 + (lane & 31);
#pragma unroll
    for (int i = 0; i < 32; ++i) { tmp[i] = okc ? __builtin_nontemporal_load(p) : 0.f; p += 2 * Ns; asm volatile("" : "+v"(p)); }
}
__device__ __forceinline__ void tr_store(const TrItem& t, float* scr, int lane, const float (&tmp)[32]) {
    const int k0 = 64 * t.kb, n0 = 32 * t.nb;
#pragma unroll
    for (int i = 0; i < 32; ++i) scr[(2 * i + (lane >> 5)) * 33 + (lane & 31)] = tmp[i];
    LDS_FENCE();
    const int c = lane & 7;
    int n8 = lane >> 3; asm volatile("" : "+v"(n8));
#pragma unroll
    for (int j = 0; j < 4; ++j) {
        const int n = n8 + 8 * j; const float* sp = scr + (8 * c) * 33 + n;
        const int ng = n0 + n;
        float sc = 1.f; int nd = ng; int coff = 0;
        if (t.mode == 1) { if (ng >= 512 && ng < 1024) sc = 0.08838834764831845f; }
        if (t.mode == 2) { nd = (ng < 512) ? 2 * ng : 2 * (ng - 512) + 1; }
        if (t.mode == 3) { coff = ((ng >> 6) & 3) * 256; }
        u32x4 o; o.x = pk2(sp[0 * 33] * sc, sp[1 * 33] * sc); o.y = pk2(sp[2 * 33] * sc, sp[3 * 33] * sc); o.z = pk2(sp[4 * 33] * sc, sp[5 * 33] * sc); o.w = pk2(sp[6 * 33] * sc, sp[7 * 33] * sc);
        *(u32x4*)(t.dst + (size_t)nd * t.dst_ld + coff + k0 + 8 * c) = o;
    }
    LDS_FENCE();
}
__device__ __forceinline__ int tr_items(const TrDesc& d) { return d.nbatch * (d.K / 64) * (d.N / 32); }

constexpr int N_DEFERRED = 32 * 512 + 32 * 256;
__device__ __forceinline__ TrItem deferred_item(const Params& P, int idx) {
    TrItem t;
    if (idx < 32 * 512) { const int b = 32 + (idx >> 9), r = idx & 511;
        t.src = P.in[22] + (size_t)b * 1024 * 1024; t.dst = (bf16_t*)(P.ws + WS_W_GU) + (size_t)b * 1024 * 1024; t.Nsrc = 1024; t.dst_ld = 1024; t.mode = 2; t.kb = r >> 5; t.nb = r & 31; }
    else { const int i2 = idx - 32 * 512, b = 32 + (i2 >> 8), r = i2 & 255;
        t.src = P.in[23] + (size_t)b * 512 * 1024; t.dst = (bf16_t*)(P.ws + WS_W_DN) + (size_t)b * 1024 * 512; t.Nsrc = 1024; t.dst_ld = 512; t.mode = 0; t.kb = r >> 5; t.nb = r & 31; }
    return t;
}
__device__ __forceinline__ void phase_prep(const Params& P, unsigned char* lds) {
    unsigned char* ws = P.ws;
    const int tid = threadIdx.x, lane = tid & 63, wave = tid >> 6;
    const int gw = blockIdx.x * NWAVE + wave, NGW = gridDim.x * NWAVE;
    float* scr = (float*)lds + wave * (64 * 33);
    constexpr int ND = 9;
    TrDesc d[ND];
    d[0] = {P.in[22], (bf16_t*)(ws + WS_W_GU), 1024, 1024, 1024, 32, 2, 1024};
    d[1] = {P.in[23], (bf16_t*)(ws + WS_W_DN), 512, 1024, 1024, 32, 0, 512};
    d[2] = {P.in[2], (bf16_t*)(ws + WS_W_IN0), 1024, 2560, 2560, 1, 1, 1024};
    d[3] = {P.in[6], (bf16_t*)(ws + WS_W_OUT0), 1024, 1024, 1024, 1, 0, 1024};
    d[4] = {P.in[13], (bf16_t*)(ws + WS_W_COUT), 1024, 1024, 1024, 1, 0, 1024};
    d[5] = {P.in[24], (bf16_t*)(ws + WS_W_G), 1024, 1024, 1024, 2, 0, 1024};
    d[6] = {P.in[25], (bf16_t*)(ws + WS_W_P), 256, 1024, 1024, 2, 0, 256};
    d[7] = {P.in[7], (bf16_t*)(ws + WS_W_CIN), 1024, Z1W, CIN, 1, 0, 1024};
    d[8] = {P.in[12], (bf16_t*)(ws + WS_W_UVBD), 256, 1024, 1024, 1, 3, 1024};
    int total = 0;
#pragma unroll
    for (int i = 0; i < ND; ++i) total += tr_items(d[i]);
#define TR_DECODE(it, T) do { int _r = (it); bool _f = false; T = TrItem{nullptr, nullptr, 0, 0, 0, 0, 0}; _Pragma("unroll") for (int _i = 0; _i < ND; ++_i) { const int _n = tr_items(d[_i]); \
            if (!_f && _r < _n) { _f = true; const int _per = (d[_i].K / 64) * (d[_i].N / 32), _b = _r / _per, _q = _r % _per, _nblk = d[_i].N / 32; \
                T.src = d[_i].src + (size_t)_b * d[_i].K * d[_i].Nsrc; T.dst = d[_i].dst + (size_t)_b * d[_i].N * d[_i].dst_ld; T.Nsrc = d[_i].Nsrc; T.dst_ld = d[_i].dst_ld; T.mode = d[_i].mode; T.kb = _q / _nblk; T.nb = _q % _nblk; } \
            if (!_f) _r -= _n; } } while (0)
    {
        float cur[32], nxt[32];
        TrItem tc, tn;
        int it = gw;
        if (it < total) { TR_DECODE(it, tc); tr_load(tc, lane, cur); }
        while (it < total) {
            const int itn = it + NGW;
            if (itn < total) { TR_DECODE(itn, tn); tr_load(tn, lane, nxt); }
            tr_store(tc, scr, lane, cur);
#pragma unroll
            for (int i = 0; i < 32; ++i) cur[i] = nxt[i];
            it = itn; tc = tn;
        }
    }
#undef TR_DECODE
    const size_t gt = (size_t)blockIdx.x * NT + tid, GS = (size_t)gridDim.x * NT;
    {
        bf16_t* o = (bf16_t*)(ws + WS_W_POOL); const float* pw = P.in[4];
        for (size_t i = gt; i < 512 * 256; i += GS) { const int n = (int)(i >> 8), k = (int)(i & 255), g = n >> 7, dd = n & 127, kg = k >> 7, c = k & 127;
            o[i] = (bf16_t)((kg == (g & 1)) ? f2bf(pw[((size_t)g * 128 + c) * 128 + dd]) : 0u); }
    }
    {
        u32x4* o = (u32x4*)(ws + WS_W_UVBD);
        for (size_t i = gt; i < (size_t)1024 * 1024 / 8; i += GS) { const int n = (int)(i >> 7), k = (int)(i & 127) * 8; if (((n >> 6) & 3) != (k >> 8)) o[i] = (u32x4){0u, 0u, 0u, 0u}; }
    }
    {
        bf16_t* o = (bf16_t*)(ws + WS_W_QA); const float* uq = P.in[10]; const float* uk = P.in[11];
        float* Bq = (float*)lds; float* Ak = Bq + 256 * 65;
        for (int item = blockIdx.x; item < 128; item += gridDim.x) {
            const int h = item >> 3, c0 = (item & 7) * 32;
            __syncthreads();
            for (int i = tid; i < 256 * 16; i += NT) { const int r = i >> 4, d4 = (i & 15) * 4; const f32x4 v = *(const f32x4*)(uq + (size_t)r * 1024 + h * 64 + d4);
                float* q = Bq + r * 65 + d4; q[0] = v.x; q[1] = v.y; q[2] = v.z; q[3] = v.w; }
            for (int i = tid; i < 32 * 16; i += NT) { const int c = i >> 4, d4 = (i & 15) * 4; const f32x4 v = *(const f32x4*)(uk + (size_t)(c0 + c) * 1024 + h * 64 + d4);
                float* q = Ak + c * 65 + d4; q[0] = v.x; q[1] = v.y; q[2] = v.z; q[3] = v.w; }
            __syncthreads();
            const int r = tid & 255, cg = tid >> 8;
            float acc[16];
#pragma unroll
            for (int j = 0; j < 16; ++j) acc[j] = 0.f;
            for (int dd = 0; dd < 64; ++dd) { const float bv = Bq[r * 65 + dd];
#pragma unroll
                for (int j = 0; j < 16; ++j) acc[j] += Ak[(cg * 16 + j) * 65 + dd] * bv; }
#pragma unroll
            for (int j = 0; j < 16; ++j) o[(size_t)(h * 256 + c0 + cg * 16 + j) * 256 + r] = (bf16_t)f2bf(acc[j] * 0.125f);
        }
        __syncthreads();
    }
    {
        bf16_t* GT = (bf16_t*)(ws + WS_GT); float* SGB = (float*)(ws + WS_SGB);
        for (size_t i = gt; i < (size_t)2 * 48 * 1024; i += GS) {
            const int l = (int)(i / (48 * 1024)), j = (int)((i / 1024) % 48), c = (int)(i & 1023);
            float w = 0.f;
            if (j < 4) w = P.in[18][(size_t)l * DM * 4 + (size_t)c * 4 + j]; else if (j < 36) w = P.in[20][(size_t)l * DM * 32 + (size_t)c * 32 + (j - 4)];
            const float g = P.in[14][l * DM + c] * w;
            const unsigned hi = f2bf(g); const unsigned lo = f2bf(g - bf2f(hi));
            GT[((size_t)(l * 2 + 0) * 48 + j) * 1024 + c] = (bf16_t)hi; GT[((size_t)(l * 2 + 1) * 48 + j) * 1024 + c] = (bf16_t)lo;
        }
        for (int it = gw; it < 96; it += NGW) {
            const int l = it / 48, j = it % 48; float sg = 0.f, sb = 0.f;
            for (int c = lane; c < 1024; c += 64) {
                float w = 0.f;
                if (j < 4) w = P.in[18][(size_t)l * DM * 4 + (size_t)c * 4 + j]; else if (j < 36) w = P.in[20][(size_t)l * DM * 32 + (size_t)c * 32 + (j - 4)];
                sg += P.in[14][l * DM + c] * w; sb += P.in[15][l * DM + c] * w;
            }
            sg = wave_sum(sg); sb = wave_sum(sb);
            const float bias = (j < 4) ? P.in[19][l * 4 + j] : ((j < 36) ? P.in[21][l * 32 + (j - 4)] : 0.f);
            if (lane == 0) { SGB[(l * 2 + 0) * 48 + j] = sg; SGB[(l * 2 + 1) * 48 + j] = sb + bias; }
        }
    }
    {
        const f32x4* x = (const f32x4*)P.in[0]; u32x4* xb = (u32x4*)(ws + WS_XB);
        const size_t nx = (size_t)NTOK * DM / 8, np = (size_t)2 * NTOK * 256 / 8;
        size_t i = gt;
        for (; i + 3 * GS < nx; i += 4 * GS) { f32x4 a[8];
#pragma unroll
            for (int q = 0; q < 4; ++q) { a[2 * q] = __builtin_nontemporal_load(x + 2 * (i + q * GS)); a[2 * q + 1] = __builtin_nontemporal_load(x + 2 * (i + q * GS) + 1); }
#pragma unroll
            for (int q = 0; q < 4; ++q) xb[i + q * GS] = pack8(a[2 * q], a[2 * q + 1]); }
        for (; i < nx; i += GS) xb[i] = pack8(x[2 * i], x[2 * i + 1]);
        const f32x4* p = (const f32x4*)P.in[1]; u32x4* pb = (u32x4*)(ws + WS_PB);
        i = gt;
        for (; i + 3 * GS < np; i += 4 * GS) { f32x4 a[8];
#pragma unroll
            for (int q = 0; q < 4; ++q) { a[2 * q] = __builtin_nontemporal_load(p + 2 * (i + q * GS)); a[2 * q + 1] = __builtin_nontemporal_load(p + 2 * (i + q * GS) + 1); }
#pragma unroll
            for (int q = 0; q < 4; ++q) pb[i + q * GS] = pack8(a[2 * q], a[2 * q + 1]); }
        for (; i < np; i += GS) pb[i] = pack8(p[2 * i], p[2 * i + 1]);
    }
}


template <bool DRY>
__device__ __forceinline__ void phase_ln_route(const Params& P, unsigned char* lds, int layer) {
    using pg8::bf16x8;
    const bf16_t* F = (const bf16_t*)(P.ws + WS_F); bf16_t* XB = (bf16_t*)(P.ws + (DRY ? WS_M0 + 128 * MiB : WS_XB));
    float* TOKG = (float*)(P.ws + WS_TOKG); int* LIST = (int*)(P.ws + WS_LIST);
    int* CNT = (int*)(P.ws + WS_CTL) + layer * 64;
    const float* lg = P.in[14] + layer * DM; const float* lb = P.in[15] + layer * DM;
    const bf16_t* GTh = (const bf16_t*)(P.ws + WS_GT) + (size_t)(layer * 2) * 48 * 1024; const bf16_t* GTl = GTh + 48 * 1024;
    const float* SG = (const float*)(P.ws + WS_SGB) + (layer * 2) * 48; const float* BB = SG + 48;
    const int tid = threadIdx.x, lane = tid & 63, wave = tid >> 6, r16 = lane & 15, g = lane >> 4;
    int* dec = (int*)lds;
    int* rank = dec + 256;
    int* lcnt = rank + 256;
    int* lbase = lcnt + 32;
    float* stat = (float*)(lds + 4096) + wave * 32;
    float* LG = (float*)(lds + 8192) + wave * (16 * 48);
    f32x4 g4[4], b4[4];
#pragma unroll
    for (int j = 0; j < 4; ++j) { g4[j] = *(const f32x4*)(lg + 256 * j + 4 * lane); b4[j] = *(const f32x4*)(lb + 256 * j + 4 * lane); }
    for (int rb = blockIdx.x; rb < NTOK / 128; rb += gridDim.x) {
        if (tid < 32) lcnt[tid] = 0;
        __syncthreads();
        const int tbase = rb * 128 + wave * 16;
        f32x4 acc[3];
#pragma unroll
        for (int i = 0; i < 3; ++i) acc[i] = (f32x4){0.f, 0.f, 0.f, 0.f};
        float sm = 0.f, sq = 0.f;
        const bf16_t* yrow = F + (size_t)(tbase + r16) * DM + 8 * g;
        const bf16_t* ghp = GTh + (size_t)r16 * 1024 + 8 * g; const bf16_t* glp = GTl + (size_t)r16 * 1024 + 8 * g;
#pragma unroll 2
        for (int k = 0; k < 32; ++k) {
            const u32x4 yw = *(const u32x4*)(yrow + 32 * k);
            bf16x8 gh[3], gl[3];
#pragma unroll
            for (int i = 0; i < 3; ++i) { gh[i] = *(const bf16x8*)(ghp + (size_t)i * 16 * 1024 + 32 * k); gl[i] = *(const bf16x8*)(glp + (size_t)i * 16 * 1024 + 32 * k); }
            const float y0 = bflo(yw.x), y1 = bfhi(yw.x), y2 = bflo(yw.y), y3 = bfhi(yw.y), y4 = bflo(yw.z), y5 = bfhi(yw.z), y6 = bflo(yw.w), y7 = bfhi(yw.w);
            sm += (y0 + y1) + (y2 + y3) + (y4 + y5) + (y6 + y7);
            sq += (y0 * y0 + y1 * y1) + (y2 * y2 + y3 * y3) + (y4 * y4 + y5 * y5) + (y6 * y6 + y7 * y7);
            const bf16x8 yh = __builtin_bit_cast(bf16x8, yw);
#pragma unroll
            for (int i = 0; i < 3; ++i) {
                acc[i] = __builtin_amdgcn_mfma_f32_16x16x32_bf16(yh, gh[i], acc[i], 0, 0, 0);
                acc[i] = __builtin_amdgcn_mfma_f32_16x16x32_bf16(yh, gl[i], acc[i], 0, 0, 0);
            }
        }
        sm += __shfl_xor(sm, 16); sm += __shfl_xor(sm, 32); sq += __shfl_xor(sq, 16); sq += __shfl_xor(sq, 32);
        const float mean = sm * (1.0f / DM), var = fmaxf(sq * (1.0f / DM) - mean * mean, 0.f), rstd = 1.0f / sqrtf(var + LN_EPS);
        if (g == 0) { stat[r16 * 2] = mean; stat[r16 * 2 + 1] = rstd; }
        LDS_FENCE();
#pragma unroll
        for (int i = 0; i < 3; ++i) { const float sg = SG[16 * i + r16], bb = BB[16 * i + r16];
#pragma unroll
            for (int r = 0; r < 4; ++r) { const float mu = stat[(4 * g + r) * 2], rs = stat[(4 * g + r) * 2 + 1];
                LG[(4 * g + r) * 48 + 16 * i + r16] = rs * (acc[i][r] - mu * sg) + bb; } }
        LDS_FENCE();
        if (lane < 16) {
            const float* lr = LG + lane * 48; const int rl = wave * 16 + lane, t = tbase + lane;
            float gl4[4];
#pragma unroll
            for (int j = 0; j < 4; ++j) gl4[j] = lr[j];
            int grp = 0; float gm = gl4[0];
#pragma unroll
            for (int j = 1; j < 4; ++j) if (gl4[j] > gm) { gm = gl4[j]; grp = j; }
            float gs = 0.f;
#pragma unroll
            for (int j = 0; j < 4; ++j) gs += __expf(gl4[j] - gm);
            const float gwt = 1.0f / gs;
            float el[8];
#pragma unroll
            for (int j = 0; j < 8; ++j) el[j] = lr[4 + grp * 8 + j];
            int i0 = 0; float m0 = el[0];
#pragma unroll
            for (int j = 1; j < 8; ++j) if (el[j] > m0) { m0 = el[j]; i0 = j; }
            int i1 = -1; float m1 = -INFINITY;
#pragma unroll
            for (int j = 0; j < 8; ++j) if (j != i0 && el[j] > m1) { m1 = el[j]; i1 = j; }
            const float ex = __expf(m1 - m0);
            const float p0 = 1.0f / (1.0f + ex), p1 = ex / (1.0f + ex);
            dec[rl * 2] = grp * 8 + i0; dec[rl * 2 + 1] = grp * 8 + i1;
            if (!DRY) { TOKG[(size_t)t * 2] = gwt * p0; TOKG[(size_t)t * 2 + 1] = gwt * p1; }
        }
#pragma unroll 4
        for (int r = 0; r < 16; ++r) {
            const float mu = stat[r * 2], rs = stat[r * 2 + 1];
            const bf16_t* fr = F + (size_t)(tbase + r) * DM + 4 * lane; bf16_t* xo = XB + (size_t)(tbase + r) * DM + 4 * lane;
#pragma unroll
            for (int j = 0; j < 4; ++j) { const u32x2 yw = *(const u32x2*)(fr + 256 * j); const f32x4 y = {bflo(yw.x), bfhi(yw.x), bflo(yw.y), bfhi(yw.y)};
                const f32x4 v = (y - mu) * rs * g4[j] + b4[j];
                u32x2 w; w.x = pk2(v.x, v.y); w.y = pk2(v.z, v.w); *(u32x2*)(xo + 256 * j) = w; }
        }
        __syncthreads();
        if (tid < 256) rank[tid] = atomicAdd(&lcnt[dec[tid]], 1);
        __syncthreads();
        if (tid < 32) lbase[tid] = DRY ? 0 : atomicAdd(&CNT[tid], lcnt[tid]);
        __syncthreads();
        if (!DRY && tid < 256) { const int e = dec[tid]; LIST[(size_t)e * LIST_CAP + lbase[e] + rank[tid]] = (rb * 128 + (tid >> 1)) * 2 + (tid & 1); }
        __syncthreads();
    }
}
__device__ __forceinline__ void moe_setup(const Params& P, int* tb, int layer) {
    const int* CNT = (const int*)(P.ws + WS_CTL) + layer * 64;
    if (threadIdx.x == 0) { int a = 0; for (int e = 0; e < 32; ++e) { tb[e] = a; a += (CNT[e] + 255) >> 8; } tb[32] = a; }
    __syncthreads();
}
template <bool DRY>
__device__ __forceinline__ void phase_ln2(const Params& P, int layer) {
    const bf16_t* XI = (const bf16_t*)(P.ws + WS_XB); bf16_t* XO = (bf16_t*)(P.ws + (DRY ? WS_XB2 : WS_XB));
    const bf16_t* YS = (const bf16_t*)(P.ws + WS_YS); const float* TOKG = (const float*)(P.ws + WS_TOKG);
    const float* lg = P.in[16] + layer * DM; const float* lb = P.in[17] + layer * DM;
    const int lane = threadIdx.x & 63, gw = blockIdx.x * NWAVE + (threadIdx.x >> 6), NGW = gridDim.x * NWAVE;
    f32x4 g4[4], b4[4];
#pragma unroll
    for (int j = 0; j < 4; ++j) { g4[j] = *(const f32x4*)(lg + 256 * j + 4 * lane); b4[j] = *(const f32x4*)(lb + 256 * j + 4 * lane); }
    u32x2 nx[4], na[4], nb[4]; float ng0 = 0.f, ng1 = 0.f;
    if (gw < NTOK) { const int t = gw;
#pragma unroll
        for (int j = 0; j < 4; ++j) { const int c0 = 256 * j + 4 * lane; nx[j] = *(const u32x2*)(XI + (size_t)t * DM + c0); na[j] = *(const u32x2*)(YS + (size_t)(2 * t) * DM + c0); nb[j] = *(const u32x2*)(YS + (size_t)(2 * t + 1) * DM + c0); }
        ng0 = TOKG[(size_t)t * 2]; ng1 = TOKG[(size_t)t * 2 + 1]; }
    for (int t = gw; t < NTOK; t += NGW) {
        const float g0 = ng0, g1 = ng1;
        u32x2 xw[4], aw[4], bw[4];
#pragma unroll
        for (int j = 0; j < 4; ++j) { xw[j] = nx[j]; aw[j] = na[j]; bw[j] = nb[j]; }
        if (t + NGW < NTOK) { const int tn = t + NGW;
#pragma unroll
            for (int j = 0; j < 4; ++j) { const int c0 = 256 * j + 4 * lane; nx[j] = *(const u32x2*)(XI + (size_t)tn * DM + c0); na[j] = *(const u32x2*)(YS + (size_t)(2 * tn) * DM + c0); nb[j] = *(const u32x2*)(YS + (size_t)(2 * tn + 1) * DM + c0); }
            ng0 = TOKG[(size_t)tn * 2]; ng1 = TOKG[(size_t)tn * 2 + 1]; }
        f32x4 v[4]; float s = 0.f;
#pragma unroll
        for (int j = 0; j < 4; ++j) {
            const u32x2 x = xw[j], a = aw[j], b = bw[j];
            v[j].x = bflo(x.x) * ALPHA + g0 * bflo(a.x) + g1 * bflo(b.x); v[j].y = bfhi(x.x) * ALPHA + g0 * bfhi(a.x) + g1 * bfhi(b.x);
            v[j].z = bflo(x.y) * ALPHA + g0 * bflo(a.y) + g1 * bflo(b.y); v[j].w = bfhi(x.y) * ALPHA + g0 * bfhi(a.y) + g1 * bfhi(b.y);
            s += (v[j].x + v[j].y) + (v[j].z + v[j].w); }
        const float mean = wave_sum(s) * (1.0f / DM); float s2 = 0.f;
#pragma unroll
        for (int j = 0; j < 4; ++j) { v[j] = v[j] - mean; s2 += (v[j].x * v[j].x + v[j].y * v[j].y) + (v[j].z * v[j].z + v[j].w * v[j].w); }
        const float rstd = 1.0f / sqrtf(wave_sum(s2) * (1.0f / DM) + LN_EPS);
#pragma unroll
        for (int j = 0; j < 4; ++j) { const int c0 = 256 * j + 4 * lane;
            v[j] = v[j] * rstd * g4[j] + b4[j];
            u32x2 w; w.x = pk2(v[j].x, v[j].y); w.y = pk2(v[j].z, v[j].w); *(u32x2*)(XO + (size_t)t * DM + c0) = w; }
    }
}

__device__ __forceinline__ unsigned e5m2enc(float y) {
    const unsigned hb = (unsigned)__builtin_bit_cast(unsigned short, (_Float16)y);
    return ((hb + 0x7fu + ((hb >> 8) & 1u)) >> 8) & 0xffu;
}
__device__ __forceinline__ void phase_norms(const Params& P) {
    const bf16_t* Z1 = (const bf16_t*)(P.ws + WS_Z1); bf16_t* CQ = (bf16_t*)(P.ws + WS_CQ); bf16_t* CKV = (bf16_t*)(P.ws + WS_CKV); unsigned char* CKV8 = (unsigned char*)(P.ws + WS_CKV8);
    const float* qn = P.in[8]; const float* kn = P.in[9];
    const int lane = threadIdx.x & 63, gw = blockIdx.x * NWAVE + (threadIdx.x >> 6), NGW = gridDim.x * NWAVE;
    for (int t = gw; t < NTOK; t += NGW) {
        const u32x2 a = *(const u32x2*)(Z1 + (size_t)t * Z1W + 4 * lane), b = *(const u32x2*)(Z1 + (size_t)t * Z1W + 256 + 4 * lane);
        const float q[4] = {bflo(a.x), bfhi(a.x), bflo(a.y), bfhi(a.y)}, k[4] = {bflo(b.x), bfhi(b.x), bflo(b.y), bfhi(b.y)};
        const float sq = wave_sum(q[0] * q[0] + q[1] * q[1] + q[2] * q[2] + q[3] * q[3]), sk = wave_sum(k[0] * k[0] + k[1] * k[1] + k[2] * k[2] + k[3] * k[3]);
        const float rq = 1.0f / sqrtf(sq * (1.0f / 256.0f) + 1e-6f), rk = 1.0f / sqrtf(sk * (1.0f / 256.0f) + 1e-6f);
        const f32x4 gq = *(const f32x4*)(qn + 4 * lane), gk = *(const f32x4*)(kn + 4 * lane);
        u32x2 o; o.x = pk2(q[0] * rq * gq.x, q[1] * rq * gq.y); o.y = pk2(q[2] * rq * gq.z, q[3] * rq * gq.w);
        *(u32x2*)(CQ + (size_t)t * 256 + 4 * lane) = o;
        o.x = pk2(k[0] * rk * gk.x, k[1] * rk * gk.y); o.y = pk2(k[2] * rk * gk.z, k[3] * rk * gk.w);
        *(u32x2*)(CKV + (size_t)t * 256 + 4 * lane) = o;
        *(unsigned*)(CKV8 + (size_t)t * 256 + 4 * lane) = e5m2enc(k[0] * rk * gk.x) | (e5m2enc(k[1] * rk * gk.y) << 8) | (e5m2enc(k[2] * rk * gk.z) << 16) | (e5m2enc(k[3] * rk * gk.w) << 24);
    }
}


constexpr int NPH_TOTAL = 23;


typedef short v4i16_t __attribute__((ext_vector_type(4)));


__device__ __forceinline__ void glds16(const void* gsrc, unsigned lds_dst) {
    unsigned keep;
    asm volatile("s_mov_b32 %0, m0\n\ts_mov_b32 m0, %2\n\ts_nop 0\n\tglobal_load_lds_dwordx4 %1, off\n\ts_mov_b32 m0, %0" : "=&s"(keep) : "v"(gsrc), "s"(lds_dst) : "memory");
}
typedef _Float16 f16x8 __attribute__((ext_vector_type(8)));
typedef int v8i_t __attribute__((ext_vector_type(8)));
template <bool DRY>
__device__ __forceinline__ void phase_sparse_attn_e(const Params& P, unsigned char* lds_) {
    const unsigned char* QA = (const unsigned char*)(P.ws + WS_QA); bf16_t* OLAT = (bf16_t*)(P.ws + WS_OLAT); const unsigned char* CKV8 = (const unsigned char*)(P.ws + WS_CKV8); const unsigned short* SEL = (const unsigned short*)(P.ws + WS_SEL);
    const int tid = threadIdx.x, lane = tid & 63, wave = __builtin_amdgcn_readfirstlane(tid >> 6);
    const int fr = lane & 15, fq = lane >> 4;
    LAS unsigned char* cbuf = (LAS unsigned char*)lds_ + wave * 16896;
    LAS unsigned short* selw = (LAS unsigned short*)(cbuf + 16384);
    const unsigned cbuf0 = (unsigned)(unsigned long)cbuf;
    const int G = gridDim.x, NGW = G * NWAVE;
    int vw;
    if ((G & 7) == 0) vw = (((int)blockIdx.x & 7) * (G >> 3) + ((int)blockIdx.x >> 3)) * NWAVE + wave; else vw = (int)blockIdx.x * NWAVE + wave;
    const float LOG2E = 1.4426950408889634f;
    const float slope2 = exp2f(-0.5f * (float)(fr + 1)) * LOG2E;
    unsigned qoffB[4];
#pragma unroll
    for (int e = 0; e < 4; ++e) { const int r15 = (4 * e + fq) & 15; qoffB[e] = (unsigned)((fr ^ (((r15 & 7) << 1) | (r15 >> 3))) << 4); }
    const unsigned fA = (unsigned)(((fr & 7) << 1) | (fr >> 3));
    const unsigned SA = (fA & 14u) << 4, baseA = (unsigned)fr * 256u + ((((unsigned)fq >> 1) ^ (fA & 1u)) << 4) + ((unsigned)fq & 1u) * 8u;
    const int rT = 4 * fq + (fr >> 2), pT_ = fr & 3;
    const unsigned fT = (unsigned)(((rT & 7) << 1) | (rT >> 3));
    const unsigned ST = (fT & 14u) << 4, baseT = (unsigned)rT * 256u + ((((unsigned)pT_ >> 1) ^ (fT & 1u)) << 4) + ((unsigned)pT_ & 1u) * 8u;
    const int per = NGW >> 2, bq = vw / per, wb = vw % per;
    int ditem = DRY ? N_DEFERRED : vw;
    u32x2 selnext = {0u, 0u}; long qfn[8];
    if (wb < SEQ) { const int t0 = bq * SEQ + wb; selnext = *(const u32x2*)(SEL + (size_t)t0 * TOPK + 4 * lane);
#pragma unroll
        for (int cc = 0; cc < 8; ++cc) qfn[cc] = *(const long*)(QA + (size_t)t0 * 4096 + fr * 256 + 32 * cc + 8 * fq); }
    for (int tl0 = wb; tl0 < SEQ; tl0 += per) {
        const int t = bq * SEQ + tl0;
        const int b = t >> 13, tl = t & (SEQ - 1), ns = min(tl + 1, TOPK), nch = (ns + 31) >> 5;
        const bool has_nextq = (tl0 + per < SEQ);
        asm volatile("s_waitcnt vmcnt(0)" ::: "memory");
        {
            const u32x2 w = selnext;
            unsigned short i0 = (unsigned short)(w.x & 0xffffu), i1 = (unsigned short)(w.x >> 16), i2 = (unsigned short)(w.y & 0xffffu), i3 = (unsigned short)(w.y >> 16);
            const int k0 = 4 * lane;
            if (k0 >= ns) i0 = 0; if (k0 + 1 >= ns) i1 = 0; if (k0 + 2 >= ns) i2 = 0; if (k0 + 3 >= ns) i3 = 0;
            u32x2 o; o.x = (unsigned)i0 | ((unsigned)i1 << 16); o.y = (unsigned)i2 | ((unsigned)i3 << 16);
            asm volatile("s_waitcnt lgkmcnt(0)" ::: "memory");
            *(LAS u32x2*)(selw + 4 * lane) = o;
        }
        v8i_t qB[2];
#pragma unroll
        for (int cc = 0; cc < 8; ++cc) { const u32x2 qw = __builtin_bit_cast(u32x2, qfn[cc]); qB[cc >> 2][2 * (cc & 3)] = (int)qw.x; qB[cc >> 2][2 * (cc & 3) + 1] = (int)qw.y; }
#define ATT_PREFETCH() do { if (has_nextq) { const int tn_ = t + per; selnext = *(const u32x2*)(SEL + (size_t)tn_ * TOPK + 4 * lane); \
            _Pragma("unroll") for (int cc = 0; cc < 8; ++cc) qfn[cc] = *(const long*)(QA + (size_t)tn_ * 4096 + fr * 256 + 32 * cc + 8 * fq); pf = true; } } while (0)
        f32x4 Oe[8], Oo[8];
#pragma unroll
        for (int ut = 0; ut < 8; ++ut) { Oe[ut] = (f32x4){0.f, 0.f, 0.f, 0.f}; Oo[ut] = (f32x4){0.f, 0.f, 0.f, 0.f}; }
        float m = -INFINITY, l = 0.f;
        const unsigned char* cb = CKV8 + (size_t)b * SEQ * 256;
        asm volatile("s_waitcnt vmcnt(0) lgkmcnt(0)" ::: "memory");
#define ATT_DMA(jj, bufoff) do { unsigned idx_[8]; \
            _Pragma("unroll") for (int e = 0; e < 8; ++e) idx_[e] = (DRY && PROBE_ATT == 1) ? (unsigned)((32 * (jj) + 4 * e + fq + 64 * wave) & 8191) : (unsigned)selw[32 * (jj) + 4 * e + fq]; \
            _Pragma("unroll") for (int e = 0; e < 8; ++e) { \
            if (!(DRY && PROBE_ATT == 3)) glds16(cb + (size_t)idx_[e] * 256 + qoffB[e & 3], (unsigned)__builtin_amdgcn_readfirstlane((int)(cbuf0 + (bufoff) + e * 1024))); } } while (0)
        ATT_DMA(0, 0);
        if (nch > 1) ATT_DMA(1, 8192);
        const bool have_item = ditem < N_DEFERRED;
        TrItem titem = deferred_item(P, have_item ? ditem : 0);
        float tcur[32];
        bool trf = false, pf = false;
        if (nch <= 2) { if (have_item) { tr_load(titem, lane, tcur); trf = true; } ATT_PREFETCH(); }
        for (int j = 0; j < nch; ++j) {
            const unsigned bo = (unsigned)(j & 1) * 8192u;
            if (j + 1 < nch) { if (trf && pf) asm volatile("s_waitcnt vmcnt(49)" ::: "memory"); else if (trf) asm volatile("s_waitcnt vmcnt(40)" ::: "memory");
                               else if (pf) asm volatile("s_waitcnt vmcnt(17)" ::: "memory"); else asm volatile("s_waitcnt vmcnt(8)" ::: "memory"); }
            else { if (trf && pf) asm volatile("s_waitcnt vmcnt(41)" ::: "memory"); else if (trf) asm volatile("s_waitcnt vmcnt(32)" ::: "memory");
                   else if (pf) asm volatile("s_waitcnt vmcnt(9)" ::: "memory"); else asm volatile("s_waitcnt vmcnt(0)" ::: "memory"); }
            const LAS unsigned char* img = cbuf + bo;
            if (DRY && PROBE_ATT == 2) { if (j + 2 < nch) { asm volatile("s_waitcnt lgkmcnt(0)" ::: "memory"); ATT_DMA(j + 2, bo); } continue; }
            f32x4 s0 = {0.f, 0.f, 0.f, 0.f}, s1 = {0.f, 0.f, 0.f, 0.f};
#pragma unroll
            for (int hb = 0; hb < 2; ++hb) {
                u32x2 ra[4], rb[4];
#pragma unroll
                for (int c4 = 0; c4 < 4; ++c4) { const int cc = hb * 4 + c4; const LAS unsigned char* pa = img + ((SA ^ (unsigned)(cc << 5)) + baseA); ra[c4] = *(const LAS u32x2*)(pa); rb[c4] = *(const LAS u32x2*)(pa + 4096); }
                __builtin_amdgcn_sched_barrier(0);
                v8i_t A0, A1;
#pragma unroll
                for (int c4 = 0; c4 < 4; ++c4) { A0[2 * c4] = (int)ra[c4].x; A0[2 * c4 + 1] = (int)ra[c4].y; A1[2 * c4] = (int)rb[c4].x; A1[2 * c4 + 1] = (int)rb[c4].y; }
                s0 = __builtin_amdgcn_mfma_scale_f32_16x16x128_f8f6f4(A0, qB[hb], s0, 1, 0, 0, 0, 0, 0);
                s1 = __builtin_amdgcn_mfma_scale_f32_16x16x128_f8f6f4(A1, qB[hb], s1, 1, 0, 0, 0, 0, 0);
                __builtin_amdgcn_sched_barrier(0);
            }
            const u32x2 k0w = *(const LAS u32x2*)(selw + 32 * j + 4 * fq), k1w = *(const LAS u32x2*)(selw + 32 * j + 16 + 4 * fq);
            u32x2 tl_[4], th_[4];
#pragma unroll
            for (int ut = 0; ut < 4; ++ut) { const LAS unsigned char* pt = img + ((ST ^ (unsigned)(ut << 5)) + baseT);
                tl_[ut] = __builtin_bit_cast(u32x2, __builtin_amdgcn_ds_read_tr16_b64_v4i16((LAS v4i16_t*)(pt)));
                th_[ut] = __builtin_bit_cast(u32x2, __builtin_amdgcn_ds_read_tr16_b64_v4i16((LAS v4i16_t*)(pt + 4096))); }
            __builtin_amdgcn_sched_barrier(0);
            const int rem = ns - (32 * j + 4 * fq);
            float lg[8];
            {
                const int i00 = (int)(k0w.x & 0xffffu), i01 = (int)(k0w.x >> 16), i02 = (int)(k0w.y & 0xffffu), i03 = (int)(k0w.y >> 16);
                const int i10 = (int)(k1w.x & 0xffffu), i11 = (int)(k1w.x >> 16), i12 = (int)(k1w.y & 0xffffu), i13 = (int)(k1w.y >> 16);
                lg[0] = (0 < rem) ? s0.x * LOG2E - slope2 * (float)(tl - i00) : -INFINITY;
                lg[1] = (1 < rem) ? s0.y * LOG2E - slope2 * (float)(tl - i01) : -INFINITY;
                lg[2] = (2 < rem) ? s0.z * LOG2E - slope2 * (float)(tl - i02) : -INFINITY;
                lg[3] = (3 < rem) ? s0.w * LOG2E - slope2 * (float)(tl - i03) : -INFINITY;
                lg[4] = (16 < rem) ? s1.x * LOG2E - slope2 * (float)(tl - i10) : -INFINITY;
                lg[5] = (17 < rem) ? s1.y * LOG2E - slope2 * (float)(tl - i11) : -INFINITY;
                lg[6] = (18 < rem) ? s1.z * LOG2E - slope2 * (float)(tl - i12) : -INFINITY;
                lg[7] = (19 < rem) ? s1.w * LOG2E - slope2 * (float)(tl - i13) : -INFINITY;
            }
            const float cm = fmaxf(fmaxf(fmaxf(lg[0], lg[1]), fmaxf(lg[2], lg[3])), fmaxf(fmaxf(lg[4], lg[5]), fmaxf(lg[6], lg[7])));
            if (j == 0) { float cx = fmaxf(cm, __shfl_xor(cm, 16)); m = fmaxf(cx, __shfl_xor(cx, 32)); }
            else if (__any(cm > m + 8.0f)) {
                float cx = fmaxf(cm, __shfl_xor(cm, 16)); cx = fmaxf(cx, __shfl_xor(cx, 32));
                const float mn = fmaxf(m, cx);
                const float sc = __builtin_amdgcn_exp2f(m - mn);
                l *= sc;
#pragma unroll
                for (int ut = 0; ut < 8; ++ut) { Oe[ut] *= sc; Oo[ut] *= sc; }
                m = mn;
            }
            float p[8]; float ps = 0.f;
#pragma unroll
            for (int i = 0; i < 8; ++i) { p[i] = __builtin_amdgcn_exp2f(lg[i] - m); ps += p[i]; }
            l += ps;
            int pw0 = __builtin_amdgcn_cvt_pk_fp8_f32(p[0], p[1], 0, false); pw0 = __builtin_amdgcn_cvt_pk_fp8_f32(p[2], p[3], pw0, true);
            int pw1 = __builtin_amdgcn_cvt_pk_fp8_f32(p[4], p[5], 0, false); pw1 = __builtin_amdgcn_cvt_pk_fp8_f32(p[6], p[7], pw1, true);
            const long pk = __builtin_bit_cast(long, (u32x2){(unsigned)pw0, (unsigned)pw1});
#pragma unroll
            for (int hb = 0; hb < 2; ++hb) {
                if (hb == 1) {
#pragma unroll
                    for (int u4 = 0; u4 < 4; ++u4) { const int ut = 4 + u4; const LAS unsigned char* pt = img + ((ST ^ (unsigned)(ut << 5)) + baseT);
                        tl_[u4] = __builtin_bit_cast(u32x2, __builtin_amdgcn_ds_read_tr16_b64_v4i16((LAS v4i16_t*)(pt)));
                        th_[u4] = __builtin_bit_cast(u32x2, __builtin_amdgcn_ds_read_tr16_b64_v4i16((LAS v4i16_t*)(pt + 4096))); }
                    __builtin_amdgcn_sched_barrier(0);
                }
#pragma unroll
                for (int u4 = 0; u4 < 4; ++u4) { const int ut = hb * 4 + u4;
                    const u32x2 lw = tl_[u4], hw = th_[u4];
                    u32x2 ae, ao;
                    ae.x = __builtin_amdgcn_perm(lw.y, lw.x, 0x06040200u); ae.y = __builtin_amdgcn_perm(hw.y, hw.x, 0x06040200u);
                    ao.x = __builtin_amdgcn_perm(lw.y, lw.x, 0x07050301u); ao.y = __builtin_amdgcn_perm(hw.y, hw.x, 0x07050301u);
                    Oe[ut] = __builtin_amdgcn_mfma_f32_16x16x32_bf8_fp8(__builtin_bit_cast(long, ae), pk, Oe[ut], 0, 0, 0);
                    Oo[ut] = __builtin_amdgcn_mfma_f32_16x16x32_bf8_fp8(__builtin_bit_cast(long, ao), pk, Oo[ut], 0, 0, 0);
                }
                __builtin_amdgcn_sched_barrier(0);
            }
            if (j + 2 < nch) { asm volatile("s_waitcnt lgkmcnt(0)" ::: "memory"); ATT_DMA(j + 2, bo);
                if (j + 3 == nch) { if (have_item) { tr_load(titem, lane, tcur); trf = true; } ATT_PREFETCH(); } }
        }
#undef ATT_DMA
#undef ATT_PREFETCH
        l += __shfl_xor(l, 16); l += __shfl_xor(l, 32);
        const float inv = 1.0f / l;
        bf16_t* orow = (DRY ? (bf16_t*)(P.ws + WS_PP) + (size_t)(t & 8191) * 4096 : OLAT + (size_t)t * 4096) + fr * 256 + 8 * fq;
#pragma unroll
        for (int ut = 0; ut < 8; ++ut) {
            u32x4 w; w.x = pk2(Oe[ut].x * inv, Oo[ut].x * inv); w.y = pk2(Oe[ut].y * inv, Oo[ut].y * inv); w.z = pk2(Oe[ut].z * inv, Oo[ut].z * inv); w.w = pk2(Oe[ut].w * inv, Oo[ut].w * inv);
            *(u32x4*)(orow + 32 * ut) = w;
        }
        if (have_item) { asm volatile("s_waitcnt lgkmcnt(0)" ::: "memory"); tr_store(titem, (float*)(lds_ + wave * 16896), lane, tcur); ditem += NGW; }
    }
    int lane_l = lane; asm volatile("" : "+v"(lane_l));
    for (; ditem < N_DEFERRED; ditem += NGW) { const TrItem t = deferred_item(P, ditem); float tmp[32]; tr_load(t, lane_l, tmp); tr_store(t, (float*)(lds_ + wave * 16896), lane_l, tmp); }
}

constexpr size_t SC_BATCH = (size_t)1024 * 256 * 257 / 2;
__device__ __forceinline__ size_t sc_row_off(int b, int tl) { const size_t m = (size_t)(tl >> 5); return (size_t)b * SC_BATCH + 1024 * (m * (m + 1) / 2) + (size_t)(tl & 31) * 32 * (m + 1); }
typedef float f32x16 __attribute__((ext_vector_type(16)));
__device__ __forceinline__ unsigned okey_pk(float a, float b) {
    const unsigned w = __builtin_bit_cast(unsigned, __builtin_amdgcn_cvt_pkrtz(a, b));
    const unsigned neg = (w >> 15) & 0x00010001u;
    return w ^ ((neg * 0xffffu) | 0x80008000u);
}
__device__ __forceinline__ void phase_index_scores(const Params& P, unsigned char* lds_) {
    using pg8::bf16x8;
    const bf16_t* Z1 = (const bf16_t*)(P.ws + WS_Z1); unsigned short* SC = (unsigned short*)(P.ws + WS_SC);
    LAS unsigned char* lds = (LAS unsigned char*)lds_;
    constexpr int QROW = 144;
    LAS unsigned char* QL = lds;
    LAS float* SG = (LAS float*)(lds + 9 * 64 * QROW);
    const int tid = threadIdx.x, lane = tid & 63, wave = __builtin_amdgcn_readfirstlane(tid >> 6);
    LAS unsigned char* ST = lds + 9 * 64 * QROW + 2048 + wave * 5120;
    const int l31 = lane & 31, hh = lane >> 5;
    for (int pid = blockIdx.x; pid < 256; pid += gridDim.x) {
        const int b = pid >> 6;
        for (int side = 0; side < 2; ++side) {
            const int qb = side ? (127 - (pid & 63)) : (pid & 63);
            const int q0 = qb * 64;
            __syncthreads();
            {
                const int qi = tid >> 3, part = tid & 7;
                const bf16_t* zr = Z1 + ((size_t)b * SEQ + q0 + qi) * Z1W;
                const u32x4 ww = *(const u32x4*)(zr + 1088);
                const float w8[8] = {bflo(ww.x), bfhi(ww.x), bflo(ww.y), bfhi(ww.y), bflo(ww.z), bfhi(ww.z), bflo(ww.w), bfhi(ww.w)};
                float wh = 0.f;
#pragma unroll
                for (int h = 0; h < 8; ++h) wh = (h == part) ? w8[h] : wh;
                const float sc = 0.5f * fabsf(wh);
                SG[qi * 8 + part] = (wh >= 0.f) ? 1.0f : -1.0f;
#pragma unroll
                for (int c = 0; c < 8; ++c) {
                    const u32x4 v = *(const u32x4*)(zr + 512 + part * 64 + c * 8);
                    u32x4 o; o.x = pk2(bflo(v.x) * sc, bfhi(v.x) * sc); o.y = pk2(bflo(v.y) * sc, bfhi(v.y) * sc); o.z = pk2(bflo(v.z) * sc, bfhi(v.z) * sc); o.w = pk2(bflo(v.w) * sc, bfhi(v.w) * sc);
                    *(LAS u32x4*)(QL + (part * 64 + qi) * QROW + c * 16) = o;
                }
                float a8[8];
#pragma unroll
                for (int j = 0; j < 8; ++j) a8[j] = 0.f;
#pragma unroll
                for (int h = 0; h < 8; ++h) {
                    const u32x4 v = *(const u32x4*)(zr + 512 + h * 64 + part * 8); const float s2 = 0.5f * w8[h];
                    a8[0] += s2 * bflo(v.x); a8[1] += s2 * bfhi(v.x); a8[2] += s2 * bflo(v.y); a8[3] += s2 * bfhi(v.y);
                    a8[4] += s2 * bflo(v.z); a8[5] += s2 * bfhi(v.z); a8[6] += s2 * bflo(v.w); a8[7] += s2 * bfhi(v.w);
                }
                u32x4 o; o.x = pk2(a8[0], a8[1]); o.y = pk2(a8[2], a8[3]); o.z = pk2(a8[4], a8[5]); o.w = pk2(a8[6], a8[7]);
                *(LAS u32x4*)(QL + (8 * 64 + qi) * QROW + part * 16) = o;
            }
            __syncthreads();
            const int ktmax = 2 * qb + 1;
            bf16x8 kn[4];
            {   const bf16_t* kr = Z1 + ((size_t)b * SEQ + min(wave, ktmax) * 32 + l31) * Z1W + 1024 + hh * 8;
#pragma unroll
                for (int dq = 0; dq < 4; ++dq) kn[dq] = *(const bf16x8*)(kr + dq * 16); }
            for (int kt = wave; kt <= ktmax; kt += NWAVE) {
                bf16x8 kf[4];
#pragma unroll
                for (int dq = 0; dq < 4; ++dq) kf[dq] = kn[dq];
                {   const bf16_t* kr = Z1 + ((size_t)b * SEQ + min(kt + NWAVE, ktmax) * 32 + l31) * Z1W + 1024 + hh * 8;
#pragma unroll
                    for (int dq = 0; dq < 4; ++dq) kn[dq] = *(const bf16x8*)(kr + dq * 16); }
#pragma unroll
                for (int qs = 0; qs < 2; ++qs) {
                    const LAS unsigned char* qrow = QL + (qs * 32 + l31) * QROW + hh * 16;
                    const LAS float* sgp = SG + (qs * 32 + l31) * 8;
                    bf16x8 fc[4], fn[4];
#pragma unroll
                    for (int dq = 0; dq < 4; ++dq) fc[dq] = *(const LAS bf16x8*)(qrow + 8 * 64 * QROW + dq * 32);
#pragma unroll
                    for (int dq = 0; dq < 4; ++dq) fn[dq] = *(const LAS bf16x8*)(qrow + dq * 32);
                    const f32x4 sg03 = *(const LAS f32x4*)(sgp), sg47 = *(const LAS f32x4*)(sgp + 4);
                    f32x16 acc;
#pragma unroll
                    for (int r = 0; r < 16; ++r) acc[r] = 0.f;
#pragma unroll
                    for (int dq = 0; dq < 4; ++dq) acc = __builtin_amdgcn_mfma_f32_32x32x16_bf16(kf[dq], fc[dq], acc, 0, 0, 0);
                    f32x16 up;
#pragma unroll
                    for (int h = 0; h < 8; ++h) {
#pragma unroll
                        for (int dq = 0; dq < 4; ++dq) fc[dq] = fn[dq];
                        if (h < 7) {
#pragma unroll
                            for (int dq = 0; dq < 4; ++dq) fn[dq] = *(const LAS bf16x8*)(qrow + (h + 1) * 64 * QROW + dq * 32);
                        }
                        f32x16 u;
#pragma unroll
                        for (int r = 0; r < 16; ++r) u[r] = 0.f;
#pragma unroll
                        for (int dq = 0; dq < 4; ++dq) u = __builtin_amdgcn_mfma_f32_32x32x16_bf16(kf[dq], fc[dq], u, 0, 0, 0);
                        __builtin_amdgcn_sched_barrier(0);
                        if (h > 0) {
                            const float sg = (h - 1 < 4) ? sg03[(h - 1) & 3] : sg47[(h - 1) & 3];
#pragma unroll
                            for (int r = 0; r < 16; ++r) acc[r] = fmaf(fabsf(up[r]), sg, acc[r]);
                        }
                        __builtin_amdgcn_sched_barrier(0);
                        up = u;
                    }
                    {
                        const float sg = sg47[3];
#pragma unroll
                        for (int r = 0; r < 16; ++r) acc[r] = fmaf(fabsf(up[r]), sg, acc[r]);
                    }
#pragma unroll
                    for (int g = 0; g < 4; ++g) { u32x2 w; w.x = okey_pk(acc[4 * g], acc[4 * g + 1]); w.y = okey_pk(acc[4 * g + 2], acc[4 * g + 3]);
                        *(LAS u32x2*)(ST + (qs * 32 + l31) * 80 + (8 * g + 4 * hh) * 2) = w; }
                }
#pragma unroll
                for (int i = 0; i < 4; ++i) {
                    const int row = 16 * i + (lane >> 2), ch = lane & 3, tl = q0 + row;
                    const u32x4 v = *(const LAS u32x4*)(ST + row * 80 + ch * 16);
                    if (kt <= (tl >> 5)) *(u32x4*)(SC + sc_row_off(b, tl) + (size_t)kt * 32 + ch * 8) = v;
                }
            }
        }
    }
}
template <int MODE>
__device__ __forceinline__ void phase_index_select(const Params& P, unsigned char* lds_) {
    const unsigned short* SC = (const unsigned short*)(P.ws + WS_SC); unsigned short* SEL = (unsigned short*)(P.ws + WS_SEL);
    const int tid = threadIdx.x, lane = tid & 63, wave = __builtin_amdgcn_readfirstlane(tid >> 6);
    LAS unsigned char* wbase = (LAS unsigned char*)lds_ + wave * 19456;
    LAS u32x4* rowbuf = (LAS u32x4*)wbase;
    LAS unsigned* hist = (LAS unsigned*)(wbase + 16384);
    LAS unsigned* dummy = hist + 512 + lane;
    LAS unsigned short* outw = (LAS unsigned short*)(wbase + 16384 + 2048 + 256);
    LAS unsigned short* dummy16 = outw + 256 + lane;
    const unsigned rowbuf0 = (unsigned)(unsigned long)wbase;
    const int gw = blockIdx.x * NWAVE + wave, NGW = gridDim.x * NWAVE;
#define SEL_DMA(tt) do { const int _tl = (tt) & (SEQ - 1), _n = _tl + 1; if (_n > TOPK) { const unsigned char* _src = (const unsigned char*)(SC + sc_row_off((tt) >> 13, _tl)) + lane * 16; \
            for (int _sg = 0; _sg * 512 < _n; ++_sg) glds16(_src + _sg * 1024, (unsigned)__builtin_amdgcn_readfirstlane((int)(rowbuf0 + _sg * 1024))); } } while (0)
#define SEL_Q(i) ((i) * NGW + (((i) & 1) ? (NGW - 1 - gw) : gw))
    if (SEL_Q(0) < NTOK) SEL_DMA(SEL_Q(0));
    for (int qi = 0; qi * NGW < NTOK; ++qi) {
        const int t = SEL_Q(qi), tnext = SEL_Q(qi + 1);
        if (t >= NTOK) { if (tnext < NTOK) SEL_DMA(tnext); continue; }
        const int tl = t & (SEQ - 1), n = tl + 1;
        unsigned short* so = SEL + (size_t)t * TOPK;
        if (n <= TOPK) { for (int i = lane; i < n; i += 64) so[i] = (unsigned short)i; if (tnext < NTOK && (qi + 1) * NGW < NTOK) SEL_DMA(tnext); continue; }
        asm volatile("s_waitcnt vmcnt(0)" ::: "memory");
        u32x4 d[16];
        const int lastsg = (n - 1) >> 9;
#pragma unroll
        for (int sg = 0; sg < 16; ++sg) {
            if (sg * 512 < n) {
                d[sg] = rowbuf[sg * 64 + lane];
                if (sg == lastsg) {
#pragma unroll
                    for (int q = 0; q < 4; ++q) { const int i0 = sg * 512 + lane * 8 + 2 * q;
                        d[sg][q] &= ((i0 < n) ? 0x0000ffffu : 0u) | ((i0 + 1 < n) ? 0xffff0000u : 0u); }
                }
            } else d[sg] = (u32x4){0u, 0u, 0u, 0u};
        }
        asm volatile("s_waitcnt lgkmcnt(0)" ::: "memory");
        if (tnext < NTOK && (qi + 1) * NGW < NTOK) SEL_DMA(tnext);
#pragma unroll
        for (int i = 0; i < 8; ++i) { hist[i * 64 + lane] = 0u; }
        asm volatile("s_waitcnt lgkmcnt(0)" ::: "memory");
        LAS unsigned* myh = hist + (lane & 1) * 256;
        if (MODE == 4) { if (d[0].x == 0x12345u) so[lane] = 1; continue; }
#pragma unroll
        for (int sg = 0; sg < 16; ++sg) if (MODE != 1 && sg * 512 < n) {
#pragma unroll
            for (int q = 0; q < 4; ++q) { const unsigned w = d[sg][q];
                __hip_atomic_fetch_add(myh + ((w >> 8) & 0xffu), 1u, __ATOMIC_RELAXED, __HIP_MEMORY_SCOPE_WORKGROUP);
                __hip_atomic_fetch_add(myh + (w >> 24), 1u, __ATOMIC_RELAXED, __HIP_MEMORY_SCOPE_WORKGROUP); }
        }
        asm volatile("s_waitcnt lgkmcnt(0)" ::: "memory");
        unsigned b1, need1;
        {
            unsigned c[4];
#pragma unroll
            for (int q = 0; q < 4; ++q) c[q] = hist[4 * lane + q] + hist[256 + 4 * lane + q];
            const unsigned mine = c[0] + c[1] + c[2] + c[3];
            unsigned suf = mine;
#pragma unroll
            for (int o = 1; o < 64; o <<= 1) { const unsigned v = __shfl_down(suf, o); if (lane + o < 64) suf += v; }
            const unsigned above = suf - mine;
            int fb = -1; unsigned fneed = 0;
            if (above < (unsigned)TOPK && suf >= (unsigned)TOPK) { unsigned a = above;
#pragma unroll
                for (int q = 3; q >= 0; --q) { if (fb < 0 && a + c[q] >= (unsigned)TOPK) { fb = 4 * lane + q; fneed = (unsigned)TOPK - a; } a += c[q]; } }
            const unsigned long long bal = __ballot(fb >= 0);
            const int src = (int)__builtin_ctzll(bal);
            b1 = (unsigned)__shfl(fb, src); need1 = __shfl(fneed, src);
        }
#pragma unroll
        for (int i = 0; i < 8; ++i) { hist[i * 64 + lane] = 0u; }
        asm volatile("s_waitcnt lgkmcnt(0)" ::: "memory");
#pragma unroll
        for (int sg = 0; sg < 16; ++sg) if (MODE != 2 && sg * 512 < n) {
#pragma unroll
            for (int q = 0; q < 4; ++q) { const unsigned w = d[sg][q];
                LAS unsigned* p0 = (((w >> 8) & 0xffu) == b1) ? (myh + (w & 0xffu)) : dummy;
                LAS unsigned* p1 = ((w >> 24) == b1) ? (myh + ((w >> 16) & 0xffu)) : dummy;
                __hip_atomic_fetch_add(p0, 1u, __ATOMIC_RELAXED, __HIP_MEMORY_SCOPE_WORKGROUP);
                __hip_atomic_fetch_add(p1, 1u, __ATOMIC_RELAXED, __HIP_MEMORY_SCOPE_WORKGROUP); }
        }
        asm volatile("s_waitcnt lgkmcnt(0)" ::: "memory");
        unsigned T, need2;
        {
            unsigned c[4];
#pragma unroll
            for (int q = 0; q < 4; ++q) c[q] = hist[4 * lane + q] + hist[256 + 4 * lane + q];
            const unsigned mine = c[0] + c[1] + c[2] + c[3];
            unsigned suf = mine;
#pragma unroll
            for (int o = 1; o < 64; o <<= 1) { const unsigned v = __shfl_down(suf, o); if (lane + o < 64) suf += v; }
            const unsigned above = suf - mine;
            int fb = -1; unsigned fneed = 0;
            if (above < need1 && suf >= need1) { unsigned a = above;
#pragma unroll
                for (int q = 3; q >= 0; --q) { if (fb < 0 && a + c[q] >= need1) { fb = 4 * lane + q; fneed = need1 - a; } a += c[q]; } }
            const unsigned long long bal = __ballot(fb >= 0);
            const int src = (int)__builtin_ctzll(bal);
            T = (b1 << 8) | (unsigned)__shfl(fb, src); need2 = __shfl(fneed, src);
        }
        unsigned base = 0; const unsigned ngt = (unsigned)TOPK - need2; unsigned eqbase = 0;
#pragma unroll
        for (int sg = 0; sg < 16; ++sg) if (MODE != 3 && sg * 512 < n) {
            unsigned ce = 0;
#pragma unroll
            for (int j = 0; j < 8; ++j) {
                const unsigned k = (j & 1) ? (d[sg][j >> 1] >> 16) : (d[sg][j >> 1] & 0xffffu);
                const bool gt = k > T;
                const unsigned long long mk = __ballot(gt);
                const unsigned pos = base + (unsigned)__builtin_amdgcn_mbcnt_hi((unsigned)(mk >> 32), __builtin_amdgcn_mbcnt_lo((unsigned)mk, 0u));
                LAS unsigned short* po = gt ? (outw + pos) : dummy16;
                *po = (unsigned short)(sg * 512 + lane * 8 + j);
                base += (unsigned)__builtin_popcountll(mk);
                ce += (k == T) ? 1u : 0u;
            }
            if (__any(ce > 0u)) {
                unsigned pre = ce;
#pragma unroll
                for (int o = 1; o < 64; o <<= 1) { const unsigned v = __shfl_up(pre, o); if (lane >= o) pre += v; }
                unsigned r = eqbase + pre - ce;
#pragma unroll
                for (int j = 0; j < 8; ++j) { const unsigned k = (j & 1) ? (d[sg][j >> 1] >> 16) : (d[sg][j >> 1] & 0xffffu);
                    if (k == T) { if (r < need2) outw[ngt + r] = (unsigned short)(sg * 512 + lane * 8 + j); ++r; } }
                eqbase += __shfl(pre, 63);
            }
        }
        asm volatile("s_waitcnt lgkmcnt(0)" ::: "memory");
        ((unsigned*)so)[lane] = ((LAS unsigned*)outw)[lane];
        ((unsigned*)so)[64 + lane] = ((LAS unsigned*)outw)[64 + lane];
        asm volatile("s_waitcnt lgkmcnt(0)" ::: "memory");
    }
#undef SEL_DMA
#undef SEL_Q
    asm volatile("s_waitcnt vmcnt(0)" ::: "memory");
}

__device__ __forceinline__ void ret_fill_image(LAS unsigned char* img, const unsigned char* src, size_t row_stride_bytes, int wave, int lane) {
#pragma unroll
    for (int e4 = 0; e4 < 4; ++e4) {
        const int e = wave * 4 + e4, row = 4 * e + (lane >> 4), q = (lane & 15) ^ ((row & 7) << 1);
        __builtin_amdgcn_global_load_lds((const unsigned*)(src + (size_t)row * row_stride_bytes + q * 16), (LAS unsigned*)(img + e * 1024), 16, 0, 0);
    }
}
__device__ __forceinline__ pg8::bf16x8 ret_tr_pair(const LAS unsigned char* img, int row0, int chunk2, int lane) {
    const int g = lane >> 4, i = lane & 15, r0 = row0 + 4 * g + (i >> 2), pb = (i & 3) >> 1, half = (i & 1) * 8;
    const int r1 = r0 + 16;
    const v4i16_t lo = __builtin_amdgcn_ds_read_tr16_b64_v4i16((LAS v4i16_t*)(img + r0 * 256 + ((((chunk2) ^ ((r0 & 7) << 1)) | pb) << 4) + half));
    const v4i16_t hi = __builtin_amdgcn_ds_read_tr16_b64_v4i16((LAS v4i16_t*)(img + r1 * 256 + ((((chunk2) ^ ((r1 & 7) << 1)) | pb) << 4) + half));
    return (pg8::bf16x8){lo[0], lo[1], lo[2], lo[3], hi[0], hi[1], hi[2], hi[3]};
}
__device__ __forceinline__ void phase_ret_kv_mfma(const Params& P, unsigned char* lds_) {
    using pg8::bf16x8;
    const unsigned char* Z0 = (const unsigned char*)(P.ws + WS_Z0); float* KV = (float*)(P.ws + WS_KV);
    LAS unsigned char* Kimg = (LAS unsigned char*)lds_; LAS unsigned char* Vimg = Kimg + 32768;
    const int tid = threadIdx.x, lane = tid & 63, wave = __builtin_amdgcn_readfirstlane(tid >> 6), fr = lane & 15, fq = lane >> 4;
    for (int u = blockIdx.x; u < 1024; u += gridDim.x) {
        const int n = u & 63, h = (u >> 6) & 3, b = u >> 8;
        const size_t row0 = (size_t)b * SEQ + n * 128;
        __syncthreads();
        ret_fill_image(Kimg, Z0 + row0 * ZW * 2 + (512 + h * 128) * 2, ZW * 2, wave, lane);
        ret_fill_image(Vimg, Z0 + row0 * ZW * 2 + (1024 + h * 128) * 2, ZW * 2, wave, lane);
        asm volatile("s_waitcnt vmcnt(0)" ::: "memory");
        __syncthreads();
        bf16x8 va[4];
#pragma unroll
        for (int jc = 0; jc < 4; ++jc) va[jc] = ret_tr_pair(Vimg, 32 * jc, 2 * wave, lane);
        const float g127 = exp2f(ret_log2g(h) * 127.0f);
        float* o = KV + (size_t)u * 16384;
#pragma unroll
        for (int dt = 0; dt < 8; ++dt) {
            f32x4 acc = {0.f, 0.f, 0.f, 0.f};
#pragma unroll
            for (int jc = 0; jc < 4; ++jc) acc = __builtin_amdgcn_mfma_f32_16x16x32_bf16(va[jc], ret_tr_pair(Kimg, 32 * jc, 2 * dt, lane), acc, 0, 0, 0);
            *(f32x4*)(o + (size_t)(16 * dt + fr) * 128 + 16 * wave + 4 * fq) = acc * g127;
        }
    }
}
__device__ __forceinline__ void phase_ret_scan_pool2(const Params& P) {
    const float* KV = (const float*)(P.ws + WS_KV); bf16_t* SB = (bf16_t*)(P.ws + WS_SB);
    const size_t gt = (size_t)blockIdx.x * NT + threadIdx.x, GS = (size_t)gridDim.x * NT;
    for (size_t i = gt; i < (size_t)16 * 8192; i += GS) {
        const int s = (int)(i >> 13), e2 = (int)(i & 8191), h = s & 3;
        const float l2 = ret_log2g(h), cd = exp2f(l2 * 128.0f), g1 = exp2f(l2);
        typedef float f32x2v __attribute__((ext_vector_type(2)));
        const f32x2v* p = (const f32x2v*)(KV + (size_t)s * 64 * 16384) + e2;
        unsigned* q = (unsigned*)(SB + (size_t)s * 64 * 16384) + e2;
        f32x2v R = {0.f, 0.f};
        for (int n0 = 0; n0 < 64; n0 += 16) {
            f32x2v kv[16];
#pragma unroll
            for (int j = 0; j < 16; ++j) kv[j] = __builtin_nontemporal_load(p + (size_t)(n0 + j) * 8192);
#pragma unroll
            for (int j = 0; j < 16; ++j) { q[(size_t)(n0 + j) * 8192] = pk2(R.x * g1, R.y * g1); R = R * cd + kv[j]; }
        }
    }
    const bf16_t* Z0 = (const bf16_t*)(P.ws + WS_Z0); bf16_t* DP = (bf16_t*)(P.ws + WS_DP);
    for (size_t i = gt; i < (size_t)NTOK * 64; i += GS) {
        const int t = (int)(i >> 6), c8 = (int)(i & 63) * 8, g = c8 >> 7, w = 2 << g, tl = t & (SEQ - 1);
        const int cnt = min(tl + 1, w);
        float sm[8];
#pragma unroll
        for (int j = 0; j < 8; ++j) sm[j] = 0.f;
        float u0[8];
        for (int q = 0; q < cnt; ++q) {
            const u32x4 v = *(const u32x4*)(Z0 + (size_t)(t - q) * ZW + 2048 + c8);
            const float f[8] = {bflo(v.x), bfhi(v.x), bflo(v.y), bfhi(v.y), bflo(v.z), bfhi(v.z), bflo(v.w), bfhi(v.w)};
#pragma unroll
            for (int j = 0; j < 8; ++j) { sm[j] += f[j]; if (q == 0) u0[j] = f[j]; }
        }
        const float inv = 1.0f / (float)cnt;
        u32x4 o; o.x = pk2(sm[0] * inv - u0[0], sm[1] * inv - u0[1]); o.y = pk2(sm[2] * inv - u0[2], sm[3] * inv - u0[3]);
        o.z = pk2(sm[4] * inv - u0[4], sm[5] * inv - u0[5]); o.w = pk2(sm[6] * inv - u0[6], sm[7] * inv - u0[7]);
        *(u32x4*)(DP + (size_t)t * 512 + c8) = o;
    }
}
__device__ __forceinline__ void phase_ret_out_mfma(const Params& P, unsigned char* lds_) {
    using pg8::bf16x8;
    const unsigned char* Z0 = (const unsigned char*)(P.ws + WS_Z0); const unsigned char* SB = (const unsigned char*)(P.ws + WS_SB); bf16_t* MIX = (bf16_t*)(P.ws + WS_MIX);
    const float* gn = P.in[3];
    LAS unsigned char* Kimg = (LAS unsigned char*)lds_; LAS unsigned char* Vimg = Kimg + 32768; LAS unsigned char* Rimg = Kimg + 65536;
    const int tid = threadIdx.x, lane = tid & 63, wave = __builtin_amdgcn_readfirstlane(tid >> 6), fr = lane & 15, fq = lane >> 4;
    for (int u = blockIdx.x; u < 1024; u += gridDim.x) {
        const int n = u & 63, h = (u >> 6) & 3, b = u >> 8;
        const size_t row0 = (size_t)b * SEQ + n * 128;
        __syncthreads();
        ret_fill_image(Kimg, Z0 + row0 * ZW * 2 + (512 + h * 128) * 2, ZW * 2, wave, lane);
        ret_fill_image(Vimg, Z0 + row0 * ZW * 2 + (1024 + h * 128) * 2, ZW * 2, wave, lane);
        ret_fill_image(Rimg, SB + (size_t)u * 32768, 256, wave, lane);
        const bf16_t* qrow = (const bf16_t*)Z0 + (row0 + 16 * wave + fr) * ZW + h * 128;
        bf16x8 qf[4], qr[4];
#pragma unroll
        for (int c = 0; c < 4; ++c) {
            qf[c] = *(const bf16x8*)(qrow + 32 * c + 8 * fq);
            const u32x2 a = *(const u32x2*)(qrow + 32 * c + 4 * fq), bb = *(const u32x2*)(qrow + 32 * c + 16 + 4 * fq);
            u32x4 w; w.x = a.x; w.y = a.y; w.z = bb.x; w.w = bb.y; qr[c] = __builtin_bit_cast(bf16x8, w);
        }
        asm volatile("s_waitcnt vmcnt(0)" ::: "memory");
        __syncthreads();
        f32x4 sT[8];
#pragma unroll
        for (int jt = 0; jt < 8; ++jt) sT[jt] = (f32x4){0.f, 0.f, 0.f, 0.f};
#pragma unroll
        for (int jt = 0; jt < 8; ++jt) if (jt <= wave) {
            const int r = 16 * jt + fr;
#pragma unroll
            for (int c = 0; c < 4; ++c) {
                const bf16x8 a = *(const LAS bf16x8*)(Kimg + r * 256 + ((((4 * c + fq)) ^ ((r & 7) << 1)) << 4));
                sT[jt] = __builtin_amdgcn_mfma_f32_16x16x32_bf16(a, qf[c], sT[jt], 0, 0, 0);
            }
            if (jt == wave) {
                if (4 * fq + 0 > fr) sT[jt].x = 0.f; if (4 * fq + 1 > fr) sT[jt].y = 0.f; if (4 * fq + 2 > fr) sT[jt].z = 0.f; if (4 * fq + 3 > fr) sT[jt].w = 0.f;
            }
        }
        bf16x8 pT[4];
#pragma unroll
        for (int jp = 0; jp < 4; ++jp) { u32x4 w; w.x = pk2(sT[2 * jp].x, sT[2 * jp].y); w.y = pk2(sT[2 * jp].z, sT[2 * jp].w); w.z = pk2(sT[2 * jp + 1].x, sT[2 * jp + 1].y); w.w = pk2(sT[2 * jp + 1].z, sT[2 * jp + 1].w);
            pT[jp] = __builtin_bit_cast(bf16x8, w); }
        f32x4 O[8];
#pragma unroll
        for (int vt = 0; vt < 8; ++vt) {
            f32x4 acc = {0.f, 0.f, 0.f, 0.f};
#pragma unroll
            for (int jp = 0; jp < 4; ++jp) if (2 * jp <= wave) acc = __builtin_amdgcn_mfma_f32_16x16x32_bf16(ret_tr_pair(Vimg, 32 * jp, 2 * vt, lane), pT[jp], acc, 0, 0, 0);
#pragma unroll
            for (int c = 0; c < 4; ++c) acc = __builtin_amdgcn_mfma_f32_16x16x32_bf16(ret_tr_pair(Rimg, 32 * c, 2 * vt, lane), qr[c], acc, 0, 0, 0);
            O[vt] = acc;
        }
        float sm = 0.f;
#pragma unroll
        for (int vt = 0; vt < 8; ++vt) sm += (O[vt].x + O[vt].y) + (O[vt].z + O[vt].w);
        sm += __shfl_xor(sm, 16); sm += __shfl_xor(sm, 32);
        const float mu = sm * (1.0f / 128.0f);
        float sq = 0.f;
#pragma unroll
        for (int vt = 0; vt < 8; ++vt) { const f32x4 dlt = O[vt] - mu; sq += (dlt.x * dlt.x + dlt.y * dlt.y) + (dlt.z * dlt.z + dlt.w * dlt.w); }
        sq += __shfl_xor(sq, 16); sq += __shfl_xor(sq, 32);
        const float rstd = 1.0f / sqrtf(sq * (1.0f / 128.0f) + LN_EPS);
        const bf16_t* grow = (const bf16_t*)Z0 + (row0 + 16 * wave + fr) * ZW + 1536 + h * 128 + 4 * fq;
        bf16_t* orow = MIX + (row0 + 16 * wave + fr) * DM + h * 128 + 4 * fq;
#pragma unroll
        for (int vt = 0; vt < 8; ++vt) {
            const u32x2 gv = *(const u32x2*)(grow + 16 * vt);
            const f32x4 g4 = *(const f32x4*)(gn + h * 128 + 16 * vt + 4 * fq);
            const f32x4 y = (O[vt] - mu) * rstd * g4;
            u32x2 w; w.x = pk2(y.x * silu_f(bflo(gv.x)), y.y * silu_f(bfhi(gv.x))); w.y = pk2(y.z * silu_f(bflo(gv.y)), y.w * silu_f(bfhi(gv.y)));
            *(u32x2*)(orow + 16 * vt) = w;
        }
    }
}

#define XB_TMO      128
#define XB_XCNT(j)  (256  + 64 * (j))
#define XB_XSUB(j)  (1280 + 64 * (j))
#define XB_XGEN(j)  (2304 + 64 * (j))
#define XB_TOP      3328
#define XB_TOPGEN   3392
#define XCD_BAR_WORDS 3456
#define XB_SPIN_CAP (1u << 22)
__device__ __forceinline__ unsigned xb_ld(unsigned* p)              { return __hip_atomic_load(p, __ATOMIC_RELAXED, __HIP_MEMORY_SCOPE_AGENT); }
__device__ __forceinline__ unsigned xb_add(unsigned* p, unsigned v) { return __hip_atomic_fetch_add(p, v, __ATOMIC_RELAXED, __HIP_MEMORY_SCOPE_AGENT); }
__device__ __forceinline__ unsigned xb_xcc_id() { return (unsigned)__builtin_amdgcn_s_getreg((3 << 11) | 20) & 0xFu; }
#define XB_SPIN(cond, bar) do { unsigned _sp = 0; while (cond) { __builtin_amdgcn_s_sleep(1); \
    if ((++_sp & 255u) == 0u) { if (xb_ld(&(bar)[XB_TMO])) break; if (_sp > XB_SPIN_CAP) { atomicAdd(&(bar)[XB_TMO], 1u); break; } } } } while (0)
struct XcdBarrier { unsigned* bar; unsigned x; volatile LAS unsigned* st; };
__device__ __forceinline__ XcdBarrier xcd_barrier_post(unsigned* bar, volatile LAS unsigned* st) {
    XcdBarrier b; b.bar = bar; b.x = xb_xcc_id(); b.st = st;
    if (threadIdx.x == 0) (void)xb_add(&bar[XB_XCNT(b.x)], 1u);
    return b;
}
__device__ __forceinline__ void xcd_barrier_complete(unsigned* bar, unsigned x, unsigned& nloc, unsigned& nx) {
    const unsigned G = gridDim.x * gridDim.y * gridDim.z;
    unsigned sum, cnt, mine, sp = 0u;
    for (;;) {
        sum = 0u; cnt = 0u; mine = 0u;
#pragma unroll
        for (unsigned j = 0; j < 16; ++j) { const unsigned c = xb_ld(&bar[XB_XCNT(j)]); sum += c; cnt += (c > 0u) ? 1u : 0u; mine = (j == x) ? c : mine; }
        if (sum == G) break;
        __builtin_amdgcn_s_sleep(1);
        if ((++sp & 255u) == 0u) { if (xb_ld(&bar[XB_TMO])) break; if (sp > XB_SPIN_CAP) { atomicAdd(&bar[XB_TMO], 1u); break; } }
    }
    nloc = mine > 0u ? mine : 1u; nx = cnt > 0u ? cnt : 1u;
}
__device__ __forceinline__ void xcd_barrier(const XcdBarrier& b) {
    asm volatile("s_waitcnt vmcnt(0)" ::: "memory");
    __syncthreads();
    if (threadIdx.x == 0) {
        unsigned* bar = b.bar;
        __builtin_amdgcn_s_waitcnt(0);
        unsigned nloc = b.st[0], nx = b.st[1];
        if (nloc == 0u) { xcd_barrier_complete(bar, b.x, nloc, nx); b.st[0] = nloc; b.st[1] = nx; }
        const unsigned old = xb_add(&bar[XB_XSUB(b.x)], 1u);
        const unsigned gen = old / nloc;
        if (old + 1u == (gen + 1u) * nloc) {
            __builtin_amdgcn_fence(__ATOMIC_RELEASE, "agent");
            asm volatile("s_waitcnt vmcnt(0)" ::: "memory");
            const unsigned og = xb_add(&bar[XB_TOP], 1u);
            const unsigned tg = og / nx;
            if (og + 1u == (tg + 1u) * nx) xb_add(&bar[XB_TOPGEN], 1u);
            else XB_SPIN(xb_ld(&bar[XB_TOPGEN]) == tg, bar);
            __builtin_amdgcn_fence(__ATOMIC_ACQUIRE, "agent");
            xb_add(&bar[XB_XGEN(b.x)], 1u);
            asm volatile("s_waitcnt vmcnt(0)" ::: "memory");
        } else {
            XB_SPIN(xb_ld(&bar[XB_XGEN(b.x)]) == gen, bar);
            __builtin_amdgcn_fence(__ATOMIC_ACQUIRE, "agent");
            asm volatile("s_waitcnt vmcnt(0)" ::: "memory");
        }
    }
    __syncthreads();
}
constexpr size_t CTL_BAR_OFF = 16384;
constexpr size_t CTL_ZERO_BYTES = 65536;

#ifdef PH_ONLY
#define IN(k) ((k) == PH_ONLY)
#else
#define IN(k) (lo <= (k) && (k) < hi)
#endif
#define SEAM(k) do { if (IN(k) && IN((k) + 1)) xcd_barrier(grid); } while (0)
#ifndef PROBE_DUP
#define PROBE_DUP (-1)
#endif
#define REP(k) for (int _rep = 0; _rep < ((PROBE_DUP == (k)) ? 2 : 1); ++_rep)
#define REPS(k) ((PROBE_DUP == 100 + (k)) ? 2 : 1)

template <int LAYER, int BASE>
__device__ __forceinline__ void layer_tail(const Params& P, unsigned char* lds, const XcdBarrier& grid, int lo, int hi) {
    unsigned char* ws = P.ws;
    int* tb = (int*)(lds + MISC_OFF);
    if (IN(BASE)) { if (PROBE_DUP == BASE) phase_ln_route<true>(P, lds, LAYER); phase_ln_route<false>(P, lds, LAYER); }
    SEAM(BASE);
    if (IN(BASE + 1)) REP(BASE + 1) { moe_setup(P, tb, LAYER);
        MoeSched S{tb, (const int*)(ws + WS_CTL) + LAYER * 64, (const int*)(ws + WS_LIST), (const bf16_t*)(ws + WS_XB),
                   (const bf16_t*)(ws + WS_W_GU) + (size_t)LAYER * 32 * DM * DM, DM, (size_t)DM * DM, true};
        EpiGU E{(bf16_t*)(ws + WS_ACT)}; gemm_moe<true>(lds, S, E);
        { const int U = tb[32] * 4, G = (int)gridDim.x, nheavy = (U % G), nlight = G - nheavy, lr = (int)blockIdx.x - nheavy;
          DenseSched S2{(const bf16_t*)(ws + WS_PB) + (size_t)LAYER * NTOK * 256, (const bf16_t*)(ws + WS_W_P) + (size_t)LAYER * DM * 256, NTOK, DM, 256, 256, 0, 1, lr, nlight};
          EpiStoreBf16 E2{(bf16_t*)(ws + WS_PP), DM, 0, nullptr}; gemm_dense(lds, S2, E2); } }
    SEAM(BASE + 1);
    if (IN(BASE + 2)) REP(BASE + 2) { moe_setup(P, tb, LAYER);
        MoeSched S{tb, (const int*)(ws + WS_CTL) + LAYER * 64, (const int*)(ws + WS_LIST), (const bf16_t*)(ws + WS_ACT),
                   (const bf16_t*)(ws + WS_W_DN) + (size_t)LAYER * 32 * DM * 512, 512, (size_t)DM * 512, false};
        EpiDown E{(bf16_t*)(ws + WS_YS)}; gemm_moe<false>(lds, S, E); }
    SEAM(BASE + 2);
    if (IN(BASE + 3)) { if (PROBE_DUP == BASE + 3) phase_ln2<true>(P, LAYER); phase_ln2<false>(P, LAYER); }
    SEAM(BASE + 3);
    if (IN(BASE + 4)) REP(BASE + 4) {
        { DenseSched S{(const bf16_t*)(ws + WS_XB), (const bf16_t*)(ws + WS_W_G) + (size_t)LAYER * DM * DM, NTOK, DM, DM, DM, 0, REPS(BASE + 4)};
          EpiPle E{(const bf16_t*)(ws + WS_XB), (const bf16_t*)(ws + WS_PP), LAYER == 1 ? P.out : (float*)nullptr, LAYER == 1 ? (bf16_t*)nullptr : (bf16_t*)(ws + WS_XB2)}; gemm_dense(lds, S, E); }
    }
}

__global__ void __launch_bounds__(NT, 2) mega(Params P, int lo, int hi) {
    extern __shared__ __attribute__((aligned(16))) unsigned char lds[];
    unsigned char* ws = P.ws;
    if (threadIdx.x < 16) ((LAS unsigned*)((LAS unsigned char*)lds + BARW_OFF))[threadIdx.x] = 0u;
    __syncthreads();
    const XcdBarrier grid = xcd_barrier_post((unsigned*)(ws + WS_CTL + CTL_BAR_OFF), (volatile LAS unsigned*)((LAS unsigned char*)lds + BARW_OFF));
    if (IN(0)) REP(0) phase_prep(P, lds);
    SEAM(0);
    if (IN(1)) REP(1) { DenseSched S{(const bf16_t*)(ws + WS_XB), (const bf16_t*)(ws + WS_W_IN0), NTOK, ZW, DM, DM, 0, REPS(1)};
        EpiZ0 E{(bf16_t*)(ws + WS_Z0)}; gemm_dense(lds, S, E); }
    SEAM(1);
    if (IN(2)) REP(2) phase_ret_kv_mfma(P, lds);
    SEAM(2);
    if (IN(3)) REP(3) phase_ret_scan_pool2(P);
    SEAM(3);
    if (IN(4)) REP(4) { phase_ret_out_mfma(P, lds); __syncthreads();
        DenseSched S{(const bf16_t*)(ws + WS_DP), (const bf16_t*)(ws + WS_W_POOL), NTOK, 512, 256, 512, 256};
        EpiStoreBf16 E{(bf16_t*)(ws + WS_MIX), DM, 512, P.in[5]}; gemm_dense(lds, S, E); }
    SEAM(4);
    if (IN(5)) REP(5) { DenseSched S{(const bf16_t*)(ws + WS_MIX), (const bf16_t*)(ws + WS_W_OUT0), NTOK, DM, DM, DM, 0, REPS(5)};
        EpiResidB E{(const bf16_t*)(ws + WS_XB), (bf16_t*)(ws + WS_F)}; gemm_dense(lds, S, E); }
    SEAM(5);
    layer_tail<0, 6>(P, lds, grid, lo, hi);
    SEAM(10);
    if (IN(11)) REP(11) { DenseSched S{(const bf16_t*)(ws + WS_XB2), (const bf16_t*)(ws + WS_W_CIN), NTOK, Z1W, DM, DM, 0, REPS(11)};
        EpiStoreBf16 E{(bf16_t*)(ws + WS_Z1), Z1W, 0, nullptr}; gemm_dense(lds, S, E); }
    SEAM(11);
    if (IN(12)) REP(12) { phase_norms(P); phase_index_scores(P, lds); }
    SEAM(12);
    if (IN(13)) { if (PROBE_DUP == 13) phase_index_select<PROBE_SEL>(P, lds); phase_index_select<0>(P, lds); }
    if (IN(13) && IN(14)) __syncthreads();
    if (IN(14)) REP(14) { DenseSched S{(const bf16_t*)(ws + WS_CQ), (const bf16_t*)(ws + WS_W_QA), NTOK, 4096, 256, 256, 0, REPS(14)};
        EpiStoreFp8 E{(unsigned char*)(ws + WS_QA), 4096}; gemm_dense(lds, S, E); }
    SEAM(14);
    if (IN(15)) { if (PROBE_DUP == 15) phase_sparse_attn_e<true>(P, lds); phase_sparse_attn_e<false>(P, lds); }
    SEAM(15);
    if (IN(16)) REP(16) { DenseSched S{(const bf16_t*)(ws + WS_OLAT), (const bf16_t*)(ws + WS_W_UVBD), NTOK, DM, DM, 4096, 1024, REPS(16)};
        EpiStoreBf16 E{(bf16_t*)(ws + WS_XB), DM, 0, nullptr}; gemm_dense_bdiag(lds, S, E); }
    SEAM(16);
    if (IN(17)) REP(17) { DenseSched S{(const bf16_t*)(ws + WS_XB), (const bf16_t*)(ws + WS_W_COUT), NTOK, DM, DM, DM, 0, REPS(17)};
        EpiResidB E{(const bf16_t*)(ws + WS_XB2), (bf16_t*)(ws + WS_F)}; gemm_dense(lds, S, E); }
    SEAM(17);
    layer_tail<1, 18>(P, lds, grid, lo, hi);
}
#undef IN
#undef SEAM

extern "C" void kernel_launch(void* const* d_in, const int* in_sizes, int n_in, void* d_out, int out_size, void* d_ws, size_t ws_size, hipStream_t stream) {
    static int grid = 0;
    if (grid == 0) {
        if (n_in != 26 || ws_size < WS_END || out_size != NTOK * DM) { fprintf(stderr, "kernel_launch: unexpected problem (n_in %d, ws %zu, out %d)\n", n_in, ws_size, out_size); grid = -1; return; }
        int dev = 0, cus = 0, per_cu = 0;
        (void)hipGetDevice(&dev);
        (void)hipDeviceGetAttribute(&cus, hipDeviceAttributeMultiprocessorCount, dev);
        (void)hipFuncSetAttribute((const void*)mega, hipFuncAttributeMaxDynamicSharedMemorySize, LDS_BYTES);
        (void)hipOccupancyMaxActiveBlocksPerMultiprocessor(&per_cu, (const void*)mega, NT, LDS_BYTES);
        if (per_cu < 1) { fprintf(stderr, "kernel_launch: occupancy query reports %d blocks per CU\n", per_cu); per_cu = 1; }
        (void)hipGetLastError();
        grid = cus;
    }
    if (grid < 0) return;
    (void)hipMemsetAsync((char*)d_ws + WS_CTL, 0, CTL_ZERO_BYTES, stream);
    Params p{};
    for (int i = 0; i < 26; ++i) p.in[i] = (const float*)d_in[i];
    p.out = (float*)d_out; p.ws = (unsigned char*)d_ws;
#if MK_ONE_LAUNCH
    int lo = 0, hi = NPH_TOTAL;
    void* args[] = {&p, &lo, &hi};
    (void)args;
    hipLaunchKernelGGL(mega, dim3(grid), dim3(NT), LDS_BYTES, stream, p, lo, hi);
    hipError_t e = hipPeekAtLastError();
    if (e != hipSuccess) fprintf(stderr, "launch failed: %s (grid %d)\n", hipGetErrorString(e), grid);
#else
    for (int k = 0; k < NPH_TOTAL; ++k) hipLaunchKernelGGL(mega, dim3(grid), dim3(NT), LDS_BYTES, stream, p, k, k + 1);
#endif
}
```

```cpp
#include <hip/hip_runtime.h>
#include <cstdio>
#include <cstdint>

#ifndef PROBE_ATT
#define PROBE_ATT 0
#endif
#ifndef PROBE_SEL
#define PROBE_SEL 0
#endif
#ifndef MK_ONE_LAUNCH
#define MK_ONE_LAUNCH 1
#endif

typedef unsigned short bf16_t;
typedef float f32x4 __attribute__((ext_vector_type(4)));
typedef unsigned u32x4 __attribute__((ext_vector_type(4)));
typedef unsigned u32x2 __attribute__((ext_vector_type(2)));

constexpr int NT = 512;
constexpr int NWAVE = NT / 64;
constexpr int NTOK = 32768, DM = 1024, SEQ = 8192, NBATCH = 4;
constexpr int ZW = 2560;
constexpr int Z1W = 1280;
constexpr int CIN = 1096;
constexpr int TOPK = 256;
constexpr float ALPHA = 1.4142135623730951f;
constexpr float LN_EPS = 1e-5f;
constexpr int LDS_BYTES = 163840;
constexpr int BARW_OFF = LDS_BYTES - 64;
constexpr int MISC_OFF = 135168;

constexpr size_t MiB = (size_t)1 << 20;
constexpr size_t WS_CTL = 0;
constexpr size_t WS_W_IN0 = 1 * MiB, WS_W_OUT0 = 6 * MiB, WS_W_POOL = 8 * MiB, WS_W_CIN = 9 * MiB, WS_W_QA = 12 * MiB,
                 WS_W_UVBD = 14 * MiB, WS_W_COUT = 16 * MiB, WS_W_G = 18 * MiB, WS_W_P = 22 * MiB, WS_W_GU = 24 * MiB, WS_W_DN = 152 * MiB;
constexpr size_t WS_XB = 224 * MiB, WS_F = 288 * MiB, WS_PB = 416 * MiB, WS_PP = 448 * MiB, WS_CQ = 512 * MiB, WS_CKV = 528 * MiB,
                 WS_SEL = 544 * MiB, WS_TOKG = 560 * MiB, WS_LIST = 561 * MiB, WS_CKV8 = 566 * MiB;
constexpr size_t WS_M0 = 576 * MiB;
constexpr size_t WS_Z0 = WS_M0, WS_KV = WS_M0 + 160 * MiB, WS_MIX = WS_M0 + 224 * MiB, WS_DP = WS_M0 + 288 * MiB, WS_SB = WS_M0 + 320 * MiB;
constexpr size_t WS_OLAT = WS_M0, WS_QA = WS_F  , WS_SC = WS_M0, WS_Z1 = WS_M0 + 272 * MiB;
constexpr size_t WS_ACT = WS_M0, WS_YS = WS_M0 + 72 * MiB;
constexpr size_t WS_XB2 = 960 * MiB;
constexpr size_t WS_END = 1024 * MiB;
constexpr int LIST_CAP = 32768;
constexpr size_t WS_GT = WS_CTL + 262144;
constexpr size_t WS_SGB = WS_CTL + 786432;

struct Params {
    const float* in[26];
    float* out;
    unsigned char* ws;
};

__device__ __forceinline__ unsigned f2bf(float f) { unsigned u = __float_as_uint(f); return (u + 0x7fffu + ((u >> 16) & 1u)) >> 16; }
__device__ __forceinline__ float bf2f(unsigned h) { return __uint_as_float(h << 16); }
typedef float f32x2_t __attribute__((ext_vector_type(2))); typedef __bf16 bf16x2_t __attribute__((ext_vector_type(2)));
__device__ __forceinline__ unsigned pk2(float lo, float hi) { f32x2_t v = {lo, hi}; bf16x2_t b = __builtin_convertvector(v, bf16x2_t); return __builtin_bit_cast(unsigned, b); }
__device__ __forceinline__ float bflo(unsigned w) { return __uint_as_float(w << 16); }
__device__ __forceinline__ float bfhi(unsigned w) { return __uint_as_float(w & 0xffff0000u); }
#define WAVE_SUM_DPP(v) ({ float _v = (v); \
    _v += __builtin_bit_cast(float, __builtin_amdgcn_update_dpp(0, __builtin_bit_cast(int, _v), 0xB1, 0xf, 0xf, true));     \
    _v += __builtin_bit_cast(float, __builtin_amdgcn_update_dpp(0, __builtin_bit_cast(int, _v), 0x4E, 0xf, 0xf, true));     \
    _v += __builtin_bit_cast(float, __builtin_amdgcn_update_dpp(0, __builtin_bit_cast(int, _v), 0x141, 0xf, 0xf, true));    \
    _v += __builtin_bit_cast(float, __builtin_amdgcn_update_dpp(0, __builtin_bit_cast(int, _v), 0x140, 0xf, 0xf, true));    \
    _v += __builtin_bit_cast(float, __builtin_amdgcn_update_dpp(0, __builtin_bit_cast(int, _v), 0x142, 0xa, 0xf, false));   \
    _v += __builtin_bit_cast(float, __builtin_amdgcn_update_dpp(0, __builtin_bit_cast(int, _v), 0x143, 0xc, 0xf, false));   \
    __builtin_bit_cast(float, __builtin_amdgcn_readlane(__builtin_bit_cast(int, _v), 63)); })
__device__ __forceinline__ float wave_sum(float v) { return WAVE_SUM_DPP(v); }
#define WAVE_SCAN_DPP(v) ({ unsigned _v = (v); \
    _v += (unsigned)__builtin_amdgcn_update_dpp(0, (int)_v, 0x111, 0xf, 0xf, false); \
    _v += (unsigned)__builtin_amdgcn_update_dpp(0, (int)_v, 0x112, 0xf, 0xf, false); \
    _v += (unsigned)__builtin_amdgcn_update_dpp(0, (int)_v, 0x114, 0xf, 0xf, false); \
    _v += (unsigned)__builtin_amdgcn_update_dpp(0, (int)_v, 0x118, 0xf, 0xf, false); \
    _v += (unsigned)__builtin_amdgcn_update_dpp(0, (int)_v, 0x142, 0xa, 0xf, false); \
    _v += (unsigned)__builtin_amdgcn_update_dpp(0, (int)_v, 0x143, 0xc, 0xf, false); \
    _v; })

__device__ __forceinline__ float silu_f(float a) { return a / (1.0f + __expf(-a)); }
__device__ __forceinline__ float sigmoid_f(float a) { return 1.0f / (1.0f + __expf(-a)); }
#define LDS_FENCE() asm volatile("s_waitcnt lgkmcnt(0)" ::: "memory")

struct UnitInfo {
    const bf16_t* A; int lda;
    const int* rows; int rshift;
    int nvalid;
    const bf16_t* Bt; int ldb;
    int K;
    int orow0;
    int pn;
};

struct DenseSched {
    const bf16_t* A; const bf16_t* Bt; int M, N, K, lda, a_pn_stride; int reps = 1;
    int wrank = -1, wcount = 0;
    __device__ __forceinline__ bool next(int round, UnitInfo& u) const {
        const int nN = N >> 8, nM = M >> 8, nwg = nN * nM;
        if (wcount > 0 && wrank < 0) return false;
        const long L = (wcount > 0) ? ((long)round * wcount + wrank) : ((long)round * gridDim.x + blockIdx.x); if (L >= (long)nwg * reps) return false;
        int wgid = (int)(L % nwg); { const int q = nwg / 8, r = nwg % 8, xcd = wgid % 8, off = wgid / 8; wgid = (xcd < r ? xcd * (q + 1) : r * (q + 1) + (xcd - r) * q) + off; }
        const int nig = 8 * nN, gid = wgid / nig, fm = gid * 8, gsz = (nM - fm) < 8 ? (nM - fm) : 8;
        const int pm = fm + ((wgid % nig) % gsz), pn = (wgid % nig) / gsz;
        u.A = A + (size_t)pm * 256 * lda + (size_t)pn * a_pn_stride; u.lda = lda; u.rows = nullptr; u.rshift = 0; u.nvalid = 256;
        u.Bt = Bt + (size_t)pn * 256 * K; u.ldb = K; u.K = K; u.orow0 = pm * 256; u.pn = pn;
        return true;
    }
};
struct MoeSched {
    const int* tb; const int* cnt; const int* list;
    const bf16_t* A; const bf16_t* W; int K; size_t wstride; bool gather;
    __device__ __forceinline__ bool next(int round, UnitInfo& u) const {
        const int i = round * gridDim.x + blockIdx.x;
        const int j = i >> 2, pn = i & 3;
        if (j >= tb[32]) return false;
        int e = 0;
        while (tb[e + 1] <= j) ++e;
        const int rb = j - tb[e];
        const int nv = min(256, cnt[e] - rb * 256);
        u.rows = list + (size_t)e * LIST_CAP + rb * 256; u.nvalid = nv; u.orow0 = j * 256; u.pn = pn;
        if (gather) { u.A = A; u.lda = K; u.rshift = 1; }
        else { u.A = A + (size_t)j * 256 * K; u.lda = K; u.rshift = 31;   }
        u.Bt = W + (size_t)e * wstride + (size_t)pn * 256 * K; u.ldb = K; u.K = K;
        return true;
    }
};


namespace pg8 {
#define LAS __attribute__((address_space(3)))
typedef short bf16x8 __attribute__((ext_vector_type(8)));
constexpr int BK = 64, HALF = 128, HTB = HALF * BK * 2, STAGE_BYTES = 8 * HTB;
__device__ __forceinline__ int lds_byte(int r, int c) { const int st = (r >> 4) * 2 + (c >> 5), rr = r & 15, cc = c & 31, ob = rr * 64 + cc * 2; return st * 1024 + (ob ^ (((ob >> 9) & 1) << 5)); }
__device__ __forceinline__ void stage_rc(int b, int& R, int& C) { const int st = b / 1024, sb = b % 1024, swz = sb ^ (((sb >> 9) & 1) << 5); R = (st >> 1) * 16 + swz / 64; C = (st & 1) * 32 + (swz % 64) / 2; }
__device__ __forceinline__ int perm32(int rho) { const int n = rho >> 4, i = rho & 15; return 8 * (i >> 2) + 4 * n + (i & 3); }

template <bool GATHER, class Sched, class Epi, bool BDIAG = false>
__device__ __forceinline__ void gemm_phase(LAS unsigned char* lds, const LAS unsigned* rowtab, const Sched& S, const Epi& E, const int lda, const int ldb, const int K) {
    const int tid = threadIdx.x, wid = __builtin_amdgcn_readfirstlane(tid >> 6), lane = tid & 63, wr = wid >> 2, wc = wid & 3, fr = lane & 15, fq = lane >> 4;
    const int nt = K / BK;
    unsigned voffA[2], voffB[2]; int RA[2]; unsigned CA2[2];
#pragma unroll
    for (int i = 0; i < 2; ++i) { int R, C; stage_rc(tid * 16 + i * 8192, R, C); const int Rb = (R & ~31) + perm32(R & 31);
        voffA[i] = (unsigned)(R * lda + C) * 2u; voffB[i] = (unsigned)(Rb * ldb + C) * 2u; RA[i] = R; CA2[i] = (unsigned)C * 2u; }
    const size_t kstep = (size_t)(BK * 2);
    const size_t hstepA = (size_t)HALF * lda * 2, hstepB = (size_t)HALF * ldb * 2;
    const unsigned ldsw = (unsigned)wid * 1024u;
    const int aoff = lds_byte(wr * 64 + fr, fq * 8), boff = lds_byte(wc * 32 + fr, fq * 8);
    unsigned offA[2][2];
#define PG8_SA(b, h) (((b) * 2 + (h)) * HTB)
#define PG8_SB(b, h) ((4 + (b) * 2 + (h)) * HTB)
#define PG8_STAGE(bufoff, gbase, voff) do { _Pragma("unroll") for (int _i = 0; _i < 2; ++_i) \
        __builtin_amdgcn_global_load_lds((const unsigned*)((const char*)(gbase) + (voff)[_i]), (LAS unsigned*)(lds + (bufoff) + ldsw + _i * 8192), 16, 0, 0); } while (0)
#define PG8_STAGE_A(bufoff, h, gbase) do { if (GATHER) PG8_STAGE(bufoff, gbase, offA[h]); else PG8_STAGE(bufoff, (gbase) + (h) * hstepA, voffA); } while (0)
#define PG8_LOADOFF(round) do { _Pragma("unroll") for (int _h = 0; _h < 2; ++_h) _Pragma("unroll") for (int _i = 0; _i < 2; ++_i) offA[_h][_i] = rowtab[(round) * 256 + _h * 128 + RA[_i]] + CA2[_i]; } while (0)
#define PG8_LDA(dst, b, h) do { _Pragma("unroll") for (int m = 0; m < 4; ++m) _Pragma("unroll") for (int k = 0; k < 2; ++k) dst[m][k] = *(const LAS bf16x8*)(lds + PG8_SA(b, h) + aoff + m * 2048 + k * 1024); } while (0)
#define PG8_LDB(dst, b, h) do { _Pragma("unroll") for (int n = 0; n < 2; ++n) _Pragma("unroll") for (int k = 0; k < 2; ++k) dst[n][k] = *(const LAS bf16x8*)(lds + PG8_SB(b, h) + boff + n * 2048 + k * 1024); } while (0)
#define PG8_MMA(ai, bj, At, Bt) do { if (!BDIAG || (((kt_ >> 2) & 3) == 2 * (bj) + (wc >> 1))) { __builtin_amdgcn_s_setprio(1); _Pragma("unroll") for (int m = 0; m < 4; ++m) _Pragma("unroll") for (int n = 0; n < 2; ++n) _Pragma("unroll") for (int k = 0; k < 2; ++k) \
        acc[ai][bj][m][n] = __builtin_amdgcn_mfma_f32_16x16x32_bf16(Bt[n][k], At[m][k], acc[ai][bj][m][n], 0, 0, 0); __builtin_amdgcn_s_setprio(0); } } while (0)
#define PG8_WAIT_V(n) asm volatile("s_waitcnt vmcnt(" #n ")" ::: "memory")
#define PG8_WAIT_L(n) asm volatile("s_waitcnt lgkmcnt(" #n ")" ::: "memory")
#define PG8_BAR __builtin_amdgcn_s_barrier()
#define PG8_SCHED __builtin_amdgcn_sched_barrier(0)
    UnitInfo cur, nxt; int ui = 0;
    if (!S.next(0, cur)) return;
    f32x4 acc[2][2][4][2];
#pragma unroll
    for (int a = 0; a < 2; ++a)
#pragma unroll
        for (int b = 0; b < 2; ++b)
#pragma unroll
            for (int m = 0; m < 4; ++m)
#pragma unroll
                for (int n = 0; n < 2; ++n) acc[a][b][m][n] = (f32x4){0.f, 0.f, 0.f, 0.f};
    bf16x8 At[4][2], B0[2][2], B1[2][2];
    const char* cA = (const char*)cur.A; const char* cB = (const char*)cur.Bt;
    if (GATHER) { PG8_LOADOFF(0); }
    PG8_STAGE(PG8_SB(0, 0), cB, voffB); PG8_STAGE(PG8_SB(0, 1), cB + hstepB, voffB); PG8_STAGE_A(PG8_SA(0, 0), 0, cA); PG8_STAGE_A(PG8_SA(0, 1), 1, cA);
    if (wr == 1) PG8_BAR;
    PG8_WAIT_V(2); PG8_BAR;
    PG8_STAGE(PG8_SB(1, 0), cB + kstep, voffB); PG8_STAGE_A(PG8_SA(1, 0), 0, cA + kstep); PG8_STAGE(PG8_SB(1, 1), cB + hstepB + kstep, voffB);
    PG8_WAIT_V(6); PG8_BAR;
    for (;;) {
        const bool has_next = S.next(ui + 1, nxt);
        const char* nA = has_next ? (const char*)nxt.A : cA; const char* nB = has_next ? (const char*)nxt.Bt : cB;
        for (int t = 0; t < nt; t += 2) {
            const bool last = (t == nt - 2);
            const char* a1 = cA + (size_t)(t + 1) * kstep;
            const char* a2 = last ? nA : cA + (size_t)(t + 2) * kstep; const char* b2 = last ? nB : cB + (size_t)(t + 2) * kstep;
            const char* a3 = a2 + kstep; const char* b3 = b2 + kstep;
            int kt_ = t;
            PG8_LDB(B0, 0, 0); PG8_LDB(B1, 0, 1); PG8_SCHED; PG8_LDA(At, 0, 0); PG8_STAGE_A(PG8_SA(1, 1), 1, a1);
            if (GATHER) { if (last && has_next) { PG8_LOADOFF(ui + 1); } }
            PG8_WAIT_V(8); PG8_WAIT_L(0); PG8_BAR; PG8_MMA(0, 0, At, B0); PG8_MMA(0, 1, At, B1); PG8_BAR; PG8_SCHED;
            PG8_LDA(At, 0, 1); PG8_STAGE(PG8_SB(0, 0), b2, voffB); PG8_STAGE(PG8_SB(0, 1), b2 + hstepB, voffB); PG8_STAGE_A(PG8_SA(0, 0), 0, a2);
            PG8_WAIT_V(8); PG8_WAIT_L(0); PG8_BAR; PG8_MMA(1, 0, At, B0); PG8_MMA(1, 1, At, B1); PG8_BAR; PG8_SCHED;
            kt_ = t + 1;
            PG8_LDB(B0, 1, 0); PG8_LDB(B1, 1, 1); PG8_SCHED; PG8_LDA(At, 1, 0); PG8_STAGE_A(PG8_SA(0, 1), 1, a2);
            PG8_WAIT_V(8); PG8_WAIT_L(0); PG8_BAR; PG8_MMA(0, 0, At, B0); PG8_MMA(0, 1, At, B1); PG8_BAR; PG8_SCHED;
            PG8_LDA(At, 1, 1); PG8_STAGE(PG8_SB(1, 0), b3, voffB); PG8_STAGE(PG8_SB(1, 1), b3 + hstepB, voffB); PG8_STAGE_A(PG8_SA(1, 0), 0, a3);
            PG8_WAIT_V(8); PG8_WAIT_L(0); PG8_BAR; PG8_MMA(1, 0, At, B0); PG8_MMA(1, 1, At, B1); PG8_BAR; PG8_SCHED;
        }
        if (wr == 0) PG8_BAR;
#pragma unroll
        for (int ai = 0; ai < 2; ++ai)
#pragma unroll
            for (int m = 0; m < 4; ++m)
#pragma unroll
                for (int bj = 0; bj < 2; ++bj) E(cur, ai * HALF + wr * 64 + m * 16 + fr, bj * HALF + wc * 32 + 8 * fq, acc[ai][bj][m][0], acc[ai][bj][m][1]);
        if (!has_next) break;
#pragma unroll
        for (int a = 0; a < 2; ++a)
#pragma unroll
            for (int b = 0; b < 2; ++b)
#pragma unroll
                for (int m = 0; m < 4; ++m)
#pragma unroll
                    for (int n = 0; n < 2; ++n) acc[a][b][m][n] = (f32x4){0.f, 0.f, 0.f, 0.f};
        cur = nxt; cA = nA; cB = nB; ++ui;
        if (wr == 1) PG8_BAR;
    }
    PG8_WAIT_V(0);
    PG8_BAR;
#undef PG8_SA
#undef PG8_SB
#undef PG8_STAGE
#undef PG8_STAGE_A
#undef PG8_LOADOFF
#undef PG8_LDA
#undef PG8_LDB
#undef PG8_MMA
#undef PG8_WAIT_V
#undef PG8_WAIT_L
#undef PG8_BAR
#undef PG8_SCHED
}
}

template <class Sched, class Epi>
__device__ __forceinline__ void gemm_dense(unsigned char* lds, const Sched& S, const Epi& E) {
    pg8::gemm_phase<false>((LAS unsigned char*)lds, (const LAS unsigned*)nullptr, S, E, S.lda, S.K, S.K);
    __syncthreads();
}
template <class Sched, class Epi>
__device__ __forceinline__ void gemm_dense_bdiag(unsigned char* lds, const Sched& S, const Epi& E) {
    pg8::gemm_phase<false, Sched, Epi, true>((LAS unsigned char*)lds, (const LAS unsigned*)nullptr, S, E, S.lda, S.K, S.K);
    __syncthreads();
}


template <bool GATHER, class Epi>
__device__ __forceinline__ void gemm_moe(unsigned char* lds, const MoeSched& S, const Epi& E) {
    LAS unsigned* rowtab = (LAS unsigned*)(lds + MISC_OFF + 256);
    if (GATHER) {
        UnitInfo u;
        for (int round = 0; round < 10 && S.next(round, u); ++round)
            if (threadIdx.x < 256) rowtab[round * 256 + threadIdx.x] = ((int)threadIdx.x < u.nvalid) ? (unsigned)(u.rows[threadIdx.x] >> 1) * (unsigned)(S.K * 2) : 0u;
        __syncthreads();
    }
    pg8::gemm_phase<GATHER>((LAS unsigned char*)lds, (const LAS unsigned*)rowtab, S, E, S.K, S.K, S.K);
    __syncthreads();
}

__device__ __forceinline__ u32x4 pack8(f32x4 a, f32x4 b) { u32x4 w; w.x = pk2(a.x, a.y); w.y = pk2(a.z, a.w); w.z = pk2(b.x, b.y); w.w = pk2(b.z, b.w); return w; }
struct EpiStoreBf16 {
    bf16_t* O; int ldc; int coff; const float* colscale;
    __device__ __forceinline__ void operator()(const UnitInfo& u, int r, int c, f32x4 v0, f32x4 v1) const {
        const int col = u.pn * 256 + c;
        if (colscale) { const f32x4 s0 = *(const f32x4*)(colscale + col), s1 = *(const f32x4*)(colscale + col + 4); v0 *= s0; v1 *= s1; }
        *(u32x4*)(O + (size_t)(u.orow0 + r) * ldc + coff + col) = pack8(v0, v1);
    }
};

__device__ __forceinline__ float ret_log2g(int h) { return log2f(1.0f - exp2f(-5.0f - (float)h)); }
struct EpiZ0 {
    bf16_t* O;
    __device__ __forceinline__ void operator()(const UnitInfo& u, int r, int c, f32x4 v0, f32x4 v1) const {
        const int col = u.pn * 256 + c, row = u.orow0 + r;
        if (col < 1024) { const float e = ret_log2g((col >> 7) & 3) * (float)(row & 127); const float sc = exp2f(col < 512 ? e : -e); v0 *= sc; v1 *= sc; }
        *(u32x4*)(O + (size_t)row * ZW + col) = pack8(v0, v1);
    }
};

struct EpiStoreFp8 {
    unsigned char* O; int ldc;
    __device__ __forceinline__ void operator()(const UnitInfo& u, int r, int c, f32x4 v0, f32x4 v1) const {
        int w0 = __builtin_amdgcn_cvt_pk_fp8_f32(v0.x, v0.y, 0, false); w0 = __builtin_amdgcn_cvt_pk_fp8_f32(v0.z, v0.w, w0, true);
        int w1 = __builtin_amdgcn_cvt_pk_fp8_f32(v1.x, v1.y, 0, false); w1 = __builtin_amdgcn_cvt_pk_fp8_f32(v1.z, v1.w, w1, true);
        u32x2 w; w.x = (unsigned)w0; w.y = (unsigned)w1;
        *(u32x2*)(O + (size_t)(u.orow0 + r) * ldc + u.pn * 256 + c) = w;
    }
};
struct EpiResidB {
    const bf16_t* X; bf16_t* Yo;
    __device__ __forceinline__ void operator()(const UnitInfo& u, int r, int c, f32x4 v0, f32x4 v1) const {
        const size_t off = (size_t)(u.orow0 + r) * DM + u.pn * 256 + c;
        const u32x4 xw = *(const u32x4*)(X + off);
        const f32x4 x0 = {bflo(xw.x), bfhi(xw.x), bflo(xw.y), bfhi(xw.y)}, x1 = {bflo(xw.z), bfhi(xw.z), bflo(xw.w), bfhi(xw.w)};
        *(u32x4*)(Yo + off) = pack8(x0 * ALPHA + v0, x1 * ALPHA + v1);
    }
};

struct EpiGU {
    bf16_t* ACT;
    __device__ __forceinline__ void operator()(const UnitInfo& u, int r, int c, f32x4 v0, f32x4 v1) const {
        u32x2 w; w.x = pk2(silu_f(v0.x) * v0.y, silu_f(v0.z) * v0.w); w.y = pk2(silu_f(v1.x) * v1.y, silu_f(v1.z) * v1.w);
        *(u32x2*)(ACT + (size_t)(u.orow0 + r) * 512 + u.pn * 128 + (c >> 1)) = w;
    }
};
struct EpiDown {
    bf16_t* YS;
    __device__ __forceinline__ void operator()(const UnitInfo& u, int r, int c, f32x4 v0, f32x4 v1) const {
        if (r < u.nvalid) { const int pair = u.rows[r]; *(u32x4*)(YS + (size_t)pair * DM + u.pn * 256 + c) = pack8(v0, v1); }
    }
};
struct EpiPle {
    const bf16_t* XI; const bf16_t* PP; float* OUT; bf16_t* XO;
    __device__ __forceinline__ void operator()(const UnitInfo& u, int r, int c, f32x4 v0, f32x4 v1) const {
        const size_t off = (size_t)(u.orow0 + r) * DM + u.pn * 256 + c;
        const u32x4 pw = *(const u32x4*)(PP + off), xw = *(const u32x4*)(XI + off);
        f32x4 f0 = {bflo(xw.x), bfhi(xw.x), bflo(xw.y), bfhi(xw.y)}, f1 = {bflo(xw.z), bfhi(xw.z), bflo(xw.w), bfhi(xw.w)};
        f0.x += sigmoid_f(v0.x) * bflo(pw.x); f0.y += sigmoid_f(v0.y) * bfhi(pw.x); f0.z += sigmoid_f(v0.z) * bflo(pw.y); f0.w += sigmoid_f(v0.w) * bfhi(pw.y);
        f1.x += sigmoid_f(v1.x) * bflo(pw.z); f1.y += sigmoid_f(v1.y) * bfhi(pw.z); f1.z += sigmoid_f(v1.z) * bflo(pw.w); f1.w += sigmoid_f(v1.w) * bfhi(pw.w);
        if (OUT) { *(f32x4*)(OUT + off) = f0; *(f32x4*)(OUT + off + 4) = f1; }
        if (XO) *(u32x4*)(XO + off) = pack8(f0, f1);
    }
};

struct TrDesc { const float* src; bf16_t* dst; int K, N, Nsrc, nbatch, mode, dst_ld; };
struct TrItem { const float* src; bf16_t* dst; int Nsrc, dst_ld, mode, kb, nb; };
__device__ __forceinline__ void tr_load(const TrItem& t, int lane, float (&tmp)[32]) {
    const int k0 = 64 * t.kb, n0 = 32 * t.nb, Ns = t.Nsrc;
    const bool okc = (n0 + (lane & 31)) < Ns;
    const float* p = t.src + (size_t)(k0 + (lane >> 5)) * Ns + n0 + (lane & 31);
#pragma unroll
    for (int i = 0; i < 32; ++i) { tmp[i] = okc ? __builtin_nontemporal_load(p) : 0.f; p += 2 * Ns; asm volatile("" : "+v"(p)); }
}
__device__ __forceinline__ void tr_store(const TrItem& t, float* scr, int lane, const float (&tmp)[32]) {
    const int k0 = 64 * t.kb, n0 = 32 * t.nb;
#pragma unroll
    for (int i = 0; i < 32; ++i) scr[(2 * i + (lane >> 5)) * 33 + (lane & 31)] = tmp[i];
    LDS_FENCE();
    const int c = lane & 7;
    int n8 = lane >> 3; asm volatile("" : "+v"(n8));
#pragma unroll
    for (int j = 0; j < 4; ++j) {
        const int n = n8 + 8 * j; const float* sp = scr + (8 * c) * 33 + n;
        const int ng = n0 + n;
        float sc = 1.f; int nd = ng; int coff = 0;
        if (t.mode == 1) { if (ng >= 512 && ng < 1024) sc = 0.08838834764831845f; }
        if (t.mode == 2) { nd = (ng < 512) ? 2 * ng : 2 * (ng - 512) + 1; }
        if (t.mode == 3) { coff = ((ng >> 6) & 3) * 256; }
        u32x4 o; o.x = pk2(sp[0 * 33] * sc, sp[1 * 33] * sc); o.y = pk2(sp[2 * 33] * sc, sp[3 * 33] * sc); o.z = pk2(sp[4 * 33] * sc, sp[5 * 33] * sc); o.w = pk2(sp[6 * 33] * sc, sp[7 * 33] * sc);
        *(u32x4*)(t.dst + (size_t)nd * t.dst_ld + coff + k0 + 8 * c) = o;
    }
    LDS_FENCE();
}
__device__ __forceinline__ int tr_items(const TrDesc& d) { return d.nbatch * (d.K / 64) * (d.N / 32); }

constexpr int N_DEFERRED = 32 * 512 + 32 * 256;
__device__ __forceinline__ TrItem deferred_item(const Params& P, int idx) {
    TrItem t;
    if (idx < 32 * 512) { const int b = 32 + (idx >> 9), r = idx & 511;
        t.src = P.in[22] + (size_t)b * 1024 * 1024; t.dst = (bf16_t*)(P.ws + WS_W_GU) + (size_t)b * 1024 * 1024; t.Nsrc = 1024; t.dst_ld = 1024; t.mode = 2; t.kb = r >> 5; t.nb = r & 31; }
    else { const int i2 = idx - 32 * 512, b = 32 + (i2 >> 8), r = i2 & 255;
        t.src = P.in[23] + (size_t)b * 512 * 1024; t.dst = (bf16_t*)(P.ws + WS_W_DN) + (size_t)b * 1024 * 512; t.Nsrc = 1024; t.dst_ld = 512; t.mode = 0; t.kb = r >> 5; t.nb = r & 31; }
    return t;
}
__device__ __forceinline__ void phase_prep(const Params& P, unsigned char* lds) {
    unsigned char* ws = P.ws;
    const int tid = threadIdx.x, lane = tid & 63, wave = tid >> 6;
    const int gw = blockIdx.x * NWAVE + wave, NGW = gridDim.x * NWAVE;
    float* scr = (float*)lds + wave * (64 * 33);
    constexpr int ND = 9;
    TrDesc d[ND];
    d[0] = {P.in[22], (bf16_t*)(ws + WS_W_GU), 1024, 1024, 1024, 32, 2, 1024};
    d[1] = {P.in[23], (bf16_t*)(ws + WS_W_DN), 512, 1024, 1024, 32, 0, 512};
    d[2] = {P.in[2], (bf16_t*)(ws + WS_W_IN0), 1024, 2560, 2560, 1, 1, 1024};
    d[3] = {P.in[6], (bf16_t*)(ws + WS_W_OUT0), 1024, 1024, 1024, 1, 0, 1024};
    d[4] = {P.in[13], (bf16_t*)(ws + WS_W_COUT), 1024, 1024, 1024, 1, 0, 1024};
    d[5] = {P.in[24], (bf16_t*)(ws + WS_W_G), 1024, 1024, 1024, 2, 0, 1024};
    d[6] = {P.in[25], (bf16_t*)(ws + WS_W_P), 256, 1024, 1024, 2, 0, 256};
    d[7] = {P.in[7], (bf16_t*)(ws + WS_W_CIN), 1024, Z1W, CIN, 1, 0, 1024};
    d[8] = {P.in[12], (bf16_t*)(ws + WS_W_UVBD), 256, 1024, 1024, 1, 3, 1024};
    int total = 0;
#pragma unroll
    for (int i = 0; i < ND; ++i) total += tr_items(d[i]);
#define TR_DECODE(it, T) do { int _r = (it); bool _f = false; T = TrItem{nullptr, nullptr, 0, 0, 0, 0, 0}; _Pragma("unroll") for (int _i = 0; _i < ND; ++_i) { const int _n = tr_items(d[_i]); \
            if (!_f && _r < _n) { _f = true; const int _per = (d[_i].K / 64) * (d[_i].N / 32), _b = _r / _per, _q = _r % _per, _nblk = d[_i].N / 32; \
                T.src = d[_i].src + (size_t)_b * d[_i].K * d[_i].Nsrc; T.dst = d[_i].dst + (size_t)_b * d[_i].N * d[_i].dst_ld; T.Nsrc = d[_i].Nsrc; T.dst_ld = d[_i].dst_ld; T.mode = d[_i].mode; T.kb = _q / _nblk; T.nb = _q % _nblk; } \
            if (!_f) _r -= _n; } } while (0)
    {
        float cur[32], nxt[32];
        TrItem tc, tn;
        int it = gw;
        if (it < total) { TR_DECODE(it, tc); tr_load(tc, lane, cur); }
        while (it < total) {
            const int itn = it + NGW;
            if (itn < total) { TR_DECODE(itn, tn); tr_load(tn, lane, nxt); }
            tr_store(tc, scr, lane, cur);
#pragma unroll
            for (int i = 0; i < 32; ++i) cur[i] = nxt[i];
            it = itn; tc = tn;
        }
    }
#undef TR_DECODE
    const size_t gt = (size_t)blockIdx.x * NT + tid, GS = (size_t)gridDim.x * NT;
    {
        bf16_t* o = (bf16_t*)(ws + WS_W_POOL); const float* pw = P.in[4];
        for (size_t i = gt; i < 512 * 256; i += GS) { const int n = (int)(i >> 8), k = (int)(i & 255), g = n >> 7, dd = n & 127, kg = k >> 7, c = k & 127;
            o[i] = (bf16_t)((kg == (g & 1)) ? f2bf(pw[((size_t)g * 128 + c) * 128 + dd]) : 0u); }
    }
    {
        u32x4* o = (u32x4*)(ws + WS_W_UVBD);
        for (size_t i = gt; i < (size_t)1024 * 1024 / 8; i += GS) { const int n = (int)(i >> 7), k = (int)(i & 127) * 8; if (((n >> 6) & 3) != (k >> 8)) o[i] = (u32x4){0u, 0u, 0u, 0u}; }
    }
    {
        bf16_t* o = (bf16_t*)(ws + WS_W_QA); const float* uq = P.in[10]; const float* uk = P.in[11];
        float* Bq = (float*)lds; float* Ak = Bq + 256 * 65;
        for (int item = blockIdx.x; item < 128; item += gridDim.x) {
            const int h = item >> 3, c0 = (item & 7) * 32;
            __syncthreads();
            for (int i = tid; i < 256 * 16; i += NT) { const int r = i >> 4, d4 = (i & 15) * 4; const f32x4 v = *(const f32x4*)(uq + (size_t)r * 1024 + h * 64 + d4);
                float* q = Bq + r * 65 + d4; q[0] = v.x; q[1] = v.y; q[2] = v.z; q[3] = v.w; }
            for (int i = tid; i < 32 * 16; i += NT) { const int c = i >> 4, d4 = (i & 15) * 4; const f32x4 v = *(const f32x4*)(uk + (size_t)(c0 + c) * 1024 + h * 64 + d4);
                float* q = Ak + c * 65 + d4; q[0] = v.x; q[1] = v.y; q[2] = v.z; q[3] = v.w; }
            __syncthreads();
            const int r = tid & 255, cg = tid >> 8;
            float acc[16];
#pragma unroll
            for (int j = 0; j < 16; ++j) acc[j] = 0.f;
            for (int dd = 0; dd < 64; ++dd) { const float bv = Bq[r * 65 + dd];
#pragma unroll
                for (int j = 0; j < 16; ++j) acc[j] += Ak[(cg * 16 + j) * 65 + dd] * bv; }
#pragma unroll
            for (int j = 0; j < 16; ++j) o[(size_t)(h * 256 + c0 + cg * 16 + j) * 256 + r] = (bf16_t)f2bf(acc[j] * 0.125f);
        }
        __syncthreads();
    }
    {
        bf16_t* GT = (bf16_t*)(ws + WS_GT); float* SGB = (float*)(ws + WS_SGB);
        for (size_t i = gt; i < (size_t)2 * 48 * 1024; i += GS) {
            const int l = (int)(i / (48 * 1024)), j = (int)((i / 1024) % 48), c = (int)(i & 1023);
            float w = 0.f;
            if (j < 4) w = P.in[18][(size_t)l * DM * 4 + (size_t)c * 4 + j]; else if (j < 36) w = P.in[20][(size_t)l * DM * 32 + (size_t)c * 32 + (j - 4)];
            const float g = P.in[14][l * DM + c] * w;
            const unsigned hi = f2bf(g); const unsigned lo = f2bf(g - bf2f(hi));
            GT[((size_t)(l * 2 + 0) * 48 + j) * 1024 + c] = (bf16_t)hi; GT[((size_t)(l * 2 + 1) * 48 + j) * 1024 + c] = (bf16_t)lo;
        }
        for (int it = gw; it < 96; it += NGW) {
            const int l = it / 48, j = it % 48; float sg = 0.f, sb = 0.f;
            for (int c = lane; c < 1024; c += 64) {
                float w = 0.f;
                if (j < 4) w = P.in[18][(size_t)l * DM * 4 + (size_t)c * 4 + j]; else if (j < 36) w = P.in[20][(size_t)l * DM * 32 + (size_t)c * 32 + (j - 4)];
                sg += P.in[14][l * DM + c] * w; sb += P.in[15][l * DM + c] * w;
            }
            sg = wave_sum(sg); sb = wave_sum(sb);
            const float bias = (j < 4) ? P.in[19][l * 4 + j] : ((j < 36) ? P.in[21][l * 32 + (j - 4)] : 0.f);
            if (lane == 0) { SGB[(l * 2 + 0) * 48 + j] = sg; SGB[(l * 2 + 1) * 48 + j] = sb + bias; }
        }
    }
    {
        const f32x4* x = (const f32x4*)P.in[0]; u32x4* xb = (u32x4*)(ws + WS_XB);
        const size_t nx = (size_t)NTOK * DM / 8, np = (size_t)2 * NTOK * 256 / 8;
        size_t i = gt;
        for (; i + 3 * GS < nx; i += 4 * GS) { f32x4 a[8];
#pragma unroll
            for (int q = 0; q < 4; ++q) { a[2 * q] = __builtin_nontemporal_load(x + 2 * (i + q * GS)); a[2 * q + 1] = __builtin_nontemporal_load(x + 2 * (i + q * GS) + 1); }
#pragma unroll
            for (int q = 0; q < 4; ++q) xb[i + q * GS] = pack8(a[2 * q], a[2 * q + 1]); }
        for (; i < nx; i += GS) xb[i] = pack8(x[2 * i], x[2 * i + 1]);
        const f32x4* p = (const f32x4*)P.in[1]; u32x4* pb = (u32x4*)(ws + WS_PB);
        i = gt;
        for (; i + 3 * GS < np; i += 4 * GS) { f32x4 a[8];
#pragma unroll
            for (int q = 0; q < 4; ++q) { a[2 * q] = __builtin_nontemporal_load(p + 2 * (i + q * GS)); a[2 * q + 1] = __builtin_nontemporal_load(p + 2 * (i + q * GS) + 1); }
#pragma unroll
            for (int q = 0; q < 4; ++q) pb[i + q * GS] = pack8(a[2 * q], a[2 * q + 1]); }
        for (; i < np; i += GS) pb[i] = pack8(p[2 * i], p[2 * i + 1]);
    }
}


template <bool DRY>
__device__ __forceinline__ void phase_ln_route(const Params& P, unsigned char* lds, int layer) {
    using pg8::bf16x8;
    const bf16_t* F = (const bf16_t*)(P.ws + WS_F); bf16_t* XB = (bf16_t*)(P.ws + (DRY ? WS_M0 + 128 * MiB : WS_XB));
    float* TOKG = (float*)(P.ws + WS_TOKG); int* LIST = (int*)(P.ws + WS_LIST);
    int* CNT = (int*)(P.ws + WS_CTL) + layer * 64;
    const float* lg = P.in[14] + layer * DM; const float* lb = P.in[15] + layer * DM;
    const bf16_t* GTh = (const bf16_t*)(P.ws + WS_GT) + (size_t)(layer * 2) * 48 * 1024; const bf16_t* GTl = GTh + 48 * 1024;
    const float* SG = (const float*)(P.ws + WS_SGB) + (layer * 2) * 48; const float* BB = SG + 48;
    const int tid = threadIdx.x, lane = tid & 63, wave = tid >> 6, r16 = lane & 15, g = lane >> 4;
    int* dec = (int*)lds;
    int* rank = dec + 256;
    int* lcnt = rank + 256;
    int* lbase = lcnt + 32;
    float* stat = (float*)(lds + 4096) + wave * 32;
    float* LG = (float*)(lds + 8192) + wave * (16 * 48);
    f32x4 g4[4], b4[4];
#pragma unroll
    for (int j = 0; j < 4; ++j) { g4[j] = *(const f32x4*)(lg + 256 * j + 4 * lane); b4[j] = *(const f32x4*)(lb + 256 * j + 4 * lane); }
    for (int rb = blockIdx.x; rb < NTOK / 128; rb += gridDim.x) {
        if (tid < 32) lcnt[tid] = 0;
        __syncthreads();
        const int tbase = rb * 128 + wave * 16;
        f32x4 acc[3];
#pragma unroll
        for (int i = 0; i < 3; ++i) acc[i] = (f32x4){0.f, 0.f, 0.f, 0.f};
        float sm = 0.f, sq = 0.f;
        const bf16_t* yrow = F + (size_t)(tbase + r16) * DM + 8 * g;
        const bf16_t* ghp = GTh + (size_t)r16 * 1024 + 8 * g; const bf16_t* glp = GTl + (size_t)r16 * 1024 + 8 * g;
#pragma unroll 2
        for (int k = 0; k < 32; ++k) {
            const u32x4 yw = *(const u32x4*)(yrow + 32 * k);
            bf16x8 gh[3], gl[3];
#pragma unroll
            for (int i = 0; i < 3; ++i) { gh[i] = *(const bf16x8*)(ghp + (size_t)i * 16 * 1024 + 32 * k); gl[i] = *(const bf16x8*)(glp + (size_t)i * 16 * 1024 + 32 * k); }
            const float y0 = bflo(yw.x), y1 = bfhi(yw.x), y2 = bflo(yw.y), y3 = bfhi(yw.y), y4 = bflo(yw.z), y5 = bfhi(yw.z), y6 = bflo(yw.w), y7 = bfhi(yw.w);
            sm += (y0 + y1) + (y2 + y3) + (y4 + y5) + (y6 + y7);
            sq += (y0 * y0 + y1 * y1) + (y2 * y2 + y3 * y3) + (y4 * y4 + y5 * y5) + (y6 * y6 + y7 * y7);
            const bf16x8 yh = __builtin_bit_cast(bf16x8, yw);
#pragma unroll
            for (int i = 0; i < 3; ++i) {
                acc[i] = __builtin_amdgcn_mfma_f32_16x16x32_bf16(yh, gh[i], acc[i], 0, 0, 0);
                acc[i] = __builtin_amdgcn_mfma_f32_16x16x32_bf16(yh, gl[i], acc[i], 0, 0, 0);
            }
        }
        sm += __shfl_xor(sm, 16); sm += __shfl_xor(sm, 32); sq += __shfl_xor(sq, 16); sq += __shfl_xor(sq, 32);
        const float mean = sm * (1.0f / DM), var = fmaxf(sq * (1.0f / DM) - mean * mean, 0.f), rstd = 1.0f / sqrtf(var + LN_EPS);
        if (g == 0) { stat[r16 * 2] = mean; stat[r16 * 2 + 1] = rstd; }
        LDS_FENCE();
#pragma unroll
        for (int i = 0; i < 3; ++i) { const float sg = SG[16 * i + r16], bb = BB[16 * i + r16];
#pragma unroll
            for (int r = 0; r < 4; ++r) { const float mu = stat[(4 * g + r) * 2], rs = stat[(4 * g + r) * 2 + 1];
                LG[(4 * g + r) * 48 + 16 * i + r16] = rs * (acc[i][r] - mu * sg) + bb; } }
        LDS_FENCE();
        if (lane < 16) {
            const float* lr = LG + lane * 48; const int rl = wave * 16 + lane, t = tbase + lane;
            float gl4[4];
#pragma unroll
            for (int j = 0; j < 4; ++j) gl4[j] = lr[j];
            int grp = 0; float gm = gl4[0];
#pragma unroll
            for (int j = 1; j < 4; ++j) if (gl4[j] > gm) { gm = gl4[j]; grp = j; }
            float gs = 0.f;
#pragma unroll
            for (int j = 0; j < 4; ++j) gs += __expf(gl4[j] - gm);
            const float gwt = 1.0f / gs;
            float el[8];
#pragma unroll
            for (int j = 0; j < 8; ++j) el[j] = lr[4 + grp * 8 + j];
            int i0 = 0; float m0 = el[0];
#pragma unroll
            for (int j = 1; j < 8; ++j) if (el[j] > m0) { m0 = el[j]; i0 = j; }
            int i1 = -1; float m1 = -INFINITY;
#pragma unroll
            for (int j = 0; j < 8; ++j) if (j != i0 && el[j] > m1) { m1 = el[j]; i1 = j; }
            const float ex = __expf(m1 - m0);
            const float p0 = 1.0f / (1.0f + ex), p1 = ex / (1.0f + ex);
            dec[rl * 2] = grp * 8 + i0; dec[rl * 2 + 1] = grp * 8 + i1;
            if (!DRY) { TOKG[(size_t)t * 2] = gwt * p0; TOKG[(size_t)t * 2 + 1] = gwt * p1; }
        }
#pragma unroll 4
        for (int r = 0; r < 16; ++r) {
            const float mu = stat[r * 2], rs = stat[r * 2 + 1];
            const bf16_t* fr = F + (size_t)(tbase + r) * DM + 4 * lane; bf16_t* xo = XB + (size_t)(tbase + r) * DM + 4 * lane;
#pragma unroll
            for (int j = 0; j < 4; ++j) { const u32x2 yw = *(const u32x2*)(fr + 256 * j); const f32x4 y = {bflo(yw.x), bfhi(yw.x), bflo(yw.y), bfhi(yw.y)};
                const f32x4 v = (y - mu) * rs * g4[j] + b4[j];
                u32x2 w; w.x = pk2(v.x, v.y); w.y = pk2(v.z, v.w); *(u32x2*)(xo + 256 * j) = w; }
        }
        __syncthreads();
        if (tid < 256) rank[tid] = atomicAdd(&lcnt[dec[tid]], 1);
        __syncthreads();
        if (tid < 32) lbase[tid] = DRY ? 0 : atomicAdd(&CNT[tid], lcnt[tid]);
        __syncthreads();
        if (!DRY && tid < 256) { const int e = dec[tid]; LIST[(size_t)e * LIST_CAP + lbase[e] + rank[tid]] = (rb * 128 + (tid >> 1)) * 2 + (tid & 1); }
        __syncthreads();
    }
}
__device__ __forceinline__ void moe_setup(const Params& P, int* tb, int layer) {
    const int* CNT = (const int*)(P.ws + WS_CTL) + layer * 64;
    if (threadIdx.x == 0) { int a = 0; for (int e = 0; e < 32; ++e) { tb[e] = a; a += (CNT[e] + 255) >> 8; } tb[32] = a; }
    __syncthreads();
}
template <bool DRY>
__device__ __forceinline__ void phase_ln2(const Params& P, int layer) {
    const bf16_t* XI = (const bf16_t*)(P.ws + WS_XB); bf16_t* XO = (bf16_t*)(P.ws + (DRY ? WS_XB2 : WS_XB));
    const bf16_t* YS = (const bf16_t*)(P.ws + WS_YS); const float* TOKG = (const float*)(P.ws + WS_TOKG);
    const float* lg = P.in[16] + layer * DM; const float* lb = P.in[17] + layer * DM;
    const int lane = threadIdx.x & 63, gw = blockIdx.x * NWAVE + (threadIdx.x >> 6), NGW = gridDim.x * NWAVE;
    f32x4 g4[4], b4[4];
#pragma unroll
    for (int j = 0; j < 4; ++j) { g4[j] = *(const f32x4*)(lg + 256 * j + 4 * lane); b4[j] = *(const f32x4*)(lb + 256 * j + 4 * lane); }
    u32x2 nx[4], na[4], nb[4]; float ng0 = 0.f, ng1 = 0.f;
    if (gw < NTOK) { const int t = gw;
#pragma unroll
        for (int j = 0; j < 4; ++j) { const int c0 = 256 * j + 4 * lane; nx[j] = *(const u32x2*)(XI + (size_t)t * DM + c0); na[j] = *(const u32x2*)(YS + (size_t)(2 * t) * DM + c0); nb[j] = *(const u32x2*)(YS + (size_t)(2 * t + 1) * DM + c0); }
        ng0 = TOKG[(size_t)t * 2]; ng1 = TOKG[(size_t)t * 2 + 1]; }
    for (int t = gw; t < NTOK; t += NGW) {
        const float g0 = ng0, g1 = ng1;
        u32x2 xw[4], aw[4], bw[4];
#pragma unroll
        for (int j = 0; j < 4; ++j) { xw[j] = nx[j]; aw[j] = na[j]; bw[j] = nb[j]; }
        if (t + NGW < NTOK) { const int tn = t + NGW;
#pragma unroll
            for (int j = 0; j < 4; ++j) { const int c0 = 256 * j + 4 * lane; nx[j] = *(const u32x2*)(XI + (size_t)tn * DM + c0); na[j] = *(const u32x2*)(YS + (size_t)(2 * tn) * DM + c0); nb[j] = *(const u32x2*)(YS + (size_t)(2 * tn + 1) * DM + c0); }
            ng0 = TOKG[(size_t)tn * 2]; ng1 = TOKG[(size_t)tn * 2 + 1]; }
        f32x4 v[4]; float s = 0.f;
#pragma unroll
        for (int j = 0; j < 4; ++j) {
            const u32x2 x = xw[j], a = aw[j], b = bw[j];
            v[j].x = bflo(x.x) * ALPHA + g0 * bflo(a.x) + g1 * bflo(b.x); v[j].y = bfhi(x.x) * ALPHA + g0 * bfhi(a.x) + g1 * bfhi(b.x);
            v[j].z = bflo(x.y) * ALPHA + g0 * bflo(a.y) + g1 * bflo(b.y); v[j].w = bfhi(x.y) * ALPHA + g0 * bfhi(a.y) + g1 * bfhi(b.y);
            s += (v[j].x + v[j].y) + (v[j].z + v[j].w); }
        const float mean = wave_sum(s) * (1.0f / DM); float s2 = 0.f;
#pragma unroll
        for (int j = 0; j < 4; ++j) { v[j] = v[j] - mean; s2 += (v[j].x * v[j].x + v[j].y * v[j].y) + (v[j].z * v[j].z + v[j].w * v[j].w); }
        const float rstd = 1.0f / sqrtf(wave_sum(s2) * (1.0f / DM) + LN_EPS);
#pragma unroll
        for (int j = 0; j < 4; ++j) { const int c0 = 256 * j + 4 * lane;
            v[j] = v[j] * rstd * g4[j] + b4[j];
            u32x2 w; w.x = pk2(v[j].x, v[j].y); w.y = pk2(v[j].z, v[j].w); *(u32x2*)(XO + (size_t)t * DM + c0) = w; }
    }
}

__device__ __forceinline__ unsigned e5m2enc(float y) {
    const unsigned hb = (unsigned)__builtin_bit_cast(unsigned short, (_Float16)y);
    return ((hb + 0x7fu + ((hb >> 8) & 1u)) >> 8) & 0xffu;
}
__device__ __forceinline__ void phase_norms(const Params& P) {
    const bf16_t* Z1 = (const bf16_t*)(P.ws + WS_Z1); bf16_t* CQ = (bf16_t*)(P.ws + WS_CQ); bf16_t* CKV = (bf16_t*)(P.ws + WS_CKV); unsigned char* CKV8 = (unsigned char*)(P.ws + WS_CKV8);
    const float* qn = P.in[8]; const float* kn = P.in[9];
    const int lane = threadIdx.x & 63, gw = blockIdx.x * NWAVE + (threadIdx.x >> 6), NGW = gridDim.x * NWAVE;
    for (int t = gw; t < NTOK; t += NGW) {
        const u32x2 a = *(const u32x2*)(Z1 + (size_t)t * Z1W + 4 * lane), b = *(const u32x2*)(Z1 + (size_t)t * Z1W + 256 + 4 * lane);
        const float q[4] = {bflo(a.x), bfhi(a.x), bflo(a.y), bfhi(a.y)}, k[4] = {bflo(b.x), bfhi(b.x), bflo(b.y), bfhi(b.y)};
        const float sq = wave_sum(q[0] * q[0] + q[1] * q[1] + q[2] * q[2] + q[3] * q[3]), sk = wave_sum(k[0] * k[0] + k[1] * k[1] + k[2] * k[2] + k[3] * k[3]);
        const float rq = 1.0f / sqrtf(sq * (1.0f / 256.0f) + 1e-6f), rk = 1.0f / sqrtf(sk * (1.0f / 256.0f) + 1e-6f);
        const f32x4 gq = *(const f32x4*)(qn + 4 * lane), gk = *(const f32x4*)(kn + 4 * lane);
        u32x2 o; o.x = pk2(q[0] * rq * gq.x, q[1] * rq * gq.y); o.y = pk2(q[2] * rq * gq.z, q[3] * rq * gq.w);
        *(u32x2*)(CQ + (size_t)t * 256 + 4 * lane) = o;
        o.x = pk2(k[0] * rk * gk.x, k[1] * rk * gk.y); o.y = pk2(k[2] * rk * gk.z, k[3] * rk * gk.w);
        *(u32x2*)(CKV + (size_t)t * 256 + 4 * lane) = o;
        *(unsigned*)(CKV8 + (size_t)t * 256 + 4 * lane) = e5m2enc(k[0] * rk * gk.x) | (e5m2enc(k[1] * rk * gk.y) << 8) | (e5m2enc(k[2] * rk * gk.z) << 16) | (e5m2enc(k[3] * rk * gk.w) << 24);
    }
}


constexpr int NPH_TOTAL = 23;


typedef short v4i16_t __attribute__((ext_vector_type(4)));


__device__ __forceinline__ void glds16(const void* gsrc, unsigned lds_dst) {
    unsigned keep;
    asm volatile("s_mov_b32 %0, m0\n\ts_mov_b32 m0, %2\n\ts_nop 0\n\tglobal_load_lds_dwordx4 %1, off\n\ts_mov_b32 m0, %0" : "=&s"(keep) : "v"(gsrc), "s"(lds_dst) : "memory");
}
__device__ __forceinline__ void glds16_set(const void* gsrc, unsigned lds_dst) {
    asm volatile("s_mov_b32 m0, %1\n\ts_nop 0\n\tglobal_load_lds_dwordx4 %0, off" : : "v"(gsrc), "s"(lds_dst) : "memory", "m0");
}
template <int OFF> __device__ __forceinline__ void glds16_m0(const void* gsrc) {
    asm volatile("global_load_lds_dwordx4 %0, off offset:%1" : : "v"(gsrc), "n"(OFF) : "memory");
}
typedef _Float16 f16x8 __attribute__((ext_vector_type(8)));
typedef int v8i_t __attribute__((ext_vector_type(8)));
template <bool DRY>
__device__ __forceinline__ void phase_sparse_attn_e(const Params& P, unsigned char* lds_) {
    const unsigned char* QA = (const unsigned char*)(P.ws + WS_QA); bf16_t* OLAT = (bf16_t*)(P.ws + WS_OLAT); const unsigned char* CKV8 = (const unsigned char*)(P.ws + WS_CKV8); const unsigned short* SEL = (const unsigned short*)(P.ws + WS_SEL);
    const int tid = threadIdx.x, lane = tid & 63, wave = __builtin_amdgcn_readfirstlane(tid >> 6);
    const int fr = lane & 15, fq = lane >> 4;
    LAS unsigned char* cbuf = (LAS unsigned char*)lds_ + wave * 17920;
    LAS unsigned short* selw = (LAS unsigned short*)(cbuf + 16384);
    LAS unsigned* selo = (LAS unsigned*)(cbuf + 16384 + 512);
    LAS unsigned* selo_st = selo + (lane >> 3) * 32 + (lane & 7);
    const unsigned cbuf0 = (unsigned)(unsigned long)cbuf;
    const int G = gridDim.x, NGW = G * NWAVE;
    int vw;
    if ((G & 7) == 0) vw = (((int)blockIdx.x & 7) * (G >> 3) + ((int)blockIdx.x >> 3)) * NWAVE + wave; else vw = (int)blockIdx.x * NWAVE + wave;
    const float LOG2E = 1.4426950408889634f;
    const float slope2 = exp2f(-0.5f * (float)(fr + 1)) * LOG2E;
    unsigned qoffB[4];
#pragma unroll
    for (int e = 0; e < 4; ++e) { const int r15 = (4 * e + fq) & 15; qoffB[e] = (unsigned)((fr ^ (((r15 & 7) << 1) | (r15 >> 3))) << 4); }
    const unsigned fA = (unsigned)(((fr & 7) << 1) | (fr >> 3));
    const unsigned SA = (fA & 14u) << 4, baseA = (unsigned)fr * 256u + ((((unsigned)fq >> 1) ^ (fA & 1u)) << 4) + ((unsigned)fq & 1u) * 8u;
    const int rT = 4 * fq + (fr >> 2), pT_ = fr & 3;
    const unsigned fT = (unsigned)(((rT & 7) << 1) | (rT >> 3));
    const unsigned ST = (fT & 14u) << 4, baseT = (unsigned)rT * 256u + ((((unsigned)pT_ >> 1) ^ (fT & 1u)) << 4) + ((unsigned)pT_ & 1u) * 8u;
    const int per = NGW >> 2, bq = vw / per, wb = vw % per;
    int ditem = DRY ? N_DEFERRED : vw;
    u32x2 selnext = {0u, 0u}; long qfn[8];
    if (wb < SEQ) { const int t0 = bq * SEQ + wb; selnext = *(const u32x2*)(SEL + (size_t)t0 * TOPK + 4 * lane);
#pragma unroll
        for (int cc = 0; cc < 8; ++cc) qfn[cc] = *(const long*)(QA + (size_t)t0 * 4096 + fr * 256 + 32 * cc + 8 * fq); }
    for (int tl0 = wb; tl0 < SEQ; tl0 += per) {
        const int t = bq * SEQ + tl0;
        const int b = t >> 13, tl = t & (SEQ - 1), ns = min(tl + 1, TOPK), nch = (ns + 31) >> 5;
        const bool has_nextq = (tl0 + per < SEQ);
        asm volatile("s_waitcnt vmcnt(0)" ::: "memory");
        {
            const u32x2 w = selnext;
            unsigned short i0 = (unsigned short)(w.x & 0xffffu), i1 = (unsigned short)(w.x >> 16), i2 = (unsigned short)(w.y & 0xffffu), i3 = (unsigned short)(w.y >> 16);
            const int k0 = 4 * lane;
            if (k0 >= ns) i0 = 0; if (k0 + 1 >= ns) i1 = 0; if (k0 + 2 >= ns) i2 = 0; if (k0 + 3 >= ns) i3 = 0;
            u32x2 o; o.x = (unsigned)i0 | ((unsigned)i1 << 16); o.y = (unsigned)i2 | ((unsigned)i3 << 16);
            asm volatile("s_waitcnt lgkmcnt(0)" ::: "memory");
            *(LAS u32x2*)(selw + 4 * lane) = o;
            selo_st[0] = (unsigned)i0 << 8; selo_st[8] = (unsigned)i1 << 8; selo_st[16] = (unsigned)i2 << 8; selo_st[24] = (unsigned)i3 << 8;
        }
        v8i_t qB[2];
#pragma unroll
        for (int cc = 0; cc < 8; ++cc) { const u32x2 qw = __builtin_bit_cast(u32x2, qfn[cc]); qB[cc >> 2][2 * (cc & 3)] = (int)qw.x; qB[cc >> 2][2 * (cc & 3) + 1] = (int)qw.y; }
#define ATT_PREFETCH() do { if (has_nextq) { const int tn_ = t + per; selnext = *(const u32x2*)(SEL + (size_t)tn_ * TOPK + 4 * lane); \
            _Pragma("unroll") for (int cc = 0; cc < 8; ++cc) qfn[cc] = *(const long*)(QA + (size_t)tn_ * 4096 + fr * 256 + 32 * cc + 8 * fq); pf = true; } } while (0)
        f32x4 Oe[8], Oo[8];
#pragma unroll
        for (int ut = 0; ut < 8; ++ut) { Oe[ut] = (f32x4){0.f, 0.f, 0.f, 0.f}; Oo[ut] = (f32x4){0.f, 0.f, 0.f, 0.f}; }
        float m = -INFINITY, l = 0.f;
        const unsigned char* cb = CKV8 + (size_t)b * SEQ * 256;
        asm volatile("s_waitcnt vmcnt(0) lgkmcnt(0)" ::: "memory");
        const unsigned char* cbq0 = cb + qoffB[0]; const unsigned char* cbq1 = cb + qoffB[1] - 1024; const unsigned char* cbq2 = cb + qoffB[2] - 2048; const unsigned char* cbq3 = cb + qoffB[3] - 3072;
        asm volatile("" : "+v"(cbq0), "+v"(cbq1), "+v"(cbq2), "+v"(cbq3));
#define ATT_DMA(jj, bufoff) do { u32x4 oa_ = *(const LAS u32x4*)(selo + 32 * (jj) + 8 * fq), ob_ = *(const LAS u32x4*)(selo + 32 * (jj) + 8 * fq + 4); \
            if (DRY && PROBE_ATT == 1) { oa_ = (u32x4){0u, 256u, 512u, 768u}; ob_ = oa_; } \
            if (!(DRY && PROBE_ATT == 3)) { \
                glds16_set(cbq0 + oa_.x, (unsigned)__builtin_amdgcn_readfirstlane((int)(cbuf0 + (bufoff)))); \
                glds16_m0<1024>(cbq1 + oa_.y); glds16_m0<2048>(cbq2 + oa_.z); glds16_m0<3072>(cbq3 + oa_.w); \
                glds16_set(cbq0 + ob_.x, (unsigned)__builtin_amdgcn_readfirstlane((int)(cbuf0 + (bufoff) + 4096))); \
                glds16_m0<1024>(cbq1 + ob_.y); glds16_m0<2048>(cbq2 + ob_.z); glds16_m0<3072>(cbq3 + ob_.w); } } while (0)
        ATT_DMA(0, 0);
        if (nch > 1) ATT_DMA(1, 8192);
        const bool have_item = ditem < N_DEFERRED;
        TrItem titem = deferred_item(P, have_item ? ditem : 0);
        float tcur[32];
        bool trf = false, pf = false;
        if (nch <= 2) { if (have_item) { tr_load(titem, lane, tcur); trf = true; } ATT_PREFETCH(); }
        for (int j = 0; j < nch; ++j) {
            const unsigned bo = (unsigned)(j & 1) * 8192u;
            if (j + 1 < nch) { if (trf && pf) asm volatile("s_waitcnt vmcnt(49)" ::: "memory"); else if (trf) asm volatile("s_waitcnt vmcnt(40)" ::: "memory");
                               else if (pf) asm volatile("s_waitcnt vmcnt(17)" ::: "memory"); else asm volatile("s_waitcnt vmcnt(8)" ::: "memory"); }
            else { if (trf && pf) asm volatile("s_waitcnt vmcnt(41)" ::: "memory"); else if (trf) asm volatile("s_waitcnt vmcnt(32)" ::: "memory");
                   else if (pf) asm volatile("s_waitcnt vmcnt(9)" ::: "memory"); else asm volatile("s_waitcnt vmcnt(0)" ::: "memory"); }
            const LAS unsigned char* img = cbuf + bo;
            if (DRY && PROBE_ATT == 2) { if (j + 2 < nch) { asm volatile("s_waitcnt lgkmcnt(0)" ::: "memory"); ATT_DMA(j + 2, bo); } continue; }
            f32x4 s0 = {0.f, 0.f, 0.f, 0.f}, s1 = {0.f, 0.f, 0.f, 0.f};
#pragma unroll
            for (int hb = 0; hb < 2; ++hb) {
                u32x2 ra[4], rb[4];
#pragma unroll
                for (int c4 = 0; c4 < 4; ++c4) { const int cc = hb * 4 + c4; const LAS unsigned char* pa = img + ((SA ^ (unsigned)(cc << 5)) + baseA); ra[c4] = *(const LAS u32x2*)(pa); rb[c4] = *(const LAS u32x2*)(pa + 4096); }
                __builtin_amdgcn_sched_barrier(0);
                v8i_t A0, A1;
#pragma unroll
                for (int c4 = 0; c4 < 4; ++c4) { A0[2 * c4] = (int)ra[c4].x; A0[2 * c4 + 1] = (int)ra[c4].y; A1[2 * c4] = (int)rb[c4].x; A1[2 * c4 + 1] = (int)rb[c4].y; }
                s0 = __builtin_amdgcn_mfma_scale_f32_16x16x128_f8f6f4(A0, qB[hb], s0, 1, 0, 0, 0, 0, 0);
                s1 = __builtin_amdgcn_mfma_scale_f32_16x16x128_f8f6f4(A1, qB[hb], s1, 1, 0, 0, 0, 0, 0);
                __builtin_amdgcn_sched_barrier(0);
            }
            const u32x2 k0w = *(const LAS u32x2*)(selw + 32 * j + 4 * fq), k1w = *(const LAS u32x2*)(selw + 32 * j + 16 + 4 * fq);
            u32x2 tl_[4], th_[4];
#pragma unroll
            for (int ut = 0; ut < 4; ++ut) { const LAS unsigned char* pt = img + ((ST ^ (unsigned)(ut << 5)) + baseT);
                tl_[ut] = __builtin_bit_cast(u32x2, __builtin_amdgcn_ds_read_tr16_b64_v4i16((LAS v4i16_t*)(pt)));
                th_[ut] = __builtin_bit_cast(u32x2, __builtin_amdgcn_ds_read_tr16_b64_v4i16((LAS v4i16_t*)(pt + 4096))); }
            __builtin_amdgcn_sched_barrier(0);
            const int rem = ns - (32 * j + 4 * fq);
            float lg[8];
            {
                const int i00 = (int)(k0w.x & 0xffffu), i01 = (int)(k0w.x >> 16), i02 = (int)(k0w.y & 0xffffu), i03 = (int)(k0w.y >> 16);
                const int i10 = (int)(k1w.x & 0xffffu), i11 = (int)(k1w.x >> 16), i12 = (int)(k1w.y & 0xffffu), i13 = (int)(k1w.y >> 16);
                lg[0] = (0 < rem) ? s0.x * LOG2E - slope2 * (float)(tl - i00) : -INFINITY;
                lg[1] = (1 < rem) ? s0.y * LOG2E - slope2 * (float)(tl - i01) : -INFINITY;
                lg[2] = (2 < rem) ? s0.z * LOG2E - slope2 * (float)(tl - i02) : -INFINITY;
                lg[3] = (3 < rem) ? s0.w * LOG2E - slope2 * (float)(tl - i03) : -INFINITY;
                lg[4] = (16 < rem) ? s1.x * LOG2E - slope2 * (float)(tl - i10) : -INFINITY;
                lg[5] = (17 < rem) ? s1.y * LOG2E - slope2 * (float)(tl - i11) : -INFINITY;
                lg[6] = (18 < rem) ? s1.z * LOG2E - slope2 * (float)(tl - i12) : -INFINITY;
                lg[7] = (19 < rem) ? s1.w * LOG2E - slope2 * (float)(tl - i13) : -INFINITY;
            }
            const float cm = fmaxf(fmaxf(fmaxf(lg[0], lg[1]), fmaxf(lg[2], lg[3])), fmaxf(fmaxf(lg[4], lg[5]), fmaxf(lg[6], lg[7])));
            if (j == 0) { float cx = fmaxf(cm, __shfl_xor(cm, 16)); m = fmaxf(cx, __shfl_xor(cx, 32)); }
            else if (__any(cm > m + 8.0f)) {
                float cx = fmaxf(cm, __shfl_xor(cm, 16)); cx = fmaxf(cx, __shfl_xor(cx, 32));
                const float mn = fmaxf(m, cx);
                const float sc = __builtin_amdgcn_exp2f(m - mn);
                l *= sc;
#pragma unroll
                for (int ut = 0; ut < 8; ++ut) { Oe[ut] *= sc; Oo[ut] *= sc; }
                m = mn;
            }
            float p[8]; float ps = 0.f;
#pragma unroll
            for (int i = 0; i < 8; ++i) { p[i] = __builtin_amdgcn_exp2f(lg[i] - m); ps += p[i]; }
            l += ps;
            int pw0 = __builtin_amdgcn_cvt_pk_fp8_f32(p[0], p[1], 0, false); pw0 = __builtin_amdgcn_cvt_pk_fp8_f32(p[2], p[3], pw0, true);
            int pw1 = __builtin_amdgcn_cvt_pk_fp8_f32(p[4], p[5], 0, false); pw1 = __builtin_amdgcn_cvt_pk_fp8_f32(p[6], p[7], pw1, true);
            const long pk = __builtin_bit_cast(long, (u32x2){(unsigned)pw0, (unsigned)pw1});
#pragma unroll
            for (int hb = 0; hb < 2; ++hb) {
                if (hb == 1) {
#pragma unroll
                    for (int u4 = 0; u4 < 4; ++u4) { const int ut = 4 + u4; const LAS unsigned char* pt = img + ((ST ^ (unsigned)(ut << 5)) + baseT);
                        tl_[u4] = __builtin_bit_cast(u32x2, __builtin_amdgcn_ds_read_tr16_b64_v4i16((LAS v4i16_t*)(pt)));
                        th_[u4] = __builtin_bit_cast(u32x2, __builtin_amdgcn_ds_read_tr16_b64_v4i16((LAS v4i16_t*)(pt + 4096))); }
                    __builtin_amdgcn_sched_barrier(0);
                }
#pragma unroll
                for (int u4 = 0; u4 < 4; ++u4) { const int ut = hb * 4 + u4;
                    const u32x2 lw = tl_[u4], hw = th_[u4];
                    u32x2 ae, ao;
                    ae.x = __builtin_amdgcn_perm(lw.y, lw.x, 0x06040200u); ae.y = __builtin_amdgcn_perm(hw.y, hw.x, 0x06040200u);
                    ao.x = __builtin_amdgcn_perm(lw.y, lw.x, 0x07050301u); ao.y = __builtin_amdgcn_perm(hw.y, hw.x, 0x07050301u);
                    Oe[ut] = __builtin_amdgcn_mfma_f32_16x16x32_bf8_fp8(__builtin_bit_cast(long, ae), pk, Oe[ut], 0, 0, 0);
                    Oo[ut] = __builtin_amdgcn_mfma_f32_16x16x32_bf8_fp8(__builtin_bit_cast(long, ao), pk, Oo[ut], 0, 0, 0);
                }
                __builtin_amdgcn_sched_barrier(0);
            }
            if (j + 2 < nch) { asm volatile("s_waitcnt lgkmcnt(0)" ::: "memory"); ATT_DMA(j + 2, bo);
                if (j + 3 == nch) { if (have_item) { tr_load(titem, lane, tcur); trf = true; } ATT_PREFETCH(); } }
        }
#undef ATT_DMA
#undef ATT_PREFETCH
        l += __shfl_xor(l, 16); l += __shfl_xor(l, 32);
        const float inv = 1.0f / l;
        bf16_t* orow = (DRY ? (bf16_t*)(P.ws + WS_PP) + (size_t)(t & 8191) * 4096 : OLAT + (size_t)t * 4096) + fr * 256 + 8 * fq;
#pragma unroll
        for (int ut = 0; ut < 8; ++ut) {
            u32x4 w; w.x = pk2(Oe[ut].x * inv, Oo[ut].x * inv); w.y = pk2(Oe[ut].y * inv, Oo[ut].y * inv); w.z = pk2(Oe[ut].z * inv, Oo[ut].z * inv); w.w = pk2(Oe[ut].w * inv, Oo[ut].w * inv);
            *(u32x4*)(orow + 32 * ut) = w;
        }
        if (have_item) { asm volatile("s_waitcnt lgkmcnt(0)" ::: "memory"); tr_store(titem, (float*)(lds_ + wave * 17920), lane, tcur); ditem += NGW; }
    }
    int lane_l = lane; asm volatile("" : "+v"(lane_l));
    for (; ditem < N_DEFERRED; ditem += NGW) { const TrItem t = deferred_item(P, ditem); float tmp[32]; tr_load(t, lane_l, tmp); tr_store(t, (float*)(lds_ + wave * 17920), lane_l, tmp); }
}

constexpr size_t SC_BATCH = (size_t)1024 * 256 * 257 / 2;
__device__ __forceinline__ size_t sc_row_off(int b, int tl) { const size_t m = (size_t)(tl >> 5); return (size_t)b * SC_BATCH + 1024 * (m * (m + 1) / 2) + (size_t)(tl & 31) * 32 * (m + 1); }
typedef float f32x16 __attribute__((ext_vector_type(16)));
__device__ __forceinline__ unsigned okey_pk(float a, float b) {
    const unsigned w = __builtin_bit_cast(unsigned, __builtin_amdgcn_cvt_pkrtz(a, b));
    const unsigned neg = (w >> 15) & 0x00010001u;
    return w ^ ((neg * 0xffffu) | 0x80008000u);
}
__device__ __forceinline__ void phase_index_scores(const Params& P, unsigned char* lds_) {
    using pg8::bf16x8;
    const bf16_t* Z1 = (const bf16_t*)(P.ws + WS_Z1); unsigned short* SC = (unsigned short*)(P.ws + WS_SC);
    LAS unsigned char* lds = (LAS unsigned char*)lds_;
    constexpr int QROW = 144;
    LAS unsigned char* QL = lds;
    LAS float* SG = (LAS float*)(lds + 9 * 64 * QROW);
    const int tid = threadIdx.x, lane = tid & 63, wave = __builtin_amdgcn_readfirstlane(tid >> 6);
    LAS unsigned char* ST = lds + 9 * 64 * QROW + 2048 + wave * 5120;
    const int l31 = lane & 31, hh = lane >> 5;
    for (int pid = blockIdx.x; pid < 256; pid += gridDim.x) {
        const int b = pid >> 6;
        for (int side = 0; side < 2; ++side) {
            const int qb = side ? (127 - (pid & 63)) : (pid & 63);
            const int q0 = qb * 64;
            __syncthreads();
            {
                const int qi = tid >> 3, part = tid & 7;
                const bf16_t* zr = Z1 + ((size_t)b * SEQ + q0 + qi) * Z1W;
                const u32x4 ww = *(const u32x4*)(zr + 1088);
                const float w8[8] = {bflo(ww.x), bfhi(ww.x), bflo(ww.y), bfhi(ww.y), bflo(ww.z), bfhi(ww.z), bflo(ww.w), bfhi(ww.w)};
                float wh = 0.f;
#pragma unroll
                for (int h = 0; h < 8; ++h) wh = (h == part) ? w8[h] : wh;
                const float sc = 0.5f * fabsf(wh);
                SG[qi * 8 + part] = (wh >= 0.f) ? 1.0f : -1.0f;
#pragma unroll
                for (int c = 0; c < 8; ++c) {
                    const u32x4 v = *(const u32x4*)(zr + 512 + part * 64 + c * 8);
                    u32x4 o; o.x = pk2(bflo(v.x) * sc, bfhi(v.x) * sc); o.y = pk2(bflo(v.y) * sc, bfhi(v.y) * sc); o.z = pk2(bflo(v.z) * sc, bfhi(v.z) * sc); o.w = pk2(bflo(v.w) * sc, bfhi(v.w) * sc);
                    *(LAS u32x4*)(QL + (part * 64 + qi) * QROW + c * 16) = o;
                }
                float a8[8];
#pragma unroll
                for (int j = 0; j < 8; ++j) a8[j] = 0.f;
#pragma unroll
                for (int h = 0; h < 8; ++h) {
                    const u32x4 v = *(const u32x4*)(zr + 512 + h * 64 + part * 8); const float s2 = 0.5f * w8[h];
                    a8[0] += s2 * bflo(v.x); a8[1] += s2 * bfhi(v.x); a8[2] += s2 * bflo(v.y); a8[3] += s2 * bfhi(v.y);
                    a8[4] += s2 * bflo(v.z); a8[5] += s2 * bfhi(v.z); a8[6] += s2 * bflo(v.w); a8[7] += s2 * bfhi(v.w);
                }
                u32x4 o; o.x = pk2(a8[0], a8[1]); o.y = pk2(a8[2], a8[3]); o.z = pk2(a8[4], a8[5]); o.w = pk2(a8[6], a8[7]);
                *(LAS u32x4*)(QL + (8 * 64 + qi) * QROW + part * 16) = o;
            }
            __syncthreads();
            const int ktmax = 2 * qb + 1;
            bf16x8 kn[4];
            {   const bf16_t* kr = Z1 + ((size_t)b * SEQ + min(wave, ktmax) * 32 + l31) * Z1W + 1024 + hh * 8;
#pragma unroll
                for (int dq = 0; dq < 4; ++dq) kn[dq] = *(const bf16x8*)(kr + dq * 16); }
            for (int kt = wave; kt <= ktmax; kt += NWAVE) {
                bf16x8 kf[4];
#pragma unroll
                for (int dq = 0; dq < 4; ++dq) kf[dq] = kn[dq];
                {   const bf16_t* kr = Z1 + ((size_t)b * SEQ + min(kt + NWAVE, ktmax) * 32 + l31) * Z1W + 1024 + hh * 8;
#pragma unroll
                    for (int dq = 0; dq < 4; ++dq) kn[dq] = *(const bf16x8*)(kr + dq * 16); }
#pragma unroll
                for (int qs = 0; qs < 2; ++qs) {
                    const LAS unsigned char* qrow = QL + (qs * 32 + l31) * QROW + hh * 16;
                    const LAS float* sgp = SG + (qs * 32 + l31) * 8;
                    bf16x8 fc[4], fn[4];
#pragma unroll
                    for (int dq = 0; dq < 4; ++dq) fc[dq] = *(const LAS bf16x8*)(qrow + 8 * 64 * QROW + dq * 32);
#pragma unroll
                    for (int dq = 0; dq < 4; ++dq) fn[dq] = *(const LAS bf16x8*)(qrow + dq * 32);
                    const f32x4 sg03 = *(const LAS f32x4*)(sgp), sg47 = *(const LAS f32x4*)(sgp + 4);
                    f32x16 acc;
#pragma unroll
                    for (int r = 0; r < 16; ++r) acc[r] = 0.f;
#pragma unroll
                    for (int dq = 0; dq < 4; ++dq) acc = __builtin_amdgcn_mfma_f32_32x32x16_bf16(kf[dq], fc[dq], acc, 0, 0, 0);
                    f32x16 up;
#pragma unroll
                    for (int h = 0; h < 8; ++h) {
#pragma unroll
                        for (int dq = 0; dq < 4; ++dq) fc[dq] = fn[dq];
                        if (h < 7) {
#pragma unroll
                            for (int dq = 0; dq < 4; ++dq) fn[dq] = *(const LAS bf16x8*)(qrow + (h + 1) * 64 * QROW + dq * 32);
                        }
                        f32x16 u;
#pragma unroll
                        for (int r = 0; r < 16; ++r) u[r] = 0.f;
#pragma unroll
                        for (int dq = 0; dq < 4; ++dq) u = __builtin_amdgcn_mfma_f32_32x32x16_bf16(kf[dq], fc[dq], u, 0, 0, 0);
                        __builtin_amdgcn_sched_barrier(0);
                        if (h > 0) {
                            const float sg = (h - 1 < 4) ? sg03[(h - 1) & 3] : sg47[(h - 1) & 3];
#pragma unroll
                            for (int r = 0; r < 16; ++r) acc[r] = fmaf(fabsf(up[r]), sg, acc[r]);
                        }
                        __builtin_amdgcn_sched_barrier(0);
                        up = u;
                    }
                    {
                        const float sg = sg47[3];
#pragma unroll
                        for (int r = 0; r < 16; ++r) acc[r] = fmaf(fabsf(up[r]), sg, acc[r]);
                    }
#pragma unroll
                    for (int g = 0; g < 4; ++g) { u32x2 w; w.x = okey_pk(acc[4 * g], acc[4 * g + 1]); w.y = okey_pk(acc[4 * g + 2], acc[4 * g + 3]);
                        *(LAS u32x2*)(ST + (qs * 32 + l31) * 80 + (8 * g + 4 * hh) * 2) = w; }
                }
#pragma unroll
                for (int i = 0; i < 4; ++i) {
                    const int row = 16 * i + (lane >> 2), ch = lane & 3, tl = q0 + row;
                    const u32x4 v = *(const LAS u32x4*)(ST + row * 80 + ch * 16);
                    if (kt <= (tl >> 5)) *(u32x4*)(SC + sc_row_off(b, tl) + (size_t)kt * 32 + ch * 8) = v;
                }
            }
        }
    }
}
template <int MODE>
__device__ __forceinline__ void phase_index_select(const Params& P, unsigned char* lds_) {
    const unsigned short* SC = (const unsigned short*)(P.ws + WS_SC); unsigned short* SEL = (unsigned short*)(P.ws + WS_SEL);
    const int tid = threadIdx.x, lane = tid & 63, wave = __builtin_amdgcn_readfirstlane(tid >> 6);
    LAS unsigned char* wbase = (LAS unsigned char*)lds_ + wave * 19456;
    LAS u32x4* rowbuf = (LAS u32x4*)wbase;
    LAS unsigned* hist = (LAS unsigned*)(wbase + 16384);
    LAS unsigned* dummy = hist + 512 + lane;
    LAS unsigned short* outw = (LAS unsigned short*)(wbase + 16384 + 2048 + 256);
    LAS unsigned short* dummy16 = outw + 256 + lane;
    const unsigned rowbuf0 = (unsigned)(unsigned long)wbase;
    const int gw = blockIdx.x * NWAVE + wave, NGW = gridDim.x * NWAVE;
#define SEL_DMA(tt) do { const int _tl = (tt) & (SEQ - 1), _n = _tl + 1; if (_n > TOPK) { const unsigned char* _src = (const unsigned char*)(SC + sc_row_off((tt) >> 13, _tl)) + lane * 16; \
            for (int _sg = 0; _sg * 512 < _n; ++_sg) glds16(_src + _sg * 1024, (unsigned)__builtin_amdgcn_readfirstlane((int)(rowbuf0 + _sg * 1024))); } } while (0)
#define SEL_Q(i) ((i) * NGW + (((i) & 1) ? (NGW - 1 - gw) : gw))
    if (SEL_Q(0) < NTOK) SEL_DMA(SEL_Q(0));
    for (int qi = 0; qi * NGW < NTOK; ++qi) {
        const int t = SEL_Q(qi), tnext = SEL_Q(qi + 1);
        if (t >= NTOK) { if (tnext < NTOK) SEL_DMA(tnext); continue; }
        const int tl = t & (SEQ - 1), n = tl + 1;
        unsigned short* so = SEL + (size_t)t * TOPK;
        if (n <= TOPK) { for (int i = lane; i < n; i += 64) so[i] = (unsigned short)i; if (tnext < NTOK && (qi + 1) * NGW < NTOK) SEL_DMA(tnext); continue; }
        asm volatile("s_waitcnt vmcnt(0)" ::: "memory");
        u32x4 d[16];
        const int lastsg = (n - 1) >> 9;
#pragma unroll
        for (int sg = 0; sg < 16; ++sg) {
            if (sg * 512 < n) {
                d[sg] = rowbuf[sg * 64 + lane];
                if (sg == lastsg) {
#pragma unroll
                    for (int q = 0; q < 4; ++q) { const int i0 = sg * 512 + lane * 8 + 2 * q;
                        d[sg][q] &= ((i0 < n) ? 0x0000ffffu : 0u) | ((i0 + 1 < n) ? 0xffff0000u : 0u); }
                }
            } else d[sg] = (u32x4){0u, 0u, 0u, 0u};
        }
        asm volatile("s_waitcnt lgkmcnt(0)" ::: "memory");
        if (tnext < NTOK && (qi + 1) * NGW < NTOK) SEL_DMA(tnext);
#pragma unroll
        for (int i = 0; i < 8; ++i) { hist[i * 64 + lane] = 0u; }
        asm volatile("s_waitcnt lgkmcnt(0)" ::: "memory");
        LAS unsigned* myh = hist + (lane & 1) * 256;
        if (MODE == 4) { if (d[0].x == 0x12345u) so[lane] = 1; continue; }
#pragma unroll
        for (int sg = 0; sg < 16; ++sg) if (MODE != 1 && sg * 512 < n) {
#pragma unroll
            for (int q = 0; q < 4; ++q) { const unsigned w = d[sg][q];
                __hip_atomic_fetch_add(myh + ((w >> 8) & 0xffu), 1u, __ATOMIC_RELAXED, __HIP_MEMORY_SCOPE_WORKGROUP);
                __hip_atomic_fetch_add(myh + (w >> 24), 1u, __ATOMIC_RELAXED, __HIP_MEMORY_SCOPE_WORKGROUP); }
        }
        asm volatile("s_waitcnt lgkmcnt(0)" ::: "memory");
        unsigned b1, need1;
        {
            unsigned c[4];
#pragma unroll
            for (int q = 0; q < 4; ++q) c[q] = hist[4 * lane + q] + hist[256 + 4 * lane + q];
            const unsigned mine = c[0] + c[1] + c[2] + c[3];
            unsigned suf = mine;
#pragma unroll
            for (int o = 1; o < 64; o <<= 1) { const unsigned v = __shfl_down(suf, o); if (lane + o < 64) suf += v; }
            const unsigned above = suf - mine;
            int fb = -1; unsigned fneed = 0;
            if (above < (unsigned)TOPK && suf >= (unsigned)TOPK) { unsigned a = above;
#pragma unroll
                for (int q = 3; q >= 0; --q) { if (fb < 0 && a + c[q] >= (unsigned)TOPK) { fb = 4 * lane + q; fneed = (unsigned)TOPK - a; } a += c[q]; } }
            const unsigned long long bal = __ballot(fb >= 0);
            const int src = (int)__builtin_ctzll(bal);
            b1 = (unsigned)__shfl(fb, src); need1 = __shfl(fneed, src);
        }
#pragma unroll
        for (int i = 0; i < 8; ++i) { hist[i * 64 + lane] = 0u; }
        asm volatile("s_waitcnt lgkmcnt(0)" ::: "memory");
#pragma unroll
        for (int sg = 0; sg < 16; ++sg) if (MODE != 2 && sg * 512 < n) {
#pragma unroll
            for (int q = 0; q < 4; ++q) { const unsigned w = d[sg][q];
                LAS unsigned* p0 = (((w >> 8) & 0xffu) == b1) ? (myh + (w & 0xffu)) : dummy;
                LAS unsigned* p1 = ((w >> 24) == b1) ? (myh + ((w >> 16) & 0xffu)) : dummy;
                __hip_atomic_fetch_add(p0, 1u, __ATOMIC_RELAXED, __HIP_MEMORY_SCOPE_WORKGROUP);
                __hip_atomic_fetch_add(p1, 1u, __ATOMIC_RELAXED, __HIP_MEMORY_SCOPE_WORKGROUP); }
        }
        asm volatile("s_waitcnt lgkmcnt(0)" ::: "memory");
        unsigned T, need2;
        {
            unsigned c[4];
#pragma unroll
            for (int q = 0; q < 4; ++q) c[q] = hist[4 * lane + q] + hist[256 + 4 * lane + q];
            const unsigned mine = c[0] + c[1] + c[2] + c[3];
            unsigned suf = mine;
#pragma unroll
            for (int o = 1; o < 64; o <<= 1) { const unsigned v = __shfl_down(suf, o); if (lane + o < 64) suf += v; }
            const unsigned above = suf - mine;
            int fb = -1; unsigned fneed = 0;
            if (above < need1 && suf >= need1) { unsigned a = above;
#pragma unroll
                for (int q = 3; q >= 0; --q) { if (fb < 0 && a + c[q] >= need1) { fb = 4 * lane + q; fneed = need1 - a; } a += c[q]; } }
            const unsigned long long bal = __ballot(fb >= 0);
            const int src = (int)__builtin_ctzll(bal);
            T = (b1 << 8) | (unsigned)__shfl(fb, src); need2 = __shfl(fneed, src);
        }
        unsigned base = 0; const unsigned ngt = (unsigned)TOPK - need2; unsigned eqbase = 0;
#pragma unroll
        for (int sg = 0; sg < 16; ++sg) if (MODE != 3 && sg * 512 < n) {
            unsigned ce = 0;
#pragma unroll
            for (int j = 0; j < 8; ++j) {
                const unsigned k = (j & 1) ? (d[sg][j >> 1] >> 16) : (d[sg][j >> 1] & 0xffffu);
                const bool gt = k > T;
                const unsigned long long mk = __ballot(gt);
                const unsigned pos = base + (unsigned)__builtin_amdgcn_mbcnt_hi((unsigned)(mk >> 32), __builtin_amdgcn_mbcnt_lo((unsigned)mk, 0u));
                LAS unsigned short* po = gt ? (outw + pos) : dummy16;
                *po = (unsigned short)(sg * 512 + lane * 8 + j);
                base += (unsigned)__builtin_popcountll(mk);
                ce += (k == T) ? 1u : 0u;
            }
            if (__any(ce > 0u)) {
                unsigned pre = ce;
#pragma unroll
                for (int o = 1; o < 64; o <<= 1) { const unsigned v = __shfl_up(pre, o); if (lane >= o) pre += v; }
                unsigned r = eqbase + pre - ce;
#pragma unroll
                for (int j = 0; j < 8; ++j) { const unsigned k = (j & 1) ? (d[sg][j >> 1] >> 16) : (d[sg][j >> 1] & 0xffffu);
                    if (k == T) { if (r < need2) outw[ngt + r] = (unsigned short)(sg * 512 + lane * 8 + j); ++r; } }
                eqbase += __shfl(pre, 63);
            }
        }
        asm volatile("s_waitcnt lgkmcnt(0)" ::: "memory");
        ((unsigned*)so)[lane] = ((LAS unsigned*)outw)[lane];
        ((unsigned*)so)[64 + lane] = ((LAS unsigned*)outw)[64 + lane];
        asm volatile("s_waitcnt lgkmcnt(0)" ::: "memory");
    }
#undef SEL_DMA
#undef SEL_Q
    asm volatile("s_waitcnt vmcnt(0)" ::: "memory");
}

__device__ __forceinline__ void ret_fill_image(LAS unsigned char* img, const unsigned char* src, size_t row_stride_bytes, int wave, int lane) {
#pragma unroll
    for (int e4 = 0; e4 < 4; ++e4) {
        const int e = wave * 4 + e4, row = 4 * e + (lane >> 4), q = (lane & 15) ^ ((row & 7) << 1);
        __builtin_amdgcn_global_load_lds((const unsigned*)(src + (size_t)row * row_stride_bytes + q * 16), (LAS unsigned*)(img + e * 1024), 16, 0, 0);
    }
}
__device__ __forceinline__ pg8::bf16x8 ret_tr_pair(const LAS unsigned char* img, int row0, int chunk2, int lane) {
    const int g = lane >> 4, i = lane & 15, r0 = row0 + 4 * g + (i >> 2), pb = (i & 3) >> 1, half = (i & 1) * 8;
    const int r1 = r0 + 16;
    const v4i16_t lo = __builtin_amdgcn_ds_read_tr16_b64_v4i16((LAS v4i16_t*)(img + r0 * 256 + ((((chunk2) ^ ((r0 & 7) << 1)) | pb) << 4) + half));
    const v4i16_t hi = __builtin_amdgcn_ds_read_tr16_b64_v4i16((LAS v4i16_t*)(img + r1 * 256 + ((((chunk2) ^ ((r1 & 7) << 1)) | pb) << 4) + half));
    return (pg8::bf16x8){lo[0], lo[1], lo[2], lo[3], hi[0], hi[1], hi[2], hi[3]};
}
__device__ __forceinline__ void phase_ret_kv_mfma(const Params& P, unsigned char* lds_) {
    using pg8::bf16x8;
    const unsigned char* Z0 = (const unsigned char*)(P.ws + WS_Z0); float* KV = (float*)(P.ws + WS_KV);
    LAS unsigned char* Kimg = (LAS unsigned char*)lds_; LAS unsigned char* Vimg = Kimg + 32768;
    const int tid = threadIdx.x, lane = tid & 63, wave = __builtin_amdgcn_readfirstlane(tid >> 6), fr = lane & 15, fq = lane >> 4;
    for (int u = blockIdx.x; u < 1024; u += gridDim.x) {
        const int n = u & 63, h = (u >> 6) & 3, b = u >> 8;
        const size_t row0 = (size_t)b * SEQ + n * 128;
        __syncthreads();
        ret_fill_image(Kimg, Z0 + row0 * ZW * 2 + (512 + h * 128) * 2, ZW * 2, wave, lane);
        ret_fill_image(Vimg, Z0 + row0 * ZW * 2 + (1024 + h * 128) * 2, ZW * 2, wave, lane);
        asm volatile("s_waitcnt vmcnt(0)" ::: "memory");
        __syncthreads();
        bf16x8 va[4];
#pragma unroll
        for (int jc = 0; jc < 4; ++jc) va[jc] = ret_tr_pair(Vimg, 32 * jc, 2 * wave, lane);
        const float g127 = exp2f(ret_log2g(h) * 127.0f);
        float* o = KV + (size_t)u * 16384;
#pragma unroll
        for (int dt = 0; dt < 8; ++dt) {
            f32x4 acc = {0.f, 0.f, 0.f, 0.f};
#pragma unroll
            for (int jc = 0; jc < 4; ++jc) acc = __builtin_amdgcn_mfma_f32_16x16x32_bf16(va[jc], ret_tr_pair(Kimg, 32 * jc, 2 * dt, lane), acc, 0, 0, 0);
            *(f32x4*)(o + (size_t)(16 * dt + fr) * 128 + 16 * wave + 4 * fq) = acc * g127;
        }
    }
}
__device__ __forceinline__ void phase_ret_scan_pool2(const Params& P) {
    const float* KV = (const float*)(P.ws + WS_KV); bf16_t* SB = (bf16_t*)(P.ws + WS_SB);
    const size_t gt = (size_t)blockIdx.x * NT + threadIdx.x, GS = (size_t)gridDim.x * NT;
    for (size_t i = gt; i < (size_t)16 * 8192; i += GS) {
        const int s = (int)(i >> 13), e2 = (int)(i & 8191), h = s & 3;
        const float l2 = ret_log2g(h), cd = exp2f(l2 * 128.0f), g1 = exp2f(l2);
        typedef float f32x2v __attribute__((ext_vector_type(2)));
        const f32x2v* p = (const f32x2v*)(KV + (size_t)s * 64 * 16384) + e2;
        unsigned* q = (unsigned*)(SB + (size_t)s * 64 * 16384) + e2;
        f32x2v R = {0.f, 0.f};
        for (int n0 = 0; n0 < 64; n0 += 16) {
            f32x2v kv[16];
#pragma unroll
            for (int j = 0; j < 16; ++j) kv[j] = __builtin_nontemporal_load(p + (size_t)(n0 + j) * 8192);
#pragma unroll
            for (int j = 0; j < 16; ++j) { q[(size_t)(n0 + j) * 8192] = pk2(R.x * g1, R.y * g1); R = R * cd + kv[j]; }
        }
    }
    const bf16_t* Z0 = (const bf16_t*)(P.ws + WS_Z0); bf16_t* DP = (bf16_t*)(P.ws + WS_DP);
    for (size_t i = gt; i < (size_t)NTOK * 64; i += GS) {
        const int t = (int)(i >> 6), c8 = (int)(i & 63) * 8, g = c8 >> 7, w = 2 << g, tl = t & (SEQ - 1);
        const int cnt = min(tl + 1, w);
        float sm[8];
#pragma unroll
        for (int j = 0; j < 8; ++j) sm[j] = 0.f;
        float u0[8];
        for (int q = 0; q < cnt; ++q) {
            const u32x4 v = *(const u32x4*)(Z0 + (size_t)(t - q) * ZW + 2048 + c8);
            const float f[8] = {bflo(v.x), bfhi(v.x), bflo(v.y), bfhi(v.y), bflo(v.z), bfhi(v.z), bflo(v.w), bfhi(v.w)};
#pragma unroll
            for (int j = 0; j < 8; ++j) { sm[j] += f[j]; if (q == 0) u0[j] = f[j]; }
        }
        const float inv = 1.0f / (float)cnt;
        u32x4 o; o.x = pk2(sm[0] * inv - u0[0], sm[1] * inv - u0[1]); o.y = pk2(sm[2] * inv - u0[2], sm[3] * inv - u0[3]);
        o.z = pk2(sm[4] * inv - u0[4], sm[5] * inv - u0[5]); o.w = pk2(sm[6] * inv - u0[6], sm[7] * inv - u0[7]);
        *(u32x4*)(DP + (size_t)t * 512 + c8) = o;
    }
}
__device__ __forceinline__ void phase_ret_out_mfma(const Params& P, unsigned char* lds_) {
    using pg8::bf16x8;
    const unsigned char* Z0 = (const unsigned char*)(P.ws + WS_Z0); const unsigned char* SB = (const unsigned char*)(P.ws + WS_SB); bf16_t* MIX = (bf16_t*)(P.ws + WS_MIX);
    const float* gn = P.in[3];
    LAS unsigned char* Kimg = (LAS unsigned char*)lds_; LAS unsigned char* Vimg = Kimg + 32768; LAS unsigned char* Rimg = Kimg + 65536;
    const int tid = threadIdx.x, lane = tid & 63, wave = __builtin_amdgcn_readfirstlane(tid >> 6), fr = lane & 15, fq = lane >> 4;
    for (int u = blockIdx.x; u < 1024; u += gridDim.x) {
        const int n = u & 63, h = (u >> 6) & 3, b = u >> 8;
        const size_t row0 = (size_t)b * SEQ + n * 128;
        __syncthreads();
        ret_fill_image(Kimg, Z0 + row0 * ZW * 2 + (512 + h * 128) * 2, ZW * 2, wave, lane);
        ret_fill_image(Vimg, Z0 + row0 * ZW * 2 + (1024 + h * 128) * 2, ZW * 2, wave, lane);
        ret_fill_image(Rimg, SB + (size_t)u * 32768, 256, wave, lane);
        const bf16_t* qrow = (const bf16_t*)Z0 + (row0 + 16 * wave + fr) * ZW + h * 128;
        bf16x8 qf[4], qr[4];
#pragma unroll
        for (int c = 0; c < 4; ++c) {
            qf[c] = *(const bf16x8*)(qrow + 32 * c + 8 * fq);
            const u32x2 a = *(const u32x2*)(qrow + 32 * c + 4 * fq), bb = *(const u32x2*)(qrow + 32 * c + 16 + 4 * fq);
            u32x4 w; w.x = a.x; w.y = a.y; w.z = bb.x; w.w = bb.y; qr[c] = __builtin_bit_cast(bf16x8, w);
        }
        asm volatile("s_waitcnt vmcnt(0)" ::: "memory");
        __syncthreads();
        f32x4 sT[8];
#pragma unroll
        for (int jt = 0; jt < 8; ++jt) sT[jt] = (f32x4){0.f, 0.f, 0.f, 0.f};
#pragma unroll
        for (int jt = 0; jt < 8; ++jt) if (jt <= wave) {
            const int r = 16 * jt + fr;
#pragma unroll
            for (int c = 0; c < 4; ++c) {
                const bf16x8 a = *(const LAS bf16x8*)(Kimg + r * 256 + ((((4 * c + fq)) ^ ((r & 7) << 1)) << 4));
                sT[jt] = __builtin_amdgcn_mfma_f32_16x16x32_bf16(a, qf[c], sT[jt], 0, 0, 0);
            }
            if (jt == wave) {
                if (4 * fq + 0 > fr) sT[jt].x = 0.f; if (4 * fq + 1 > fr) sT[jt].y = 0.f; if (4 * fq + 2 > fr) sT[jt].z = 0.f; if (4 * fq + 3 > fr) sT[jt].w = 0.f;
            }
        }
        bf16x8 pT[4];
#pragma unroll
        for (int jp = 0; jp < 4; ++jp) { u32x4 w; w.x = pk2(sT[2 * jp].x, sT[2 * jp].y); w.y = pk2(sT[2 * jp].z, sT[2 * jp].w); w.z = pk2(sT[2 * jp + 1].x, sT[2 * jp + 1].y); w.w = pk2(sT[2 * jp + 1].z, sT[2 * jp + 1].w);
            pT[jp] = __builtin_bit_cast(bf16x8, w); }
        f32x4 O[8];
#pragma unroll
        for (int vt = 0; vt < 8; ++vt) {
            f32x4 acc = {0.f, 0.f, 0.f, 0.f};
#pragma unroll
            for (int jp = 0; jp < 4; ++jp) if (2 * jp <= wave) acc = __builtin_amdgcn_mfma_f32_16x16x32_bf16(ret_tr_pair(Vimg, 32 * jp, 2 * vt, lane), pT[jp], acc, 0, 0, 0);
#pragma unroll
            for (int c = 0; c < 4; ++c) acc = __builtin_amdgcn_mfma_f32_16x16x32_bf16(ret_tr_pair(Rimg, 32 * c, 2 * vt, lane), qr[c], acc, 0, 0, 0);
            O[vt] = acc;
        }
        float sm = 0.f;
#pragma unroll
        for (int vt = 0; vt < 8; ++vt) sm += (O[vt].x + O[vt].y) + (O[vt].z + O[vt].w);
        sm += __shfl_xor(sm, 16); sm += __shfl_xor(sm, 32);
        const float mu = sm * (1.0f / 128.0f);
        float sq = 0.f;
#pragma unroll
        for (int vt = 0; vt < 8; ++vt) { const f32x4 dlt = O[vt] - mu; sq += (dlt.x * dlt.x + dlt.y * dlt.y) + (dlt.z * dlt.z + dlt.w * dlt.w); }
        sq += __shfl_xor(sq, 16); sq += __shfl_xor(sq, 32);
        const float rstd = 1.0f / sqrtf(sq * (1.0f / 128.0f) + LN_EPS);
        const bf16_t* grow = (const bf16_t*)Z0 + (row0 + 16 * wave + fr) * ZW + 1536 + h * 128 + 4 * fq;
        bf16_t* orow = MIX + (row0 + 16 * wave + fr) * DM + h * 128 + 4 * fq;
#pragma unroll
        for (int vt = 0; vt < 8; ++vt) {
            const u32x2 gv = *(const u32x2*)(grow + 16 * vt);
            const f32x4 g4 = *(const f32x4*)(gn + h * 128 + 16 * vt + 4 * fq);
            const f32x4 y = (O[vt] - mu) * rstd * g4;
            u32x2 w; w.x = pk2(y.x * silu_f(bflo(gv.x)), y.y * silu_f(bfhi(gv.x))); w.y = pk2(y.z * silu_f(bflo(gv.y)), y.w * silu_f(bfhi(gv.y)));
            *(u32x2*)(orow + 16 * vt) = w;
        }
    }
}

#define XB_TMO      128
#define XB_XCNT(j)  (256  + 64 * (j))
#define XB_XSUB(j)  (1280 + 64 * (j))
#define XB_XGEN(j)  (2304 + 64 * (j))
#define XB_TOP      3328
#define XB_TOPGEN   3392
#define XCD_BAR_WORDS 3456
#define XB_SPIN_CAP (1u << 22)
__device__ __forceinline__ unsigned xb_ld(unsigned* p)              { return __hip_atomic_load(p, __ATOMIC_RELAXED, __HIP_MEMORY_SCOPE_AGENT); }
__device__ __forceinline__ unsigned xb_add(unsigned* p, unsigned v) { return __hip_atomic_fetch_add(p, v, __ATOMIC_RELAXED, __HIP_MEMORY_SCOPE_AGENT); }
__device__ __forceinline__ unsigned xb_xcc_id() { return (unsigned)__builtin_amdgcn_s_getreg((3 << 11) | 20) & 0xFu; }
#define XB_SPIN(cond, bar) do { unsigned _sp = 0; while (cond) { __builtin_amdgcn_s_sleep(1); \
    if ((++_sp & 255u) == 0u) { if (xb_ld(&(bar)[XB_TMO])) break; if (_sp > XB_SPIN_CAP) { atomicAdd(&(bar)[XB_TMO], 1u); break; } } } } while (0)
struct XcdBarrier { unsigned* bar; unsigned x; volatile LAS unsigned* st; };
__device__ __forceinline__ XcdBarrier xcd_barrier_post(unsigned* bar, volatile LAS unsigned* st) {
    XcdBarrier b; b.bar = bar; b.x = xb_xcc_id(); b.st = st;
    if (threadIdx.x == 0) (void)xb_add(&bar[XB_XCNT(b.x)], 1u);
    return b;
}
__device__ __forceinline__ void xcd_barrier_complete(unsigned* bar, unsigned x, unsigned& nloc, unsigned& nx) {
    const unsigned G = gridDim.x * gridDim.y * gridDim.z;
    unsigned sum, cnt, mine, sp = 0u;
    for (;;) {
        sum = 0u; cnt = 0u; mine = 0u;
#pragma unroll
        for (unsigned j = 0; j < 16; ++j) { const unsigned c = xb_ld(&bar[XB_XCNT(j)]); sum += c; cnt += (c > 0u) ? 1u : 0u; mine = (j == x) ? c : mine; }
        if (sum == G) break;
        __builtin_amdgcn_s_sleep(1);
        if ((++sp & 255u) == 0u) { if (xb_ld(&bar[XB_TMO])) break; if (sp > XB_SPIN_CAP) { atomicAdd(&bar[XB_TMO], 1u); break; } }
    }
    nloc = mine > 0u ? mine : 1u; nx = cnt > 0u ? cnt : 1u;
}
__device__ __forceinline__ void xcd_barrier(const XcdBarrier& b) {
    asm volatile("s_waitcnt vmcnt(0)" ::: "memory");
    __syncthreads();
    if (threadIdx.x == 0) {
        unsigned* bar = b.bar;
        __builtin_amdgcn_s_waitcnt(0);
        unsigned nloc = b.st[0], nx = b.st[1];
        if (nloc == 0u) { xcd_barrier_complete(bar, b.x, nloc, nx); b.st[0] = nloc; b.st[1] = nx; }
        const unsigned old = xb_add(&bar[XB_XSUB(b.x)], 1u);
        const unsigned gen = old / nloc;
        if (old + 1u == (gen + 1u) * nloc) {
            __builtin_amdgcn_fence(__ATOMIC_RELEASE, "agent");
            asm volatile("s_waitcnt vmcnt(0)" ::: "memory");
            const unsigned og = xb_add(&bar[XB_TOP], 1u);
            const unsigned tg = og / nx;
            if (og + 1u == (tg + 1u) * nx) xb_add(&bar[XB_TOPGEN], 1u);
            else XB_SPIN(xb_ld(&bar[XB_TOPGEN]) == tg, bar);
            __builtin_amdgcn_fence(__ATOMIC_ACQUIRE, "agent");
            xb_add(&bar[XB_XGEN(b.x)], 1u);
            asm volatile("s_waitcnt vmcnt(0)" ::: "memory");
        } else {
            XB_SPIN(xb_ld(&bar[XB_XGEN(b.x)]) == gen, bar);
            __builtin_amdgcn_fence(__ATOMIC_ACQUIRE, "agent");
            asm volatile("s_waitcnt vmcnt(0)" ::: "memory");
        }
    }
    __syncthreads();
}
constexpr size_t CTL_BAR_OFF = 16384;
constexpr size_t CTL_ZERO_BYTES = 65536;

#ifdef PH_ONLY
#define IN(k) ((k) == PH_ONLY)
#else
#define IN(k) (lo <= (k) && (k) < hi)
#endif
#define SEAM(k) do { if (IN(k) && IN((k) + 1)) xcd_barrier(grid); } while (0)
#ifndef PROBE_DUP
#define PROBE_DUP (-1)
#endif
#define REP(k) for (int _rep = 0; _rep < ((PROBE_DUP == (k)) ? 2 : 1); ++_rep)
#define REPS(k) ((PROBE_DUP == 100 + (k)) ? 2 : 1)

template <int LAYER, int BASE>
__device__ __forceinline__ void layer_tail(const Params& P, unsigned char* lds, const XcdBarrier& grid, int lo, int hi) {
    unsigned char* ws = P.ws;
    int* tb = (int*)(lds + MISC_OFF);
    if (IN(BASE)) { if (PROBE_DUP == BASE) phase_ln_route<true>(P, lds, LAYER); phase_ln_route<false>(P, lds, LAYER); }
    SEAM(BASE);
    if (IN(BASE + 1)) REP(BASE + 1) { moe_setup(P, tb, LAYER);
        MoeSched S{tb, (const int*)(ws + WS_CTL) + LAYER * 64, (const int*)(ws + WS_LIST), (const bf16_t*)(ws + WS_XB),
                   (const bf16_t*)(ws + WS_W_GU) + (size_t)LAYER * 32 * DM * DM, DM, (size_t)DM * DM, true};
        EpiGU E{(bf16_t*)(ws + WS_ACT)}; gemm_moe<true>(lds, S, E);
        { const int U = tb[32] * 4, G = (int)gridDim.x, nheavy = (U % G), nlight = G - nheavy, lr = (int)blockIdx.x - nheavy;
          DenseSched S2{(const bf16_t*)(ws + WS_PB) + (size_t)LAYER * NTOK * 256, (const bf16_t*)(ws + WS_W_P) + (size_t)LAYER * DM * 256, NTOK, DM, 256, 256, 0, 1, lr, nlight};
          EpiStoreBf16 E2{(bf16_t*)(ws + WS_PP), DM, 0, nullptr}; gemm_dense(lds, S2, E2); } }
    SEAM(BASE + 1);
    if (IN(BASE + 2)) REP(BASE + 2) { moe_setup(P, tb, LAYER);
        MoeSched S{tb, (const int*)(ws + WS_CTL) + LAYER * 64, (const int*)(ws + WS_LIST), (const bf16_t*)(ws + WS_ACT),
                   (const bf16_t*)(ws + WS_W_DN) + (size_t)LAYER * 32 * DM * 512, 512, (size_t)DM * 512, false};
        EpiDown E{(bf16_t*)(ws + WS_YS)}; gemm_moe<false>(lds, S, E); }
    SEAM(BASE + 2);
    if (IN(BASE + 3)) { if (PROBE_DUP == BASE + 3) phase_ln2<true>(P, LAYER); phase_ln2<false>(P, LAYER); }
    SEAM(BASE + 3);
    if (IN(BASE + 4)) REP(BASE + 4) {
        { DenseSched S{(const bf16_t*)(ws + WS_XB), (const bf16_t*)(ws + WS_W_G) + (size_t)LAYER * DM * DM, NTOK, DM, DM, DM, 0, REPS(BASE + 4)};
          EpiPle E{(const bf16_t*)(ws + WS_XB), (const bf16_t*)(ws + WS_PP), LAYER == 1 ? P.out : (float*)nullptr, LAYER == 1 ? (bf16_t*)nullptr : (bf16_t*)(ws + WS_XB2)}; gemm_dense(lds, S, E); }
    }
}

__global__ void __launch_bounds__(NT, 2) mega(Params P, int lo, int hi) {
    extern __shared__ __attribute__((aligned(16))) unsigned char lds[];
    unsigned char* ws = P.ws;
    if (threadIdx.x < 16) ((LAS unsigned*)((LAS unsigned char*)lds + BARW_OFF))[threadIdx.x] = 0u;
    __syncthreads();
    const XcdBarrier grid = xcd_barrier_post((unsigned*)(ws + WS_CTL + CTL_BAR_OFF), (volatile LAS unsigned*)((LAS unsigned char*)lds + BARW_OFF));
    if (IN(0)) REP(0) phase_prep(P, lds);
    SEAM(0);
    if (IN(1)) REP(1) { DenseSched S{(const bf16_t*)(ws + WS_XB), (const bf16_t*)(ws + WS_W_IN0), NTOK, ZW, DM, DM, 0, REPS(1)};
        EpiZ0 E{(bf16_t*)(ws + WS_Z0)}; gemm_dense(lds, S, E); }
    SEAM(1);
    if (IN(2)) REP(2) phase_ret_kv_mfma(P, lds);
    SEAM(2);
    if (IN(3)) REP(3) phase_ret_scan_pool2(P);
    SEAM(3);
    if (IN(4)) REP(4) { phase_ret_out_mfma(P, lds); __syncthreads();
        DenseSched S{(const bf16_t*)(ws + WS_DP), (const bf16_t*)(ws + WS_W_POOL), NTOK, 512, 256, 512, 256};
        EpiStoreBf16 E{(bf16_t*)(ws + WS_MIX), DM, 512, P.in[5]}; gemm_dense(lds, S, E); }
    SEAM(4);
    if (IN(5)) REP(5) { DenseSched S{(const bf16_t*)(ws + WS_MIX), (const bf16_t*)(ws + WS_W_OUT0), NTOK, DM, DM, DM, 0, REPS(5)};
        EpiResidB E{(const bf16_t*)(ws + WS_XB), (bf16_t*)(ws + WS_F)}; gemm_dense(lds, S, E); }
    SEAM(5);
    layer_tail<0, 6>(P, lds, grid, lo, hi);
    SEAM(10);
    if (IN(11)) REP(11) { DenseSched S{(const bf16_t*)(ws + WS_XB2), (const bf16_t*)(ws + WS_W_CIN), NTOK, Z1W, DM, DM, 0, REPS(11)};
        EpiStoreBf16 E{(bf16_t*)(ws + WS_Z1), Z1W, 0, nullptr}; gemm_dense(lds, S, E); }
    SEAM(11);
    if (IN(12)) REP(12) { phase_norms(P); phase_index_scores(P, lds); }
    SEAM(12);
    if (IN(13)) { if (PROBE_DUP == 13) phase_index_select<PROBE_SEL>(P, lds); phase_index_select<0>(P, lds); }
    if (IN(13) && IN(14)) __syncthreads();
    if (IN(14)) REP(14) { DenseSched S{(const bf16_t*)(ws + WS_CQ), (const bf16_t*)(ws + WS_W_QA), NTOK, 4096, 256, 256, 0, REPS(14)};
        EpiStoreFp8 E{(unsigned char*)(ws + WS_QA), 4096}; gemm_dense(lds, S, E); }
    SEAM(14);
    if (IN(15)) { if (PROBE_DUP == 15) phase_sparse_attn_e<true>(P, lds); phase_sparse_attn_e<false>(P, lds); }
    SEAM(15);
    if (IN(16)) REP(16) { DenseSched S{(const bf16_t*)(ws + WS_OLAT), (const bf16_t*)(ws + WS_W_UVBD), NTOK, DM, DM, 4096, 1024, REPS(16)};
        EpiStoreBf16 E{(bf16_t*)(ws + WS_XB), DM, 0, nullptr}; gemm_dense_bdiag(lds, S, E); }
    SEAM(16);
    if (IN(17)) REP(17) { DenseSched S{(const bf16_t*)(ws + WS_XB), (const bf16_t*)(ws + WS_W_COUT), NTOK, DM, DM, DM, 0, REPS(17)};
        EpiResidB E{(const bf16_t*)(ws + WS_XB2), (bf16_t*)(ws + WS_F)}; gemm_dense(lds, S, E); }
    SEAM(17);
    layer_tail<1, 18>(P, lds, grid, lo, hi);
}
#undef IN
#undef SEAM

extern "C" void kernel_launch(void* const* d_in, const int* in_sizes, int n_in, void* d_out, int out_size, void* d_ws, size_t ws_size, hipStream_t stream) {
    static int grid = 0;
    if (grid == 0) {
        if (n_in != 26 || ws_size < WS_END || out_size != NTOK * DM) { fprintf(stderr, "kernel_launch: unexpected problem (n_in %d, ws %zu, out %d)\n", n_in, ws_size, out_size); grid = -1; return; }
        int dev = 0, cus = 0, per_cu = 0;
        (void)hipGetDevice(&dev);
        (void)hipDeviceGetAttribute(&cus, hipDeviceAttributeMultiprocessorCount, dev);
        (void)hipFuncSetAttribute((const void*)mega, hipFuncAttributeMaxDynamicSharedMemorySize, LDS_BYTES);
        (void)hipOccupancyMaxActiveBlocksPerMultiprocessor(&per_cu, (const void*)mega, NT, LDS_BYTES);
        if (per_cu < 1) { fprintf(stderr, "kernel_launch: occupancy query reports %d blocks per CU\n", per_cu); per_cu = 1; }
        (void)hipGetLastError();
        grid = cus;
    }
    if (grid < 0) return;
    (void)hipMemsetAsync((char*)d_ws + WS_CTL, 0, CTL_ZERO_BYTES, stream);
    Params p{};
    for (int i = 0; i < 26; ++i) p.in[i] = (const float*)d_in[i];
    p.out = (float*)d_out; p.ws = (unsigned char*)d_ws;
#if MK_ONE_LAUNCH
    int lo = 0, hi = NPH_TOTAL;
    void* args[] = {&p, &lo, &hi};
    (void)args;
    hipLaunchKernelGGL(mega, dim3(grid), dim3(NT), LDS_BYTES, stream, p, lo, hi);
    hipError_t e = hipPeekAtLastError();
    if (e != hipSuccess) fprintf(stderr, "launch failed: %s (grid %d)\n", hipGetErrorString(e), grid);
#else
    for (int k = 0; k < NPH_TOTAL; ++k) hipLaunchKernelGGL(mega, dim3(grid), dim3(NT), LDS_BYTES, stream, p, k, k + 1);
#endif
}
```

```cpp
#include <hip/hip_runtime.h>
#include <cstdio>
#include <cstdint>

#ifndef PROBE_ATT
#define PROBE_ATT 0
#endif
#ifndef PROBE_LN
#define PROBE_LN 0
#endif
#ifndef PROBE_SEL
#define PROBE_SEL 0
#endif
#ifndef MK_ONE_LAUNCH
#define MK_ONE_LAUNCH 1
#endif

typedef unsigned short bf16_t;
typedef float f32x4 __attribute__((ext_vector_type(4)));
typedef unsigned u32x4 __attribute__((ext_vector_type(4)));
typedef unsigned u32x2 __attribute__((ext_vector_type(2)));

constexpr int NT = 512;
constexpr int NWAVE = NT / 64;
constexpr int NTOK = 32768, DM = 1024, SEQ = 8192, NBATCH = 4;
constexpr int ZW = 2560;
constexpr int Z1W = 1280;
constexpr int CIN = 1096;
constexpr int TOPK = 256;
constexpr float ALPHA = 1.4142135623730951f;
constexpr float LN_EPS = 1e-5f;
constexpr int LDS_BYTES = 163840;
constexpr int BARW_OFF = LDS_BYTES - 64;
constexpr int MISC_OFF = 135168;

constexpr size_t MiB = (size_t)1 << 20;
constexpr size_t WS_CTL = 0;
constexpr size_t WS_W_IN0 = 1 * MiB, WS_W_OUT0 = 6 * MiB, WS_W_POOL = 8 * MiB, WS_W_CIN = 9 * MiB, WS_W_QA = 12 * MiB,
                 WS_W_UVBD = 14 * MiB, WS_W_COUT = 16 * MiB, WS_W_G = 18 * MiB, WS_W_P = 22 * MiB, WS_W_GU = 24 * MiB, WS_W_DN = 152 * MiB;
constexpr size_t WS_XB = 224 * MiB, WS_F = 288 * MiB, WS_PB = 416 * MiB, WS_PP = 448 * MiB, WS_CQ = 512 * MiB, WS_CKV = 528 * MiB,
                 WS_SEL = 544 * MiB, WS_TOKG = 560 * MiB, WS_LIST = 561 * MiB, WS_CKV8 = 566 * MiB;
constexpr size_t WS_M0 = 576 * MiB;
constexpr size_t WS_Z0 = WS_M0, WS_KV = WS_M0 + 160 * MiB, WS_MIX = WS_M0 + 224 * MiB, WS_DP = WS_M0 + 288 * MiB, WS_SB = WS_M0 + 320 * MiB;
constexpr size_t WS_OLAT = WS_M0, WS_QA = WS_F  , WS_SC = WS_M0, WS_Z1 = WS_M0 + 272 * MiB;
constexpr size_t WS_ACT = WS_M0, WS_YS = WS_M0 + 72 * MiB;
constexpr size_t WS_XB2 = 960 * MiB;
constexpr size_t WS_END = 1024 * MiB;
constexpr int LIST_CAP = 32768;
constexpr size_t CTL_CNT_OFF = 32768;
constexpr int CNT_STRIDE = 64;
constexpr size_t WS_GT = WS_CTL + 262144;
constexpr size_t WS_SGB = WS_CTL + 786432;

struct Params {
    const float* in[26];
    float* out;
    unsigned char* ws;
};

__device__ __forceinline__ unsigned f2bf(float f) { unsigned u = __float_as_uint(f); return (u + 0x7fffu + ((u >> 16) & 1u)) >> 16; }
__device__ __forceinline__ float bf2f(unsigned h) { return __uint_as_float(h << 16); }
typedef float f32x2_t __attribute__((ext_vector_type(2))); typedef __bf16 bf16x2_t __attribute__((ext_vector_type(2)));
__device__ __forceinline__ unsigned pk2(float lo, float hi) { f32x2_t v = {lo, hi}; bf16x2_t b = __builtin_convertvector(v, bf16x2_t); return __builtin_bit_cast(unsigned, b); }
__device__ __forceinline__ float bflo(unsigned w) { return __uint_as_float(w << 16); }
__device__ __forceinline__ float bfhi(unsigned w) { return __uint_as_float(w & 0xffff0000u); }
#define WAVE_SUM_DPP(v) ({ float _v = (v); \
    _v += __builtin_bit_cast(float, __builtin_amdgcn_update_dpp(0, __builtin_bit_cast(int, _v), 0xB1, 0xf, 0xf, true));     \
    _v += __builtin_bit_cast(float, __builtin_amdgcn_update_dpp(0, __builtin_bit_cast(int, _v), 0x4E, 0xf, 0xf, true));     \
    _v += __builtin_bit_cast(float, __builtin_amdgcn_update_dpp(0, __builtin_bit_cast(int, _v), 0x141, 0xf, 0xf, true));    \
    _v += __builtin_bit_cast(float, __builtin_amdgcn_update_dpp(0, __builtin_bit_cast(int, _v), 0x140, 0xf, 0xf, true));    \
    _v += __builtin_bit_cast(float, __builtin_amdgcn_update_dpp(0, __builtin_bit_cast(int, _v), 0x142, 0xa, 0xf, false));   \
    _v += __builtin_bit_cast(float, __builtin_amdgcn_update_dpp(0, __builtin_bit_cast(int, _v), 0x143, 0xc, 0xf, false));   \
    __builtin_bit_cast(float, __builtin_amdgcn_readlane(__builtin_bit_cast(int, _v), 63)); })
__device__ __forceinline__ float wave_sum(float v) { return WAVE_SUM_DPP(v); }
#define WAVE_SCAN_DPP(v) ({ unsigned _v = (v); \
    _v += (unsigned)__builtin_amdgcn_update_dpp(0, (int)_v, 0x111, 0xf, 0xf, false); \
    _v += (unsigned)__builtin_amdgcn_update_dpp(0, (int)_v, 0x112, 0xf, 0xf, false); \
    _v += (unsigned)__builtin_amdgcn_update_dpp(0, (int)_v, 0x114, 0xf, 0xf, false); \
    _v += (unsigned)__builtin_amdgcn_update_dpp(0, (int)_v, 0x118, 0xf, 0xf, false); \
    _v += (unsigned)__builtin_amdgcn_update_dpp(0, (int)_v, 0x142, 0xa, 0xf, false); \
    _v += (unsigned)__builtin_amdgcn_update_dpp(0, (int)_v, 0x143, 0xc, 0xf, false); \
    _v; })

__device__ __forceinline__ float silu_f(float a) { return a / (1.0f + __expf(-a)); }
__device__ __forceinline__ float sigmoid_f(float a) { return 1.0f / (1.0f + __expf(-a)); }
#define LDS_FENCE() asm volatile("s_waitcnt lgkmcnt(0)" ::: "memory")

struct UnitInfo {
    const bf16_t* A; int lda;
    const int* rows; int rshift;
    int nvalid;
    const bf16_t* Bt; int ldb;
    int K;
    int orow0;
    int pn;
};

struct DenseSched {
    const bf16_t* A; const bf16_t* Bt; int M, N, K, lda, a_pn_stride; int reps = 1;
    int wrank = -1, wcount = 0;
    __device__ __forceinline__ bool next(int round, UnitInfo& u) const {
        const int nN = N >> 8, nM = M >> 8, nwg = nN * nM;
        if (wcount > 0 && wrank < 0) return false;
        const long L = (wcount > 0) ? ((long)round * wcount + wrank) : ((long)round * gridDim.x + blockIdx.x); if (L >= (long)nwg * reps) return false;
        int wgid = (int)(L % nwg); { const int q = nwg / 8, r = nwg % 8, xcd = wgid % 8, off = wgid / 8; wgid = (xcd < r ? xcd * (q + 1) : r * (q + 1) + (xcd - r) * q) + off; }
        const int nig = 8 * nN, gid = wgid / nig, fm = gid * 8, gsz = (nM - fm) < 8 ? (nM - fm) : 8;
        const int pm = fm + ((wgid % nig) % gsz), pn = (wgid % nig) / gsz;
        u.A = A + (size_t)pm * 256 * lda + (size_t)pn * a_pn_stride; u.lda = lda; u.rows = nullptr; u.rshift = 0; u.nvalid = 256;
        u.Bt = Bt + (size_t)pn * 256 * K; u.ldb = K; u.K = K; u.orow0 = pm * 256; u.pn = pn;
        return true;
    }
};
struct MoeSched {
    const int* tb; const int* cnt; const int* list;
    const bf16_t* A; const bf16_t* W; int K; size_t wstride; bool gather;
    __device__ __forceinline__ bool next(int round, UnitInfo& u) const {
        const int i = round * gridDim.x + blockIdx.x;
        const int j = i >> 2, pn = i & 3;
        if (j >= tb[32]) return false;
        int e = 0;
        while (tb[e + 1] <= j) ++e;
        const int rb = j - tb[e];
        const int nv = min(256, cnt[e * CNT_STRIDE] - rb * 256);
        u.rows = list + (size_t)e * LIST_CAP + rb * 256; u.nvalid = nv; u.orow0 = j * 256; u.pn = pn;
        if (gather) { u.A = A; u.lda = K; u.rshift = 1; }
        else { u.A = A + (size_t)j * 256 * K; u.lda = K; u.rshift = 31;   }
        u.Bt = W + (size_t)e * wstride + (size_t)pn * 256 * K; u.ldb = K; u.K = K;
        return true;
    }
};


namespace pg8 {
#define LAS __attribute__((address_space(3)))
typedef short bf16x8 __attribute__((ext_vector_type(8)));
constexpr int BK = 64, HALF = 128, HTB = HALF * BK * 2, STAGE_BYTES = 8 * HTB;
__device__ __forceinline__ int lds_byte(int r, int c) { const int st = (r >> 4) * 2 + (c >> 5), rr = r & 15, cc = c & 31, ob = rr * 64 + cc * 2; return st * 1024 + (ob ^ (((ob >> 9) & 1) << 5)); }
__device__ __forceinline__ void stage_rc(int b, int& R, int& C) { const int st = b / 1024, sb = b % 1024, swz = sb ^ (((sb >> 9) & 1) << 5); R = (st >> 1) * 16 + swz / 64; C = (st & 1) * 32 + (swz % 64) / 2; }
__device__ __forceinline__ int perm32(int rho) { const int n = rho >> 4, i = rho & 15; return 8 * (i >> 2) + 4 * n + (i & 3); }

template <bool GATHER, class Sched, class Epi, bool BDIAG = false>
__device__ __forceinline__ void gemm_phase(LAS unsigned char* lds, const LAS unsigned* rowtab, const Sched& S, const Epi& E, const int lda, const int ldb, const int K) {
    const int tid = threadIdx.x, wid = __builtin_amdgcn_readfirstlane(tid >> 6), lane = tid & 63, wr = wid >> 2, wc = wid & 3, fr = lane & 15, fq = lane >> 4;
    const int nt = K / BK;
    unsigned voffA[2], voffB[2]; int RA[2]; unsigned CA2[2];
#pragma unroll
    for (int i = 0; i < 2; ++i) { int R, C; stage_rc(tid * 16 + i * 8192, R, C); const int Rb = (R & ~31) + perm32(R & 31);
        voffA[i] = (unsigned)(R * lda + C) * 2u; voffB[i] = (unsigned)(Rb * ldb + C) * 2u; RA[i] = R; CA2[i] = (unsigned)C * 2u; }
    const size_t kstep = (size_t)(BK * 2);
    const size_t hstepA = (size_t)HALF * lda * 2, hstepB = (size_t)HALF * ldb * 2;
    const unsigned ldsw = (unsigned)wid * 1024u;
    const int aoff = lds_byte(wr * 64 + fr, fq * 8), boff = lds_byte(wc * 32 + fr, fq * 8);
    unsigned offA[2][2];
#define PG8_SA(b, h) (((b) * 2 + (h)) * HTB)
#define PG8_SB(b, h) ((4 + (b) * 2 + (h)) * HTB)
#define PG8_STAGE(bufoff, gbase, voff) do { _Pragma("unroll") for (int _i = 0; _i < 2; ++_i) \
        __builtin_amdgcn_global_load_lds((const unsigned*)((const char*)(gbase) + (voff)[_i]), (LAS unsigned*)(lds + (bufoff) + ldsw + _i * 8192), 16, 0, 0); } while (0)
#define PG8_STAGE_A(bufoff, h, gbase) do { if (GATHER) PG8_STAGE(bufoff, gbase, offA[h]); else PG8_STAGE(bufoff, (gbase) + (h) * hstepA, voffA); } while (0)
#define PG8_LOADOFF(round) do { _Pragma("unroll") for (int _h = 0; _h < 2; ++_h) _Pragma("unroll") for (int _i = 0; _i < 2; ++_i) offA[_h][_i] = rowtab[(round) * 256 + _h * 128 + RA[_i]] + CA2[_i]; } while (0)
#define PG8_LDA(dst, b, h) do { _Pragma("unroll") for (int m = 0; m < 4; ++m) _Pragma("unroll") for (int k = 0; k < 2; ++k) dst[m][k] = *(const LAS bf16x8*)(lds + PG8_SA(b, h) + aoff + m * 2048 + k * 1024); } while (0)
#define PG8_LDB(dst, b, h) do { _Pragma("unroll") for (int n = 0; n < 2; ++n) _Pragma("unroll") for (int k = 0; k < 2; ++k) dst[n][k] = *(const LAS bf16x8*)(lds + PG8_SB(b, h) + boff + n * 2048 + k * 1024); } while (0)
#define PG8_MMA(ai, bj, At, Bt) do { if (!BDIAG || (((kt_ >> 2) & 3) == 2 * (bj) + (wc >> 1))) { __builtin_amdgcn_s_setprio(1); _Pragma("unroll") for (int m = 0; m < 4; ++m) _Pragma("unroll") for (int n = 0; n < 2; ++n) _Pragma("unroll") for (int k = 0; k < 2; ++k) \
        acc[ai][bj][m][n] = __builtin_amdgcn_mfma_f32_16x16x32_bf16(Bt[n][k], At[m][k], acc[ai][bj][m][n], 0, 0, 0); __builtin_amdgcn_s_setprio(0); } } while (0)
#define PG8_WAIT_V(n) asm volatile("s_waitcnt vmcnt(" #n ")" ::: "memory")
#define PG8_WAIT_L(n) asm volatile("s_waitcnt lgkmcnt(" #n ")" ::: "memory")
#define PG8_BAR __builtin_amdgcn_s_barrier()
#define PG8_SCHED __builtin_amdgcn_sched_barrier(0)
    UnitInfo cur, nxt; int ui = 0;
    if (!S.next(0, cur)) return;
    f32x4 acc[2][2][4][2];
#pragma unroll
    for (int a = 0; a < 2; ++a)
#pragma unroll
        for (int b = 0; b < 2; ++b)
#pragma unroll
            for (int m = 0; m < 4; ++m)
#pragma unroll
                for (int n = 0; n < 2; ++n) acc[a][b][m][n] = (f32x4){0.f, 0.f, 0.f, 0.f};
    bf16x8 At[4][2], B0[2][2], B1[2][2];
    const char* cA = (const char*)cur.A; const char* cB = (const char*)cur.Bt;
    if (GATHER) { PG8_LOADOFF(0); }
    PG8_STAGE(PG8_SB(0, 0), cB, voffB); PG8_STAGE(PG8_SB(0, 1), cB + hstepB, voffB); PG8_STAGE_A(PG8_SA(0, 0), 0, cA); PG8_STAGE_A(PG8_SA(0, 1), 1, cA);
    if (wr == 1) PG8_BAR;
    PG8_WAIT_V(2); PG8_BAR;
    PG8_STAGE(PG8_SB(1, 0), cB + kstep, voffB); PG8_STAGE_A(PG8_SA(1, 0), 0, cA + kstep); PG8_STAGE(PG8_SB(1, 1), cB + hstepB + kstep, voffB);
    PG8_WAIT_V(6); PG8_BAR;
    for (;;) {
        const bool has_next = S.next(ui + 1, nxt);
        const char* nA = has_next ? (const char*)nxt.A : cA; const char* nB = has_next ? (const char*)nxt.Bt : cB;
        for (int t = 0; t < nt; t += 2) {
            const bool last = (t == nt - 2);
            const char* a1 = cA + (size_t)(t + 1) * kstep;
            const char* a2 = last ? nA : cA + (size_t)(t + 2) * kstep; const char* b2 = last ? nB : cB + (size_t)(t + 2) * kstep;
            const char* a3 = a2 + kstep; const char* b3 = b2 + kstep;
            int kt_ = t;
            PG8_LDB(B0, 0, 0); PG8_LDB(B1, 0, 1); PG8_SCHED; PG8_LDA(At, 0, 0); PG8_STAGE_A(PG8_SA(1, 1), 1, a1);
            if (GATHER) { if (last && has_next) { PG8_LOADOFF(ui + 1); } }
            PG8_WAIT_V(8); PG8_WAIT_L(0); PG8_BAR; PG8_MMA(0, 0, At, B0); PG8_MMA(0, 1, At, B1); PG8_BAR; PG8_SCHED;
            PG8_LDA(At, 0, 1); PG8_STAGE(PG8_SB(0, 0), b2, voffB); PG8_STAGE(PG8_SB(0, 1), b2 + hstepB, voffB); PG8_STAGE_A(PG8_SA(0, 0), 0, a2);
            PG8_WAIT_V(8); PG8_WAIT_L(0); PG8_BAR; PG8_MMA(1, 0, At, B0); PG8_MMA(1, 1, At, B1); PG8_BAR; PG8_SCHED;
            kt_ = t + 1;
            PG8_LDB(B0, 1, 0); PG8_LDB(B1, 1, 1); PG8_SCHED; PG8_LDA(At, 1, 0); PG8_STAGE_A(PG8_SA(0, 1), 1, a2);
            PG8_WAIT_V(8); PG8_WAIT_L(0); PG8_BAR; PG8_MMA(0, 0, At, B0); PG8_MMA(0, 1, At, B1); PG8_BAR; PG8_SCHED;
            PG8_LDA(At, 1, 1); PG8_STAGE(PG8_SB(1, 0), b3, voffB); PG8_STAGE(PG8_SB(1, 1), b3 + hstepB, voffB); PG8_STAGE_A(PG8_SA(1, 0), 0, a3);
            PG8_WAIT_V(8); PG8_WAIT_L(0); PG8_BAR; PG8_MMA(1, 0, At, B0); PG8_MMA(1, 1, At, B1); PG8_BAR; PG8_SCHED;
        }
        if (wr == 0) PG8_BAR;
#pragma unroll
        for (int ai = 0; ai < 2; ++ai)
#pragma unroll
            for (int m = 0; m < 4; ++m)
#pragma unroll
                for (int bj = 0; bj < 2; ++bj) E(cur, ai * HALF + wr * 64 + m * 16 + fr, bj * HALF + wc * 32 + 8 * fq, acc[ai][bj][m][0], acc[ai][bj][m][1]);
        if (!has_next) break;
#pragma unroll
        for (int a = 0; a < 2; ++a)
#pragma unroll
            for (int b = 0; b < 2; ++b)
#pragma unroll
                for (int m = 0; m < 4; ++m)
#pragma unroll
                    for (int n = 0; n < 2; ++n) acc[a][b][m][n] = (f32x4){0.f, 0.f, 0.f, 0.f};
        cur = nxt; cA = nA; cB = nB; ++ui;
        if (wr == 1) PG8_BAR;
    }
    PG8_WAIT_V(0);
    PG8_BAR;
#undef PG8_SA
#undef PG8_SB
#undef PG8_STAGE
#undef PG8_STAGE_A
#undef PG8_LOADOFF
#undef PG8_LDA
#undef PG8_LDB
#undef PG8_MMA
#undef PG8_WAIT_V
#undef PG8_WAIT_L
#undef PG8_BAR
#undef PG8_SCHED
}
}

template <class Sched, class Epi>
__device__ __forceinline__ void gemm_dense(unsigned char* lds, const Sched& S, const Epi& E) {
    pg8::gemm_phase<false>((LAS unsigned char*)lds, (const LAS unsigned*)nullptr, S, E, S.lda, S.K, S.K);
    __syncthreads();
}
template <class Sched, class Epi>
__device__ __forceinline__ void gemm_dense_bdiag(unsigned char* lds, const Sched& S, const Epi& E) {
    pg8::gemm_phase<false, Sched, Epi, true>((LAS unsigned char*)lds, (const LAS unsigned*)nullptr, S, E, S.lda, S.K, S.K);
    __syncthreads();
}


template <bool GATHER, class Epi>
__device__ __forceinline__ void gemm_moe(unsigned char* lds, const MoeSched& S, const Epi& E) {
    LAS unsigned* rowtab = (LAS unsigned*)(lds + MISC_OFF + 256);
    if (GATHER) {
        for (int r0 = 0; r0 < 10; r0 += 5) {
            const int* rp[5]; int nv[5]; bool ok[5]; int v[5];
#pragma unroll
            for (int q = 0; q < 5; ++q) { UnitInfo u; ok[q] = S.next(r0 + q, u); rp[q] = u.rows; nv[q] = ok[q] ? u.nvalid : 0; }
#pragma unroll
            for (int q = 0; q < 5; ++q) v[q] = (threadIdx.x < 256 && (int)threadIdx.x < nv[q]) ? rp[q][threadIdx.x] : 0;
#pragma unroll
            for (int q = 0; q < 5; ++q) if (ok[q] && threadIdx.x < 256) rowtab[(r0 + q) * 256 + threadIdx.x] = (unsigned)(v[q] >> 1) * (unsigned)(S.K * 2);
            if (!ok[4]) break;
        }
        __syncthreads();
    }
    pg8::gemm_phase<GATHER>((LAS unsigned char*)lds, (const LAS unsigned*)rowtab, S, E, S.K, S.K, S.K);
    __syncthreads();
}

__device__ __forceinline__ u32x4 pack8(f32x4 a, f32x4 b) { u32x4 w; w.x = pk2(a.x, a.y); w.y = pk2(a.z, a.w); w.z = pk2(b.x, b.y); w.w = pk2(b.z, b.w); return w; }
struct EpiStoreBf16 {
    bf16_t* O; int ldc; int coff; const float* colscale;
    __device__ __forceinline__ void operator()(const UnitInfo& u, int r, int c, f32x4 v0, f32x4 v1) const {
        const int col = u.pn * 256 + c;
        if (colscale) { const f32x4 s0 = *(const f32x4*)(colscale + col), s1 = *(const f32x4*)(colscale + col + 4); v0 *= s0; v1 *= s1; }
        *(u32x4*)(O + (size_t)(u.orow0 + r) * ldc + coff + col) = pack8(v0, v1);
    }
};

__device__ __forceinline__ float ret_log2g(int h) { return log2f(1.0f - exp2f(-5.0f - (float)h)); }
struct EpiZ0 {
    bf16_t* O;
    __device__ __forceinline__ void operator()(const UnitInfo& u, int r, int c, f32x4 v0, f32x4 v1) const {
        const int col = u.pn * 256 + c, row = u.orow0 + r;
        if (col < 1024) { const float e = ret_log2g((col >> 7) & 3) * (float)(row & 127); const float sc = exp2f(col < 512 ? e : -e); v0 *= sc; v1 *= sc; }
        *(u32x4*)(O + (size_t)row * ZW + col) = pack8(v0, v1);
    }
};

struct EpiStoreFp8 {
    unsigned char* O; int ldc;
    __device__ __forceinline__ void operator()(const UnitInfo& u, int r, int c, f32x4 v0, f32x4 v1) const {
        int w0 = __builtin_amdgcn_cvt_pk_fp8_f32(v0.x, v0.y, 0, false); w0 = __builtin_amdgcn_cvt_pk_fp8_f32(v0.z, v0.w, w0, true);
        int w1 = __builtin_amdgcn_cvt_pk_fp8_f32(v1.x, v1.y, 0, false); w1 = __builtin_amdgcn_cvt_pk_fp8_f32(v1.z, v1.w, w1, true);
        u32x2 w; w.x = (unsigned)w0; w.y = (unsigned)w1;
        *(u32x2*)(O + (size_t)(u.orow0 + r) * ldc + u.pn * 256 + c) = w;
    }
};
struct EpiResidB {
    const bf16_t* X; bf16_t* Yo;
    __device__ __forceinline__ void operator()(const UnitInfo& u, int r, int c, f32x4 v0, f32x4 v1) const {
        const size_t off = (size_t)(u.orow0 + r) * DM + u.pn * 256 + c;
        const u32x4 xw = *(const u32x4*)(X + off);
        const f32x4 x0 = {bflo(xw.x), bfhi(xw.x), bflo(xw.y), bfhi(xw.y)}, x1 = {bflo(xw.z), bfhi(xw.z), bflo(xw.w), bfhi(xw.w)};
        *(u32x4*)(Yo + off) = pack8(x0 * ALPHA + v0, x1 * ALPHA + v1);
    }
};

struct EpiGU {
    bf16_t* ACT;
    __device__ __forceinline__ void operator()(const UnitInfo& u, int r, int c, f32x4 v0, f32x4 v1) const {
        u32x2 w; w.x = pk2(silu_f(v0.x) * v0.y, silu_f(v0.z) * v0.w); w.y = pk2(silu_f(v1.x) * v1.y, silu_f(v1.z) * v1.w);
        *(u32x2*)(ACT + (size_t)(u.orow0 + r) * 512 + u.pn * 128 + (c >> 1)) = w;
    }
};
struct EpiDown {
    bf16_t* YS;
    __device__ __forceinline__ void operator()(const UnitInfo& u, int r, int c, f32x4 v0, f32x4 v1) const {
        if (r < u.nvalid) { const int pair = u.rows[r]; *(u32x4*)(YS + (size_t)pair * DM + u.pn * 256 + c) = pack8(v0, v1); }
    }
};
struct EpiPle {
    const bf16_t* XI; const bf16_t* PP; float* OUT; bf16_t* XO;
    __device__ __forceinline__ void operator()(const UnitInfo& u, int r, int c, f32x4 v0, f32x4 v1) const {
        const size_t off = (size_t)(u.orow0 + r) * DM + u.pn * 256 + c;
        const u32x4 pw = *(const u32x4*)(PP + off), xw = *(const u32x4*)(XI + off);
        f32x4 f0 = {bflo(xw.x), bfhi(xw.x), bflo(xw.y), bfhi(xw.y)}, f1 = {bflo(xw.z), bfhi(xw.z), bflo(xw.w), bfhi(xw.w)};
        f0.x += sigmoid_f(v0.x) * bflo(pw.x); f0.y += sigmoid_f(v0.y) * bfhi(pw.x); f0.z += sigmoid_f(v0.z) * bflo(pw.y); f0.w += sigmoid_f(v0.w) * bfhi(pw.y);
        f1.x += sigmoid_f(v1.x) * bflo(pw.z); f1.y += sigmoid_f(v1.y) * bfhi(pw.z); f1.z += sigmoid_f(v1.z) * bflo(pw.w); f1.w += sigmoid_f(v1.w) * bfhi(pw.w);
        if (OUT) { *(f32x4*)(OUT + off) = f0; *(f32x4*)(OUT + off + 4) = f1; }
        if (XO) *(u32x4*)(XO + off) = pack8(f0, f1);
    }
};

struct TrDesc { const float* src; bf16_t* dst; int K, N, Nsrc, nbatch, mode, dst_ld; };
struct TrItem { const float* src; bf16_t* dst; int Nsrc, dst_ld, mode, kb, nb; };
__device__ __forceinline__ void tr_load(const TrItem& t, int lane, float (&tmp)[32]) {
    const int k0 = 64 * t.kb, n0 = 32 * t.nb, Ns = t.Nsrc;
    const bool okc = (n0 + (lane & 31)) < Ns;
    const float* p = t.src + (size_t)(k0 + (lane >> 5)) * Ns + n0 + (lane & 31);
#pragma unroll
    for (int i = 0; i < 32; ++i) { tmp[i] = okc ? __builtin_nontemporal_load(p) : 0.f; p += 2 * Ns; asm volatile("" : "+v"(p)); }
}
__device__ __forceinline__ void tr_store(const TrItem& t, float* scr, int lane, const float (&tmp)[32]) {
    const int k0 = 64 * t.kb, n0 = 32 * t.nb;
#pragma unroll
    for (int i = 0; i < 32; ++i) scr[(2 * i + (lane >> 5)) * 33 + (lane & 31)] = tmp[i];
    LDS_FENCE();
    const int c = lane & 7;
    int n8 = lane >> 3; asm volatile("" : "+v"(n8));
#pragma unroll
    for (int j = 0; j < 4; ++j) {
        const int n = n8 + 8 * j; const float* sp = scr + (8 * c) * 33 + n;
        const int ng = n0 + n;
        float sc = 1.f; int nd = ng; int coff = 0;
        if (t.mode == 1) { if (ng >= 512 && ng < 1024) sc = 0.08838834764831845f; }
        if (t.mode == 2) { nd = (ng < 512) ? 2 * ng : 2 * (ng - 512) + 1; }
        if (t.mode == 3) { coff = ((ng >> 6) & 3) * 256; }
        u32x4 o; o.x = pk2(sp[0 * 33] * sc, sp[1 * 33] * sc); o.y = pk2(sp[2 * 33] * sc, sp[3 * 33] * sc); o.z = pk2(sp[4 * 33] * sc, sp[5 * 33] * sc); o.w = pk2(sp[6 * 33] * sc, sp[7 * 33] * sc);
        *(u32x4*)(t.dst + (size_t)nd * t.dst_ld + coff + k0 + 8 * c) = o;
    }
    LDS_FENCE();
}
__device__ __forceinline__ int tr_items(const TrDesc& d) { return d.nbatch * (d.K / 64) * (d.N / 32); }

constexpr int N_DEFERRED = 32 * 512 + 32 * 256;
__device__ __forceinline__ TrItem deferred_item(const Params& P, int idx) {
    TrItem t;
    if (idx < 32 * 512) { const int b = 32 + (idx >> 9), r = idx & 511;
        t.src = P.in[22] + (size_t)b * 1024 * 1024; t.dst = (bf16_t*)(P.ws + WS_W_GU) + (size_t)b * 1024 * 1024; t.Nsrc = 1024; t.dst_ld = 1024; t.mode = 2; t.kb = r >> 5; t.nb = r & 31; }
    else { const int i2 = idx - 32 * 512, b = 32 + (i2 >> 8), r = i2 & 255;
        t.src = P.in[23] + (size_t)b * 512 * 1024; t.dst = (bf16_t*)(P.ws + WS_W_DN) + (size_t)b * 1024 * 512; t.Nsrc = 1024; t.dst_ld = 512; t.mode = 0; t.kb = r >> 5; t.nb = r & 31; }
    return t;
}
__device__ __forceinline__ void phase_prep(const Params& P, unsigned char* lds) {
    unsigned char* ws = P.ws;
    const int tid = threadIdx.x, lane = tid & 63, wave = tid >> 6;
    const int gw = blockIdx.x * NWAVE + wave, NGW = gridDim.x * NWAVE;
    float* scr = (float*)lds + wave * (64 * 33);
    constexpr int ND = 9;
    TrDesc d[ND];
    d[0] = {P.in[22], (bf16_t*)(ws + WS_W_GU), 1024, 1024, 1024, 32, 2, 1024};
    d[1] = {P.in[23], (bf16_t*)(ws + WS_W_DN), 512, 1024, 1024, 32, 0, 512};
    d[2] = {P.in[2], (bf16_t*)(ws + WS_W_IN0), 1024, 2560, 2560, 1, 1, 1024};
    d[3] = {P.in[6], (bf16_t*)(ws + WS_W_OUT0), 1024, 1024, 1024, 1, 0, 1024};
    d[4] = {P.in[13], (bf16_t*)(ws + WS_W_COUT), 1024, 1024, 1024, 1, 0, 1024};
    d[5] = {P.in[24], (bf16_t*)(ws + WS_W_G), 1024, 1024, 1024, 2, 0, 1024};
    d[6] = {P.in[25], (bf16_t*)(ws + WS_W_P), 256, 1024, 1024, 2, 0, 256};
    d[7] = {P.in[7], (bf16_t*)(ws + WS_W_CIN), 1024, Z1W, CIN, 1, 0, 1024};
    d[8] = {P.in[12], (bf16_t*)(ws + WS_W_UVBD), 256, 1024, 1024, 1, 3, 1024};
    int total = 0;
#pragma unroll
    for (int i = 0; i < ND; ++i) total += tr_items(d[i]);
#define TR_DECODE(it, T) do { int _r = (it); bool _f = false; T = TrItem{nullptr, nullptr, 0, 0, 0, 0, 0}; _Pragma("unroll") for (int _i = 0; _i < ND; ++_i) { const int _n = tr_items(d[_i]); \
            if (!_f && _r < _n) { _f = true; const int _per = (d[_i].K / 64) * (d[_i].N / 32), _b = _r / _per, _q = _r % _per, _nblk = d[_i].N / 32; \
                T.src = d[_i].src + (size_t)_b * d[_i].K * d[_i].Nsrc; T.dst = d[_i].dst + (size_t)_b * d[_i].N * d[_i].dst_ld; T.Nsrc = d[_i].Nsrc; T.dst_ld = d[_i].dst_ld; T.mode = d[_i].mode; T.kb = _q / _nblk; T.nb = _q % _nblk; } \
            if (!_f) _r -= _n; } } while (0)
    {
        float cur[32], nxt[32];
        TrItem tc, tn;
        int it = gw;
        if (it < total) { TR_DECODE(it, tc); tr_load(tc, lane, cur); }
        while (it < total) {
            const int itn = it + NGW;
            if (itn < total) { TR_DECODE(itn, tn); tr_load(tn, lane, nxt); }
            tr_store(tc, scr, lane, cur);
#pragma unroll
            for (int i = 0; i < 32; ++i) cur[i] = nxt[i];
            it = itn; tc = tn;
        }
    }
#undef TR_DECODE
    const size_t gt = (size_t)blockIdx.x * NT + tid, GS = (size_t)gridDim.x * NT;
    {
        bf16_t* o = (bf16_t*)(ws + WS_W_POOL); const float* pw = P.in[4];
        for (size_t i = gt; i < 512 * 256; i += GS) { const int n = (int)(i >> 8), k = (int)(i & 255), g = n >> 7, dd = n & 127, kg = k >> 7, c = k & 127;
            o[i] = (bf16_t)((kg == (g & 1)) ? f2bf(pw[((size_t)g * 128 + c) * 128 + dd]) : 0u); }
    }
    {
        u32x4* o = (u32x4*)(ws + WS_W_UVBD);
        for (size_t i = gt; i < (size_t)1024 * 1024 / 8; i += GS) { const int n = (int)(i >> 7), k = (int)(i & 127) * 8; if (((n >> 6) & 3) != (k >> 8)) o[i] = (u32x4){0u, 0u, 0u, 0u}; }
    }
    {
        bf16_t* o = (bf16_t*)(ws + WS_W_QA); const float* uq = P.in[10]; const float* uk = P.in[11];
        float* Bq = (float*)lds; float* Ak = Bq + 256 * 65;
        for (int item = blockIdx.x; item < 256; item += gridDim.x) {
            const int h = item >> 4, c0 = (item & 15) * 16;
            __syncthreads();
            {   f32x4 v[8];
#pragma unroll
                for (int q = 0; q < 8; ++q) { const int i = tid + NT * q, r = i >> 4, d4 = (i & 15) * 4; v[q] = *(const f32x4*)(uq + (size_t)r * 1024 + h * 64 + d4); }
                f32x4 vk = {0.f, 0.f, 0.f, 0.f};
                if (tid < 256) { const int c = tid >> 4, d4 = (tid & 15) * 4; vk = *(const f32x4*)(uk + (size_t)(c0 + c) * 1024 + h * 64 + d4); }
#pragma unroll
                for (int q = 0; q < 8; ++q) { const int i = tid + NT * q, r = i >> 4, d4 = (i & 15) * 4; float* qd = Bq + r * 65 + d4; qd[0] = v[q].x; qd[1] = v[q].y; qd[2] = v[q].z; qd[3] = v[q].w; }
                if (tid < 256) { const int c = tid >> 4, d4 = (tid & 15) * 4; float* qd = Ak + c * 65 + d4; qd[0] = vk.x; qd[1] = vk.y; qd[2] = vk.z; qd[3] = vk.w; }
            }
            __syncthreads();
            const int r = tid & 255, cg = tid >> 8;
            float acc[8];
#pragma unroll
            for (int j = 0; j < 8; ++j) acc[j] = 0.f;
#pragma unroll 8
            for (int dd = 0; dd < 64; ++dd) { const float bv = Bq[r * 65 + dd];
#pragma unroll
                for (int j = 0; j < 8; ++j) acc[j] += Ak[(cg * 8 + j) * 65 + dd] * bv; }
#pragma unroll
            for (int j = 0; j < 8; ++j) o[(size_t)(h * 256 + c0 + cg * 8 + j) * 256 + r] = (bf16_t)f2bf(acc[j] * 0.125f);
        }
        __syncthreads();
    }
    {
        bf16_t* GT = (bf16_t*)(ws + WS_GT); float* SGB = (float*)(ws + WS_SGB);
        for (size_t i = gt; i < (size_t)2 * 48 * 1024; i += GS) {
            const int l = (int)(i / (48 * 1024)), j = (int)((i / 1024) % 48), c = (int)(i & 1023);
            float w = 0.f;
            if (j < 4) w = P.in[18][(size_t)l * DM * 4 + (size_t)c * 4 + j]; else if (j < 36) w = P.in[20][(size_t)l * DM * 32 + (size_t)c * 32 + (j - 4)];
            const float g = P.in[14][l * DM + c] * w;
            const unsigned hi = f2bf(g); const unsigned lo = f2bf(g - bf2f(hi));
            GT[((size_t)(l * 2 + 0) * 48 + j) * 1024 + c] = (bf16_t)hi; GT[((size_t)(l * 2 + 1) * 48 + j) * 1024 + c] = (bf16_t)lo;
        }
        for (int it = NGW - 1 - gw; it < 96; it += NGW) {
            const int l = it / 48, j = it % 48; float sg = 0.f, sb = 0.f;
#pragma unroll
            for (int c = lane; c < 1024; c += 64) {
                float w = 0.f;
                if (j < 4) w = P.in[18][(size_t)l * DM * 4 + (size_t)c * 4 + j]; else if (j < 36) w = P.in[20][(size_t)l * DM * 32 + (size_t)c * 32 + (j - 4)];
                sg += P.in[14][l * DM + c] * w; sb += P.in[15][l * DM + c] * w;
            }
            sg = wave_sum(sg); sb = wave_sum(sb);
            const float bias = (j < 4) ? P.in[19][l * 4 + j] : ((j < 36) ? P.in[21][l * 32 + (j - 4)] : 0.f);
            if (lane == 0) { SGB[(l * 2 + 0) * 48 + j] = sg; SGB[(l * 2 + 1) * 48 + j] = sb + bias; }
        }
    }
    {
        const f32x4* x = (const f32x4*)P.in[0]; u32x4* xb = (u32x4*)(ws + WS_XB);
        const size_t nx = (size_t)NTOK * DM / 8, np = (size_t)2 * NTOK * 256 / 8;
        size_t i = gt;
        for (; i + 3 * GS < nx; i += 4 * GS) { f32x4 a[8];
#pragma unroll
            for (int q = 0; q < 4; ++q) { a[2 * q] = __builtin_nontemporal_load(x + 2 * (i + q * GS)); a[2 * q + 1] = __builtin_nontemporal_load(x + 2 * (i + q * GS) + 1); }
#pragma unroll
            for (int q = 0; q < 4; ++q) xb[i + q * GS] = pack8(a[2 * q], a[2 * q + 1]); }
        for (; i < nx; i += GS) xb[i] = pack8(x[2 * i], x[2 * i + 1]);
        const f32x4* p = (const f32x4*)P.in[1]; u32x4* pb = (u32x4*)(ws + WS_PB);
        i = gt;
        for (; i + 3 * GS < np; i += 4 * GS) { f32x4 a[8];
#pragma unroll
            for (int q = 0; q < 4; ++q) { a[2 * q] = __builtin_nontemporal_load(p + 2 * (i + q * GS)); a[2 * q + 1] = __builtin_nontemporal_load(p + 2 * (i + q * GS) + 1); }
#pragma unroll
            for (int q = 0; q < 4; ++q) pb[i + q * GS] = pack8(a[2 * q], a[2 * q + 1]); }
        for (; i < np; i += GS) pb[i] = pack8(p[2 * i], p[2 * i + 1]);
    }
}


template <bool DRY>
__device__ __forceinline__ void phase_ln_route(const Params& P, unsigned char* lds, int layer) {
    using pg8::bf16x8;
    const bf16_t* F = (const bf16_t*)(P.ws + WS_F); bf16_t* XB = (bf16_t*)(P.ws + (DRY ? WS_M0 + 128 * MiB : WS_XB));
    float* TOKG = (float*)(P.ws + WS_TOKG); int* LIST = (int*)(P.ws + WS_LIST);
    int* CNT = (int*)(P.ws + WS_CTL + CTL_CNT_OFF) + layer * 32 * CNT_STRIDE;
    const float* lg = P.in[14] + layer * DM; const float* lb = P.in[15] + layer * DM;
    const bf16_t* GTh = (const bf16_t*)(P.ws + WS_GT) + (size_t)(layer * 2) * 48 * 1024; const bf16_t* GTl = GTh + 48 * 1024;
    const float* SG = (const float*)(P.ws + WS_SGB) + (layer * 2) * 48; const float* BB = SG + 48;
    const int tid = threadIdx.x, lane = tid & 63, wave = tid >> 6, r16 = lane & 15, g = lane >> 4;
    int* dec = (int*)lds;
    int* rank = dec + 256;
    int* lcnt = rank + 256;
    int* lbase = lcnt + 32;
    float* SS = (float*)(lds + 4096);
    float* stat = SS + wave * 32;
    float* LGs = (float*)(lds + 8192);
    float* LG = LGs + wave * (16 * 52);
    float* PP_ = (float*)(lds + 36864);
    float* PS = (float*)(lds + 36864 + 8 * 64 * 52 * 4);
    for (int rb = blockIdx.x; rb < NTOK / 128; rb += gridDim.x) {
        if (tid < 32) lcnt[tid] = 0;
        __syncthreads();
        const int tbase = rb * 128 + wave * 16;
        {
            bf16x8 GH[12], GL[12];
            {   int r16l = r16; asm volatile("" : "+v"(r16l));
                const bf16_t* hp = GTh + (size_t)r16l * 1024 + 128 * wave + 8 * g; const bf16_t* lp = GTl + (size_t)r16l * 1024 + 128 * wave + 8 * g;
#pragma unroll
                for (int ks = 0; ks < 4; ++ks)
#pragma unroll
                    for (int i = 0; i < 3; ++i) { GH[ks * 3 + i] = *(const bf16x8*)(hp + (size_t)i * 16 * 1024 + 32 * ks); GL[ks * 3 + i] = *(const bf16x8*)(lp + (size_t)i * 16 * 1024 + 32 * ks); } }
            const bf16_t* yp = F + (size_t)(rb * 128 + r16) * DM + 128 * wave + 8 * g;
#pragma unroll 1
            for (int half = 0; half < ((DRY && PROBE_LN == 1) ? 0 : 2); ++half) {
#pragma unroll 1
              for (int rp = 0; rp < 2; ++rp) {
                u32x4 YW[8];
#pragma unroll
                for (int rt2 = 0; rt2 < 2; ++rt2) {
#pragma unroll
                    for (int ks = 0; ks < 4; ++ks) YW[rt2 * 4 + ks] = *(const u32x4*)(yp + 32 * ks);
                    yp += 16 * DM; asm volatile("" : "+v"(yp)); }
                __builtin_amdgcn_sched_barrier(0);
#pragma unroll
                for (int rt2 = 0; rt2 < 2; ++rt2) {
                    const int rt4 = rp * 2 + rt2;
                    f32x4 acc[3];
#pragma unroll
                    for (int i = 0; i < 3; ++i) acc[i] = (f32x4){0.f, 0.f, 0.f, 0.f};
                    float sm = 0.f, sq = 0.f;
#pragma unroll
                    for (int ks = 0; ks < 4; ++ks) {
                        const u32x4 yw = YW[rt2 * 4 + ks];
                        const float y0 = bflo(yw.x), y1 = bfhi(yw.x), y2 = bflo(yw.y), y3 = bfhi(yw.y), y4 = bflo(yw.z), y5 = bfhi(yw.z), y6 = bflo(yw.w), y7 = bfhi(yw.w);
                        sm += (y0 + y1) + (y2 + y3) + (y4 + y5) + (y6 + y7);
                        sq += (y0 * y0 + y1 * y1) + (y2 * y2 + y3 * y3) + (y4 * y4 + y5 * y5) + (y6 * y6 + y7 * y7);
                        const bf16x8 yh = __builtin_bit_cast(bf16x8, yw);
#pragma unroll
                        for (int i = 0; i < 3; ++i) {
                            acc[i] = __builtin_amdgcn_mfma_f32_16x16x32_bf16(yh, GH[ks * 3 + i], acc[i], 0, 0, 0);
                            acc[i] = __builtin_amdgcn_mfma_f32_16x16x32_bf16(yh, GL[ks * 3 + i], acc[i], 0, 0, 0);
                        }
                    }
                    sm += __shfl_xor(sm, 16); sm += __shfl_xor(sm, 32); sq += __shfl_xor(sq, 16); sq += __shfl_xor(sq, 32);
                    if (g == 0) { PS[(wave * 64 + 16 * rt4 + r16) * 2] = sm; PS[(wave * 64 + 16 * rt4 + r16) * 2 + 1] = sq; }
#pragma unroll
                    for (int i = 0; i < 3; ++i)
#pragma unroll
                        for (int r = 0; r < 4; ++r) PP_[(wave * 64 + 16 * rt4 + 4 * g + r) * 52 + 16 * i + r16] = acc[i][r];
                }
                __builtin_amdgcn_sched_barrier(0);
              }
                __syncthreads();
#pragma unroll
                for (int q = 0; q < 6; ++q) { const int idx = tid + NT * q, row = idx / 48, col = idx - row * 48;
                    float a = 0.f;
#pragma unroll
                    for (int w = 0; w < 8; ++w) a += PP_[(w * 64 + row) * 52 + col];
                    LGs[(half * 64 + row) * 52 + col] = a; }
                if (tid < 128) { float a = 0.f;
#pragma unroll
                    for (int w = 0; w < 8; ++w) a += PS[w * 128 + tid];
                    SS[half * 128 + tid] = a; }
                __syncthreads();
            }
        }
        {
            int tid_l = tid; asm volatile("" : "+v"(tid_l));
            const int t = tid_l >> 2, c0 = (tid_l & 3) * 12;
            const float s1 = SS[t * 2], s2 = SS[t * 2 + 1];
            const float mean = s1 * (1.0f / DM), var = fmaxf(s2 * (1.0f / DM) - mean * mean, 0.f), rstd = 1.0f / sqrtf(var + LN_EPS);
#pragma unroll
            for (int c = 0; c < 12; ++c) LGs[t * 52 + c0 + c] = rstd * (LGs[t * 52 + c0 + c] - mean * SG[c0 + c]) + BB[c0 + c];
            __syncthreads();
            if ((tid_l & 3) == 0) { SS[t * 2] = mean; SS[t * 2 + 1] = rstd; }
        }
        __syncthreads();
        if (lane < 16) {
            const float* lr = LG + lane * 52; const int rl = wave * 16 + lane, t = tbase + lane;
            float gl4[4];
#pragma unroll
            for (int j = 0; j < 4; ++j) gl4[j] = lr[j];
            int grp = 0; float gm = gl4[0];
#pragma unroll
            for (int j = 1; j < 4; ++j) if (gl4[j] > gm) { gm = gl4[j]; grp = j; }
            float gs = 0.f;
#pragma unroll
            for (int j = 0; j < 4; ++j) gs += __expf(gl4[j] - gm);
            const float gwt = 1.0f / gs;
            float el[8];
#pragma unroll
            for (int j = 0; j < 8; ++j) el[j] = lr[4 + grp * 8 + j];
            int i0 = 0; float m0 = el[0];
#pragma unroll
            for (int j = 1; j < 8; ++j) if (el[j] > m0) { m0 = el[j]; i0 = j; }
            int i1 = -1; float m1 = -INFINITY;
#pragma unroll
            for (int j = 0; j < 8; ++j) if (j != i0 && el[j] > m1) { m1 = el[j]; i1 = j; }
            const float ex = __expf(m1 - m0);
            const float p0 = 1.0f / (1.0f + ex), p1 = ex / (1.0f + ex);
            dec[rl * 2] = grp * 8 + i0; dec[rl * 2 + 1] = grp * 8 + i1;
            if (!DRY) { TOKG[(size_t)t * 2] = gwt * p0; TOKG[(size_t)t * 2 + 1] = gwt * p1; }
        }
        int lane_l = lane; asm volatile("" : "+v"(lane_l));
        f32x4 g4[4], b4[4];
#pragma unroll
        for (int j = 0; j < 2; ++j) { g4[2 * j] = *(const f32x4*)(lg + 512 * j + 8 * lane_l); g4[2 * j + 1] = *(const f32x4*)(lg + 512 * j + 8 * lane_l + 4);
                                      b4[2 * j] = *(const f32x4*)(lb + 512 * j + 8 * lane_l); b4[2 * j + 1] = *(const f32x4*)(lb + 512 * j + 8 * lane_l + 4); }
#pragma unroll 1
        for (int rg = 0; rg < ((DRY && PROBE_LN == 2) ? 0 : 2); ++rg) {
            const bf16_t* fr = F + (size_t)(tbase + 8 * rg) * DM + 8 * lane_l; bf16_t* xo = XB + (size_t)(tbase + 8 * rg) * DM + 8 * lane_l;
            u32x4 yv[16];
#pragma unroll
            for (int r8 = 0; r8 < 8; ++r8) {
#pragma unroll
                for (int j = 0; j < 2; ++j) yv[2 * r8 + j] = *(const u32x4*)(fr + 512 * j);
                fr += DM; asm volatile("" : "+v"(fr)); }
            __builtin_amdgcn_sched_barrier(0);
#pragma unroll
            for (int r8 = 0; r8 < 8; ++r8) { const int r = 8 * rg + r8;
                const float mu = stat[r * 2], rs = stat[r * 2 + 1];
#pragma unroll
                for (int j = 0; j < 2; ++j) {
                    const u32x4 yw = yv[2 * r8 + j];
                    const f32x4 ya = {bflo(yw.x), bfhi(yw.x), bflo(yw.y), bfhi(yw.y)}, yb = {bflo(yw.z), bfhi(yw.z), bflo(yw.w), bfhi(yw.w)};
                    const f32x4 va = (ya - mu) * rs * g4[2 * j] + b4[2 * j], vb = (yb - mu) * rs * g4[2 * j + 1] + b4[2 * j + 1];
                    u32x4 w; w.x = pk2(va.x, va.y); w.y = pk2(va.z, va.w); w.z = pk2(vb.x, vb.y); w.w = pk2(vb.z, vb.w); *(u32x4*)(xo + 512 * j) = w; }
                xo += DM; asm volatile("" : "+v"(xo)); }
        }
        __syncthreads();
        if (tid < 256) rank[tid] = atomicAdd(&lcnt[dec[tid]], 1);
        __syncthreads();
        if (tid < 32) { int te = tid; asm volatile("" : "+v"(te)); lbase[tid] = DRY ? 0 : atomicAdd(&CNT[te * CNT_STRIDE], lcnt[tid]); }
        __syncthreads();
        if (!DRY && tid < 256) { const int e = dec[tid]; LIST[(size_t)e * LIST_CAP + lbase[e] + rank[tid]] = (rb * 128 + (tid >> 1)) * 2 + (tid & 1); }
        __syncthreads();
    }
}
__device__ __forceinline__ void moe_setup(const Params& P, int* tb, int layer) {
    const int* CNT = (const int*)(P.ws + WS_CTL + CTL_CNT_OFF) + layer * 32 * CNT_STRIDE;
    if (threadIdx.x < 64) {
        const int e = (int)threadIdx.x;
        const unsigned tiles = (e < 32) ? (unsigned)((CNT[e * CNT_STRIDE] + 255) >> 8) : 0u;
        const unsigned inc = WAVE_SCAN_DPP(tiles);
        if (e < 32) tb[e] = (int)(inc - tiles);
        if (e == 31) tb[32] = (int)inc;
    }
    __syncthreads();
}
template <bool DRY>
__device__ __forceinline__ void phase_ln2(const Params& P, int layer) {
    const bf16_t* XI = (const bf16_t*)(P.ws + WS_XB); bf16_t* XO = (bf16_t*)(P.ws + (DRY ? WS_XB2 : WS_XB));
    const bf16_t* YS = (const bf16_t*)(P.ws + WS_YS); const float* TOKG = (const float*)(P.ws + WS_TOKG);
    const float* lg = P.in[16] + layer * DM; const float* lb = P.in[17] + layer * DM;
    const int lane = threadIdx.x & 63, gw = blockIdx.x * NWAVE + (threadIdx.x >> 6), NGW = gridDim.x * NWAVE;
    f32x4 g4[4], b4[4];
#pragma unroll
    for (int j = 0; j < 4; ++j) { g4[j] = *(const f32x4*)(lg + 256 * j + 4 * lane); b4[j] = *(const f32x4*)(lb + 256 * j + 4 * lane); }
    u32x2 nx[4], na[4], nb[4]; float ng0 = 0.f, ng1 = 0.f;
    if (gw < NTOK) { const int t = gw;
#pragma unroll
        for (int j = 0; j < 4; ++j) { const int c0 = 256 * j + 4 * lane; nx[j] = *(const u32x2*)(XI + (size_t)t * DM + c0); na[j] = *(const u32x2*)(YS + (size_t)(2 * t) * DM + c0); nb[j] = *(const u32x2*)(YS + (size_t)(2 * t + 1) * DM + c0); }
        ng0 = TOKG[(size_t)t * 2]; ng1 = TOKG[(size_t)t * 2 + 1]; }
    for (int t = gw; t < NTOK; t += NGW) {
        const float g0 = ng0, g1 = ng1;
        u32x2 xw[4], aw[4], bw[4];
#pragma unroll
        for (int j = 0; j < 4; ++j) { xw[j] = nx[j]; aw[j] = na[j]; bw[j] = nb[j]; }
        if (t + NGW < NTOK) { const int tn = t + NGW;
#pragma unroll
            for (int j = 0; j < 4; ++j) { const int c0 = 256 * j + 4 * lane; nx[j] = *(const u32x2*)(XI + (size_t)tn * DM + c0); na[j] = *(const u32x2*)(YS + (size_t)(2 * tn) * DM + c0); nb[j] = *(const u32x2*)(YS + (size_t)(2 * tn + 1) * DM + c0); }
            ng0 = TOKG[(size_t)tn * 2]; ng1 = TOKG[(size_t)tn * 2 + 1]; }
        f32x4 v[4]; float s = 0.f;
#pragma unroll
        for (int j = 0; j < 4; ++j) {
            const u32x2 x = xw[j], a = aw[j], b = bw[j];
            v[j].x = bflo(x.x) * ALPHA + g0 * bflo(a.x) + g1 * bflo(b.x); v[j].y = bfhi(x.x) * ALPHA + g0 * bfhi(a.x) + g1 * bfhi(b.x);
            v[j].z = bflo(x.y) * ALPHA + g0 * bflo(a.y) + g1 * bflo(b.y); v[j].w = bfhi(x.y) * ALPHA + g0 * bfhi(a.y) + g1 * bfhi(b.y);
            s += (v[j].x + v[j].y) + (v[j].z + v[j].w); }
        const float mean = wave_sum(s) * (1.0f / DM); float s2 = 0.f;
#pragma unroll
        for (int j = 0; j < 4; ++j) { v[j] = v[j] - mean; s2 += (v[j].x * v[j].x + v[j].y * v[j].y) + (v[j].z * v[j].z + v[j].w * v[j].w); }
        const float rstd = 1.0f / sqrtf(wave_sum(s2) * (1.0f / DM) + LN_EPS);
#pragma unroll
        for (int j = 0; j < 4; ++j) { const int c0 = 256 * j + 4 * lane;
            v[j] = v[j] * rstd * g4[j] + b4[j];
            u32x2 w; w.x = pk2(v[j].x, v[j].y); w.y = pk2(v[j].z, v[j].w); *(u32x2*)(XO + (size_t)t * DM + c0) = w; }
    }
}

__device__ __forceinline__ unsigned e5m2enc(float y) {
    const unsigned hb = (unsigned)__builtin_bit_cast(unsigned short, (_Float16)y);
    return ((hb + 0x7fu + ((hb >> 8) & 1u)) >> 8) & 0xffu;
}
__device__ __forceinline__ void phase_norms(const Params& P) {
    const bf16_t* Z1 = (const bf16_t*)(P.ws + WS_Z1); bf16_t* CQ = (bf16_t*)(P.ws + WS_CQ); unsigned char* CKV8 = (unsigned char*)(P.ws + WS_CKV8);
    const float* qn = P.in[8]; const float* kn = P.in[9];
    const int lane = threadIdx.x & 63, gw = blockIdx.x * NWAVE + (threadIdx.x >> 6), NGW = gridDim.x * NWAVE;
    const f32x4 gq = *(const f32x4*)(qn + 4 * lane), gk = *(const f32x4*)(kn + 4 * lane);
    for (int t0 = gw; t0 < NTOK; t0 += 2 * NGW) {
        const int t1 = (t0 + NGW < NTOK) ? t0 + NGW : t0;
        const u32x2 a0 = *(const u32x2*)(Z1 + (size_t)t0 * Z1W + 4 * lane), b0 = *(const u32x2*)(Z1 + (size_t)t0 * Z1W + 256 + 4 * lane);
        const u32x2 a1 = *(const u32x2*)(Z1 + (size_t)t1 * Z1W + 4 * lane), b1 = *(const u32x2*)(Z1 + (size_t)t1 * Z1W + 256 + 4 * lane);
#pragma unroll
        for (int s = 0; s < 2; ++s) {
            const int t = s ? t1 : t0; const u32x2 a = s ? a1 : a0, b = s ? b1 : b0;
            const float q[4] = {bflo(a.x), bfhi(a.x), bflo(a.y), bfhi(a.y)}, k[4] = {bflo(b.x), bfhi(b.x), bflo(b.y), bfhi(b.y)};
            const float sq = wave_sum(q[0] * q[0] + q[1] * q[1] + q[2] * q[2] + q[3] * q[3]), sk = wave_sum(k[0] * k[0] + k[1] * k[1] + k[2] * k[2] + k[3] * k[3]);
            const float rq = 1.0f / sqrtf(sq * (1.0f / 256.0f) + 1e-6f), rk = 1.0f / sqrtf(sk * (1.0f / 256.0f) + 1e-6f);
            u32x2 o; o.x = pk2(q[0] * rq * gq.x, q[1] * rq * gq.y); o.y = pk2(q[2] * rq * gq.z, q[3] * rq * gq.w);
            *(u32x2*)(CQ + (size_t)t * 256 + 4 * lane) = o;
            *(unsigned*)(CKV8 + (size_t)t * 256 + 4 * lane) = e5m2enc(k[0] * rk * gk.x) | (e5m2enc(k[1] * rk * gk.y) << 8) | (e5m2enc(k[2] * rk * gk.z) << 16) | (e5m2enc(k[3] * rk * gk.w) << 24);
        }
    }
}


constexpr int NPH_TOTAL = 23;


typedef short v4i16_t __attribute__((ext_vector_type(4)));


__device__ __forceinline__ void glds16(const void* gsrc, unsigned lds_dst) {
    unsigned keep;
    asm volatile("s_mov_b32 %0, m0\n\ts_mov_b32 m0, %2\n\ts_nop 0\n\tglobal_load_lds_dwordx4 %1, off\n\ts_mov_b32 m0, %0" : "=&s"(keep) : "v"(gsrc), "s"(lds_dst) : "memory");
}
__device__ __forceinline__ void glds16_set(const void* gsrc, unsigned lds_dst) {
    asm volatile("s_mov_b32 m0, %1\n\ts_nop 0\n\tglobal_load_lds_dwordx4 %0, off" : : "v"(gsrc), "s"(lds_dst) : "memory", "m0");
}
template <int OFF> __device__ __forceinline__ void glds16_m0(const void* gsrc) {
    asm volatile("global_load_lds_dwordx4 %0, off offset:%1" : : "v"(gsrc), "n"(OFF) : "memory");
}
__device__ __forceinline__ void glds16s_set(const void* sbase, unsigned voff, unsigned lds_dst) {
    asm volatile("s_mov_b32 m0, %2\n\ts_nop 0\n\tglobal_load_lds_dwordx4 %0, %1" : : "v"(voff), "s"(sbase), "s"(lds_dst) : "memory", "m0");
}
template <int OFF> __device__ __forceinline__ void glds16s_m0(const void* sbase, unsigned voff) {
    asm volatile("global_load_lds_dwordx4 %0, %1 offset:%2" : : "v"(voff), "s"(sbase), "n"(OFF) : "memory");
}
typedef _Float16 f16x8 __attribute__((ext_vector_type(8)));
typedef int v8i_t __attribute__((ext_vector_type(8)));
template <bool DRY>
__device__ __forceinline__ void phase_sparse_attn_e(const Params& P, unsigned char* lds_) {
    const unsigned char* QA = (const unsigned char*)(P.ws + WS_QA); bf16_t* OLAT = (bf16_t*)(P.ws + WS_OLAT); const unsigned char* CKV8 = (const unsigned char*)(P.ws + WS_CKV8); const unsigned short* SEL = (const unsigned short*)(P.ws + WS_SEL);
    const int tid = threadIdx.x, lane = tid & 63, wave = __builtin_amdgcn_readfirstlane(tid >> 6);
    const int fr = lane & 15, fq = lane >> 4;
    LAS unsigned char* cbuf = (LAS unsigned char*)lds_ + wave * 17920;
    LAS unsigned short* selw = (LAS unsigned short*)(cbuf + 16384);
    LAS unsigned* selo = (LAS unsigned*)(cbuf + 16384 + 512);
    LAS unsigned* selo_st = selo + (lane >> 3) * 32 + (lane & 7);
    const unsigned cbuf0 = (unsigned)(unsigned long)cbuf;
    const int G = gridDim.x, NGW = G * NWAVE;
    int vw;
    if ((G & 7) == 0) vw = (((int)blockIdx.x & 7) * (G >> 3) + ((int)blockIdx.x >> 3)) * NWAVE + wave; else vw = (int)blockIdx.x * NWAVE + wave;
    const float LOG2E = 1.4426950408889634f;
    const float slope2 = exp2f(-0.5f * (float)(fr + 1)) * LOG2E;
    unsigned qoffB[4];
#pragma unroll
    for (int e = 0; e < 4; ++e) { const int r15 = (4 * e + fq) & 15; qoffB[e] = (unsigned)((fr ^ (((r15 & 7) << 1) | (r15 >> 3))) << 4); }
    unsigned qoffS[4];
#pragma unroll
    for (int e = 0; e < 4; ++e) qoffS[e] = qoffB[e] + 3072u - 1024u * e;
    const unsigned fA = (unsigned)(((fr & 7) << 1) | (fr >> 3));
    const unsigned SA = (fA & 14u) << 4, baseA = (unsigned)fr * 256u + ((((unsigned)fq >> 1) ^ (fA & 1u)) << 4) + ((unsigned)fq & 1u) * 8u;
    const int rT = 4 * fq + (fr >> 2), pT_ = fr & 3;
    const unsigned fT = (unsigned)(((rT & 7) << 1) | (rT >> 3));
    const unsigned ST = (fT & 14u) << 4, baseT = (unsigned)rT * 256u + ((((unsigned)pT_ >> 1) ^ (fT & 1u)) << 4) + ((unsigned)pT_ & 1u) * 8u;
    const int per = NGW >> 2, bq = vw / per, wb = vw % per;
    int ditem = DRY ? N_DEFERRED : vw;
    u32x2 selnext = {0u, 0u}; long qfn[8];
    if (wb < SEQ) { const int t0 = bq * SEQ + wb; selnext = *(const u32x2*)(SEL + (size_t)t0 * TOPK + 4 * lane);
#pragma unroll
        for (int cc = 0; cc < 8; ++cc) qfn[cc] = *(const long*)(QA + (size_t)t0 * 4096 + fr * 256 + 32 * cc + 8 * fq); }
    for (int tl0 = wb; tl0 < SEQ; tl0 += per) {
        const int t = bq * SEQ + tl0;
        const int b = t >> 13, tl = t & (SEQ - 1), ns = min(tl + 1, TOPK), nch = (ns + 31) >> 5;
        const bool has_nextq = (tl0 + per < SEQ);
        asm volatile("s_waitcnt vmcnt(0)" ::: "memory");
        {
            const u32x2 w = selnext;
            unsigned short i0 = (unsigned short)(w.x & 0xffffu), i1 = (unsigned short)(w.x >> 16), i2 = (unsigned short)(w.y & 0xffffu), i3 = (unsigned short)(w.y >> 16);
            const int k0 = 4 * lane;
            if (k0 >= ns) i0 = 0; if (k0 + 1 >= ns) i1 = 0; if (k0 + 2 >= ns) i2 = 0; if (k0 + 3 >= ns) i3 = 0;
            u32x2 o; o.x = (unsigned)i0 | ((unsigned)i1 << 16); o.y = (unsigned)i2 | ((unsigned)i3 << 16);
            asm volatile("s_waitcnt lgkmcnt(0)" ::: "memory");
            *(LAS u32x2*)(selw + 4 * lane) = o;
            selo_st[0] = (unsigned)i0 << 8; selo_st[8] = (unsigned)i1 << 8; selo_st[16] = (unsigned)i2 << 8; selo_st[24] = (unsigned)i3 << 8;
        }
        v8i_t qB[2];
#pragma unroll
        for (int cc = 0; cc < 8; ++cc) { const u32x2 qw = __builtin_bit_cast(u32x2, qfn[cc]); qB[cc >> 2][2 * (cc & 3)] = (int)qw.x; qB[cc >> 2][2 * (cc & 3) + 1] = (int)qw.y; }
#define ATT_PREFETCH() do { if (has_nextq) { const int tn_ = t + per; selnext = *(const u32x2*)(SEL + (size_t)tn_ * TOPK + 4 * lane); \
            _Pragma("unroll") for (int cc = 0; cc < 8; ++cc) qfn[cc] = *(const long*)(QA + (size_t)tn_ * 4096 + fr * 256 + 32 * cc + 8 * fq); pf = true; } } while (0)
        f32x4 Oe[8], Oo[8];
#pragma unroll
        for (int ut = 0; ut < 8; ++ut) { Oe[ut] = (f32x4){0.f, 0.f, 0.f, 0.f}; Oo[ut] = (f32x4){0.f, 0.f, 0.f, 0.f}; }
        float m = -INFINITY, l = 0.f;
        const unsigned char* cb = CKV8 + (size_t)b * SEQ * 256;
        asm volatile("s_waitcnt vmcnt(0) lgkmcnt(0)" ::: "memory");
        const unsigned char* cbs = cb - 3072;
#define ATT_DMA(jj, bufoff) do { u32x4 oa_ = *(const LAS u32x4*)(selo + 32 * (jj) + 8 * fq), ob_ = *(const LAS u32x4*)(selo + 32 * (jj) + 8 * fq + 4); \
            if (DRY && PROBE_ATT == 1) { oa_ = (u32x4){0u, 256u, 512u, 768u}; ob_ = oa_; } \
            if (!(DRY && PROBE_ATT == 3)) { \
                glds16s_set(cbs, oa_.x + qoffS[0], (unsigned)__builtin_amdgcn_readfirstlane((int)(cbuf0 + (bufoff)))); \
                glds16s_m0<1024>(cbs, oa_.y + qoffS[1]); glds16s_m0<2048>(cbs, oa_.z + qoffS[2]); glds16s_m0<3072>(cbs, oa_.w + qoffS[3]); \
                glds16s_set(cbs, ob_.x + qoffS[0], (unsigned)__builtin_amdgcn_readfirstlane((int)(cbuf0 + (bufoff) + 4096))); \
                glds16s_m0<1024>(cbs, ob_.y + qoffS[1]); glds16s_m0<2048>(cbs, ob_.z + qoffS[2]); glds16s_m0<3072>(cbs, ob_.w + qoffS[3]); } } while (0)
        ATT_DMA(0, 0);
        if (nch > 1) ATT_DMA(1, 8192);
        const bool have_item = ditem < N_DEFERRED;
        TrItem titem = deferred_item(P, have_item ? ditem : 0);
        float tcur[32];
        bool trf = false, pf = false;
        if (nch <= 2) { if (have_item) { tr_load(titem, lane, tcur); trf = true; } ATT_PREFETCH(); }
        for (int j = 0; j < nch; ++j) {
            const unsigned bo = (unsigned)(j & 1) * 8192u;
            if (j + 1 < nch) { if (trf && pf) asm volatile("s_waitcnt vmcnt(49)" ::: "memory"); else if (trf) asm volatile("s_waitcnt vmcnt(40)" ::: "memory");
                               else if (pf) asm volatile("s_waitcnt vmcnt(17)" ::: "memory"); else asm volatile("s_waitcnt vmcnt(8)" ::: "memory"); }
            else { if (trf && pf) asm volatile("s_waitcnt vmcnt(41)" ::: "memory"); else if (trf) asm volatile("s_waitcnt vmcnt(32)" ::: "memory");
                   else if (pf) asm volatile("s_waitcnt vmcnt(9)" ::: "memory"); else asm volatile("s_waitcnt vmcnt(0)" ::: "memory"); }
            const LAS unsigned char* img = cbuf + bo;
            if (DRY && PROBE_ATT == 2) { if (j + 2 < nch) { asm volatile("s_waitcnt lgkmcnt(0)" ::: "memory"); ATT_DMA(j + 2, bo); } continue; }
            f32x4 s0 = {0.f, 0.f, 0.f, 0.f}, s1 = {0.f, 0.f, 0.f, 0.f};
#pragma unroll
            for (int hb = 0; hb < 2; ++hb) {
                u32x2 ra[4], rb[4];
#pragma unroll
                for (int c4 = 0; c4 < 4; ++c4) { const int cc = hb * 4 + c4; const LAS unsigned char* pa = img + ((SA ^ (unsigned)(cc << 5)) + baseA); ra[c4] = *(const LAS u32x2*)(pa); rb[c4] = *(const LAS u32x2*)(pa + 4096); }
                __builtin_amdgcn_sched_barrier(0);
                v8i_t A0, A1;
#pragma unroll
                for (int c4 = 0; c4 < 4; ++c4) { A0[2 * c4] = (int)ra[c4].x; A0[2 * c4 + 1] = (int)ra[c4].y; A1[2 * c4] = (int)rb[c4].x; A1[2 * c4 + 1] = (int)rb[c4].y; }
                s0 = __builtin_amdgcn_mfma_scale_f32_16x16x128_f8f6f4(A0, qB[hb], s0, 1, 0, 0, 0, 0, 0);
                s1 = __builtin_amdgcn_mfma_scale_f32_16x16x128_f8f6f4(A1, qB[hb], s1, 1, 0, 0, 0, 0, 0);
                __builtin_amdgcn_sched_barrier(0);
            }
            const u32x2 k0w = *(const LAS u32x2*)(selw + 32 * j + 4 * fq), k1w = *(const LAS u32x2*)(selw + 32 * j + 16 + 4 * fq);
            u32x2 tl_[4], th_[4];
#pragma unroll
            for (int ut = 0; ut < 4; ++ut) { const LAS unsigned char* pt = img + ((ST ^ (unsigned)(ut << 5)) + baseT);
                tl_[ut] = __builtin_bit_cast(u32x2, __builtin_amdgcn_ds_read_tr16_b64_v4i16((LAS v4i16_t*)(pt)));
                th_[ut] = __builtin_bit_cast(u32x2, __builtin_amdgcn_ds_read_tr16_b64_v4i16((LAS v4i16_t*)(pt + 4096))); }
            __builtin_amdgcn_sched_barrier(0);
            const int rem = ns - (32 * j + 4 * fq);
            float lg[8];
            {
                const int i00 = (int)(k0w.x & 0xffffu), i01 = (int)(k0w.x >> 16), i02 = (int)(k0w.y & 0xffffu), i03 = (int)(k0w.y >> 16);
                const int i10 = (int)(k1w.x & 0xffffu), i11 = (int)(k1w.x >> 16), i12 = (int)(k1w.y & 0xffffu), i13 = (int)(k1w.y >> 16);
                lg[0] = (0 < rem) ? s0.x * LOG2E - slope2 * (float)(tl - i00) : -INFINITY;
                lg[1] = (1 < rem) ? s0.y * LOG2E - slope2 * (float)(tl - i01) : -INFINITY;
                lg[2] = (2 < rem) ? s0.z * LOG2E - slope2 * (float)(tl - i02) : -INFINITY;
                lg[3] = (3 < rem) ? s0.w * LOG2E - slope2 * (float)(tl - i03) : -INFINITY;
                lg[4] = (16 < rem) ? s1.x * LOG2E - slope2 * (float)(tl - i10) : -INFINITY;
                lg[5] = (17 < rem) ? s1.y * LOG2E - slope2 * (float)(tl - i11) : -INFINITY;
                lg[6] = (18 < rem) ? s1.z * LOG2E - slope2 * (float)(tl - i12) : -INFINITY;
                lg[7] = (19 < rem) ? s1.w * LOG2E - slope2 * (float)(tl - i13) : -INFINITY;
            }
            const float cm = fmaxf(fmaxf(fmaxf(lg[0], lg[1]), fmaxf(lg[2], lg[3])), fmaxf(fmaxf(lg[4], lg[5]), fmaxf(lg[6], lg[7])));
            if (j == 0) { float cx = fmaxf(cm, __shfl_xor(cm, 16)); m = fmaxf(cx, __shfl_xor(cx, 32)); }
            else if (__any(cm > m + 8.0f)) {
                float cx = fmaxf(cm, __shfl_xor(cm, 16)); cx = fmaxf(cx, __shfl_xor(cx, 32));
                const float mn = fmaxf(m, cx);
                const float sc = __builtin_amdgcn_exp2f(m - mn);
                l *= sc;
#pragma unroll
                for (int ut = 0; ut < 8; ++ut) { Oe[ut] *= sc; Oo[ut] *= sc; }
                m = mn;
            }
            float p[8]; float ps = 0.f;
#pragma unroll
            for (int i = 0; i < 8; ++i) { p[i] = __builtin_amdgcn_exp2f(lg[i] - m); ps += p[i]; }
            l += ps;
            int pw0 = __builtin_amdgcn_cvt_pk_fp8_f32(p[0], p[1], 0, false); pw0 = __builtin_amdgcn_cvt_pk_fp8_f32(p[2], p[3], pw0, true);
            int pw1 = __builtin_amdgcn_cvt_pk_fp8_f32(p[4], p[5], 0, false); pw1 = __builtin_amdgcn_cvt_pk_fp8_f32(p[6], p[7], pw1, true);
            const long pk = __builtin_bit_cast(long, (u32x2){(unsigned)pw0, (unsigned)pw1});
#pragma unroll
            for (int hb = 0; hb < 2; ++hb) {
                if (hb == 1) {
#pragma unroll
                    for (int u4 = 0; u4 < 4; ++u4) { const int ut = 4 + u4; const LAS unsigned char* pt = img + ((ST ^ (unsigned)(ut << 5)) + baseT);
                        tl_[u4] = __builtin_bit_cast(u32x2, __builtin_amdgcn_ds_read_tr16_b64_v4i16((LAS v4i16_t*)(pt)));
                        th_[u4] = __builtin_bit_cast(u32x2, __builtin_amdgcn_ds_read_tr16_b64_v4i16((LAS v4i16_t*)(pt + 4096))); }
                    __builtin_amdgcn_sched_barrier(0);
                }
#pragma unroll
                for (int u4 = 0; u4 < 4; ++u4) { const int ut = hb * 4 + u4;
                    const u32x2 lw = tl_[u4], hw = th_[u4];
                    u32x2 ae, ao;
                    ae.x = __builtin_amdgcn_perm(lw.y, lw.x, 0x06040200u); ae.y = __builtin_amdgcn_perm(hw.y, hw.x, 0x06040200u);
                    ao.x = __builtin_amdgcn_perm(lw.y, lw.x, 0x07050301u); ao.y = __builtin_amdgcn_perm(hw.y, hw.x, 0x07050301u);
                    Oe[ut] = __builtin_amdgcn_mfma_f32_16x16x32_bf8_fp8(__builtin_bit_cast(long, ae), pk, Oe[ut], 0, 0, 0);
                    Oo[ut] = __builtin_amdgcn_mfma_f32_16x16x32_bf8_fp8(__builtin_bit_cast(long, ao), pk, Oo[ut], 0, 0, 0);
                }
                __builtin_amdgcn_sched_barrier(0);
            }
            if (j + 2 < nch) { asm volatile("s_waitcnt lgkmcnt(0)" ::: "memory"); ATT_DMA(j + 2, bo);
                if (j + 3 == nch) { if (have_item) { tr_load(titem, lane, tcur); trf = true; } ATT_PREFETCH(); } }
        }
#undef ATT_DMA
#undef ATT_PREFETCH
        l += __shfl_xor(l, 16); l += __shfl_xor(l, 32);
        const float inv = 1.0f / l;
        bf16_t* orow = (DRY ? (bf16_t*)(P.ws + WS_PP) + (size_t)(t & 8191) * 4096 : OLAT + (size_t)t * 4096) + fr * 256 + 8 * fq;
#pragma unroll
        for (int ut = 0; ut < 8; ++ut) {
            u32x4 w; w.x = pk2(Oe[ut].x * inv, Oo[ut].x * inv); w.y = pk2(Oe[ut].y * inv, Oo[ut].y * inv); w.z = pk2(Oe[ut].z * inv, Oo[ut].z * inv); w.w = pk2(Oe[ut].w * inv, Oo[ut].w * inv);
            *(u32x4*)(orow + 32 * ut) = w;
        }
        if (have_item) { asm volatile("s_waitcnt lgkmcnt(0)" ::: "memory"); tr_store(titem, (float*)(lds_ + wave * 17920), lane, tcur); ditem += NGW; }
    }
    int lane_l = lane; asm volatile("" : "+v"(lane_l));
    for (; ditem < N_DEFERRED; ditem += NGW) { const TrItem t = deferred_item(P, ditem); float tmp[32]; tr_load(t, lane_l, tmp); tr_store(t, (float*)(lds_ + wave * 17920), lane_l, tmp); }
}

constexpr size_t SC_BATCH = (size_t)1024 * 256 * 257 / 2;
__device__ __forceinline__ size_t sc_row_off(int b, int tl) { const size_t m = (size_t)(tl >> 5); return (size_t)b * SC_BATCH + 1024 * (m * (m + 1) / 2) + (size_t)(tl & 31) * 32 * (m + 1); }
typedef float f32x16 __attribute__((ext_vector_type(16)));
__device__ __forceinline__ unsigned okey_pk(float a, float b) {
    const unsigned w = __builtin_bit_cast(unsigned, __builtin_amdgcn_cvt_pkrtz(a, b));
    const unsigned neg = (w >> 15) & 0x00010001u;
    return w ^ ((neg * 0xffffu) | 0x80008000u);
}
__device__ __forceinline__ void phase_index_scores(const Params& P, unsigned char* lds_) {
    using pg8::bf16x8;
    const bf16_t* Z1 = (const bf16_t*)(P.ws + WS_Z1); unsigned short* SC = (unsigned short*)(P.ws + WS_SC);
    LAS unsigned char* lds = (LAS unsigned char*)lds_;
    constexpr int QROW = 144;
    LAS unsigned char* QL = lds;
    LAS float* SG = (LAS float*)(lds + 9 * 64 * QROW);
    const int tid = threadIdx.x, lane = tid & 63, wave = __builtin_amdgcn_readfirstlane(tid >> 6);
    LAS unsigned char* ST = lds + 9 * 64 * QROW + 2048 + wave * 5120;
    const int l31 = lane & 31, hh = lane >> 5;
    for (int pid = blockIdx.x; pid < 256; pid += gridDim.x) {
        const int b = pid >> 6;
        for (int side = 0; side < 2; ++side) {
            const int qb = side ? (127 - (pid & 63)) : (pid & 63);
            const int q0 = qb * 64;
            __syncthreads();
            {
                const int qi = tid >> 3, part = tid & 7;
                const bf16_t* zr = Z1 + ((size_t)b * SEQ + q0 + qi) * Z1W;
                const u32x4 ww = *(const u32x4*)(zr + 1088);
                const float w8[8] = {bflo(ww.x), bfhi(ww.x), bflo(ww.y), bfhi(ww.y), bflo(ww.z), bfhi(ww.z), bflo(ww.w), bfhi(ww.w)};
                float wh = 0.f;
#pragma unroll
                for (int h = 0; h < 8; ++h) wh = (h == part) ? w8[h] : wh;
                const float sc = 0.5f * fabsf(wh);
                SG[qi * 8 + part] = (wh >= 0.f) ? 1.0f : -1.0f;
#pragma unroll
                for (int c = 0; c < 8; ++c) {
                    const u32x4 v = *(const u32x4*)(zr + 512 + part * 64 + c * 8);
                    u32x4 o; o.x = pk2(bflo(v.x) * sc, bfhi(v.x) * sc); o.y = pk2(bflo(v.y) * sc, bfhi(v.y) * sc); o.z = pk2(bflo(v.z) * sc, bfhi(v.z) * sc); o.w = pk2(bflo(v.w) * sc, bfhi(v.w) * sc);
                    *(LAS u32x4*)(QL + (part * 64 + qi) * QROW + c * 16) = o;
                }
                float a8[8];
#pragma unroll
                for (int j = 0; j < 8; ++j) a8[j] = 0.f;
#pragma unroll
                for (int h = 0; h < 8; ++h) {
                    const u32x4 v = *(const u32x4*)(zr + 512 + h * 64 + part * 8); const float s2 = 0.5f * w8[h];
                    a8[0] += s2 * bflo(v.x); a8[1] += s2 * bfhi(v.x); a8[2] += s2 * bflo(v.y); a8[3] += s2 * bfhi(v.y);
                    a8[4] += s2 * bflo(v.z); a8[5] += s2 * bfhi(v.z); a8[6] += s2 * bflo(v.w); a8[7] += s2 * bfhi(v.w);
                }
                u32x4 o; o.x = pk2(a8[0], a8[1]); o.y = pk2(a8[2], a8[3]); o.z = pk2(a8[4], a8[5]); o.w = pk2(a8[6], a8[7]);
                *(LAS u32x4*)(QL + (8 * 64 + qi) * QROW + part * 16) = o;
            }
            __syncthreads();
            const int ktmax = 2 * qb + 1;
            bf16x8 kn[4];
            {   const bf16_t* kr = Z1 + ((size_t)b * SEQ + min(wave, ktmax) * 32 + l31) * Z1W + 1024 + hh * 8;
#pragma unroll
                for (int dq = 0; dq < 4; ++dq) kn[dq] = *(const bf16x8*)(kr + dq * 16); }
            for (int kt = wave; kt <= ktmax; kt += NWAVE) {
                bf16x8 kf[4];
#pragma unroll
                for (int dq = 0; dq < 4; ++dq) kf[dq] = kn[dq];
                {   const bf16_t* kr = Z1 + ((size_t)b * SEQ + min(kt + NWAVE, ktmax) * 32 + l31) * Z1W + 1024 + hh * 8;
#pragma unroll
                    for (int dq = 0; dq < 4; ++dq) kn[dq] = *(const bf16x8*)(kr + dq * 16); }
#pragma unroll
                for (int qs = 0; qs < 2; ++qs) {
                    const LAS unsigned char* qrow = QL + (qs * 32 + l31) * QROW + hh * 16;
                    const LAS float* sgp = SG + (qs * 32 + l31) * 8;
                    bf16x8 fc[4], fn[4];
#pragma unroll
                    for (int dq = 0; dq < 4; ++dq) fc[dq] = *(const LAS bf16x8*)(qrow + 8 * 64 * QROW + dq * 32);
#pragma unroll
                    for (int dq = 0; dq < 4; ++dq) fn[dq] = *(const LAS bf16x8*)(qrow + dq * 32);
                    const f32x4 sg03 = *(const LAS f32x4*)(sgp), sg47 = *(const LAS f32x4*)(sgp + 4);
                    f32x16 acc;
#pragma unroll
                    for (int r = 0; r < 16; ++r) acc[r] = 0.f;
#pragma unroll
                    for (int dq = 0; dq < 4; ++dq) acc = __builtin_amdgcn_mfma_f32_32x32x16_bf16(kf[dq], fc[dq], acc, 0, 0, 0);
                    f32x16 up;
#pragma unroll
                    for (int h = 0; h < 8; ++h) {
#pragma unroll
                        for (int dq = 0; dq < 4; ++dq) fc[dq] = fn[dq];
                        if (h < 7) {
#pragma unroll
                            for (int dq = 0; dq < 4; ++dq) fn[dq] = *(const LAS bf16x8*)(qrow + (h + 1) * 64 * QROW + dq * 32);
                        }
                        f32x16 u;
#pragma unroll
                        for (int r = 0; r < 16; ++r) u[r] = 0.f;
#pragma unroll
                        for (int dq = 0; dq < 4; ++dq) u = __builtin_amdgcn_mfma_f32_32x32x16_bf16(kf[dq], fc[dq], u, 0, 0, 0);
                        __builtin_amdgcn_sched_barrier(0);
                        if (h > 0) {
                            const float sg = (h - 1 < 4) ? sg03[(h - 1) & 3] : sg47[(h - 1) & 3];
#pragma unroll
                            for (int r = 0; r < 16; ++r) acc[r] = fmaf(fabsf(up[r]), sg, acc[r]);
                        }
                        __builtin_amdgcn_sched_barrier(0);
                        up = u;
                    }
                    {
                        const float sg = sg47[3];
#pragma unroll
                        for (int r = 0; r < 16; ++r) acc[r] = fmaf(fabsf(up[r]), sg, acc[r]);
                    }
#pragma unroll
                    for (int g = 0; g < 4; ++g) { u32x2 w; w.x = okey_pk(acc[4 * g], acc[4 * g + 1]); w.y = okey_pk(acc[4 * g + 2], acc[4 * g + 3]);
                        *(LAS u32x2*)(ST + (qs * 32 + l31) * 80 + (8 * g + 4 * hh) * 2) = w; }
                }
#pragma unroll
                for (int i = 0; i < 4; ++i) {
                    const int row = 16 * i + (lane >> 2), ch = lane & 3, tl = q0 + row;
                    const u32x4 v = *(const LAS u32x4*)(ST + row * 80 + ch * 16);
                    if (kt <= (tl >> 5)) *(u32x4*)(SC + sc_row_off(b, tl) + (size_t)kt * 32 + ch * 8) = v;
                }
            }
        }
    }
}
template <int MODE>
__device__ __forceinline__ void phase_index_select(const Params& P, unsigned char* lds_) {
    const unsigned short* SC = (const unsigned short*)(P.ws + WS_SC); unsigned short* SEL = (unsigned short*)(P.ws + WS_SEL);
    const int tid = threadIdx.x, lane = tid & 63, wave = __builtin_amdgcn_readfirstlane(tid >> 6);
    LAS unsigned char* wbase = (LAS unsigned char*)lds_ + wave * 19456;
    LAS u32x4* rowbuf = (LAS u32x4*)wbase;
    LAS unsigned* hist = (LAS unsigned*)(wbase + 16384);
    LAS unsigned* dummy = hist + 512 + lane;
    LAS unsigned short* outw = (LAS unsigned short*)(wbase + 16384 + 2048 + 256);
    LAS unsigned short* dummy16 = outw + 256 + lane;
    const unsigned rowbuf0 = (unsigned)(unsigned long)wbase;
    const int gw = blockIdx.x * NWAVE + wave, NGW = gridDim.x * NWAVE;
#define SEL_DMA(tt) do { const int _tl = (tt) & (SEQ - 1), _n = _tl + 1; if (_n > TOPK) { const unsigned char* _src = (const unsigned char*)(SC + sc_row_off((tt) >> 13, _tl)) + lane * 16; \
            for (int _sg = 0; _sg * 512 < _n; ++_sg) glds16(_src + _sg * 1024, (unsigned)__builtin_amdgcn_readfirstlane((int)(rowbuf0 + _sg * 1024))); } } while (0)
#define SEL_Q(i) ((i) * NGW + (((i) & 1) ? (NGW - 1 - gw) : gw))
    if (SEL_Q(0) < NTOK) SEL_DMA(SEL_Q(0));
    for (int qi = 0; qi * NGW < NTOK; ++qi) {
        const int t = SEL_Q(qi), tnext = SEL_Q(qi + 1);
        if (t >= NTOK) { if (tnext < NTOK) SEL_DMA(tnext); continue; }
        const int tl = t & (SEQ - 1), n = tl + 1;
        unsigned short* so = SEL + (size_t)t * TOPK;
        if (n <= TOPK) { for (int i = lane; i < n; i += 64) so[i] = (unsigned short)i; if (tnext < NTOK && (qi + 1) * NGW < NTOK) SEL_DMA(tnext); continue; }
        asm volatile("s_waitcnt vmcnt(0)" ::: "memory");
        u32x4 d[16];
        const int lastsg = (n - 1) >> 9;
#pragma unroll
        for (int sg = 0; sg < 16; ++sg) {
            if (sg * 512 < n) {
                d[sg] = rowbuf[sg * 64 + lane];
                if (sg == lastsg) {
#pragma unroll
                    for (int q = 0; q < 4; ++q) { const int i0 = sg * 512 + lane * 8 + 2 * q;
                        d[sg][q] &= ((i0 < n) ? 0x0000ffffu : 0u) | ((i0 + 1 < n) ? 0xffff0000u : 0u); }
                }
            } else d[sg] = (u32x4){0u, 0u, 0u, 0u};
        }
        asm volatile("s_waitcnt lgkmcnt(0)" ::: "memory");
        if (tnext < NTOK && (qi + 1) * NGW < NTOK) SEL_DMA(tnext);
#pragma unroll
        for (int i = 0; i < 8; ++i) { hist[i * 64 + lane] = 0u; }
        asm volatile("s_waitcnt lgkmcnt(0)" ::: "memory");
        LAS unsigned* myh = hist + (lane & 1) * 256;
        if (MODE == 4) { if (d[0].x == 0x12345u) so[lane] = 1; continue; }
#pragma unroll
        for (int sg = 0; sg < 16; ++sg) if (MODE != 1 && sg * 512 < n) {
#pragma unroll
            for (int q = 0; q < 4; ++q) { const unsigned w = d[sg][q];
                __hip_atomic_fetch_add(myh + ((w >> 8) & 0xffu), 1u, __ATOMIC_RELAXED, __HIP_MEMORY_SCOPE_WORKGROUP);
                __hip_atomic_fetch_add(myh + (w >> 24), 1u, __ATOMIC_RELAXED, __HIP_MEMORY_SCOPE_WORKGROUP); }
        }
        asm volatile("s_waitcnt lgkmcnt(0)" ::: "memory");
        unsigned b1, need1;
        {
            unsigned c[4];
#pragma unroll
            for (int q = 0; q < 4; ++q) c[q] = hist[4 * lane + q] + hist[256 + 4 * lane + q];
            const unsigned mine = c[0] + c[1] + c[2] + c[3];
            unsigned suf = mine;
#pragma unroll
            for (int o = 1; o < 64; o <<= 1) { const unsigned v = __shfl_down(suf, o); if (lane + o < 64) suf += v; }
            const unsigned above = suf - mine;
            int fb = -1; unsigned fneed = 0;
            if (above < (unsigned)TOPK && suf >= (unsigned)TOPK) { unsigned a = above;
#pragma unroll
                for (int q = 3; q >= 0; --q) { if (fb < 0 && a + c[q] >= (unsigned)TOPK) { fb = 4 * lane + q; fneed = (unsigned)TOPK - a; } a += c[q]; } }
            const unsigned long long bal = __ballot(fb >= 0);
            const int src = (int)__builtin_ctzll(bal);
            b1 = (unsigned)__shfl(fb, src); need1 = __shfl(fneed, src);
        }
#pragma unroll
        for (int i = 0; i < 8; ++i) { hist[i * 64 + lane] = 0u; }
        asm volatile("s_waitcnt lgkmcnt(0)" ::: "memory");
#pragma unroll
        for (int sg = 0; sg < 16; ++sg) if (MODE != 2 && sg * 512 < n) {
#pragma unroll
            for (int q = 0; q < 4; ++q) { const unsigned w = d[sg][q];
                LAS unsigned* p0 = (((w >> 8) & 0xffu) == b1) ? (myh + (w & 0xffu)) : dummy;
                LAS unsigned* p1 = ((w >> 24) == b1) ? (myh + ((w >> 16) & 0xffu)) : dummy;
                __hip_atomic_fetch_add(p0, 1u, __ATOMIC_RELAXED, __HIP_MEMORY_SCOPE_WORKGROUP);
                __hip_atomic_fetch_add(p1, 1u, __ATOMIC_RELAXED, __HIP_MEMORY_SCOPE_WORKGROUP); }
        }
        asm volatile("s_waitcnt lgkmcnt(0)" ::: "memory");
        unsigned T, need2;
        {
            unsigned c[4];
#pragma unroll
            for (int q = 0; q < 4; ++q) c[q] = hist[4 * lane + q] + hist[256 + 4 * lane + q];
            const unsigned mine = c[0] + c[1] + c[2] + c[3];
            unsigned suf = mine;
#pragma unroll
            for (int o = 1; o < 64; o <<= 1) { const unsigned v = __shfl_down(suf, o); if (lane + o < 64) suf += v; }
            const unsigned above = suf - mine;
            int fb = -1; unsigned fneed = 0;
            if (above < need1 && suf >= need1) { unsigned a = above;
#pragma unroll
                for (int q = 3; q >= 0; --q) { if (fb < 0 && a + c[q] >= need1) { fb = 4 * lane + q; fneed = need1 - a; } a += c[q]; } }
            const unsigned long long bal = __ballot(fb >= 0);
            const int src = (int)__builtin_ctzll(bal);
            T = (b1 << 8) | (unsigned)__shfl(fb, src); need2 = __shfl(fneed, src);
        }
        unsigned base = 0; const unsigned ngt = (unsigned)TOPK - need2; unsigned eqbase = 0;
#pragma unroll
        for (int sg = 0; sg < 16; ++sg) if (MODE != 3 && sg * 512 < n) {
            unsigned ce = 0;
#pragma unroll
            for (int j = 0; j < 8; ++j) {
                const unsigned k = (j & 1) ? (d[sg][j >> 1] >> 16) : (d[sg][j >> 1] & 0xffffu);
                const bool gt = k > T;
                const unsigned long long mk = __ballot(gt);
                const unsigned pos = base + (unsigned)__builtin_amdgcn_mbcnt_hi((unsigned)(mk >> 32), __builtin_amdgcn_mbcnt_lo((unsigned)mk, 0u));
                LAS unsigned short* po = gt ? (outw + pos) : dummy16;
                *po = (unsigned short)(sg * 512 + lane * 8 + j);
                base += (unsigned)__builtin_popcountll(mk);
                ce += (k == T) ? 1u : 0u;
            }
            if (__any(ce > 0u)) {
                unsigned pre = ce;
#pragma unroll
                for (int o = 1; o < 64; o <<= 1) { const unsigned v = __shfl_up(pre, o); if (lane >= o) pre += v; }
                unsigned r = eqbase + pre - ce;
#pragma unroll
                for (int j = 0; j < 8; ++j) { const unsigned k = (j & 1) ? (d[sg][j >> 1] >> 16) : (d[sg][j >> 1] & 0xffffu);
                    if (k == T) { if (r < need2) outw[ngt + r] = (unsigned short)(sg * 512 + lane * 8 + j); ++r; } }
                eqbase += __shfl(pre, 63);
            }
        }
        asm volatile("s_waitcnt lgkmcnt(0)" ::: "memory");
        ((unsigned*)so)[lane] = ((LAS unsigned*)outw)[lane];
        ((unsigned*)so)[64 + lane] = ((LAS unsigned*)outw)[64 + lane];
        asm volatile("s_waitcnt lgkmcnt(0)" ::: "memory");
    }
#undef SEL_DMA
#undef SEL_Q
    asm volatile("s_waitcnt vmcnt(0)" ::: "memory");
}

__device__ __forceinline__ void ret_fill_image(LAS unsigned char* img, const unsigned char* src, size_t row_stride_bytes, int wave, int lane) {
#pragma unroll
    for (int e4 = 0; e4 < 4; ++e4) {
        const int e = wave * 4 + e4, row = 4 * e + (lane >> 4), q = (lane & 15) ^ ((row & 7) << 1);
        __builtin_amdgcn_global_load_lds((const unsigned*)(src + (size_t)row * row_stride_bytes + q * 16), (LAS unsigned*)(img + e * 1024), 16, 0, 0);
    }
}
__device__ __forceinline__ pg8::bf16x8 ret_tr_pair(const LAS unsigned char* img, int row0, int chunk2, int lane) {
    const int g = lane >> 4, i = lane & 15, r0 = row0 + 4 * g + (i >> 2), pb = (i & 3) >> 1, half = (i & 1) * 8;
    const int r1 = r0 + 16;
    const v4i16_t lo = __builtin_amdgcn_ds_read_tr16_b64_v4i16((LAS v4i16_t*)(img + r0 * 256 + ((((chunk2) ^ ((r0 & 7) << 1)) | pb) << 4) + half));
    const v4i16_t hi = __builtin_amdgcn_ds_read_tr16_b64_v4i16((LAS v4i16_t*)(img + r1 * 256 + ((((chunk2) ^ ((r1 & 7) << 1)) | pb) << 4) + half));
    return (pg8::bf16x8){lo[0], lo[1], lo[2], lo[3], hi[0], hi[1], hi[2], hi[3]};
}
__device__ __forceinline__ void phase_ret_kv_mfma(const Params& P, unsigned char* lds_) {
    using pg8::bf16x8;
    const unsigned char* Z0 = (const unsigned char*)(P.ws + WS_Z0); float* KV = (float*)(P.ws + WS_KV);
    LAS unsigned char* Kimg = (LAS unsigned char*)lds_; LAS unsigned char* Vimg = Kimg + 32768;
    const int tid = threadIdx.x, lane = tid & 63, wave = __builtin_amdgcn_readfirstlane(tid >> 6), fr = lane & 15, fq = lane >> 4;
    for (int u = blockIdx.x; u < 1024; u += gridDim.x) {
        const int n = u & 63, h = (u >> 6) & 3, b = u >> 8;
        const size_t row0 = (size_t)b * SEQ + n * 128;
        __syncthreads();
        ret_fill_image(Kimg, Z0 + row0 * ZW * 2 + (512 + h * 128) * 2, ZW * 2, wave, lane);
        ret_fill_image(Vimg, Z0 + row0 * ZW * 2 + (1024 + h * 128) * 2, ZW * 2, wave, lane);
        asm volatile("s_waitcnt vmcnt(0)" ::: "memory");
        __syncthreads();
        bf16x8 va[4];
#pragma unroll
        for (int jc = 0; jc < 4; ++jc) va[jc] = ret_tr_pair(Vimg, 32 * jc, 2 * wave, lane);
        const float g127 = exp2f(ret_log2g(h) * 127.0f);
        float* o = KV + (size_t)u * 16384;
#pragma unroll
        for (int dt = 0; dt < 8; ++dt) {
            f32x4 acc = {0.f, 0.f, 0.f, 0.f};
#pragma unroll
            for (int jc = 0; jc < 4; ++jc) acc = __builtin_amdgcn_mfma_f32_16x16x32_bf16(va[jc], ret_tr_pair(Kimg, 32 * jc, 2 * dt, lane), acc, 0, 0, 0);
            *(f32x4*)(o + (size_t)(16 * dt + fr) * 128 + 16 * wave + 4 * fq) = acc * g127;
        }
    }
}
template <int W>
__device__ __forceinline__ void pool_item(const Params& P, int t0, int c8) {
    const bf16_t* Z0 = (const bf16_t*)(P.ws + WS_Z0); bf16_t* DP = (bf16_t*)(P.ws + WS_DP);
    const int tl0 = t0 & (SEQ - 1);
    u32x4 rows[W + 7];
#pragma unroll
    for (int r = 0; r < W + 7; ++r) { const int d = r - (W - 1);
        rows[r] = (tl0 + d >= 0) ? *(const u32x4*)(Z0 + (size_t)(t0 + d) * ZW + 2048 + c8) : (u32x4){0u, 0u, 0u, 0u}; }
    float sm[8];
#pragma unroll
    for (int j = 0; j < 8; ++j) sm[j] = 0.f;
#pragma unroll
    for (int r = 0; r < W; ++r) { const u32x4 v = rows[r];
        sm[0] += bflo(v.x); sm[1] += bfhi(v.x); sm[2] += bflo(v.y); sm[3] += bfhi(v.y); sm[4] += bflo(v.z); sm[5] += bfhi(v.z); sm[6] += bflo(v.w); sm[7] += bfhi(v.w); }
#pragma unroll
    for (int o = 0; o < 8; ++o) {
        const u32x4 v = rows[o + W - 1];
        if (o > 0) { const u32x4 q = rows[o - 1];
            sm[0] += bflo(v.x) - bflo(q.x); sm[1] += bfhi(v.x) - bfhi(q.x); sm[2] += bflo(v.y) - bflo(q.y); sm[3] += bfhi(v.y) - bfhi(q.y);
            sm[4] += bflo(v.z) - bflo(q.z); sm[5] += bfhi(v.z) - bfhi(q.z); sm[6] += bflo(v.w) - bflo(q.w); sm[7] += bfhi(v.w) - bfhi(q.w); }
        const float inv = 1.0f / (float)min(tl0 + o + 1, W);
        u32x4 w; w.x = pk2(sm[0] * inv - bflo(v.x), sm[1] * inv - bfhi(v.x)); w.y = pk2(sm[2] * inv - bflo(v.y), sm[3] * inv - bfhi(v.y));
        w.z = pk2(sm[4] * inv - bflo(v.z), sm[5] * inv - bfhi(v.z)); w.w = pk2(sm[6] * inv - bflo(v.w), sm[7] * inv - bfhi(v.w));
        *(u32x4*)(DP + (size_t)(t0 + o) * 512 + c8) = w;
    }
}
__device__ __forceinline__ void phase_ret_scan_pool2(const Params& P) {
    const float* KV = (const float*)(P.ws + WS_KV); bf16_t* SB = (bf16_t*)(P.ws + WS_SB);
    const size_t gt = (size_t)blockIdx.x * NT + threadIdx.x, GS = (size_t)gridDim.x * NT;
    for (size_t i = gt; i < (size_t)16 * 8192; i += GS) {
        const int s = (int)(i >> 13), e2 = (int)(i & 8191), h = s & 3;
        const float l2 = ret_log2g(h), cd = exp2f(l2 * 128.0f), g1 = exp2f(l2);
        typedef float f32x2v __attribute__((ext_vector_type(2)));
        const f32x2v* p = (const f32x2v*)(KV + (size_t)s * 64 * 16384) + e2;
        unsigned* q = (unsigned*)(SB + (size_t)s * 64 * 16384) + e2;
        f32x2v R = {0.f, 0.f};
        for (int n0 = 0; n0 < 64; n0 += 32) {
            f32x2v kv[32];
#pragma unroll
            for (int j = 0; j < 32; ++j) kv[j] = __builtin_nontemporal_load(p + (size_t)(n0 + j) * 8192);
#pragma unroll
            for (int j = 0; j < 32; ++j) { q[(size_t)(n0 + j) * 8192] = pk2(R.x * g1, R.y * g1); R = R * cd + kv[j]; }
        }
    }
    const int lane = threadIdx.x & 63, gwv = (int)blockIdx.x * NWAVE + (int)(threadIdx.x >> 6), NGWv = (int)gridDim.x * NWAVE;
    for (int wi = gwv; wi < 2048; wi += NGWv) {
#pragma unroll
        for (int half = 0; half < 2; ++half) {
            const int slot = wi & 1023, gsel = wi >> 10, g = half ? 3 - gsel : gsel;
            const int t0 = (slot * 4 + (lane >> 4)) * 8, c8 = g * 128 + (lane & 15) * 8;
            if (g == 0) pool_item<2>(P, t0, c8); else if (g == 1) pool_item<4>(P, t0, c8); else if (g == 2) pool_item<8>(P, t0, c8); else pool_item<16>(P, t0, c8);
        }
    }
}
__device__ __forceinline__ void phase_ret_out_mfma(const Params& P, unsigned char* lds_) {
    using pg8::bf16x8;
    const unsigned char* Z0 = (const unsigned char*)(P.ws + WS_Z0); const unsigned char* SB = (const unsigned char*)(P.ws + WS_SB); bf16_t* MIX = (bf16_t*)(P.ws + WS_MIX);
    const float* gn = P.in[3];
    LAS unsigned char* Kimg = (LAS unsigned char*)lds_; LAS unsigned char* Vimg = Kimg + 32768; LAS unsigned char* Rimg = Kimg + 65536;
    const int tid = threadIdx.x, lane = tid & 63, wave = __builtin_amdgcn_readfirstlane(tid >> 6), fr = lane & 15, fq = lane >> 4;
    for (int u = blockIdx.x; u < 1024; u += gridDim.x) {
        const int n = u & 63, h = (u >> 6) & 3, b = u >> 8;
        const size_t row0 = (size_t)b * SEQ + n * 128;
        __syncthreads();
        ret_fill_image(Kimg, Z0 + row0 * ZW * 2 + (512 + h * 128) * 2, ZW * 2, wave, lane);
        ret_fill_image(Vimg, Z0 + row0 * ZW * 2 + (1024 + h * 128) * 2, ZW * 2, wave, lane);
        ret_fill_image(Rimg, SB + (size_t)u * 32768, 256, wave, lane);
        const bf16_t* qrow = (const bf16_t*)Z0 + (row0 + 16 * wave + fr) * ZW + h * 128;
        bf16x8 qf[4], qr[4];
#pragma unroll
        for (int c = 0; c < 4; ++c) {
            qf[c] = *(const bf16x8*)(qrow + 32 * c + 8 * fq);
            const u32x2 a = *(const u32x2*)(qrow + 32 * c + 4 * fq), bb = *(const u32x2*)(qrow + 32 * c + 16 + 4 * fq);
            u32x4 w; w.x = a.x; w.y = a.y; w.z = bb.x; w.w = bb.y; qr[c] = __builtin_bit_cast(bf16x8, w);
        }
        asm volatile("s_waitcnt vmcnt(0)" ::: "memory");
        __syncthreads();
        f32x4 sT[8];
#pragma unroll
        for (int jt = 0; jt < 8; ++jt) sT[jt] = (f32x4){0.f, 0.f, 0.f, 0.f};
#pragma unroll
        for (int jp = 0; jp < 4; ++jp) if (2 * jp <= wave) {
            bf16x8 a[8];
#pragma unroll
            for (int t2 = 0; t2 < 2; ++t2) { const int r = 16 * (2 * jp + t2) + fr;
#pragma unroll
                for (int c = 0; c < 4; ++c) a[t2 * 4 + c] = *(const LAS bf16x8*)(Kimg + r * 256 + ((((4 * c + fq)) ^ ((r & 7) << 1)) << 4)); }
            __builtin_amdgcn_sched_barrier(0);
#pragma unroll
            for (int t2 = 0; t2 < 2; ++t2)
#pragma unroll
                for (int c = 0; c < 4; ++c) sT[2 * jp + t2] = __builtin_amdgcn_mfma_f32_16x16x32_bf16(a[t2 * 4 + c], qf[c], sT[2 * jp + t2], 0, 0, 0);
            __builtin_amdgcn_sched_barrier(0);
        }
#pragma unroll
        for (int jt = 0; jt < 8; ++jt) {
            if (jt == wave) {
                if (4 * fq + 0 > fr) sT[jt].x = 0.f; if (4 * fq + 1 > fr) sT[jt].y = 0.f; if (4 * fq + 2 > fr) sT[jt].z = 0.f; if (4 * fq + 3 > fr) sT[jt].w = 0.f;
            }
            if (jt > wave) sT[jt] = (f32x4){0.f, 0.f, 0.f, 0.f};
        }
        bf16x8 pT[4];
#pragma unroll
        for (int jp = 0; jp < 4; ++jp) { u32x4 w; w.x = pk2(sT[2 * jp].x, sT[2 * jp].y); w.y = pk2(sT[2 * jp].z, sT[2 * jp].w); w.z = pk2(sT[2 * jp + 1].x, sT[2 * jp + 1].y); w.w = pk2(sT[2 * jp + 1].z, sT[2 * jp + 1].w);
            pT[jp] = __builtin_bit_cast(bf16x8, w); }
        f32x4 O[8];
        const int nact = (wave >> 1) + 1;
#pragma unroll
        for (int vt = 0; vt < 8; ++vt) {
            bf16x8 rr[4], vv[4];
#pragma unroll
            for (int c = 0; c < 4; ++c) rr[c] = ret_tr_pair(Rimg, 32 * c, 2 * vt, lane);
#pragma unroll
            for (int jp = 0; jp < 4; ++jp) vv[jp] = (jp < nact) ? ret_tr_pair(Vimg, 32 * jp, 2 * vt, lane) : pT[jp];
            __builtin_amdgcn_sched_barrier(0);
            f32x4 acc = {0.f, 0.f, 0.f, 0.f};
#pragma unroll
            for (int c = 0; c < 4; ++c) acc = __builtin_amdgcn_mfma_f32_16x16x32_bf16(rr[c], qr[c], acc, 0, 0, 0);
#pragma unroll
            for (int jp = 0; jp < 4; ++jp) acc = __builtin_amdgcn_mfma_f32_16x16x32_bf16(vv[jp], pT[jp], acc, 0, 0, 0);
            __builtin_amdgcn_sched_barrier(0);
            O[vt] = acc;
        }
        float sm = 0.f;
#pragma unroll
        for (int vt = 0; vt < 8; ++vt) sm += (O[vt].x + O[vt].y) + (O[vt].z + O[vt].w);
        sm += __shfl_xor(sm, 16); sm += __shfl_xor(sm, 32);
        const float mu = sm * (1.0f / 128.0f);
        float sq = 0.f;
#pragma unroll
        for (int vt = 0; vt < 8; ++vt) { const f32x4 dlt = O[vt] - mu; sq += (dlt.x * dlt.x + dlt.y * dlt.y) + (dlt.z * dlt.z + dlt.w * dlt.w); }
        sq += __shfl_xor(sq, 16); sq += __shfl_xor(sq, 32);
        const float rstd = 1.0f / sqrtf(sq * (1.0f / 128.0f) + LN_EPS);
        const bf16_t* grow = (const bf16_t*)Z0 + (row0 + 16 * wave + fr) * ZW + 1536 + h * 128 + 4 * fq;
        bf16_t* orow = MIX + (row0 + 16 * wave + fr) * DM + h * 128 + 4 * fq;
#pragma unroll
        for (int vt = 0; vt < 8; ++vt) {
            const u32x2 gv = *(const u32x2*)(grow + 16 * vt);
            const f32x4 g4 = *(const f32x4*)(gn + h * 128 + 16 * vt + 4 * fq);
            const f32x4 y = (O[vt] - mu) * rstd * g4;
            u32x2 w; w.x = pk2(y.x * silu_f(bflo(gv.x)), y.y * silu_f(bfhi(gv.x))); w.y = pk2(y.z * silu_f(bflo(gv.y)), y.w * silu_f(bfhi(gv.y)));
            *(u32x2*)(orow + 16 * vt) = w;
        }
    }
}

#define XB_TMO      128
#define XB_XCNT(j)  (256  + 64 * (j))
#define XB_XSUB(j)  (1280 + 64 * (j))
#define XB_XGEN(j)  (2304 + 64 * (j))
#define XB_TOP      3328
#define XB_TOPGEN   3392
#define XCD_BAR_WORDS 3456
#define XB_SPIN_CAP (1u << 22)
__device__ __forceinline__ unsigned xb_ld(unsigned* p)              { return __hip_atomic_load(p, __ATOMIC_RELAXED, __HIP_MEMORY_SCOPE_AGENT); }
__device__ __forceinline__ unsigned xb_add(unsigned* p, unsigned v) { return __hip_atomic_fetch_add(p, v, __ATOMIC_RELAXED, __HIP_MEMORY_SCOPE_AGENT); }
__device__ __forceinline__ unsigned xb_xcc_id() { return (unsigned)__builtin_amdgcn_s_getreg((3 << 11) | 20) & 0xFu; }
#define XB_SPIN(cond, bar) do { unsigned _sp = 0; while (cond) { __builtin_amdgcn_s_sleep(1); \
    if ((++_sp & 255u) == 0u) { if (xb_ld(&(bar)[XB_TMO])) break; if (_sp > XB_SPIN_CAP) { atomicAdd(&(bar)[XB_TMO], 1u); break; } } } } while (0)
struct XcdBarrier { unsigned* bar; unsigned x; volatile LAS unsigned* st; };
__device__ __forceinline__ XcdBarrier xcd_barrier_post(unsigned* bar, volatile LAS unsigned* st) {
    XcdBarrier b; b.bar = bar; b.x = xb_xcc_id(); b.st = st;
    if (threadIdx.x == 0) (void)xb_add(&bar[XB_XCNT(b.x)], 1u);
    return b;
}
__device__ __forceinline__ void xcd_barrier_complete(unsigned* bar, unsigned x, unsigned& nloc, unsigned& nx) {
    const unsigned G = gridDim.x * gridDim.y * gridDim.z;
    unsigned sum, cnt, mine, sp = 0u;
    for (;;) {
        sum = 0u; cnt = 0u; mine = 0u;
#pragma unroll
        for (unsigned j = 0; j < 16; ++j) { const unsigned c = xb_ld(&bar[XB_XCNT(j)]); sum += c; cnt += (c > 0u) ? 1u : 0u; mine = (j == x) ? c : mine; }
        if (sum == G) break;
        __builtin_amdgcn_s_sleep(1);
        if ((++sp & 255u) == 0u) { if (xb_ld(&bar[XB_TMO])) break; if (sp > XB_SPIN_CAP) { atomicAdd(&bar[XB_TMO], 1u); break; } }
    }
    nloc = mine > 0u ? mine : 1u; nx = cnt > 0u ? cnt : 1u;
}
__device__ __forceinline__ void xcd_barrier(const XcdBarrier& b) {
    asm volatile("s_waitcnt vmcnt(0)" ::: "memory");
    __syncthreads();
    if (threadIdx.x == 0) {
        unsigned* bar = b.bar;
        __builtin_amdgcn_s_waitcnt(0);
        unsigned nloc = b.st[0], nx = b.st[1];
        if (nloc == 0u) { xcd_barrier_complete(bar, b.x, nloc, nx); b.st[0] = nloc; b.st[1] = nx; }
        const unsigned old = xb_add(&bar[XB_XSUB(b.x)], 1u);
        const unsigned gen = old / nloc;
        if (old + 1u == (gen + 1u) * nloc) {
            __builtin_amdgcn_fence(__ATOMIC_RELEASE, "agent");
            asm volatile("s_waitcnt vmcnt(0)" ::: "memory");
            const unsigned og = xb_add(&bar[XB_TOP], 1u);
            const unsigned tg = og / nx;
            if (og + 1u == (tg + 1u) * nx) xb_add(&bar[XB_TOPGEN], 1u);
            else XB_SPIN(xb_ld(&bar[XB_TOPGEN]) == tg, bar);
            __builtin_amdgcn_fence(__ATOMIC_ACQUIRE, "agent");
            xb_add(&bar[XB_XGEN(b.x)], 1u);
            asm volatile("s_waitcnt vmcnt(0)" ::: "memory");
        } else {
            XB_SPIN(xb_ld(&bar[XB_XGEN(b.x)]) == gen, bar);
            __builtin_amdgcn_fence(__ATOMIC_ACQUIRE, "agent");
            asm volatile("s_waitcnt vmcnt(0)" ::: "memory");
        }
    }
    __syncthreads();
}
constexpr size_t CTL_BAR_OFF = 16384;
constexpr size_t CTL_ZERO_BYTES = 65536;

#ifdef PH_ONLY
#define IN(k) ((k) == PH_ONLY)
#else
#define IN(k) (lo <= (k) && (k) < hi)
#endif
#define SEAM(k) do { if (IN(k) && IN((k) + 1)) xcd_barrier(grid); } while (0)
#ifndef PROBE_DUP
#define PROBE_DUP (-1)
#endif
#define REP(k) for (int _rep = 0; _rep < ((PROBE_DUP == (k)) ? 2 : 1); ++_rep)
#define REPS(k) ((PROBE_DUP == 100 + (k)) ? 2 : 1)

template <int LAYER, int BASE>
__device__ __forceinline__ void layer_tail(const Params& P, unsigned char* lds, const XcdBarrier& grid, int lo, int hi) {
    unsigned char* ws = P.ws;
    int* tb = (int*)(lds + MISC_OFF);
    if (IN(BASE)) { if (PROBE_DUP == BASE) phase_ln_route<true>(P, lds, LAYER); phase_ln_route<false>(P, lds, LAYER); }
    SEAM(BASE);
    if (IN(BASE + 1)) REP(BASE + 1) { moe_setup(P, tb, LAYER);
        MoeSched S{tb, (const int*)(ws + WS_CTL + CTL_CNT_OFF) + LAYER * 32 * CNT_STRIDE, (const int*)(ws + WS_LIST), (const bf16_t*)(ws + WS_XB),
                   (const bf16_t*)(ws + WS_W_GU) + (size_t)LAYER * 32 * DM * DM, DM, (size_t)DM * DM, true};
        EpiGU E{(bf16_t*)(ws + WS_ACT)}; gemm_moe<true>(lds, S, E);
        { const int U = tb[32] * 4, G = (int)gridDim.x, nheavy = (U % G), nlight = G - nheavy, lr = (int)blockIdx.x - nheavy;
          DenseSched S2{(const bf16_t*)(ws + WS_PB) + (size_t)LAYER * NTOK * 256, (const bf16_t*)(ws + WS_W_P) + (size_t)LAYER * DM * 256, NTOK, DM, 256, 256, 0, 1, lr, nlight};
          EpiStoreBf16 E2{(bf16_t*)(ws + WS_PP), DM, 0, nullptr}; gemm_dense(lds, S2, E2); } }
    SEAM(BASE + 1);
    if (IN(BASE + 2)) REP(BASE + 2) { moe_setup(P, tb, LAYER);
        MoeSched S{tb, (const int*)(ws + WS_CTL + CTL_CNT_OFF) + LAYER * 32 * CNT_STRIDE, (const int*)(ws + WS_LIST), (const bf16_t*)(ws + WS_ACT),
                   (const bf16_t*)(ws + WS_W_DN) + (size_t)LAYER * 32 * DM * 512, 512, (size_t)DM * 512, false};
        EpiDown E{(bf16_t*)(ws + WS_YS)}; gemm_moe<false>(lds, S, E); }
    SEAM(BASE + 2);
    if (IN(BASE + 3)) { if (PROBE_DUP == BASE + 3) phase_ln2<true>(P, LAYER); phase_ln2<false>(P, LAYER); }
    SEAM(BASE + 3);
    if (IN(BASE + 4)) REP(BASE + 4) {
        { DenseSched S{(const bf16_t*)(ws + WS_XB), (const bf16_t*)(ws + WS_W_G) + (size_t)LAYER * DM * DM, NTOK, DM, DM, DM, 0, REPS(BASE + 4)};
          EpiPle E{(const bf16_t*)(ws + WS_XB), (const bf16_t*)(ws + WS_PP), LAYER == 1 ? P.out : (float*)nullptr, LAYER == 1 ? (bf16_t*)nullptr : (bf16_t*)(ws + WS_XB2)}; gemm_dense(lds, S, E); }
    }
}

__global__ void __launch_bounds__(NT, 2) mega(Params P, int lo, int hi) {
    extern __shared__ __attribute__((aligned(16))) unsigned char lds[];
    unsigned char* ws = P.ws;
    if (threadIdx.x < 16) ((LAS unsigned*)((LAS unsigned char*)lds + BARW_OFF))[threadIdx.x] = 0u;
    __syncthreads();
    const XcdBarrier grid = xcd_barrier_post((unsigned*)(ws + WS_CTL + CTL_BAR_OFF), (volatile LAS unsigned*)((LAS unsigned char*)lds + BARW_OFF));
    if (IN(0)) REP(0) phase_prep(P, lds);
    SEAM(0);
    if (IN(1)) REP(1) { DenseSched S{(const bf16_t*)(ws + WS_XB), (const bf16_t*)(ws + WS_W_IN0), NTOK, ZW, DM, DM, 0, REPS(1)};
        EpiZ0 E{(bf16_t*)(ws + WS_Z0)}; gemm_dense(lds, S, E); }
    SEAM(1);
    if (IN(2)) REP(2) phase_ret_kv_mfma(P, lds);
    SEAM(2);
    if (IN(3)) REP(3) phase_ret_scan_pool2(P);
    SEAM(3);
    if (IN(4)) REP(4) { phase_ret_out_mfma(P, lds); __syncthreads();
        DenseSched S{(const bf16_t*)(ws + WS_DP), (const bf16_t*)(ws + WS_W_POOL), NTOK, 512, 256, 512, 256};
        EpiStoreBf16 E{(bf16_t*)(ws + WS_MIX), DM, 512, P.in[5]}; gemm_dense(lds, S, E); }
    SEAM(4);
    if (IN(5)) REP(5) { DenseSched S{(const bf16_t*)(ws + WS_MIX), (const bf16_t*)(ws + WS_W_OUT0), NTOK, DM, DM, DM, 0, REPS(5)};
        EpiResidB E{(const bf16_t*)(ws + WS_XB), (bf16_t*)(ws + WS_F)}; gemm_dense(lds, S, E); }
    SEAM(5);
    layer_tail<0, 6>(P, lds, grid, lo, hi);
    SEAM(10);
    if (IN(11)) REP(11) { DenseSched S{(const bf16_t*)(ws + WS_XB2), (const bf16_t*)(ws + WS_W_CIN), NTOK, Z1W, DM, DM, 0, REPS(11)};
        EpiStoreBf16 E{(bf16_t*)(ws + WS_Z1), Z1W, 0, nullptr}; gemm_dense(lds, S, E); }
    SEAM(11);
    if (IN(12)) REP(12) { phase_norms(P); phase_index_scores(P, lds); }
    SEAM(12);
    if (IN(13)) { if (PROBE_DUP == 13) phase_index_select<PROBE_SEL>(P, lds); phase_index_select<0>(P, lds); }
    if (IN(13) && IN(14)) __syncthreads();
    if (IN(14)) REP(14) { DenseSched S{(const bf16_t*)(ws + WS_CQ), (const bf16_t*)(ws + WS_W_QA), NTOK, 4096, 256, 256, 0, REPS(14)};
        EpiStoreFp8 E{(unsigned char*)(ws + WS_QA), 4096}; gemm_dense(lds, S, E); }
    SEAM(14);
    if (IN(15)) { if (PROBE_DUP == 15) phase_sparse_attn_e<true>(P, lds); phase_sparse_attn_e<false>(P, lds); }
    SEAM(15);
    if (IN(16)) REP(16) { DenseSched S{(const bf16_t*)(ws + WS_OLAT), (const bf16_t*)(ws + WS_W_UVBD), NTOK, DM, DM, 4096, 1024, REPS(16)};
        EpiStoreBf16 E{(bf16_t*)(ws + WS_XB), DM, 0, nullptr}; gemm_dense_bdiag(lds, S, E); }
    SEAM(16);
    if (IN(17)) REP(17) { DenseSched S{(const bf16_t*)(ws + WS_XB), (const bf16_t*)(ws + WS_W_COUT), NTOK, DM, DM, DM, 0, REPS(17)};
        EpiResidB E{(const bf16_t*)(ws + WS_XB2), (bf16_t*)(ws + WS_F)}; gemm_dense(lds, S, E); }
    SEAM(17);
    layer_tail<1, 18>(P, lds, grid, lo, hi);
}
#undef IN
#undef SEAM

extern "C" void kernel_launch(void* const* d_in, const int* in_sizes, int n_in, void* d_out, int out_size, void* d_ws, size_t ws_size, hipStream_t stream) {
    static int grid = 0;
    if (grid == 0) {
        if (n_in != 26 || ws_size < WS_END || out_size != NTOK * DM) { fprintf(stderr, "kernel_launch: unexpected problem (n_in %d, ws %zu, out %d)\n", n_in, ws_size, out_size); grid = -1; return; }
        int dev = 0, cus = 0, per_cu = 0;
        (void)hipGetDevice(&dev);
        (void)hipDeviceGetAttribute(&cus, hipDeviceAttributeMultiprocessorCount, dev);
        (void)hipFuncSetAttribute((const void*)mega, hipFuncAttributeMaxDynamicSharedMemorySize, LDS_BYTES);
        (void)hipOccupancyMaxActiveBlocksPerMultiprocessor(&per_cu, (const void*)mega, NT, LDS_BYTES);
        if (per_cu < 1) { fprintf(stderr, "kernel_launch: occupancy query reports %d blocks per CU\n", per_cu); per_cu = 1; }
        (void)hipGetLastError();
        grid = cus;
    }
    if (grid < 0) return;
    (void)hipMemsetAsync((char*)d_ws + WS_CTL, 0, CTL_ZERO_BYTES, stream);
    Params p{};
    for (int i = 0; i < 26; ++i) p.in[i] = (const float*)d_in[i];
    p.out = (float*)d_out; p.ws = (unsigned char*)d_ws;
#if MK_ONE_LAUNCH
    int lo = 0, hi = NPH_TOTAL;
    void* args[] = {&p, &lo, &hi};
    (void)args;
    hipLaunchKernelGGL(mega, dim3(grid), dim3(NT), LDS_BYTES, stream, p, lo, hi);
    hipError_t e = hipPeekAtLastError();
    if (e != hipSuccess) fprintf(stderr, "launch failed: %s (grid %d)\n", hipGetErrorString(e), grid);
#else
    for (int k = 0; k < NPH_TOTAL; ++k) hipLaunchKernelGGL(mega, dim3(grid), dim3(NT), LDS_BYTES, stream, p, k, k + 1);
#endif
}
```

```cpp
#include <hip/hip_runtime.h>
#include <cstdio>
#include <cstdint>

#ifndef PROBE_ATT
#define PROBE_ATT 0
#endif
#ifndef PROBE_LN
#define PROBE_LN 0
#endif
#ifndef PROBE_SEL
#define PROBE_SEL 0
#endif
#ifndef MK_ONE_LAUNCH
#define MK_ONE_LAUNCH 1
#endif

typedef unsigned short bf16_t;
typedef float f32x4 __attribute__((ext_vector_type(4)));
typedef unsigned u32x4 __attribute__((ext_vector_type(4)));
typedef unsigned u32x2 __attribute__((ext_vector_type(2)));

constexpr int NT = 512;
constexpr int NWAVE = NT / 64;
constexpr int NTOK = 32768, DM = 1024, SEQ = 8192, NBATCH = 4;
constexpr int ZW = 2560;
constexpr int Z1W = 1280;
constexpr int CIN = 1096;
constexpr int TOPK = 256;
constexpr float ALPHA = 1.4142135623730951f;
constexpr float LN_EPS = 1e-5f;
constexpr int LDS_BYTES = 163840;
constexpr int BARW_OFF = LDS_BYTES - 64;
constexpr int MISC_OFF = 135168;

constexpr size_t MiB = (size_t)1 << 20;
constexpr size_t WS_CTL = 0;
constexpr size_t WS_W_IN0 = 1 * MiB, WS_W_OUT0 = 6 * MiB, WS_W_POOL = 8 * MiB, WS_W_CIN = 9 * MiB, WS_W_QA = 12 * MiB,
                 WS_W_UVBD = 14 * MiB, WS_W_COUT = 16 * MiB, WS_W_G = 18 * MiB, WS_W_P = 22 * MiB, WS_W_GU = 24 * MiB, WS_W_DN = 152 * MiB;
constexpr size_t WS_XB = 224 * MiB, WS_F = 288 * MiB, WS_PB = 416 * MiB, WS_PP = 448 * MiB, WS_CQ = 512 * MiB, WS_CKV = 528 * MiB,
                 WS_SEL = 544 * MiB, WS_TOKG = 560 * MiB, WS_LIST = 561 * MiB, WS_CKV8 = 566 * MiB;
constexpr size_t WS_M0 = 576 * MiB;
constexpr size_t WS_Z0 = WS_M0, WS_KV = WS_M0 + 160 * MiB, WS_MIX = WS_M0 + 224 * MiB, WS_DP = WS_M0 + 288 * MiB, WS_SB = WS_M0 + 320 * MiB;
constexpr size_t WS_OLAT = WS_M0, WS_QA = WS_F  , WS_SC = WS_M0, WS_Z1 = WS_M0 + 272 * MiB;
constexpr size_t WS_ACT = WS_M0, WS_YS = WS_M0 + 72 * MiB;
constexpr size_t WS_XB2 = 960 * MiB;
constexpr size_t WS_END = 1024 * MiB;
constexpr int LIST_CAP = 32768;
constexpr size_t CTL_CNT_OFF = 32768;
constexpr int CNT_STRIDE = 64;
constexpr size_t WS_GT = WS_CTL + 262144;
constexpr size_t WS_SGB = WS_CTL + 786432;

struct Params {
    const float* in[26];
    float* out;
    unsigned char* ws;
};

__device__ __forceinline__ unsigned f2bf(float f) { unsigned u = __float_as_uint(f); return (u + 0x7fffu + ((u >> 16) & 1u)) >> 16; }
__device__ __forceinline__ float bf2f(unsigned h) { return __uint_as_float(h << 16); }
typedef float f32x2_t __attribute__((ext_vector_type(2))); typedef __bf16 bf16x2_t __attribute__((ext_vector_type(2)));
__device__ __forceinline__ unsigned pk2(float lo, float hi) { f32x2_t v = {lo, hi}; bf16x2_t b = __builtin_convertvector(v, bf16x2_t); return __builtin_bit_cast(unsigned, b); }
__device__ __forceinline__ float bflo(unsigned w) { return __uint_as_float(w << 16); }
__device__ __forceinline__ float bfhi(unsigned w) { return __uint_as_float(w & 0xffff0000u); }
#define WAVE_SUM_DPP(v) ({ float _v = (v); \
    _v += __builtin_bit_cast(float, __builtin_amdgcn_update_dpp(0, __builtin_bit_cast(int, _v), 0xB1, 0xf, 0xf, true));     \
    _v += __builtin_bit_cast(float, __builtin_amdgcn_update_dpp(0, __builtin_bit_cast(int, _v), 0x4E, 0xf, 0xf, true));     \
    _v += __builtin_bit_cast(float, __builtin_amdgcn_update_dpp(0, __builtin_bit_cast(int, _v), 0x141, 0xf, 0xf, true));    \
    _v += __builtin_bit_cast(float, __builtin_amdgcn_update_dpp(0, __builtin_bit_cast(int, _v), 0x140, 0xf, 0xf, true));    \
    _v += __builtin_bit_cast(float, __builtin_amdgcn_update_dpp(0, __builtin_bit_cast(int, _v), 0x142, 0xa, 0xf, false));   \
    _v += __builtin_bit_cast(float, __builtin_amdgcn_update_dpp(0, __builtin_bit_cast(int, _v), 0x143, 0xc, 0xf, false));   \
    __builtin_bit_cast(float, __builtin_amdgcn_readlane(__builtin_bit_cast(int, _v), 63)); })
__device__ __forceinline__ float wave_sum(float v) { return WAVE_SUM_DPP(v); }
#define WAVE_SCAN_DPP(v) ({ unsigned _v = (v); \
    _v += (unsigned)__builtin_amdgcn_update_dpp(0, (int)_v, 0x111, 0xf, 0xf, false); \
    _v += (unsigned)__builtin_amdgcn_update_dpp(0, (int)_v, 0x112, 0xf, 0xf, false); \
    _v += (unsigned)__builtin_amdgcn_update_dpp(0, (int)_v, 0x114, 0xf, 0xf, false); \
    _v += (unsigned)__builtin_amdgcn_update_dpp(0, (int)_v, 0x118, 0xf, 0xf, false); \
    _v += (unsigned)__builtin_amdgcn_update_dpp(0, (int)_v, 0x142, 0xa, 0xf, false); \
    _v += (unsigned)__builtin_amdgcn_update_dpp(0, (int)_v, 0x143, 0xc, 0xf, false); \
    _v; })

__device__ __forceinline__ float silu_f(float a) { return a / (1.0f + __expf(-a)); }
__device__ __forceinline__ float sigmoid_f(float a) { return 1.0f / (1.0f + __expf(-a)); }
#define LDS_FENCE() asm volatile("s_waitcnt lgkmcnt(0)" ::: "memory")

struct UnitInfo {
    const bf16_t* A; int lda;
    const int* rows; int rshift;
    int nvalid;
    const bf16_t* Bt; int ldb;
    int K;
    int orow0;
    int pn;
};

struct DenseSched {
    const bf16_t* A; const bf16_t* Bt; int M, N, K, lda, a_pn_stride; int reps = 1;
    int wrank = -1, wcount = 0;
    __device__ __forceinline__ bool next(int round, UnitInfo& u) const {
        const int nN = N >> 8, nM = M >> 8, nwg = nN * nM;
        if (wcount > 0 && wrank < 0) return false;
        const long L = (wcount > 0) ? ((long)round * wcount + wrank) : ((long)round * gridDim.x + blockIdx.x); if (L >= (long)nwg * reps) return false;
        int wgid = (int)(L % nwg); { const int q = nwg / 8, r = nwg % 8, xcd = wgid % 8, off = wgid / 8; wgid = (xcd < r ? xcd * (q + 1) : r * (q + 1) + (xcd - r) * q) + off; }
        const int nig = 8 * nN, gid = wgid / nig, fm = gid * 8, gsz = (nM - fm) < 8 ? (nM - fm) : 8;
        const int pm = fm + ((wgid % nig) % gsz), pn = (wgid % nig) / gsz;
        u.A = A + (size_t)pm * 256 * lda + (size_t)pn * a_pn_stride; u.lda = lda; u.rows = nullptr; u.rshift = 0; u.nvalid = 256;
        u.Bt = Bt + (size_t)pn * 256 * K; u.ldb = K; u.K = K; u.orow0 = pm * 256; u.pn = pn;
        return true;
    }
};
struct MoeSched {
    const int* tb; const int* cnt; const int* list;
    const bf16_t* A; const bf16_t* W; int K; size_t wstride; bool gather;
    __device__ __forceinline__ bool next(int round, UnitInfo& u) const {
        const int i = round * gridDim.x + blockIdx.x;
        const int j = i >> 2, pn = i & 3;
        if (j >= tb[32]) return false;
        int e = 0;
        while (tb[e + 1] <= j) ++e;
        const int rb = j - tb[e];
        const int nv = min(256, cnt[e * CNT_STRIDE] - rb * 256);
        u.rows = list + (size_t)e * LIST_CAP + rb * 256; u.nvalid = nv; u.orow0 = j * 256; u.pn = pn;
        if (gather) { u.A = A; u.lda = K; u.rshift = 1; }
        else { u.A = A + (size_t)j * 256 * K; u.lda = K; u.rshift = 31;   }
        u.Bt = W + (size_t)e * wstride + (size_t)pn * 256 * K; u.ldb = K; u.K = K;
        return true;
    }
};


namespace pg8 {
#define LAS __attribute__((address_space(3)))
typedef short bf16x8 __attribute__((ext_vector_type(8)));
constexpr int BK = 64, HALF = 128, HTB = HALF * BK * 2, STAGE_BYTES = 8 * HTB;
__device__ __forceinline__ int lds_byte(int r, int c) { const int st = (r >> 4) * 2 + (c >> 5), rr = r & 15, cc = c & 31, ob = rr * 64 + cc * 2; return st * 1024 + (ob ^ (((ob >> 9) & 1) << 5)); }
__device__ __forceinline__ void stage_rc(int b, int& R, int& C) { const int st = b / 1024, sb = b % 1024, swz = sb ^ (((sb >> 9) & 1) << 5); R = (st >> 1) * 16 + swz / 64; C = (st & 1) * 32 + (swz % 64) / 2; }
__device__ __forceinline__ int perm32(int rho) { const int n = rho >> 4, i = rho & 15; return 8 * (i >> 2) + 4 * n + (i & 3); }

template <bool GATHER, class Sched, class Epi, bool BDIAG = false>
__device__ __forceinline__ void gemm_phase(LAS unsigned char* lds, const LAS unsigned* rowtab, const Sched& S, const Epi& E, const int lda, const int ldb, const int K) {
    const int tid = threadIdx.x, wid = __builtin_amdgcn_readfirstlane(tid >> 6), lane = tid & 63, wr = wid >> 2, wc = wid & 3, fr = lane & 15, fq = lane >> 4;
    const int nt = K / BK;
    unsigned voffA[2], voffB[2]; int RA[2]; unsigned CA2[2];
#pragma unroll
    for (int i = 0; i < 2; ++i) { int R, C; stage_rc(tid * 16 + i * 8192, R, C); const int Rb = (R & ~31) + perm32(R & 31);
        voffA[i] = (unsigned)(R * lda + C) * 2u; voffB[i] = (unsigned)(Rb * ldb + C) * 2u; RA[i] = R; CA2[i] = (unsigned)C * 2u; }
    const size_t kstep = (size_t)(BK * 2);
    const size_t hstepA = (size_t)HALF * lda * 2, hstepB = (size_t)HALF * ldb * 2;
    const unsigned ldsw = (unsigned)wid * 1024u;
    const int aoff = lds_byte(wr * 64 + fr, fq * 8), boff = lds_byte(wc * 32 + fr, fq * 8);
    unsigned offA[2][2];
#define PG8_SA(b, h) (((b) * 2 + (h)) * HTB)
#define PG8_SB(b, h) ((4 + (b) * 2 + (h)) * HTB)
#define PG8_STAGE(bufoff, gbase, voff) do { _Pragma("unroll") for (int _i = 0; _i < 2; ++_i) \
        __builtin_amdgcn_global_load_lds((const unsigned*)((const char*)(gbase) + (voff)[_i]), (LAS unsigned*)(lds + (bufoff) + ldsw + _i * 8192), 16, 0, 0); } while (0)
#define PG8_STAGE_A(bufoff, h, gbase) do { if (GATHER) PG8_STAGE(bufoff, gbase, offA[h]); else PG8_STAGE(bufoff, (gbase) + (h) * hstepA, voffA); } while (0)
#define PG8_LOADOFF(round) do { _Pragma("unroll") for (int _h = 0; _h < 2; ++_h) _Pragma("unroll") for (int _i = 0; _i < 2; ++_i) offA[_h][_i] = rowtab[(round) * 256 + _h * 128 + RA[_i]] + CA2[_i]; } while (0)
#define PG8_LDA(dst, b, h) do { _Pragma("unroll") for (int m = 0; m < 4; ++m) _Pragma("unroll") for (int k = 0; k < 2; ++k) dst[m][k] = *(const LAS bf16x8*)(lds + PG8_SA(b, h) + aoff + m * 2048 + k * 1024); } while (0)
#define PG8_LDB(dst, b, h) do { _Pragma("unroll") for (int n = 0; n < 2; ++n) _Pragma("unroll") for (int k = 0; k < 2; ++k) dst[n][k] = *(const LAS bf16x8*)(lds + PG8_SB(b, h) + boff + n * 2048 + k * 1024); } while (0)
#define PG8_MMA(ai, bj, At, Bt) do { if (!BDIAG || (((kt_ >> 2) & 3) == 2 * (bj) + (wc >> 1))) { __builtin_amdgcn_s_setprio(1); _Pragma("unroll") for (int m = 0; m < 4; ++m) _Pragma("unroll") for (int n = 0; n < 2; ++n) _Pragma("unroll") for (int k = 0; k < 2; ++k) \
        acc[ai][bj][m][n] = __builtin_amdgcn_mfma_f32_16x16x32_bf16(Bt[n][k], At[m][k], acc[ai][bj][m][n], 0, 0, 0); __builtin_amdgcn_s_setprio(0); } } while (0)
#define PG8_WAIT_V(n) asm volatile("s_waitcnt vmcnt(" #n ")" ::: "memory")
#define PG8_WAIT_L(n) asm volatile("s_waitcnt lgkmcnt(" #n ")" ::: "memory")
#define PG8_BAR __builtin_amdgcn_s_barrier()
#define PG8_SCHED __builtin_amdgcn_sched_barrier(0)
    UnitInfo cur, nxt; int ui = 0;
    if (!S.next(0, cur)) return;
    f32x4 acc[2][2][4][2];
#pragma unroll
    for (int a = 0; a < 2; ++a)
#pragma unroll
        for (int b = 0; b < 2; ++b)
#pragma unroll
            for (int m = 0; m < 4; ++m)
#pragma unroll
                for (int n = 0; n < 2; ++n) acc[a][b][m][n] = (f32x4){0.f, 0.f, 0.f, 0.f};
    bf16x8 At[4][2], B0[2][2], B1[2][2];
    const char* cA = (const char*)cur.A; const char* cB = (const char*)cur.Bt;
    if (GATHER) { PG8_LOADOFF(0); }
    PG8_STAGE(PG8_SB(0, 0), cB, voffB); PG8_STAGE(PG8_SB(0, 1), cB + hstepB, voffB); PG8_STAGE_A(PG8_SA(0, 0), 0, cA); PG8_STAGE_A(PG8_SA(0, 1), 1, cA);
    if (wr == 1) PG8_BAR;
    PG8_WAIT_V(2); PG8_BAR;
    PG8_STAGE(PG8_SB(1, 0), cB + kstep, voffB); PG8_STAGE_A(PG8_SA(1, 0), 0, cA + kstep); PG8_STAGE(PG8_SB(1, 1), cB + hstepB + kstep, voffB);
    PG8_WAIT_V(6); PG8_BAR;
    for (;;) {
        const bool has_next = S.next(ui + 1, nxt);
        const char* nA = has_next ? (const char*)nxt.A : cA; const char* nB = has_next ? (const char*)nxt.Bt : cB;
        for (int t = 0; t < nt; t += 2) {
            const bool last = (t == nt - 2);
            const char* a1 = cA + (size_t)(t + 1) * kstep;
            const char* a2 = last ? nA : cA + (size_t)(t + 2) * kstep; const char* b2 = last ? nB : cB + (size_t)(t + 2) * kstep;
            const char* a3 = a2 + kstep; const char* b3 = b2 + kstep;
            int kt_ = t;
            PG8_LDB(B0, 0, 0); PG8_LDB(B1, 0, 1); PG8_SCHED; PG8_LDA(At, 0, 0); PG8_STAGE_A(PG8_SA(1, 1), 1, a1);
            if (GATHER) { if (last && has_next) { PG8_LOADOFF(ui + 1); } }
            PG8_WAIT_V(8); PG8_WAIT_L(0); PG8_BAR; PG8_MMA(0, 0, At, B0); PG8_MMA(0, 1, At, B1); PG8_BAR; PG8_SCHED;
            PG8_LDA(At, 0, 1); PG8_STAGE(PG8_SB(0, 0), b2, voffB); PG8_STAGE(PG8_SB(0, 1), b2 + hstepB, voffB); PG8_STAGE_A(PG8_SA(0, 0), 0, a2);
            PG8_WAIT_V(8); PG8_WAIT_L(0); PG8_BAR; PG8_MMA(1, 0, At, B0); PG8_MMA(1, 1, At, B1); PG8_BAR; PG8_SCHED;
            kt_ = t + 1;
            PG8_LDB(B0, 1, 0); PG8_LDB(B1, 1, 1); PG8_SCHED; PG8_LDA(At, 1, 0); PG8_STAGE_A(PG8_SA(0, 1), 1, a2);
            PG8_WAIT_V(8); PG8_WAIT_L(0); PG8_BAR; PG8_MMA(0, 0, At, B0); PG8_MMA(0, 1, At, B1); PG8_BAR; PG8_SCHED;
            PG8_LDA(At, 1, 1); PG8_STAGE(PG8_SB(1, 0), b3, voffB); PG8_STAGE(PG8_SB(1, 1), b3 + hstepB, voffB); PG8_STAGE_A(PG8_SA(1, 0), 0, a3);
            PG8_WAIT_V(8); PG8_WAIT_L(0); PG8_BAR; PG8_MMA(1, 0, At, B0); PG8_MMA(1, 1, At, B1); PG8_BAR; PG8_SCHED;
        }
        if (wr == 0) PG8_BAR;
        if constexpr (Epi::NPRE > 0) {
#pragma unroll
            for (int ai = 0; ai < 2; ++ai) {
                u32x4 pre[8 * Epi::NPRE];
#pragma unroll
                for (int m = 0; m < 4; ++m)
#pragma unroll
                    for (int bj = 0; bj < 2; ++bj) E.pre(cur, ai * HALF + wr * 64 + m * 16 + fr, bj * HALF + wc * 32 + 8 * fq, &pre[(m * 2 + bj) * Epi::NPRE]);
                PG8_SCHED;
#pragma unroll
                for (int m = 0; m < 4; ++m)
#pragma unroll
                    for (int bj = 0; bj < 2; ++bj) E.post(cur, ai * HALF + wr * 64 + m * 16 + fr, bj * HALF + wc * 32 + 8 * fq, acc[ai][bj][m][0], acc[ai][bj][m][1], &pre[(m * 2 + bj) * Epi::NPRE]);
                PG8_SCHED;
            }
        } else {
#pragma unroll
        for (int ai = 0; ai < 2; ++ai)
#pragma unroll
            for (int m = 0; m < 4; ++m)
#pragma unroll
                for (int bj = 0; bj < 2; ++bj) E(cur, ai * HALF + wr * 64 + m * 16 + fr, bj * HALF + wc * 32 + 8 * fq, acc[ai][bj][m][0], acc[ai][bj][m][1]);
        }
        if (!has_next) break;
#pragma unroll
        for (int a = 0; a < 2; ++a)
#pragma unroll
            for (int b = 0; b < 2; ++b)
#pragma unroll
                for (int m = 0; m < 4; ++m)
#pragma unroll
                    for (int n = 0; n < 2; ++n) acc[a][b][m][n] = (f32x4){0.f, 0.f, 0.f, 0.f};
        cur = nxt; cA = nA; cB = nB; ++ui;
        if (wr == 1) PG8_BAR;
    }
    PG8_WAIT_V(0);
    PG8_BAR;
#undef PG8_SA
#undef PG8_SB
#undef PG8_STAGE
#undef PG8_STAGE_A
#undef PG8_LOADOFF
#undef PG8_LDA
#undef PG8_LDB
#undef PG8_MMA
#undef PG8_WAIT_V
#undef PG8_WAIT_L
#undef PG8_BAR
#undef PG8_SCHED
}
}

template <class Sched, class Epi>
__device__ __forceinline__ void gemm_dense(unsigned char* lds, const Sched& S, const Epi& E) {
    pg8::gemm_phase<false>((LAS unsigned char*)lds, (const LAS unsigned*)nullptr, S, E, S.lda, S.K, S.K);
    __syncthreads();
}
template <class Sched, class Epi>
__device__ __forceinline__ void gemm_dense_bdiag(unsigned char* lds, const Sched& S, const Epi& E) {
    pg8::gemm_phase<false, Sched, Epi, true>((LAS unsigned char*)lds, (const LAS unsigned*)nullptr, S, E, S.lda, S.K, S.K);
    __syncthreads();
}


template <bool GATHER, class Epi>
__device__ __forceinline__ void gemm_moe(unsigned char* lds, const MoeSched& S, const Epi& E) {
    LAS unsigned* rowtab = (LAS unsigned*)(lds + MISC_OFF + 256);
    if (GATHER) {
        for (int r0 = 0; r0 < 10; r0 += 5) {
            const int* rp[5]; int nv[5]; bool ok[5]; int v[5];
#pragma unroll
            for (int q = 0; q < 5; ++q) { UnitInfo u; ok[q] = S.next(r0 + q, u); rp[q] = u.rows; nv[q] = ok[q] ? u.nvalid : 0; }
#pragma unroll
            for (int q = 0; q < 5; ++q) v[q] = (threadIdx.x < 256 && (int)threadIdx.x < nv[q]) ? rp[q][threadIdx.x] : 0;
#pragma unroll
            for (int q = 0; q < 5; ++q) if (ok[q] && threadIdx.x < 256) rowtab[(r0 + q) * 256 + threadIdx.x] = (unsigned)(v[q] >> 1) * (unsigned)(S.K * 2);
            if (!ok[4]) break;
        }
        __syncthreads();
    }
    pg8::gemm_phase<GATHER>((LAS unsigned char*)lds, (const LAS unsigned*)rowtab, S, E, S.K, S.K, S.K);
    __syncthreads();
}

__device__ __forceinline__ u32x4 pack8(f32x4 a, f32x4 b) { u32x4 w; w.x = pk2(a.x, a.y); w.y = pk2(a.z, a.w); w.z = pk2(b.x, b.y); w.w = pk2(b.z, b.w); return w; }
struct EpiStoreBf16 {
    static constexpr int NPRE = 0;
    bf16_t* O; int ldc; int coff; const float* colscale;
    __device__ __forceinline__ void operator()(const UnitInfo& u, int r, int c, f32x4 v0, f32x4 v1) const {
        const int col = u.pn * 256 + c;
        if (colscale) { const f32x4 s0 = *(const f32x4*)(colscale + col), s1 = *(const f32x4*)(colscale + col + 4); v0 *= s0; v1 *= s1; }
        *(u32x4*)(O + (size_t)(u.orow0 + r) * ldc + coff + col) = pack8(v0, v1);
    }
};

__device__ __forceinline__ float ret_log2g(int h) { return log2f(1.0f - exp2f(-5.0f - (float)h)); }
struct EpiZ0 {
    static constexpr int NPRE = 0;
    bf16_t* O;
    __device__ __forceinline__ void operator()(const UnitInfo& u, int r, int c, f32x4 v0, f32x4 v1) const {
        const int col = u.pn * 256 + c, row = u.orow0 + r;
        if (col < 1024) { const float e = ret_log2g((col >> 7) & 3) * (float)(row & 127); const float sc = exp2f(col < 512 ? e : -e); v0 *= sc; v1 *= sc; }
        *(u32x4*)(O + (size_t)row * ZW + col) = pack8(v0, v1);
    }
};

struct EpiStoreFp8 {
    static constexpr int NPRE = 0;
    unsigned char* O; int ldc;
    __device__ __forceinline__ void operator()(const UnitInfo& u, int r, int c, f32x4 v0, f32x4 v1) const {
        int w0 = __builtin_amdgcn_cvt_pk_fp8_f32(v0.x, v0.y, 0, false); w0 = __builtin_amdgcn_cvt_pk_fp8_f32(v0.z, v0.w, w0, true);
        int w1 = __builtin_amdgcn_cvt_pk_fp8_f32(v1.x, v1.y, 0, false); w1 = __builtin_amdgcn_cvt_pk_fp8_f32(v1.z, v1.w, w1, true);
        u32x2 w; w.x = (unsigned)w0; w.y = (unsigned)w1;
        *(u32x2*)(O + (size_t)(u.orow0 + r) * ldc + u.pn * 256 + c) = w;
    }
};
struct EpiResidB {
    static constexpr int NPRE = 1;
    const bf16_t* X; bf16_t* Yo;
    __device__ __forceinline__ void pre(const UnitInfo& u, int r, int c, u32x4* p) const { p[0] = *(const u32x4*)(X + (size_t)(u.orow0 + r) * DM + u.pn * 256 + c); }
    __device__ __forceinline__ void post(const UnitInfo& u, int r, int c, f32x4 v0, f32x4 v1, const u32x4* p) const {
        const size_t off = (size_t)(u.orow0 + r) * DM + u.pn * 256 + c;
        const u32x4 xw = p[0];
        const f32x4 x0 = {bflo(xw.x), bfhi(xw.x), bflo(xw.y), bfhi(xw.y)}, x1 = {bflo(xw.z), bfhi(xw.z), bflo(xw.w), bfhi(xw.w)};
        *(u32x4*)(Yo + off) = pack8(x0 * ALPHA + v0, x1 * ALPHA + v1);
    }
};

struct EpiGU {
    static constexpr int NPRE = 0;
    bf16_t* ACT;
    __device__ __forceinline__ void operator()(const UnitInfo& u, int r, int c, f32x4 v0, f32x4 v1) const {
        u32x2 w; w.x = pk2(silu_f(v0.x) * v0.y, silu_f(v0.z) * v0.w); w.y = pk2(silu_f(v1.x) * v1.y, silu_f(v1.z) * v1.w);
        *(u32x2*)(ACT + (size_t)(u.orow0 + r) * 512 + u.pn * 128 + (c >> 1)) = w;
    }
};
struct EpiDown {
    static constexpr int NPRE = 0;
    bf16_t* YS;
    __device__ __forceinline__ void operator()(const UnitInfo& u, int r, int c, f32x4 v0, f32x4 v1) const {
        if (r < u.nvalid) { const int pair = u.rows[r]; *(u32x4*)(YS + (size_t)pair * DM + u.pn * 256 + c) = pack8(v0, v1); }
    }
};
struct EpiPle {
    static constexpr int NPRE = 2;
    const bf16_t* XI; const bf16_t* PP; float* OUT; bf16_t* XO;
    __device__ __forceinline__ void pre(const UnitInfo& u, int r, int c, u32x4* p) const {
        const size_t off = (size_t)(u.orow0 + r) * DM + u.pn * 256 + c; p[0] = *(const u32x4*)(PP + off); p[1] = *(const u32x4*)(XI + off); }
    __device__ __forceinline__ void post(const UnitInfo& u, int r, int c, f32x4 v0, f32x4 v1, const u32x4* p) const {
        const size_t off = (size_t)(u.orow0 + r) * DM + u.pn * 256 + c;
        const u32x4 pw = p[0], xw = p[1];
        f32x4 f0 = {bflo(xw.x), bfhi(xw.x), bflo(xw.y), bfhi(xw.y)}, f1 = {bflo(xw.z), bfhi(xw.z), bflo(xw.w), bfhi(xw.w)};
        f0.x += sigmoid_f(v0.x) * bflo(pw.x); f0.y += sigmoid_f(v0.y) * bfhi(pw.x); f0.z += sigmoid_f(v0.z) * bflo(pw.y); f0.w += sigmoid_f(v0.w) * bfhi(pw.y);
        f1.x += sigmoid_f(v1.x) * bflo(pw.z); f1.y += sigmoid_f(v1.y) * bfhi(pw.z); f1.z += sigmoid_f(v1.z) * bflo(pw.w); f1.w += sigmoid_f(v1.w) * bfhi(pw.w);
        if (OUT) { *(f32x4*)(OUT + off) = f0; *(f32x4*)(OUT + off + 4) = f1; }
        if (XO) *(u32x4*)(XO + off) = pack8(f0, f1);
    }
};

struct TrDesc { const float* src; bf16_t* dst; int K, N, Nsrc, nbatch, mode, dst_ld; };
struct TrItem { const float* src; bf16_t* dst; int Nsrc, dst_ld, mode, kb, nb; };
__device__ __forceinline__ void tr_load(const TrItem& t, int lane, float (&tmp)[32]) {
    const int k0 = 64 * t.kb, n0 = 32 * t.nb, Ns = t.Nsrc;
    const bool okc = (n0 + (lane & 31)) < Ns;
    const float* p = t.src + (size_t)(k0 + (lane >> 5)) * Ns + n0 + (lane & 31);
#pragma unroll
    for (int i = 0; i < 32; ++i) { tmp[i] = okc ? __builtin_nontemporal_load(p) : 0.f; p += 2 * Ns; asm volatile("" : "+v"(p)); }
}
__device__ __forceinline__ void tr_store(const TrItem& t, float* scr, int lane, const float (&tmp)[32]) {
    const int k0 = 64 * t.kb, n0 = 32 * t.nb;
#pragma unroll
    for (int i = 0; i < 32; ++i) scr[(2 * i + (lane >> 5)) * 33 + (lane & 31)] = tmp[i];
    LDS_FENCE();
    const int c = lane & 7;
    int n8 = lane >> 3; asm volatile("" : "+v"(n8));
#pragma unroll
    for (int j = 0; j < 4; ++j) {
        const int n = n8 + 8 * j; const float* sp = scr + (8 * c) * 33 + n;
        const int ng = n0 + n;
        float sc = 1.f; int nd = ng; int coff = 0;
        if (t.mode == 1) { if (ng >= 512 && ng < 1024) sc = 0.08838834764831845f; }
        if (t.mode == 2) { nd = (ng < 512) ? 2 * ng : 2 * (ng - 512) + 1; }
        if (t.mode == 3) { coff = ((ng >> 6) & 3) * 256; }
        u32x4 o; o.x = pk2(sp[0 * 33] * sc, sp[1 * 33] * sc); o.y = pk2(sp[2 * 33] * sc, sp[3 * 33] * sc); o.z = pk2(sp[4 * 33] * sc, sp[5 * 33] * sc); o.w = pk2(sp[6 * 33] * sc, sp[7 * 33] * sc);
        *(u32x4*)(t.dst + (size_t)nd * t.dst_ld + coff + k0 + 8 * c) = o;
    }
    LDS_FENCE();
}
__device__ __forceinline__ int tr_items(const TrDesc& d) { return d.nbatch * (d.K / 64) * (d.N / 32); }

constexpr int N_DEFERRED = 32 * 512 + 32 * 256;
__device__ __forceinline__ TrItem deferred_item(const Params& P, int idx) {
    TrItem t;
    if (idx < 32 * 512) { const int b = 32 + (idx >> 9), r = idx & 511;
        t.src = P.in[22] + (size_t)b * 1024 * 1024; t.dst = (bf16_t*)(P.ws + WS_W_GU) + (size_t)b * 1024 * 1024; t.Nsrc = 1024; t.dst_ld = 1024; t.mode = 2; t.kb = r >> 5; t.nb = r & 31; }
    else { const int i2 = idx - 32 * 512, b = 32 + (i2 >> 8), r = i2 & 255;
        t.src = P.in[23] + (size_t)b * 512 * 1024; t.dst = (bf16_t*)(P.ws + WS_W_DN) + (size_t)b * 1024 * 512; t.Nsrc = 1024; t.dst_ld = 512; t.mode = 0; t.kb = r >> 5; t.nb = r & 31; }
    return t;
}
__device__ __forceinline__ void phase_prep(const Params& P, unsigned char* lds) {
    unsigned char* ws = P.ws;
    const int tid = threadIdx.x, lane = tid & 63, wave = tid >> 6;
    const int gw = blockIdx.x * NWAVE + wave, NGW = gridDim.x * NWAVE;
    float* scr = (float*)lds + wave * (64 * 33);
    constexpr int ND = 9;
    TrDesc d[ND];
    d[0] = {P.in[22], (bf16_t*)(ws + WS_W_GU), 1024, 1024, 1024, 32, 2, 1024};
    d[1] = {P.in[23], (bf16_t*)(ws + WS_W_DN), 512, 1024, 1024, 32, 0, 512};
    d[2] = {P.in[2], (bf16_t*)(ws + WS_W_IN0), 1024, 2560, 2560, 1, 1, 1024};
    d[3] = {P.in[6], (bf16_t*)(ws + WS_W_OUT0), 1024, 1024, 1024, 1, 0, 1024};
    d[4] = {P.in[13], (bf16_t*)(ws + WS_W_COUT), 1024, 1024, 1024, 1, 0, 1024};
    d[5] = {P.in[24], (bf16_t*)(ws + WS_W_G), 1024, 1024, 1024, 2, 0, 1024};
    d[6] = {P.in[25], (bf16_t*)(ws + WS_W_P), 256, 1024, 1024, 2, 0, 256};
    d[7] = {P.in[7], (bf16_t*)(ws + WS_W_CIN), 1024, Z1W, CIN, 1, 0, 1024};
    d[8] = {P.in[12], (bf16_t*)(ws + WS_W_UVBD), 256, 1024, 1024, 1, 3, 1024};
    int total = 0;
#pragma unroll
    for (int i = 0; i < ND; ++i) total += tr_items(d[i]);
#define TR_DECODE(it, T) do { int _r = (it); bool _f = false; T = TrItem{nullptr, nullptr, 0, 0, 0, 0, 0}; _Pragma("unroll") for (int _i = 0; _i < ND; ++_i) { const int _n = tr_items(d[_i]); \
            if (!_f && _r < _n) { _f = true; const int _per = (d[_i].K / 64) * (d[_i].N / 32), _b = _r / _per, _q = _r % _per, _nblk = d[_i].N / 32; \
                T.src = d[_i].src + (size_t)_b * d[_i].K * d[_i].Nsrc; T.dst = d[_i].dst + (size_t)_b * d[_i].N * d[_i].dst_ld; T.Nsrc = d[_i].Nsrc; T.dst_ld = d[_i].dst_ld; T.mode = d[_i].mode; T.kb = _q / _nblk; T.nb = _q % _nblk; } \
            if (!_f) _r -= _n; } } while (0)
    {
        float cur[32], nxt[32];
        TrItem tc, tn;
        int it = gw;
        if (it < total) { TR_DECODE(it, tc); tr_load(tc, lane, cur); }
        while (it < total) {
            const int itn = it + NGW;
            if (itn < total) { TR_DECODE(itn, tn); tr_load(tn, lane, nxt); }
            tr_store(tc, scr, lane, cur);
#pragma unroll
            for (int i = 0; i < 32; ++i) cur[i] = nxt[i];
            it = itn; tc = tn;
        }
    }
#undef TR_DECODE
    const size_t gt = (size_t)blockIdx.x * NT + tid, GS = (size_t)gridDim.x * NT;
    {
        bf16_t* o = (bf16_t*)(ws + WS_W_POOL); const float* pw = P.in[4];
        for (size_t i = gt; i < 512 * 256; i += GS) { const int n = (int)(i >> 8), k = (int)(i & 255), g = n >> 7, dd = n & 127, kg = k >> 7, c = k & 127;
            o[i] = (bf16_t)((kg == (g & 1)) ? f2bf(pw[((size_t)g * 128 + c) * 128 + dd]) : 0u); }
    }
    {
        u32x4* o = (u32x4*)(ws + WS_W_UVBD);
        for (size_t i = gt; i < (size_t)1024 * 1024 / 8; i += GS) { const int n = (int)(i >> 7), k = (int)(i & 127) * 8; if (((n >> 6) & 3) != (k >> 8)) o[i] = (u32x4){0u, 0u, 0u, 0u}; }
    }
    {
        bf16_t* o = (bf16_t*)(ws + WS_W_QA); const float* uq = P.in[10]; const float* uk = P.in[11];
        float* Bq = (float*)lds; float* Ak = Bq + 256 * 65;
        for (int item = blockIdx.x; item < 256; item += gridDim.x) {
            const int h = item >> 4, c0 = (item & 15) * 16;
            __syncthreads();
            {   f32x4 v[8];
#pragma unroll
                for (int q = 0; q < 8; ++q) { const int i = tid + NT * q, r = i >> 4, d4 = (i & 15) * 4; v[q] = *(const f32x4*)(uq + (size_t)r * 1024 + h * 64 + d4); }
                f32x4 vk = {0.f, 0.f, 0.f, 0.f};
                if (tid < 256) { const int c = tid >> 4, d4 = (tid & 15) * 4; vk = *(const f32x4*)(uk + (size_t)(c0 + c) * 1024 + h * 64 + d4); }
#pragma unroll
                for (int q = 0; q < 8; ++q) { const int i = tid + NT * q, r = i >> 4, d4 = (i & 15) * 4; float* qd = Bq + r * 65 + d4; qd[0] = v[q].x; qd[1] = v[q].y; qd[2] = v[q].z; qd[3] = v[q].w; }
                if (tid < 256) { const int c = tid >> 4, d4 = (tid & 15) * 4; float* qd = Ak + c * 65 + d4; qd[0] = vk.x; qd[1] = vk.y; qd[2] = vk.z; qd[3] = vk.w; }
            }
            __syncthreads();
            const int r = tid & 255, cg = tid >> 8;
            float acc[8];
#pragma unroll
            for (int j = 0; j < 8; ++j) acc[j] = 0.f;
#pragma unroll 8
            for (int dd = 0; dd < 64; ++dd) { const float bv = Bq[r * 65 + dd];
#pragma unroll
                for (int j = 0; j < 8; ++j) acc[j] += Ak[(cg * 8 + j) * 65 + dd] * bv; }
#pragma unroll
            for (int j = 0; j < 8; ++j) o[(size_t)(h * 256 + c0 + cg * 8 + j) * 256 + r] = (bf16_t)f2bf(acc[j] * 0.125f);
        }
        __syncthreads();
    }
    {
        bf16_t* GT = (bf16_t*)(ws + WS_GT); float* SGB = (float*)(ws + WS_SGB);
        for (size_t i = gt; i < (size_t)2 * 48 * 1024; i += GS) {
            const int l = (int)(i / (48 * 1024)), j = (int)((i / 1024) % 48), c = (int)(i & 1023);
            float w = 0.f;
            if (j < 4) w = P.in[18][(size_t)l * DM * 4 + (size_t)c * 4 + j]; else if (j < 36) w = P.in[20][(size_t)l * DM * 32 + (size_t)c * 32 + (j - 4)];
            const float g = P.in[14][l * DM + c] * w;
            const unsigned hi = f2bf(g); const unsigned lo = f2bf(g - bf2f(hi));
            GT[((size_t)(l * 2 + 0) * 48 + j) * 1024 + c] = (bf16_t)hi; GT[((size_t)(l * 2 + 1) * 48 + j) * 1024 + c] = (bf16_t)lo;
        }
        for (int it = NGW - 1 - gw; it < 96; it += NGW) {
            const int l = it / 48, j = it % 48; float sg = 0.f, sb = 0.f;
#pragma unroll
            for (int c = lane; c < 1024; c += 64) {
                float w = 0.f;
                if (j < 4) w = P.in[18][(size_t)l * DM * 4 + (size_t)c * 4 + j]; else if (j < 36) w = P.in[20][(size_t)l * DM * 32 + (size_t)c * 32 + (j - 4)];
                sg += P.in[14][l * DM + c] * w; sb += P.in[15][l * DM + c] * w;
            }
            sg = wave_sum(sg); sb = wave_sum(sb);
            const float bias = (j < 4) ? P.in[19][l * 4 + j] : ((j < 36) ? P.in[21][l * 32 + (j - 4)] : 0.f);
            if (lane == 0) { SGB[(l * 2 + 0) * 48 + j] = sg; SGB[(l * 2 + 1) * 48 + j] = sb + bias; }
        }
    }
    {
        const f32x4* x = (const f32x4*)P.in[0]; u32x4* xb = (u32x4*)(ws + WS_XB);
        const size_t nx = (size_t)NTOK * DM / 8, np = (size_t)2 * NTOK * 256 / 8;
        size_t i = gt;
        for (; i + 3 * GS < nx; i += 4 * GS) { f32x4 a[8];
#pragma unroll
            for (int q = 0; q < 4; ++q) { a[2 * q] = __builtin_nontemporal_load(x + 2 * (i + q * GS)); a[2 * q + 1] = __builtin_nontemporal_load(x + 2 * (i + q * GS) + 1); }
#pragma unroll
            for (int q = 0; q < 4; ++q) xb[i + q * GS] = pack8(a[2 * q], a[2 * q + 1]); }
        for (; i < nx; i += GS) xb[i] = pack8(x[2 * i], x[2 * i + 1]);
        const f32x4* p = (const f32x4*)P.in[1]; u32x4* pb = (u32x4*)(ws + WS_PB);
        i = gt;
        for (; i + 3 * GS < np; i += 4 * GS) { f32x4 a[8];
#pragma unroll
            for (int q = 0; q < 4; ++q) { a[2 * q] = __builtin_nontemporal_load(p + 2 * (i + q * GS)); a[2 * q + 1] = __builtin_nontemporal_load(p + 2 * (i + q * GS) + 1); }
#pragma unroll
            for (int q = 0; q < 4; ++q) pb[i + q * GS] = pack8(a[2 * q], a[2 * q + 1]); }
        for (; i < np; i += GS) pb[i] = pack8(p[2 * i], p[2 * i + 1]);
    }
}


template <bool DRY>
__device__ __forceinline__ void phase_ln_route(const Params& P, unsigned char* lds, int layer) {
    using pg8::bf16x8;
    const bf16_t* F = (const bf16_t*)(P.ws + WS_F); bf16_t* XB = (bf16_t*)(P.ws + (DRY ? WS_M0 + 128 * MiB : WS_XB));
    float* TOKG = (float*)(P.ws + WS_TOKG); int* LIST = (int*)(P.ws + WS_LIST);
    int* CNT = (int*)(P.ws + WS_CTL + CTL_CNT_OFF) + layer * 32 * CNT_STRIDE;
    const float* lg = P.in[14] + layer * DM; const float* lb = P.in[15] + layer * DM;
    const bf16_t* GTh = (const bf16_t*)(P.ws + WS_GT) + (size_t)(layer * 2) * 48 * 1024; const bf16_t* GTl = GTh + 48 * 1024;
    const float* SG = (const float*)(P.ws + WS_SGB) + (layer * 2) * 48; const float* BB = SG + 48;
    const int tid = threadIdx.x, lane = tid & 63, wave = tid >> 6, r16 = lane & 15, g = lane >> 4;
    int* dec = (int*)lds;
    int* rank = dec + 256;
    int* lcnt = rank + 256;
    int* lbase = lcnt + 32;
    float* SS = (float*)(lds + 4096);
    float* stat = SS + wave * 32;
    float* LGs = (float*)(lds + 8192);
    float* LG = LGs + wave * (16 * 52);
    float* PP_ = (float*)(lds + 36864);
    float* PS = (float*)(lds + 36864 + 8 * 64 * 52 * 4);
    for (int rb = blockIdx.x; rb < NTOK / 128; rb += gridDim.x) {
        if (tid < 32) lcnt[tid] = 0;
        __syncthreads();
        const int tbase = rb * 128 + wave * 16;
        {
            bf16x8 GH[12], GL[12];
            {   int r16l = r16; asm volatile("" : "+v"(r16l));
                const bf16_t* hp = GTh + (size_t)r16l * 1024 + 128 * wave + 8 * g; const bf16_t* lp = GTl + (size_t)r16l * 1024 + 128 * wave + 8 * g;
#pragma unroll
                for (int ks = 0; ks < 4; ++ks)
#pragma unroll
                    for (int i = 0; i < 3; ++i) { GH[ks * 3 + i] = *(const bf16x8*)(hp + (size_t)i * 16 * 1024 + 32 * ks); GL[ks * 3 + i] = *(const bf16x8*)(lp + (size_t)i * 16 * 1024 + 32 * ks); } }
            const bf16_t* yp = F + (size_t)(rb * 128 + r16) * DM + 128 * wave + 8 * g;
#pragma unroll 1
            for (int half = 0; half < ((DRY && PROBE_LN == 1) ? 0 : 2); ++half) {
#pragma unroll 1
              for (int rp = 0; rp < 2; ++rp) {
                u32x4 YW[8];
#pragma unroll
                for (int rt2 = 0; rt2 < 2; ++rt2) {
#pragma unroll
                    for (int ks = 0; ks < 4; ++ks) YW[rt2 * 4 + ks] = *(const u32x4*)(yp + 32 * ks);
                    yp += 16 * DM; asm volatile("" : "+v"(yp)); }
                __builtin_amdgcn_sched_barrier(0);
#pragma unroll
                for (int rt2 = 0; rt2 < 2; ++rt2) {
                    const int rt4 = rp * 2 + rt2;
                    f32x4 acc[3];
#pragma unroll
                    for (int i = 0; i < 3; ++i) acc[i] = (f32x4){0.f, 0.f, 0.f, 0.f};
                    float sm = 0.f, sq = 0.f;
#pragma unroll
                    for (int ks = 0; ks < 4; ++ks) {
                        const u32x4 yw = YW[rt2 * 4 + ks];
                        const float y0 = bflo(yw.x), y1 = bfhi(yw.x), y2 = bflo(yw.y), y3 = bfhi(yw.y), y4 = bflo(yw.z), y5 = bfhi(yw.z), y6 = bflo(yw.w), y7 = bfhi(yw.w);
                        sm += (y0 + y1) + (y2 + y3) + (y4 + y5) + (y6 + y7);
                        sq += (y0 * y0 + y1 * y1) + (y2 * y2 + y3 * y3) + (y4 * y4 + y5 * y5) + (y6 * y6 + y7 * y7);
                        const bf16x8 yh = __builtin_bit_cast(bf16x8, yw);
#pragma unroll
                        for (int i = 0; i < 3; ++i) {
                            acc[i] = __builtin_amdgcn_mfma_f32_16x16x32_bf16(yh, GH[ks * 3 + i], acc[i], 0, 0, 0);
                            acc[i] = __builtin_amdgcn_mfma_f32_16x16x32_bf16(yh, GL[ks * 3 + i], acc[i], 0, 0, 0);
                        }
                    }
                    sm += __shfl_xor(sm, 16); sm += __shfl_xor(sm, 32); sq += __shfl_xor(sq, 16); sq += __shfl_xor(sq, 32);
                    if (g == 0) { PS[(wave * 64 + 16 * rt4 + r16) * 2] = sm; PS[(wave * 64 + 16 * rt4 + r16) * 2 + 1] = sq; }
#pragma unroll
                    for (int i = 0; i < 3; ++i)
#pragma unroll
                        for (int r = 0; r < 4; ++r) PP_[(wave * 64 + 16 * rt4 + 4 * g + r) * 52 + 16 * i + r16] = acc[i][r];
                }
                __builtin_amdgcn_sched_barrier(0);
              }
                __syncthreads();
#pragma unroll
                for (int q = 0; q < 6; ++q) { const int idx = tid + NT * q, row = idx / 48, col = idx - row * 48;
                    float a = 0.f;
#pragma unroll
                    for (int w = 0; w < 8; ++w) a += PP_[(w * 64 + row) * 52 + col];
                    LGs[(half * 64 + row) * 52 + col] = a; }
                if (tid < 128) { float a = 0.f;
#pragma unroll
                    for (int w = 0; w < 8; ++w) a += PS[w * 128 + tid];
                    SS[half * 128 + tid] = a; }
                __syncthreads();
            }
        }
        {
            int tid_l = tid; asm volatile("" : "+v"(tid_l));
            const int t = tid_l >> 2, c0 = (tid_l & 3) * 12;
            const float s1 = SS[t * 2], s2 = SS[t * 2 + 1];
            const float mean = s1 * (1.0f / DM), var = fmaxf(s2 * (1.0f / DM) - mean * mean, 0.f), rstd = 1.0f / sqrtf(var + LN_EPS);
#pragma unroll
            for (int c = 0; c < 12; ++c) LGs[t * 52 + c0 + c] = rstd * (LGs[t * 52 + c0 + c] - mean * SG[c0 + c]) + BB[c0 + c];
            __syncthreads();
            if ((tid_l & 3) == 0) { SS[t * 2] = mean; SS[t * 2 + 1] = rstd; }
        }
        __syncthreads();
        if (lane < 16) {
            const float* lr = LG + lane * 52; const int rl = wave * 16 + lane, t = tbase + lane;
            float gl4[4];
#pragma unroll
            for (int j = 0; j < 4; ++j) gl4[j] = lr[j];
            int grp = 0; float gm = gl4[0];
#pragma unroll
            for (int j = 1; j < 4; ++j) if (gl4[j] > gm) { gm = gl4[j]; grp = j; }
            float gs = 0.f;
#pragma unroll
            for (int j = 0; j < 4; ++j) gs += __expf(gl4[j] - gm);
            const float gwt = 1.0f / gs;
            float el[8];
#pragma unroll
            for (int j = 0; j < 8; ++j) el[j] = lr[4 + grp * 8 + j];
            int i0 = 0; float m0 = el[0];
#pragma unroll
            for (int j = 1; j < 8; ++j) if (el[j] > m0) { m0 = el[j]; i0 = j; }
            int i1 = -1; float m1 = -INFINITY;
#pragma unroll
            for (int j = 0; j < 8; ++j) if (j != i0 && el[j] > m1) { m1 = el[j]; i1 = j; }
            const float ex = __expf(m1 - m0);
            const float p0 = 1.0f / (1.0f + ex), p1 = ex / (1.0f + ex);
            dec[rl * 2] = grp * 8 + i0; dec[rl * 2 + 1] = grp * 8 + i1;
            if (!DRY) { TOKG[(size_t)t * 2] = gwt * p0; TOKG[(size_t)t * 2 + 1] = gwt * p1; }
        }
        int lane_l = lane; asm volatile("" : "+v"(lane_l));
        f32x4 g4[4], b4[4];
#pragma unroll
        for (int j = 0; j < 2; ++j) { g4[2 * j] = *(const f32x4*)(lg + 512 * j + 8 * lane_l); g4[2 * j + 1] = *(const f32x4*)(lg + 512 * j + 8 * lane_l + 4);
                                      b4[2 * j] = *(const f32x4*)(lb + 512 * j + 8 * lane_l); b4[2 * j + 1] = *(const f32x4*)(lb + 512 * j + 8 * lane_l + 4); }
#pragma unroll 1
        for (int rg = 0; rg < ((DRY && PROBE_LN == 2) ? 0 : 2); ++rg) {
            const bf16_t* fr = F + (size_t)(tbase + 8 * rg) * DM + 8 * lane_l; bf16_t* xo = XB + (size_t)(tbase + 8 * rg) * DM + 8 * lane_l;
            u32x4 yv[16];
#pragma unroll
            for (int r8 = 0; r8 < 8; ++r8) {
#pragma unroll
                for (int j = 0; j < 2; ++j) yv[2 * r8 + j] = *(const u32x4*)(fr + 512 * j);
                fr += DM; asm volatile("" : "+v"(fr)); }
            __builtin_amdgcn_sched_barrier(0);
#pragma unroll
            for (int r8 = 0; r8 < 8; ++r8) { const int r = 8 * rg + r8;
                const float mu = stat[r * 2], rs = stat[r * 2 + 1];
#pragma unroll
                for (int j = 0; j < 2; ++j) {
                    const u32x4 yw = yv[2 * r8 + j];
                    const f32x4 ya = {bflo(yw.x), bfhi(yw.x), bflo(yw.y), bfhi(yw.y)}, yb = {bflo(yw.z), bfhi(yw.z), bflo(yw.w), bfhi(yw.w)};
                    const f32x4 va = (ya - mu) * rs * g4[2 * j] + b4[2 * j], vb = (yb - mu) * rs * g4[2 * j + 1] + b4[2 * j + 1];
                    u32x4 w; w.x = pk2(va.x, va.y); w.y = pk2(va.z, va.w); w.z = pk2(vb.x, vb.y); w.w = pk2(vb.z, vb.w); *(u32x4*)(xo + 512 * j) = w; }
                xo += DM; asm volatile("" : "+v"(xo)); }
        }
        __syncthreads();
        if (tid < 256) rank[tid] = atomicAdd(&lcnt[dec[tid]], 1);
        __syncthreads();
        if (tid < 32) { int te = tid; asm volatile("" : "+v"(te)); lbase[tid] = DRY ? 0 : atomicAdd(&CNT[te * CNT_STRIDE], lcnt[tid]); }
        __syncthreads();
        if (!DRY && tid < 256) { const int e = dec[tid]; LIST[(size_t)e * LIST_CAP + lbase[e] + rank[tid]] = (rb * 128 + (tid >> 1)) * 2 + (tid & 1); }
        __syncthreads();
    }
}
__device__ __forceinline__ void moe_setup(const Params& P, int* tb, int layer) {
    const int* CNT = (const int*)(P.ws + WS_CTL + CTL_CNT_OFF) + layer * 32 * CNT_STRIDE;
    if (threadIdx.x < 64) {
        const int e = (int)threadIdx.x;
        const unsigned tiles = (e < 32) ? (unsigned)((CNT[e * CNT_STRIDE] + 255) >> 8) : 0u;
        const unsigned inc = WAVE_SCAN_DPP(tiles);
        if (e < 32) tb[e] = (int)(inc - tiles);
        if (e == 31) tb[32] = (int)inc;
    }
    __syncthreads();
}
template <bool DRY>
__device__ __forceinline__ void phase_ln2(const Params& P, int layer) {
    const bf16_t* XI = (const bf16_t*)(P.ws + WS_XB); bf16_t* XO = (bf16_t*)(P.ws + (DRY ? WS_XB2 : WS_XB));
    const bf16_t* YS = (const bf16_t*)(P.ws + WS_YS); const float* TOKG = (const float*)(P.ws + WS_TOKG);
    const float* lg = P.in[16] + layer * DM; const float* lb = P.in[17] + layer * DM;
    const int lane = threadIdx.x & 63, gw = blockIdx.x * NWAVE + (threadIdx.x >> 6), NGW = gridDim.x * NWAVE;
    f32x4 g4[4], b4[4];
#pragma unroll
    for (int j = 0; j < 4; ++j) { g4[j] = *(const f32x4*)(lg + 256 * j + 4 * lane); b4[j] = *(const f32x4*)(lb + 256 * j + 4 * lane); }
    u32x2 nx[4], na[4], nb[4]; float ng0 = 0.f, ng1 = 0.f;
    if (gw < NTOK) { const int t = gw;
#pragma unroll
        for (int j = 0; j < 4; ++j) { const int c0 = 256 * j + 4 * lane; nx[j] = *(const u32x2*)(XI + (size_t)t * DM + c0); na[j] = *(const u32x2*)(YS + (size_t)(2 * t) * DM + c0); nb[j] = *(const u32x2*)(YS + (size_t)(2 * t + 1) * DM + c0); }
        ng0 = TOKG[(size_t)t * 2]; ng1 = TOKG[(size_t)t * 2 + 1]; }
    for (int t = gw; t < NTOK; t += NGW) {
        const float g0 = ng0, g1 = ng1;
        u32x2 xw[4], aw[4], bw[4];
#pragma unroll
        for (int j = 0; j < 4; ++j) { xw[j] = nx[j]; aw[j] = na[j]; bw[j] = nb[j]; }
        if (t + NGW < NTOK) { const int tn = t + NGW;
#pragma unroll
            for (int j = 0; j < 4; ++j) { const int c0 = 256 * j + 4 * lane; nx[j] = *(const u32x2*)(XI + (size_t)tn * DM + c0); na[j] = *(const u32x2*)(YS + (size_t)(2 * tn) * DM + c0); nb[j] = *(const u32x2*)(YS + (size_t)(2 * tn + 1) * DM + c0); }
            ng0 = TOKG[(size_t)tn * 2]; ng1 = TOKG[(size_t)tn * 2 + 1]; }
        f32x4 v[4]; float s = 0.f;
#pragma unroll
        for (int j = 0; j < 4; ++j) {
            const u32x2 x = xw[j], a = aw[j], b = bw[j];
            v[j].x = bflo(x.x) * ALPHA + g0 * bflo(a.x) + g1 * bflo(b.x); v[j].y = bfhi(x.x) * ALPHA + g0 * bfhi(a.x) + g1 * bfhi(b.x);
            v[j].z = bflo(x.y) * ALPHA + g0 * bflo(a.y) + g1 * bflo(b.y); v[j].w = bfhi(x.y) * ALPHA + g0 * bfhi(a.y) + g1 * bfhi(b.y);
            s += (v[j].x + v[j].y) + (v[j].z + v[j].w); }
        const float mean = wave_sum(s) * (1.0f / DM); float s2 = 0.f;
#pragma unroll
        for (int j = 0; j < 4; ++j) { v[j] = v[j] - mean; s2 += (v[j].x * v[j].x + v[j].y * v[j].y) + (v[j].z * v[j].z + v[j].w * v[j].w); }
        const float rstd = 1.0f / sqrtf(wave_sum(s2) * (1.0f / DM) + LN_EPS);
#pragma unroll
        for (int j = 0; j < 4; ++j) { const int c0 = 256 * j + 4 * lane;
            v[j] = v[j] * rstd * g4[j] + b4[j];
            u32x2 w; w.x = pk2(v[j].x, v[j].y); w.y = pk2(v[j].z, v[j].w); *(u32x2*)(XO + (size_t)t * DM + c0) = w; }
    }
}

__device__ __forceinline__ unsigned e5m2enc(float y) {
    const unsigned hb = (unsigned)__builtin_bit_cast(unsigned short, (_Float16)y);
    return ((hb + 0x7fu + ((hb >> 8) & 1u)) >> 8) & 0xffu;
}
__device__ __forceinline__ void phase_norms(const Params& P) {
    const bf16_t* Z1 = (const bf16_t*)(P.ws + WS_Z1); bf16_t* CQ = (bf16_t*)(P.ws + WS_CQ); unsigned char* CKV8 = (unsigned char*)(P.ws + WS_CKV8);
    const float* qn = P.in[8]; const float* kn = P.in[9];
    const int lane = threadIdx.x & 63, gw = blockIdx.x * NWAVE + (threadIdx.x >> 6), NGW = gridDim.x * NWAVE;
    const f32x4 gq = *(const f32x4*)(qn + 4 * lane), gk = *(const f32x4*)(kn + 4 * lane);
    for (int t0 = gw; t0 < NTOK; t0 += 2 * NGW) {
        const int t1 = (t0 + NGW < NTOK) ? t0 + NGW : t0;
        const u32x2 a0 = *(const u32x2*)(Z1 + (size_t)t0 * Z1W + 4 * lane), b0 = *(const u32x2*)(Z1 + (size_t)t0 * Z1W + 256 + 4 * lane);
        const u32x2 a1 = *(const u32x2*)(Z1 + (size_t)t1 * Z1W + 4 * lane), b1 = *(const u32x2*)(Z1 + (size_t)t1 * Z1W + 256 + 4 * lane);
#pragma unroll
        for (int s = 0; s < 2; ++s) {
            const int t = s ? t1 : t0; const u32x2 a = s ? a1 : a0, b = s ? b1 : b0;
            const float q[4] = {bflo(a.x), bfhi(a.x), bflo(a.y), bfhi(a.y)}, k[4] = {bflo(b.x), bfhi(b.x), bflo(b.y), bfhi(b.y)};
            const float sq = wave_sum(q[0] * q[0] + q[1] * q[1] + q[2] * q[2] + q[3] * q[3]), sk = wave_sum(k[0] * k[0] + k[1] * k[1] + k[2] * k[2] + k[3] * k[3]);
            const float rq = 1.0f / sqrtf(sq * (1.0f / 256.0f) + 1e-6f), rk = 1.0f / sqrtf(sk * (1.0f / 256.0f) + 1e-6f);
            u32x2 o; o.x = pk2(q[0] * rq * gq.x, q[1] * rq * gq.y); o.y = pk2(q[2] * rq * gq.z, q[3] * rq * gq.w);
            *(u32x2*)(CQ + (size_t)t * 256 + 4 * lane) = o;
            *(unsigned*)(CKV8 + (size_t)t * 256 + 4 * lane) = e5m2enc(k[0] * rk * gk.x) | (e5m2enc(k[1] * rk * gk.y) << 8) | (e5m2enc(k[2] * rk * gk.z) << 16) | (e5m2enc(k[3] * rk * gk.w) << 24);
        }
    }
}


constexpr int NPH_TOTAL = 23;


typedef short v4i16_t __attribute__((ext_vector_type(4)));


__device__ __forceinline__ void glds16(const void* gsrc, unsigned lds_dst) {
    unsigned keep;
    asm volatile("s_mov_b32 %0, m0\n\ts_mov_b32 m0, %2\n\ts_nop 0\n\tglobal_load_lds_dwordx4 %1, off\n\ts_mov_b32 m0, %0" : "=&s"(keep) : "v"(gsrc), "s"(lds_dst) : "memory");
}
__device__ __forceinline__ void glds16_set(const void* gsrc, unsigned lds_dst) {
    asm volatile("s_mov_b32 m0, %1\n\ts_nop 0\n\tglobal_load_lds_dwordx4 %0, off" : : "v"(gsrc), "s"(lds_dst) : "memory", "m0");
}
template <int OFF> __device__ __forceinline__ void glds16_m0(const void* gsrc) {
    asm volatile("global_load_lds_dwordx4 %0, off offset:%1" : : "v"(gsrc), "n"(OFF) : "memory");
}
__device__ __forceinline__ void glds16s_set(const void* sbase, unsigned voff, unsigned lds_dst) {
    asm volatile("s_mov_b32 m0, %2\n\ts_nop 0\n\tglobal_load_lds_dwordx4 %0, %1" : : "v"(voff), "s"(sbase), "s"(lds_dst) : "memory", "m0");
}
template <int OFF> __device__ __forceinline__ void glds16s_m0(const void* sbase, unsigned voff) {
    asm volatile("global_load_lds_dwordx4 %0, %1 offset:%2" : : "v"(voff), "s"(sbase), "n"(OFF) : "memory");
}
typedef _Float16 f16x8 __attribute__((ext_vector_type(8)));
typedef int v8i_t __attribute__((ext_vector_type(8)));
template <bool DRY>
__device__ __forceinline__ void phase_sparse_attn_e(const Params& P, unsigned char* lds_) {
    const unsigned char* QA = (const unsigned char*)(P.ws + WS_QA); bf16_t* OLAT = (bf16_t*)(P.ws + WS_OLAT); const unsigned char* CKV8 = (const unsigned char*)(P.ws + WS_CKV8); const unsigned short* SEL = (const unsigned short*)(P.ws + WS_SEL);
    const int tid = threadIdx.x, lane = tid & 63, wave = __builtin_amdgcn_readfirstlane(tid >> 6);
    const int fr = lane & 15, fq = lane >> 4;
    LAS unsigned char* cbuf = (LAS unsigned char*)lds_ + wave * 17920;
    LAS unsigned short* selw = (LAS unsigned short*)(cbuf + 16384);
    LAS unsigned* selo = (LAS unsigned*)(cbuf + 16384 + 512);
    LAS unsigned* selo_st = selo + (lane >> 3) * 32 + (lane & 7);
    const unsigned cbuf0 = (unsigned)(unsigned long)cbuf;
    const int G = gridDim.x, NGW = G * NWAVE;
    int vw;
    if ((G & 7) == 0) vw = (((int)blockIdx.x & 7) * (G >> 3) + ((int)blockIdx.x >> 3)) * NWAVE + wave; else vw = (int)blockIdx.x * NWAVE + wave;
    const float LOG2E = 1.4426950408889634f;
    const float slope2 = exp2f(-0.5f * (float)(fr + 1)) * LOG2E;
    unsigned qoffB[4];
#pragma unroll
    for (int e = 0; e < 4; ++e) { const int r15 = (4 * e + fq) & 15; qoffB[e] = (unsigned)((fr ^ (((r15 & 7) << 1) | (r15 >> 3))) << 4); }
    unsigned qoffS[4];
#pragma unroll
    for (int e = 0; e < 4; ++e) qoffS[e] = qoffB[e] + 3072u - 1024u * e;
    const unsigned fA = (unsigned)(((fr & 7) << 1) | (fr >> 3));
    const unsigned SA = (fA & 14u) << 4, baseA = (unsigned)fr * 256u + ((((unsigned)fq >> 1) ^ (fA & 1u)) << 4) + ((unsigned)fq & 1u) * 8u;
    const int rT = 4 * fq + (fr >> 2), pT_ = fr & 3;
    const unsigned fT = (unsigned)(((rT & 7) << 1) | (rT >> 3));
    const unsigned ST = (fT & 14u) << 4, baseT = (unsigned)rT * 256u + ((((unsigned)pT_ >> 1) ^ (fT & 1u)) << 4) + ((unsigned)pT_ & 1u) * 8u;
    const int per = NGW >> 2, bq = vw / per, wb = vw % per;
    int ditem = DRY ? N_DEFERRED : vw;
    u32x2 selnext = {0u, 0u}; long qfn[8];
    if (wb < SEQ) { const int t0 = bq * SEQ + wb; selnext = *(const u32x2*)(SEL + (size_t)t0 * TOPK + 4 * lane);
#pragma unroll
        for (int cc = 0; cc < 8; ++cc) qfn[cc] = *(const long*)(QA + (size_t)t0 * 4096 + fr * 256 + 32 * cc + 8 * fq); }
    for (int tl0 = wb; tl0 < SEQ; tl0 += per) {
        const int t = bq * SEQ + tl0;
        const int b = t >> 13, tl = t & (SEQ - 1), ns = min(tl + 1, TOPK), nch = (ns + 31) >> 5;
        const bool has_nextq = (tl0 + per < SEQ);
        asm volatile("s_waitcnt vmcnt(0)" ::: "memory");
        {
            const u32x2 w = selnext;
            unsigned short i0 = (unsigned short)(w.x & 0xffffu), i1 = (unsigned short)(w.x >> 16), i2 = (unsigned short)(w.y & 0xffffu), i3 = (unsigned short)(w.y >> 16);
            const int k0 = 4 * lane;
            if (k0 >= ns) i0 = 0; if (k0 + 1 >= ns) i1 = 0; if (k0 + 2 >= ns) i2 = 0; if (k0 + 3 >= ns) i3 = 0;
            u32x2 o; o.x = (unsigned)i0 | ((unsigned)i1 << 16); o.y = (unsigned)i2 | ((unsigned)i3 << 16);
            asm volatile("s_waitcnt lgkmcnt(0)" ::: "memory");
            *(LAS u32x2*)(selw + 4 * lane) = o;
            selo_st[0] = (unsigned)i0 << 8; selo_st[8] = (unsigned)i1 << 8; selo_st[16] = (unsigned)i2 << 8; selo_st[24] = (unsigned)i3 << 8;
        }
        v8i_t qB[2];
#pragma unroll
        for (int cc = 0; cc < 8; ++cc) { const u32x2 qw = __builtin_bit_cast(u32x2, qfn[cc]); qB[cc >> 2][2 * (cc & 3)] = (int)qw.x; qB[cc >> 2][2 * (cc & 3) + 1] = (int)qw.y; }
#define ATT_PREFETCH() do { if (has_nextq) { const int tn_ = t + per; selnext = *(const u32x2*)(SEL + (size_t)tn_ * TOPK + 4 * lane); \
            _Pragma("unroll") for (int cc = 0; cc < 8; ++cc) qfn[cc] = *(const long*)(QA + (size_t)tn_ * 4096 + fr * 256 + 32 * cc + 8 * fq); pf = true; } } while (0)
        f32x4 Oe[8], Oo[8];
#pragma unroll
        for (int ut = 0; ut < 8; ++ut) { Oe[ut] = (f32x4){0.f, 0.f, 0.f, 0.f}; Oo[ut] = (f32x4){0.f, 0.f, 0.f, 0.f}; }
        float m = -INFINITY, l = 0.f;
        const unsigned char* cb = CKV8 + (size_t)b * SEQ * 256;
        asm volatile("s_waitcnt vmcnt(0) lgkmcnt(0)" ::: "memory");
        const unsigned char* cbs = cb - 3072;
#define ATT_DMA(jj, bufoff) do { u32x4 oa_ = *(const LAS u32x4*)(selo + 32 * (jj) + 8 * fq), ob_ = *(const LAS u32x4*)(selo + 32 * (jj) + 8 * fq + 4); \
            if (DRY && PROBE_ATT == 1) { oa_ = (u32x4){0u, 256u, 512u, 768u}; ob_ = oa_; } \
            if (!(DRY && PROBE_ATT == 3)) { \
                glds16s_set(cbs, oa_.x + qoffS[0], (unsigned)__builtin_amdgcn_readfirstlane((int)(cbuf0 + (bufoff)))); \
                glds16s_m0<1024>(cbs, oa_.y + qoffS[1]); glds16s_m0<2048>(cbs, oa_.z + qoffS[2]); glds16s_m0<3072>(cbs, oa_.w + qoffS[3]); \
                glds16s_set(cbs, ob_.x + qoffS[0], (unsigned)__builtin_amdgcn_readfirstlane((int)(cbuf0 + (bufoff) + 4096))); \
                glds16s_m0<1024>(cbs, ob_.y + qoffS[1]); glds16s_m0<2048>(cbs, ob_.z + qoffS[2]); glds16s_m0<3072>(cbs, ob_.w + qoffS[3]); } } while (0)
        ATT_DMA(0, 0);
        if (nch > 1) ATT_DMA(1, 8192);
        const bool have_item = ditem < N_DEFERRED;
        TrItem titem = deferred_item(P, have_item ? ditem : 0);
        float tcur[32];
        bool trf = false, pf = false;
        if (nch <= 2) { if (have_item) { tr_load(titem, lane, tcur); trf = true; } ATT_PREFETCH(); }
        for (int j = 0; j < nch; ++j) {
            const unsigned bo = (unsigned)(j & 1) * 8192u;
            if (j + 1 < nch) { if (trf && pf) asm volatile("s_waitcnt vmcnt(49)" ::: "memory"); else if (trf) asm volatile("s_waitcnt vmcnt(40)" ::: "memory");
                               else if (pf) asm volatile("s_waitcnt vmcnt(17)" ::: "memory"); else asm volatile("s_waitcnt vmcnt(8)" ::: "memory"); }
            else { if (trf && pf) asm volatile("s_waitcnt vmcnt(41)" ::: "memory"); else if (trf) asm volatile("s_waitcnt vmcnt(32)" ::: "memory");
                   else if (pf) asm volatile("s_waitcnt vmcnt(9)" ::: "memory"); else asm volatile("s_waitcnt vmcnt(0)" ::: "memory"); }
            const LAS unsigned char* img = cbuf + bo;
            if (DRY && PROBE_ATT == 2) { if (j + 2 < nch) { asm volatile("s_waitcnt lgkmcnt(0)" ::: "memory"); ATT_DMA(j + 2, bo); } continue; }
            f32x4 s0 = {0.f, 0.f, 0.f, 0.f}, s1 = {0.f, 0.f, 0.f, 0.f};
#pragma unroll
            for (int hb = 0; hb < 2; ++hb) {
                u32x2 ra[4], rb[4];
#pragma unroll
                for (int c4 = 0; c4 < 4; ++c4) { const int cc = hb * 4 + c4; const LAS unsigned char* pa = img + ((SA ^ (unsigned)(cc << 5)) + baseA); ra[c4] = *(const LAS u32x2*)(pa); rb[c4] = *(const LAS u32x2*)(pa + 4096); }
                __builtin_amdgcn_sched_barrier(0);
                v8i_t A0, A1;
#pragma unroll
                for (int c4 = 0; c4 < 4; ++c4) { A0[2 * c4] = (int)ra[c4].x; A0[2 * c4 + 1] = (int)ra[c4].y; A1[2 * c4] = (int)rb[c4].x; A1[2 * c4 + 1] = (int)rb[c4].y; }
                s0 = __builtin_amdgcn_mfma_scale_f32_16x16x128_f8f6f4(A0, qB[hb], s0, 1, 0, 0, 0, 0, 0);
                s1 = __builtin_amdgcn_mfma_scale_f32_16x16x128_f8f6f4(A1, qB[hb], s1, 1, 0, 0, 0, 0, 0);
                __builtin_amdgcn_sched_barrier(0);
            }
            const u32x2 k0w = *(const LAS u32x2*)(selw + 32 * j + 4 * fq), k1w = *(const LAS u32x2*)(selw + 32 * j + 16 + 4 * fq);
            u32x2 tl_[4], th_[4];
#pragma unroll
            for (int ut = 0; ut < 4; ++ut) { const LAS unsigned char* pt = img + ((ST ^ (unsigned)(ut << 5)) + baseT);
                tl_[ut] = __builtin_bit_cast(u32x2, __builtin_amdgcn_ds_read_tr16_b64_v4i16((LAS v4i16_t*)(pt)));
                th_[ut] = __builtin_bit_cast(u32x2, __builtin_amdgcn_ds_read_tr16_b64_v4i16((LAS v4i16_t*)(pt + 4096))); }
            __builtin_amdgcn_sched_barrier(0);
            const int rem = ns - (32 * j + 4 * fq);
            float lg[8];
            {
                const int i00 = (int)(k0w.x & 0xffffu), i01 = (int)(k0w.x >> 16), i02 = (int)(k0w.y & 0xffffu), i03 = (int)(k0w.y >> 16);
                const int i10 = (int)(k1w.x & 0xffffu), i11 = (int)(k1w.x >> 16), i12 = (int)(k1w.y & 0xffffu), i13 = (int)(k1w.y >> 16);
                lg[0] = (0 < rem) ? s0.x * LOG2E - slope2 * (float)(tl - i00) : -INFINITY;
                lg[1] = (1 < rem) ? s0.y * LOG2E - slope2 * (float)(tl - i01) : -INFINITY;
                lg[2] = (2 < rem) ? s0.z * LOG2E - slope2 * (float)(tl - i02) : -INFINITY;
                lg[3] = (3 < rem) ? s0.w * LOG2E - slope2 * (float)(tl - i03) : -INFINITY;
                lg[4] = (16 < rem) ? s1.x * LOG2E - slope2 * (float)(tl - i10) : -INFINITY;
                lg[5] = (17 < rem) ? s1.y * LOG2E - slope2 * (float)(tl - i11) : -INFINITY;
                lg[6] = (18 < rem) ? s1.z * LOG2E - slope2 * (float)(tl - i12) : -INFINITY;
                lg[7] = (19 < rem) ? s1.w * LOG2E - slope2 * (float)(tl - i13) : -INFINITY;
            }
            const float cm = fmaxf(fmaxf(fmaxf(lg[0], lg[1]), fmaxf(lg[2], lg[3])), fmaxf(fmaxf(lg[4], lg[5]), fmaxf(lg[6], lg[7])));
            if (j == 0) { float cx = fmaxf(cm, __shfl_xor(cm, 16)); m = fmaxf(cx, __shfl_xor(cx, 32)); }
            else if (__any(cm > m + 8.0f)) {
                float cx = fmaxf(cm, __shfl_xor(cm, 16)); cx = fmaxf(cx, __shfl_xor(cx, 32));
                const float mn = fmaxf(m, cx);
                const float sc = __builtin_amdgcn_exp2f(m - mn);
                l *= sc;
#pragma unroll
                for (int ut = 0; ut < 8; ++ut) { Oe[ut] *= sc; Oo[ut] *= sc; }
                m = mn;
            }
            float p[8]; float ps = 0.f;
#pragma unroll
            for (int i = 0; i < 8; ++i) { p[i] = __builtin_amdgcn_exp2f(lg[i] - m); ps += p[i]; }
            l += ps;
            int pw0 = __builtin_amdgcn_cvt_pk_fp8_f32(p[0], p[1], 0, false); pw0 = __builtin_amdgcn_cvt_pk_fp8_f32(p[2], p[3], pw0, true);
            int pw1 = __builtin_amdgcn_cvt_pk_fp8_f32(p[4], p[5], 0, false); pw1 = __builtin_amdgcn_cvt_pk_fp8_f32(p[6], p[7], pw1, true);
            const long pk = __builtin_bit_cast(long, (u32x2){(unsigned)pw0, (unsigned)pw1});
#pragma unroll
            for (int hb = 0; hb < 2; ++hb) {
                if (hb == 1) {
#pragma unroll
                    for (int u4 = 0; u4 < 4; ++u4) { const int ut = 4 + u4; const LAS unsigned char* pt = img + ((ST ^ (unsigned)(ut << 5)) + baseT);
                        tl_[u4] = __builtin_bit_cast(u32x2, __builtin_amdgcn_ds_read_tr16_b64_v4i16((LAS v4i16_t*)(pt)));
                        th_[u4] = __builtin_bit_cast(u32x2, __builtin_amdgcn_ds_read_tr16_b64_v4i16((LAS v4i16_t*)(pt + 4096))); }
                    __builtin_amdgcn_sched_barrier(0);
                }
#pragma unroll
                for (int u4 = 0; u4 < 4; ++u4) { const int ut = hb * 4 + u4;
                    const u32x2 lw = tl_[u4], hw = th_[u4];
                    u32x2 ae, ao;
                    ae.x = __builtin_amdgcn_perm(lw.y, lw.x, 0x06040200u); ae.y = __builtin_amdgcn_perm(hw.y, hw.x, 0x06040200u);
                    ao.x = __builtin_amdgcn_perm(lw.y, lw.x, 0x07050301u); ao.y = __builtin_amdgcn_perm(hw.y, hw.x, 0x07050301u);
                    Oe[ut] = __builtin_amdgcn_mfma_f32_16x16x32_bf8_fp8(__builtin_bit_cast(long, ae), pk, Oe[ut], 0, 0, 0);
                    Oo[ut] = __builtin_amdgcn_mfma_f32_16x16x32_bf8_fp8(__builtin_bit_cast(long, ao), pk, Oo[ut], 0, 0, 0);
                }
                __builtin_amdgcn_sched_barrier(0);
            }
            if (j + 2 < nch) { asm volatile("s_waitcnt lgkmcnt(0)" ::: "memory"); ATT_DMA(j + 2, bo);
                if (j + 3 == nch) { if (have_item) { tr_load(titem, lane, tcur); trf = true; } ATT_PREFETCH(); } }
        }
#undef ATT_DMA
#undef ATT_PREFETCH
        l += __shfl_xor(l, 16); l += __shfl_xor(l, 32);
        const float inv = 1.0f / l;
        bf16_t* orow = (DRY ? (bf16_t*)(P.ws + WS_PP) + (size_t)(t & 8191) * 4096 : OLAT + (size_t)t * 4096) + fr * 256 + 8 * fq;
#pragma unroll
        for (int ut = 0; ut < 8; ++ut) {
            u32x4 w; w.x = pk2(Oe[ut].x * inv, Oo[ut].x * inv); w.y = pk2(Oe[ut].y * inv, Oo[ut].y * inv); w.z = pk2(Oe[ut].z * inv, Oo[ut].z * inv); w.w = pk2(Oe[ut].w * inv, Oo[ut].w * inv);
            *(u32x4*)(orow + 32 * ut) = w;
        }
        if (have_item) { asm volatile("s_waitcnt lgkmcnt(0)" ::: "memory"); tr_store(titem, (float*)(lds_ + wave * 17920), lane, tcur); ditem += NGW; }
    }
    int lane_l = lane; asm volatile("" : "+v"(lane_l));
    for (; ditem < N_DEFERRED; ditem += NGW) { const TrItem t = deferred_item(P, ditem); float tmp[32]; tr_load(t, lane_l, tmp); tr_store(t, (float*)(lds_ + wave * 17920), lane_l, tmp); }
}

constexpr size_t SC_BATCH = (size_t)1024 * 256 * 257 / 2;
__device__ __forceinline__ size_t sc_row_off(int b, int tl) { const size_t m = (size_t)(tl >> 5); return (size_t)b * SC_BATCH + 1024 * (m * (m + 1) / 2) + (size_t)(tl & 31) * 32 * (m + 1); }
typedef float f32x16 __attribute__((ext_vector_type(16)));
__device__ __forceinline__ unsigned okey_pk(float a, float b) {
    const unsigned w = __builtin_bit_cast(unsigned, __builtin_amdgcn_cvt_pkrtz(a, b));
    const unsigned neg = (w >> 15) & 0x00010001u;
    return w ^ ((neg * 0xffffu) | 0x80008000u);
}
__device__ __forceinline__ void phase_index_scores(const Params& P, unsigned char* lds_) {
    using pg8::bf16x8;
    const bf16_t* Z1 = (const bf16_t*)(P.ws + WS_Z1); unsigned short* SC = (unsigned short*)(P.ws + WS_SC);
    LAS unsigned char* lds = (LAS unsigned char*)lds_;
    constexpr int QROW = 144;
    LAS unsigned char* QL = lds;
    LAS float* SG = (LAS float*)(lds + 9 * 64 * QROW);
    const int tid = threadIdx.x, lane = tid & 63, wave = __builtin_amdgcn_readfirstlane(tid >> 6);
    LAS unsigned char* ST = lds + 9 * 64 * QROW + 2048 + wave * 5120;
    const int l31 = lane & 31, hh = lane >> 5;
    for (int pid = blockIdx.x; pid < 256; pid += gridDim.x) {
        const int b = pid >> 6;
        for (int side = 0; side < 2; ++side) {
            const int qb = side ? (127 - (pid & 63)) : (pid & 63);
            const int q0 = qb * 64;
            __syncthreads();
            {
                const int qi = tid >> 3, part = tid & 7;
                const bf16_t* zr = Z1 + ((size_t)b * SEQ + q0 + qi) * Z1W;
                const u32x4 ww = *(const u32x4*)(zr + 1088);
                const float w8[8] = {bflo(ww.x), bfhi(ww.x), bflo(ww.y), bfhi(ww.y), bflo(ww.z), bfhi(ww.z), bflo(ww.w), bfhi(ww.w)};
                float wh = 0.f;
#pragma unroll
                for (int h = 0; h < 8; ++h) wh = (h == part) ? w8[h] : wh;
                const float sc = 0.5f * fabsf(wh);
                SG[qi * 8 + part] = (wh >= 0.f) ? 1.0f : -1.0f;
#pragma unroll
                for (int c = 0; c < 8; ++c) {
                    const u32x4 v = *(const u32x4*)(zr + 512 + part * 64 + c * 8);
                    u32x4 o; o.x = pk2(bflo(v.x) * sc, bfhi(v.x) * sc); o.y = pk2(bflo(v.y) * sc, bfhi(v.y) * sc); o.z = pk2(bflo(v.z) * sc, bfhi(v.z) * sc); o.w = pk2(bflo(v.w) * sc, bfhi(v.w) * sc);
                    *(LAS u32x4*)(QL + (part * 64 + qi) * QROW + c * 16) = o;
                }
                float a8[8];
#pragma unroll
                for (int j = 0; j < 8; ++j) a8[j] = 0.f;
#pragma unroll
                for (int h = 0; h < 8; ++h) {
                    const u32x4 v = *(const u32x4*)(zr + 512 + h * 64 + part * 8); const float s2 = 0.5f * w8[h];
                    a8[0] += s2 * bflo(v.x); a8[1] += s2 * bfhi(v.x); a8[2] += s2 * bflo(v.y); a8[3] += s2 * bfhi(v.y);
                    a8[4] += s2 * bflo(v.z); a8[5] += s2 * bfhi(v.z); a8[6] += s2 * bflo(v.w); a8[7] += s2 * bfhi(v.w);
                }
                u32x4 o; o.x = pk2(a8[0], a8[1]); o.y = pk2(a8[2], a8[3]); o.z = pk2(a8[4], a8[5]); o.w = pk2(a8[6], a8[7]);
                *(LAS u32x4*)(QL + (8 * 64 + qi) * QROW + part * 16) = o;
            }
            __syncthreads();
            const int ktmax = 2 * qb + 1;
            bf16x8 kn[4];
            {   const bf16_t* kr = Z1 + ((size_t)b * SEQ + min(wave, ktmax) * 32 + l31) * Z1W + 1024 + hh * 8;
#pragma unroll
                for (int dq = 0; dq < 4; ++dq) kn[dq] = *(const bf16x8*)(kr + dq * 16); }
            for (int kt = wave; kt <= ktmax; kt += NWAVE) {
                bf16x8 kf[4];
#pragma unroll
                for (int dq = 0; dq < 4; ++dq) kf[dq] = kn[dq];
                {   const bf16_t* kr = Z1 + ((size_t)b * SEQ + min(kt + NWAVE, ktmax) * 32 + l31) * Z1W + 1024 + hh * 8;
#pragma unroll
                    for (int dq = 0; dq < 4; ++dq) kn[dq] = *(const bf16x8*)(kr + dq * 16); }
#pragma unroll
                for (int qs = 0; qs < 2; ++qs) {
                    const LAS unsigned char* qrow = QL + (qs * 32 + l31) * QROW + hh * 16;
                    const LAS float* sgp = SG + (qs * 32 + l31) * 8;
                    bf16x8 fc[4], fn[4];
#pragma unroll
                    for (int dq = 0; dq < 4; ++dq) fc[dq] = *(const LAS bf16x8*)(qrow + 8 * 64 * QROW + dq * 32);
#pragma unroll
                    for (int dq = 0; dq < 4; ++dq) fn[dq] = *(const LAS bf16x8*)(qrow + dq * 32);
                    const f32x4 sg03 = *(const LAS f32x4*)(sgp), sg47 = *(const LAS f32x4*)(sgp + 4);
                    f32x16 acc;
#pragma unroll
                    for (int r = 0; r < 16; ++r) acc[r] = 0.f;
#pragma unroll
                    for (int dq = 0; dq < 4; ++dq) acc = __builtin_amdgcn_mfma_f32_32x32x16_bf16(kf[dq], fc[dq], acc, 0, 0, 0);
                    f32x16 up;
#pragma unroll
                    for (int h = 0; h < 8; ++h) {
#pragma unroll
                        for (int dq = 0; dq < 4; ++dq) fc[dq] = fn[dq];
                        if (h < 7) {
#pragma unroll
                            for (int dq = 0; dq < 4; ++dq) fn[dq] = *(const LAS bf16x8*)(qrow + (h + 1) * 64 * QROW + dq * 32);
                        }
                        f32x16 u;
#pragma unroll
                        for (int r = 0; r < 16; ++r) u[r] = 0.f;
#pragma unroll
                        for (int dq = 0; dq < 4; ++dq) u = __builtin_amdgcn_mfma_f32_32x32x16_bf16(kf[dq], fc[dq], u, 0, 0, 0);
                        __builtin_amdgcn_sched_barrier(0);
                        if (h > 0) {
                            const float sg = (h - 1 < 4) ? sg03[(h - 1) & 3] : sg47[(h - 1) & 3];
#pragma unroll
                            for (int r = 0; r < 16; ++r) acc[r] = fmaf(fabsf(up[r]), sg, acc[r]);
                        }
                        __builtin_amdgcn_sched_barrier(0);
                        up = u;
                    }
                    {
                        const float sg = sg47[3];
#pragma unroll
                        for (int r = 0; r < 16; ++r) acc[r] = fmaf(fabsf(up[r]), sg, acc[r]);
                    }
#pragma unroll
                    for (int g = 0; g < 4; ++g) { u32x2 w; w.x = okey_pk(acc[4 * g], acc[4 * g + 1]); w.y = okey_pk(acc[4 * g + 2], acc[4 * g + 3]);
                        *(LAS u32x2*)(ST + (qs * 32 + l31) * 80 + (8 * g + 4 * hh) * 2) = w; }
                }
#pragma unroll
                for (int i = 0; i < 4; ++i) {
                    const int row = 16 * i + (lane >> 2), ch = lane & 3, tl = q0 + row;
                    const u32x4 v = *(const LAS u32x4*)(ST + row * 80 + ch * 16);
                    if (kt <= (tl >> 5)) *(u32x4*)(SC + sc_row_off(b, tl) + (size_t)kt * 32 + ch * 8) = v;
                }
            }
        }
    }
}
template <int MODE>
__device__ __forceinline__ void phase_index_select(const Params& P, unsigned char* lds_) {
    const unsigned short* SC = (const unsigned short*)(P.ws + WS_SC); unsigned short* SEL = (unsigned short*)(P.ws + WS_SEL);
    const int tid = threadIdx.x, lane = tid & 63, wave = __builtin_amdgcn_readfirstlane(tid >> 6);
    LAS unsigned char* wbase = (LAS unsigned char*)lds_ + wave * 19456;
    LAS u32x4* rowbuf = (LAS u32x4*)wbase;
    LAS unsigned* hist = (LAS unsigned*)(wbase + 16384);
    LAS unsigned* dummy = hist + 512 + lane;
    LAS unsigned short* outw = (LAS unsigned short*)(wbase + 16384 + 2048 + 256);
    LAS unsigned short* dummy16 = outw + 256 + lane;
    const unsigned rowbuf0 = (unsigned)(unsigned long)wbase;
    const int gw = blockIdx.x * NWAVE + wave, NGW = gridDim.x * NWAVE;
#define SEL_DMA(tt) do { const int _tl = (tt) & (SEQ - 1), _n = _tl + 1; if (_n > TOPK) { const unsigned char* _src = (const unsigned char*)(SC + sc_row_off((tt) >> 13, _tl)) + lane * 16; \
            for (int _sg = 0; _sg * 512 < _n; ++_sg) glds16(_src + _sg * 1024, (unsigned)__builtin_amdgcn_readfirstlane((int)(rowbuf0 + _sg * 1024))); } } while (0)
#define SEL_Q(i) ((i) * NGW + (((i) & 1) ? (NGW - 1 - gw) : gw))
    if (SEL_Q(0) < NTOK) SEL_DMA(SEL_Q(0));
    for (int qi = 0; qi * NGW < NTOK; ++qi) {
        const int t = SEL_Q(qi), tnext = SEL_Q(qi + 1);
        if (t >= NTOK) { if (tnext < NTOK) SEL_DMA(tnext); continue; }
        const int tl = t & (SEQ - 1), n = tl + 1;
        unsigned short* so = SEL + (size_t)t * TOPK;
        if (n <= TOPK) { for (int i = lane; i < n; i += 64) so[i] = (unsigned short)i; if (tnext < NTOK && (qi + 1) * NGW < NTOK) SEL_DMA(tnext); continue; }
        asm volatile("s_waitcnt vmcnt(0)" ::: "memory");
        u32x4 d[16];
        const int lastsg = (n - 1) >> 9;
#pragma unroll
        for (int sg = 0; sg < 16; ++sg) {
            if (sg * 512 < n) {
                d[sg] = rowbuf[sg * 64 + lane];
                if (sg == lastsg) {
#pragma unroll
                    for (int q = 0; q < 4; ++q) { const int i0 = sg * 512 + lane * 8 + 2 * q;
                        d[sg][q] &= ((i0 < n) ? 0x0000ffffu : 0u) | ((i0 + 1 < n) ? 0xffff0000u : 0u); }
                }
            } else d[sg] = (u32x4){0u, 0u, 0u, 0u};
        }
        asm volatile("s_waitcnt lgkmcnt(0)" ::: "memory");
        if (tnext < NTOK && (qi + 1) * NGW < NTOK) SEL_DMA(tnext);
#pragma unroll
        for (int i = 0; i < 8; ++i) { hist[i * 64 + lane] = 0u; }
        asm volatile("s_waitcnt lgkmcnt(0)" ::: "memory");
        LAS unsigned* myh = hist + (lane & 1) * 256;
        if (MODE == 4) { if (d[0].x == 0x12345u) so[lane] = 1; continue; }
#pragma unroll
        for (int sg = 0; sg < 16; ++sg) if (MODE != 1 && sg * 512 < n) {
#pragma unroll
            for (int q = 0; q < 4; ++q) { const unsigned w = d[sg][q];
                __hip_atomic_fetch_add(myh + ((w >> 8) & 0xffu), 1u, __ATOMIC_RELAXED, __HIP_MEMORY_SCOPE_WORKGROUP);
                __hip_atomic_fetch_add(myh + (w >> 24), 1u, __ATOMIC_RELAXED, __HIP_MEMORY_SCOPE_WORKGROUP); }
        }
        asm volatile("s_waitcnt lgkmcnt(0)" ::: "memory");
        unsigned b1, need1;
        {
            unsigned c[4];
#pragma unroll
            for (int q = 0; q < 4; ++q) c[q] = hist[4 * lane + q] + hist[256 + 4 * lane + q];
            const unsigned mine = c[0] + c[1] + c[2] + c[3];
            unsigned suf = mine;
#pragma unroll
            for (int o = 1; o < 64; o <<= 1) { const unsigned v = __shfl_down(suf, o); if (lane + o < 64) suf += v; }
            const unsigned above = suf - mine;
            int fb = -1; unsigned fneed = 0;
            if (above < (unsigned)TOPK && suf >= (unsigned)TOPK) { unsigned a = above;
#pragma unroll
                for (int q = 3; q >= 0; --q) { if (fb < 0 && a + c[q] >= (unsigned)TOPK) { fb = 4 * lane + q; fneed = (unsigned)TOPK - a; } a += c[q]; } }
            const unsigned long long bal = __ballot(fb >= 0);
            const int src = (int)__builtin_ctzll(bal);
            b1 = (unsigned)__shfl(fb, src); need1 = __shfl(fneed, src);
        }
#pragma unroll
        for (int i = 0; i < 8; ++i) { hist[i * 64 + lane] = 0u; }
        asm volatile("s_waitcnt lgkmcnt(0)" ::: "memory");
#pragma unroll
        for (int sg = 0; sg < 16; ++sg) if (MODE != 2 && sg * 512 < n) {
#pragma unroll
            for (int q = 0; q < 4; ++q) { const unsigned w = d[sg][q];
                LAS unsigned* p0 = (((w >> 8) & 0xffu) == b1) ? (myh + (w & 0xffu)) : dummy;
                LAS unsigned* p1 = ((w >> 24) == b1) ? (myh + ((w >> 16) & 0xffu)) : dummy;
                __hip_atomic_fetch_add(p0, 1u, __ATOMIC_RELAXED, __HIP_MEMORY_SCOPE_WORKGROUP);
                __hip_atomic_fetch_add(p1, 1u, __ATOMIC_RELAXED, __HIP_MEMORY_SCOPE_WORKGROUP); }
        }
        asm volatile("s_waitcnt lgkmcnt(0)" ::: "memory");
        unsigned T, need2;
        {
            unsigned c[4];
#pragma unroll
            for (int q = 0; q < 4; ++q) c[q] = hist[4 * lane + q] + hist[256 + 4 * lane + q];
            const unsigned mine = c[0] + c[1] + c[2] + c[3];
            unsigned suf = mine;
#pragma unroll
            for (int o = 1; o < 64; o <<= 1) { const unsigned v = __shfl_down(suf, o); if (lane + o < 64) suf += v; }
            const unsigned above = suf - mine;
            int fb = -1; unsigned fneed = 0;
            if (above < need1 && suf >= need1) { unsigned a = above;
#pragma unroll
                for (int q = 3; q >= 0; --q) { if (fb < 0 && a + c[q] >= need1) { fb = 4 * lane + q; fneed = need1 - a; } a += c[q]; } }
            const unsigned long long bal = __ballot(fb >= 0);
            const int src = (int)__builtin_ctzll(bal);
            T = (b1 << 8) | (unsigned)__shfl(fb, src); need2 = __shfl(fneed, src);
        }
        unsigned base = 0; const unsigned ngt = (unsigned)TOPK - need2; unsigned eqbase = 0;
#pragma unroll
        for (int sg = 0; sg < 16; ++sg) if (MODE != 3 && sg * 512 < n) {
            unsigned ce = 0;
#pragma unroll
            for (int j = 0; j < 8; ++j) {
                const unsigned k = (j & 1) ? (d[sg][j >> 1] >> 16) : (d[sg][j >> 1] & 0xffffu);
                const bool gt = k > T;
                const unsigned long long mk = __ballot(gt);
                const unsigned pos = base + (unsigned)__builtin_amdgcn_mbcnt_hi((unsigned)(mk >> 32), __builtin_amdgcn_mbcnt_lo((unsigned)mk, 0u));
                LAS unsigned short* po = gt ? (outw + pos) : dummy16;
                *po = (unsigned short)(sg * 512 + lane * 8 + j);
                base += (unsigned)__builtin_popcountll(mk);
                ce += (k == T) ? 1u : 0u;
            }
            if (__any(ce > 0u)) {
                unsigned pre = ce;
#pragma unroll
                for (int o = 1; o < 64; o <<= 1) { const unsigned v = __shfl_up(pre, o); if (lane >= o) pre += v; }
                unsigned r = eqbase + pre - ce;
#pragma unroll
                for (int j = 0; j < 8; ++j) { const unsigned k = (j & 1) ? (d[sg][j >> 1] >> 16) : (d[sg][j >> 1] & 0xffffu);
                    if (k == T) { if (r < need2) outw[ngt + r] = (unsigned short)(sg * 512 + lane * 8 + j); ++r; } }
                eqbase += __shfl(pre, 63);
            }
        }
        asm volatile("s_waitcnt lgkmcnt(0)" ::: "memory");
        ((unsigned*)so)[lane] = ((LAS unsigned*)outw)[lane];
        ((unsigned*)so)[64 + lane] = ((LAS unsigned*)outw)[64 + lane];
        asm volatile("s_waitcnt lgkmcnt(0)" ::: "memory");
    }
#undef SEL_DMA
#undef SEL_Q
    asm volatile("s_waitcnt vmcnt(0)" ::: "memory");
}

__device__ __forceinline__ void ret_fill_image(LAS unsigned char* img, const unsigned char* src, size_t row_stride_bytes, int wave, int lane) {
#pragma unroll
    for (int e4 = 0; e4 < 4; ++e4) {
        const int e = wave * 4 + e4, row = 4 * e + (lane >> 4), q = (lane & 15) ^ ((row & 7) << 1);
        __builtin_amdgcn_global_load_lds((const unsigned*)(src + (size_t)row * row_stride_bytes + q * 16), (LAS unsigned*)(img + e * 1024), 16, 0, 0);
    }
}
__device__ __forceinline__ pg8::bf16x8 ret_tr_pair(const LAS unsigned char* img, int row0, int chunk2, int lane) {
    const int g = lane >> 4, i = lane & 15, r0 = row0 + 4 * g + (i >> 2), pb = (i & 3) >> 1, half = (i & 1) * 8;
    const int r1 = r0 + 16;
    const v4i16_t lo = __builtin_amdgcn_ds_read_tr16_b64_v4i16((LAS v4i16_t*)(img + r0 * 256 + ((((chunk2) ^ ((r0 & 7) << 1)) | pb) << 4) + half));
    const v4i16_t hi = __builtin_amdgcn_ds_read_tr16_b64_v4i16((LAS v4i16_t*)(img + r1 * 256 + ((((chunk2) ^ ((r1 & 7) << 1)) | pb) << 4) + half));
    return (pg8::bf16x8){lo[0], lo[1], lo[2], lo[3], hi[0], hi[1], hi[2], hi[3]};
}
__device__ __forceinline__ void phase_ret_kv_mfma(const Params& P, unsigned char* lds_) {
    using pg8::bf16x8;
    const unsigned char* Z0 = (const unsigned char*)(P.ws + WS_Z0); float* KV = (float*)(P.ws + WS_KV);
    LAS unsigned char* Kimg = (LAS unsigned char*)lds_; LAS unsigned char* Vimg = Kimg + 32768;
    const int tid = threadIdx.x, lane = tid & 63, wave = __builtin_amdgcn_readfirstlane(tid >> 6), fr = lane & 15, fq = lane >> 4;
    for (int u = blockIdx.x; u < 1024; u += gridDim.x) {
        const int n = u & 63, h = (u >> 6) & 3, b = u >> 8;
        const size_t row0 = (size_t)b * SEQ + n * 128;
        __syncthreads();
        ret_fill_image(Kimg, Z0 + row0 * ZW * 2 + (512 + h * 128) * 2, ZW * 2, wave, lane);
        ret_fill_image(Vimg, Z0 + row0 * ZW * 2 + (1024 + h * 128) * 2, ZW * 2, wave, lane);
        asm volatile("s_waitcnt vmcnt(0)" ::: "memory");
        __syncthreads();
        bf16x8 va[4];
#pragma unroll
        for (int jc = 0; jc < 4; ++jc) va[jc] = ret_tr_pair(Vimg, 32 * jc, 2 * wave, lane);
        const float g127 = exp2f(ret_log2g(h) * 127.0f);
        float* o = KV + (size_t)u * 16384;
#pragma unroll
        for (int dt = 0; dt < 8; ++dt) {
            f32x4 acc = {0.f, 0.f, 0.f, 0.f};
#pragma unroll
            for (int jc = 0; jc < 4; ++jc) acc = __builtin_amdgcn_mfma_f32_16x16x32_bf16(va[jc], ret_tr_pair(Kimg, 32 * jc, 2 * dt, lane), acc, 0, 0, 0);
            *(f32x4*)(o + (size_t)(16 * dt + fr) * 128 + 16 * wave + 4 * fq) = acc * g127;
        }
    }
}
template <int W>
__device__ __forceinline__ void pool_item(const Params& P, int t0, int c8) {
    const bf16_t* Z0 = (const bf16_t*)(P.ws + WS_Z0); bf16_t* DP = (bf16_t*)(P.ws + WS_DP);
    const int tl0 = t0 & (SEQ - 1);
    u32x4 rows[W + 7];
#pragma unroll
    for (int r = 0; r < W + 7; ++r) { const int d = r - (W - 1);
        rows[r] = (tl0 + d >= 0) ? *(const u32x4*)(Z0 + (size_t)(t0 + d) * ZW + 2048 + c8) : (u32x4){0u, 0u, 0u, 0u}; }
    float sm[8];
#pragma unroll
    for (int j = 0; j < 8; ++j) sm[j] = 0.f;
#pragma unroll
    for (int r = 0; r < W; ++r) { const u32x4 v = rows[r];
        sm[0] += bflo(v.x); sm[1] += bfhi(v.x); sm[2] += bflo(v.y); sm[3] += bfhi(v.y); sm[4] += bflo(v.z); sm[5] += bfhi(v.z); sm[6] += bflo(v.w); sm[7] += bfhi(v.w); }
#pragma unroll
    for (int o = 0; o < 8; ++o) {
        const u32x4 v = rows[o + W - 1];
        if (o > 0) { const u32x4 q = rows[o - 1];
            sm[0] += bflo(v.x) - bflo(q.x); sm[1] += bfhi(v.x) - bfhi(q.x); sm[2] += bflo(v.y) - bflo(q.y); sm[3] += bfhi(v.y) - bfhi(q.y);
            sm[4] += bflo(v.z) - bflo(q.z); sm[5] += bfhi(v.z) - bfhi(q.z); sm[6] += bflo(v.w) - bflo(q.w); sm[7] += bfhi(v.w) - bfhi(q.w); }
        const float inv = 1.0f / (float)min(tl0 + o + 1, W);
        u32x4 w; w.x = pk2(sm[0] * inv - bflo(v.x), sm[1] * inv - bfhi(v.x)); w.y = pk2(sm[2] * inv - bflo(v.y), sm[3] * inv - bfhi(v.y));
        w.z = pk2(sm[4] * inv - bflo(v.z), sm[5] * inv - bfhi(v.z)); w.w = pk2(sm[6] * inv - bflo(v.w), sm[7] * inv - bfhi(v.w));
        *(u32x4*)(DP + (size_t)(t0 + o) * 512 + c8) = w;
    }
}
__device__ __forceinline__ void phase_ret_scan_pool2(const Params& P) {
    const float* KV = (const float*)(P.ws + WS_KV); bf16_t* SB = (bf16_t*)(P.ws + WS_SB);
    const size_t gt = (size_t)blockIdx.x * NT + threadIdx.x, GS = (size_t)gridDim.x * NT;
    for (size_t i = gt; i < (size_t)16 * 8192; i += GS) {
        const int s = (int)(i >> 13), e2 = (int)(i & 8191), h = s & 3;
        const float l2 = ret_log2g(h), cd = exp2f(l2 * 128.0f), g1 = exp2f(l2);
        typedef float f32x2v __attribute__((ext_vector_type(2)));
        const f32x2v* p = (const f32x2v*)(KV + (size_t)s * 64 * 16384) + e2;
        unsigned* q = (unsigned*)(SB + (size_t)s * 64 * 16384) + e2;
        f32x2v R = {0.f, 0.f};
        for (int n0 = 0; n0 < 64; n0 += 32) {
            f32x2v kv[32];
#pragma unroll
            for (int j = 0; j < 32; ++j) kv[j] = __builtin_nontemporal_load(p + (size_t)(n0 + j) * 8192);
#pragma unroll
            for (int j = 0; j < 32; ++j) { q[(size_t)(n0 + j) * 8192] = pk2(R.x * g1, R.y * g1); R = R * cd + kv[j]; }
        }
    }
    const int lane = threadIdx.x & 63, gwv = (int)blockIdx.x * NWAVE + (int)(threadIdx.x >> 6), NGWv = (int)gridDim.x * NWAVE;
    for (int wi = gwv; wi < 2048; wi += NGWv) {
#pragma unroll
        for (int half = 0; half < 2; ++half) {
            const int slot = wi & 1023, gsel = wi >> 10, g = half ? 3 - gsel : gsel;
            const int t0 = (slot * 4 + (lane >> 4)) * 8, c8 = g * 128 + (lane & 15) * 8;
            if (g == 0) pool_item<2>(P, t0, c8); else if (g == 1) pool_item<4>(P, t0, c8); else if (g == 2) pool_item<8>(P, t0, c8); else pool_item<16>(P, t0, c8);
        }
    }
}
__device__ __forceinline__ void phase_ret_out_mfma(const Params& P, unsigned char* lds_) {
    using pg8::bf16x8;
    const unsigned char* Z0 = (const unsigned char*)(P.ws + WS_Z0); const unsigned char* SB = (const unsigned char*)(P.ws + WS_SB); bf16_t* MIX = (bf16_t*)(P.ws + WS_MIX);
    const float* gn = P.in[3];
    LAS unsigned char* Kimg = (LAS unsigned char*)lds_; LAS unsigned char* Vimg = Kimg + 32768; LAS unsigned char* Rimg = Kimg + 65536;
    const int tid = threadIdx.x, lane = tid & 63, wave = __builtin_amdgcn_readfirstlane(tid >> 6), fr = lane & 15, fq = lane >> 4;
    for (int u = blockIdx.x; u < 1024; u += gridDim.x) {
        const int n = u & 63, h = (u >> 6) & 3, b = u >> 8;
        const size_t row0 = (size_t)b * SEQ + n * 128;
        __syncthreads();
        ret_fill_image(Kimg, Z0 + row0 * ZW * 2 + (512 + h * 128) * 2, ZW * 2, wave, lane);
        ret_fill_image(Vimg, Z0 + row0 * ZW * 2 + (1024 + h * 128) * 2, ZW * 2, wave, lane);
        ret_fill_image(Rimg, SB + (size_t)u * 32768, 256, wave, lane);
        const bf16_t* qrow = (const bf16_t*)Z0 + (row0 + 16 * wave + fr) * ZW + h * 128;
        bf16x8 qf[4], qr[4];
#pragma unroll
        for (int c = 0; c < 4; ++c) {
            qf[c] = *(const bf16x8*)(qrow + 32 * c + 8 * fq);
            const u32x2 a = *(const u32x2*)(qrow + 32 * c + 4 * fq), bb = *(const u32x2*)(qrow + 32 * c + 16 + 4 * fq);
            u32x4 w; w.x = a.x; w.y = a.y; w.z = bb.x; w.w = bb.y; qr[c] = __builtin_bit_cast(bf16x8, w);
        }
        asm volatile("s_waitcnt vmcnt(0)" ::: "memory");
        __syncthreads();
        f32x4 sT[8];
#pragma unroll
        for (int jt = 0; jt < 8; ++jt) sT[jt] = (f32x4){0.f, 0.f, 0.f, 0.f};
#pragma unroll
        for (int jp = 0; jp < 4; ++jp) if (2 * jp <= wave) {
            bf16x8 a[8];
#pragma unroll
            for (int t2 = 0; t2 < 2; ++t2) { const int r = 16 * (2 * jp + t2) + fr;
#pragma unroll
                for (int c = 0; c < 4; ++c) a[t2 * 4 + c] = *(const LAS bf16x8*)(Kimg + r * 256 + ((((4 * c + fq)) ^ ((r & 7) << 1)) << 4)); }
            __builtin_amdgcn_sched_barrier(0);
#pragma unroll
            for (int t2 = 0; t2 < 2; ++t2)
#pragma unroll
                for (int c = 0; c < 4; ++c) sT[2 * jp + t2] = __builtin_amdgcn_mfma_f32_16x16x32_bf16(a[t2 * 4 + c], qf[c], sT[2 * jp + t2], 0, 0, 0);
            __builtin_amdgcn_sched_barrier(0);
        }
#pragma unroll
        for (int jt = 0; jt < 8; ++jt) {
            if (jt == wave) {
                if (4 * fq + 0 > fr) sT[jt].x = 0.f; if (4 * fq + 1 > fr) sT[jt].y = 0.f; if (4 * fq + 2 > fr) sT[jt].z = 0.f; if (4 * fq + 3 > fr) sT[jt].w = 0.f;
            }
            if (jt > wave) sT[jt] = (f32x4){0.f, 0.f, 0.f, 0.f};
        }
        bf16x8 pT[4];
#pragma unroll
        for (int jp = 0; jp < 4; ++jp) { u32x4 w; w.x = pk2(sT[2 * jp].x, sT[2 * jp].y); w.y = pk2(sT[2 * jp].z, sT[2 * jp].w); w.z = pk2(sT[2 * jp + 1].x, sT[2 * jp + 1].y); w.w = pk2(sT[2 * jp + 1].z, sT[2 * jp + 1].w);
            pT[jp] = __builtin_bit_cast(bf16x8, w); }
        f32x4 O[8];
        const int nact = (wave >> 1) + 1;
#pragma unroll
        for (int vt = 0; vt < 8; ++vt) {
            bf16x8 rr[4], vv[4];
#pragma unroll
            for (int c = 0; c < 4; ++c) rr[c] = ret_tr_pair(Rimg, 32 * c, 2 * vt, lane);
#pragma unroll
            for (int jp = 0; jp < 4; ++jp) vv[jp] = (jp < nact) ? ret_tr_pair(Vimg, 32 * jp, 2 * vt, lane) : pT[jp];
            __builtin_amdgcn_sched_barrier(0);
            f32x4 acc = {0.f, 0.f, 0.f, 0.f};
#pragma unroll
            for (int c = 0; c < 4; ++c) acc = __builtin_amdgcn_mfma_f32_16x16x32_bf16(rr[c], qr[c], acc, 0, 0, 0);
#pragma unroll
            for (int jp = 0; jp < 4; ++jp) acc = __builtin_amdgcn_mfma_f32_16x16x32_bf16(vv[jp], pT[jp], acc, 0, 0, 0);
            __builtin_amdgcn_sched_barrier(0);
            O[vt] = acc;
        }
        float sm = 0.f;
#pragma unroll
        for (int vt = 0; vt < 8; ++vt) sm += (O[vt].x + O[vt].y) + (O[vt].z + O[vt].w);
        sm += __shfl_xor(sm, 16); sm += __shfl_xor(sm, 32);
        const float mu = sm * (1.0f / 128.0f);
        float sq = 0.f;
#pragma unroll
        for (int vt = 0; vt < 8; ++vt) { const f32x4 dlt = O[vt] - mu; sq += (dlt.x * dlt.x + dlt.y * dlt.y) + (dlt.z * dlt.z + dlt.w * dlt.w); }
        sq += __shfl_xor(sq, 16); sq += __shfl_xor(sq, 32);
        const float rstd = 1.0f / sqrtf(sq * (1.0f / 128.0f) + LN_EPS);
        const bf16_t* grow = (const bf16_t*)Z0 + (row0 + 16 * wave + fr) * ZW + 1536 + h * 128 + 4 * fq;
        bf16_t* orow = MIX + (row0 + 16 * wave + fr) * DM + h * 128 + 4 * fq;
#pragma unroll
        for (int vt = 0; vt < 8; ++vt) {
            const u32x2 gv = *(const u32x2*)(grow + 16 * vt);
            const f32x4 g4 = *(const f32x4*)(gn + h * 128 + 16 * vt + 4 * fq);
            const f32x4 y = (O[vt] - mu) * rstd * g4;
            u32x2 w; w.x = pk2(y.x * silu_f(bflo(gv.x)), y.y * silu_f(bfhi(gv.x))); w.y = pk2(y.z * silu_f(bflo(gv.y)), y.w * silu_f(bfhi(gv.y)));
            *(u32x2*)(orow + 16 * vt) = w;
        }
    }
}

#define XB_TMO      128
#define XB_XCNT(j)  (256  + 64 * (j))
#define XB_XSUB(j)  (1280 + 64 * (j))
#define XB_XGEN(j)  (2304 + 64 * (j))
#define XB_TOP      3328
#define XB_TOPGEN   3392
#define XCD_BAR_WORDS 3456
#define XB_SPIN_CAP (1u << 22)
__device__ __forceinline__ unsigned xb_ld(unsigned* p)              { return __hip_atomic_load(p, __ATOMIC_RELAXED, __HIP_MEMORY_SCOPE_AGENT); }
__device__ __forceinline__ unsigned xb_add(unsigned* p, unsigned v) { return __hip_atomic_fetch_add(p, v, __ATOMIC_RELAXED, __HIP_MEMORY_SCOPE_AGENT); }
__device__ __forceinline__ unsigned xb_xcc_id() { return (unsigned)__builtin_amdgcn_s_getreg((3 << 11) | 20) & 0xFu; }
#define XB_SPIN(cond, bar) do { unsigned _sp = 0; while (cond) { __builtin_amdgcn_s_sleep(1); \
    if ((++_sp & 255u) == 0u) { if (xb_ld(&(bar)[XB_TMO])) break; if (_sp > XB_SPIN_CAP) { atomicAdd(&(bar)[XB_TMO], 1u); break; } } } } while (0)
struct XcdBarrier { unsigned* bar; unsigned x; volatile LAS unsigned* st; };
__device__ __forceinline__ XcdBarrier xcd_barrier_post(unsigned* bar, volatile LAS unsigned* st) {
    XcdBarrier b; b.bar = bar; b.x = xb_xcc_id(); b.st = st;
    if (threadIdx.x == 0) (void)xb_add(&bar[XB_XCNT(b.x)], 1u);
    return b;
}
__device__ __forceinline__ void xcd_barrier_complete(unsigned* bar, unsigned x, unsigned& nloc, unsigned& nx) {
    const unsigned G = gridDim.x * gridDim.y * gridDim.z;
    unsigned sum, cnt, mine, sp = 0u;
    for (;;) {
        sum = 0u; cnt = 0u; mine = 0u;
#pragma unroll
        for (unsigned j = 0; j < 16; ++j) { const unsigned c = xb_ld(&bar[XB_XCNT(j)]); sum += c; cnt += (c > 0u) ? 1u : 0u; mine = (j == x) ? c : mine; }
        if (sum == G) break;
        __builtin_amdgcn_s_sleep(1);
        if ((++sp & 255u) == 0u) { if (xb_ld(&bar[XB_TMO])) break; if (sp > XB_SPIN_CAP) { atomicAdd(&bar[XB_TMO], 1u); break; } }
    }
    nloc = mine > 0u ? mine : 1u; nx = cnt > 0u ? cnt : 1u;
}
__device__ __forceinline__ void xcd_barrier(const XcdBarrier& b) {
    asm volatile("s_waitcnt vmcnt(0)" ::: "memory");
    __syncthreads();
    if (threadIdx.x == 0) {
        unsigned* bar = b.bar;
        __builtin_amdgcn_s_waitcnt(0);
        unsigned nloc = b.st[0], nx = b.st[1];
        if (nloc == 0u) { xcd_barrier_complete(bar, b.x, nloc, nx); b.st[0] = nloc; b.st[1] = nx; }
        const unsigned old = xb_add(&bar[XB_XSUB(b.x)], 1u);
        const unsigned gen = old / nloc;
        if (old + 1u == (gen + 1u) * nloc) {
            __builtin_amdgcn_fence(__ATOMIC_RELEASE, "agent");
            asm volatile("s_waitcnt vmcnt(0)" ::: "memory");
            const unsigned og = xb_add(&bar[XB_TOP], 1u);
            const unsigned tg = og / nx;
            if (og + 1u == (tg + 1u) * nx) xb_add(&bar[XB_TOPGEN], 1u);
            else XB_SPIN(xb_ld(&bar[XB_TOPGEN]) == tg, bar);
            __builtin_amdgcn_fence(__ATOMIC_ACQUIRE, "agent");
            xb_add(&bar[XB_XGEN(b.x)], 1u);
            asm volatile("s_waitcnt vmcnt(0)" ::: "memory");
        } else {
            XB_SPIN(xb_ld(&bar[XB_XGEN(b.x)]) == gen, bar);
            __builtin_amdgcn_fence(__ATOMIC_ACQUIRE, "agent");
            asm volatile("s_waitcnt vmcnt(0)" ::: "memory");
        }
    }
    __syncthreads();
}
constexpr size_t CTL_BAR_OFF = 16384;
constexpr size_t CTL_ZERO_BYTES = 65536;

#ifdef PH_ONLY
#define IN(k) ((k) == PH_ONLY)
#else
#define IN(k) (lo <= (k) && (k) < hi)
#endif
#define SEAM(k) do { if (IN(k) && IN((k) + 1)) xcd_barrier(grid); } while (0)
#ifndef PROBE_DUP
#define PROBE_DUP (-1)
#endif
#define REP(k) for (int _rep = 0; _rep < ((PROBE_DUP == (k)) ? 2 : 1); ++_rep)
#define REPS(k) ((PROBE_DUP == 100 + (k)) ? 2 : 1)

template <int LAYER, int BASE>
__device__ __forceinline__ void layer_tail(const Params& P, unsigned char* lds, const XcdBarrier& grid, int lo, int hi) {
    unsigned char* ws = P.ws;
    int* tb = (int*)(lds + MISC_OFF);
    if (IN(BASE)) { if (PROBE_DUP == BASE) phase_ln_route<true>(P, lds, LAYER); phase_ln_route<false>(P, lds, LAYER); }
    SEAM(BASE);
    if (IN(BASE + 1)) REP(BASE + 1) { moe_setup(P, tb, LAYER);
        MoeSched S{tb, (const int*)(ws + WS_CTL + CTL_CNT_OFF) + LAYER * 32 * CNT_STRIDE, (const int*)(ws + WS_LIST), (const bf16_t*)(ws + WS_XB),
                   (const bf16_t*)(ws + WS_W_GU) + (size_t)LAYER * 32 * DM * DM, DM, (size_t)DM * DM, true};
        EpiGU E{(bf16_t*)(ws + WS_ACT)}; gemm_moe<true>(lds, S, E);
        { const int U = tb[32] * 4, G = (int)gridDim.x, nheavy = (U % G), nlight = G - nheavy, lr = (int)blockIdx.x - nheavy;
          DenseSched S2{(const bf16_t*)(ws + WS_PB) + (size_t)LAYER * NTOK * 256, (const bf16_t*)(ws + WS_W_P) + (size_t)LAYER * DM * 256, NTOK, DM, 256, 256, 0, 1, lr, nlight};
          EpiStoreBf16 E2{(bf16_t*)(ws + WS_PP), DM, 0, nullptr}; gemm_dense(lds, S2, E2); } }
    SEAM(BASE + 1);
    if (IN(BASE + 2)) REP(BASE + 2) { moe_setup(P, tb, LAYER);
        MoeSched S{tb, (const int*)(ws + WS_CTL + CTL_CNT_OFF) + LAYER * 32 * CNT_STRIDE, (const int*)(ws + WS_LIST), (const bf16_t*)(ws + WS_ACT),
                   (const bf16_t*)(ws + WS_W_DN) + (size_t)LAYER * 32 * DM * 512, 512, (size_t)DM * 512, false};
        EpiDown E{(bf16_t*)(ws + WS_YS)}; gemm_moe<false>(lds, S, E); }
    SEAM(BASE + 2);
    if (IN(BASE + 3)) { if (PROBE_DUP == BASE + 3) phase_ln2<true>(P, LAYER); phase_ln2<false>(P, LAYER); }
    SEAM(BASE + 3);
    if (IN(BASE + 4)) REP(BASE + 4) {
        { DenseSched S{(const bf16_t*)(ws + WS_XB), (const bf16_t*)(ws + WS_W_G) + (size_t)LAYER * DM * DM, NTOK, DM, DM, DM, 0, REPS(BASE + 4)};
          EpiPle E{(const bf16_t*)(ws + WS_XB), (const bf16_t*)(ws + WS_PP), LAYER == 1 ? P.out : (float*)nullptr, LAYER == 1 ? (bf16_t*)nullptr : (bf16_t*)(ws + WS_XB2)}; gemm_dense(lds, S, E); }
    }
}

__global__ void __launch_bounds__(NT, 2) mega(Params P, int lo, int hi) {
    extern __shared__ __attribute__((aligned(16))) unsigned char lds[];
    unsigned char* ws = P.ws;
    if (threadIdx.x < 16) ((LAS unsigned*)((LAS unsigned char*)lds + BARW_OFF))[threadIdx.x] = 0u;
    __syncthreads();
    const XcdBarrier grid = xcd_barrier_post((unsigned*)(ws + WS_CTL + CTL_BAR_OFF), (volatile LAS unsigned*)((LAS unsigned char*)lds + BARW_OFF));
    if (IN(0)) REP(0) phase_prep(P, lds);
    SEAM(0);
    if (IN(1)) REP(1) { DenseSched S{(const bf16_t*)(ws + WS_XB), (const bf16_t*)(ws + WS_W_IN0), NTOK, ZW, DM, DM, 0, REPS(1)};
        EpiZ0 E{(bf16_t*)(ws + WS_Z0)}; gemm_dense(lds, S, E); }
    SEAM(1);
    if (IN(2)) REP(2) phase_ret_kv_mfma(P, lds);
    SEAM(2);
    if (IN(3)) REP(3) phase_ret_scan_pool2(P);
    SEAM(3);
    if (IN(4)) REP(4) { phase_ret_out_mfma(P, lds); __syncthreads();
        DenseSched S{(const bf16_t*)(ws + WS_DP), (const bf16_t*)(ws + WS_W_POOL), NTOK, 512, 256, 512, 256};
        EpiStoreBf16 E{(bf16_t*)(ws + WS_MIX), DM, 512, P.in[5]}; gemm_dense(lds, S, E); }
    SEAM(4);
    if (IN(5)) REP(5) { DenseSched S{(const bf16_t*)(ws + WS_MIX), (const bf16_t*)(ws + WS_W_OUT0), NTOK, DM, DM, DM, 0, REPS(5)};
        EpiResidB E{(const bf16_t*)(ws + WS_XB), (bf16_t*)(ws + WS_F)}; gemm_dense(lds, S, E); }
    SEAM(5);
    layer_tail<0, 6>(P, lds, grid, lo, hi);
    SEAM(10);
    if (IN(11)) REP(11) { DenseSched S{(const bf16_t*)(ws + WS_XB2), (const bf16_t*)(ws + WS_W_CIN), NTOK, Z1W, DM, DM, 0, REPS(11)};
        EpiStoreBf16 E{(bf16_t*)(ws + WS_Z1), Z1W, 0, nullptr}; gemm_dense(lds, S, E); }
    SEAM(11);
    if (IN(12)) REP(12) { phase_norms(P); phase_index_scores(P, lds); }
    SEAM(12);
    if (IN(13)) { if (PROBE_DUP == 13) phase_index_select<PROBE_SEL>(P, lds); phase_index_select<0>(P, lds); }
    if (IN(13) && IN(14)) __syncthreads();
    if (IN(14)) REP(14) { DenseSched S{(const bf16_t*)(ws + WS_CQ), (const bf16_t*)(ws + WS_W_QA), NTOK, 4096, 256, 256, 0, REPS(14)};
        EpiStoreFp8 E{(unsigned char*)(ws + WS_QA), 4096}; gemm_dense(lds, S, E); }
    SEAM(14);
    if (IN(15)) { if (PROBE_DUP == 15) phase_sparse_attn_e<true>(P, lds); phase_sparse_attn_e<false>(P, lds); }
    SEAM(15);
    if (IN(16)) REP(16) { DenseSched S{(const bf16_t*)(ws + WS_OLAT), (const bf16_t*)(ws + WS_W_UVBD), NTOK, DM, DM, 4096, 1024, REPS(16)};
        EpiStoreBf16 E{(bf16_t*)(ws + WS_XB), DM, 0, nullptr}; gemm_dense_bdiag(lds, S, E); }
    SEAM(16);
    if (IN(17)) REP(17) { DenseSched S{(const bf16_t*)(ws + WS_XB), (const bf16_t*)(ws + WS_W_COUT), NTOK, DM, DM, DM, 0, REPS(17)};
        EpiResidB E{(const bf16_t*)(ws + WS_XB2), (bf16_t*)(ws + WS_F)}; gemm_dense(lds, S, E); }
    SEAM(17);
    layer_tail<1, 18>(P, lds, grid, lo, hi);
}
#undef IN
#undef SEAM

extern "C" void kernel_launch(void* const* d_in, const int* in_sizes, int n_in, void* d_out, int out_size, void* d_ws, size_t ws_size, hipStream_t stream) {
    static int grid = 0;
    if (grid == 0) {
        if (n_in != 26 || ws_size < WS_END || out_size != NTOK * DM) { fprintf(stderr, "kernel_launch: unexpected problem (n_in %d, ws %zu, out %d)\n", n_in, ws_size, out_size); grid = -1; return; }
        int dev = 0, cus = 0, per_cu = 0;
        (void)hipGetDevice(&dev);
        (void)hipDeviceGetAttribute(&cus, hipDeviceAttributeMultiprocessorCount, dev);
        (void)hipFuncSetAttribute((const void*)mega, hipFuncAttributeMaxDynamicSharedMemorySize, LDS_BYTES);
        (void)hipOccupancyMaxActiveBlocksPerMultiprocessor(&per_cu, (const void*)mega, NT, LDS_BYTES);
        if (per_cu < 1) { fprintf(stderr, "kernel_launch: occupancy query reports %d blocks per CU\n", per_cu); per_cu = 1; }
        (void)hipGetLastError();
        grid = cus;
    }
    if (grid < 0) return;
    (void)hipMemsetAsync((char*)d_ws + WS_CTL, 0, CTL_ZERO_BYTES, stream);
    Params p{};
    for (int i = 0; i < 26; ++i) p.in[i] = (const float*)d_in[i];
    p.out = (float*)d_out; p.ws = (unsigned char*)d_ws;
#if MK_ONE_LAUNCH
    int lo = 0, hi = NPH_TOTAL;
    void* args[] = {&p, &lo, &hi};
    (void)args;
    hipLaunchKernelGGL(mega, dim3(grid), dim3(NT), LDS_BYTES, stream, p, lo, hi);
    hipError_t e = hipPeekAtLastError();
    if (e != hipSuccess) fprintf(stderr, "launch failed: %s (grid %d)\n", hipGetErrorString(e), grid);
#else
    for (int k = 0; k < NPH_TOTAL; ++k) hipLaunchKernelGGL(mega, dim3(grid), dim3(NT), LDS_BYTES, stream, p, k, k + 1);
#endif
}
```

```cpp
#include <hip/hip_runtime.h>
#include <cstdio>
#include <cstdint>

#ifndef PROBE_ATT
#define PROBE_ATT 0
#endif
#ifndef PROBE_LN
#define PROBE_LN 0
#endif
#ifndef PROBE_SEL
#define PROBE_SEL 0
#endif
#ifndef MK_ONE_LAUNCH
#define MK_ONE_LAUNCH 1
#endif

typedef unsigned short bf16_t;
typedef float f32x4 __attribute__((ext_vector_type(4)));
typedef unsigned u32x4 __attribute__((ext_vector_type(4)));
typedef unsigned u32x2 __attribute__((ext_vector_type(2)));

constexpr int NT = 512;
constexpr int NWAVE = NT / 64;
constexpr int NTOK = 32768, DM = 1024, SEQ = 8192, NBATCH = 4;
constexpr int ZW = 2560;
constexpr int Z1W = 1280;
constexpr int CIN = 1096;
constexpr int TOPK = 256;
constexpr float ALPHA = 1.4142135623730951f;
constexpr float LN_EPS = 1e-5f;
constexpr int LDS_BYTES = 163840;
constexpr int BARW_OFF = LDS_BYTES - 64;
constexpr int MISC_OFF = 135168;

constexpr size_t MiB = (size_t)1 << 20;
constexpr size_t WS_CTL = 0;
constexpr size_t WS_W_IN0 = 1 * MiB, WS_W_OUT0 = 6 * MiB, WS_W_POOL = 8 * MiB, WS_W_CIN = 9 * MiB, WS_W_QA = 12 * MiB,
                 WS_W_UVBD = 14 * MiB, WS_W_COUT = 16 * MiB, WS_W_G = 18 * MiB, WS_W_P = 22 * MiB, WS_W_GU = 24 * MiB, WS_W_DN = 152 * MiB;
constexpr size_t WS_XB = 224 * MiB, WS_F = 288 * MiB, WS_PB = 416 * MiB, WS_PP = 448 * MiB, WS_CQ = 512 * MiB, WS_CKV = 528 * MiB,
                 WS_SEL = 544 * MiB, WS_TOKG = 560 * MiB, WS_LIST = 561 * MiB, WS_CKV8 = 566 * MiB;
constexpr size_t WS_M0 = 576 * MiB;
constexpr size_t WS_Z0 = WS_M0, WS_KV = WS_M0 + 160 * MiB, WS_MIX = WS_M0 + 224 * MiB, WS_DP = WS_M0 + 288 * MiB, WS_SB = WS_M0 + 320 * MiB;
constexpr size_t WS_OLAT = WS_M0, WS_QA = WS_F  , WS_SC = WS_M0, WS_Z1 = WS_M0 + 272 * MiB;
constexpr size_t WS_ACT = WS_M0, WS_YS = WS_M0 + 72 * MiB;
constexpr size_t WS_XB2 = 960 * MiB;
constexpr size_t WS_END = 1024 * MiB;
constexpr int LIST_CAP = 32768;
constexpr size_t CTL_CNT_OFF = 32768;
constexpr int CNT_STRIDE = 64;
constexpr size_t WS_GT = WS_CTL + 262144;
constexpr size_t WS_SGB = WS_CTL + 786432;

struct Params {
    const float* in[26];
    float* out;
    unsigned char* ws;
};

__device__ __forceinline__ unsigned f2bf(float f) { unsigned u = __float_as_uint(f); return (u + 0x7fffu + ((u >> 16) & 1u)) >> 16; }
__device__ __forceinline__ float bf2f(unsigned h) { return __uint_as_float(h << 16); }
typedef float f32x2_t __attribute__((ext_vector_type(2))); typedef __bf16 bf16x2_t __attribute__((ext_vector_type(2)));
__device__ __forceinline__ unsigned pk2(float lo, float hi) { f32x2_t v = {lo, hi}; bf16x2_t b = __builtin_convertvector(v, bf16x2_t); return __builtin_bit_cast(unsigned, b); }
__device__ __forceinline__ float bflo(unsigned w) { return __uint_as_float(w << 16); }
__device__ __forceinline__ float bfhi(unsigned w) { return __uint_as_float(w & 0xffff0000u); }
#define WAVE_SUM_DPP(v) ({ float _v = (v); \
    _v += __builtin_bit_cast(float, __builtin_amdgcn_update_dpp(0, __builtin_bit_cast(int, _v), 0xB1, 0xf, 0xf, true));     \
    _v += __builtin_bit_cast(float, __builtin_amdgcn_update_dpp(0, __builtin_bit_cast(int, _v), 0x4E, 0xf, 0xf, true));     \
    _v += __builtin_bit_cast(float, __builtin_amdgcn_update_dpp(0, __builtin_bit_cast(int, _v), 0x141, 0xf, 0xf, true));    \
    _v += __builtin_bit_cast(float, __builtin_amdgcn_update_dpp(0, __builtin_bit_cast(int, _v), 0x140, 0xf, 0xf, true));    \
    _v += __builtin_bit_cast(float, __builtin_amdgcn_update_dpp(0, __builtin_bit_cast(int, _v), 0x142, 0xa, 0xf, false));   \
    _v += __builtin_bit_cast(float, __builtin_amdgcn_update_dpp(0, __builtin_bit_cast(int, _v), 0x143, 0xc, 0xf, false));   \
    __builtin_bit_cast(float, __builtin_amdgcn_readlane(__builtin_bit_cast(int, _v), 63)); })
__device__ __forceinline__ float wave_sum(float v) { return WAVE_SUM_DPP(v); }
#define WAVE_SCAN_DPP(v) ({ unsigned _v = (v); \
    _v += (unsigned)__builtin_amdgcn_update_dpp(0, (int)_v, 0x111, 0xf, 0xf, false); \
    _v += (unsigned)__builtin_amdgcn_update_dpp(0, (int)_v, 0x112, 0xf, 0xf, false); \
    _v += (unsigned)__builtin_amdgcn_update_dpp(0, (int)_v, 0x114, 0xf, 0xf, false); \
    _v += (unsigned)__builtin_amdgcn_update_dpp(0, (int)_v, 0x118, 0xf, 0xf, false); \
    _v += (unsigned)__builtin_amdgcn_update_dpp(0, (int)_v, 0x142, 0xa, 0xf, false); \
    _v += (unsigned)__builtin_amdgcn_update_dpp(0, (int)_v, 0x143, 0xc, 0xf, false); \
    _v; })

__device__ __forceinline__ float silu_f(float a) { return a / (1.0f + __expf(-a)); }
__device__ __forceinline__ float sigmoid_f(float a) { return 1.0f / (1.0f + __expf(-a)); }
#define LDS_FENCE() asm volatile("s_waitcnt lgkmcnt(0)" ::: "memory")

struct UnitInfo {
    const bf16_t* A; int lda;
    const int* rows; int rshift;
    int nvalid;
    const bf16_t* Bt; int ldb;
    int K;
    int orow0;
    int pn;
};

struct DenseSched {
    const bf16_t* A; const bf16_t* Bt; int M, N, K, lda, a_pn_stride; int reps = 1;
    int wrank = -1, wcount = 0;
    __device__ __forceinline__ bool next(int round, UnitInfo& u) const {
        const int nN = N >> 8, nM = M >> 8, nwg = nN * nM;
        if (wcount > 0 && wrank < 0) return false;
        const long L = (wcount > 0) ? ((long)round * wcount + wrank) : ((long)round * gridDim.x + blockIdx.x); if (L >= (long)nwg * reps) return false;
        int wgid = (int)(L % nwg); { const int q = nwg / 8, r = nwg % 8, xcd = wgid % 8, off = wgid / 8; wgid = (xcd < r ? xcd * (q + 1) : r * (q + 1) + (xcd - r) * q) + off; }
        const int nig = 8 * nN, gid = wgid / nig, fm = gid * 8, gsz = (nM - fm) < 8 ? (nM - fm) : 8;
        const int pm = fm + ((wgid % nig) % gsz), pn = (wgid % nig) / gsz;
        u.A = A + (size_t)pm * 256 * lda + (size_t)pn * a_pn_stride; u.lda = lda; u.rows = nullptr; u.rshift = 0; u.nvalid = 256;
        u.Bt = Bt + (size_t)pn * 256 * K; u.ldb = K; u.K = K; u.orow0 = pm * 256; u.pn = pn;
        return true;
    }
};
struct MoeSched {
    const int* tb; const int* cnt; const int* list;
    const bf16_t* A; const bf16_t* W; int K; size_t wstride; bool gather;
    __device__ __forceinline__ bool next(int round, UnitInfo& u) const {
        const int i = round * gridDim.x + blockIdx.x;
        const int j = i >> 2, pn = i & 3;
        if (j >= tb[32]) return false;
        int e = 0;
        while (tb[e + 1] <= j) ++e;
        const int rb = j - tb[e];
        const int nv = min(256, cnt[e * CNT_STRIDE] - rb * 256);
        u.rows = list + (size_t)e * LIST_CAP + rb * 256; u.nvalid = nv; u.orow0 = j * 256; u.pn = pn;
        if (gather) { u.A = A; u.lda = K; u.rshift = 1; }
        else { u.A = A + (size_t)j * 256 * K; u.lda = K; u.rshift = 31;   }
        u.Bt = W + (size_t)e * wstride + (size_t)pn * 256 * K; u.ldb = K; u.K = K;
        return true;
    }
};


namespace pg8 {
#define LAS __attribute__((address_space(3)))
typedef short bf16x8 __attribute__((ext_vector_type(8)));
constexpr int BK = 64, HALF = 128, HTB = HALF * BK * 2, STAGE_BYTES = 8 * HTB;
__device__ __forceinline__ int lds_byte(int r, int c) { const int st = (r >> 4) * 2 + (c >> 5), rr = r & 15, cc = c & 31, ob = rr * 64 + cc * 2; return st * 1024 + (ob ^ (((ob >> 9) & 1) << 5)); }
__device__ __forceinline__ void stage_rc(int b, int& R, int& C) { const int st = b / 1024, sb = b % 1024, swz = sb ^ (((sb >> 9) & 1) << 5); R = (st >> 1) * 16 + swz / 64; C = (st & 1) * 32 + (swz % 64) / 2; }
__device__ __forceinline__ int perm32(int rho) { const int n = rho >> 4, i = rho & 15; return 8 * (i >> 2) + 4 * n + (i & 3); }

template <bool GATHER, class Sched, class Epi, bool BDIAG = false>
__device__ __forceinline__ void gemm_phase(LAS unsigned char* lds, const LAS unsigned* rowtab, const Sched& S, const Epi& E, const int lda, const int ldb, const int K) {
    const int tid = threadIdx.x, wid = __builtin_amdgcn_readfirstlane(tid >> 6), lane = tid & 63, wr = wid >> 2, wc = wid & 3, fr = lane & 15, fq = lane >> 4;
    const int nt = K / BK;
    unsigned voffA[2], voffB[2]; int RA[2]; unsigned CA2[2];
#pragma unroll
    for (int i = 0; i < 2; ++i) { int R, C; stage_rc(tid * 16 + i * 8192, R, C); const int Rb = (R & ~31) + perm32(R & 31);
        voffA[i] = (unsigned)(R * lda + C) * 2u; voffB[i] = (unsigned)(Rb * ldb + C) * 2u; RA[i] = R; CA2[i] = (unsigned)C * 2u; }
    const size_t kstep = (size_t)(BK * 2);
    const size_t hstepA = (size_t)HALF * lda * 2, hstepB = (size_t)HALF * ldb * 2;
    const unsigned ldsw = (unsigned)wid * 1024u;
    const int aoff = lds_byte(wr * 64 + fr, fq * 8), boff = lds_byte(wc * 32 + fr, fq * 8);
    unsigned offA[2][2];
#define PG8_SA(b, h) (((b) * 2 + (h)) * HTB)
#define PG8_SB(b, h) ((4 + (b) * 2 + (h)) * HTB)
#define PG8_STAGE(bufoff, gbase, voff) do { _Pragma("unroll") for (int _i = 0; _i < 2; ++_i) \
        __builtin_amdgcn_global_load_lds((const unsigned*)((const char*)(gbase) + (voff)[_i]), (LAS unsigned*)(lds + (bufoff) + ldsw + _i * 8192), 16, 0, 0); } while (0)
#define PG8_STAGE_A(bufoff, h, gbase) do { if (GATHER) PG8_STAGE(bufoff, gbase, offA[h]); else PG8_STAGE(bufoff, (gbase) + (h) * hstepA, voffA); } while (0)
#define PG8_LOADOFF(round) do { _Pragma("unroll") for (int _h = 0; _h < 2; ++_h) _Pragma("unroll") for (int _i = 0; _i < 2; ++_i) offA[_h][_i] = rowtab[(round) * 256 + _h * 128 + RA[_i]] + CA2[_i]; } while (0)
#define PG8_LDA(dst, b, h) do { _Pragma("unroll") for (int m = 0; m < 4; ++m) _Pragma("unroll") for (int k = 0; k < 2; ++k) dst[m][k] = *(const LAS bf16x8*)(lds + PG8_SA(b, h) + aoff + m * 2048 + k * 1024); } while (0)
#define PG8_LDB(dst, b, h) do { _Pragma("unroll") for (int n = 0; n < 2; ++n) _Pragma("unroll") for (int k = 0; k < 2; ++k) dst[n][k] = *(const LAS bf16x8*)(lds + PG8_SB(b, h) + boff + n * 2048 + k * 1024); } while (0)
#define PG8_MMA(ai, bj, At, Bt) do { if (!BDIAG || (((kt_ >> 2) & 3) == 2 * (bj) + (wc >> 1))) { __builtin_amdgcn_s_setprio(1); _Pragma("unroll") for (int m = 0; m < 4; ++m) _Pragma("unroll") for (int n = 0; n < 2; ++n) _Pragma("unroll") for (int k = 0; k < 2; ++k) \
        acc[ai][bj][m][n] = __builtin_amdgcn_mfma_f32_16x16x32_bf16(Bt[n][k], At[m][k], acc[ai][bj][m][n], 0, 0, 0); __builtin_amdgcn_s_setprio(0); } } while (0)
#define PG8_WAIT_V(n) asm volatile("s_waitcnt vmcnt(" #n ")" ::: "memory")
#define PG8_WAIT_L(n) asm volatile("s_waitcnt lgkmcnt(" #n ")" ::: "memory")
#define PG8_BAR __builtin_amdgcn_s_barrier()
#define PG8_SCHED __builtin_amdgcn_sched_barrier(0)
    UnitInfo cur, nxt; int ui = 0;
    if (!S.next(0, cur)) return;
    f32x4 acc[2][2][4][2];
#pragma unroll
    for (int a = 0; a < 2; ++a)
#pragma unroll
        for (int b = 0; b < 2; ++b)
#pragma unroll
            for (int m = 0; m < 4; ++m)
#pragma unroll
                for (int n = 0; n < 2; ++n) acc[a][b][m][n] = (f32x4){0.f, 0.f, 0.f, 0.f};
    bf16x8 At[4][2], B0[2][2], B1[2][2];
    const char* cA = (const char*)cur.A; const char* cB = (const char*)cur.Bt;
    if (GATHER) { PG8_LOADOFF(0); }
    PG8_STAGE(PG8_SB(0, 0), cB, voffB); PG8_STAGE(PG8_SB(0, 1), cB + hstepB, voffB); PG8_STAGE_A(PG8_SA(0, 0), 0, cA); PG8_STAGE_A(PG8_SA(0, 1), 1, cA);
    if (wr == 1) PG8_BAR;
    PG8_WAIT_V(2); PG8_BAR;
    PG8_STAGE(PG8_SB(1, 0), cB + kstep, voffB); PG8_STAGE_A(PG8_SA(1, 0), 0, cA + kstep); PG8_STAGE(PG8_SB(1, 1), cB + hstepB + kstep, voffB);
    PG8_WAIT_V(6); PG8_BAR;
    for (;;) {
        const bool has_next = S.next(ui + 1, nxt);
        const char* nA = has_next ? (const char*)nxt.A : cA; const char* nB = has_next ? (const char*)nxt.Bt : cB;
        for (int t = 0; t < nt; t += 2) {
            const bool last = (t == nt - 2);
            const char* a1 = cA + (size_t)(t + 1) * kstep;
            const char* a2 = last ? nA : cA + (size_t)(t + 2) * kstep; const char* b2 = last ? nB : cB + (size_t)(t + 2) * kstep;
            const char* a3 = a2 + kstep; const char* b3 = b2 + kstep;
            int kt_ = t;
            PG8_LDB(B0, 0, 0); PG8_LDB(B1, 0, 1); PG8_SCHED; PG8_LDA(At, 0, 0); PG8_STAGE_A(PG8_SA(1, 1), 1, a1);
            if (GATHER) { if (last && has_next) { PG8_LOADOFF(ui + 1); } }
            PG8_WAIT_V(8); PG8_WAIT_L(0); PG8_BAR; PG8_MMA(0, 0, At, B0); PG8_MMA(0, 1, At, B1); PG8_BAR; PG8_SCHED;
            PG8_LDA(At, 0, 1); PG8_STAGE(PG8_SB(0, 0), b2, voffB); PG8_STAGE(PG8_SB(0, 1), b2 + hstepB, voffB); PG8_STAGE_A(PG8_SA(0, 0), 0, a2);
            PG8_WAIT_V(8); PG8_WAIT_L(0); PG8_BAR; PG8_MMA(1, 0, At, B0); PG8_MMA(1, 1, At, B1); PG8_BAR; PG8_SCHED;
            kt_ = t + 1;
            PG8_LDB(B0, 1, 0); PG8_LDB(B1, 1, 1); PG8_SCHED; PG8_LDA(At, 1, 0); PG8_STAGE_A(PG8_SA(0, 1), 1, a2);
            PG8_WAIT_V(8); PG8_WAIT_L(0); PG8_BAR; PG8_MMA(0, 0, At, B0); PG8_MMA(0, 1, At, B1); PG8_BAR; PG8_SCHED;
            PG8_LDA(At, 1, 1); PG8_STAGE(PG8_SB(1, 0), b3, voffB); PG8_STAGE(PG8_SB(1, 1), b3 + hstepB, voffB); PG8_STAGE_A(PG8_SA(1, 0), 0, a3);
            PG8_WAIT_V(8); PG8_WAIT_L(0); PG8_BAR; PG8_MMA(1, 0, At, B0); PG8_MMA(1, 1, At, B1); PG8_BAR; PG8_SCHED;
        }
        if (wr == 0) PG8_BAR;
        if constexpr (Epi::NPRE > 0) {
#pragma unroll
            for (int ai = 0; ai < 2; ++ai) {
                u32x4 pre[8 * Epi::NPRE];
#pragma unroll
                for (int m = 0; m < 4; ++m)
#pragma unroll
                    for (int bj = 0; bj < 2; ++bj) E.pre(cur, ai * HALF + wr * 64 + m * 16 + fr, bj * HALF + wc * 32 + 8 * fq, &pre[(m * 2 + bj) * Epi::NPRE]);
                PG8_SCHED;
#pragma unroll
                for (int m = 0; m < 4; ++m)
#pragma unroll
                    for (int bj = 0; bj < 2; ++bj) E.post(cur, ai * HALF + wr * 64 + m * 16 + fr, bj * HALF + wc * 32 + 8 * fq, acc[ai][bj][m][0], acc[ai][bj][m][1], &pre[(m * 2 + bj) * Epi::NPRE]);
                PG8_SCHED;
            }
        } else {
#pragma unroll
        for (int ai = 0; ai < 2; ++ai)
#pragma unroll
            for (int m = 0; m < 4; ++m)
#pragma unroll
                for (int bj = 0; bj < 2; ++bj) E(cur, ai * HALF + wr * 64 + m * 16 + fr, bj * HALF + wc * 32 + 8 * fq, acc[ai][bj][m][0], acc[ai][bj][m][1]);
        }
        if (!has_next) break;
#pragma unroll
        for (int a = 0; a < 2; ++a)
#pragma unroll
            for (int b = 0; b < 2; ++b)
#pragma unroll
                for (int m = 0; m < 4; ++m)
#pragma unroll
                    for (int n = 0; n < 2; ++n) acc[a][b][m][n] = (f32x4){0.f, 0.f, 0.f, 0.f};
        cur = nxt; cA = nA; cB = nB; ++ui;
        if (wr == 1) PG8_BAR;
    }
    PG8_WAIT_V(0);
    PG8_BAR;
#undef PG8_SA
#undef PG8_SB
#undef PG8_STAGE
#undef PG8_STAGE_A
#undef PG8_LOADOFF
#undef PG8_LDA
#undef PG8_LDB
#undef PG8_MMA
#undef PG8_WAIT_V
#undef PG8_WAIT_L
#undef PG8_BAR
#undef PG8_SCHED
}
}

template <class Sched, class Epi>
__device__ __forceinline__ void gemm_dense(unsigned char* lds, const Sched& S, const Epi& E) {
    pg8::gemm_phase<false>((LAS unsigned char*)lds, (const LAS unsigned*)nullptr, S, E, S.lda, S.K, S.K);
    __syncthreads();
}
template <class Sched, class Epi>
__device__ __forceinline__ void gemm_dense_bdiag(unsigned char* lds, const Sched& S, const Epi& E) {
    pg8::gemm_phase<false, Sched, Epi, true>((LAS unsigned char*)lds, (const LAS unsigned*)nullptr, S, E, S.lda, S.K, S.K);
    __syncthreads();
}


template <bool GATHER, class Epi>
__device__ __forceinline__ void gemm_moe(unsigned char* lds, const MoeSched& S, const Epi& E) {
    LAS unsigned* rowtab = (LAS unsigned*)(lds + MISC_OFF + 256);
    if (GATHER) {
        for (int r0 = 0; r0 < 10; r0 += 5) {
            const int* rp[5]; int nv[5]; bool ok[5]; int v[5];
#pragma unroll
            for (int q = 0; q < 5; ++q) { UnitInfo u; ok[q] = S.next(r0 + q, u); rp[q] = u.rows; nv[q] = ok[q] ? u.nvalid : 0; }
#pragma unroll
            for (int q = 0; q < 5; ++q) v[q] = (threadIdx.x < 256 && (int)threadIdx.x < nv[q]) ? rp[q][threadIdx.x] : 0;
#pragma unroll
            for (int q = 0; q < 5; ++q) if (ok[q] && threadIdx.x < 256) rowtab[(r0 + q) * 256 + threadIdx.x] = (unsigned)(v[q] >> 1) * (unsigned)(S.K * 2);
            if (!ok[4]) break;
        }
        __syncthreads();
    }
    pg8::gemm_phase<GATHER>((LAS unsigned char*)lds, (const LAS unsigned*)rowtab, S, E, S.K, S.K, S.K);
    __syncthreads();
}

__device__ __forceinline__ u32x4 pack8(f32x4 a, f32x4 b) { u32x4 w; w.x = pk2(a.x, a.y); w.y = pk2(a.z, a.w); w.z = pk2(b.x, b.y); w.w = pk2(b.z, b.w); return w; }
struct EpiStoreBf16 {
    static constexpr int NPRE = 0;
    bf16_t* O; int ldc; int coff; const float* colscale;
    __device__ __forceinline__ void operator()(const UnitInfo& u, int r, int c, f32x4 v0, f32x4 v1) const {
        const int col = u.pn * 256 + c;
        if (colscale) { const f32x4 s0 = *(const f32x4*)(colscale + col), s1 = *(const f32x4*)(colscale + col + 4); v0 *= s0; v1 *= s1; }
        *(u32x4*)(O + (size_t)(u.orow0 + r) * ldc + coff + col) = pack8(v0, v1);
    }
};

struct EpiStoreBf16S {
    static constexpr int NPRE = 2;
    bf16_t* O; int ldc; int coff; const float* colscale;
    __device__ __forceinline__ void pre(const UnitInfo& u, int r, int c, u32x4* p) const {
        const int col = u.pn * 256 + c; p[0] = *(const u32x4*)(colscale + col); p[1] = *(const u32x4*)(colscale + col + 4); }
    __device__ __forceinline__ void post(const UnitInfo& u, int r, int c, f32x4 v0, f32x4 v1, const u32x4* p) const {
        const int col = u.pn * 256 + c;
        v0 *= __builtin_bit_cast(f32x4, p[0]); v1 *= __builtin_bit_cast(f32x4, p[1]);
        *(u32x4*)(O + (size_t)(u.orow0 + r) * ldc + coff + col) = pack8(v0, v1);
    }
};

__device__ __forceinline__ float ret_log2g(int h) { return log2f(1.0f - exp2f(-5.0f - (float)h)); }
struct EpiZ0 {
    static constexpr int NPRE = 0;
    bf16_t* O;
    __device__ __forceinline__ void operator()(const UnitInfo& u, int r, int c, f32x4 v0, f32x4 v1) const {
        const int col = u.pn * 256 + c, row = u.orow0 + r;
        if (col < 1024) { const float e = ret_log2g((col >> 7) & 3) * (float)(row & 127); const float sc = exp2f(col < 512 ? e : -e); v0 *= sc; v1 *= sc; }
        *(u32x4*)(O + (size_t)row * ZW + col) = pack8(v0, v1);
    }
};

struct EpiStoreFp8 {
    static constexpr int NPRE = 0;
    unsigned char* O; int ldc;
    __device__ __forceinline__ void operator()(const UnitInfo& u, int r, int c, f32x4 v0, f32x4 v1) const {
        int w0 = __builtin_amdgcn_cvt_pk_fp8_f32(v0.x, v0.y, 0, false); w0 = __builtin_amdgcn_cvt_pk_fp8_f32(v0.z, v0.w, w0, true);
        int w1 = __builtin_amdgcn_cvt_pk_fp8_f32(v1.x, v1.y, 0, false); w1 = __builtin_amdgcn_cvt_pk_fp8_f32(v1.z, v1.w, w1, true);
        u32x2 w; w.x = (unsigned)w0; w.y = (unsigned)w1;
        *(u32x2*)(O + (size_t)(u.orow0 + r) * ldc + u.pn * 256 + c) = w;
    }
};
struct EpiResidB {
    static constexpr int NPRE = 1;
    const bf16_t* X; bf16_t* Yo;
    __device__ __forceinline__ void pre(const UnitInfo& u, int r, int c, u32x4* p) const { p[0] = *(const u32x4*)(X + (size_t)(u.orow0 + r) * DM + u.pn * 256 + c); }
    __device__ __forceinline__ void post(const UnitInfo& u, int r, int c, f32x4 v0, f32x4 v1, const u32x4* p) const {
        const size_t off = (size_t)(u.orow0 + r) * DM + u.pn * 256 + c;
        const u32x4 xw = p[0];
        const f32x4 x0 = {bflo(xw.x), bfhi(xw.x), bflo(xw.y), bfhi(xw.y)}, x1 = {bflo(xw.z), bfhi(xw.z), bflo(xw.w), bfhi(xw.w)};
        *(u32x4*)(Yo + off) = pack8(x0 * ALPHA + v0, x1 * ALPHA + v1);
    }
};

struct EpiGU {
    static constexpr int NPRE = 0;
    bf16_t* ACT;
    __device__ __forceinline__ void operator()(const UnitInfo& u, int r, int c, f32x4 v0, f32x4 v1) const {
        u32x2 w; w.x = pk2(silu_f(v0.x) * v0.y, silu_f(v0.z) * v0.w); w.y = pk2(silu_f(v1.x) * v1.y, silu_f(v1.z) * v1.w);
        *(u32x2*)(ACT + (size_t)(u.orow0 + r) * 512 + u.pn * 128 + (c >> 1)) = w;
    }
};
struct EpiDown {
    static constexpr int NPRE = 1;
    bf16_t* YS;
    __device__ __forceinline__ void pre(const UnitInfo& u, int r, int c, u32x4* p) const { p[0].x = (unsigned)u.rows[r]; }
    __device__ __forceinline__ void post(const UnitInfo& u, int r, int c, f32x4 v0, f32x4 v1, const u32x4* p) const {
        const int pair = (r < u.nvalid) ? (int)p[0].x : 2 * NTOK;
        *(u32x4*)(YS + (size_t)pair * DM + u.pn * 256 + c) = pack8(v0, v1);
    }
};
struct EpiPle {
    static constexpr int NPRE = 2;
    const bf16_t* XI; const bf16_t* PP; float* OUT; bf16_t* XO;
    __device__ __forceinline__ void pre(const UnitInfo& u, int r, int c, u32x4* p) const {
        const size_t off = (size_t)(u.orow0 + r) * DM + u.pn * 256 + c; p[0] = *(const u32x4*)(PP + off); p[1] = *(const u32x4*)(XI + off); }
    __device__ __forceinline__ void post(const UnitInfo& u, int r, int c, f32x4 v0, f32x4 v1, const u32x4* p) const {
        const size_t off = (size_t)(u.orow0 + r) * DM + u.pn * 256 + c;
        const u32x4 pw = p[0], xw = p[1];
        f32x4 f0 = {bflo(xw.x), bfhi(xw.x), bflo(xw.y), bfhi(xw.y)}, f1 = {bflo(xw.z), bfhi(xw.z), bflo(xw.w), bfhi(xw.w)};
        f0.x += sigmoid_f(v0.x) * bflo(pw.x); f0.y += sigmoid_f(v0.y) * bfhi(pw.x); f0.z += sigmoid_f(v0.z) * bflo(pw.y); f0.w += sigmoid_f(v0.w) * bfhi(pw.y);
        f1.x += sigmoid_f(v1.x) * bflo(pw.z); f1.y += sigmoid_f(v1.y) * bfhi(pw.z); f1.z += sigmoid_f(v1.z) * bflo(pw.w); f1.w += sigmoid_f(v1.w) * bfhi(pw.w);
        if (OUT) { *(f32x4*)(OUT + off) = f0; *(f32x4*)(OUT + off + 4) = f1; }
        if (XO) *(u32x4*)(XO + off) = pack8(f0, f1);
    }
};

struct TrDesc { const float* src; bf16_t* dst; int K, N, Nsrc, nbatch, mode, dst_ld; };
struct TrItem { const float* src; bf16_t* dst; int Nsrc, dst_ld, mode, kb, nb; };
__device__ __forceinline__ void tr_load(const TrItem& t, int lane, float (&tmp)[32]) {
    const int k0 = 64 * t.kb, n0 = 32 * t.nb, Ns = t.Nsrc;
    const bool okc = (n0 + (lane & 31)) < Ns;
    const float* p = t.src + (size_t)(k0 + (lane >> 5)) * Ns + n0 + (lane & 31);
#pragma unroll
    for (int i = 0; i < 32; ++i) { tmp[i] = okc ? __builtin_nontemporal_load(p) : 0.f; p += 2 * Ns; asm volatile("" : "+v"(p)); }
}
__device__ __forceinline__ void tr_store(const TrItem& t, float* scr, int lane, const float (&tmp)[32]) {
    const int k0 = 64 * t.kb, n0 = 32 * t.nb;
#pragma unroll
    for (int i = 0; i < 32; ++i) scr[(2 * i + (lane >> 5)) * 33 + (lane & 31)] = tmp[i];
    LDS_FENCE();
    const int c = lane & 7;
    int n8 = lane >> 3; asm volatile("" : "+v"(n8));
#pragma unroll
    for (int j = 0; j < 4; ++j) {
        const int n = n8 + 8 * j; const float* sp = scr + (8 * c) * 33 + n;
        const int ng = n0 + n;
        float sc = 1.f; int nd = ng; int coff = 0;
        if (t.mode == 1) { if (ng >= 512 && ng < 1024) sc = 0.08838834764831845f; }
        if (t.mode == 2) { nd = (ng < 512) ? 2 * ng : 2 * (ng - 512) + 1; }
        if (t.mode == 3) { coff = ((ng >> 6) & 3) * 256; }
        u32x4 o; o.x = pk2(sp[0 * 33] * sc, sp[1 * 33] * sc); o.y = pk2(sp[2 * 33] * sc, sp[3 * 33] * sc); o.z = pk2(sp[4 * 33] * sc, sp[5 * 33] * sc); o.w = pk2(sp[6 * 33] * sc, sp[7 * 33] * sc);
        *(u32x4*)(t.dst + (size_t)nd * t.dst_ld + coff + k0 + 8 * c) = o;
    }
    LDS_FENCE();
}
__device__ __forceinline__ int tr_items(const TrDesc& d) { return d.nbatch * (d.K / 64) * (d.N / 32); }

constexpr int N_DEFERRED = 32 * 512 + 32 * 256;
__device__ __forceinline__ TrItem deferred_item(const Params& P, int idx) {
    TrItem t;
    if (idx < 32 * 512) { const int b = 32 + (idx >> 9), r = idx & 511;
        t.src = P.in[22] + (size_t)b * 1024 * 1024; t.dst = (bf16_t*)(P.ws + WS_W_GU) + (size_t)b * 1024 * 1024; t.Nsrc = 1024; t.dst_ld = 1024; t.mode = 2; t.kb = r >> 5; t.nb = r & 31; }
    else { const int i2 = idx - 32 * 512, b = 32 + (i2 >> 8), r = i2 & 255;
        t.src = P.in[23] + (size_t)b * 512 * 1024; t.dst = (bf16_t*)(P.ws + WS_W_DN) + (size_t)b * 1024 * 512; t.Nsrc = 1024; t.dst_ld = 512; t.mode = 0; t.kb = r >> 5; t.nb = r & 31; }
    return t;
}
__device__ __forceinline__ void phase_prep(const Params& P, unsigned char* lds) {
    unsigned char* ws = P.ws;
    const int tid = threadIdx.x, lane = tid & 63, wave = tid >> 6;
    const int gw = blockIdx.x * NWAVE + wave, NGW = gridDim.x * NWAVE;
    float* scr = (float*)lds + wave * (64 * 33);
    constexpr int ND = 9;
    TrDesc d[ND];
    d[0] = {P.in[22], (bf16_t*)(ws + WS_W_GU), 1024, 1024, 1024, 32, 2, 1024};
    d[1] = {P.in[23], (bf16_t*)(ws + WS_W_DN), 512, 1024, 1024, 32, 0, 512};
    d[2] = {P.in[2], (bf16_t*)(ws + WS_W_IN0), 1024, 2560, 2560, 1, 1, 1024};
    d[3] = {P.in[6], (bf16_t*)(ws + WS_W_OUT0), 1024, 1024, 1024, 1, 0, 1024};
    d[4] = {P.in[13], (bf16_t*)(ws + WS_W_COUT), 1024, 1024, 1024, 1, 0, 1024};
    d[5] = {P.in[24], (bf16_t*)(ws + WS_W_G), 1024, 1024, 1024, 2, 0, 1024};
    d[6] = {P.in[25], (bf16_t*)(ws + WS_W_P), 256, 1024, 1024, 2, 0, 256};
    d[7] = {P.in[7], (bf16_t*)(ws + WS_W_CIN), 1024, Z1W, CIN, 1, 0, 1024};
    d[8] = {P.in[12], (bf16_t*)(ws + WS_W_UVBD), 256, 1024, 1024, 1, 3, 1024};
    int total = 0;
#pragma unroll
    for (int i = 0; i < ND; ++i) total += tr_items(d[i]);
#define TR_DECODE(it, T) do { int _r = (it); bool _f = false; T = TrItem{nullptr, nullptr, 0, 0, 0, 0, 0}; _Pragma("unroll") for (int _i = 0; _i < ND; ++_i) { const int _n = tr_items(d[_i]); \
            if (!_f && _r < _n) { _f = true; const int _per = (d[_i].K / 64) * (d[_i].N / 32), _b = _r / _per, _q = _r % _per, _nblk = d[_i].N / 32; \
                T.src = d[_i].src + (size_t)_b * d[_i].K * d[_i].Nsrc; T.dst = d[_i].dst + (size_t)_b * d[_i].N * d[_i].dst_ld; T.Nsrc = d[_i].Nsrc; T.dst_ld = d[_i].dst_ld; T.mode = d[_i].mode; T.kb = _q / _nblk; T.nb = _q % _nblk; } \
            if (!_f) _r -= _n; } } while (0)
    {
        float cur[32], nxt[32];
        TrItem tc, tn;
        int it = gw;
        if (it < total) { TR_DECODE(it, tc); tr_load(tc, lane, cur); }
        while (it < total) {
            const int itn = it + NGW;
            if (itn < total) { TR_DECODE(itn, tn); tr_load(tn, lane, nxt); }
            tr_store(tc, scr, lane, cur);
#pragma unroll
            for (int i = 0; i < 32; ++i) cur[i] = nxt[i];
            it = itn; tc = tn;
        }
    }
#undef TR_DECODE
    const size_t gt = (size_t)blockIdx.x * NT + tid, GS = (size_t)gridDim.x * NT;
    {
        bf16_t* o = (bf16_t*)(ws + WS_W_POOL); const float* pw = P.in[4];
        for (size_t i = gt; i < 512 * 256; i += GS) { const int n = (int)(i >> 8), k = (int)(i & 255), g = n >> 7, dd = n & 127, kg = k >> 7, c = k & 127;
            o[i] = (bf16_t)((kg == (g & 1)) ? f2bf(pw[((size_t)g * 128 + c) * 128 + dd]) : 0u); }
    }
    {
        u32x4* o = (u32x4*)(ws + WS_W_UVBD);
        for (size_t i = gt; i < (size_t)1024 * 1024 / 8; i += GS) { const int n = (int)(i >> 7), k = (int)(i & 127) * 8; if (((n >> 6) & 3) != (k >> 8)) o[i] = (u32x4){0u, 0u, 0u, 0u}; }
    }
    {
        bf16_t* o = (bf16_t*)(ws + WS_W_QA); const float* uq = P.in[10]; const float* uk = P.in[11];
        float* Bq = (float*)lds; float* Ak = Bq + 256 * 65;
        for (int item = blockIdx.x; item < 256; item += gridDim.x) {
            const int h = item >> 4, c0 = (item & 15) * 16;
            __syncthreads();
            {   f32x4 v[8];
#pragma unroll
                for (int q = 0; q < 8; ++q) { const int i = tid + NT * q, r = i >> 4, d4 = (i & 15) * 4; v[q] = *(const f32x4*)(uq + (size_t)r * 1024 + h * 64 + d4); }
                f32x4 vk = {0.f, 0.f, 0.f, 0.f};
                if (tid < 256) { const int c = tid >> 4, d4 = (tid & 15) * 4; vk = *(const f32x4*)(uk + (size_t)(c0 + c) * 1024 + h * 64 + d4); }
#pragma unroll
                for (int q = 0; q < 8; ++q) { const int i = tid + NT * q, r = i >> 4, d4 = (i & 15) * 4; float* qd = Bq + r * 65 + d4; qd[0] = v[q].x; qd[1] = v[q].y; qd[2] = v[q].z; qd[3] = v[q].w; }
                if (tid < 256) { const int c = tid >> 4, d4 = (tid & 15) * 4; float* qd = Ak + c * 65 + d4; qd[0] = vk.x; qd[1] = vk.y; qd[2] = vk.z; qd[3] = vk.w; }
            }
            __syncthreads();
            const int r = tid & 255, cg = tid >> 8;
            float acc[8];
#pragma unroll
            for (int j = 0; j < 8; ++j) acc[j] = 0.f;
#pragma unroll 8
            for (int dd = 0; dd < 64; ++dd) { const float bv = Bq[r * 65 + dd];
#pragma unroll
                for (int j = 0; j < 8; ++j) acc[j] += Ak[(cg * 8 + j) * 65 + dd] * bv; }
#pragma unroll
            for (int j = 0; j < 8; ++j) o[(size_t)(h * 256 + c0 + cg * 8 + j) * 256 + r] = (bf16_t)f2bf(acc[j] * 0.125f);
        }
        __syncthreads();
    }
    {
        bf16_t* GT = (bf16_t*)(ws + WS_GT); float* SGB = (float*)(ws + WS_SGB);
        for (size_t i = gt; i < (size_t)2 * 48 * 1024; i += GS) {
            const int l = (int)(i / (48 * 1024)), j = (int)((i / 1024) % 48), c = (int)(i & 1023);
            float w = 0.f;
            if (j < 4) w = P.in[18][(size_t)l * DM * 4 + (size_t)c * 4 + j]; else if (j < 36) w = P.in[20][(size_t)l * DM * 32 + (size_t)c * 32 + (j - 4)];
            const float g = P.in[14][l * DM + c] * w;
            const unsigned hi = f2bf(g); const unsigned lo = f2bf(g - bf2f(hi));
            GT[((size_t)(l * 2 + 0) * 48 + j) * 1024 + c] = (bf16_t)hi; GT[((size_t)(l * 2 + 1) * 48 + j) * 1024 + c] = (bf16_t)lo;
        }
        for (int it = NGW - 1 - gw; it < 96; it += NGW) {
            const int l = it / 48, j = it % 48; float sg = 0.f, sb = 0.f;
#pragma unroll
            for (int c = lane; c < 1024; c += 64) {
                float w = 0.f;
                if (j < 4) w = P.in[18][(size_t)l * DM * 4 + (size_t)c * 4 + j]; else if (j < 36) w = P.in[20][(size_t)l * DM * 32 + (size_t)c * 32 + (j - 4)];
                sg += P.in[14][l * DM + c] * w; sb += P.in[15][l * DM + c] * w;
            }
            sg = wave_sum(sg); sb = wave_sum(sb);
            const float bias = (j < 4) ? P.in[19][l * 4 + j] : ((j < 36) ? P.in[21][l * 32 + (j - 4)] : 0.f);
            if (lane == 0) { SGB[(l * 2 + 0) * 48 + j] = sg; SGB[(l * 2 + 1) * 48 + j] = sb + bias; }
        }
    }
    {
        const f32x4* x = (const f32x4*)P.in[0]; u32x4* xb = (u32x4*)(ws + WS_XB);
        const size_t nx = (size_t)NTOK * DM / 8, np = (size_t)2 * NTOK * 256 / 8;
        size_t i = gt;
        for (; i + 3 * GS < nx; i += 4 * GS) { f32x4 a[8];
#pragma unroll
            for (int q = 0; q < 4; ++q) { a[2 * q] = __builtin_nontemporal_load(x + 2 * (i + q * GS)); a[2 * q + 1] = __builtin_nontemporal_load(x + 2 * (i + q * GS) + 1); }
#pragma unroll
            for (int q = 0; q < 4; ++q) xb[i + q * GS] = pack8(a[2 * q], a[2 * q + 1]); }
        for (; i < nx; i += GS) xb[i] = pack8(x[2 * i], x[2 * i + 1]);
        const f32x4* p = (const f32x4*)P.in[1]; u32x4* pb = (u32x4*)(ws + WS_PB);
        i = gt;
        for (; i + 3 * GS < np; i += 4 * GS) { f32x4 a[8];
#pragma unroll
            for (int q = 0; q < 4; ++q) { a[2 * q] = __builtin_nontemporal_load(p + 2 * (i + q * GS)); a[2 * q + 1] = __builtin_nontemporal_load(p + 2 * (i + q * GS) + 1); }
#pragma unroll
            for (int q = 0; q < 4; ++q) pb[i + q * GS] = pack8(a[2 * q], a[2 * q + 1]); }
        for (; i < np; i += GS) pb[i] = pack8(p[2 * i], p[2 * i + 1]);
    }
}


template <bool DRY>
__device__ __forceinline__ void phase_ln_route(const Params& P, unsigned char* lds, int layer) {
    using pg8::bf16x8;
    const bf16_t* F = (const bf16_t*)(P.ws + WS_F); bf16_t* XB = (bf16_t*)(P.ws + (DRY ? WS_M0 + 128 * MiB : WS_XB));
    float* TOKG = (float*)(P.ws + WS_TOKG); int* LIST = (int*)(P.ws + WS_LIST);
    int* CNT = (int*)(P.ws + WS_CTL + CTL_CNT_OFF) + layer * 32 * CNT_STRIDE;
    const float* lg = P.in[14] + layer * DM; const float* lb = P.in[15] + layer * DM;
    const bf16_t* GTh = (const bf16_t*)(P.ws + WS_GT) + (size_t)(layer * 2) * 48 * 1024; const bf16_t* GTl = GTh + 48 * 1024;
    const float* SG = (const float*)(P.ws + WS_SGB) + (layer * 2) * 48; const float* BB = SG + 48;
    const int tid = threadIdx.x, lane = tid & 63, wave = tid >> 6, r16 = lane & 15, g = lane >> 4;
    int* dec = (int*)lds;
    int* rank = dec + 256;
    int* lcnt = rank + 256;
    int* lbase = lcnt + 32;
    float* SS = (float*)(lds + 4096);
    float* stat = SS + wave * 32;
    float* LGs = (float*)(lds + 8192);
    float* LG = LGs + wave * (16 * 52);
    float* PP_ = (float*)(lds + 36864);
    float* PS = (float*)(lds + 36864 + 8 * 64 * 52 * 4);
    for (int rb = blockIdx.x; rb < NTOK / 128; rb += gridDim.x) {
        if (tid < 32) lcnt[tid] = 0;
        __syncthreads();
        const int tbase = rb * 128 + wave * 16;
        {
            bf16x8 GH[12], GL[12];
            {   int r16l = r16; asm volatile("" : "+v"(r16l));
                const bf16_t* hp = GTh + (size_t)r16l * 1024 + 128 * wave + 8 * g; const bf16_t* lp = GTl + (size_t)r16l * 1024 + 128 * wave + 8 * g;
#pragma unroll
                for (int ks = 0; ks < 4; ++ks)
#pragma unroll
                    for (int i = 0; i < 3; ++i) { GH[ks * 3 + i] = *(const bf16x8*)(hp + (size_t)i * 16 * 1024 + 32 * ks); GL[ks * 3 + i] = *(const bf16x8*)(lp + (size_t)i * 16 * 1024 + 32 * ks); } }
            const bf16_t* yp = F + (size_t)(rb * 128 + r16) * DM + 128 * wave + 8 * g;
#pragma unroll 1
            for (int half = 0; half < ((DRY && PROBE_LN == 1) ? 0 : 2); ++half) {
#pragma unroll 1
              for (int rp = 0; rp < 2; ++rp) {
                u32x4 YW[8];
#pragma unroll
                for (int rt2 = 0; rt2 < 2; ++rt2) {
#pragma unroll
                    for (int ks = 0; ks < 4; ++ks) YW[rt2 * 4 + ks] = *(const u32x4*)(yp + 32 * ks);
                    yp += 16 * DM; asm volatile("" : "+v"(yp)); }
                __builtin_amdgcn_sched_barrier(0);
#pragma unroll
                for (int rt2 = 0; rt2 < 2; ++rt2) {
                    const int rt4 = rp * 2 + rt2;
                    f32x4 acc[3];
#pragma unroll
                    for (int i = 0; i < 3; ++i) acc[i] = (f32x4){0.f, 0.f, 0.f, 0.f};
                    float sm = 0.f, sq = 0.f;
#pragma unroll
                    for (int ks = 0; ks < 4; ++ks) {
                        const u32x4 yw = YW[rt2 * 4 + ks];
                        const float y0 = bflo(yw.x), y1 = bfhi(yw.x), y2 = bflo(yw.y), y3 = bfhi(yw.y), y4 = bflo(yw.z), y5 = bfhi(yw.z), y6 = bflo(yw.w), y7 = bfhi(yw.w);
                        sm += (y0 + y1) + (y2 + y3) + (y4 + y5) + (y6 + y7);
                        sq += (y0 * y0 + y1 * y1) + (y2 * y2 + y3 * y3) + (y4 * y4 + y5 * y5) + (y6 * y6 + y7 * y7);
                        const bf16x8 yh = __builtin_bit_cast(bf16x8, yw);
#pragma unroll
                        for (int i = 0; i < 3; ++i) {
                            acc[i] = __builtin_amdgcn_mfma_f32_16x16x32_bf16(yh, GH[ks * 3 + i], acc[i], 0, 0, 0);
                            acc[i] = __builtin_amdgcn_mfma_f32_16x16x32_bf16(yh, GL[ks * 3 + i], acc[i], 0, 0, 0);
                        }
                    }
                    sm += __shfl_xor(sm, 16); sm += __shfl_xor(sm, 32); sq += __shfl_xor(sq, 16); sq += __shfl_xor(sq, 32);
                    if (g == 0) { PS[(wave * 64 + 16 * rt4 + r16) * 2] = sm; PS[(wave * 64 + 16 * rt4 + r16) * 2 + 1] = sq; }
#pragma unroll
                    for (int i = 0; i < 3; ++i)
#pragma unroll
                        for (int r = 0; r < 4; ++r) PP_[(wave * 64 + 16 * rt4 + 4 * g + r) * 52 + 16 * i + r16] = acc[i][r];
                }
                __builtin_amdgcn_sched_barrier(0);
              }
                __syncthreads();
#pragma unroll
                for (int q = 0; q < 6; ++q) { const int idx = tid + NT * q, row = idx / 48, col = idx - row * 48;
                    float a = 0.f;
#pragma unroll
                    for (int w = 0; w < 8; ++w) a += PP_[(w * 64 + row) * 52 + col];
                    LGs[(half * 64 + row) * 52 + col] = a; }
                if (tid < 128) { float a = 0.f;
#pragma unroll
                    for (int w = 0; w < 8; ++w) a += PS[w * 128 + tid];
                    SS[half * 128 + tid] = a; }
                __syncthreads();
            }
        }
        {
            int tid_l = tid; asm volatile("" : "+v"(tid_l));
            const int t = tid_l >> 2, c0 = (tid_l & 3) * 12;
            const float s1 = SS[t * 2], s2 = SS[t * 2 + 1];
            const float mean = s1 * (1.0f / DM), var = fmaxf(s2 * (1.0f / DM) - mean * mean, 0.f), rstd = 1.0f / sqrtf(var + LN_EPS);
#pragma unroll
            for (int c = 0; c < 12; ++c) LGs[t * 52 + c0 + c] = rstd * (LGs[t * 52 + c0 + c] - mean * SG[c0 + c]) + BB[c0 + c];
            __syncthreads();
            if ((tid_l & 3) == 0) { SS[t * 2] = mean; SS[t * 2 + 1] = rstd; }
        }
        __syncthreads();
        if (lane < 16) {
            const float* lr = LG + lane * 52; const int rl = wave * 16 + lane, t = tbase + lane;
            float gl4[4];
#pragma unroll
            for (int j = 0; j < 4; ++j) gl4[j] = lr[j];
            int grp = 0; float gm = gl4[0];
#pragma unroll
            for (int j = 1; j < 4; ++j) if (gl4[j] > gm) { gm = gl4[j]; grp = j; }
            float gs = 0.f;
#pragma unroll
            for (int j = 0; j < 4; ++j) gs += __expf(gl4[j] - gm);
            const float gwt = 1.0f / gs;
            float el[8];
#pragma unroll
            for (int j = 0; j < 8; ++j) el[j] = lr[4 + grp * 8 + j];
            int i0 = 0; float m0 = el[0];
#pragma unroll
            for (int j = 1; j < 8; ++j) if (el[j] > m0) { m0 = el[j]; i0 = j; }
            int i1 = -1; float m1 = -INFINITY;
#pragma unroll
            for (int j = 0; j < 8; ++j) if (j != i0 && el[j] > m1) { m1 = el[j]; i1 = j; }
            const float ex = __expf(m1 - m0);
            const float p0 = 1.0f / (1.0f + ex), p1 = ex / (1.0f + ex);
            dec[rl * 2] = grp * 8 + i0; dec[rl * 2 + 1] = grp * 8 + i1;
            if (!DRY) { TOKG[(size_t)t * 2] = gwt * p0; TOKG[(size_t)t * 2 + 1] = gwt * p1; }
        }
        int lane_l = lane; asm volatile("" : "+v"(lane_l));
        f32x4 g4[4], b4[4];
#pragma unroll
        for (int j = 0; j < 2; ++j) { g4[2 * j] = *(const f32x4*)(lg + 512 * j + 8 * lane_l); g4[2 * j + 1] = *(const f32x4*)(lg + 512 * j + 8 * lane_l + 4);
                                      b4[2 * j] = *(const f32x4*)(lb + 512 * j + 8 * lane_l); b4[2 * j + 1] = *(const f32x4*)(lb + 512 * j + 8 * lane_l + 4); }
#pragma unroll 1
        for (int rg = 0; rg < ((DRY && PROBE_LN == 2) ? 0 : 2); ++rg) {
            const bf16_t* fr = F + (size_t)(tbase + 8 * rg) * DM + 8 * lane_l; bf16_t* xo = XB + (size_t)(tbase + 8 * rg) * DM + 8 * lane_l;
            u32x4 yv[16];
#pragma unroll
            for (int r8 = 0; r8 < 8; ++r8) {
#pragma unroll
                for (int j = 0; j < 2; ++j) yv[2 * r8 + j] = *(const u32x4*)(fr + 512 * j);
                fr += DM; asm volatile("" : "+v"(fr)); }
            __builtin_amdgcn_sched_barrier(0);
#pragma unroll
            for (int r8 = 0; r8 < 8; ++r8) { const int r = 8 * rg + r8;
                const float mu = stat[r * 2], rs = stat[r * 2 + 1];
#pragma unroll
                for (int j = 0; j < 2; ++j) {
                    const u32x4 yw = yv[2 * r8 + j];
                    const f32x4 ya = {bflo(yw.x), bfhi(yw.x), bflo(yw.y), bfhi(yw.y)}, yb = {bflo(yw.z), bfhi(yw.z), bflo(yw.w), bfhi(yw.w)};
                    const f32x4 va = (ya - mu) * rs * g4[2 * j] + b4[2 * j], vb = (yb - mu) * rs * g4[2 * j + 1] + b4[2 * j + 1];
                    u32x4 w; w.x = pk2(va.x, va.y); w.y = pk2(va.z, va.w); w.z = pk2(vb.x, vb.y); w.w = pk2(vb.z, vb.w); *(u32x4*)(xo + 512 * j) = w; }
                xo += DM; asm volatile("" : "+v"(xo)); }
        }
        __syncthreads();
        if (tid < 256) rank[tid] = atomicAdd(&lcnt[dec[tid]], 1);
        __syncthreads();
        if (tid < 32) { int te = tid; asm volatile("" : "+v"(te)); lbase[tid] = DRY ? 0 : atomicAdd(&CNT[te * CNT_STRIDE], lcnt[tid]); }
        __syncthreads();
        if (!DRY && tid < 256) { const int e = dec[tid]; LIST[(size_t)e * LIST_CAP + lbase[e] + rank[tid]] = (rb * 128 + (tid >> 1)) * 2 + (tid & 1); }
        __syncthreads();
    }
}
__device__ __forceinline__ void moe_setup(const Params& P, int* tb, int layer) {
    const int* CNT = (const int*)(P.ws + WS_CTL + CTL_CNT_OFF) + layer * 32 * CNT_STRIDE;
    if (threadIdx.x < 64) {
        const int e = (int)threadIdx.x;
        const unsigned tiles = (e < 32) ? (unsigned)((CNT[e * CNT_STRIDE] + 255) >> 8) : 0u;
        const unsigned inc = WAVE_SCAN_DPP(tiles);
        if (e < 32) tb[e] = (int)(inc - tiles);
        if (e == 31) tb[32] = (int)inc;
    }
    __syncthreads();
}
template <bool DRY>
__device__ __forceinline__ void phase_ln2(const Params& P, int layer) {
    const bf16_t* XI = (const bf16_t*)(P.ws + WS_XB); bf16_t* XO = (bf16_t*)(P.ws + (DRY ? WS_XB2 : WS_XB));
    const bf16_t* YS = (const bf16_t*)(P.ws + WS_YS); const float* TOKG = (const float*)(P.ws + WS_TOKG);
    const float* lg = P.in[16] + layer * DM; const float* lb = P.in[17] + layer * DM;
    const int lane = threadIdx.x & 63, gw = blockIdx.x * NWAVE + (threadIdx.x >> 6), NGW = gridDim.x * NWAVE;
    f32x4 g4[4], b4[4];
#pragma unroll
    for (int j = 0; j < 4; ++j) { g4[j] = *(const f32x4*)(lg + 256 * j + 4 * lane); b4[j] = *(const f32x4*)(lb + 256 * j + 4 * lane); }
    u32x2 nx[4], na[4], nb[4]; float ng0 = 0.f, ng1 = 0.f;
    if (gw < NTOK) { const int t = gw;
#pragma unroll
        for (int j = 0; j < 4; ++j) { const int c0 = 256 * j + 4 * lane; nx[j] = *(const u32x2*)(XI + (size_t)t * DM + c0); na[j] = *(const u32x2*)(YS + (size_t)(2 * t) * DM + c0); nb[j] = *(const u32x2*)(YS + (size_t)(2 * t + 1) * DM + c0); }
        ng0 = TOKG[(size_t)t * 2]; ng1 = TOKG[(size_t)t * 2 + 1]; }
    for (int t = gw; t < NTOK; t += NGW) {
        const float g0 = ng0, g1 = ng1;
        u32x2 xw[4], aw[4], bw[4];
#pragma unroll
        for (int j = 0; j < 4; ++j) { xw[j] = nx[j]; aw[j] = na[j]; bw[j] = nb[j]; }
        if (t + NGW < NTOK) { const int tn = t + NGW;
#pragma unroll
            for (int j = 0; j < 4; ++j) { const int c0 = 256 * j + 4 * lane; nx[j] = *(const u32x2*)(XI + (size_t)tn * DM + c0); na[j] = *(const u32x2*)(YS + (size_t)(2 * tn) * DM + c0); nb[j] = *(const u32x2*)(YS + (size_t)(2 * tn + 1) * DM + c0); }
            ng0 = TOKG[(size_t)tn * 2]; ng1 = TOKG[(size_t)tn * 2 + 1]; }
        f32x4 v[4]; float s = 0.f;
#pragma unroll
        for (int j = 0; j < 4; ++j) {
            const u32x2 x = xw[j], a = aw[j], b = bw[j];
            v[j].x = bflo(x.x) * ALPHA + g0 * bflo(a.x) + g1 * bflo(b.x); v[j].y = bfhi(x.x) * ALPHA + g0 * bfhi(a.x) + g1 * bfhi(b.x);
            v[j].z = bflo(x.y) * ALPHA + g0 * bflo(a.y) + g1 * bflo(b.y); v[j].w = bfhi(x.y) * ALPHA + g0 * bfhi(a.y) + g1 * bfhi(b.y);
            s += (v[j].x + v[j].y) + (v[j].z + v[j].w); }
        const float mean = wave_sum(s) * (1.0f / DM); float s2 = 0.f;
#pragma unroll
        for (int j = 0; j < 4; ++j) { v[j] = v[j] - mean; s2 += (v[j].x * v[j].x + v[j].y * v[j].y) + (v[j].z * v[j].z + v[j].w * v[j].w); }
        const float rstd = 1.0f / sqrtf(wave_sum(s2) * (1.0f / DM) + LN_EPS);
#pragma unroll
        for (int j = 0; j < 4; ++j) { const int c0 = 256 * j + 4 * lane;
            v[j] = v[j] * rstd * g4[j] + b4[j];
            u32x2 w; w.x = pk2(v[j].x, v[j].y); w.y = pk2(v[j].z, v[j].w); *(u32x2*)(XO + (size_t)t * DM + c0) = w; }
    }
}

__device__ __forceinline__ unsigned e5m2enc(float y) {
    const unsigned hb = (unsigned)__builtin_bit_cast(unsigned short, (_Float16)y);
    return ((hb + 0x7fu + ((hb >> 8) & 1u)) >> 8) & 0xffu;
}
__device__ __forceinline__ void phase_norms(const Params& P) {
    const bf16_t* Z1 = (const bf16_t*)(P.ws + WS_Z1); bf16_t* CQ = (bf16_t*)(P.ws + WS_CQ); unsigned char* CKV8 = (unsigned char*)(P.ws + WS_CKV8);
    const float* qn = P.in[8]; const float* kn = P.in[9];
    const int lane = threadIdx.x & 63, gw = blockIdx.x * NWAVE + (threadIdx.x >> 6), NGW = gridDim.x * NWAVE;
    const f32x4 gq = *(const f32x4*)(qn + 4 * lane), gk = *(const f32x4*)(kn + 4 * lane);
    for (int t0 = gw; t0 < NTOK; t0 += 2 * NGW) {
        const int t1 = (t0 + NGW < NTOK) ? t0 + NGW : t0;
        const u32x2 a0 = *(const u32x2*)(Z1 + (size_t)t0 * Z1W + 4 * lane), b0 = *(const u32x2*)(Z1 + (size_t)t0 * Z1W + 256 + 4 * lane);
        const u32x2 a1 = *(const u32x2*)(Z1 + (size_t)t1 * Z1W + 4 * lane), b1 = *(const u32x2*)(Z1 + (size_t)t1 * Z1W + 256 + 4 * lane);
#pragma unroll
        for (int s = 0; s < 2; ++s) {
            const int t = s ? t1 : t0; const u32x2 a = s ? a1 : a0, b = s ? b1 : b0;
            const float q[4] = {bflo(a.x), bfhi(a.x), bflo(a.y), bfhi(a.y)}, k[4] = {bflo(b.x), bfhi(b.x), bflo(b.y), bfhi(b.y)};
            const float sq = wave_sum(q[0] * q[0] + q[1] * q[1] + q[2] * q[2] + q[3] * q[3]), sk = wave_sum(k[0] * k[0] + k[1] * k[1] + k[2] * k[2] + k[3] * k[3]);
            const float rq = 1.0f / sqrtf(sq * (1.0f / 256.0f) + 1e-6f), rk = 1.0f / sqrtf(sk * (1.0f / 256.0f) + 1e-6f);
            u32x2 o; o.x = pk2(q[0] * rq * gq.x, q[1] * rq * gq.y); o.y = pk2(q[2] * rq * gq.z, q[3] * rq * gq.w);
            *(u32x2*)(CQ + (size_t)t * 256 + 4 * lane) = o;
            *(unsigned*)(CKV8 + (size_t)t * 256 + 4 * lane) = e5m2enc(k[0] * rk * gk.x) | (e5m2enc(k[1] * rk * gk.y) << 8) | (e5m2enc(k[2] * rk * gk.z) << 16) | (e5m2enc(k[3] * rk * gk.w) << 24);
        }
    }
}


constexpr int NPH_TOTAL = 23;


typedef short v4i16_t __attribute__((ext_vector_type(4)));


__device__ __forceinline__ void glds16(const void* gsrc, unsigned lds_dst) {
    unsigned keep;
    asm volatile("s_mov_b32 %0, m0\n\ts_mov_b32 m0, %2\n\ts_nop 0\n\tglobal_load_lds_dwordx4 %1, off\n\ts_mov_b32 m0, %0" : "=&s"(keep) : "v"(gsrc), "s"(lds_dst) : "memory");
}
__device__ __forceinline__ void glds16_set(const void* gsrc, unsigned lds_dst) {
    asm volatile("s_mov_b32 m0, %1\n\ts_nop 0\n\tglobal_load_lds_dwordx4 %0, off" : : "v"(gsrc), "s"(lds_dst) : "memory", "m0");
}
template <int OFF> __device__ __forceinline__ void glds16_m0(const void* gsrc) {
    asm volatile("global_load_lds_dwordx4 %0, off offset:%1" : : "v"(gsrc), "n"(OFF) : "memory");
}
__device__ __forceinline__ void glds16s_set(const void* sbase, unsigned voff, unsigned lds_dst) {
    asm volatile("s_mov_b32 m0, %2\n\ts_nop 0\n\tglobal_load_lds_dwordx4 %0, %1" : : "v"(voff), "s"(sbase), "s"(lds_dst) : "memory", "m0");
}
template <int OFF> __device__ __forceinline__ void glds16s_m0(const void* sbase, unsigned voff) {
    asm volatile("global_load_lds_dwordx4 %0, %1 offset:%2" : : "v"(voff), "s"(sbase), "n"(OFF) : "memory");
}
typedef _Float16 f16x8 __attribute__((ext_vector_type(8)));
typedef int v8i_t __attribute__((ext_vector_type(8)));
template <bool DRY>
__device__ __forceinline__ void phase_sparse_attn_e(const Params& P, unsigned char* lds_) {
    const unsigned char* QA = (const unsigned char*)(P.ws + WS_QA); bf16_t* OLAT = (bf16_t*)(P.ws + WS_OLAT); const unsigned char* CKV8 = (const unsigned char*)(P.ws + WS_CKV8); const unsigned short* SEL = (const unsigned short*)(P.ws + WS_SEL);
    const int tid = threadIdx.x, lane = tid & 63, wave = __builtin_amdgcn_readfirstlane(tid >> 6);
    const int fr = lane & 15, fq = lane >> 4;
    LAS unsigned char* cbuf = (LAS unsigned char*)lds_ + wave * 17920;
    LAS unsigned short* selw = (LAS unsigned short*)(cbuf + 16384);
    LAS unsigned* selo = (LAS unsigned*)(cbuf + 16384 + 512);
    LAS unsigned* selo_st = selo + (lane >> 3) * 32 + (lane & 7);
    const unsigned cbuf0 = (unsigned)(unsigned long)cbuf;
    const int G = gridDim.x, NGW = G * NWAVE;
    int vw;
    if ((G & 7) == 0) vw = (((int)blockIdx.x & 7) * (G >> 3) + ((int)blockIdx.x >> 3)) * NWAVE + wave; else vw = (int)blockIdx.x * NWAVE + wave;
    const float LOG2E = 1.4426950408889634f;
    const float slope2 = exp2f(-0.5f * (float)(fr + 1)) * LOG2E;
    unsigned qoffB[4];
#pragma unroll
    for (int e = 0; e < 4; ++e) { const int r15 = (4 * e + fq) & 15; qoffB[e] = (unsigned)((fr ^ (((r15 & 7) << 1) | (r15 >> 3))) << 4); }
    unsigned qoffS[4];
#pragma unroll
    for (int e = 0; e < 4; ++e) qoffS[e] = qoffB[e] + 3072u - 1024u * e;
    const unsigned fA = (unsigned)(((fr & 7) << 1) | (fr >> 3));
    const unsigned SA = (fA & 14u) << 4, baseA = (unsigned)fr * 256u + ((((unsigned)fq >> 1) ^ (fA & 1u)) << 4) + ((unsigned)fq & 1u) * 8u;
    const int rT = 4 * fq + (fr >> 2), pT_ = fr & 3;
    const unsigned fT = (unsigned)(((rT & 7) << 1) | (rT >> 3));
    const unsigned ST = (fT & 14u) << 4, baseT = (unsigned)rT * 256u + ((((unsigned)pT_ >> 1) ^ (fT & 1u)) << 4) + ((unsigned)pT_ & 1u) * 8u;
    const int per = NGW >> 2, bq = vw / per, wb = vw % per;
    int ditem = DRY ? N_DEFERRED : vw;
    u32x2 selnext = {0u, 0u}; long qfn[8];
    if (wb < SEQ) { const int t0 = bq * SEQ + wb; selnext = *(const u32x2*)(SEL + (size_t)t0 * TOPK + 4 * lane);
#pragma unroll
        for (int cc = 0; cc < 8; ++cc) qfn[cc] = *(const long*)(QA + (size_t)t0 * 4096 + fr * 256 + 32 * cc + 8 * fq); }
    for (int tl0 = wb; tl0 < SEQ; tl0 += per) {
        const int t = bq * SEQ + tl0;
        const int b = t >> 13, tl = t & (SEQ - 1), ns = min(tl + 1, TOPK), nch = (ns + 31) >> 5;
        const bool has_nextq = (tl0 + per < SEQ);
        asm volatile("s_waitcnt vmcnt(0)" ::: "memory");
        {
            const u32x2 w = selnext;
            unsigned short i0 = (unsigned short)(w.x & 0xffffu), i1 = (unsigned short)(w.x >> 16), i2 = (unsigned short)(w.y & 0xffffu), i3 = (unsigned short)(w.y >> 16);
            const int k0 = 4 * lane;
            if (k0 >= ns) i0 = 0; if (k0 + 1 >= ns) i1 = 0; if (k0 + 2 >= ns) i2 = 0; if (k0 + 3 >= ns) i3 = 0;
            u32x2 o; o.x = (unsigned)i0 | ((unsigned)i1 << 16); o.y = (unsigned)i2 | ((unsigned)i3 << 16);
            asm volatile("s_waitcnt lgkmcnt(0)" ::: "memory");
            *(LAS u32x2*)(selw + 4 * lane) = o;
            selo_st[0] = (unsigned)i0 << 8; selo_st[8] = (unsigned)i1 << 8; selo_st[16] = (unsigned)i2 << 8; selo_st[24] = (unsigned)i3 << 8;
        }
        v8i_t qB[2];
#pragma unroll
        for (int cc = 0; cc < 8; ++cc) { const u32x2 qw = __builtin_bit_cast(u32x2, qfn[cc]); qB[cc >> 2][2 * (cc & 3)] = (int)qw.x; qB[cc >> 2][2 * (cc & 3) + 1] = (int)qw.y; }
#define ATT_PREFETCH() do { if (has_nextq) { const int tn_ = t + per; selnext = *(const u32x2*)(SEL + (size_t)tn_ * TOPK + 4 * lane); \
            _Pragma("unroll") for (int cc = 0; cc < 8; ++cc) qfn[cc] = *(const long*)(QA + (size_t)tn_ * 4096 + fr * 256 + 32 * cc + 8 * fq); pf = true; } } while (0)
        f32x4 Oe[8], Oo[8];
#pragma unroll
        for (int ut = 0; ut < 8; ++ut) { Oe[ut] = (f32x4){0.f, 0.f, 0.f, 0.f}; Oo[ut] = (f32x4){0.f, 0.f, 0.f, 0.f}; }
        float m = -INFINITY, l = 0.f;
        const unsigned char* cb = CKV8 + (size_t)b * SEQ * 256;
        asm volatile("s_waitcnt vmcnt(0) lgkmcnt(0)" ::: "memory");
        const unsigned char* cbs = cb - 3072;
#define ATT_DMA(jj, bufoff) do { u32x4 oa_ = *(const LAS u32x4*)(selo + 32 * (jj) + 8 * fq), ob_ = *(const LAS u32x4*)(selo + 32 * (jj) + 8 * fq + 4); \
            if (DRY && PROBE_ATT == 1) { oa_ = (u32x4){0u, 256u, 512u, 768u}; ob_ = oa_; } \
            if (!(DRY && PROBE_ATT == 3)) { \
                glds16s_set(cbs, oa_.x + qoffS[0], (unsigned)__builtin_amdgcn_readfirstlane((int)(cbuf0 + (bufoff)))); \
                glds16s_m0<1024>(cbs, oa_.y + qoffS[1]); glds16s_m0<2048>(cbs, oa_.z + qoffS[2]); glds16s_m0<3072>(cbs, oa_.w + qoffS[3]); \
                glds16s_set(cbs, ob_.x + qoffS[0], (unsigned)__builtin_amdgcn_readfirstlane((int)(cbuf0 + (bufoff) + 4096))); \
                glds16s_m0<1024>(cbs, ob_.y + qoffS[1]); glds16s_m0<2048>(cbs, ob_.z + qoffS[2]); glds16s_m0<3072>(cbs, ob_.w + qoffS[3]); } } while (0)
        ATT_DMA(0, 0);
        if (nch > 1) ATT_DMA(1, 8192);
        const bool have_item = ditem < N_DEFERRED;
        TrItem titem = deferred_item(P, have_item ? ditem : 0);
        float tcur[32];
        bool trf = false, pf = false;
        if (nch <= 2) { if (have_item) { tr_load(titem, lane, tcur); trf = true; } ATT_PREFETCH(); }
        for (int j = 0; j < nch; ++j) {
            const unsigned bo = (unsigned)(j & 1) * 8192u;
            if (j + 1 < nch) { if (trf && pf) asm volatile("s_waitcnt vmcnt(49)" ::: "memory"); else if (trf) asm volatile("s_waitcnt vmcnt(40)" ::: "memory");
                               else if (pf) asm volatile("s_waitcnt vmcnt(17)" ::: "memory"); else asm volatile("s_waitcnt vmcnt(8)" ::: "memory"); }
            else { if (trf && pf) asm volatile("s_waitcnt vmcnt(41)" ::: "memory"); else if (trf) asm volatile("s_waitcnt vmcnt(32)" ::: "memory");
                   else if (pf) asm volatile("s_waitcnt vmcnt(9)" ::: "memory"); else asm volatile("s_waitcnt vmcnt(0)" ::: "memory"); }
            const LAS unsigned char* img = cbuf + bo;
            if (DRY && PROBE_ATT == 2) { if (j + 2 < nch) { asm volatile("s_waitcnt lgkmcnt(0)" ::: "memory"); ATT_DMA(j + 2, bo); } continue; }
            f32x4 s0 = {0.f, 0.f, 0.f, 0.f}, s1 = {0.f, 0.f, 0.f, 0.f};
#pragma unroll
            for (int hb = 0; hb < 2; ++hb) {
                u32x2 ra[4], rb[4];
#pragma unroll
                for (int c4 = 0; c4 < 4; ++c4) { const int cc = hb * 4 + c4; const LAS unsigned char* pa = img + ((SA ^ (unsigned)(cc << 5)) + baseA); ra[c4] = *(const LAS u32x2*)(pa); rb[c4] = *(const LAS u32x2*)(pa + 4096); }
                __builtin_amdgcn_sched_barrier(0);
                v8i_t A0, A1;
#pragma unroll
                for (int c4 = 0; c4 < 4; ++c4) { A0[2 * c4] = (int)ra[c4].x; A0[2 * c4 + 1] = (int)ra[c4].y; A1[2 * c4] = (int)rb[c4].x; A1[2 * c4 + 1] = (int)rb[c4].y; }
                s0 = __builtin_amdgcn_mfma_scale_f32_16x16x128_f8f6f4(A0, qB[hb], s0, 1, 0, 0, 0, 0, 0);
                s1 = __builtin_amdgcn_mfma_scale_f32_16x16x128_f8f6f4(A1, qB[hb], s1, 1, 0, 0, 0, 0, 0);
                __builtin_amdgcn_sched_barrier(0);
            }
            const u32x2 k0w = *(const LAS u32x2*)(selw + 32 * j + 4 * fq), k1w = *(const LAS u32x2*)(selw + 32 * j + 16 + 4 * fq);
            u32x2 tl_[4], th_[4];
#pragma unroll
            for (int ut = 0; ut < 4; ++ut) { const LAS unsigned char* pt = img + ((ST ^ (unsigned)(ut << 5)) + baseT);
                tl_[ut] = __builtin_bit_cast(u32x2, __builtin_amdgcn_ds_read_tr16_b64_v4i16((LAS v4i16_t*)(pt)));
                th_[ut] = __builtin_bit_cast(u32x2, __builtin_amdgcn_ds_read_tr16_b64_v4i16((LAS v4i16_t*)(pt + 4096))); }
            __builtin_amdgcn_sched_barrier(0);
            const int rem = ns - (32 * j + 4 * fq);
            float lg[8];
            {
                const int i00 = (int)(k0w.x & 0xffffu), i01 = (int)(k0w.x >> 16), i02 = (int)(k0w.y & 0xffffu), i03 = (int)(k0w.y >> 16);
                const int i10 = (int)(k1w.x & 0xffffu), i11 = (int)(k1w.x >> 16), i12 = (int)(k1w.y & 0xffffu), i13 = (int)(k1w.y >> 16);
                lg[0] = (0 < rem) ? s0.x * LOG2E - slope2 * (float)(tl - i00) : -INFINITY;
                lg[1] = (1 < rem) ? s0.y * LOG2E - slope2 * (float)(tl - i01) : -INFINITY;
                lg[2] = (2 < rem) ? s0.z * LOG2E - slope2 * (float)(tl - i02) : -INFINITY;
                lg[3] = (3 < rem) ? s0.w * LOG2E - slope2 * (float)(tl - i03) : -INFINITY;
                lg[4] = (16 < rem) ? s1.x * LOG2E - slope2 * (float)(tl - i10) : -INFINITY;
                lg[5] = (17 < rem) ? s1.y * LOG2E - slope2 * (float)(tl - i11) : -INFINITY;
                lg[6] = (18 < rem) ? s1.z * LOG2E - slope2 * (float)(tl - i12) : -INFINITY;
                lg[7] = (19 < rem) ? s1.w * LOG2E - slope2 * (float)(tl - i13) : -INFINITY;
            }
            const float cm = fmaxf(fmaxf(fmaxf(lg[0], lg[1]), fmaxf(lg[2], lg[3])), fmaxf(fmaxf(lg[4], lg[5]), fmaxf(lg[6], lg[7])));
            if (j == 0) { float cx = fmaxf(cm, __shfl_xor(cm, 16)); m = fmaxf(cx, __shfl_xor(cx, 32)); }
            else if (__any(cm > m + 8.0f)) {
                float cx = fmaxf(cm, __shfl_xor(cm, 16)); cx = fmaxf(cx, __shfl_xor(cx, 32));
                const float mn = fmaxf(m, cx);
                const float sc = __builtin_amdgcn_exp2f(m - mn);
                l *= sc;
#pragma unroll
                for (int ut = 0; ut < 8; ++ut) { Oe[ut] *= sc; Oo[ut] *= sc; }
                m = mn;
            }
            float p[8]; float ps = 0.f;
#pragma unroll
            for (int i = 0; i < 8; ++i) { p[i] = __builtin_amdgcn_exp2f(lg[i] - m); ps += p[i]; }
            l += ps;
            int pw0 = __builtin_amdgcn_cvt_pk_fp8_f32(p[0], p[1], 0, false); pw0 = __builtin_amdgcn_cvt_pk_fp8_f32(p[2], p[3], pw0, true);
            int pw1 = __builtin_amdgcn_cvt_pk_fp8_f32(p[4], p[5], 0, false); pw1 = __builtin_amdgcn_cvt_pk_fp8_f32(p[6], p[7], pw1, true);
            const long pk = __builtin_bit_cast(long, (u32x2){(unsigned)pw0, (unsigned)pw1});
#pragma unroll
            for (int hb = 0; hb < 2; ++hb) {
                if (hb == 1) {
#pragma unroll
                    for (int u4 = 0; u4 < 4; ++u4) { const int ut = 4 + u4; const LAS unsigned char* pt = img + ((ST ^ (unsigned)(ut << 5)) + baseT);
                        tl_[u4] = __builtin_bit_cast(u32x2, __builtin_amdgcn_ds_read_tr16_b64_v4i16((LAS v4i16_t*)(pt)));
                        th_[u4] = __builtin_bit_cast(u32x2, __builtin_amdgcn_ds_read_tr16_b64_v4i16((LAS v4i16_t*)(pt + 4096))); }
                    __builtin_amdgcn_sched_barrier(0);
                }
#pragma unroll
                for (int u4 = 0; u4 < 4; ++u4) { const int ut = hb * 4 + u4;
                    const u32x2 lw = tl_[u4], hw = th_[u4];
                    u32x2 ae, ao;
                    ae.x = __builtin_amdgcn_perm(lw.y, lw.x, 0x06040200u); ae.y = __builtin_amdgcn_perm(hw.y, hw.x, 0x06040200u);
                    ao.x = __builtin_amdgcn_perm(lw.y, lw.x, 0x07050301u); ao.y = __builtin_amdgcn_perm(hw.y, hw.x, 0x07050301u);
                    Oe[ut] = __builtin_amdgcn_mfma_f32_16x16x32_bf8_fp8(__builtin_bit_cast(long, ae), pk, Oe[ut], 0, 0, 0);
                    Oo[ut] = __builtin_amdgcn_mfma_f32_16x16x32_bf8_fp8(__builtin_bit_cast(long, ao), pk, Oo[ut], 0, 0, 0);
                }
                __builtin_amdgcn_sched_barrier(0);
            }
            if (j + 2 < nch) { asm volatile("s_waitcnt lgkmcnt(0)" ::: "memory"); ATT_DMA(j + 2, bo);
                if (j + 3 == nch) { if (have_item) { tr_load(titem, lane, tcur); trf = true; } ATT_PREFETCH(); } }
        }
#undef ATT_DMA
#undef ATT_PREFETCH
        l += __shfl_xor(l, 16); l += __shfl_xor(l, 32);
        const float inv = 1.0f / l;
        bf16_t* orow = (DRY ? (bf16_t*)(P.ws + WS_PP) + (size_t)(t & 8191) * 4096 : OLAT + (size_t)t * 4096) + fr * 256 + 8 * fq;
#pragma unroll
        for (int ut = 0; ut < 8; ++ut) {
            u32x4 w; w.x = pk2(Oe[ut].x * inv, Oo[ut].x * inv); w.y = pk2(Oe[ut].y * inv, Oo[ut].y * inv); w.z = pk2(Oe[ut].z * inv, Oo[ut].z * inv); w.w = pk2(Oe[ut].w * inv, Oo[ut].w * inv);
            *(u32x4*)(orow + 32 * ut) = w;
        }
        if (have_item) { asm volatile("s_waitcnt lgkmcnt(0)" ::: "memory"); tr_store(titem, (float*)(lds_ + wave * 17920), lane, tcur); ditem += NGW; }
    }
    int lane_l = lane; asm volatile("" : "+v"(lane_l));
    for (; ditem < N_DEFERRED; ditem += NGW) { const TrItem t = deferred_item(P, ditem); float tmp[32]; tr_load(t, lane_l, tmp); tr_store(t, (float*)(lds_ + wave * 17920), lane_l, tmp); }
}

constexpr size_t SC_BATCH = (size_t)1024 * 256 * 257 / 2;
__device__ __forceinline__ size_t sc_row_off(int b, int tl) { const size_t m = (size_t)(tl >> 5); return (size_t)b * SC_BATCH + 1024 * (m * (m + 1) / 2) + (size_t)(tl & 31) * 32 * (m + 1); }
typedef float f32x16 __attribute__((ext_vector_type(16)));
__device__ __forceinline__ unsigned okey_pk(float a, float b) {
    const unsigned w = __builtin_bit_cast(unsigned, __builtin_amdgcn_cvt_pkrtz(a, b));
    const unsigned neg = (w >> 15) & 0x00010001u;
    return w ^ ((neg * 0xffffu) | 0x80008000u);
}
__device__ __forceinline__ void phase_index_scores(const Params& P, unsigned char* lds_) {
    using pg8::bf16x8;
    const bf16_t* Z1 = (const bf16_t*)(P.ws + WS_Z1); unsigned short* SC = (unsigned short*)(P.ws + WS_SC);
    LAS unsigned char* lds = (LAS unsigned char*)lds_;
    constexpr int QROW = 144;
    LAS unsigned char* QL = lds;
    LAS float* SG = (LAS float*)(lds + 9 * 64 * QROW);
    const int tid = threadIdx.x, lane = tid & 63, wave = __builtin_amdgcn_readfirstlane(tid >> 6);
    LAS unsigned char* ST = lds + 9 * 64 * QROW + 2048 + wave * 5120;
    const int l31 = lane & 31, hh = lane >> 5;
    for (int pid = blockIdx.x; pid < 256; pid += gridDim.x) {
        const int b = pid >> 6;
        for (int side = 0; side < 2; ++side) {
            const int qb = side ? (127 - (pid & 63)) : (pid & 63);
            const int q0 = qb * 64;
            __syncthreads();
            {
                const int qi = tid >> 3, part = tid & 7;
                const bf16_t* zr = Z1 + ((size_t)b * SEQ + q0 + qi) * Z1W;
                const u32x4 ww = *(const u32x4*)(zr + 1088);
                const float w8[8] = {bflo(ww.x), bfhi(ww.x), bflo(ww.y), bfhi(ww.y), bflo(ww.z), bfhi(ww.z), bflo(ww.w), bfhi(ww.w)};
                float wh = 0.f;
#pragma unroll
                for (int h = 0; h < 8; ++h) wh = (h == part) ? w8[h] : wh;
                const float sc = 0.5f * fabsf(wh);
                SG[qi * 8 + part] = (wh >= 0.f) ? 1.0f : -1.0f;
#pragma unroll
                for (int c = 0; c < 8; ++c) {
                    const u32x4 v = *(const u32x4*)(zr + 512 + part * 64 + c * 8);
                    u32x4 o; o.x = pk2(bflo(v.x) * sc, bfhi(v.x) * sc); o.y = pk2(bflo(v.y) * sc, bfhi(v.y) * sc); o.z = pk2(bflo(v.z) * sc, bfhi(v.z) * sc); o.w = pk2(bflo(v.w) * sc, bfhi(v.w) * sc);
                    *(LAS u32x4*)(QL + (part * 64 + qi) * QROW + c * 16) = o;
                }
                float a8[8];
#pragma unroll
                for (int j = 0; j < 8; ++j) a8[j] = 0.f;
#pragma unroll
                for (int h = 0; h < 8; ++h) {
                    const u32x4 v = *(const u32x4*)(zr + 512 + h * 64 + part * 8); const float s2 = 0.5f * w8[h];
                    a8[0] += s2 * bflo(v.x); a8[1] += s2 * bfhi(v.x); a8[2] += s2 * bflo(v.y); a8[3] += s2 * bfhi(v.y);
                    a8[4] += s2 * bflo(v.z); a8[5] += s2 * bfhi(v.z); a8[6] += s2 * bflo(v.w); a8[7] += s2 * bfhi(v.w);
                }
                u32x4 o; o.x = pk2(a8[0], a8[1]); o.y = pk2(a8[2], a8[3]); o.z = pk2(a8[4], a8[5]); o.w = pk2(a8[6], a8[7]);
                *(LAS u32x4*)(QL + (8 * 64 + qi) * QROW + part * 16) = o;
            }
            __syncthreads();
            const int ktmax = 2 * qb + 1;
            bf16x8 kn[4];
            {   const bf16_t* kr = Z1 + ((size_t)b * SEQ + min(wave, ktmax) * 32 + l31) * Z1W + 1024 + hh * 8;
#pragma unroll
                for (int dq = 0; dq < 4; ++dq) kn[dq] = *(const bf16x8*)(kr + dq * 16); }
            for (int kt = wave; kt <= ktmax; kt += NWAVE) {
                bf16x8 kf[4];
#pragma unroll
                for (int dq = 0; dq < 4; ++dq) kf[dq] = kn[dq];
                {   const bf16_t* kr = Z1 + ((size_t)b * SEQ + min(kt + NWAVE, ktmax) * 32 + l31) * Z1W + 1024 + hh * 8;
#pragma unroll
                    for (int dq = 0; dq < 4; ++dq) kn[dq] = *(const bf16x8*)(kr + dq * 16); }
#pragma unroll
                for (int qs = 0; qs < 2; ++qs) {
                    const LAS unsigned char* qrow = QL + (qs * 32 + l31) * QROW + hh * 16;
                    const LAS float* sgp = SG + (qs * 32 + l31) * 8;
                    bf16x8 fc[4], fn[4];
#pragma unroll
                    for (int dq = 0; dq < 4; ++dq) fc[dq] = *(const LAS bf16x8*)(qrow + 8 * 64 * QROW + dq * 32);
#pragma unroll
                    for (int dq = 0; dq < 4; ++dq) fn[dq] = *(const LAS bf16x8*)(qrow + dq * 32);
                    const f32x4 sg03 = *(const LAS f32x4*)(sgp), sg47 = *(const LAS f32x4*)(sgp + 4);
                    f32x16 acc;
#pragma unroll
                    for (int r = 0; r < 16; ++r) acc[r] = 0.f;
#pragma unroll
                    for (int dq = 0; dq < 4; ++dq) acc = __builtin_amdgcn_mfma_f32_32x32x16_bf16(kf[dq], fc[dq], acc, 0, 0, 0);
                    f32x16 up;
#pragma unroll
                    for (int h = 0; h < 8; ++h) {
#pragma unroll
                        for (int dq = 0; dq < 4; ++dq) fc[dq] = fn[dq];
                        if (h < 7) {
#pragma unroll
                            for (int dq = 0; dq < 4; ++dq) fn[dq] = *(const LAS bf16x8*)(qrow + (h + 1) * 64 * QROW + dq * 32);
                        }
                        f32x16 u;
#pragma unroll
                        for (int r = 0; r < 16; ++r) u[r] = 0.f;
#pragma unroll
                        for (int dq = 0; dq < 4; ++dq) u = __builtin_amdgcn_mfma_f32_32x32x16_bf16(kf[dq], fc[dq], u, 0, 0, 0);
                        __builtin_amdgcn_sched_barrier(0);
                        if (h > 0) {
                            const float sg = (h - 1 < 4) ? sg03[(h - 1) & 3] : sg47[(h - 1) & 3];
#pragma unroll
                            for (int r = 0; r < 16; ++r) acc[r] = fmaf(fabsf(up[r]), sg, acc[r]);
                        }
                        __builtin_amdgcn_sched_barrier(0);
                        up = u;
                    }
                    {
                        const float sg = sg47[3];
#pragma unroll
                        for (int r = 0; r < 16; ++r) acc[r] = fmaf(fabsf(up[r]), sg, acc[r]);
                    }
#pragma unroll
                    for (int g = 0; g < 4; ++g) { u32x2 w; w.x = okey_pk(acc[4 * g], acc[4 * g + 1]); w.y = okey_pk(acc[4 * g + 2], acc[4 * g + 3]);
                        *(LAS u32x2*)(ST + (qs * 32 + l31) * 80 + (8 * g + 4 * hh) * 2) = w; }
                }
#pragma unroll
                for (int i = 0; i < 4; ++i) {
                    const int row = 16 * i + (lane >> 2), ch = lane & 3, tl = q0 + row;
                    const u32x4 v = *(const LAS u32x4*)(ST + row * 80 + ch * 16);
                    if (kt <= (tl >> 5)) *(u32x4*)(SC + sc_row_off(b, tl) + (size_t)kt * 32 + ch * 8) = v;
                }
            }
        }
    }
}
template <int MODE>
__device__ __forceinline__ void phase_index_select(const Params& P, unsigned char* lds_) {
    const unsigned short* SC = (const unsigned short*)(P.ws + WS_SC); unsigned short* SEL = (unsigned short*)(P.ws + WS_SEL);
    const int tid = threadIdx.x, lane = tid & 63, wave = __builtin_amdgcn_readfirstlane(tid >> 6);
    LAS unsigned char* wbase = (LAS unsigned char*)lds_ + wave * 19456;
    LAS u32x4* rowbuf = (LAS u32x4*)wbase;
    LAS unsigned* hist = (LAS unsigned*)(wbase + 16384);
    LAS unsigned* dummy = hist + 512 + lane;
    LAS unsigned short* outw = (LAS unsigned short*)(wbase + 16384 + 2048 + 256);
    LAS unsigned short* dummy16 = outw + 256 + lane;
    const unsigned rowbuf0 = (unsigned)(unsigned long)wbase;
    const int gw = blockIdx.x * NWAVE + wave, NGW = gridDim.x * NWAVE;
#define SEL_DMA(tt) do { const int _tl = (tt) & (SEQ - 1), _n = _tl + 1; if (_n > TOPK) { const unsigned char* _src = (const unsigned char*)(SC + sc_row_off((tt) >> 13, _tl)) + lane * 16; \
            for (int _sg = 0; _sg * 512 < _n; ++_sg) glds16(_src + _sg * 1024, (unsigned)__builtin_amdgcn_readfirstlane((int)(rowbuf0 + _sg * 1024))); } } while (0)
#define SEL_Q(i) ((i) * NGW + (((i) & 1) ? (NGW - 1 - gw) : gw))
    if (SEL_Q(0) < NTOK) SEL_DMA(SEL_Q(0));
    for (int qi = 0; qi * NGW < NTOK; ++qi) {
        const int t = SEL_Q(qi), tnext = SEL_Q(qi + 1);
        if (t >= NTOK) { if (tnext < NTOK) SEL_DMA(tnext); continue; }
        const int tl = t & (SEQ - 1), n = tl + 1;
        unsigned short* so = SEL + (size_t)t * TOPK;
        if (n <= TOPK) { for (int i = lane; i < n; i += 64) so[i] = (unsigned short)i; if (tnext < NTOK && (qi + 1) * NGW < NTOK) SEL_DMA(tnext); continue; }
        asm volatile("s_waitcnt vmcnt(0)" ::: "memory");
        u32x4 d[16];
        const int lastsg = (n - 1) >> 9;
#pragma unroll
        for (int sg = 0; sg < 16; ++sg) {
            if (sg * 512 < n) {
                d[sg] = rowbuf[sg * 64 + lane];
                if (sg == lastsg) {
#pragma unroll
                    for (int q = 0; q < 4; ++q) { const int i0 = sg * 512 + lane * 8 + 2 * q;
                        d[sg][q] &= ((i0 < n) ? 0x0000ffffu : 0u) | ((i0 + 1 < n) ? 0xffff0000u : 0u); }
                }
            } else d[sg] = (u32x4){0u, 0u, 0u, 0u};
        }
        asm volatile("s_waitcnt lgkmcnt(0)" ::: "memory");
        if (tnext < NTOK && (qi + 1) * NGW < NTOK) SEL_DMA(tnext);
#pragma unroll
        for (int i = 0; i < 8; ++i) { hist[i * 64 + lane] = 0u; }
        asm volatile("s_waitcnt lgkmcnt(0)" ::: "memory");
        LAS unsigned* myh = hist + (lane & 1) * 256;
        if (MODE == 4) { if (d[0].x == 0x12345u) so[lane] = 1; continue; }
#pragma unroll
        for (int sg = 0; sg < 16; ++sg) if (MODE != 1 && sg * 512 < n) {
#pragma unroll
            for (int q = 0; q < 4; ++q) { const unsigned w = d[sg][q];
                __hip_atomic_fetch_add(myh + ((w >> 8) & 0xffu), 1u, __ATOMIC_RELAXED, __HIP_MEMORY_SCOPE_WORKGROUP);
                __hip_atomic_fetch_add(myh + (w >> 24), 1u, __ATOMIC_RELAXED, __HIP_MEMORY_SCOPE_WORKGROUP); }
        }
        asm volatile("s_waitcnt lgkmcnt(0)" ::: "memory");
        unsigned b1, need1;
        {
            unsigned c[4];
#pragma unroll
            for (int q = 0; q < 4; ++q) c[q] = hist[4 * lane + q] + hist[256 + 4 * lane + q];
            const unsigned mine = c[0] + c[1] + c[2] + c[3];
            unsigned suf = mine;
#pragma unroll
            for (int o = 1; o < 64; o <<= 1) { const unsigned v = __shfl_down(suf, o); if (lane + o < 64) suf += v; }
            const unsigned above = suf - mine;
            int fb = -1; unsigned fneed = 0;
            if (above < (unsigned)TOPK && suf >= (unsigned)TOPK) { unsigned a = above;
#pragma unroll
                for (int q = 3; q >= 0; --q) { if (fb < 0 && a + c[q] >= (unsigned)TOPK) { fb = 4 * lane + q; fneed = (unsigned)TOPK - a; } a += c[q]; } }
            const unsigned long long bal = __ballot(fb >= 0);
            const int src = (int)__builtin_ctzll(bal);
            b1 = (unsigned)__shfl(fb, src); need1 = __shfl(fneed, src);
        }
#pragma unroll
        for (int i = 0; i < 8; ++i) { hist[i * 64 + lane] = 0u; }
        asm volatile("s_waitcnt lgkmcnt(0)" ::: "memory");
#pragma unroll
        for (int sg = 0; sg < 16; ++sg) if (MODE != 2 && sg * 512 < n) {
#pragma unroll
            for (int q = 0; q < 4; ++q) { const unsigned w = d[sg][q];
                LAS unsigned* p0 = (((w >> 8) & 0xffu) == b1) ? (myh + (w & 0xffu)) : dummy;
                LAS unsigned* p1 = ((w >> 24) == b1) ? (myh + ((w >> 16) & 0xffu)) : dummy;
                __hip_atomic_fetch_add(p0, 1u, __ATOMIC_RELAXED, __HIP_MEMORY_SCOPE_WORKGROUP);
                __hip_atomic_fetch_add(p1, 1u, __ATOMIC_RELAXED, __HIP_MEMORY_SCOPE_WORKGROUP); }
        }
        asm volatile("s_waitcnt lgkmcnt(0)" ::: "memory");
        unsigned T, need2;
        {
            unsigned c[4];
#pragma unroll
            for (int q = 0; q < 4; ++q) c[q] = hist[4 * lane + q] + hist[256 + 4 * lane + q];
            const unsigned mine = c[0] + c[1] + c[2] + c[3];
            unsigned suf = mine;
#pragma unroll
            for (int o = 1; o < 64; o <<= 1) { const unsigned v = __shfl_down(suf, o); if (lane + o < 64) suf += v; }
            const unsigned above = suf - mine;
            int fb = -1; unsigned fneed = 0;
            if (above < need1 && suf >= need1) { unsigned a = above;
#pragma unroll
                for (int q = 3; q >= 0; --q) { if (fb < 0 && a + c[q] >= need1) { fb = 4 * lane + q; fneed = need1 - a; } a += c[q]; } }
            const unsigned long long bal = __ballot(fb >= 0);
            const int src = (int)__builtin_ctzll(bal);
            T = (b1 << 8) | (unsigned)__shfl(fb, src); need2 = __shfl(fneed, src);
        }
        unsigned base = 0; const unsigned ngt = (unsigned)TOPK - need2; unsigned eqbase = 0;
#pragma unroll
        for (int sg = 0; sg < 16; ++sg) if (MODE != 3 && sg * 512 < n) {
            unsigned ce = 0;
#pragma unroll
            for (int j = 0; j < 8; ++j) {
                const unsigned k = (j & 1) ? (d[sg][j >> 1] >> 16) : (d[sg][j >> 1] & 0xffffu);
                const bool gt = k > T;
                const unsigned long long mk = __ballot(gt);
                const unsigned pos = base + (unsigned)__builtin_amdgcn_mbcnt_hi((unsigned)(mk >> 32), __builtin_amdgcn_mbcnt_lo((unsigned)mk, 0u));
                LAS unsigned short* po = gt ? (outw + pos) : dummy16;
                *po = (unsigned short)(sg * 512 + lane * 8 + j);
                base += (unsigned)__builtin_popcountll(mk);
                ce += (k == T) ? 1u : 0u;
            }
            if (__any(ce > 0u)) {
                unsigned pre = ce;
#pragma unroll
                for (int o = 1; o < 64; o <<= 1) { const unsigned v = __shfl_up(pre, o); if (lane >= o) pre += v; }
                unsigned r = eqbase + pre - ce;
#pragma unroll
                for (int j = 0; j < 8; ++j) { const unsigned k = (j & 1) ? (d[sg][j >> 1] >> 16) : (d[sg][j >> 1] & 0xffffu);
                    if (k == T) { if (r < need2) outw[ngt + r] = (unsigned short)(sg * 512 + lane * 8 + j); ++r; } }
                eqbase += __shfl(pre, 63);
            }
        }
        asm volatile("s_waitcnt lgkmcnt(0)" ::: "memory");
        ((unsigned*)so)[lane] = ((LAS unsigned*)outw)[lane];
        ((unsigned*)so)[64 + lane] = ((LAS unsigned*)outw)[64 + lane];
        asm volatile("s_waitcnt lgkmcnt(0)" ::: "memory");
    }
#undef SEL_DMA
#undef SEL_Q
    asm volatile("s_waitcnt vmcnt(0)" ::: "memory");
}

__device__ __forceinline__ void ret_fill_image(LAS unsigned char* img, const unsigned char* src, size_t row_stride_bytes, int wave, int lane) {
#pragma unroll
    for (int e4 = 0; e4 < 4; ++e4) {
        const int e = wave * 4 + e4, row = 4 * e + (lane >> 4), q = (lane & 15) ^ ((row & 7) << 1);
        __builtin_amdgcn_global_load_lds((const unsigned*)(src + (size_t)row * row_stride_bytes + q * 16), (LAS unsigned*)(img + e * 1024), 16, 0, 0);
    }
}
__device__ __forceinline__ pg8::bf16x8 ret_tr_pair(const LAS unsigned char* img, int row0, int chunk2, int lane) {
    const int g = lane >> 4, i = lane & 15, r0 = row0 + 4 * g + (i >> 2), pb = (i & 3) >> 1, half = (i & 1) * 8;
    const int r1 = r0 + 16;
    const v4i16_t lo = __builtin_amdgcn_ds_read_tr16_b64_v4i16((LAS v4i16_t*)(img + r0 * 256 + ((((chunk2) ^ ((r0 & 7) << 1)) | pb) << 4) + half));
    const v4i16_t hi = __builtin_amdgcn_ds_read_tr16_b64_v4i16((LAS v4i16_t*)(img + r1 * 256 + ((((chunk2) ^ ((r1 & 7) << 1)) | pb) << 4) + half));
    return (pg8::bf16x8){lo[0], lo[1], lo[2], lo[3], hi[0], hi[1], hi[2], hi[3]};
}
__device__ __forceinline__ void phase_ret_kv_mfma(const Params& P, unsigned char* lds_) {
    using pg8::bf16x8;
    const unsigned char* Z0 = (const unsigned char*)(P.ws + WS_Z0); float* KV = (float*)(P.ws + WS_KV);
    LAS unsigned char* Kimg = (LAS unsigned char*)lds_; LAS unsigned char* Vimg = Kimg + 32768;
    const int tid = threadIdx.x, lane = tid & 63, wave = __builtin_amdgcn_readfirstlane(tid >> 6), fr = lane & 15, fq = lane >> 4;
    for (int u = blockIdx.x; u < 1024; u += gridDim.x) {
        const int n = u & 63, h = (u >> 6) & 3, b = u >> 8;
        const size_t row0 = (size_t)b * SEQ + n * 128;
        __syncthreads();
        ret_fill_image(Kimg, Z0 + row0 * ZW * 2 + (512 + h * 128) * 2, ZW * 2, wave, lane);
        ret_fill_image(Vimg, Z0 + row0 * ZW * 2 + (1024 + h * 128) * 2, ZW * 2, wave, lane);
        asm volatile("s_waitcnt vmcnt(0)" ::: "memory");
        __syncthreads();
        bf16x8 va[4];
#pragma unroll
        for (int jc = 0; jc < 4; ++jc) va[jc] = ret_tr_pair(Vimg, 32 * jc, 2 * wave, lane);
        const float g127 = exp2f(ret_log2g(h) * 127.0f);
        float* o = KV + (size_t)u * 16384;
#pragma unroll
        for (int dt = 0; dt < 8; ++dt) {
            f32x4 acc = {0.f, 0.f, 0.f, 0.f};
#pragma unroll
            for (int jc = 0; jc < 4; ++jc) acc = __builtin_amdgcn_mfma_f32_16x16x32_bf16(va[jc], ret_tr_pair(Kimg, 32 * jc, 2 * dt, lane), acc, 0, 0, 0);
            *(f32x4*)(o + (size_t)(16 * dt + fr) * 128 + 16 * wave + 4 * fq) = acc * g127;
        }
    }
}
template <int W>
__device__ __forceinline__ void pool_item(const Params& P, int t0, int c8) {
    const bf16_t* Z0 = (const bf16_t*)(P.ws + WS_Z0); bf16_t* DP = (bf16_t*)(P.ws + WS_DP);
    const int tl0 = t0 & (SEQ - 1);
    u32x4 rows[W + 7];
#pragma unroll
    for (int r = 0; r < W + 7; ++r) { const int d = r - (W - 1);
        rows[r] = (tl0 + d >= 0) ? *(const u32x4*)(Z0 + (size_t)(t0 + d) * ZW + 2048 + c8) : (u32x4){0u, 0u, 0u, 0u}; }
    float sm[8];
#pragma unroll
    for (int j = 0; j < 8; ++j) sm[j] = 0.f;
#pragma unroll
    for (int r = 0; r < W; ++r) { const u32x4 v = rows[r];
        sm[0] += bflo(v.x); sm[1] += bfhi(v.x); sm[2] += bflo(v.y); sm[3] += bfhi(v.y); sm[4] += bflo(v.z); sm[5] += bfhi(v.z); sm[6] += bflo(v.w); sm[7] += bfhi(v.w); }
#pragma unroll
    for (int o = 0; o < 8; ++o) {
        const u32x4 v = rows[o + W - 1];
        if (o > 0) { const u32x4 q = rows[o - 1];
            sm[0] += bflo(v.x) - bflo(q.x); sm[1] += bfhi(v.x) - bfhi(q.x); sm[2] += bflo(v.y) - bflo(q.y); sm[3] += bfhi(v.y) - bfhi(q.y);
            sm[4] += bflo(v.z) - bflo(q.z); sm[5] += bfhi(v.z) - bfhi(q.z); sm[6] += bflo(v.w) - bflo(q.w); sm[7] += bfhi(v.w) - bfhi(q.w); }
        const float inv = 1.0f / (float)min(tl0 + o + 1, W);
        u32x4 w; w.x = pk2(sm[0] * inv - bflo(v.x), sm[1] * inv - bfhi(v.x)); w.y = pk2(sm[2] * inv - bflo(v.y), sm[3] * inv - bfhi(v.y));
        w.z = pk2(sm[4] * inv - bflo(v.z), sm[5] * inv - bfhi(v.z)); w.w = pk2(sm[6] * inv - bflo(v.w), sm[7] * inv - bfhi(v.w));
        *(u32x4*)(DP + (size_t)(t0 + o) * 512 + c8) = w;
    }
}
__device__ __forceinline__ void phase_ret_scan_pool2(const Params& P) {
    const float* KV = (const float*)(P.ws + WS_KV); bf16_t* SB = (bf16_t*)(P.ws + WS_SB);
    const size_t gt = (size_t)blockIdx.x * NT + threadIdx.x, GS = (size_t)gridDim.x * NT;
    for (size_t i = gt; i < (size_t)16 * 8192; i += GS) {
        const int s = (int)(i >> 13), e2 = (int)(i & 8191), h = s & 3;
        const float l2 = ret_log2g(h), cd = exp2f(l2 * 128.0f), g1 = exp2f(l2);
        typedef float f32x2v __attribute__((ext_vector_type(2)));
        const f32x2v* p = (const f32x2v*)(KV + (size_t)s * 64 * 16384) + e2;
        unsigned* q = (unsigned*)(SB + (size_t)s * 64 * 16384) + e2;
        f32x2v R = {0.f, 0.f};
        for (int n0 = 0; n0 < 64; n0 += 32) {
            f32x2v kv[32];
#pragma unroll
            for (int j = 0; j < 32; ++j) kv[j] = __builtin_nontemporal_load(p + (size_t)(n0 + j) * 8192);
#pragma unroll
            for (int j = 0; j < 32; ++j) { q[(size_t)(n0 + j) * 8192] = pk2(R.x * g1, R.y * g1); R = R * cd + kv[j]; }
        }
    }
    const int lane = threadIdx.x & 63, gwv = (int)blockIdx.x * NWAVE + (int)(threadIdx.x >> 6), NGWv = (int)gridDim.x * NWAVE;
    for (int wi = gwv; wi < 2048; wi += NGWv) {
#pragma unroll
        for (int half = 0; half < 2; ++half) {
            const int slot = wi & 1023, gsel = wi >> 10, g = half ? 3 - gsel : gsel;
            const int t0 = (slot * 4 + (lane >> 4)) * 8, c8 = g * 128 + (lane & 15) * 8;
            if (g == 0) pool_item<2>(P, t0, c8); else if (g == 1) pool_item<4>(P, t0, c8); else if (g == 2) pool_item<8>(P, t0, c8); else pool_item<16>(P, t0, c8);
        }
    }
}
__device__ __forceinline__ void phase_ret_out_mfma(const Params& P, unsigned char* lds_) {
    using pg8::bf16x8;
    const unsigned char* Z0 = (const unsigned char*)(P.ws + WS_Z0); const unsigned char* SB = (const unsigned char*)(P.ws + WS_SB); bf16_t* MIX = (bf16_t*)(P.ws + WS_MIX);
    const float* gn = P.in[3];
    LAS unsigned char* Kimg = (LAS unsigned char*)lds_; LAS unsigned char* Vimg = Kimg + 32768; LAS unsigned char* Rimg = Kimg + 65536;
    const int tid = threadIdx.x, lane = tid & 63, wave = __builtin_amdgcn_readfirstlane(tid >> 6), fr = lane & 15, fq = lane >> 4;
    for (int u = blockIdx.x; u < 1024; u += gridDim.x) {
        const int n = u & 63, h = (u >> 6) & 3, b = u >> 8;
        const size_t row0 = (size_t)b * SEQ + n * 128;
        __syncthreads();
        ret_fill_image(Kimg, Z0 + row0 * ZW * 2 + (512 + h * 128) * 2, ZW * 2, wave, lane);
        ret_fill_image(Vimg, Z0 + row0 * ZW * 2 + (1024 + h * 128) * 2, ZW * 2, wave, lane);
        ret_fill_image(Rimg, SB + (size_t)u * 32768, 256, wave, lane);
        const bf16_t* qrow = (const bf16_t*)Z0 + (row0 + 16 * wave + fr) * ZW + h * 128;
        bf16x8 qf[4], qr[4];
#pragma unroll
        for (int c = 0; c < 4; ++c) {
            qf[c] = *(const bf16x8*)(qrow + 32 * c + 8 * fq);
            const u32x2 a = *(const u32x2*)(qrow + 32 * c + 4 * fq), bb = *(const u32x2*)(qrow + 32 * c + 16 + 4 * fq);
            u32x4 w; w.x = a.x; w.y = a.y; w.z = bb.x; w.w = bb.y; qr[c] = __builtin_bit_cast(bf16x8, w);
        }
        asm volatile("s_waitcnt vmcnt(0)" ::: "memory");
        __syncthreads();
        f32x4 sT[8];
#pragma unroll
        for (int jt = 0; jt < 8; ++jt) sT[jt] = (f32x4){0.f, 0.f, 0.f, 0.f};
#pragma unroll
        for (int jp = 0; jp < 4; ++jp) if (2 * jp <= wave) {
            bf16x8 a[8];
#pragma unroll
            for (int t2 = 0; t2 < 2; ++t2) { const int r = 16 * (2 * jp + t2) + fr;
#pragma unroll
                for (int c = 0; c < 4; ++c) a[t2 * 4 + c] = *(const LAS bf16x8*)(Kimg + r * 256 + ((((4 * c + fq)) ^ ((r & 7) << 1)) << 4)); }
            __builtin_amdgcn_sched_barrier(0);
#pragma unroll
            for (int t2 = 0; t2 < 2; ++t2)
#pragma unroll
                for (int c = 0; c < 4; ++c) sT[2 * jp + t2] = __builtin_amdgcn_mfma_f32_16x16x32_bf16(a[t2 * 4 + c], qf[c], sT[2 * jp + t2], 0, 0, 0);
            __builtin_amdgcn_sched_barrier(0);
        }
#pragma unroll
        for (int jt = 0; jt < 8; ++jt) {
            if (jt == wave) {
                if (4 * fq + 0 > fr) sT[jt].x = 0.f; if (4 * fq + 1 > fr) sT[jt].y = 0.f; if (4 * fq + 2 > fr) sT[jt].z = 0.f; if (4 * fq + 3 > fr) sT[jt].w = 0.f;
            }
            if (jt > wave) sT[jt] = (f32x4){0.f, 0.f, 0.f, 0.f};
        }
        bf16x8 pT[4];
#pragma unroll
        for (int jp = 0; jp < 4; ++jp) { u32x4 w; w.x = pk2(sT[2 * jp].x, sT[2 * jp].y); w.y = pk2(sT[2 * jp].z, sT[2 * jp].w); w.z = pk2(sT[2 * jp + 1].x, sT[2 * jp + 1].y); w.w = pk2(sT[2 * jp + 1].z, sT[2 * jp + 1].w);
            pT[jp] = __builtin_bit_cast(bf16x8, w); }
        f32x4 O[8];
        const int nact = (wave >> 1) + 1;
#pragma unroll
        for (int vt = 0; vt < 8; ++vt) {
            bf16x8 rr[4], vv[4];
#pragma unroll
            for (int c = 0; c < 4; ++c) rr[c] = ret_tr_pair(Rimg, 32 * c, 2 * vt, lane);
#pragma unroll
            for (int jp = 0; jp < 4; ++jp) vv[jp] = (jp < nact) ? ret_tr_pair(Vimg, 32 * jp, 2 * vt, lane) : pT[jp];
            __builtin_amdgcn_sched_barrier(0);
            f32x4 acc = {0.f, 0.f, 0.f, 0.f};
#pragma unroll
            for (int c = 0; c < 4; ++c) acc = __builtin_amdgcn_mfma_f32_16x16x32_bf16(rr[c], qr[c], acc, 0, 0, 0);
#pragma unroll
            for (int jp = 0; jp < 4; ++jp) acc = __builtin_amdgcn_mfma_f32_16x16x32_bf16(vv[jp], pT[jp], acc, 0, 0, 0);
            __builtin_amdgcn_sched_barrier(0);
            O[vt] = acc;
        }
        float sm = 0.f;
#pragma unroll
        for (int vt = 0; vt < 8; ++vt) sm += (O[vt].x + O[vt].y) + (O[vt].z + O[vt].w);
        sm += __shfl_xor(sm, 16); sm += __shfl_xor(sm, 32);
        const float mu = sm * (1.0f / 128.0f);
        float sq = 0.f;
#pragma unroll
        for (int vt = 0; vt < 8; ++vt) { const f32x4 dlt = O[vt] - mu; sq += (dlt.x * dlt.x + dlt.y * dlt.y) + (dlt.z * dlt.z + dlt.w * dlt.w); }
        sq += __shfl_xor(sq, 16); sq += __shfl_xor(sq, 32);
        const float rstd = 1.0f / sqrtf(sq * (1.0f / 128.0f) + LN_EPS);
        const bf16_t* grow = (const bf16_t*)Z0 + (row0 + 16 * wave + fr) * ZW + 1536 + h * 128 + 4 * fq;
        bf16_t* orow = MIX + (row0 + 16 * wave + fr) * DM + h * 128 + 4 * fq;
#pragma unroll
        for (int vt = 0; vt < 8; ++vt) {
            const u32x2 gv = *(const u32x2*)(grow + 16 * vt);
            const f32x4 g4 = *(const f32x4*)(gn + h * 128 + 16 * vt + 4 * fq);
            const f32x4 y = (O[vt] - mu) * rstd * g4;
            u32x2 w; w.x = pk2(y.x * silu_f(bflo(gv.x)), y.y * silu_f(bfhi(gv.x))); w.y = pk2(y.z * silu_f(bflo(gv.y)), y.w * silu_f(bfhi(gv.y)));
            *(u32x2*)(orow + 16 * vt) = w;
        }
    }
}

#define XB_TMO      128
#define XB_XCNT(j)  (256  + 64 * (j))
#define XB_XSUB(j)  (1280 + 64 * (j))
#define XB_XGEN(j)  (2304 + 64 * (j))
#define XB_TOP      3328
#define XB_TOPGEN   3392
#define XCD_BAR_WORDS 3456
#define XB_SPIN_CAP (1u << 22)
__device__ __forceinline__ unsigned xb_ld(unsigned* p)              { return __hip_atomic_load(p, __ATOMIC_RELAXED, __HIP_MEMORY_SCOPE_AGENT); }
__device__ __forceinline__ unsigned xb_add(unsigned* p, unsigned v) { return __hip_atomic_fetch_add(p, v, __ATOMIC_RELAXED, __HIP_MEMORY_SCOPE_AGENT); }
__device__ __forceinline__ unsigned xb_xcc_id() { return (unsigned)__builtin_amdgcn_s_getreg((3 << 11) | 20) & 0xFu; }
#define XB_SPIN(cond, bar) do { unsigned _sp = 0; while (cond) { __builtin_amdgcn_s_sleep(1); \
    if ((++_sp & 255u) == 0u) { if (xb_ld(&(bar)[XB_TMO])) break; if (_sp > XB_SPIN_CAP) { atomicAdd(&(bar)[XB_TMO], 1u); break; } } } } while (0)
struct XcdBarrier { unsigned* bar; unsigned x; volatile LAS unsigned* st; };
__device__ __forceinline__ XcdBarrier xcd_barrier_post(unsigned* bar, volatile LAS unsigned* st) {
    XcdBarrier b; b.bar = bar; b.x = xb_xcc_id(); b.st = st;
    if (threadIdx.x == 0) (void)xb_add(&bar[XB_XCNT(b.x)], 1u);
    return b;
}
__device__ __forceinline__ void xcd_barrier_complete(unsigned* bar, unsigned x, unsigned& nloc, unsigned& nx) {
    const unsigned G = gridDim.x * gridDim.y * gridDim.z;
    unsigned sum, cnt, mine, sp = 0u;
    for (;;) {
        sum = 0u; cnt = 0u; mine = 0u;
#pragma unroll
        for (unsigned j = 0; j < 16; ++j) { const unsigned c = xb_ld(&bar[XB_XCNT(j)]); sum += c; cnt += (c > 0u) ? 1u : 0u; mine = (j == x) ? c : mine; }
        if (sum == G) break;
        __builtin_amdgcn_s_sleep(1);
        if ((++sp & 255u) == 0u) { if (xb_ld(&bar[XB_TMO])) break; if (sp > XB_SPIN_CAP) { atomicAdd(&bar[XB_TMO], 1u); break; } }
    }
    nloc = mine > 0u ? mine : 1u; nx = cnt > 0u ? cnt : 1u;
}
__device__ __forceinline__ void xcd_barrier(const XcdBarrier& b) {
    asm volatile("s_waitcnt vmcnt(0)" ::: "memory");
    __syncthreads();
    if (threadIdx.x == 0) {
        unsigned* bar = b.bar;
        __builtin_amdgcn_s_waitcnt(0);
        unsigned nloc = b.st[0], nx = b.st[1];
        if (nloc == 0u) { xcd_barrier_complete(bar, b.x, nloc, nx); b.st[0] = nloc; b.st[1] = nx; }
        const unsigned old = xb_add(&bar[XB_XSUB(b.x)], 1u);
        const unsigned gen = old / nloc;
        if (old + 1u == (gen + 1u) * nloc) {
            __builtin_amdgcn_fence(__ATOMIC_RELEASE, "agent");
            asm volatile("s_waitcnt vmcnt(0)" ::: "memory");
            const unsigned og = xb_add(&bar[XB_TOP], 1u);
            const unsigned tg = og / nx;
            if (og + 1u == (tg + 1u) * nx) xb_add(&bar[XB_TOPGEN], 1u);
            else XB_SPIN(xb_ld(&bar[XB_TOPGEN]) == tg, bar);
            __builtin_amdgcn_fence(__ATOMIC_ACQUIRE, "agent");
            xb_add(&bar[XB_XGEN(b.x)], 1u);
            asm volatile("s_waitcnt vmcnt(0)" ::: "memory");
        } else {
            XB_SPIN(xb_ld(&bar[XB_XGEN(b.x)]) == gen, bar);
            __builtin_amdgcn_fence(__ATOMIC_ACQUIRE, "agent");
            asm volatile("s_waitcnt vmcnt(0)" ::: "memory");
        }
    }
    __syncthreads();
}
constexpr size_t CTL_BAR_OFF = 16384;
constexpr size_t CTL_ZERO_BYTES = 65536;

#ifdef PH_ONLY
#define IN(k) ((k) == PH_ONLY)
#else
#define IN(k) (lo <= (k) && (k) < hi)
#endif
#define SEAM(k) do { if (IN(k) && IN((k) + 1)) xcd_barrier(grid); } while (0)
#ifndef PROBE_DUP
#define PROBE_DUP (-1)
#endif
#define REP(k) for (int _rep = 0; _rep < ((PROBE_DUP == (k)) ? 2 : 1); ++_rep)
#define REPS(k) ((PROBE_DUP == 100 + (k)) ? 2 : 1)

template <int LAYER, int BASE>
__device__ __forceinline__ void layer_tail(const Params& P, unsigned char* lds, const XcdBarrier& grid, int lo, int hi) {
    unsigned char* ws = P.ws;
    int* tb = (int*)(lds + MISC_OFF);
    if (IN(BASE)) { if (PROBE_DUP == BASE) phase_ln_route<true>(P, lds, LAYER); phase_ln_route<false>(P, lds, LAYER); }
    SEAM(BASE);
    if (IN(BASE + 1)) REP(BASE + 1) { moe_setup(P, tb, LAYER);
        MoeSched S{tb, (const int*)(ws + WS_CTL + CTL_CNT_OFF) + LAYER * 32 * CNT_STRIDE, (const int*)(ws + WS_LIST), (const bf16_t*)(ws + WS_XB),
                   (const bf16_t*)(ws + WS_W_GU) + (size_t)LAYER * 32 * DM * DM, DM, (size_t)DM * DM, true};
        EpiGU E{(bf16_t*)(ws + WS_ACT)}; gemm_moe<true>(lds, S, E);
        { const int U = tb[32] * 4, G = (int)gridDim.x, nheavy = (U % G), nlight = G - nheavy, lr = (int)blockIdx.x - nheavy;
          DenseSched S2{(const bf16_t*)(ws + WS_PB) + (size_t)LAYER * NTOK * 256, (const bf16_t*)(ws + WS_W_P) + (size_t)LAYER * DM * 256, NTOK, DM, 256, 256, 0, 1, lr, nlight};
          EpiStoreBf16 E2{(bf16_t*)(ws + WS_PP), DM, 0, nullptr}; gemm_dense(lds, S2, E2); } }
    SEAM(BASE + 1);
    if (IN(BASE + 2)) REP(BASE + 2) { moe_setup(P, tb, LAYER);
        MoeSched S{tb, (const int*)(ws + WS_CTL + CTL_CNT_OFF) + LAYER * 32 * CNT_STRIDE, (const int*)(ws + WS_LIST), (const bf16_t*)(ws + WS_ACT),
                   (const bf16_t*)(ws + WS_W_DN) + (size_t)LAYER * 32 * DM * 512, 512, (size_t)DM * 512, false};
        EpiDown E{(bf16_t*)(ws + WS_YS)}; gemm_moe<false>(lds, S, E); }
    SEAM(BASE + 2);
    if (IN(BASE + 3)) { if (PROBE_DUP == BASE + 3) phase_ln2<true>(P, LAYER); phase_ln2<false>(P, LAYER); }
    SEAM(BASE + 3);
    if (IN(BASE + 4)) REP(BASE + 4) {
        { DenseSched S{(const bf16_t*)(ws + WS_XB), (const bf16_t*)(ws + WS_W_G) + (size_t)LAYER * DM * DM, NTOK, DM, DM, DM, 0, REPS(BASE + 4)};
          EpiPle E{(const bf16_t*)(ws + WS_XB), (const bf16_t*)(ws + WS_PP), LAYER == 1 ? P.out : (float*)nullptr, LAYER == 1 ? (bf16_t*)nullptr : (bf16_t*)(ws + WS_XB2)}; gemm_dense(lds, S, E); }
    }
}

__global__ void __launch_bounds__(NT, 2) mega(Params P, int lo, int hi) {
    extern __shared__ __attribute__((aligned(16))) unsigned char lds[];
    unsigned char* ws = P.ws;
    if (threadIdx.x < 16) ((LAS unsigned*)((LAS unsigned char*)lds + BARW_OFF))[threadIdx.x] = 0u;
    __syncthreads();
    const XcdBarrier grid = xcd_barrier_post((unsigned*)(ws + WS_CTL + CTL_BAR_OFF), (volatile LAS unsigned*)((LAS unsigned char*)lds + BARW_OFF));
    if (IN(0)) REP(0) phase_prep(P, lds);
    SEAM(0);
    if (IN(1)) REP(1) { DenseSched S{(const bf16_t*)(ws + WS_XB), (const bf16_t*)(ws + WS_W_IN0), NTOK, ZW, DM, DM, 0, REPS(1)};
        EpiZ0 E{(bf16_t*)(ws + WS_Z0)}; gemm_dense(lds, S, E); }
    SEAM(1);
    if (IN(2)) REP(2) phase_ret_kv_mfma(P, lds);
    SEAM(2);
    if (IN(3)) REP(3) phase_ret_scan_pool2(P);
    SEAM(3);
    if (IN(4)) REP(4) { phase_ret_out_mfma(P, lds); __syncthreads();
        DenseSched S{(const bf16_t*)(ws + WS_DP), (const bf16_t*)(ws + WS_W_POOL), NTOK, 512, 256, 512, 256};
        EpiStoreBf16S E{(bf16_t*)(ws + WS_MIX), DM, 512, P.in[5]}; gemm_dense(lds, S, E); }
    SEAM(4);
    if (IN(5)) REP(5) { DenseSched S{(const bf16_t*)(ws + WS_MIX), (const bf16_t*)(ws + WS_W_OUT0), NTOK, DM, DM, DM, 0, REPS(5)};
        EpiResidB E{(const bf16_t*)(ws + WS_XB), (bf16_t*)(ws + WS_F)}; gemm_dense(lds, S, E); }
    SEAM(5);
    layer_tail<0, 6>(P, lds, grid, lo, hi);
    SEAM(10);
    if (IN(11)) REP(11) { DenseSched S{(const bf16_t*)(ws + WS_XB2), (const bf16_t*)(ws + WS_W_CIN), NTOK, Z1W, DM, DM, 0, REPS(11)};
        EpiStoreBf16 E{(bf16_t*)(ws + WS_Z1), Z1W, 0, nullptr}; gemm_dense(lds, S, E); }
    SEAM(11);
    if (IN(12)) REP(12) { phase_norms(P); phase_index_scores(P, lds); }
    SEAM(12);
    if (IN(13)) { if (PROBE_DUP == 13) phase_index_select<PROBE_SEL>(P, lds); phase_index_select<0>(P, lds); }
    if (IN(13) && IN(14)) __syncthreads();
    if (IN(14)) REP(14) { DenseSched S{(const bf16_t*)(ws + WS_CQ), (const bf16_t*)(ws + WS_W_QA), NTOK, 4096, 256, 256, 0, REPS(14)};
        EpiStoreFp8 E{(unsigned char*)(ws + WS_QA), 4096}; gemm_dense(lds, S, E); }
    SEAM(14);
    if (IN(15)) { if (PROBE_DUP == 15) phase_sparse_attn_e<true>(P, lds); phase_sparse_attn_e<false>(P, lds); }
    SEAM(15);
    if (IN(16)) REP(16) { DenseSched S{(const bf16_t*)(ws + WS_OLAT), (const bf16_t*)(ws + WS_W_UVBD), NTOK, DM, DM, 4096, 1024, REPS(16)};
        EpiStoreBf16 E{(bf16_t*)(ws + WS_XB), DM, 0, nullptr}; gemm_dense_bdiag(lds, S, E); }
    SEAM(16);
    if (IN(17)) REP(17) { DenseSched S{(const bf16_t*)(ws + WS_XB), (const bf16_t*)(ws + WS_W_COUT), NTOK, DM, DM, DM, 0, REPS(17)};
        EpiResidB E{(const bf16_t*)(ws + WS_XB2), (bf16_t*)(ws + WS_F)}; gemm_dense(lds, S, E); }
    SEAM(17);
    layer_tail<1, 18>(P, lds, grid, lo, hi);
}
#undef IN
#undef SEAM

extern "C" void kernel_launch(void* const* d_in, const int* in_sizes, int n_in, void* d_out, int out_size, void* d_ws, size_t ws_size, hipStream_t stream) {
    static int grid = 0;
    if (grid == 0) {
        if (n_in != 26 || ws_size < WS_END || out_size != NTOK * DM) { fprintf(stderr, "kernel_launch: unexpected problem (n_in %d, ws %zu, out %d)\n", n_in, ws_size, out_size); grid = -1; return; }
        int dev = 0, cus = 0, per_cu = 0;
        (void)hipGetDevice(&dev);
        (void)hipDeviceGetAttribute(&cus, hipDeviceAttributeMultiprocessorCount, dev);
        (void)hipFuncSetAttribute((const void*)mega, hipFuncAttributeMaxDynamicSharedMemorySize, LDS_BYTES);
        (void)hipOccupancyMaxActiveBlocksPerMultiprocessor(&per_cu, (const void*)mega, NT, LDS_BYTES);
        if (per_cu < 1) { fprintf(stderr, "kernel_launch: occupancy query reports %d blocks per CU\n", per_cu); per_cu = 1; }
        (void)hipGetLastError();
        grid = cus;
    }
    if (grid < 0) return;
    (void)hipMemsetAsync((char*)d_ws + WS_CTL, 0, CTL_ZERO_BYTES, stream);
    Params p{};
    for (int i = 0; i < 26; ++i) p.in[i] = (const float*)d_in[i];
    p.out = (float*)d_out; p.ws = (unsigned char*)d_ws;
#if MK_ONE_LAUNCH
    int lo = 0, hi = NPH_TOTAL;
    void* args[] = {&p, &lo, &hi};
    (void)args;
    hipLaunchKernelGGL(mega, dim3(grid), dim3(NT), LDS_BYTES, stream, p, lo, hi);
    hipError_t e = hipPeekAtLastError();
    if (e != hipSuccess) fprintf(stderr, "launch failed: %s (grid %d)\n", hipGetErrorString(e), grid);
#else
    for (int k = 0; k < NPH_TOTAL; ++k) hipLaunchKernelGGL(mega, dim3(grid), dim3(NT), LDS_BYTES, stream, p, k, k + 1);
#endif
}
```

```cpp
#include <hip/hip_runtime.h>
#include <cstdio>
#include <cstdint>

#ifndef PROBE_ATT
#define PROBE_ATT 0
#endif
#ifndef PROBE_LN
#define PROBE_LN 0
#endif
#ifndef PROBE_SEL
#define PROBE_SEL 0
#endif
#ifndef MK_ONE_LAUNCH
#define MK_ONE_LAUNCH 1
#endif

typedef unsigned short bf16_t;
typedef float f32x4 __attribute__((ext_vector_type(4)));
typedef unsigned u32x4 __attribute__((ext_vector_type(4)));
typedef unsigned u32x2 __attribute__((ext_vector_type(2)));

constexpr int NT = 512;
constexpr int NWAVE = NT / 64;
constexpr int NTOK = 32768, DM = 1024, SEQ = 8192, NBATCH = 4;
constexpr int ZW = 2560;
constexpr int Z1W = 1280;
constexpr int CIN = 1096;
constexpr int TOPK = 256;
constexpr float ALPHA = 1.4142135623730951f;
constexpr float LN_EPS = 1e-5f;
constexpr int LDS_BYTES = 163840;
constexpr int BARW_OFF = LDS_BYTES - 64;
constexpr int MISC_OFF = 135168;

constexpr size_t MiB = (size_t)1 << 20;
constexpr size_t WS_CTL = 0;
constexpr size_t WS_W_IN0 = 1 * MiB, WS_W_OUT0 = 6 * MiB, WS_W_POOL = 8 * MiB, WS_W_CIN = 9 * MiB, WS_W_QA = 12 * MiB,
                 WS_W_UVBD = 14 * MiB, WS_W_COUT = 16 * MiB, WS_W_G = 18 * MiB, WS_W_P = 22 * MiB, WS_W_GU = 24 * MiB, WS_W_DN = 152 * MiB;
constexpr size_t WS_XB = 224 * MiB, WS_F = 288 * MiB, WS_PB = 416 * MiB, WS_PP = 448 * MiB, WS_CQ = 512 * MiB, WS_CKV = 528 * MiB,
                 WS_SEL = 544 * MiB, WS_TOKG = 560 * MiB, WS_LIST = 561 * MiB, WS_CKV8 = 566 * MiB;
constexpr size_t WS_M0 = 576 * MiB;
constexpr size_t WS_Z0 = WS_M0, WS_KV = WS_M0 + 160 * MiB, WS_MIX = WS_M0 + 224 * MiB, WS_DP = WS_M0 + 288 * MiB, WS_SB = WS_M0 + 320 * MiB;
constexpr size_t WS_OLAT = WS_M0, WS_QA = WS_F  , WS_SC = WS_M0, WS_Z1 = WS_M0 + 272 * MiB;
constexpr size_t WS_ACT = WS_M0, WS_YS = WS_M0 + 72 * MiB;
constexpr size_t WS_XB2 = 960 * MiB;
constexpr size_t WS_END = 1024 * MiB;
constexpr int LIST_CAP = 32768;
constexpr size_t CTL_CNT_OFF = 32768;
constexpr int CNT_STRIDE = 64;
constexpr size_t WS_GT = WS_CTL + 262144;
constexpr size_t WS_SGB = WS_CTL + 786432;

struct Params {
    const float* in[26];
    float* out;
    unsigned char* ws;
};

__device__ __forceinline__ unsigned f2bf(float f) { unsigned u = __float_as_uint(f); return (u + 0x7fffu + ((u >> 16) & 1u)) >> 16; }
__device__ __forceinline__ float bf2f(unsigned h) { return __uint_as_float(h << 16); }
typedef float f32x2_t __attribute__((ext_vector_type(2))); typedef __bf16 bf16x2_t __attribute__((ext_vector_type(2)));
__device__ __forceinline__ unsigned pk2(float lo, float hi) { f32x2_t v = {lo, hi}; bf16x2_t b = __builtin_convertvector(v, bf16x2_t); return __builtin_bit_cast(unsigned, b); }
__device__ __forceinline__ float bflo(unsigned w) { return __uint_as_float(w << 16); }
__device__ __forceinline__ float bfhi(unsigned w) { return __uint_as_float(w & 0xffff0000u); }
#define WAVE_SUM_DPP(v) ({ float _v = (v); \
    _v += __builtin_bit_cast(float, __builtin_amdgcn_update_dpp(0, __builtin_bit_cast(int, _v), 0xB1, 0xf, 0xf, true));     \
    _v += __builtin_bit_cast(float, __builtin_amdgcn_update_dpp(0, __builtin_bit_cast(int, _v), 0x4E, 0xf, 0xf, true));     \
    _v += __builtin_bit_cast(float, __builtin_amdgcn_update_dpp(0, __builtin_bit_cast(int, _v), 0x141, 0xf, 0xf, true));    \
    _v += __builtin_bit_cast(float, __builtin_amdgcn_update_dpp(0, __builtin_bit_cast(int, _v), 0x140, 0xf, 0xf, true));    \
    _v += __builtin_bit_cast(float, __builtin_amdgcn_update_dpp(0, __builtin_bit_cast(int, _v), 0x142, 0xa, 0xf, false));   \
    _v += __builtin_bit_cast(float, __builtin_amdgcn_update_dpp(0, __builtin_bit_cast(int, _v), 0x143, 0xc, 0xf, false));   \
    __builtin_bit_cast(float, __builtin_amdgcn_readlane(__builtin_bit_cast(int, _v), 63)); })
__device__ __forceinline__ float wave_sum(float v) { return WAVE_SUM_DPP(v); }
#define WAVE_SCAN_DPP(v) ({ unsigned _v = (v); \
    _v += (unsigned)__builtin_amdgcn_update_dpp(0, (int)_v, 0x111, 0xf, 0xf, false); \
    _v += (unsigned)__builtin_amdgcn_update_dpp(0, (int)_v, 0x112, 0xf, 0xf, false); \
    _v += (unsigned)__builtin_amdgcn_update_dpp(0, (int)_v, 0x114, 0xf, 0xf, false); \
    _v += (unsigned)__builtin_amdgcn_update_dpp(0, (int)_v, 0x118, 0xf, 0xf, false); \
    _v += (unsigned)__builtin_amdgcn_update_dpp(0, (int)_v, 0x142, 0xa, 0xf, false); \
    _v += (unsigned)__builtin_amdgcn_update_dpp(0, (int)_v, 0x143, 0xc, 0xf, false); \
    _v; })

__device__ __forceinline__ float silu_f(float a) { return a / (1.0f + __expf(-a)); }
__device__ __forceinline__ float sigmoid_f(float a) { return 1.0f / (1.0f + __expf(-a)); }
#define LDS_FENCE() asm volatile("s_waitcnt lgkmcnt(0)" ::: "memory")

struct UnitInfo {
    const bf16_t* A; int lda;
    const int* rows; int rshift;
    int nvalid;
    const bf16_t* Bt; int ldb;
    int K;
    int orow0;
    int pn;
};

struct DenseSched {
    const bf16_t* A; const bf16_t* Bt; int M, N, K, lda, a_pn_stride; int reps = 1;
    int wrank = -1, wcount = 0;
    __device__ __forceinline__ bool next(int round, UnitInfo& u) const {
        const int nN = N >> 8, nM = M >> 8, nwg = nN * nM;
        if (wcount > 0 && wrank < 0) return false;
        const long L = (wcount > 0) ? ((long)round * wcount + wrank) : ((long)round * gridDim.x + blockIdx.x); if (L >= (long)nwg * reps) return false;
        int wgid = (int)(L % nwg); { const int q = nwg / 8, r = nwg % 8, xcd = wgid % 8, off = wgid / 8; wgid = (xcd < r ? xcd * (q + 1) : r * (q + 1) + (xcd - r) * q) + off; }
        const int nig = 8 * nN, gid = wgid / nig, fm = gid * 8, gsz = (nM - fm) < 8 ? (nM - fm) : 8;
        const int pm = fm + ((wgid % nig) % gsz), pn = (wgid % nig) / gsz;
        u.A = A + (size_t)pm * 256 * lda + (size_t)pn * a_pn_stride; u.lda = lda; u.rows = nullptr; u.rshift = 0; u.nvalid = 256;
        u.Bt = Bt + (size_t)pn * 256 * K; u.ldb = K; u.K = K; u.orow0 = pm * 256; u.pn = pn;
        return true;
    }
};
struct MoeSched {
    const int* tb; const int* cnt; const int* list;
    const bf16_t* A; const bf16_t* W; int K; size_t wstride; bool gather;
    __device__ __forceinline__ bool next(int round, UnitInfo& u) const {
        const int i = round * gridDim.x + blockIdx.x;
        const int j = i >> 2, pn = i & 3;
        if (j >= tb[32]) return false;
        int e = 0;
        while (tb[e + 1] <= j) ++e;
        const int rb = j - tb[e];
        const int nv = min(256, cnt[e] - rb * 256);
        u.rows = list + (size_t)e * LIST_CAP + rb * 256; u.nvalid = nv; u.orow0 = j * 256; u.pn = pn;
        if (gather) { u.A = A; u.lda = K; u.rshift = 1; }
        else { u.A = A + (size_t)j * 256 * K; u.lda = K; u.rshift = 31;   }
        u.Bt = W + (size_t)e * wstride + (size_t)pn * 256 * K; u.ldb = K; u.K = K;
        return true;
    }
};


namespace pg8 {
#define LAS __attribute__((address_space(3)))
typedef short bf16x8 __attribute__((ext_vector_type(8)));
constexpr int BK = 64, HALF = 128, HTB = HALF * BK * 2, STAGE_BYTES = 8 * HTB;
__device__ __forceinline__ int lds_byte(int r, int c) { const int st = (r >> 4) * 2 + (c >> 5), rr = r & 15, cc = c & 31, ob = rr * 64 + cc * 2; return st * 1024 + (ob ^ (((ob >> 9) & 1) << 5)); }
__device__ __forceinline__ void stage_rc(int b, int& R, int& C) { const int st = b / 1024, sb = b % 1024, swz = sb ^ (((sb >> 9) & 1) << 5); R = (st >> 1) * 16 + swz / 64; C = (st & 1) * 32 + (swz % 64) / 2; }
__device__ __forceinline__ int perm32(int rho) { const int n = rho >> 4, i = rho & 15; return 8 * (i >> 2) + 4 * n + (i & 3); }

template <bool GATHER, class Sched, class Epi, bool BDIAG = false>
__device__ __forceinline__ void gemm_phase(LAS unsigned char* lds, const LAS unsigned* rowtab, const Sched& S, const Epi& E, const int lda, const int ldb, const int K) {
    const int tid = threadIdx.x, wid = __builtin_amdgcn_readfirstlane(tid >> 6), lane = tid & 63, wr = wid >> 2, wc = wid & 3, fr = lane & 15, fq = lane >> 4;
    const int nt = K / BK;
    unsigned voffA[2], voffB[2]; int RA[2]; unsigned CA2[2];
#pragma unroll
    for (int i = 0; i < 2; ++i) { int R, C; stage_rc(tid * 16 + i * 8192, R, C); const int Rb = (R & ~31) + perm32(R & 31);
        voffA[i] = (unsigned)(R * lda + C) * 2u; voffB[i] = (unsigned)(Rb * ldb + C) * 2u; RA[i] = R; CA2[i] = (unsigned)C * 2u; }
    const size_t kstep = (size_t)(BK * 2);
    const size_t hstepA = (size_t)HALF * lda * 2, hstepB = (size_t)HALF * ldb * 2;
    const unsigned ldsw = (unsigned)wid * 1024u;
    const int aoff = lds_byte(wr * 64 + fr, fq * 8), boff = lds_byte(wc * 32 + fr, fq * 8);
    unsigned offA[2][2];
#define PG8_SA(b, h) (((b) * 2 + (h)) * HTB)
#define PG8_SB(b, h) ((4 + (b) * 2 + (h)) * HTB)
#define PG8_STAGE(bufoff, gbase, voff) do { _Pragma("unroll") for (int _i = 0; _i < 2; ++_i) \
        __builtin_amdgcn_global_load_lds((const unsigned*)((const char*)(gbase) + (voff)[_i]), (LAS unsigned*)(lds + (bufoff) + ldsw + _i * 8192), 16, 0, 0); } while (0)
#define PG8_STAGE_A(bufoff, h, gbase) do { if (GATHER) PG8_STAGE(bufoff, gbase, offA[h]); else PG8_STAGE(bufoff, (gbase) + (h) * hstepA, voffA); } while (0)
#define PG8_LOADOFF(round) do { _Pragma("unroll") for (int _h = 0; _h < 2; ++_h) _Pragma("unroll") for (int _i = 0; _i < 2; ++_i) offA[_h][_i] = rowtab[(round) * 256 + _h * 128 + RA[_i]] + CA2[_i]; } while (0)
#define PG8_LDA(dst, b, h) do { _Pragma("unroll") for (int m = 0; m < 4; ++m) _Pragma("unroll") for (int k = 0; k < 2; ++k) dst[m][k] = *(const LAS bf16x8*)(lds + PG8_SA(b, h) + aoff + m * 2048 + k * 1024); } while (0)
#define PG8_LDB(dst, b, h) do { _Pragma("unroll") for (int n = 0; n < 2; ++n) _Pragma("unroll") for (int k = 0; k < 2; ++k) dst[n][k] = *(const LAS bf16x8*)(lds + PG8_SB(b, h) + boff + n * 2048 + k * 1024); } while (0)
#define PG8_MMA(ai, bj, At, Bt) do { if (!BDIAG || (((kt_ >> 2) & 3) == 2 * (bj) + (wc >> 1))) { __builtin_amdgcn_s_setprio(1); _Pragma("unroll") for (int m = 0; m < 4; ++m) _Pragma("unroll") for (int n = 0; n < 2; ++n) _Pragma("unroll") for (int k = 0; k < 2; ++k) \
        acc[ai][bj][m][n] = __builtin_amdgcn_mfma_f32_16x16x32_bf16(Bt[n][k], At[m][k], acc[ai][bj][m][n], 0, 0, 0); __builtin_amdgcn_s_setprio(0); } } while (0)
#define PG8_WAIT_V(n) asm volatile("s_waitcnt vmcnt(" #n ")" ::: "memory")
#define PG8_WAIT_L(n) asm volatile("s_waitcnt lgkmcnt(" #n ")" ::: "memory")
#define PG8_BAR __builtin_amdgcn_s_barrier()
#define PG8_SCHED __builtin_amdgcn_sched_barrier(0)
    UnitInfo cur, nxt; int ui = 0;
    if (!S.next(0, cur)) return;
    f32x4 acc[2][2][4][2];
#pragma unroll
    for (int a = 0; a < 2; ++a)
#pragma unroll
        for (int b = 0; b < 2; ++b)
#pragma unroll
            for (int m = 0; m < 4; ++m)
#pragma unroll
                for (int n = 0; n < 2; ++n) acc[a][b][m][n] = (f32x4){0.f, 0.f, 0.f, 0.f};
    bf16x8 At[4][2], B0[2][2], B1[2][2];
    const char* cA = (const char*)cur.A; const char* cB = (const char*)cur.Bt;
    if (GATHER) { PG8_LOADOFF(0); }
    PG8_STAGE(PG8_SB(0, 0), cB, voffB); PG8_STAGE(PG8_SB(0, 1), cB + hstepB, voffB); PG8_STAGE_A(PG8_SA(0, 0), 0, cA); PG8_STAGE_A(PG8_SA(0, 1), 1, cA);
    if (wr == 1) PG8_BAR;
    PG8_WAIT_V(2); PG8_BAR;
    PG8_STAGE(PG8_SB(1, 0), cB + kstep, voffB); PG8_STAGE_A(PG8_SA(1, 0), 0, cA + kstep); PG8_STAGE(PG8_SB(1, 1), cB + hstepB + kstep, voffB);
    PG8_WAIT_V(6); PG8_BAR;
    for (;;) {
        const bool has_next = S.next(ui + 1, nxt);
        const char* nA = has_next ? (const char*)nxt.A : cA; const char* nB = has_next ? (const char*)nxt.Bt : cB;
        for (int t = 0; t < nt; t += 2) {
            const bool last = (t == nt - 2);
            const char* a1 = cA + (size_t)(t + 1) * kstep;
            const char* a2 = last ? nA : cA + (size_t)(t + 2) * kstep; const char* b2 = last ? nB : cB + (size_t)(t + 2) * kstep;
            const char* a3 = a2 + kstep; const char* b3 = b2 + kstep;
            int kt_ = t;
            PG8_LDB(B0, 0, 0); PG8_LDB(B1, 0, 1); PG8_SCHED; PG8_LDA(At, 0, 0); PG8_STAGE_A(PG8_SA(1, 1), 1, a1);
            if (GATHER) { if (last && has_next) { PG8_LOADOFF(ui + 1); } }
            PG8_WAIT_V(8); PG8_WAIT_L(0); PG8_BAR; PG8_MMA(0, 0, At, B0); PG8_MMA(0, 1, At, B1); PG8_BAR; PG8_SCHED;
            PG8_LDA(At, 0, 1); PG8_STAGE(PG8_SB(0, 0), b2, voffB); PG8_STAGE(PG8_SB(0, 1), b2 + hstepB, voffB); PG8_STAGE_A(PG8_SA(0, 0), 0, a2);
            PG8_WAIT_V(8); PG8_WAIT_L(0); PG8_BAR; PG8_MMA(1, 0, At, B0); PG8_MMA(1, 1, At, B1); PG8_BAR; PG8_SCHED;
            kt_ = t + 1;
            PG8_LDB(B0, 1, 0); PG8_LDB(B1, 1, 1); PG8_SCHED; PG8_LDA(At, 1, 0); PG8_STAGE_A(PG8_SA(0, 1), 1, a2);
            PG8_WAIT_V(8); PG8_WAIT_L(0); PG8_BAR; PG8_MMA(0, 0, At, B0); PG8_MMA(0, 1, At, B1); PG8_BAR; PG8_SCHED;
            PG8_LDA(At, 1, 1); PG8_STAGE(PG8_SB(1, 0), b3, voffB); PG8_STAGE(PG8_SB(1, 1), b3 + hstepB, voffB); PG8_STAGE_A(PG8_SA(1, 0), 0, a3);
            PG8_WAIT_V(8); PG8_WAIT_L(0); PG8_BAR; PG8_MMA(1, 0, At, B0); PG8_MMA(1, 1, At, B1); PG8_BAR; PG8_SCHED;
        }
        if (wr == 0) PG8_BAR;
        if constexpr (Epi::NPRE > 0) {
#pragma unroll
            for (int ai = 0; ai < 2; ++ai) {
                u32x4 pre[8 * Epi::NPRE];
#pragma unroll
                for (int m = 0; m < 4; ++m)
#pragma unroll
                    for (int bj = 0; bj < 2; ++bj) E.pre(cur, ai * HALF + wr * 64 + m * 16 + fr, bj * HALF + wc * 32 + 8 * fq, &pre[(m * 2 + bj) * Epi::NPRE]);
                PG8_SCHED;
#pragma unroll
                for (int m = 0; m < 4; ++m)
#pragma unroll
                    for (int bj = 0; bj < 2; ++bj) E.post(cur, ai * HALF + wr * 64 + m * 16 + fr, bj * HALF + wc * 32 + 8 * fq, acc[ai][bj][m][0], acc[ai][bj][m][1], &pre[(m * 2 + bj) * Epi::NPRE]);
                PG8_SCHED;
            }
        } else {
#pragma unroll
        for (int ai = 0; ai < 2; ++ai)
#pragma unroll
            for (int m = 0; m < 4; ++m)
#pragma unroll
                for (int bj = 0; bj < 2; ++bj) E(cur, ai * HALF + wr * 64 + m * 16 + fr, bj * HALF + wc * 32 + 8 * fq, acc[ai][bj][m][0], acc[ai][bj][m][1]);
        }
        if (!has_next) break;
#pragma unroll
        for (int a = 0; a < 2; ++a)
#pragma unroll
            for (int b = 0; b < 2; ++b)
#pragma unroll
                for (int m = 0; m < 4; ++m)
#pragma unroll
                    for (int n = 0; n < 2; ++n) acc[a][b][m][n] = (f32x4){0.f, 0.f, 0.f, 0.f};
        cur = nxt; cA = nA; cB = nB; ++ui;
        if (wr == 1) PG8_BAR;
    }
    PG8_WAIT_V(0);
    PG8_BAR;
#undef PG8_SA
#undef PG8_SB
#undef PG8_STAGE
#undef PG8_STAGE_A
#undef PG8_LOADOFF
#undef PG8_LDA
#undef PG8_LDB
#undef PG8_MMA
#undef PG8_WAIT_V
#undef PG8_WAIT_L
#undef PG8_BAR
#undef PG8_SCHED
}
}

template <class Sched, class Epi>
__device__ __forceinline__ void gemm_dense(unsigned char* lds, const Sched& S, const Epi& E) {
    pg8::gemm_phase<false>((LAS unsigned char*)lds, (const LAS unsigned*)nullptr, S, E, S.lda, S.K, S.K);
    __syncthreads();
}
template <class Sched, class Epi>
__device__ __forceinline__ void gemm_dense_bdiag(unsigned char* lds, const Sched& S, const Epi& E) {
    pg8::gemm_phase<false, Sched, Epi, true>((LAS unsigned char*)lds, (const LAS unsigned*)nullptr, S, E, S.lda, S.K, S.K);
    __syncthreads();
}


template <bool GATHER, class Epi>
__device__ __forceinline__ void gemm_moe(unsigned char* lds, const MoeSched& S, const Epi& E) {
    LAS unsigned* rowtab = (LAS unsigned*)(lds + MISC_OFF + 512);
    if (GATHER) {
        for (int r0 = 0; r0 < 10; r0 += 5) {
            const int* rp[5]; int nv[5]; bool ok[5]; int v[5];
#pragma unroll
            for (int q = 0; q < 5; ++q) { UnitInfo u; ok[q] = S.next(r0 + q, u); rp[q] = ok[q] ? u.rows : S.list; nv[q] = ok[q] ? u.nvalid : 0; }
            const int tr = (int)(threadIdx.x & 255);
#pragma unroll
            for (int q = 0; q < 5; ++q) v[q] = rp[q][tr];
#pragma unroll
            for (int q = 0; q < 5; ++q) if (ok[q] && threadIdx.x < 256) rowtab[(r0 + q) * 256 + threadIdx.x] = (tr < nv[q]) ? (unsigned)(v[q] >> 1) * (unsigned)(S.K * 2) : 0u;
            if (!ok[4]) break;
        }
        __syncthreads();
    }
    pg8::gemm_phase<GATHER>((LAS unsigned char*)lds, (const LAS unsigned*)rowtab, S, E, S.K, S.K, S.K);
    __syncthreads();
}

__device__ __forceinline__ u32x4 pack8(f32x4 a, f32x4 b) { u32x4 w; w.x = pk2(a.x, a.y); w.y = pk2(a.z, a.w); w.z = pk2(b.x, b.y); w.w = pk2(b.z, b.w); return w; }
struct EpiStoreBf16 {
    static constexpr int NPRE = 0;
    bf16_t* O; int ldc; int coff; const float* colscale;
    __device__ __forceinline__ void operator()(const UnitInfo& u, int r, int c, f32x4 v0, f32x4 v1) const {
        const int col = u.pn * 256 + c;
        if (colscale) { const f32x4 s0 = *(const f32x4*)(colscale + col), s1 = *(const f32x4*)(colscale + col + 4); v0 *= s0; v1 *= s1; }
        *(u32x4*)(O + (size_t)(u.orow0 + r) * ldc + coff + col) = pack8(v0, v1);
    }
};

struct EpiStoreBf16S {
    static constexpr int NPRE = 2;
    bf16_t* O; int ldc; int coff; const float* colscale;
    __device__ __forceinline__ void pre(const UnitInfo& u, int r, int c, u32x4* p) const {
        const int col = u.pn * 256 + c; p[0] = *(const u32x4*)(colscale + col); p[1] = *(const u32x4*)(colscale + col + 4); }
    __device__ __forceinline__ void post(const UnitInfo& u, int r, int c, f32x4 v0, f32x4 v1, const u32x4* p) const {
        const int col = u.pn * 256 + c;
        v0 *= __builtin_bit_cast(f32x4, p[0]); v1 *= __builtin_bit_cast(f32x4, p[1]);
        *(u32x4*)(O + (size_t)(u.orow0 + r) * ldc + coff + col) = pack8(v0, v1);
    }
};

__device__ __forceinline__ float ret_log2g(int h) { return log2f(1.0f - exp2f(-5.0f - (float)h)); }
struct EpiZ0 {
    static constexpr int NPRE = 0;
    bf16_t* O;
    __device__ __forceinline__ void operator()(const UnitInfo& u, int r, int c, f32x4 v0, f32x4 v1) const {
        const int col = u.pn * 256 + c, row = u.orow0 + r;
        if (col < 1024) { const float e = ret_log2g((col >> 7) & 3) * (float)(row & 127); const float sc = exp2f(col < 512 ? e : -e); v0 *= sc; v1 *= sc; }
        *(u32x4*)(O + (size_t)row * ZW + col) = pack8(v0, v1);
    }
};

struct EpiStoreFp8 {
    static constexpr int NPRE = 0;
    unsigned char* O; int ldc;
    __device__ __forceinline__ void operator()(const UnitInfo& u, int r, int c, f32x4 v0, f32x4 v1) const {
        int w0 = __builtin_amdgcn_cvt_pk_fp8_f32(v0.x, v0.y, 0, false); w0 = __builtin_amdgcn_cvt_pk_fp8_f32(v0.z, v0.w, w0, true);
        int w1 = __builtin_amdgcn_cvt_pk_fp8_f32(v1.x, v1.y, 0, false); w1 = __builtin_amdgcn_cvt_pk_fp8_f32(v1.z, v1.w, w1, true);
        u32x2 w; w.x = (unsigned)w0; w.y = (unsigned)w1;
        *(u32x2*)(O + (size_t)(u.orow0 + r) * ldc + u.pn * 256 + c) = w;
    }
};
struct EpiResidB {
    static constexpr int NPRE = 1;
    const bf16_t* X; bf16_t* Yo;
    __device__ __forceinline__ void pre(const UnitInfo& u, int r, int c, u32x4* p) const { p[0] = *(const u32x4*)(X + (size_t)(u.orow0 + r) * DM + u.pn * 256 + c); }
    __device__ __forceinline__ void post(const UnitInfo& u, int r, int c, f32x4 v0, f32x4 v1, const u32x4* p) const {
        const size_t off = (size_t)(u.orow0 + r) * DM + u.pn * 256 + c;
        const u32x4 xw = p[0];
        const f32x4 x0 = {bflo(xw.x), bfhi(xw.x), bflo(xw.y), bfhi(xw.y)}, x1 = {bflo(xw.z), bfhi(xw.z), bflo(xw.w), bfhi(xw.w)};
        *(u32x4*)(Yo + off) = pack8(x0 * ALPHA + v0, x1 * ALPHA + v1);
    }
};

struct EpiGU {
    static constexpr int NPRE = 0;
    bf16_t* ACT;
    __device__ __forceinline__ void operator()(const UnitInfo& u, int r, int c, f32x4 v0, f32x4 v1) const {
        u32x2 w; w.x = pk2(silu_f(v0.x) * v0.y, silu_f(v0.z) * v0.w); w.y = pk2(silu_f(v1.x) * v1.y, silu_f(v1.z) * v1.w);
        *(u32x2*)(ACT + (size_t)(u.orow0 + r) * 512 + u.pn * 128 + (c >> 1)) = w;
    }
};
struct EpiDown {
    static constexpr int NPRE = 1;
    bf16_t* YS;
    __device__ __forceinline__ void pre(const UnitInfo& u, int r, int c, u32x4* p) const { p[0].x = (unsigned)u.rows[r]; }
    __device__ __forceinline__ void post(const UnitInfo& u, int r, int c, f32x4 v0, f32x4 v1, const u32x4* p) const {
        const int pair = (r < u.nvalid) ? (int)p[0].x : 2 * NTOK;
        *(u32x4*)(YS + (size_t)pair * DM + u.pn * 256 + c) = pack8(v0, v1);
    }
};
struct EpiPle {
    static constexpr int NPRE = 2;
    const bf16_t* XI; const bf16_t* PP; float* OUT; bf16_t* XO;
    __device__ __forceinline__ void pre(const UnitInfo& u, int r, int c, u32x4* p) const {
        const size_t off = (size_t)(u.orow0 + r) * DM + u.pn * 256 + c; p[0] = *(const u32x4*)(PP + off); p[1] = *(const u32x4*)(XI + off); }
    __device__ __forceinline__ void post(const UnitInfo& u, int r, int c, f32x4 v0, f32x4 v1, const u32x4* p) const {
        const size_t off = (size_t)(u.orow0 + r) * DM + u.pn * 256 + c;
        const u32x4 pw = p[0], xw = p[1];
        f32x4 f0 = {bflo(xw.x), bfhi(xw.x), bflo(xw.y), bfhi(xw.y)}, f1 = {bflo(xw.z), bfhi(xw.z), bflo(xw.w), bfhi(xw.w)};
        f0.x += sigmoid_f(v0.x) * bflo(pw.x); f0.y += sigmoid_f(v0.y) * bfhi(pw.x); f0.z += sigmoid_f(v0.z) * bflo(pw.y); f0.w += sigmoid_f(v0.w) * bfhi(pw.y);
        f1.x += sigmoid_f(v1.x) * bflo(pw.z); f1.y += sigmoid_f(v1.y) * bfhi(pw.z); f1.z += sigmoid_f(v1.z) * bflo(pw.w); f1.w += sigmoid_f(v1.w) * bfhi(pw.w);
        if (OUT) { *(f32x4*)(OUT + off) = f0; *(f32x4*)(OUT + off + 4) = f1; }
        if (XO) *(u32x4*)(XO + off) = pack8(f0, f1);
    }
};

struct TrDesc { const float* src; bf16_t* dst; int K, N, Nsrc, nbatch, mode, dst_ld; };
struct TrItem { const float* src; bf16_t* dst; int Nsrc, dst_ld, mode, kb, nb; };
__device__ __forceinline__ void tr_load(const TrItem& t, int lane, float (&tmp)[32]) {
    const int k0 = 64 * t.kb, n0 = 32 * t.nb, Ns = t.Nsrc;
    const bool okc = (n0 + (lane & 31)) < Ns;
    const float* p = t.src + (size_t)(k0 + (lane >> 5)) * Ns + n0 + (lane & 31);
#pragma unroll
    for (int i = 0; i < 32; ++i) { tmp[i] = okc ? __builtin_nontemporal_load(p) : 0.f; p += 2 * Ns; asm volatile("" : "+v"(p)); }
}
__device__ __forceinline__ void tr_store(const TrItem& t, float* scr, int lane, const float (&tmp)[32]) {
    const int k0 = 64 * t.kb, n0 = 32 * t.nb;
#pragma unroll
    for (int i = 0; i < 32; ++i) scr[(2 * i + (lane >> 5)) * 33 + (lane & 31)] = tmp[i];
    LDS_FENCE();
    const int c = lane & 7;
    int n8 = lane >> 3; asm volatile("" : "+v"(n8));
#pragma unroll
    for (int j = 0; j < 4; ++j) {
        const int n = n8 + 8 * j; const float* sp = scr + (8 * c) * 33 + n;
        const int ng = n0 + n;
        float sc = 1.f; int nd = ng; int coff = 0;
        if (t.mode == 1) { if (ng >= 512 && ng < 1024) sc = 0.08838834764831845f; }
        if (t.mode == 2) { nd = (ng < 512) ? 2 * ng : 2 * (ng - 512) + 1; }
        if (t.mode == 3) { coff = ((ng >> 6) & 3) * 256; }
        u32x4 o; o.x = pk2(sp[0 * 33] * sc, sp[1 * 33] * sc); o.y = pk2(sp[2 * 33] * sc, sp[3 * 33] * sc); o.z = pk2(sp[4 * 33] * sc, sp[5 * 33] * sc); o.w = pk2(sp[6 * 33] * sc, sp[7 * 33] * sc);
        *(u32x4*)(t.dst + (size_t)nd * t.dst_ld + coff + k0 + 8 * c) = o;
    }
    LDS_FENCE();
}
__device__ __forceinline__ int tr_items(const TrDesc& d) { return d.nbatch * (d.K / 64) * (d.N / 32); }

constexpr int N_DEFERRED = 32 * 512 + 32 * 256;
__device__ __forceinline__ TrItem deferred_item(const Params& P, int idx) {
    TrItem t;
    if (idx < 32 * 512) { const int b = 32 + (idx >> 9), r = idx & 511;
        t.src = P.in[22] + (size_t)b * 1024 * 1024; t.dst = (bf16_t*)(P.ws + WS_W_GU) + (size_t)b * 1024 * 1024; t.Nsrc = 1024; t.dst_ld = 1024; t.mode = 2; t.kb = r >> 5; t.nb = r & 31; }
    else { const int i2 = idx - 32 * 512, b = 32 + (i2 >> 8), r = i2 & 255;
        t.src = P.in[23] + (size_t)b * 512 * 1024; t.dst = (bf16_t*)(P.ws + WS_W_DN) + (size_t)b * 1024 * 512; t.Nsrc = 1024; t.dst_ld = 512; t.mode = 0; t.kb = r >> 5; t.nb = r & 31; }
    return t;
}
__device__ __forceinline__ void phase_prep(const Params& P, unsigned char* lds) {
    unsigned char* ws = P.ws;
    const int tid = threadIdx.x, lane = tid & 63, wave = tid >> 6;
    const int gw = blockIdx.x * NWAVE + wave, NGW = gridDim.x * NWAVE;
    float* scr = (float*)lds + wave * (64 * 33);
    constexpr int ND = 9;
    TrDesc d[ND];
    d[0] = {P.in[22], (bf16_t*)(ws + WS_W_GU), 1024, 1024, 1024, 32, 2, 1024};
    d[1] = {P.in[23], (bf16_t*)(ws + WS_W_DN), 512, 1024, 1024, 32, 0, 512};
    d[2] = {P.in[2], (bf16_t*)(ws + WS_W_IN0), 1024, 2560, 2560, 1, 1, 1024};
    d[3] = {P.in[6], (bf16_t*)(ws + WS_W_OUT0), 1024, 1024, 1024, 1, 0, 1024};
    d[4] = {P.in[13], (bf16_t*)(ws + WS_W_COUT), 1024, 1024, 1024, 1, 0, 1024};
    d[5] = {P.in[24], (bf16_t*)(ws + WS_W_G), 1024, 1024, 1024, 2, 0, 1024};
    d[6] = {P.in[25], (bf16_t*)(ws + WS_W_P), 256, 1024, 1024, 2, 0, 256};
    d[7] = {P.in[7], (bf16_t*)(ws + WS_W_CIN), 1024, Z1W, CIN, 1, 0, 1024};
    d[8] = {P.in[12], (bf16_t*)(ws + WS_W_UVBD), 256, 1024, 1024, 1, 3, 1024};
    int total = 0;
#pragma unroll
    for (int i = 0; i < ND; ++i) total += tr_items(d[i]);
#define TR_DECODE(it, T) do { int _r = (it); bool _f = false; T = TrItem{nullptr, nullptr, 0, 0, 0, 0, 0}; _Pragma("unroll") for (int _i = 0; _i < ND; ++_i) { const int _n = tr_items(d[_i]); \
            if (!_f && _r < _n) { _f = true; const int _per = (d[_i].K / 64) * (d[_i].N / 32), _b = _r / _per, _q = _r % _per, _nblk = d[_i].N / 32; \
                T.src = d[_i].src + (size_t)_b * d[_i].K * d[_i].Nsrc; T.dst = d[_i].dst + (size_t)_b * d[_i].N * d[_i].dst_ld; T.Nsrc = d[_i].Nsrc; T.dst_ld = d[_i].dst_ld; T.mode = d[_i].mode; T.kb = _q / _nblk; T.nb = _q % _nblk; } \
            if (!_f) _r -= _n; } } while (0)
    {
        float cur[32], nxt[32];
        TrItem tc, tn;
        int it = gw;
        if (it < total) { TR_DECODE(it, tc); tr_load(tc, lane, cur); }
        while (it < total) {
            const int itn = it + NGW;
            if (itn < total) { TR_DECODE(itn, tn); tr_load(tn, lane, nxt); }
            tr_store(tc, scr, lane, cur);
#pragma unroll
            for (int i = 0; i < 32; ++i) cur[i] = nxt[i];
            it = itn; tc = tn;
        }
    }
#undef TR_DECODE
    const size_t gt = (size_t)blockIdx.x * NT + tid, GS = (size_t)gridDim.x * NT;
    {
        bf16_t* o = (bf16_t*)(ws + WS_W_POOL); const float* pw = P.in[4];
        for (size_t i = gt; i < 512 * 256; i += GS) { const int n = (int)(i >> 8), k = (int)(i & 255), g = n >> 7, dd = n & 127, kg = k >> 7, c = k & 127;
            o[i] = (bf16_t)((kg == (g & 1)) ? f2bf(pw[((size_t)g * 128 + c) * 128 + dd]) : 0u); }
    }
    {
        u32x4* o = (u32x4*)(ws + WS_W_UVBD);
        for (size_t i = gt; i < (size_t)1024 * 1024 / 8; i += GS) { const int n = (int)(i >> 7), k = (int)(i & 127) * 8; if (((n >> 6) & 3) != (k >> 8)) o[i] = (u32x4){0u, 0u, 0u, 0u}; }
    }
    {
        bf16_t* o = (bf16_t*)(ws + WS_W_QA); const float* uq = P.in[10]; const float* uk = P.in[11];
        float* Bq = (float*)lds; float* Ak = Bq + 256 * 65;
        for (int item = blockIdx.x; item < 256; item += gridDim.x) {
            const int h = item >> 4, c0 = (item & 15) * 16;
            __syncthreads();
            {   f32x4 v[8];
#pragma unroll
                for (int q = 0; q < 8; ++q) { const int i = tid + NT * q, r = i >> 4, d4 = (i & 15) * 4; v[q] = *(const f32x4*)(uq + (size_t)r * 1024 + h * 64 + d4); }
                f32x4 vk = {0.f, 0.f, 0.f, 0.f};
                if (tid < 256) { const int c = tid >> 4, d4 = (tid & 15) * 4; vk = *(const f32x4*)(uk + (size_t)(c0 + c) * 1024 + h * 64 + d4); }
#pragma unroll
                for (int q = 0; q < 8; ++q) { const int i = tid + NT * q, r = i >> 4, d4 = (i & 15) * 4; float* qd = Bq + r * 65 + d4; qd[0] = v[q].x; qd[1] = v[q].y; qd[2] = v[q].z; qd[3] = v[q].w; }
                if (tid < 256) { const int c = tid >> 4, d4 = (tid & 15) * 4; float* qd = Ak + c * 65 + d4; qd[0] = vk.x; qd[1] = vk.y; qd[2] = vk.z; qd[3] = vk.w; }
            }
            __syncthreads();
            const int r = tid & 255, cg = tid >> 8;
            float acc[8];
#pragma unroll
            for (int j = 0; j < 8; ++j) acc[j] = 0.f;
#pragma unroll 8
            for (int dd = 0; dd < 64; ++dd) { const float bv = Bq[r * 65 + dd];
#pragma unroll
                for (int j = 0; j < 8; ++j) acc[j] += Ak[(cg * 8 + j) * 65 + dd] * bv; }
#pragma unroll
            for (int j = 0; j < 8; ++j) o[(size_t)(h * 256 + c0 + cg * 8 + j) * 256 + r] = (bf16_t)f2bf(acc[j] * 0.125f);
        }
        __syncthreads();
    }
    {
        bf16_t* GT = (bf16_t*)(ws + WS_GT); float* SGB = (float*)(ws + WS_SGB);
        for (size_t i = gt; i < (size_t)2 * 48 * 1024; i += GS) {
            const int l = (int)(i / (48 * 1024)), j = (int)((i / 1024) % 48), c = (int)(i & 1023);
            float w = 0.f;
            if (j < 4) w = P.in[18][(size_t)l * DM * 4 + (size_t)c * 4 + j]; else if (j < 36) w = P.in[20][(size_t)l * DM * 32 + (size_t)c * 32 + (j - 4)];
            const float g = P.in[14][l * DM + c] * w;
            const unsigned hi = f2bf(g); const unsigned lo = f2bf(g - bf2f(hi));
            GT[((size_t)(l * 2 + 0) * 48 + j) * 1024 + c] = (bf16_t)hi; GT[((size_t)(l * 2 + 1) * 48 + j) * 1024 + c] = (bf16_t)lo;
        }
        for (int it = NGW - 1 - gw; it < 96; it += NGW) {
            const int l = it / 48, j = it % 48; float sg = 0.f, sb = 0.f;
#pragma unroll
            for (int c = lane; c < 1024; c += 64) {
                float w = 0.f;
                if (j < 4) w = P.in[18][(size_t)l * DM * 4 + (size_t)c * 4 + j]; else if (j < 36) w = P.in[20][(size_t)l * DM * 32 + (size_t)c * 32 + (j - 4)];
                sg += P.in[14][l * DM + c] * w; sb += P.in[15][l * DM + c] * w;
            }
            sg = wave_sum(sg); sb = wave_sum(sb);
            const float bias = (j < 4) ? P.in[19][l * 4 + j] : ((j < 36) ? P.in[21][l * 32 + (j - 4)] : 0.f);
            if (lane == 0) { SGB[(l * 2 + 0) * 48 + j] = sg; SGB[(l * 2 + 1) * 48 + j] = sb + bias; }
        }
    }
    {
        const f32x4* x = (const f32x4*)P.in[0]; u32x4* xb = (u32x4*)(ws + WS_XB);
        const size_t nx = (size_t)NTOK * DM / 8, np = (size_t)2 * NTOK * 256 / 8;
        size_t i = gt;
        for (; i + 3 * GS < nx; i += 4 * GS) { f32x4 a[8];
#pragma unroll
            for (int q = 0; q < 4; ++q) { a[2 * q] = __builtin_nontemporal_load(x + 2 * (i + q * GS)); a[2 * q + 1] = __builtin_nontemporal_load(x + 2 * (i + q * GS) + 1); }
#pragma unroll
            for (int q = 0; q < 4; ++q) xb[i + q * GS] = pack8(a[2 * q], a[2 * q + 1]); }
        for (; i < nx; i += GS) xb[i] = pack8(x[2 * i], x[2 * i + 1]);
        const f32x4* p = (const f32x4*)P.in[1]; u32x4* pb = (u32x4*)(ws + WS_PB);
        i = gt;
        for (; i + 3 * GS < np; i += 4 * GS) { f32x4 a[8];
#pragma unroll
            for (int q = 0; q < 4; ++q) { a[2 * q] = __builtin_nontemporal_load(p + 2 * (i + q * GS)); a[2 * q + 1] = __builtin_nontemporal_load(p + 2 * (i + q * GS) + 1); }
#pragma unroll
            for (int q = 0; q < 4; ++q) pb[i + q * GS] = pack8(a[2 * q], a[2 * q + 1]); }
        for (; i < np; i += GS) pb[i] = pack8(p[2 * i], p[2 * i + 1]);
    }
}


template <bool DRY>
__device__ __forceinline__ void phase_ln_route(const Params& P, unsigned char* lds, int layer) {
    using pg8::bf16x8;
    const bf16_t* F = (const bf16_t*)(P.ws + WS_F); bf16_t* XB = (bf16_t*)(P.ws + (DRY ? WS_M0 + 128 * MiB : WS_XB));
    float* TOKG = (float*)(P.ws + WS_TOKG); int* LIST = (int*)(P.ws + WS_LIST);
    int* CNT = (int*)(P.ws + WS_CTL + CTL_CNT_OFF) + layer * 32 * CNT_STRIDE;
    const float* lg = P.in[14] + layer * DM; const float* lb = P.in[15] + layer * DM;
    const bf16_t* GTh = (const bf16_t*)(P.ws + WS_GT) + (size_t)(layer * 2) * 48 * 1024; const bf16_t* GTl = GTh + 48 * 1024;
    const float* SG = (const float*)(P.ws + WS_SGB) + (layer * 2) * 48; const float* BB = SG + 48;
    const int tid = threadIdx.x, lane = tid & 63, wave = tid >> 6, r16 = lane & 15, g = lane >> 4;
    int* dec = (int*)lds;
    int* rank = dec + 256;
    int* lcnt = rank + 256;
    int* lbase = lcnt + 32;
    float* SS = (float*)(lds + 4096);
    float* stat = SS + wave * 32;
    float* LGs = (float*)(lds + 8192);
    float* LG = LGs + wave * (16 * 52);
    float* PP_ = (float*)(lds + 36864);
    float* PS = (float*)(lds + 36864 + 8 * 64 * 52 * 4);
    for (int rb = blockIdx.x; rb < NTOK / 128; rb += gridDim.x) {
        if (tid < 32) lcnt[tid] = 0;
        __syncthreads();
        const int tbase = rb * 128 + wave * 16;
        {
            bf16x8 GH[12], GL[12];
            {   int r16l = r16; asm volatile("" : "+v"(r16l));
                const bf16_t* hp = GTh + (size_t)r16l * 1024 + 128 * wave + 8 * g; const bf16_t* lp = GTl + (size_t)r16l * 1024 + 128 * wave + 8 * g;
#pragma unroll
                for (int ks = 0; ks < 4; ++ks)
#pragma unroll
                    for (int i = 0; i < 3; ++i) { GH[ks * 3 + i] = *(const bf16x8*)(hp + (size_t)i * 16 * 1024 + 32 * ks); GL[ks * 3 + i] = *(const bf16x8*)(lp + (size_t)i * 16 * 1024 + 32 * ks); } }
            const bf16_t* yp = F + (size_t)(rb * 128 + r16) * DM + 128 * wave + 8 * g;
#pragma unroll 1
            for (int half = 0; half < ((DRY && PROBE_LN == 1) ? 0 : 2); ++half) {
#pragma unroll 1
              for (int rp = 0; rp < 2; ++rp) {
                u32x4 YW[8];
#pragma unroll
                for (int rt2 = 0; rt2 < 2; ++rt2) {
#pragma unroll
                    for (int ks = 0; ks < 4; ++ks) YW[rt2 * 4 + ks] = *(const u32x4*)(yp + 32 * ks);
                    yp += 16 * DM; asm volatile("" : "+v"(yp)); }
                __builtin_amdgcn_sched_barrier(0);
#pragma unroll
                for (int rt2 = 0; rt2 < 2; ++rt2) {
                    const int rt4 = rp * 2 + rt2;
                    f32x4 acc[3];
#pragma unroll
                    for (int i = 0; i < 3; ++i) acc[i] = (f32x4){0.f, 0.f, 0.f, 0.f};
                    float sm = 0.f, sq = 0.f;
#pragma unroll
                    for (int ks = 0; ks < 4; ++ks) {
                        const u32x4 yw = YW[rt2 * 4 + ks];
                        const float y0 = bflo(yw.x), y1 = bfhi(yw.x), y2 = bflo(yw.y), y3 = bfhi(yw.y), y4 = bflo(yw.z), y5 = bfhi(yw.z), y6 = bflo(yw.w), y7 = bfhi(yw.w);
                        sm += (y0 + y1) + (y2 + y3) + (y4 + y5) + (y6 + y7);
                        sq += (y0 * y0 + y1 * y1) + (y2 * y2 + y3 * y3) + (y4 * y4 + y5 * y5) + (y6 * y6 + y7 * y7);
                        const bf16x8 yh = __builtin_bit_cast(bf16x8, yw);
#pragma unroll
                        for (int i = 0; i < 3; ++i) {
                            acc[i] = __builtin_amdgcn_mfma_f32_16x16x32_bf16(yh, GH[ks * 3 + i], acc[i], 0, 0, 0);
                            acc[i] = __builtin_amdgcn_mfma_f32_16x16x32_bf16(yh, GL[ks * 3 + i], acc[i], 0, 0, 0);
                        }
                    }
                    sm += __shfl_xor(sm, 16); sm += __shfl_xor(sm, 32); sq += __shfl_xor(sq, 16); sq += __shfl_xor(sq, 32);
                    if (g == 0) { PS[(wave * 64 + 16 * rt4 + r16) * 2] = sm; PS[(wave * 64 + 16 * rt4 + r16) * 2 + 1] = sq; }
#pragma unroll
                    for (int i = 0; i < 3; ++i)
#pragma unroll
                        for (int r = 0; r < 4; ++r) PP_[(wave * 64 + 16 * rt4 + 4 * g + r) * 52 + 16 * i + r16] = acc[i][r];
                }
                __builtin_amdgcn_sched_barrier(0);
              }
                __syncthreads();
#pragma unroll
                for (int q = 0; q < 6; ++q) { const int idx = tid + NT * q, row = idx / 48, col = idx - row * 48;
                    float a = 0.f;
#pragma unroll
                    for (int w = 0; w < 8; ++w) a += PP_[(w * 64 + row) * 52 + col];
                    LGs[(half * 64 + row) * 52 + col] = a; }
                if (tid < 128) { float a = 0.f;
#pragma unroll
                    for (int w = 0; w < 8; ++w) a += PS[w * 128 + tid];
                    SS[half * 128 + tid] = a; }
                __syncthreads();
            }
        }
        {
            int tid_l = tid; asm volatile("" : "+v"(tid_l));
            const int t = tid_l >> 2, c0 = (tid_l & 3) * 12;
            const float s1 = SS[t * 2], s2 = SS[t * 2 + 1];
            const float mean = s1 * (1.0f / DM), var = fmaxf(s2 * (1.0f / DM) - mean * mean, 0.f), rstd = 1.0f / sqrtf(var + LN_EPS);
#pragma unroll
            for (int c = 0; c < 12; ++c) LGs[t * 52 + c0 + c] = rstd * (LGs[t * 52 + c0 + c] - mean * SG[c0 + c]) + BB[c0 + c];
            __syncthreads();
            if ((tid_l & 3) == 0) { SS[t * 2] = mean; SS[t * 2 + 1] = rstd; }
        }
        __syncthreads();
        if (lane < 16) {
            const float* lr = LG + lane * 52; const int rl = wave * 16 + lane, t = tbase + lane;
            float gl4[4];
#pragma unroll
            for (int j = 0; j < 4; ++j) gl4[j] = lr[j];
            int grp = 0; float gm = gl4[0];
#pragma unroll
            for (int j = 1; j < 4; ++j) if (gl4[j] > gm) { gm = gl4[j]; grp = j; }
            float gs = 0.f;
#pragma unroll
            for (int j = 0; j < 4; ++j) gs += __expf(gl4[j] - gm);
            const float gwt = 1.0f / gs;
            float el[8];
#pragma unroll
            for (int j = 0; j < 8; ++j) el[j] = lr[4 + grp * 8 + j];
            int i0 = 0; float m0 = el[0];
#pragma unroll
            for (int j = 1; j < 8; ++j) if (el[j] > m0) { m0 = el[j]; i0 = j; }
            int i1 = -1; float m1 = -INFINITY;
#pragma unroll
            for (int j = 0; j < 8; ++j) if (j != i0 && el[j] > m1) { m1 = el[j]; i1 = j; }
            const float ex = __expf(m1 - m0);
            const float p0 = 1.0f / (1.0f + ex), p1 = ex / (1.0f + ex);
            dec[rl * 2] = grp * 8 + i0; dec[rl * 2 + 1] = grp * 8 + i1;
            if (!DRY) { TOKG[(size_t)t * 2] = gwt * p0; TOKG[(size_t)t * 2 + 1] = gwt * p1; }
        }
        int lane_l = lane; asm volatile("" : "+v"(lane_l));
        f32x4 g4[4], b4[4];
#pragma unroll
        for (int j = 0; j < 2; ++j) { g4[2 * j] = *(const f32x4*)(lg + 512 * j + 8 * lane_l); g4[2 * j + 1] = *(const f32x4*)(lg + 512 * j + 8 * lane_l + 4);
                                      b4[2 * j] = *(const f32x4*)(lb + 512 * j + 8 * lane_l); b4[2 * j + 1] = *(const f32x4*)(lb + 512 * j + 8 * lane_l + 4); }
#pragma unroll 1
        for (int rg = 0; rg < ((DRY && PROBE_LN == 2) ? 0 : 2); ++rg) {
            const bf16_t* fr = F + (size_t)(tbase + 8 * rg) * DM + 8 * lane_l; bf16_t* xo = XB + (size_t)(tbase + 8 * rg) * DM + 8 * lane_l;
            u32x4 yv[16];
#pragma unroll
            for (int r8 = 0; r8 < 8; ++r8) {
#pragma unroll
                for (int j = 0; j < 2; ++j) yv[2 * r8 + j] = *(const u32x4*)(fr + 512 * j);
                fr += DM; asm volatile("" : "+v"(fr)); }
            __builtin_amdgcn_sched_barrier(0);
#pragma unroll
            for (int r8 = 0; r8 < 8; ++r8) { const int r = 8 * rg + r8;
                const float mu = stat[r * 2], rs = stat[r * 2 + 1];
#pragma unroll
                for (int j = 0; j < 2; ++j) {
                    const u32x4 yw = yv[2 * r8 + j];
                    const f32x4 ya = {bflo(yw.x), bfhi(yw.x), bflo(yw.y), bfhi(yw.y)}, yb = {bflo(yw.z), bfhi(yw.z), bflo(yw.w), bfhi(yw.w)};
                    const f32x4 va = (ya - mu) * rs * g4[2 * j] + b4[2 * j], vb = (yb - mu) * rs * g4[2 * j + 1] + b4[2 * j + 1];
                    u32x4 w; w.x = pk2(va.x, va.y); w.y = pk2(va.z, va.w); w.z = pk2(vb.x, vb.y); w.w = pk2(vb.z, vb.w); *(u32x4*)(xo + 512 * j) = w; }
                xo += DM; asm volatile("" : "+v"(xo)); }
        }
        __syncthreads();
        if (tid < 256) rank[tid] = atomicAdd(&lcnt[dec[tid]], 1);
        __syncthreads();
        if (tid < 32) { int te = tid; asm volatile("" : "+v"(te)); lbase[tid] = DRY ? 0 : atomicAdd(&CNT[te * CNT_STRIDE], lcnt[tid]); }
        __syncthreads();
        if (!DRY && tid < 256) { const int e = dec[tid]; LIST[(size_t)e * LIST_CAP + lbase[e] + rank[tid]] = (rb * 128 + (tid >> 1)) * 2 + (tid & 1); }
        __syncthreads();
    }
}
__device__ __forceinline__ void moe_setup(const Params& P, int* tb, int layer) {
    const int* CNT = (const int*)(P.ws + WS_CTL + CTL_CNT_OFF) + layer * 32 * CNT_STRIDE;
    if (threadIdx.x < 64) {
        const int e = (int)threadIdx.x;
        const int ce = (e < 32) ? CNT[e * CNT_STRIDE] : 0;
        const unsigned tiles = (unsigned)((ce + 255) >> 8);
        const unsigned inc = WAVE_SCAN_DPP(tiles);
        if (e < 32) { tb[e] = (int)(inc - tiles); tb[64 + e] = ce; }
        if (e == 31) tb[32] = (int)inc;
    }
    __syncthreads();
}
template <bool DRY>
__device__ __forceinline__ void phase_ln2(const Params& P, int layer) {
    const bf16_t* XI = (const bf16_t*)(P.ws + WS_XB); bf16_t* XO = (bf16_t*)(P.ws + (DRY ? WS_XB2 : WS_XB));
    const bf16_t* YS = (const bf16_t*)(P.ws + WS_YS); const float* TOKG = (const float*)(P.ws + WS_TOKG);
    const float* lg = P.in[16] + layer * DM; const float* lb = P.in[17] + layer * DM;
    const int lane = threadIdx.x & 63, gw = blockIdx.x * NWAVE + (threadIdx.x >> 6), NGW = gridDim.x * NWAVE;
    f32x4 g4[4], b4[4];
#pragma unroll
    for (int j = 0; j < 4; ++j) { g4[j] = *(const f32x4*)(lg + 256 * j + 4 * lane); b4[j] = *(const f32x4*)(lb + 256 * j + 4 * lane); }
    u32x2 nx[4], na[4], nb[4]; float ng0 = 0.f, ng1 = 0.f;
    if (gw < NTOK) { const int t = gw;
#pragma unroll
        for (int j = 0; j < 4; ++j) { const int c0 = 256 * j + 4 * lane; nx[j] = *(const u32x2*)(XI + (size_t)t * DM + c0); na[j] = *(const u32x2*)(YS + (size_t)(2 * t) * DM + c0); nb[j] = *(const u32x2*)(YS + (size_t)(2 * t + 1) * DM + c0); }
        ng0 = TOKG[(size_t)t * 2]; ng1 = TOKG[(size_t)t * 2 + 1]; }
    for (int t = gw; t < NTOK; t += NGW) {
        const float g0 = ng0, g1 = ng1;
        u32x2 xw[4], aw[4], bw[4];
#pragma unroll
        for (int j = 0; j < 4; ++j) { xw[j] = nx[j]; aw[j] = na[j]; bw[j] = nb[j]; }
        if (t + NGW < NTOK) { const int tn = t + NGW;
#pragma unroll
            for (int j = 0; j < 4; ++j) { const int c0 = 256 * j + 4 * lane; nx[j] = *(const u32x2*)(XI + (size_t)tn * DM + c0); na[j] = *(const u32x2*)(YS + (size_t)(2 * tn) * DM + c0); nb[j] = *(const u32x2*)(YS + (size_t)(2 * tn + 1) * DM + c0); }
            ng0 = TOKG[(size_t)tn * 2]; ng1 = TOKG[(size_t)tn * 2 + 1]; }
        f32x4 v[4]; float s = 0.f;
#pragma unroll
        for (int j = 0; j < 4; ++j) {
            const u32x2 x = xw[j], a = aw[j], b = bw[j];
            v[j].x = bflo(x.x) * ALPHA + g0 * bflo(a.x) + g1 * bflo(b.x); v[j].y = bfhi(x.x) * ALPHA + g0 * bfhi(a.x) + g1 * bfhi(b.x);
            v[j].z = bflo(x.y) * ALPHA + g0 * bflo(a.y) + g1 * bflo(b.y); v[j].w = bfhi(x.y) * ALPHA + g0 * bfhi(a.y) + g1 * bfhi(b.y);
            s += (v[j].x + v[j].y) + (v[j].z + v[j].w); }
        const float mean = wave_sum(s) * (1.0f / DM); float s2 = 0.f;
#pragma unroll
        for (int j = 0; j < 4; ++j) { v[j] = v[j] - mean; s2 += (v[j].x * v[j].x + v[j].y * v[j].y) + (v[j].z * v[j].z + v[j].w * v[j].w); }
        const float rstd = 1.0f / sqrtf(wave_sum(s2) * (1.0f / DM) + LN_EPS);
#pragma unroll
        for (int j = 0; j < 4; ++j) { const int c0 = 256 * j + 4 * lane;
            v[j] = v[j] * rstd * g4[j] + b4[j];
            u32x2 w; w.x = pk2(v[j].x, v[j].y); w.y = pk2(v[j].z, v[j].w); *(u32x2*)(XO + (size_t)t * DM + c0) = w; }
    }
}

__device__ __forceinline__ unsigned e5m2enc(float y) {
    const unsigned hb = (unsigned)__builtin_bit_cast(unsigned short, (_Float16)y);
    return ((hb + 0x7fu + ((hb >> 8) & 1u)) >> 8) & 0xffu;
}
__device__ __forceinline__ void phase_norms(const Params& P) {
    const bf16_t* Z1 = (const bf16_t*)(P.ws + WS_Z1); bf16_t* CQ = (bf16_t*)(P.ws + WS_CQ); unsigned char* CKV8 = (unsigned char*)(P.ws + WS_CKV8);
    const float* qn = P.in[8]; const float* kn = P.in[9];
    const int lane = threadIdx.x & 63, gw = blockIdx.x * NWAVE + (threadIdx.x >> 6), NGW = gridDim.x * NWAVE;
    const f32x4 gq = *(const f32x4*)(qn + 4 * lane), gk = *(const f32x4*)(kn + 4 * lane);
    for (int t0 = gw; t0 < NTOK; t0 += 2 * NGW) {
        const int t1 = (t0 + NGW < NTOK) ? t0 + NGW : t0;
        const u32x2 a0 = *(const u32x2*)(Z1 + (size_t)t0 * Z1W + 4 * lane), b0 = *(const u32x2*)(Z1 + (size_t)t0 * Z1W + 256 + 4 * lane);
        const u32x2 a1 = *(const u32x2*)(Z1 + (size_t)t1 * Z1W + 4 * lane), b1 = *(const u32x2*)(Z1 + (size_t)t1 * Z1W + 256 + 4 * lane);
#pragma unroll
        for (int s = 0; s < 2; ++s) {
            const int t = s ? t1 : t0; const u32x2 a = s ? a1 : a0, b = s ? b1 : b0;
            const float q[4] = {bflo(a.x), bfhi(a.x), bflo(a.y), bfhi(a.y)}, k[4] = {bflo(b.x), bfhi(b.x), bflo(b.y), bfhi(b.y)};
            const float sq = wave_sum(q[0] * q[0] + q[1] * q[1] + q[2] * q[2] + q[3] * q[3]), sk = wave_sum(k[0] * k[0] + k[1] * k[1] + k[2] * k[2] + k[3] * k[3]);
            const float rq = 1.0f / sqrtf(sq * (1.0f / 256.0f) + 1e-6f), rk = 1.0f / sqrtf(sk * (1.0f / 256.0f) + 1e-6f);
            u32x2 o; o.x = pk2(q[0] * rq * gq.x, q[1] * rq * gq.y); o.y = pk2(q[2] * rq * gq.z, q[3] * rq * gq.w);
            *(u32x2*)(CQ + (size_t)t * 256 + 4 * lane) = o;
            *(unsigned*)(CKV8 + (size_t)t * 256 + 4 * lane) = e5m2enc(k[0] * rk * gk.x) | (e5m2enc(k[1] * rk * gk.y) << 8) | (e5m2enc(k[2] * rk * gk.z) << 16) | (e5m2enc(k[3] * rk * gk.w) << 24);
        }
    }
}


constexpr int NPH_TOTAL = 23;


typedef short v4i16_t __attribute__((ext_vector_type(4)));


__device__ __forceinline__ void glds16(const void* gsrc, unsigned lds_dst) {
    unsigned keep;
    asm volatile("s_mov_b32 %0, m0\n\ts_mov_b32 m0, %2\n\ts_nop 0\n\tglobal_load_lds_dwordx4 %1, off\n\ts_mov_b32 m0, %0" : "=&s"(keep) : "v"(gsrc), "s"(lds_dst) : "memory");
}
__device__ __forceinline__ void glds16_set(const void* gsrc, unsigned lds_dst) {
    asm volatile("s_mov_b32 m0, %1\n\ts_nop 0\n\tglobal_load_lds_dwordx4 %0, off" : : "v"(gsrc), "s"(lds_dst) : "memory", "m0");
}
template <int OFF> __device__ __forceinline__ void glds16_m0(const void* gsrc) {
    asm volatile("global_load_lds_dwordx4 %0, off offset:%1" : : "v"(gsrc), "n"(OFF) : "memory");
}
__device__ __forceinline__ void glds16s_set(const void* sbase, unsigned voff, unsigned lds_dst) {
    asm volatile("s_mov_b32 m0, %2\n\ts_nop 0\n\tglobal_load_lds_dwordx4 %0, %1" : : "v"(voff), "s"(sbase), "s"(lds_dst) : "memory", "m0");
}
template <int OFF> __device__ __forceinline__ void glds16s_m0(const void* sbase, unsigned voff) {
    asm volatile("global_load_lds_dwordx4 %0, %1 offset:%2" : : "v"(voff), "s"(sbase), "n"(OFF) : "memory");
}
typedef _Float16 f16x8 __attribute__((ext_vector_type(8)));
typedef int v8i_t __attribute__((ext_vector_type(8)));
template <bool DRY>
__device__ __forceinline__ void phase_sparse_attn_e(const Params& P, unsigned char* lds_) {
    const unsigned char* QA = (const unsigned char*)(P.ws + WS_QA); bf16_t* OLAT = (bf16_t*)(P.ws + WS_OLAT); const unsigned char* CKV8 = (const unsigned char*)(P.ws + WS_CKV8); const unsigned short* SEL = (const unsigned short*)(P.ws + WS_SEL);
    const int tid = threadIdx.x, lane = tid & 63, wave = __builtin_amdgcn_readfirstlane(tid >> 6);
    const int fr = lane & 15, fq = lane >> 4;
    LAS unsigned char* cbuf = (LAS unsigned char*)lds_ + wave * 17920;
    LAS unsigned short* selw = (LAS unsigned short*)(cbuf + 16384);
    LAS unsigned* selo = (LAS unsigned*)(cbuf + 16384 + 512);
    LAS unsigned* selo_st = selo + (lane >> 3) * 32 + (lane & 7);
    const unsigned cbuf0 = (unsigned)(unsigned long)cbuf;
    const int G = gridDim.x, NGW = G * NWAVE;
    int vw;
    if ((G & 7) == 0) vw = (((int)blockIdx.x & 7) * (G >> 3) + ((int)blockIdx.x >> 3)) * NWAVE + wave; else vw = (int)blockIdx.x * NWAVE + wave;
    const float LOG2E = 1.4426950408889634f;
    const float slope2 = exp2f(-0.5f * (float)(fr + 1)) * LOG2E;
    unsigned qoffB[4];
#pragma unroll
    for (int e = 0; e < 4; ++e) { const int r15 = (4 * e + fq) & 15; qoffB[e] = (unsigned)((fr ^ (((r15 & 7) << 1) | (r15 >> 3))) << 4); }
    unsigned qoffS[4];
#pragma unroll
    for (int e = 0; e < 4; ++e) qoffS[e] = qoffB[e] + 3072u - 1024u * e;
    const unsigned fA = (unsigned)(((fr & 7) << 1) | (fr >> 3));
    const unsigned SA = (fA & 14u) << 4, baseA = (unsigned)fr * 256u + ((((unsigned)fq >> 1) ^ (fA & 1u)) << 4) + ((unsigned)fq & 1u) * 8u;
    const int rT = 4 * fq + (fr >> 2), pT_ = fr & 3;
    const unsigned fT = (unsigned)(((rT & 7) << 1) | (rT >> 3));
    const unsigned ST = (fT & 14u) << 4, baseT = (unsigned)rT * 256u + ((((unsigned)pT_ >> 1) ^ (fT & 1u)) << 4) + ((unsigned)pT_ & 1u) * 8u;
    const int per = NGW >> 2, bq = vw / per, wb = vw % per;
    int ditem = DRY ? N_DEFERRED : vw;
    u32x2 selnext = {0u, 0u}; long qfn[8];
    if (wb < SEQ) { const int t0 = bq * SEQ + wb; selnext = *(const u32x2*)(SEL + (size_t)t0 * TOPK + 4 * lane);
#pragma unroll
        for (int cc = 0; cc < 8; ++cc) qfn[cc] = *(const long*)(QA + (size_t)t0 * 4096 + fr * 256 + 32 * cc + 8 * fq); }
    for (int tl0 = wb; tl0 < SEQ; tl0 += per) {
        const int t = bq * SEQ + tl0;
        const int b = t >> 13, tl = t & (SEQ - 1), ns = min(tl + 1, TOPK), nch = (ns + 31) >> 5;
        const bool has_nextq = (tl0 + per < SEQ);
        asm volatile("s_waitcnt vmcnt(0)" ::: "memory");
        {
            const u32x2 w = selnext;
            unsigned short i0 = (unsigned short)(w.x & 0xffffu), i1 = (unsigned short)(w.x >> 16), i2 = (unsigned short)(w.y & 0xffffu), i3 = (unsigned short)(w.y >> 16);
            const int k0 = 4 * lane;
            if (k0 >= ns) i0 = 0; if (k0 + 1 >= ns) i1 = 0; if (k0 + 2 >= ns) i2 = 0; if (k0 + 3 >= ns) i3 = 0;
            u32x2 o; o.x = (unsigned)i0 | ((unsigned)i1 << 16); o.y = (unsigned)i2 | ((unsigned)i3 << 16);
            asm volatile("s_waitcnt lgkmcnt(0)" ::: "memory");
            *(LAS u32x2*)(selw + 4 * lane) = o;
            selo_st[0] = (unsigned)i0 << 8; selo_st[8] = (unsigned)i1 << 8; selo_st[16] = (unsigned)i2 << 8; selo_st[24] = (unsigned)i3 << 8;
        }
        v8i_t qB[2];
#pragma unroll
        for (int cc = 0; cc < 8; ++cc) { const u32x2 qw = __builtin_bit_cast(u32x2, qfn[cc]); qB[cc >> 2][2 * (cc & 3)] = (int)qw.x; qB[cc >> 2][2 * (cc & 3) + 1] = (int)qw.y; }
#define ATT_PREFETCH() do { if (has_nextq) { const int tn_ = t + per; selnext = *(const u32x2*)(SEL + (size_t)tn_ * TOPK + 4 * lane); \
            _Pragma("unroll") for (int cc = 0; cc < 8; ++cc) qfn[cc] = *(const long*)(QA + (size_t)tn_ * 4096 + fr * 256 + 32 * cc + 8 * fq); pf = true; } } while (0)
        f32x4 Oe[8], Oo[8];
#pragma unroll
        for (int ut = 0; ut < 8; ++ut) { Oe[ut] = (f32x4){0.f, 0.f, 0.f, 0.f}; Oo[ut] = (f32x4){0.f, 0.f, 0.f, 0.f}; }
        float m = -INFINITY, l = 0.f;
        const unsigned char* cb = CKV8 + (size_t)b * SEQ * 256;
        asm volatile("s_waitcnt vmcnt(0) lgkmcnt(0)" ::: "memory");
        const unsigned char* cbs = cb - 3072;
#define ATT_DMA(jj, bufoff) do { u32x4 oa_ = *(const LAS u32x4*)(selo + 32 * (jj) + 8 * fq), ob_ = *(const LAS u32x4*)(selo + 32 * (jj) + 8 * fq + 4); \
            if (DRY && PROBE_ATT == 1) { oa_ = (u32x4){0u, 256u, 512u, 768u}; ob_ = oa_; } \
            if (!(DRY && PROBE_ATT == 3)) { \
                glds16s_set(cbs, oa_.x + qoffS[0], (unsigned)__builtin_amdgcn_readfirstlane((int)(cbuf0 + (bufoff)))); \
                glds16s_m0<1024>(cbs, oa_.y + qoffS[1]); glds16s_m0<2048>(cbs, oa_.z + qoffS[2]); glds16s_m0<3072>(cbs, oa_.w + qoffS[3]); \
                glds16s_set(cbs, ob_.x + qoffS[0], (unsigned)__builtin_amdgcn_readfirstlane((int)(cbuf0 + (bufoff) + 4096))); \
                glds16s_m0<1024>(cbs, ob_.y + qoffS[1]); glds16s_m0<2048>(cbs, ob_.z + qoffS[2]); glds16s_m0<3072>(cbs, ob_.w + qoffS[3]); } } while (0)
        ATT_DMA(0, 0);
        if (nch > 1) ATT_DMA(1, 8192);
        const bool have_item = ditem < N_DEFERRED;
        TrItem titem = deferred_item(P, have_item ? ditem : 0);
        float tcur[32];
        bool trf = false, pf = false;
        if (nch <= 2) { if (have_item) { tr_load(titem, lane, tcur); trf = true; } ATT_PREFETCH(); }
        for (int j = 0; j < nch; ++j) {
            const unsigned bo = (unsigned)(j & 1) * 8192u;
            if (j + 1 < nch) { if (trf && pf) asm volatile("s_waitcnt vmcnt(49)" ::: "memory"); else if (trf) asm volatile("s_waitcnt vmcnt(40)" ::: "memory");
                               else if (pf) asm volatile("s_waitcnt vmcnt(17)" ::: "memory"); else asm volatile("s_waitcnt vmcnt(8)" ::: "memory"); }
            else { if (trf && pf) asm volatile("s_waitcnt vmcnt(41)" ::: "memory"); else if (trf) asm volatile("s_waitcnt vmcnt(32)" ::: "memory");
                   else if (pf) asm volatile("s_waitcnt vmcnt(9)" ::: "memory"); else asm volatile("s_waitcnt vmcnt(0)" ::: "memory"); }
            const LAS unsigned char* img = cbuf + bo;
            if (DRY && PROBE_ATT == 2) { if (j + 2 < nch) { asm volatile("s_waitcnt lgkmcnt(0)" ::: "memory"); ATT_DMA(j + 2, bo); } continue; }
            f32x4 s0 = {0.f, 0.f, 0.f, 0.f}, s1 = {0.f, 0.f, 0.f, 0.f};
#pragma unroll
            for (int hb = 0; hb < 2; ++hb) {
                u32x2 ra[4], rb[4];
#pragma unroll
                for (int c4 = 0; c4 < 4; ++c4) { const int cc = hb * 4 + c4; const LAS unsigned char* pa = img + ((SA ^ (unsigned)(cc << 5)) + baseA); ra[c4] = *(const LAS u32x2*)(pa); rb[c4] = *(const LAS u32x2*)(pa + 4096); }
                __builtin_amdgcn_sched_barrier(0);
                v8i_t A0, A1;
#pragma unroll
                for (int c4 = 0; c4 < 4; ++c4) { A0[2 * c4] = (int)ra[c4].x; A0[2 * c4 + 1] = (int)ra[c4].y; A1[2 * c4] = (int)rb[c4].x; A1[2 * c4 + 1] = (int)rb[c4].y; }
                s0 = __builtin_amdgcn_mfma_scale_f32_16x16x128_f8f6f4(A0, qB[hb], s0, 1, 0, 0, 0, 0, 0);
                s1 = __builtin_amdgcn_mfma_scale_f32_16x16x128_f8f6f4(A1, qB[hb], s1, 1, 0, 0, 0, 0, 0);
                __builtin_amdgcn_sched_barrier(0);
            }
            const u32x2 k0w = *(const LAS u32x2*)(selw + 32 * j + 4 * fq), k1w = *(const LAS u32x2*)(selw + 32 * j + 16 + 4 * fq);
            u32x2 tl_[4], th_[4];
#pragma unroll
            for (int ut = 0; ut < 4; ++ut) { const LAS unsigned char* pt = img + ((ST ^ (unsigned)(ut << 5)) + baseT);
                tl_[ut] = __builtin_bit_cast(u32x2, __builtin_amdgcn_ds_read_tr16_b64_v4i16((LAS v4i16_t*)(pt)));
                th_[ut] = __builtin_bit_cast(u32x2, __builtin_amdgcn_ds_read_tr16_b64_v4i16((LAS v4i16_t*)(pt + 4096))); }
            __builtin_amdgcn_sched_barrier(0);
            const int rem = ns - (32 * j + 4 * fq);
            float lg[8];
            {
                const int i00 = (int)(k0w.x & 0xffffu), i01 = (int)(k0w.x >> 16), i02 = (int)(k0w.y & 0xffffu), i03 = (int)(k0w.y >> 16);
                const int i10 = (int)(k1w.x & 0xffffu), i11 = (int)(k1w.x >> 16), i12 = (int)(k1w.y & 0xffffu), i13 = (int)(k1w.y >> 16);
                lg[0] = (0 < rem) ? s0.x * LOG2E - slope2 * (float)(tl - i00) : -INFINITY;
                lg[1] = (1 < rem) ? s0.y * LOG2E - slope2 * (float)(tl - i01) : -INFINITY;
                lg[2] = (2 < rem) ? s0.z * LOG2E - slope2 * (float)(tl - i02) : -INFINITY;
                lg[3] = (3 < rem) ? s0.w * LOG2E - slope2 * (float)(tl - i03) : -INFINITY;
                lg[4] = (16 < rem) ? s1.x * LOG2E - slope2 * (float)(tl - i10) : -INFINITY;
                lg[5] = (17 < rem) ? s1.y * LOG2E - slope2 * (float)(tl - i11) : -INFINITY;
                lg[6] = (18 < rem) ? s1.z * LOG2E - slope2 * (float)(tl - i12) : -INFINITY;
                lg[7] = (19 < rem) ? s1.w * LOG2E - slope2 * (float)(tl - i13) : -INFINITY;
            }
            const float cm = fmaxf(fmaxf(fmaxf(lg[0], lg[1]), fmaxf(lg[2], lg[3])), fmaxf(fmaxf(lg[4], lg[5]), fmaxf(lg[6], lg[7])));
            if (j == 0) { float cx = fmaxf(cm, __shfl_xor(cm, 16)); m = fmaxf(cx, __shfl_xor(cx, 32)); }
            else if (__any(cm > m + 8.0f)) {
                float cx = fmaxf(cm, __shfl_xor(cm, 16)); cx = fmaxf(cx, __shfl_xor(cx, 32));
                const float mn = fmaxf(m, cx);
                const float sc = __builtin_amdgcn_exp2f(m - mn);
                l *= sc;
#pragma unroll
                for (int ut = 0; ut < 8; ++ut) { Oe[ut] *= sc; Oo[ut] *= sc; }
                m = mn;
            }
            float p[8]; float ps = 0.f;
#pragma unroll
            for (int i = 0; i < 8; ++i) { p[i] = __builtin_amdgcn_exp2f(lg[i] - m); ps += p[i]; }
            l += ps;
            int pw0 = __builtin_amdgcn_cvt_pk_fp8_f32(p[0], p[1], 0, false); pw0 = __builtin_amdgcn_cvt_pk_fp8_f32(p[2], p[3], pw0, true);
            int pw1 = __builtin_amdgcn_cvt_pk_fp8_f32(p[4], p[5], 0, false); pw1 = __builtin_amdgcn_cvt_pk_fp8_f32(p[6], p[7], pw1, true);
            const long pk = __builtin_bit_cast(long, (u32x2){(unsigned)pw0, (unsigned)pw1});
#pragma unroll
            for (int hb = 0; hb < 2; ++hb) {
                if (hb == 1) {
#pragma unroll
                    for (int u4 = 0; u4 < 4; ++u4) { const int ut = 4 + u4; const LAS unsigned char* pt = img + ((ST ^ (unsigned)(ut << 5)) + baseT);
                        tl_[u4] = __builtin_bit_cast(u32x2, __builtin_amdgcn_ds_read_tr16_b64_v4i16((LAS v4i16_t*)(pt)));
                        th_[u4] = __builtin_bit_cast(u32x2, __builtin_amdgcn_ds_read_tr16_b64_v4i16((LAS v4i16_t*)(pt + 4096))); }
                    __builtin_amdgcn_sched_barrier(0);
                }
#pragma unroll
                for (int u4 = 0; u4 < 4; ++u4) { const int ut = hb * 4 + u4;
                    const u32x2 lw = tl_[u4], hw = th_[u4];
                    u32x2 ae, ao;
                    ae.x = __builtin_amdgcn_perm(lw.y, lw.x, 0x06040200u); ae.y = __builtin_amdgcn_perm(hw.y, hw.x, 0x06040200u);
                    ao.x = __builtin_amdgcn_perm(lw.y, lw.x, 0x07050301u); ao.y = __builtin_amdgcn_perm(hw.y, hw.x, 0x07050301u);
                    Oe[ut] = __builtin_amdgcn_mfma_f32_16x16x32_bf8_fp8(__builtin_bit_cast(long, ae), pk, Oe[ut], 0, 0, 0);
                    Oo[ut] = __builtin_amdgcn_mfma_f32_16x16x32_bf8_fp8(__builtin_bit_cast(long, ao), pk, Oo[ut], 0, 0, 0);
                }
                __builtin_amdgcn_sched_barrier(0);
            }
            if (j + 2 < nch) { asm volatile("s_waitcnt lgkmcnt(0)" ::: "memory"); ATT_DMA(j + 2, bo);
                if (j + 3 == nch) { if (have_item) { tr_load(titem, lane, tcur); trf = true; } ATT_PREFETCH(); } }
        }
#undef ATT_DMA
#undef ATT_PREFETCH
        l += __shfl_xor(l, 16); l += __shfl_xor(l, 32);
        const float inv = 1.0f / l;
        bf16_t* orow = (DRY ? (bf16_t*)(P.ws + WS_PP) + (size_t)(t & 8191) * 4096 : OLAT + (size_t)t * 4096) + fr * 256 + 8 * fq;
#pragma unroll
        for (int ut = 0; ut < 8; ++ut) {
            u32x4 w; w.x = pk2(Oe[ut].x * inv, Oo[ut].x * inv); w.y = pk2(Oe[ut].y * inv, Oo[ut].y * inv); w.z = pk2(Oe[ut].z * inv, Oo[ut].z * inv); w.w = pk2(Oe[ut].w * inv, Oo[ut].w * inv);
            *(u32x4*)(orow + 32 * ut) = w;
        }
        if (have_item) { asm volatile("s_waitcnt lgkmcnt(0)" ::: "memory"); tr_store(titem, (float*)(lds_ + wave * 17920), lane, tcur); ditem += NGW; }
    }
    int lane_l = lane; asm volatile("" : "+v"(lane_l));
    for (; ditem < N_DEFERRED; ditem += NGW) { const TrItem t = deferred_item(P, ditem); float tmp[32]; tr_load(t, lane_l, tmp); tr_store(t, (float*)(lds_ + wave * 17920), lane_l, tmp); }
}

constexpr size_t SC_BATCH = (size_t)1024 * 256 * 257 / 2;
__device__ __forceinline__ size_t sc_row_off(int b, int tl) { const size_t m = (size_t)(tl >> 5); return (size_t)b * SC_BATCH + 1024 * (m * (m + 1) / 2) + (size_t)(tl & 31) * 32 * (m + 1); }
typedef float f32x16 __attribute__((ext_vector_type(16)));
__device__ __forceinline__ unsigned okey_pk(float a, float b) {
    const unsigned w = __builtin_bit_cast(unsigned, __builtin_amdgcn_cvt_pkrtz(a, b));
    const unsigned neg = (w >> 15) & 0x00010001u;
    return w ^ ((neg * 0xffffu) | 0x80008000u);
}
__device__ __forceinline__ void phase_index_scores(const Params& P, unsigned char* lds_) {
    using pg8::bf16x8;
    const bf16_t* Z1 = (const bf16_t*)(P.ws + WS_Z1); unsigned short* SC = (unsigned short*)(P.ws + WS_SC);
    LAS unsigned char* lds = (LAS unsigned char*)lds_;
    constexpr int QROW = 144;
    LAS unsigned char* QL = lds;
    LAS float* SG = (LAS float*)(lds + 9 * 64 * QROW);
    const int tid = threadIdx.x, lane = tid & 63, wave = __builtin_amdgcn_readfirstlane(tid >> 6);
    LAS unsigned char* ST = lds + 9 * 64 * QROW + 2048 + wave * 5120;
    const int l31 = lane & 31, hh = lane >> 5;
    for (int pid = blockIdx.x; pid < 256; pid += gridDim.x) {
        const int b = pid >> 6;
        for (int side = 0; side < 2; ++side) {
            const int qb = side ? (127 - (pid & 63)) : (pid & 63);
            const int q0 = qb * 64;
            __syncthreads();
            {
                const int qi = tid >> 3, part = tid & 7;
                const bf16_t* zr = Z1 + ((size_t)b * SEQ + q0 + qi) * Z1W;
                const u32x4 ww = *(const u32x4*)(zr + 1088);
                const float w8[8] = {bflo(ww.x), bfhi(ww.x), bflo(ww.y), bfhi(ww.y), bflo(ww.z), bfhi(ww.z), bflo(ww.w), bfhi(ww.w)};
                float wh = 0.f;
#pragma unroll
                for (int h = 0; h < 8; ++h) wh = (h == part) ? w8[h] : wh;
                const float sc = 0.5f * fabsf(wh);
                SG[qi * 8 + part] = (wh >= 0.f) ? 1.0f : -1.0f;
#pragma unroll
                for (int c = 0; c < 8; ++c) {
                    const u32x4 v = *(const u32x4*)(zr + 512 + part * 64 + c * 8);
                    u32x4 o; o.x = pk2(bflo(v.x) * sc, bfhi(v.x) * sc); o.y = pk2(bflo(v.y) * sc, bfhi(v.y) * sc); o.z = pk2(bflo(v.z) * sc, bfhi(v.z) * sc); o.w = pk2(bflo(v.w) * sc, bfhi(v.w) * sc);
                    *(LAS u32x4*)(QL + (part * 64 + qi) * QROW + c * 16) = o;
                }
                float a8[8];
#pragma unroll
                for (int j = 0; j < 8; ++j) a8[j] = 0.f;
#pragma unroll
                for (int h = 0; h < 8; ++h) {
                    const u32x4 v = *(const u32x4*)(zr + 512 + h * 64 + part * 8); const float s2 = 0.5f * w8[h];
                    a8[0] += s2 * bflo(v.x); a8[1] += s2 * bfhi(v.x); a8[2] += s2 * bflo(v.y); a8[3] += s2 * bfhi(v.y);
                    a8[4] += s2 * bflo(v.z); a8[5] += s2 * bfhi(v.z); a8[6] += s2 * bflo(v.w); a8[7] += s2 * bfhi(v.w);
                }
                u32x4 o; o.x = pk2(a8[0], a8[1]); o.y = pk2(a8[2], a8[3]); o.z = pk2(a8[4], a8[5]); o.w = pk2(a8[6], a8[7]);
                *(LAS u32x4*)(QL + (8 * 64 + qi) * QROW + part * 16) = o;
            }
            __syncthreads();
            const int ktmax = 2 * qb + 1;
            bf16x8 kn[4];
            {   const bf16_t* kr = Z1 + ((size_t)b * SEQ + min(wave, ktmax) * 32 + l31) * Z1W + 1024 + hh * 8;
#pragma unroll
                for (int dq = 0; dq < 4; ++dq) kn[dq] = *(const bf16x8*)(kr + dq * 16); }
            for (int kt = wave; kt <= ktmax; kt += NWAVE) {
                bf16x8 kf[4];
#pragma unroll
                for (int dq = 0; dq < 4; ++dq) kf[dq] = kn[dq];
                {   const bf16_t* kr = Z1 + ((size_t)b * SEQ + min(kt + NWAVE, ktmax) * 32 + l31) * Z1W + 1024 + hh * 8;
#pragma unroll
                    for (int dq = 0; dq < 4; ++dq) kn[dq] = *(const bf16x8*)(kr + dq * 16); }
#pragma unroll
                for (int qs = 0; qs < 2; ++qs) {
                    const LAS unsigned char* qrow = QL + (qs * 32 + l31) * QROW + hh * 16;
                    const LAS float* sgp = SG + (qs * 32 + l31) * 8;
                    bf16x8 fc[4], fn[4];
#pragma unroll
                    for (int dq = 0; dq < 4; ++dq) fc[dq] = *(const LAS bf16x8*)(qrow + 8 * 64 * QROW + dq * 32);
#pragma unroll
                    for (int dq = 0; dq < 4; ++dq) fn[dq] = *(const LAS bf16x8*)(qrow + dq * 32);
                    const f32x4 sg03 = *(const LAS f32x4*)(sgp), sg47 = *(const LAS f32x4*)(sgp + 4);
                    f32x16 acc;
#pragma unroll
                    for (int r = 0; r < 16; ++r) acc[r] = 0.f;
#pragma unroll
                    for (int dq = 0; dq < 4; ++dq) acc = __builtin_amdgcn_mfma_f32_32x32x16_bf16(kf[dq], fc[dq], acc, 0, 0, 0);
                    f32x16 up;
#pragma unroll
                    for (int h = 0; h < 8; ++h) {
#pragma unroll
                        for (int dq = 0; dq < 4; ++dq) fc[dq] = fn[dq];
                        if (h < 7) {
#pragma unroll
                            for (int dq = 0; dq < 4; ++dq) fn[dq] = *(const LAS bf16x8*)(qrow + (h + 1) * 64 * QROW + dq * 32);
                        }
                        f32x16 u;
#pragma unroll
                        for (int r = 0; r < 16; ++r) u[r] = 0.f;
#pragma unroll
                        for (int dq = 0; dq < 4; ++dq) u = __builtin_amdgcn_mfma_f32_32x32x16_bf16(kf[dq], fc[dq], u, 0, 0, 0);
                        __builtin_amdgcn_sched_barrier(0);
                        if (h > 0) {
                            const float sg = (h - 1 < 4) ? sg03[(h - 1) & 3] : sg47[(h - 1) & 3];
#pragma unroll
                            for (int r = 0; r < 16; ++r) acc[r] = fmaf(fabsf(up[r]), sg, acc[r]);
                        }
                        __builtin_amdgcn_sched_barrier(0);
                        up = u;
                    }
                    {
                        const float sg = sg47[3];
#pragma unroll
                        for (int r = 0; r < 16; ++r) acc[r] = fmaf(fabsf(up[r]), sg, acc[r]);
                    }
#pragma unroll
                    for (int g = 0; g < 4; ++g) { u32x2 w; w.x = okey_pk(acc[4 * g], acc[4 * g + 1]); w.y = okey_pk(acc[4 * g + 2], acc[4 * g + 3]);
                        *(LAS u32x2*)(ST + (qs * 32 + l31) * 80 + (8 * g + 4 * hh) * 2) = w; }
                }
#pragma unroll
                for (int i = 0; i < 4; ++i) {
                    const int row = 16 * i + (lane >> 2), ch = lane & 3, tl = q0 + row;
                    const u32x4 v = *(const LAS u32x4*)(ST + row * 80 + ch * 16);
                    if (kt <= (tl >> 5)) *(u32x4*)(SC + sc_row_off(b, tl) + (size_t)kt * 32 + ch * 8) = v;
                }
            }
        }
    }
}
template <int MODE>
__device__ __forceinline__ void phase_index_select(const Params& P, unsigned char* lds_) {
    const unsigned short* SC = (const unsigned short*)(P.ws + WS_SC); unsigned short* SEL = (unsigned short*)(P.ws + WS_SEL);
    const int tid = threadIdx.x, lane = tid & 63, wave = __builtin_amdgcn_readfirstlane(tid >> 6);
    LAS unsigned char* wbase = (LAS unsigned char*)lds_ + wave * 19456;
    LAS u32x4* rowbuf = (LAS u32x4*)wbase;
    LAS unsigned* hist = (LAS unsigned*)(wbase + 16384);
    LAS unsigned* dummy = hist + 512 + lane;
    LAS unsigned short* outw = (LAS unsigned short*)(wbase + 16384 + 2048 + 256);
    LAS unsigned short* dummy16 = outw + 256 + lane;
    const unsigned rowbuf0 = (unsigned)(unsigned long)wbase;
    const int gw = blockIdx.x * NWAVE + wave, NGW = gridDim.x * NWAVE;
#define SEL_DMA(tt) do { const int _tl = (tt) & (SEQ - 1), _n = _tl + 1; if (_n > TOPK) { const unsigned char* _src = (const unsigned char*)(SC + sc_row_off((tt) >> 13, _tl)) + lane * 16; \
            for (int _sg = 0; _sg * 512 < _n; ++_sg) glds16(_src + _sg * 1024, (unsigned)__builtin_amdgcn_readfirstlane((int)(rowbuf0 + _sg * 1024))); } } while (0)
#define SEL_Q(i) ((i) * NGW + (((i) & 1) ? (NGW - 1 - gw) : gw))
    if (SEL_Q(0) < NTOK) SEL_DMA(SEL_Q(0));
    for (int qi = 0; qi * NGW < NTOK; ++qi) {
        const int t = SEL_Q(qi), tnext = SEL_Q(qi + 1);
        if (t >= NTOK) { if (tnext < NTOK) SEL_DMA(tnext); continue; }
        const int tl = t & (SEQ - 1), n = tl + 1;
        unsigned short* so = SEL + (size_t)t * TOPK;
        if (n <= TOPK) { for (int i = lane; i < n; i += 64) so[i] = (unsigned short)i; if (tnext < NTOK && (qi + 1) * NGW < NTOK) SEL_DMA(tnext); continue; }
        asm volatile("s_waitcnt vmcnt(0)" ::: "memory");
        u32x4 d[16];
        const int lastsg = (n - 1) >> 9;
#pragma unroll
        for (int sg = 0; sg < 16; ++sg) {
            if (sg * 512 < n) {
                d[sg] = rowbuf[sg * 64 + lane];
                if (sg == lastsg) {
#pragma unroll
                    for (int q = 0; q < 4; ++q) { const int i0 = sg * 512 + lane * 8 + 2 * q;
                        d[sg][q] &= ((i0 < n) ? 0x0000ffffu : 0u) | ((i0 + 1 < n) ? 0xffff0000u : 0u); }
                }
            } else d[sg] = (u32x4){0u, 0u, 0u, 0u};
        }
        asm volatile("s_waitcnt lgkmcnt(0)" ::: "memory");
        if (tnext < NTOK && (qi + 1) * NGW < NTOK) SEL_DMA(tnext);
#pragma unroll
        for (int i = 0; i < 8; ++i) { hist[i * 64 + lane] = 0u; }
        asm volatile("s_waitcnt lgkmcnt(0)" ::: "memory");
        LAS unsigned* myh = hist + (lane & 1) * 256;
        if (MODE == 4) { if (d[0].x == 0x12345u) so[lane] = 1; continue; }
#pragma unroll
        for (int sg = 0; sg < 16; ++sg) if (MODE != 1 && sg * 512 < n) {
#pragma unroll
            for (int q = 0; q < 4; ++q) { const unsigned w = d[sg][q];
                __hip_atomic_fetch_add(myh + ((w >> 8) & 0xffu), 1u, __ATOMIC_RELAXED, __HIP_MEMORY_SCOPE_WORKGROUP);
                __hip_atomic_fetch_add(myh + (w >> 24), 1u, __ATOMIC_RELAXED, __HIP_MEMORY_SCOPE_WORKGROUP); }
        }
        asm volatile("s_waitcnt lgkmcnt(0)" ::: "memory");
        unsigned b1, need1;
        {
            unsigned c[4];
#pragma unroll
            for (int q = 0; q < 4; ++q) c[q] = hist[4 * lane + q] + hist[256 + 4 * lane + q];
            const unsigned mine = c[0] + c[1] + c[2] + c[3];
            unsigned suf = mine;
#pragma unroll
            for (int o = 1; o < 64; o <<= 1) { const unsigned v = __shfl_down(suf, o); if (lane + o < 64) suf += v; }
            const unsigned above = suf - mine;
            int fb = -1; unsigned fneed = 0;
            if (above < (unsigned)TOPK && suf >= (unsigned)TOPK) { unsigned a = above;
#pragma unroll
                for (int q = 3; q >= 0; --q) { if (fb < 0 && a + c[q] >= (unsigned)TOPK) { fb = 4 * lane + q; fneed = (unsigned)TOPK - a; } a += c[q]; } }
            const unsigned long long bal = __ballot(fb >= 0);
            const int src = (int)__builtin_ctzll(bal);
            b1 = (unsigned)__shfl(fb, src); need1 = __shfl(fneed, src);
        }
#pragma unroll
        for (int i = 0; i < 8; ++i) { hist[i * 64 + lane] = 0u; }
        asm volatile("s_waitcnt lgkmcnt(0)" ::: "memory");
#pragma unroll
        for (int sg = 0; sg < 16; ++sg) if (MODE != 2 && sg * 512 < n) {
#pragma unroll
            for (int q = 0; q < 4; ++q) { const unsigned w = d[sg][q];
                LAS unsigned* p0 = (((w >> 8) & 0xffu) == b1) ? (myh + (w & 0xffu)) : dummy;
                LAS unsigned* p1 = ((w >> 24) == b1) ? (myh + ((w >> 16) & 0xffu)) : dummy;
                __hip_atomic_fetch_add(p0, 1u, __ATOMIC_RELAXED, __HIP_MEMORY_SCOPE_WORKGROUP);
                __hip_atomic_fetch_add(p1, 1u, __ATOMIC_RELAXED, __HIP_MEMORY_SCOPE_WORKGROUP); }
        }
        asm volatile("s_waitcnt lgkmcnt(0)" ::: "memory");
        unsigned T, need2;
        {
            unsigned c[4];
#pragma unroll
            for (int q = 0; q < 4; ++q) c[q] = hist[4 * lane + q] + hist[256 + 4 * lane + q];
            const unsigned mine = c[0] + c[1] + c[2] + c[3];
            unsigned suf = mine;
#pragma unroll
            for (int o = 1; o < 64; o <<= 1) { const unsigned v = __shfl_down(suf, o); if (lane + o < 64) suf += v; }
            const unsigned above = suf - mine;
            int fb = -1; unsigned fneed = 0;
            if (above < need1 && suf >= need1) { unsigned a = above;
#pragma unroll
                for (int q = 3; q >= 0; --q) { if (fb < 0 && a + c[q] >= need1) { fb = 4 * lane + q; fneed = need1 - a; } a += c[q]; } }
            const unsigned long long bal = __ballot(fb >= 0);
            const int src = (int)__builtin_ctzll(bal);
            T = (b1 << 8) | (unsigned)__shfl(fb, src); need2 = __shfl(fneed, src);
        }
        unsigned base = 0; const unsigned ngt = (unsigned)TOPK - need2; unsigned eqbase = 0;
#pragma unroll
        for (int sg = 0; sg < 16; ++sg) if (MODE != 3 && sg * 512 < n) {
            unsigned ce = 0;
#pragma unroll
            for (int j = 0; j < 8; ++j) {
                const unsigned k = (j & 1) ? (d[sg][j >> 1] >> 16) : (d[sg][j >> 1] & 0xffffu);
                const bool gt = k > T;
                const unsigned long long mk = __ballot(gt);
                const unsigned pos = base + (unsigned)__builtin_amdgcn_mbcnt_hi((unsigned)(mk >> 32), __builtin_amdgcn_mbcnt_lo((unsigned)mk, 0u));
                LAS unsigned short* po = gt ? (outw + pos) : dummy16;
                *po = (unsigned short)(sg * 512 + lane * 8 + j);
                base += (unsigned)__builtin_popcountll(mk);
                ce += (k == T) ? 1u : 0u;
            }
            if (__any(ce > 0u)) {
                unsigned pre = ce;
#pragma unroll
                for (int o = 1; o < 64; o <<= 1) { const unsigned v = __shfl_up(pre, o); if (lane >= o) pre += v; }
                unsigned r = eqbase + pre - ce;
#pragma unroll
                for (int j = 0; j < 8; ++j) { const unsigned k = (j & 1) ? (d[sg][j >> 1] >> 16) : (d[sg][j >> 1] & 0xffffu);
                    if (k == T) { if (r < need2) outw[ngt + r] = (unsigned short)(sg * 512 + lane * 8 + j); ++r; } }
                eqbase += __shfl(pre, 63);
            }
        }
        asm volatile("s_waitcnt lgkmcnt(0)" ::: "memory");
        ((unsigned*)so)[lane] = ((LAS unsigned*)outw)[lane];
        ((unsigned*)so)[64 + lane] = ((LAS unsigned*)outw)[64 + lane];
        asm volatile("s_waitcnt lgkmcnt(0)" ::: "memory");
    }
#undef SEL_DMA
#undef SEL_Q
    asm volatile("s_waitcnt vmcnt(0)" ::: "memory");
}

__device__ __forceinline__ void ret_fill_image(LAS unsigned char* img, const unsigned char* src, size_t row_stride_bytes, int wave, int lane) {
#pragma unroll
    for (int e4 = 0; e4 < 4; ++e4) {
        const int e = wave * 4 + e4, row = 4 * e + (lane >> 4), q = (lane & 15) ^ ((row & 7) << 1);
        __builtin_amdgcn_global_load_lds((const unsigned*)(src + (size_t)row * row_stride_bytes + q * 16), (LAS unsigned*)(img + e * 1024), 16, 0, 0);
    }
}
__device__ __forceinline__ pg8::bf16x8 ret_tr_pair(const LAS unsigned char* img, int row0, int chunk2, int lane) {
    const int g = lane >> 4, i = lane & 15, r0 = row0 + 4 * g + (i >> 2), pb = (i & 3) >> 1, half = (i & 1) * 8;
    const int r1 = r0 + 16;
    const v4i16_t lo = __builtin_amdgcn_ds_read_tr16_b64_v4i16((LAS v4i16_t*)(img + r0 * 256 + ((((chunk2) ^ ((r0 & 7) << 1)) | pb) << 4) + half));
    const v4i16_t hi = __builtin_amdgcn_ds_read_tr16_b64_v4i16((LAS v4i16_t*)(img + r1 * 256 + ((((chunk2) ^ ((r1 & 7) << 1)) | pb) << 4) + half));
    return (pg8::bf16x8){lo[0], lo[1], lo[2], lo[3], hi[0], hi[1], hi[2], hi[3]};
}
__device__ __forceinline__ void phase_ret_kv_mfma(const Params& P, unsigned char* lds_) {
    using pg8::bf16x8;
    const unsigned char* Z0 = (const unsigned char*)(P.ws + WS_Z0); float* KV = (float*)(P.ws + WS_KV);
    LAS unsigned char* Kimg = (LAS unsigned char*)lds_; LAS unsigned char* Vimg = Kimg + 32768;
    const int tid = threadIdx.x, lane = tid & 63, wave = __builtin_amdgcn_readfirstlane(tid >> 6), fr = lane & 15, fq = lane >> 4;
    for (int u = blockIdx.x; u < 1024; u += gridDim.x) {
        const int n = u & 63, h = (u >> 6) & 3, b = u >> 8;
        const size_t row0 = (size_t)b * SEQ + n * 128;
        __syncthreads();
        ret_fill_image(Kimg, Z0 + row0 * ZW * 2 + (512 + h * 128) * 2, ZW * 2, wave, lane);
        ret_fill_image(Vimg, Z0 + row0 * ZW * 2 + (1024 + h * 128) * 2, ZW * 2, wave, lane);
        asm volatile("s_waitcnt vmcnt(0)" ::: "memory");
        __syncthreads();
        bf16x8 va[4];
#pragma unroll
        for (int jc = 0; jc < 4; ++jc) va[jc] = ret_tr_pair(Vimg, 32 * jc, 2 * wave, lane);
        const float g127 = exp2f(ret_log2g(h) * 127.0f);
        float* o = KV + (size_t)u * 16384;
#pragma unroll
        for (int dt = 0; dt < 8; ++dt) {
            f32x4 acc = {0.f, 0.f, 0.f, 0.f};
#pragma unroll
            for (int jc = 0; jc < 4; ++jc) acc = __builtin_amdgcn_mfma_f32_16x16x32_bf16(va[jc], ret_tr_pair(Kimg, 32 * jc, 2 * dt, lane), acc, 0, 0, 0);
            *(f32x4*)(o + (size_t)(16 * dt + fr) * 128 + 16 * wave + 4 * fq) = acc * g127;
        }
    }
}
template <int W>
__device__ __forceinline__ void pool_item(const Params& P, int t0, int c8) {
    const bf16_t* Z0 = (const bf16_t*)(P.ws + WS_Z0); bf16_t* DP = (bf16_t*)(P.ws + WS_DP);
    const int tl0 = t0 & (SEQ - 1);
    u32x4 rows[W + 7];
#pragma unroll
    for (int r = 0; r < W + 7; ++r) { const int d = r - (W - 1);
        rows[r] = (tl0 + d >= 0) ? *(const u32x4*)(Z0 + (size_t)(t0 + d) * ZW + 2048 + c8) : (u32x4){0u, 0u, 0u, 0u}; }
    float sm[8];
#pragma unroll
    for (int j = 0; j < 8; ++j) sm[j] = 0.f;
#pragma unroll
    for (int r = 0; r < W; ++r) { const u32x4 v = rows[r];
        sm[0] += bflo(v.x); sm[1] += bfhi(v.x); sm[2] += bflo(v.y); sm[3] += bfhi(v.y); sm[4] += bflo(v.z); sm[5] += bfhi(v.z); sm[6] += bflo(v.w); sm[7] += bfhi(v.w); }
#pragma unroll
    for (int o = 0; o < 8; ++o) {
        const u32x4 v = rows[o + W - 1];
        if (o > 0) { const u32x4 q = rows[o - 1];
            sm[0] += bflo(v.x) - bflo(q.x); sm[1] += bfhi(v.x) - bfhi(q.x); sm[2] += bflo(v.y) - bflo(q.y); sm[3] += bfhi(v.y) - bfhi(q.y);
            sm[4] += bflo(v.z) - bflo(q.z); sm[5] += bfhi(v.z) - bfhi(q.z); sm[6] += bflo(v.w) - bflo(q.w); sm[7] += bfhi(v.w) - bfhi(q.w); }
        const float inv = 1.0f / (float)min(tl0 + o + 1, W);
        u32x4 w; w.x = pk2(sm[0] * inv - bflo(v.x), sm[1] * inv - bfhi(v.x)); w.y = pk2(sm[2] * inv - bflo(v.y), sm[3] * inv - bfhi(v.y));
        w.z = pk2(sm[4] * inv - bflo(v.z), sm[5] * inv - bfhi(v.z)); w.w = pk2(sm[6] * inv - bflo(v.w), sm[7] * inv - bfhi(v.w));
        *(u32x4*)(DP + (size_t)(t0 + o) * 512 + c8) = w;
    }
}
__device__ __forceinline__ void phase_ret_scan_pool2(const Params& P) {
    const float* KV = (const float*)(P.ws + WS_KV); bf16_t* SB = (bf16_t*)(P.ws + WS_SB);
    const size_t gt = (size_t)blockIdx.x * NT + threadIdx.x, GS = (size_t)gridDim.x * NT;
    for (size_t i = gt; i < (size_t)16 * 8192; i += GS) {
        const int s = (int)(i >> 13), e2 = (int)(i & 8191), h = s & 3;
        const float l2 = ret_log2g(h), cd = exp2f(l2 * 128.0f), g1 = exp2f(l2);
        typedef float f32x2v __attribute__((ext_vector_type(2)));
        const f32x2v* p = (const f32x2v*)(KV + (size_t)s * 64 * 16384) + e2;
        unsigned* q = (unsigned*)(SB + (size_t)s * 64 * 16384) + e2;
        f32x2v R = {0.f, 0.f};
        for (int n0 = 0; n0 < 64; n0 += 32) {
            f32x2v kv[32];
#pragma unroll
            for (int j = 0; j < 32; ++j) kv[j] = __builtin_nontemporal_load(p + (size_t)(n0 + j) * 8192);
#pragma unroll
            for (int j = 0; j < 32; ++j) { q[(size_t)(n0 + j) * 8192] = pk2(R.x * g1, R.y * g1); R = R * cd + kv[j]; }
        }
    }
    const int lane = threadIdx.x & 63, gwv = (int)blockIdx.x * NWAVE + (int)(threadIdx.x >> 6), NGWv = (int)gridDim.x * NWAVE;
    for (int wi = gwv; wi < 2048; wi += NGWv) {
#pragma unroll
        for (int half = 0; half < 2; ++half) {
            const int slot = wi & 1023, gsel = wi >> 10, g = half ? 3 - gsel : gsel;
            const int t0 = (slot * 4 + (lane >> 4)) * 8, c8 = g * 128 + (lane & 15) * 8;
            if (g == 0) pool_item<2>(P, t0, c8); else if (g == 1) pool_item<4>(P, t0, c8); else if (g == 2) pool_item<8>(P, t0, c8); else pool_item<16>(P, t0, c8);
        }
    }
}
__device__ __forceinline__ void phase_ret_out_mfma(const Params& P, unsigned char* lds_) {
    using pg8::bf16x8;
    const unsigned char* Z0 = (const unsigned char*)(P.ws + WS_Z0); const unsigned char* SB = (const unsigned char*)(P.ws + WS_SB); bf16_t* MIX = (bf16_t*)(P.ws + WS_MIX);
    const float* gn = P.in[3];
    LAS unsigned char* Kimg = (LAS unsigned char*)lds_; LAS unsigned char* Vimg = Kimg + 32768; LAS unsigned char* Rimg = Kimg + 65536;
    const int tid = threadIdx.x, lane = tid & 63, wave = __builtin_amdgcn_readfirstlane(tid >> 6), fr = lane & 15, fq = lane >> 4;
    for (int u = blockIdx.x; u < 1024; u += gridDim.x) {
        const int n = u & 63, h = (u >> 6) & 3, b = u >> 8;
        const size_t row0 = (size_t)b * SEQ + n * 128;
        __syncthreads();
        ret_fill_image(Kimg, Z0 + row0 * ZW * 2 + (512 + h * 128) * 2, ZW * 2, wave, lane);
        ret_fill_image(Vimg, Z0 + row0 * ZW * 2 + (1024 + h * 128) * 2, ZW * 2, wave, lane);
        ret_fill_image(Rimg, SB + (size_t)u * 32768, 256, wave, lane);
        const bf16_t* qrow = (const bf16_t*)Z0 + (row0 + 16 * wave + fr) * ZW + h * 128;
        bf16x8 qf[4], qr[4];
#pragma unroll
        for (int c = 0; c < 4; ++c) {
            qf[c] = *(const bf16x8*)(qrow + 32 * c + 8 * fq);
            const u32x2 a = *(const u32x2*)(qrow + 32 * c + 4 * fq), bb = *(const u32x2*)(qrow + 32 * c + 16 + 4 * fq);
            u32x4 w; w.x = a.x; w.y = a.y; w.z = bb.x; w.w = bb.y; qr[c] = __builtin_bit_cast(bf16x8, w);
        }
        asm volatile("s_waitcnt vmcnt(0)" ::: "memory");
        __syncthreads();
        f32x4 sT[8];
#pragma unroll
        for (int jt = 0; jt < 8; ++jt) sT[jt] = (f32x4){0.f, 0.f, 0.f, 0.f};
#pragma unroll
        for (int jp = 0; jp < 4; ++jp) if (2 * jp <= wave) {
            bf16x8 a[8];
#pragma unroll
            for (int t2 = 0; t2 < 2; ++t2) { const int r = 16 * (2 * jp + t2) + fr;
#pragma unroll
                for (int c = 0; c < 4; ++c) a[t2 * 4 + c] = *(const LAS bf16x8*)(Kimg + r * 256 + ((((4 * c + fq)) ^ ((r & 7) << 1)) << 4)); }
            __builtin_amdgcn_sched_barrier(0);
#pragma unroll
            for (int t2 = 0; t2 < 2; ++t2)
#pragma unroll
                for (int c = 0; c < 4; ++c) sT[2 * jp + t2] = __builtin_amdgcn_mfma_f32_16x16x32_bf16(a[t2 * 4 + c], qf[c], sT[2 * jp + t2], 0, 0, 0);
            __builtin_amdgcn_sched_barrier(0);
        }
#pragma unroll
        for (int jt = 0; jt < 8; ++jt) {
            if (jt == wave) {
                if (4 * fq + 0 > fr) sT[jt].x = 0.f; if (4 * fq + 1 > fr) sT[jt].y = 0.f; if (4 * fq + 2 > fr) sT[jt].z = 0.f; if (4 * fq + 3 > fr) sT[jt].w = 0.f;
            }
            if (jt > wave) sT[jt] = (f32x4){0.f, 0.f, 0.f, 0.f};
        }
        bf16x8 pT[4];
#pragma unroll
        for (int jp = 0; jp < 4; ++jp) { u32x4 w; w.x = pk2(sT[2 * jp].x, sT[2 * jp].y); w.y = pk2(sT[2 * jp].z, sT[2 * jp].w); w.z = pk2(sT[2 * jp + 1].x, sT[2 * jp + 1].y); w.w = pk2(sT[2 * jp + 1].z, sT[2 * jp + 1].w);
            pT[jp] = __builtin_bit_cast(bf16x8, w); }
        f32x4 O[8];
        const int nact = (wave >> 1) + 1;
#pragma unroll
        for (int vt = 0; vt < 8; ++vt) {
            bf16x8 rr[4], vv[4];
#pragma unroll
            for (int c = 0; c < 4; ++c) rr[c] = ret_tr_pair(Rimg, 32 * c, 2 * vt, lane);
#pragma unroll
            for (int jp = 0; jp < 4; ++jp) vv[jp] = (jp < nact) ? ret_tr_pair(Vimg, 32 * jp, 2 * vt, lane) : pT[jp];
            __builtin_amdgcn_sched_barrier(0);
            f32x4 acc = {0.f, 0.f, 0.f, 0.f};
#pragma unroll
            for (int c = 0; c < 4; ++c) acc = __builtin_amdgcn_mfma_f32_16x16x32_bf16(rr[c], qr[c], acc, 0, 0, 0);
#pragma unroll
            for (int jp = 0; jp < 4; ++jp) acc = __builtin_amdgcn_mfma_f32_16x16x32_bf16(vv[jp], pT[jp], acc, 0, 0, 0);
            __builtin_amdgcn_sched_barrier(0);
            O[vt] = acc;
        }
        float sm = 0.f;
#pragma unroll
        for (int vt = 0; vt < 8; ++vt) sm += (O[vt].x + O[vt].y) + (O[vt].z + O[vt].w);
        sm += __shfl_xor(sm, 16); sm += __shfl_xor(sm, 32);
        const float mu = sm * (1.0f / 128.0f);
        float sq = 0.f;
#pragma unroll
        for (int vt = 0; vt < 8; ++vt) { const f32x4 dlt = O[vt] - mu; sq += (dlt.x * dlt.x + dlt.y * dlt.y) + (dlt.z * dlt.z + dlt.w * dlt.w); }
        sq += __shfl_xor(sq, 16); sq += __shfl_xor(sq, 32);
        const float rstd = 1.0f / sqrtf(sq * (1.0f / 128.0f) + LN_EPS);
        const bf16_t* grow = (const bf16_t*)Z0 + (row0 + 16 * wave + fr) * ZW + 1536 + h * 128 + 4 * fq;
        bf16_t* orow = MIX + (row0 + 16 * wave + fr) * DM + h * 128 + 4 * fq;
#pragma unroll
        for (int vt = 0; vt < 8; ++vt) {
            const u32x2 gv = *(const u32x2*)(grow + 16 * vt);
            const f32x4 g4 = *(const f32x4*)(gn + h * 128 + 16 * vt + 4 * fq);
            const f32x4 y = (O[vt] - mu) * rstd * g4;
            u32x2 w; w.x = pk2(y.x * silu_f(bflo(gv.x)), y.y * silu_f(bfhi(gv.x))); w.y = pk2(y.z * silu_f(bflo(gv.y)), y.w * silu_f(bfhi(gv.y)));
            *(u32x2*)(orow + 16 * vt) = w;
        }
    }
}

#define XB_TMO      128
#define XB_XCNT(j)  (256  + 64 * (j))
#define XB_XSUB(j)  (1280 + 64 * (j))
#define XB_XGEN(j)  (2304 + 64 * (j))
#define XB_TOP      3328
#define XB_TOPGEN   3392
#define XCD_BAR_WORDS 3456
#define XB_SPIN_CAP (1u << 22)
__device__ __forceinline__ unsigned xb_ld(unsigned* p)              { return __hip_atomic_load(p, __ATOMIC_RELAXED, __HIP_MEMORY_SCOPE_AGENT); }
__device__ __forceinline__ unsigned xb_add(unsigned* p, unsigned v) { return __hip_atomic_fetch_add(p, v, __ATOMIC_RELAXED, __HIP_MEMORY_SCOPE_AGENT); }
__device__ __forceinline__ unsigned xb_xcc_id() { return (unsigned)__builtin_amdgcn_s_getreg((3 << 11) | 20) & 0xFu; }
#define XB_SPIN(cond, bar) do { unsigned _sp = 0; while (cond) { __builtin_amdgcn_s_sleep(1); \
    if ((++_sp & 255u) == 0u) { if (xb_ld(&(bar)[XB_TMO])) break; if (_sp > XB_SPIN_CAP) { atomicAdd(&(bar)[XB_TMO], 1u); break; } } } } while (0)
struct XcdBarrier { unsigned* bar; unsigned x; volatile LAS unsigned* st; };
__device__ __forceinline__ XcdBarrier xcd_barrier_post(unsigned* bar, volatile LAS unsigned* st) {
    XcdBarrier b; b.bar = bar; b.x = xb_xcc_id(); b.st = st;
    if (threadIdx.x == 0) (void)xb_add(&bar[XB_XCNT(b.x)], 1u);
    return b;
}
__device__ __forceinline__ void xcd_barrier_complete(unsigned* bar, unsigned x, unsigned& nloc, unsigned& nx) {
    const unsigned G = gridDim.x * gridDim.y * gridDim.z;
    unsigned sum, cnt, mine, sp = 0u;
    for (;;) {
        sum = 0u; cnt = 0u; mine = 0u;
#pragma unroll
        for (unsigned j = 0; j < 16; ++j) { const unsigned c = xb_ld(&bar[XB_XCNT(j)]); sum += c; cnt += (c > 0u) ? 1u : 0u; mine = (j == x) ? c : mine; }
        if (sum == G) break;
        __builtin_amdgcn_s_sleep(1);
        if ((++sp & 255u) == 0u) { if (xb_ld(&bar[XB_TMO])) break; if (sp > XB_SPIN_CAP) { atomicAdd(&bar[XB_TMO], 1u); break; } }
    }
    nloc = mine > 0u ? mine : 1u; nx = cnt > 0u ? cnt : 1u;
}
__device__ __forceinline__ void xcd_barrier(const XcdBarrier& b) {
    asm volatile("s_waitcnt vmcnt(0)" ::: "memory");
    __syncthreads();
    if (threadIdx.x == 0) {
        unsigned* bar = b.bar;
        __builtin_amdgcn_s_waitcnt(0);
        unsigned nloc = b.st[0], nx = b.st[1];
        if (nloc == 0u) { xcd_barrier_complete(bar, b.x, nloc, nx); b.st[0] = nloc; b.st[1] = nx; }
        const unsigned old = xb_add(&bar[XB_XSUB(b.x)], 1u);
        const unsigned gen = old / nloc;
        if (old + 1u == (gen + 1u) * nloc) {
            __builtin_amdgcn_fence(__ATOMIC_RELEASE, "agent");
            asm volatile("s_waitcnt vmcnt(0)" ::: "memory");
            const unsigned og = xb_add(&bar[XB_TOP], 1u);
            const unsigned tg = og / nx;
            if (og + 1u == (tg + 1u) * nx) xb_add(&bar[XB_TOPGEN], 1u);
            else XB_SPIN(xb_ld(&bar[XB_TOPGEN]) == tg, bar);
            __builtin_amdgcn_fence(__ATOMIC_ACQUIRE, "agent");
            xb_add(&bar[XB_XGEN(b.x)], 1u);
            asm volatile("s_waitcnt vmcnt(0)" ::: "memory");
        } else {
            XB_SPIN(xb_ld(&bar[XB_XGEN(b.x)]) == gen, bar);
            __builtin_amdgcn_fence(__ATOMIC_ACQUIRE, "agent");
            asm volatile("s_waitcnt vmcnt(0)" ::: "memory");
        }
    }
    __syncthreads();
}
constexpr size_t CTL_BAR_OFF = 16384;
constexpr size_t CTL_ZERO_BYTES = 65536;

#ifdef PH_ONLY
#define IN(k) ((k) == PH_ONLY)
#else
#define IN(k) (lo <= (k) && (k) < hi)
#endif
#define SEAM(k) do { if (IN(k) && IN((k) + 1)) xcd_barrier(grid); } while (0)
#ifndef PROBE_DUP
#define PROBE_DUP (-1)
#endif
#define REP(k) for (int _rep = 0; _rep < ((PROBE_DUP == (k)) ? 2 : 1); ++_rep)
#define REPS(k) ((PROBE_DUP == 100 + (k)) ? 2 : 1)

template <int LAYER, int BASE>
__device__ __forceinline__ void layer_tail(const Params& P, unsigned char* lds, const XcdBarrier& grid, int lo, int hi) {
    unsigned char* ws = P.ws;
    int* tb = (int*)(lds + MISC_OFF);
    if (IN(BASE)) { if (PROBE_DUP == BASE) phase_ln_route<true>(P, lds, LAYER); phase_ln_route<false>(P, lds, LAYER); }
    SEAM(BASE);
    if (IN(BASE + 1)) REP(BASE + 1) { moe_setup(P, tb, LAYER);
        MoeSched S{tb, tb + 64, (const int*)(ws + WS_LIST), (const bf16_t*)(ws + WS_XB),
                   (const bf16_t*)(ws + WS_W_GU) + (size_t)LAYER * 32 * DM * DM, DM, (size_t)DM * DM, true};
        EpiGU E{(bf16_t*)(ws + WS_ACT)}; gemm_moe<true>(lds, S, E);
        { const int U = tb[32] * 4, G = (int)gridDim.x, nheavy = (U % G), nlight = G - nheavy, lr = (int)blockIdx.x - nheavy;
          DenseSched S2{(const bf16_t*)(ws + WS_PB) + (size_t)LAYER * NTOK * 256, (const bf16_t*)(ws + WS_W_P) + (size_t)LAYER * DM * 256, NTOK, DM, 256, 256, 0, 1, lr, nlight};
          EpiStoreBf16 E2{(bf16_t*)(ws + WS_PP), DM, 0, nullptr}; gemm_dense(lds, S2, E2); } }
    SEAM(BASE + 1);
    if (IN(BASE + 2)) REP(BASE + 2) { moe_setup(P, tb, LAYER);
        MoeSched S{tb, tb + 64, (const int*)(ws + WS_LIST), (const bf16_t*)(ws + WS_ACT),
                   (const bf16_t*)(ws + WS_W_DN) + (size_t)LAYER * 32 * DM * 512, 512, (size_t)DM * 512, false};
        EpiDown E{(bf16_t*)(ws + WS_YS)}; gemm_moe<false>(lds, S, E); }
    SEAM(BASE + 2);
    if (IN(BASE + 3)) { if (PROBE_DUP == BASE + 3) phase_ln2<true>(P, LAYER); phase_ln2<false>(P, LAYER); }
    SEAM(BASE + 3);
    if (IN(BASE + 4)) REP(BASE + 4) {
        { DenseSched S{(const bf16_t*)(ws + WS_XB), (const bf16_t*)(ws + WS_W_G) + (size_t)LAYER * DM * DM, NTOK, DM, DM, DM, 0, REPS(BASE + 4)};
          EpiPle E{(const bf16_t*)(ws + WS_XB), (const bf16_t*)(ws + WS_PP), LAYER == 1 ? P.out : (float*)nullptr, LAYER == 1 ? (bf16_t*)nullptr : (bf16_t*)(ws + WS_XB2)}; gemm_dense(lds, S, E); }
    }
}

__global__ void __launch_bounds__(NT, 2) mega(Params P, int lo, int hi) {
    extern __shared__ __attribute__((aligned(16))) unsigned char lds[];
    unsigned char* ws = P.ws;
    if (threadIdx.x < 16) ((LAS unsigned*)((LAS unsigned char*)lds + BARW_OFF))[threadIdx.x] = 0u;
    __syncthreads();
    const XcdBarrier grid = xcd_barrier_post((unsigned*)(ws + WS_CTL + CTL_BAR_OFF), (volatile LAS unsigned*)((LAS unsigned char*)lds + BARW_OFF));
    if (IN(0)) REP(0) phase_prep(P, lds);
    SEAM(0);
    if (IN(1)) REP(1) { DenseSched S{(const bf16_t*)(ws + WS_XB), (const bf16_t*)(ws + WS_W_IN0), NTOK, ZW, DM, DM, 0, REPS(1)};
        EpiZ0 E{(bf16_t*)(ws + WS_Z0)}; gemm_dense(lds, S, E); }
    SEAM(1);
    if (IN(2)) REP(2) phase_ret_kv_mfma(P, lds);
    SEAM(2);
    if (IN(3)) REP(3) phase_ret_scan_pool2(P);
    SEAM(3);
    if (IN(4)) REP(4) { phase_ret_out_mfma(P, lds); __syncthreads();
        DenseSched S{(const bf16_t*)(ws + WS_DP), (const bf16_t*)(ws + WS_W_POOL), NTOK, 512, 256, 512, 256};
        EpiStoreBf16S E{(bf16_t*)(ws + WS_MIX), DM, 512, P.in[5]}; gemm_dense(lds, S, E); }
    SEAM(4);
    if (IN(5)) REP(5) { DenseSched S{(const bf16_t*)(ws + WS_MIX), (const bf16_t*)(ws + WS_W_OUT0), NTOK, DM, DM, DM, 0, REPS(5)};
        EpiResidB E{(const bf16_t*)(ws + WS_XB), (bf16_t*)(ws + WS_F)}; gemm_dense(lds, S, E); }
    SEAM(5);
    layer_tail<0, 6>(P, lds, grid, lo, hi);
    SEAM(10);
    if (IN(11)) REP(11) { DenseSched S{(const bf16_t*)(ws + WS_XB2), (const bf16_t*)(ws + WS_W_CIN), NTOK, Z1W, DM, DM, 0, REPS(11)};
        EpiStoreBf16 E{(bf16_t*)(ws + WS_Z1), Z1W, 0, nullptr}; gemm_dense(lds, S, E); }
    SEAM(11);
    if (IN(12)) REP(12) { phase_norms(P); phase_index_scores(P, lds); }
    SEAM(12);
    if (IN(13)) { if (PROBE_DUP == 13) phase_index_select<PROBE_SEL>(P, lds); phase_index_select<0>(P, lds); }
    if (IN(13) && IN(14)) __syncthreads();
    if (IN(14)) REP(14) { DenseSched S{(const bf16_t*)(ws + WS_CQ), (const bf16_t*)(ws + WS_W_QA), NTOK, 4096, 256, 256, 0, REPS(14)};
        EpiStoreFp8 E{(unsigned char*)(ws + WS_QA), 4096}; gemm_dense(lds, S, E); }
    SEAM(14);
    if (IN(15)) { if (PROBE_DUP == 15) phase_sparse_attn_e<true>(P, lds); phase_sparse_attn_e<false>(P, lds); }
    SEAM(15);
    if (IN(16)) REP(16) { DenseSched S{(const bf16_t*)(ws + WS_OLAT), (const bf16_t*)(ws + WS_W_UVBD), NTOK, DM, DM, 4096, 1024, REPS(16)};
        EpiStoreBf16 E{(bf16_t*)(ws + WS_XB), DM, 0, nullptr}; gemm_dense_bdiag(lds, S, E); }
    SEAM(16);
    if (IN(17)) REP(17) { DenseSched S{(const bf16_t*)(ws + WS_XB), (const bf16_t*)(ws + WS_W_COUT), NTOK, DM, DM, DM, 0, REPS(17)};
        EpiResidB E{(const bf16_t*)(ws + WS_XB2), (bf16_t*)(ws + WS_F)}; gemm_dense(lds, S, E); }
    SEAM(17);
    layer_tail<1, 18>(P, lds, grid, lo, hi);
}
#undef IN
#undef SEAM

extern "C" void kernel_launch(void* const* d_in, const int* in_sizes, int n_in, void* d_out, int out_size, void* d_ws, size_t ws_size, hipStream_t stream) {
    static int grid = 0;
    if (grid == 0) {
        if (n_in != 26 || ws_size < WS_END || out_size != NTOK * DM) { fprintf(stderr, "kernel_launch: unexpected problem (n_in %d, ws %zu, out %d)\n", n_in, ws_size, out_size); grid = -1; return; }
        int dev = 0, cus = 0, per_cu = 0;
        (void)hipGetDevice(&dev);
        (void)hipDeviceGetAttribute(&cus, hipDeviceAttributeMultiprocessorCount, dev);
        (void)hipFuncSetAttribute((const void*)mega, hipFuncAttributeMaxDynamicSharedMemorySize, LDS_BYTES);
        (void)hipOccupancyMaxActiveBlocksPerMultiprocessor(&per_cu, (const void*)mega, NT, LDS_BYTES);
        if (per_cu < 1) { fprintf(stderr, "kernel_launch: occupancy query reports %d blocks per CU\n", per_cu); per_cu = 1; }
        (void)hipGetLastError();
        grid = cus;
    }
    if (grid < 0) return;
    (void)hipMemsetAsync((char*)d_ws + WS_CTL, 0, CTL_ZERO_BYTES, stream);
    Params p{};
    for (int i = 0; i < 26; ++i) p.in[i] = (const float*)d_in[i];
    p.out = (float*)d_out; p.ws = (unsigned char*)d_ws;
#if MK_ONE_LAUNCH
    int lo = 0, hi = NPH_TOTAL;
    void* args[] = {&p, &lo, &hi};
    (void)args;
    hipLaunchKernelGGL(mega, dim3(grid), dim3(NT), LDS_BYTES, stream, p, lo, hi);
    hipError_t e = hipPeekAtLastError();
    if (e != hipSuccess) fprintf(stderr, "launch failed: %s (grid %d)\n", hipGetErrorString(e), grid);
#else
    for (int k = 0; k < NPH_TOTAL; ++k) hipLaunchKernelGGL(mega, dim3(grid), dim3(NT), LDS_BYTES, stream, p, k, k + 1);
#endif
}
```

```cpp
#include <hip/hip_runtime.h>
#include <cstdio>
#include <cstdint>

#ifndef PROBE_ATT
#define PROBE_ATT 0
#endif
#ifndef PROBE_LN
#define PROBE_LN 0
#endif
#ifndef PROBE_SEL
#define PROBE_SEL 0
#endif
#ifndef MK_ONE_LAUNCH
#define MK_ONE_LAUNCH 1
#endif

typedef unsigned short bf16_t;
typedef float f32x4 __attribute__((ext_vector_type(4)));
typedef unsigned u32x4 __attribute__((ext_vector_type(4)));
typedef unsigned u32x2 __attribute__((ext_vector_type(2)));

constexpr int NT = 512;
constexpr int NWAVE = NT / 64;
constexpr int NTOK = 32768, DM = 1024, SEQ = 8192, NBATCH = 4;
constexpr int ZW = 2560;
constexpr int Z1W = 1280;
constexpr int CIN = 1096;
constexpr int TOPK = 256;
constexpr float ALPHA = 1.4142135623730951f;
constexpr float LN_EPS = 1e-5f;
constexpr int LDS_BYTES = 163840;
constexpr int BARW_OFF = LDS_BYTES - 64;
constexpr int MISC_OFF = 135168;

constexpr size_t MiB = (size_t)1 << 20;
constexpr size_t WS_CTL = 0;
constexpr size_t WS_W_IN0 = 1 * MiB, WS_W_OUT0 = 6 * MiB, WS_W_POOL = 8 * MiB, WS_W_CIN = 9 * MiB, WS_W_QA = 12 * MiB,
                 WS_W_UVBD = 14 * MiB, WS_W_COUT = 16 * MiB, WS_W_G = 18 * MiB, WS_W_P = 22 * MiB, WS_W_GU = 24 * MiB, WS_W_DN = 152 * MiB;
constexpr size_t WS_XB = 224 * MiB, WS_F = 288 * MiB, WS_PB = 416 * MiB, WS_PP = 448 * MiB, WS_CQ = 512 * MiB, WS_CKV = 528 * MiB,
                 WS_SEL = 544 * MiB, WS_TOKG = 560 * MiB, WS_LIST = 561 * MiB, WS_CKV8 = 566 * MiB;
constexpr size_t WS_M0 = 576 * MiB;
constexpr size_t WS_Z0 = WS_M0, WS_KV = WS_M0 + 160 * MiB, WS_MIX = WS_M0 + 224 * MiB, WS_DP = WS_M0 + 288 * MiB, WS_SB = WS_M0 + 320 * MiB;
constexpr size_t WS_OLAT = WS_M0, WS_QA = WS_F  , WS_SC = WS_M0, WS_Z1 = WS_M0 + 272 * MiB;
constexpr size_t WS_ACT = WS_M0, WS_YS = WS_M0 + 72 * MiB;
constexpr size_t WS_XB2 = 960 * MiB;
constexpr size_t WS_END = 1024 * MiB;
constexpr int LIST_CAP = 32768;
constexpr size_t CTL_CNT_OFF = 32768;
constexpr int CNT_STRIDE = 64;
constexpr size_t WS_GT = WS_CTL + 262144;
constexpr size_t WS_SGB = WS_CTL + 786432;

struct Params {
    const float* in[26];
    float* out;
    unsigned char* ws;
};

__device__ __forceinline__ unsigned f2bf(float f) { unsigned u = __float_as_uint(f); return (u + 0x7fffu + ((u >> 16) & 1u)) >> 16; }
__device__ __forceinline__ float bf2f(unsigned h) { return __uint_as_float(h << 16); }
typedef float f32x2_t __attribute__((ext_vector_type(2))); typedef __bf16 bf16x2_t __attribute__((ext_vector_type(2)));
__device__ __forceinline__ unsigned pk2(float lo, float hi) { f32x2_t v = {lo, hi}; bf16x2_t b = __builtin_convertvector(v, bf16x2_t); return __builtin_bit_cast(unsigned, b); }
__device__ __forceinline__ float bflo(unsigned w) { return __uint_as_float(w << 16); }
__device__ __forceinline__ float bfhi(unsigned w) { return __uint_as_float(w & 0xffff0000u); }
#define WAVE_SUM_DPP(v) ({ float _v = (v); \
    _v += __builtin_bit_cast(float, __builtin_amdgcn_update_dpp(0, __builtin_bit_cast(int, _v), 0xB1, 0xf, 0xf, true));     \
    _v += __builtin_bit_cast(float, __builtin_amdgcn_update_dpp(0, __builtin_bit_cast(int, _v), 0x4E, 0xf, 0xf, true));     \
    _v += __builtin_bit_cast(float, __builtin_amdgcn_update_dpp(0, __builtin_bit_cast(int, _v), 0x141, 0xf, 0xf, true));    \
    _v += __builtin_bit_cast(float, __builtin_amdgcn_update_dpp(0, __builtin_bit_cast(int, _v), 0x140, 0xf, 0xf, true));    \
    _v += __builtin_bit_cast(float, __builtin_amdgcn_update_dpp(0, __builtin_bit_cast(int, _v), 0x142, 0xa, 0xf, false));   \
    _v += __builtin_bit_cast(float, __builtin_amdgcn_update_dpp(0, __builtin_bit_cast(int, _v), 0x143, 0xc, 0xf, false));   \
    __builtin_bit_cast(float, __builtin_amdgcn_readlane(__builtin_bit_cast(int, _v), 63)); })
__device__ __forceinline__ float wave_sum(float v) { return WAVE_SUM_DPP(v); }
#define WAVE_SCAN_DPP(v) ({ unsigned _v = (v); \
    _v += (unsigned)__builtin_amdgcn_update_dpp(0, (int)_v, 0x111, 0xf, 0xf, false); \
    _v += (unsigned)__builtin_amdgcn_update_dpp(0, (int)_v, 0x112, 0xf, 0xf, false); \
    _v += (unsigned)__builtin_amdgcn_update_dpp(0, (int)_v, 0x114, 0xf, 0xf, false); \
    _v += (unsigned)__builtin_amdgcn_update_dpp(0, (int)_v, 0x118, 0xf, 0xf, false); \
    _v += (unsigned)__builtin_amdgcn_update_dpp(0, (int)_v, 0x142, 0xa, 0xf, false); \
    _v += (unsigned)__builtin_amdgcn_update_dpp(0, (int)_v, 0x143, 0xc, 0xf, false); \
    _v; })

__device__ __forceinline__ float silu_f(float a) { return a * __builtin_amdgcn_rcpf(1.0f + __expf(-a)); }
__device__ __forceinline__ float sigmoid_f(float a) { return __builtin_amdgcn_rcpf(1.0f + __expf(-a)); }
#define LDS_FENCE() asm volatile("s_waitcnt lgkmcnt(0)" ::: "memory")

struct UnitInfo {
    const bf16_t* A; int lda;
    const int* rows; int rshift;
    int nvalid;
    const bf16_t* Bt; int ldb;
    int K;
    int orow0;
    int pn;
    int skip;
};

struct DenseSched {
    const bf16_t* A; const bf16_t* Bt; int M, N, K, lda, a_pn_stride; int reps = 1;
    int wrank = -1, wcount = 0;
    int nvalid_cols = 1 << 30;
    __device__ __forceinline__ bool next(int round, UnitInfo& u) const {
        const int nN = N >> 8, nM = M >> 8, nwg = nN * nM;
        if (wcount > 0 && wrank < 0) return false;
        const long L = (wcount > 0) ? ((long)round * wcount + wrank) : ((long)round * gridDim.x + blockIdx.x); if (L >= (long)nwg * reps) return false;
        int wgid = (int)(L % nwg); { const int q = nwg / 8, r = nwg % 8, xcd = wgid % 8, off = wgid / 8; wgid = (xcd < r ? xcd * (q + 1) : r * (q + 1) + (xcd - r) * q) + off; }
        const int nig = 8 * nN, gid = wgid / nig, fm = gid * 8, gsz = (nM - fm) < 8 ? (nM - fm) : 8;
        const int pm = fm + ((wgid % nig) % gsz), pn = (wgid % nig) / gsz;
        u.A = A + (size_t)pm * 256 * lda + (size_t)pn * a_pn_stride; u.lda = lda; u.rows = nullptr; u.rshift = 0; u.nvalid = 256;
        u.Bt = Bt + (size_t)pn * 256 * K; u.ldb = K; u.K = K; u.orow0 = pm * 256; u.pn = pn; u.skip = (pn * 256 + 128 >= nvalid_cols) ? 2 : 0;
        return true;
    }
};
struct MoeSched {
    const int* tb; const int* cnt; const int* list;
    const bf16_t* A; const bf16_t* W; int K; size_t wstride; bool gather;
    __device__ __forceinline__ bool next(int round, UnitInfo& u) const {
        const int i = round * gridDim.x + blockIdx.x;
        const int j = i >> 2, pn = i & 3;
        if (j >= tb[32]) return false;
        const int tm = tb[96 + j];
        const int e = tm >> 8, rb = tm & 255;
        const int nv = min(256, cnt[e] - rb * 256);
        u.rows = list + (size_t)e * LIST_CAP + rb * 256; u.nvalid = nv; u.orow0 = j * 256; u.pn = pn; u.skip = (nv <= 128) ? 1 : 0;
        if (gather) { u.A = A; u.lda = K; u.rshift = 1; }
        else { u.A = A + (size_t)j * 256 * K; u.lda = K; u.rshift = 31;   }
        u.Bt = W + (size_t)e * wstride + (size_t)pn * 256 * K; u.ldb = K; u.K = K;
        return true;
    }
};


namespace pg8 {
#define LAS __attribute__((address_space(3)))
typedef short bf16x8 __attribute__((ext_vector_type(8)));
constexpr int BK = 64, HALF = 128, HTB = HALF * BK * 2, STAGE_BYTES = 8 * HTB;
__device__ __forceinline__ int lds_byte(int r, int c) { const int st = (r >> 4) * 2 + (c >> 5), rr = r & 15, cc = c & 31, ob = rr * 64 + cc * 2; return st * 1024 + (ob ^ (((ob >> 9) & 1) << 5)); }
__device__ __forceinline__ void stage_rc(int b, int& R, int& C) { const int st = b / 1024, sb = b % 1024, swz = sb ^ (((sb >> 9) & 1) << 5); R = (st >> 1) * 16 + swz / 64; C = (st & 1) * 32 + (swz % 64) / 2; }
__device__ __forceinline__ int perm32(int rho) { const int n = rho >> 4, i = rho & 15; return 8 * (i >> 2) + 4 * n + (i & 3); }

template <bool GATHER, class Sched, class Epi, bool BDIAG = false>
__device__ __forceinline__ void gemm_phase(LAS unsigned char* lds, const LAS unsigned* rowtab, const Sched& S, const Epi& E, const int lda, const int ldb, const int K) {
    const int tid = threadIdx.x, wid = __builtin_amdgcn_readfirstlane(tid >> 6), lane = tid & 63, wr = wid >> 2, wc = wid & 3, fr = lane & 15, fq = lane >> 4;
    const int nt = K / BK;
    unsigned voffA[2], voffB[2]; int RA[2]; unsigned CA2[2];
#pragma unroll
    for (int i = 0; i < 2; ++i) { int R, C; stage_rc(tid * 16 + i * 8192, R, C); const int Rb = (R & ~31) + perm32(R & 31);
        voffA[i] = (unsigned)(R * lda + C) * 2u; voffB[i] = (unsigned)(Rb * ldb + C) * 2u; RA[i] = R; CA2[i] = (unsigned)C * 2u; }
    const size_t kstep = (size_t)(BK * 2);
    const size_t hstepA = (size_t)HALF * lda * 2, hstepB = (size_t)HALF * ldb * 2;
    const unsigned ldsw = (unsigned)wid * 1024u;
    const int aoff = lds_byte(wr * 64 + fr, fq * 8), boff = lds_byte(wc * 32 + fr, fq * 8);
    unsigned offA[2][2];
#define PG8_SA(b, h) (((b) * 2 + (h)) * HTB)
#define PG8_SB(b, h) ((4 + (b) * 2 + (h)) * HTB)
#define PG8_STAGE(bufoff, gbase, voff) do { _Pragma("unroll") for (int _i = 0; _i < 2; ++_i) \
        __builtin_amdgcn_global_load_lds((const unsigned*)((const char*)(gbase) + (voff)[_i]), (LAS unsigned*)(lds + (bufoff) + ldsw + _i * 8192), 16, 0, 0); } while (0)
#define PG8_STAGE_A(bufoff, h, gbase) do { if (GATHER) PG8_STAGE(bufoff, gbase, offA[h]); else PG8_STAGE(bufoff, (gbase) + (h) * hstepA, voffA); } while (0)
#define PG8_LOADOFF(round) do { _Pragma("unroll") for (int _h = 0; _h < 2; ++_h) _Pragma("unroll") for (int _i = 0; _i < 2; ++_i) offA[_h][_i] = rowtab[(round) * 256 + _h * 128 + RA[_i]] + CA2[_i]; } while (0)
#define PG8_LDA(dst, b, h) do { _Pragma("unroll") for (int m = 0; m < 4; ++m) _Pragma("unroll") for (int k = 0; k < 2; ++k) dst[m][k] = *(const LAS bf16x8*)(lds + PG8_SA(b, h) + aoff + m * 2048 + k * 1024); } while (0)
#define PG8_LDB(dst, b, h) do { _Pragma("unroll") for (int n = 0; n < 2; ++n) _Pragma("unroll") for (int k = 0; k < 2; ++k) dst[n][k] = *(const LAS bf16x8*)(lds + PG8_SB(b, h) + boff + n * 2048 + k * 1024); } while (0)
#define PG8_MMA(ai, bj, At, Bt) do { if ((!BDIAG || (((kt_ >> 2) & 3) == 2 * (bj) + (wc >> 1))) && !((ai) == 1 && (cur.skip & 1)) && !((bj) == 1 && (cur.skip & 2))) { __builtin_amdgcn_s_setprio(1); _Pragma("unroll") for (int m = 0; m < 4; ++m) _Pragma("unroll") for (int n = 0; n < 2; ++n) _Pragma("unroll") for (int k = 0; k < 2; ++k) \
        acc[ai][bj][m][n] = __builtin_amdgcn_mfma_f32_16x16x32_bf16(Bt[n][k], At[m][k], acc[ai][bj][m][n], 0, 0, 0); __builtin_amdgcn_s_setprio(0); } } while (0)
#define PG8_WAIT_V(n) asm volatile("s_waitcnt vmcnt(" #n ")" ::: "memory")
#define PG8_WAIT_L(n) asm volatile("s_waitcnt lgkmcnt(" #n ")" ::: "memory")
#define PG8_BAR __builtin_amdgcn_s_barrier()
#define PG8_SCHED __builtin_amdgcn_sched_barrier(0)
    UnitInfo cur, nxt; int ui = 0;
    if (!S.next(0, cur)) return;
    f32x4 acc[2][2][4][2];
#pragma unroll
    for (int a = 0; a < 2; ++a)
#pragma unroll
        for (int b = 0; b < 2; ++b)
#pragma unroll
            for (int m = 0; m < 4; ++m)
#pragma unroll
                for (int n = 0; n < 2; ++n) acc[a][b][m][n] = (f32x4){0.f, 0.f, 0.f, 0.f};
    bf16x8 At[4][2], B0[2][2], B1[2][2];
    const char* cA = (const char*)cur.A; const char* cB = (const char*)cur.Bt;
    if (GATHER) { PG8_LOADOFF(0); }
    PG8_STAGE(PG8_SB(0, 0), cB, voffB); PG8_STAGE(PG8_SB(0, 1), cB + hstepB, voffB); PG8_STAGE_A(PG8_SA(0, 0), 0, cA); PG8_STAGE_A(PG8_SA(0, 1), 1, cA);
    if (wr == 1) PG8_BAR;
    PG8_WAIT_V(2); PG8_BAR;
    PG8_STAGE(PG8_SB(1, 0), cB + kstep, voffB); PG8_STAGE_A(PG8_SA(1, 0), 0, cA + kstep); PG8_STAGE(PG8_SB(1, 1), cB + hstepB + kstep, voffB);
    PG8_WAIT_V(6); PG8_BAR;
    for (;;) {
        const bool has_next = S.next(ui + 1, nxt);
        const char* nA = has_next ? (const char*)nxt.A : cA; const char* nB = has_next ? (const char*)nxt.Bt : cB;
        for (int t = 0; t < nt; t += 2) {
            const bool last = (t == nt - 2);
            const char* a1 = cA + (size_t)(t + 1) * kstep;
            const char* a2 = last ? nA : cA + (size_t)(t + 2) * kstep; const char* b2 = last ? nB : cB + (size_t)(t + 2) * kstep;
            const char* a3 = a2 + kstep; const char* b3 = b2 + kstep;
            int kt_ = t;
            PG8_LDB(B0, 0, 0); PG8_LDB(B1, 0, 1); PG8_SCHED; PG8_LDA(At, 0, 0); PG8_STAGE_A(PG8_SA(1, 1), 1, a1);
            if (GATHER) { if (last && has_next) { PG8_LOADOFF(ui + 1); } }
            PG8_WAIT_V(8); PG8_WAIT_L(0); PG8_BAR; PG8_MMA(0, 0, At, B0); PG8_MMA(0, 1, At, B1); PG8_BAR; PG8_SCHED;
            PG8_LDA(At, 0, 1); PG8_STAGE(PG8_SB(0, 0), b2, voffB); PG8_STAGE(PG8_SB(0, 1), b2 + hstepB, voffB); PG8_STAGE_A(PG8_SA(0, 0), 0, a2);
            PG8_WAIT_V(8); PG8_WAIT_L(0); PG8_BAR; PG8_MMA(1, 0, At, B0); PG8_MMA(1, 1, At, B1); PG8_BAR; PG8_SCHED;
            kt_ = t + 1;
            PG8_LDB(B0, 1, 0); PG8_LDB(B1, 1, 1); PG8_SCHED; PG8_LDA(At, 1, 0); PG8_STAGE_A(PG8_SA(0, 1), 1, a2);
            PG8_WAIT_V(8); PG8_WAIT_L(0); PG8_BAR; PG8_MMA(0, 0, At, B0); PG8_MMA(0, 1, At, B1); PG8_BAR; PG8_SCHED;
            PG8_LDA(At, 1, 1); PG8_STAGE(PG8_SB(1, 0), b3, voffB); PG8_STAGE(PG8_SB(1, 1), b3 + hstepB, voffB); PG8_STAGE_A(PG8_SA(1, 0), 0, a3);
            PG8_WAIT_V(8); PG8_WAIT_L(0); PG8_BAR; PG8_MMA(1, 0, At, B0); PG8_MMA(1, 1, At, B1); PG8_BAR; PG8_SCHED;
        }
        if (wr == 0) PG8_BAR;
        if constexpr (Epi::NPRE < 0) {
#pragma unroll
            for (int ai = 0; ai < 2; ++ai)
#pragma unroll
                for (int bj = 0; bj < 2; ++bj)
#pragma unroll
                    for (int mp = 0; mp < 2; ++mp) E.pair(cur, ai * HALF + wr * 64 + mp * 32 + fr, bj * HALF + wc * 32 + 8 * fq, fq,
                                                          acc[ai][bj][2 * mp][0], acc[ai][bj][2 * mp][1], acc[ai][bj][2 * mp + 1][0], acc[ai][bj][2 * mp + 1][1]);
        } else if constexpr (Epi::NPRE > 0) {
#pragma unroll
            for (int ai = 0; ai < 2; ++ai) {
                u32x4 pre[8 * Epi::NPRE];
#pragma unroll
                for (int m = 0; m < 4; ++m)
#pragma unroll
                    for (int bj = 0; bj < 2; ++bj) E.pre(cur, ai * HALF + wr * 64 + m * 16 + fr, bj * HALF + wc * 32 + 8 * fq, &pre[(m * 2 + bj) * Epi::NPRE]);
                PG8_SCHED;
#pragma unroll
                for (int m = 0; m < 4; ++m)
#pragma unroll
                    for (int bj = 0; bj < 2; ++bj) E.post(cur, ai * HALF + wr * 64 + m * 16 + fr, bj * HALF + wc * 32 + 8 * fq, acc[ai][bj][m][0], acc[ai][bj][m][1], &pre[(m * 2 + bj) * Epi::NPRE]);
                PG8_SCHED;
            }
        } else {
#pragma unroll
        for (int ai = 0; ai < 2; ++ai)
#pragma unroll
            for (int m = 0; m < 4; ++m)
#pragma unroll
                for (int bj = 0; bj < 2; ++bj) E(cur, ai * HALF + wr * 64 + m * 16 + fr, bj * HALF + wc * 32 + 8 * fq, acc[ai][bj][m][0], acc[ai][bj][m][1]);
        }
        if (!has_next) break;
#pragma unroll
        for (int a = 0; a < 2; ++a)
#pragma unroll
            for (int b = 0; b < 2; ++b)
#pragma unroll
                for (int m = 0; m < 4; ++m)
#pragma unroll
                    for (int n = 0; n < 2; ++n) acc[a][b][m][n] = (f32x4){0.f, 0.f, 0.f, 0.f};
        cur = nxt; cA = nA; cB = nB; ++ui;
        if (wr == 1) PG8_BAR;
    }
    PG8_WAIT_V(0);
    PG8_BAR;
#undef PG8_SA
#undef PG8_SB
#undef PG8_STAGE
#undef PG8_STAGE_A
#undef PG8_LOADOFF
#undef PG8_LDA
#undef PG8_LDB
#undef PG8_MMA
#undef PG8_WAIT_V
#undef PG8_WAIT_L
#undef PG8_BAR
#undef PG8_SCHED
}
}

template <class Sched, class Epi>
__device__ __forceinline__ void gemm_dense(unsigned char* lds, const Sched& S, const Epi& E) {
    pg8::gemm_phase<false>((LAS unsigned char*)lds, (const LAS unsigned*)nullptr, S, E, S.lda, S.K, S.K);
    __syncthreads();
}
template <class Sched, class Epi>
__device__ __forceinline__ void gemm_dense_bdiag(unsigned char* lds, const Sched& S, const Epi& E) {
    pg8::gemm_phase<false, Sched, Epi, true>((LAS unsigned char*)lds, (const LAS unsigned*)nullptr, S, E, S.lda, S.K, S.K);
    __syncthreads();
}


template <bool GATHER, class Epi>
__device__ __forceinline__ void gemm_moe(unsigned char* lds, const MoeSched& S, const Epi& E) {
    LAS unsigned* rowtab = (LAS unsigned*)(lds + MISC_OFF + 2048);
    if (GATHER) {
        for (int r0 = 0; r0 < 10; r0 += 5) {
            const int* rp[5]; int nv[5]; bool ok[5]; int v[5];
#pragma unroll
            for (int q = 0; q < 5; ++q) { UnitInfo u; ok[q] = S.next(r0 + q, u); rp[q] = ok[q] ? u.rows : S.list; nv[q] = ok[q] ? u.nvalid : 0; }
            const int tr = (int)(threadIdx.x & 255);
#pragma unroll
            for (int q = 0; q < 5; ++q) v[q] = rp[q][tr];
#pragma unroll
            for (int q = 0; q < 5; ++q) if (ok[q] && threadIdx.x < 256) rowtab[(r0 + q) * 256 + threadIdx.x] = (tr < nv[q]) ? (unsigned)(v[q] >> 1) * (unsigned)(S.K * 2) : 0u;
            if (!ok[4]) break;
        }
        __syncthreads();
    }
    pg8::gemm_phase<GATHER>((LAS unsigned char*)lds, (const LAS unsigned*)rowtab, S, E, S.K, S.K, S.K);
    __syncthreads();
}

__device__ __forceinline__ u32x4 pack8(f32x4 a, f32x4 b) { u32x4 w; w.x = pk2(a.x, a.y); w.y = pk2(a.z, a.w); w.z = pk2(b.x, b.y); w.w = pk2(b.z, b.w); return w; }
struct EpiStoreBf16 {
    static constexpr int NPRE = 0;
    bf16_t* O; int ldc; int coff; const float* colscale;
    __device__ __forceinline__ void operator()(const UnitInfo& u, int r, int c, f32x4 v0, f32x4 v1) const {
        const int col = u.pn * 256 + c;
        if (colscale) { const f32x4 s0 = *(const f32x4*)(colscale + col), s1 = *(const f32x4*)(colscale + col + 4); v0 *= s0; v1 *= s1; }
        *(u32x4*)(O + (size_t)(u.orow0 + r) * ldc + coff + col) = pack8(v0, v1);
    }
};

struct EpiStoreBf16S {
    static constexpr int NPRE = 2;
    bf16_t* O; int ldc; int coff; const float* colscale;
    __device__ __forceinline__ void pre(const UnitInfo& u, int r, int c, u32x4* p) const {
        const int col = u.pn * 256 + c; p[0] = *(const u32x4*)(colscale + col); p[1] = *(const u32x4*)(colscale + col + 4); }
    __device__ __forceinline__ void post(const UnitInfo& u, int r, int c, f32x4 v0, f32x4 v1, const u32x4* p) const {
        const int col = u.pn * 256 + c;
        v0 *= __builtin_bit_cast(f32x4, p[0]); v1 *= __builtin_bit_cast(f32x4, p[1]);
        *(u32x4*)(O + (size_t)(u.orow0 + r) * ldc + coff + col) = pack8(v0, v1);
    }
};

__device__ __forceinline__ float ret_log2g(int h) { return (h == 0) ? -0x1.77394cp-5f : (h == 1) ? -0x1.743ee8p-6f : (h == 2) ? -0x1.72c7bap-7f : -0x1.720d9cp-8f; }
struct EpiZ0 {
    static constexpr int NPRE = 0;
    bf16_t* O;
    __device__ __forceinline__ void operator()(const UnitInfo& u, int r, int c, f32x4 v0, f32x4 v1) const {
        const int col = u.pn * 256 + c, row = u.orow0 + r;
        if (col < 1024) { const float e = ret_log2g((col >> 7) & 3) * (float)(row & 127); const float sc = __builtin_amdgcn_exp2f(col < 512 ? e : -e); v0 *= sc; v1 *= sc; }
        *(u32x4*)(O + (size_t)row * ZW + col) = pack8(v0, v1);
    }
};

struct EpiStoreFp8 {
    static constexpr int NPRE = -1;
    unsigned char* O; int ldc;
    __device__ __forceinline__ void pair(const UnitInfo& u, int rA, int c, int fq, f32x4 a0, f32x4 a1, f32x4 b0, f32x4 b1) const {
        int x0 = __builtin_amdgcn_cvt_pk_fp8_f32(a0.x, a0.y, 0, false); x0 = __builtin_amdgcn_cvt_pk_fp8_f32(a0.z, a0.w, x0, true);
        int x1 = __builtin_amdgcn_cvt_pk_fp8_f32(a1.x, a1.y, 0, false); x1 = __builtin_amdgcn_cvt_pk_fp8_f32(a1.z, a1.w, x1, true);
        int y0 = __builtin_amdgcn_cvt_pk_fp8_f32(b0.x, b0.y, 0, false); y0 = __builtin_amdgcn_cvt_pk_fp8_f32(b0.z, b0.w, y0, true);
        int y1 = __builtin_amdgcn_cvt_pk_fp8_f32(b1.x, b1.y, 0, false); y1 = __builtin_amdgcn_cvt_pk_fp8_f32(b1.z, b1.w, y1, true);
        const auto s0 = __builtin_amdgcn_permlane16_swap((unsigned)y0, (unsigned)x0, false, false), s1 = __builtin_amdgcn_permlane16_swap((unsigned)y1, (unsigned)x1, false, false);
        u32x4 w; w.x = s0[0]; w.y = s1[0]; w.z = s0[1]; w.w = s1[1];
        const int odd = fq & 1, row = odd ? rA : rA + 16, col = odd ? c - 8 : c;
        *(u32x4*)(O + (size_t)(u.orow0 + row) * ldc + u.pn * 256 + col) = w;
    }
};
struct EpiResidB {
    static constexpr int NPRE = 1;
    const bf16_t* X; bf16_t* Yo;
    __device__ __forceinline__ void pre(const UnitInfo& u, int r, int c, u32x4* p) const { p[0] = *(const u32x4*)(X + (size_t)(u.orow0 + r) * DM + u.pn * 256 + c); }
    __device__ __forceinline__ void post(const UnitInfo& u, int r, int c, f32x4 v0, f32x4 v1, const u32x4* p) const {
        const size_t off = (size_t)(u.orow0 + r) * DM + u.pn * 256 + c;
        const u32x4 xw = p[0];
        const f32x4 x0 = {bflo(xw.x), bfhi(xw.x), bflo(xw.y), bfhi(xw.y)}, x1 = {bflo(xw.z), bfhi(xw.z), bflo(xw.w), bfhi(xw.w)};
        *(u32x4*)(Yo + off) = pack8(x0 * ALPHA + v0, x1 * ALPHA + v1);
    }
};

struct EpiGU {
    static constexpr int NPRE = -1;
    bf16_t* ACT;
    __device__ __forceinline__ void pair(const UnitInfo& u, int rA, int c, int fq, f32x4 a0, f32x4 a1, f32x4 b0, f32x4 b1) const {
        const unsigned x0 = pk2(silu_f(a0.x) * a0.y, silu_f(a0.z) * a0.w), x1 = pk2(silu_f(a1.x) * a1.y, silu_f(a1.z) * a1.w);
        const unsigned y0 = pk2(silu_f(b0.x) * b0.y, silu_f(b0.z) * b0.w), y1 = pk2(silu_f(b1.x) * b1.y, silu_f(b1.z) * b1.w);
        const auto s0 = __builtin_amdgcn_permlane16_swap(y0, x0, false, false), s1 = __builtin_amdgcn_permlane16_swap(y1, x1, false, false);
        u32x4 w; w.x = s0[0]; w.y = s1[0]; w.z = s0[1]; w.w = s1[1];
        const int odd = fq & 1, row = odd ? rA : rA + 16, col = (c >> 1) - (odd ? 4 : 0);
        *(u32x4*)(ACT + (size_t)(u.orow0 + row) * 512 + u.pn * 128 + col) = w;
    }
};
struct EpiDown {
    static constexpr int NPRE = 1;
    bf16_t* YS;
    __device__ __forceinline__ void pre(const UnitInfo& u, int r, int c, u32x4* p) const { p[0].x = (unsigned)u.rows[r]; }
    __device__ __forceinline__ void post(const UnitInfo& u, int r, int c, f32x4 v0, f32x4 v1, const u32x4* p) const {
        const int pair = (r < u.nvalid) ? (int)p[0].x : 2 * NTOK;
        *(u32x4*)(YS + (size_t)pair * DM + u.pn * 256 + c) = pack8(v0, v1);
    }
};
struct EpiPle {
    static constexpr int NPRE = 2;
    const bf16_t* XI; const bf16_t* PP; float* OUT; bf16_t* XO;
    __device__ __forceinline__ void pre(const UnitInfo& u, int r, int c, u32x4* p) const {
        const size_t off = (size_t)(u.orow0 + r) * DM + u.pn * 256 + c; p[0] = *(const u32x4*)(PP + off); p[1] = *(const u32x4*)(XI + off); }
    __device__ __forceinline__ void post(const UnitInfo& u, int r, int c, f32x4 v0, f32x4 v1, const u32x4* p) const {
        const size_t off = (size_t)(u.orow0 + r) * DM + u.pn * 256 + c;
        const u32x4 pw = p[0], xw = p[1];
        f32x4 f0 = {bflo(xw.x), bfhi(xw.x), bflo(xw.y), bfhi(xw.y)}, f1 = {bflo(xw.z), bfhi(xw.z), bflo(xw.w), bfhi(xw.w)};
        f0.x += sigmoid_f(v0.x) * bflo(pw.x); f0.y += sigmoid_f(v0.y) * bfhi(pw.x); f0.z += sigmoid_f(v0.z) * bflo(pw.y); f0.w += sigmoid_f(v0.w) * bfhi(pw.y);
        f1.x += sigmoid_f(v1.x) * bflo(pw.z); f1.y += sigmoid_f(v1.y) * bfhi(pw.z); f1.z += sigmoid_f(v1.z) * bflo(pw.w); f1.w += sigmoid_f(v1.w) * bfhi(pw.w);
        if (OUT) { *(f32x4*)(OUT + off) = f0; *(f32x4*)(OUT + off + 4) = f1; }
        if (XO) *(u32x4*)(XO + off) = pack8(f0, f1);
    }
};

struct TrDesc { const float* src; bf16_t* dst; int K, N, Nsrc, nbatch, mode, dst_ld; };
struct TrItem { const float* src; bf16_t* dst; int Nsrc, dst_ld, mode, kb, nb; };
__device__ __forceinline__ void tr_load(const TrItem& t, int lane, float (&tmp)[32]) {
    const int k0 = 64 * t.kb, n0 = 32 * t.nb, Ns = t.Nsrc;
    const bool okc = (n0 + 4 * (lane & 7)) < Ns;
    const float* p = t.src + (size_t)(k0 + (lane >> 3)) * Ns + n0 + 4 * (lane & 7);
#pragma unroll
    for (int i = 0; i < 8; ++i) { f32x4 v = {0.f, 0.f, 0.f, 0.f}; if (okc) v = __builtin_nontemporal_load((const f32x4*)p);
        tmp[4 * i] = v.x; tmp[4 * i + 1] = v.y; tmp[4 * i + 2] = v.z; tmp[4 * i + 3] = v.w; p += 8 * Ns; asm volatile("" : "+v"(p)); }
}
__device__ __forceinline__ void tr_store(const TrItem& t, float* scr, int lane, const float (&tmp)[32]) {
    const int k0 = 64 * t.kb, n0 = 32 * t.nb;
#pragma unroll
    for (int i = 0; i < 32; ++i) scr[(8 * (i >> 2) + (lane >> 3)) * 33 + 4 * (lane & 7) + (i & 3)] = tmp[i];
    LDS_FENCE();
    const int c = lane & 7;
    int n8 = lane >> 3; asm volatile("" : "+v"(n8));
#pragma unroll
    for (int j = 0; j < 4; ++j) {
        const int n = n8 + 8 * j; const float* sp = scr + (8 * c) * 33 + n;
        const int ng = n0 + n;
        float sc = 1.f; int nd = ng; int coff = 0;
        if (t.mode == 1) { if (ng >= 512 && ng < 1024) sc = 0.08838834764831845f; }
        if (t.mode == 2) { nd = (ng < 512) ? 2 * ng : 2 * (ng - 512) + 1; }
        if (t.mode == 3) { coff = ((ng >> 6) & 3) * 256; }
        u32x4 o; o.x = pk2(sp[0 * 33] * sc, sp[1 * 33] * sc); o.y = pk2(sp[2 * 33] * sc, sp[3 * 33] * sc); o.z = pk2(sp[4 * 33] * sc, sp[5 * 33] * sc); o.w = pk2(sp[6 * 33] * sc, sp[7 * 33] * sc);
        *(u32x4*)(t.dst + (size_t)nd * t.dst_ld + coff + k0 + 8 * c) = o;
    }
    LDS_FENCE();
}
__device__ __forceinline__ int tr_items(const TrDesc& d) { return d.nbatch * (d.K / 64) * (d.N / 32); }

constexpr int N_DEFERRED = 32 * 512 + 32 * 256;
__device__ __forceinline__ TrItem deferred_item(const Params& P, int idx) {
    TrItem t;
    if (idx < 32 * 512) { const int b = 32 + (idx >> 9), r = idx & 511;
        t.src = P.in[22] + (size_t)b * 1024 * 1024; t.dst = (bf16_t*)(P.ws + WS_W_GU) + (size_t)b * 1024 * 1024; t.Nsrc = 1024; t.dst_ld = 1024; t.mode = 2; t.kb = r >> 5; t.nb = r & 31; }
    else { const int i2 = idx - 32 * 512, b = 32 + (i2 >> 8), r = i2 & 255;
        t.src = P.in[23] + (size_t)b * 512 * 1024; t.dst = (bf16_t*)(P.ws + WS_W_DN) + (size_t)b * 1024 * 512; t.Nsrc = 1024; t.dst_ld = 512; t.mode = 0; t.kb = r >> 5; t.nb = r & 31; }
    return t;
}
__device__ __forceinline__ void phase_prep(const Params& P, unsigned char* lds) {
    unsigned char* ws = P.ws;
    const int tid = threadIdx.x, lane = tid & 63, wave = tid >> 6;
    const int gw = blockIdx.x * NWAVE + wave, NGW = gridDim.x * NWAVE;
    float* scr = (float*)lds + wave * (64 * 33);
    constexpr int ND = 9;
    TrDesc d[ND];
    d[0] = {P.in[22], (bf16_t*)(ws + WS_W_GU), 1024, 1024, 1024, 32, 2, 1024};
    d[1] = {P.in[23], (bf16_t*)(ws + WS_W_DN), 512, 1024, 1024, 32, 0, 512};
    d[2] = {P.in[2], (bf16_t*)(ws + WS_W_IN0), 1024, 2560, 2560, 1, 1, 1024};
    d[3] = {P.in[6], (bf16_t*)(ws + WS_W_OUT0), 1024, 1024, 1024, 1, 0, 1024};
    d[4] = {P.in[13], (bf16_t*)(ws + WS_W_COUT), 1024, 1024, 1024, 1, 0, 1024};
    d[5] = {P.in[24], (bf16_t*)(ws + WS_W_G), 1024, 1024, 1024, 2, 0, 1024};
    d[6] = {P.in[25], (bf16_t*)(ws + WS_W_P), 256, 1024, 1024, 2, 0, 256};
    d[7] = {P.in[7], (bf16_t*)(ws + WS_W_CIN), 1024, Z1W, CIN, 1, 0, 1024};
    d[8] = {P.in[12], (bf16_t*)(ws + WS_W_UVBD), 256, 1024, 1024, 1, 3, 1024};
    int total = 0;
#pragma unroll
    for (int i = 0; i < ND; ++i) total += tr_items(d[i]);
#define TR_DECODE(it, T) do { int _r = (it); bool _f = false; T = TrItem{nullptr, nullptr, 0, 0, 0, 0, 0}; _Pragma("unroll") for (int _i = 0; _i < ND; ++_i) { const int _n = tr_items(d[_i]); \
            if (!_f && _r < _n) { _f = true; const int _per = (d[_i].K / 64) * (d[_i].N / 32), _b = _r / _per, _q = _r % _per, _nblk = d[_i].N / 32; \
                T.src = d[_i].src + (size_t)_b * d[_i].K * d[_i].Nsrc; T.dst = d[_i].dst + (size_t)_b * d[_i].N * d[_i].dst_ld; T.Nsrc = d[_i].Nsrc; T.dst_ld = d[_i].dst_ld; T.mode = d[_i].mode; T.kb = _q / _nblk; T.nb = _q % _nblk; } \
            if (!_f) _r -= _n; } } while (0)
    {
        float cur[32], nxt[32];
        TrItem tc, tn;
        int it = gw;
        if (it < total) { TR_DECODE(it, tc); tr_load(tc, lane, cur); }
        while (it < total) {
            const int itn = it + NGW;
            if (itn < total) { TR_DECODE(itn, tn); tr_load(tn, lane, nxt); }
            tr_store(tc, scr, lane, cur);
#pragma unroll
            for (int i = 0; i < 32; ++i) cur[i] = nxt[i];
            it = itn; tc = tn;
        }
    }
#undef TR_DECODE
    const size_t gt = (size_t)blockIdx.x * NT + tid, GS = (size_t)gridDim.x * NT;
    {
        bf16_t* o = (bf16_t*)(ws + WS_W_POOL); const float* pw = P.in[4];
        for (size_t i = gt; i < 512 * 256; i += GS) { const int n = (int)(i >> 8), k = (int)(i & 255), g = n >> 7, dd = n & 127, kg = k >> 7, c = k & 127;
            o[i] = (bf16_t)((kg == (g & 1)) ? f2bf(pw[((size_t)g * 128 + c) * 128 + dd]) : 0u); }
    }
    {
        u32x4* o = (u32x4*)(ws + WS_W_UVBD);
        for (size_t i = gt; i < (size_t)1024 * 1024 / 8; i += GS) { const int n = (int)(i >> 7), k = (int)(i & 127) * 8; if (((n >> 6) & 3) != (k >> 8)) o[i] = (u32x4){0u, 0u, 0u, 0u}; }
    }
    {
        bf16_t* o = (bf16_t*)(ws + WS_W_QA); const float* uq = P.in[10]; const float* uk = P.in[11];
        float* Bq = (float*)lds; float* Ak = Bq + 256 * 65;
        for (int item = blockIdx.x; item < 256; item += gridDim.x) {
            const int h = item >> 4, c0 = (item & 15) * 16;
            __syncthreads();
            {   f32x4 v[8];
#pragma unroll
                for (int q = 0; q < 8; ++q) { const int i = tid + NT * q, r = i >> 4, d4 = (i & 15) * 4; v[q] = *(const f32x4*)(uq + (size_t)r * 1024 + h * 64 + d4); }
                f32x4 vk = {0.f, 0.f, 0.f, 0.f};
                if (tid < 256) { const int c = tid >> 4, d4 = (tid & 15) * 4; vk = *(const f32x4*)(uk + (size_t)(c0 + c) * 1024 + h * 64 + d4); }
#pragma unroll
                for (int q = 0; q < 8; ++q) { const int i = tid + NT * q, r = i >> 4, d4 = (i & 15) * 4; float* qd = Bq + r * 65 + d4; qd[0] = v[q].x; qd[1] = v[q].y; qd[2] = v[q].z; qd[3] = v[q].w; }
                if (tid < 256) { const int c = tid >> 4, d4 = (tid & 15) * 4; float* qd = Ak + c * 65 + d4; qd[0] = vk.x; qd[1] = vk.y; qd[2] = vk.z; qd[3] = vk.w; }
            }
            __syncthreads();
            const int r = tid & 255, cg = tid >> 8;
            float acc[8];
#pragma unroll
            for (int j = 0; j < 8; ++j) acc[j] = 0.f;
#pragma unroll 8
            for (int dd = 0; dd < 64; ++dd) { const float bv = Bq[r * 65 + dd];
#pragma unroll
                for (int j = 0; j < 8; ++j) acc[j] += Ak[(cg * 8 + j) * 65 + dd] * bv; }
#pragma unroll
            for (int j = 0; j < 8; ++j) o[(size_t)(h * 256 + c0 + cg * 8 + j) * 256 + r] = (bf16_t)f2bf(acc[j] * 0.125f);
        }
        __syncthreads();
    }
    {
        bf16_t* GT = (bf16_t*)(ws + WS_GT); float* SGB = (float*)(ws + WS_SGB);
        for (size_t i = gt; i < (size_t)2 * 48 * 1024; i += GS) {
            const int l = (int)(i / (48 * 1024)), j = (int)((i / 1024) % 48), c = (int)(i & 1023);
            float w = 0.f;
            if (j < 4) w = P.in[18][(size_t)l * DM * 4 + (size_t)c * 4 + j]; else if (j < 36) w = P.in[20][(size_t)l * DM * 32 + (size_t)c * 32 + (j - 4)];
            const float g = P.in[14][l * DM + c] * w;
            const unsigned hi = f2bf(g); const unsigned lo = f2bf(g - bf2f(hi));
            GT[((size_t)(l * 2 + 0) * 48 + j) * 1024 + c] = (bf16_t)hi; GT[((size_t)(l * 2 + 1) * 48 + j) * 1024 + c] = (bf16_t)lo;
        }
        for (int it = NGW - 1 - gw; it < 96; it += NGW) {
            const int l = it / 48, j = it % 48; float sg = 0.f, sb = 0.f;
#pragma unroll
            for (int c = lane; c < 1024; c += 64) {
                float w = 0.f;
                if (j < 4) w = P.in[18][(size_t)l * DM * 4 + (size_t)c * 4 + j]; else if (j < 36) w = P.in[20][(size_t)l * DM * 32 + (size_t)c * 32 + (j - 4)];
                sg += P.in[14][l * DM + c] * w; sb += P.in[15][l * DM + c] * w;
            }
            sg = wave_sum(sg); sb = wave_sum(sb);
            const float bias = (j < 4) ? P.in[19][l * 4 + j] : ((j < 36) ? P.in[21][l * 32 + (j - 4)] : 0.f);
            if (lane == 0) { SGB[(l * 2 + 0) * 48 + j] = sg; SGB[(l * 2 + 1) * 48 + j] = sb + bias; }
        }
    }
    {
        const f32x4* x = (const f32x4*)P.in[0]; u32x4* xb = (u32x4*)(ws + WS_XB);
        const size_t nx = (size_t)NTOK * DM / 8, np = (size_t)2 * NTOK * 256 / 8;
        size_t i = gt;
        for (; i + 3 * GS < nx; i += 4 * GS) { f32x4 a[8];
#pragma unroll
            for (int q = 0; q < 4; ++q) { a[2 * q] = __builtin_nontemporal_load(x + 2 * (i + q * GS)); a[2 * q + 1] = __builtin_nontemporal_load(x + 2 * (i + q * GS) + 1); }
#pragma unroll
            for (int q = 0; q < 4; ++q) xb[i + q * GS] = pack8(a[2 * q], a[2 * q + 1]); }
        for (; i < nx; i += GS) xb[i] = pack8(x[2 * i], x[2 * i + 1]);
        const f32x4* p = (const f32x4*)P.in[1]; u32x4* pb = (u32x4*)(ws + WS_PB);
        i = gt;
        for (; i + 3 * GS < np; i += 4 * GS) { f32x4 a[8];
#pragma unroll
            for (int q = 0; q < 4; ++q) { a[2 * q] = __builtin_nontemporal_load(p + 2 * (i + q * GS)); a[2 * q + 1] = __builtin_nontemporal_load(p + 2 * (i + q * GS) + 1); }
#pragma unroll
            for (int q = 0; q < 4; ++q) pb[i + q * GS] = pack8(a[2 * q], a[2 * q + 1]); }
        for (; i < np; i += GS) pb[i] = pack8(p[2 * i], p[2 * i + 1]);
    }
}


template <bool DRY>
__device__ __forceinline__ void phase_ln_route(const Params& P, unsigned char* lds, int layer) {
    using pg8::bf16x8;
    const bf16_t* F = (const bf16_t*)(P.ws + WS_F); bf16_t* XB = (bf16_t*)(P.ws + (DRY ? WS_M0 + 128 * MiB : WS_XB));
    float* TOKG = (float*)(P.ws + WS_TOKG); int* LIST = (int*)(P.ws + WS_LIST);
    int* CNT = (int*)(P.ws + WS_CTL + CTL_CNT_OFF) + layer * 32 * CNT_STRIDE;
    const float* lg = P.in[14] + layer * DM; const float* lb = P.in[15] + layer * DM;
    const bf16_t* GTh = (const bf16_t*)(P.ws + WS_GT) + (size_t)(layer * 2) * 48 * 1024; const bf16_t* GTl = GTh + 48 * 1024;
    const float* SG = (const float*)(P.ws + WS_SGB) + (layer * 2) * 48; const float* BB = SG + 48;
    const int tid = threadIdx.x, lane = tid & 63, wave = tid >> 6, r16 = lane & 15, g = lane >> 4;
    int* dec = (int*)lds;
    int* rank = dec + 256;
    int* lcnt = rank + 256;
    int* lbase = lcnt + 32;
    float* SS = (float*)(lds + 4096);
    float* stat = SS + wave * 32;
    float* LGs = (float*)(lds + 8192);
    float* LG = LGs + wave * (16 * 52);
    float* PP_ = (float*)(lds + 36864);
    float* PS = (float*)(lds + 36864 + 8 * 64 * 52 * 4);
    for (int rb = blockIdx.x; rb < NTOK / 128; rb += gridDim.x) {
        if (tid < 32) lcnt[tid] = 0;
        __syncthreads();
        const int tbase = rb * 128 + wave * 16;
        {
            bf16x8 GH[12], GL[12];
            {   int r16l = r16; asm volatile("" : "+v"(r16l));
                const bf16_t* hp = GTh + (size_t)r16l * 1024 + 128 * wave + 8 * g; const bf16_t* lp = GTl + (size_t)r16l * 1024 + 128 * wave + 8 * g;
#pragma unroll
                for (int ks = 0; ks < 4; ++ks)
#pragma unroll
                    for (int i = 0; i < 3; ++i) { GH[ks * 3 + i] = *(const bf16x8*)(hp + (size_t)i * 16 * 1024 + 32 * ks); GL[ks * 3 + i] = *(const bf16x8*)(lp + (size_t)i * 16 * 1024 + 32 * ks); } }
            const bf16_t* yp = F + (size_t)(rb * 128 + r16) * DM + 128 * wave + 8 * g;
#pragma unroll 1
            for (int half = 0; half < ((DRY && PROBE_LN == 1) ? 0 : 2); ++half) {
#pragma unroll 1
              for (int rp = 0; rp < 2; ++rp) {
                u32x4 YW[8];
#pragma unroll
                for (int rt2 = 0; rt2 < 2; ++rt2) {
#pragma unroll
                    for (int ks = 0; ks < 4; ++ks) YW[rt2 * 4 + ks] = *(const u32x4*)(yp + 32 * ks);
                    yp += 16 * DM; asm volatile("" : "+v"(yp)); }
                __builtin_amdgcn_sched_barrier(0);
#pragma unroll
                for (int rt2 = 0; rt2 < 2; ++rt2) {
                    const int rt4 = rp * 2 + rt2;
                    f32x4 acc[3];
#pragma unroll
                    for (int i = 0; i < 3; ++i) acc[i] = (f32x4){0.f, 0.f, 0.f, 0.f};
                    float sm = 0.f, sq = 0.f;
#pragma unroll
                    for (int ks = 0; ks < 4; ++ks) {
                        const u32x4 yw = YW[rt2 * 4 + ks];
                        const float y0 = bflo(yw.x), y1 = bfhi(yw.x), y2 = bflo(yw.y), y3 = bfhi(yw.y), y4 = bflo(yw.z), y5 = bfhi(yw.z), y6 = bflo(yw.w), y7 = bfhi(yw.w);
                        sm += (y0 + y1) + (y2 + y3) + (y4 + y5) + (y6 + y7);
                        sq += (y0 * y0 + y1 * y1) + (y2 * y2 + y3 * y3) + (y4 * y4 + y5 * y5) + (y6 * y6 + y7 * y7);
                        const bf16x8 yh = __builtin_bit_cast(bf16x8, yw);
#pragma unroll
                        for (int i = 0; i < 3; ++i) {
                            acc[i] = __builtin_amdgcn_mfma_f32_16x16x32_bf16(yh, GH[ks * 3 + i], acc[i], 0, 0, 0);
                            acc[i] = __builtin_amdgcn_mfma_f32_16x16x32_bf16(yh, GL[ks * 3 + i], acc[i], 0, 0, 0);
                        }
                    }
                    sm += __shfl_xor(sm, 16); sm += __shfl_xor(sm, 32); sq += __shfl_xor(sq, 16); sq += __shfl_xor(sq, 32);
                    if (g == 0) { PS[(wave * 64 + 16 * rt4 + r16) * 2] = sm; PS[(wave * 64 + 16 * rt4 + r16) * 2 + 1] = sq; }
#pragma unroll
                    for (int i = 0; i < 3; ++i)
#pragma unroll
                        for (int r = 0; r < 4; ++r) PP_[(wave * 64 + 16 * rt4 + 4 * g + r) * 52 + 16 * i + r16] = acc[i][r];
                }
                __builtin_amdgcn_sched_barrier(0);
              }
                __syncthreads();
#pragma unroll
                for (int q = 0; q < 6; ++q) { const int idx = tid + NT * q, row = idx / 48, col = idx - row * 48;
                    float a = 0.f;
#pragma unroll
                    for (int w = 0; w < 8; ++w) a += PP_[(w * 64 + row) * 52 + col];
                    LGs[(half * 64 + row) * 52 + col] = a; }
                if (tid < 128) { float a = 0.f;
#pragma unroll
                    for (int w = 0; w < 8; ++w) a += PS[w * 128 + tid];
                    SS[half * 128 + tid] = a; }
                __syncthreads();
            }
        }
        {
            int tid_l = tid; asm volatile("" : "+v"(tid_l));
            const int t = tid_l >> 2, c0 = (tid_l & 3) * 12;
            const float s1 = SS[t * 2], s2 = SS[t * 2 + 1];
            const float mean = s1 * (1.0f / DM), var = fmaxf(s2 * (1.0f / DM) - mean * mean, 0.f), rstd = __builtin_amdgcn_rsqf(var + LN_EPS);
#pragma unroll
            for (int c = 0; c < 12; ++c) LGs[t * 52 + c0 + c] = rstd * (LGs[t * 52 + c0 + c] - mean * SG[c0 + c]) + BB[c0 + c];
            __syncthreads();
            if ((tid_l & 3) == 0) { SS[t * 2] = mean; SS[t * 2 + 1] = rstd; }
        }
        __syncthreads();
        if (lane < 16) {
            const float* lr = LG + lane * 52; const int rl = wave * 16 + lane, t = tbase + lane;
            float gl4[4];
#pragma unroll
            for (int j = 0; j < 4; ++j) gl4[j] = lr[j];
            int grp = 0; float gm = gl4[0];
#pragma unroll
            for (int j = 1; j < 4; ++j) if (gl4[j] > gm) { gm = gl4[j]; grp = j; }
            float gs = 0.f;
#pragma unroll
            for (int j = 0; j < 4; ++j) gs += __expf(gl4[j] - gm);
            const float gwt = __builtin_amdgcn_rcpf(gs);
            float el[8];
#pragma unroll
            for (int j = 0; j < 8; ++j) el[j] = lr[4 + grp * 8 + j];
            int i0 = 0; float m0 = el[0];
#pragma unroll
            for (int j = 1; j < 8; ++j) if (el[j] > m0) { m0 = el[j]; i0 = j; }
            int i1 = -1; float m1 = -INFINITY;
#pragma unroll
            for (int j = 0; j < 8; ++j) if (j != i0 && el[j] > m1) { m1 = el[j]; i1 = j; }
            const float ex = __expf(m1 - m0);
            const float p0 = __builtin_amdgcn_rcpf(1.0f + ex), p1 = ex * p0;
            dec[rl * 2] = grp * 8 + i0; dec[rl * 2 + 1] = grp * 8 + i1;
            if (!DRY) { TOKG[(size_t)t * 2] = gwt * p0; TOKG[(size_t)t * 2 + 1] = gwt * p1; }
        }
        __syncthreads();
        if (tid < 256) rank[tid] = atomicAdd(&lcnt[dec[tid]], 1);
        __syncthreads();
        int mybase = 0;
        if (tid < 32) { int te = tid; asm volatile("" : "+v"(te)); mybase = DRY ? 0 : atomicAdd(&CNT[te * CNT_STRIDE], lcnt[tid]); }
        int lane_l = lane; asm volatile("" : "+v"(lane_l));
        f32x4 g4[4], b4[4];
#pragma unroll
        for (int j = 0; j < 2; ++j) { g4[2 * j] = *(const f32x4*)(lg + 512 * j + 8 * lane_l); g4[2 * j + 1] = *(const f32x4*)(lg + 512 * j + 8 * lane_l + 4);
                                      b4[2 * j] = *(const f32x4*)(lb + 512 * j + 8 * lane_l); b4[2 * j + 1] = *(const f32x4*)(lb + 512 * j + 8 * lane_l + 4); }
#pragma unroll 1
        for (int rg = 0; rg < ((DRY && PROBE_LN == 2) ? 0 : 2); ++rg) {
            const bf16_t* fr = F + (size_t)(tbase + 8 * rg) * DM + 8 * lane_l; bf16_t* xo = XB + (size_t)(tbase + 8 * rg) * DM + 8 * lane_l;
            u32x4 yv[16];
#pragma unroll
            for (int r8 = 0; r8 < 8; ++r8) {
#pragma unroll
                for (int j = 0; j < 2; ++j) yv[2 * r8 + j] = *(const u32x4*)(fr + 512 * j);
                fr += DM; asm volatile("" : "+v"(fr)); }
            __builtin_amdgcn_sched_barrier(0);
#pragma unroll
            for (int r8 = 0; r8 < 8; ++r8) { const int r = 8 * rg + r8;
                const float mu = stat[r * 2], rs = stat[r * 2 + 1];
#pragma unroll
                for (int j = 0; j < 2; ++j) {
                    const u32x4 yw = yv[2 * r8 + j];
                    const f32x4 ya = {bflo(yw.x), bfhi(yw.x), bflo(yw.y), bfhi(yw.y)}, yb = {bflo(yw.z), bfhi(yw.z), bflo(yw.w), bfhi(yw.w)};
                    const f32x4 va = (ya - mu) * rs * g4[2 * j] + b4[2 * j], vb = (yb - mu) * rs * g4[2 * j + 1] + b4[2 * j + 1];
                    u32x4 w; w.x = pk2(va.x, va.y); w.y = pk2(va.z, va.w); w.z = pk2(vb.x, vb.y); w.w = pk2(vb.z, vb.w); *(u32x4*)(xo + 512 * j) = w; }
                xo += DM; asm volatile("" : "+v"(xo)); }
        }
        if (tid < 32) lbase[tid] = mybase;
        __syncthreads();
        if (!DRY && tid < 256) { const int e = dec[tid]; LIST[(size_t)e * LIST_CAP + lbase[e] + rank[tid]] = (rb * 128 + (tid >> 1)) * 2 + (tid & 1); }
        __syncthreads();
    }
}
__device__ __forceinline__ void moe_setup(const Params& P, int* tb, int layer) {
    const int* CNT = (const int*)(P.ws + WS_CTL + CTL_CNT_OFF) + layer * 32 * CNT_STRIDE;
    if (threadIdx.x < 64) {
        const int e = (int)threadIdx.x;
        const int ce = (e < 32) ? CNT[e * CNT_STRIDE] : 0;
        const unsigned tiles = (unsigned)((ce + 255) >> 8);
        const unsigned inc = WAVE_SCAN_DPP(tiles);
        if (e < 32) { tb[e] = (int)(inc - tiles); tb[64 + e] = ce;
            for (unsigned rb = 0; rb < tiles; ++rb) tb[96 + (inc - tiles) + rb] = (e << 8) | (int)rb; }
        if (e == 31) tb[32] = (int)inc;
    }
    __syncthreads();
}
template <bool DRY>
__device__ __forceinline__ void phase_ln2(const Params& P, int layer) {
    const bf16_t* XI = (const bf16_t*)(P.ws + WS_XB); bf16_t* XO = (bf16_t*)(P.ws + (DRY ? WS_XB2 : WS_XB));
    const bf16_t* YS = (const bf16_t*)(P.ws + WS_YS); const float* TOKG = (const float*)(P.ws + WS_TOKG);
    const float* lg = P.in[16] + layer * DM; const float* lb = P.in[17] + layer * DM;
    const int lane = threadIdx.x & 63, gw = blockIdx.x * NWAVE + (threadIdx.x >> 6), NGW = gridDim.x * NWAVE;
    f32x4 g4[4], b4[4];
#pragma unroll
    for (int j = 0; j < 4; ++j) { g4[j] = *(const f32x4*)(lg + 256 * j + 4 * lane); b4[j] = *(const f32x4*)(lb + 256 * j + 4 * lane); }
    u32x2 nx[4], na[4], nb[4]; float ng0 = 0.f, ng1 = 0.f;
    if (gw < NTOK) { const int t = gw;
#pragma unroll
        for (int j = 0; j < 4; ++j) { const int c0 = 256 * j + 4 * lane; nx[j] = *(const u32x2*)(XI + (size_t)t * DM + c0); na[j] = *(const u32x2*)(YS + (size_t)(2 * t) * DM + c0); nb[j] = *(const u32x2*)(YS + (size_t)(2 * t + 1) * DM + c0); }
        ng0 = TOKG[(size_t)t * 2]; ng1 = TOKG[(size_t)t * 2 + 1]; }
    for (int t = gw; t < NTOK; t += NGW) {
        const float g0 = ng0, g1 = ng1;
        u32x2 xw[4], aw[4], bw[4];
#pragma unroll
        for (int j = 0; j < 4; ++j) { xw[j] = nx[j]; aw[j] = na[j]; bw[j] = nb[j]; }
        if (t + NGW < NTOK) { const int tn = t + NGW;
#pragma unroll
            for (int j = 0; j < 4; ++j) { const int c0 = 256 * j + 4 * lane; nx[j] = *(const u32x2*)(XI + (size_t)tn * DM + c0); na[j] = *(const u32x2*)(YS + (size_t)(2 * tn) * DM + c0); nb[j] = *(const u32x2*)(YS + (size_t)(2 * tn + 1) * DM + c0); }
            ng0 = TOKG[(size_t)tn * 2]; ng1 = TOKG[(size_t)tn * 2 + 1]; }
        f32x4 v[4]; float s = 0.f;
#pragma unroll
        for (int j = 0; j < 4; ++j) {
            const u32x2 x = xw[j], a = aw[j], b = bw[j];
            v[j].x = bflo(x.x) * ALPHA + g0 * bflo(a.x) + g1 * bflo(b.x); v[j].y = bfhi(x.x) * ALPHA + g0 * bfhi(a.x) + g1 * bfhi(b.x);
            v[j].z = bflo(x.y) * ALPHA + g0 * bflo(a.y) + g1 * bflo(b.y); v[j].w = bfhi(x.y) * ALPHA + g0 * bfhi(a.y) + g1 * bfhi(b.y);
            s += (v[j].x + v[j].y) + (v[j].z + v[j].w); }
        const float mean = wave_sum(s) * (1.0f / DM); float s2 = 0.f;
#pragma unroll
        for (int j = 0; j < 4; ++j) { v[j] = v[j] - mean; s2 += (v[j].x * v[j].x + v[j].y * v[j].y) + (v[j].z * v[j].z + v[j].w * v[j].w); }
        const float rstd = __builtin_amdgcn_rsqf(wave_sum(s2) * (1.0f / DM) + LN_EPS);
#pragma unroll
        for (int j = 0; j < 4; ++j) { const int c0 = 256 * j + 4 * lane;
            v[j] = v[j] * rstd * g4[j] + b4[j];
            u32x2 w; w.x = pk2(v[j].x, v[j].y); w.y = pk2(v[j].z, v[j].w); *(u32x2*)(XO + (size_t)t * DM + c0) = w; }
    }
}

__device__ __forceinline__ unsigned e5m2enc(float y) {
    const unsigned hb = (unsigned)__builtin_bit_cast(unsigned short, (_Float16)y);
    return ((hb + 0x7fu + ((hb >> 8) & 1u)) >> 8) & 0xffu;
}
__device__ __forceinline__ void phase_norms(const Params& P) {
    const bf16_t* Z1 = (const bf16_t*)(P.ws + WS_Z1); bf16_t* CQ = (bf16_t*)(P.ws + WS_CQ); unsigned char* CKV8 = (unsigned char*)(P.ws + WS_CKV8);
    const float* qn = P.in[8]; const float* kn = P.in[9];
    const int lane = threadIdx.x & 63, gw = blockIdx.x * NWAVE + (threadIdx.x >> 6), NGW = gridDim.x * NWAVE;
    const f32x4 gq = *(const f32x4*)(qn + 4 * lane), gk = *(const f32x4*)(kn + 4 * lane);
    for (int t0 = gw; t0 < NTOK; t0 += 2 * NGW) {
        const int t1 = (t0 + NGW < NTOK) ? t0 + NGW : t0;
        const u32x2 a0 = *(const u32x2*)(Z1 + (size_t)t0 * Z1W + 4 * lane), b0 = *(const u32x2*)(Z1 + (size_t)t0 * Z1W + 256 + 4 * lane);
        const u32x2 a1 = *(const u32x2*)(Z1 + (size_t)t1 * Z1W + 4 * lane), b1 = *(const u32x2*)(Z1 + (size_t)t1 * Z1W + 256 + 4 * lane);
#pragma unroll
        for (int s = 0; s < 2; ++s) {
            const int t = s ? t1 : t0; const u32x2 a = s ? a1 : a0, b = s ? b1 : b0;
            const float q[4] = {bflo(a.x), bfhi(a.x), bflo(a.y), bfhi(a.y)}, k[4] = {bflo(b.x), bfhi(b.x), bflo(b.y), bfhi(b.y)};
            const float sq = wave_sum(q[0] * q[0] + q[1] * q[1] + q[2] * q[2] + q[3] * q[3]), sk = wave_sum(k[0] * k[0] + k[1] * k[1] + k[2] * k[2] + k[3] * k[3]);
            const float rq = __builtin_amdgcn_rsqf(sq * (1.0f / 256.0f) + 1e-6f), rk = __builtin_amdgcn_rsqf(sk * (1.0f / 256.0f) + 1e-6f);
            u32x2 o; o.x = pk2(q[0] * rq * gq.x, q[1] * rq * gq.y); o.y = pk2(q[2] * rq * gq.z, q[3] * rq * gq.w);
            *(u32x2*)(CQ + (size_t)t * 256 + 4 * lane) = o;
            *(unsigned*)(CKV8 + (size_t)t * 256 + 4 * lane) = e5m2enc(k[0] * rk * gk.x) | (e5m2enc(k[1] * rk * gk.y) << 8) | (e5m2enc(k[2] * rk * gk.z) << 16) | (e5m2enc(k[3] * rk * gk.w) << 24);
        }
    }
}


constexpr int NPH_TOTAL = 23;


typedef short v4i16_t __attribute__((ext_vector_type(4)));


__device__ __forceinline__ void glds16(const void* gsrc, unsigned lds_dst) {
    unsigned keep;
    asm volatile("s_mov_b32 %0, m0\n\ts_mov_b32 m0, %2\n\ts_nop 0\n\tglobal_load_lds_dwordx4 %1, off\n\ts_mov_b32 m0, %0" : "=&s"(keep) : "v"(gsrc), "s"(lds_dst) : "memory");
}
__device__ __forceinline__ void glds16_set(const void* gsrc, unsigned lds_dst) {
    asm volatile("s_mov_b32 m0, %1\n\ts_nop 0\n\tglobal_load_lds_dwordx4 %0, off" : : "v"(gsrc), "s"(lds_dst) : "memory", "m0");
}
template <int OFF> __device__ __forceinline__ void glds16_m0(const void* gsrc) {
    asm volatile("global_load_lds_dwordx4 %0, off offset:%1" : : "v"(gsrc), "n"(OFF) : "memory");
}
__device__ __forceinline__ void glds16s_set(const void* sbase, unsigned voff, unsigned lds_dst) {
    asm volatile("s_mov_b32 m0, %2\n\ts_nop 0\n\tglobal_load_lds_dwordx4 %0, %1" : : "v"(voff), "s"(sbase), "s"(lds_dst) : "memory", "m0");
}
template <int OFF> __device__ __forceinline__ void glds16s_m0(const void* sbase, unsigned voff) {
    asm volatile("global_load_lds_dwordx4 %0, %1 offset:%2" : : "v"(voff), "s"(sbase), "n"(OFF) : "memory");
}
typedef _Float16 f16x8 __attribute__((ext_vector_type(8)));
typedef int v8i_t __attribute__((ext_vector_type(8)));
template <bool DRY>
__device__ __forceinline__ void phase_sparse_attn_e(const Params& P, unsigned char* lds_) {
    const unsigned char* QA = (const unsigned char*)(P.ws + WS_QA); bf16_t* OLAT = (bf16_t*)(P.ws + WS_OLAT); const unsigned char* CKV8 = (const unsigned char*)(P.ws + WS_CKV8); const unsigned short* SEL = (const unsigned short*)(P.ws + WS_SEL);
    const int tid = threadIdx.x, lane = tid & 63, wave = __builtin_amdgcn_readfirstlane(tid >> 6);
    const int fr = lane & 15, fq = lane >> 4;
    LAS unsigned char* cbuf = (LAS unsigned char*)lds_ + wave * 17920;
    LAS unsigned short* selw = (LAS unsigned short*)(cbuf + 16384);
    LAS unsigned* selo = (LAS unsigned*)(cbuf + 16384 + 512);
    LAS unsigned* selo_st = selo + (lane >> 3) * 32 + (lane & 7);
    const unsigned cbuf0 = (unsigned)(unsigned long)cbuf;
    const int G = gridDim.x, NGW = G * NWAVE;
    int vw;
    if ((G & 7) == 0) vw = (((int)blockIdx.x & 7) * (G >> 3) + ((int)blockIdx.x >> 3)) * NWAVE + wave; else vw = (int)blockIdx.x * NWAVE + wave;
    const float LOG2E = 1.4426950408889634f;
    const float slope2 = exp2f(-0.5f * (float)(fr + 1)) * LOG2E;
    unsigned qoffB[4];
#pragma unroll
    for (int e = 0; e < 4; ++e) { const int r15 = (4 * e + fq) & 15; qoffB[e] = (unsigned)((fr ^ (((r15 & 7) << 1) | (r15 >> 3))) << 4); }
    unsigned qoffS[4];
#pragma unroll
    for (int e = 0; e < 4; ++e) qoffS[e] = qoffB[e] + 3072u - 1024u * e;
    const unsigned fA = (unsigned)(((fr & 7) << 1) | (fr >> 3));
    unsigned pA[4];
#pragma unroll
    for (int i = 0; i < 4; ++i) pA[i] = (unsigned)fr * 256u + ((((unsigned)(8 * (i >> 1) + 2 * fq + (i & 1))) ^ fA) << 4);
    const int rT = 4 * fq + (fr >> 2), pT_ = fr & 3;
    const unsigned fT = (unsigned)(((rT & 7) << 1) | (rT >> 3));
    const unsigned ST = (fT & 14u) << 4, baseT = (unsigned)rT * 256u + ((((unsigned)pT_ >> 1) ^ (fT & 1u)) << 4) + ((unsigned)pT_ & 1u) * 8u;
    const int per = NGW >> 2, bq = vw / per, wb = vw % per;
    int ditem = DRY ? N_DEFERRED : vw;
    u32x2 selnext = {0u, 0u}; u32x4 qfn[4];
    if (wb < SEQ) { const int t0 = bq * SEQ + wb; selnext = *(const u32x2*)(SEL + (size_t)t0 * TOPK + 4 * lane);
#pragma unroll
        for (int i = 0; i < 4; ++i) qfn[i] = *(const u32x4*)(QA + (size_t)t0 * 4096 + fr * 256 + 128 * (i >> 1) + 32 * fq + 16 * (i & 1)); }
    for (int tl0 = wb; tl0 < SEQ; tl0 += per) {
        const int t = bq * SEQ + tl0;
        const int b = t >> 13, tl = t & (SEQ - 1), ns = min(tl + 1, TOPK), nch = (ns + 31) >> 5;
        const bool has_nextq = (tl0 + per < SEQ);
        asm volatile("s_waitcnt vmcnt(0)" ::: "memory");
        {
            const u32x2 w = selnext;
            unsigned short i0 = (unsigned short)(w.x & 0xffffu), i1 = (unsigned short)(w.x >> 16), i2 = (unsigned short)(w.y & 0xffffu), i3 = (unsigned short)(w.y >> 16);
            const int k0 = 4 * lane;
            if (k0 >= ns) i0 = 0; if (k0 + 1 >= ns) i1 = 0; if (k0 + 2 >= ns) i2 = 0; if (k0 + 3 >= ns) i3 = 0;
            u32x2 o; o.x = (unsigned)i0 | ((unsigned)i1 << 16); o.y = (unsigned)i2 | ((unsigned)i3 << 16);
            asm volatile("s_waitcnt lgkmcnt(0)" ::: "memory");
            *(LAS u32x2*)(selw + 4 * lane) = o;
            selo_st[0] = (unsigned)i0 << 8; selo_st[8] = (unsigned)i1 << 8; selo_st[16] = (unsigned)i2 << 8; selo_st[24] = (unsigned)i3 << 8;
        }
        v8i_t qB[2];
#pragma unroll
        for (int hb = 0; hb < 2; ++hb) { const u32x4 q0 = qfn[2 * hb], q1 = qfn[2 * hb + 1];
            qB[hb][0] = (int)q0.x; qB[hb][1] = (int)q0.y; qB[hb][2] = (int)q0.z; qB[hb][3] = (int)q0.w; qB[hb][4] = (int)q1.x; qB[hb][5] = (int)q1.y; qB[hb][6] = (int)q1.z; qB[hb][7] = (int)q1.w; }
#define ATT_PREFETCH() do { if (has_nextq) { const int tn_ = t + per; selnext = *(const u32x2*)(SEL + (size_t)tn_ * TOPK + 4 * lane); \
            _Pragma("unroll") for (int i = 0; i < 4; ++i) qfn[i] = *(const u32x4*)(QA + (size_t)tn_ * 4096 + fr * 256 + 128 * (i >> 1) + 32 * fq + 16 * (i & 1)); pf = true; } } while (0)
        f32x4 Oe[8], Oo[8];
#pragma unroll
        for (int ut = 0; ut < 8; ++ut) { Oe[ut] = (f32x4){0.f, 0.f, 0.f, 0.f}; Oo[ut] = (f32x4){0.f, 0.f, 0.f, 0.f}; }
        float m = -INFINITY, l = 0.f;
        const unsigned char* cb = CKV8 + (size_t)b * SEQ * 256;
        asm volatile("s_waitcnt vmcnt(0) lgkmcnt(0)" ::: "memory");
        const unsigned char* cbs = cb - 3072;
#define ATT_DMA(jj, bufoff) do { u32x4 oa_ = *(const LAS u32x4*)(selo + 32 * (jj) + 8 * fq), ob_ = *(const LAS u32x4*)(selo + 32 * (jj) + 8 * fq + 4); \
            if (DRY && PROBE_ATT == 1) { oa_ = (u32x4){0u, 256u, 512u, 768u}; ob_ = oa_; } \
            if (!(DRY && PROBE_ATT == 3)) { \
                glds16s_set(cbs, oa_.x + qoffS[0], (unsigned)__builtin_amdgcn_readfirstlane((int)(cbuf0 + (bufoff)))); \
                glds16s_m0<1024>(cbs, oa_.y + qoffS[1]); glds16s_m0<2048>(cbs, oa_.z + qoffS[2]); glds16s_m0<3072>(cbs, oa_.w + qoffS[3]); \
                glds16s_set(cbs, ob_.x + qoffS[0], (unsigned)__builtin_amdgcn_readfirstlane((int)(cbuf0 + (bufoff) + 4096))); \
                glds16s_m0<1024>(cbs, ob_.y + qoffS[1]); glds16s_m0<2048>(cbs, ob_.z + qoffS[2]); glds16s_m0<3072>(cbs, ob_.w + qoffS[3]); } } while (0)
        ATT_DMA(0, 0);
        if (nch > 1) ATT_DMA(1, 8192);
        const bool have_item = ditem < N_DEFERRED;
        TrItem titem = deferred_item(P, have_item ? ditem : 0);
        float tcur[32];
        bool trf = false, pf = false;
        if (nch <= 2) { if (have_item) { tr_load(titem, lane, tcur); trf = true; } ATT_PREFETCH(); }
        for (int j = 0; j < nch; ++j) {
            const unsigned bo = (unsigned)(j & 1) * 8192u;
            if (j + 1 < nch) { if (trf && pf) asm volatile("s_waitcnt vmcnt(21)" ::: "memory"); else if (trf) asm volatile("s_waitcnt vmcnt(16)" ::: "memory");
                               else if (pf) asm volatile("s_waitcnt vmcnt(13)" ::: "memory"); else asm volatile("s_waitcnt vmcnt(8)" ::: "memory"); }
            else { if (trf && pf) asm volatile("s_waitcnt vmcnt(13)" ::: "memory"); else if (trf) asm volatile("s_waitcnt vmcnt(8)" ::: "memory");
                   else if (pf) asm volatile("s_waitcnt vmcnt(5)" ::: "memory"); else asm volatile("s_waitcnt vmcnt(0)" ::: "memory"); }
            const LAS unsigned char* img = cbuf + bo;
            if (DRY && PROBE_ATT == 2) { if (j + 2 < nch) { asm volatile("s_waitcnt lgkmcnt(0)" ::: "memory"); ATT_DMA(j + 2, bo); } continue; }
            f32x4 s0 = {0.f, 0.f, 0.f, 0.f}, s1 = {0.f, 0.f, 0.f, 0.f};
#pragma unroll
            for (int hb = 0; hb < 2; ++hb) {
                const LAS unsigned char* p0 = img + pA[2 * hb]; const LAS unsigned char* p1 = img + pA[2 * hb + 1];
                const u32x4 a0 = *(const LAS u32x4*)(p0), a1 = *(const LAS u32x4*)(p1), b0 = *(const LAS u32x4*)(p0 + 4096), b1 = *(const LAS u32x4*)(p1 + 4096);
                __builtin_amdgcn_sched_barrier(0);
                v8i_t A0, A1;
                A0[0] = (int)a0.x; A0[1] = (int)a0.y; A0[2] = (int)a0.z; A0[3] = (int)a0.w; A0[4] = (int)a1.x; A0[5] = (int)a1.y; A0[6] = (int)a1.z; A0[7] = (int)a1.w;
                A1[0] = (int)b0.x; A1[1] = (int)b0.y; A1[2] = (int)b0.z; A1[3] = (int)b0.w; A1[4] = (int)b1.x; A1[5] = (int)b1.y; A1[6] = (int)b1.z; A1[7] = (int)b1.w;
                s0 = __builtin_amdgcn_mfma_scale_f32_16x16x128_f8f6f4(A0, qB[hb], s0, 1, 0, 0, 0, 0, 0);
                s1 = __builtin_amdgcn_mfma_scale_f32_16x16x128_f8f6f4(A1, qB[hb], s1, 1, 0, 0, 0, 0, 0);
                __builtin_amdgcn_sched_barrier(0);
            }
            const u32x2 k0w = *(const LAS u32x2*)(selw + 32 * j + 4 * fq), k1w = *(const LAS u32x2*)(selw + 32 * j + 16 + 4 * fq);
            u32x2 tl_[4], th_[4];
#pragma unroll
            for (int ut = 0; ut < 4; ++ut) { const LAS unsigned char* pt = img + ((ST ^ (unsigned)(ut << 5)) + baseT);
                tl_[ut] = __builtin_bit_cast(u32x2, __builtin_amdgcn_ds_read_tr16_b64_v4i16((LAS v4i16_t*)(pt)));
                th_[ut] = __builtin_bit_cast(u32x2, __builtin_amdgcn_ds_read_tr16_b64_v4i16((LAS v4i16_t*)(pt + 4096))); }
            __builtin_amdgcn_sched_barrier(0);
            const int rem = ns - (32 * j + 4 * fq);
            float lg[8];
            {
                const int i00 = (int)(k0w.x & 0xffffu), i01 = (int)(k0w.x >> 16), i02 = (int)(k0w.y & 0xffffu), i03 = (int)(k0w.y >> 16);
                const int i10 = (int)(k1w.x & 0xffffu), i11 = (int)(k1w.x >> 16), i12 = (int)(k1w.y & 0xffffu), i13 = (int)(k1w.y >> 16);
                lg[0] = (0 < rem) ? s0.x * LOG2E - slope2 * (float)(tl - i00) : -INFINITY;
                lg[1] = (1 < rem) ? s0.y * LOG2E - slope2 * (float)(tl - i01) : -INFINITY;
                lg[2] = (2 < rem) ? s0.z * LOG2E - slope2 * (float)(tl - i02) : -INFINITY;
                lg[3] = (3 < rem) ? s0.w * LOG2E - slope2 * (float)(tl - i03) : -INFINITY;
                lg[4] = (16 < rem) ? s1.x * LOG2E - slope2 * (float)(tl - i10) : -INFINITY;
                lg[5] = (17 < rem) ? s1.y * LOG2E - slope2 * (float)(tl - i11) : -INFINITY;
                lg[6] = (18 < rem) ? s1.z * LOG2E - slope2 * (float)(tl - i12) : -INFINITY;
                lg[7] = (19 < rem) ? s1.w * LOG2E - slope2 * (float)(tl - i13) : -INFINITY;
            }
            const float cm = fmaxf(fmaxf(fmaxf(lg[0], lg[1]), fmaxf(lg[2], lg[3])), fmaxf(fmaxf(lg[4], lg[5]), fmaxf(lg[6], lg[7])));
            if (j == 0) { float cx = fmaxf(cm, __shfl_xor(cm, 16)); m = fmaxf(cx, __shfl_xor(cx, 32)); }
            else if (__any(cm > m + 8.0f)) {
                float cx = fmaxf(cm, __shfl_xor(cm, 16)); cx = fmaxf(cx, __shfl_xor(cx, 32));
                const float mn = fmaxf(m, cx);
                const float sc = __builtin_amdgcn_exp2f(m - mn);
                l *= sc;
#pragma unroll
                for (int ut = 0; ut < 8; ++ut) { Oe[ut] *= sc; Oo[ut] *= sc; }
                m = mn;
            }
            float p[8]; float ps = 0.f;
#pragma unroll
            for (int i = 0; i < 8; ++i) { p[i] = __builtin_amdgcn_exp2f(lg[i] - m); ps += p[i]; }
            l += ps;
            int pw0 = __builtin_amdgcn_cvt_pk_fp8_f32(p[0], p[1], 0, false); pw0 = __builtin_amdgcn_cvt_pk_fp8_f32(p[2], p[3], pw0, true);
            int pw1 = __builtin_amdgcn_cvt_pk_fp8_f32(p[4], p[5], 0, false); pw1 = __builtin_amdgcn_cvt_pk_fp8_f32(p[6], p[7], pw1, true);
            const long pk = __builtin_bit_cast(long, (u32x2){(unsigned)pw0, (unsigned)pw1});
#pragma unroll
            for (int hb = 0; hb < 2; ++hb) {
                if (hb == 1) {
#pragma unroll
                    for (int u4 = 0; u4 < 4; ++u4) { const int ut = 4 + u4; const LAS unsigned char* pt = img + ((ST ^ (unsigned)(ut << 5)) + baseT);
                        tl_[u4] = __builtin_bit_cast(u32x2, __builtin_amdgcn_ds_read_tr16_b64_v4i16((LAS v4i16_t*)(pt)));
                        th_[u4] = __builtin_bit_cast(u32x2, __builtin_amdgcn_ds_read_tr16_b64_v4i16((LAS v4i16_t*)(pt + 4096))); }
                    __builtin_amdgcn_sched_barrier(0);
                }
#pragma unroll
                for (int u4 = 0; u4 < 4; ++u4) { const int ut = hb * 4 + u4;
                    const u32x2 lw = tl_[u4], hw = th_[u4];
                    u32x2 ae, ao;
                    ae.x = __builtin_amdgcn_perm(lw.y, lw.x, 0x06040200u); ae.y = __builtin_amdgcn_perm(hw.y, hw.x, 0x06040200u);
                    ao.x = __builtin_amdgcn_perm(lw.y, lw.x, 0x07050301u); ao.y = __builtin_amdgcn_perm(hw.y, hw.x, 0x07050301u);
                    Oe[ut] = __builtin_amdgcn_mfma_f32_16x16x32_bf8_fp8(__builtin_bit_cast(long, ae), pk, Oe[ut], 0, 0, 0);
                    Oo[ut] = __builtin_amdgcn_mfma_f32_16x16x32_bf8_fp8(__builtin_bit_cast(long, ao), pk, Oo[ut], 0, 0, 0);
                }
                __builtin_amdgcn_sched_barrier(0);
            }
            if (j + 2 < nch) { asm volatile("s_waitcnt lgkmcnt(0)" ::: "memory"); ATT_DMA(j + 2, bo);
                if (j + 3 == nch) { if (have_item) { tr_load(titem, lane, tcur); trf = true; } ATT_PREFETCH(); } }
        }
#undef ATT_DMA
#undef ATT_PREFETCH
        l += __shfl_xor(l, 16); l += __shfl_xor(l, 32);
        const float inv = __builtin_amdgcn_rcpf(l);
        bf16_t* orow = (DRY ? (bf16_t*)(P.ws + WS_PP) + (size_t)(t & 8191) * 4096 : OLAT + (size_t)t * 4096) + fr * 256 + 8 * fq;
#pragma unroll
        for (int ut = 0; ut < 8; ++ut) {
            u32x4 w; w.x = pk2(Oe[ut].x * inv, Oo[ut].x * inv); w.y = pk2(Oe[ut].y * inv, Oo[ut].y * inv); w.z = pk2(Oe[ut].z * inv, Oo[ut].z * inv); w.w = pk2(Oe[ut].w * inv, Oo[ut].w * inv);
            *(u32x4*)(orow + 32 * ut) = w;
        }
        if (have_item) { asm volatile("s_waitcnt lgkmcnt(0)" ::: "memory"); tr_store(titem, (float*)(lds_ + wave * 17920), lane, tcur); ditem += NGW; }
    }
    int lane_l = lane; asm volatile("" : "+v"(lane_l));
    for (; ditem < N_DEFERRED; ditem += NGW) { const TrItem t = deferred_item(P, ditem); float tmp[32]; tr_load(t, lane_l, tmp); tr_store(t, (float*)(lds_ + wave * 17920), lane_l, tmp); }
}

constexpr size_t SC_BATCH = (size_t)1024 * 256 * 257 / 2;
__device__ __forceinline__ size_t sc_row_off(int b, int tl) { const size_t m = (size_t)(tl >> 5); return (size_t)b * SC_BATCH + 1024 * (m * (m + 1) / 2) + (size_t)(tl & 31) * 32 * (m + 1); }
typedef float f32x16 __attribute__((ext_vector_type(16)));
__device__ __forceinline__ unsigned okey_pk(float a, float b) {
    const unsigned w = __builtin_bit_cast(unsigned, __builtin_amdgcn_cvt_pkrtz(a, b));
    typedef short s16x2_t __attribute__((ext_vector_type(2)));
    const unsigned sm = __builtin_bit_cast(unsigned, (s16x2_t)(__builtin_bit_cast(s16x2_t, w) >> (s16x2_t){15, 15}));
    return w ^ (sm | 0x80008000u);
}
__device__ __forceinline__ void phase_index_scores(const Params& P, unsigned char* lds_) {
    using pg8::bf16x8;
    const bf16_t* Z1 = (const bf16_t*)(P.ws + WS_Z1); unsigned short* SC = (unsigned short*)(P.ws + WS_SC);
    LAS unsigned char* lds = (LAS unsigned char*)lds_;
    constexpr int QROW = 144;
    LAS unsigned char* QL = lds;
    LAS float* SG = (LAS float*)(lds + 9 * 64 * QROW);
    const int tid = threadIdx.x, lane = tid & 63, wave = __builtin_amdgcn_readfirstlane(tid >> 6);
    LAS unsigned char* ST = lds + 9 * 64 * QROW + 2048 + wave * 5120;
    const int l31 = lane & 31, hh = lane >> 5;
    for (int pid = blockIdx.x; pid < 256; pid += gridDim.x) {
        const int b = pid >> 6;
        for (int side = 0; side < 2; ++side) {
            const int qb = side ? (127 - (pid & 63)) : (pid & 63);
            const int q0 = qb * 64;
            __syncthreads();
            {
                const int qi = tid >> 3, part = tid & 7;
                const bf16_t* zr = Z1 + ((size_t)b * SEQ + q0 + qi) * Z1W;
                const u32x4 ww = *(const u32x4*)(zr + 1088);
                const float w8[8] = {bflo(ww.x), bfhi(ww.x), bflo(ww.y), bfhi(ww.y), bflo(ww.z), bfhi(ww.z), bflo(ww.w), bfhi(ww.w)};
                float wh = 0.f;
#pragma unroll
                for (int h = 0; h < 8; ++h) wh = (h == part) ? w8[h] : wh;
                const float sc = 0.5f * fabsf(wh);
                SG[qi * 8 + part] = (wh >= 0.f) ? 1.0f : -1.0f;
#pragma unroll
                for (int c = 0; c < 8; ++c) {
                    const u32x4 v = *(const u32x4*)(zr + 512 + part * 64 + c * 8);
                    u32x4 o; o.x = pk2(bflo(v.x) * sc, bfhi(v.x) * sc); o.y = pk2(bflo(v.y) * sc, bfhi(v.y) * sc); o.z = pk2(bflo(v.z) * sc, bfhi(v.z) * sc); o.w = pk2(bflo(v.w) * sc, bfhi(v.w) * sc);
                    *(LAS u32x4*)(QL + (part * 64 + qi) * QROW + c * 16) = o;
                }
                float a8[8];
#pragma unroll
                for (int j = 0; j < 8; ++j) a8[j] = 0.f;
#pragma unroll
                for (int h = 0; h < 8; ++h) {
                    const u32x4 v = *(const u32x4*)(zr + 512 + h * 64 + part * 8); const float s2 = 0.5f * w8[h];
                    a8[0] += s2 * bflo(v.x); a8[1] += s2 * bfhi(v.x); a8[2] += s2 * bflo(v.y); a8[3] += s2 * bfhi(v.y);
                    a8[4] += s2 * bflo(v.z); a8[5] += s2 * bfhi(v.z); a8[6] += s2 * bflo(v.w); a8[7] += s2 * bfhi(v.w);
                }
                u32x4 o; o.x = pk2(a8[0], a8[1]); o.y = pk2(a8[2], a8[3]); o.z = pk2(a8[4], a8[5]); o.w = pk2(a8[6], a8[7]);
                *(LAS u32x4*)(QL + (8 * 64 + qi) * QROW + part * 16) = o;
            }
            __syncthreads();
            const int ktmax = 2 * qb + 1;
            bf16x8 kn[4];
            {   const bf16_t* kr = Z1 + ((size_t)b * SEQ + min(wave, ktmax) * 32 + l31) * Z1W + 1024 + hh * 8;
#pragma unroll
                for (int dq = 0; dq < 4; ++dq) kn[dq] = *(const bf16x8*)(kr + dq * 16); }
            for (int kt = wave; kt <= ktmax; kt += NWAVE) {
                bf16x8 kf[4];
#pragma unroll
                for (int dq = 0; dq < 4; ++dq) kf[dq] = kn[dq];
                {   const bf16_t* kr = Z1 + ((size_t)b * SEQ + min(kt + NWAVE, ktmax) * 32 + l31) * Z1W + 1024 + hh * 8;
#pragma unroll
                    for (int dq = 0; dq < 4; ++dq) kn[dq] = *(const bf16x8*)(kr + dq * 16); }
#pragma unroll
                for (int qs = 0; qs < 2; ++qs) {
                    const LAS unsigned char* qrow = QL + (qs * 32 + l31) * QROW + hh * 16;
                    const LAS float* sgp = SG + (qs * 32 + l31) * 8;
                    bf16x8 fc[4], fn[4];
#pragma unroll
                    for (int dq = 0; dq < 4; ++dq) fc[dq] = *(const LAS bf16x8*)(qrow + 8 * 64 * QROW + dq * 32);
#pragma unroll
                    for (int dq = 0; dq < 4; ++dq) fn[dq] = *(const LAS bf16x8*)(qrow + dq * 32);
                    const f32x4 sg03 = *(const LAS f32x4*)(sgp), sg47 = *(const LAS f32x4*)(sgp + 4);
                    f32x16 acc;
#pragma unroll
                    for (int r = 0; r < 16; ++r) acc[r] = 0.f;
#pragma unroll
                    for (int dq = 0; dq < 4; ++dq) acc = __builtin_amdgcn_mfma_f32_32x32x16_bf16(kf[dq], fc[dq], acc, 0, 0, 0);
                    f32x16 up;
#pragma unroll
                    for (int h = 0; h < 8; ++h) {
#pragma unroll
                        for (int dq = 0; dq < 4; ++dq) fc[dq] = fn[dq];
                        if (h < 7) {
#pragma unroll
                            for (int dq = 0; dq < 4; ++dq) fn[dq] = *(const LAS bf16x8*)(qrow + (h + 1) * 64 * QROW + dq * 32);
                        }
                        f32x16 u;
#pragma unroll
                        for (int r = 0; r < 16; ++r) u[r] = 0.f;
#pragma unroll
                        for (int dq = 0; dq < 4; ++dq) u = __builtin_amdgcn_mfma_f32_32x32x16_bf16(kf[dq], fc[dq], u, 0, 0, 0);
                        __builtin_amdgcn_sched_barrier(0);
                        if (h > 0) {
                            const float sg = (h - 1 < 4) ? sg03[(h - 1) & 3] : sg47[(h - 1) & 3];
#pragma unroll
                            for (int r = 0; r < 16; ++r) acc[r] = fmaf(fabsf(up[r]), sg, acc[r]);
                        }
                        __builtin_amdgcn_sched_barrier(0);
                        up = u;
                    }
                    {
                        const float sg = sg47[3];
#pragma unroll
                        for (int r = 0; r < 16; ++r) acc[r] = fmaf(fabsf(up[r]), sg, acc[r]);
                    }
#pragma unroll
                    for (int g = 0; g < 4; ++g) { u32x2 w; w.x = okey_pk(acc[4 * g], acc[4 * g + 1]); w.y = okey_pk(acc[4 * g + 2], acc[4 * g + 3]);
                        *(LAS u32x2*)(ST + (qs * 32 + l31) * 80 + (8 * g + 4 * hh) * 2) = w; }
                }
#pragma unroll
                for (int i = 0; i < 4; ++i) {
                    const int row = 16 * i + (lane >> 2), ch = lane & 3, tl = q0 + row;
                    const u32x4 v = *(const LAS u32x4*)(ST + row * 80 + ch * 16);
                    if (kt <= (tl >> 5)) *(u32x4*)(SC + sc_row_off(b, tl) + (size_t)kt * 32 + ch * 8) = v;
                }
            }
        }
    }
}
template <int MODE>
__device__ __forceinline__ void phase_index_select(const Params& P, unsigned char* lds_) {
    const unsigned short* SC = (const unsigned short*)(P.ws + WS_SC); unsigned short* SEL = (unsigned short*)(P.ws + WS_SEL);
    const int tid = threadIdx.x, lane = tid & 63, wave = __builtin_amdgcn_readfirstlane(tid >> 6);
    LAS unsigned char* wbase = (LAS unsigned char*)lds_ + wave * 19456;
    LAS u32x4* rowbuf = (LAS u32x4*)wbase;
    LAS unsigned* hist = (LAS unsigned*)(wbase + 16384);
    LAS unsigned* dummy = hist + 512 + lane;
    LAS unsigned short* outw = (LAS unsigned short*)(wbase + 16384 + 2048 + 256);
    LAS unsigned short* dummy16 = outw + 256 + lane;
    const unsigned rowbuf0 = (unsigned)(unsigned long)wbase;
    const int gw = blockIdx.x * NWAVE + wave, NGW = gridDim.x * NWAVE;
#define SEL_DMA(tt) do { const int _tl = (tt) & (SEQ - 1), _n = _tl + 1; if (_n > TOPK) { const unsigned char* _src = (const unsigned char*)(SC + sc_row_off((tt) >> 13, _tl)) + lane * 16; \
            for (int _g = 0; _g * 2048 < _n; ++_g) {        \
                const unsigned char* _p = _src + _g * 4096; \
                glds16_set(_p, (unsigned)__builtin_amdgcn_readfirstlane((int)(rowbuf0 + _g * 4096))); \
                if ((4 * _g + 1) * 512 < _n) glds16_m0<1024>(_p); if ((4 * _g + 2) * 512 < _n) glds16_m0<2048>(_p); if ((4 * _g + 3) * 512 < _n) glds16_m0<3072>(_p); } } } while (0)
#define SEL_Q(i) ((i) * NGW + (((i) & 1) ? (NGW - 1 - gw) : gw))
    if (SEL_Q(0) < NTOK) SEL_DMA(SEL_Q(0));
    for (int qi = 0; qi * NGW < NTOK; ++qi) {
        const int t = SEL_Q(qi), tnext = SEL_Q(qi + 1);
        if (t >= NTOK) { if (tnext < NTOK) SEL_DMA(tnext); continue; }
        const int tl = t & (SEQ - 1), n = tl + 1;
        unsigned short* so = SEL + (size_t)t * TOPK;
        if (n <= TOPK) { for (int i = lane; i < n; i += 64) so[i] = (unsigned short)i; if (tnext < NTOK && (qi + 1) * NGW < NTOK) SEL_DMA(tnext); continue; }
        asm volatile("s_waitcnt vmcnt(0)" ::: "memory");
        u32x4 d[16];
        const int lastsg = (n - 1) >> 9;
#pragma unroll
        for (int sg = 0; sg < 16; ++sg) {
            if (sg * 512 < n) {
                d[sg] = rowbuf[sg * 64 + lane];
                if (sg == lastsg) {
#pragma unroll
                    for (int q = 0; q < 4; ++q) { const int i0 = sg * 512 + lane * 8 + 2 * q;
                        d[sg][q] &= ((i0 < n) ? 0x0000ffffu : 0u) | ((i0 + 1 < n) ? 0xffff0000u : 0u); }
                }
            } else d[sg] = (u32x4){0u, 0u, 0u, 0u};
        }
        asm volatile("s_waitcnt lgkmcnt(0)" ::: "memory");
        if (tnext < NTOK && (qi + 1) * NGW < NTOK) SEL_DMA(tnext);
#pragma unroll
        for (int i = 0; i < 8; ++i) { hist[i * 64 + lane] = 0u; }
        asm volatile("s_waitcnt lgkmcnt(0)" ::: "memory");
        LAS unsigned* myh = hist + (lane & 1) * 256;
        if (MODE == 4) { if (d[0].x == 0x12345u) so[lane] = 1; continue; }
#pragma unroll
        for (int sg = 0; sg < 16; ++sg) if (MODE != 1 && sg * 512 < n) {
#pragma unroll
            for (int q = 0; q < 4; ++q) { const unsigned w = d[sg][q];
                __hip_atomic_fetch_add(myh + ((w >> 8) & 0xffu), 1u, __ATOMIC_RELAXED, __HIP_MEMORY_SCOPE_WORKGROUP);
                __hip_atomic_fetch_add(myh + (w >> 24), 1u, __ATOMIC_RELAXED, __HIP_MEMORY_SCOPE_WORKGROUP); }
        }
        asm volatile("s_waitcnt lgkmcnt(0)" ::: "memory");
        unsigned b1, need1;
        {
            unsigned c[4];
#pragma unroll
            for (int q = 0; q < 4; ++q) c[q] = hist[4 * lane + q] + hist[256 + 4 * lane + q];
            const unsigned mine = c[0] + c[1] + c[2] + c[3];
            unsigned suf = mine;
#pragma unroll
            for (int o = 1; o < 64; o <<= 1) { const unsigned v = __shfl_down(suf, o); if (lane + o < 64) suf += v; }
            const unsigned above = suf - mine;
            int fb = -1; unsigned fneed = 0;
            if (above < (unsigned)TOPK && suf >= (unsigned)TOPK) { unsigned a = above;
#pragma unroll
                for (int q = 3; q >= 0; --q) { if (fb < 0 && a + c[q] >= (unsigned)TOPK) { fb = 4 * lane + q; fneed = (unsigned)TOPK - a; } a += c[q]; } }
            const unsigned long long bal = __ballot(fb >= 0);
            const int src = (int)__builtin_ctzll(bal);
            b1 = (unsigned)__shfl(fb, src); need1 = __shfl(fneed, src);
        }
#pragma unroll
        for (int i = 0; i < 8; ++i) { hist[i * 64 + lane] = 0u; }
        asm volatile("s_waitcnt lgkmcnt(0)" ::: "memory");
#pragma unroll
        for (int sg = 0; sg < 16; ++sg) if (MODE != 2 && sg * 512 < n) {
#pragma unroll
            for (int q = 0; q < 4; ++q) { const unsigned w = d[sg][q];
                LAS unsigned* p0 = (((w >> 8) & 0xffu) == b1) ? (myh + (w & 0xffu)) : dummy;
                LAS unsigned* p1 = ((w >> 24) == b1) ? (myh + ((w >> 16) & 0xffu)) : dummy;
                __hip_atomic_fetch_add(p0, 1u, __ATOMIC_RELAXED, __HIP_MEMORY_SCOPE_WORKGROUP);
                __hip_atomic_fetch_add(p1, 1u, __ATOMIC_RELAXED, __HIP_MEMORY_SCOPE_WORKGROUP); }
        }
        asm volatile("s_waitcnt lgkmcnt(0)" ::: "memory");
        unsigned T, need2;
        {
            unsigned c[4];
#pragma unroll
            for (int q = 0; q < 4; ++q) c[q] = hist[4 * lane + q] + hist[256 + 4 * lane + q];
            const unsigned mine = c[0] + c[1] + c[2] + c[3];
            unsigned suf = mine;
#pragma unroll
            for (int o = 1; o < 64; o <<= 1) { const unsigned v = __shfl_down(suf, o); if (lane + o < 64) suf += v; }
            const unsigned above = suf - mine;
            int fb = -1; unsigned fneed = 0;
            if (above < need1 && suf >= need1) { unsigned a = above;
#pragma unroll
                for (int q = 3; q >= 0; --q) { if (fb < 0 && a + c[q] >= need1) { fb = 4 * lane + q; fneed = need1 - a; } a += c[q]; } }
            const unsigned long long bal = __ballot(fb >= 0);
            const int src = (int)__builtin_ctzll(bal);
            T = (b1 << 8) | (unsigned)__shfl(fb, src); need2 = __shfl(fneed, src);
        }
        unsigned base = 0; const unsigned ngt = (unsigned)TOPK - need2; unsigned eqbase = 0;
#pragma unroll
        for (int sg = 0; sg < 16; ++sg) if (MODE != 3 && sg * 512 < n) {
            unsigned ce = 0;
#pragma unroll
            for (int j = 0; j < 8; ++j) {
                const unsigned k = (j & 1) ? (d[sg][j >> 1] >> 16) : (d[sg][j >> 1] & 0xffffu);
                const bool gt = k > T;
                const unsigned long long mk = __ballot(gt);
                const unsigned pos = base + (unsigned)__builtin_amdgcn_mbcnt_hi((unsigned)(mk >> 32), __builtin_amdgcn_mbcnt_lo((unsigned)mk, 0u));
                LAS unsigned short* po = gt ? (outw + pos) : dummy16;
                *po = (unsigned short)(sg * 512 + lane * 8 + j);
                base += (unsigned)__builtin_popcountll(mk);
                ce += (k == T) ? 1u : 0u;
            }
            if (__any(ce > 0u)) {
                unsigned pre = ce;
#pragma unroll
                for (int o = 1; o < 64; o <<= 1) { const unsigned v = __shfl_up(pre, o); if (lane >= o) pre += v; }
                unsigned r = eqbase + pre - ce;
#pragma unroll
                for (int j = 0; j < 8; ++j) { const unsigned k = (j & 1) ? (d[sg][j >> 1] >> 16) : (d[sg][j >> 1] & 0xffffu);
                    if (k == T) { if (r < need2) outw[ngt + r] = (unsigned short)(sg * 512 + lane * 8 + j); ++r; } }
                eqbase += __shfl(pre, 63);
            }
        }
        asm volatile("s_waitcnt lgkmcnt(0)" ::: "memory");
        ((unsigned*)so)[lane] = ((LAS unsigned*)outw)[lane];
        ((unsigned*)so)[64 + lane] = ((LAS unsigned*)outw)[64 + lane];
        asm volatile("s_waitcnt lgkmcnt(0)" ::: "memory");
    }
#undef SEL_DMA
#undef SEL_Q
    asm volatile("s_waitcnt vmcnt(0)" ::: "memory");
}

__device__ __forceinline__ void ret_fill_image(LAS unsigned char* img, const unsigned char* src, size_t row_stride_bytes, int wave, int lane) {
#pragma unroll
    for (int e4 = 0; e4 < 4; ++e4) {
        const int e = wave * 4 + e4, row = 4 * e + (lane >> 4), q = (lane & 15) ^ ((row & 7) << 1);
        __builtin_amdgcn_global_load_lds((const unsigned*)(src + (size_t)row * row_stride_bytes + q * 16), (LAS unsigned*)(img + e * 1024), 16, 0, 0);
    }
}
__device__ __forceinline__ pg8::bf16x8 ret_tr_pair(const LAS unsigned char* img, int row0, int chunk2, int lane) {
    const int g = lane >> 4, i = lane & 15, r0 = row0 + 4 * g + (i >> 2), pb = (i & 3) >> 1, half = (i & 1) * 8;
    const int r1 = r0 + 16;
    const v4i16_t lo = __builtin_amdgcn_ds_read_tr16_b64_v4i16((LAS v4i16_t*)(img + r0 * 256 + ((((chunk2) ^ ((r0 & 7) << 1)) | pb) << 4) + half));
    const v4i16_t hi = __builtin_amdgcn_ds_read_tr16_b64_v4i16((LAS v4i16_t*)(img + r1 * 256 + ((((chunk2) ^ ((r1 & 7) << 1)) | pb) << 4) + half));
    return (pg8::bf16x8){lo[0], lo[1], lo[2], lo[3], hi[0], hi[1], hi[2], hi[3]};
}
__device__ __forceinline__ void phase_ret_kv_mfma(const Params& P, unsigned char* lds_) {
    using pg8::bf16x8;
    const unsigned char* Z0 = (const unsigned char*)(P.ws + WS_Z0); float* KV = (float*)(P.ws + WS_KV);
    LAS unsigned char* Kimg = (LAS unsigned char*)lds_; LAS unsigned char* Vimg = Kimg + 32768;
    const int tid = threadIdx.x, lane = tid & 63, wave = __builtin_amdgcn_readfirstlane(tid >> 6), fr = lane & 15, fq = lane >> 4;
    for (int u = blockIdx.x; u < 1024; u += gridDim.x) {
        const int n = u & 63, h = (u >> 6) & 3, b = u >> 8;
        const size_t row0 = (size_t)b * SEQ + n * 128;
        __syncthreads();
        ret_fill_image(Kimg, Z0 + row0 * ZW * 2 + (512 + h * 128) * 2, ZW * 2, wave, lane);
        ret_fill_image(Vimg, Z0 + row0 * ZW * 2 + (1024 + h * 128) * 2, ZW * 2, wave, lane);
        asm volatile("s_waitcnt vmcnt(0)" ::: "memory");
        __syncthreads();
        bf16x8 va[4];
#pragma unroll
        for (int jc = 0; jc < 4; ++jc) va[jc] = ret_tr_pair(Vimg, 32 * jc, 2 * wave, lane);
        const float g127 = exp2f(ret_log2g(h) * 127.0f);
        float* o = KV + (size_t)u * 16384;
#pragma unroll
        for (int dt = 0; dt < 8; ++dt) {
            f32x4 acc = {0.f, 0.f, 0.f, 0.f};
#pragma unroll
            for (int jc = 0; jc < 4; ++jc) acc = __builtin_amdgcn_mfma_f32_16x16x32_bf16(va[jc], ret_tr_pair(Kimg, 32 * jc, 2 * dt, lane), acc, 0, 0, 0);
            *(f32x4*)(o + (size_t)(16 * dt + fr) * 128 + 16 * wave + 4 * fq) = acc * g127;
        }
    }
}
template <int W>
__device__ __forceinline__ void pool_item(const Params& P, int t0, int c8) {
    const bf16_t* Z0 = (const bf16_t*)(P.ws + WS_Z0); bf16_t* DP = (bf16_t*)(P.ws + WS_DP);
    const int tl0 = t0 & (SEQ - 1);
    u32x4 rows[W + 7];
#pragma unroll
    for (int r = 0; r < W + 7; ++r) { const int d = r - (W - 1);
        rows[r] = (tl0 + d >= 0) ? *(const u32x4*)(Z0 + (size_t)(t0 + d) * ZW + 2048 + c8) : (u32x4){0u, 0u, 0u, 0u}; }
    float sm[8];
#pragma unroll
    for (int j = 0; j < 8; ++j) sm[j] = 0.f;
#pragma unroll
    for (int r = 0; r < W; ++r) { const u32x4 v = rows[r];
        sm[0] += bflo(v.x); sm[1] += bfhi(v.x); sm[2] += bflo(v.y); sm[3] += bfhi(v.y); sm[4] += bflo(v.z); sm[5] += bfhi(v.z); sm[6] += bflo(v.w); sm[7] += bfhi(v.w); }
#pragma unroll
    for (int o = 0; o < 8; ++o) {
        const u32x4 v = rows[o + W - 1];
        if (o > 0) { const u32x4 q = rows[o - 1];
            sm[0] += bflo(v.x) - bflo(q.x); sm[1] += bfhi(v.x) - bfhi(q.x); sm[2] += bflo(v.y) - bflo(q.y); sm[3] += bfhi(v.y) - bfhi(q.y);
            sm[4] += bflo(v.z) - bflo(q.z); sm[5] += bfhi(v.z) - bfhi(q.z); sm[6] += bflo(v.w) - bflo(q.w); sm[7] += bfhi(v.w) - bfhi(q.w); }
        const float inv = __builtin_amdgcn_rcpf((float)min(tl0 + o + 1, W));
        u32x4 w; w.x = pk2(sm[0] * inv - bflo(v.x), sm[1] * inv - bfhi(v.x)); w.y = pk2(sm[2] * inv - bflo(v.y), sm[3] * inv - bfhi(v.y));
        w.z = pk2(sm[4] * inv - bflo(v.z), sm[5] * inv - bfhi(v.z)); w.w = pk2(sm[6] * inv - bflo(v.w), sm[7] * inv - bfhi(v.w));
        *(u32x4*)(DP + (size_t)(t0 + o) * 512 + c8) = w;
    }
}
__device__ __forceinline__ void phase_ret_scan_pool2(const Params& P) {
    const float* KV = (const float*)(P.ws + WS_KV); bf16_t* SB = (bf16_t*)(P.ws + WS_SB);
    const size_t gt = (size_t)blockIdx.x * NT + threadIdx.x, GS = (size_t)gridDim.x * NT;
    for (size_t i = gt; i < (size_t)16 * 8192; i += GS) {
        const int s = (int)(i >> 13), e2 = (int)(i & 8191), h = s & 3;
        const float l2 = ret_log2g(h), cd = exp2f(l2 * 128.0f), g1 = exp2f(l2);
        typedef float f32x2v __attribute__((ext_vector_type(2)));
        const f32x2v* p = (const f32x2v*)(KV + (size_t)s * 64 * 16384) + e2;
        unsigned* q = (unsigned*)(SB + (size_t)s * 64 * 16384) + e2;
        f32x2v R = {0.f, 0.f};
        for (int n0 = 0; n0 < 64; n0 += 32) {
            f32x2v kv[32];
#pragma unroll
            for (int j = 0; j < 32; ++j) kv[j] = __builtin_nontemporal_load(p + (size_t)(n0 + j) * 8192);
#pragma unroll
            for (int j = 0; j < 32; ++j) { q[(size_t)(n0 + j) * 8192] = pk2(R.x * g1, R.y * g1); R = R * cd + kv[j]; }
        }
    }
    const int lane = threadIdx.x & 63, gwv = (int)blockIdx.x * NWAVE + (int)(threadIdx.x >> 6), NGWv = (int)gridDim.x * NWAVE;
    for (int wi = gwv; wi < 2048; wi += NGWv) {
#pragma unroll
        for (int half = 0; half < 2; ++half) {
            const int slot = wi & 1023, gsel = wi >> 10, g = half ? 3 - gsel : gsel;
            const int t0 = (slot * 4 + (lane >> 4)) * 8, c8 = g * 128 + (lane & 15) * 8;
            if (g == 0) pool_item<2>(P, t0, c8); else if (g == 1) pool_item<4>(P, t0, c8); else if (g == 2) pool_item<8>(P, t0, c8); else pool_item<16>(P, t0, c8);
        }
    }
}
__device__ __forceinline__ void phase_ret_out_mfma(const Params& P, unsigned char* lds_) {
    using pg8::bf16x8;
    const unsigned char* Z0 = (const unsigned char*)(P.ws + WS_Z0); const unsigned char* SB = (const unsigned char*)(P.ws + WS_SB); bf16_t* MIX = (bf16_t*)(P.ws + WS_MIX);
    const float* gn = P.in[3];
    LAS unsigned char* Kimg = (LAS unsigned char*)lds_; LAS unsigned char* Vimg = Kimg + 32768; LAS unsigned char* Rimg = Kimg + 65536;
    const int tid = threadIdx.x, lane = tid & 63, wave = __builtin_amdgcn_readfirstlane(tid >> 6), fr = lane & 15, fq = lane >> 4;
    for (int u = blockIdx.x; u < 1024; u += gridDim.x) {
        const int n = u & 63, h = (u >> 6) & 3, b = u >> 8;
        const size_t row0 = (size_t)b * SEQ + n * 128;
        __syncthreads();
        ret_fill_image(Kimg, Z0 + row0 * ZW * 2 + (512 + h * 128) * 2, ZW * 2, wave, lane);
        ret_fill_image(Vimg, Z0 + row0 * ZW * 2 + (1024 + h * 128) * 2, ZW * 2, wave, lane);
        ret_fill_image(Rimg, SB + (size_t)u * 32768, 256, wave, lane);
        const bf16_t* qrow = (const bf16_t*)Z0 + (row0 + 16 * wave + fr) * ZW + h * 128;
        bf16x8 qf[4], qr[4];
#pragma unroll
        for (int c = 0; c < 4; ++c) {
            qf[c] = *(const bf16x8*)(qrow + 32 * c + 8 * fq);
            const u32x2 a = *(const u32x2*)(qrow + 32 * c + 4 * fq), bb = *(const u32x2*)(qrow + 32 * c + 16 + 4 * fq);
            u32x4 w; w.x = a.x; w.y = a.y; w.z = bb.x; w.w = bb.y; qr[c] = __builtin_bit_cast(bf16x8, w);
        }
        asm volatile("s_waitcnt vmcnt(0)" ::: "memory");
        __syncthreads();
        f32x4 sT[8];
#pragma unroll
        for (int jt = 0; jt < 8; ++jt) sT[jt] = (f32x4){0.f, 0.f, 0.f, 0.f};
#pragma unroll
        for (int jp = 0; jp < 4; ++jp) if (2 * jp <= wave) {
            bf16x8 a[8];
#pragma unroll
            for (int t2 = 0; t2 < 2; ++t2) { const int r = 16 * (2 * jp + t2) + fr;
#pragma unroll
                for (int c = 0; c < 4; ++c) a[t2 * 4 + c] = *(const LAS bf16x8*)(Kimg + r * 256 + ((((4 * c + fq)) ^ ((r & 7) << 1)) << 4)); }
            __builtin_amdgcn_sched_barrier(0);
#pragma unroll
            for (int t2 = 0; t2 < 2; ++t2)
#pragma unroll
                for (int c = 0; c < 4; ++c) sT[2 * jp + t2] = __builtin_amdgcn_mfma_f32_16x16x32_bf16(a[t2 * 4 + c], qf[c], sT[2 * jp + t2], 0, 0, 0);
            __builtin_amdgcn_sched_barrier(0);
        }
#pragma unroll
        for (int jt = 0; jt < 8; ++jt) {
            if (jt == wave) {
                if (4 * fq + 0 > fr) sT[jt].x = 0.f; if (4 * fq + 1 > fr) sT[jt].y = 0.f; if (4 * fq + 2 > fr) sT[jt].z = 0.f; if (4 * fq + 3 > fr) sT[jt].w = 0.f;
            }
            if (jt > wave) sT[jt] = (f32x4){0.f, 0.f, 0.f, 0.f};
        }
        bf16x8 pT[4];
#pragma unroll
        for (int jp = 0; jp < 4; ++jp) { u32x4 w; w.x = pk2(sT[2 * jp].x, sT[2 * jp].y); w.y = pk2(sT[2 * jp].z, sT[2 * jp].w); w.z = pk2(sT[2 * jp + 1].x, sT[2 * jp + 1].y); w.w = pk2(sT[2 * jp + 1].z, sT[2 * jp + 1].w);
            pT[jp] = __builtin_bit_cast(bf16x8, w); }
        f32x4 O[8];
        const int nact = (wave >> 1) + 1;
#pragma unroll
        for (int vt = 0; vt < 8; ++vt) {
            bf16x8 rr[4], vv[4];
#pragma unroll
            for (int c = 0; c < 4; ++c) rr[c] = ret_tr_pair(Rimg, 32 * c, 2 * vt, lane);
#pragma unroll
            for (int jp = 0; jp < 4; ++jp) vv[jp] = (jp < nact) ? ret_tr_pair(Vimg, 32 * jp, 2 * vt, lane) : pT[jp];
            __builtin_amdgcn_sched_barrier(0);
            f32x4 acc = {0.f, 0.f, 0.f, 0.f};
#pragma unroll
            for (int c = 0; c < 4; ++c) acc = __builtin_amdgcn_mfma_f32_16x16x32_bf16(rr[c], qr[c], acc, 0, 0, 0);
#pragma unroll
            for (int jp = 0; jp < 4; ++jp) acc = __builtin_amdgcn_mfma_f32_16x16x32_bf16(vv[jp], pT[jp], acc, 0, 0, 0);
            __builtin_amdgcn_sched_barrier(0);
            O[vt] = acc;
        }
        float sm = 0.f;
#pragma unroll
        for (int vt = 0; vt < 8; ++vt) sm += (O[vt].x + O[vt].y) + (O[vt].z + O[vt].w);
        sm += __shfl_xor(sm, 16); sm += __shfl_xor(sm, 32);
        const float mu = sm * (1.0f / 128.0f);
        float sq = 0.f;
#pragma unroll
        for (int vt = 0; vt < 8; ++vt) { const f32x4 dlt = O[vt] - mu; sq += (dlt.x * dlt.x + dlt.y * dlt.y) + (dlt.z * dlt.z + dlt.w * dlt.w); }
        sq += __shfl_xor(sq, 16); sq += __shfl_xor(sq, 32);
        const float rstd = __builtin_amdgcn_rsqf(sq * (1.0f / 128.0f) + LN_EPS);
        const bf16_t* grow = (const bf16_t*)Z0 + (row0 + 16 * wave + fr) * ZW + 1536 + h * 128 + 4 * fq;
        bf16_t* orow = MIX + (row0 + 16 * wave + fr) * DM + h * 128 + 4 * fq;
#pragma unroll
        for (int vt = 0; vt < 8; ++vt) {
            const u32x2 gv = *(const u32x2*)(grow + 16 * vt);
            const f32x4 g4 = *(const f32x4*)(gn + h * 128 + 16 * vt + 4 * fq);
            const f32x4 y = (O[vt] - mu) * rstd * g4;
            u32x2 w; w.x = pk2(y.x * silu_f(bflo(gv.x)), y.y * silu_f(bfhi(gv.x))); w.y = pk2(y.z * silu_f(bflo(gv.y)), y.w * silu_f(bfhi(gv.y)));
            *(u32x2*)(orow + 16 * vt) = w;
        }
    }
}

#define XB_TMO      128
#define XB_XCNT(j)  (256  + 64 * (j))
#define XB_XSUB(j)  (1280 + 64 * (j))
#define XB_XGEN(j)  (2304 + 64 * (j))
#define XB_TOP      3328
#define XB_TOPGEN   3392
#define XCD_BAR_WORDS 3456
#define XB_SPIN_CAP (1u << 22)
__device__ __forceinline__ unsigned xb_ld(unsigned* p)              { return __hip_atomic_load(p, __ATOMIC_RELAXED, __HIP_MEMORY_SCOPE_AGENT); }
__device__ __forceinline__ unsigned xb_add(unsigned* p, unsigned v) { return __hip_atomic_fetch_add(p, v, __ATOMIC_RELAXED, __HIP_MEMORY_SCOPE_AGENT); }
__device__ __forceinline__ unsigned xb_xcc_id() { return (unsigned)__builtin_amdgcn_s_getreg((3 << 11) | 20) & 0xFu; }
#define XB_SPIN(cond, bar) do { unsigned _sp = 0; while (cond) { __builtin_amdgcn_s_sleep(1); \
    if ((++_sp & 255u) == 0u) { if (xb_ld(&(bar)[XB_TMO])) break; if (_sp > XB_SPIN_CAP) { atomicAdd(&(bar)[XB_TMO], 1u); break; } } } } while (0)
struct XcdBarrier { unsigned* bar; unsigned x; volatile LAS unsigned* st; };
__device__ __forceinline__ XcdBarrier xcd_barrier_post(unsigned* bar, volatile LAS unsigned* st) {
    XcdBarrier b; b.bar = bar; b.x = xb_xcc_id(); b.st = st;
    if (threadIdx.x == 0) (void)xb_add(&bar[XB_XCNT(b.x)], 1u);
    return b;
}
__device__ __forceinline__ void xcd_barrier_complete(unsigned* bar, unsigned x, unsigned& nloc, unsigned& nx) {
    const unsigned G = gridDim.x * gridDim.y * gridDim.z;
    unsigned sum, cnt, mine, sp = 0u;
    for (;;) {
        sum = 0u; cnt = 0u; mine = 0u;
#pragma unroll
        for (unsigned j = 0; j < 16; ++j) { const unsigned c = xb_ld(&bar[XB_XCNT(j)]); sum += c; cnt += (c > 0u) ? 1u : 0u; mine = (j == x) ? c : mine; }
        if (sum == G) break;
        __builtin_amdgcn_s_sleep(1);
        if ((++sp & 255u) == 0u) { if (xb_ld(&bar[XB_TMO])) break; if (sp > XB_SPIN_CAP) { atomicAdd(&bar[XB_TMO], 1u); break; } }
    }
    nloc = mine > 0u ? mine : 1u; nx = cnt > 0u ? cnt : 1u;
}
__device__ __forceinline__ void xcd_barrier(const XcdBarrier& b) {
    asm volatile("s_waitcnt vmcnt(0)" ::: "memory");
    __syncthreads();
    if (threadIdx.x == 0) {
        unsigned* bar = b.bar;
        __builtin_amdgcn_s_waitcnt(0);
        unsigned nloc = b.st[0], nx = b.st[1];
        if (nloc == 0u) { xcd_barrier_complete(bar, b.x, nloc, nx); b.st[0] = nloc; b.st[1] = nx; }
        const unsigned old = xb_add(&bar[XB_XSUB(b.x)], 1u);
        const unsigned gen = old / nloc;
        if (old + 1u == (gen + 1u) * nloc) {
            __builtin_amdgcn_fence(__ATOMIC_RELEASE, "agent");
            asm volatile("s_waitcnt vmcnt(0)" ::: "memory");
            const unsigned og = xb_add(&bar[XB_TOP], 1u);
            const unsigned tg = og / nx;
            if (og + 1u == (tg + 1u) * nx) xb_add(&bar[XB_TOPGEN], 1u);
            else XB_SPIN(xb_ld(&bar[XB_TOPGEN]) == tg, bar);
            __builtin_amdgcn_fence(__ATOMIC_ACQUIRE, "agent");
            xb_add(&bar[XB_XGEN(b.x)], 1u);
            asm volatile("s_waitcnt vmcnt(0)" ::: "memory");
        } else {
            XB_SPIN(xb_ld(&bar[XB_XGEN(b.x)]) == gen, bar);
            __builtin_amdgcn_fence(__ATOMIC_ACQUIRE, "agent");
            asm volatile("s_waitcnt vmcnt(0)" ::: "memory");
        }
    }
    __syncthreads();
}
constexpr size_t CTL_BAR_OFF = 16384;
constexpr size_t CTL_ZERO_BYTES = 65536;

#ifdef PH_ONLY
#define IN(k) ((k) == PH_ONLY)
#else
#define IN(k) (lo <= (k) && (k) < hi)
#endif
#define SEAM(k) do { if (IN(k) && IN((k) + 1)) xcd_barrier(grid); } while (0)
#ifndef PROBE_DUP
#define PROBE_DUP (-1)
#endif
#define REP(k) for (int _rep = 0; _rep < ((PROBE_DUP == (k)) ? 2 : 1); ++_rep)
#define REPS(k) ((PROBE_DUP == 100 + (k)) ? 2 : 1)

template <int LAYER, int BASE>
__device__ __forceinline__ void layer_tail(const Params& P, unsigned char* lds, const XcdBarrier& grid, int lo, int hi) {
    unsigned char* ws = P.ws;
    int* tb = (int*)(lds + MISC_OFF);
    if (IN(BASE)) { if (PROBE_DUP == BASE) phase_ln_route<true>(P, lds, LAYER); phase_ln_route<false>(P, lds, LAYER); }
    SEAM(BASE);
    if (IN(BASE + 1)) REP(BASE + 1) { moe_setup(P, tb, LAYER);
        MoeSched S{tb, tb + 64, (const int*)(ws + WS_LIST), (const bf16_t*)(ws + WS_XB),
                   (const bf16_t*)(ws + WS_W_GU) + (size_t)LAYER * 32 * DM * DM, DM, (size_t)DM * DM, true};
        EpiGU E{(bf16_t*)(ws + WS_ACT)}; gemm_moe<true>(lds, S, E);
        { const int U = tb[32] * 4, G = (int)gridDim.x, nheavy = (U % G), nlight = G - nheavy, lr = (int)blockIdx.x - nheavy;
          DenseSched S2{(const bf16_t*)(ws + WS_PB) + (size_t)LAYER * NTOK * 256, (const bf16_t*)(ws + WS_W_P) + (size_t)LAYER * DM * 256, NTOK, DM, 256, 256, 0, 1, lr, nlight};
          EpiStoreBf16 E2{(bf16_t*)(ws + WS_PP), DM, 0, nullptr}; gemm_dense(lds, S2, E2); } }
    SEAM(BASE + 1);
    if (IN(BASE + 2)) REP(BASE + 2) { if (!IN(BASE + 1)) moe_setup(P, tb, LAYER);
        MoeSched S{tb, tb + 64, (const int*)(ws + WS_LIST), (const bf16_t*)(ws + WS_ACT),
                   (const bf16_t*)(ws + WS_W_DN) + (size_t)LAYER * 32 * DM * 512, 512, (size_t)DM * 512, false};
        EpiDown E{(bf16_t*)(ws + WS_YS)}; gemm_moe<false>(lds, S, E); }
    SEAM(BASE + 2);
    if (IN(BASE + 3)) { if (PROBE_DUP == BASE + 3) phase_ln2<true>(P, LAYER); phase_ln2<false>(P, LAYER); }
    SEAM(BASE + 3);
    if (IN(BASE + 4)) REP(BASE + 4) {
        { DenseSched S{(const bf16_t*)(ws + WS_XB), (const bf16_t*)(ws + WS_W_G) + (size_t)LAYER * DM * DM, NTOK, DM, DM, DM, 0, REPS(BASE + 4)};
          EpiPle E{(const bf16_t*)(ws + WS_XB), (const bf16_t*)(ws + WS_PP), LAYER == 1 ? P.out : (float*)nullptr, LAYER == 1 ? (bf16_t*)nullptr : (bf16_t*)(ws + WS_XB2)}; gemm_dense(lds, S, E); }
    }
}

__global__ void __launch_bounds__(NT, 2) mega(Params P, int lo, int hi) {
    extern __shared__ __attribute__((aligned(16))) unsigned char lds[];
    unsigned char* ws = P.ws;
    if (threadIdx.x < 16) ((LAS unsigned*)((LAS unsigned char*)lds + BARW_OFF))[threadIdx.x] = 0u;
    __syncthreads();
    const XcdBarrier grid = xcd_barrier_post((unsigned*)(ws + WS_CTL + CTL_BAR_OFF), (volatile LAS unsigned*)((LAS unsigned char*)lds + BARW_OFF));
    if (IN(0)) REP(0) phase_prep(P, lds);
    SEAM(0);
    if (IN(1)) REP(1) { DenseSched S{(const bf16_t*)(ws + WS_XB), (const bf16_t*)(ws + WS_W_IN0), NTOK, ZW, DM, DM, 0, REPS(1)};
        EpiZ0 E{(bf16_t*)(ws + WS_Z0)}; gemm_dense(lds, S, E); }
    SEAM(1);
    if (IN(2)) REP(2) phase_ret_kv_mfma(P, lds);
    SEAM(2);
    if (IN(3)) REP(3) phase_ret_scan_pool2(P);
    SEAM(3);
    if (IN(4)) REP(4) { phase_ret_out_mfma(P, lds); __syncthreads();
        DenseSched S{(const bf16_t*)(ws + WS_DP), (const bf16_t*)(ws + WS_W_POOL), NTOK, 512, 256, 512, 256};
        EpiStoreBf16S E{(bf16_t*)(ws + WS_MIX), DM, 512, P.in[5]}; gemm_dense(lds, S, E); }
    SEAM(4);
    if (IN(5)) REP(5) { DenseSched S{(const bf16_t*)(ws + WS_MIX), (const bf16_t*)(ws + WS_W_OUT0), NTOK, DM, DM, DM, 0, REPS(5)};
        EpiResidB E{(const bf16_t*)(ws + WS_XB), (bf16_t*)(ws + WS_F)}; gemm_dense(lds, S, E); }
    SEAM(5);
    layer_tail<0, 6>(P, lds, grid, lo, hi);
    SEAM(10);
    if (IN(11)) REP(11) { DenseSched S{(const bf16_t*)(ws + WS_XB2), (const bf16_t*)(ws + WS_W_CIN), NTOK, Z1W, DM, DM, 0, REPS(11)}; S.nvalid_cols = CIN;
        EpiStoreBf16 E{(bf16_t*)(ws + WS_Z1), Z1W, 0, nullptr}; gemm_dense(lds, S, E); }
    SEAM(11);
    if (IN(12)) REP(12) { phase_norms(P); phase_index_scores(P, lds); }
    SEAM(12);
    if (IN(13)) { if (PROBE_DUP == 13) phase_index_select<PROBE_SEL>(P, lds); phase_index_select<0>(P, lds); }
    if (IN(13) && IN(14)) __syncthreads();
    if (IN(14)) REP(14) { DenseSched S{(const bf16_t*)(ws + WS_CQ), (const bf16_t*)(ws + WS_W_QA), NTOK, 4096, 256, 256, 0, REPS(14)};
        EpiStoreFp8 E{(unsigned char*)(ws + WS_QA), 4096}; gemm_dense(lds, S, E); }
    SEAM(14);
    if (IN(15)) { if (PROBE_DUP == 15) phase_sparse_attn_e<true>(P, lds); phase_sparse_attn_e<false>(P, lds); }
    SEAM(15);
    if (IN(16)) REP(16) { DenseSched S{(const bf16_t*)(ws + WS_OLAT), (const bf16_t*)(ws + WS_W_UVBD), NTOK, DM, DM, 4096, 1024, REPS(16)};
        EpiStoreBf16 E{(bf16_t*)(ws + WS_XB), DM, 0, nullptr}; gemm_dense_bdiag(lds, S, E); }
    SEAM(16);
    if (IN(17)) REP(17) { DenseSched S{(const bf16_t*)(ws + WS_XB), (const bf16_t*)(ws + WS_W_COUT), NTOK, DM, DM, DM, 0, REPS(17)};
        EpiResidB E{(const bf16_t*)(ws + WS_XB2), (bf16_t*)(ws + WS_F)}; gemm_dense(lds, S, E); }
    SEAM(17);
    layer_tail<1, 18>(P, lds, grid, lo, hi);
}
#undef IN
#undef SEAM

extern "C" void kernel_launch(void* const* d_in, const int* in_sizes, int n_in, void* d_out, int out_size, void* d_ws, size_t ws_size, hipStream_t stream) {
    static int grid = 0;
    if (grid == 0) {
        if (n_in != 26 || ws_size < WS_END || out_size != NTOK * DM) { fprintf(stderr, "kernel_launch: unexpected problem (n_in %d, ws %zu, out %d)\n", n_in, ws_size, out_size); grid = -1; return; }
        int dev = 0, cus = 0, per_cu = 0;
        (void)hipGetDevice(&dev);
        (void)hipDeviceGetAttribute(&cus, hipDeviceAttributeMultiprocessorCount, dev);
        (void)hipFuncSetAttribute((const void*)mega, hipFuncAttributeMaxDynamicSharedMemorySize, LDS_BYTES);
        (void)hipOccupancyMaxActiveBlocksPerMultiprocessor(&per_cu, (const void*)mega, NT, LDS_BYTES);
        if (per_cu < 1) { fprintf(stderr, "kernel_launch: occupancy query reports %d blocks per CU\n", per_cu); per_cu = 1; }
        (void)hipGetLastError();
        grid = cus;
    }
    if (grid < 0) return;
    (void)hipMemsetAsync((char*)d_ws + WS_CTL, 0, CTL_ZERO_BYTES, stream);
    Params p{};
    for (int i = 0; i < 26; ++i) p.in[i] = (const float*)d_in[i];
    p.out = (float*)d_out; p.ws = (unsigned char*)d_ws;
#if MK_ONE_LAUNCH
    int lo = 0, hi = NPH_TOTAL;
    void* args[] = {&p, &lo, &hi};
    (void)args;
    hipLaunchKernelGGL(mega, dim3(grid), dim3(NT), LDS_BYTES, stream, p, lo, hi);
    hipError_t e = hipPeekAtLastError();
    if (e != hipSuccess) fprintf(stderr, "launch failed: %s (grid %d)\n", hipGetErrorString(e), grid);
#else
    for (int k = 0; k < NPH_TOTAL; ++k) hipLaunchKernelGGL(mega, dim3(grid), dim3(NT), LDS_BYTES, stream, p, k, k + 1);
#endif
}
```
